# Optimizing an MI355X kernel written in HIP

```python
import math
import jax
import jax.numpy as jnp
from jax import lax
import numpy as np


D_MODEL = 1024
BATCH = 8
SEQ = 4096
DEPTH = 2

EPS = 1e-6
NEG_INF = -1e30
FORCED_SCORE = 1e9
NSA_HEADS = 8
NSA_KV_GROUPS = 2
NSA_HEAD_DIM = 64
CMP_BLOCK = 32
CMP_STRIDE = 16
CMP_HIDDEN = 256
SEL_BLOCK = 64
SEL_TOP_N = 16
WINDOW = 512
NSA_Q_BLOCK = 64
MLA_HEADS = 8
MLA_Q_RANK = 256
MLA_KV_RANK = 128
MLA_NOPE_DIM = 64
MLA_ROPE_DIM = 32
MLA_V_DIM = 64
ROPE_THETA = 10000.0
ATTN_Q_BLOCK = 128
REL_BUCKETS = 32
REL_MAX_DIST = 128
CONV_WIDTH = 3
D_FF = 2816
N_EXPERTS = 8
TOP_K = 2
D_FF_EXPERT = 1408
MOE_ROW_BLOCK = 256
NSA_Q_W = NSA_HEADS * NSA_HEAD_DIM
NSA_KV_W = NSA_KV_GROUPS * NSA_HEAD_DIM
NSA_GATE_W = NSA_HEADS * 3
EVEN_IN_SIZES = (NSA_Q_W,) + (NSA_KV_W,) * 6 + (NSA_GATE_W, MLA_Q_RANK, MLA_KV_RANK, MLA_ROPE_DIM)
EVEN_IN_W = sum(EVEN_IN_SIZES)
MIX_OUT_W = NSA_HEADS * NSA_HEAD_DIM + MLA_HEADS * MLA_V_DIM

kernel_name = 'hybrid_nsa_mla_shortconv_moe'


def rms_norm(x, g):
    xf = x.astype(jnp.float32)
    y = xf * lax.rsqrt(jnp.mean(jnp.square(xf), axis=-1, keepdims=True) + EPS)
    return (y * g.astype(jnp.float32)).astype(x.dtype)


def masked_softmax(s, mask):
    p = jax.nn.softmax(jnp.where(mask, s, NEG_INF), axis=-1)
    return jnp.where(mask, p, 0.0)


def t5_bucket(dist):
    n = jnp.maximum(dist, 0)
    max_exact = REL_BUCKETS // 2
    nf = jnp.maximum(n, max_exact).astype(jnp.float32)
    large = max_exact + (jnp.log(nf / max_exact) / math.log(REL_MAX_DIST / max_exact)
                         * (REL_BUCKETS - max_exact)).astype(jnp.int32)
    return jnp.where(n < max_exact, n, jnp.minimum(large, REL_BUCKETS - 1))


def rope(x, pos):
    half = x.shape[-1] // 2
    inv_freq = ROPE_THETA ** (-jnp.arange(half, dtype=jnp.float32) / half)
    ang = pos.astype(jnp.float32)[:, None] * inv_freq[None, :]
    cos = jnp.cos(ang)[:, None, :]
    sin = jnp.sin(ang)[:, None, :]
    xf = x.astype(jnp.float32)
    x1, x2 = xf[..., :half], xf[..., half:]
    return jnp.concatenate([x1 * cos - x2 * sin, x1 * sin + x2 * cos], axis=-1).astype(x.dtype)


def compress(kv, pos_emb, w1, w2):
    B, S, G, dk = kv.shape
    nc = (S - CMP_BLOCK) // CMP_STRIDE + 1
    idx = jnp.arange(nc)[:, None] * CMP_STRIDE + jnp.arange(CMP_BLOCK)[None, :]
    blk = kv[:, idx] + pos_emb[None, None, :, None, :]
    blk = blk.transpose(0, 1, 3, 2, 4).reshape(B, nc, G, CMP_BLOCK * dk)
    return jax.nn.gelu(blk @ w1) @ w2


def nsa_mixer(q, k_cmp, v_cmp, k_sel, v_sel, k_win, v_win, gates, rel_bias,
              q_norm, k_norm, cmp_pos, cmp_w1, cmp_w2):
    B, S = q.shape[0], q.shape[1]
    G, R, dk = NSA_KV_GROUPS, NSA_HEADS // NSA_KV_GROUPS, NSA_HEAD_DIM
    QB, L = NSA_Q_BLOCK, WINDOW + NSA_Q_BLOCK
    scale = dk ** -0.5
    qn = rms_norm(q, q_norm).reshape(B, S, G, R, dk)
    kc = rms_norm(compress(k_cmp, cmp_pos[0], cmp_w1[0], cmp_w2[0]), k_norm[0])
    vc = compress(v_cmp, cmp_pos[1], cmp_w1[1], cmp_w2[1])
    nc = kc.shape[1]
    ns = S // SEL_BLOCK
    n_top = min(SEL_TOP_N, ns)

    def to_blocks(a):
        return a.reshape(B, ns, SEL_BLOCK, G, dk).transpose(0, 3, 1, 2, 4).reshape(B, G, ns, SEL_BLOCK * dk)

    ks_blk = to_blocks(rms_norm(k_sel, k_norm[1]))
    vs_blk = to_blocks(v_sel)
    pad = ((0, 0), (WINDOW, 0), (0, 0), (0, 0))
    kw_pad = jnp.pad(rms_norm(k_win, k_norm[2]), pad)
    vw_pad = jnp.pad(v_win, pad)
    gate_all = gates.reshape(B, S, G, R, 3)

    cmp_start = jnp.arange(nc) * CMP_STRIDE
    cmp_end = cmp_start + CMP_BLOCK - 1
    sel_start = jnp.arange(ns) * SEL_BLOCK
    overlap = ((cmp_start[:, None] < sel_start[None, :] + SEL_BLOCK)
               & (cmp_end[:, None] >= sel_start[None, :])).astype(jnp.float32)
    bias_gr = rel_bias.reshape(REL_BUCKETS, G, R)
    g_idx = jnp.arange(G)[None, :, None, None, None]
    blk_ids = jnp.arange(ns)
    offs_sel = jnp.arange(SEL_BLOCK)
    flat = n_top * SEL_BLOCK

    def one_block(i):
        q0 = i * QB
        t = q0 + jnp.arange(QB)
        qb = lax.dynamic_slice_in_dim(qn, q0, QB, axis=1)
        d_c = t[:, None] - cmp_end[None, :]
        s_c = jnp.einsum('bqgrd,bcgd->bgrqc', qb, kc).astype(jnp.float32) * scale
        s_c = s_c + bias_gr[t5_bucket(d_c)].transpose(2, 3, 0, 1).astype(jnp.float32)
        p_c = masked_softmax(s_c, d_c >= 0)
        o_c = jnp.einsum('bgrqc,bcgd->bqgrd', p_c.astype(vc.dtype), vc)
        imp = jnp.einsum('bgrqc,cj->bgqj', p_c, overlap)
        forced = (blk_ids[None, :] == (t // SEL_BLOCK)[:, None]) | (blk_ids[None, :] == 0)
        imp = jnp.where(forced, FORCED_SCORE, imp)
        imp = jnp.where(sel_start[None, :] <= t[:, None], imp, -1.0)
        _, sel = lax.top_k(imp, n_top)
        sel_flat = sel.reshape(B, G, QB * n_top, 1)
        k_g = jnp.take_along_axis(ks_blk, sel_flat, axis=2).reshape(B, G, QB, n_top, SEL_BLOCK, dk)
        v_g = jnp.take_along_axis(vs_blk, sel_flat, axis=2).reshape(B, G, QB, flat, dk)
        s_pos = sel[..., None] * SEL_BLOCK + offs_sel
        d_s = t[None, None, :, None, None] - s_pos
        s_s = jnp.einsum('bqgrd,bgqnkd->bgrqnk', qb, k_g).astype(jnp.float32) * scale
        s_s = s_s + jnp.moveaxis(bias_gr[t5_bucket(d_s), g_idx], -1, 2).astype(jnp.float32)
        p_s = masked_softmax(s_s.reshape(B, G, R, QB, flat), (d_s >= 0).reshape(B, G, 1, QB, flat))
        o_s = jnp.einsum('bgrqk,bgqkd->bqgrd', p_s.astype(v_g.dtype), v_g)
        k_w = lax.dynamic_slice_in_dim(kw_pad, q0, L, axis=1)
        v_w = lax.dynamic_slice_in_dim(vw_pad, q0, L, axis=1)
        w_pos = q0 - WINDOW + jnp.arange(L)
        d_w = t[:, None] - w_pos[None, :]
        s_w = jnp.einsum('bqgrd,bkgd->bgrqk', qb, k_w).astype(jnp.float32) * scale
        s_w = s_w + bias_gr[t5_bucket(d_w)].transpose(2, 3, 0, 1).astype(jnp.float32)
        p_w = masked_softmax(s_w, (d_w >= 0) & (d_w < WINDOW) & (w_pos[None, :] >= 0))
        o_w = jnp.einsum('bgrqk,bkgd->bqgrd', p_w.astype(v_w.dtype), v_w)
        g = jax.nn.sigmoid(lax.dynamic_slice_in_dim(gate_all, q0, QB, axis=1).astype(jnp.float32))
        o = g[..., 0:1] * o_c + g[..., 1:2] * o_s + g[..., 2:3] * o_w
        return o.astype(q.dtype)

    out = lax.map(one_block, jnp.arange(S // QB))
    return out.transpose(1, 0, 2, 3, 4, 5).reshape(B, S, NSA_HEADS * dk)


def causal_block_attention(q, k, v):
    B, S, H, dh = q.shape
    scale = dh ** -0.5
    key_pos = jnp.arange(S)

    def one_block(i):
        q0 = i * ATTN_Q_BLOCK
        qb = lax.dynamic_slice_in_dim(q, q0, ATTN_Q_BLOCK, axis=1)
        s = jnp.einsum('bqhd,bkhd->bhqk', qb, k).astype(jnp.float32) * scale
        mask = (q0 + jnp.arange(ATTN_Q_BLOCK))[:, None] >= key_pos[None, :]
        p = masked_softmax(s, mask)
        return jnp.einsum('bhqk,bkhd->bqhd', p.astype(v.dtype), v)

    out = lax.map(one_block, jnp.arange(S // ATTN_Q_BLOCK))
    return out.transpose(1, 0, 2, 3, 4).reshape(B, S, H, v.shape[-1])


def mla_mixer(c_q, c_kv, k_rope, cq_norm, ckv_norm, w_uq, w_ukv, q_norm, k_norm):
    B, S = c_q.shape[0], c_q.shape[1]
    H, dn, dr, dv = MLA_HEADS, MLA_NOPE_DIM, MLA_ROPE_DIM, MLA_V_DIM
    pos = jnp.arange(S)
    q = (rms_norm(c_q, cq_norm) @ w_uq).reshape(B, S, H, dn + dr)
    kv = (rms_norm(c_kv, ckv_norm) @ w_ukv).reshape(B, S, H, dn + dv)
    k = jnp.concatenate([kv[..., :dn], jnp.broadcast_to(k_rope[:, :, None, :], (B, S, H, dr))], axis=-1)
    v = kv[..., dn:]
    q = rms_norm(q, q_norm)
    k = rms_norm(k, k_norm)
    q = jnp.concatenate([q[..., :dn], rope(q[..., dn:], pos)], axis=-1)
    k = jnp.concatenate([k[..., :dn], rope(k[..., dn:], pos)], axis=-1)
    return causal_block_attention(q, k, v).reshape(B, S, H * dv)


def short_conv_mixer(u, b_gate, c_gate, conv_w):
    y = lax.conv_general_dilated(c_gate * u, conv_w[:, None, :], window_strides=(1,),
                                 padding=[(CONV_WIDTH - 1, 0)],
                                 dimension_numbers=('NWC', 'WIO', 'NWC'),
                                 feature_group_count=u.shape[-1])
    return b_gate * y


def swiglu(x, w_gate, w_up, w_down):
    return (jax.nn.silu(x @ w_gate) * (x @ w_up)) @ w_down


def moe_swiglu(x, w_router, b_router, w_gate, w_up, w_down):
    B, S, D = x.shape
    T = B * S
    RB = MOE_ROW_BLOCK
    xt = x.reshape(T, D)
    logits = (xt @ w_router).astype(jnp.float32) + b_router.astype(jnp.float32)
    top_logit, top_e = lax.top_k(logits, TOP_K)
    top_w = jax.nn.softmax(top_logit, axis=-1)
    P = T * TOP_K
    e_flat = top_e.reshape(P)
    tok_flat = jnp.arange(P) // TOP_K
    w_flat = top_w.reshape(P)
    order = jnp.argsort(e_flat)
    e_s, tok_s, w_s = e_flat[order], tok_flat[order], w_flat[order]
    counts = jnp.bincount(e_flat, length=N_EXPERTS)
    padded = (counts + RB - 1) // RB * RB
    start = jnp.cumsum(counts) - counts
    pad_end = jnp.cumsum(padded)
    pad_start = pad_end - padded
    dest = pad_start[e_s] + jnp.arange(P) - start[e_s]
    n_blk = (P + RB - 1) // RB + N_EXPERTS
    n_rows = n_blk * RB
    tok_buf = jnp.zeros((n_rows,), jnp.int32).at[dest].set(tok_s)
    w_buf = jnp.zeros((n_rows,), jnp.float32).at[dest].set(w_s)
    blk_expert = jnp.minimum(jnp.sum(pad_end[None, :] <= (jnp.arange(n_blk) * RB)[:, None], axis=1),
                             N_EXPERTS - 1)

    def one_block(args):
        e, toks, w = args
        xb = xt[toks]
        h = jax.nn.silu(xb @ w_gate[e]) * (xb @ w_up[e])
        return (h @ w_down[e]) * w[:, None].astype(h.dtype)

    out = lax.map(one_block, (blk_expert, tok_buf.reshape(n_blk, RB), w_buf.reshape(n_blk, RB)))
    y = jnp.zeros((T, D), x.dtype).at[tok_buf].add(out.reshape(n_rows, D).astype(x.dtype))
    return y.reshape(B, S, D)


def setup_inputs(seed: int = 0) -> dict:
    key = jax.random.key(seed)
    keys = iter(jax.random.split(key, 32))
    ne, no = (DEPTH + 1) // 2, DEPTH // 2

    def dense(shape, fan_in):
        return jax.random.normal(next(keys), shape, jnp.float32) * (fan_in ** -0.5)

    def gain(shape):
        return 1.0 + 0.02 * jax.random.normal(next(keys), shape, jnp.float32)

    def small(shape, scale):
        return scale * jax.random.normal(next(keys), shape, jnp.float32)

    cmp_in = CMP_BLOCK * NSA_HEAD_DIM
    mla_qk = MLA_NOPE_DIM + MLA_ROPE_DIM
    return {
        'x': jax.random.normal(next(keys), (BATCH, SEQ, D_MODEL), jnp.float32),
        'rel_bias': small((REL_BUCKETS, NSA_HEADS), 0.1),
        'ev_mix_norm': gain((ne, D_MODEL)),
        'ev_w_in': dense((ne, D_MODEL, EVEN_IN_W), D_MODEL),
        'nsa_q_norm': gain((ne, NSA_HEAD_DIM)),
        'nsa_k_norm': gain((ne, 3, NSA_HEAD_DIM)),
        'nsa_cmp_pos': small((ne, 2, CMP_BLOCK, NSA_HEAD_DIM), 0.02),
        'nsa_cmp_w1': dense((ne, 2, cmp_in, CMP_HIDDEN), cmp_in),
        'nsa_cmp_w2': dense((ne, 2, CMP_HIDDEN, NSA_HEAD_DIM), CMP_HIDDEN),
        'mla_cq_norm': gain((ne, MLA_Q_RANK)),
        'mla_ckv_norm': gain((ne, MLA_KV_RANK)),
        'mla_w_uq': dense((ne, MLA_Q_RANK, MLA_HEADS * mla_qk), MLA_Q_RANK),
        'mla_w_ukv': dense((ne, MLA_KV_RANK, MLA_HEADS * (MLA_NOPE_DIM + MLA_V_DIM)), MLA_KV_RANK),
        'mla_q_norm': gain((ne, mla_qk)),
        'mla_k_norm': gain((ne, mla_qk)),
        'ev_w_out': dense((ne, MIX_OUT_W, D_MODEL), MIX_OUT_W),
        'ev_ffn_norm': gain((ne, D_MODEL)),
        'ffn_w_gate': dense((ne, D_MODEL, D_FF), D_MODEL),
        'ffn_w_up': dense((ne, D_MODEL, D_FF), D_MODEL),
        'ffn_w_down': dense((ne, D_FF, D_MODEL), D_FF),
        'od_mix_norm': gain((no, D_MODEL)),
        'od_w_in': dense((no, D_MODEL, 3 * D_MODEL), D_MODEL),
        'conv_w': dense((no, CONV_WIDTH, D_MODEL), CONV_WIDTH),
        'od_w_out': dense((no, D_MODEL, D_MODEL), D_MODEL),
        'od_ffn_norm': gain((no, D_MODEL)),
        'moe_w_router': dense((no, D_MODEL, N_EXPERTS), D_MODEL),
        'moe_b_router': small((no, N_EXPERTS), 0.01),
        'moe_w_gate': dense((no, N_EXPERTS, D_MODEL, D_FF_EXPERT), D_MODEL),
        'moe_w_up': dense((no, N_EXPERTS, D_MODEL, D_FF_EXPERT), D_MODEL),
        'moe_w_down': dense((no, N_EXPERTS, D_FF_EXPERT, D_MODEL), D_FF_EXPERT),
    }


def reference(x, rel_bias, ev_mix_norm, ev_w_in, nsa_q_norm, nsa_k_norm, nsa_cmp_pos, nsa_cmp_w1,
              nsa_cmp_w2, mla_cq_norm, mla_ckv_norm, mla_w_uq, mla_w_ukv, mla_q_norm, mla_k_norm,
              ev_w_out, ev_ffn_norm, ffn_w_gate, ffn_w_up, ffn_w_down, od_mix_norm, od_w_in, conv_w,
              od_w_out, od_ffn_norm, moe_w_router, moe_b_router, moe_w_gate, moe_w_up, moe_w_down):
    B, S, _ = x.shape
    split_at = np.cumsum(EVEN_IN_SIZES)[:-1].tolist()
    kv_shape = (B, S, NSA_KV_GROUPS, NSA_HEAD_DIM)
    for layer in range(DEPTH):
        i = layer // 2
        if layer % 2 == 0:
            h = rms_norm(x, ev_mix_norm[i]) @ ev_w_in[i]
            (q, k_c, v_c, k_s, v_s, k_w, v_w, gates, c_q, c_kv, k_rope) = jnp.split(h, split_at, axis=-1)
            o_nsa = nsa_mixer(q.reshape(B, S, NSA_HEADS, NSA_HEAD_DIM),
                              k_c.reshape(kv_shape), v_c.reshape(kv_shape),
                              k_s.reshape(kv_shape), v_s.reshape(kv_shape),
                              k_w.reshape(kv_shape), v_w.reshape(kv_shape),
                              gates, rel_bias, nsa_q_norm[i], nsa_k_norm[i],
                              nsa_cmp_pos[i], nsa_cmp_w1[i], nsa_cmp_w2[i])
            o_mla = mla_mixer(c_q, c_kv, k_rope, mla_cq_norm[i], mla_ckv_norm[i],
                              mla_w_uq[i], mla_w_ukv[i], mla_q_norm[i], mla_k_norm[i])
            x = x + jnp.concatenate([o_nsa, o_mla], axis=-1) @ ev_w_out[i]
            x = x + swiglu(rms_norm(x, ev_ffn_norm[i]), ffn_w_gate[i], ffn_w_up[i], ffn_w_down[i])
        else:
            b_g, c_g, u = jnp.split(rms_norm(x, od_mix_norm[i]) @ od_w_in[i], 3, axis=-1)
            x = x + short_conv_mixer(u, b_g, c_g, conv_w[i]) @ od_w_out[i]
            x = x + moe_swiglu(rms_norm(x, od_ffn_norm[i]), moe_w_router[i], moe_b_router[i],
                               moe_w_gate[i], moe_w_up[i], moe_w_down[i])
    return x
```

```cpp
#include <hip/hip_runtime.h>
#include <hip/hip_bf16.h>
#include <stdint.h>
#include <stdio.h>
namespace gold {
constexpr int S = 4096, D = 1024, HW = 1720;
constexpr float EPS = 1e-6f;

__device__ const unsigned char T5B[128] = {0, 1, 2, 3, 4, 5, 6, 7, 8, 9, 10, 11, 12, 13, 14, 15, 16, 16, 16, 17, 17, 18, 18, 18, 19, 19, 19, 20, 20, 20, 20, 21, 21, 21, 21, 22, 22, 22, 22, 22, 23, 23, 23, 23, 23, 23, 24, 24, 24, 24, 24, 24, 25, 25, 25, 25, 25, 25, 25, 26, 26, 26, 26, 26, 26, 26, 26, 27, 27, 27, 27, 27, 27, 27, 27, 27, 27, 28, 28, 28, 28, 28, 28, 28, 28, 28, 28, 29, 29, 29, 29, 29, 29, 29, 29, 29, 29, 29, 29, 30, 30, 30, 30, 30, 30, 30, 30, 30, 30, 30, 30, 30, 30, 31, 31, 31, 31, 31, 31, 31, 31, 31, 31, 31, 31, 31, 31};

__device__ __forceinline__ float wsum(float v) {
#pragma unroll
    for (int o = 32; o > 0; o >>= 1) v += __shfl_xor(v, o);
    return v;
}
__device__ __forceinline__ float gelu_tanh(float x) { return 0.5f * x * (1.f + tanhf(0.7978845608028654f * (x + 0.044715f * x * x * x))); }
__device__ __forceinline__ float silu(float x) { return x / (1.f + expf(-x)); }

__global__ void rmsnorm_k(const float* x, int ldi, const float* g, float* out, int ldo, int Dn, int rows) {
    int row = blockIdx.x * (blockDim.x >> 6) + (threadIdx.x >> 6), lane = threadIdx.x & 63;
    if (row >= rows) return;
    const float* xr = x + (size_t)row * ldi; float s = 0.f;
    for (int i = lane; i < Dn; i += 64) { float v = xr[i]; s += v * v; }
    s = wsum(s); float r = rsqrtf(s / Dn + EPS);
    for (int i = lane; i < Dn; i += 64) out[(size_t)row * ldo + i] = xr[i] * r * g[i];
}

template <int MODE>
__global__ __launch_bounds__(256) void sgemm_k(const float* A, int lda, const int* rowidx, const float* B0, const float* B1, int ldb,
                                               const int* tile_e, size_t estride, float* C, int ldc, const float* R, const float* bias,
                                               int M, int N, int K) {
    __shared__ float As[16][68];
    __shared__ float Bs0[16][68];
    __shared__ float Bs1[MODE == 3 ? 16 : 1][68];
    const int tid = threadIdx.x, tx = tid & 15, ty = tid >> 4;
    const int m0 = blockIdx.y * 64, n0 = blockIdx.x * 64;
    size_t eoff = 0;
    if (tile_e) { int e = tile_e[blockIdx.y]; if (e < 0) return; eoff = (size_t)e * estride; }
    const int ar = tid >> 2, ak = (tid & 3) * 4;
    const int bk = tid >> 4, bn = (tid & 15) * 4;
    long arow = m0 + ar; bool avalid = true;
    if (rowidx) { int t = rowidx[m0 + ar]; avalid = t >= 0; arow = avalid ? t : 0; }
    const float* Ap = A + (size_t)arow * lda + ak;
    const bool bvalid = (n0 + bn) < N;
    const float* Bp0 = B0 + eoff + (size_t)bk * ldb + n0 + bn;
    const float* Bp1 = (MODE == 3) ? (B1 + eoff + (size_t)bk * ldb + n0 + bn) : nullptr;
    float acc0[4][4], acc1[4][4];
#pragma unroll
    for (int i = 0; i < 4; ++i)
#pragma unroll
        for (int j = 0; j < 4; ++j) { acc0[i][j] = 0.f; acc1[i][j] = 0.f; }
    for (int k0 = 0; k0 < K; k0 += 16) {
        float4 av = avalid ? *(const float4*)(Ap + k0) : make_float4(0.f, 0.f, 0.f, 0.f);
        float4 bv0 = bvalid ? *(const float4*)(Bp0 + (size_t)k0 * ldb) : make_float4(0.f, 0.f, 0.f, 0.f);
        float4 bv1 = make_float4(0.f, 0.f, 0.f, 0.f);
        if (MODE == 3) { if (bvalid) bv1 = *(const float4*)(Bp1 + (size_t)k0 * ldb); }
        __syncthreads();
        As[ak + 0][ar] = av.x; As[ak + 1][ar] = av.y; As[ak + 2][ar] = av.z; As[ak + 3][ar] = av.w;
        *(float4*)&Bs0[bk][bn] = bv0;
        if (MODE == 3) *(float4*)&Bs1[bk][bn] = bv1;
        __syncthreads();
#pragma unroll
        for (int k = 0; k < 16; ++k) {
            float4 a = *(const float4*)&As[k][ty * 4];
            float4 b = *(const float4*)&Bs0[k][tx * 4];
            float aa[4] = {a.x, a.y, a.z, a.w}, bb[4] = {b.x, b.y, b.z, b.w};
#pragma unroll
            for (int i = 0; i < 4; ++i)
#pragma unroll
                for (int j = 0; j < 4; ++j) acc0[i][j] += aa[i] * bb[j];
            if (MODE == 3) {
                float4 c = *(const float4*)&Bs1[k][tx * 4];
                float cc[4] = {c.x, c.y, c.z, c.w};
#pragma unroll
                for (int i = 0; i < 4; ++i)
#pragma unroll
                    for (int j = 0; j < 4; ++j) acc1[i][j] += aa[i] * cc[j];
            }
        }
    }
    const int col = n0 + tx * 4;
    if (col >= N) return;
#pragma unroll
    for (int i = 0; i < 4; ++i) {
        const int row = m0 + ty * 4 + i;
        if (row >= M) continue;
        float o[4];
#pragma unroll
        for (int j = 0; j < 4; ++j) {
            float v = acc0[i][j];
            if (MODE == 1) v += R[(size_t)row * ldc + col + j];
            if (MODE == 2) v = gelu_tanh(v + bias[col + j]);
            if (MODE == 3) v = silu(v) * acc1[i][j];
            o[j] = v;
        }
        *(float4*)(C + (size_t)row * ldc + col) = make_float4(o[0], o[1], o[2], o[3]);
    }
}

__global__ void nsa_prep_k(const float* h, const float* q_norm, const float* k_norm  , float* nq  ,
                           float* ks  , float* kw, float* kcin  , float* vcin) {
    int t = blockIdx.x * (blockDim.x >> 6) + (threadIdx.x >> 6), lane = threadIdx.x & 63;
    if (t >= S) return;
    const float* hr = h + (size_t)t * HW;
    for (int hh = 0; hh < 8; ++hh) { float v = hr[hh * 64 + lane]; float r = rsqrtf(wsum(v * v) / 64.f + EPS); nq[((size_t)t * 8 + hh) * 64 + lane] = v * r * q_norm[lane]; }
    for (int g = 0; g < 2; ++g) {
        float v = hr[768 + g * 64 + lane]; float r = rsqrtf(wsum(v * v) / 64.f + EPS); ks[((size_t)t * 2 + g) * 64 + lane] = v * r * k_norm[64 + lane];
        v = hr[1024 + g * 64 + lane]; r = rsqrtf(wsum(v * v) / 64.f + EPS); kw[((size_t)t * 2 + g) * 64 + lane] = v * r * k_norm[128 + lane];
        kcin[((size_t)g * S + t) * 64 + lane] = hr[512 + g * 64 + lane];
        vcin[((size_t)g * S + t) * 64 + lane] = hr[640 + g * 64 + lane];
    }
}
__global__ void zero_k(float* p, int n) { int i = blockIdx.x * blockDim.x + threadIdx.x; if (i < n) p[i] = 0.f; }
__global__ void cmp_bias_k(const float* pos  , const float* w1  , float* bias1  ) {
    int kv = blockIdx.x, n = threadIdx.x; float s = 0.f;
    for (int k = 0; k < 2048; ++k) s += pos[kv * 2048 + k] * w1[((size_t)kv * 2048 + k) * 256 + n];
    bias1[kv * 256 + n] = s;
}
__global__ void kc_norm_k(float* kc, const float* k_norm0) {
    int row = blockIdx.x * (blockDim.x >> 6) + (threadIdx.x >> 6), lane = threadIdx.x & 63;
    if (row >= 512) return;
    float v = kc[row * 64 + lane]; float r = rsqrtf(wsum(v * v) / 64.f + EPS); kc[row * 64 + lane] = v * r * k_norm0[lane];
}

__global__ __launch_bounds__(64) void nsa_cmp_k(const float* nq, const float* kc  , const float* vc, const float* rel_bias  ,
                                                float* oc, float* imp_h) {
    __shared__ float bias_s[129];
    const int hh = blockIdx.y, g = hh >> 2, q0 = blockIdx.x * 64, t = q0 + threadIdx.x;
    for (int i = threadIdx.x; i < 129; i += 64) bias_s[i] = rel_bias[(i < 128 ? (int)T5B[i] : 31) * 8 + hh];
    __syncthreads();
    float qv[64];
#pragma unroll
    for (int d = 0; d < 64; ++d) qv[d] = nq[((size_t)t * 8 + hh) * 64 + d] * 0.125f;
    const int nvalid = t >= 31 ? (t - 31) / 16 + 1 : 0;
    const int nmax = (q0 + 63 >= 31) ? (q0 + 63 - 31) / 16 + 1 : 0;
    const float* kcg = kc + (size_t)g * 256 * 64; const float* vcg = vc + (size_t)g * 256 * 64;
    float m = -1e30f, l = 0.f;
    for (int c = 0; c < nmax; ++c) {
        float s = 0.f;
#pragma unroll
        for (int d = 0; d < 64; ++d) s += qv[d] * kcg[c * 64 + d];
        int dist = t - (16 * c + 31);
        if (c < nvalid) { s += bias_s[dist < 128 ? dist : 128]; if (s > m) { l *= expf(m - s); m = s; } l += expf(s - m); }
    }
    float o[64];
#pragma unroll
    for (int d = 0; d < 64; ++d) o[d] = 0.f;
    const float il = l > 0.f ? 1.f / l : 0.f;
    float carry = 0.f, run = 0.f;
    for (int c = 0; c < 256; ++c) {
        float p = 0.f;
        if (c < nmax) {
            float s = 0.f;
#pragma unroll
            for (int d = 0; d < 64; ++d) s += qv[d] * kcg[c * 64 + d];
            int dist = t - (16 * c + 31);
            if (c < nvalid) { s += bias_s[dist < 128 ? dist : 128]; p = expf(s - m) * il; }
#pragma unroll
            for (int d = 0; d < 64; ++d) o[d] += p * vcg[c * 64 + d];
        }
        run += p;
        if ((c & 3) == 3) { imp_h[((size_t)hh * S + t) * 64 + (c >> 2)] = run + carry; carry = p; run = 0.f; }
    }
#pragma unroll
    for (int d = 0; d < 64; ++d) oc[((size_t)t * 8 + hh) * 64 + d] = o[d];
}

__global__ __launch_bounds__(64) void nsa_select_k(const float* imp_h, unsigned long long* selmask  ) {
    __shared__ float v_s[64][65];
    const int g = blockIdx.y, t = blockIdx.x * 64 + threadIdx.x, jt = t >> 6, tx = threadIdx.x;
    for (int j = 0; j < 64; ++j) {
        float v = 0.f;
        for (int r = 0; r < 4; ++r) v += imp_h[((size_t)(g * 4 + r) * S + t) * 64 + j];
        if (j == jt || j == 0) v = 1e9f;
        if (j * 64 > t) v = -1.0f;
        v_s[j][tx] = v;
    }
    unsigned long long mask = 0ull;
    for (int j = 0; j <= jt; ++j) {
        float vj = v_s[j][tx]; int rank = 0;
        for (int i = 0; i < 64; ++i) { float vi = v_s[i][tx]; rank += (vi > vj || (vi == vj && i < j)) ? 1 : 0; }
        if (rank < 16) mask |= (1ull << j);
    }
    selmask[(size_t)g * S + t] = mask;
}

__global__ __launch_bounds__(64) void nsa_sel_k(const float* nq, const float* ks  , const float* h  ,
                                                const float* rel_bias, const unsigned long long* selmask, float* os) {
    __shared__ float bias_s[129];
    const int hh = blockIdx.y, g = hh >> 2, q0 = blockIdx.x * 64, t = q0 + threadIdx.x, jt = q0 >> 6;
    for (int i = threadIdx.x; i < 129; i += 64) bias_s[i] = rel_bias[(i < 128 ? (int)T5B[i] : 31) * 8 + hh];
    __syncthreads();
    float qv[64], o[64];
#pragma unroll
    for (int d = 0; d < 64; ++d) { qv[d] = nq[((size_t)t * 8 + hh) * 64 + d] * 0.125f; o[d] = 0.f; }
    const unsigned long long mask = selmask[(size_t)g * S + t];
    float m = -1e30f, l = 0.f;
    for (int j = 0; j <= jt; ++j) {
        const bool mine = (mask >> j) & 1ull;
        if (!__any(mine)) continue;
        for (int kk = 0; kk < 64; ++kk) {
            const int key = j * 64 + kk;
            const float* kr = ks + ((size_t)key * 2 + g) * 64; const float* vr = h + (size_t)key * HW + 896 + g * 64;
            float s = 0.f;
#pragma unroll
            for (int d = 0; d < 64; ++d) s += qv[d] * kr[d];
            const int dist = t - key;
            if (mine && dist >= 0) {
                s += bias_s[dist < 128 ? dist : 128];
                if (s > m) { float c = expf(m - s); l *= c;
#pragma unroll
                    for (int d = 0; d < 64; ++d) o[d] *= c;
                    m = s; }
                float p = expf(s - m); l += p;
#pragma unroll
                for (int d = 0; d < 64; ++d) o[d] += p * vr[d];
            }
        }
    }
    const float il = 1.f / l;
#pragma unroll
    for (int d = 0; d < 64; ++d) os[((size_t)t * 8 + hh) * 64 + d] = o[d] * il;
}

__global__ __launch_bounds__(64) void nsa_win_k(const float* nq, const float* kw, const float* h  ,
                                                const float* rel_bias, const float* oc, const float* os, float* ocat) {
    __shared__ float bias_s[129];
    const int hh = blockIdx.y, g = hh >> 2, q0 = blockIdx.x * 64, t = q0 + threadIdx.x;
    for (int i = threadIdx.x; i < 129; i += 64) bias_s[i] = rel_bias[(i < 128 ? (int)T5B[i] : 31) * 8 + hh];
    __syncthreads();
    float qv[64], o[64];
#pragma unroll
    for (int d = 0; d < 64; ++d) { qv[d] = nq[((size_t)t * 8 + hh) * 64 + d] * 0.125f; o[d] = 0.f; }
    float m = -1e30f, l = 0.f;
    const int k0 = q0 - 511 > 0 ? q0 - 511 : 0;
    for (int key = k0; key <= q0 + 63; ++key) {
        const float* kr = kw + ((size_t)key * 2 + g) * 64; const float* vr = h + (size_t)key * HW + 1152 + g * 64;
        float s = 0.f;
#pragma unroll
        for (int d = 0; d < 64; ++d) s += qv[d] * kr[d];
        const int dist = t - key;
        if (dist >= 0 && dist < 512) {
            s += bias_s[dist < 128 ? dist : 128];
            if (s > m) { float c = expf(m - s); l *= c;
#pragma unroll
                for (int d = 0; d < 64; ++d) o[d] *= c;
                m = s; }
            float p = expf(s - m); l += p;
#pragma unroll
            for (int d = 0; d < 64; ++d) o[d] += p * vr[d];
        }
    }
    const float il = 1.f / l;
    const float* gr = h + (size_t)t * HW + 1280 + hh * 3;
    const float g0 = 1.f / (1.f + expf(-gr[0])), g1 = 1.f / (1.f + expf(-gr[1])), g2 = 1.f / (1.f + expf(-gr[2]));
#pragma unroll
    for (int d = 0; d < 64; ++d) {
        const size_t idx = ((size_t)t * 8 + hh) * 64 + d;
        ocat[(size_t)t * 1024 + hh * 64 + d] = g0 * oc[idx] + g1 * os[idx] + g2 * o[d] * il;
    }
}

__global__ void mla_post_k(const float* qraw  , const float* kvraw  , const float* h  ,
                           const float* q_norm, const float* k_norm, float* qm, float* km) {
    int w = blockIdx.x * (blockDim.x >> 6) + (threadIdx.x >> 6), lane = threadIdx.x & 63;
    if (w >= S * 8) return;
    const int t = w >> 3, hh = w & 7;
    const int e2 = 64 + (lane & 31), i = lane & 15;
    const float inv_freq = powf(10000.f, -(float)i / 16.f); const float ang = (float)t * inv_freq; const float cs = cosf(ang), sn = sinf(ang);
    {
        const float* qr = qraw + (size_t)t * 768 + hh * 96;
        float a = qr[lane], b = qr[e2];
        float ss = wsum(a * a + (lane < 32 ? b * b : 0.f)); float r = rsqrtf(ss / 96.f + EPS);
        a = a * r * q_norm[lane]; b = b * r * q_norm[e2];
        float pb = __shfl_xor(b, 16);
        float ob = ((lane & 31) < 16) ? (b * cs - pb * sn) : (pb * sn + b * cs);
        qm[((size_t)t * 8 + hh) * 96 + lane] = a; if (lane < 32) qm[((size_t)t * 8 + hh) * 96 + e2] = ob;
    }
    {
        float a = kvraw[(size_t)t * 1024 + hh * 128 + lane], b = h[(size_t)t * HW + 1688 + (lane & 31)];
        float ss = wsum(a * a + (lane < 32 ? b * b : 0.f)); float r = rsqrtf(ss / 96.f + EPS);
        a = a * r * k_norm[lane]; b = b * r * k_norm[e2];
        float pb = __shfl_xor(b, 16);
        float ob = ((lane & 31) < 16) ? (b * cs - pb * sn) : (pb * sn + b * cs);
        km[((size_t)t * 8 + hh) * 96 + lane] = a; if (lane < 32) km[((size_t)t * 8 + hh) * 96 + e2] = ob;
    }
}

__global__ __launch_bounds__(64) void mla_attn_k(const float* qm, const float* km, const float* kvraw, float* ocat) {
    const int hh = blockIdx.y, q0 = blockIdx.x * 64, t = q0 + threadIdx.x;
    float qv[96], o[64];
    const float scale = 0.10206207261596577f;
#pragma unroll
    for (int d = 0; d < 96; ++d) qv[d] = qm[((size_t)t * 8 + hh) * 96 + d] * scale;
#pragma unroll
    for (int d = 0; d < 64; ++d) o[d] = 0.f;
    float m = -1e30f, l = 0.f;
    for (int key = 0; key <= q0 + 63; ++key) {
        const float* kr = km + ((size_t)key * 8 + hh) * 96; const float* vr = kvraw + (size_t)key * 1024 + hh * 128 + 64;
        float s = 0.f;
#pragma unroll
        for (int d = 0; d < 96; ++d) s += qv[d] * kr[d];
        if (key <= t) {
            if (s > m) { float c = expf(m - s); l *= c;
#pragma unroll
                for (int d = 0; d < 64; ++d) o[d] *= c;
                m = s; }
            float p = expf(s - m); l += p;
#pragma unroll
            for (int d = 0; d < 64; ++d) o[d] += p * vr[d];
        }
    }
    const float il = 1.f / l;
#pragma unroll
    for (int d = 0; d < 64; ++d) ocat[(size_t)t * 1024 + 512 + hh * 64 + d] = o[d] * il;
}

__global__ void conv_k(const float* hh, const float* cw  , float* v) {
    size_t i = (size_t)blockIdx.x * blockDim.x + threadIdx.x; if (i >= (size_t)S * 1024) return;
    const int t = (int)(i >> 10), d = (int)(i & 1023);
    float y = 0.f;
#pragma unroll
    for (int w = 0; w < 3; ++w) { int tt = t - 2 + w; if (tt >= 0) y += cw[w * 1024 + d] * hh[(size_t)tt * 3072 + 1024 + d] * hh[(size_t)tt * 3072 + 2048 + d]; }
    v[i] = hh[(size_t)t * 3072 + d] * y;
}

__global__ void router_k(const float* xn, const float* wr  , const float* br, int* te, float* tw, int* rank, int* cnt) {
    int t = blockIdx.x * (blockDim.x >> 6) + (threadIdx.x >> 6), lane = threadIdx.x & 63;
    if (t >= S) return;
    float lg[8];
#pragma unroll
    for (int e = 0; e < 8; ++e) lg[e] = 0.f;
    for (int k = lane; k < 1024; k += 64) { float xv = xn[(size_t)t * 1024 + k];
#pragma unroll
        for (int e = 0; e < 8; ++e) lg[e] += xv * wr[k * 8 + e]; }
#pragma unroll
    for (int e = 0; e < 8; ++e) lg[e] = wsum(lg[e]) + br[e];
    int e1 = 0; float l1 = lg[0];
#pragma unroll
    for (int e = 1; e < 8; ++e) if (lg[e] > l1) { l1 = lg[e]; e1 = e; }
    int e2 = -1; float l2 = -3e38f;
#pragma unroll
    for (int e = 0; e < 8; ++e) if (e != e1 && lg[e] > l2) { l2 = lg[e]; e2 = e; }
    if (lane == 0) {
        const float w1 = 1.f / (1.f + expf(l2 - l1));
        te[t * 2] = e1; te[t * 2 + 1] = e2; tw[t * 2] = w1; tw[t * 2 + 1] = 1.f - w1;
        rank[t * 2] = atomicAdd(&cnt[e1], 1); rank[t * 2 + 1] = atomicAdd(&cnt[e2], 1);
    }
}
__global__ void moe_off_k(const int* cnt, int* off  , int* tile_e  ) {
    if (threadIdx.x != 0 || blockIdx.x != 0) return;
    int o = 0, ti = 0;
    for (int e = 0; e < 8; ++e) { off[e] = o; int nt = (cnt[e] + 63) / 64; for (int i = 0; i < nt; ++i) tile_e[ti++] = e; o += nt * 64; }
    for (; ti < 136; ++ti) tile_e[ti] = -1;
}
__global__ void moe_fill_k(const int* te, const int* rank, const int* off, int* rowtok  , int* pos  ) {
    int p = blockIdx.x * blockDim.x + threadIdx.x; if (p >= S * 2) return;
    int r = off[te[p]] + rank[p]; rowtok[r] = p >> 1; pos[p] = r;
}
__global__ void moe_combine_k(const float* x3, const float* ym  , const int* pos, const float* tw, float* out) {
    size_t i = (size_t)blockIdx.x * blockDim.x + threadIdx.x; if (i >= (size_t)S * 1024) return;
    const int t = (int)(i >> 10), d = (int)(i & 1023);
    out[i] = x3[i] + (tw[t * 2] * ym[(size_t)pos[t * 2] * 1024 + d] + tw[t * 2 + 1] * ym[(size_t)pos[t * 2 + 1] * 1024 + d]);
}
__global__ void fill_i32_k(int* p, int v, int n) { int i = blockIdx.x * blockDim.x + threadIdx.x; if (i < n) p[i] = v; }

struct Bufs {
    float *xn, *h, *nq, *ks, *kw, *kcin, *vcin, *bias1, *hid, *kc, *vc, *oc, *os, *imp_h, *cqn, *qraw, *qm, *ckvn, *kvraw, *km, *ocat, *x1, *x2, *x3, *v, *big, *ym, *tw;
    unsigned long long* selmask; int *te, *rank, *cnt, *off, *tile_e, *rowtok, *pos;
};
inline size_t carve(Bufs& b, char* base) {
    size_t o = 0;
    auto take = [&](size_t bytes) { char* p = base + o; o += (bytes + 255) & ~(size_t)255; return p; };
    b.xn = (float*)take((size_t)S * 1024 * 4); b.h = (float*)take((size_t)S * HW * 4); b.nq = (float*)take((size_t)S * 512 * 4);
    b.ks = (float*)take((size_t)S * 128 * 4); b.kw = (float*)take((size_t)S * 128 * 4);
    b.kcin = (float*)take(((size_t)2 * S + 16) * 64 * 4); b.vcin = (float*)take(((size_t)2 * S + 16) * 64 * 4);
    b.bias1 = (float*)take(512 * 4); b.hid = (float*)take((size_t)2 * 512 * 256 * 4); b.kc = (float*)take(512 * 64 * 4); b.vc = (float*)take(512 * 64 * 4);
    b.oc = (float*)take((size_t)S * 512 * 4); b.os = (float*)take((size_t)S * 512 * 4); b.imp_h = (float*)take((size_t)8 * S * 64 * 4);
    b.cqn = (float*)take((size_t)S * 256 * 4); b.qraw = (float*)take((size_t)S * 768 * 4); b.qm = (float*)take((size_t)S * 768 * 4);
    b.ckvn = (float*)take((size_t)S * 128 * 4); b.kvraw = (float*)take((size_t)S * 1024 * 4); b.km = (float*)take((size_t)S * 768 * 4);
    b.ocat = (float*)take((size_t)S * 1024 * 4); b.x1 = (float*)take((size_t)S * 1024 * 4); b.x2 = (float*)take((size_t)S * 1024 * 4);
    b.x3 = (float*)take((size_t)S * 1024 * 4); b.v = (float*)take((size_t)S * 1024 * 4);
    b.big = (float*)take((size_t)8704 * 1408 * 4 > (size_t)S * 3072 * 4 ? (size_t)8704 * 1408 * 4 : (size_t)S * 3072 * 4);
    b.ym = (float*)take((size_t)8704 * 1024 * 4); b.tw = (float*)take(S * 2 * 4);
    b.selmask = (unsigned long long*)take((size_t)2 * S * 8);
    b.te = (int*)take(S * 2 * 4); b.rank = (int*)take(S * 2 * 4); b.cnt = (int*)take(256); b.off = (int*)take(256); b.tile_e = (int*)take(136 * 4);
    b.rowtok = (int*)take(8704 * 4); b.pos = (int*)take(S * 2 * 4);
    return o;
}

inline void run_batch(void* const* d_in, int bi, const Bufs& b, float* outb, hipStream_t st) {
    auto F = [&](int i) { return (const float*)d_in[i]; };
    const float* x = F(0) + (size_t)bi * S * 1024;
    const dim3 w256(256);
    rmsnorm_k<<<S / 4, w256, 0, st>>>(x, 1024, F(2), b.xn, 1024, 1024, S);
    sgemm_k<0><<<dim3((HW + 63) / 64, S / 64), w256, 0, st>>>(b.xn, 1024, nullptr, F(3), nullptr, HW, nullptr, 0, b.h, HW, nullptr, nullptr, S, HW, 1024);
    nsa_prep_k<<<S / 4, w256, 0, st>>>(b.h, F(4), F(5), b.nq, b.ks, b.kw, b.kcin, b.vcin);
    zero_k<<<4, w256, 0, st>>>(b.kcin + (size_t)2 * S * 64, 1024); zero_k<<<4, w256, 0, st>>>(b.vcin + (size_t)2 * S * 64, 1024);
    cmp_bias_k<<<2, w256, 0, st>>>(F(6), F(7), b.bias1);
    for (int kv = 0; kv < 2; ++kv) {
        const float* ain = kv ? b.vcin : b.kcin; float* hid = b.hid + (size_t)kv * 512 * 256; float* outp = kv ? b.vc : b.kc;
        sgemm_k<2><<<dim3(4, 8), w256, 0, st>>>(ain, 1024, nullptr, F(7) + (size_t)kv * 2048 * 256, nullptr, 256, nullptr, 0, hid, 256, nullptr, b.bias1 + kv * 256, 512, 256, 2048);
        sgemm_k<0><<<dim3(1, 8), w256, 0, st>>>(hid, 256, nullptr, F(8) + (size_t)kv * 256 * 64, nullptr, 64, nullptr, 0, outp, 64, nullptr, nullptr, 512, 64, 256);
    }
    kc_norm_k<<<128, w256, 0, st>>>(b.kc, F(5));
    nsa_cmp_k<<<dim3(S / 64, 8), 64, 0, st>>>(b.nq, b.kc, b.vc, F(1), b.oc, b.imp_h);
    nsa_select_k<<<dim3(S / 64, 2), 64, 0, st>>>(b.imp_h, b.selmask);
    nsa_sel_k<<<dim3(S / 64, 8), 64, 0, st>>>(b.nq, b.ks, b.h, F(1), b.selmask, b.os);
    nsa_win_k<<<dim3(S / 64, 8), 64, 0, st>>>(b.nq, b.kw, b.h, F(1), b.oc, b.os, b.ocat);
    rmsnorm_k<<<S / 4, w256, 0, st>>>(b.h + 1304, HW, F(9), b.cqn, 256, 256, S);
    rmsnorm_k<<<S / 4, w256, 0, st>>>(b.h + 1560, HW, F(10), b.ckvn, 128, 128, S);
    sgemm_k<0><<<dim3(12, S / 64), w256, 0, st>>>(b.cqn, 256, nullptr, F(11), nullptr, 768, nullptr, 0, b.qraw, 768, nullptr, nullptr, S, 768, 256);
    sgemm_k<0><<<dim3(16, S / 64), w256, 0, st>>>(b.ckvn, 128, nullptr, F(12), nullptr, 1024, nullptr, 0, b.kvraw, 1024, nullptr, nullptr, S, 1024, 128);
    mla_post_k<<<S * 8 / 4, w256, 0, st>>>(b.qraw, b.kvraw, b.h, F(13), F(14), b.qm, b.km);
    mla_attn_k<<<dim3(S / 64, 8), 64, 0, st>>>(b.qm, b.km, b.kvraw, b.ocat);
    sgemm_k<1><<<dim3(16, S / 64), w256, 0, st>>>(b.ocat, 1024, nullptr, F(15), nullptr, 1024, nullptr, 0, b.x1, 1024, x, nullptr, S, 1024, 1024);
    rmsnorm_k<<<S / 4, w256, 0, st>>>(b.x1, 1024, F(16), b.xn, 1024, 1024, S);
    sgemm_k<3><<<dim3(2816 / 64, S / 64), w256, 0, st>>>(b.xn, 1024, nullptr, F(17), F(18), 2816, nullptr, 0, b.big, 2816, nullptr, nullptr, S, 2816, 1024);
    sgemm_k<1><<<dim3(16, S / 64), w256, 0, st>>>(b.big, 2816, nullptr, F(19), nullptr, 1024, nullptr, 0, b.x2, 1024, b.x1, nullptr, S, 1024, 2816);
    rmsnorm_k<<<S / 4, w256, 0, st>>>(b.x2, 1024, F(20), b.xn, 1024, 1024, S);
    sgemm_k<0><<<dim3(3072 / 64, S / 64), w256, 0, st>>>(b.xn, 1024, nullptr, F(21), nullptr, 3072, nullptr, 0, b.big, 3072, nullptr, nullptr, S, 3072, 1024);
    conv_k<<<S * 1024 / 256, w256, 0, st>>>(b.big, F(22), b.v);
    sgemm_k<1><<<dim3(16, S / 64), w256, 0, st>>>(b.v, 1024, nullptr, F(23), nullptr, 1024, nullptr, 0, b.x3, 1024, b.x2, nullptr, S, 1024, 1024);
    rmsnorm_k<<<S / 4, w256, 0, st>>>(b.x3, 1024, F(24), b.xn, 1024, 1024, S);
    fill_i32_k<<<1, 64, 0, st>>>(b.cnt, 0, 8);
    fill_i32_k<<<(8704 + 255) / 256, w256, 0, st>>>(b.rowtok, -1, 8704);
    router_k<<<S / 4, w256, 0, st>>>(b.xn, F(25), F(26), b.te, b.tw, b.rank, b.cnt);
    moe_off_k<<<1, 64, 0, st>>>(b.cnt, b.off, b.tile_e);
    moe_fill_k<<<S * 2 / 256, w256, 0, st>>>(b.te, b.rank, b.off, b.rowtok, b.pos);
    sgemm_k<3><<<dim3(1408 / 64, 136), w256, 0, st>>>(b.xn, 1024, b.rowtok, F(27), F(28), 1408, b.tile_e, (size_t)1024 * 1408, b.big, 1408, nullptr, nullptr, 8704, 1408, 1024);
    sgemm_k<0><<<dim3(16, 136), w256, 0, st>>>(b.big, 1408, nullptr, F(29), nullptr, 1024, b.tile_e, (size_t)1408 * 1024, b.ym, 1024, nullptr, nullptr, 8704, 1024, 1408);
    moe_combine_k<<<S * 1024 / 256, w256, 0, st>>>(b.x3, b.ym, b.pos, b.tw, outb);
}
}
extern "C" void kernel_launch(void* const* d_in, const int* in_sizes, int n_in, void* d_out, int out_size, void* d_ws, size_t ws_size, hipStream_t stream) {
    gold::Bufs b; size_t used = gold::carve(b, (char*)d_ws);
    if (used > ws_size) { fprintf(stderr, "ws too small: need %zu have %zu\n", used, ws_size); return; }
    for (int bi = 0; bi < 8; ++bi) gold::run_batch(d_in, bi, b, (float*)d_out + (size_t)bi * 4096 * 1024, stream);
}
```

```cpp
#include <hip/hip_runtime.h>
#include <hip/hip_bf16.h>
#include <stdint.h>
#include <stdio.h>
#include <string.h>
#include <hip/hip_cooperative_groups.h>
namespace cg = cooperative_groups;
#define NB 8
namespace gold {
constexpr int S = 4096, D = 1024, HW = 1720;
constexpr float EPS = 1e-6f;

__device__ const unsigned char T5B[128] = {0, 1, 2, 3, 4, 5, 6, 7, 8, 9, 10, 11, 12, 13, 14, 15, 16, 16, 16, 17, 17, 18, 18, 18, 19, 19, 19, 20, 20, 20, 20, 21, 21, 21, 21, 22, 22, 22, 22, 22, 23, 23, 23, 23, 23, 23, 24, 24, 24, 24, 24, 24, 25, 25, 25, 25, 25, 25, 25, 26, 26, 26, 26, 26, 26, 26, 26, 27, 27, 27, 27, 27, 27, 27, 27, 27, 27, 28, 28, 28, 28, 28, 28, 28, 28, 28, 28, 29, 29, 29, 29, 29, 29, 29, 29, 29, 29, 29, 29, 30, 30, 30, 30, 30, 30, 30, 30, 30, 30, 30, 30, 30, 30, 31, 31, 31, 31, 31, 31, 31, 31, 31, 31, 31, 31, 31, 31};
}
#ifndef NB
#define NB 8
#endif
namespace fast {
#define LAS __attribute__((address_space(3)))
typedef unsigned short bf16_t;
typedef short bf16x8 __attribute__((ext_vector_type(8)));
typedef float f32x4 __attribute__((ext_vector_type(4)));
typedef float f32x2 __attribute__((ext_vector_type(2)));
typedef float f32x16 __attribute__((ext_vector_type(16)));
typedef unsigned u32x4 __attribute__((ext_vector_type(4)));
typedef unsigned u32x2 __attribute__((ext_vector_type(2)));
typedef __bf16 bf16x2_t __attribute__((ext_vector_type(2)));

constexpr int S = 4096, T = NB * S, D = 1024;
constexpr float EPS = 1e-6f, LOG2E = 1.4426950408889634f;

__device__ __forceinline__ unsigned cvtpk(float lo, float hi) { f32x2 v = {lo, hi}; bf16x2_t b = __builtin_convertvector(v, bf16x2_t); return __builtin_bit_cast(unsigned, b); }
__device__ __forceinline__ bf16_t f2bf(float f) { return (bf16_t)(cvtpk(f, 0.f) & 0xffffu); }
__device__ __forceinline__ float bf2f(bf16_t u) { return __builtin_bit_cast(float, (unsigned)u << 16); }
__device__ __forceinline__ float bflo(unsigned u) { return __builtin_bit_cast(float, u << 16); }
__device__ __forceinline__ float bfhi(unsigned u) { return __builtin_bit_cast(float, u & 0xffff0000u); }
__device__ __forceinline__ float wsum(float v) {
#pragma unroll
    for (int o = 1; o < 64; o <<= 1) v += __shfl_xor(v, o);
    return v;
}
__device__ __forceinline__ float fexp2(float x) { return __builtin_amdgcn_exp2f(x); }
__device__ __forceinline__ float frcp(float x) { return __builtin_amdgcn_rcpf(x); }
__device__ __forceinline__ float silu_f(float x) { return x * frcp(1.f + fexp2(-x * LOG2E)); }
__device__ __forceinline__ float gelu_tanh_f(float x) {
    const float u = 0.7978845608028654f * (x + 0.044715f * x * x * x);
    return x * frcp(1.f + fexp2(-2.f * LOG2E * u));
}

namespace pg8 {
constexpr int BM = 256, BK = 64, HALF = 128, HTB = HALF * BK * 2, STAGE_BYTES = 8 * HTB, NXCD = 8, WGM = 8;
__host__ __device__ __forceinline__ int lds_byte(int r, int c) { const int st = (r >> 4) * 2 + (c >> 5), rr = r & 15, cc = c & 31, ob = rr * 64 + cc * 2; return st * 1024 + (ob ^ (((ob >> 9) & 1) << 5)); }
__host__ __device__ __forceinline__ void stage_rc(int b, int& R, int& C) { const int st = b / 1024, sb = b % 1024, swz = sb ^ (((sb >> 9) & 1) << 5); R = (st >> 1) * 16 + swz / 64; C = (st & 1) * 32 + (swz % 64) / 2; }
__host__ __device__ __forceinline__ int perm32(int rho) { const int n = rho >> 4, i = rho & 15; return 8 * (i >> 2) + 4 * n + (i & 3); }

struct Unit { int pm, pn; };
struct Gemm { const bf16_t* A; const bf16_t* Bt; int M, N, K, lda; const int* tile_e; size_t estride; };

struct StaticOrder {
    int nM, nN, nwg, G, c;
    __device__ void init(int M, int N, int G_, int c_) { nM = M / BM; nN = N / BM; nwg = nM * nN; G = G_; c = c_; }
    __device__ bool next(int i, Unit& u) const {
        const long L = (long)i * G + c; if (L >= nwg) return false;
        int wgid = (int)L; { const int q = nwg / NXCD, r = nwg % NXCD, xcd = wgid % NXCD, off = wgid / NXCD; wgid = (xcd < r ? xcd * (q + 1) : r * (q + 1) + (xcd - r) * q) + off; }
        const int nig = WGM * nN, gid = wgid / nig, fm = gid * WGM, gsz = (nM - fm) < WGM ? (nM - fm) : WGM;
        u.pm = fm + ((wgid % nig) % gsz); u.pn = (wgid % nig) / gsz; return true;
    }
};

template <class Epi, bool ALIGN_EPI>
__device__ __forceinline__ void gemm_phase(LAS unsigned char* lds, const Gemm g, const StaticOrder& S, const Epi& E) {
    const int tid = threadIdx.x, wid = __builtin_amdgcn_readfirstlane(tid >> 6), lane = tid & 63, wr = wid >> 2, wc = wid & 3, fr = lane & 15, fq = lane >> 4;
    const int K = g.K, nt = K / BK, lda = g.lda;
    unsigned voffA[2], voffB[2];
#pragma unroll
    for (int i = 0; i < 2; ++i) { int R, C; stage_rc(tid * 16 + i * 8192, R, C); const int Rb = Epi::PERM ? ((R & ~31) + perm32(R & 31)) : R;
        voffA[i] = (unsigned)(R * lda + C) * 2u; voffB[i] = (unsigned)(Rb * K + C) * 2u; }
    const size_t kstep = (size_t)(BK * 2);
    const size_t hsA = (size_t)HALF * lda * 2, tsA = 2 * hsA, hsB = (size_t)HALF * K * 2, tsB = 2 * hsB;
    const unsigned ldsw = (unsigned)wid * 1024u;
    const int aoff = lds_byte(wr * 64 + fr, fq * 8), boff = lds_byte(wc * 32 + fr, fq * 8);
#define PG8_SA(b, h) (((b) * 2 + (h)) * HTB)
#define PG8_SB(b, h) ((4 + (b) * 2 + (h)) * HTB)
#define PG8_STAGE(bufoff, gbase, voff) do { _Pragma("unroll") for (int _i = 0; _i < 2; ++_i) \
        __builtin_amdgcn_global_load_lds((const unsigned*)((const char*)(gbase) + (voff)[_i]), (LAS unsigned*)(lds + (bufoff) + ldsw + _i * 8192), 16, 0, 0); } while (0)
#define PG8_LDA(dst, b, h) do { _Pragma("unroll") for (int m = 0; m < 4; ++m) _Pragma("unroll") for (int k = 0; k < 2; ++k) dst[m][k] = *(const LAS bf16x8*)(lds + PG8_SA(b, h) + aoff + m * 2048 + k * 1024); } while (0)
#define PG8_LDB(dst, b, h) do { _Pragma("unroll") for (int n = 0; n < 2; ++n) _Pragma("unroll") for (int k = 0; k < 2; ++k) dst[n][k] = *(const LAS bf16x8*)(lds + PG8_SB(b, h) + boff + n * 2048 + k * 1024); } while (0)
#define PG8_MMA(ai, bj, At, Bt) do { __builtin_amdgcn_s_setprio(1); _Pragma("unroll") for (int m = 0; m < 4; ++m) _Pragma("unroll") for (int n = 0; n < 2; ++n) _Pragma("unroll") for (int k = 0; k < 2; ++k) \
        acc[ai][bj][m][n] = __builtin_amdgcn_mfma_f32_16x16x32_bf16(Bt[n][k], At[m][k], acc[ai][bj][m][n], 0, 0, 0); __builtin_amdgcn_s_setprio(0); } while (0)
#define PG8_WAIT_V(n) asm volatile("s_waitcnt vmcnt(" #n ")" ::: "memory")
#define PG8_WAIT_L(n) asm volatile("s_waitcnt lgkmcnt(" #n ")" ::: "memory")
#define PG8_BAR __builtin_amdgcn_s_barrier()
#define PG8_SCHED __builtin_amdgcn_sched_barrier(0)
#define PG8_EOFF(pm_) (g.tile_e ? (size_t)g.tile_e[pm_] * g.estride * 2 : (size_t)0)
    Unit cur, nxt; int ui = 0;
    if (!S.next(0, cur)) return;
    f32x4 acc[2][2][4][2];
#pragma unroll
    for (int a = 0; a < 2; ++a)
#pragma unroll
        for (int b = 0; b < 2; ++b)
#pragma unroll
            for (int m = 0; m < 4; ++m)
#pragma unroll
                for (int n = 0; n < 2; ++n) acc[a][b][m][n] = (f32x4){0.f, 0.f, 0.f, 0.f};
    bf16x8 At[4][2], B0[2][2], B1[2][2];
    const char* cA = (const char*)g.A + (size_t)cur.pm * tsA; const char* cB = (const char*)g.Bt + PG8_EOFF(cur.pm) + (size_t)cur.pn * tsB;
    PG8_STAGE(PG8_SB(0, 0), cB, voffB); PG8_STAGE(PG8_SB(0, 1), cB + hsB, voffB); PG8_STAGE(PG8_SA(0, 0), cA, voffA); PG8_STAGE(PG8_SA(0, 1), cA + hsA, voffA);
    if (wr == 1) PG8_BAR;
    PG8_WAIT_V(2); PG8_BAR;
    PG8_STAGE(PG8_SB(1, 0), cB + kstep, voffB); PG8_STAGE(PG8_SA(1, 0), cA + kstep, voffA); PG8_STAGE(PG8_SB(1, 1), cB + hsB + kstep, voffB);
    PG8_WAIT_V(6); PG8_BAR;
    for (;;) {
        const bool has_next = S.next(ui + 1, nxt);
        const char* nA = has_next ? (const char*)g.A + (size_t)nxt.pm * tsA : cA;
        const char* nB = has_next ? (const char*)g.Bt + PG8_EOFF(nxt.pm) + (size_t)nxt.pn * tsB : cB;
        for (int t = 0; t < nt; t += 2) {
            const bool last = (t == nt - 2);
            const char* a1 = cA + (size_t)(t + 1) * kstep;
            const char* a2 = last ? nA : cA + (size_t)(t + 2) * kstep; const char* b2 = last ? nB : cB + (size_t)(t + 2) * kstep;
            const char* a3 = a2 + kstep; const char* b3 = b2 + kstep;
            PG8_LDB(B0, 0, 0); PG8_LDB(B1, 0, 1); PG8_SCHED; PG8_LDA(At, 0, 0); PG8_STAGE(PG8_SA(1, 1), a1 + hsA, voffA);
            PG8_WAIT_V(8); PG8_WAIT_L(0); PG8_BAR; PG8_MMA(0, 0, At, B0); PG8_MMA(0, 1, At, B1); PG8_BAR; PG8_SCHED;
            PG8_LDA(At, 0, 1); PG8_STAGE(PG8_SB(0, 0), b2, voffB); PG8_STAGE(PG8_SB(0, 1), b2 + hsB, voffB); PG8_STAGE(PG8_SA(0, 0), a2, voffA);
            PG8_WAIT_V(8); PG8_WAIT_L(0); PG8_BAR; PG8_MMA(1, 0, At, B0); PG8_MMA(1, 1, At, B1); PG8_BAR; PG8_SCHED;
            PG8_LDB(B0, 1, 0); PG8_LDB(B1, 1, 1); PG8_SCHED; PG8_LDA(At, 1, 0); PG8_STAGE(PG8_SA(0, 1), a2 + hsA, voffA);
            PG8_WAIT_V(8); PG8_WAIT_L(0); PG8_BAR; PG8_MMA(0, 0, At, B0); PG8_MMA(0, 1, At, B1); PG8_BAR; PG8_SCHED;
            PG8_LDA(At, 1, 1); PG8_STAGE(PG8_SB(1, 0), b3, voffB); PG8_STAGE(PG8_SB(1, 1), b3 + hsB, voffB); PG8_STAGE(PG8_SA(1, 0), a3, voffA);
            PG8_WAIT_V(8); PG8_WAIT_L(0); PG8_BAR; PG8_MMA(1, 0, At, B0); PG8_MMA(1, 1, At, B1); PG8_BAR; PG8_SCHED;
        }
        if constexpr (ALIGN_EPI) { if (wr == 0) PG8_BAR; }
        E(acc, cur, wr, wc, fr, fq);
        if (!has_next) break;
#pragma unroll
        for (int a = 0; a < 2; ++a)
#pragma unroll
            for (int b = 0; b < 2; ++b)
#pragma unroll
                for (int m = 0; m < 4; ++m)
#pragma unroll
                    for (int n = 0; n < 2; ++n) acc[a][b][m][n] = (f32x4){0.f, 0.f, 0.f, 0.f};
        cur = nxt; cA = nA; cB = nB; ++ui;
        if constexpr (ALIGN_EPI) { if (wr == 1) PG8_BAR; }
    }
    PG8_WAIT_V(0);
    if constexpr (!ALIGN_EPI) { if (wr == 0) PG8_BAR; }
    PG8_BAR;
#undef PG8_SA
#undef PG8_SB
#undef PG8_STAGE
#undef PG8_LDA
#undef PG8_LDB
#undef PG8_MMA
#undef PG8_WAIT_V
#undef PG8_WAIT_L
#undef PG8_BAR
#undef PG8_SCHED
#undef PG8_EOFF
}

template <int ACT> struct EpiBf16 {
    static constexpr bool PERM = true;
    bf16_t* O; int ldc; const float* bias;
    __device__ __forceinline__ void operator()(const f32x4 (&acc)[2][2][4][2], const Unit& u, int wr, int wc, int fr, int fq) const {
        const int row0 = u.pm * BM + wr * 64 + fr, col0 = u.pn * BM + wc * 32 + 8 * fq;
        f32x4 bv[2][2];
#pragma unroll
        for (int bj = 0; bj < 2; ++bj)
#pragma unroll
            for (int n = 0; n < 2; ++n) bv[bj][n] = bias ? *(const f32x4*)(bias + col0 + bj * HALF + 4 * n) : (f32x4){0.f, 0.f, 0.f, 0.f};
#pragma unroll
        for (int ai = 0; ai < 2; ++ai)
#pragma unroll
            for (int m = 0; m < 4; ++m) { bf16_t* rowp = O + (size_t)(row0 + ai * HALF + m * 16) * ldc + col0;
#pragma unroll
                for (int bj = 0; bj < 2; ++bj) { f32x4 v0 = acc[ai][bj][m][0] + bv[bj][0], v1 = acc[ai][bj][m][1] + bv[bj][1];
                    if (ACT == 2) {
#pragma unroll
                        for (int i = 0; i < 4; ++i) { v0[i] = gelu_tanh_f(v0[i]); v1[i] = gelu_tanh_f(v1[i]); } }
                    u32x4 w; w.x = cvtpk(v0[0], v0[1]); w.y = cvtpk(v0[2], v0[3]); w.z = cvtpk(v1[0], v1[1]); w.w = cvtpk(v1[2], v1[3]);
                    *(u32x4*)(rowp + bj * HALF) = w; } }
    }
};
struct EpiResF32 {
    static constexpr bool PERM = false;
    const float* base; float* out; int ldc;
    __device__ __forceinline__ void operator()(const f32x4 (&acc)[2][2][4][2], const Unit& u, int wr, int wc, int fr, int fq) const {
        const int col0 = u.pn * BM + wc * 32 + 4 * fq;
#pragma unroll
        for (int ai = 0; ai < 2; ++ai)
#pragma unroll
            for (int m = 0; m < 4; ++m) { const size_t off = (size_t)(u.pm * BM + ai * HALF + wr * 64 + m * 16 + fr) * ldc + col0;
#pragma unroll
                for (int bj = 0; bj < 2; ++bj)
#pragma unroll
                    for (int n = 0; n < 2; ++n) { const f32x4 bs = *(const f32x4*)(base + off + bj * HALF + n * 16); *(f32x4*)(out + off + bj * HALF + n * 16) = bs + acc[ai][bj][m][n]; } }
    }
};
struct EpiSwiGLU {
    static constexpr bool PERM = true;
    bf16_t* O; int ldc;
    __device__ __forceinline__ void operator()(const f32x4 (&acc)[2][2][4][2], const Unit& u, int wr, int wc, int fr, int fq) const {
        const int row0 = u.pm * BM + wr * 64 + fr, col0 = u.pn * HALF + wc * 32 + 8 * fq;
#pragma unroll
        for (int ai = 0; ai < 2; ++ai)
#pragma unroll
            for (int m = 0; m < 4; ++m) { bf16_t* rowp = O + (size_t)(row0 + ai * HALF + m * 16) * ldc + col0;
                float h[8];
#pragma unroll
                for (int n = 0; n < 2; ++n)
#pragma unroll
                    for (int i = 0; i < 4; ++i) h[n * 4 + i] = silu_f(acc[ai][0][m][n][i]) * acc[ai][1][m][n][i];
                u32x4 w; w.x = cvtpk(h[0], h[1]); w.y = cvtpk(h[2], h[3]); w.z = cvtpk(h[4], h[5]); w.w = cvtpk(h[6], h[7]);
                *(u32x4*)rowp = w; }
    }
};
struct EpiRowScaleBf16 {
    static constexpr bool PERM = true;
    bf16_t* O; int ldc; const float* roww;
    __device__ __forceinline__ void operator()(const f32x4 (&acc)[2][2][4][2], const Unit& u, int wr, int wc, int fr, int fq) const {
        const int row0 = u.pm * BM + wr * 64 + fr, col0 = u.pn * BM + wc * 32 + 8 * fq;
#pragma unroll
        for (int ai = 0; ai < 2; ++ai)
#pragma unroll
            for (int m = 0; m < 4; ++m) { const int row = row0 + ai * HALF + m * 16; const float sc = roww[row]; bf16_t* rowp = O + (size_t)row * ldc + col0;
#pragma unroll
                for (int bj = 0; bj < 2; ++bj) { const f32x4 v0 = acc[ai][bj][m][0] * sc, v1 = acc[ai][bj][m][1] * sc;
                    u32x4 w; w.x = cvtpk(v0[0], v0[1]); w.y = cvtpk(v0[2], v0[3]); w.z = cvtpk(v1[0], v1[1]); w.w = cvtpk(v1[2], v1[3]);
                    *(u32x4*)(rowp + bj * HALF) = w; } }
    }
};
}
constexpr int ROWS_MAX = 2 * T + 8 * 256;
constexpr size_t al256(size_t x) { return (x + 255) & ~(size_t)255; }
constexpr size_t W_IN_E = 0;
constexpr size_t W_CW1 = W_IN_E + (size_t)1792 * 1024 * 2;
constexpr size_t W_UQ = W_CW1 + (size_t)2 * 256 * 2048 * 2;
constexpr size_t W_UKV = W_UQ + (size_t)768 * 256 * 2;
constexpr size_t W_OUT_E = W_UKV + (size_t)1024 * 128 * 2;
constexpr size_t W_GU = W_OUT_E + (size_t)1024 * 1024 * 2;
constexpr size_t W_D = W_GU + (size_t)5632 * 1024 * 2;
constexpr size_t W_IN_O = W_D + (size_t)1024 * 2816 * 2;
constexpr size_t W_OUT_O = W_IN_O + (size_t)3072 * 1024 * 2;
constexpr size_t W_MGU = W_OUT_O + (size_t)1024 * 1024 * 2;
constexpr size_t W_MD = W_MGU + (size_t)8 * 2816 * 1024 * 2;
constexpr size_t W_END = W_MD + (size_t)8 * 1024 * 1408 * 2;
constexpr size_t SM_CTL = al256(W_END);
constexpr size_t SM_B1P = SM_CTL + 4096;
constexpr size_t SM_B1 = SM_B1P + 32 * 512 * 4;
constexpr size_t SM_ROPE = SM_B1 + 512 * 4;
constexpr size_t SM_BL = SM_ROPE + (size_t)S * 32 * 4;
constexpr size_t SM_HID = SM_BL + 8 * 132 * 4;
constexpr size_t SM_KC = SM_HID + (size_t)2 * NB * 512 * 256 * 2;
constexpr size_t SM_VCT = SM_KC + (size_t)NB * 512 * 64 * 2;
constexpr size_t SM_TE = SM_VCT + (size_t)NB * 512 * 64 * 2;
constexpr size_t SM_TW = SM_TE + (size_t)T * 8;
constexpr size_t SM_RANK = SM_TW + (size_t)T * 8;
constexpr size_t SM_POS = SM_RANK + (size_t)T * 8;
constexpr size_t SM_ROWW = SM_POS + (size_t)T * 8;
constexpr size_t SM_TILEE = SM_ROWW + (size_t)ROWS_MAX * 4;
constexpr size_t SM_END = SM_TILEE + (size_t)(ROWS_MAX / 256 + 8) * 4;
constexpr size_t R_XA = al256(SM_END);
constexpr size_t SZ_XA = (size_t)T * 4096 + (size_t)4 * 1048576;
constexpr size_t R_XN = R_XA + SZ_XA;
constexpr size_t SZ_XN = (size_t)T * 2048;
constexpr size_t R_H = R_XN + SZ_XN;
constexpr size_t SZ_H = ((size_t)T * 6144 > (size_t)ROWS_MAX * 2816) ? (size_t)T * 6144 : (size_t)ROWS_MAX * 2816;
constexpr size_t WS_FAST_END = R_H + SZ_H;
constexpr size_t A_QN = 0;
constexpr size_t A_KSN = A_QN + (size_t)T * 1024;
constexpr size_t A_KWN = A_KSN + (size_t)T * 256;
constexpr size_t A_VST = A_KWN + (size_t)T * 256;
constexpr size_t A_VWT = A_VST + (size_t)T * 256;
constexpr size_t A_KCIN = A_VWT + (size_t)T * 256;
constexpr size_t A_VCIN = A_KCIN + (size_t)T * 256 + 2048;
constexpr size_t A_CQN = A_VCIN + (size_t)T * 256 + 2048;
constexpr size_t A_CKVN = A_CQN + (size_t)T * 512;
constexpr size_t A_KROPE = A_CKVN + (size_t)T * 256;
constexpr size_t A_GATES = A_KROPE + (size_t)T * 64;
constexpr size_t A_END = A_GATES + (size_t)T * 96;
static_assert(A_END <= SZ_XA, "attention inputs fit R_XA");
constexpr size_t O_QM = 0;
constexpr size_t O_KM = O_QM + (size_t)T * 1536;
constexpr size_t O_VMT = O_KM + (size_t)T * 1536;
static_assert(O_VMT + (size_t)T * 1024 <= (size_t)T * 4096, "d_out scratch");

struct Params {
    const float* in[30];
    float* out;
    unsigned char* ws;
    int ph_lo, ph_hi, dbg_branch, pad_;
};

constexpr int LDS_BYTES = 147456;

__device__ __forceinline__ int perm16(int k) { return (k & ~12) | ((k & 4) << 1) | ((k & 8) >> 1); }

struct WDesc { int in_idx, K, N, rep, map, row_off; size_t src_stride, dst_off, dst_stride; };
__device__ const WDesc WDESC[12] = {
    {3, 1024, 1720, 1, 0, 0, 0, W_IN_E / 2, 0},
    {7, 2048, 256, 2, 0, 0, (size_t)2048 * 256, W_CW1 / 2, (size_t)256 * 2048},
    {11, 256, 768, 1, 0, 0, 0, W_UQ / 2, 0},
    {12, 128, 1024, 1, 0, 0, 0, W_UKV / 2, 0},
    {15, 1024, 1024, 1, 0, 0, 0, W_OUT_E / 2, 0},
    {17, 1024, 2816, 1, 1, 0, 0, W_GU / 2, 0},
    {18, 1024, 2816, 1, 1, 128, 0, W_GU / 2, 0},
    {19, 2816, 1024, 1, 0, 0, 0, W_D / 2, 0},
    {21, 1024, 3072, 1, 0, 0, 0, W_IN_O / 2, 0},
    {23, 1024, 1024, 1, 0, 0, 0, W_OUT_O / 2, 0},
    {27, 1024, 1408, 8, 1, 0, (size_t)1024 * 1408, W_MGU / 2, (size_t)2816 * 1024},
    {28, 1024, 1408, 8, 1, 128, (size_t)1024 * 1408, W_MGU / 2, (size_t)2816 * 1024},
};
__device__ const WDesc WDESC_MD = {29, 1408, 1024, 8, 0, 0, (size_t)1408 * 1024, W_MD / 2, (size_t)1024 * 1408};

__device__ __forceinline__ void transpose_item(const float* W, int K, int N, bf16_t* WT, int map, int row_off, LAS float* scr, int item, int lane) {
    const int nblk = (N + 31) / 32, kb = item / nblk, nb = item % nblk, k0 = 64 * kb, n0 = 32 * nb;
    const bool nok = (n0 + (lane & 31)) < N;
#pragma unroll 8
    for (int i = 0; i < 32; ++i) { const int kk = 2 * i + (lane >> 5); scr[kk * 33 + (lane & 31)] = nok ? W[(size_t)(k0 + kk) * N + n0 + (lane & 31)] : 0.f; }
    asm volatile("s_waitcnt lgkmcnt(0)" ::: "memory");
    const int c = lane & 7;
#pragma unroll
    for (int j = 0; j < 4; ++j) { const int n = (lane >> 3) + 8 * j; const LAS float* s = scr + (8 * c) * 33 + n;
        u32x4 o; o.x = cvtpk(s[0 * 33], s[1 * 33]); o.y = cvtpk(s[2 * 33], s[3 * 33]); o.z = cvtpk(s[4 * 33], s[5 * 33]); o.w = cvtpk(s[6 * 33], s[7 * 33]);
        const int nn = n0 + n;
        if (nn < N) { const int row = map ? (256 * (nn >> 7) + (nn & 127) + row_off) : (nn + row_off);
            *(u32x4*)(WT + (size_t)row * K + k0 + 8 * c) = o; } }
    asm volatile("s_waitcnt lgkmcnt(0)" ::: "memory");
}
__device__ __forceinline__ void do_wdesc(const Params& p, const WDesc& d, int it, LAS float* scr, int lane) {
    const int per = (d.K / 64) * ((d.N + 31) / 32); const int r = it / per, ii = it % per;
    transpose_item(p.in[d.in_idx] + (size_t)r * d.src_stride, d.K, d.N, (bf16_t*)p.ws + d.dst_off + (size_t)r * d.dst_stride, d.map, d.row_off, scr, ii, lane);
}
__device__ __forceinline__ void rms_row_to_bf16(const float* xrow, const float* g, bf16_t* orow, int lane) {
    const f32x4* xr = (const f32x4*)xrow + lane; const f32x4* gr = (const f32x4*)g + lane;
    f32x4 v[4]; float s = 0.f;
#pragma unroll
    for (int j = 0; j < 4; ++j) { v[j] = xr[64 * j]; s += (v[j].x * v[j].x + v[j].y * v[j].y) + (v[j].z * v[j].z + v[j].w * v[j].w); }
    const float r = rsqrtf(wsum(s) * (1.f / 1024.f) + EPS);
    u32x2* o8 = (u32x2*)orow + lane;
#pragma unroll
    for (int j = 0; j < 4; ++j) { const f32x4 gg = gr[64 * j]; u32x2 w; w.x = cvtpk(v[j].x * r * gg.x, v[j].y * r * gg.y); w.y = cvtpk(v[j].z * r * gg.z, v[j].w * r * gg.w); o8[64 * j] = w; }
}
__device__ __forceinline__ void phase_p0(const Params& p, LAS unsigned char* lds) {
    const int tid = threadIdx.x, lane = tid & 63, wave = tid >> 6;
    const int gw = blockIdx.x * 8 + wave, NGW = gridDim.x * 8;
    LAS float* scr = (LAS float*)(lds + wave * 16384);
    int base = 0;
#pragma unroll 1
    for (int d = 0; d < 13; ++d) {
        const WDesc& wd = (d < 12) ? WDESC[d] : WDESC_MD;
        const int n_it = wd.rep * (wd.K / 64) * ((wd.N + 31) / 32);
        int first = (gw - (base % NGW) + NGW) % NGW;
        for (int it = first; it < n_it; it += NGW) do_wdesc(p, wd, it, scr, lane);
        base += n_it;
    }
    bf16_t* xn = (bf16_t*)(p.ws + R_XN);
    for (int m = gw; m < T; m += NGW) rms_row_to_bf16(p.in[0] + (size_t)m * D, p.in[2], xn + (size_t)m * D, lane);
    for (int u = gw; u < 256; u += NGW) {
        const int kc = u >> 3, kv = (u >> 2) & 1, nb = u & 3; float s = 0.f;
        const float* pos = p.in[6] + kv * 2048 + kc * 64; const float* w1 = p.in[7] + ((size_t)kv * 2048 + kc * 64) * 256 + nb * 64 + lane;
#pragma unroll 8
        for (int k = 0; k < 64; ++k) s += pos[k] * w1[(size_t)k * 256];
        ((float*)(p.ws + SM_B1P))[kc * 512 + kv * 256 + nb * 64 + lane] = s;
    }
    for (int i = blockIdx.x * 512 + tid; i < S * 16; i += gridDim.x * 512) {
        const int t = i >> 4, f = i & 15; const float ang = (float)t * powf(10000.f, -(float)f / 16.f);
        float* rp = (float*)(p.ws + SM_ROPE) + t * 32; rp[f] = cosf(ang); rp[16 + f] = sinf(ang);
    }
    if (blockIdx.x == 0) for (int i = tid; i < 8 * 129; i += 512) { const int h = i / 129, dd = i % 129; ((float*)(p.ws + SM_BL))[h * 132 + dd] = p.in[1][(dd < 128 ? (int)gold::T5B[dd] : 31) * 8 + h] * LOG2E; }
}

__device__ __forceinline__ void phase_p2(const Params& p, LAS unsigned char* lds) {
    const int tid = threadIdx.x, lane = tid & 63, wave = tid >> 6;
    const bf16_t* hb = (const bf16_t*)(p.ws + R_H);
    unsigned char* xa = p.ws + R_XA;
    bf16_t* qn = (bf16_t*)(xa + A_QN); bf16_t* ksn = (bf16_t*)(xa + A_KSN); bf16_t* kwn = (bf16_t*)(xa + A_KWN);
    bf16_t* vst = (bf16_t*)(xa + A_VST); bf16_t* vwt = (bf16_t*)(xa + A_VWT); bf16_t* kcin = (bf16_t*)(xa + A_KCIN); bf16_t* vcin = (bf16_t*)(xa + A_VCIN);
    bf16_t* cqn = (bf16_t*)(xa + A_CQN); bf16_t* ckvn = (bf16_t*)(xa + A_CKVN); bf16_t* krope = (bf16_t*)(xa + A_KROPE); float* gates = (float*)(xa + A_GATES);
    const float* q_norm = p.in[4]; const float* k_norm = p.in[5]; const float* cq_norm = p.in[9]; const float* ckv_norm = p.in[10];
    LAS bf16_t* vs = (LAS bf16_t*)lds;
    if (blockIdx.x == 0) {
        { float s = 0.f; for (int k = 0; k < 32; ++k) s += ((const float*)(p.ws + SM_B1P))[k * 512 + tid]; ((float*)(p.ws + SM_B1))[tid] = s; }
        for (int i = tid; i < 1024; i += 512) { kcin[(size_t)T * 128 + i] = 0; vcin[(size_t)T * 128 + i] = 0; }
    }
    for (int tile = blockIdx.x; tile < T / 64; tile += gridDim.x) {
        const int b = tile / (S / 64), s0 = (tile % (S / 64)) * 64;
        for (int tt = 0; tt < 8; ++tt) {
            const int sl = wave * 8 + tt, s = s0 + sl; const size_t t = (size_t)b * S + s;
            const bf16_t* hr = hb + t * 1792;
#pragma unroll
            for (int hh = 0; hh < 8; ++hh) { const float v = bf2f(hr[hh * 64 + lane]); const float r = rsqrtf(wsum(v * v) * (1.f / 64.f) + EPS);
                qn[(t * 8 + hh) * 64 + lane] = f2bf(v * r * q_norm[lane] * (0.125f * LOG2E)); }
#pragma unroll
            for (int g = 0; g < 2; ++g) {
                const size_t gm = (((size_t)b * 2 + g) * S + s) * 64 + lane;
                float v = bf2f(hr[768 + g * 64 + lane]); float r = rsqrtf(wsum(v * v) * (1.f / 64.f) + EPS); ksn[gm] = f2bf(v * r * k_norm[64 + lane]);
                v = bf2f(hr[1024 + g * 64 + lane]); r = rsqrtf(wsum(v * v) * (1.f / 64.f) + EPS); kwn[gm] = f2bf(v * r * k_norm[128 + lane]);
                kcin[gm] = hr[512 + g * 64 + lane]; vcin[gm] = hr[640 + g * 64 + lane];
                const int pp = (sl & ~15) | perm16(sl & 15);
                vs[((0 + g) * 64 + lane) * 72 + pp] = hr[896 + g * 64 + lane];
                vs[((2 + g) * 64 + lane) * 72 + pp] = hr[1152 + g * 64 + lane];
            }
            if (lane < 24) gates[t * 24 + lane] = frcp(1.f + fexp2(-bf2f(hr[1280 + lane]) * LOG2E));
            { float a[4]; float ss = 0.f;
#pragma unroll
                for (int j = 0; j < 4; ++j) { a[j] = bf2f(hr[1304 + j * 64 + lane]); ss += a[j] * a[j]; }
                const float r = rsqrtf(wsum(ss) * (1.f / 256.f) + EPS);
#pragma unroll
                for (int j = 0; j < 4; ++j) cqn[t * 256 + j * 64 + lane] = f2bf(a[j] * r * cq_norm[j * 64 + lane]); }
            { float a[2]; float ss = 0.f;
#pragma unroll
                for (int j = 0; j < 2; ++j) { a[j] = bf2f(hr[1560 + j * 64 + lane]); ss += a[j] * a[j]; }
                const float r = rsqrtf(wsum(ss) * (1.f / 128.f) + EPS);
#pragma unroll
                for (int j = 0; j < 2; ++j) ckvn[t * 128 + j * 64 + lane] = f2bf(a[j] * r * ckv_norm[j * 64 + lane]); }
            if (lane < 32) krope[t * 32 + lane] = hr[1688 + lane];
        }
        __syncthreads();
        {
            const int row = tid >> 1, half = tid & 1, which = row >> 6, d = row & 63, g = which & 1;
            bf16_t* dst = ((which < 2) ? vst : vwt) + (((size_t)b * 2 + g) * 64 + d) * S + s0 + half * 32;
            const LAS bf16_t* src = vs + row * 72 + half * 32;
#pragma unroll
            for (int c = 0; c < 4; ++c) *(u32x4*)(dst + c * 8) = *(const LAS u32x4*)(src + c * 8);
        }
        __syncthreads();
    }
}
__device__ __forceinline__ void phase_p3b(const Params& p, LAS unsigned char* lds) {
    const int tid = threadIdx.x, lane = tid & 63, wave = tid >> 6;
    const int gw = blockIdx.x * 8 + wave, NGW = gridDim.x * 8;
    const bf16_t* qraw = (const bf16_t*)(p.ws + R_H);
    const bf16_t* kvraw = (const bf16_t*)(p.ws + R_H + (size_t)T * 1536);
    const bf16_t* krope = (const bf16_t*)(p.ws + R_XA + A_KROPE);
    const float* rope = (const float*)(p.ws + SM_ROPE);
    bf16_t* qm = (bf16_t*)((unsigned char*)p.out + O_QM); bf16_t* km = (bf16_t*)((unsigned char*)p.out + O_KM); bf16_t* vmt = (bf16_t*)((unsigned char*)p.out + O_VMT);
    const float* q_norm = p.in[13]; const float* k_norm = p.in[14];
    LAS bf16_t* vs = (LAS bf16_t*)lds;
    LAS float* w2s = (LAS float*)(lds + 73728);
    for (int kv = 0; kv < 2; ++kv) {
        __syncthreads();
        for (int i = tid; i < 256 * 64; i += 512) w2s[i] = p.in[8][kv * 16384 + i];
        __syncthreads();
        const bf16_t* hid = (const bf16_t*)(p.ws + SM_HID) + (size_t)kv * NB * 512 * 256;
        for (int row = gw; row < NB * 512; row += NGW) {
            const u32x2 hv = *(const u32x2*)(hid + (size_t)row * 256 + lane * 4);
            const float h0 = bflo(hv.x), h1 = bfhi(hv.x), h2 = bflo(hv.y), h3 = bfhi(hv.y);
            float acc = 0.f;
#pragma unroll 8
            for (int k4 = 0; k4 < 64; ++k4) {
                acc += __shfl(h0, k4) * w2s[(k4 * 4 + 0) * 64 + lane]; acc += __shfl(h1, k4) * w2s[(k4 * 4 + 1) * 64 + lane];
                acc += __shfl(h2, k4) * w2s[(k4 * 4 + 2) * 64 + lane]; acc += __shfl(h3, k4) * w2s[(k4 * 4 + 3) * 64 + lane];
            }
            if (kv == 0) { const float r = rsqrtf(wsum(acc * acc) * (1.f / 64.f) + EPS); ((bf16_t*)(p.ws + SM_KC))[(size_t)row * 64 + lane] = f2bf(acc * r * p.in[5][lane]); }
            else { const int c = row & 255; ((bf16_t*)(p.ws + SM_VCT))[((size_t)(row >> 8) * 64 + lane) * 256 + ((c & ~15) | perm16(c & 15))] = f2bf(acc); }
        }
    }
    __syncthreads();
    const float QS = 0.10206207261596577f * LOG2E;
    for (int tile = blockIdx.x; tile < T / 64; tile += gridDim.x) {
        const int b = tile / (S / 64), s0 = (tile % (S / 64)) * 64;
        for (int tt = 0; tt < 8; ++tt) {
            const int sl = wave * 8 + tt, s = s0 + sl; const size_t t = (size_t)b * S + s;
            const int e2 = 64 + (lane & 31), f = lane & 15;
            const float cs = rope[s * 32 + f], sn = rope[s * 32 + 16 + f];
            const float kr = bf2f(krope[t * 32 + (lane & 31)]);
            const int pp = (sl & ~15) | perm16(sl & 15);
#pragma unroll 2
            for (int hh = 0; hh < 8; ++hh) {
                {
                    float a = bf2f(qraw[t * 768 + hh * 96 + lane]), bb = bf2f(qraw[t * 768 + hh * 96 + e2]);
                    const float r = rsqrtf(wsum(a * a + (lane < 32 ? bb * bb : 0.f)) * (1.f / 96.f) + EPS);
                    a = a * r * q_norm[lane]; bb = bb * r * q_norm[e2];
                    const float pb = __shfl_xor(bb, 16);
                    const float ob = ((lane & 31) < 16) ? (bb * cs - pb * sn) : (pb * sn + bb * cs);
                    qm[(t * 8 + hh) * 96 + lane] = f2bf(a * QS); if (lane < 32) qm[(t * 8 + hh) * 96 + e2] = f2bf(ob * QS);
                }
                {
                    float a = bf2f(kvraw[t * 1024 + hh * 128 + lane]), bb = kr;
                    const float r = rsqrtf(wsum(a * a + (lane < 32 ? bb * bb : 0.f)) * (1.f / 96.f) + EPS);
                    a = a * r * k_norm[lane]; bb = bb * r * k_norm[e2];
                    const float pb = __shfl_xor(bb, 16);
                    const float ob = ((lane & 31) < 16) ? (bb * cs - pb * sn) : (pb * sn + bb * cs);
                    const size_t ko = (((size_t)b * 8 + hh) * S + s) * 96;
                    km[ko + lane] = f2bf(a); if (lane < 32) km[ko + e2] = f2bf(ob);
                    vs[(hh * 64 + lane) * 72 + pp] = kvraw[t * 1024 + hh * 128 + 64 + lane];
                }
            }
        }
        __syncthreads();
        {
            const int hh = tid >> 6, d = tid & 63;
            bf16_t* dst = vmt + (((size_t)b * 8 + hh) * 64 + d) * S + s0;
            const LAS bf16_t* src = vs + tid * 72;
#pragma unroll
            for (int c = 0; c < 8; ++c) *(u32x4*)(dst + c * 8) = *(const LAS u32x4*)(src + c * 8);
        }
        __syncthreads();
    }
}

__device__ const unsigned short UNIT_TYPES[256] = {63,127,62,126,61,125,527,591,655,719,783,847,911,975,60,124,59,123,58,122,57,121,56,120,526,590,654,718,782,846,910,974,55,119,54,118,53,117,52,116,51,115,525,589,653,717,781,845,909,973,50,114,49,113,48,112,47,111,524,588,652,716,780,844,908,972,46,110,45,109,44,108,43,107,523,587,651,715,779,843,907,971,42,106,41,105,40,104,39,103,38,102,522,586,650,714,778,842,906,970,37,101,36,100,35,99,34,98,33,97,521,585,649,713,777,841,905,969,32,96,31,95,30,94,520,584,648,712,776,840,904,968,29,93,28,92,27,91,26,90,25,89,519,583,647,711,775,839,903,967,24,88,23,87,22,86,21,85,20,84,518,582,646,710,774,838,902,966,19,83,18,82,17,81,16,80,15,79,517,581,645,709,773,837,901,965,14,78,13,77,12,76,516,580,644,708,772,836,900,964,11,75,10,74,9,73,8,72,515,579,643,707,771,835,899,963,7,71,6,70,5,69,514,578,642,706,770,834,898,962,4,68,3,67,513,577,641,705,769,833,897,961,2,66,1,65,0,64,512,576,640,704,768,832,896,960};
__device__ __forceinline__ int crow(int r, int hi) { return (r & 3) + 8 * (r >> 2) + 4 * hi; }
struct Flash { f32x16 o0, o1; float m, l; };
__device__ __forceinline__ void flash_init(Flash& st) {
#pragma unroll
    for (int r = 0; r < 16; ++r) { st.o0[r] = 0.f; st.o1[r] = 0.f; }
    st.m = -1e30f; st.l = 0.f;
}
constexpr int AL_KB = 0, AL_KBSZ = 64 * 208, AL_VB = 2 * AL_KBSZ, AL_VBSZ = 64 * 144, AL_IMP = AL_VB + 2 * AL_VBSZ, AL_SELB = AL_IMP + 64 * 65 * 4, AL_UNI = AL_SELB + 512, AL_BL = AL_UNI + 64, AL_OT = AL_BL + 4 * 132 * 4, AL_END = AL_OT + 8 * 32 * 64 * 4;

template <int DK, int KP> __device__ __forceinline__ void qk_tile(f32x16& p0, f32x16& p1, const LAS unsigned char* Kt, const bf16x8* qf, int r32, int hi) {
#pragma unroll
    for (int r = 0; r < 16; ++r) { p0[r] = 0.f; p1[r] = 0.f; }
#pragma unroll
    for (int s = 0; s < DK / 16; ++s) {
        const bf16x8 a0 = *(const LAS bf16x8*)(Kt + r32 * KP + (16 * s + 8 * hi) * 2);
        const bf16x8 a1 = *(const LAS bf16x8*)(Kt + (32 + r32) * KP + (16 * s + 8 * hi) * 2);
        p0 = __builtin_amdgcn_mfma_f32_32x32x16_bf16(a0, qf[s], p0, 0, 0, 0);
        p1 = __builtin_amdgcn_mfma_f32_32x32x16_bf16(a1, qf[s], p1, 0, 0, 0);
    }
}
template <class F> __device__ __forceinline__ void softmax_pv(Flash& st, f32x16& p0, f32x16& p1, const LAS unsigned char* Vt, int r32, int hi, F f) {
    float mx = -1e30f;
#pragma unroll
    for (int r = 0; r < 16; ++r) {
        bool v0, v1; float b0, b1; f(r, 0, v0, b0); f(r, 1, v1, b1);
        p0[r] = v0 ? p0[r] + b0 : -INFINITY; p1[r] = v1 ? p1[r] + b1 : -INFINITY;
        mx = fmaxf(mx, fmaxf(p0[r], p1[r]));
    }
    mx = fmaxf(mx, __shfl_xor(mx, 32));
    const float mnew = fmaxf(st.m, mx);
    if (__any(mnew > st.m)) {
        const float fsc = fexp2(st.m - mnew);
        st.l *= fsc;
#pragma unroll
        for (int r = 0; r < 16; ++r) { const float fr_ = __shfl(fsc, crow(r, hi)); st.o0[r] *= fr_; st.o1[r] *= fr_; }
        st.m = mnew;
    }
    float ls = 0.f;
#pragma unroll
    for (int r = 0; r < 16; ++r) { p0[r] = fexp2(p0[r] - st.m); p1[r] = fexp2(p1[r] - st.m); ls += p0[r] + p1[r]; }
    st.l += ls;
    int voff = r32 * 144 + 16 * hi;
    asm volatile("" : "+v"(voff) : "v"(ls));
#pragma unroll
    for (int s = 0; s < 4; ++s) {
        u32x4 w;
        if (s < 2) { w.x = cvtpk(p0[8 * s + 0], p0[8 * s + 1]); w.y = cvtpk(p0[8 * s + 2], p0[8 * s + 3]); w.z = cvtpk(p0[8 * s + 4], p0[8 * s + 5]); w.w = cvtpk(p0[8 * s + 6], p0[8 * s + 7]); }
        else { const int q = s - 2; w.x = cvtpk(p1[8 * q + 0], p1[8 * q + 1]); w.y = cvtpk(p1[8 * q + 2], p1[8 * q + 3]); w.z = cvtpk(p1[8 * q + 4], p1[8 * q + 5]); w.w = cvtpk(p1[8 * q + 6], p1[8 * q + 7]); }
        const bf16x8 pa = __builtin_bit_cast(bf16x8, w);
        const bf16x8 vb0 = *(const LAS bf16x8*)(Vt + voff + 32 * s);
        const bf16x8 vb1 = *(const LAS bf16x8*)(Vt + voff + 32 * 144 + 32 * s);
        st.o0 = __builtin_amdgcn_mfma_f32_32x32x16_bf16(pa, vb0, st.o0, 0, 0, 0);
        st.o1 = __builtin_amdgcn_mfma_f32_32x32x16_bf16(pa, vb1, st.o1, 0, 0, 0);
    }
}
template <bool FIRST> __device__ __forceinline__ void flash_accum(LAS float* otl, const Flash& st, float gate, int hi, int lane) {
    const float lt = st.l + __shfl_xor(st.l, 32);
    const float f = lt > 0.f ? gate * frcp(lt) : 0.f;
#pragma unroll
    for (int r = 0; r < 16; ++r) { const float fr_ = __shfl(f, crow(r, hi));
        if (FIRST) { otl[r * 64 + lane] = fr_ * st.o0[r]; otl[(16 + r) * 64 + lane] = fr_ * st.o1[r]; }
        else { otl[r * 64 + lane] += fr_ * st.o0[r]; otl[(16 + r) * 64 + lane] += fr_ * st.o1[r]; } }
}

#ifdef DEBUG_NSA
__device__ __forceinline__ void dbg_store(float* dst  , const Flash& st, int hi, int r32, size_t rowbase  , int h) {
    const float lt = st.l + __shfl_xor(st.l, 32); const float f = lt > 0.f ? frcp(lt) : 0.f;
#pragma unroll
    for (int r = 0; r < 16; ++r) { const float fr_ = __shfl(f, crow(r, hi)); const size_t o = ((rowbase + crow(r, hi)) * 8 + h) * 64 + r32; dst[o] = st.o0[r] * fr_; dst[o + 32] = st.o1[r] * fr_; }
}
#define DBG_STORE(k) dbg_store((float*)(p.ws + R_H) + (size_t)(k) * T * 512, st, hi, r32, (size_t)b * S + q0 + 32 * qh, h)
#else
#define DBG_STORE(k)
#endif
template <int RB> struct TileRegs { u32x4 a, b; };
template <int RB> __device__ __forceinline__ void tile_load(TileRegs<RB>& R, const unsigned char* g, size_t gs, int tid) {
    constexpr int CPR = RB / 16;
    asm volatile("" : "+v"(tid));
    { const int row = tid / CPR, c = tid % CPR; R.a = *(const u32x4*)(g + (size_t)row * gs + c * 16); }
    if (RB == 192) { const int id = tid + 512; if (id < 768) { const int row = id / CPR, c = id % CPR; R.b = *(const u32x4*)(g + (size_t)row * gs + c * 16); } }
}
template <int RB, int P> __device__ __forceinline__ void tile_store(const TileRegs<RB>& R, LAS unsigned char* l, int tid) {
    constexpr int CPR = RB / 16;
    asm volatile("" : "+v"(tid));
    { const int row = tid / CPR, c = tid % CPR; *(LAS u32x4*)(l + row * P + c * 16) = R.a; }
    if (RB == 192) { const int id = tid + 512; if (id < 768) { const int row = id / CPR, c = id % CPR; *(LAS u32x4*)(l + row * P + c * 16) = R.b; } }
}

__device__ __forceinline__ void mla_unit(const Params& p, LAS unsigned char* lds, int b, int h, int qb) {
    int tid = threadIdx.x; asm volatile("" : "+v"(tid));
    const int lane = tid & 63, w = __builtin_amdgcn_readfirstlane(tid >> 6), r32 = lane & 31, hi = lane >> 5;
    const bf16_t* qm = (const bf16_t*)((const unsigned char*)p.out + O_QM);
    const unsigned char* km = (const unsigned char*)p.out + O_KM + (((size_t)b * 8 + h) * S) * 192;
    const unsigned char* vmt = (const unsigned char*)p.out + O_VMT + (((size_t)b * 8 + h) * 64) * (size_t)S * 2;
    bf16_t* ocat = (bf16_t*)(p.ws + R_XN);
    const int tq = qb * 256 + 32 * w + r32;
    bf16x8 qf[6];
#pragma unroll
    for (int s = 0; s < 6; ++s) qf[s] = *(const bf16x8*)(qm + (((size_t)b * S + tq) * 8 + h) * 96 + 16 * s + 8 * hi);
    Flash st; flash_init(st);
    const int ntile = 4 * qb + 4, dt = 4 * qb + (w >> 1);
    TileRegs<192> kr; TileRegs<128> vr;
    tile_load<192>(kr, km, 192, tid); tile_load<128>(vr, vmt, (size_t)S * 2, tid);
    for (int i = 0; i < ntile; ++i) {
        LAS unsigned char* kb = lds + AL_KB + (i & 1) * AL_KBSZ; LAS unsigned char* vb = lds + AL_VB + (i & 1) * AL_VBSZ;
        tile_store<192, 208>(kr, kb, tid); tile_store<128, 144>(vr, vb, tid);
        __syncthreads();
        if (i + 1 < ntile) { tile_load<192>(kr, km + (size_t)(i + 1) * 64 * 192, 192, tid); tile_load<128>(vr, vmt + (size_t)(i + 1) * 128, (size_t)S * 2, tid); }
        if (i <= dt) {
            f32x16 p0, p1; qk_tile<96, 208>(p0, p1, kb, qf, r32, hi);
            if (i < dt) softmax_pv(st, p0, p1, vb, r32, hi, [&](int r, int half, bool& v, float& bs) { v = true; bs = 0.f; });
            else { const int kb0 = 64 * i + 4 * hi; softmax_pv(st, p0, p1, vb, r32, hi, [&](int r, int half, bool& v, float& bs) { v = (kb0 + 32 * half + (r & 3) + 8 * (r >> 2)) <= tq; bs = 0.f; }); }
        }
    }
    {
        const float lt = st.l + __shfl_xor(st.l, 32); const float f = lt > 0.f ? frcp(lt) : 0.f;
#pragma unroll
        for (int r = 0; r < 16; ++r) { const float fr_ = __shfl(f, crow(r, hi)); const size_t ro = ((size_t)b * S + qb * 256 + 32 * w + crow(r, hi)) * 1024 + 512 + h * 64 + r32; ocat[ro] = f2bf(st.o0[r] * fr_); ocat[ro + 32] = f2bf(st.o1[r] * fr_); }
    }
    __syncthreads();
}

__device__ __forceinline__ void nsa_unit(const Params& p, LAS unsigned char* lds, int b, int g, int jt) {
    int tid = threadIdx.x; asm volatile("" : "+v"(tid));
    const int lane = tid & 63, w = __builtin_amdgcn_readfirstlane(tid >> 6), r32 = lane & 31, hi = lane >> 5;
    const int rh = w >> 1, qh = w & 1, h = 4 * g + rh, q0 = 64 * jt, ql = 32 * qh + r32, tq = q0 + ql;
    const unsigned char* xa = p.ws + R_XA;
    const bf16_t* qn = (const bf16_t*)(xa + A_QN);
    const size_t bg = (size_t)b * 2 + g;
    const unsigned char* ksn = xa + A_KSN + bg * S * 128; const unsigned char* kwn = xa + A_KWN + bg * S * 128;
    const unsigned char* vst = xa + A_VST + bg * 64 * (size_t)S * 2; const unsigned char* vwt = xa + A_VWT + bg * 64 * (size_t)S * 2;
    const unsigned char* kc = p.ws + SM_KC + bg * 256 * 128; const unsigned char* vct = p.ws + SM_VCT + bg * 64 * 512;
    const float* gates = (const float*)(xa + A_GATES) + ((size_t)b * S + tq) * 24 + h * 3;
    bf16_t* ocat = (bf16_t*)(p.ws + R_XN);
    LAS float* imp = (LAS float*)(lds + AL_IMP); LAS unsigned char* selb = lds + AL_SELB; LAS unsigned* uni = (LAS unsigned*)(lds + AL_UNI); LAS float* bls = (LAS float*)(lds + AL_BL);
    for (int i = tid; i < 4 * 132; i += 512) bls[i] = ((const float*)(p.ws + SM_BL))[(4 * g) * 132 + i];
    const LAS float* blh = bls + rh * 132;
    bf16x8 qf[4];
#pragma unroll
    for (int s = 0; s < 4; ++s) qf[s] = *(const bf16x8*)(qn + (((size_t)b * S + tq) * 8 + h) * 64 + 16 * s + 8 * hi);
    float g0 = gates[0], g1 = gates[1], g2 = gates[2];
    if (p.dbg_branch >= 0) { g0 = p.dbg_branch == 0 ? 1.f : 0.f; g1 = p.dbg_branch == 1 ? 1.f : 0.f; g2 = p.dbg_branch == 2 ? 1.f : 0.f; }
    LAS float* otl = (LAS float*)(lds + AL_OT) + w * 2048;
    TileRegs<128> kr, vr;
    const int nvmax = (q0 + 63 - 31) / 16 + 1, ntc = (nvmax + 63) / 64;
    Flash st; flash_init(st);
    tile_load<128>(kr, kc, 128, tid); tile_load<128>(vr, vct, 512, tid);
    for (int i = 0; i < ntc; ++i) {
        LAS unsigned char* kb = lds + AL_KB + (i & 1) * AL_KBSZ; LAS unsigned char* vb = lds + AL_VB + (i & 1) * AL_VBSZ;
        tile_store<128, 144>(kr, kb, tid); tile_store<128, 144>(vr, vb, tid);
        __syncthreads();
        if (i + 1 < ntc) { tile_load<128>(kr, kc + (size_t)(i + 1) * 64 * 128, 128, tid); tile_load<128>(vr, vct + (size_t)(i + 1) * 128, 512, tid); }
        f32x16 p0, p1; qk_tile<64, 144>(p0, p1, kb, qf, r32, hi);
        const int cb = 64 * i + 4 * hi;
        softmax_pv(st, p0, p1, vb, r32, hi, [&](int r, int half, bool& v, float& bs) {
            const int c = cb + 32 * half + (r & 3) + 8 * (r >> 2); const int dist = tq - 16 * c - 31; v = dist >= 0; bs = blh[dist < 0 ? 0 : (dist > 128 ? 128 : dist)]; });
    }
    flash_accum<true>(otl, st, g0, hi, lane);
    __syncthreads();
    unsigned mlo, mhi;
    unsigned ulo, uhi;
    if (jt < 16) { const unsigned long long mk = (jt == 63) ? ~0ull : ((1ull << (jt + 1)) - 1ull); mlo = (unsigned)mk; mhi = (unsigned)(mk >> 32); ulo = mlo; uhi = mhi; }
    else {
        for (int i = tid; i < 64 * 65; i += 512) imp[i] = 0.f;
        const float mfin = st.m; const float lt = st.l + __shfl_xor(st.l, 32); const float linv = lt > 0.f ? frcp(lt) : 0.f;
        float xlast = 0.f;
        tile_load<128>(kr, kc, 128, tid);
        for (int i = 0; i < ntc; ++i) {
            LAS unsigned char* kb = lds + AL_KB + (i & 1) * AL_KBSZ;
            tile_store<128, 144>(kr, kb, tid);
            __syncthreads();
            if (i + 1 < ntc) tile_load<128>(kr, kc + (size_t)(i + 1) * 64 * 128, 128, tid);
            f32x16 p0, p1; qk_tile<64, 144>(p0, p1, kb, qf, r32, hi);
            const int cb = 64 * i + 4 * hi;
            float sm[2][4], cr[2][4];
#pragma unroll
            for (int half = 0; half < 2; ++half)
#pragma unroll
                for (int a = 0; a < 4; ++a) {
                    float s4 = 0.f, last = 0.f;
#pragma unroll
                    for (int k = 0; k < 4; ++k) {
                        const int r = 4 * a + k; const int c = cb + 32 * half + k + 8 * a; const int dist = tq - 16 * c - 31;
                        const float sc = (half ? p1[r] : p0[r]) + blh[dist < 0 ? 0 : (dist > 128 ? 128 : dist)];
                        const float pv = dist >= 0 ? fexp2(sc - mfin) * linv : 0.f;
                        s4 += pv; last = pv;
                    }
                    sm[half][a] = s4; cr[half][a] = last;
                }
            float tot[2][4];
#pragma unroll
            for (int half = 0; half < 2; ++half)
#pragma unroll
                for (int a = 0; a < 4; ++a) {
                    const float xs_ = __shfl_xor(cr[half][a], 32);
                    const float xp_ = (a > 0) ? __shfl_xor(cr[half][a > 0 ? a - 1 : 0], 32) : (half ? __shfl_xor(cr[0][3], 32) : xlast);
                    tot[half][a] = sm[half][a] + (hi ? xs_ : xp_);
                }
            xlast = __shfl_xor(cr[1][3], 32);
            for (int rr = 0; rr < 4; ++rr) {
                if (rh == rr) {
#pragma unroll
                    for (int half = 0; half < 2; ++half)
#pragma unroll
                        for (int a = 0; a < 4; ++a) { const int j = 16 * i + 8 * half + 2 * a + hi; imp[ql * 65 + j] += tot[half][a]; }
                }
                __syncthreads();
            }
        }
        if (p.dbg_branch == 1) { for (int i = tid; i < 4096; i += 512) ((float*)(p.ws + R_H))[((size_t)g * S + q0 + (i >> 6)) * 64 + (i & 63)] = imp[(i >> 6) * 65 + (i & 63)]; }
        {
            const int q = tid >> 3, jg = tid & 7;
            unsigned byte = 0;
#pragma unroll 1
            for (int jj = 0; jj < 8; ++jj) {
                const int j = jg * 8 + jj;
                if (j <= jt) {
                    const float x = imp[q * 65 + j]; const float vj = (j == jt || j == 0) ? 1e9f : x;
                    int rank = 0;
#pragma unroll 8
                    for (int i = 0; i < 64; ++i) { const float xi = imp[q * 65 + i]; const float vi = (i > jt) ? -1.f : ((i == jt || i == 0) ? 1e9f : xi); rank += (vi > vj || (vi == vj && i < j)) ? 1 : 0; }
                    if (rank < 16) byte |= 1u << jj;
                }
            }
            selb[q * 8 + jg] = (unsigned char)byte;
        }
        __syncthreads();
        if (w == 0) {
            unsigned a = ((const LAS unsigned*)selb)[lane * 2], c = ((const LAS unsigned*)selb)[lane * 2 + 1];
#pragma unroll
            for (int o = 1; o < 64; o <<= 1) { a |= __shfl_xor(a, o); c |= __shfl_xor(c, o); }
            if (lane == 0) { uni[0] = a; uni[1] = c; }
        }
        __syncthreads();
        mlo = ((const LAS unsigned*)selb)[ql * 2]; mhi = ((const LAS unsigned*)selb)[ql * 2 + 1];
        ulo = uni[0]; uhi = uni[1];
    }
    if (p.dbg_branch == 1 && rh == 0) { if (hi == 0) ((unsigned long long*)(p.ws + R_H + 4 * 1048576))[(size_t)g * S + tq] = ((unsigned long long)mhi << 32) | mlo; }
    {
        unsigned long long rem = ((unsigned long long)__builtin_amdgcn_readfirstlane(uhi) << 32) | (unsigned)__builtin_amdgcn_readfirstlane(ulo);
        const unsigned long long mymask = ((unsigned long long)mhi << 32) | mlo;
        flash_init(st);
        int j = __builtin_ctzll(rem); rem &= rem - 1;
        tile_load<128>(kr, ksn + (size_t)j * 64 * 128, 128, tid); tile_load<128>(vr, vst + (size_t)j * 128, (size_t)S * 2, tid);
        for (int i = 0;; ++i) {
            LAS unsigned char* kb = lds + AL_KB + (i & 1) * AL_KBSZ; LAS unsigned char* vb = lds + AL_VB + (i & 1) * AL_VBSZ;
            tile_store<128, 144>(kr, kb, tid); tile_store<128, 144>(vr, vb, tid);
            __syncthreads();
            const int jn = rem ? __builtin_ctzll(rem) : -1; rem &= rem - 1;
            if (jn >= 0) { tile_load<128>(kr, ksn + (size_t)jn * 64 * 128, 128, tid); tile_load<128>(vr, vst + (size_t)jn * 128, (size_t)S * 2, tid); }
            f32x16 p0, p1; qk_tile<64, 144>(p0, p1, kb, qf, r32, hi);
            const bool mine = (mymask >> j) & 1ull;
            if (q0 + 32 * qh - (64 * j + 63) >= 128) { const float cbias = blh[128]; softmax_pv(st, p0, p1, vb, r32, hi, [&](int r, int half, bool& v, float& bs) { v = mine; bs = cbias; }); }
            else { const int kb0 = 64 * j + 4 * hi;
                softmax_pv(st, p0, p1, vb, r32, hi, [&](int r, int half, bool& v, float& bs) { const int dist = tq - (kb0 + 32 * half + (r & 3) + 8 * (r >> 2)); v = mine && dist >= 0; bs = blh[dist < 0 ? 0 : (dist > 128 ? 128 : dist)]; }); }
            if (jn < 0) break;
            j = jn;
        }
        flash_accum<false>(otl, st, g1, hi, lane);
        __syncthreads();
    }
    {
        const int j0 = jt >= 8 ? jt - 8 : 0, nw = jt - j0 + 1;
        flash_init(st);
        tile_load<128>(kr, kwn + (size_t)j0 * 64 * 128, 128, tid); tile_load<128>(vr, vwt + (size_t)j0 * 128, (size_t)S * 2, tid);
        for (int i = 0; i < nw; ++i) {
            const int j = j0 + i;
            LAS unsigned char* kb = lds + AL_KB + (i & 1) * AL_KBSZ; LAS unsigned char* vb = lds + AL_VB + (i & 1) * AL_VBSZ;
            tile_store<128, 144>(kr, kb, tid); tile_store<128, 144>(vr, vb, tid);
            __syncthreads();
            if (i + 1 < nw) { tile_load<128>(kr, kwn + (size_t)(j + 1) * 64 * 128, 128, tid); tile_load<128>(vr, vwt + (size_t)(j + 1) * 128, (size_t)S * 2, tid); }
            f32x16 p0, p1; qk_tile<64, 144>(p0, p1, kb, qf, r32, hi);
            const int kb0 = 64 * j + 4 * hi;
            softmax_pv(st, p0, p1, vb, r32, hi, [&](int r, int half, bool& v, float& bs) { const int dist = tq - (kb0 + 32 * half + (r & 3) + 8 * (r >> 2)); v = dist >= 0 && dist < 512; bs = blh[dist < 0 ? 0 : (dist > 128 ? 128 : dist)]; });
        }
        flash_accum<false>(otl, st, g2, hi, lane);
    }
#pragma unroll
    for (int r = 0; r < 16; ++r) { const size_t ro = ((size_t)b * S + q0 + 32 * qh + crow(r, hi)) * 1024 + h * 64 + r32; ocat[ro] = f2bf(otl[r * 64 + lane]); ocat[ro + 32] = f2bf(otl[(16 + r) * 64 + lane]); }
    __syncthreads();
}

__device__ __forceinline__ void phase_p4(const Params& p, LAS unsigned char* lds) {
    const int G = gridDim.x, c = blockIdx.x, nunits = 256 * NB;
    for (int j = 0;; ++j) {
        const int k = j * G + ((j & 1) ? (G - 1 - c) : c);
        if (j * G >= nunits) break;
        if (k >= nunits) continue;
        const int ty = UNIT_TYPES[k / NB], b = k % NB, kind = ty >> 9, a = (ty >> 6) & 7, cc = ty & 63;
#if defined(ATT_ONLY) && ATT_ONLY == 0
        if (kind == 0) nsa_unit(p, lds, b, a, cc);
#elif defined(ATT_ONLY) && ATT_ONLY == 1
        if (kind != 0) mla_unit(p, lds, b, a, cc);
#else
        if (kind == 0) nsa_unit(p, lds, b, a, cc); else mla_unit(p, lds, b, a, cc);
#endif
    }
}
__device__ __forceinline__ void phase_norm(const float* x, const float* g, bf16_t* xn) {
    const int lane = threadIdx.x & 63, gw = blockIdx.x * 8 + (threadIdx.x >> 6), NGW = gridDim.x * 8;
    for (int m = gw; m < T; m += NGW) rms_row_to_bf16(x + (size_t)m * D, g, xn + (size_t)m * D, lane);
}
__device__ __forceinline__ void phase_conv(const Params& p) {
    const int lane = threadIdx.x & 63, gw = blockIdx.x * 8 + (threadIdx.x >> 6), NGW = gridDim.x * 8;
    const bf16_t* hh = (const bf16_t*)(p.ws + R_H); bf16_t* v = (bf16_t*)(p.ws + R_XN); const float* cw = p.in[22];
    for (int m = gw; m < T; m += NGW) {
        const int s = m & (S - 1);
#pragma unroll
        for (int j = 0; j < 4; ++j) {
            const int d = 4 * lane + 256 * j;
            float y[4] = {0.f, 0.f, 0.f, 0.f};
#pragma unroll
            for (int w = 0; w < 3; ++w) {
                if (s - 2 + w >= 0) {
                    const bf16_t* r = hh + (size_t)(m - 2 + w) * 3072;
                    const u32x2 c = *(const u32x2*)(r + 1024 + d), u = *(const u32x2*)(r + 2048 + d); const f32x4 cwv = *(const f32x4*)(cw + w * 1024 + d);
                    y[0] += cwv.x * bflo(c.x) * bflo(u.x); y[1] += cwv.y * bfhi(c.x) * bfhi(u.x); y[2] += cwv.z * bflo(c.y) * bflo(u.y); y[3] += cwv.w * bfhi(c.y) * bfhi(u.y);
                }
            }
            const u32x2 bv = *(const u32x2*)(hh + (size_t)m * 3072 + d);
            u32x2 o; o.x = cvtpk(bflo(bv.x) * y[0], bfhi(bv.x) * y[1]); o.y = cvtpk(bflo(bv.y) * y[2], bfhi(bv.y) * y[3]);
            *(u32x2*)(v + (size_t)m * 1024 + d) = o;
        }
    }
}
__device__ __forceinline__ void phase_norm_router(const Params& p, LAS unsigned char* lds) {
    const int tid = threadIdx.x, lane = tid & 63, wave = tid >> 6, gw = blockIdx.x * 8 + wave, NGW = gridDim.x * 8;
    const float* x3 = p.out; const float* g = p.in[24]; bf16_t* xn = (bf16_t*)(p.ws + R_XN);
    LAS float* wr = (LAS float*)lds;
    LAS int* lcnt = (LAS int*)(lds + 32768); LAS int* gb = lcnt + 8;
    int* te = (int*)(p.ws + SM_TE); float* tw = (float*)(p.ws + SM_TW); int* rank = (int*)(p.ws + SM_RANK); int* cnt = (int*)(p.ws + SM_CTL);
    for (int i = tid; i < 8192; i += 512) wr[i] = p.in[25][i];
    if (tid < 8) lcnt[tid] = 0;
    __syncthreads();
    for (int m = gw; m < T; m += NGW) {
        const f32x4* xr = (const f32x4*)(x3 + (size_t)m * D) + lane; const f32x4* gr = (const f32x4*)g + lane;
        f32x4 v[4]; float s = 0.f;
#pragma unroll
        for (int j = 0; j < 4; ++j) { v[j] = xr[64 * j]; s += (v[j].x * v[j].x + v[j].y * v[j].y) + (v[j].z * v[j].z + v[j].w * v[j].w); }
        const float r = rsqrtf(wsum(s) * (1.f / 1024.f) + EPS);
        float lg[8];
#pragma unroll
        for (int e = 0; e < 8; ++e) lg[e] = 0.f;
        u32x2* o8 = (u32x2*)(xn + (size_t)m * D) + lane;
#pragma unroll
        for (int j = 0; j < 4; ++j) { const f32x4 gg = gr[64 * j]; const f32x4 y = {v[j].x * r * gg.x, v[j].y * r * gg.y, v[j].z * r * gg.z, v[j].w * r * gg.w};
            u32x2 w; w.x = cvtpk(y.x, y.y); w.y = cvtpk(y.z, y.w); o8[64 * j] = w;
#pragma unroll
            for (int i = 0; i < 4; ++i) { const int d = 4 * lane + 256 * j + i; const f32x4 w0 = *(const LAS f32x4*)(wr + d * 8), w1 = *(const LAS f32x4*)(wr + d * 8 + 4);
                lg[0] += y[i] * w0.x; lg[1] += y[i] * w0.y; lg[2] += y[i] * w0.z; lg[3] += y[i] * w0.w; lg[4] += y[i] * w1.x; lg[5] += y[i] * w1.y; lg[6] += y[i] * w1.z; lg[7] += y[i] * w1.w; } }
#pragma unroll
        for (int e = 0; e < 8; ++e) lg[e] = wsum(lg[e]) + p.in[26][e];
        int e1 = 0; float l1 = lg[0];
#pragma unroll
        for (int e = 1; e < 8; ++e) if (lg[e] > l1) { l1 = lg[e]; e1 = e; }
        int e2 = -1; float l2 = -3e38f;
#pragma unroll
        for (int e = 0; e < 8; ++e) if (e != e1 && lg[e] > l2) { l2 = lg[e]; e2 = e; }
        if (lane == 0) {
            const float w1 = 1.f / (1.f + __expf(l2 - l1));
            te[m * 2] = e1; te[m * 2 + 1] = e2; tw[m * 2] = w1; tw[m * 2 + 1] = 1.f - w1;
            rank[m * 2] = __hip_atomic_fetch_add(&lcnt[e1], 1, __ATOMIC_RELAXED, __HIP_MEMORY_SCOPE_WORKGROUP); rank[m * 2 + 1] = __hip_atomic_fetch_add(&lcnt[e2], 1, __ATOMIC_RELAXED, __HIP_MEMORY_SCOPE_WORKGROUP);
        }
    }
    __syncthreads();
    if (tid < 8) gb[tid] = atomicAdd(&cnt[tid], lcnt[tid]);
    __syncthreads();
    for (int m = gw; m < T; m += NGW) if (lane < 2) rank[m * 2 + lane] += gb[te[m * 2 + lane]];
}
__device__ __forceinline__ void phase_moe_gather(const Params& p) {
    const int tid = threadIdx.x, lane = tid & 63, gw = blockIdx.x * 8 + (tid >> 6), NGW = gridDim.x * 8;
    const int* cnt = (const int*)(p.ws + SM_CTL); const int* te = (const int*)(p.ws + SM_TE); const float* tw = (const float*)(p.ws + SM_TW); const int* rank = (const int*)(p.ws + SM_RANK);
    int* pos = (int*)(p.ws + SM_POS); float* roww = (float*)(p.ws + SM_ROWW); int* tile_e = (int*)(p.ws + SM_TILEE);
    const bf16_t* xn = (const bf16_t*)(p.ws + R_XN); bf16_t* xs = (bf16_t*)(p.ws + R_XA);
    int off[9]; off[0] = 0;
#pragma unroll
    for (int e = 0; e < 8; ++e) off[e + 1] = off[e] + ((cnt[e] + 255) & ~255);
    if (blockIdx.x == 0) {
        for (int i = tid; i < ROWS_MAX / 256; i += 512) { int e = -1;
#pragma unroll
            for (int k = 0; k < 8; ++k) if (i * 256 >= off[k] && i * 256 < off[k + 1]) e = k;
            tile_e[i] = e < 0 ? 0 : e; }
        if (tid == 0) ((int*)(p.ws + SM_CTL))[8] = off[8];
    }
    if (blockIdx.x < 8 && tid < 256) {
#pragma unroll
        for (int e = 0; e < 8; ++e) if (e == (int)blockIdx.x) { const int c = cnt[e]; if (c + tid < off[e + 1] - off[e]) roww[off[e] + c + tid] = 0.f; }
    }
    for (int pi = gw; pi < 2 * T; pi += NGW) {
        const int e = te[pi]; int o = 0;
#pragma unroll
        for (int k = 0; k < 8; ++k) if (k == e) o = off[k];
        const int r = o + rank[pi];
        if (lane == 0) { pos[pi] = r; roww[r] = tw[pi]; }
        const u32x4* src = (const u32x4*)(xn + (size_t)(pi >> 1) * D); u32x4* dst = (u32x4*)(xs + (size_t)r * D);
        dst[lane] = src[lane]; dst[64 + lane] = src[64 + lane];
    }
}
__device__ __forceinline__ void phase_moe_combine(const Params& p) {
    const int lane = threadIdx.x & 63, gw = blockIdx.x * 8 + (threadIdx.x >> 6), NGW = gridDim.x * 8;
    const int* pos = (const int*)(p.ws + SM_POS); const bf16_t* ym = (const bf16_t*)(p.ws + R_XA);
    for (int m = gw; m < T; m += NGW) {
        const int p0 = pos[m * 2], p1 = pos[m * 2 + 1];
#pragma unroll
        for (int j = 0; j < 4; ++j) {
            const int d = 4 * lane + 256 * j;
            f32x4* o = (f32x4*)(p.out + (size_t)m * D + d); f32x4 x = *o;
            const u32x2 a = *(const u32x2*)(ym + (size_t)p0 * D + d), c = *(const u32x2*)(ym + (size_t)p1 * D + d);
            x.x += bflo(a.x) + bflo(c.x); x.y += bfhi(a.x) + bfhi(c.x); x.z += bflo(a.y) + bflo(c.y); x.w += bfhi(a.y) + bfhi(c.y);
            *o = x;
        }
    }
}

__global__ void __launch_bounds__(512) mega_fwd(Params p) {
    extern __shared__ __attribute__((aligned(16))) unsigned char lds_raw[];
    LAS unsigned char* lds = (LAS unsigned char*)lds_raw;
    cg::grid_group grid = cg::this_grid();
    const int G = gridDim.x, c = blockIdx.x;
    bf16_t* W = (bf16_t*)p.ws;
    bf16_t* xn = (bf16_t*)(p.ws + R_XN);
    float* x1 = (float*)(p.ws + R_XA);
    pg8::StaticOrder SO;
#ifndef PHMASK
#define PHMASK 0xFFFFFFFFu
#endif
#define PH(k) if (((PHMASK >> (k)) & 1u) && (k) >= p.ph_lo && (k) <= p.ph_hi)
    PH(0) phase_p0(p, lds);
    grid.sync();
    PH(1) {
        pg8::Gemm g{xn, W + W_IN_E / 2, T, 1792, 1024, 1024, nullptr, 0}; SO.init(T, 1792, G, c);
        pg8::EpiBf16<0> E{(bf16_t*)(p.ws + R_H), 1792, nullptr};
        pg8::gemm_phase<pg8::EpiBf16<0>, true>(lds, g, SO, E);
    }
    grid.sync();
    PH(2) phase_p2(p, lds);
    grid.sync();
    PH(3) {
        for (int kv = 0; kv < 2; ++kv) {
            pg8::Gemm g{(const bf16_t*)(p.ws + R_XA + (kv ? A_VCIN : A_KCIN)), W + W_CW1 / 2 + (size_t)kv * 256 * 2048, NB * 512, 256, 2048, 1024, nullptr, 0}; SO.init(NB * 512, 256, G, c);
            pg8::EpiBf16<2> E{(bf16_t*)(p.ws + SM_HID) + (size_t)kv * NB * 512 * 256, 256, (const float*)(p.ws + SM_B1) + kv * 256};
            pg8::gemm_phase<pg8::EpiBf16<2>, true>(lds, g, SO, E);
        }
        {
            pg8::Gemm g{(const bf16_t*)(p.ws + R_XA + A_CQN), W + W_UQ / 2, T, 768, 256, 256, nullptr, 0}; SO.init(T, 768, G, c);
            pg8::EpiBf16<0> E{(bf16_t*)(p.ws + R_H), 768, nullptr};
            pg8::gemm_phase<pg8::EpiBf16<0>, true>(lds, g, SO, E);
        }
        {
            pg8::Gemm g{(const bf16_t*)(p.ws + R_XA + A_CKVN), W + W_UKV / 2, T, 1024, 128, 128, nullptr, 0}; SO.init(T, 1024, G, c);
            pg8::EpiBf16<0> E{(bf16_t*)(p.ws + R_H + (size_t)T * 1536), 1024, nullptr};
            pg8::gemm_phase<pg8::EpiBf16<0>, true>(lds, g, SO, E);
        }
    }
    grid.sync();
    PH(4) phase_p3b(p, lds);
    grid.sync();
    PH(5) phase_p4(p, lds);
    grid.sync();
    PH(6) {
        pg8::Gemm g{xn, W + W_OUT_E / 2, T, 1024, 1024, 1024, nullptr, 0}; SO.init(T, 1024, G, c);
        pg8::EpiResF32 E{p.in[0], x1, 1024};
        pg8::gemm_phase<pg8::EpiResF32, true>(lds, g, SO, E);
    }
    grid.sync();
    PH(7) phase_norm(x1, p.in[16], xn);
    grid.sync();
    PH(8) {
        pg8::Gemm g{xn, W + W_GU / 2, T, 5632, 1024, 1024, nullptr, 0}; SO.init(T, 5632, G, c);
        pg8::EpiSwiGLU E{(bf16_t*)(p.ws + R_H), 2816};
        pg8::gemm_phase<pg8::EpiSwiGLU, true>(lds, g, SO, E);
    }
    grid.sync();
    PH(9) {
        pg8::Gemm g{(const bf16_t*)(p.ws + R_H), W + W_D / 2, T, 1024, 2816, 2816, nullptr, 0}; SO.init(T, 1024, G, c);
        pg8::EpiResF32 E{x1, p.out, 1024};
        pg8::gemm_phase<pg8::EpiResF32, true>(lds, g, SO, E);
    }
    grid.sync();
    PH(10) phase_norm(p.out, p.in[20], xn);
    grid.sync();
    PH(11) {
        pg8::Gemm g{xn, W + W_IN_O / 2, T, 3072, 1024, 1024, nullptr, 0}; SO.init(T, 3072, G, c);
        pg8::EpiBf16<0> E{(bf16_t*)(p.ws + R_H), 3072, nullptr};
        pg8::gemm_phase<pg8::EpiBf16<0>, true>(lds, g, SO, E);
    }
    grid.sync();
    PH(12) phase_conv(p);
    grid.sync();
    PH(13) {
        pg8::Gemm g{xn, W + W_OUT_O / 2, T, 1024, 1024, 1024, nullptr, 0}; SO.init(T, 1024, G, c);
        pg8::EpiResF32 E{p.out, p.out, 1024};
        pg8::gemm_phase<pg8::EpiResF32, true>(lds, g, SO, E);
    }
    grid.sync();
    PH(14) phase_norm_router(p, lds);
    grid.sync();
    PH(15) phase_moe_gather(p);
    grid.sync();
    const int mrows = ((const int*)(p.ws + SM_CTL))[8];
    PH(16) {
        pg8::Gemm g{(const bf16_t*)(p.ws + R_XA), W + W_MGU / 2, mrows, 2816, 1024, 1024, (const int*)(p.ws + SM_TILEE), (size_t)2816 * 1024}; SO.init(mrows, 2816, G, c);
        pg8::EpiSwiGLU E{(bf16_t*)(p.ws + R_H), 1408};
        pg8::gemm_phase<pg8::EpiSwiGLU, true>(lds, g, SO, E);
    }
    grid.sync();
    PH(17) {
        pg8::Gemm g{(const bf16_t*)(p.ws + R_H), W + W_MD / 2, mrows, 1024, 1408, 1408, (const int*)(p.ws + SM_TILEE), (size_t)1024 * 1408}; SO.init(mrows, 1024, G, c);
        pg8::EpiRowScaleBf16 E{(bf16_t*)(p.ws + R_XA), 1024, (const float*)(p.ws + SM_ROWW)};
        pg8::gemm_phase<pg8::EpiRowScaleBf16, true>(lds, g, SO, E);
    }
    grid.sync();
    PH(18) phase_moe_combine(p);
#undef PH
}

inline void launch(void* const* d_in, float* d_out, void* d_ws, size_t ws_size, hipStream_t stream, int ph_lo = 0, int ph_hi = 99, int dbg_branch = -1) {
    static int grid = 0;
    if (grid == 0) {
        int dev = 0, cus = 0, per_cu = 0;
        hipGetDevice(&dev); hipDeviceGetAttribute(&cus, hipDeviceAttributeMultiprocessorCount, dev);
        hipFuncSetAttribute((const void*)mega_fwd, hipFuncAttributeMaxDynamicSharedMemorySize, LDS_BYTES);
        hipOccupancyMaxActiveBlocksPerMultiprocessor(&per_cu, (const void*)mega_fwd, 512, LDS_BYTES);
        if (per_cu < 1) { fprintf(stderr, "occupancy query says %d blocks/CU\n", per_cu); per_cu = 1; }
        grid = cus;
        if (WS_FAST_END > ws_size) { fprintf(stderr, "ws too small: need %zu have %zu\n", (size_t)WS_FAST_END, ws_size); grid = -1; }
    }
    if (grid < 0) return;
    if (ph_lo <= 14 && ph_hi >= 14) hipMemsetAsync((char*)d_ws + SM_CTL, 0, 4096, stream);
    Params p{};
    for (int i = 0; i < 30; ++i) p.in[i] = (const float*)d_in[i];
    p.out = d_out; p.ws = (unsigned char*)d_ws; p.ph_lo = ph_lo; p.ph_hi = ph_hi; p.dbg_branch = dbg_branch;
    void* args[] = {&p};
    hipError_t e = hipLaunchCooperativeKernel((const void*)mega_fwd, dim3(grid), dim3(512), args, LDS_BYTES, stream);
    if (e != hipSuccess) fprintf(stderr, "cooperative launch failed: %s (grid %d)\n", hipGetErrorString(e), grid);
}
}
extern "C" void kernel_launch(void* const* d_in, const int* in_sizes, int n_in, void* d_out, int out_size, void* d_ws, size_t ws_size, hipStream_t stream) {
    fast::launch(d_in, (float*)d_out, d_ws, ws_size, stream);
}
```

```cpp
#include <hip/hip_runtime.h>
#include <hip/hip_bf16.h>
#include <stdint.h>
#include <stdio.h>
#include <string.h>
#include <hip/hip_cooperative_groups.h>
namespace cg = cooperative_groups;
#define NB 8
#define REPEAT_MASK 0x0u
namespace gold {
constexpr int S = 4096, D = 1024, HW = 1720;
constexpr float EPS = 1e-6f;

__device__ const unsigned char T5B[128] = {0, 1, 2, 3, 4, 5, 6, 7, 8, 9, 10, 11, 12, 13, 14, 15, 16, 16, 16, 17, 17, 18, 18, 18, 19, 19, 19, 20, 20, 20, 20, 21, 21, 21, 21, 22, 22, 22, 22, 22, 23, 23, 23, 23, 23, 23, 24, 24, 24, 24, 24, 24, 25, 25, 25, 25, 25, 25, 25, 26, 26, 26, 26, 26, 26, 26, 26, 27, 27, 27, 27, 27, 27, 27, 27, 27, 27, 28, 28, 28, 28, 28, 28, 28, 28, 28, 28, 29, 29, 29, 29, 29, 29, 29, 29, 29, 29, 29, 29, 30, 30, 30, 30, 30, 30, 30, 30, 30, 30, 30, 30, 30, 30, 31, 31, 31, 31, 31, 31, 31, 31, 31, 31, 31, 31, 31, 31};
}
#ifndef NB
#define NB 8
#endif
namespace fast {
#define LAS __attribute__((address_space(3)))
typedef unsigned short bf16_t;
typedef short bf16x8 __attribute__((ext_vector_type(8)));
typedef float f32x4 __attribute__((ext_vector_type(4)));
typedef float f32x2 __attribute__((ext_vector_type(2)));
typedef float f32x16 __attribute__((ext_vector_type(16)));
typedef unsigned u32x4 __attribute__((ext_vector_type(4)));
typedef unsigned u32x2 __attribute__((ext_vector_type(2)));
typedef __bf16 bf16x2_t __attribute__((ext_vector_type(2)));

constexpr int S = 4096, T = NB * S, D = 1024;
constexpr float EPS = 1e-6f, LOG2E = 1.4426950408889634f;

__device__ __forceinline__ unsigned cvtpk(float lo, float hi) { f32x2 v = {lo, hi}; bf16x2_t b = __builtin_convertvector(v, bf16x2_t); return __builtin_bit_cast(unsigned, b); }
__device__ __forceinline__ bf16_t f2bf(float f) { return (bf16_t)(cvtpk(f, 0.f) & 0xffffu); }
__device__ __forceinline__ float bf2f(bf16_t u) { return __builtin_bit_cast(float, (unsigned)u << 16); }
__device__ __forceinline__ float bflo(unsigned u) { return __builtin_bit_cast(float, u << 16); }
__device__ __forceinline__ float bfhi(unsigned u) { return __builtin_bit_cast(float, u & 0xffff0000u); }
__device__ __forceinline__ float wsum(float v) {
#pragma unroll
    for (int o = 1; o < 64; o <<= 1) v += __shfl_xor(v, o);
    return v;
}
__device__ __forceinline__ float fexp2(float x) { return __builtin_amdgcn_exp2f(x); }
__device__ __forceinline__ float frcp(float x) { return __builtin_amdgcn_rcpf(x); }
__device__ __forceinline__ float silu_f(float x) { return x * frcp(1.f + fexp2(-x * LOG2E)); }
__device__ __forceinline__ float gelu_tanh_f(float x) {
    const float u = 0.7978845608028654f * (x + 0.044715f * x * x * x);
    return x * frcp(1.f + fexp2(-2.f * LOG2E * u));
}

namespace pg8 {
constexpr int BM = 256, BK = 64, HALF = 128, HTB = HALF * BK * 2, STAGE_BYTES = 8 * HTB, NXCD = 8, WGM = 8;
__host__ __device__ __forceinline__ int lds_byte(int r, int c) { const int st = (r >> 4) * 2 + (c >> 5), rr = r & 15, cc = c & 31, ob = rr * 64 + cc * 2; return st * 1024 + (ob ^ (((ob >> 9) & 1) << 5)); }
__host__ __device__ __forceinline__ void stage_rc(int b, int& R, int& C) { const int st = b / 1024, sb = b % 1024, swz = sb ^ (((sb >> 9) & 1) << 5); R = (st >> 1) * 16 + swz / 64; C = (st & 1) * 32 + (swz % 64) / 2; }
__host__ __device__ __forceinline__ int perm32(int rho) { const int n = rho >> 4, i = rho & 15; return 8 * (i >> 2) + 4 * n + (i & 3); }

struct Unit { int pm, pn; };
struct Gemm { const bf16_t* A; const bf16_t* Bt; int M, N, K, lda; const int* tile_e; size_t estride; };

struct StaticOrder {
    int nM, nN, nwg, G, c;
    __device__ void init(int M, int N, int G_, int c_) { nM = M / BM; nN = N / BM; nwg = nM * nN; G = G_; c = c_; }
    __device__ bool next(int i, Unit& u) const {
        const long L = (long)i * G + c; if (L >= nwg) return false;
        int wgid = (int)L; { const int q = nwg / NXCD, r = nwg % NXCD, xcd = wgid % NXCD, off = wgid / NXCD; wgid = (xcd < r ? xcd * (q + 1) : r * (q + 1) + (xcd - r) * q) + off; }
        const int nig = WGM * nN, gid = wgid / nig, fm = gid * WGM, gsz = (nM - fm) < WGM ? (nM - fm) : WGM;
        u.pm = fm + ((wgid % nig) % gsz); u.pn = (wgid % nig) / gsz; return true;
    }
};

template <class Epi, bool ALIGN_EPI>
__device__ __forceinline__ void gemm_phase(LAS unsigned char* lds, const Gemm g, const StaticOrder& S, const Epi& E) {
    int tid = threadIdx.x; asm volatile("" : "+v"(tid));
    const int wid = __builtin_amdgcn_readfirstlane(tid >> 6), lane = tid & 63, wr = wid >> 2, wc = wid & 3, fr = lane & 15, fq = lane >> 4;
    const int K = g.K, nt = K / BK, lda = g.lda;
    unsigned voffA[2], voffB[2];
#pragma unroll
    for (int i = 0; i < 2; ++i) { int R, C; stage_rc(tid * 16 + i * 8192, R, C); const int Rb = Epi::PERM ? ((R & ~31) + perm32(R & 31)) : R;
        voffA[i] = (unsigned)(R * lda + C) * 2u; voffB[i] = (unsigned)(Rb * K + C) * 2u; }
    const size_t kstep = (size_t)(BK * 2);
    const size_t hsA = (size_t)HALF * lda * 2, tsA = 2 * hsA, hsB = (size_t)HALF * K * 2, tsB = 2 * hsB;
    const unsigned ldsw = (unsigned)wid * 1024u;
    const int aoff = lds_byte(wr * 64 + fr, fq * 8), boff = lds_byte(wc * 32 + fr, fq * 8);
#define PG8_SA(b, h) (((b) * 2 + (h)) * HTB)
#define PG8_SB(b, h) ((4 + (b) * 2 + (h)) * HTB)
#define PG8_STAGE(bufoff, gbase, voff) do { _Pragma("unroll") for (int _i = 0; _i < 2; ++_i) \
        __builtin_amdgcn_global_load_lds((const unsigned*)((const char*)(gbase) + (voff)[_i]), (LAS unsigned*)(lds + (bufoff) + ldsw + _i * 8192), 16, 0, 0); } while (0)
#define PG8_LDA(dst, b, h) do { _Pragma("unroll") for (int m = 0; m < 4; ++m) _Pragma("unroll") for (int k = 0; k < 2; ++k) dst[m][k] = *(const LAS bf16x8*)(lds + PG8_SA(b, h) + aoff + m * 2048 + k * 1024); } while (0)
#define PG8_LDB(dst, b, h) do { _Pragma("unroll") for (int n = 0; n < 2; ++n) _Pragma("unroll") for (int k = 0; k < 2; ++k) dst[n][k] = *(const LAS bf16x8*)(lds + PG8_SB(b, h) + boff + n * 2048 + k * 1024); } while (0)
#define PG8_MMA(ai, bj, At, Bt) do { __builtin_amdgcn_s_setprio(1); _Pragma("unroll") for (int m = 0; m < 4; ++m) _Pragma("unroll") for (int n = 0; n < 2; ++n) _Pragma("unroll") for (int k = 0; k < 2; ++k) \
        acc[ai][bj][m][n] = __builtin_amdgcn_mfma_f32_16x16x32_bf16(Bt[n][k], At[m][k], acc[ai][bj][m][n], 0, 0, 0); __builtin_amdgcn_s_setprio(0); } while (0)
#define PG8_WAIT_V(n) asm volatile("s_waitcnt vmcnt(" #n ")" ::: "memory")
#define PG8_WAIT_L(n) asm volatile("s_waitcnt lgkmcnt(" #n ")" ::: "memory")
#define PG8_BAR __builtin_amdgcn_s_barrier()
#define PG8_SCHED __builtin_amdgcn_sched_barrier(0)
#define PG8_EOFF(pm_) (g.tile_e ? (size_t)g.tile_e[pm_] * g.estride * 2 : (size_t)0)
    Unit cur, nxt; int ui = 0;
    if (!S.next(0, cur)) return;
    f32x4 acc[2][2][4][2];
#pragma unroll
    for (int a = 0; a < 2; ++a)
#pragma unroll
        for (int b = 0; b < 2; ++b)
#pragma unroll
            for (int m = 0; m < 4; ++m)
#pragma unroll
                for (int n = 0; n < 2; ++n) acc[a][b][m][n] = (f32x4){0.f, 0.f, 0.f, 0.f};
    bf16x8 At[4][2], B0[2][2], B1[2][2];
    const char* cA = (const char*)g.A + (size_t)cur.pm * tsA; const char* cB = (const char*)g.Bt + PG8_EOFF(cur.pm) + (size_t)cur.pn * tsB;
    PG8_STAGE(PG8_SB(0, 0), cB, voffB); PG8_STAGE(PG8_SB(0, 1), cB + hsB, voffB); PG8_STAGE(PG8_SA(0, 0), cA, voffA); PG8_STAGE(PG8_SA(0, 1), cA + hsA, voffA);
    if (wr == 1) PG8_BAR;
    PG8_WAIT_V(2); PG8_BAR;
    PG8_STAGE(PG8_SB(1, 0), cB + kstep, voffB); PG8_STAGE(PG8_SA(1, 0), cA + kstep, voffA); PG8_STAGE(PG8_SB(1, 1), cB + hsB + kstep, voffB);
    PG8_WAIT_V(6); PG8_BAR;
    for (;;) {
        const bool has_next = S.next(ui + 1, nxt);
        const char* nA = has_next ? (const char*)g.A + (size_t)nxt.pm * tsA : cA;
        const char* nB = has_next ? (const char*)g.Bt + PG8_EOFF(nxt.pm) + (size_t)nxt.pn * tsB : cB;
        for (int t = 0; t < nt; t += 2) {
            const bool last = (t == nt - 2);
            const char* a1 = cA + (size_t)(t + 1) * kstep;
            const char* a2 = last ? nA : cA + (size_t)(t + 2) * kstep; const char* b2 = last ? nB : cB + (size_t)(t + 2) * kstep;
            const char* a3 = a2 + kstep; const char* b3 = b2 + kstep;
            PG8_LDB(B0, 0, 0); PG8_LDB(B1, 0, 1); PG8_SCHED; PG8_LDA(At, 0, 0); PG8_STAGE(PG8_SA(1, 1), a1 + hsA, voffA);
            PG8_WAIT_V(8); PG8_WAIT_L(0); PG8_BAR; PG8_MMA(0, 0, At, B0); PG8_MMA(0, 1, At, B1); PG8_BAR; PG8_SCHED;
            PG8_LDA(At, 0, 1); PG8_STAGE(PG8_SB(0, 0), b2, voffB); PG8_STAGE(PG8_SB(0, 1), b2 + hsB, voffB); PG8_STAGE(PG8_SA(0, 0), a2, voffA);
            PG8_WAIT_V(8); PG8_WAIT_L(0); PG8_BAR; PG8_MMA(1, 0, At, B0); PG8_MMA(1, 1, At, B1); PG8_BAR; PG8_SCHED;
            PG8_LDB(B0, 1, 0); PG8_LDB(B1, 1, 1); PG8_SCHED; PG8_LDA(At, 1, 0); PG8_STAGE(PG8_SA(0, 1), a2 + hsA, voffA);
            PG8_WAIT_V(8); PG8_WAIT_L(0); PG8_BAR; PG8_MMA(0, 0, At, B0); PG8_MMA(0, 1, At, B1); PG8_BAR; PG8_SCHED;
            PG8_LDA(At, 1, 1); PG8_STAGE(PG8_SB(1, 0), b3, voffB); PG8_STAGE(PG8_SB(1, 1), b3 + hsB, voffB); PG8_STAGE(PG8_SA(1, 0), a3, voffA);
            PG8_WAIT_V(8); PG8_WAIT_L(0); PG8_BAR; PG8_MMA(1, 0, At, B0); PG8_MMA(1, 1, At, B1); PG8_BAR; PG8_SCHED;
        }
        if constexpr (ALIGN_EPI) { if (wr == 0) PG8_BAR; }
        E(acc, cur, wr, wc, fr, fq);
        if (!has_next) break;
#pragma unroll
        for (int a = 0; a < 2; ++a)
#pragma unroll
            for (int b = 0; b < 2; ++b)
#pragma unroll
                for (int m = 0; m < 4; ++m)
#pragma unroll
                    for (int n = 0; n < 2; ++n) acc[a][b][m][n] = (f32x4){0.f, 0.f, 0.f, 0.f};
        cur = nxt; cA = nA; cB = nB; ++ui;
        if constexpr (ALIGN_EPI) { if (wr == 1) PG8_BAR; }
    }
    PG8_WAIT_V(0);
    if constexpr (!ALIGN_EPI) { if (wr == 0) PG8_BAR; }
    PG8_BAR;
#undef PG8_SA
#undef PG8_SB
#undef PG8_STAGE
#undef PG8_LDA
#undef PG8_LDB
#undef PG8_MMA
#undef PG8_WAIT_V
#undef PG8_WAIT_L
#undef PG8_BAR
#undef PG8_SCHED
#undef PG8_EOFF
}

template <int ACT> struct EpiBf16 {
    static constexpr bool PERM = true;
    bf16_t* O; int ldc; const float* bias;
    __device__ __forceinline__ void operator()(const f32x4 (&acc)[2][2][4][2], const Unit& u, int wr, int wc, int fr, int fq) const {
        const int row0 = u.pm * BM + wr * 64 + fr, col0 = u.pn * BM + wc * 32 + 8 * fq;
        f32x4 bv[2][2];
#pragma unroll
        for (int bj = 0; bj < 2; ++bj)
#pragma unroll
            for (int n = 0; n < 2; ++n) bv[bj][n] = bias ? *(const f32x4*)(bias + col0 + bj * HALF + 4 * n) : (f32x4){0.f, 0.f, 0.f, 0.f};
#pragma unroll
        for (int ai = 0; ai < 2; ++ai)
#pragma unroll
            for (int m = 0; m < 4; ++m) { bf16_t* rowp = O + (size_t)(row0 + ai * HALF + m * 16) * ldc + col0;
#pragma unroll
                for (int bj = 0; bj < 2; ++bj) { f32x4 v0 = acc[ai][bj][m][0] + bv[bj][0], v1 = acc[ai][bj][m][1] + bv[bj][1];
                    if (ACT == 2) {
#pragma unroll
                        for (int i = 0; i < 4; ++i) { v0[i] = gelu_tanh_f(v0[i]); v1[i] = gelu_tanh_f(v1[i]); } }
                    u32x4 w; w.x = cvtpk(v0[0], v0[1]); w.y = cvtpk(v0[2], v0[3]); w.z = cvtpk(v1[0], v1[1]); w.w = cvtpk(v1[2], v1[3]);
                    *(u32x4*)(rowp + bj * HALF) = w; } }
    }
};
struct EpiResF32 {
    static constexpr bool PERM = false;
    const float* base; float* out; int ldc;
    __device__ __forceinline__ void operator()(const f32x4 (&acc)[2][2][4][2], const Unit& u, int wr, int wc, int fr, int fq) const {
        const int col0 = u.pn * BM + wc * 32 + 4 * fq;
#pragma unroll
        for (int ai = 0; ai < 2; ++ai)
#pragma unroll
            for (int m = 0; m < 4; ++m) { const size_t off = (size_t)(u.pm * BM + ai * HALF + wr * 64 + m * 16 + fr) * ldc + col0;
#pragma unroll
                for (int bj = 0; bj < 2; ++bj)
#pragma unroll
                    for (int n = 0; n < 2; ++n) { const f32x4 bs = *(const f32x4*)(base + off + bj * HALF + n * 16); *(f32x4*)(out + off + bj * HALF + n * 16) = bs + acc[ai][bj][m][n]; } }
    }
};
struct EpiSwiGLU {
    static constexpr bool PERM = true;
    bf16_t* O; int ldc;
    __device__ __forceinline__ void operator()(const f32x4 (&acc)[2][2][4][2], const Unit& u, int wr, int wc, int fr, int fq) const {
        const int row0 = u.pm * BM + wr * 64 + fr, col0 = u.pn * HALF + wc * 32 + 8 * fq;
#pragma unroll
        for (int ai = 0; ai < 2; ++ai)
#pragma unroll
            for (int m = 0; m < 4; ++m) { bf16_t* rowp = O + (size_t)(row0 + ai * HALF + m * 16) * ldc + col0;
                float h[8];
#pragma unroll
                for (int n = 0; n < 2; ++n)
#pragma unroll
                    for (int i = 0; i < 4; ++i) h[n * 4 + i] = silu_f(acc[ai][0][m][n][i]) * acc[ai][1][m][n][i];
                u32x4 w; w.x = cvtpk(h[0], h[1]); w.y = cvtpk(h[2], h[3]); w.z = cvtpk(h[4], h[5]); w.w = cvtpk(h[6], h[7]);
                *(u32x4*)rowp = w; }
    }
};
struct EpiRowScaleBf16 {
    static constexpr bool PERM = true;
    bf16_t* O; int ldc; const float* roww;
    __device__ __forceinline__ void operator()(const f32x4 (&acc)[2][2][4][2], const Unit& u, int wr, int wc, int fr, int fq) const {
        const int row0 = u.pm * BM + wr * 64 + fr, col0 = u.pn * BM + wc * 32 + 8 * fq;
#pragma unroll
        for (int ai = 0; ai < 2; ++ai)
#pragma unroll
            for (int m = 0; m < 4; ++m) { const int row = row0 + ai * HALF + m * 16; const float sc = roww[row]; bf16_t* rowp = O + (size_t)row * ldc + col0;
#pragma unroll
                for (int bj = 0; bj < 2; ++bj) { const f32x4 v0 = acc[ai][bj][m][0] * sc, v1 = acc[ai][bj][m][1] * sc;
                    u32x4 w; w.x = cvtpk(v0[0], v0[1]); w.y = cvtpk(v0[2], v0[3]); w.z = cvtpk(v1[0], v1[1]); w.w = cvtpk(v1[2], v1[3]);
                    *(u32x4*)(rowp + bj * HALF) = w; } }
    }
};
}
constexpr int ROWS_MAX = 2 * T + 8 * 256;
constexpr size_t al256(size_t x) { return (x + 255) & ~(size_t)255; }
constexpr size_t W_IN_E = 0;
constexpr size_t W_CW1 = W_IN_E + (size_t)1792 * 1024 * 2;
constexpr size_t W_UQ = W_CW1 + (size_t)2 * 256 * 2048 * 2;
constexpr size_t W_UKV = W_UQ + (size_t)768 * 256 * 2;
constexpr size_t W_OUT_E = W_UKV + (size_t)1024 * 128 * 2;
constexpr size_t W_GU = W_OUT_E + (size_t)1024 * 1024 * 2;
constexpr size_t W_D = W_GU + (size_t)5632 * 1024 * 2;
constexpr size_t W_IN_O = W_D + (size_t)1024 * 2816 * 2;
constexpr size_t W_OUT_O = W_IN_O + (size_t)3072 * 1024 * 2;
constexpr size_t W_MGU = W_OUT_O + (size_t)1024 * 1024 * 2;
constexpr size_t W_MD = W_MGU + (size_t)8 * 2816 * 1024 * 2;
constexpr size_t W_END = W_MD + (size_t)8 * 1024 * 1408 * 2;
constexpr size_t SM_CTL = al256(W_END);
constexpr size_t SM_B1P = SM_CTL + 4096;
constexpr size_t SM_B1 = SM_B1P + 32 * 512 * 4;
constexpr size_t SM_ROPE = SM_B1 + 512 * 4;
constexpr size_t SM_BL = SM_ROPE + (size_t)S * 32 * 4;
constexpr size_t SM_HID = SM_BL + 8 * 132 * 4;
constexpr size_t SM_KC = SM_HID + (size_t)2 * NB * 512 * 256 * 2;
constexpr size_t SM_VCT = SM_KC + (size_t)NB * 512 * 64 * 2;
constexpr size_t SM_TE = SM_VCT + (size_t)NB * 512 * 64 * 2;
constexpr size_t SM_TW = SM_TE + (size_t)T * 8;
constexpr size_t SM_RANK = SM_TW + (size_t)T * 8;
constexpr size_t SM_POS = SM_RANK + (size_t)T * 8;
constexpr size_t SM_ROWW = SM_POS + (size_t)T * 8;
constexpr size_t SM_TILEE = SM_ROWW + (size_t)ROWS_MAX * 4;
constexpr size_t SM_END = SM_TILEE + (size_t)(ROWS_MAX / 256 + 8) * 4;
constexpr size_t R_XA = al256(SM_END);
constexpr size_t SZ_XA = (size_t)T * 4096 + (size_t)4 * 1048576;
constexpr size_t R_XN = R_XA + SZ_XA;
constexpr size_t SZ_XN = (size_t)T * 2048;
constexpr size_t R_H = R_XN + SZ_XN;
constexpr size_t SZ_H = ((size_t)T * 6144 > (size_t)ROWS_MAX * 2816) ? (size_t)T * 6144 : (size_t)ROWS_MAX * 2816;
constexpr size_t WS_FAST_END = R_H + SZ_H;
constexpr size_t A_QN = 0;
constexpr size_t A_KSN = A_QN + (size_t)T * 1024;
constexpr size_t A_KWN = A_KSN + (size_t)T * 256;
constexpr size_t A_VST = A_KWN + (size_t)T * 256;
constexpr size_t A_VWT = A_VST + (size_t)T * 256;
constexpr size_t A_KCIN = A_VWT + (size_t)T * 256;
constexpr size_t A_VCIN = A_KCIN + (size_t)T * 256 + 2048;
constexpr size_t A_CQN = A_VCIN + (size_t)T * 256 + 2048;
constexpr size_t A_CKVN = A_CQN + (size_t)T * 512;
constexpr size_t A_KROPE = A_CKVN + (size_t)T * 256;
constexpr size_t A_GATES = A_KROPE + (size_t)T * 64;
constexpr size_t A_END = A_GATES + (size_t)T * 96;
static_assert(A_END <= SZ_XA, "attention inputs fit R_XA");
constexpr size_t O_QM = 0;
constexpr size_t O_KM = O_QM + (size_t)T * 1536;
constexpr size_t O_VMT = O_KM + (size_t)T * 1536;
static_assert(O_VMT + (size_t)T * 1024 <= (size_t)T * 4096, "d_out scratch");

struct Params {
    const float* in[30];
    float* out;
    unsigned char* ws;
    int ph_lo, ph_hi, dbg_branch, pad_;
};

constexpr int LDS_BYTES = 147456;

__device__ __forceinline__ int ltid() { int t = threadIdx.x; asm volatile("" : "+v"(t)); return t; }
__device__ __forceinline__ int perm16(int k) { return (k & ~12) | ((k & 4) << 1) | ((k & 8) >> 1); }

struct WDesc { int in_idx, K, N, rep, map, row_off; size_t src_stride, dst_off, dst_stride; };
__device__ const WDesc WDESC[12] = {
    {3, 1024, 1720, 1, 0, 0, 0, W_IN_E / 2, 0},
    {7, 2048, 256, 2, 0, 0, (size_t)2048 * 256, W_CW1 / 2, (size_t)256 * 2048},
    {11, 256, 768, 1, 0, 0, 0, W_UQ / 2, 0},
    {12, 128, 1024, 1, 0, 0, 0, W_UKV / 2, 0},
    {15, 1024, 1024, 1, 0, 0, 0, W_OUT_E / 2, 0},
    {17, 1024, 2816, 1, 1, 0, 0, W_GU / 2, 0},
    {18, 1024, 2816, 1, 1, 128, 0, W_GU / 2, 0},
    {19, 2816, 1024, 1, 0, 0, 0, W_D / 2, 0},
    {21, 1024, 3072, 1, 0, 0, 0, W_IN_O / 2, 0},
    {23, 1024, 1024, 1, 0, 0, 0, W_OUT_O / 2, 0},
    {27, 1024, 1408, 8, 1, 0, (size_t)1024 * 1408, W_MGU / 2, (size_t)2816 * 1024},
    {28, 1024, 1408, 8, 1, 128, (size_t)1024 * 1408, W_MGU / 2, (size_t)2816 * 1024},
};
__device__ const WDesc WDESC_MD = {29, 1408, 1024, 8, 0, 0, (size_t)1408 * 1024, W_MD / 2, (size_t)1024 * 1408};

__device__ __forceinline__ void transpose_item(const float* W, int K, int N, bf16_t* WT, int map, int row_off, LAS float* scr, int item, int lane) {
    const int nblk = (N + 31) / 32, kb = item / nblk, nb = item % nblk, k0 = 64 * kb, n0 = 32 * nb;
    const int n4 = (lane & 7) * 4; const bool nok = (n0 + n4) < N;
    f32x4 v[8];
#pragma unroll
    for (int i = 0; i < 8; ++i) { const int kk = (lane >> 3) + 8 * i; v[i] = nok ? *(const f32x4*)(W + (size_t)(k0 + kk) * N + n0 + n4) : (f32x4){0.f, 0.f, 0.f, 0.f}; }
#pragma unroll
    for (int i = 0; i < 8; ++i) { const int kk = (lane >> 3) + 8 * i; LAS float* d = scr + kk * 33 + n4; d[0] = v[i].x; d[1] = v[i].y; d[2] = v[i].z; d[3] = v[i].w; }
    asm volatile("s_waitcnt lgkmcnt(0)" ::: "memory");
    const int c = lane & 7;
#pragma unroll
    for (int j = 0; j < 4; ++j) { const int n = (lane >> 3) + 8 * j; const LAS float* s = scr + (8 * c) * 33 + n;
        u32x4 o; o.x = cvtpk(s[0 * 33], s[1 * 33]); o.y = cvtpk(s[2 * 33], s[3 * 33]); o.z = cvtpk(s[4 * 33], s[5 * 33]); o.w = cvtpk(s[6 * 33], s[7 * 33]);
        const int nn = n0 + n;
        if (nn < N) { const int row = map ? (256 * (nn >> 7) + (nn & 127) + row_off) : (nn + row_off);
            *(u32x4*)(WT + (size_t)row * K + k0 + 8 * c) = o; } }
    asm volatile("s_waitcnt lgkmcnt(0)" ::: "memory");
}
__device__ __forceinline__ void do_wdesc(const Params& p, const WDesc& d, int it, LAS float* scr, int lane) {
    const int per = (d.K / 64) * ((d.N + 31) / 32); const int r = it / per, ii = it % per;
    transpose_item(p.in[d.in_idx] + (size_t)r * d.src_stride, d.K, d.N, (bf16_t*)p.ws + d.dst_off + (size_t)r * d.dst_stride, d.map, d.row_off, scr, ii, lane);
}
__device__ __forceinline__ void rms_row_to_bf16(const float* xrow, const float* g, bf16_t* orow, int lane) {
    const f32x4* xr = (const f32x4*)xrow + lane; const f32x4* gr = (const f32x4*)g + lane;
    f32x4 v[4]; float s = 0.f;
#pragma unroll
    for (int j = 0; j < 4; ++j) { v[j] = xr[64 * j]; s += (v[j].x * v[j].x + v[j].y * v[j].y) + (v[j].z * v[j].z + v[j].w * v[j].w); }
    const float r = rsqrtf(wsum(s) * (1.f / 1024.f) + EPS);
    u32x2* o8 = (u32x2*)orow + lane;
#pragma unroll
    for (int j = 0; j < 4; ++j) { const f32x4 gg = gr[64 * j]; u32x2 w; w.x = cvtpk(v[j].x * r * gg.x, v[j].y * r * gg.y); w.y = cvtpk(v[j].z * r * gg.z, v[j].w * r * gg.w); o8[64 * j] = w; }
}
__device__ __forceinline__ void phase_p0(const Params& p, LAS unsigned char* lds) {
    const int tid = ltid(), lane = tid & 63, wave = tid >> 6;
    const int gw = blockIdx.x * 8 + wave, NGW = gridDim.x * 8;
    LAS float* scr = (LAS float*)(lds + wave * 16384);
    int base = 0;
#pragma unroll 1
    for (int d = 0; d < 13; ++d) {
        const WDesc& wd = (d < 12) ? WDESC[d] : WDESC_MD;
        const int n_it = wd.rep * (wd.K / 64) * ((wd.N + 31) / 32);
        int first = (gw - (base % NGW) + NGW) % NGW;
        for (int it = first; it < n_it; it += NGW) do_wdesc(p, wd, it, scr, lane);
        base += n_it;
    }
    bf16_t* xn = (bf16_t*)(p.ws + R_XN);
    for (int m = gw; m < T; m += 2 * NGW) { rms_row_to_bf16(p.in[0] + (size_t)m * D, p.in[2], xn + (size_t)m * D, lane); if (m + NGW < T) rms_row_to_bf16(p.in[0] + (size_t)(m + NGW) * D, p.in[2], xn + (size_t)(m + NGW) * D, lane); }
    for (int u = gw; u < 256; u += NGW) {
        const int kc = u >> 3, kv = (u >> 2) & 1, nb = u & 3; float s = 0.f;
        const float* pos = p.in[6] + kv * 2048 + kc * 64; const float* w1 = p.in[7] + ((size_t)kv * 2048 + kc * 64) * 256 + nb * 64 + lane;
#pragma unroll 8
        for (int k = 0; k < 64; ++k) s += pos[k] * w1[(size_t)k * 256];
        ((float*)(p.ws + SM_B1P))[kc * 512 + kv * 256 + nb * 64 + lane] = s;
    }
    for (int i = blockIdx.x * 512 + tid; i < S * 16; i += gridDim.x * 512) {
        const int t = i >> 4, f = i & 15; const float ang = (float)t * powf(10000.f, -(float)f / 16.f);
        float* rp = (float*)(p.ws + SM_ROPE) + t * 32; rp[f] = cosf(ang); rp[16 + f] = sinf(ang);
    }
    if (blockIdx.x == 0) for (int i = tid; i < 8 * 129; i += 512) { const int h = i / 129, dd = i % 129; ((float*)(p.ws + SM_BL))[h * 132 + dd] = p.in[1][(dd < 128 ? (int)gold::T5B[dd] : 31) * 8 + h] * LOG2E; }
}

__device__ __forceinline__ void phase_p2(const Params& p, LAS unsigned char* lds) {
    const int tid = ltid(), lane = tid & 63, wave = tid >> 6;
    const bf16_t* hb = (const bf16_t*)(p.ws + R_H);
    unsigned char* xa = p.ws + R_XA;
    bf16_t* qn = (bf16_t*)(xa + A_QN); bf16_t* ksn = (bf16_t*)(xa + A_KSN); bf16_t* kwn = (bf16_t*)(xa + A_KWN);
    bf16_t* vst = (bf16_t*)(xa + A_VST); bf16_t* vwt = (bf16_t*)(xa + A_VWT); bf16_t* kcin = (bf16_t*)(xa + A_KCIN); bf16_t* vcin = (bf16_t*)(xa + A_VCIN);
    bf16_t* cqn = (bf16_t*)(xa + A_CQN); bf16_t* ckvn = (bf16_t*)(xa + A_CKVN); bf16_t* krope = (bf16_t*)(xa + A_KROPE); float* gates = (float*)(xa + A_GATES);
    const float* q_norm = p.in[4]; const float* k_norm = p.in[5]; const float* cq_norm = p.in[9]; const float* ckv_norm = p.in[10];
    LAS bf16_t* vs = (LAS bf16_t*)lds;
    if (blockIdx.x == 0) {
        { float s = 0.f; for (int k = 0; k < 32; ++k) s += ((const float*)(p.ws + SM_B1P))[k * 512 + tid]; ((float*)(p.ws + SM_B1))[tid] = s; }
        for (int i = tid; i < 1024; i += 512) { kcin[(size_t)T * 128 + i] = 0; vcin[(size_t)T * 128 + i] = 0; }
    }
    for (int tile = blockIdx.x; tile < T / 64; tile += gridDim.x) {
        const int b = tile / (S / 64), s0 = (tile % (S / 64)) * 64;
        for (int tt = 0; tt < 8; ++tt) {
            const int sl = wave * 8 + tt, s = s0 + sl; const size_t t = (size_t)b * S + s;
            const bf16_t* hr = hb + t * 1792;
#pragma unroll
            for (int hh = 0; hh < 8; ++hh) { const float v = bf2f(hr[hh * 64 + lane]); const float r = rsqrtf(wsum(v * v) * (1.f / 64.f) + EPS);
                qn[(t * 8 + hh) * 64 + lane] = f2bf(v * r * q_norm[lane] * (0.125f * LOG2E)); }
#pragma unroll
            for (int g = 0; g < 2; ++g) {
                const size_t gm = (((size_t)b * 2 + g) * S + s) * 64 + lane;
                float v = bf2f(hr[768 + g * 64 + lane]); float r = rsqrtf(wsum(v * v) * (1.f / 64.f) + EPS); ksn[gm] = f2bf(v * r * k_norm[64 + lane]);
                v = bf2f(hr[1024 + g * 64 + lane]); r = rsqrtf(wsum(v * v) * (1.f / 64.f) + EPS); kwn[gm] = f2bf(v * r * k_norm[128 + lane]);
                kcin[gm] = hr[512 + g * 64 + lane]; vcin[gm] = hr[640 + g * 64 + lane];
                const int pp = (sl & ~15) | perm16(sl & 15);
                vs[((0 + g) * 64 + lane) * 72 + pp] = hr[896 + g * 64 + lane];
                vs[((2 + g) * 64 + lane) * 72 + pp] = hr[1152 + g * 64 + lane];
            }
            if (lane < 24) gates[t * 24 + lane] = frcp(1.f + fexp2(-bf2f(hr[1280 + lane]) * LOG2E));
            { float a[4]; float ss = 0.f;
#pragma unroll
                for (int j = 0; j < 4; ++j) { a[j] = bf2f(hr[1304 + j * 64 + lane]); ss += a[j] * a[j]; }
                const float r = rsqrtf(wsum(ss) * (1.f / 256.f) + EPS);
#pragma unroll
                for (int j = 0; j < 4; ++j) cqn[t * 256 + j * 64 + lane] = f2bf(a[j] * r * cq_norm[j * 64 + lane]); }
            { float a[2]; float ss = 0.f;
#pragma unroll
                for (int j = 0; j < 2; ++j) { a[j] = bf2f(hr[1560 + j * 64 + lane]); ss += a[j] * a[j]; }
                const float r = rsqrtf(wsum(ss) * (1.f / 128.f) + EPS);
#pragma unroll
                for (int j = 0; j < 2; ++j) ckvn[t * 128 + j * 64 + lane] = f2bf(a[j] * r * ckv_norm[j * 64 + lane]); }
            if (lane < 32) krope[t * 32 + lane] = hr[1688 + lane];
        }
        __syncthreads();
        {
            const int row = tid >> 1, half = tid & 1, which = row >> 6, d = row & 63, g = which & 1;
            bf16_t* dst = ((which < 2) ? vst : vwt) + (((size_t)b * 2 + g) * 64 + d) * S + s0 + half * 32;
            const LAS bf16_t* src = vs + row * 72 + half * 32;
#pragma unroll
            for (int c = 0; c < 4; ++c) *(u32x4*)(dst + c * 8) = *(const LAS u32x4*)(src + c * 8);
        }
        __syncthreads();
    }
}
__device__ __forceinline__ void phase_p3b(const Params& p, LAS unsigned char* lds) {
    const int tid = ltid(), lane = tid & 63, wave = tid >> 6;
    const int gw = blockIdx.x * 8 + wave, NGW = gridDim.x * 8;
    const bf16_t* qraw = (const bf16_t*)(p.ws + R_H);
    const bf16_t* kvraw = (const bf16_t*)(p.ws + R_H + (size_t)T * 1536);
    const bf16_t* krope = (const bf16_t*)(p.ws + R_XA + A_KROPE);
    const float* rope = (const float*)(p.ws + SM_ROPE);
    bf16_t* qm = (bf16_t*)((unsigned char*)p.out + O_QM); bf16_t* km = (bf16_t*)((unsigned char*)p.out + O_KM); bf16_t* vmt = (bf16_t*)((unsigned char*)p.out + O_VMT);
    const float* q_norm = p.in[13]; const float* k_norm = p.in[14];
    LAS bf16_t* vs = (LAS bf16_t*)lds;
    LAS float* w2s = (LAS float*)(lds + 73728);
    for (int kv = 0; kv < 2; ++kv) {
        __syncthreads();
        for (int i = tid; i < 256 * 64; i += 512) w2s[i] = p.in[8][kv * 16384 + i];
        __syncthreads();
        const bf16_t* hid = (const bf16_t*)(p.ws + SM_HID) + (size_t)kv * NB * 512 * 256;
        for (int row = gw; row < NB * 512; row += NGW) {
            const u32x2 hv = *(const u32x2*)(hid + (size_t)row * 256 + lane * 4);
            const float h0 = bflo(hv.x), h1 = bfhi(hv.x), h2 = bflo(hv.y), h3 = bfhi(hv.y);
            float acc = 0.f;
#pragma unroll 8
            for (int k4 = 0; k4 < 64; ++k4) {
                acc += __shfl(h0, k4) * w2s[(k4 * 4 + 0) * 64 + lane]; acc += __shfl(h1, k4) * w2s[(k4 * 4 + 1) * 64 + lane];
                acc += __shfl(h2, k4) * w2s[(k4 * 4 + 2) * 64 + lane]; acc += __shfl(h3, k4) * w2s[(k4 * 4 + 3) * 64 + lane];
            }
            if (kv == 0) { const float r = rsqrtf(wsum(acc * acc) * (1.f / 64.f) + EPS); ((bf16_t*)(p.ws + SM_KC))[(size_t)row * 64 + lane] = f2bf(acc * r * p.in[5][lane]); }
            else { const int c = row & 255; ((bf16_t*)(p.ws + SM_VCT))[((size_t)(row >> 8) * 64 + lane) * 256 + ((c & ~15) | perm16(c & 15))] = f2bf(acc); }
        }
    }
    __syncthreads();
    const float QS = 0.10206207261596577f * LOG2E;
    for (int tile = blockIdx.x; tile < T / 64; tile += gridDim.x) {
        const int b = tile / (S / 64), s0 = (tile % (S / 64)) * 64;
        for (int tt = 0; tt < 8; ++tt) {
            const int sl = wave * 8 + tt, s = s0 + sl; const size_t t = (size_t)b * S + s;
            const int e2 = 64 + (lane & 31), f = lane & 15;
            const float cs = rope[s * 32 + f], sn = rope[s * 32 + 16 + f];
            const float kr = bf2f(krope[t * 32 + (lane & 31)]);
            const int pp = (sl & ~15) | perm16(sl & 15);
#pragma unroll 2
            for (int hh = 0; hh < 8; ++hh) {
                {
                    float a = bf2f(qraw[t * 768 + hh * 96 + lane]), bb = bf2f(qraw[t * 768 + hh * 96 + e2]);
                    const float r = rsqrtf(wsum(a * a + (lane < 32 ? bb * bb : 0.f)) * (1.f / 96.f) + EPS);
                    a = a * r * q_norm[lane]; bb = bb * r * q_norm[e2];
                    const float pb = __shfl_xor(bb, 16);
                    const float ob = ((lane & 31) < 16) ? (bb * cs - pb * sn) : (pb * sn + bb * cs);
                    qm[(t * 8 + hh) * 96 + lane] = f2bf(a * QS); if (lane < 32) qm[(t * 8 + hh) * 96 + e2] = f2bf(ob * QS);
                }
                {
                    float a = bf2f(kvraw[t * 1024 + hh * 128 + lane]), bb = kr;
                    const float r = rsqrtf(wsum(a * a + (lane < 32 ? bb * bb : 0.f)) * (1.f / 96.f) + EPS);
                    a = a * r * k_norm[lane]; bb = bb * r * k_norm[e2];
                    const float pb = __shfl_xor(bb, 16);
                    const float ob = ((lane & 31) < 16) ? (bb * cs - pb * sn) : (pb * sn + bb * cs);
                    const size_t ko = (((size_t)b * 8 + hh) * S + s) * 96;
                    km[ko + lane] = f2bf(a); if (lane < 32) km[ko + e2] = f2bf(ob);
                    vs[(hh * 64 + lane) * 72 + pp] = kvraw[t * 1024 + hh * 128 + 64 + lane];
                }
            }
        }
        __syncthreads();
        {
            const int hh = tid >> 6, d = tid & 63;
            bf16_t* dst = vmt + (((size_t)b * 8 + hh) * 64 + d) * S + s0;
            const LAS bf16_t* src = vs + tid * 72;
#pragma unroll
            for (int c = 0; c < 8; ++c) *(u32x4*)(dst + c * 8) = *(const LAS u32x4*)(src + c * 8);
        }
        __syncthreads();
    }
}

__device__ const unsigned short UNIT_TYPES[256] = {63,127,62,126,61,125,527,591,655,719,783,847,911,975,60,124,59,123,58,122,57,121,56,120,526,590,654,718,782,846,910,974,55,119,54,118,53,117,52,116,51,115,525,589,653,717,781,845,909,973,50,114,49,113,48,112,47,111,524,588,652,716,780,844,908,972,46,110,45,109,44,108,43,107,523,587,651,715,779,843,907,971,42,106,41,105,40,104,39,103,38,102,522,586,650,714,778,842,906,970,37,101,36,100,35,99,34,98,33,97,521,585,649,713,777,841,905,969,32,96,31,95,30,94,520,584,648,712,776,840,904,968,29,93,28,92,27,91,26,90,25,89,519,583,647,711,775,839,903,967,24,88,23,87,22,86,21,85,20,84,518,582,646,710,774,838,902,966,19,83,18,82,17,81,16,80,15,79,517,581,645,709,773,837,901,965,14,78,13,77,12,76,516,580,644,708,772,836,900,964,11,75,10,74,9,73,8,72,515,579,643,707,771,835,899,963,7,71,6,70,5,69,514,578,642,706,770,834,898,962,4,68,3,67,513,577,641,705,769,833,897,961,2,66,1,65,0,64,512,576,640,704,768,832,896,960};
__device__ __forceinline__ int crow(int r, int hi) { return (r & 3) + 8 * (r >> 2) + 4 * hi; }
struct Flash { f32x16 o0, o1; float m, l; };
__device__ __forceinline__ void flash_init(Flash& st) {
#pragma unroll
    for (int r = 0; r < 16; ++r) { st.o0[r] = 0.f; st.o1[r] = 0.f; }
    st.m = -1e30f; st.l = 0.f;
}
constexpr int AL_KB = 0, AL_KBSZ = 64 * 208, AL_VB = 2 * AL_KBSZ, AL_VBSZ = 64 * 144, AL_IMP = AL_VB + 2 * AL_VBSZ, AL_SELB = AL_IMP + 64 * 65 * 4, AL_UNI = AL_SELB + 512, AL_BL = AL_UNI + 64, AL_OT = AL_BL + 4 * 132 * 4, AL_END = AL_OT + 8 * 32 * 64 * 4;

template <int DK, int KP> __device__ __forceinline__ void qk_tile(f32x16& p0, f32x16& p1, const LAS unsigned char* Kt, const bf16x8* qf, int r32, int hi) {
#pragma unroll
    for (int r = 0; r < 16; ++r) { p0[r] = 0.f; p1[r] = 0.f; }
#pragma unroll
    for (int s = 0; s < DK / 16; ++s) {
        const bf16x8 a0 = *(const LAS bf16x8*)(Kt + r32 * KP + (16 * s + 8 * hi) * 2);
        const bf16x8 a1 = *(const LAS bf16x8*)(Kt + (32 + r32) * KP + (16 * s + 8 * hi) * 2);
        p0 = __builtin_amdgcn_mfma_f32_32x32x16_bf16(a0, qf[s], p0, 0, 0, 0);
        p1 = __builtin_amdgcn_mfma_f32_32x32x16_bf16(a1, qf[s], p1, 0, 0, 0);
    }
}
template <class F> __device__ __forceinline__ void softmax_pv(Flash& st, f32x16& p0, f32x16& p1, const LAS unsigned char* Vt, int r32, int hi, F f) {
    float mx = -1e30f;
#pragma unroll
    for (int r = 0; r < 16; ++r) {
        bool v0, v1; float b0, b1; f(r, 0, v0, b0); f(r, 1, v1, b1);
        p0[r] = v0 ? p0[r] + b0 : -INFINITY; p1[r] = v1 ? p1[r] + b1 : -INFINITY;
        mx = fmaxf(mx, fmaxf(p0[r], p1[r]));
    }
    mx = fmaxf(mx, __shfl_xor(mx, 32));
    const float mnew = fmaxf(st.m, mx);
    if (__any(mnew > st.m)) {
        const float fsc = fexp2(st.m - mnew);
        st.l *= fsc;
#pragma unroll
        for (int r = 0; r < 16; ++r) { const float fr_ = __shfl(fsc, crow(r, hi)); st.o0[r] *= fr_; st.o1[r] *= fr_; }
        st.m = mnew;
    }
    float ls = 0.f;
#pragma unroll
    for (int r = 0; r < 16; ++r) { p0[r] = fexp2(p0[r] - st.m); p1[r] = fexp2(p1[r] - st.m); ls += p0[r] + p1[r]; }
    st.l += ls;
    int voff = r32 * 144 + 16 * hi;
    asm volatile("" : "+v"(voff) : "v"(ls));
#pragma unroll
    for (int s = 0; s < 4; ++s) {
        u32x4 w;
        if (s < 2) { w.x = cvtpk(p0[8 * s + 0], p0[8 * s + 1]); w.y = cvtpk(p0[8 * s + 2], p0[8 * s + 3]); w.z = cvtpk(p0[8 * s + 4], p0[8 * s + 5]); w.w = cvtpk(p0[8 * s + 6], p0[8 * s + 7]); }
        else { const int q = s - 2; w.x = cvtpk(p1[8 * q + 0], p1[8 * q + 1]); w.y = cvtpk(p1[8 * q + 2], p1[8 * q + 3]); w.z = cvtpk(p1[8 * q + 4], p1[8 * q + 5]); w.w = cvtpk(p1[8 * q + 6], p1[8 * q + 7]); }
        const bf16x8 pa = __builtin_bit_cast(bf16x8, w);
        const bf16x8 vb0 = *(const LAS bf16x8*)(Vt + voff + 32 * s);
        const bf16x8 vb1 = *(const LAS bf16x8*)(Vt + voff + 32 * 144 + 32 * s);
        st.o0 = __builtin_amdgcn_mfma_f32_32x32x16_bf16(pa, vb0, st.o0, 0, 0, 0);
        st.o1 = __builtin_amdgcn_mfma_f32_32x32x16_bf16(pa, vb1, st.o1, 0, 0, 0);
    }
}
template <bool FIRST> __device__ __forceinline__ void flash_accum(LAS float* otl, const Flash& st, float gate, int hi, int lane) {
    const float lt = st.l + __shfl_xor(st.l, 32);
    const float f = lt > 0.f ? gate * frcp(lt) : 0.f;
#pragma unroll
    for (int r = 0; r < 16; ++r) { const float fr_ = __shfl(f, crow(r, hi));
        if (FIRST) { otl[r * 64 + lane] = fr_ * st.o0[r]; otl[(16 + r) * 64 + lane] = fr_ * st.o1[r]; }
        else { otl[r * 64 + lane] += fr_ * st.o0[r]; otl[(16 + r) * 64 + lane] += fr_ * st.o1[r]; } }
}

#ifdef DEBUG_NSA
__device__ __forceinline__ void dbg_store(float* dst  , const Flash& st, int hi, int r32, size_t rowbase  , int h) {
    const float lt = st.l + __shfl_xor(st.l, 32); const float f = lt > 0.f ? frcp(lt) : 0.f;
#pragma unroll
    for (int r = 0; r < 16; ++r) { const float fr_ = __shfl(f, crow(r, hi)); const size_t o = ((rowbase + crow(r, hi)) * 8 + h) * 64 + r32; dst[o] = st.o0[r] * fr_; dst[o + 32] = st.o1[r] * fr_; }
}
#define DBG_STORE(k) dbg_store((float*)(p.ws + R_H) + (size_t)(k) * T * 512, st, hi, r32, (size_t)b * S + q0 + 32 * qh, h)
#else
#define DBG_STORE(k)
#endif
template <int RB> struct TileRegs { u32x4 a, b; };
template <int RB> __device__ __forceinline__ void tile_load(TileRegs<RB>& R, const unsigned char* g, size_t gs, int tid) {
    constexpr int CPR = RB / 16;
    asm volatile("" : "+v"(tid));
    { const int row = tid / CPR, c = tid % CPR; R.a = *(const u32x4*)(g + (size_t)row * gs + c * 16); }
    if (RB == 192) { const int id = tid + 512; if (id < 768) { const int row = id / CPR, c = id % CPR; R.b = *(const u32x4*)(g + (size_t)row * gs + c * 16); } }
}
template <int RB, int P> __device__ __forceinline__ void tile_store(const TileRegs<RB>& R, LAS unsigned char* l, int tid) {
    constexpr int CPR = RB / 16;
    asm volatile("" : "+v"(tid));
    { const int row = tid / CPR, c = tid % CPR; *(LAS u32x4*)(l + row * P + c * 16) = R.a; }
    if (RB == 192) { const int id = tid + 512; if (id < 768) { const int row = id / CPR, c = id % CPR; *(LAS u32x4*)(l + row * P + c * 16) = R.b; } }
}

__device__ __forceinline__ void mla_unit(const Params& p, LAS unsigned char* lds, int b, int h, int qb) {
    int tid = threadIdx.x; asm volatile("" : "+v"(tid));
    const int lane = tid & 63, w = __builtin_amdgcn_readfirstlane(tid >> 6), r32 = lane & 31, hi = lane >> 5;
    const bf16_t* qm = (const bf16_t*)((const unsigned char*)p.out + O_QM);
    const unsigned char* km = (const unsigned char*)p.out + O_KM + (((size_t)b * 8 + h) * S) * 192;
    const unsigned char* vmt = (const unsigned char*)p.out + O_VMT + (((size_t)b * 8 + h) * 64) * (size_t)S * 2;
    bf16_t* ocat = (bf16_t*)(p.ws + R_XN);
    const int tq = qb * 256 + 32 * w + r32;
    bf16x8 qf[6];
#pragma unroll
    for (int s = 0; s < 6; ++s) qf[s] = *(const bf16x8*)(qm + (((size_t)b * S + tq) * 8 + h) * 96 + 16 * s + 8 * hi);
    Flash st; flash_init(st);
    const int ntile = 4 * qb + 4, dt = 4 * qb + (w >> 1);
    TileRegs<192> kr; TileRegs<128> vr;
    tile_load<192>(kr, km, 192, tid); tile_load<128>(vr, vmt, (size_t)S * 2, tid);
    for (int i = 0; i < ntile; ++i) {
        LAS unsigned char* kb = lds + AL_KB + (i & 1) * AL_KBSZ; LAS unsigned char* vb = lds + AL_VB + (i & 1) * AL_VBSZ;
        tile_store<192, 208>(kr, kb, tid); tile_store<128, 144>(vr, vb, tid);
        __syncthreads();
        if (i + 1 < ntile) { tile_load<192>(kr, km + (size_t)(i + 1) * 64 * 192, 192, tid); tile_load<128>(vr, vmt + (size_t)(i + 1) * 128, (size_t)S * 2, tid); }
        if (i <= dt) {
            f32x16 p0, p1; qk_tile<96, 208>(p0, p1, kb, qf, r32, hi);
            if (i < dt) softmax_pv(st, p0, p1, vb, r32, hi, [&](int r, int half, bool& v, float& bs) { v = true; bs = 0.f; });
            else { const int kb0 = 64 * i + 4 * hi; softmax_pv(st, p0, p1, vb, r32, hi, [&](int r, int half, bool& v, float& bs) { v = (kb0 + 32 * half + (r & 3) + 8 * (r >> 2)) <= tq; bs = 0.f; }); }
        }
    }
    {
        const float lt = st.l + __shfl_xor(st.l, 32); const float f = lt > 0.f ? frcp(lt) : 0.f;
#pragma unroll
        for (int r = 0; r < 16; ++r) { const float fr_ = __shfl(f, crow(r, hi)); const size_t ro = ((size_t)b * S + qb * 256 + 32 * w + crow(r, hi)) * 1024 + 512 + h * 64 + r32; ocat[ro] = f2bf(st.o0[r] * fr_); ocat[ro + 32] = f2bf(st.o1[r] * fr_); }
    }
    __syncthreads();
}

__device__ __forceinline__ void nsa_unit(const Params& p, LAS unsigned char* lds, int b, int g, int jt) {
    int tid = threadIdx.x; asm volatile("" : "+v"(tid));
    const int lane = tid & 63, w = __builtin_amdgcn_readfirstlane(tid >> 6), r32 = lane & 31, hi = lane >> 5;
    const int rh = w >> 1, qh = w & 1, h = 4 * g + rh, q0 = 64 * jt, ql = 32 * qh + r32, tq = q0 + ql;
    const unsigned char* xa = p.ws + R_XA;
    const bf16_t* qn = (const bf16_t*)(xa + A_QN);
    const size_t bg = (size_t)b * 2 + g;
    const unsigned char* ksn = xa + A_KSN + bg * S * 128; const unsigned char* kwn = xa + A_KWN + bg * S * 128;
    const unsigned char* vst = xa + A_VST + bg * 64 * (size_t)S * 2; const unsigned char* vwt = xa + A_VWT + bg * 64 * (size_t)S * 2;
    const unsigned char* kc = p.ws + SM_KC + bg * 256 * 128; const unsigned char* vct = p.ws + SM_VCT + bg * 64 * 512;
    const float* gates = (const float*)(xa + A_GATES) + ((size_t)b * S + tq) * 24 + h * 3;
    bf16_t* ocat = (bf16_t*)(p.ws + R_XN);
    LAS float* imp = (LAS float*)(lds + AL_IMP); LAS unsigned char* selb = lds + AL_SELB; LAS unsigned* uni = (LAS unsigned*)(lds + AL_UNI); LAS float* bls = (LAS float*)(lds + AL_BL);
    for (int i = tid; i < 4 * 132; i += 512) bls[i] = ((const float*)(p.ws + SM_BL))[(4 * g) * 132 + i];
    const LAS float* blh = bls + rh * 132;
    bf16x8 qf[4];
#pragma unroll
    for (int s = 0; s < 4; ++s) qf[s] = *(const bf16x8*)(qn + (((size_t)b * S + tq) * 8 + h) * 64 + 16 * s + 8 * hi);
    float g0 = gates[0], g1 = gates[1], g2 = gates[2];
    if (p.dbg_branch >= 0) { g0 = p.dbg_branch == 0 ? 1.f : 0.f; g1 = p.dbg_branch == 1 ? 1.f : 0.f; g2 = p.dbg_branch == 2 ? 1.f : 0.f; }
    LAS float* otl = (LAS float*)(lds + AL_OT) + w * 2048;
    TileRegs<128> kr, vr;
    const int nvmax = (q0 + 63 - 31) / 16 + 1, ntc = (nvmax + 63) / 64;
    Flash st; flash_init(st);
    tile_load<128>(kr, kc, 128, tid); tile_load<128>(vr, vct, 512, tid);
    for (int i = 0; i < ntc; ++i) {
        LAS unsigned char* kb = lds + AL_KB + (i & 1) * AL_KBSZ; LAS unsigned char* vb = lds + AL_VB + (i & 1) * AL_VBSZ;
        tile_store<128, 144>(kr, kb, tid); tile_store<128, 144>(vr, vb, tid);
        __syncthreads();
        if (i + 1 < ntc) { tile_load<128>(kr, kc + (size_t)(i + 1) * 64 * 128, 128, tid); tile_load<128>(vr, vct + (size_t)(i + 1) * 128, 512, tid); }
        f32x16 p0, p1; qk_tile<64, 144>(p0, p1, kb, qf, r32, hi);
        const int cb = 64 * i + 4 * hi;
        softmax_pv(st, p0, p1, vb, r32, hi, [&](int r, int half, bool& v, float& bs) {
            const int c = cb + 32 * half + (r & 3) + 8 * (r >> 2); const int dist = tq - 16 * c - 31; v = dist >= 0; bs = blh[dist < 0 ? 0 : (dist > 128 ? 128 : dist)]; });
    }
    flash_accum<true>(otl, st, g0, hi, lane);
    __syncthreads();
    unsigned mlo, mhi;
    unsigned ulo, uhi;
    if (jt < 16) { const unsigned long long mk = (jt == 63) ? ~0ull : ((1ull << (jt + 1)) - 1ull); mlo = (unsigned)mk; mhi = (unsigned)(mk >> 32); ulo = mlo; uhi = mhi; }
    else {
        for (int i = tid; i < 64 * 65; i += 512) imp[i] = 0.f;
        const float mfin = st.m; const float lt = st.l + __shfl_xor(st.l, 32); const float linv = lt > 0.f ? frcp(lt) : 0.f;
        float xlast = 0.f;
        tile_load<128>(kr, kc, 128, tid);
        for (int i = 0; i < ntc; ++i) {
            LAS unsigned char* kb = lds + AL_KB + (i & 1) * AL_KBSZ;
            tile_store<128, 144>(kr, kb, tid);
            __syncthreads();
            if (i + 1 < ntc) tile_load<128>(kr, kc + (size_t)(i + 1) * 64 * 128, 128, tid);
            f32x16 p0, p1; qk_tile<64, 144>(p0, p1, kb, qf, r32, hi);
            const int cb = 64 * i + 4 * hi;
            float sm[2][4], cr[2][4];
#pragma unroll
            for (int half = 0; half < 2; ++half)
#pragma unroll
                for (int a = 0; a < 4; ++a) {
                    float s4 = 0.f, last = 0.f;
#pragma unroll
                    for (int k = 0; k < 4; ++k) {
                        const int r = 4 * a + k; const int c = cb + 32 * half + k + 8 * a; const int dist = tq - 16 * c - 31;
                        const float sc = (half ? p1[r] : p0[r]) + blh[dist < 0 ? 0 : (dist > 128 ? 128 : dist)];
                        const float pv = dist >= 0 ? fexp2(sc - mfin) * linv : 0.f;
                        s4 += pv; last = pv;
                    }
                    sm[half][a] = s4; cr[half][a] = last;
                }
            float tot[2][4];
#pragma unroll
            for (int half = 0; half < 2; ++half)
#pragma unroll
                for (int a = 0; a < 4; ++a) {
                    const float xs_ = __shfl_xor(cr[half][a], 32);
                    const float xp_ = (a > 0) ? __shfl_xor(cr[half][a > 0 ? a - 1 : 0], 32) : (half ? __shfl_xor(cr[0][3], 32) : xlast);
                    tot[half][a] = sm[half][a] + (hi ? xs_ : xp_);
                }
            xlast = __shfl_xor(cr[1][3], 32);
            for (int rr = 0; rr < 4; ++rr) {
                if (rh == rr) {
#pragma unroll
                    for (int half = 0; half < 2; ++half)
#pragma unroll
                        for (int a = 0; a < 4; ++a) { const int j = 16 * i + 8 * half + 2 * a + hi; imp[ql * 65 + j] += tot[half][a]; }
                }
                __syncthreads();
            }
        }
        if (p.dbg_branch == 1) { for (int i = tid; i < 4096; i += 512) ((float*)(p.ws + R_H))[((size_t)g * S + q0 + (i >> 6)) * 64 + (i & 63)] = imp[(i >> 6) * 65 + (i & 63)]; }
        {
            const int q = tid >> 3, jg = tid & 7;
            unsigned byte = 0;
#pragma unroll 1
            for (int jj = 0; jj < 8; ++jj) {
                const int j = jg * 8 + jj;
                if (j <= jt) {
                    const float x = imp[q * 65 + j]; const float vj = (j == jt || j == 0) ? 1e9f : x;
                    int rank = 0;
#pragma unroll 8
                    for (int i = 0; i < 64; ++i) { const float xi = imp[q * 65 + i]; const float vi = (i > jt) ? -1.f : ((i == jt || i == 0) ? 1e9f : xi); rank += (vi > vj || (vi == vj && i < j)) ? 1 : 0; }
                    if (rank < 16) byte |= 1u << jj;
                }
            }
            selb[q * 8 + jg] = (unsigned char)byte;
        }
        __syncthreads();
        if (w == 0) {
            unsigned a = ((const LAS unsigned*)selb)[lane * 2], c = ((const LAS unsigned*)selb)[lane * 2 + 1];
#pragma unroll
            for (int o = 1; o < 64; o <<= 1) { a |= __shfl_xor(a, o); c |= __shfl_xor(c, o); }
            if (lane == 0) { uni[0] = a; uni[1] = c; }
        }
        __syncthreads();
        mlo = ((const LAS unsigned*)selb)[ql * 2]; mhi = ((const LAS unsigned*)selb)[ql * 2 + 1];
        ulo = uni[0]; uhi = uni[1];
    }
    if (p.dbg_branch == 1 && rh == 0) { if (hi == 0) ((unsigned long long*)(p.ws + R_H + 4 * 1048576))[(size_t)g * S + tq] = ((unsigned long long)mhi << 32) | mlo; }
    {
        unsigned long long rem = ((unsigned long long)__builtin_amdgcn_readfirstlane(uhi) << 32) | (unsigned)__builtin_amdgcn_readfirstlane(ulo);
        const unsigned long long mymask = ((unsigned long long)mhi << 32) | mlo;
        flash_init(st);
        int j = __builtin_ctzll(rem); rem &= rem - 1;
        tile_load<128>(kr, ksn + (size_t)j * 64 * 128, 128, tid); tile_load<128>(vr, vst + (size_t)j * 128, (size_t)S * 2, tid);
        for (int i = 0;; ++i) {
            LAS unsigned char* kb = lds + AL_KB + (i & 1) * AL_KBSZ; LAS unsigned char* vb = lds + AL_VB + (i & 1) * AL_VBSZ;
            tile_store<128, 144>(kr, kb, tid); tile_store<128, 144>(vr, vb, tid);
            __syncthreads();
            const int jn = rem ? __builtin_ctzll(rem) : -1; rem &= rem - 1;
            if (jn >= 0) { tile_load<128>(kr, ksn + (size_t)jn * 64 * 128, 128, tid); tile_load<128>(vr, vst + (size_t)jn * 128, (size_t)S * 2, tid); }
            f32x16 p0, p1; qk_tile<64, 144>(p0, p1, kb, qf, r32, hi);
            const bool mine = (mymask >> j) & 1ull;
            if (q0 + 32 * qh - (64 * j + 63) >= 128) { const float cbias = blh[128]; softmax_pv(st, p0, p1, vb, r32, hi, [&](int r, int half, bool& v, float& bs) { v = mine; bs = cbias; }); }
            else { const int kb0 = 64 * j + 4 * hi;
                softmax_pv(st, p0, p1, vb, r32, hi, [&](int r, int half, bool& v, float& bs) { const int dist = tq - (kb0 + 32 * half + (r & 3) + 8 * (r >> 2)); v = mine && dist >= 0; bs = blh[dist < 0 ? 0 : (dist > 128 ? 128 : dist)]; }); }
            if (jn < 0) break;
            j = jn;
        }
        flash_accum<false>(otl, st, g1, hi, lane);
        __syncthreads();
    }
    {
        const int j0 = jt >= 8 ? jt - 8 : 0, nw = jt - j0 + 1;
        flash_init(st);
        tile_load<128>(kr, kwn + (size_t)j0 * 64 * 128, 128, tid); tile_load<128>(vr, vwt + (size_t)j0 * 128, (size_t)S * 2, tid);
        for (int i = 0; i < nw; ++i) {
            const int j = j0 + i;
            LAS unsigned char* kb = lds + AL_KB + (i & 1) * AL_KBSZ; LAS unsigned char* vb = lds + AL_VB + (i & 1) * AL_VBSZ;
            tile_store<128, 144>(kr, kb, tid); tile_store<128, 144>(vr, vb, tid);
            __syncthreads();
            if (i + 1 < nw) { tile_load<128>(kr, kwn + (size_t)(j + 1) * 64 * 128, 128, tid); tile_load<128>(vr, vwt + (size_t)(j + 1) * 128, (size_t)S * 2, tid); }
            f32x16 p0, p1; qk_tile<64, 144>(p0, p1, kb, qf, r32, hi);
            const int kb0 = 64 * j + 4 * hi;
            softmax_pv(st, p0, p1, vb, r32, hi, [&](int r, int half, bool& v, float& bs) { const int dist = tq - (kb0 + 32 * half + (r & 3) + 8 * (r >> 2)); v = dist >= 0 && dist < 512; bs = blh[dist < 0 ? 0 : (dist > 128 ? 128 : dist)]; });
        }
        flash_accum<false>(otl, st, g2, hi, lane);
    }
#pragma unroll
    for (int r = 0; r < 16; ++r) { const size_t ro = ((size_t)b * S + q0 + 32 * qh + crow(r, hi)) * 1024 + h * 64 + r32; ocat[ro] = f2bf(otl[r * 64 + lane]); ocat[ro + 32] = f2bf(otl[(16 + r) * 64 + lane]); }
    __syncthreads();
}

__device__ __forceinline__ void phase_p4(const Params& p, LAS unsigned char* lds) {
    const int G = gridDim.x, c = blockIdx.x, nunits = 256 * NB;
    for (int j = 0;; ++j) {
        const int k = j * G + ((j & 1) ? (G - 1 - c) : c);
        if (j * G >= nunits) break;
        if (k >= nunits) continue;
        const int ty = UNIT_TYPES[k / NB], b = k % NB, kind = ty >> 9, a = (ty >> 6) & 7, cc = ty & 63;
#if defined(ATT_ONLY) && ATT_ONLY == 0
        if (kind == 0) nsa_unit(p, lds, b, a, cc);
#elif defined(ATT_ONLY) && ATT_ONLY == 1
        if (kind != 0) mla_unit(p, lds, b, a, cc);
#else
        if (kind == 0) nsa_unit(p, lds, b, a, cc); else mla_unit(p, lds, b, a, cc);
#endif
    }
}
__device__ __forceinline__ void phase_norm(const float* x, const float* g, bf16_t* xn) {
    const int tid_ = ltid(); const int lane = tid_ & 63, gw = blockIdx.x * 8 + (tid_ >> 6), NGW = gridDim.x * 8;
    for (int m = gw; m < T; m += NGW) rms_row_to_bf16(x + (size_t)m * D, g, xn + (size_t)m * D, lane);
}
__device__ __forceinline__ void phase_conv(const Params& p) {
    const int tid_ = ltid(); const int lane = tid_ & 63, gw = blockIdx.x * 8 + (tid_ >> 6), NGW = gridDim.x * 8;
    const bf16_t* hh = (const bf16_t*)(p.ws + R_H); bf16_t* v = (bf16_t*)(p.ws + R_XN); const float* cw = p.in[22];
    for (int m = gw; m < T; m += NGW) {
        const int s = m & (S - 1);
#pragma unroll
        for (int j = 0; j < 4; ++j) {
            const int d = 4 * lane + 256 * j;
            float y[4] = {0.f, 0.f, 0.f, 0.f};
#pragma unroll
            for (int w = 0; w < 3; ++w) {
                if (s - 2 + w >= 0) {
                    const bf16_t* r = hh + (size_t)(m - 2 + w) * 3072;
                    const u32x2 c = *(const u32x2*)(r + 1024 + d), u = *(const u32x2*)(r + 2048 + d); const f32x4 cwv = *(const f32x4*)(cw + w * 1024 + d);
                    y[0] += cwv.x * bflo(c.x) * bflo(u.x); y[1] += cwv.y * bfhi(c.x) * bfhi(u.x); y[2] += cwv.z * bflo(c.y) * bflo(u.y); y[3] += cwv.w * bfhi(c.y) * bfhi(u.y);
                }
            }
            const u32x2 bv = *(const u32x2*)(hh + (size_t)m * 3072 + d);
            u32x2 o; o.x = cvtpk(bflo(bv.x) * y[0], bfhi(bv.x) * y[1]); o.y = cvtpk(bflo(bv.y) * y[2], bfhi(bv.y) * y[3]);
            *(u32x2*)(v + (size_t)m * 1024 + d) = o;
        }
    }
}
__device__ __forceinline__ void phase_norm_router(const Params& p, LAS unsigned char* lds) {
    const int tid = ltid(), lane = tid & 63, wave = tid >> 6, gw = blockIdx.x * 8 + wave, NGW = gridDim.x * 8;
    const float* x3 = p.out; const float* g = p.in[24]; bf16_t* xn = (bf16_t*)(p.ws + R_XN);
    LAS float* wr = (LAS float*)lds;
    LAS int* lcnt = (LAS int*)(lds + 32768); LAS int* gb = lcnt + 8;
    int* te = (int*)(p.ws + SM_TE); float* tw = (float*)(p.ws + SM_TW); int* rank = (int*)(p.ws + SM_RANK); int* cnt = (int*)(p.ws + SM_CTL);
    for (int i = tid; i < 8192; i += 512) wr[i] = p.in[25][i];
    if (tid < 8) lcnt[tid] = 0;
    __syncthreads();
    for (int m = gw; m < T; m += NGW) {
        const f32x4* xr = (const f32x4*)(x3 + (size_t)m * D) + lane; const f32x4* gr = (const f32x4*)g + lane;
        f32x4 v[4]; float s = 0.f;
#pragma unroll
        for (int j = 0; j < 4; ++j) { v[j] = xr[64 * j]; s += (v[j].x * v[j].x + v[j].y * v[j].y) + (v[j].z * v[j].z + v[j].w * v[j].w); }
        const float r = rsqrtf(wsum(s) * (1.f / 1024.f) + EPS);
        float lg[8];
#pragma unroll
        for (int e = 0; e < 8; ++e) lg[e] = 0.f;
        u32x2* o8 = (u32x2*)(xn + (size_t)m * D) + lane;
#pragma unroll
        for (int j = 0; j < 4; ++j) { const f32x4 gg = gr[64 * j]; const f32x4 y = {v[j].x * r * gg.x, v[j].y * r * gg.y, v[j].z * r * gg.z, v[j].w * r * gg.w};
            u32x2 w; w.x = cvtpk(y.x, y.y); w.y = cvtpk(y.z, y.w); o8[64 * j] = w;
#pragma unroll
            for (int i = 0; i < 4; ++i) { const int d = 4 * lane + 256 * j + i; const f32x4 w0 = *(const LAS f32x4*)(wr + d * 8), w1 = *(const LAS f32x4*)(wr + d * 8 + 4);
                lg[0] += y[i] * w0.x; lg[1] += y[i] * w0.y; lg[2] += y[i] * w0.z; lg[3] += y[i] * w0.w; lg[4] += y[i] * w1.x; lg[5] += y[i] * w1.y; lg[6] += y[i] * w1.z; lg[7] += y[i] * w1.w; } }
#pragma unroll
        for (int e = 0; e < 8; ++e) lg[e] = wsum(lg[e]) + p.in[26][e];
        int e1 = 0; float l1 = lg[0];
#pragma unroll
        for (int e = 1; e < 8; ++e) if (lg[e] > l1) { l1 = lg[e]; e1 = e; }
        int e2 = -1; float l2 = -3e38f;
#pragma unroll
        for (int e = 0; e < 8; ++e) if (e != e1 && lg[e] > l2) { l2 = lg[e]; e2 = e; }
        if (lane == 0) {
            const float w1 = 1.f / (1.f + __expf(l2 - l1));
            te[m * 2] = e1; te[m * 2 + 1] = e2; tw[m * 2] = w1; tw[m * 2 + 1] = 1.f - w1;
            rank[m * 2] = __hip_atomic_fetch_add(&lcnt[e1], 1, __ATOMIC_RELAXED, __HIP_MEMORY_SCOPE_WORKGROUP); rank[m * 2 + 1] = __hip_atomic_fetch_add(&lcnt[e2], 1, __ATOMIC_RELAXED, __HIP_MEMORY_SCOPE_WORKGROUP);
        }
    }
    __syncthreads();
    if (tid < 8) gb[tid] = atomicAdd(&cnt[tid], lcnt[tid]);
    __syncthreads();
    for (int m = gw; m < T; m += NGW) if (lane < 2) rank[m * 2 + lane] += gb[te[m * 2 + lane]];
}
__device__ __forceinline__ void phase_moe_gather(const Params& p) {
    const int tid = ltid(), lane = tid & 63, gw = blockIdx.x * 8 + (tid >> 6), NGW = gridDim.x * 8;
    const int* cnt = (const int*)(p.ws + SM_CTL); const int* te = (const int*)(p.ws + SM_TE); const float* tw = (const float*)(p.ws + SM_TW); const int* rank = (const int*)(p.ws + SM_RANK);
    int* pos = (int*)(p.ws + SM_POS); float* roww = (float*)(p.ws + SM_ROWW); int* tile_e = (int*)(p.ws + SM_TILEE);
    const bf16_t* xn = (const bf16_t*)(p.ws + R_XN); bf16_t* xs = (bf16_t*)(p.ws + R_XA);
    int off[9]; off[0] = 0;
#pragma unroll
    for (int e = 0; e < 8; ++e) off[e + 1] = off[e] + ((cnt[e] + 255) & ~255);
    if (blockIdx.x == 0) {
        for (int i = tid; i < ROWS_MAX / 256; i += 512) { int e = -1;
#pragma unroll
            for (int k = 0; k < 8; ++k) if (i * 256 >= off[k] && i * 256 < off[k + 1]) e = k;
            tile_e[i] = e < 0 ? 0 : e; }
        if (tid == 0) ((int*)(p.ws + SM_CTL))[8] = off[8];
    }
    if (blockIdx.x < 8 && tid < 256) {
#pragma unroll
        for (int e = 0; e < 8; ++e) if (e == (int)blockIdx.x) { const int c = cnt[e]; if (c + tid < off[e + 1] - off[e]) roww[off[e] + c + tid] = 0.f; }
    }
    for (int pi = gw; pi < 2 * T; pi += NGW) {
        const int e = te[pi]; int o = 0;
#pragma unroll
        for (int k = 0; k < 8; ++k) if (k == e) o = off[k];
        const int r = o + rank[pi];
        if (lane == 0) { pos[pi] = r; roww[r] = tw[pi]; }
        const u32x4* src = (const u32x4*)(xn + (size_t)(pi >> 1) * D); u32x4* dst = (u32x4*)(xs + (size_t)r * D);
        dst[lane] = src[lane]; dst[64 + lane] = src[64 + lane];
    }
}
__device__ __forceinline__ void phase_moe_combine(const Params& p) {
    const int tid_ = ltid(); const int lane = tid_ & 63, gw = blockIdx.x * 8 + (tid_ >> 6), NGW = gridDim.x * 8;
    const int* pos = (const int*)(p.ws + SM_POS); const bf16_t* ym = (const bf16_t*)(p.ws + R_XA);
    for (int m = gw; m < T; m += NGW) {
        const int p0 = pos[m * 2], p1 = pos[m * 2 + 1];
#pragma unroll
        for (int j = 0; j < 4; ++j) {
            const int d = 4 * lane + 256 * j;
            f32x4* o = (f32x4*)(p.out + (size_t)m * D + d); f32x4 x = *o;
            const u32x2 a = *(const u32x2*)(ym + (size_t)p0 * D + d), c = *(const u32x2*)(ym + (size_t)p1 * D + d);
            x.x += bflo(a.x) + bflo(c.x); x.y += bfhi(a.x) + bfhi(c.x); x.z += bflo(a.y) + bflo(c.y); x.w += bfhi(a.y) + bfhi(c.y);
            *o = x;
        }
    }
}

__global__ void __launch_bounds__(512) mega_fwd(Params p) {
    extern __shared__ __attribute__((aligned(16))) unsigned char lds_raw[];
    LAS unsigned char* lds = (LAS unsigned char*)lds_raw;
    cg::grid_group grid = cg::this_grid();
    const int G = gridDim.x, c = blockIdx.x;
    bf16_t* W = (bf16_t*)p.ws;
    bf16_t* xn = (bf16_t*)(p.ws + R_XN);
    float* x1 = (float*)(p.ws + R_XA);
    pg8::StaticOrder SO;
#ifndef PHMASK
#define PHMASK 0xFFFFFFFFu
#endif
#ifndef REPEAT_MASK
#define REPEAT_MASK 0u
#endif
#define PH(k) if (((PHMASK >> (k)) & 1u) && (k) >= p.ph_lo && (k) <= p.ph_hi)
#define RPT(k) if ((REPEAT_MASK >> (k)) & 1u)
    PH(0) phase_p0(p, lds);
    grid.sync();
    RPT(0) { phase_p0(p, lds); grid.sync(); }
    PH(1) {
        pg8::Gemm g{xn, W + W_IN_E / 2, T, 1792, 1024, 1024, nullptr, 0}; SO.init(T, 1792, G, c);
        pg8::EpiBf16<0> E{(bf16_t*)(p.ws + R_H), 1792, nullptr};
        pg8::gemm_phase<pg8::EpiBf16<0>, true>(lds, g, SO, E);
    }
    grid.sync();
    PH(2) phase_p2(p, lds);
    grid.sync();
    RPT(2) { phase_p2(p, lds); grid.sync(); }
    PH(3) {
        const int nCu = 2 * (NB * 512 / 256), Gc = (nCu < G / 2) ? nCu : 0;
        if (Gc == 0 || c < Gc) {
            for (int kv = 0; kv < 2; ++kv) {
                pg8::Gemm g{(const bf16_t*)(p.ws + R_XA + (kv ? A_VCIN : A_KCIN)), W + W_CW1 / 2 + (size_t)kv * 256 * 2048, NB * 512, 256, 2048, 1024, nullptr, 0};
                if (Gc) SO.init(NB * 512, 256, Gc / 2, c - kv * (Gc / 2)); else SO.init(NB * 512, 256, G, c);
                pg8::EpiBf16<2> E{(bf16_t*)(p.ws + SM_HID) + (size_t)kv * NB * 512 * 256, 256, (const float*)(p.ws + SM_B1) + kv * 256};
                if (Gc == 0 || (c / (Gc / 2)) == kv) pg8::gemm_phase<pg8::EpiBf16<2>, true>(lds, g, SO, E);
            }
        }
        if (Gc == 0 || c >= Gc) {
            {
                pg8::Gemm g{(const bf16_t*)(p.ws + R_XA + A_CQN), W + W_UQ / 2, T, 768, 256, 256, nullptr, 0}; SO.init(T, 768, G - Gc, c - Gc);
                pg8::EpiBf16<0> E{(bf16_t*)(p.ws + R_H), 768, nullptr};
                pg8::gemm_phase<pg8::EpiBf16<0>, true>(lds, g, SO, E);
            }
            {
                pg8::Gemm g{(const bf16_t*)(p.ws + R_XA + A_CKVN), W + W_UKV / 2, T, 1024, 128, 128, nullptr, 0}; SO.init(T, 1024, G - Gc, c - Gc);
                pg8::EpiBf16<0> E{(bf16_t*)(p.ws + R_H + (size_t)T * 1536), 1024, nullptr};
                pg8::gemm_phase<pg8::EpiBf16<0>, true>(lds, g, SO, E);
            }
        }
    }
    grid.sync();
    PH(4) phase_p3b(p, lds);
    grid.sync();
    RPT(4) { phase_p3b(p, lds); grid.sync(); }
    PH(5) phase_p4(p, lds);
    grid.sync();
    RPT(5) { phase_p4(p, lds); grid.sync(); }
    PH(6) {
        pg8::Gemm g{xn, W + W_OUT_E / 2, T, 1024, 1024, 1024, nullptr, 0}; SO.init(T, 1024, G, c);
        pg8::EpiResF32 E{p.in[0], x1, 1024};
        pg8::gemm_phase<pg8::EpiResF32, true>(lds, g, SO, E);
    }
    grid.sync();
    PH(7) phase_norm(x1, p.in[16], xn);
    grid.sync();
    RPT(7) { phase_norm(x1, p.in[16], xn); grid.sync(); }
    PH(8) {
        pg8::Gemm g{xn, W + W_GU / 2, T, 5632, 1024, 1024, nullptr, 0}; SO.init(T, 5632, G, c);
        pg8::EpiSwiGLU E{(bf16_t*)(p.ws + R_H), 2816};
        pg8::gemm_phase<pg8::EpiSwiGLU, true>(lds, g, SO, E);
    }
    grid.sync();
    PH(9) {
        pg8::Gemm g{(const bf16_t*)(p.ws + R_H), W + W_D / 2, T, 1024, 2816, 2816, nullptr, 0}; SO.init(T, 1024, G, c);
        pg8::EpiResF32 E{x1, p.out, 1024};
        pg8::gemm_phase<pg8::EpiResF32, true>(lds, g, SO, E);
    }
    grid.sync();
    PH(10) phase_norm(p.out, p.in[20], xn);
    grid.sync();
    PH(11) {
        pg8::Gemm g{xn, W + W_IN_O / 2, T, 3072, 1024, 1024, nullptr, 0}; SO.init(T, 3072, G, c);
        pg8::EpiBf16<0> E{(bf16_t*)(p.ws + R_H), 3072, nullptr};
        pg8::gemm_phase<pg8::EpiBf16<0>, true>(lds, g, SO, E);
    }
    grid.sync();
    PH(12) phase_conv(p);
    grid.sync();
    RPT(12) { phase_conv(p); grid.sync(); }
    PH(13) {
        pg8::Gemm g{xn, W + W_OUT_O / 2, T, 1024, 1024, 1024, nullptr, 0}; SO.init(T, 1024, G, c);
        pg8::EpiResF32 E{p.out, p.out, 1024};
        pg8::gemm_phase<pg8::EpiResF32, true>(lds, g, SO, E);
    }
    grid.sync();
    PH(14) phase_norm_router(p, lds);
    grid.sync();
    PH(15) phase_moe_gather(p);
    grid.sync();
    const int mrows = ((const int*)(p.ws + SM_CTL))[8];
    PH(16) {
        pg8::Gemm g{(const bf16_t*)(p.ws + R_XA), W + W_MGU / 2, mrows, 2816, 1024, 1024, (const int*)(p.ws + SM_TILEE), (size_t)2816 * 1024}; SO.init(mrows, 2816, G, c);
        pg8::EpiSwiGLU E{(bf16_t*)(p.ws + R_H), 1408};
        pg8::gemm_phase<pg8::EpiSwiGLU, true>(lds, g, SO, E);
    }
    grid.sync();
    PH(17) {
        pg8::Gemm g{(const bf16_t*)(p.ws + R_H), W + W_MD / 2, mrows, 1024, 1408, 1408, (const int*)(p.ws + SM_TILEE), (size_t)1024 * 1408}; SO.init(mrows, 1024, G, c);
        pg8::EpiRowScaleBf16 E{(bf16_t*)(p.ws + R_XA), 1024, (const float*)(p.ws + SM_ROWW)};
        pg8::gemm_phase<pg8::EpiRowScaleBf16, true>(lds, g, SO, E);
    }
    grid.sync();
    PH(18) phase_moe_combine(p);
#undef PH
}

inline void launch(void* const* d_in, float* d_out, void* d_ws, size_t ws_size, hipStream_t stream, int ph_lo = 0, int ph_hi = 99, int dbg_branch = -1) {
    static int grid = 0;
    if (grid == 0) {
        int dev = 0, cus = 0, per_cu = 0;
        hipGetDevice(&dev); hipDeviceGetAttribute(&cus, hipDeviceAttributeMultiprocessorCount, dev);
        hipFuncSetAttribute((const void*)mega_fwd, hipFuncAttributeMaxDynamicSharedMemorySize, LDS_BYTES);
        hipOccupancyMaxActiveBlocksPerMultiprocessor(&per_cu, (const void*)mega_fwd, 512, LDS_BYTES);
        if (per_cu < 1) { fprintf(stderr, "occupancy query says %d blocks/CU\n", per_cu); per_cu = 1; }
        grid = cus;
        if (WS_FAST_END > ws_size) { fprintf(stderr, "ws too small: need %zu have %zu\n", (size_t)WS_FAST_END, ws_size); grid = -1; }
    }
    if (grid < 0) return;
    if (ph_lo <= 14 && ph_hi >= 14) hipMemsetAsync((char*)d_ws + SM_CTL, 0, 4096, stream);
    Params p{};
    for (int i = 0; i < 30; ++i) p.in[i] = (const float*)d_in[i];
    p.out = d_out; p.ws = (unsigned char*)d_ws; p.ph_lo = ph_lo; p.ph_hi = ph_hi; p.dbg_branch = dbg_branch;
    void* args[] = {&p};
    hipError_t e = hipLaunchCooperativeKernel((const void*)mega_fwd, dim3(grid), dim3(512), args, LDS_BYTES, stream);
    if (e != hipSuccess) fprintf(stderr, "cooperative launch failed: %s (grid %d)\n", hipGetErrorString(e), grid);
}
}
extern "C" void kernel_launch(void* const* d_in, const int* in_sizes, int n_in, void* d_out, int out_size, void* d_ws, size_t ws_size, hipStream_t stream) {
    fast::launch(d_in, (float*)d_out, d_ws, ws_size, stream);
}
```

```cpp
#include <hip/hip_runtime.h>
#include <hip/hip_bf16.h>
#include <stdint.h>
#include <stdio.h>
#include <string.h>
#include <hip/hip_cooperative_groups.h>
namespace cg = cooperative_groups;
#define NB 8
#define REPEAT_MASK 0x0u
namespace gold {
constexpr int S = 4096, D = 1024, HW = 1720;
constexpr float EPS = 1e-6f;

__device__ const unsigned char T5B[128] = {0, 1, 2, 3, 4, 5, 6, 7, 8, 9, 10, 11, 12, 13, 14, 15, 16, 16, 16, 17, 17, 18, 18, 18, 19, 19, 19, 20, 20, 20, 20, 21, 21, 21, 21, 22, 22, 22, 22, 22, 23, 23, 23, 23, 23, 23, 24, 24, 24, 24, 24, 24, 25, 25, 25, 25, 25, 25, 25, 26, 26, 26, 26, 26, 26, 26, 26, 27, 27, 27, 27, 27, 27, 27, 27, 27, 27, 28, 28, 28, 28, 28, 28, 28, 28, 28, 28, 29, 29, 29, 29, 29, 29, 29, 29, 29, 29, 29, 29, 30, 30, 30, 30, 30, 30, 30, 30, 30, 30, 30, 30, 30, 30, 31, 31, 31, 31, 31, 31, 31, 31, 31, 31, 31, 31, 31, 31};
}
#ifndef NB
#define NB 8
#endif
namespace fast {
#define LAS __attribute__((address_space(3)))
typedef unsigned short bf16_t;
typedef short bf16x8 __attribute__((ext_vector_type(8)));
typedef float f32x4 __attribute__((ext_vector_type(4)));
typedef float f32x2 __attribute__((ext_vector_type(2)));
typedef float f32x16 __attribute__((ext_vector_type(16)));
typedef unsigned u32x4 __attribute__((ext_vector_type(4)));
typedef unsigned u32x2 __attribute__((ext_vector_type(2)));
typedef __bf16 bf16x2_t __attribute__((ext_vector_type(2)));

constexpr int S = 4096, T = NB * S, D = 1024;
constexpr float EPS = 1e-6f, LOG2E = 1.4426950408889634f;

__device__ __forceinline__ unsigned cvtpk(float lo, float hi) { f32x2 v = {lo, hi}; bf16x2_t b = __builtin_convertvector(v, bf16x2_t); return __builtin_bit_cast(unsigned, b); }
__device__ __forceinline__ bf16_t f2bf(float f) { return (bf16_t)(cvtpk(f, 0.f) & 0xffffu); }
__device__ __forceinline__ float bf2f(bf16_t u) { return __builtin_bit_cast(float, (unsigned)u << 16); }
__device__ __forceinline__ float bflo(unsigned u) { return __builtin_bit_cast(float, u << 16); }
__device__ __forceinline__ float bfhi(unsigned u) { return __builtin_bit_cast(float, u & 0xffff0000u); }
__device__ __forceinline__ float wsum(float v) {
#pragma unroll
    for (int o = 1; o < 64; o <<= 1) v += __shfl_xor(v, o);
    return v;
}
__device__ __forceinline__ float fexp2(float x) { return __builtin_amdgcn_exp2f(x); }
__device__ __forceinline__ float frcp(float x) { return __builtin_amdgcn_rcpf(x); }
__device__ __forceinline__ float silu_f(float x) { return x * frcp(1.f + fexp2(-x * LOG2E)); }
__device__ __forceinline__ float gelu_tanh_f(float x) {
    const float u = 0.7978845608028654f * (x + 0.044715f * x * x * x);
    return x * frcp(1.f + fexp2(-2.f * LOG2E * u));
}

namespace pg8 {
constexpr int BM = 256, BK = 64, HALF = 128, HTB = HALF * BK * 2, STAGE_BYTES = 8 * HTB, NXCD = 8, WGM = 8;
__host__ __device__ __forceinline__ int lds_byte(int r, int c) { const int st = (r >> 4) * 2 + (c >> 5), rr = r & 15, cc = c & 31, ob = rr * 64 + cc * 2; return st * 1024 + (ob ^ (((ob >> 9) & 1) << 5)); }
__host__ __device__ __forceinline__ void stage_rc(int b, int& R, int& C) { const int st = b / 1024, sb = b % 1024, swz = sb ^ (((sb >> 9) & 1) << 5); R = (st >> 1) * 16 + swz / 64; C = (st & 1) * 32 + (swz % 64) / 2; }
__host__ __device__ __forceinline__ int perm32(int rho) { const int n = rho >> 4, i = rho & 15; return 8 * (i >> 2) + 4 * n + (i & 3); }

struct Unit { int pm, pn; };
struct Gemm { const bf16_t* A; const bf16_t* Bt; int M, N, K, lda; const int* tile_e; size_t estride; };

struct StaticOrder {
    int nM, nN, nwg, G, c;
    __device__ void init(int M, int N, int G_, int c_) { nM = M / BM; nN = N / BM; nwg = nM * nN; G = G_; c = c_; }
    __device__ bool next(int i, Unit& u) const {
        const long L = (long)i * G + c; if (L >= nwg) return false;
        int wgid = (int)L; { const int q = nwg / NXCD, r = nwg % NXCD, xcd = wgid % NXCD, off = wgid / NXCD; wgid = (xcd < r ? xcd * (q + 1) : r * (q + 1) + (xcd - r) * q) + off; }
        const int nig = WGM * nN, gid = wgid / nig, fm = gid * WGM, gsz = (nM - fm) < WGM ? (nM - fm) : WGM;
        u.pm = fm + ((wgid % nig) % gsz); u.pn = (wgid % nig) / gsz; return true;
    }
};

template <class Epi, bool ALIGN_EPI>
__device__ __forceinline__ void gemm_phase(LAS unsigned char* lds, const Gemm g, const StaticOrder& S, const Epi& E) {
    int tid = threadIdx.x; asm volatile("" : "+v"(tid));
    const int wid = __builtin_amdgcn_readfirstlane(tid >> 6), lane = tid & 63, wr = wid >> 2, wc = wid & 3, fr = lane & 15, fq = lane >> 4;
    const int K = g.K, nt = K / BK, lda = g.lda;
    unsigned voffA[2], voffB[2];
#pragma unroll
    for (int i = 0; i < 2; ++i) { int R, C; stage_rc(tid * 16 + i * 8192, R, C); const int Rb = Epi::PERM ? ((R & ~31) + perm32(R & 31)) : R;
        voffA[i] = (unsigned)(R * lda + C) * 2u; voffB[i] = (unsigned)(Rb * K + C) * 2u; }
    const size_t kstep = (size_t)(BK * 2);
    const size_t hsA = (size_t)HALF * lda * 2, tsA = 2 * hsA, hsB = (size_t)HALF * K * 2, tsB = 2 * hsB;
    const unsigned ldsw = (unsigned)wid * 1024u;
    const int aoff = lds_byte(wr * 64 + fr, fq * 8), boff = lds_byte(wc * 32 + fr, fq * 8);
#define PG8_SA(b, h) (((b) * 2 + (h)) * HTB)
#define PG8_SB(b, h) ((4 + (b) * 2 + (h)) * HTB)
#define PG8_STAGE(bufoff, gbase, voff) do { _Pragma("unroll") for (int _i = 0; _i < 2; ++_i) \
        __builtin_amdgcn_global_load_lds((const unsigned*)((const char*)(gbase) + (voff)[_i]), (LAS unsigned*)(lds + (bufoff) + ldsw + _i * 8192), 16, 0, 0); } while (0)
#define PG8_LDA(dst, b, h) do { _Pragma("unroll") for (int m = 0; m < 4; ++m) _Pragma("unroll") for (int k = 0; k < 2; ++k) dst[m][k] = *(const LAS bf16x8*)(lds + PG8_SA(b, h) + aoff + m * 2048 + k * 1024); } while (0)
#define PG8_LDB(dst, b, h) do { _Pragma("unroll") for (int n = 0; n < 2; ++n) _Pragma("unroll") for (int k = 0; k < 2; ++k) dst[n][k] = *(const LAS bf16x8*)(lds + PG8_SB(b, h) + boff + n * 2048 + k * 1024); } while (0)
#define PG8_MMA(ai, bj, At, Bt) do { __builtin_amdgcn_s_setprio(1); _Pragma("unroll") for (int m = 0; m < 4; ++m) _Pragma("unroll") for (int n = 0; n < 2; ++n) _Pragma("unroll") for (int k = 0; k < 2; ++k) \
        acc[ai][bj][m][n] = __builtin_amdgcn_mfma_f32_16x16x32_bf16(Bt[n][k], At[m][k], acc[ai][bj][m][n], 0, 0, 0); __builtin_amdgcn_s_setprio(0); } while (0)
#define PG8_WAIT_V(n) asm volatile("s_waitcnt vmcnt(" #n ")" ::: "memory")
#define PG8_WAIT_L(n) asm volatile("s_waitcnt lgkmcnt(" #n ")" ::: "memory")
#define PG8_BAR __builtin_amdgcn_s_barrier()
#define PG8_SCHED __builtin_amdgcn_sched_barrier(0)
#define PG8_EOFF(pm_) (g.tile_e ? (size_t)g.tile_e[pm_] * g.estride * 2 : (size_t)0)
    Unit cur, nxt; int ui = 0;
    if (!S.next(0, cur)) return;
    f32x4 acc[2][2][4][2];
#pragma unroll
    for (int a = 0; a < 2; ++a)
#pragma unroll
        for (int b = 0; b < 2; ++b)
#pragma unroll
            for (int m = 0; m < 4; ++m)
#pragma unroll
                for (int n = 0; n < 2; ++n) acc[a][b][m][n] = (f32x4){0.f, 0.f, 0.f, 0.f};
    bf16x8 At[4][2], B0[2][2], B1[2][2];
    const char* cA = (const char*)g.A + (size_t)cur.pm * tsA; const char* cB = (const char*)g.Bt + PG8_EOFF(cur.pm) + (size_t)cur.pn * tsB;
    PG8_STAGE(PG8_SB(0, 0), cB, voffB); PG8_STAGE(PG8_SB(0, 1), cB + hsB, voffB); PG8_STAGE(PG8_SA(0, 0), cA, voffA); PG8_STAGE(PG8_SA(0, 1), cA + hsA, voffA);
    if (wr == 1) PG8_BAR;
    PG8_WAIT_V(2); PG8_BAR;
    PG8_STAGE(PG8_SB(1, 0), cB + kstep, voffB); PG8_STAGE(PG8_SA(1, 0), cA + kstep, voffA); PG8_STAGE(PG8_SB(1, 1), cB + hsB + kstep, voffB);
    PG8_WAIT_V(6); PG8_BAR;
    for (;;) {
        const bool has_next = S.next(ui + 1, nxt);
        const char* nA = has_next ? (const char*)g.A + (size_t)nxt.pm * tsA : cA;
        const char* nB = has_next ? (const char*)g.Bt + PG8_EOFF(nxt.pm) + (size_t)nxt.pn * tsB : cB;
        for (int t = 0; t < nt; t += 2) {
            const bool last = (t == nt - 2);
            const char* a1 = cA + (size_t)(t + 1) * kstep;
            const char* a2 = last ? nA : cA + (size_t)(t + 2) * kstep; const char* b2 = last ? nB : cB + (size_t)(t + 2) * kstep;
            const char* a3 = a2 + kstep; const char* b3 = b2 + kstep;
            PG8_LDB(B0, 0, 0); PG8_LDB(B1, 0, 1); PG8_SCHED; PG8_LDA(At, 0, 0); PG8_STAGE(PG8_SA(1, 1), a1 + hsA, voffA);
            PG8_WAIT_V(8); PG8_WAIT_L(0); PG8_BAR; PG8_MMA(0, 0, At, B0); PG8_MMA(0, 1, At, B1); PG8_BAR; PG8_SCHED;
            PG8_LDA(At, 0, 1); PG8_STAGE(PG8_SB(0, 0), b2, voffB); PG8_STAGE(PG8_SB(0, 1), b2 + hsB, voffB); PG8_STAGE(PG8_SA(0, 0), a2, voffA);
            PG8_WAIT_V(8); PG8_WAIT_L(0); PG8_BAR; PG8_MMA(1, 0, At, B0); PG8_MMA(1, 1, At, B1); PG8_BAR; PG8_SCHED;
            PG8_LDB(B0, 1, 0); PG8_LDB(B1, 1, 1); PG8_SCHED; PG8_LDA(At, 1, 0); PG8_STAGE(PG8_SA(0, 1), a2 + hsA, voffA);
            PG8_WAIT_V(8); PG8_WAIT_L(0); PG8_BAR; PG8_MMA(0, 0, At, B0); PG8_MMA(0, 1, At, B1); PG8_BAR; PG8_SCHED;
            PG8_LDA(At, 1, 1); PG8_STAGE(PG8_SB(1, 0), b3, voffB); PG8_STAGE(PG8_SB(1, 1), b3 + hsB, voffB); PG8_STAGE(PG8_SA(1, 0), a3, voffA);
            PG8_WAIT_V(8); PG8_WAIT_L(0); PG8_BAR; PG8_MMA(1, 0, At, B0); PG8_MMA(1, 1, At, B1); PG8_BAR; PG8_SCHED;
        }
        if constexpr (ALIGN_EPI) { if (wr == 0) PG8_BAR; }
        E(acc, cur, wr, wc, fr, fq);
        if (!has_next) break;
#pragma unroll
        for (int a = 0; a < 2; ++a)
#pragma unroll
            for (int b = 0; b < 2; ++b)
#pragma unroll
                for (int m = 0; m < 4; ++m)
#pragma unroll
                    for (int n = 0; n < 2; ++n) acc[a][b][m][n] = (f32x4){0.f, 0.f, 0.f, 0.f};
        cur = nxt; cA = nA; cB = nB; ++ui;
        if constexpr (ALIGN_EPI) { if (wr == 1) PG8_BAR; }
    }
    PG8_WAIT_V(0);
    if constexpr (!ALIGN_EPI) { if (wr == 0) PG8_BAR; }
    PG8_BAR;
#undef PG8_SA
#undef PG8_SB
#undef PG8_STAGE
#undef PG8_LDA
#undef PG8_LDB
#undef PG8_MMA
#undef PG8_WAIT_V
#undef PG8_WAIT_L
#undef PG8_BAR
#undef PG8_SCHED
#undef PG8_EOFF
}

template <int ACT> struct EpiBf16 {
    static constexpr bool PERM = true;
    bf16_t* O; int ldc; const float* bias;
    __device__ __forceinline__ void operator()(const f32x4 (&acc)[2][2][4][2], const Unit& u, int wr, int wc, int fr, int fq) const {
        const int row0 = u.pm * BM + wr * 64 + fr, col0 = u.pn * BM + wc * 32 + 8 * fq;
        f32x4 bv[2][2];
#pragma unroll
        for (int bj = 0; bj < 2; ++bj)
#pragma unroll
            for (int n = 0; n < 2; ++n) bv[bj][n] = bias ? *(const f32x4*)(bias + col0 + bj * HALF + 4 * n) : (f32x4){0.f, 0.f, 0.f, 0.f};
#pragma unroll
        for (int ai = 0; ai < 2; ++ai)
#pragma unroll
            for (int m = 0; m < 4; ++m) { bf16_t* rowp = O + (size_t)(row0 + ai * HALF + m * 16) * ldc + col0;
#pragma unroll
                for (int bj = 0; bj < 2; ++bj) { f32x4 v0 = acc[ai][bj][m][0] + bv[bj][0], v1 = acc[ai][bj][m][1] + bv[bj][1];
                    if (ACT == 2) {
#pragma unroll
                        for (int i = 0; i < 4; ++i) { v0[i] = gelu_tanh_f(v0[i]); v1[i] = gelu_tanh_f(v1[i]); } }
                    u32x4 w; w.x = cvtpk(v0[0], v0[1]); w.y = cvtpk(v0[2], v0[3]); w.z = cvtpk(v1[0], v1[1]); w.w = cvtpk(v1[2], v1[3]);
                    *(u32x4*)(rowp + bj * HALF) = w; } }
    }
};
struct EpiResF32 {
    static constexpr bool PERM = false;
    const float* base; float* out; int ldc;
    __device__ __forceinline__ void operator()(const f32x4 (&acc)[2][2][4][2], const Unit& u, int wr, int wc, int fr, int fq) const {
        const int col0 = u.pn * BM + wc * 32 + 4 * fq;
#pragma unroll
        for (int ai = 0; ai < 2; ++ai)
#pragma unroll
            for (int m = 0; m < 4; ++m) { const size_t off = (size_t)(u.pm * BM + ai * HALF + wr * 64 + m * 16 + fr) * ldc + col0;
#pragma unroll
                for (int bj = 0; bj < 2; ++bj)
#pragma unroll
                    for (int n = 0; n < 2; ++n) { const f32x4 bs = *(const f32x4*)(base + off + bj * HALF + n * 16); *(f32x4*)(out + off + bj * HALF + n * 16) = bs + acc[ai][bj][m][n]; } }
    }
};
struct EpiSwiGLU {
    static constexpr bool PERM = true;
    bf16_t* O; int ldc;
    __device__ __forceinline__ void operator()(const f32x4 (&acc)[2][2][4][2], const Unit& u, int wr, int wc, int fr, int fq) const {
        const int row0 = u.pm * BM + wr * 64 + fr, col0 = u.pn * HALF + wc * 32 + 8 * fq;
#pragma unroll
        for (int ai = 0; ai < 2; ++ai)
#pragma unroll
            for (int m = 0; m < 4; ++m) { bf16_t* rowp = O + (size_t)(row0 + ai * HALF + m * 16) * ldc + col0;
                float h[8];
#pragma unroll
                for (int n = 0; n < 2; ++n)
#pragma unroll
                    for (int i = 0; i < 4; ++i) h[n * 4 + i] = silu_f(acc[ai][0][m][n][i]) * acc[ai][1][m][n][i];
                u32x4 w; w.x = cvtpk(h[0], h[1]); w.y = cvtpk(h[2], h[3]); w.z = cvtpk(h[4], h[5]); w.w = cvtpk(h[6], h[7]);
                *(u32x4*)rowp = w; }
    }
};
struct EpiRowScaleBf16 {
    static constexpr bool PERM = true;
    bf16_t* O; int ldc; const float* roww;
    __device__ __forceinline__ void operator()(const f32x4 (&acc)[2][2][4][2], const Unit& u, int wr, int wc, int fr, int fq) const {
        const int row0 = u.pm * BM + wr * 64 + fr, col0 = u.pn * BM + wc * 32 + 8 * fq;
#pragma unroll
        for (int ai = 0; ai < 2; ++ai)
#pragma unroll
            for (int m = 0; m < 4; ++m) { const int row = row0 + ai * HALF + m * 16; const float sc = roww[row]; bf16_t* rowp = O + (size_t)row * ldc + col0;
#pragma unroll
                for (int bj = 0; bj < 2; ++bj) { const f32x4 v0 = acc[ai][bj][m][0] * sc, v1 = acc[ai][bj][m][1] * sc;
                    u32x4 w; w.x = cvtpk(v0[0], v0[1]); w.y = cvtpk(v0[2], v0[3]); w.z = cvtpk(v1[0], v1[1]); w.w = cvtpk(v1[2], v1[3]);
                    *(u32x4*)(rowp + bj * HALF) = w; } }
    }
};
}
constexpr int ROWS_MAX = 2 * T + 8 * 256;
constexpr size_t al256(size_t x) { return (x + 255) & ~(size_t)255; }
constexpr size_t W_IN_E = 0;
constexpr size_t W_CW1 = W_IN_E + (size_t)1792 * 1024 * 2;
constexpr size_t W_UQ = W_CW1 + (size_t)2 * 256 * 2048 * 2;
constexpr size_t W_UKV = W_UQ + (size_t)768 * 256 * 2;
constexpr size_t W_OUT_E = W_UKV + (size_t)1024 * 128 * 2;
constexpr size_t W_GU = W_OUT_E + (size_t)1024 * 1024 * 2;
constexpr size_t W_D = W_GU + (size_t)5632 * 1024 * 2;
constexpr size_t W_IN_O = W_D + (size_t)1024 * 2816 * 2;
constexpr size_t W_OUT_O = W_IN_O + (size_t)3072 * 1024 * 2;
constexpr size_t W_MGU = W_OUT_O + (size_t)1024 * 1024 * 2;
constexpr size_t W_MD = W_MGU + (size_t)8 * 2816 * 1024 * 2;
constexpr size_t W_END = W_MD + (size_t)8 * 1024 * 1408 * 2;
constexpr size_t SM_CTL = al256(W_END);
constexpr size_t SM_B1P = SM_CTL + 4096;
constexpr size_t SM_B1 = SM_B1P + 32 * 512 * 4;
constexpr size_t SM_ROPE = SM_B1 + 512 * 4;
constexpr size_t SM_BL = SM_ROPE + (size_t)S * 32 * 4;
constexpr size_t SM_HID = SM_BL + 8 * 132 * 4;
constexpr size_t SM_KC = SM_HID + (size_t)2 * NB * 512 * 256 * 2;
constexpr size_t SM_VCT = SM_KC + (size_t)NB * 512 * 64 * 2;
constexpr size_t SM_TE = SM_VCT + (size_t)NB * 512 * 64 * 2;
constexpr size_t SM_TW = SM_TE + (size_t)T * 8;
constexpr size_t SM_RANK = SM_TW + (size_t)T * 8;
constexpr size_t SM_POS = SM_RANK + (size_t)T * 8;
constexpr size_t SM_ROWW = SM_POS + (size_t)T * 8;
constexpr size_t SM_TILEE = SM_ROWW + (size_t)ROWS_MAX * 4;
constexpr size_t SM_END = SM_TILEE + (size_t)(ROWS_MAX / 256 + 8) * 4;
constexpr size_t R_XA = al256(SM_END);
constexpr size_t SZ_XA = (size_t)T * 4096 + (size_t)4 * 1048576;
constexpr size_t R_XN = R_XA + SZ_XA;
constexpr size_t SZ_XN = (size_t)T * 2048;
constexpr size_t R_H = R_XN + SZ_XN;
constexpr size_t SZ_H = ((size_t)T * 6144 > (size_t)ROWS_MAX * 2816) ? (size_t)T * 6144 : (size_t)ROWS_MAX * 2816;
constexpr size_t WS_FAST_END = R_H + SZ_H;
constexpr size_t A_QN = 0;
constexpr size_t A_KSN = A_QN + (size_t)T * 1024;
constexpr size_t A_KWN = A_KSN + (size_t)T * 256;
constexpr size_t A_VST = A_KWN + (size_t)T * 256;
constexpr size_t A_VWT = A_VST + (size_t)T * 256;
constexpr size_t A_KCIN = A_VWT + (size_t)T * 256;
constexpr size_t A_VCIN = A_KCIN + (size_t)T * 256 + 2048;
constexpr size_t A_CQN = A_VCIN + (size_t)T * 256 + 2048;
constexpr size_t A_CKVN = A_CQN + (size_t)T * 512;
constexpr size_t A_KROPE = A_CKVN + (size_t)T * 256;
constexpr size_t A_GATES = A_KROPE + (size_t)T * 64;
constexpr size_t A_END = A_GATES + (size_t)T * 96;
static_assert(A_END <= SZ_XA, "attention inputs fit R_XA");
constexpr size_t O_QM = 0;
constexpr size_t O_KM = O_QM + (size_t)T * 1536;
constexpr size_t O_VMT = O_KM + (size_t)T * 1536;
static_assert(O_VMT + (size_t)T * 1024 <= (size_t)T * 4096, "d_out scratch");

struct Params {
    const float* in[30];
    float* out;
    unsigned char* ws;
    int ph_lo, ph_hi, dbg_branch, pad_;
};

constexpr int LDS_BYTES = 147456;

__device__ __forceinline__ int ltid() { int t = threadIdx.x; asm volatile("" : "+v"(t)); return t; }
__device__ __forceinline__ int perm16(int k) { return (k & ~12) | ((k & 4) << 1) | ((k & 8) >> 1); }

struct WDesc { int in_idx, K, N, rep, map, row_off; size_t src_stride, dst_off, dst_stride; };
__device__ const WDesc WDESC[12] = {
    {3, 1024, 1720, 1, 0, 0, 0, W_IN_E / 2, 0},
    {7, 2048, 256, 2, 0, 0, (size_t)2048 * 256, W_CW1 / 2, (size_t)256 * 2048},
    {11, 256, 768, 1, 0, 0, 0, W_UQ / 2, 0},
    {12, 128, 1024, 1, 0, 0, 0, W_UKV / 2, 0},
    {15, 1024, 1024, 1, 0, 0, 0, W_OUT_E / 2, 0},
    {17, 1024, 2816, 1, 1, 0, 0, W_GU / 2, 0},
    {18, 1024, 2816, 1, 1, 128, 0, W_GU / 2, 0},
    {19, 2816, 1024, 1, 0, 0, 0, W_D / 2, 0},
    {21, 1024, 3072, 1, 0, 0, 0, W_IN_O / 2, 0},
    {23, 1024, 1024, 1, 0, 0, 0, W_OUT_O / 2, 0},
    {27, 1024, 1408, 8, 1, 0, (size_t)1024 * 1408, W_MGU / 2, (size_t)2816 * 1024},
    {28, 1024, 1408, 8, 1, 128, (size_t)1024 * 1408, W_MGU / 2, (size_t)2816 * 1024},
};
__device__ const WDesc WDESC_MD = {29, 1408, 1024, 8, 0, 0, (size_t)1408 * 1024, W_MD / 2, (size_t)1024 * 1408};

__device__ __forceinline__ void transpose_item(const float* W, int K, int N, bf16_t* WT, int map, int row_off, LAS float* scr, int item, int lane) {
    const int nblk = (N + 31) / 32, kb = item / nblk, nb = item % nblk, k0 = 64 * kb, n0 = 32 * nb;
    const int n4 = (lane & 7) * 4; const bool nok = (n0 + n4) < N;
    f32x4 v[8];
#pragma unroll
    for (int i = 0; i < 8; ++i) { const int kk = (lane >> 3) + 8 * i; v[i] = nok ? *(const f32x4*)(W + (size_t)(k0 + kk) * N + n0 + n4) : (f32x4){0.f, 0.f, 0.f, 0.f}; }
#pragma unroll
    for (int i = 0; i < 8; ++i) { const int kk = (lane >> 3) + 8 * i; LAS float* d = scr + kk * 33 + n4; d[0] = v[i].x; d[1] = v[i].y; d[2] = v[i].z; d[3] = v[i].w; }
    asm volatile("s_waitcnt lgkmcnt(0)" ::: "memory");
    const int c = lane & 7;
#pragma unroll
    for (int j = 0; j < 4; ++j) { const int n = (lane >> 3) + 8 * j; const LAS float* s = scr + (8 * c) * 33 + n;
        u32x4 o; o.x = cvtpk(s[0 * 33], s[1 * 33]); o.y = cvtpk(s[2 * 33], s[3 * 33]); o.z = cvtpk(s[4 * 33], s[5 * 33]); o.w = cvtpk(s[6 * 33], s[7 * 33]);
        const int nn = n0 + n;
        if (nn < N) { const int row = map ? (256 * (nn >> 7) + (nn & 127) + row_off) : (nn + row_off);
            *(u32x4*)(WT + (size_t)row * K + k0 + 8 * c) = o; } }
    asm volatile("s_waitcnt lgkmcnt(0)" ::: "memory");
}
__device__ __forceinline__ void do_wdesc(const Params& p, const WDesc& d, int it, LAS float* scr, int lane) {
    const int per = (d.K / 64) * ((d.N + 31) / 32); const int r = it / per, ii = it % per;
    transpose_item(p.in[d.in_idx] + (size_t)r * d.src_stride, d.K, d.N, (bf16_t*)p.ws + d.dst_off + (size_t)r * d.dst_stride, d.map, d.row_off, scr, ii, lane);
}
__device__ __forceinline__ void rms_row_to_bf16(const float* xrow, const float* g, bf16_t* orow, int lane) {
    const f32x4* xr = (const f32x4*)xrow + lane; const f32x4* gr = (const f32x4*)g + lane;
    f32x4 v[4]; float s = 0.f;
#pragma unroll
    for (int j = 0; j < 4; ++j) { v[j] = xr[64 * j]; s += (v[j].x * v[j].x + v[j].y * v[j].y) + (v[j].z * v[j].z + v[j].w * v[j].w); }
    const float r = rsqrtf(wsum(s) * (1.f / 1024.f) + EPS);
    u32x2* o8 = (u32x2*)orow + lane;
#pragma unroll
    for (int j = 0; j < 4; ++j) { const f32x4 gg = gr[64 * j]; u32x2 w; w.x = cvtpk(v[j].x * r * gg.x, v[j].y * r * gg.y); w.y = cvtpk(v[j].z * r * gg.z, v[j].w * r * gg.w); o8[64 * j] = w; }
}
__device__ __forceinline__ void phase_p0(const Params& p, LAS unsigned char* lds) {
    const int tid = ltid(), lane = tid & 63, wave = tid >> 6;
    const int gw = blockIdx.x * 8 + wave, NGW = gridDim.x * 8;
    LAS float* scr = (LAS float*)(lds + wave * 16384);
    int base = 0;
#pragma unroll 1
    for (int d = 0; d < 13; ++d) {
        const WDesc& wd = (d < 12) ? WDESC[d] : WDESC_MD;
        const int n_it = wd.rep * (wd.K / 64) * ((wd.N + 31) / 32);
        int first = (gw - (base % NGW) + NGW) % NGW;
        for (int it = first; it < n_it; it += NGW) do_wdesc(p, wd, it, scr, lane);
        base += n_it;
    }
    bf16_t* xn = (bf16_t*)(p.ws + R_XN);
    for (int m = gw; m < T; m += 2 * NGW) { rms_row_to_bf16(p.in[0] + (size_t)m * D, p.in[2], xn + (size_t)m * D, lane); if (m + NGW < T) rms_row_to_bf16(p.in[0] + (size_t)(m + NGW) * D, p.in[2], xn + (size_t)(m + NGW) * D, lane); }
    for (int u = gw; u < 256; u += NGW) {
        const int kc = u >> 3, kv = (u >> 2) & 1, nb = u & 3; float s = 0.f;
        const float* pos = p.in[6] + kv * 2048 + kc * 64; const float* w1 = p.in[7] + ((size_t)kv * 2048 + kc * 64) * 256 + nb * 64 + lane;
#pragma unroll 8
        for (int k = 0; k < 64; ++k) s += pos[k] * w1[(size_t)k * 256];
        ((float*)(p.ws + SM_B1P))[kc * 512 + kv * 256 + nb * 64 + lane] = s;
    }
    for (int i = blockIdx.x * 512 + tid; i < S * 16; i += gridDim.x * 512) {
        const int t = i >> 4, f = i & 15; const float ang = (float)t * powf(10000.f, -(float)f / 16.f);
        float* rp = (float*)(p.ws + SM_ROPE) + t * 32; rp[f] = cosf(ang); rp[16 + f] = sinf(ang);
    }
    if (blockIdx.x == 0) for (int i = tid; i < 8 * 129; i += 512) { const int h = i / 129, dd = i % 129; ((float*)(p.ws + SM_BL))[h * 132 + dd] = p.in[1][(dd < 128 ? (int)gold::T5B[dd] : 31) * 8 + h] * LOG2E; }
}

__device__ __forceinline__ void phase_p2(const Params& p, LAS unsigned char* lds) {
    const int tid = ltid(), lane = tid & 63, wave = tid >> 6;
    const bf16_t* hb = (const bf16_t*)(p.ws + R_H);
    unsigned char* xa = p.ws + R_XA;
    bf16_t* qn = (bf16_t*)(xa + A_QN); bf16_t* ksn = (bf16_t*)(xa + A_KSN); bf16_t* kwn = (bf16_t*)(xa + A_KWN);
    bf16_t* vst = (bf16_t*)(xa + A_VST); bf16_t* vwt = (bf16_t*)(xa + A_VWT); bf16_t* kcin = (bf16_t*)(xa + A_KCIN); bf16_t* vcin = (bf16_t*)(xa + A_VCIN);
    bf16_t* cqn = (bf16_t*)(xa + A_CQN); bf16_t* ckvn = (bf16_t*)(xa + A_CKVN); bf16_t* krope = (bf16_t*)(xa + A_KROPE); float* gates = (float*)(xa + A_GATES);
    const float* q_norm = p.in[4]; const float* k_norm = p.in[5]; const float* cq_norm = p.in[9]; const float* ckv_norm = p.in[10];
    LAS bf16_t* vs = (LAS bf16_t*)lds;
    if (blockIdx.x == 0) {
        { float s = 0.f; for (int k = 0; k < 32; ++k) s += ((const float*)(p.ws + SM_B1P))[k * 512 + tid]; ((float*)(p.ws + SM_B1))[tid] = s; }
        for (int i = tid; i < 1024; i += 512) { kcin[(size_t)T * 128 + i] = 0; vcin[(size_t)T * 128 + i] = 0; }
    }
    for (int tile = blockIdx.x; tile < T / 64; tile += gridDim.x) {
        const int b = tile / (S / 64), s0 = (tile % (S / 64)) * 64;
        for (int tt = 0; tt < 8; ++tt) {
            const int sl = wave * 8 + tt, s = s0 + sl; const size_t t = (size_t)b * S + s;
            const bf16_t* hr = hb + t * 1792;
#pragma unroll
            for (int hh = 0; hh < 8; ++hh) { const float v = bf2f(hr[hh * 64 + lane]); const float r = rsqrtf(wsum(v * v) * (1.f / 64.f) + EPS);
                qn[(t * 8 + hh) * 64 + lane] = f2bf(v * r * q_norm[lane] * (0.125f * LOG2E)); }
#pragma unroll
            for (int g = 0; g < 2; ++g) {
                const size_t gm = (((size_t)b * 2 + g) * S + s) * 64 + lane;
                float v = bf2f(hr[768 + g * 64 + lane]); float r = rsqrtf(wsum(v * v) * (1.f / 64.f) + EPS); ksn[gm] = f2bf(v * r * k_norm[64 + lane]);
                v = bf2f(hr[1024 + g * 64 + lane]); r = rsqrtf(wsum(v * v) * (1.f / 64.f) + EPS); kwn[gm] = f2bf(v * r * k_norm[128 + lane]);
                kcin[gm] = hr[512 + g * 64 + lane]; vcin[gm] = hr[640 + g * 64 + lane];
                const int pp = (sl & ~15) | perm16(sl & 15);
                vs[((0 + g) * 64 + lane) * 72 + pp] = hr[896 + g * 64 + lane];
                vs[((2 + g) * 64 + lane) * 72 + pp] = hr[1152 + g * 64 + lane];
            }
            if (lane < 24) gates[t * 24 + lane] = frcp(1.f + fexp2(-bf2f(hr[1280 + lane]) * LOG2E));
            { float a[4]; float ss = 0.f;
#pragma unroll
                for (int j = 0; j < 4; ++j) { a[j] = bf2f(hr[1304 + j * 64 + lane]); ss += a[j] * a[j]; }
                const float r = rsqrtf(wsum(ss) * (1.f / 256.f) + EPS);
#pragma unroll
                for (int j = 0; j < 4; ++j) cqn[t * 256 + j * 64 + lane] = f2bf(a[j] * r * cq_norm[j * 64 + lane]); }
            { float a[2]; float ss = 0.f;
#pragma unroll
                for (int j = 0; j < 2; ++j) { a[j] = bf2f(hr[1560 + j * 64 + lane]); ss += a[j] * a[j]; }
                const float r = rsqrtf(wsum(ss) * (1.f / 128.f) + EPS);
#pragma unroll
                for (int j = 0; j < 2; ++j) ckvn[t * 128 + j * 64 + lane] = f2bf(a[j] * r * ckv_norm[j * 64 + lane]); }
            if (lane < 32) krope[t * 32 + lane] = hr[1688 + lane];
        }
        __syncthreads();
        {
            const int row = tid >> 1, half = tid & 1, which = row >> 6, d = row & 63, g = which & 1;
            bf16_t* dst = ((which < 2) ? vst : vwt) + (((size_t)b * 2 + g) * 64 + d) * S + s0 + half * 32;
            const LAS bf16_t* src = vs + row * 72 + half * 32;
#pragma unroll
            for (int c = 0; c < 4; ++c) *(u32x4*)(dst + c * 8) = *(const LAS u32x4*)(src + c * 8);
        }
        __syncthreads();
    }
}
__device__ __forceinline__ void phase_p3b(const Params& p, LAS unsigned char* lds) {
    const int tid = ltid(), lane = tid & 63, wave = tid >> 6;
    const int gw = blockIdx.x * 8 + wave, NGW = gridDim.x * 8;
    const bf16_t* qraw = (const bf16_t*)(p.ws + R_H);
    const bf16_t* kvraw = (const bf16_t*)(p.ws + R_H + (size_t)T * 1536);
    const bf16_t* krope = (const bf16_t*)(p.ws + R_XA + A_KROPE);
    const float* rope = (const float*)(p.ws + SM_ROPE);
    bf16_t* qm = (bf16_t*)((unsigned char*)p.out + O_QM); bf16_t* km = (bf16_t*)((unsigned char*)p.out + O_KM); bf16_t* vmt = (bf16_t*)((unsigned char*)p.out + O_VMT);
    const float* q_norm = p.in[13]; const float* k_norm = p.in[14];
    LAS bf16_t* vs = (LAS bf16_t*)lds;
    LAS float* w2s = (LAS float*)(lds + 73728);
    for (int kv = 0; kv < 2; ++kv) {
        __syncthreads();
        for (int i = tid; i < 256 * 64; i += 512) w2s[i] = p.in[8][kv * 16384 + i];
        __syncthreads();
        const bf16_t* hid = (const bf16_t*)(p.ws + SM_HID) + (size_t)kv * NB * 512 * 256;
        for (int row = gw; row < NB * 512; row += NGW) {
            const u32x2 hv = *(const u32x2*)(hid + (size_t)row * 256 + lane * 4);
            const float h0 = bflo(hv.x), h1 = bfhi(hv.x), h2 = bflo(hv.y), h3 = bfhi(hv.y);
            float acc = 0.f;
#pragma unroll 8
            for (int k4 = 0; k4 < 64; ++k4) {
                acc += __shfl(h0, k4) * w2s[(k4 * 4 + 0) * 64 + lane]; acc += __shfl(h1, k4) * w2s[(k4 * 4 + 1) * 64 + lane];
                acc += __shfl(h2, k4) * w2s[(k4 * 4 + 2) * 64 + lane]; acc += __shfl(h3, k4) * w2s[(k4 * 4 + 3) * 64 + lane];
            }
            if (kv == 0) { const float r = rsqrtf(wsum(acc * acc) * (1.f / 64.f) + EPS); ((bf16_t*)(p.ws + SM_KC))[(size_t)row * 64 + lane] = f2bf(acc * r * p.in[5][lane]); }
            else { const int c = row & 255; ((bf16_t*)(p.ws + SM_VCT))[((size_t)(row >> 8) * 64 + lane) * 256 + ((c & ~15) | perm16(c & 15))] = f2bf(acc); }
        }
    }
    __syncthreads();
    const float QS = 0.10206207261596577f * LOG2E;
    for (int tile = blockIdx.x; tile < T / 64; tile += gridDim.x) {
        const int b = tile / (S / 64), s0 = (tile % (S / 64)) * 64;
        for (int tt = 0; tt < 8; ++tt) {
            const int sl = wave * 8 + tt, s = s0 + sl; const size_t t = (size_t)b * S + s;
            const int e2 = 64 + (lane & 31), f = lane & 15;
            const float cs = rope[s * 32 + f], sn = rope[s * 32 + 16 + f];
            const float kr = bf2f(krope[t * 32 + (lane & 31)]);
            const int pp = (sl & ~15) | perm16(sl & 15);
#pragma unroll 2
            for (int hh = 0; hh < 8; ++hh) {
                {
                    float a = bf2f(qraw[t * 768 + hh * 96 + lane]), bb = bf2f(qraw[t * 768 + hh * 96 + e2]);
                    const float r = rsqrtf(wsum(a * a + (lane < 32 ? bb * bb : 0.f)) * (1.f / 96.f) + EPS);
                    a = a * r * q_norm[lane]; bb = bb * r * q_norm[e2];
                    const float pb = __shfl_xor(bb, 16);
                    const float ob = ((lane & 31) < 16) ? (bb * cs - pb * sn) : (pb * sn + bb * cs);
                    qm[(t * 8 + hh) * 96 + lane] = f2bf(a * QS); if (lane < 32) qm[(t * 8 + hh) * 96 + e2] = f2bf(ob * QS);
                }
                {
                    float a = bf2f(kvraw[t * 1024 + hh * 128 + lane]), bb = kr;
                    const float r = rsqrtf(wsum(a * a + (lane < 32 ? bb * bb : 0.f)) * (1.f / 96.f) + EPS);
                    a = a * r * k_norm[lane]; bb = bb * r * k_norm[e2];
                    const float pb = __shfl_xor(bb, 16);
                    const float ob = ((lane & 31) < 16) ? (bb * cs - pb * sn) : (pb * sn + bb * cs);
                    const size_t ko = (((size_t)b * 8 + hh) * S + s) * 96;
                    km[ko + lane] = f2bf(a); if (lane < 32) km[ko + e2] = f2bf(ob);
                    vs[(hh * 64 + lane) * 72 + pp] = kvraw[t * 1024 + hh * 128 + 64 + lane];
                }
            }
        }
        __syncthreads();
        {
            const int hh = tid >> 6, d = tid & 63;
            bf16_t* dst = vmt + (((size_t)b * 8 + hh) * 64 + d) * S + s0;
            const LAS bf16_t* src = vs + tid * 72;
#pragma unroll
            for (int c = 0; c < 8; ++c) *(u32x4*)(dst + c * 8) = *(const LAS u32x4*)(src + c * 8);
        }
        __syncthreads();
    }
}

__device__ const unsigned short UNIT_TYPES[256] = {63,127,62,126,61,125,527,591,655,719,783,847,911,975,60,124,59,123,58,122,57,121,56,120,526,590,654,718,782,846,910,974,55,119,54,118,53,117,52,116,51,115,525,589,653,717,781,845,909,973,50,114,49,113,48,112,47,111,524,588,652,716,780,844,908,972,46,110,45,109,44,108,43,107,523,587,651,715,779,843,907,971,42,106,41,105,40,104,39,103,38,102,522,586,650,714,778,842,906,970,37,101,36,100,35,99,34,98,33,97,521,585,649,713,777,841,905,969,32,96,31,95,30,94,520,584,648,712,776,840,904,968,29,93,28,92,27,91,26,90,25,89,519,583,647,711,775,839,903,967,24,88,23,87,22,86,21,85,20,84,518,582,646,710,774,838,902,966,19,83,18,82,17,81,16,80,15,79,517,581,645,709,773,837,901,965,14,78,13,77,12,76,516,580,644,708,772,836,900,964,11,75,10,74,9,73,8,72,515,579,643,707,771,835,899,963,7,71,6,70,5,69,514,578,642,706,770,834,898,962,4,68,3,67,513,577,641,705,769,833,897,961,2,66,1,65,0,64,512,576,640,704,768,832,896,960};
__device__ __forceinline__ int crow(int r, int hi) { return (r & 3) + 8 * (r >> 2) + 4 * hi; }
struct Flash { f32x16 o0, o1; float l; };
__device__ __forceinline__ void flash_init(Flash& st) {
#pragma unroll
    for (int r = 0; r < 16; ++r) { st.o0[r] = 0.f; st.o1[r] = 0.f; }
    st.l = 0.f;
}
constexpr int AL_KB = 0, AL_KBSZ = 64 * 208, AL_VB = 2 * AL_KBSZ, AL_VBSZ = 64 * 144, AL_IMP = AL_VB + 2 * AL_VBSZ, AL_SELB = AL_IMP + 64 * 65 * 4, AL_UNI = AL_SELB + 512, AL_TL = AL_UNI + 64, AL_BL = AL_TL + 128,
              AL_OT = AL_BL + 4 * 132 * 4, AL_END = AL_OT + 8 * 32 * 64 * 4;
static_assert(AL_END <= 131072, "attention LDS");

template <int DK, int KP> __device__ __forceinline__ void qk_tile(f32x16& p0, f32x16& p1, const LAS unsigned char* Kt, const bf16x8* qf, const f32x16& negm, int r32, int hi) {
#pragma unroll
    for (int s = 0; s < DK / 16; ++s) {
        const bf16x8 a0 = *(const LAS bf16x8*)(Kt + r32 * KP + (16 * s + 8 * hi) * 2);
        const bf16x8 a1 = *(const LAS bf16x8*)(Kt + (32 + r32) * KP + (16 * s + 8 * hi) * 2);
        if (s == 0) { p0 = __builtin_amdgcn_mfma_f32_32x32x16_bf16(a0, qf[0], negm, 0, 0, 0); p1 = __builtin_amdgcn_mfma_f32_32x32x16_bf16(a1, qf[0], negm, 0, 0, 0); }
        else { p0 = __builtin_amdgcn_mfma_f32_32x32x16_bf16(a0, qf[s], p0, 0, 0, 0); p1 = __builtin_amdgcn_mfma_f32_32x32x16_bf16(a1, qf[s], p1, 0, 0, 0); }
    }
}
template <bool LANEMASK, class F> __device__ __forceinline__ void softmax_pv(Flash& st, f32x16& p0, f32x16& p1, const LAS unsigned char* Vt, int r32, int hi, bool mine, F f) {
    float ls = 0.f;
#pragma unroll
    for (int r = 0; r < 16; ++r) {
        float x0 = p0[r], x1 = p1[r]; const bool v0 = f(r, 0, x0), v1 = f(r, 1, x1);
        const float e0 = fexp2(x0), e1 = fexp2(x1);
        p0[r] = v0 ? e0 : 0.f; p1[r] = v1 ? e1 : 0.f; ls += p0[r] + p1[r];
    }
    if (LANEMASK) ls = mine ? ls : 0.f;
    st.l += ls;
#pragma unroll
    for (int s = 0; s < 4; ++s) {
        u32x4 w;
        if (s < 2) { w.x = cvtpk(p0[8 * s + 0], p0[8 * s + 1]); w.y = cvtpk(p0[8 * s + 2], p0[8 * s + 3]); w.z = cvtpk(p0[8 * s + 4], p0[8 * s + 5]); w.w = cvtpk(p0[8 * s + 6], p0[8 * s + 7]); }
        else { const int q = s - 2; w.x = cvtpk(p1[8 * q + 0], p1[8 * q + 1]); w.y = cvtpk(p1[8 * q + 2], p1[8 * q + 3]); w.z = cvtpk(p1[8 * q + 4], p1[8 * q + 5]); w.w = cvtpk(p1[8 * q + 6], p1[8 * q + 7]); }
        if (LANEMASK) { w.x = mine ? w.x : 0u; w.y = mine ? w.y : 0u; w.z = mine ? w.z : 0u; w.w = mine ? w.w : 0u; }
        const bf16x8 pa = __builtin_bit_cast(bf16x8, w);
        const bf16x8 vb0 = *(const LAS bf16x8*)(Vt + r32 * 144 + (16 * s + 8 * hi) * 2);
        const bf16x8 vb1 = *(const LAS bf16x8*)(Vt + (32 + r32) * 144 + (16 * s + 8 * hi) * 2);
        st.o0 = __builtin_amdgcn_mfma_f32_32x32x16_bf16(pa, vb0, st.o0, 0, 0, 0);
        st.o1 = __builtin_amdgcn_mfma_f32_32x32x16_bf16(pa, vb1, st.o1, 0, 0, 0);
    }
}
template <bool FIRST> __device__ __forceinline__ void flash_accum(LAS float* otl, const Flash& st, float gate, int hi, int lane) {
    const float lt = st.l + __shfl_xor(st.l, 32);
    const float f = lt > 0.f ? gate * frcp(lt) : 0.f;
#pragma unroll
    for (int r = 0; r < 16; ++r) { const float fr_ = __shfl(f, crow(r, hi));
        if (FIRST) { otl[r * 64 + lane] = fr_ * st.o0[r]; otl[(16 + r) * 64 + lane] = fr_ * st.o1[r]; }
        else { otl[r * 64 + lane] += fr_ * st.o0[r]; otl[(16 + r) * 64 + lane] += fr_ * st.o1[r]; } }
}
template <int NS> __device__ __forceinline__ float qnorm2(const bf16x8* qf) {
    float s = 0.f;
#pragma unroll
    for (int i = 0; i < NS; ++i)
#pragma unroll
        for (int j = 0; j < 8; ++j) { const float x = bf2f((bf16_t)qf[i][j]); s += x * x; }
    return s + __shfl_xor(s, 32);
}
__device__ __forceinline__ float wmax(float v) {
#pragma unroll
    for (int o = 1; o < 64; o <<= 1) v = fmaxf(v, __shfl_xor(v, o));
    return v;
}

template <int RB> struct TileRegs { u32x4 a, b; };
template <int RB> __device__ __forceinline__ void tile_load(TileRegs<RB>& R, const unsigned char* g, size_t gs, int tid) {
    constexpr int CPR = RB / 16;
    asm volatile("" : "+v"(tid));
    { const int row = tid / CPR, c = tid % CPR; R.a = *(const u32x4*)(g + (size_t)row * gs + c * 16); }
    if (RB == 192) { const int id = (tid < 256) ? tid + 512 : tid; const int row = id / CPR, c = id % CPR; R.b = *(const u32x4*)(g + (size_t)row * gs + c * 16); }
}
template <int RB, int P> __device__ __forceinline__ void tile_store(const TileRegs<RB>& R, LAS unsigned char* l, int tid) {
    constexpr int CPR = RB / 16;
    asm volatile("" : "+v"(tid));
    { const int row = tid / CPR, c = tid % CPR; *(LAS u32x4*)(l + row * P + c * 16) = R.a; }
    if (RB == 192) { const int id = tid + 512; if (id < 768) { const int row = id / CPR, c = id % CPR; *(LAS u32x4*)(l + row * P + c * 16) = R.b; } }
}
template <int RBK, int PK, bool HASV, class SrcK, class SrcV, class Comp>
__device__ __forceinline__ void run_tiles(int n, LAS unsigned char* lds, int tid, size_t gsK, size_t gsV, SrcK srcK, SrcV srcV, Comp comp) {
    TileRegs<RBK> k0, k1, k2; TileRegs<128> v0, v1, v2;
    const int nl = n - 1;
    { tile_load<RBK>(k0, srcK(0), gsK, tid); if (HASV) tile_load<128>(v0, srcV(0), gsV, tid); }
    { const int t1 = nl < 1 ? nl : 1; tile_load<RBK>(k1, srcK(t1), gsK, tid); if (HASV) tile_load<128>(v1, srcV(t1), gsV, tid); }
    { const int t2 = nl < 2 ? nl : 2; tile_load<RBK>(k2, srcK(t2), gsK, tid); if (HASV) tile_load<128>(v2, srcV(t2), gsV, tid); }
#define RT_STEP(KR, VR, ii) do { const int i_ = (ii); \
        LAS unsigned char* kb = lds + AL_KB + (i_ & 1) * AL_KBSZ; LAS unsigned char* vb = lds + AL_VB + (i_ & 1) * AL_VBSZ; \
        tile_store<RBK, PK>(KR, kb, tid); if (HASV) tile_store<128, 144>(VR, vb, tid); \
        __syncthreads(); \
        { const int tn = (i_ + 3 < nl) ? i_ + 3 : nl; tile_load<RBK>(KR, srcK(tn), gsK, tid); if (HASV) tile_load<128>(VR, srcV(tn), gsV, tid); } \
        if (i_ < n) comp(i_, kb, vb); } while (0)
    for (int i = 0; i < n; i += 3) { RT_STEP(k0, v0, i); RT_STEP(k1, v1, i + 1); RT_STEP(k2, v2, i + 2); }
#undef RT_STEP
    __syncthreads();
}

__device__ __forceinline__ void mla_unit(const Params& p, LAS unsigned char* lds, int b, int h, int qb) {
    int tid = threadIdx.x; asm volatile("" : "+v"(tid));
    const int lane = tid & 63, w = __builtin_amdgcn_readfirstlane(tid >> 6), r32 = lane & 31, hi = lane >> 5;
    const bf16_t* qm = (const bf16_t*)((const unsigned char*)p.out + O_QM);
    const unsigned char* km = (const unsigned char*)p.out + O_KM + (((size_t)b * 8 + h) * S) * 192;
    const unsigned char* vmt = (const unsigned char*)p.out + O_VMT + (((size_t)b * 8 + h) * 64) * (size_t)S * 2;
    bf16_t* ocat = (bf16_t*)(p.ws + R_XN);
    const int tq = qb * 256 + 32 * w + r32;
    bf16x8 qf[6];
#pragma unroll
    for (int s = 0; s < 6; ++s) qf[s] = *(const bf16x8*)(qm + (((size_t)b * S + tq) * 8 + h) * 96 + 16 * s + 8 * hi);
    const float kn = 9.797958971f * 1.01f * wmax(fmaxf(fabsf(p.in[14][lane]), lane < 32 ? fabsf(p.in[14][64 + lane]) : 0.f));
    const float mref = sqrtf(qnorm2<6>(qf)) * kn;
    f32x16 negm;
#pragma unroll
    for (int r = 0; r < 16; ++r) negm[r] = -mref;
    Flash st; flash_init(st);
    const int ntile = 4 * qb + 4, dt = 4 * qb + (w >> 1);
    run_tiles<192, 208, true>(ntile, lds, tid, 192, (size_t)S * 2,
        [&](int i) { return km + (size_t)i * 64 * 192; }, [&](int i) { return vmt + (size_t)i * 128; },
        [&](int i, LAS unsigned char* kb, LAS unsigned char* vb) {
            if (i <= dt) {
                f32x16 p0, p1; qk_tile<96, 208>(p0, p1, kb, qf, negm, r32, hi);
                if (i < dt) softmax_pv<false>(st, p0, p1, vb, r32, hi, true, [&](int r, int half, float& x) { return true; });
                else { const int kb0 = 64 * i + 4 * hi; softmax_pv<false>(st, p0, p1, vb, r32, hi, true, [&](int r, int half, float& x) { return (kb0 + 32 * half + (r & 3) + 8 * (r >> 2)) <= tq; }); }
            }
        });
    {
        const float lt = st.l + __shfl_xor(st.l, 32); const float f = lt > 0.f ? frcp(lt) : 0.f;
#pragma unroll
        for (int r = 0; r < 16; ++r) { const float fr_ = __shfl(f, crow(r, hi)); const size_t ro = ((size_t)b * S + qb * 256 + 32 * w + crow(r, hi)) * 1024 + 512 + h * 64 + r32; ocat[ro] = f2bf(st.o0[r] * fr_); ocat[ro + 32] = f2bf(st.o1[r] * fr_); }
    }
}

__device__ __forceinline__ void nsa_unit(const Params& p, LAS unsigned char* lds, int b, int g, int jt) {
    int tid = threadIdx.x; asm volatile("" : "+v"(tid));
    const int lane = tid & 63, w = __builtin_amdgcn_readfirstlane(tid >> 6), r32 = lane & 31, hi = lane >> 5;
    const int rh = w >> 1, qh = w & 1, h = 4 * g + rh, q0 = 64 * jt, ql = 32 * qh + r32, tq = q0 + ql;
    const unsigned char* xa = p.ws + R_XA;
    const bf16_t* qn = (const bf16_t*)(xa + A_QN);
    const size_t bg = (size_t)b * 2 + g;
    const unsigned char* ksn = xa + A_KSN + bg * S * 128; const unsigned char* kwn = xa + A_KWN + bg * S * 128;
    const unsigned char* vst = xa + A_VST + bg * 64 * (size_t)S * 2; const unsigned char* vwt = xa + A_VWT + bg * 64 * (size_t)S * 2;
    const unsigned char* kc = p.ws + SM_KC + bg * 256 * 128; const unsigned char* vct = p.ws + SM_VCT + bg * 64 * 512;
    const float* gates = (const float*)(xa + A_GATES) + ((size_t)b * S + tq) * 24 + h * 3;
    bf16_t* ocat = (bf16_t*)(p.ws + R_XN);
    LAS float* imp = (LAS float*)(lds + AL_IMP); LAS unsigned char* selb = lds + AL_SELB; LAS unsigned* uni = (LAS unsigned*)(lds + AL_UNI); LAS unsigned char* tl = lds + AL_TL; LAS float* bls = (LAS float*)(lds + AL_BL);
    const float* blg = (const float*)(p.ws + SM_BL) + h * 132;
    const float cb = blg[128];
    const float bmax = wmax(fmaxf(fmaxf(blg[lane], blg[64 + lane]), cb));
    if (qh == 0) { bls[rh * 132 + lane] = blg[lane] - cb; bls[rh * 132 + 64 + lane] = blg[64 + lane] - cb; if (lane == 0) bls[rh * 132 + 128] = 0.f; }
    const LAS float* blh = bls + rh * 132;
    bf16x8 qf[4];
#pragma unroll
    for (int s = 0; s < 4; ++s) qf[s] = *(const bf16x8*)(qn + (((size_t)b * S + tq) * 8 + h) * 64 + 16 * s + 8 * hi);
    const float kn = 8.f * 1.01f * wmax(fmaxf(fmaxf(fabsf(p.in[5][lane]), fabsf(p.in[5][64 + lane])), fabsf(p.in[5][128 + lane])));
    const float mref = sqrtf(qnorm2<4>(qf)) * kn + bmax;
    f32x16 negm;
#pragma unroll
    for (int r = 0; r < 16; ++r) negm[r] = cb - mref;
    float g0 = gates[0], g1 = gates[1], g2 = gates[2];
    if (p.dbg_branch >= 0) { g0 = p.dbg_branch == 0 ? 1.f : 0.f; g1 = p.dbg_branch == 1 ? 1.f : 0.f; g2 = p.dbg_branch == 2 ? 1.f : 0.f; }
    LAS float* otl = (LAS float*)(lds + AL_OT) + w * 2048;
    const int nvmax = (q0 + 63 - 31) / 16 + 1, ntc = (nvmax + 63) / 64;
    Flash st; flash_init(st);
    run_tiles<128, 144, true>(ntc, lds, tid, 128, 512,
        [&](int i) { return kc + (size_t)i * 64 * 128; }, [&](int i) { return vct + (size_t)i * 128; },
        [&](int i, LAS unsigned char* kb, LAS unsigned char* vb) {
            f32x16 p0, p1; qk_tile<64, 144>(p0, p1, kb, qf, negm, r32, hi);
            const int cb0 = 64 * i + 4 * hi;
            softmax_pv<false>(st, p0, p1, vb, r32, hi, true, [&](int r, int half, float& x) {
                const int c = cb0 + 32 * half + (r & 3) + 8 * (r >> 2); const int dist = tq - 16 * c - 31; x += blh[dist < 0 ? 0 : (dist > 128 ? 128 : dist)]; return dist >= 0; });
        });
    flash_accum<true>(otl, st, g0, hi, lane);
    unsigned mlo, mhi;
    int nsel;
    if (jt < 16) { const unsigned long long mk = (1ull << (jt + 1)) - 1ull; mlo = (unsigned)mk; mhi = (unsigned)(mk >> 32); nsel = jt + 1; if (tid <= jt) tl[tid] = (unsigned char)tid; }
    else {
        for (int i = tid; i < 64 * 65; i += 512) imp[i] = 0.f;
        const float lt = st.l + __shfl_xor(st.l, 32); const float linv = lt > 0.f ? frcp(lt) : 0.f;
        float xlast = 0.f;
        run_tiles<128, 144, false>(ntc, lds, tid, 128, 0,
            [&](int i) { return kc + (size_t)i * 64 * 128; }, [&](int i) { return kc; },
            [&](int i, LAS unsigned char* kb, LAS unsigned char* vb) {
                f32x16 p0, p1; qk_tile<64, 144>(p0, p1, kb, qf, negm, r32, hi);
                const int cb0 = 64 * i + 4 * hi;
                float sm[2][4], cr[2][4];
#pragma unroll
                for (int half = 0; half < 2; ++half)
#pragma unroll
                    for (int a = 0; a < 4; ++a) {
                        float s4 = 0.f, last = 0.f;
#pragma unroll
                        for (int k = 0; k < 4; ++k) {
                            const int r = 4 * a + k; const int c = cb0 + 32 * half + k + 8 * a; const int dist = tq - 16 * c - 31;
                            const float sc = (half ? p1[r] : p0[r]) + blh[dist < 0 ? 0 : (dist > 128 ? 128 : dist)];
                            const float pv = dist >= 0 ? fexp2(sc) * linv : 0.f;
                            s4 += pv; last = pv;
                        }
                        sm[half][a] = s4; cr[half][a] = last;
                    }
                float tot[2][4];
#pragma unroll
                for (int half = 0; half < 2; ++half)
#pragma unroll
                    for (int a = 0; a < 4; ++a) {
                        const float xs_ = __shfl_xor(cr[half][a], 32);
                        const float xp_ = (a > 0) ? __shfl_xor(cr[half][a > 0 ? a - 1 : 0], 32) : (half ? __shfl_xor(cr[0][3], 32) : xlast);
                        tot[half][a] = sm[half][a] + (hi ? xs_ : xp_);
                    }
                xlast = __shfl_xor(cr[1][3], 32);
                for (int rr = 0; rr < 4; ++rr) {
                    if (rh == rr) {
#pragma unroll
                        for (int half = 0; half < 2; ++half)
#pragma unroll
                            for (int a = 0; a < 4; ++a) { const int j = 16 * i + 8 * half + 2 * a + hi; imp[ql * 65 + j] += tot[half][a]; }
                    }
                    __syncthreads();
                }
            });
        if (p.dbg_branch == 1) { for (int i = tid; i < 4096; i += 512) ((float*)(p.ws + R_H))[((size_t)g * S + q0 + (i >> 6)) * 64 + (i & 63)] = imp[(i >> 6) * 65 + (i & 63)]; }
        {
            const int q = tid >> 3, jg = tid & 7;
            unsigned byte = 0;
#pragma unroll 1
            for (int jj = 0; jj < 8; ++jj) {
                const int j = jg * 8 + jj;
                if (j <= jt) {
                    const float x = imp[q * 65 + j]; const float vj = (j == jt || j == 0) ? 1e9f : x;
                    int rank = 0;
#pragma unroll 8
                    for (int i = 0; i < 64; ++i) { const float xi = imp[q * 65 + i]; const float vi = (i > jt) ? -1.f : ((i == jt || i == 0) ? 1e9f : xi); rank += (vi > vj || (vi == vj && i < j)) ? 1 : 0; }
                    if (rank < 16) byte |= 1u << jj;
                }
            }
            selb[q * 8 + jg] = (unsigned char)byte;
        }
        __syncthreads();
        if (w == 0) {
            unsigned a = ((const LAS unsigned*)selb)[lane * 2], c = ((const LAS unsigned*)selb)[lane * 2 + 1];
#pragma unroll
            for (int o = 1; o < 64; o <<= 1) { a |= __shfl_xor(a, o); c |= __shfl_xor(c, o); }
            const unsigned long long um = ((unsigned long long)c << 32) | a;
            if ((um >> lane) & 1ull) tl[__builtin_popcountll(um & ((1ull << lane) - 1ull))] = (unsigned char)lane;
            if (lane == 0) uni[0] = (unsigned)__builtin_popcountll(um);
        }
        __syncthreads();
        mlo = ((const LAS unsigned*)selb)[ql * 2]; mhi = ((const LAS unsigned*)selb)[ql * 2 + 1];
        nsel = (int)uni[0];
    }
    if (p.dbg_branch == 1 && rh == 0) { if (hi == 0) ((unsigned long long*)(p.ws + R_H + 4 * 1048576))[(size_t)g * S + tq] = ((unsigned long long)mhi << 32) | mlo; }
    __syncthreads();
    {
        const unsigned long long mymask = ((unsigned long long)mhi << 32) | mlo;
        nsel = __builtin_amdgcn_readfirstlane(nsel);
        flash_init(st);
        run_tiles<128, 144, true>(nsel, lds, tid, 128, (size_t)S * 2,
            [&](int i) { return ksn + (size_t)tl[i] * 64 * 128; }, [&](int i) { return vst + (size_t)tl[i] * 128; },
            [&](int i, LAS unsigned char* kb, LAS unsigned char* vb) {
                const int j = __builtin_amdgcn_readfirstlane((int)tl[i]);
                f32x16 p0, p1; qk_tile<64, 144>(p0, p1, kb, qf, negm, r32, hi);
                const bool mine = (mymask >> j) & 1ull;
                if (q0 + 32 * qh - (64 * j + 63) >= 128) softmax_pv<true>(st, p0, p1, vb, r32, hi, mine, [&](int r, int half, float& x) { return true; });
                else { const int kb0 = 64 * j + 4 * hi;
                    softmax_pv<true>(st, p0, p1, vb, r32, hi, mine, [&](int r, int half, float& x) { const int dist = tq - (kb0 + 32 * half + (r & 3) + 8 * (r >> 2)); x += blh[dist < 0 ? 0 : (dist > 128 ? 128 : dist)]; return dist >= 0; }); }
            });
        flash_accum<false>(otl, st, g1, hi, lane);
    }
    {
        const int j0 = jt >= 8 ? jt - 8 : 0, nw = jt - j0 + 1;
        flash_init(st);
        run_tiles<128, 144, true>(nw, lds, tid, 128, (size_t)S * 2,
            [&](int i) { return kwn + (size_t)(j0 + i) * 64 * 128; }, [&](int i) { return vwt + (size_t)(j0 + i) * 128; },
            [&](int i, LAS unsigned char* kb, LAS unsigned char* vb) {
                f32x16 p0, p1; qk_tile<64, 144>(p0, p1, kb, qf, negm, r32, hi);
                const int kb0 = 64 * (j0 + i) + 4 * hi;
                softmax_pv<false>(st, p0, p1, vb, r32, hi, true, [&](int r, int half, float& x) { const int dist = tq - (kb0 + 32 * half + (r & 3) + 8 * (r >> 2)); x += blh[dist < 0 ? 0 : (dist > 128 ? 128 : dist)]; return dist >= 0 && dist < 512; });
            });
        flash_accum<false>(otl, st, g2, hi, lane);
    }
#pragma unroll
    for (int r = 0; r < 16; ++r) { const size_t ro = ((size_t)b * S + q0 + 32 * qh + crow(r, hi)) * 1024 + h * 64 + r32; ocat[ro] = f2bf(otl[r * 64 + lane]); ocat[ro + 32] = f2bf(otl[(16 + r) * 64 + lane]); }
    __syncthreads();
}

__device__ __forceinline__ void phase_p4(const Params& p, LAS unsigned char* lds) {
    const int G = gridDim.x, c = blockIdx.x, nunits = 256 * NB;
#if NB == 8
    if (G == 256) {
        const int b = c & 7, idx = c >> 3, pi = idx & 7, hq = idx >> 3;
#pragma unroll 1
        for (int u = 0; u < 8; ++u) {
            if (u < 4) nsa_unit(p, lds, b, u >> 1, (u & 1) ? idx : 63 - idx);
            else mla_unit(p, lds, b, ((u - 4) >> 1) * 4 + hq, (u & 1) ? pi : 15 - pi);
        }
        return;
    }
#endif
    for (int j = 0;; ++j) {
        const int k = j * G + ((j & 1) ? (G - 1 - c) : c);
        if (j * G >= nunits) break;
        if (k >= nunits) continue;
        const int ty = UNIT_TYPES[k / NB], b = k % NB, kind = ty >> 9, a = (ty >> 6) & 7, cc = ty & 63;
        if (kind == 0) nsa_unit(p, lds, b, a, cc); else mla_unit(p, lds, b, a, cc);
    }
}
__device__ __forceinline__ void phase_norm(const float* x, const float* g, bf16_t* xn) {
    const int tid_ = ltid(); const int lane = tid_ & 63, gw = blockIdx.x * 8 + (tid_ >> 6), NGW = gridDim.x * 8;
    for (int m = gw; m < T; m += NGW) rms_row_to_bf16(x + (size_t)m * D, g, xn + (size_t)m * D, lane);
}
__device__ __forceinline__ void phase_conv(const Params& p) {
    const int tid_ = ltid(); const int lane = tid_ & 63, gw = blockIdx.x * 8 + (tid_ >> 6), NGW = gridDim.x * 8;
    const bf16_t* hh = (const bf16_t*)(p.ws + R_H); bf16_t* v = (bf16_t*)(p.ws + R_XN); const float* cw = p.in[22];
    for (int m = gw; m < T; m += NGW) {
        const int s = m & (S - 1);
#pragma unroll
        for (int j = 0; j < 4; ++j) {
            const int d = 4 * lane + 256 * j;
            float y[4] = {0.f, 0.f, 0.f, 0.f};
#pragma unroll
            for (int w = 0; w < 3; ++w) {
                if (s - 2 + w >= 0) {
                    const bf16_t* r = hh + (size_t)(m - 2 + w) * 3072;
                    const u32x2 c = *(const u32x2*)(r + 1024 + d), u = *(const u32x2*)(r + 2048 + d); const f32x4 cwv = *(const f32x4*)(cw + w * 1024 + d);
                    y[0] += cwv.x * bflo(c.x) * bflo(u.x); y[1] += cwv.y * bfhi(c.x) * bfhi(u.x); y[2] += cwv.z * bflo(c.y) * bflo(u.y); y[3] += cwv.w * bfhi(c.y) * bfhi(u.y);
                }
            }
            const u32x2 bv = *(const u32x2*)(hh + (size_t)m * 3072 + d);
            u32x2 o; o.x = cvtpk(bflo(bv.x) * y[0], bfhi(bv.x) * y[1]); o.y = cvtpk(bflo(bv.y) * y[2], bfhi(bv.y) * y[3]);
            *(u32x2*)(v + (size_t)m * 1024 + d) = o;
        }
    }
}
__device__ __forceinline__ void phase_norm_router(const Params& p, LAS unsigned char* lds) {
    const int tid = ltid(), lane = tid & 63, wave = tid >> 6, gw = blockIdx.x * 8 + wave, NGW = gridDim.x * 8;
    const float* x3 = p.out; const float* g = p.in[24]; bf16_t* xn = (bf16_t*)(p.ws + R_XN);
    LAS float* wr = (LAS float*)lds;
    LAS int* lcnt = (LAS int*)(lds + 32768); LAS int* gb = lcnt + 8;
    int* te = (int*)(p.ws + SM_TE); float* tw = (float*)(p.ws + SM_TW); int* rank = (int*)(p.ws + SM_RANK); int* cnt = (int*)(p.ws + SM_CTL);
    for (int i = tid; i < 8192; i += 512) wr[i] = p.in[25][i];
    if (tid < 8) lcnt[tid] = 0;
    __syncthreads();
    for (int m = gw; m < T; m += NGW) {
        const f32x4* xr = (const f32x4*)(x3 + (size_t)m * D) + lane; const f32x4* gr = (const f32x4*)g + lane;
        f32x4 v[4]; float s = 0.f;
#pragma unroll
        for (int j = 0; j < 4; ++j) { v[j] = xr[64 * j]; s += (v[j].x * v[j].x + v[j].y * v[j].y) + (v[j].z * v[j].z + v[j].w * v[j].w); }
        const float r = rsqrtf(wsum(s) * (1.f / 1024.f) + EPS);
        float lg[8];
#pragma unroll
        for (int e = 0; e < 8; ++e) lg[e] = 0.f;
        u32x2* o8 = (u32x2*)(xn + (size_t)m * D) + lane;
#pragma unroll
        for (int j = 0; j < 4; ++j) { const f32x4 gg = gr[64 * j]; const f32x4 y = {v[j].x * r * gg.x, v[j].y * r * gg.y, v[j].z * r * gg.z, v[j].w * r * gg.w};
            u32x2 w; w.x = cvtpk(y.x, y.y); w.y = cvtpk(y.z, y.w); o8[64 * j] = w;
#pragma unroll
            for (int i = 0; i < 4; ++i) { const int d = 4 * lane + 256 * j + i; const f32x4 w0 = *(const LAS f32x4*)(wr + d * 8), w1 = *(const LAS f32x4*)(wr + d * 8 + 4);
                lg[0] += y[i] * w0.x; lg[1] += y[i] * w0.y; lg[2] += y[i] * w0.z; lg[3] += y[i] * w0.w; lg[4] += y[i] * w1.x; lg[5] += y[i] * w1.y; lg[6] += y[i] * w1.z; lg[7] += y[i] * w1.w; } }
#pragma unroll
        for (int e = 0; e < 8; ++e) lg[e] = wsum(lg[e]) + p.in[26][e];
        int e1 = 0; float l1 = lg[0];
#pragma unroll
        for (int e = 1; e < 8; ++e) if (lg[e] > l1) { l1 = lg[e]; e1 = e; }
        int e2 = -1; float l2 = -3e38f;
#pragma unroll
        for (int e = 0; e < 8; ++e) if (e != e1 && lg[e] > l2) { l2 = lg[e]; e2 = e; }
        if (lane == 0) {
            const float w1 = 1.f / (1.f + __expf(l2 - l1));
            te[m * 2] = e1; te[m * 2 + 1] = e2; tw[m * 2] = w1; tw[m * 2 + 1] = 1.f - w1;
            rank[m * 2] = __hip_atomic_fetch_add(&lcnt[e1], 1, __ATOMIC_RELAXED, __HIP_MEMORY_SCOPE_WORKGROUP); rank[m * 2 + 1] = __hip_atomic_fetch_add(&lcnt[e2], 1, __ATOMIC_RELAXED, __HIP_MEMORY_SCOPE_WORKGROUP);
        }
    }
    __syncthreads();
    if (tid < 8) gb[tid] = atomicAdd(&cnt[tid], lcnt[tid]);
    __syncthreads();
    for (int m = gw; m < T; m += NGW) if (lane < 2) rank[m * 2 + lane] += gb[te[m * 2 + lane]];
}
__device__ __forceinline__ void phase_moe_gather(const Params& p) {
    const int tid = ltid(), lane = tid & 63, gw = blockIdx.x * 8 + (tid >> 6), NGW = gridDim.x * 8;
    const int* cnt = (const int*)(p.ws + SM_CTL); const int* te = (const int*)(p.ws + SM_TE); const float* tw = (const float*)(p.ws + SM_TW); const int* rank = (const int*)(p.ws + SM_RANK);
    int* pos = (int*)(p.ws + SM_POS); float* roww = (float*)(p.ws + SM_ROWW); int* tile_e = (int*)(p.ws + SM_TILEE);
    const bf16_t* xn = (const bf16_t*)(p.ws + R_XN); bf16_t* xs = (bf16_t*)(p.ws + R_XA);
    int off[9]; off[0] = 0;
#pragma unroll
    for (int e = 0; e < 8; ++e) off[e + 1] = off[e] + ((cnt[e] + 255) & ~255);
    if (blockIdx.x == 0) {
        for (int i = tid; i < ROWS_MAX / 256; i += 512) { int e = -1;
#pragma unroll
            for (int k = 0; k < 8; ++k) if (i * 256 >= off[k] && i * 256 < off[k + 1]) e = k;
            tile_e[i] = e < 0 ? 0 : e; }
        if (tid == 0) ((int*)(p.ws + SM_CTL))[8] = off[8];
    }
    if (blockIdx.x < 8 && tid < 256) {
#pragma unroll
        for (int e = 0; e < 8; ++e) if (e == (int)blockIdx.x) { const int c = cnt[e]; if (c + tid < off[e + 1] - off[e]) roww[off[e] + c + tid] = 0.f; }
    }
    for (int pi = gw; pi < 2 * T; pi += NGW) {
        const int e = te[pi]; int o = 0;
#pragma unroll
        for (int k = 0; k < 8; ++k) if (k == e) o = off[k];
        const int r = o + rank[pi];
        if (lane == 0) { pos[pi] = r; roww[r] = tw[pi]; }
        const u32x4* src = (const u32x4*)(xn + (size_t)(pi >> 1) * D); u32x4* dst = (u32x4*)(xs + (size_t)r * D);
        dst[lane] = src[lane]; dst[64 + lane] = src[64 + lane];
    }
}
__device__ __forceinline__ void phase_moe_combine(const Params& p) {
    const int tid_ = ltid(); const int lane = tid_ & 63, gw = blockIdx.x * 8 + (tid_ >> 6), NGW = gridDim.x * 8;
    const int* pos = (const int*)(p.ws + SM_POS); const bf16_t* ym = (const bf16_t*)(p.ws + R_XA);
    for (int m = gw; m < T; m += NGW) {
        const int p0 = pos[m * 2], p1 = pos[m * 2 + 1];
#pragma unroll
        for (int j = 0; j < 4; ++j) {
            const int d = 4 * lane + 256 * j;
            f32x4* o = (f32x4*)(p.out + (size_t)m * D + d); f32x4 x = *o;
            const u32x2 a = *(const u32x2*)(ym + (size_t)p0 * D + d), c = *(const u32x2*)(ym + (size_t)p1 * D + d);
            x.x += bflo(a.x) + bflo(c.x); x.y += bfhi(a.x) + bfhi(c.x); x.z += bflo(a.y) + bflo(c.y); x.w += bfhi(a.y) + bfhi(c.y);
            *o = x;
        }
    }
}

__global__ void __launch_bounds__(512) mega_fwd(Params p) {
    extern __shared__ __attribute__((aligned(16))) unsigned char lds_raw[];
    LAS unsigned char* lds = (LAS unsigned char*)lds_raw;
    cg::grid_group grid = cg::this_grid();
    const int G = gridDim.x, c = blockIdx.x;
    bf16_t* W = (bf16_t*)p.ws;
    bf16_t* xn = (bf16_t*)(p.ws + R_XN);
    float* x1 = (float*)(p.ws + R_XA);
    pg8::StaticOrder SO;
#ifndef PHMASK
#define PHMASK 0xFFFFFFFFu
#endif
#ifndef REPEAT_MASK
#define REPEAT_MASK 0u
#endif
#define PH(k) if (((PHMASK >> (k)) & 1u) && (k) >= p.ph_lo && (k) <= p.ph_hi)
#define RPT(k) if ((REPEAT_MASK >> (k)) & 1u)
    PH(0) phase_p0(p, lds);
    grid.sync();
    RPT(0) { phase_p0(p, lds); grid.sync(); }
    PH(1) {
        pg8::Gemm g{xn, W + W_IN_E / 2, T, 1792, 1024, 1024, nullptr, 0}; SO.init(T, 1792, G, c);
        pg8::EpiBf16<0> E{(bf16_t*)(p.ws + R_H), 1792, nullptr};
        pg8::gemm_phase<pg8::EpiBf16<0>, true>(lds, g, SO, E);
    }
    grid.sync();
    PH(2) phase_p2(p, lds);
    grid.sync();
    RPT(2) { phase_p2(p, lds); grid.sync(); }
    PH(3) {
        const int nCu = 2 * (NB * 512 / 256), Gc = (nCu < G / 2) ? nCu : 0;
        if (Gc == 0 || c < Gc) {
            for (int kv = 0; kv < 2; ++kv) {
                pg8::Gemm g{(const bf16_t*)(p.ws + R_XA + (kv ? A_VCIN : A_KCIN)), W + W_CW1 / 2 + (size_t)kv * 256 * 2048, NB * 512, 256, 2048, 1024, nullptr, 0};
                if (Gc) SO.init(NB * 512, 256, Gc / 2, c - kv * (Gc / 2)); else SO.init(NB * 512, 256, G, c);
                pg8::EpiBf16<2> E{(bf16_t*)(p.ws + SM_HID) + (size_t)kv * NB * 512 * 256, 256, (const float*)(p.ws + SM_B1) + kv * 256};
                if (Gc == 0 || (c / (Gc / 2)) == kv) pg8::gemm_phase<pg8::EpiBf16<2>, true>(lds, g, SO, E);
            }
        }
        if (Gc == 0 || c >= Gc) {
            {
                pg8::Gemm g{(const bf16_t*)(p.ws + R_XA + A_CQN), W + W_UQ / 2, T, 768, 256, 256, nullptr, 0}; SO.init(T, 768, G - Gc, c - Gc);
                pg8::EpiBf16<0> E{(bf16_t*)(p.ws + R_H), 768, nullptr};
                pg8::gemm_phase<pg8::EpiBf16<0>, true>(lds, g, SO, E);
            }
            {
                pg8::Gemm g{(const bf16_t*)(p.ws + R_XA + A_CKVN), W + W_UKV / 2, T, 1024, 128, 128, nullptr, 0}; SO.init(T, 1024, G - Gc, c - Gc);
                pg8::EpiBf16<0> E{(bf16_t*)(p.ws + R_H + (size_t)T * 1536), 1024, nullptr};
                pg8::gemm_phase<pg8::EpiBf16<0>, true>(lds, g, SO, E);
            }
        }
    }
    grid.sync();
    PH(4) phase_p3b(p, lds);
    grid.sync();
    RPT(4) { phase_p3b(p, lds); grid.sync(); }
    PH(5) phase_p4(p, lds);
    grid.sync();
    RPT(5) { phase_p4(p, lds); grid.sync(); }
    PH(6) {
        pg8::Gemm g{xn, W + W_OUT_E / 2, T, 1024, 1024, 1024, nullptr, 0}; SO.init(T, 1024, G, c);
        pg8::EpiResF32 E{p.in[0], x1, 1024};
        pg8::gemm_phase<pg8::EpiResF32, true>(lds, g, SO, E);
    }
    grid.sync();
    PH(7) phase_norm(x1, p.in[16], xn);
    grid.sync();
    RPT(7) { phase_norm(x1, p.in[16], xn); grid.sync(); }
    PH(8) {
        pg8::Gemm g{xn, W + W_GU / 2, T, 5632, 1024, 1024, nullptr, 0}; SO.init(T, 5632, G, c);
        pg8::EpiSwiGLU E{(bf16_t*)(p.ws + R_H), 2816};
        pg8::gemm_phase<pg8::EpiSwiGLU, true>(lds, g, SO, E);
    }
    grid.sync();
    PH(9) {
        pg8::Gemm g{(const bf16_t*)(p.ws + R_H), W + W_D / 2, T, 1024, 2816, 2816, nullptr, 0}; SO.init(T, 1024, G, c);
        pg8::EpiResF32 E{x1, p.out, 1024};
        pg8::gemm_phase<pg8::EpiResF32, true>(lds, g, SO, E);
    }
    grid.sync();
    PH(10) phase_norm(p.out, p.in[20], xn);
    grid.sync();
    PH(11) {
        pg8::Gemm g{xn, W + W_IN_O / 2, T, 3072, 1024, 1024, nullptr, 0}; SO.init(T, 3072, G, c);
        pg8::EpiBf16<0> E{(bf16_t*)(p.ws + R_H), 3072, nullptr};
        pg8::gemm_phase<pg8::EpiBf16<0>, true>(lds, g, SO, E);
    }
    grid.sync();
    PH(12) phase_conv(p);
    grid.sync();
    RPT(12) { phase_conv(p); grid.sync(); }
    PH(13) {
        pg8::Gemm g{xn, W + W_OUT_O / 2, T, 1024, 1024, 1024, nullptr, 0}; SO.init(T, 1024, G, c);
        pg8::EpiResF32 E{p.out, p.out, 1024};
        pg8::gemm_phase<pg8::EpiResF32, true>(lds, g, SO, E);
    }
    grid.sync();
    PH(14) phase_norm_router(p, lds);
    grid.sync();
    PH(15) phase_moe_gather(p);
    grid.sync();
    const int mrows = ((const int*)(p.ws + SM_CTL))[8];
    PH(16) {
        pg8::Gemm g{(const bf16_t*)(p.ws + R_XA), W + W_MGU / 2, mrows, 2816, 1024, 1024, (const int*)(p.ws + SM_TILEE), (size_t)2816 * 1024}; SO.init(mrows, 2816, G, c);
        pg8::EpiSwiGLU E{(bf16_t*)(p.ws + R_H), 1408};
        pg8::gemm_phase<pg8::EpiSwiGLU, true>(lds, g, SO, E);
    }
    grid.sync();
    PH(17) {
        pg8::Gemm g{(const bf16_t*)(p.ws + R_H), W + W_MD / 2, mrows, 1024, 1408, 1408, (const int*)(p.ws + SM_TILEE), (size_t)1024 * 1408}; SO.init(mrows, 1024, G, c);
        pg8::EpiRowScaleBf16 E{(bf16_t*)(p.ws + R_XA), 1024, (const float*)(p.ws + SM_ROWW)};
        pg8::gemm_phase<pg8::EpiRowScaleBf16, true>(lds, g, SO, E);
    }
    grid.sync();
    PH(18) phase_moe_combine(p);
#undef PH
}

inline void launch(void* const* d_in, float* d_out, void* d_ws, size_t ws_size, hipStream_t stream, int ph_lo = 0, int ph_hi = 99, int dbg_branch = -1) {
    static int grid = 0;
    if (grid == 0) {
        int dev = 0, cus = 0, per_cu = 0;
        hipGetDevice(&dev); hipDeviceGetAttribute(&cus, hipDeviceAttributeMultiprocessorCount, dev);
        hipFuncSetAttribute((const void*)mega_fwd, hipFuncAttributeMaxDynamicSharedMemorySize, LDS_BYTES);
        hipOccupancyMaxActiveBlocksPerMultiprocessor(&per_cu, (const void*)mega_fwd, 512, LDS_BYTES);
        if (per_cu < 1) { fprintf(stderr, "occupancy query says %d blocks/CU\n", per_cu); per_cu = 1; }
        grid = cus;
        if (WS_FAST_END > ws_size) { fprintf(stderr, "ws too small: need %zu have %zu\n", (size_t)WS_FAST_END, ws_size); grid = -1; }
    }
    if (grid < 0) return;
    if (ph_lo <= 14 && ph_hi >= 14) hipMemsetAsync((char*)d_ws + SM_CTL, 0, 4096, stream);
    Params p{};
    for (int i = 0; i < 30; ++i) p.in[i] = (const float*)d_in[i];
    p.out = d_out; p.ws = (unsigned char*)d_ws; p.ph_lo = ph_lo; p.ph_hi = ph_hi; p.dbg_branch = dbg_branch;
    void* args[] = {&p};
    hipError_t e = hipLaunchCooperativeKernel((const void*)mega_fwd, dim3(grid), dim3(512), args, LDS_BYTES, stream);
    if (e != hipSuccess) fprintf(stderr, "cooperative launch failed: %s (grid %d)\n", hipGetErrorString(e), grid);
}
}
extern "C" void kernel_launch(void* const* d_in, const int* in_sizes, int n_in, void* d_out, int out_size, void* d_ws, size_t ws_size, hipStream_t stream) {
    fast::launch(d_in, (float*)d_out, d_ws, ws_size, stream);
}
```

```cpp
#include <hip/hip_runtime.h>
#include <hip/hip_bf16.h>
#include <stdint.h>
#include <stdio.h>
#include <string.h>
#include <hip/hip_cooperative_groups.h>
namespace cg = cooperative_groups;
#define NB 8
#define REPEAT_MASK 0x0u
namespace gold {
constexpr int S = 4096, D = 1024, HW = 1720;
constexpr float EPS = 1e-6f;

__device__ const unsigned char T5B[128] = {0, 1, 2, 3, 4, 5, 6, 7, 8, 9, 10, 11, 12, 13, 14, 15, 16, 16, 16, 17, 17, 18, 18, 18, 19, 19, 19, 20, 20, 20, 20, 21, 21, 21, 21, 22, 22, 22, 22, 22, 23, 23, 23, 23, 23, 23, 24, 24, 24, 24, 24, 24, 25, 25, 25, 25, 25, 25, 25, 26, 26, 26, 26, 26, 26, 26, 26, 27, 27, 27, 27, 27, 27, 27, 27, 27, 27, 28, 28, 28, 28, 28, 28, 28, 28, 28, 28, 29, 29, 29, 29, 29, 29, 29, 29, 29, 29, 29, 29, 30, 30, 30, 30, 30, 30, 30, 30, 30, 30, 30, 30, 30, 30, 31, 31, 31, 31, 31, 31, 31, 31, 31, 31, 31, 31, 31, 31};
}
#ifndef NB
#define NB 8
#endif
namespace fast {
#define LAS __attribute__((address_space(3)))
typedef unsigned short bf16_t;
typedef short bf16x8 __attribute__((ext_vector_type(8)));
typedef float f32x4 __attribute__((ext_vector_type(4)));
typedef float f32x2 __attribute__((ext_vector_type(2)));
typedef float f32x16 __attribute__((ext_vector_type(16)));
typedef unsigned u32x4 __attribute__((ext_vector_type(4)));
typedef unsigned u32x2 __attribute__((ext_vector_type(2)));
typedef __bf16 bf16x2_t __attribute__((ext_vector_type(2)));

constexpr int S = 4096, T = NB * S, D = 1024;
constexpr float EPS = 1e-6f, LOG2E = 1.4426950408889634f;

__device__ __forceinline__ unsigned cvtpk(float lo, float hi) { f32x2 v = {lo, hi}; bf16x2_t b = __builtin_convertvector(v, bf16x2_t); return __builtin_bit_cast(unsigned, b); }
__device__ __forceinline__ bf16_t f2bf(float f) { return (bf16_t)(cvtpk(f, 0.f) & 0xffffu); }
__device__ __forceinline__ float bf2f(bf16_t u) { return __builtin_bit_cast(float, (unsigned)u << 16); }
__device__ __forceinline__ float bflo(unsigned u) { return __builtin_bit_cast(float, u << 16); }
__device__ __forceinline__ float bfhi(unsigned u) { return __builtin_bit_cast(float, u & 0xffff0000u); }
__device__ __forceinline__ float wsum(float v) {
#pragma unroll
    for (int o = 1; o < 64; o <<= 1) v += __shfl_xor(v, o);
    return v;
}
__device__ __forceinline__ float fexp2(float x) { return __builtin_amdgcn_exp2f(x); }
__device__ __forceinline__ float frcp(float x) { return __builtin_amdgcn_rcpf(x); }
__device__ __forceinline__ float silu_f(float x) { return x * frcp(1.f + fexp2(-x * LOG2E)); }
__device__ __forceinline__ float gelu_tanh_f(float x) {
    const float u = 0.7978845608028654f * (x + 0.044715f * x * x * x);
    return x * frcp(1.f + fexp2(-2.f * LOG2E * u));
}

namespace pg8 {
constexpr int BM = 256, BK = 64, HALF = 128, HTB = HALF * BK * 2, STAGE_BYTES = 8 * HTB, NXCD = 8, WGM = 8;
__host__ __device__ __forceinline__ int lds_byte(int r, int c) { const int st = (r >> 4) * 2 + (c >> 5), rr = r & 15, cc = c & 31, ob = rr * 64 + cc * 2; return st * 1024 + (ob ^ (((ob >> 9) & 1) << 5)); }
__host__ __device__ __forceinline__ void stage_rc(int b, int& R, int& C) { const int st = b / 1024, sb = b % 1024, swz = sb ^ (((sb >> 9) & 1) << 5); R = (st >> 1) * 16 + swz / 64; C = (st & 1) * 32 + (swz % 64) / 2; }
__host__ __device__ __forceinline__ int perm32(int rho) { const int n = rho >> 4, i = rho & 15; return 8 * (i >> 2) + 4 * n + (i & 3); }

struct Unit { int pm, pn; };
struct Gemm { const bf16_t* A; const bf16_t* Bt; int M, N, K, lda; const int* tile_e; size_t estride; };

struct StaticOrder {
    int nM, nN, nwg, G, c;
    __device__ void init(int M, int N, int G_, int c_) { nM = M / BM; nN = N / BM; nwg = nM * nN; G = G_; c = c_; }
    __device__ bool next(int i, Unit& u) const {
        const long L = (long)i * G + c; if (L >= nwg) return false;
        int wgid = (int)L; { const int q = nwg / NXCD, r = nwg % NXCD, xcd = wgid % NXCD, off = wgid / NXCD; wgid = (xcd < r ? xcd * (q + 1) : r * (q + 1) + (xcd - r) * q) + off; }
        const int nig = WGM * nN, gid = wgid / nig, fm = gid * WGM, gsz = (nM - fm) < WGM ? (nM - fm) : WGM;
        u.pm = fm + ((wgid % nig) % gsz); u.pn = (wgid % nig) / gsz; return true;
    }
};

template <class Epi, bool ALIGN_EPI>
__device__ __forceinline__ void gemm_phase(LAS unsigned char* lds, const Gemm g, const StaticOrder& S, const Epi& E) {
    int tid = threadIdx.x; asm volatile("" : "+v"(tid));
    const int wid = __builtin_amdgcn_readfirstlane(tid >> 6), lane = tid & 63, wr = wid >> 2, wc = wid & 3, fr = lane & 15, fq = lane >> 4;
    const int K = g.K, nt = K / BK, lda = g.lda;
    unsigned voffA[2], voffB[2];
#pragma unroll
    for (int i = 0; i < 2; ++i) { int R, C; stage_rc(tid * 16 + i * 8192, R, C); const int Rb = Epi::PERM ? ((R & ~31) + perm32(R & 31)) : R;
        voffA[i] = (unsigned)(R * lda + C) * 2u; voffB[i] = (unsigned)(Rb * K + C) * 2u; }
    const size_t kstep = (size_t)(BK * 2);
    const size_t hsA = (size_t)HALF * lda * 2, tsA = 2 * hsA, hsB = (size_t)HALF * K * 2, tsB = 2 * hsB;
    const unsigned ldsw = (unsigned)wid * 1024u;
    const int aoff = lds_byte(wr * 64 + fr, fq * 8), boff = lds_byte(wc * 32 + fr, fq * 8);
#define PG8_SA(b, h) (((b) * 2 + (h)) * HTB)
#define PG8_SB(b, h) ((4 + (b) * 2 + (h)) * HTB)
#define PG8_STAGE(bufoff, gbase, voff) do { _Pragma("unroll") for (int _i = 0; _i < 2; ++_i) \
        __builtin_amdgcn_global_load_lds((const unsigned*)((const char*)(gbase) + (voff)[_i]), (LAS unsigned*)(lds + (bufoff) + ldsw + _i * 8192), 16, 0, 0); } while (0)
#define PG8_LDA(dst, b, h) do { _Pragma("unroll") for (int m = 0; m < 4; ++m) _Pragma("unroll") for (int k = 0; k < 2; ++k) dst[m][k] = *(const LAS bf16x8*)(lds + PG8_SA(b, h) + aoff + m * 2048 + k * 1024); } while (0)
#define PG8_LDB(dst, b, h) do { _Pragma("unroll") for (int n = 0; n < 2; ++n) _Pragma("unroll") for (int k = 0; k < 2; ++k) dst[n][k] = *(const LAS bf16x8*)(lds + PG8_SB(b, h) + boff + n * 2048 + k * 1024); } while (0)
#define PG8_MMA(ai, bj, At, Bt) do { __builtin_amdgcn_s_setprio(1); _Pragma("unroll") for (int m = 0; m < 4; ++m) _Pragma("unroll") for (int n = 0; n < 2; ++n) _Pragma("unroll") for (int k = 0; k < 2; ++k) \
        acc[ai][bj][m][n] = __builtin_amdgcn_mfma_f32_16x16x32_bf16(Bt[n][k], At[m][k], acc[ai][bj][m][n], 0, 0, 0); __builtin_amdgcn_s_setprio(0); } while (0)
#define PG8_WAIT_V(n) asm volatile("s_waitcnt vmcnt(" #n ")" ::: "memory")
#define PG8_WAIT_L(n) asm volatile("s_waitcnt lgkmcnt(" #n ")" ::: "memory")
#define PG8_BAR __builtin_amdgcn_s_barrier()
#define PG8_SCHED __builtin_amdgcn_sched_barrier(0)
#define PG8_EOFF(pm_) (g.tile_e ? (size_t)g.tile_e[pm_] * g.estride * 2 : (size_t)0)
    Unit cur, nxt; int ui = 0;
    if (!S.next(0, cur)) return;
    f32x4 acc[2][2][4][2];
#pragma unroll
    for (int a = 0; a < 2; ++a)
#pragma unroll
        for (int b = 0; b < 2; ++b)
#pragma unroll
            for (int m = 0; m < 4; ++m)
#pragma unroll
                for (int n = 0; n < 2; ++n) acc[a][b][m][n] = (f32x4){0.f, 0.f, 0.f, 0.f};
    bf16x8 At[4][2], B0[2][2], B1[2][2];
    const char* cA = (const char*)g.A + (size_t)cur.pm * tsA; const char* cB = (const char*)g.Bt + PG8_EOFF(cur.pm) + (size_t)cur.pn * tsB;
    PG8_STAGE(PG8_SB(0, 0), cB, voffB); PG8_STAGE(PG8_SB(0, 1), cB + hsB, voffB); PG8_STAGE(PG8_SA(0, 0), cA, voffA); PG8_STAGE(PG8_SA(0, 1), cA + hsA, voffA);
    if (wr == 1) PG8_BAR;
    PG8_WAIT_V(2); PG8_BAR;
    PG8_STAGE(PG8_SB(1, 0), cB + kstep, voffB); PG8_STAGE(PG8_SA(1, 0), cA + kstep, voffA); PG8_STAGE(PG8_SB(1, 1), cB + hsB + kstep, voffB);
    PG8_WAIT_V(6); PG8_BAR;
    for (;;) {
        const bool has_next = S.next(ui + 1, nxt);
        const char* nA = has_next ? (const char*)g.A + (size_t)nxt.pm * tsA : cA;
        const char* nB = has_next ? (const char*)g.Bt + PG8_EOFF(nxt.pm) + (size_t)nxt.pn * tsB : cB;
        for (int t = 0; t < nt; t += 2) {
            const bool last = (t == nt - 2);
            const char* a1 = cA + (size_t)(t + 1) * kstep;
            const char* a2 = last ? nA : cA + (size_t)(t + 2) * kstep; const char* b2 = last ? nB : cB + (size_t)(t + 2) * kstep;
            const char* a3 = a2 + kstep; const char* b3 = b2 + kstep;
            PG8_LDB(B0, 0, 0); PG8_LDB(B1, 0, 1); PG8_SCHED; PG8_LDA(At, 0, 0); PG8_STAGE(PG8_SA(1, 1), a1 + hsA, voffA);
            PG8_WAIT_V(8); PG8_WAIT_L(0); PG8_BAR; PG8_MMA(0, 0, At, B0); PG8_MMA(0, 1, At, B1); PG8_BAR; PG8_SCHED;
            PG8_LDA(At, 0, 1); PG8_STAGE(PG8_SB(0, 0), b2, voffB); PG8_STAGE(PG8_SB(0, 1), b2 + hsB, voffB); PG8_STAGE(PG8_SA(0, 0), a2, voffA);
            PG8_WAIT_V(8); PG8_WAIT_L(0); PG8_BAR; PG8_MMA(1, 0, At, B0); PG8_MMA(1, 1, At, B1); PG8_BAR; PG8_SCHED;
            PG8_LDB(B0, 1, 0); PG8_LDB(B1, 1, 1); PG8_SCHED; PG8_LDA(At, 1, 0); PG8_STAGE(PG8_SA(0, 1), a2 + hsA, voffA);
            PG8_WAIT_V(8); PG8_WAIT_L(0); PG8_BAR; PG8_MMA(0, 0, At, B0); PG8_MMA(0, 1, At, B1); PG8_BAR; PG8_SCHED;
            PG8_LDA(At, 1, 1); PG8_STAGE(PG8_SB(1, 0), b3, voffB); PG8_STAGE(PG8_SB(1, 1), b3 + hsB, voffB); PG8_STAGE(PG8_SA(1, 0), a3, voffA);
            PG8_WAIT_V(8); PG8_WAIT_L(0); PG8_BAR; PG8_MMA(1, 0, At, B0); PG8_MMA(1, 1, At, B1); PG8_BAR; PG8_SCHED;
        }
        if constexpr (ALIGN_EPI) { if (wr == 0) PG8_BAR; }
        E(acc, cur, wr, wc, fr, fq);
        if (!has_next) break;
#pragma unroll
        for (int a = 0; a < 2; ++a)
#pragma unroll
            for (int b = 0; b < 2; ++b)
#pragma unroll
                for (int m = 0; m < 4; ++m)
#pragma unroll
                    for (int n = 0; n < 2; ++n) acc[a][b][m][n] = (f32x4){0.f, 0.f, 0.f, 0.f};
        cur = nxt; cA = nA; cB = nB; ++ui;
        if constexpr (ALIGN_EPI) { if (wr == 1) PG8_BAR; }
    }
    PG8_WAIT_V(0);
    if constexpr (!ALIGN_EPI) { if (wr == 0) PG8_BAR; }
    PG8_BAR;
#undef PG8_SA
#undef PG8_SB
#undef PG8_STAGE
#undef PG8_LDA
#undef PG8_LDB
#undef PG8_MMA
#undef PG8_WAIT_V
#undef PG8_WAIT_L
#undef PG8_BAR
#undef PG8_SCHED
#undef PG8_EOFF
}

template <int ACT> struct EpiBf16 {
    static constexpr bool PERM = true;
    bf16_t* O; int ldc; const float* bias;
    __device__ __forceinline__ void operator()(const f32x4 (&acc)[2][2][4][2], const Unit& u, int wr, int wc, int fr, int fq) const {
        const int row0 = u.pm * BM + wr * 64 + fr, col0 = u.pn * BM + wc * 32 + 8 * fq;
        f32x4 bv[2][2];
#pragma unroll
        for (int bj = 0; bj < 2; ++bj)
#pragma unroll
            for (int n = 0; n < 2; ++n) bv[bj][n] = bias ? *(const f32x4*)(bias + col0 + bj * HALF + 4 * n) : (f32x4){0.f, 0.f, 0.f, 0.f};
#pragma unroll
        for (int ai = 0; ai < 2; ++ai)
#pragma unroll
            for (int m = 0; m < 4; ++m) { bf16_t* rowp = O + (size_t)(row0 + ai * HALF + m * 16) * ldc + col0;
#pragma unroll
                for (int bj = 0; bj < 2; ++bj) { f32x4 v0 = acc[ai][bj][m][0] + bv[bj][0], v1 = acc[ai][bj][m][1] + bv[bj][1];
                    if (ACT == 2) {
#pragma unroll
                        for (int i = 0; i < 4; ++i) { v0[i] = gelu_tanh_f(v0[i]); v1[i] = gelu_tanh_f(v1[i]); } }
                    u32x4 w; w.x = cvtpk(v0[0], v0[1]); w.y = cvtpk(v0[2], v0[3]); w.z = cvtpk(v1[0], v1[1]); w.w = cvtpk(v1[2], v1[3]);
                    *(u32x4*)(rowp + bj * HALF) = w; } }
    }
};
struct EpiResF32 {
    static constexpr bool PERM = false;
    const float* base; float* out; int ldc;
    __device__ __forceinline__ void operator()(const f32x4 (&acc)[2][2][4][2], const Unit& u, int wr, int wc, int fr, int fq) const {
        const int col0 = u.pn * BM + wc * 32 + 4 * fq;
#pragma unroll
        for (int ai = 0; ai < 2; ++ai)
#pragma unroll
            for (int m = 0; m < 4; ++m) { const size_t off = (size_t)(u.pm * BM + ai * HALF + wr * 64 + m * 16 + fr) * ldc + col0;
#pragma unroll
                for (int bj = 0; bj < 2; ++bj)
#pragma unroll
                    for (int n = 0; n < 2; ++n) { const f32x4 bs = *(const f32x4*)(base + off + bj * HALF + n * 16); *(f32x4*)(out + off + bj * HALF + n * 16) = bs + acc[ai][bj][m][n]; } }
    }
};
struct EpiSwiGLU {
    static constexpr bool PERM = true;
    bf16_t* O; int ldc;
    __device__ __forceinline__ void operator()(const f32x4 (&acc)[2][2][4][2], const Unit& u, int wr, int wc, int fr, int fq) const {
        const int row0 = u.pm * BM + wr * 64 + fr, col0 = u.pn * HALF + wc * 32 + 8 * fq;
#pragma unroll
        for (int ai = 0; ai < 2; ++ai)
#pragma unroll
            for (int m = 0; m < 4; ++m) { bf16_t* rowp = O + (size_t)(row0 + ai * HALF + m * 16) * ldc + col0;
                float h[8];
#pragma unroll
                for (int n = 0; n < 2; ++n)
#pragma unroll
                    for (int i = 0; i < 4; ++i) h[n * 4 + i] = silu_f(acc[ai][0][m][n][i]) * acc[ai][1][m][n][i];
                u32x4 w; w.x = cvtpk(h[0], h[1]); w.y = cvtpk(h[2], h[3]); w.z = cvtpk(h[4], h[5]); w.w = cvtpk(h[6], h[7]);
                *(u32x4*)rowp = w; }
    }
};
struct EpiRowScaleBf16 {
    static constexpr bool PERM = true;
    bf16_t* O; int ldc; const float* roww;
    __device__ __forceinline__ void operator()(const f32x4 (&acc)[2][2][4][2], const Unit& u, int wr, int wc, int fr, int fq) const {
        const int row0 = u.pm * BM + wr * 64 + fr, col0 = u.pn * BM + wc * 32 + 8 * fq;
#pragma unroll
        for (int ai = 0; ai < 2; ++ai)
#pragma unroll
            for (int m = 0; m < 4; ++m) { const int row = row0 + ai * HALF + m * 16; const float sc = roww[row]; bf16_t* rowp = O + (size_t)row * ldc + col0;
#pragma unroll
                for (int bj = 0; bj < 2; ++bj) { const f32x4 v0 = acc[ai][bj][m][0] * sc, v1 = acc[ai][bj][m][1] * sc;
                    u32x4 w; w.x = cvtpk(v0[0], v0[1]); w.y = cvtpk(v0[2], v0[3]); w.z = cvtpk(v1[0], v1[1]); w.w = cvtpk(v1[2], v1[3]);
                    *(u32x4*)(rowp + bj * HALF) = w; } }
    }
};
}
constexpr int ROWS_MAX = 2 * T + 8 * 256;
constexpr size_t al256(size_t x) { return (x + 255) & ~(size_t)255; }
constexpr size_t W_IN_E = 0;
constexpr size_t W_CW1 = W_IN_E + (size_t)1792 * 1024 * 2;
constexpr size_t W_UQ = W_CW1 + (size_t)2 * 256 * 2048 * 2;
constexpr size_t W_UKV = W_UQ + (size_t)1024 * 256 * 2;
constexpr size_t W_OUT_E = W_UKV + (size_t)1024 * 128 * 2;
constexpr size_t W_GU = W_OUT_E + (size_t)1024 * 1024 * 2;
constexpr size_t W_D = W_GU + (size_t)5632 * 1024 * 2;
constexpr size_t W_IN_O = W_D + (size_t)1024 * 2816 * 2;
constexpr size_t W_OUT_O = W_IN_O + (size_t)3072 * 1024 * 2;
constexpr size_t W_MGU = W_OUT_O + (size_t)1024 * 1024 * 2;
constexpr size_t W_MD = W_MGU + (size_t)8 * 2816 * 1024 * 2;
constexpr size_t W_END = W_MD + (size_t)8 * 1024 * 1408 * 2;
constexpr size_t SM_CTL = al256(W_END);
constexpr size_t SM_BAR = SM_CTL + 4096;
constexpr size_t SM_B1P = SM_BAR + 16384;
constexpr size_t SM_B1 = SM_B1P + 32 * 512 * 4;
constexpr size_t SM_ROPE = SM_B1 + 512 * 4;
constexpr size_t SM_BL = SM_ROPE + (size_t)S * 32 * 4;
constexpr size_t SM_HID = SM_BL + 8 * 132 * 4;
constexpr size_t SM_KC = SM_HID + (size_t)2 * NB * 512 * 256 * 2;
constexpr size_t SM_VCT = SM_KC + (size_t)NB * 512 * 64 * 2;
constexpr size_t SM_TE = SM_VCT + (size_t)NB * 512 * 64 * 2;
constexpr size_t SM_TW = SM_TE + (size_t)T * 8;
constexpr size_t SM_RANK = SM_TW + (size_t)T * 8;
constexpr size_t SM_POS = SM_RANK + (size_t)T * 8;
constexpr size_t SM_ROWW = SM_POS + (size_t)T * 8;
constexpr size_t SM_TILEE = SM_ROWW + (size_t)ROWS_MAX * 4;
constexpr size_t SM_END = SM_TILEE + (size_t)(ROWS_MAX / 256 + 8) * 4;
constexpr size_t R_XA = al256(SM_END);
constexpr size_t SZ_XA = (size_t)T * 4096 + (size_t)4 * 1048576;
constexpr size_t R_XN = R_XA + SZ_XA;
constexpr size_t SZ_XN = (size_t)T * 2048;
constexpr size_t R_H = R_XN + SZ_XN;
constexpr size_t SZ_H = ((size_t)T * 6144 > (size_t)ROWS_MAX * 2816) ? (size_t)T * 6144 : (size_t)ROWS_MAX * 2816;
constexpr size_t WS_FAST_END = R_H + SZ_H;
constexpr size_t A_QN = 0;
constexpr size_t A_KSN = A_QN + (size_t)T * 1024;
constexpr size_t A_KWN = A_KSN + (size_t)T * 256;
constexpr size_t A_VST = A_KWN + (size_t)T * 256;
constexpr size_t A_VWT = A_VST + (size_t)T * 256;
constexpr size_t A_KCIN = A_VWT + (size_t)T * 256;
constexpr size_t A_VCIN = A_KCIN + (size_t)T * 256 + 2048;
constexpr size_t A_CQN = A_VCIN + (size_t)T * 256 + 2048;
constexpr size_t A_CKVN = A_CQN + (size_t)T * 512;
constexpr size_t A_KROPE = A_CKVN + (size_t)T * 256;
constexpr size_t A_GATES = A_KROPE + (size_t)T * 64;
constexpr size_t A_END = A_GATES + (size_t)T * 96;
static_assert(A_END <= SZ_XA, "attention inputs fit R_XA");
constexpr size_t O_QM = 0;
constexpr size_t O_KM = O_QM + (size_t)T * 1536;
constexpr size_t O_VMT = O_KM + (size_t)T * 1536;
static_assert(O_VMT + (size_t)T * 1024 <= (size_t)T * 4096, "d_out scratch");

struct Params {
    const float* in[30];
    float* out;
    unsigned char* ws;
    int ph_lo, ph_hi, dbg_branch, pad_;
};

constexpr int LDS_BYTES = 147456;

__device__ __forceinline__ int ltid() { int t = threadIdx.x; asm volatile("" : "+v"(t)); return t; }
__device__ __forceinline__ int perm16(int k) { return (k & ~12) | ((k & 4) << 1) | ((k & 8) >> 1); }

struct WDesc { int in_idx, K, N, rep, map, row_off; size_t src_stride, dst_off, dst_stride; };
__device__ const WDesc WDESC[12] = {
    {3, 1024, 1720, 1, 2, 0, 0, W_IN_E / 2, 0},
    {7, 2048, 256, 2, 0, 0, (size_t)2048 * 256, W_CW1 / 2, (size_t)256 * 2048},
    {11, 256, 768, 1, 3, 0, 0, W_UQ / 2, 0},
    {12, 128, 1024, 1, 0, 0, 0, W_UKV / 2, 0},
    {15, 1024, 1024, 1, 0, 0, 0, W_OUT_E / 2, 0},
    {17, 1024, 2816, 1, 1, 0, 0, W_GU / 2, 0},
    {18, 1024, 2816, 1, 1, 128, 0, W_GU / 2, 0},
    {19, 2816, 1024, 1, 0, 0, 0, W_D / 2, 0},
    {21, 1024, 3072, 1, 0, 0, 0, W_IN_O / 2, 0},
    {23, 1024, 1024, 1, 0, 0, 0, W_OUT_O / 2, 0},
    {27, 1024, 1408, 8, 1, 0, (size_t)1024 * 1408, W_MGU / 2, (size_t)2816 * 1024},
    {28, 1024, 1408, 8, 1, 128, (size_t)1024 * 1408, W_MGU / 2, (size_t)2816 * 1024},
};
__device__ const WDesc WDESC_MD = {29, 1408, 1024, 8, 0, 0, (size_t)1408 * 1024, W_MD / 2, (size_t)1024 * 1408};

__device__ __forceinline__ void transpose_item(const float* W, int K, int N, bf16_t* WT, int map, int row_off, LAS float* scr, int item, int lane) {
    const int nblk = (N + 31) / 32, kb = item / nblk, nb = item % nblk, k0 = 64 * kb, n0 = 32 * nb;
    const int n4 = (lane & 7) * 4; const bool nok = (n0 + n4) < N;
    f32x4 v[8];
#pragma unroll
    for (int i = 0; i < 8; ++i) { const int kk = (lane >> 3) + 8 * i; v[i] = nok ? *(const f32x4*)(W + (size_t)(k0 + kk) * N + n0 + n4) : (f32x4){0.f, 0.f, 0.f, 0.f}; }
#pragma unroll
    for (int i = 0; i < 8; ++i) { const int kk = (lane >> 3) + 8 * i; LAS float* d = scr + kk * 33 + n4; d[0] = v[i].x; d[1] = v[i].y; d[2] = v[i].z; d[3] = v[i].w; }
    asm volatile("s_waitcnt lgkmcnt(0)" ::: "memory");
    const int c = lane & 7;
#pragma unroll
    for (int j = 0; j < 4; ++j) { const int n = (lane >> 3) + 8 * j; const LAS float* s = scr + (8 * c) * 33 + n;
        u32x4 o; o.x = cvtpk(s[0 * 33], s[1 * 33]); o.y = cvtpk(s[2 * 33], s[3 * 33]); o.z = cvtpk(s[4 * 33], s[5 * 33]); o.w = cvtpk(s[6 * 33], s[7 * 33]);
        const int nn = n0 + n;
        if (nn < N) { const int row = (map == 1) ? (256 * (nn >> 7) + (nn & 127) + row_off) : (map == 2) ? (nn < 1280 ? nn : (nn < 1304 ? nn + 416 : nn - 24)) : (map == 3) ? ((nn / 96) * 128 + nn % 96) : (nn + row_off);
            *(u32x4*)(WT + (size_t)row * K + k0 + 8 * c) = o; } }
    asm volatile("s_waitcnt lgkmcnt(0)" ::: "memory");
}
__device__ __forceinline__ void do_wdesc(const Params& p, const WDesc& d, int it, LAS float* scr, int lane) {
    const int per = (d.K / 64) * ((d.N + 31) / 32); const int r = it / per, ii = it % per;
    transpose_item(p.in[d.in_idx] + (size_t)r * d.src_stride, d.K, d.N, (bf16_t*)p.ws + d.dst_off + (size_t)r * d.dst_stride, d.map, d.row_off, scr, ii, lane);
}
__device__ __forceinline__ void rms_row_to_bf16(const float* xrow, const float* g, bf16_t* orow, int lane) {
    const f32x4* xr = (const f32x4*)xrow + lane; const f32x4* gr = (const f32x4*)g + lane;
    f32x4 v[4]; float s = 0.f;
#pragma unroll
    for (int j = 0; j < 4; ++j) { v[j] = xr[64 * j]; s += (v[j].x * v[j].x + v[j].y * v[j].y) + (v[j].z * v[j].z + v[j].w * v[j].w); }
    const float r = rsqrtf(wsum(s) * (1.f / 1024.f) + EPS);
    u32x2* o8 = (u32x2*)orow + lane;
#pragma unroll
    for (int j = 0; j < 4; ++j) { const f32x4 gg = gr[64 * j]; u32x2 w; w.x = cvtpk(v[j].x * r * gg.x, v[j].y * r * gg.y); w.y = cvtpk(v[j].z * r * gg.z, v[j].w * r * gg.w); o8[64 * j] = w; }
}
__device__ __forceinline__ void phase_p0(const Params& p, LAS unsigned char* lds) {
    const int tid = ltid(), lane = tid & 63, wave = tid >> 6;
    const int gw = blockIdx.x * 8 + wave, NGW = gridDim.x * 8;
    LAS float* scr = (LAS float*)(lds + wave * 16384);
    int base = 0;
#pragma unroll 1
    for (int d = 0; d < 13; ++d) {
        const WDesc& wd = (d < 12) ? WDESC[d] : WDESC_MD;
        const int n_it = wd.rep * (wd.K / 64) * ((wd.N + 31) / 32);
        int first = (gw - (base % NGW) + NGW) % NGW;
        for (int it = first; it < n_it; it += NGW) do_wdesc(p, wd, it, scr, lane);
        base += n_it;
    }
    bf16_t* xn = (bf16_t*)(p.ws + R_XN);
    for (int m = gw; m < T; m += 2 * NGW) { rms_row_to_bf16(p.in[0] + (size_t)m * D, p.in[2], xn + (size_t)m * D, lane); if (m + NGW < T) rms_row_to_bf16(p.in[0] + (size_t)(m + NGW) * D, p.in[2], xn + (size_t)(m + NGW) * D, lane); }
    for (int u = gw; u < 256; u += NGW) {
        const int kc = u >> 3, kv = (u >> 2) & 1, nb = u & 3; float s = 0.f;
        const float* pos = p.in[6] + kv * 2048 + kc * 64; const float* w1 = p.in[7] + ((size_t)kv * 2048 + kc * 64) * 256 + nb * 64 + lane;
#pragma unroll 8
        for (int k = 0; k < 64; ++k) s += pos[k] * w1[(size_t)k * 256];
        ((float*)(p.ws + SM_B1P))[kc * 512 + kv * 256 + nb * 64 + lane] = s;
    }
    for (int i = blockIdx.x * 512 + tid; i < S * 16; i += gridDim.x * 512) {
        const int t = i >> 4, f = i & 15; const float ang = (float)t * powf(10000.f, -(float)f / 16.f);
        float* rp = (float*)(p.ws + SM_ROPE) + t * 32; rp[f] = cosf(ang); rp[16 + f] = sinf(ang);
    }
    if (blockIdx.x == 0) for (int i = tid; i < 8 * 129; i += 512) { const int h = i / 129, dd = i % 129; ((float*)(p.ws + SM_BL))[h * 132 + dd] = p.in[1][(dd < 128 ? (int)gold::T5B[dd] : 31) * 8 + h] * LOG2E; }
}

__device__ __forceinline__ void unpack8(const u32x4 v, float (&x)[8]) { x[0] = bflo(v.x); x[1] = bfhi(v.x); x[2] = bflo(v.y); x[3] = bfhi(v.y); x[4] = bflo(v.z); x[5] = bfhi(v.z); x[6] = bflo(v.w); x[7] = bfhi(v.w); }
__device__ __forceinline__ u32x4 pack8(const float (&x)[8]) { u32x4 w; w.x = cvtpk(x[0], x[1]); w.y = cvtpk(x[2], x[3]); w.z = cvtpk(x[4], x[5]); w.w = cvtpk(x[6], x[7]); return w; }
__device__ __forceinline__ float ss8f(const float (&x)[8]) { return ((x[0] * x[0] + x[1] * x[1]) + (x[2] * x[2] + x[3] * x[3])) + ((x[4] * x[4] + x[5] * x[5]) + (x[6] * x[6] + x[7] * x[7])); }
__device__ __forceinline__ void load8f(const float* g, float (&x)[8], float sc) { const f32x4 a = *(const f32x4*)g, b = *(const f32x4*)(g + 4); x[0] = a.x * sc; x[1] = a.y * sc; x[2] = a.z * sc; x[3] = a.w * sc; x[4] = b.x * sc; x[5] = b.y * sc; x[6] = b.z * sc; x[7] = b.w * sc; }
__device__ __forceinline__ void phase_p2(const Params& p, LAS unsigned char* lds) {
    const int tid = ltid(), lane = tid & 63, wave = tid >> 6;
    const bf16_t* hb = (const bf16_t*)(p.ws + R_H);
    unsigned char* xa = p.ws + R_XA;
    bf16_t* qn = (bf16_t*)(xa + A_QN); bf16_t* ksn = (bf16_t*)(xa + A_KSN); bf16_t* kwn = (bf16_t*)(xa + A_KWN);
    bf16_t* vst = (bf16_t*)(xa + A_VST); bf16_t* vwt = (bf16_t*)(xa + A_VWT); bf16_t* kcin = (bf16_t*)(xa + A_KCIN); bf16_t* vcin = (bf16_t*)(xa + A_VCIN);
    bf16_t* cqn = (bf16_t*)(xa + A_CQN); bf16_t* ckvn = (bf16_t*)(xa + A_CKVN); bf16_t* krope = (bf16_t*)(xa + A_KROPE); float* gates = (float*)(xa + A_GATES);
    LAS bf16_t* vs = (LAS bf16_t*)lds;
    if (blockIdx.x == 0) {
        { float s = 0.f; for (int k = 0; k < 32; ++k) s += ((const float*)(p.ws + SM_B1P))[k * 512 + tid]; ((float*)(p.ws + SM_B1))[tid] = s; }
        for (int i = tid; i < 1024; i += 512) { kcin[(size_t)T * 128 + i] = 0; vcin[(size_t)T * 128 + i] = 0; }
    }
    const int c8 = (lane & 7) * 8, seg = lane >> 3;
    float qg[8], ksg[8], kwg[8], cqg[8], ckvg[8];
    load8f(p.in[4] + c8, qg, 0.125f * LOG2E); load8f(p.in[5] + 64 + c8, ksg, 1.f); load8f(p.in[5] + 128 + c8, kwg, 1.f);
    load8f(p.in[9] + (lane & 31) * 8, cqg, 1.f); load8f(p.in[10] + (lane & 15) * 8, ckvg, 1.f);
    for (int tile = blockIdx.x; tile < T / 64; tile += gridDim.x) {
        const int b = tile / (S / 64), s0 = (tile % (S / 64)) * 64;
#pragma unroll 2
        for (int tt = 0; tt < 8; ++tt) {
            const int sl = wave * 8 + tt, s = s0 + sl; const size_t t = (size_t)b * S + s;
            const bf16_t* hr = hb + t * 1792 + lane * 8;
            const u32x4 L0 = *(const u32x4*)hr, L1 = *(const u32x4*)(hr + 512), L2 = *(const u32x4*)(hr + 1024);
            u32x4 L3 = {0u, 0u, 0u, 0u}; if (lane < 32) L3 = *(const u32x4*)(hr + 1536);
            float x0[8], x1[8], x2[8], x3[8];
            unpack8(L0, x0); unpack8(L1, x1); unpack8(L2, x2); unpack8(L3, x3);
            float a0 = ss8f(x0), a1 = ss8f(x1), a2 = ss8f(x2), a3 = ss8f(x3);
#pragma unroll
            for (int o = 1; o < 8; o <<= 1) { a0 += __shfl_xor(a0, o); a1 += __shfl_xor(a1, o); a2 += __shfl_xor(a2, o); a3 += __shfl_xor(a3, o); }
            float a2w = a2 + __shfl_xor(a2, 8); a2w += __shfl_xor(a2w, 16);
            const float a3w = a3 + __shfl_xor(a3, 8);
            const int pp = (sl & ~15) | perm16(sl & 15);
            {
                const float r = rsqrtf(a0 * (1.f / 64.f) + EPS); float y[8];
#pragma unroll
                for (int j = 0; j < 8; ++j) y[j] = x0[j] * r * qg[j];
                *(u32x4*)(qn + t * 512 + lane * 8) = pack8(y);
            }
            {
                const int g = seg & 1; const size_t gm = (((size_t)b * 2 + g) * S + s) * 64 + c8;
                if (seg < 2) *(u32x4*)(kcin + gm) = L1;
                else if (seg < 4) *(u32x4*)(vcin + gm) = L1;
                else if (seg < 6) { const float r = rsqrtf(a1 * (1.f / 64.f) + EPS); float y[8];
#pragma unroll
                    for (int j = 0; j < 8; ++j) y[j] = x1[j] * r * ksg[j];
                    *(u32x4*)(ksn + gm) = pack8(y); }
                else {
#pragma unroll
                    for (int j = 0; j < 8; ++j) vs[((0 + g) * 64 + c8 + j) * 72 + pp] = (bf16_t)((j & 1) ? (L1[j >> 1] >> 16) : (L1[j >> 1] & 0xffffu)); }
            }
            {
                const int g = seg & 1; const size_t gm = (((size_t)b * 2 + g) * S + s) * 64 + c8;
                if (seg < 2) { const float r = rsqrtf(a2 * (1.f / 64.f) + EPS); float y[8];
#pragma unroll
                    for (int j = 0; j < 8; ++j) y[j] = x2[j] * r * kwg[j];
                    *(u32x4*)(kwn + gm) = pack8(y); }
                else if (seg < 4) {
#pragma unroll
                    for (int j = 0; j < 8; ++j) vs[((2 + g) * 64 + c8 + j) * 72 + pp] = (bf16_t)((j & 1) ? (L2[j >> 1] >> 16) : (L2[j >> 1] & 0xffffu)); }
                else { const float r = rsqrtf(a2w * (1.f / 256.f) + EPS); float y[8];
#pragma unroll
                    for (int j = 0; j < 8; ++j) y[j] = x2[j] * r * cqg[j];
                    *(u32x4*)(cqn + t * 256 + (lane - 32) * 8) = pack8(y); }
            }
            {
                if (lane < 16) { const float r = rsqrtf(a3w * (1.f / 128.f) + EPS); float y[8];
#pragma unroll
                    for (int j = 0; j < 8; ++j) y[j] = x3[j] * r * ckvg[j];
                    *(u32x4*)(ckvn + t * 128 + lane * 8) = pack8(y); }
                else if (lane < 20) *(u32x4*)(krope + t * 32 + (lane - 16) * 8) = L3;
                else if (lane < 23) { float y[8];
#pragma unroll
                    for (int j = 0; j < 8; ++j) y[j] = frcp(1.f + fexp2(-x3[j] * LOG2E));
                    float* gp = gates + t * 24 + (lane - 20) * 8; *(f32x4*)gp = (f32x4){y[0], y[1], y[2], y[3]}; *(f32x4*)(gp + 4) = (f32x4){y[4], y[5], y[6], y[7]}; }
            }
        }
        __syncthreads();
        {
            const int row = tid >> 1, half = tid & 1, which = row >> 6, d = row & 63, g = which & 1;
            bf16_t* dst = ((which < 2) ? vst : vwt) + (((size_t)b * 2 + g) * 64 + d) * S + s0 + half * 32;
            const LAS bf16_t* src = vs + row * 72 + half * 32;
#pragma unroll
            for (int c = 0; c < 4; ++c) *(u32x4*)(dst + c * 8) = *(const LAS u32x4*)(src + c * 8);
        }
        __syncthreads();
    }
}
__device__ __forceinline__ void phase_p3b(const Params& p, LAS unsigned char* lds) {
    const int tid = ltid(), lane = tid & 63, wave = tid >> 6;
    const int gw = blockIdx.x * 8 + wave, NGW = gridDim.x * 8;
    const bf16_t* qraw = (const bf16_t*)(p.ws + R_H);
    const bf16_t* kvraw = (const bf16_t*)(p.ws + R_H + (size_t)T * 2048);
    const bf16_t* krope = (const bf16_t*)(p.ws + R_XA + A_KROPE);
    const float* rope = (const float*)(p.ws + SM_ROPE);
    bf16_t* qm = (bf16_t*)((unsigned char*)p.out + O_QM); bf16_t* km = (bf16_t*)((unsigned char*)p.out + O_KM); bf16_t* vmt = (bf16_t*)((unsigned char*)p.out + O_VMT);
    const float* q_norm = p.in[13]; const float* k_norm = p.in[14];
    LAS bf16_t* vs = (LAS bf16_t*)lds;
    LAS float* w2s = (LAS float*)(lds + 73728);
    for (int kv = 0; kv < 2; ++kv) {
        __syncthreads();
        for (int i = tid; i < 256 * 64; i += 512) w2s[i] = p.in[8][kv * 16384 + i];
        __syncthreads();
        const bf16_t* hid = (const bf16_t*)(p.ws + SM_HID) + (size_t)kv * NB * 512 * 256;
        for (int row = gw; row < NB * 512; row += NGW) {
            const u32x2 hv = *(const u32x2*)(hid + (size_t)row * 256 + lane * 4);
            const float h0 = bflo(hv.x), h1 = bfhi(hv.x), h2 = bflo(hv.y), h3 = bfhi(hv.y);
            float acc = 0.f;
#pragma unroll 8
            for (int k4 = 0; k4 < 64; ++k4) {
                acc += __shfl(h0, k4) * w2s[(k4 * 4 + 0) * 64 + lane]; acc += __shfl(h1, k4) * w2s[(k4 * 4 + 1) * 64 + lane];
                acc += __shfl(h2, k4) * w2s[(k4 * 4 + 2) * 64 + lane]; acc += __shfl(h3, k4) * w2s[(k4 * 4 + 3) * 64 + lane];
            }
            if (kv == 0) { const float r = rsqrtf(wsum(acc * acc) * (1.f / 64.f) + EPS); ((bf16_t*)(p.ws + SM_KC))[(size_t)row * 64 + lane] = f2bf(acc * r * p.in[5][lane]); }
            else { const int c = row & 255; ((bf16_t*)(p.ws + SM_VCT))[((size_t)(row >> 8) * 64 + lane) * 256 + ((c & ~15) | perm16(c & 15))] = f2bf(acc); }
        }
    }
    __syncthreads();
    const float QS = 0.10206207261596577f * LOG2E;
    const int c = lane & 15, hl = lane >> 4;
    float qg[8], kg[8];
    load8f(q_norm + (c < 12 ? c * 8 : 0), qg, QS);
    load8f(k_norm + (c < 12 ? c * 8 : 0), kg, 1.f);
    for (int tile = blockIdx.x; tile < T / 64; tile += gridDim.x) {
        const int b = tile / (S / 64), s0 = (tile % (S / 64)) * 64;
#pragma unroll 2
        for (int tt = 0; tt < 8; ++tt) {
            const int sl = wave * 8 + tt, s = s0 + sl; const size_t t = (size_t)b * S + s;
            const int pp = (sl & ~15) | perm16(sl & 15);
            u32x4 Q[2], KV[2];
#pragma unroll
            for (int ld = 0; ld < 2; ++ld) { Q[ld] = *(const u32x4*)(qraw + t * 1024 + ld * 512 + lane * 8); KV[ld] = *(const u32x4*)(kvraw + t * 1024 + ld * 512 + lane * 8); }
            u32x4 KR = {0u, 0u, 0u, 0u}; f32x4 cs0 = {0.f, 0.f, 0.f, 0.f}, cs1 = cs0, sn0 = cs0, sn1 = cs0;
            if (c >= 8 && c < 12) { KR = *(const u32x4*)(krope + t * 32 + (c - 8) * 8);
                const float* rp = rope + s * 32 + (c & 1) * 8; cs0 = *(const f32x4*)rp; cs1 = *(const f32x4*)(rp + 4); sn0 = *(const f32x4*)(rp + 16); sn1 = *(const f32x4*)(rp + 20); }
            const float cs[8] = {cs0.x, cs0.y, cs0.z, cs0.w, cs1.x, cs1.y, cs1.z, cs1.w}, sn[8] = {sn0.x, sn0.y, sn0.z, sn0.w, sn1.x, sn1.y, sn1.z, sn1.w};
            float kr[8]; unpack8(KR, kr);
            const float krs = ss8f(kr);
#pragma unroll
            for (int ld = 0; ld < 2; ++ld) {
                const int hh = ld * 4 + hl;
                {
                    float x[8]; unpack8(Q[ld], x);
                    float ss = c < 12 ? ss8f(x) : 0.f;
#pragma unroll
                    for (int o = 1; o < 16; o <<= 1) ss += __shfl_xor(ss, o);
                    const float r = rsqrtf(ss * (1.f / 96.f) + EPS); float y[8], z[8];
#pragma unroll
                    for (int j = 0; j < 8; ++j) y[j] = x[j] * r * qg[j];
#pragma unroll
                    for (int j = 0; j < 8; ++j) { const float pb = __shfl_xor(y[j], 2); z[j] = (c < 8) ? y[j] : ((c < 10) ? (y[j] * cs[j] - pb * sn[j]) : (pb * sn[j] + y[j] * cs[j])); }
                    if (c < 12) *(u32x4*)(qm + (t * 8 + hh) * 96 + c * 8) = pack8(z);
                }
                {
                    float x[8]; unpack8(KV[ld], x);
                    float ss = c < 8 ? ss8f(x) : krs;
#pragma unroll
                    for (int o = 1; o < 16; o <<= 1) ss += __shfl_xor(ss, o);
                    const float r = rsqrtf(ss * (1.f / 96.f) + EPS); float y[8], z[8];
#pragma unroll
                    for (int j = 0; j < 8; ++j) y[j] = (c < 8 ? x[j] : kr[j]) * r * kg[j];
#pragma unroll
                    for (int j = 0; j < 8; ++j) { const float pb = __shfl_xor(y[j], 2); z[j] = (c < 8) ? y[j] : ((c < 10) ? (y[j] * cs[j] - pb * sn[j]) : (pb * sn[j] + y[j] * cs[j])); }
                    if (c < 12) *(u32x4*)(km + (((size_t)b * 8 + hh) * S + s) * 96 + c * 8) = pack8(z);
                    if (c >= 8) {
#pragma unroll
                        for (int j = 0; j < 8; ++j) vs[(hh * 64 + (c - 8) * 8 + j) * 72 + pp] = (bf16_t)((j & 1) ? (KV[ld][j >> 1] >> 16) : (KV[ld][j >> 1] & 0xffffu)); }
                }
            }
        }
        __syncthreads();
        {
            const int hh = tid >> 6, d = tid & 63;
            bf16_t* dst = vmt + (((size_t)b * 8 + hh) * 64 + d) * S + s0;
            const LAS bf16_t* src = vs + tid * 72;
#pragma unroll
            for (int cc = 0; cc < 8; ++cc) *(u32x4*)(dst + cc * 8) = *(const LAS u32x4*)(src + cc * 8);
        }
        __syncthreads();
    }
}

__device__ const unsigned short UNIT_TYPES[256] = {63,127,62,126,61,125,527,591,655,719,783,847,911,975,60,124,59,123,58,122,57,121,56,120,526,590,654,718,782,846,910,974,55,119,54,118,53,117,52,116,51,115,525,589,653,717,781,845,909,973,50,114,49,113,48,112,47,111,524,588,652,716,780,844,908,972,46,110,45,109,44,108,43,107,523,587,651,715,779,843,907,971,42,106,41,105,40,104,39,103,38,102,522,586,650,714,778,842,906,970,37,101,36,100,35,99,34,98,33,97,521,585,649,713,777,841,905,969,32,96,31,95,30,94,520,584,648,712,776,840,904,968,29,93,28,92,27,91,26,90,25,89,519,583,647,711,775,839,903,967,24,88,23,87,22,86,21,85,20,84,518,582,646,710,774,838,902,966,19,83,18,82,17,81,16,80,15,79,517,581,645,709,773,837,901,965,14,78,13,77,12,76,516,580,644,708,772,836,900,964,11,75,10,74,9,73,8,72,515,579,643,707,771,835,899,963,7,71,6,70,5,69,514,578,642,706,770,834,898,962,4,68,3,67,513,577,641,705,769,833,897,961,2,66,1,65,0,64,512,576,640,704,768,832,896,960};
__device__ __forceinline__ int crow(int r, int hi) { return (r & 3) + 8 * (r >> 2) + 4 * hi; }
struct Flash { f32x16 o0, o1; float l; };
__device__ __forceinline__ void flash_init(Flash& st) {
#pragma unroll
    for (int r = 0; r < 16; ++r) { st.o0[r] = 0.f; st.o1[r] = 0.f; }
    st.l = 0.f;
}
constexpr int AL_KB = 0, AL_KBSZ = 64 * 208, AL_VB = 2 * AL_KBSZ, AL_VBSZ = 64 * 144, AL_IMP = AL_VB + 2 * AL_VBSZ, AL_SELB = AL_IMP + 64 * 65 * 4, AL_UNI = AL_SELB + 512, AL_TL = AL_UNI + 64, AL_BL = AL_TL + 128,
              AL_OT = AL_BL + 4 * 132 * 4, AL_END = AL_OT + 8 * 32 * 64 * 4;
static_assert(AL_END <= 131072, "attention LDS");

template <int DK, int KP> __device__ __forceinline__ void qk_tile(f32x16& p0, f32x16& p1, const LAS unsigned char* Kt, const bf16x8* qf, const f32x16& negm, int r32, int hi) {
#pragma unroll
    for (int s = 0; s < DK / 16; ++s) {
        const bf16x8 a0 = *(const LAS bf16x8*)(Kt + r32 * KP + (16 * s + 8 * hi) * 2);
        const bf16x8 a1 = *(const LAS bf16x8*)(Kt + (32 + r32) * KP + (16 * s + 8 * hi) * 2);
        if (s == 0) { p0 = __builtin_amdgcn_mfma_f32_32x32x16_bf16(a0, qf[0], negm, 0, 0, 0); p1 = __builtin_amdgcn_mfma_f32_32x32x16_bf16(a1, qf[0], negm, 0, 0, 0); }
        else { p0 = __builtin_amdgcn_mfma_f32_32x32x16_bf16(a0, qf[s], p0, 0, 0, 0); p1 = __builtin_amdgcn_mfma_f32_32x32x16_bf16(a1, qf[s], p1, 0, 0, 0); }
    }
}
template <bool LANEMASK, class F> __device__ __forceinline__ void softmax_pv(Flash& st, f32x16& p0, f32x16& p1, const LAS unsigned char* Vt, int r32, int hi, bool mine, F f) {
    float ls = 0.f;
#pragma unroll
    for (int r = 0; r < 16; ++r) {
        float x0 = p0[r], x1 = p1[r]; const bool v0 = f(r, 0, x0), v1 = f(r, 1, x1);
        const float e0 = fexp2(x0), e1 = fexp2(x1);
        p0[r] = v0 ? e0 : 0.f; p1[r] = v1 ? e1 : 0.f; ls += p0[r] + p1[r];
    }
    if (LANEMASK) ls = mine ? ls : 0.f;
    st.l += ls;
#pragma unroll
    for (int s = 0; s < 4; ++s) {
        u32x4 w;
        if (s < 2) { w.x = cvtpk(p0[8 * s + 0], p0[8 * s + 1]); w.y = cvtpk(p0[8 * s + 2], p0[8 * s + 3]); w.z = cvtpk(p0[8 * s + 4], p0[8 * s + 5]); w.w = cvtpk(p0[8 * s + 6], p0[8 * s + 7]); }
        else { const int q = s - 2; w.x = cvtpk(p1[8 * q + 0], p1[8 * q + 1]); w.y = cvtpk(p1[8 * q + 2], p1[8 * q + 3]); w.z = cvtpk(p1[8 * q + 4], p1[8 * q + 5]); w.w = cvtpk(p1[8 * q + 6], p1[8 * q + 7]); }
        if (LANEMASK) { w.x = mine ? w.x : 0u; w.y = mine ? w.y : 0u; w.z = mine ? w.z : 0u; w.w = mine ? w.w : 0u; }
        const bf16x8 pa = __builtin_bit_cast(bf16x8, w);
        const bf16x8 vb0 = *(const LAS bf16x8*)(Vt + r32 * 144 + (16 * s + 8 * hi) * 2);
        const bf16x8 vb1 = *(const LAS bf16x8*)(Vt + (32 + r32) * 144 + (16 * s + 8 * hi) * 2);
        st.o0 = __builtin_amdgcn_mfma_f32_32x32x16_bf16(pa, vb0, st.o0, 0, 0, 0);
        st.o1 = __builtin_amdgcn_mfma_f32_32x32x16_bf16(pa, vb1, st.o1, 0, 0, 0);
    }
}
template <bool FIRST> __device__ __forceinline__ void flash_accum(LAS float* otl, const Flash& st, float gate, int hi, int lane) {
    const float lt = st.l + __shfl_xor(st.l, 32);
    const float f = lt > 0.f ? gate * frcp(lt) : 0.f;
#pragma unroll
    for (int r = 0; r < 16; ++r) { const float fr_ = __shfl(f, crow(r, hi));
        if (FIRST) { otl[r * 64 + lane] = fr_ * st.o0[r]; otl[(16 + r) * 64 + lane] = fr_ * st.o1[r]; }
        else { otl[r * 64 + lane] += fr_ * st.o0[r]; otl[(16 + r) * 64 + lane] += fr_ * st.o1[r]; } }
}
template <int NS> __device__ __forceinline__ float qnorm2(const bf16x8* qf) {
    float s = 0.f;
#pragma unroll
    for (int i = 0; i < NS; ++i)
#pragma unroll
        for (int j = 0; j < 8; ++j) { const float x = bf2f((bf16_t)qf[i][j]); s += x * x; }
    return s + __shfl_xor(s, 32);
}
__device__ __forceinline__ float wmax(float v) {
#pragma unroll
    for (int o = 1; o < 64; o <<= 1) v = fmaxf(v, __shfl_xor(v, o));
    return v;
}

template <int RB> struct TileRegs { u32x4 a, b; };
template <int RB> __device__ __forceinline__ void tile_load(TileRegs<RB>& R, const unsigned char* g, size_t gs, int tid) {
    constexpr int CPR = RB / 16;
    asm volatile("" : "+v"(tid));
    { const int row = tid / CPR, c = tid % CPR; R.a = *(const u32x4*)(g + (size_t)row * gs + c * 16); }
    if (RB == 192) { const int id = (tid < 256) ? tid + 512 : tid; const int row = id / CPR, c = id % CPR; R.b = *(const u32x4*)(g + (size_t)row * gs + c * 16); }
}
template <int RB, int P> __device__ __forceinline__ void tile_store(const TileRegs<RB>& R, LAS unsigned char* l, int tid) {
    constexpr int CPR = RB / 16;
    asm volatile("" : "+v"(tid));
    { const int row = tid / CPR, c = tid % CPR; *(LAS u32x4*)(l + row * P + c * 16) = R.a; }
    if (RB == 192) { const int id = tid + 512; if (id < 768) { const int row = id / CPR, c = id % CPR; *(LAS u32x4*)(l + row * P + c * 16) = R.b; } }
}
template <int RBK, int PK, bool HASV, class SrcK, class SrcV, class Comp>
__device__ __forceinline__ void run_tiles(int n, LAS unsigned char* lds, int tid, size_t gsK, size_t gsV, SrcK srcK, SrcV srcV, Comp comp) {
    TileRegs<RBK> k0, k1, k2; TileRegs<128> v0, v1, v2;
    const int nl = n - 1;
    { tile_load<RBK>(k0, srcK(0), gsK, tid); if (HASV) tile_load<128>(v0, srcV(0), gsV, tid); }
    { const int t1 = nl < 1 ? nl : 1; tile_load<RBK>(k1, srcK(t1), gsK, tid); if (HASV) tile_load<128>(v1, srcV(t1), gsV, tid); }
    { const int t2 = nl < 2 ? nl : 2; tile_load<RBK>(k2, srcK(t2), gsK, tid); if (HASV) tile_load<128>(v2, srcV(t2), gsV, tid); }
#define RT_STEP(KR, VR, ii) do { const int i_ = (ii); \
        LAS unsigned char* kb = lds + AL_KB + (i_ & 1) * AL_KBSZ; LAS unsigned char* vb = lds + AL_VB + (i_ & 1) * AL_VBSZ; \
        tile_store<RBK, PK>(KR, kb, tid); if (HASV) tile_store<128, 144>(VR, vb, tid); \
        __syncthreads(); \
        { const int tn = (i_ + 3 < nl) ? i_ + 3 : nl; tile_load<RBK>(KR, srcK(tn), gsK, tid); if (HASV) tile_load<128>(VR, srcV(tn), gsV, tid); } \
        if (i_ < n) comp(i_, kb, vb); } while (0)
    for (int i = 0; i < n; i += 3) { RT_STEP(k0, v0, i); RT_STEP(k1, v1, i + 1); RT_STEP(k2, v2, i + 2); }
#undef RT_STEP
    __syncthreads();
}

__device__ __forceinline__ void mla_unit(const Params& p, LAS unsigned char* lds, int b, int h, int qb) {
    int tid = threadIdx.x; asm volatile("" : "+v"(tid));
    const int lane = tid & 63, w = __builtin_amdgcn_readfirstlane(tid >> 6), r32 = lane & 31, hi = lane >> 5;
    const bf16_t* qm = (const bf16_t*)((const unsigned char*)p.out + O_QM);
    const unsigned char* km = (const unsigned char*)p.out + O_KM + (((size_t)b * 8 + h) * S) * 192;
    const unsigned char* vmt = (const unsigned char*)p.out + O_VMT + (((size_t)b * 8 + h) * 64) * (size_t)S * 2;
    bf16_t* ocat = (bf16_t*)(p.ws + R_XN);
    const int tq = qb * 256 + 32 * w + r32;
    bf16x8 qf[6];
#pragma unroll
    for (int s = 0; s < 6; ++s) qf[s] = *(const bf16x8*)(qm + (((size_t)b * S + tq) * 8 + h) * 96 + 16 * s + 8 * hi);
    const float kn = 9.797958971f * 1.01f * wmax(fmaxf(fabsf(p.in[14][lane]), lane < 32 ? fabsf(p.in[14][64 + lane]) : 0.f));
    const float mref = sqrtf(qnorm2<6>(qf)) * kn;
    f32x16 negm;
#pragma unroll
    for (int r = 0; r < 16; ++r) negm[r] = -mref;
    Flash st; flash_init(st);
    const int ntile = 4 * qb + 4, dt = 4 * qb + (w >> 1);
    run_tiles<192, 208, true>(ntile, lds, tid, 192, (size_t)S * 2,
        [&](int i) { return km + (size_t)i * 64 * 192; }, [&](int i) { return vmt + (size_t)i * 128; },
        [&](int i, LAS unsigned char* kb, LAS unsigned char* vb) {
            if (i <= dt) {
                f32x16 p0, p1; qk_tile<96, 208>(p0, p1, kb, qf, negm, r32, hi);
                if (i < dt) softmax_pv<false>(st, p0, p1, vb, r32, hi, true, [&](int r, int half, float& x) { return true; });
                else { const int kb0 = 64 * i + 4 * hi; softmax_pv<false>(st, p0, p1, vb, r32, hi, true, [&](int r, int half, float& x) { return (kb0 + 32 * half + (r & 3) + 8 * (r >> 2)) <= tq; }); }
            }
        });
    {
        const float lt = st.l + __shfl_xor(st.l, 32); const float f = lt > 0.f ? frcp(lt) : 0.f;
#pragma unroll
        for (int r = 0; r < 16; ++r) { const float fr_ = __shfl(f, crow(r, hi)); const size_t ro = ((size_t)b * S + qb * 256 + 32 * w + crow(r, hi)) * 1024 + 512 + h * 64 + r32; ocat[ro] = f2bf(st.o0[r] * fr_); ocat[ro + 32] = f2bf(st.o1[r] * fr_); }
    }
}

__device__ __forceinline__ void nsa_unit(const Params& p, LAS unsigned char* lds, int b, int g, int jt) {
    int tid = threadIdx.x; asm volatile("" : "+v"(tid));
    const int lane = tid & 63, w = __builtin_amdgcn_readfirstlane(tid >> 6), r32 = lane & 31, hi = lane >> 5;
    const int rh = w >> 1, qh = w & 1, h = 4 * g + rh, q0 = 64 * jt, ql = 32 * qh + r32, tq = q0 + ql;
    const unsigned char* xa = p.ws + R_XA;
    const bf16_t* qn = (const bf16_t*)(xa + A_QN);
    const size_t bg = (size_t)b * 2 + g;
    const unsigned char* ksn = xa + A_KSN + bg * S * 128; const unsigned char* kwn = xa + A_KWN + bg * S * 128;
    const unsigned char* vst = xa + A_VST + bg * 64 * (size_t)S * 2; const unsigned char* vwt = xa + A_VWT + bg * 64 * (size_t)S * 2;
    const unsigned char* kc = p.ws + SM_KC + bg * 256 * 128; const unsigned char* vct = p.ws + SM_VCT + bg * 64 * 512;
    const float* gates = (const float*)(xa + A_GATES) + ((size_t)b * S + tq) * 24 + h * 3;
    bf16_t* ocat = (bf16_t*)(p.ws + R_XN);
    LAS float* imp = (LAS float*)(lds + AL_IMP); LAS unsigned char* selb = lds + AL_SELB; LAS unsigned* uni = (LAS unsigned*)(lds + AL_UNI); LAS unsigned char* tl = lds + AL_TL; LAS float* bls = (LAS float*)(lds + AL_BL);
    const float* blg = (const float*)(p.ws + SM_BL) + h * 132;
    const float cb = blg[128];
    const float bmax = wmax(fmaxf(fmaxf(blg[lane], blg[64 + lane]), cb));
    if (qh == 0) { bls[rh * 132 + lane] = blg[lane] - cb; bls[rh * 132 + 64 + lane] = blg[64 + lane] - cb; if (lane == 0) bls[rh * 132 + 128] = 0.f; }
    const LAS float* blh = bls + rh * 132;
    bf16x8 qf[4];
#pragma unroll
    for (int s = 0; s < 4; ++s) qf[s] = *(const bf16x8*)(qn + (((size_t)b * S + tq) * 8 + h) * 64 + 16 * s + 8 * hi);
    const float kn = 8.f * 1.01f * wmax(fmaxf(fmaxf(fabsf(p.in[5][lane]), fabsf(p.in[5][64 + lane])), fabsf(p.in[5][128 + lane])));
    const float mref = sqrtf(qnorm2<4>(qf)) * kn + bmax;
    f32x16 negm;
#pragma unroll
    for (int r = 0; r < 16; ++r) negm[r] = cb - mref;
    float g0 = gates[0], g1 = gates[1], g2 = gates[2];
    if (p.dbg_branch >= 0) { g0 = p.dbg_branch == 0 ? 1.f : 0.f; g1 = p.dbg_branch == 1 ? 1.f : 0.f; g2 = p.dbg_branch == 2 ? 1.f : 0.f; }
    LAS float* otl = (LAS float*)(lds + AL_OT) + w * 2048;
    const int nvmax = (q0 + 63 - 31) / 16 + 1, ntc = (nvmax + 63) / 64;
    Flash st; flash_init(st);
    run_tiles<128, 144, true>(ntc, lds, tid, 128, 512,
        [&](int i) { return kc + (size_t)i * 64 * 128; }, [&](int i) { return vct + (size_t)i * 128; },
        [&](int i, LAS unsigned char* kb, LAS unsigned char* vb) {
            f32x16 p0, p1; qk_tile<64, 144>(p0, p1, kb, qf, negm, r32, hi);
            const int cb0 = 64 * i + 4 * hi;
            softmax_pv<false>(st, p0, p1, vb, r32, hi, true, [&](int r, int half, float& x) {
                const int c = cb0 + 32 * half + (r & 3) + 8 * (r >> 2); const int dist = tq - 16 * c - 31; x += blh[dist < 0 ? 0 : (dist > 128 ? 128 : dist)]; return dist >= 0; });
        });
    flash_accum<true>(otl, st, g0, hi, lane);
    unsigned mlo, mhi;
    int nsel;
    if (jt < 16) { const unsigned long long mk = (1ull << (jt + 1)) - 1ull; mlo = (unsigned)mk; mhi = (unsigned)(mk >> 32); nsel = jt + 1; if (tid <= jt) tl[tid] = (unsigned char)tid; }
    else {
        for (int i = tid; i < 64 * 65; i += 512) imp[i] = 0.f;
        const float lt = st.l + __shfl_xor(st.l, 32); const float linv = lt > 0.f ? frcp(lt) : 0.f;
        float xlast = 0.f;
        run_tiles<128, 144, false>(ntc, lds, tid, 128, 0,
            [&](int i) { return kc + (size_t)i * 64 * 128; }, [&](int i) { return kc; },
            [&](int i, LAS unsigned char* kb, LAS unsigned char* vb) {
                f32x16 p0, p1; qk_tile<64, 144>(p0, p1, kb, qf, negm, r32, hi);
                const int cb0 = 64 * i + 4 * hi;
                float sm[2][4], cr[2][4];
#pragma unroll
                for (int half = 0; half < 2; ++half)
#pragma unroll
                    for (int a = 0; a < 4; ++a) {
                        float s4 = 0.f, last = 0.f;
#pragma unroll
                        for (int k = 0; k < 4; ++k) {
                            const int r = 4 * a + k; const int c = cb0 + 32 * half + k + 8 * a; const int dist = tq - 16 * c - 31;
                            const float sc = (half ? p1[r] : p0[r]) + blh[dist < 0 ? 0 : (dist > 128 ? 128 : dist)];
                            const float pv = dist >= 0 ? fexp2(sc) * linv : 0.f;
                            s4 += pv; last = pv;
                        }
                        sm[half][a] = s4; cr[half][a] = last;
                    }
                float tot[2][4];
#pragma unroll
                for (int half = 0; half < 2; ++half)
#pragma unroll
                    for (int a = 0; a < 4; ++a) {
                        const float xs_ = __shfl_xor(cr[half][a], 32);
                        const float xp_ = (a > 0) ? __shfl_xor(cr[half][a > 0 ? a - 1 : 0], 32) : (half ? __shfl_xor(cr[0][3], 32) : xlast);
                        tot[half][a] = sm[half][a] + (hi ? xs_ : xp_);
                    }
                xlast = __shfl_xor(cr[1][3], 32);
                for (int rr = 0; rr < 4; ++rr) {
                    if (rh == rr) {
#pragma unroll
                        for (int half = 0; half < 2; ++half)
#pragma unroll
                            for (int a = 0; a < 4; ++a) { const int j = 16 * i + 8 * half + 2 * a + hi; imp[ql * 65 + j] += tot[half][a]; }
                    }
                    __syncthreads();
                }
            });
        if (p.dbg_branch == 1) { for (int i = tid; i < 4096; i += 512) ((float*)(p.ws + R_H))[((size_t)g * S + q0 + (i >> 6)) * 64 + (i & 63)] = imp[(i >> 6) * 65 + (i & 63)]; }
        {
            const int q = tid >> 3, jg = tid & 7;
            unsigned byte = 0;
#pragma unroll 1
            for (int jj = 0; jj < 8; ++jj) {
                const int j = jg * 8 + jj;
                if (j <= jt) {
                    const float x = imp[q * 65 + j]; const float vj = (j == jt || j == 0) ? 1e9f : x;
                    int rank = 0;
#pragma unroll 8
                    for (int i = 0; i < 64; ++i) { const float xi = imp[q * 65 + i]; const float vi = (i > jt) ? -1.f : ((i == jt || i == 0) ? 1e9f : xi); rank += (vi > vj || (vi == vj && i < j)) ? 1 : 0; }
                    if (rank < 16) byte |= 1u << jj;
                }
            }
            selb[q * 8 + jg] = (unsigned char)byte;
        }
        __syncthreads();
        if (w == 0) {
            unsigned a = ((const LAS unsigned*)selb)[lane * 2], c = ((const LAS unsigned*)selb)[lane * 2 + 1];
#pragma unroll
            for (int o = 1; o < 64; o <<= 1) { a |= __shfl_xor(a, o); c |= __shfl_xor(c, o); }
            const unsigned long long um = ((unsigned long long)c << 32) | a;
            if ((um >> lane) & 1ull) tl[__builtin_popcountll(um & ((1ull << lane) - 1ull))] = (unsigned char)lane;
            if (lane == 0) uni[0] = (unsigned)__builtin_popcountll(um);
        }
        __syncthreads();
        mlo = ((const LAS unsigned*)selb)[ql * 2]; mhi = ((const LAS unsigned*)selb)[ql * 2 + 1];
        nsel = (int)uni[0];
    }
    if (p.dbg_branch == 1 && rh == 0) { if (hi == 0) ((unsigned long long*)(p.ws + R_H + 4 * 1048576))[(size_t)g * S + tq] = ((unsigned long long)mhi << 32) | mlo; }
    __syncthreads();
    {
        const unsigned long long mymask = ((unsigned long long)mhi << 32) | mlo;
        nsel = __builtin_amdgcn_readfirstlane(nsel);
        flash_init(st);
        run_tiles<128, 144, true>(nsel, lds, tid, 128, (size_t)S * 2,
            [&](int i) { return ksn + (size_t)tl[i] * 64 * 128; }, [&](int i) { return vst + (size_t)tl[i] * 128; },
            [&](int i, LAS unsigned char* kb, LAS unsigned char* vb) {
                const int j = __builtin_amdgcn_readfirstlane((int)tl[i]);
                f32x16 p0, p1; qk_tile<64, 144>(p0, p1, kb, qf, negm, r32, hi);
                const bool mine = (mymask >> j) & 1ull;
                if (q0 + 32 * qh - (64 * j + 63) >= 128) softmax_pv<true>(st, p0, p1, vb, r32, hi, mine, [&](int r, int half, float& x) { return true; });
                else { const int kb0 = 64 * j + 4 * hi;
                    softmax_pv<true>(st, p0, p1, vb, r32, hi, mine, [&](int r, int half, float& x) { const int dist = tq - (kb0 + 32 * half + (r & 3) + 8 * (r >> 2)); x += blh[dist < 0 ? 0 : (dist > 128 ? 128 : dist)]; return dist >= 0; }); }
            });
        flash_accum<false>(otl, st, g1, hi, lane);
    }
    {
        const int j0 = jt >= 8 ? jt - 8 : 0, nw = jt - j0 + 1;
        flash_init(st);
        run_tiles<128, 144, true>(nw, lds, tid, 128, (size_t)S * 2,
            [&](int i) { return kwn + (size_t)(j0 + i) * 64 * 128; }, [&](int i) { return vwt + (size_t)(j0 + i) * 128; },
            [&](int i, LAS unsigned char* kb, LAS unsigned char* vb) {
                f32x16 p0, p1; qk_tile<64, 144>(p0, p1, kb, qf, negm, r32, hi);
                const int kb0 = 64 * (j0 + i) + 4 * hi;
                softmax_pv<false>(st, p0, p1, vb, r32, hi, true, [&](int r, int half, float& x) { const int dist = tq - (kb0 + 32 * half + (r & 3) + 8 * (r >> 2)); x += blh[dist < 0 ? 0 : (dist > 128 ? 128 : dist)]; return dist >= 0 && dist < 512; });
            });
        flash_accum<false>(otl, st, g2, hi, lane);
    }
#pragma unroll
    for (int r = 0; r < 16; ++r) { const size_t ro = ((size_t)b * S + q0 + 32 * qh + crow(r, hi)) * 1024 + h * 64 + r32; ocat[ro] = f2bf(otl[r * 64 + lane]); ocat[ro + 32] = f2bf(otl[(16 + r) * 64 + lane]); }
    __syncthreads();
}

__device__ __forceinline__ void phase_p4(const Params& p, LAS unsigned char* lds) {
    const int G = gridDim.x, c = blockIdx.x, nunits = 256 * NB;
#if NB == 8
    if (G == 256) {
        const int b = c & 7, idx = c >> 3, pi = idx & 7, hq = idx >> 3;
#pragma unroll 1
        for (int u = 0; u < 8; ++u) {
            if (u < 4) nsa_unit(p, lds, b, u >> 1, (u & 1) ? idx : 63 - idx);
            else mla_unit(p, lds, b, ((u - 4) >> 1) * 4 + hq, (u & 1) ? pi : 15 - pi);
        }
        return;
    }
#endif
    for (int j = 0;; ++j) {
        const int k = j * G + ((j & 1) ? (G - 1 - c) : c);
        if (j * G >= nunits) break;
        if (k >= nunits) continue;
        const int ty = UNIT_TYPES[k / NB], b = k % NB, kind = ty >> 9, a = (ty >> 6) & 7, cc = ty & 63;
        if (kind == 0) nsa_unit(p, lds, b, a, cc); else mla_unit(p, lds, b, a, cc);
    }
}
__device__ __forceinline__ void phase_norm(const float* x, const float* g, bf16_t* xn) {
    const int tid_ = ltid(); const int lane = tid_ & 63, gw = blockIdx.x * 8 + (tid_ >> 6), NGW = gridDim.x * 8;
    for (int m = gw; m < T; m += NGW) rms_row_to_bf16(x + (size_t)m * D, g, xn + (size_t)m * D, lane);
}
__device__ __forceinline__ void phase_conv(const Params& p) {
    const int tid_ = ltid(); const int lane = tid_ & 63, gw = blockIdx.x * 8 + (tid_ >> 6), NGW = gridDim.x * 8;
    const bf16_t* hh = (const bf16_t*)(p.ws + R_H); bf16_t* v = (bf16_t*)(p.ws + R_XN); const float* cw = p.in[22];
    for (int m = gw; m < T; m += NGW) {
        const int s = m & (S - 1);
#pragma unroll
        for (int j = 0; j < 4; ++j) {
            const int d = 4 * lane + 256 * j;
            float y[4] = {0.f, 0.f, 0.f, 0.f};
#pragma unroll
            for (int w = 0; w < 3; ++w) {
                if (s - 2 + w >= 0) {
                    const bf16_t* r = hh + (size_t)(m - 2 + w) * 3072;
                    const u32x2 c = *(const u32x2*)(r + 1024 + d), u = *(const u32x2*)(r + 2048 + d); const f32x4 cwv = *(const f32x4*)(cw + w * 1024 + d);
                    y[0] += cwv.x * bflo(c.x) * bflo(u.x); y[1] += cwv.y * bfhi(c.x) * bfhi(u.x); y[2] += cwv.z * bflo(c.y) * bflo(u.y); y[3] += cwv.w * bfhi(c.y) * bfhi(u.y);
                }
            }
            const u32x2 bv = *(const u32x2*)(hh + (size_t)m * 3072 + d);
            u32x2 o; o.x = cvtpk(bflo(bv.x) * y[0], bfhi(bv.x) * y[1]); o.y = cvtpk(bflo(bv.y) * y[2], bfhi(bv.y) * y[3]);
            *(u32x2*)(v + (size_t)m * 1024 + d) = o;
        }
    }
}
__device__ __forceinline__ void phase_norm_router(const Params& p, LAS unsigned char* lds) {
    const int tid = ltid(), lane = tid & 63, wave = tid >> 6, gw = blockIdx.x * 8 + wave, NGW = gridDim.x * 8;
    const float* x3 = p.out; const float* g = p.in[24]; bf16_t* xn = (bf16_t*)(p.ws + R_XN);
    LAS float* wr = (LAS float*)lds;
    LAS int* lcnt = (LAS int*)(lds + 32768); LAS int* gb = lcnt + 8;
    int* te = (int*)(p.ws + SM_TE); float* tw = (float*)(p.ws + SM_TW); int* rank = (int*)(p.ws + SM_RANK); int* cnt = (int*)(p.ws + SM_CTL);
    for (int i = tid; i < 8192; i += 512) wr[i] = p.in[25][i];
    if (tid < 8) lcnt[tid] = 0;
    __syncthreads();
    for (int m = gw; m < T; m += NGW) {
        const f32x4* xr = (const f32x4*)(x3 + (size_t)m * D) + lane; const f32x4* gr = (const f32x4*)g + lane;
        f32x4 v[4]; float s = 0.f;
#pragma unroll
        for (int j = 0; j < 4; ++j) { v[j] = xr[64 * j]; s += (v[j].x * v[j].x + v[j].y * v[j].y) + (v[j].z * v[j].z + v[j].w * v[j].w); }
        const float r = rsqrtf(wsum(s) * (1.f / 1024.f) + EPS);
        float lg[8];
#pragma unroll
        for (int e = 0; e < 8; ++e) lg[e] = 0.f;
        u32x2* o8 = (u32x2*)(xn + (size_t)m * D) + lane;
#pragma unroll
        for (int j = 0; j < 4; ++j) { const f32x4 gg = gr[64 * j]; const f32x4 y = {v[j].x * r * gg.x, v[j].y * r * gg.y, v[j].z * r * gg.z, v[j].w * r * gg.w};
            u32x2 w; w.x = cvtpk(y.x, y.y); w.y = cvtpk(y.z, y.w); o8[64 * j] = w;
#pragma unroll
            for (int i = 0; i < 4; ++i) { const int d = 4 * lane + 256 * j + i; const f32x4 w0 = *(const LAS f32x4*)(wr + d * 8), w1 = *(const LAS f32x4*)(wr + d * 8 + 4);
                lg[0] += y[i] * w0.x; lg[1] += y[i] * w0.y; lg[2] += y[i] * w0.z; lg[3] += y[i] * w0.w; lg[4] += y[i] * w1.x; lg[5] += y[i] * w1.y; lg[6] += y[i] * w1.z; lg[7] += y[i] * w1.w; } }
#pragma unroll
        for (int e = 0; e < 8; ++e) lg[e] = wsum(lg[e]) + p.in[26][e];
        int e1 = 0; float l1 = lg[0];
#pragma unroll
        for (int e = 1; e < 8; ++e) if (lg[e] > l1) { l1 = lg[e]; e1 = e; }
        int e2 = -1; float l2 = -3e38f;
#pragma unroll
        for (int e = 0; e < 8; ++e) if (e != e1 && lg[e] > l2) { l2 = lg[e]; e2 = e; }
        if (lane == 0) {
            const float w1 = 1.f / (1.f + __expf(l2 - l1));
            te[m * 2] = e1; te[m * 2 + 1] = e2; tw[m * 2] = w1; tw[m * 2 + 1] = 1.f - w1;
            rank[m * 2] = __hip_atomic_fetch_add(&lcnt[e1], 1, __ATOMIC_RELAXED, __HIP_MEMORY_SCOPE_WORKGROUP); rank[m * 2 + 1] = __hip_atomic_fetch_add(&lcnt[e2], 1, __ATOMIC_RELAXED, __HIP_MEMORY_SCOPE_WORKGROUP);
        }
    }
    __syncthreads();
    if (tid < 8) gb[tid] = atomicAdd(&cnt[tid], lcnt[tid]);
    __syncthreads();
    for (int m = gw; m < T; m += NGW) if (lane < 2) rank[m * 2 + lane] += gb[te[m * 2 + lane]];
}
__device__ __forceinline__ void phase_moe_gather(const Params& p) {
    const int tid = ltid(), lane = tid & 63, gw = blockIdx.x * 8 + (tid >> 6), NGW = gridDim.x * 8;
    const int* cnt = (const int*)(p.ws + SM_CTL); const int* te = (const int*)(p.ws + SM_TE); const float* tw = (const float*)(p.ws + SM_TW); const int* rank = (const int*)(p.ws + SM_RANK);
    int* pos = (int*)(p.ws + SM_POS); float* roww = (float*)(p.ws + SM_ROWW); int* tile_e = (int*)(p.ws + SM_TILEE);
    const bf16_t* xn = (const bf16_t*)(p.ws + R_XN); bf16_t* xs = (bf16_t*)(p.ws + R_XA);
    int off[9]; off[0] = 0;
#pragma unroll
    for (int e = 0; e < 8; ++e) off[e + 1] = off[e] + ((cnt[e] + 255) & ~255);
    if (blockIdx.x == 0) {
        for (int i = tid; i < ROWS_MAX / 256; i += 512) { int e = -1;
#pragma unroll
            for (int k = 0; k < 8; ++k) if (i * 256 >= off[k] && i * 256 < off[k + 1]) e = k;
            tile_e[i] = e < 0 ? 0 : e; }
        if (tid == 0) ((int*)(p.ws + SM_CTL))[8] = off[8];
    }
    if (blockIdx.x < 8 && tid < 256) {
#pragma unroll
        for (int e = 0; e < 8; ++e) if (e == (int)blockIdx.x) { const int c = cnt[e]; if (c + tid < off[e + 1] - off[e]) roww[off[e] + c + tid] = 0.f; }
    }
    for (int pi = gw; pi < 2 * T; pi += NGW) {
        const int e = te[pi]; int o = 0;
#pragma unroll
        for (int k = 0; k < 8; ++k) if (k == e) o = off[k];
        const int r = o + rank[pi];
        if (lane == 0) { pos[pi] = r; roww[r] = tw[pi]; }
        const u32x4* src = (const u32x4*)(xn + (size_t)(pi >> 1) * D); u32x4* dst = (u32x4*)(xs + (size_t)r * D);
        dst[lane] = src[lane]; dst[64 + lane] = src[64 + lane];
    }
}
__device__ __forceinline__ void phase_moe_combine(const Params& p) {
    const int tid_ = ltid(); const int lane = tid_ & 63, gw = blockIdx.x * 8 + (tid_ >> 6), NGW = gridDim.x * 8;
    const int* pos = (const int*)(p.ws + SM_POS); const bf16_t* ym = (const bf16_t*)(p.ws + R_XA);
    for (int m = gw; m < T; m += NGW) {
        const int p0 = pos[m * 2], p1 = pos[m * 2 + 1];
#pragma unroll
        for (int j = 0; j < 4; ++j) {
            const int d = 4 * lane + 256 * j;
            f32x4* o = (f32x4*)(p.out + (size_t)m * D + d); f32x4 x = *o;
            const u32x2 a = *(const u32x2*)(ym + (size_t)p0 * D + d), c = *(const u32x2*)(ym + (size_t)p1 * D + d);
            x.x += bflo(a.x) + bflo(c.x); x.y += bfhi(a.x) + bfhi(c.x); x.z += bflo(a.y) + bflo(c.y); x.w += bfhi(a.y) + bfhi(c.y);
            *o = x;
        }
    }
}

#define XB_TMO      128
#define XB_XCNT(j)  (256  + 64 * (j))
#define XB_XSUB(j)  (1280 + 64 * (j))
#define XB_XGEN(j)  (2304 + 64 * (j))
#define XB_TOP      3328
#define XB_TOPGEN   3392
#define XCD_BAR_WORDS 3456
#define XB_SPIN_CAP (1u << 18)

__device__ __forceinline__ unsigned xb_ld(unsigned* p)              { return __hip_atomic_load(p, __ATOMIC_RELAXED, __HIP_MEMORY_SCOPE_AGENT); }
__device__ __forceinline__ unsigned xb_add(unsigned* p, unsigned v) { return __hip_atomic_fetch_add(p, v, __ATOMIC_RELAXED, __HIP_MEMORY_SCOPE_AGENT); }
__device__ __forceinline__ unsigned xb_xcc_id() { return (unsigned)__builtin_amdgcn_s_getreg((3 << 11) | 20) & 0xFu; }
#define XB_SPIN(cond, bar) do { unsigned _sp = 0; while (cond) { __builtin_amdgcn_s_sleep(1); \
    if ((++_sp & 255u) == 0u) { if (xb_ld(&(bar)[XB_TMO])) break; if (_sp > XB_SPIN_CAP) { atomicAdd(&(bar)[XB_TMO], 1u); break; } } } } while (0)

struct XcdBarrier {
    unsigned* bar; unsigned x;
    volatile LAS unsigned* st;
};

__device__ __forceinline__ XcdBarrier xcd_barrier_post(unsigned* bar, volatile LAS unsigned* st) {
    XcdBarrier b; b.bar = bar; b.x = xb_xcc_id(); b.st = st;
    if (threadIdx.x == 0) (void)xb_add(&bar[XB_XCNT(b.x)], 1u);
    return b;
}
__device__ __forceinline__ void xcd_barrier_complete(unsigned* bar, unsigned x, unsigned& nloc, unsigned& nx) {
    const unsigned G = gridDim.x * gridDim.y * gridDim.z;
    unsigned sum, cnt, mine, sp = 0u;
    for (;;) {
        sum = 0u; cnt = 0u; mine = 0u;
#pragma unroll
        for (unsigned j = 0; j < 16; ++j) { const unsigned c = xb_ld(&bar[XB_XCNT(j)]); sum += c; cnt += (c > 0u) ? 1u : 0u; mine = (j == x) ? c : mine; }
        if (sum == G) break;
        __builtin_amdgcn_s_sleep(1);
        if ((++sp & 255u) == 0u) { if (xb_ld(&bar[XB_TMO])) break; if (sp > XB_SPIN_CAP) { atomicAdd(&bar[XB_TMO], 1u); break; } }
    }
    nloc = mine > 0u ? mine : 1u; nx = cnt > 0u ? cnt : 1u;
}

__device__ __forceinline__ void xcd_barrier(const XcdBarrier& b) {
    asm volatile("s_waitcnt vmcnt(0)" ::: "memory");
    __syncthreads();
    if (threadIdx.x == 0) {
        unsigned* bar = b.bar;
        __builtin_amdgcn_s_waitcnt(0);
        unsigned nloc = b.st[0], nx = b.st[1];
        if (nloc == 0u) { xcd_barrier_complete(bar, b.x, nloc, nx); b.st[0] = nloc; b.st[1] = nx; }
        const unsigned old = xb_add(&bar[XB_XSUB(b.x)], 1u);
        const unsigned gen = old / nloc;
        if (old + 1u == (gen + 1u) * nloc) {
            __builtin_amdgcn_fence(__ATOMIC_RELEASE, "agent");
            asm volatile("s_waitcnt vmcnt(0)" ::: "memory");
            const unsigned og = xb_add(&bar[XB_TOP], 1u);
            const unsigned tg = og / nx;
            if (og + 1u == (tg + 1u) * nx) xb_add(&bar[XB_TOPGEN], 1u);
            else XB_SPIN(xb_ld(&bar[XB_TOPGEN]) == tg, bar);
            __builtin_amdgcn_fence(__ATOMIC_ACQUIRE, "agent");
            xb_add(&bar[XB_XGEN(b.x)], 1u);
            asm volatile("s_waitcnt vmcnt(0)" ::: "memory");
        } else {
            XB_SPIN(xb_ld(&bar[XB_XGEN(b.x)]) == gen, bar);
            __builtin_amdgcn_fence(__ATOMIC_ACQUIRE, "agent");
            asm volatile("s_waitcnt vmcnt(0)" ::: "memory");
        }
    }
    __syncthreads();
}


__global__ void __launch_bounds__(512) mega_fwd(Params p) {
    extern __shared__ __attribute__((aligned(16))) unsigned char lds_raw[];
    LAS unsigned char* lds = (LAS unsigned char*)lds_raw;
    cg::grid_group grid = cg::this_grid();
    volatile LAS unsigned* bst = (volatile LAS unsigned*)(lds + 140032);
    if (threadIdx.x == 0) { bst[0] = 0u; bst[1] = 0u; const unsigned long long ba = (unsigned long long)(p.ws + SM_BAR); bst[2] = (unsigned)ba; bst[3] = (unsigned)(ba >> 32); }
    __syncthreads();
    (void)xcd_barrier_post((unsigned*)(p.ws + SM_BAR), bst);
#define GSYNC() do { XcdBarrier xb_; volatile LAS unsigned* st_ = (volatile LAS unsigned*)(lds + 140032); xb_.bar = (unsigned*)(((unsigned long long)st_[3] << 32) | st_[2]); xb_.x = xb_xcc_id(); xb_.st = st_; xcd_barrier(xb_); } while (0)
    const int G = gridDim.x, c = blockIdx.x;
#define LP() bf16_t* W = (bf16_t*)p.ws; bf16_t* xn = (bf16_t*)(p.ws + R_XN); float* x1 = (float*)(p.ws + R_XA); pg8::StaticOrder SO; (void)W; (void)xn; (void)x1; (void)SO
#ifndef PHMASK
#define PHMASK 0xFFFFFFFFu
#endif
#ifndef REPEAT_MASK
#define REPEAT_MASK 0u
#endif
#define PH(k) if (((PHMASK >> (k)) & 1u) && (k) >= p.ph_lo && (k) <= p.ph_hi)
#define RPT(k) if ((REPEAT_MASK >> (k)) & 1u)
    PH(0) { LP(); phase_p0(p, lds); }
    grid.sync();
    RPT(0) { { LP(); phase_p0(p, lds); } GSYNC(); }
    PH(1) { LP();
        pg8::Gemm g{xn, W + W_IN_E / 2, T, 1792, 1024, 1024, nullptr, 0}; SO.init(T, 1792, G, c);
        pg8::EpiBf16<0> E{(bf16_t*)(p.ws + R_H), 1792, nullptr};
        pg8::gemm_phase<pg8::EpiBf16<0>, true>(lds, g, SO, E);
    }
    GSYNC();
    PH(2) { LP(); phase_p2(p, lds); }
    GSYNC();
    RPT(2) { { LP(); phase_p2(p, lds); } GSYNC(); }
    PH(3) { LP();
        const int nCu = 2 * (NB * 512 / 256), Gc = (nCu < G / 2) ? nCu : 0;
        if (Gc == 0 || c < Gc) {
            for (int kv = 0; kv < 2; ++kv) {
                pg8::Gemm g{(const bf16_t*)(p.ws + R_XA + (kv ? A_VCIN : A_KCIN)), W + W_CW1 / 2 + (size_t)kv * 256 * 2048, NB * 512, 256, 2048, 1024, nullptr, 0};
                if (Gc) SO.init(NB * 512, 256, Gc / 2, c - kv * (Gc / 2)); else SO.init(NB * 512, 256, G, c);
                pg8::EpiBf16<2> E{(bf16_t*)(p.ws + SM_HID) + (size_t)kv * NB * 512 * 256, 256, (const float*)(p.ws + SM_B1) + kv * 256};
                if (Gc == 0 || (c / (Gc / 2)) == kv) pg8::gemm_phase<pg8::EpiBf16<2>, true>(lds, g, SO, E);
            }
        }
        if (Gc == 0 || c >= Gc) {
            {
                pg8::Gemm g{(const bf16_t*)(p.ws + R_XA + A_CQN), W + W_UQ / 2, T, 1024, 256, 256, nullptr, 0}; SO.init(T, 1024, G - Gc, c - Gc);
                pg8::EpiBf16<0> E{(bf16_t*)(p.ws + R_H), 1024, nullptr};
                pg8::gemm_phase<pg8::EpiBf16<0>, true>(lds, g, SO, E);
            }
            {
                pg8::Gemm g{(const bf16_t*)(p.ws + R_XA + A_CKVN), W + W_UKV / 2, T, 1024, 128, 128, nullptr, 0}; SO.init(T, 1024, G - Gc, c - Gc);
                pg8::EpiBf16<0> E{(bf16_t*)(p.ws + R_H + (size_t)T * 2048), 1024, nullptr};
                pg8::gemm_phase<pg8::EpiBf16<0>, true>(lds, g, SO, E);
            }
        }
    }
    GSYNC();
    PH(4) { LP(); phase_p3b(p, lds); }
    GSYNC();
    RPT(4) { { LP(); phase_p3b(p, lds); } GSYNC(); }
    PH(5) { LP(); phase_p4(p, lds); }
    GSYNC();
    RPT(5) { { LP(); phase_p4(p, lds); } GSYNC(); }
    PH(6) { LP();
        pg8::Gemm g{xn, W + W_OUT_E / 2, T, 1024, 1024, 1024, nullptr, 0}; SO.init(T, 1024, G, c);
        pg8::EpiResF32 E{p.in[0], x1, 1024};
        pg8::gemm_phase<pg8::EpiResF32, true>(lds, g, SO, E);
    }
    GSYNC();
    PH(7) { LP(); phase_norm(x1, p.in[16], xn); }
    GSYNC();
    RPT(7) { { LP(); phase_norm(x1, p.in[16], xn); } GSYNC(); }
    PH(8) { LP();
        pg8::Gemm g{xn, W + W_GU / 2, T, 5632, 1024, 1024, nullptr, 0}; SO.init(T, 5632, G, c);
        pg8::EpiSwiGLU E{(bf16_t*)(p.ws + R_H), 2816};
        pg8::gemm_phase<pg8::EpiSwiGLU, true>(lds, g, SO, E);
    }
    GSYNC();
    PH(9) { LP();
        pg8::Gemm g{(const bf16_t*)(p.ws + R_H), W + W_D / 2, T, 1024, 2816, 2816, nullptr, 0}; SO.init(T, 1024, G, c);
        pg8::EpiResF32 E{x1, p.out, 1024};
        pg8::gemm_phase<pg8::EpiResF32, true>(lds, g, SO, E);
    }
    GSYNC();
    PH(10) { LP(); phase_norm(p.out, p.in[20], xn); }
    GSYNC();
    PH(11) { LP();
        pg8::Gemm g{xn, W + W_IN_O / 2, T, 3072, 1024, 1024, nullptr, 0}; SO.init(T, 3072, G, c);
        pg8::EpiBf16<0> E{(bf16_t*)(p.ws + R_H), 3072, nullptr};
        pg8::gemm_phase<pg8::EpiBf16<0>, true>(lds, g, SO, E);
    }
    GSYNC();
    PH(12) { LP(); phase_conv(p); }
    GSYNC();
    RPT(12) { { LP(); phase_conv(p); } GSYNC(); }
    PH(13) { LP();
        pg8::Gemm g{xn, W + W_OUT_O / 2, T, 1024, 1024, 1024, nullptr, 0}; SO.init(T, 1024, G, c);
        pg8::EpiResF32 E{p.out, p.out, 1024};
        pg8::gemm_phase<pg8::EpiResF32, true>(lds, g, SO, E);
    }
    GSYNC();
    PH(14) { LP(); phase_norm_router(p, lds); }
    GSYNC();
    PH(15) { LP(); phase_moe_gather(p); }
    GSYNC();
    PH(16) { LP(); const int mrows = ((const int*)(p.ws + SM_CTL))[8];
        pg8::Gemm g{(const bf16_t*)(p.ws + R_XA), W + W_MGU / 2, mrows, 2816, 1024, 1024, (const int*)(p.ws + SM_TILEE), (size_t)2816 * 1024}; SO.init(mrows, 2816, G, c);
        pg8::EpiSwiGLU E{(bf16_t*)(p.ws + R_H), 1408};
        pg8::gemm_phase<pg8::EpiSwiGLU, true>(lds, g, SO, E);
    }
    GSYNC();
    PH(17) { LP(); const int mrows = ((const int*)(p.ws + SM_CTL))[8];
        pg8::Gemm g{(const bf16_t*)(p.ws + R_H), W + W_MD / 2, mrows, 1024, 1408, 1408, (const int*)(p.ws + SM_TILEE), (size_t)1024 * 1408}; SO.init(mrows, 1024, G, c);
        pg8::EpiRowScaleBf16 E{(bf16_t*)(p.ws + R_XA), 1024, (const float*)(p.ws + SM_ROWW)};
        pg8::gemm_phase<pg8::EpiRowScaleBf16, true>(lds, g, SO, E);
    }
    GSYNC();
    PH(18) { LP(); phase_moe_combine(p); }
#undef PH
}

inline void launch(void* const* d_in, float* d_out, void* d_ws, size_t ws_size, hipStream_t stream, int ph_lo = 0, int ph_hi = 99, int dbg_branch = -1) {
    static int grid = 0;
    if (grid == 0) {
        int dev = 0, cus = 0, per_cu = 0;
        hipGetDevice(&dev); hipDeviceGetAttribute(&cus, hipDeviceAttributeMultiprocessorCount, dev);
        hipFuncSetAttribute((const void*)mega_fwd, hipFuncAttributeMaxDynamicSharedMemorySize, LDS_BYTES);
        hipOccupancyMaxActiveBlocksPerMultiprocessor(&per_cu, (const void*)mega_fwd, 512, LDS_BYTES);
        if (per_cu < 1) { fprintf(stderr, "occupancy query says %d blocks/CU\n", per_cu); per_cu = 1; }
        grid = cus;
        if (WS_FAST_END > ws_size) { fprintf(stderr, "ws too small: need %zu have %zu\n", (size_t)WS_FAST_END, ws_size); grid = -1; }
    }
    if (grid < 0) return;
    if (ph_lo <= 14 && ph_hi >= 14) hipMemsetAsync((char*)d_ws + SM_CTL, 0, 4096, stream);
    hipMemsetAsync((char*)d_ws + SM_BAR, 0, 16384, stream);
    Params p{};
    for (int i = 0; i < 30; ++i) p.in[i] = (const float*)d_in[i];
    p.out = d_out; p.ws = (unsigned char*)d_ws; p.ph_lo = ph_lo; p.ph_hi = ph_hi; p.dbg_branch = dbg_branch;
    void* args[] = {&p};
    hipError_t e = hipLaunchCooperativeKernel((const void*)mega_fwd, dim3(grid), dim3(512), args, LDS_BYTES, stream);
    if (e != hipSuccess) fprintf(stderr, "cooperative launch failed: %s (grid %d)\n", hipGetErrorString(e), grid);
}
}
extern "C" void kernel_launch(void* const* d_in, const int* in_sizes, int n_in, void* d_out, int out_size, void* d_ws, size_t ws_size, hipStream_t stream) {
    fast::launch(d_in, (float*)d_out, d_ws, ws_size, stream);
}
```

```cpp
#include <hip/hip_runtime.h>
#include <hip/hip_bf16.h>
#include <stdint.h>
#include <stdio.h>
#include <string.h>
#include <hip/hip_cooperative_groups.h>
namespace cg = cooperative_groups;
#define NB 8
#define REPEAT_MASK 0x0u
namespace gold {
constexpr int S = 4096, D = 1024, HW = 1720;
constexpr float EPS = 1e-6f;

__device__ const unsigned char T5B[128] = {0, 1, 2, 3, 4, 5, 6, 7, 8, 9, 10, 11, 12, 13, 14, 15, 16, 16, 16, 17, 17, 18, 18, 18, 19, 19, 19, 20, 20, 20, 20, 21, 21, 21, 21, 22, 22, 22, 22, 22, 23, 23, 23, 23, 23, 23, 24, 24, 24, 24, 24, 24, 25, 25, 25, 25, 25, 25, 25, 26, 26, 26, 26, 26, 26, 26, 26, 27, 27, 27, 27, 27, 27, 27, 27, 27, 27, 28, 28, 28, 28, 28, 28, 28, 28, 28, 28, 29, 29, 29, 29, 29, 29, 29, 29, 29, 29, 29, 29, 30, 30, 30, 30, 30, 30, 30, 30, 30, 30, 30, 30, 30, 30, 31, 31, 31, 31, 31, 31, 31, 31, 31, 31, 31, 31, 31, 31};
}
#ifndef NB
#define NB 8
#endif
namespace fast {
#define LAS __attribute__((address_space(3)))
typedef unsigned short bf16_t;
typedef short bf16x8 __attribute__((ext_vector_type(8)));
typedef float f32x4 __attribute__((ext_vector_type(4)));
typedef float f32x2 __attribute__((ext_vector_type(2)));
typedef float f32x16 __attribute__((ext_vector_type(16)));
typedef unsigned u32x4 __attribute__((ext_vector_type(4)));
typedef unsigned u32x2 __attribute__((ext_vector_type(2)));
typedef __bf16 bf16x2_t __attribute__((ext_vector_type(2)));

constexpr int S = 4096, T = NB * S, D = 1024;
constexpr float EPS = 1e-6f, LOG2E = 1.4426950408889634f;

__device__ __forceinline__ unsigned cvtpk(float lo, float hi) { f32x2 v = {lo, hi}; bf16x2_t b = __builtin_convertvector(v, bf16x2_t); return __builtin_bit_cast(unsigned, b); }
__device__ __forceinline__ bf16_t f2bf(float f) { return (bf16_t)(cvtpk(f, 0.f) & 0xffffu); }
__device__ __forceinline__ float bf2f(bf16_t u) { return __builtin_bit_cast(float, (unsigned)u << 16); }
__device__ __forceinline__ float bflo(unsigned u) { return __builtin_bit_cast(float, u << 16); }
__device__ __forceinline__ float bfhi(unsigned u) { return __builtin_bit_cast(float, u & 0xffff0000u); }
__device__ __forceinline__ float wsum(float v) {
#pragma unroll
    for (int o = 1; o < 64; o <<= 1) v += __shfl_xor(v, o);
    return v;
}
__device__ __forceinline__ float fexp2(float x) { return __builtin_amdgcn_exp2f(x); }
__device__ __forceinline__ float frcp(float x) { return __builtin_amdgcn_rcpf(x); }
__device__ __forceinline__ float silu_f(float x) { return x * frcp(1.f + fexp2(-x * LOG2E)); }
__device__ __forceinline__ float gelu_tanh_f(float x) {
    const float u = 0.7978845608028654f * (x + 0.044715f * x * x * x);
    return x * frcp(1.f + fexp2(-2.f * LOG2E * u));
}

namespace pg8 {
constexpr int BM = 256, BK = 64, HALF = 128, HTB = HALF * BK * 2, STAGE_BYTES = 8 * HTB, NXCD = 8, WGM = 8;
__host__ __device__ __forceinline__ int lds_byte(int r, int c) { const int st = (r >> 4) * 2 + (c >> 5), rr = r & 15, cc = c & 31, ob = rr * 64 + cc * 2; return st * 1024 + (ob ^ (((ob >> 9) & 1) << 5)); }
__host__ __device__ __forceinline__ void stage_rc(int b, int& R, int& C) { const int st = b / 1024, sb = b % 1024, swz = sb ^ (((sb >> 9) & 1) << 5); R = (st >> 1) * 16 + swz / 64; C = (st & 1) * 32 + (swz % 64) / 2; }
__host__ __device__ __forceinline__ int perm32(int rho) { const int n = rho >> 4, i = rho & 15; return 8 * (i >> 2) + 4 * n + (i & 3); }

struct Unit { int pm, pn; };
struct Gemm { const bf16_t* A; const bf16_t* Bt; int M, N, K, lda; const int* tile_e; size_t estride; };

struct StaticOrder {
    int nM, nN, nwg, G, c;
    __device__ void init(int M, int N, int G_, int c_) { nM = M / BM; nN = N / BM; nwg = nM * nN; G = G_; c = c_; }
    __device__ bool next(int i, Unit& u) const {
        const long L = (long)i * G + c; if (L >= nwg) return false;
        int wgid = (int)L; { const int q = nwg / NXCD, r = nwg % NXCD, xcd = wgid % NXCD, off = wgid / NXCD; wgid = (xcd < r ? xcd * (q + 1) : r * (q + 1) + (xcd - r) * q) + off; }
        const int nig = WGM * nN, gid = wgid / nig, fm = gid * WGM, gsz = (nM - fm) < WGM ? (nM - fm) : WGM;
        u.pm = fm + ((wgid % nig) % gsz); u.pn = (wgid % nig) / gsz; return true;
    }
};

template <class Epi, bool ALIGN_EPI>
__device__ __forceinline__ void gemm_phase(LAS unsigned char* lds, const Gemm g, const StaticOrder& S, const Epi& E) {
    int tid = threadIdx.x; asm volatile("" : "+v"(tid));
    const int wid = __builtin_amdgcn_readfirstlane(tid >> 6), lane = tid & 63, wr = wid >> 2, wc = wid & 3, fr = lane & 15, fq = lane >> 4;
    const int K = g.K, nt = K / BK, lda = g.lda;
    unsigned voffA[2], voffB[2];
#pragma unroll
    for (int i = 0; i < 2; ++i) { int R, C; stage_rc(tid * 16 + i * 8192, R, C); const int Rb = Epi::PERM ? ((R & ~31) + perm32(R & 31)) : R;
        voffA[i] = (unsigned)(R * lda + C) * 2u; voffB[i] = (unsigned)(Rb * K + C) * 2u; }
    const size_t kstep = (size_t)(BK * 2);
    const size_t hsA = (size_t)HALF * lda * 2, tsA = 2 * hsA, hsB = (size_t)HALF * K * 2, tsB = 2 * hsB;
    const unsigned ldsw = (unsigned)wid * 1024u;
    const int aoff = lds_byte(wr * 64 + fr, fq * 8), boff = lds_byte(wc * 32 + fr, fq * 8);
#define PG8_SA(b, h) (((b) * 2 + (h)) * HTB)
#define PG8_SB(b, h) ((4 + (b) * 2 + (h)) * HTB)
#define PG8_STAGE(bufoff, gbase, voff) do { _Pragma("unroll") for (int _i = 0; _i < 2; ++_i) \
        __builtin_amdgcn_global_load_lds((const unsigned*)((const char*)(gbase) + (voff)[_i]), (LAS unsigned*)(lds + (bufoff) + ldsw + _i * 8192), 16, 0, 0); } while (0)
#define PG8_LDA(dst, b, h) do { _Pragma("unroll") for (int m = 0; m < 4; ++m) _Pragma("unroll") for (int k = 0; k < 2; ++k) dst[m][k] = *(const LAS bf16x8*)(lds + PG8_SA(b, h) + aoff + m * 2048 + k * 1024); } while (0)
#define PG8_LDB(dst, b, h) do { _Pragma("unroll") for (int n = 0; n < 2; ++n) _Pragma("unroll") for (int k = 0; k < 2; ++k) dst[n][k] = *(const LAS bf16x8*)(lds + PG8_SB(b, h) + boff + n * 2048 + k * 1024); } while (0)
#define PG8_MMA(ai, bj, At, Bt) do { __builtin_amdgcn_s_setprio(1); _Pragma("unroll") for (int m = 0; m < 4; ++m) _Pragma("unroll") for (int n = 0; n < 2; ++n) _Pragma("unroll") for (int k = 0; k < 2; ++k) \
        acc[ai][bj][m][n] = __builtin_amdgcn_mfma_f32_16x16x32_bf16(Bt[n][k], At[m][k], acc[ai][bj][m][n], 0, 0, 0); __builtin_amdgcn_s_setprio(0); } while (0)
#define PG8_WAIT_V(n) asm volatile("s_waitcnt vmcnt(" #n ")" ::: "memory")
#define PG8_WAIT_L(n) asm volatile("s_waitcnt lgkmcnt(" #n ")" ::: "memory")
#define PG8_BAR __builtin_amdgcn_s_barrier()
#define PG8_SCHED __builtin_amdgcn_sched_barrier(0)
#define PG8_EOFF(pm_) (g.tile_e ? (size_t)g.tile_e[pm_] * g.estride * 2 : (size_t)0)
    Unit cur, nxt; int ui = 0;
    if (!S.next(0, cur)) return;
    f32x4 acc[2][2][4][2];
#pragma unroll
    for (int a = 0; a < 2; ++a)
#pragma unroll
        for (int b = 0; b < 2; ++b)
#pragma unroll
            for (int m = 0; m < 4; ++m)
#pragma unroll
                for (int n = 0; n < 2; ++n) acc[a][b][m][n] = (f32x4){0.f, 0.f, 0.f, 0.f};
    bf16x8 At[4][2], B0[2][2], B1[2][2];
    const char* cA = (const char*)g.A + (size_t)cur.pm * tsA; const char* cB = (const char*)g.Bt + PG8_EOFF(cur.pm) + (size_t)cur.pn * tsB;
    PG8_STAGE(PG8_SB(0, 0), cB, voffB); PG8_STAGE(PG8_SB(0, 1), cB + hsB, voffB); PG8_STAGE(PG8_SA(0, 0), cA, voffA); PG8_STAGE(PG8_SA(0, 1), cA + hsA, voffA);
    if (wr == 1) PG8_BAR;
    PG8_WAIT_V(2); PG8_BAR;
    PG8_STAGE(PG8_SB(1, 0), cB + kstep, voffB); PG8_STAGE(PG8_SA(1, 0), cA + kstep, voffA); PG8_STAGE(PG8_SB(1, 1), cB + hsB + kstep, voffB);
    PG8_WAIT_V(6); PG8_BAR;
    for (;;) {
        const bool has_next = S.next(ui + 1, nxt);
        const char* nA = has_next ? (const char*)g.A + (size_t)nxt.pm * tsA : cA;
        const char* nB = has_next ? (const char*)g.Bt + PG8_EOFF(nxt.pm) + (size_t)nxt.pn * tsB : cB;
        for (int t = 0; t < nt; t += 2) {
            const bool last = (t == nt - 2);
            const char* a1 = cA + (size_t)(t + 1) * kstep;
            const char* a2 = last ? nA : cA + (size_t)(t + 2) * kstep; const char* b2 = last ? nB : cB + (size_t)(t + 2) * kstep;
            const char* a3 = a2 + kstep; const char* b3 = b2 + kstep;
            PG8_LDB(B0, 0, 0); PG8_LDB(B1, 0, 1); PG8_SCHED; PG8_LDA(At, 0, 0); PG8_STAGE(PG8_SA(1, 1), a1 + hsA, voffA);
            PG8_WAIT_V(8); PG8_WAIT_L(0); PG8_BAR; PG8_MMA(0, 0, At, B0); PG8_MMA(0, 1, At, B1); PG8_BAR; PG8_SCHED;
            PG8_LDA(At, 0, 1); PG8_STAGE(PG8_SB(0, 0), b2, voffB); PG8_STAGE(PG8_SB(0, 1), b2 + hsB, voffB); PG8_STAGE(PG8_SA(0, 0), a2, voffA);
            PG8_WAIT_V(8); PG8_WAIT_L(0); PG8_BAR; PG8_MMA(1, 0, At, B0); PG8_MMA(1, 1, At, B1); PG8_BAR; PG8_SCHED;
            PG8_LDB(B0, 1, 0); PG8_LDB(B1, 1, 1); PG8_SCHED; PG8_LDA(At, 1, 0); PG8_STAGE(PG8_SA(0, 1), a2 + hsA, voffA);
            PG8_WAIT_V(8); PG8_WAIT_L(0); PG8_BAR; PG8_MMA(0, 0, At, B0); PG8_MMA(0, 1, At, B1); PG8_BAR; PG8_SCHED;
            PG8_LDA(At, 1, 1); PG8_STAGE(PG8_SB(1, 0), b3, voffB); PG8_STAGE(PG8_SB(1, 1), b3 + hsB, voffB); PG8_STAGE(PG8_SA(1, 0), a3, voffA);
            PG8_WAIT_V(8); PG8_WAIT_L(0); PG8_BAR; PG8_MMA(1, 0, At, B0); PG8_MMA(1, 1, At, B1); PG8_BAR; PG8_SCHED;
        }
        if constexpr (ALIGN_EPI) { if (wr == 0) PG8_BAR; }
        E(acc, cur, wr, wc, fr, fq);
        if (!has_next) break;
#pragma unroll
        for (int a = 0; a < 2; ++a)
#pragma unroll
            for (int b = 0; b < 2; ++b)
#pragma unroll
                for (int m = 0; m < 4; ++m)
#pragma unroll
                    for (int n = 0; n < 2; ++n) acc[a][b][m][n] = (f32x4){0.f, 0.f, 0.f, 0.f};
        cur = nxt; cA = nA; cB = nB; ++ui;
        if constexpr (ALIGN_EPI) { if (wr == 1) PG8_BAR; }
    }
    PG8_WAIT_V(0);
    if constexpr (!ALIGN_EPI) { if (wr == 0) PG8_BAR; }
    PG8_BAR;
#undef PG8_SA
#undef PG8_SB
#undef PG8_STAGE
#undef PG8_LDA
#undef PG8_LDB
#undef PG8_MMA
#undef PG8_WAIT_V
#undef PG8_WAIT_L
#undef PG8_BAR
#undef PG8_SCHED
#undef PG8_EOFF
}

__device__ __forceinline__ float row_rstd(const float* ssp, int row);
template <int ACT> struct EpiBf16 {
    static constexpr bool PERM = true;
    bf16_t* O; int ldc; const float* bias; const float* ssp;
    __device__ __forceinline__ void operator()(const f32x4 (&acc)[2][2][4][2], const Unit& u, int wr, int wc, int fr, int fq) const {
        const int row0 = u.pm * BM + wr * 64 + fr, col0 = u.pn * BM + wc * 32 + 8 * fq;
        f32x4 bv[2][2];
#pragma unroll
        for (int bj = 0; bj < 2; ++bj)
#pragma unroll
            for (int n = 0; n < 2; ++n) bv[bj][n] = bias ? *(const f32x4*)(bias + col0 + bj * HALF + 4 * n) : (f32x4){0.f, 0.f, 0.f, 0.f};
#pragma unroll
        for (int ai = 0; ai < 2; ++ai)
#pragma unroll
            for (int m = 0; m < 4; ++m) { bf16_t* rowp = O + (size_t)(row0 + ai * HALF + m * 16) * ldc + col0;
                const float rs = (ACT == 0 && ssp) ? row_rstd(ssp, row0 + ai * HALF + m * 16) : 1.f;
#pragma unroll
                for (int bj = 0; bj < 2; ++bj) { f32x4 v0 = acc[ai][bj][m][0] * rs + bv[bj][0], v1 = acc[ai][bj][m][1] * rs + bv[bj][1];
                    if (ACT == 2) {
#pragma unroll
                        for (int i = 0; i < 4; ++i) { v0[i] = gelu_tanh_f(v0[i]); v1[i] = gelu_tanh_f(v1[i]); } }
                    u32x4 w; w.x = cvtpk(v0[0], v0[1]); w.y = cvtpk(v0[2], v0[3]); w.z = cvtpk(v1[0], v1[1]); w.w = cvtpk(v1[2], v1[3]);
                    *(u32x4*)(rowp + bj * HALF) = w; } }
    }
};
struct EpiResF32 {
    static constexpr bool PERM = false;
    const float* base; float* out; int ldc;
    __device__ __forceinline__ void operator()(const f32x4 (&acc)[2][2][4][2], const Unit& u, int wr, int wc, int fr, int fq) const {
        const int col0 = u.pn * BM + wc * 32 + 4 * fq;
#pragma unroll
        for (int ai = 0; ai < 2; ++ai)
#pragma unroll
            for (int m = 0; m < 4; ++m) { const size_t off = (size_t)(u.pm * BM + ai * HALF + wr * 64 + m * 16 + fr) * ldc + col0;
#pragma unroll
                for (int bj = 0; bj < 2; ++bj)
#pragma unroll
                    for (int n = 0; n < 2; ++n) { const f32x4 bs = *(const f32x4*)(base + off + bj * HALF + n * 16); *(f32x4*)(out + off + bj * HALF + n * 16) = bs + acc[ai][bj][m][n]; } }
    }
};
struct EpiResF32Stat {
    static constexpr bool PERM = false;
    const float* base; float* out; bf16_t* xb; float* ssp; int ldc;
    __device__ __forceinline__ void operator()(const f32x4 (&acc)[2][2][4][2], const Unit& u, int wr, int wc, int fr, int fq) const {
        const int col0 = u.pn * BM + wc * 32 + 4 * fq;
#pragma unroll
        for (int ai = 0; ai < 2; ++ai)
#pragma unroll
            for (int m = 0; m < 4; ++m) { const int row = u.pm * BM + ai * HALF + wr * 64 + m * 16 + fr; const size_t off = (size_t)row * ldc + col0; float ss = 0.f;
#pragma unroll
                for (int bj = 0; bj < 2; ++bj)
#pragma unroll
                    for (int n = 0; n < 2; ++n) { const f32x4 v = *(const f32x4*)(base + off + bj * HALF + n * 16) + acc[ai][bj][m][n]; *(f32x4*)(out + off + bj * HALF + n * 16) = v;
                        u32x2 w; w.x = cvtpk(v.x, v.y); w.y = cvtpk(v.z, v.w); *(u32x2*)(xb + off + bj * HALF + n * 16) = w; ss += (v.x * v.x + v.y * v.y) + (v.z * v.z + v.w * v.w); }
                ss += __shfl_xor(ss, 16); ss += __shfl_xor(ss, 32);
                if (fq == 0) ssp[(size_t)row * 16 + u.pn * 4 + wc] = ss; }
    }
};
__device__ __forceinline__ float row_rstd(const float* ssp, int row) {
    const f32x4* q = (const f32x4*)(ssp + (size_t)row * 16); const f32x4 a = q[0], b = q[1], c = q[2], d = q[3];
    const float s = ((a.x + a.y) + (a.z + a.w)) + ((b.x + b.y) + (b.z + b.w)) + ((c.x + c.y) + (c.z + c.w)) + ((d.x + d.y) + (d.z + d.w));
    return rsqrtf(s * (1.f / 1024.f) + EPS);
}
struct EpiSwiGLU {
    static constexpr bool PERM = true;
    bf16_t* O; int ldc; const float* ssp;
    __device__ __forceinline__ void operator()(const f32x4 (&acc)[2][2][4][2], const Unit& u, int wr, int wc, int fr, int fq) const {
        const int row0 = u.pm * BM + wr * 64 + fr, col0 = u.pn * HALF + wc * 32 + 8 * fq;
#pragma unroll
        for (int ai = 0; ai < 2; ++ai)
#pragma unroll
            for (int m = 0; m < 4; ++m) { bf16_t* rowp = O + (size_t)(row0 + ai * HALF + m * 16) * ldc + col0;
                const float rs = ssp ? row_rstd(ssp, row0 + ai * HALF + m * 16) : 1.f;
                float h[8];
#pragma unroll
                for (int n = 0; n < 2; ++n)
#pragma unroll
                    for (int i = 0; i < 4; ++i) h[n * 4 + i] = silu_f(acc[ai][0][m][n][i] * rs) * (acc[ai][1][m][n][i] * rs);
                u32x4 w; w.x = cvtpk(h[0], h[1]); w.y = cvtpk(h[2], h[3]); w.z = cvtpk(h[4], h[5]); w.w = cvtpk(h[6], h[7]);
                *(u32x4*)rowp = w; }
    }
};
struct EpiRowScaleBf16 {
    static constexpr bool PERM = true;
    bf16_t* O; int ldc; const float* roww;
    __device__ __forceinline__ void operator()(const f32x4 (&acc)[2][2][4][2], const Unit& u, int wr, int wc, int fr, int fq) const {
        const int row0 = u.pm * BM + wr * 64 + fr, col0 = u.pn * BM + wc * 32 + 8 * fq;
#pragma unroll
        for (int ai = 0; ai < 2; ++ai)
#pragma unroll
            for (int m = 0; m < 4; ++m) { const int row = row0 + ai * HALF + m * 16; const float sc = roww[row]; bf16_t* rowp = O + (size_t)row * ldc + col0;
#pragma unroll
                for (int bj = 0; bj < 2; ++bj) { const f32x4 v0 = acc[ai][bj][m][0] * sc, v1 = acc[ai][bj][m][1] * sc;
                    u32x4 w; w.x = cvtpk(v0[0], v0[1]); w.y = cvtpk(v0[2], v0[3]); w.z = cvtpk(v1[0], v1[1]); w.w = cvtpk(v1[2], v1[3]);
                    *(u32x4*)(rowp + bj * HALF) = w; } }
    }
};
}
constexpr int ROWS_MAX = 2 * T + 8 * 256;
constexpr size_t al256(size_t x) { return (x + 255) & ~(size_t)255; }
constexpr size_t W_IN_E = 0;
constexpr size_t W_CW1 = W_IN_E + (size_t)1792 * 1024 * 2;
constexpr size_t W_UQ = W_CW1 + (size_t)2 * 256 * 2048 * 2;
constexpr size_t W_UKV = W_UQ + (size_t)1024 * 256 * 2;
constexpr size_t W_OUT_E = W_UKV + (size_t)1024 * 128 * 2;
constexpr size_t W_GU = W_OUT_E + (size_t)1024 * 1024 * 2;
constexpr size_t W_D = W_GU + (size_t)5632 * 1024 * 2;
constexpr size_t W_IN_O = W_D + (size_t)1024 * 2816 * 2;
constexpr size_t W_OUT_O = W_IN_O + (size_t)3072 * 1024 * 2;
constexpr size_t W_MGU = W_OUT_O + (size_t)1024 * 1024 * 2;
constexpr size_t W_MD = W_MGU + (size_t)8 * 2816 * 1024 * 2;
constexpr size_t W_END = W_MD + (size_t)8 * 1024 * 1408 * 2;
constexpr size_t SM_CTL = al256(W_END);
constexpr size_t SM_BAR = SM_CTL + 4096;
constexpr size_t SM_B1P = SM_BAR + 16384;
constexpr size_t SM_B1 = SM_B1P + 32 * 512 * 4;
constexpr size_t SM_ROPE = SM_B1 + 512 * 4;
constexpr size_t SM_BL = SM_ROPE + (size_t)S * 32 * 4;
constexpr size_t SM_HID = SM_BL + 8 * 132 * 4;
constexpr size_t SM_KC = SM_HID + (size_t)2 * NB * 512 * 256 * 2;
constexpr size_t SM_VCT = SM_KC + (size_t)NB * 512 * 64 * 2;
constexpr size_t SM_TE = SM_VCT + (size_t)NB * 512 * 64 * 2;
constexpr size_t SM_TW = SM_TE + (size_t)T * 8;
constexpr size_t SM_RANK = SM_TW + (size_t)T * 8;
constexpr size_t SM_POS = SM_RANK + (size_t)T * 8;
constexpr size_t SM_ROWW = SM_POS + (size_t)T * 8;
constexpr size_t SM_TILEE = SM_ROWW + (size_t)ROWS_MAX * 4;
constexpr size_t SM_SSP1 = al256(SM_TILEE + (size_t)(ROWS_MAX / 256 + 8) * 4);
constexpr size_t SM_SSP2 = SM_SSP1 + (size_t)T * 64;
constexpr size_t SM_END = SM_SSP2 + (size_t)T * 64;
constexpr size_t R_XA = al256(SM_END);
constexpr size_t SZ_XA = (size_t)T * 4096 + (size_t)4 * 1048576;
constexpr size_t R_XN = R_XA + SZ_XA;
constexpr size_t SZ_XN = (size_t)T * 2048;
constexpr size_t R_H = R_XN + SZ_XN;
constexpr size_t SZ_H = ((size_t)T * 6144 > (size_t)ROWS_MAX * 2816) ? (size_t)T * 6144 : (size_t)ROWS_MAX * 2816;
constexpr size_t WS_FAST_END = R_H + SZ_H;
constexpr size_t A_QN = 0;
constexpr size_t A_KSN = A_QN + (size_t)T * 1024;
constexpr size_t A_KWN = A_KSN + (size_t)T * 256;
constexpr size_t A_VST = A_KWN + (size_t)T * 256;
constexpr size_t A_VWT = A_VST + (size_t)T * 256;
constexpr size_t A_KCIN = A_VWT + (size_t)T * 256;
constexpr size_t A_VCIN = A_KCIN + (size_t)T * 256 + 2048;
constexpr size_t A_CQN = A_VCIN + (size_t)T * 256 + 2048;
constexpr size_t A_CKVN = A_CQN + (size_t)T * 512;
constexpr size_t A_KROPE = A_CKVN + (size_t)T * 256;
constexpr size_t A_GATES = A_KROPE + (size_t)T * 64;
constexpr size_t A_END = A_GATES + (size_t)T * 96;
static_assert(A_END <= SZ_XA, "attention inputs fit R_XA");
constexpr size_t O_QM = 0;
constexpr size_t O_KM = O_QM + (size_t)T * 1536;
constexpr size_t O_VMT = O_KM + (size_t)T * 1536;
static_assert(O_VMT + (size_t)T * 1024 <= (size_t)T * 4096, "d_out scratch");

struct Params {
    const float* in[30];
    float* out;
    unsigned char* ws;
    int ph_lo, ph_hi, dbg_branch, pad_;
};

constexpr int LDS_BYTES = 147456;

__device__ __forceinline__ int ltid() { int t = threadIdx.x; asm volatile("" : "+v"(t)); return t; }
__device__ __forceinline__ int perm16(int k) { return (k & ~12) | ((k & 4) << 1) | ((k & 8) >> 1); }

struct WDesc { int in_idx, K, N, rep, map, row_off; size_t src_stride, dst_off, dst_stride; int gain_idx, pad_; };
__device__ const WDesc WDESC[12] = {
    {3, 1024, 1720, 1, 2, 0, 0, W_IN_E / 2, 0, -1, 0},
    {7, 2048, 256, 2, 0, 0, (size_t)2048 * 256, W_CW1 / 2, (size_t)256 * 2048, -1, 0},
    {11, 256, 768, 1, 3, 0, 0, W_UQ / 2, 0, -1, 0},
    {12, 128, 1024, 1, 0, 0, 0, W_UKV / 2, 0, -1, 0},
    {15, 1024, 1024, 1, 0, 0, 0, W_OUT_E / 2, 0, -1, 0},
    {17, 1024, 2816, 1, 1, 0, 0, W_GU / 2, 0, 16, 0},
    {18, 1024, 2816, 1, 1, 128, 0, W_GU / 2, 0, 16, 0},
    {19, 2816, 1024, 1, 0, 0, 0, W_D / 2, 0, -1, 0},
    {21, 1024, 3072, 1, 0, 0, 0, W_IN_O / 2, 0, 20, 0},
    {23, 1024, 1024, 1, 0, 0, 0, W_OUT_O / 2, 0, -1, 0},
    {27, 1024, 1408, 8, 1, 0, (size_t)1024 * 1408, W_MGU / 2, (size_t)2816 * 1024, -1, 0},
    {28, 1024, 1408, 8, 1, 128, (size_t)1024 * 1408, W_MGU / 2, (size_t)2816 * 1024, -1, 0},
};
__device__ const WDesc WDESC_MD = {29, 1408, 1024, 8, 0, 0, (size_t)1408 * 1024, W_MD / 2, (size_t)1024 * 1408, -1, 0};

__device__ __forceinline__ void transpose_item(const float* W, int K, int N, bf16_t* WT, int map, int row_off, const float* gain, LAS float* scr, int item, int lane) {
    const int nblk = (N + 31) / 32, kb = item / nblk, nb = item % nblk, k0 = 64 * kb, n0 = 32 * nb;
    const int n4 = (lane & 7) * 4; const bool nok = (n0 + n4) < N;
    f32x4 v[8];
#pragma unroll
    for (int i = 0; i < 8; ++i) { const int kk = (lane >> 3) + 8 * i; v[i] = nok ? *(const f32x4*)(W + (size_t)(k0 + kk) * N + n0 + n4) : (f32x4){0.f, 0.f, 0.f, 0.f}; if (gain) v[i] = v[i] * gain[k0 + kk]; }
#pragma unroll
    for (int i = 0; i < 8; ++i) { const int kk = (lane >> 3) + 8 * i; LAS float* d = scr + kk * 33 + n4; d[0] = v[i].x; d[1] = v[i].y; d[2] = v[i].z; d[3] = v[i].w; }
    asm volatile("s_waitcnt lgkmcnt(0)" ::: "memory");
    const int c = lane & 7;
#pragma unroll
    for (int j = 0; j < 4; ++j) { const int n = (lane >> 3) + 8 * j; const LAS float* s = scr + (8 * c) * 33 + n;
        u32x4 o; o.x = cvtpk(s[0 * 33], s[1 * 33]); o.y = cvtpk(s[2 * 33], s[3 * 33]); o.z = cvtpk(s[4 * 33], s[5 * 33]); o.w = cvtpk(s[6 * 33], s[7 * 33]);
        const int nn = n0 + n;
        if (nn < N) { const int row = (map == 1) ? (256 * (nn >> 7) + (nn & 127) + row_off) : (map == 2) ? (nn < 1280 ? nn : (nn < 1304 ? nn + 416 : nn - 24)) : (map == 3) ? ((nn / 96) * 128 + nn % 96) : (nn + row_off);
            *(u32x4*)(WT + (size_t)row * K + k0 + 8 * c) = o; } }
    asm volatile("s_waitcnt lgkmcnt(0)" ::: "memory");
}
__device__ __forceinline__ void do_wdesc(const Params& p, const WDesc& d, int it, LAS float* scr, int lane) {
    const int per = (d.K / 64) * ((d.N + 31) / 32); const int r = it / per, ii = it % per;
    transpose_item(p.in[d.in_idx] + (size_t)r * d.src_stride, d.K, d.N, (bf16_t*)p.ws + d.dst_off + (size_t)r * d.dst_stride, d.map, d.row_off, d.gain_idx >= 0 ? p.in[d.gain_idx] : nullptr, scr, ii, lane);
}
__device__ __forceinline__ void rms_row_to_bf16(const float* xrow, const float* g, bf16_t* orow, int lane) {
    const f32x4* xr = (const f32x4*)xrow + lane; const f32x4* gr = (const f32x4*)g + lane;
    f32x4 v[4]; float s = 0.f;
#pragma unroll
    for (int j = 0; j < 4; ++j) { v[j] = xr[64 * j]; s += (v[j].x * v[j].x + v[j].y * v[j].y) + (v[j].z * v[j].z + v[j].w * v[j].w); }
    const float r = rsqrtf(wsum(s) * (1.f / 1024.f) + EPS);
    u32x2* o8 = (u32x2*)orow + lane;
#pragma unroll
    for (int j = 0; j < 4; ++j) { const f32x4 gg = gr[64 * j]; u32x2 w; w.x = cvtpk(v[j].x * r * gg.x, v[j].y * r * gg.y); w.y = cvtpk(v[j].z * r * gg.z, v[j].w * r * gg.w); o8[64 * j] = w; }
}
__device__ __forceinline__ void phase_p0(const Params& p, LAS unsigned char* lds) {
    const int tid = ltid(), lane = tid & 63, wave = tid >> 6;
    const int gw = blockIdx.x * 8 + wave, NGW = gridDim.x * 8;
    LAS float* scr = (LAS float*)(lds + wave * 16384);
    int base = 0;
#pragma unroll 1
    for (int d = 0; d < 13; ++d) {
        const WDesc& wd = (d < 12) ? WDESC[d] : WDESC_MD;
        const int n_it = wd.rep * (wd.K / 64) * ((wd.N + 31) / 32);
        int first = (gw - (base % NGW) + NGW) % NGW;
        for (int it = first; it < n_it; it += NGW) do_wdesc(p, wd, it, scr, lane);
        base += n_it;
    }
    bf16_t* xn = (bf16_t*)(p.ws + R_XN);
    for (int m = gw; m < T; m += 2 * NGW) { rms_row_to_bf16(p.in[0] + (size_t)m * D, p.in[2], xn + (size_t)m * D, lane); if (m + NGW < T) rms_row_to_bf16(p.in[0] + (size_t)(m + NGW) * D, p.in[2], xn + (size_t)(m + NGW) * D, lane); }
    for (int u = gw; u < 256; u += NGW) {
        const int kc = u >> 3, kv = (u >> 2) & 1, nb = u & 3; float s = 0.f;
        const float* pos = p.in[6] + kv * 2048 + kc * 64; const float* w1 = p.in[7] + ((size_t)kv * 2048 + kc * 64) * 256 + nb * 64 + lane;
#pragma unroll 8
        for (int k = 0; k < 64; ++k) s += pos[k] * w1[(size_t)k * 256];
        ((float*)(p.ws + SM_B1P))[kc * 512 + kv * 256 + nb * 64 + lane] = s;
    }
    for (int i = blockIdx.x * 512 + tid; i < S * 16; i += gridDim.x * 512) {
        const int t = i >> 4, f = i & 15; const float ang = (float)t * powf(10000.f, -(float)f / 16.f);
        float* rp = (float*)(p.ws + SM_ROPE) + t * 32; rp[f] = cosf(ang); rp[16 + f] = sinf(ang);
    }
    if (blockIdx.x == 0) for (int i = tid; i < 8 * 129; i += 512) { const int h = i / 129, dd = i % 129; ((float*)(p.ws + SM_BL))[h * 132 + dd] = p.in[1][(dd < 128 ? (int)gold::T5B[dd] : 31) * 8 + h] * LOG2E; }
}

__device__ __forceinline__ void unpack8(const u32x4 v, float (&x)[8]) { x[0] = bflo(v.x); x[1] = bfhi(v.x); x[2] = bflo(v.y); x[3] = bfhi(v.y); x[4] = bflo(v.z); x[5] = bfhi(v.z); x[6] = bflo(v.w); x[7] = bfhi(v.w); }
__device__ __forceinline__ u32x4 pack8(const float (&x)[8]) { u32x4 w; w.x = cvtpk(x[0], x[1]); w.y = cvtpk(x[2], x[3]); w.z = cvtpk(x[4], x[5]); w.w = cvtpk(x[6], x[7]); return w; }
__device__ __forceinline__ float ss8f(const float (&x)[8]) { return ((x[0] * x[0] + x[1] * x[1]) + (x[2] * x[2] + x[3] * x[3])) + ((x[4] * x[4] + x[5] * x[5]) + (x[6] * x[6] + x[7] * x[7])); }
__device__ __forceinline__ void load8f(const float* g, float (&x)[8], float sc) { const f32x4 a = *(const f32x4*)g, b = *(const f32x4*)(g + 4); x[0] = a.x * sc; x[1] = a.y * sc; x[2] = a.z * sc; x[3] = a.w * sc; x[4] = b.x * sc; x[5] = b.y * sc; x[6] = b.z * sc; x[7] = b.w * sc; }
__device__ __forceinline__ void phase_p2(const Params& p, LAS unsigned char* lds) {
    const int tid = ltid(), lane = tid & 63, wave = tid >> 6;
    const bf16_t* hb = (const bf16_t*)(p.ws + R_H);
    unsigned char* xa = p.ws + R_XA;
    bf16_t* qn = (bf16_t*)(xa + A_QN); bf16_t* ksn = (bf16_t*)(xa + A_KSN); bf16_t* kwn = (bf16_t*)(xa + A_KWN);
    bf16_t* vst = (bf16_t*)(xa + A_VST); bf16_t* vwt = (bf16_t*)(xa + A_VWT); bf16_t* kcin = (bf16_t*)(xa + A_KCIN); bf16_t* vcin = (bf16_t*)(xa + A_VCIN);
    bf16_t* cqn = (bf16_t*)(xa + A_CQN); bf16_t* ckvn = (bf16_t*)(xa + A_CKVN); bf16_t* krope = (bf16_t*)(xa + A_KROPE); float* gates = (float*)(xa + A_GATES);
    LAS bf16_t* vs = (LAS bf16_t*)lds;
    if (blockIdx.x == 0) {
        { float s = 0.f; for (int k = 0; k < 32; ++k) s += ((const float*)(p.ws + SM_B1P))[k * 512 + tid]; ((float*)(p.ws + SM_B1))[tid] = s; }
        for (int i = tid; i < 1024; i += 512) { kcin[(size_t)T * 128 + i] = 0; vcin[(size_t)T * 128 + i] = 0; }
    }
    const int c8 = (lane & 7) * 8, seg = lane >> 3;
    float qg[8], ksg[8], kwg[8], cqg[8], ckvg[8];
    load8f(p.in[4] + c8, qg, 0.125f * LOG2E); load8f(p.in[5] + 64 + c8, ksg, 1.f); load8f(p.in[5] + 128 + c8, kwg, 1.f);
    load8f(p.in[9] + (lane & 31) * 8, cqg, 1.f); load8f(p.in[10] + (lane & 15) * 8, ckvg, 1.f);
    for (int tile = blockIdx.x; tile < T / 64; tile += gridDim.x) {
        const int b = tile / (S / 64), s0 = (tile % (S / 64)) * 64;
#pragma unroll 4
        for (int tt = 0; tt < 8; ++tt) {
            const int sl = wave * 8 + tt, s = s0 + sl; const size_t t = (size_t)b * S + s;
            const bf16_t* hr = hb + t * 1792 + lane * 8;
            const u32x4 L0 = *(const u32x4*)hr, L1 = *(const u32x4*)(hr + 512), L2 = *(const u32x4*)(hr + 1024);
            u32x4 L3 = {0u, 0u, 0u, 0u}; if (lane < 32) L3 = *(const u32x4*)(hr + 1536);
            float x0[8], x1[8], x2[8], x3[8];
            unpack8(L0, x0); unpack8(L1, x1); unpack8(L2, x2); unpack8(L3, x3);
            float a0 = ss8f(x0), a1 = ss8f(x1), a2 = ss8f(x2), a3 = ss8f(x3);
#pragma unroll
            for (int o = 1; o < 8; o <<= 1) { a0 += __shfl_xor(a0, o); a1 += __shfl_xor(a1, o); a2 += __shfl_xor(a2, o); a3 += __shfl_xor(a3, o); }
            float a2w = a2 + __shfl_xor(a2, 8); a2w += __shfl_xor(a2w, 16);
            const float a3w = a3 + __shfl_xor(a3, 8);
            const int pp = (sl & ~15) | perm16(sl & 15);
            {
                const float r = rsqrtf(a0 * (1.f / 64.f) + EPS); float y[8];
#pragma unroll
                for (int j = 0; j < 8; ++j) y[j] = x0[j] * r * qg[j];
                *(u32x4*)(qn + t * 512 + lane * 8) = pack8(y);
            }
            {
                const int g = seg & 1; const size_t gm = (((size_t)b * 2 + g) * S + s) * 64 + c8;
                if (seg < 2) *(u32x4*)(kcin + gm) = L1;
                else if (seg < 4) *(u32x4*)(vcin + gm) = L1;
                else if (seg < 6) { const float r = rsqrtf(a1 * (1.f / 64.f) + EPS); float y[8];
#pragma unroll
                    for (int j = 0; j < 8; ++j) y[j] = x1[j] * r * ksg[j];
                    *(u32x4*)(ksn + gm) = pack8(y); }
                else {
#pragma unroll
                    for (int j = 0; j < 8; ++j) vs[((0 + g) * 64 + c8 + j) * 72 + pp] = (bf16_t)((j & 1) ? (L1[j >> 1] >> 16) : (L1[j >> 1] & 0xffffu)); }
            }
            {
                const int g = seg & 1; const size_t gm = (((size_t)b * 2 + g) * S + s) * 64 + c8;
                if (seg < 2) { const float r = rsqrtf(a2 * (1.f / 64.f) + EPS); float y[8];
#pragma unroll
                    for (int j = 0; j < 8; ++j) y[j] = x2[j] * r * kwg[j];
                    *(u32x4*)(kwn + gm) = pack8(y); }
                else if (seg < 4) {
#pragma unroll
                    for (int j = 0; j < 8; ++j) vs[((2 + g) * 64 + c8 + j) * 72 + pp] = (bf16_t)((j & 1) ? (L2[j >> 1] >> 16) : (L2[j >> 1] & 0xffffu)); }
                else { const float r = rsqrtf(a2w * (1.f / 256.f) + EPS); float y[8];
#pragma unroll
                    for (int j = 0; j < 8; ++j) y[j] = x2[j] * r * cqg[j];
                    *(u32x4*)(cqn + t * 256 + (lane - 32) * 8) = pack8(y); }
            }
            {
                if (lane < 16) { const float r = rsqrtf(a3w * (1.f / 128.f) + EPS); float y[8];
#pragma unroll
                    for (int j = 0; j < 8; ++j) y[j] = x3[j] * r * ckvg[j];
                    *(u32x4*)(ckvn + t * 128 + lane * 8) = pack8(y); }
                else if (lane < 20) *(u32x4*)(krope + t * 32 + (lane - 16) * 8) = L3;
                else if (lane < 23) { float y[8];
#pragma unroll
                    for (int j = 0; j < 8; ++j) y[j] = frcp(1.f + fexp2(-x3[j] * LOG2E));
                    float* gp = gates + t * 24 + (lane - 20) * 8; *(f32x4*)gp = (f32x4){y[0], y[1], y[2], y[3]}; *(f32x4*)(gp + 4) = (f32x4){y[4], y[5], y[6], y[7]}; }
            }
        }
        __syncthreads();
        {
            const int row = tid >> 1, half = tid & 1, which = row >> 6, d = row & 63, g = which & 1;
            bf16_t* dst = ((which < 2) ? vst : vwt) + (((size_t)b * 2 + g) * 64 + d) * S + s0 + half * 32;
            const LAS bf16_t* src = vs + row * 72 + half * 32;
#pragma unroll
            for (int c = 0; c < 4; ++c) *(u32x4*)(dst + c * 8) = *(const LAS u32x4*)(src + c * 8);
        }
        __syncthreads();
    }
}
__device__ __forceinline__ void phase_p3b(const Params& p, LAS unsigned char* lds) {
    const int tid = ltid(), lane = tid & 63, wave = tid >> 6;
    const int gw = blockIdx.x * 8 + wave, NGW = gridDim.x * 8;
    const bf16_t* qraw = (const bf16_t*)(p.ws + R_H);
    const bf16_t* kvraw = (const bf16_t*)(p.ws + R_H + (size_t)T * 2048);
    const bf16_t* krope = (const bf16_t*)(p.ws + R_XA + A_KROPE);
    const float* rope = (const float*)(p.ws + SM_ROPE);
    bf16_t* qm = (bf16_t*)((unsigned char*)p.out + O_QM); bf16_t* km = (bf16_t*)((unsigned char*)p.out + O_KM); bf16_t* vmt = (bf16_t*)((unsigned char*)p.out + O_VMT);
    const float* q_norm = p.in[13]; const float* k_norm = p.in[14];
    LAS bf16_t* vs = (LAS bf16_t*)lds;
    LAS float* w2s = (LAS float*)(lds + 73728);
    for (int kv = 0; kv < 2; ++kv) {
        __syncthreads();
        for (int i = tid; i < 256 * 64; i += 512) w2s[i] = p.in[8][kv * 16384 + i];
        __syncthreads();
        const bf16_t* hid = (const bf16_t*)(p.ws + SM_HID) + (size_t)kv * NB * 512 * 256;
        for (int row = gw; row < NB * 512; row += NGW) {
            const u32x2 hv = *(const u32x2*)(hid + (size_t)row * 256 + lane * 4);
            const float h0 = bflo(hv.x), h1 = bfhi(hv.x), h2 = bflo(hv.y), h3 = bfhi(hv.y);
            float acc = 0.f;
#pragma unroll 8
            for (int k4 = 0; k4 < 64; ++k4) {
                acc += __shfl(h0, k4) * w2s[(k4 * 4 + 0) * 64 + lane]; acc += __shfl(h1, k4) * w2s[(k4 * 4 + 1) * 64 + lane];
                acc += __shfl(h2, k4) * w2s[(k4 * 4 + 2) * 64 + lane]; acc += __shfl(h3, k4) * w2s[(k4 * 4 + 3) * 64 + lane];
            }
            if (kv == 0) { const float r = rsqrtf(wsum(acc * acc) * (1.f / 64.f) + EPS); ((bf16_t*)(p.ws + SM_KC))[(size_t)row * 64 + lane] = f2bf(acc * r * p.in[5][lane]); }
            else { const int c = row & 255; ((bf16_t*)(p.ws + SM_VCT))[((size_t)(row >> 8) * 64 + lane) * 256 + ((c & ~15) | perm16(c & 15))] = f2bf(acc); }
        }
    }
    __syncthreads();
    const float QS = 0.10206207261596577f * LOG2E;
    const int c = lane & 15, hl = lane >> 4;
    float qg[8], kg[8];
    load8f(q_norm + (c < 12 ? c * 8 : 0), qg, QS);
    load8f(k_norm + (c < 12 ? c * 8 : 0), kg, 1.f);
    for (int tile = blockIdx.x; tile < T / 64; tile += gridDim.x) {
        const int b = tile / (S / 64), s0 = (tile % (S / 64)) * 64;
#pragma unroll 4
        for (int tt = 0; tt < 8; ++tt) {
            const int sl = wave * 8 + tt, s = s0 + sl; const size_t t = (size_t)b * S + s;
            const int pp = (sl & ~15) | perm16(sl & 15);
            u32x4 Q[2], KV[2];
#pragma unroll
            for (int ld = 0; ld < 2; ++ld) { Q[ld] = *(const u32x4*)(qraw + t * 1024 + ld * 512 + lane * 8); KV[ld] = *(const u32x4*)(kvraw + t * 1024 + ld * 512 + lane * 8); }
            u32x4 KR = {0u, 0u, 0u, 0u}; f32x4 cs0 = {0.f, 0.f, 0.f, 0.f}, cs1 = cs0, sn0 = cs0, sn1 = cs0;
            if (c >= 8 && c < 12) { KR = *(const u32x4*)(krope + t * 32 + (c - 8) * 8);
                const float* rp = rope + s * 32 + (c & 1) * 8; cs0 = *(const f32x4*)rp; cs1 = *(const f32x4*)(rp + 4); sn0 = *(const f32x4*)(rp + 16); sn1 = *(const f32x4*)(rp + 20); }
            const float cs[8] = {cs0.x, cs0.y, cs0.z, cs0.w, cs1.x, cs1.y, cs1.z, cs1.w}, sn[8] = {sn0.x, sn0.y, sn0.z, sn0.w, sn1.x, sn1.y, sn1.z, sn1.w};
            float kr[8]; unpack8(KR, kr);
            const float krs = ss8f(kr);
#pragma unroll
            for (int ld = 0; ld < 2; ++ld) {
                const int hh = ld * 4 + hl;
                {
                    float x[8]; unpack8(Q[ld], x);
                    float ss = c < 12 ? ss8f(x) : 0.f;
#pragma unroll
                    for (int o = 1; o < 16; o <<= 1) ss += __shfl_xor(ss, o);
                    const float r = rsqrtf(ss * (1.f / 96.f) + EPS); float y[8], z[8];
#pragma unroll
                    for (int j = 0; j < 8; ++j) y[j] = x[j] * r * qg[j];
#pragma unroll
                    for (int j = 0; j < 8; ++j) { const float pb = __shfl_xor(y[j], 2); z[j] = (c < 8) ? y[j] : ((c < 10) ? (y[j] * cs[j] - pb * sn[j]) : (pb * sn[j] + y[j] * cs[j])); }
                    if (c < 12) *(u32x4*)(qm + (t * 8 + hh) * 96 + c * 8) = pack8(z);
                }
                {
                    float x[8]; unpack8(KV[ld], x);
                    float ss = c < 8 ? ss8f(x) : krs;
#pragma unroll
                    for (int o = 1; o < 16; o <<= 1) ss += __shfl_xor(ss, o);
                    const float r = rsqrtf(ss * (1.f / 96.f) + EPS); float y[8], z[8];
#pragma unroll
                    for (int j = 0; j < 8; ++j) y[j] = (c < 8 ? x[j] : kr[j]) * r * kg[j];
#pragma unroll
                    for (int j = 0; j < 8; ++j) { const float pb = __shfl_xor(y[j], 2); z[j] = (c < 8) ? y[j] : ((c < 10) ? (y[j] * cs[j] - pb * sn[j]) : (pb * sn[j] + y[j] * cs[j])); }
                    if (c < 12) *(u32x4*)(km + (((size_t)b * 8 + hh) * S + s) * 96 + c * 8) = pack8(z);
                    if (c >= 8) {
#pragma unroll
                        for (int j = 0; j < 8; ++j) vs[(hh * 64 + (c - 8) * 8 + j) * 72 + pp] = (bf16_t)((j & 1) ? (KV[ld][j >> 1] >> 16) : (KV[ld][j >> 1] & 0xffffu)); }
                }
            }
        }
        __syncthreads();
        {
            const int hh = tid >> 6, d = tid & 63;
            bf16_t* dst = vmt + (((size_t)b * 8 + hh) * 64 + d) * S + s0;
            const LAS bf16_t* src = vs + tid * 72;
#pragma unroll
            for (int cc = 0; cc < 8; ++cc) *(u32x4*)(dst + cc * 8) = *(const LAS u32x4*)(src + cc * 8);
        }
        __syncthreads();
    }
}

__device__ const unsigned short UNIT_TYPES[256] = {63,127,62,126,61,125,527,591,655,719,783,847,911,975,60,124,59,123,58,122,57,121,56,120,526,590,654,718,782,846,910,974,55,119,54,118,53,117,52,116,51,115,525,589,653,717,781,845,909,973,50,114,49,113,48,112,47,111,524,588,652,716,780,844,908,972,46,110,45,109,44,108,43,107,523,587,651,715,779,843,907,971,42,106,41,105,40,104,39,103,38,102,522,586,650,714,778,842,906,970,37,101,36,100,35,99,34,98,33,97,521,585,649,713,777,841,905,969,32,96,31,95,30,94,520,584,648,712,776,840,904,968,29,93,28,92,27,91,26,90,25,89,519,583,647,711,775,839,903,967,24,88,23,87,22,86,21,85,20,84,518,582,646,710,774,838,902,966,19,83,18,82,17,81,16,80,15,79,517,581,645,709,773,837,901,965,14,78,13,77,12,76,516,580,644,708,772,836,900,964,11,75,10,74,9,73,8,72,515,579,643,707,771,835,899,963,7,71,6,70,5,69,514,578,642,706,770,834,898,962,4,68,3,67,513,577,641,705,769,833,897,961,2,66,1,65,0,64,512,576,640,704,768,832,896,960};
__device__ __forceinline__ int crow(int r, int hi) { return (r & 3) + 8 * (r >> 2) + 4 * hi; }
struct Flash { f32x16 o0, o1; float l; };
__device__ __forceinline__ void flash_init(Flash& st) {
#pragma unroll
    for (int r = 0; r < 16; ++r) { st.o0[r] = 0.f; st.o1[r] = 0.f; }
    st.l = 0.f;
}
constexpr int AL_KB = 0, AL_KBSZ = 64 * 208, AL_VB = 2 * AL_KBSZ, AL_VBSZ = 64 * 144, AL_IMP = AL_VB + 2 * AL_VBSZ, AL_SELB = AL_IMP + 64 * 65 * 4, AL_UNI = AL_SELB + 512, AL_TL = AL_UNI + 64, AL_BL = AL_TL + 128,
              AL_OT = AL_BL + 4 * 132 * 4, AL_END = AL_OT + 8 * 32 * 64 * 4;
static_assert(AL_END <= 131072, "attention LDS");

template <int DK, int KP> __device__ __forceinline__ void qk_tile(f32x16& p0, f32x16& p1, const LAS unsigned char* Kt, const bf16x8* qf, const f32x16& negm, int r32, int hi) {
#pragma unroll
    for (int s = 0; s < DK / 16; ++s) {
        const bf16x8 a0 = *(const LAS bf16x8*)(Kt + r32 * KP + (16 * s + 8 * hi) * 2);
        const bf16x8 a1 = *(const LAS bf16x8*)(Kt + (32 + r32) * KP + (16 * s + 8 * hi) * 2);
        if (s == 0) { p0 = __builtin_amdgcn_mfma_f32_32x32x16_bf16(a0, qf[0], negm, 0, 0, 0); p1 = __builtin_amdgcn_mfma_f32_32x32x16_bf16(a1, qf[0], negm, 0, 0, 0); }
        else { p0 = __builtin_amdgcn_mfma_f32_32x32x16_bf16(a0, qf[s], p0, 0, 0, 0); p1 = __builtin_amdgcn_mfma_f32_32x32x16_bf16(a1, qf[s], p1, 0, 0, 0); }
    }
}
template <bool LANEMASK, class F> __device__ __forceinline__ void softmax_pv(Flash& st, f32x16& p0, f32x16& p1, const LAS unsigned char* Vt, int r32, int hi, bool mine, F f) {
    float ls = 0.f;
#pragma unroll
    for (int r = 0; r < 16; ++r) {
        float x0 = p0[r], x1 = p1[r]; const bool v0 = f(r, 0, x0), v1 = f(r, 1, x1);
        const float e0 = fexp2(x0), e1 = fexp2(x1);
        p0[r] = v0 ? e0 : 0.f; p1[r] = v1 ? e1 : 0.f; ls += p0[r] + p1[r];
    }
    if (LANEMASK) ls = mine ? ls : 0.f;
    st.l += ls;
#pragma unroll
    for (int s = 0; s < 4; ++s) {
        u32x4 w;
        if (s < 2) { w.x = cvtpk(p0[8 * s + 0], p0[8 * s + 1]); w.y = cvtpk(p0[8 * s + 2], p0[8 * s + 3]); w.z = cvtpk(p0[8 * s + 4], p0[8 * s + 5]); w.w = cvtpk(p0[8 * s + 6], p0[8 * s + 7]); }
        else { const int q = s - 2; w.x = cvtpk(p1[8 * q + 0], p1[8 * q + 1]); w.y = cvtpk(p1[8 * q + 2], p1[8 * q + 3]); w.z = cvtpk(p1[8 * q + 4], p1[8 * q + 5]); w.w = cvtpk(p1[8 * q + 6], p1[8 * q + 7]); }
        if (LANEMASK) { w.x = mine ? w.x : 0u; w.y = mine ? w.y : 0u; w.z = mine ? w.z : 0u; w.w = mine ? w.w : 0u; }
        const bf16x8 pa = __builtin_bit_cast(bf16x8, w);
        const bf16x8 vb0 = *(const LAS bf16x8*)(Vt + r32 * 144 + (16 * s + 8 * hi) * 2);
        const bf16x8 vb1 = *(const LAS bf16x8*)(Vt + (32 + r32) * 144 + (16 * s + 8 * hi) * 2);
        st.o0 = __builtin_amdgcn_mfma_f32_32x32x16_bf16(pa, vb0, st.o0, 0, 0, 0);
        st.o1 = __builtin_amdgcn_mfma_f32_32x32x16_bf16(pa, vb1, st.o1, 0, 0, 0);
    }
}
template <bool FIRST> __device__ __forceinline__ void flash_accum(LAS float* otl, const Flash& st, float gate, int hi, int lane) {
    const float lt = st.l + __shfl_xor(st.l, 32);
    const float f = lt > 0.f ? gate * frcp(lt) : 0.f;
#pragma unroll
    for (int r = 0; r < 16; ++r) { const float fr_ = __shfl(f, crow(r, hi));
        if (FIRST) { otl[r * 64 + lane] = fr_ * st.o0[r]; otl[(16 + r) * 64 + lane] = fr_ * st.o1[r]; }
        else { otl[r * 64 + lane] += fr_ * st.o0[r]; otl[(16 + r) * 64 + lane] += fr_ * st.o1[r]; } }
}
template <int NS> __device__ __forceinline__ float qnorm2(const bf16x8* qf) {
    float s = 0.f;
#pragma unroll
    for (int i = 0; i < NS; ++i)
#pragma unroll
        for (int j = 0; j < 8; ++j) { const float x = bf2f((bf16_t)qf[i][j]); s += x * x; }
    return s + __shfl_xor(s, 32);
}
__device__ __forceinline__ float wmax(float v) {
#pragma unroll
    for (int o = 1; o < 64; o <<= 1) v = fmaxf(v, __shfl_xor(v, o));
    return v;
}

template <int RB> struct TileRegs { u32x4 a, b; };
template <int RB> __device__ __forceinline__ void tile_load(TileRegs<RB>& R, const unsigned char* g, size_t gs, int tid) {
    constexpr int CPR = RB / 16;
    asm volatile("" : "+v"(tid));
    { const int row = tid / CPR, c = tid % CPR; R.a = *(const u32x4*)(g + (size_t)row * gs + c * 16); }
    if (RB == 192) { const int id = (tid < 256) ? tid + 512 : tid; const int row = id / CPR, c = id % CPR; R.b = *(const u32x4*)(g + (size_t)row * gs + c * 16); }
}
template <int RB, int P> __device__ __forceinline__ void tile_store(const TileRegs<RB>& R, LAS unsigned char* l, int tid) {
    constexpr int CPR = RB / 16;
    asm volatile("" : "+v"(tid));
    { const int row = tid / CPR, c = tid % CPR; *(LAS u32x4*)(l + row * P + c * 16) = R.a; }
    if (RB == 192) { const int id = tid + 512; if (id < 768) { const int row = id / CPR, c = id % CPR; *(LAS u32x4*)(l + row * P + c * 16) = R.b; } }
}
template <int RBK, int PK, bool HASV, class SrcK, class SrcV, class Comp>
__device__ __forceinline__ void run_tiles(int n, LAS unsigned char* lds, int tid, size_t gsK, size_t gsV, SrcK srcK, SrcV srcV, Comp comp) {
    TileRegs<RBK> k0, k1, k2; TileRegs<128> v0, v1, v2;
    const int nl = n - 1;
    { tile_load<RBK>(k0, srcK(0), gsK, tid); if (HASV) tile_load<128>(v0, srcV(0), gsV, tid); }
    { const int t1 = nl < 1 ? nl : 1; tile_load<RBK>(k1, srcK(t1), gsK, tid); if (HASV) tile_load<128>(v1, srcV(t1), gsV, tid); }
    { const int t2 = nl < 2 ? nl : 2; tile_load<RBK>(k2, srcK(t2), gsK, tid); if (HASV) tile_load<128>(v2, srcV(t2), gsV, tid); }
#define RT_STEP(KR, VR, ii) do { const int i_ = (ii); \
        LAS unsigned char* kb = lds + AL_KB + (i_ & 1) * AL_KBSZ; LAS unsigned char* vb = lds + AL_VB + (i_ & 1) * AL_VBSZ; \
        tile_store<RBK, PK>(KR, kb, tid); if (HASV) tile_store<128, 144>(VR, vb, tid); \
        __syncthreads(); \
        { const int tn = (i_ + 3 < nl) ? i_ + 3 : nl; tile_load<RBK>(KR, srcK(tn), gsK, tid); if (HASV) tile_load<128>(VR, srcV(tn), gsV, tid); } \
        if (i_ < n) comp(i_, kb, vb); } while (0)
    for (int i = 0; i < n; i += 3) { RT_STEP(k0, v0, i); RT_STEP(k1, v1, i + 1); RT_STEP(k2, v2, i + 2); }
#undef RT_STEP
    __syncthreads();
}

__device__ __forceinline__ void mla_unit(const Params& p, LAS unsigned char* lds, int b, int h, int qb) {
    int tid = threadIdx.x; asm volatile("" : "+v"(tid));
    const int lane = tid & 63, w = __builtin_amdgcn_readfirstlane(tid >> 6), r32 = lane & 31, hi = lane >> 5;
    const bf16_t* qm = (const bf16_t*)((const unsigned char*)p.out + O_QM);
    const unsigned char* km = (const unsigned char*)p.out + O_KM + (((size_t)b * 8 + h) * S) * 192;
    const unsigned char* vmt = (const unsigned char*)p.out + O_VMT + (((size_t)b * 8 + h) * 64) * (size_t)S * 2;
    bf16_t* ocat = (bf16_t*)(p.ws + R_XN);
    const int tq = qb * 256 + 32 * w + r32;
    bf16x8 qf[6];
#pragma unroll
    for (int s = 0; s < 6; ++s) qf[s] = *(const bf16x8*)(qm + (((size_t)b * S + tq) * 8 + h) * 96 + 16 * s + 8 * hi);
    const float kn = 9.797958971f * 1.01f * wmax(fmaxf(fabsf(p.in[14][lane]), lane < 32 ? fabsf(p.in[14][64 + lane]) : 0.f));
    const float mref = sqrtf(qnorm2<6>(qf)) * kn;
    f32x16 negm;
#pragma unroll
    for (int r = 0; r < 16; ++r) negm[r] = -mref;
    Flash st; flash_init(st);
    const int ntile = 4 * qb + 4, dt = 4 * qb + (w >> 1);
    run_tiles<192, 208, true>(ntile, lds, tid, 192, (size_t)S * 2,
        [&](int i) { return km + (size_t)i * 64 * 192; }, [&](int i) { return vmt + (size_t)i * 128; },
        [&](int i, LAS unsigned char* kb, LAS unsigned char* vb) {
            if (i <= dt) {
                f32x16 p0, p1; qk_tile<96, 208>(p0, p1, kb, qf, negm, r32, hi);
                if (i < dt) softmax_pv<false>(st, p0, p1, vb, r32, hi, true, [&](int r, int half, float& x) { return true; });
                else { const int kb0 = 64 * i + 4 * hi; softmax_pv<false>(st, p0, p1, vb, r32, hi, true, [&](int r, int half, float& x) { return (kb0 + 32 * half + (r & 3) + 8 * (r >> 2)) <= tq; }); }
            }
        });
    {
        const float lt = st.l + __shfl_xor(st.l, 32); const float f = lt > 0.f ? frcp(lt) : 0.f;
#pragma unroll
        for (int r = 0; r < 16; ++r) { const float fr_ = __shfl(f, crow(r, hi)); const size_t ro = ((size_t)b * S + qb * 256 + 32 * w + crow(r, hi)) * 1024 + 512 + h * 64 + r32; ocat[ro] = f2bf(st.o0[r] * fr_); ocat[ro + 32] = f2bf(st.o1[r] * fr_); }
    }
}

__device__ __forceinline__ void nsa_unit(const Params& p, LAS unsigned char* lds, int b, int g, int jt) {
    int tid = threadIdx.x; asm volatile("" : "+v"(tid));
    const int lane = tid & 63, w = __builtin_amdgcn_readfirstlane(tid >> 6), r32 = lane & 31, hi = lane >> 5;
    const int rh = w >> 1, qh = w & 1, h = 4 * g + rh, q0 = 64 * jt, ql = 32 * qh + r32, tq = q0 + ql;
    const unsigned char* xa = p.ws + R_XA;
    const bf16_t* qn = (const bf16_t*)(xa + A_QN);
    const size_t bg = (size_t)b * 2 + g;
    const unsigned char* ksn = xa + A_KSN + bg * S * 128; const unsigned char* kwn = xa + A_KWN + bg * S * 128;
    const unsigned char* vst = xa + A_VST + bg * 64 * (size_t)S * 2; const unsigned char* vwt = xa + A_VWT + bg * 64 * (size_t)S * 2;
    const unsigned char* kc = p.ws + SM_KC + bg * 256 * 128; const unsigned char* vct = p.ws + SM_VCT + bg * 64 * 512;
    const float* gates = (const float*)(xa + A_GATES) + ((size_t)b * S + tq) * 24 + h * 3;
    bf16_t* ocat = (bf16_t*)(p.ws + R_XN);
    LAS float* imp = (LAS float*)(lds + AL_IMP); LAS unsigned char* selb = lds + AL_SELB; LAS unsigned* uni = (LAS unsigned*)(lds + AL_UNI); LAS unsigned char* tl = lds + AL_TL; LAS float* bls = (LAS float*)(lds + AL_BL);
    const float* blg = (const float*)(p.ws + SM_BL) + h * 132;
    const float cb = blg[128];
    const float bmax = wmax(fmaxf(fmaxf(blg[lane], blg[64 + lane]), cb));
    if (qh == 0) { bls[rh * 132 + lane] = blg[lane] - cb; bls[rh * 132 + 64 + lane] = blg[64 + lane] - cb; if (lane == 0) bls[rh * 132 + 128] = 0.f; }
    const LAS float* blh = bls + rh * 132;
    bf16x8 qf[4];
#pragma unroll
    for (int s = 0; s < 4; ++s) qf[s] = *(const bf16x8*)(qn + (((size_t)b * S + tq) * 8 + h) * 64 + 16 * s + 8 * hi);
    const float kn = 8.f * 1.01f * wmax(fmaxf(fmaxf(fabsf(p.in[5][lane]), fabsf(p.in[5][64 + lane])), fabsf(p.in[5][128 + lane])));
    const float mref = sqrtf(qnorm2<4>(qf)) * kn + bmax;
    f32x16 negm;
#pragma unroll
    for (int r = 0; r < 16; ++r) negm[r] = cb - mref;
    float g0 = gates[0], g1 = gates[1], g2 = gates[2];
    if (p.dbg_branch >= 0) { g0 = p.dbg_branch == 0 ? 1.f : 0.f; g1 = p.dbg_branch == 1 ? 1.f : 0.f; g2 = p.dbg_branch == 2 ? 1.f : 0.f; }
    LAS float* otl = (LAS float*)(lds + AL_OT) + w * 2048;
    const int nvmax = (q0 + 63 - 31) / 16 + 1, ntc = (nvmax + 63) / 64;
    Flash st; flash_init(st);
    run_tiles<128, 144, true>(ntc, lds, tid, 128, 512,
        [&](int i) { return kc + (size_t)i * 64 * 128; }, [&](int i) { return vct + (size_t)i * 128; },
        [&](int i, LAS unsigned char* kb, LAS unsigned char* vb) {
            f32x16 p0, p1; qk_tile<64, 144>(p0, p1, kb, qf, negm, r32, hi);
            const int cb0 = 64 * i + 4 * hi;
            softmax_pv<false>(st, p0, p1, vb, r32, hi, true, [&](int r, int half, float& x) {
                const int c = cb0 + 32 * half + (r & 3) + 8 * (r >> 2); const int dist = tq - 16 * c - 31; x += blh[dist < 0 ? 0 : (dist > 128 ? 128 : dist)]; return dist >= 0; });
        });
    flash_accum<true>(otl, st, g0, hi, lane);
    unsigned mlo, mhi;
    int nsel;
    if (jt < 16) { const unsigned long long mk = (1ull << (jt + 1)) - 1ull; mlo = (unsigned)mk; mhi = (unsigned)(mk >> 32); nsel = jt + 1; if (tid <= jt) tl[tid] = (unsigned char)tid; }
    else {
        for (int i = tid; i < 64 * 65; i += 512) imp[i] = 0.f;
        const float lt = st.l + __shfl_xor(st.l, 32); const float linv = lt > 0.f ? frcp(lt) : 0.f;
        float xlast = 0.f;
        run_tiles<128, 144, false>(ntc, lds, tid, 128, 0,
            [&](int i) { return kc + (size_t)i * 64 * 128; }, [&](int i) { return kc; },
            [&](int i, LAS unsigned char* kb, LAS unsigned char* vb) {
                f32x16 p0, p1; qk_tile<64, 144>(p0, p1, kb, qf, negm, r32, hi);
                const int cb0 = 64 * i + 4 * hi;
                float sm[2][4], cr[2][4];
#pragma unroll
                for (int half = 0; half < 2; ++half)
#pragma unroll
                    for (int a = 0; a < 4; ++a) {
                        float s4 = 0.f, last = 0.f;
#pragma unroll
                        for (int k = 0; k < 4; ++k) {
                            const int r = 4 * a + k; const int c = cb0 + 32 * half + k + 8 * a; const int dist = tq - 16 * c - 31;
                            const float sc = (half ? p1[r] : p0[r]) + blh[dist < 0 ? 0 : (dist > 128 ? 128 : dist)];
                            const float pv = dist >= 0 ? fexp2(sc) * linv : 0.f;
                            s4 += pv; last = pv;
                        }
                        sm[half][a] = s4; cr[half][a] = last;
                    }
                float tot[2][4];
#pragma unroll
                for (int half = 0; half < 2; ++half)
#pragma unroll
                    for (int a = 0; a < 4; ++a) {
                        const float xs_ = __shfl_xor(cr[half][a], 32);
                        const float xp_ = (a > 0) ? __shfl_xor(cr[half][a > 0 ? a - 1 : 0], 32) : (half ? __shfl_xor(cr[0][3], 32) : xlast);
                        tot[half][a] = sm[half][a] + (hi ? xs_ : xp_);
                    }
                xlast = __shfl_xor(cr[1][3], 32);
                for (int rr = 0; rr < 4; ++rr) {
                    if (rh == rr) {
#pragma unroll
                        for (int half = 0; half < 2; ++half)
#pragma unroll
                            for (int a = 0; a < 4; ++a) { const int j = 16 * i + 8 * half + 2 * a + hi; imp[ql * 65 + j] += tot[half][a]; }
                    }
                    __syncthreads();
                }
            });
        if (p.dbg_branch == 1) { for (int i = tid; i < 4096; i += 512) ((float*)(p.ws + R_H))[((size_t)g * S + q0 + (i >> 6)) * 64 + (i & 63)] = imp[(i >> 6) * 65 + (i & 63)]; }
        {
            const int q = tid >> 3, jg = tid & 7;
            unsigned byte = 0;
#pragma unroll 1
            for (int jj = 0; jj < 8; ++jj) {
                const int j = jg * 8 + jj;
                if (j <= jt) {
                    const float x = imp[q * 65 + j]; const float vj = (j == jt || j == 0) ? 1e9f : x;
                    int rank = 0;
#pragma unroll 8
                    for (int i = 0; i < 64; ++i) { const float xi = imp[q * 65 + i]; const float vi = (i > jt) ? -1.f : ((i == jt || i == 0) ? 1e9f : xi); rank += (vi > vj || (vi == vj && i < j)) ? 1 : 0; }
                    if (rank < 16) byte |= 1u << jj;
                }
            }
            selb[q * 8 + jg] = (unsigned char)byte;
        }
        __syncthreads();
        if (w == 0) {
            unsigned a = ((const LAS unsigned*)selb)[lane * 2], c = ((const LAS unsigned*)selb)[lane * 2 + 1];
#pragma unroll
            for (int o = 1; o < 64; o <<= 1) { a |= __shfl_xor(a, o); c |= __shfl_xor(c, o); }
            const unsigned long long um = ((unsigned long long)c << 32) | a;
            if ((um >> lane) & 1ull) tl[__builtin_popcountll(um & ((1ull << lane) - 1ull))] = (unsigned char)lane;
            if (lane == 0) uni[0] = (unsigned)__builtin_popcountll(um);
        }
        __syncthreads();
        mlo = ((const LAS unsigned*)selb)[ql * 2]; mhi = ((const LAS unsigned*)selb)[ql * 2 + 1];
        nsel = (int)uni[0];
    }
    if (p.dbg_branch == 1 && rh == 0) { if (hi == 0) ((unsigned long long*)(p.ws + R_H + 4 * 1048576))[(size_t)g * S + tq] = ((unsigned long long)mhi << 32) | mlo; }
    __syncthreads();
    {
        const unsigned long long mymask = ((unsigned long long)mhi << 32) | mlo;
        nsel = __builtin_amdgcn_readfirstlane(nsel);
        flash_init(st);
        run_tiles<128, 144, true>(nsel, lds, tid, 128, (size_t)S * 2,
            [&](int i) { return ksn + (size_t)tl[i] * 64 * 128; }, [&](int i) { return vst + (size_t)tl[i] * 128; },
            [&](int i, LAS unsigned char* kb, LAS unsigned char* vb) {
                const int j = __builtin_amdgcn_readfirstlane((int)tl[i]);
                f32x16 p0, p1; qk_tile<64, 144>(p0, p1, kb, qf, negm, r32, hi);
                const bool mine = (mymask >> j) & 1ull;
                if (q0 + 32 * qh - (64 * j + 63) >= 128) softmax_pv<true>(st, p0, p1, vb, r32, hi, mine, [&](int r, int half, float& x) { return true; });
                else { const int kb0 = 64 * j + 4 * hi;
                    softmax_pv<true>(st, p0, p1, vb, r32, hi, mine, [&](int r, int half, float& x) { const int dist = tq - (kb0 + 32 * half + (r & 3) + 8 * (r >> 2)); x += blh[dist < 0 ? 0 : (dist > 128 ? 128 : dist)]; return dist >= 0; }); }
            });
        flash_accum<false>(otl, st, g1, hi, lane);
    }
    {
        const int j0 = jt >= 8 ? jt - 8 : 0, nw = jt - j0 + 1;
        flash_init(st);
        run_tiles<128, 144, true>(nw, lds, tid, 128, (size_t)S * 2,
            [&](int i) { return kwn + (size_t)(j0 + i) * 64 * 128; }, [&](int i) { return vwt + (size_t)(j0 + i) * 128; },
            [&](int i, LAS unsigned char* kb, LAS unsigned char* vb) {
                f32x16 p0, p1; qk_tile<64, 144>(p0, p1, kb, qf, negm, r32, hi);
                const int kb0 = 64 * (j0 + i) + 4 * hi;
                softmax_pv<false>(st, p0, p1, vb, r32, hi, true, [&](int r, int half, float& x) { const int dist = tq - (kb0 + 32 * half + (r & 3) + 8 * (r >> 2)); x += blh[dist < 0 ? 0 : (dist > 128 ? 128 : dist)]; return dist >= 0 && dist < 512; });
            });
        flash_accum<false>(otl, st, g2, hi, lane);
    }
#pragma unroll
    for (int r = 0; r < 16; ++r) { const size_t ro = ((size_t)b * S + q0 + 32 * qh + crow(r, hi)) * 1024 + h * 64 + r32; ocat[ro] = f2bf(otl[r * 64 + lane]); ocat[ro + 32] = f2bf(otl[(16 + r) * 64 + lane]); }
    __syncthreads();
}

__device__ __forceinline__ void phase_p4(const Params& p, LAS unsigned char* lds) {
    const int G = gridDim.x, c = blockIdx.x, nunits = 256 * NB;
#if NB == 8
    if (G == 256) {
        const int b = c & 7, idx = c >> 3, pi = idx & 7, hq = idx >> 3;
#pragma unroll 1
        for (int u = 0; u < 8; ++u) {
            if (u < 4) nsa_unit(p, lds, b, u >> 1, (u & 1) ? idx : 63 - idx);
            else mla_unit(p, lds, b, ((u - 4) >> 1) * 4 + hq, (u & 1) ? pi : 15 - pi);
        }
        return;
    }
#endif
    for (int j = 0;; ++j) {
        const int k = j * G + ((j & 1) ? (G - 1 - c) : c);
        if (j * G >= nunits) break;
        if (k >= nunits) continue;
        const int ty = UNIT_TYPES[k / NB], b = k % NB, kind = ty >> 9, a = (ty >> 6) & 7, cc = ty & 63;
        if (kind == 0) nsa_unit(p, lds, b, a, cc); else mla_unit(p, lds, b, a, cc);
    }
}
__device__ __forceinline__ void phase_norm(const float* x, const float* g, bf16_t* xn) {
    const int tid_ = ltid(); const int lane = tid_ & 63, gw = blockIdx.x * 8 + (tid_ >> 6), NGW = gridDim.x * 8;
    for (int m = gw; m < T; m += NGW) rms_row_to_bf16(x + (size_t)m * D, g, xn + (size_t)m * D, lane);
}
__device__ __forceinline__ void phase_conv(const Params& p) {
    const int tid = ltid(), lane = tid & 63, gw = blockIdx.x * 8 + (tid >> 6), NGW = gridDim.x * 8;
    const bf16_t* hh = (const bf16_t*)(p.ws + R_H); bf16_t* v = (bf16_t*)(p.ws + R_XN); const float* cw = p.in[22];
    constexpr int RUN = 16;
    float w0[2][8], w1[2][8], w2[2][8];
#pragma unroll
    for (int j = 0; j < 2; ++j) { const int d = 8 * lane + 512 * j; load8f(cw + d, w0[j], 1.f); load8f(cw + 1024 + d, w1[j], 1.f); load8f(cw + 2048 + d, w2[j], 1.f); }
    for (int run = gw; run < T / RUN; run += NGW) {
        const int m0 = run * RUN, s0 = m0 & (S - 1);
        float pm2[2][8], pm1[2][8];
#pragma unroll
        for (int j = 0; j < 2; ++j) { const int d = 8 * lane + 512 * j;
#pragma unroll
            for (int q = 0; q < 2; ++q) {
                float (&dst)[8] = q ? pm1[j] : pm2[j];
                if (s0 - 2 + q >= 0) { const bf16_t* r = hh + (size_t)(m0 - 2 + q) * 3072; float c[8], u[8]; unpack8(*(const u32x4*)(r + 1024 + d), c); unpack8(*(const u32x4*)(r + 2048 + d), u);
#pragma unroll
                    for (int i = 0; i < 8; ++i) dst[i] = c[i] * u[i]; }
                else {
#pragma unroll
                    for (int i = 0; i < 8; ++i) dst[i] = 0.f; }
            } }
#pragma unroll 4
        for (int rr = 0; rr < RUN; ++rr) {
            const int m = m0 + rr; const bf16_t* r = hh + (size_t)m * 3072;
#pragma unroll
            for (int j = 0; j < 2; ++j) { const int d = 8 * lane + 512 * j;
                float b[8], c[8], u[8], y[8]; unpack8(*(const u32x4*)(r + d), b); unpack8(*(const u32x4*)(r + 1024 + d), c); unpack8(*(const u32x4*)(r + 2048 + d), u);
#pragma unroll
                for (int i = 0; i < 8; ++i) { const float cu = c[i] * u[i]; y[i] = b[i] * (w0[j][i] * pm2[j][i] + w1[j][i] * pm1[j][i] + w2[j][i] * cu); pm2[j][i] = pm1[j][i]; pm1[j][i] = cu; }
                *(u32x4*)(v + (size_t)m * 1024 + d) = pack8(y); }
        }
    }
}
__device__ __forceinline__ void phase_norm_router(const Params& p, LAS unsigned char* lds) {
    const int tid = ltid(), lane = tid & 63, wave = tid >> 6, gw = blockIdx.x * 8 + wave, NGW = gridDim.x * 8;
    const float* x3 = p.out; const float* g = p.in[24]; bf16_t* xn = (bf16_t*)(p.ws + R_XN);
    LAS float* wr = (LAS float*)lds;
    LAS int* lcnt = (LAS int*)(lds + 32768); LAS int* gb = lcnt + 8;
    int* te = (int*)(p.ws + SM_TE); float* tw = (float*)(p.ws + SM_TW); int* rank = (int*)(p.ws + SM_RANK); int* cnt = (int*)(p.ws + SM_CTL);
    for (int i = tid; i < 8192; i += 512) wr[i] = p.in[25][i];
    if (tid < 8) lcnt[tid] = 0;
    __syncthreads();
    for (int m = gw; m < T; m += NGW) {
        const f32x4* xr = (const f32x4*)(x3 + (size_t)m * D) + lane; const f32x4* gr = (const f32x4*)g + lane;
        f32x4 v[4]; float s = 0.f;
#pragma unroll
        for (int j = 0; j < 4; ++j) { v[j] = xr[64 * j]; s += (v[j].x * v[j].x + v[j].y * v[j].y) + (v[j].z * v[j].z + v[j].w * v[j].w); }
        const float r = rsqrtf(wsum(s) * (1.f / 1024.f) + EPS);
        float lg[8];
#pragma unroll
        for (int e = 0; e < 8; ++e) lg[e] = 0.f;
        u32x2* o8 = (u32x2*)(xn + (size_t)m * D) + lane;
#pragma unroll
        for (int j = 0; j < 4; ++j) { const f32x4 gg = gr[64 * j]; const f32x4 y = {v[j].x * r * gg.x, v[j].y * r * gg.y, v[j].z * r * gg.z, v[j].w * r * gg.w};
            u32x2 w; w.x = cvtpk(y.x, y.y); w.y = cvtpk(y.z, y.w); o8[64 * j] = w;
#pragma unroll
            for (int i = 0; i < 4; ++i) { const int d = 4 * lane + 256 * j + i; const f32x4 w0 = *(const LAS f32x4*)(wr + d * 8), w1 = *(const LAS f32x4*)(wr + d * 8 + 4);
                lg[0] += y[i] * w0.x; lg[1] += y[i] * w0.y; lg[2] += y[i] * w0.z; lg[3] += y[i] * w0.w; lg[4] += y[i] * w1.x; lg[5] += y[i] * w1.y; lg[6] += y[i] * w1.z; lg[7] += y[i] * w1.w; } }
#pragma unroll
        for (int e = 0; e < 8; ++e) lg[e] = wsum(lg[e]) + p.in[26][e];
        int e1 = 0; float l1 = lg[0];
#pragma unroll
        for (int e = 1; e < 8; ++e) if (lg[e] > l1) { l1 = lg[e]; e1 = e; }
        int e2 = -1; float l2 = -3e38f;
#pragma unroll
        for (int e = 0; e < 8; ++e) if (e != e1 && lg[e] > l2) { l2 = lg[e]; e2 = e; }
        if (lane == 0) {
            const float w1 = 1.f / (1.f + __expf(l2 - l1));
            te[m * 2] = e1; te[m * 2 + 1] = e2; tw[m * 2] = w1; tw[m * 2 + 1] = 1.f - w1;
            rank[m * 2] = __hip_atomic_fetch_add(&lcnt[e1], 1, __ATOMIC_RELAXED, __HIP_MEMORY_SCOPE_WORKGROUP); rank[m * 2 + 1] = __hip_atomic_fetch_add(&lcnt[e2], 1, __ATOMIC_RELAXED, __HIP_MEMORY_SCOPE_WORKGROUP);
        }
    }
    __syncthreads();
    if (tid < 8) gb[tid] = atomicAdd(&cnt[tid], lcnt[tid]);
    __syncthreads();
    for (int m = gw; m < T; m += NGW) if (lane < 2) rank[m * 2 + lane] += gb[te[m * 2 + lane]];
}
__device__ __forceinline__ void phase_moe_gather(const Params& p) {
    const int tid = ltid(), lane = tid & 63, gw = blockIdx.x * 8 + (tid >> 6), NGW = gridDim.x * 8;
    const int* cnt = (const int*)(p.ws + SM_CTL); const int* te = (const int*)(p.ws + SM_TE); const float* tw = (const float*)(p.ws + SM_TW); const int* rank = (const int*)(p.ws + SM_RANK);
    int* pos = (int*)(p.ws + SM_POS); float* roww = (float*)(p.ws + SM_ROWW); int* tile_e = (int*)(p.ws + SM_TILEE);
    const bf16_t* xn = (const bf16_t*)(p.ws + R_XN); bf16_t* xs = (bf16_t*)(p.ws + R_XA);
    int off[9]; off[0] = 0;
#pragma unroll
    for (int e = 0; e < 8; ++e) off[e + 1] = off[e] + ((cnt[e] + 255) & ~255);
    if (blockIdx.x == 0) {
        for (int i = tid; i < ROWS_MAX / 256; i += 512) { int e = -1;
#pragma unroll
            for (int k = 0; k < 8; ++k) if (i * 256 >= off[k] && i * 256 < off[k + 1]) e = k;
            tile_e[i] = e < 0 ? 0 : e; }
        if (tid == 0) ((int*)(p.ws + SM_CTL))[8] = off[8];
    }
    if (blockIdx.x < 8 && tid < 256) {
#pragma unroll
        for (int e = 0; e < 8; ++e) if (e == (int)blockIdx.x) { const int c = cnt[e]; if (c + tid < off[e + 1] - off[e]) roww[off[e] + c + tid] = 0.f; }
    }
    for (int pi = gw; pi < 2 * T; pi += NGW) {
        const int e = te[pi]; int o = 0;
#pragma unroll
        for (int k = 0; k < 8; ++k) if (k == e) o = off[k];
        const int r = o + rank[pi];
        if (lane == 0) { pos[pi] = r; roww[r] = tw[pi]; }
        const u32x4* src = (const u32x4*)(xn + (size_t)(pi >> 1) * D); u32x4* dst = (u32x4*)(xs + (size_t)r * D);
        dst[lane] = src[lane]; dst[64 + lane] = src[64 + lane];
    }
}
__device__ __forceinline__ void phase_moe_combine(const Params& p) {
    const int tid_ = ltid(); const int lane = tid_ & 63, gw = blockIdx.x * 8 + (tid_ >> 6), NGW = gridDim.x * 8;
    const int* pos = (const int*)(p.ws + SM_POS); const bf16_t* ym = (const bf16_t*)(p.ws + R_XA);
    for (int m = gw; m < T; m += NGW) {
        const int p0 = pos[m * 2], p1 = pos[m * 2 + 1];
#pragma unroll
        for (int j = 0; j < 4; ++j) {
            const int d = 4 * lane + 256 * j;
            f32x4* o = (f32x4*)(p.out + (size_t)m * D + d); f32x4 x = *o;
            const u32x2 a = *(const u32x2*)(ym + (size_t)p0 * D + d), c = *(const u32x2*)(ym + (size_t)p1 * D + d);
            x.x += bflo(a.x) + bflo(c.x); x.y += bfhi(a.x) + bfhi(c.x); x.z += bflo(a.y) + bflo(c.y); x.w += bfhi(a.y) + bfhi(c.y);
            *o = x;
        }
    }
}

#define XB_TMO      128
#define XB_XCNT(j)  (256  + 64 * (j))
#define XB_XSUB(j)  (1280 + 64 * (j))
#define XB_XGEN(j)  (2304 + 64 * (j))
#define XB_TOP      3328
#define XB_TOPGEN   3392
#define XCD_BAR_WORDS 3456
#define XB_SPIN_CAP (1u << 18)

__device__ __forceinline__ unsigned xb_ld(unsigned* p)              { return __hip_atomic_load(p, __ATOMIC_RELAXED, __HIP_MEMORY_SCOPE_AGENT); }
__device__ __forceinline__ unsigned xb_add(unsigned* p, unsigned v) { return __hip_atomic_fetch_add(p, v, __ATOMIC_RELAXED, __HIP_MEMORY_SCOPE_AGENT); }
__device__ __forceinline__ unsigned xb_xcc_id() { return (unsigned)__builtin_amdgcn_s_getreg((3 << 11) | 20) & 0xFu; }
#define XB_SPIN(cond, bar) do { unsigned _sp = 0; while (cond) { __builtin_amdgcn_s_sleep(1); \
    if ((++_sp & 255u) == 0u) { if (xb_ld(&(bar)[XB_TMO])) break; if (_sp > XB_SPIN_CAP) { atomicAdd(&(bar)[XB_TMO], 1u); break; } } } } while (0)

struct XcdBarrier {
    unsigned* bar; unsigned x;
    volatile LAS unsigned* st;
};

__device__ __forceinline__ XcdBarrier xcd_barrier_post(unsigned* bar, volatile LAS unsigned* st) {
    XcdBarrier b; b.bar = bar; b.x = xb_xcc_id(); b.st = st;
    if (threadIdx.x == 0) (void)xb_add(&bar[XB_XCNT(b.x)], 1u);
    return b;
}
__device__ __forceinline__ void xcd_barrier_complete(unsigned* bar, unsigned x, unsigned& nloc, unsigned& nx) {
    const unsigned G = gridDim.x * gridDim.y * gridDim.z;
    unsigned sum, cnt, mine, sp = 0u;
    for (;;) {
        sum = 0u; cnt = 0u; mine = 0u;
#pragma unroll
        for (unsigned j = 0; j < 16; ++j) { const unsigned c = xb_ld(&bar[XB_XCNT(j)]); sum += c; cnt += (c > 0u) ? 1u : 0u; mine = (j == x) ? c : mine; }
        if (sum == G) break;
        __builtin_amdgcn_s_sleep(1);
        if ((++sp & 255u) == 0u) { if (xb_ld(&bar[XB_TMO])) break; if (sp > XB_SPIN_CAP) { atomicAdd(&bar[XB_TMO], 1u); break; } }
    }
    nloc = mine > 0u ? mine : 1u; nx = cnt > 0u ? cnt : 1u;
}

__device__ __forceinline__ void xcd_barrier(const XcdBarrier& b) {
    asm volatile("s_waitcnt vmcnt(0)" ::: "memory");
    __syncthreads();
    if (threadIdx.x == 0) {
        unsigned* bar = b.bar;
        __builtin_amdgcn_s_waitcnt(0);
        unsigned nloc = b.st[0], nx = b.st[1];
        if (nloc == 0u) { xcd_barrier_complete(bar, b.x, nloc, nx); b.st[0] = nloc; b.st[1] = nx; }
        const unsigned old = xb_add(&bar[XB_XSUB(b.x)], 1u);
        const unsigned gen = old / nloc;
        if (old + 1u == (gen + 1u) * nloc) {
            __builtin_amdgcn_fence(__ATOMIC_RELEASE, "agent");
            asm volatile("s_waitcnt vmcnt(0)" ::: "memory");
            const unsigned og = xb_add(&bar[XB_TOP], 1u);
            const unsigned tg = og / nx;
            if (og + 1u == (tg + 1u) * nx) xb_add(&bar[XB_TOPGEN], 1u);
            else XB_SPIN(xb_ld(&bar[XB_TOPGEN]) == tg, bar);
            __builtin_amdgcn_fence(__ATOMIC_ACQUIRE, "agent");
            xb_add(&bar[XB_XGEN(b.x)], 1u);
            asm volatile("s_waitcnt vmcnt(0)" ::: "memory");
        } else {
            XB_SPIN(xb_ld(&bar[XB_XGEN(b.x)]) == gen, bar);
            __builtin_amdgcn_fence(__ATOMIC_ACQUIRE, "agent");
            asm volatile("s_waitcnt vmcnt(0)" ::: "memory");
        }
    }
    __syncthreads();
}


__global__ void __launch_bounds__(512) mega_fwd(Params p) {
    extern __shared__ __attribute__((aligned(16))) unsigned char lds_raw[];
    LAS unsigned char* lds = (LAS unsigned char*)lds_raw;
    cg::grid_group grid = cg::this_grid();
    volatile LAS unsigned* bst = (volatile LAS unsigned*)(lds + 140032);
    if (threadIdx.x == 0) { bst[0] = 0u; bst[1] = 0u; const unsigned long long ba = (unsigned long long)(p.ws + SM_BAR); bst[2] = (unsigned)ba; bst[3] = (unsigned)(ba >> 32); }
    __syncthreads();
    (void)xcd_barrier_post((unsigned*)(p.ws + SM_BAR), bst);
#define GSYNC() do { XcdBarrier xb_; volatile LAS unsigned* st_ = (volatile LAS unsigned*)(lds + 140032); xb_.bar = (unsigned*)(((unsigned long long)st_[3] << 32) | st_[2]); xb_.x = xb_xcc_id(); xb_.st = st_; xcd_barrier(xb_); } while (0)
    const int G = gridDim.x, c = blockIdx.x;
#define LP() bf16_t* W = (bf16_t*)p.ws; bf16_t* xn = (bf16_t*)(p.ws + R_XN); float* x1 = (float*)(p.ws + R_XA); pg8::StaticOrder SO; (void)W; (void)xn; (void)x1; (void)SO
#ifndef PHMASK
#define PHMASK 0xFFFFFFFFu
#endif
#ifndef REPEAT_MASK
#define REPEAT_MASK 0u
#endif
#define PH(k) if (((PHMASK >> (k)) & 1u) && (k) >= p.ph_lo && (k) <= p.ph_hi)
#define RPT(k) if ((REPEAT_MASK >> (k)) & 1u)
    PH(0) { LP(); phase_p0(p, lds); }
    GSYNC();
    if (p.ph_lo == -12345) grid.sync();
    RPT(0) { { LP(); phase_p0(p, lds); } GSYNC(); }
    PH(1) { LP();
        pg8::Gemm g{xn, W + W_IN_E / 2, T, 1792, 1024, 1024, nullptr, 0}; SO.init(T, 1792, G, c);
        pg8::EpiBf16<0> E{(bf16_t*)(p.ws + R_H), 1792, nullptr, nullptr};
        pg8::gemm_phase<pg8::EpiBf16<0>, true>(lds, g, SO, E);
    }
    GSYNC();
    PH(2) { LP(); phase_p2(p, lds); }
    GSYNC();
    RPT(2) { { LP(); phase_p2(p, lds); } GSYNC(); }
    PH(3) { LP();
        const int nCu = 2 * (NB * 512 / 256), Gc = (nCu < G / 2) ? nCu : 0;
        if (Gc == 0 || c < Gc) {
            for (int kv = 0; kv < 2; ++kv) {
                pg8::Gemm g{(const bf16_t*)(p.ws + R_XA + (kv ? A_VCIN : A_KCIN)), W + W_CW1 / 2 + (size_t)kv * 256 * 2048, NB * 512, 256, 2048, 1024, nullptr, 0};
                if (Gc) SO.init(NB * 512, 256, Gc / 2, c - kv * (Gc / 2)); else SO.init(NB * 512, 256, G, c);
                pg8::EpiBf16<2> E{(bf16_t*)(p.ws + SM_HID) + (size_t)kv * NB * 512 * 256, 256, (const float*)(p.ws + SM_B1) + kv * 256, nullptr};
                if (Gc == 0 || (c / (Gc / 2)) == kv) pg8::gemm_phase<pg8::EpiBf16<2>, true>(lds, g, SO, E);
            }
        }
        if (Gc == 0 || c >= Gc) {
            {
                pg8::Gemm g{(const bf16_t*)(p.ws + R_XA + A_CQN), W + W_UQ / 2, T, 1024, 256, 256, nullptr, 0}; SO.init(T, 1024, G - Gc, c - Gc);
                pg8::EpiBf16<0> E{(bf16_t*)(p.ws + R_H), 1024, nullptr, nullptr};
                pg8::gemm_phase<pg8::EpiBf16<0>, true>(lds, g, SO, E);
            }
            {
                pg8::Gemm g{(const bf16_t*)(p.ws + R_XA + A_CKVN), W + W_UKV / 2, T, 1024, 128, 128, nullptr, 0}; SO.init(T, 1024, G - Gc, c - Gc);
                pg8::EpiBf16<0> E{(bf16_t*)(p.ws + R_H + (size_t)T * 2048), 1024, nullptr, nullptr};
                pg8::gemm_phase<pg8::EpiBf16<0>, true>(lds, g, SO, E);
            }
        }
    }
    GSYNC();
    PH(4) { LP(); phase_p3b(p, lds); }
    GSYNC();
    RPT(4) { { LP(); phase_p3b(p, lds); } GSYNC(); }
    PH(5) { LP(); phase_p4(p, lds); }
    GSYNC();
    RPT(5) { { LP(); phase_p4(p, lds); } GSYNC(); }
    PH(6) { LP();
        pg8::Gemm g{xn, W + W_OUT_E / 2, T, 1024, 1024, 1024, nullptr, 0}; SO.init(T, 1024, G, c);
        pg8::EpiResF32Stat E{p.in[0], x1, (bf16_t*)p.out, (float*)(p.ws + SM_SSP1), 1024};
        pg8::gemm_phase<pg8::EpiResF32Stat, true>(lds, g, SO, E);
    }
    GSYNC();
    PH(7) { }
    PH(8) { LP();
        pg8::Gemm g{(const bf16_t*)p.out, W + W_GU / 2, T, 5632, 1024, 1024, nullptr, 0}; SO.init(T, 5632, G, c);
        pg8::EpiSwiGLU E{(bf16_t*)(p.ws + R_H), 2816, (const float*)(p.ws + SM_SSP1)};
        pg8::gemm_phase<pg8::EpiSwiGLU, true>(lds, g, SO, E);
    }
    GSYNC();
    PH(9) { LP();
        pg8::Gemm g{(const bf16_t*)(p.ws + R_H), W + W_D / 2, T, 1024, 2816, 2816, nullptr, 0}; SO.init(T, 1024, G, c);
        pg8::EpiResF32Stat E{x1, p.out, xn, (float*)(p.ws + SM_SSP2), 1024};
        pg8::gemm_phase<pg8::EpiResF32Stat, true>(lds, g, SO, E);
    }
    GSYNC();
    PH(10) { }
    PH(11) { LP();
        pg8::Gemm g{xn, W + W_IN_O / 2, T, 3072, 1024, 1024, nullptr, 0}; SO.init(T, 3072, G, c);
        pg8::EpiBf16<0> E{(bf16_t*)(p.ws + R_H), 3072, nullptr, (const float*)(p.ws + SM_SSP2)};
        pg8::gemm_phase<pg8::EpiBf16<0>, true>(lds, g, SO, E);
    }
    GSYNC();
    PH(12) { LP(); phase_conv(p); }
    GSYNC();
    RPT(12) { { LP(); phase_conv(p); } GSYNC(); }
    PH(13) { LP();
        pg8::Gemm g{xn, W + W_OUT_O / 2, T, 1024, 1024, 1024, nullptr, 0}; SO.init(T, 1024, G, c);
        pg8::EpiResF32 E{p.out, p.out, 1024};
        pg8::gemm_phase<pg8::EpiResF32, true>(lds, g, SO, E);
    }
    GSYNC();
    PH(14) { LP(); phase_norm_router(p, lds); }
    GSYNC();
    PH(15) { LP(); phase_moe_gather(p); }
    GSYNC();
    PH(16) { LP(); const int mrows = ((const int*)(p.ws + SM_CTL))[8];
        pg8::Gemm g{(const bf16_t*)(p.ws + R_XA), W + W_MGU / 2, mrows, 2816, 1024, 1024, (const int*)(p.ws + SM_TILEE), (size_t)2816 * 1024}; SO.init(mrows, 2816, G, c);
        pg8::EpiSwiGLU E{(bf16_t*)(p.ws + R_H), 1408, nullptr};
        pg8::gemm_phase<pg8::EpiSwiGLU, true>(lds, g, SO, E);
    }
    GSYNC();
    PH(17) { LP(); const int mrows = ((const int*)(p.ws + SM_CTL))[8];
        pg8::Gemm g{(const bf16_t*)(p.ws + R_H), W + W_MD / 2, mrows, 1024, 1408, 1408, (const int*)(p.ws + SM_TILEE), (size_t)1024 * 1408}; SO.init(mrows, 1024, G, c);
        pg8::EpiRowScaleBf16 E{(bf16_t*)(p.ws + R_XA), 1024, (const float*)(p.ws + SM_ROWW)};
        pg8::gemm_phase<pg8::EpiRowScaleBf16, true>(lds, g, SO, E);
    }
    GSYNC();
    PH(18) { LP(); phase_moe_combine(p); }
#undef PH
}

inline void launch(void* const* d_in, float* d_out, void* d_ws, size_t ws_size, hipStream_t stream, int ph_lo = 0, int ph_hi = 99, int dbg_branch = -1) {
    static int grid = 0;
    if (grid == 0) {
        int dev = 0, cus = 0, per_cu = 0;
        hipGetDevice(&dev); hipDeviceGetAttribute(&cus, hipDeviceAttributeMultiprocessorCount, dev);
        hipFuncSetAttribute((const void*)mega_fwd, hipFuncAttributeMaxDynamicSharedMemorySize, LDS_BYTES);
        hipOccupancyMaxActiveBlocksPerMultiprocessor(&per_cu, (const void*)mega_fwd, 512, LDS_BYTES);
        if (per_cu < 1) { fprintf(stderr, "occupancy query says %d blocks/CU\n", per_cu); per_cu = 1; }
        grid = cus;
        if (WS_FAST_END > ws_size) { fprintf(stderr, "ws too small: need %zu have %zu\n", (size_t)WS_FAST_END, ws_size); grid = -1; }
    }
    if (grid < 0) return;
    if (ph_lo <= 14 && ph_hi >= 14) hipMemsetAsync((char*)d_ws + SM_CTL, 0, 4096, stream);
    hipMemsetAsync((char*)d_ws + SM_BAR, 0, 16384, stream);
    Params p{};
    for (int i = 0; i < 30; ++i) p.in[i] = (const float*)d_in[i];
    p.out = d_out; p.ws = (unsigned char*)d_ws; p.ph_lo = ph_lo; p.ph_hi = ph_hi; p.dbg_branch = dbg_branch;
    void* args[] = {&p};
    hipError_t e = hipLaunchCooperativeKernel((const void*)mega_fwd, dim3(grid), dim3(512), args, LDS_BYTES, stream);
    if (e != hipSuccess) fprintf(stderr, "cooperative launch failed: %s (grid %d)\n", hipGetErrorString(e), grid);
}
}
extern "C" void kernel_launch(void* const* d_in, const int* in_sizes, int n_in, void* d_out, int out_size, void* d_ws, size_t ws_size, hipStream_t stream) {
    fast::launch(d_in, (float*)d_out, d_ws, ws_size, stream);
}
```

```cpp
#include <hip/hip_runtime.h>
#include <hip/hip_bf16.h>
#include <stdint.h>
#include <stdio.h>
#include <string.h>
#include <hip/hip_cooperative_groups.h>
namespace cg = cooperative_groups;
#define NB 8
#define REPEAT_MASK 0x0u
namespace gold {
constexpr int S = 4096, D = 1024, HW = 1720;
constexpr float EPS = 1e-6f;

__device__ const unsigned char T5B[128] = {0, 1, 2, 3, 4, 5, 6, 7, 8, 9, 10, 11, 12, 13, 14, 15, 16, 16, 16, 17, 17, 18, 18, 18, 19, 19, 19, 20, 20, 20, 20, 21, 21, 21, 21, 22, 22, 22, 22, 22, 23, 23, 23, 23, 23, 23, 24, 24, 24, 24, 24, 24, 25, 25, 25, 25, 25, 25, 25, 26, 26, 26, 26, 26, 26, 26, 26, 27, 27, 27, 27, 27, 27, 27, 27, 27, 27, 28, 28, 28, 28, 28, 28, 28, 28, 28, 28, 29, 29, 29, 29, 29, 29, 29, 29, 29, 29, 29, 29, 30, 30, 30, 30, 30, 30, 30, 30, 30, 30, 30, 30, 30, 30, 31, 31, 31, 31, 31, 31, 31, 31, 31, 31, 31, 31, 31, 31};
}
#ifndef NB
#define NB 8
#endif
namespace fast {
#define LAS __attribute__((address_space(3)))
typedef unsigned short bf16_t;
typedef short bf16x8 __attribute__((ext_vector_type(8)));
typedef float f32x4 __attribute__((ext_vector_type(4)));
typedef float f32x2 __attribute__((ext_vector_type(2)));
typedef float f32x16 __attribute__((ext_vector_type(16)));
typedef unsigned u32x4 __attribute__((ext_vector_type(4)));
typedef unsigned u32x2 __attribute__((ext_vector_type(2)));
typedef __bf16 bf16x2_t __attribute__((ext_vector_type(2)));

constexpr int S = 4096, T = NB * S, D = 1024;
constexpr float EPS = 1e-6f, LOG2E = 1.4426950408889634f;

__device__ __forceinline__ unsigned cvtpk(float lo, float hi) { f32x2 v = {lo, hi}; bf16x2_t b = __builtin_convertvector(v, bf16x2_t); return __builtin_bit_cast(unsigned, b); }
__device__ __forceinline__ bf16_t f2bf(float f) { return (bf16_t)(cvtpk(f, 0.f) & 0xffffu); }
__device__ __forceinline__ float bf2f(bf16_t u) { return __builtin_bit_cast(float, (unsigned)u << 16); }
__device__ __forceinline__ float bflo(unsigned u) { return __builtin_bit_cast(float, u << 16); }
__device__ __forceinline__ float bfhi(unsigned u) { return __builtin_bit_cast(float, u & 0xffff0000u); }
__device__ __forceinline__ float wsum(float v) {
#pragma unroll
    for (int o = 1; o < 64; o <<= 1) v += __shfl_xor(v, o);
    return v;
}
__device__ __forceinline__ float fexp2(float x) { return __builtin_amdgcn_exp2f(x); }
__device__ __forceinline__ float frcp(float x) { return __builtin_amdgcn_rcpf(x); }
__device__ __forceinline__ float silu_f(float x) { return x * frcp(1.f + fexp2(-x * LOG2E)); }
__device__ __forceinline__ float gelu_tanh_f(float x) {
    const float u = 0.7978845608028654f * (x + 0.044715f * x * x * x);
    return x * frcp(1.f + fexp2(-2.f * LOG2E * u));
}

namespace pg8 {
constexpr int BM = 256, BK = 64, HALF = 128, HTB = HALF * BK * 2, STAGE_BYTES = 8 * HTB, NXCD = 8, WGM = 8;
__host__ __device__ __forceinline__ int lds_byte(int r, int c) { const int st = (r >> 4) * 2 + (c >> 5), rr = r & 15, cc = c & 31, ob = rr * 64 + cc * 2; return st * 1024 + (ob ^ (((ob >> 9) & 1) << 5)); }
__host__ __device__ __forceinline__ void stage_rc(int b, int& R, int& C) { const int st = b / 1024, sb = b % 1024, swz = sb ^ (((sb >> 9) & 1) << 5); R = (st >> 1) * 16 + swz / 64; C = (st & 1) * 32 + (swz % 64) / 2; }
__host__ __device__ __forceinline__ int perm32(int rho) { const int n = rho >> 4, i = rho & 15; return 8 * (i >> 2) + 4 * n + (i & 3); }

struct Unit { int pm, pn; };
struct Gemm { const bf16_t* A; const bf16_t* Bt; int M, N, K, lda; const int* tile_e; size_t estride; const int* rowidx; };

struct StaticOrder {
    int nM, nN, nwg, G, c;
    __device__ void init(int M, int N, int G_, int c_) { nM = M / BM; nN = N / BM; nwg = nM * nN; G = G_; c = c_; }
    __device__ bool next(int i, Unit& u) const {
        const long L = (long)i * G + c; if (L >= nwg) return false;
        int wgid = (int)L; { const int q = nwg / NXCD, r = nwg % NXCD, xcd = wgid % NXCD, off = wgid / NXCD; wgid = (xcd < r ? xcd * (q + 1) : r * (q + 1) + (xcd - r) * q) + off; }
        const int nig = WGM * nN, gid = wgid / nig, fm = gid * WGM, gsz = (nM - fm) < WGM ? (nM - fm) : WGM;
        u.pm = fm + ((wgid % nig) % gsz); u.pn = (wgid % nig) / gsz; return true;
    }
};

template <class Epi, bool ALIGN_EPI, bool GATHER = false>
__device__ __forceinline__ void gemm_phase(LAS unsigned char* lds, const Gemm g, const StaticOrder& S, const Epi& E) {
    int tid = threadIdx.x; asm volatile("" : "+v"(tid));
    const int wid = __builtin_amdgcn_readfirstlane(tid >> 6), lane = tid & 63, wr = wid >> 2, wc = wid & 3, fr = lane & 15, fq = lane >> 4;
    const int K = g.K, nt = K / BK, lda = g.lda;
    unsigned voffA[2], voffB[2];
#pragma unroll
    for (int i = 0; i < 2; ++i) { int R, C; stage_rc(tid * 16 + i * 8192, R, C); const int Rb = Epi::PERM ? ((R & ~31) + perm32(R & 31)) : R;
        voffA[i] = (unsigned)(R * lda + C) * 2u; voffB[i] = (unsigned)(Rb * K + C) * 2u; }
    const size_t kstep = (size_t)(BK * 2);
    const size_t hsA = GATHER ? 0 : (size_t)HALF * lda * 2, tsA = 2 * hsA, hsB = (size_t)HALF * K * 2, tsB = 2 * hsB;
    unsigned vgc[2][2], vgn[2][2];
#define PG8_GOFF(pm_, vg) do { _Pragma("unroll") for (int h_ = 0; h_ < 2; ++h_) _Pragma("unroll") for (int i_ = 0; i_ < 2; ++i_) { int R_, C_; stage_rc(tid * 16 + i_ * 8192, R_, C_); \
        int tok_ = g.rowidx[(pm_) * BM + h_ * HALF + R_]; tok_ = tok_ < 0 ? 0 : tok_; vg[h_][i_] = (unsigned)(tok_ * lda + C_) * 2u; } } while (0)
#define PG8_STAGE_A(bufoff, gbase, h, nx) do { unsigned va_[2]; _Pragma("unroll") for (int i_ = 0; i_ < 2; ++i_) va_[i_] = GATHER ? ((nx) ? vgn[h][i_] : vgc[h][i_]) : voffA[i_]; PG8_STAGE(bufoff, gbase, va_); } while (0)
    const unsigned ldsw = (unsigned)wid * 1024u;
    const int aoff = lds_byte(wr * 64 + fr, fq * 8), boff = lds_byte(wc * 32 + fr, fq * 8);
#define PG8_SA(b, h) (((b) * 2 + (h)) * HTB)
#define PG8_SB(b, h) ((4 + (b) * 2 + (h)) * HTB)
#define PG8_STAGE(bufoff, gbase, voff) do { _Pragma("unroll") for (int _i = 0; _i < 2; ++_i) \
        __builtin_amdgcn_global_load_lds((const unsigned*)((const char*)(gbase) + (voff)[_i]), (LAS unsigned*)(lds + (bufoff) + ldsw + _i * 8192), 16, 0, 0); } while (0)
#define PG8_LDA(dst, b, h) do { _Pragma("unroll") for (int m = 0; m < 4; ++m) _Pragma("unroll") for (int k = 0; k < 2; ++k) dst[m][k] = *(const LAS bf16x8*)(lds + PG8_SA(b, h) + aoff + m * 2048 + k * 1024); } while (0)
#define PG8_LDB(dst, b, h) do { _Pragma("unroll") for (int n = 0; n < 2; ++n) _Pragma("unroll") for (int k = 0; k < 2; ++k) dst[n][k] = *(const LAS bf16x8*)(lds + PG8_SB(b, h) + boff + n * 2048 + k * 1024); } while (0)
#define PG8_MMA(ai, bj, At, Bt) do { __builtin_amdgcn_s_setprio(1); _Pragma("unroll") for (int m = 0; m < 4; ++m) _Pragma("unroll") for (int n = 0; n < 2; ++n) _Pragma("unroll") for (int k = 0; k < 2; ++k) \
        acc[ai][bj][m][n] = __builtin_amdgcn_mfma_f32_16x16x32_bf16(Bt[n][k], At[m][k], acc[ai][bj][m][n], 0, 0, 0); __builtin_amdgcn_s_setprio(0); } while (0)
#define PG8_WAIT_V(n) asm volatile("s_waitcnt vmcnt(" #n ")" ::: "memory")
#define PG8_WAIT_L(n) asm volatile("s_waitcnt lgkmcnt(" #n ")" ::: "memory")
#define PG8_BAR __builtin_amdgcn_s_barrier()
#define PG8_SCHED __builtin_amdgcn_sched_barrier(0)
#define PG8_EOFF(pm_) (g.tile_e ? (size_t)g.tile_e[pm_] * g.estride * 2 : (size_t)0)
    Unit cur, nxt; int ui = 0;
    if (!S.next(0, cur)) return;
    f32x4 acc[2][2][4][2];
#pragma unroll
    for (int a = 0; a < 2; ++a)
#pragma unroll
        for (int b = 0; b < 2; ++b)
#pragma unroll
            for (int m = 0; m < 4; ++m)
#pragma unroll
                for (int n = 0; n < 2; ++n) acc[a][b][m][n] = (f32x4){0.f, 0.f, 0.f, 0.f};
    bf16x8 At[4][2], B0[2][2], B1[2][2];
    const char* cA = (const char*)g.A + (size_t)cur.pm * tsA; const char* cB = (const char*)g.Bt + PG8_EOFF(cur.pm) + (size_t)cur.pn * tsB;
    if constexpr (GATHER) PG8_GOFF(cur.pm, vgc);
    PG8_STAGE(PG8_SB(0, 0), cB, voffB); PG8_STAGE(PG8_SB(0, 1), cB + hsB, voffB); PG8_STAGE_A(PG8_SA(0, 0), cA, 0, false); PG8_STAGE_A(PG8_SA(0, 1), cA + hsA, 1, false);
    if (wr == 1) PG8_BAR;
    PG8_WAIT_V(2); PG8_BAR;
    PG8_STAGE(PG8_SB(1, 0), cB + kstep, voffB); PG8_STAGE_A(PG8_SA(1, 0), cA + kstep, 0, false); PG8_STAGE(PG8_SB(1, 1), cB + hsB + kstep, voffB);
    PG8_WAIT_V(6); PG8_BAR;
    for (;;) {
        const bool has_next = S.next(ui + 1, nxt);
        if constexpr (GATHER) { if (has_next) PG8_GOFF(nxt.pm, vgn); else { vgn[0][0] = vgc[0][0]; vgn[0][1] = vgc[0][1]; vgn[1][0] = vgc[1][0]; vgn[1][1] = vgc[1][1]; } }
        const char* nA = has_next ? (const char*)g.A + (size_t)nxt.pm * tsA : cA;
        const char* nB = has_next ? (const char*)g.Bt + PG8_EOFF(nxt.pm) + (size_t)nxt.pn * tsB : cB;
        for (int t = 0; t < nt; t += 2) {
            const bool last = (t == nt - 2);
            const char* a1 = cA + (size_t)(t + 1) * kstep;
            const char* a2 = last ? nA : cA + (size_t)(t + 2) * kstep; const char* b2 = last ? nB : cB + (size_t)(t + 2) * kstep;
            const char* a3 = a2 + kstep; const char* b3 = b2 + kstep;
            PG8_LDB(B0, 0, 0); PG8_LDB(B1, 0, 1); PG8_SCHED; PG8_LDA(At, 0, 0); PG8_STAGE_A(PG8_SA(1, 1), a1 + hsA, 1, false);
            PG8_WAIT_V(8); PG8_WAIT_L(0); PG8_BAR; PG8_MMA(0, 0, At, B0); PG8_MMA(0, 1, At, B1); PG8_BAR; PG8_SCHED;
            PG8_LDA(At, 0, 1); PG8_STAGE(PG8_SB(0, 0), b2, voffB); PG8_STAGE(PG8_SB(0, 1), b2 + hsB, voffB); PG8_STAGE_A(PG8_SA(0, 0), a2, 0, last);
            PG8_WAIT_V(8); PG8_WAIT_L(0); PG8_BAR; PG8_MMA(1, 0, At, B0); PG8_MMA(1, 1, At, B1); PG8_BAR; PG8_SCHED;
            PG8_LDB(B0, 1, 0); PG8_LDB(B1, 1, 1); PG8_SCHED; PG8_LDA(At, 1, 0); PG8_STAGE_A(PG8_SA(0, 1), a2 + hsA, 1, last);
            PG8_WAIT_V(8); PG8_WAIT_L(0); PG8_BAR; PG8_MMA(0, 0, At, B0); PG8_MMA(0, 1, At, B1); PG8_BAR; PG8_SCHED;
            PG8_LDA(At, 1, 1); PG8_STAGE(PG8_SB(1, 0), b3, voffB); PG8_STAGE(PG8_SB(1, 1), b3 + hsB, voffB); PG8_STAGE_A(PG8_SA(1, 0), a3, 0, last);
            PG8_WAIT_V(8); PG8_WAIT_L(0); PG8_BAR; PG8_MMA(1, 0, At, B0); PG8_MMA(1, 1, At, B1); PG8_BAR; PG8_SCHED;
        }
        if constexpr (ALIGN_EPI) { if (wr == 0) PG8_BAR; }
        E(acc, cur, wr, wc, fr, fq);
        if (!has_next) break;
#pragma unroll
        for (int a = 0; a < 2; ++a)
#pragma unroll
            for (int b = 0; b < 2; ++b)
#pragma unroll
                for (int m = 0; m < 4; ++m)
#pragma unroll
                    for (int n = 0; n < 2; ++n) acc[a][b][m][n] = (f32x4){0.f, 0.f, 0.f, 0.f};
        cur = nxt; cA = nA; cB = nB; ++ui;
        if constexpr (GATHER) { vgc[0][0] = vgn[0][0]; vgc[0][1] = vgn[0][1]; vgc[1][0] = vgn[1][0]; vgc[1][1] = vgn[1][1]; }
        if constexpr (ALIGN_EPI) { if (wr == 1) PG8_BAR; }
    }
    PG8_WAIT_V(0);
    if constexpr (!ALIGN_EPI) { if (wr == 0) PG8_BAR; }
    PG8_BAR;
#undef PG8_SA
#undef PG8_SB
#undef PG8_STAGE
#undef PG8_LDA
#undef PG8_LDB
#undef PG8_MMA
#undef PG8_WAIT_V
#undef PG8_WAIT_L
#undef PG8_BAR
#undef PG8_SCHED
#undef PG8_EOFF
#undef PG8_GOFF
#undef PG8_STAGE_A
}

__device__ __forceinline__ float row_rstd(const float* ssp, int row);
template <int ACT> struct EpiBf16 {
    static constexpr bool PERM = true;
    bf16_t* O; int ldc; const float* bias; const float* ssp;
    __device__ __forceinline__ void operator()(const f32x4 (&acc)[2][2][4][2], const Unit& u, int wr, int wc, int fr, int fq) const {
        const int row0 = u.pm * BM + wr * 64 + fr, col0 = u.pn * BM + wc * 32 + 8 * fq;
        f32x4 bv[2][2];
#pragma unroll
        for (int bj = 0; bj < 2; ++bj)
#pragma unroll
            for (int n = 0; n < 2; ++n) bv[bj][n] = bias ? *(const f32x4*)(bias + col0 + bj * HALF + 4 * n) : (f32x4){0.f, 0.f, 0.f, 0.f};
#pragma unroll
        for (int ai = 0; ai < 2; ++ai)
#pragma unroll
            for (int m = 0; m < 4; ++m) { bf16_t* rowp = O + (size_t)(row0 + ai * HALF + m * 16) * ldc + col0;
                const float rs = (ACT == 0 && ssp) ? row_rstd(ssp, row0 + ai * HALF + m * 16) : 1.f;
#pragma unroll
                for (int bj = 0; bj < 2; ++bj) { f32x4 v0 = acc[ai][bj][m][0] * rs + bv[bj][0], v1 = acc[ai][bj][m][1] * rs + bv[bj][1];
                    if (ACT == 2) {
#pragma unroll
                        for (int i = 0; i < 4; ++i) { v0[i] = gelu_tanh_f(v0[i]); v1[i] = gelu_tanh_f(v1[i]); } }
                    u32x4 w; w.x = cvtpk(v0[0], v0[1]); w.y = cvtpk(v0[2], v0[3]); w.z = cvtpk(v1[0], v1[1]); w.w = cvtpk(v1[2], v1[3]);
                    *(u32x4*)(rowp + bj * HALF) = w; } }
    }
};
struct EpiResF32 {
    static constexpr bool PERM = false;
    const float* base; float* out; int ldc;
    __device__ __forceinline__ void operator()(const f32x4 (&acc)[2][2][4][2], const Unit& u, int wr, int wc, int fr, int fq) const {
        const int col0 = u.pn * BM + wc * 32 + 4 * fq;
#pragma unroll
        for (int ai = 0; ai < 2; ++ai)
#pragma unroll
            for (int m = 0; m < 4; ++m) { const size_t off = (size_t)(u.pm * BM + ai * HALF + wr * 64 + m * 16 + fr) * ldc + col0;
#pragma unroll
                for (int bj = 0; bj < 2; ++bj)
#pragma unroll
                    for (int n = 0; n < 2; ++n) { const f32x4 bs = *(const f32x4*)(base + off + bj * HALF + n * 16); *(f32x4*)(out + off + bj * HALF + n * 16) = bs + acc[ai][bj][m][n]; } }
    }
};
struct EpiResF32Stat {
    static constexpr bool PERM = false;
    const float* base; float* out; bf16_t* xb; float* ssp; int ldc;
    __device__ __forceinline__ void operator()(const f32x4 (&acc)[2][2][4][2], const Unit& u, int wr, int wc, int fr, int fq) const {
        const int col0 = u.pn * BM + wc * 32 + 4 * fq;
#pragma unroll
        for (int ai = 0; ai < 2; ++ai)
#pragma unroll
            for (int m = 0; m < 4; ++m) { const int row = u.pm * BM + ai * HALF + wr * 64 + m * 16 + fr; const size_t off = (size_t)row * ldc + col0; float ss = 0.f;
#pragma unroll
                for (int bj = 0; bj < 2; ++bj)
#pragma unroll
                    for (int n = 0; n < 2; ++n) { const f32x4 v = *(const f32x4*)(base + off + bj * HALF + n * 16) + acc[ai][bj][m][n]; *(f32x4*)(out + off + bj * HALF + n * 16) = v;
                        u32x2 w; w.x = cvtpk(v.x, v.y); w.y = cvtpk(v.z, v.w); *(u32x2*)(xb + off + bj * HALF + n * 16) = w; ss += (v.x * v.x + v.y * v.y) + (v.z * v.z + v.w * v.w); }
                ss += __shfl_xor(ss, 16); ss += __shfl_xor(ss, 32);
                if (fq == 0) ssp[(size_t)row * 16 + u.pn * 4 + wc] = ss; }
    }
};
__device__ __forceinline__ float row_rstd(const float* ssp, int row) {
    const f32x4* q = (const f32x4*)(ssp + (size_t)row * 16); const f32x4 a = q[0], b = q[1], c = q[2], d = q[3];
    const float s = ((a.x + a.y) + (a.z + a.w)) + ((b.x + b.y) + (b.z + b.w)) + ((c.x + c.y) + (c.z + c.w)) + ((d.x + d.y) + (d.z + d.w));
    return rsqrtf(s * (1.f / 1024.f) + EPS);
}
struct EpiSwiGLU {
    static constexpr bool PERM = true;
    bf16_t* O; int ldc; const float* ssp;
    __device__ __forceinline__ void operator()(const f32x4 (&acc)[2][2][4][2], const Unit& u, int wr, int wc, int fr, int fq) const {
        const int row0 = u.pm * BM + wr * 64 + fr, col0 = u.pn * HALF + wc * 32 + 8 * fq;
#pragma unroll
        for (int ai = 0; ai < 2; ++ai)
#pragma unroll
            for (int m = 0; m < 4; ++m) { bf16_t* rowp = O + (size_t)(row0 + ai * HALF + m * 16) * ldc + col0;
                const float rs = ssp ? row_rstd(ssp, row0 + ai * HALF + m * 16) : 1.f;
                float h[8];
#pragma unroll
                for (int n = 0; n < 2; ++n)
#pragma unroll
                    for (int i = 0; i < 4; ++i) h[n * 4 + i] = silu_f(acc[ai][0][m][n][i] * rs) * (acc[ai][1][m][n][i] * rs);
                u32x4 w; w.x = cvtpk(h[0], h[1]); w.y = cvtpk(h[2], h[3]); w.z = cvtpk(h[4], h[5]); w.w = cvtpk(h[6], h[7]);
                *(u32x4*)rowp = w; }
    }
};
struct EpiRowScaleBf16 {
    static constexpr bool PERM = true;
    bf16_t* O; int ldc; const float* roww;
    __device__ __forceinline__ void operator()(const f32x4 (&acc)[2][2][4][2], const Unit& u, int wr, int wc, int fr, int fq) const {
        const int row0 = u.pm * BM + wr * 64 + fr, col0 = u.pn * BM + wc * 32 + 8 * fq;
#pragma unroll
        for (int ai = 0; ai < 2; ++ai)
#pragma unroll
            for (int m = 0; m < 4; ++m) { const int row = row0 + ai * HALF + m * 16; const float sc = roww[row]; bf16_t* rowp = O + (size_t)row * ldc + col0;
#pragma unroll
                for (int bj = 0; bj < 2; ++bj) { const f32x4 v0 = acc[ai][bj][m][0] * sc, v1 = acc[ai][bj][m][1] * sc;
                    u32x4 w; w.x = cvtpk(v0[0], v0[1]); w.y = cvtpk(v0[2], v0[3]); w.z = cvtpk(v1[0], v1[1]); w.w = cvtpk(v1[2], v1[3]);
                    *(u32x4*)(rowp + bj * HALF) = w; } }
    }
};
}
constexpr int ROWS_MAX = 2 * T + 8 * 256;
constexpr size_t al256(size_t x) { return (x + 255) & ~(size_t)255; }
constexpr size_t W_IN_E = 0;
constexpr size_t W_CW1 = W_IN_E + (size_t)1792 * 1024 * 2;
constexpr size_t W_UQ = W_CW1 + (size_t)2 * 256 * 2048 * 2;
constexpr size_t W_UKV = W_UQ + (size_t)1024 * 256 * 2;
constexpr size_t W_OUT_E = W_UKV + (size_t)1024 * 128 * 2;
constexpr size_t W_GU = W_OUT_E + (size_t)1024 * 1024 * 2;
constexpr size_t W_D = W_GU + (size_t)5632 * 1024 * 2;
constexpr size_t W_IN_O = W_D + (size_t)1024 * 2816 * 2;
constexpr size_t W_OUT_O = W_IN_O + (size_t)3072 * 1024 * 2;
constexpr size_t W_MGU = W_OUT_O + (size_t)1024 * 1024 * 2;
constexpr size_t W_MD = W_MGU + (size_t)8 * 2816 * 1024 * 2;
constexpr size_t W_END = W_MD + (size_t)8 * 1024 * 1408 * 2;
constexpr size_t SM_CTL = al256(W_END);
constexpr size_t SM_BAR = SM_CTL + 4096;
constexpr size_t SM_B1P = SM_BAR + 16384;
constexpr size_t SM_B1 = SM_B1P + 32 * 512 * 4;
constexpr size_t SM_ROPE = SM_B1 + 512 * 4;
constexpr size_t SM_BL = SM_ROPE + (size_t)S * 32 * 4;
constexpr size_t SM_HID = SM_BL + 8 * 132 * 4;
constexpr size_t SM_KC = SM_HID + (size_t)2 * NB * 512 * 256 * 2;
constexpr size_t SM_VCT = SM_KC + (size_t)NB * 512 * 64 * 2;
constexpr size_t SM_TE = SM_VCT + (size_t)NB * 512 * 64 * 2;
constexpr size_t SM_TW = SM_TE + (size_t)T * 8;
constexpr size_t SM_RANK = SM_TW + (size_t)T * 8;
constexpr size_t SM_POS = SM_RANK + (size_t)T * 8;
constexpr size_t SM_ROWW = SM_POS + (size_t)T * 8;
constexpr size_t SM_TILEE = SM_ROWW + (size_t)ROWS_MAX * 4;
constexpr size_t SM_ROWTOK = al256(SM_TILEE + (size_t)(ROWS_MAX / 256 + 8) * 4);
constexpr size_t SM_SSP1 = al256(SM_ROWTOK + (size_t)ROWS_MAX * 4);
constexpr size_t SM_SSP2 = SM_SSP1 + (size_t)T * 64;
constexpr size_t SM_END = SM_SSP2 + (size_t)T * 64;
constexpr size_t R_XA = al256(SM_END);
constexpr size_t SZ_XA = (size_t)T * 4096 + (size_t)4 * 1048576;
constexpr size_t R_XN = R_XA + SZ_XA;
constexpr size_t SZ_XN = (size_t)T * 2048;
constexpr size_t R_H = R_XN + SZ_XN;
constexpr size_t SZ_H = ((size_t)T * 6144 > (size_t)ROWS_MAX * 2816) ? (size_t)T * 6144 : (size_t)ROWS_MAX * 2816;
constexpr size_t WS_FAST_END = R_H + SZ_H;
constexpr size_t A_QN = 0;
constexpr size_t A_KSN = A_QN + (size_t)T * 1024;
constexpr size_t A_KWN = A_KSN + (size_t)T * 256;
constexpr size_t A_VST = A_KWN + (size_t)T * 256;
constexpr size_t A_VWT = A_VST + (size_t)T * 256;
constexpr size_t A_KCIN = A_VWT + (size_t)T * 256;
constexpr size_t A_VCIN = A_KCIN + (size_t)T * 256 + 2048;
constexpr size_t A_CQN = A_VCIN + (size_t)T * 256 + 2048;
constexpr size_t A_CKVN = A_CQN + (size_t)T * 512;
constexpr size_t A_KROPE = A_CKVN + (size_t)T * 256;
constexpr size_t A_GATES = A_KROPE + (size_t)T * 64;
constexpr size_t A_END = A_GATES + (size_t)T * 96;
static_assert(A_END <= SZ_XA, "attention inputs fit R_XA");
constexpr size_t O_QM = 0;
constexpr size_t O_KM = O_QM + (size_t)T * 1536;
constexpr size_t O_VMT = O_KM + (size_t)T * 1536;
static_assert(O_VMT + (size_t)T * 1024 <= (size_t)T * 4096, "d_out scratch");

struct Params {
    const float* in[30];
    float* out;
    unsigned char* ws;
    int ph_lo, ph_hi, dbg_branch, pad_;
};

constexpr int LDS_BYTES = 147456;

__device__ __forceinline__ int ltid() { int t = threadIdx.x; asm volatile("" : "+v"(t)); return t; }
__device__ __forceinline__ int perm16(int k) { return (k & ~12) | ((k & 4) << 1) | ((k & 8) >> 1); }

struct WDesc { int in_idx, K, N, rep, map, row_off; size_t src_stride, dst_off, dst_stride; int gain_idx, pad_; };
__device__ const WDesc WDESC[12] = {
    {3, 1024, 1720, 1, 2, 0, 0, W_IN_E / 2, 0, -1, 0},
    {7, 2048, 256, 2, 0, 0, (size_t)2048 * 256, W_CW1 / 2, (size_t)256 * 2048, -1, 0},
    {11, 256, 768, 1, 3, 0, 0, W_UQ / 2, 0, -1, 0},
    {12, 128, 1024, 1, 0, 0, 0, W_UKV / 2, 0, -1, 0},
    {15, 1024, 1024, 1, 0, 0, 0, W_OUT_E / 2, 0, -1, 0},
    {17, 1024, 2816, 1, 1, 0, 0, W_GU / 2, 0, 16, 0},
    {18, 1024, 2816, 1, 1, 128, 0, W_GU / 2, 0, 16, 0},
    {19, 2816, 1024, 1, 0, 0, 0, W_D / 2, 0, -1, 0},
    {21, 1024, 3072, 1, 0, 0, 0, W_IN_O / 2, 0, 20, 0},
    {23, 1024, 1024, 1, 0, 0, 0, W_OUT_O / 2, 0, -1, 0},
    {27, 1024, 1408, 8, 1, 0, (size_t)1024 * 1408, W_MGU / 2, (size_t)2816 * 1024, -1, 0},
    {28, 1024, 1408, 8, 1, 128, (size_t)1024 * 1408, W_MGU / 2, (size_t)2816 * 1024, -1, 0},
};
__device__ const WDesc WDESC_MD = {29, 1408, 1024, 8, 0, 0, (size_t)1408 * 1024, W_MD / 2, (size_t)1024 * 1408, -1, 0};

__device__ __forceinline__ void transpose_item(const float* W, int K, int N, bf16_t* WT, int map, int row_off, const float* gain, LAS float* scr, int item, int lane) {
    const int nblk = (N + 31) / 32, kb = item / nblk, nb = item % nblk, k0 = 64 * kb, n0 = 32 * nb;
    const int n4 = (lane & 7) * 4; const bool nok = (n0 + n4) < N;
    f32x4 v[8];
#pragma unroll
    for (int i = 0; i < 8; ++i) { const int kk = (lane >> 3) + 8 * i; v[i] = nok ? *(const f32x4*)(W + (size_t)(k0 + kk) * N + n0 + n4) : (f32x4){0.f, 0.f, 0.f, 0.f}; if (gain) v[i] = v[i] * gain[k0 + kk]; }
#pragma unroll
    for (int i = 0; i < 8; ++i) { const int kk = (lane >> 3) + 8 * i; LAS float* d = scr + kk * 33 + n4; d[0] = v[i].x; d[1] = v[i].y; d[2] = v[i].z; d[3] = v[i].w; }
    asm volatile("s_waitcnt lgkmcnt(0)" ::: "memory");
    const int c = lane & 7;
#pragma unroll
    for (int j = 0; j < 4; ++j) { const int n = (lane >> 3) + 8 * j; const LAS float* s = scr + (8 * c) * 33 + n;
        u32x4 o; o.x = cvtpk(s[0 * 33], s[1 * 33]); o.y = cvtpk(s[2 * 33], s[3 * 33]); o.z = cvtpk(s[4 * 33], s[5 * 33]); o.w = cvtpk(s[6 * 33], s[7 * 33]);
        const int nn = n0 + n;
        if (nn < N) { const int row = (map == 1) ? (256 * (nn >> 7) + (nn & 127) + row_off) : (map == 2) ? (nn < 1280 ? nn : (nn < 1304 ? nn + 416 : nn - 24)) : (map == 3) ? ((nn / 96) * 128 + nn % 96) : (nn + row_off);
            *(u32x4*)(WT + (size_t)row * K + k0 + 8 * c) = o; } }
    asm volatile("s_waitcnt lgkmcnt(0)" ::: "memory");
}
__device__ __forceinline__ void do_wdesc(const Params& p, const WDesc& d, int it, LAS float* scr, int lane) {
    const int per = (d.K / 64) * ((d.N + 31) / 32); const int r = it / per, ii = it % per;
    transpose_item(p.in[d.in_idx] + (size_t)r * d.src_stride, d.K, d.N, (bf16_t*)p.ws + d.dst_off + (size_t)r * d.dst_stride, d.map, d.row_off, d.gain_idx >= 0 ? p.in[d.gain_idx] : nullptr, scr, ii, lane);
}
__device__ __forceinline__ void rms_row_to_bf16(const float* xrow, const float* g, bf16_t* orow, int lane) {
    const f32x4* xr = (const f32x4*)xrow + lane; const f32x4* gr = (const f32x4*)g + lane;
    f32x4 v[4]; float s = 0.f;
#pragma unroll
    for (int j = 0; j < 4; ++j) { v[j] = xr[64 * j]; s += (v[j].x * v[j].x + v[j].y * v[j].y) + (v[j].z * v[j].z + v[j].w * v[j].w); }
    const float r = rsqrtf(wsum(s) * (1.f / 1024.f) + EPS);
    u32x2* o8 = (u32x2*)orow + lane;
#pragma unroll
    for (int j = 0; j < 4; ++j) { const f32x4 gg = gr[64 * j]; u32x2 w; w.x = cvtpk(v[j].x * r * gg.x, v[j].y * r * gg.y); w.y = cvtpk(v[j].z * r * gg.z, v[j].w * r * gg.w); o8[64 * j] = w; }
}
__device__ __forceinline__ void phase_p0(const Params& p, LAS unsigned char* lds) {
    const int tid = ltid(), lane = tid & 63, wave = tid >> 6;
    const int gw = blockIdx.x * 8 + wave, NGW = gridDim.x * 8;
    LAS float* scr = (LAS float*)(lds + wave * 16384);
    int base = 0;
#pragma unroll 1
    for (int d = 0; d < 13; ++d) {
        const WDesc& wd = (d < 12) ? WDESC[d] : WDESC_MD;
        const int n_it = wd.rep * (wd.K / 64) * ((wd.N + 31) / 32);
        int first = (gw - (base % NGW) + NGW) % NGW;
        for (int it = first; it < n_it; it += NGW) do_wdesc(p, wd, it, scr, lane);
        base += n_it;
    }
    bf16_t* xn = (bf16_t*)(p.ws + R_XN);
    for (int m = gw; m < T; m += 2 * NGW) { rms_row_to_bf16(p.in[0] + (size_t)m * D, p.in[2], xn + (size_t)m * D, lane); if (m + NGW < T) rms_row_to_bf16(p.in[0] + (size_t)(m + NGW) * D, p.in[2], xn + (size_t)(m + NGW) * D, lane); }
    for (int u = gw; u < 256; u += NGW) {
        const int kc = u >> 3, kv = (u >> 2) & 1, nb = u & 3; float s = 0.f;
        const float* pos = p.in[6] + kv * 2048 + kc * 64; const float* w1 = p.in[7] + ((size_t)kv * 2048 + kc * 64) * 256 + nb * 64 + lane;
#pragma unroll 8
        for (int k = 0; k < 64; ++k) s += pos[k] * w1[(size_t)k * 256];
        ((float*)(p.ws + SM_B1P))[kc * 512 + kv * 256 + nb * 64 + lane] = s;
    }
    for (int i = blockIdx.x * 512 + tid; i < S * 16; i += gridDim.x * 512) {
        const int t = i >> 4, f = i & 15; const float ang = (float)t * powf(10000.f, -(float)f / 16.f);
        float* rp = (float*)(p.ws + SM_ROPE) + t * 32; rp[f] = cosf(ang); rp[16 + f] = sinf(ang);
    }
    if (blockIdx.x == 0) for (int i = tid; i < 8 * 129; i += 512) { const int h = i / 129, dd = i % 129; ((float*)(p.ws + SM_BL))[h * 132 + dd] = p.in[1][(dd < 128 ? (int)gold::T5B[dd] : 31) * 8 + h] * LOG2E; }
}

__device__ __forceinline__ void unpack8(const u32x4 v, float (&x)[8]) { x[0] = bflo(v.x); x[1] = bfhi(v.x); x[2] = bflo(v.y); x[3] = bfhi(v.y); x[4] = bflo(v.z); x[5] = bfhi(v.z); x[6] = bflo(v.w); x[7] = bfhi(v.w); }
__device__ __forceinline__ u32x4 pack8(const float (&x)[8]) { u32x4 w; w.x = cvtpk(x[0], x[1]); w.y = cvtpk(x[2], x[3]); w.z = cvtpk(x[4], x[5]); w.w = cvtpk(x[6], x[7]); return w; }
__device__ __forceinline__ float ss8f(const float (&x)[8]) { return ((x[0] * x[0] + x[1] * x[1]) + (x[2] * x[2] + x[3] * x[3])) + ((x[4] * x[4] + x[5] * x[5]) + (x[6] * x[6] + x[7] * x[7])); }
__device__ __forceinline__ void load8f(const float* g, float (&x)[8], float sc) { const f32x4 a = *(const f32x4*)g, b = *(const f32x4*)(g + 4); x[0] = a.x * sc; x[1] = a.y * sc; x[2] = a.z * sc; x[3] = a.w * sc; x[4] = b.x * sc; x[5] = b.y * sc; x[6] = b.z * sc; x[7] = b.w * sc; }
__device__ __forceinline__ void phase_p2(const Params& p, LAS unsigned char* lds) {
    const int tid = ltid(), lane = tid & 63, wave = tid >> 6;
    const bf16_t* hb = (const bf16_t*)(p.ws + R_H);
    unsigned char* xa = p.ws + R_XA;
    bf16_t* qn = (bf16_t*)(xa + A_QN); bf16_t* ksn = (bf16_t*)(xa + A_KSN); bf16_t* kwn = (bf16_t*)(xa + A_KWN);
    bf16_t* vst = (bf16_t*)(xa + A_VST); bf16_t* vwt = (bf16_t*)(xa + A_VWT); bf16_t* kcin = (bf16_t*)(xa + A_KCIN); bf16_t* vcin = (bf16_t*)(xa + A_VCIN);
    bf16_t* cqn = (bf16_t*)(xa + A_CQN); bf16_t* ckvn = (bf16_t*)(xa + A_CKVN); bf16_t* krope = (bf16_t*)(xa + A_KROPE); float* gates = (float*)(xa + A_GATES);
    LAS bf16_t* vs = (LAS bf16_t*)lds;
    if (blockIdx.x == 0) {
        { float s = 0.f; for (int k = 0; k < 32; ++k) s += ((const float*)(p.ws + SM_B1P))[k * 512 + tid]; ((float*)(p.ws + SM_B1))[tid] = s; }
        for (int i = tid; i < 1024; i += 512) { kcin[(size_t)T * 128 + i] = 0; vcin[(size_t)T * 128 + i] = 0; }
    }
    const int c8 = (lane & 7) * 8, seg = lane >> 3;
    float qg[8], ksg[8], kwg[8], cqg[8], ckvg[8];
    load8f(p.in[4] + c8, qg, 0.125f * LOG2E); load8f(p.in[5] + 64 + c8, ksg, 1.f); load8f(p.in[5] + 128 + c8, kwg, 1.f);
    load8f(p.in[9] + (lane & 31) * 8, cqg, 1.f); load8f(p.in[10] + (lane & 15) * 8, ckvg, 1.f);
    for (int tile = blockIdx.x; tile < T / 64; tile += gridDim.x) {
        const int b = tile / (S / 64), s0 = (tile % (S / 64)) * 64;
#pragma unroll 4
        for (int tt = 0; tt < 8; ++tt) {
            const int sl = wave * 8 + tt, s = s0 + sl; const size_t t = (size_t)b * S + s;
            const bf16_t* hr = hb + t * 1792 + lane * 8;
            const u32x4 L0 = *(const u32x4*)hr, L1 = *(const u32x4*)(hr + 512), L2 = *(const u32x4*)(hr + 1024);
            u32x4 L3 = {0u, 0u, 0u, 0u}; if (lane < 32) L3 = *(const u32x4*)(hr + 1536);
            float x0[8], x1[8], x2[8], x3[8];
            unpack8(L0, x0); unpack8(L1, x1); unpack8(L2, x2); unpack8(L3, x3);
            float a0 = ss8f(x0), a1 = ss8f(x1), a2 = ss8f(x2), a3 = ss8f(x3);
#pragma unroll
            for (int o = 1; o < 8; o <<= 1) { a0 += __shfl_xor(a0, o); a1 += __shfl_xor(a1, o); a2 += __shfl_xor(a2, o); a3 += __shfl_xor(a3, o); }
            float a2w = a2 + __shfl_xor(a2, 8); a2w += __shfl_xor(a2w, 16);
            const float a3w = a3 + __shfl_xor(a3, 8);
            const int pp = (sl & ~15) | perm16(sl & 15);
            {
                const float r = rsqrtf(a0 * (1.f / 64.f) + EPS); float y[8];
#pragma unroll
                for (int j = 0; j < 8; ++j) y[j] = x0[j] * r * qg[j];
                *(u32x4*)(qn + t * 512 + lane * 8) = pack8(y);
            }
            {
                const int g = seg & 1; const size_t gm = (((size_t)b * 2 + g) * S + s) * 64 + c8;
                if (seg < 2) *(u32x4*)(kcin + gm) = L1;
                else if (seg < 4) *(u32x4*)(vcin + gm) = L1;
                else if (seg < 6) { const float r = rsqrtf(a1 * (1.f / 64.f) + EPS); float y[8];
#pragma unroll
                    for (int j = 0; j < 8; ++j) y[j] = x1[j] * r * ksg[j];
                    *(u32x4*)(ksn + gm) = pack8(y); }
                else {
#pragma unroll
                    for (int j = 0; j < 8; ++j) vs[((0 + g) * 64 + c8 + j) * 72 + pp] = (bf16_t)((j & 1) ? (L1[j >> 1] >> 16) : (L1[j >> 1] & 0xffffu)); }
            }
            {
                const int g = seg & 1; const size_t gm = (((size_t)b * 2 + g) * S + s) * 64 + c8;
                if (seg < 2) { const float r = rsqrtf(a2 * (1.f / 64.f) + EPS); float y[8];
#pragma unroll
                    for (int j = 0; j < 8; ++j) y[j] = x2[j] * r * kwg[j];
                    *(u32x4*)(kwn + gm) = pack8(y); }
                else if (seg < 4) {
#pragma unroll
                    for (int j = 0; j < 8; ++j) vs[((2 + g) * 64 + c8 + j) * 72 + pp] = (bf16_t)((j & 1) ? (L2[j >> 1] >> 16) : (L2[j >> 1] & 0xffffu)); }
                else { const float r = rsqrtf(a2w * (1.f / 256.f) + EPS); float y[8];
#pragma unroll
                    for (int j = 0; j < 8; ++j) y[j] = x2[j] * r * cqg[j];
                    *(u32x4*)(cqn + t * 256 + (lane - 32) * 8) = pack8(y); }
            }
            {
                if (lane < 16) { const float r = rsqrtf(a3w * (1.f / 128.f) + EPS); float y[8];
#pragma unroll
                    for (int j = 0; j < 8; ++j) y[j] = x3[j] * r * ckvg[j];
                    *(u32x4*)(ckvn + t * 128 + lane * 8) = pack8(y); }
                else if (lane < 20) *(u32x4*)(krope + t * 32 + (lane - 16) * 8) = L3;
                else if (lane < 23) { float y[8];
#pragma unroll
                    for (int j = 0; j < 8; ++j) y[j] = frcp(1.f + fexp2(-x3[j] * LOG2E));
                    float* gp = gates + t * 24 + (lane - 20) * 8; *(f32x4*)gp = (f32x4){y[0], y[1], y[2], y[3]}; *(f32x4*)(gp + 4) = (f32x4){y[4], y[5], y[6], y[7]}; }
            }
        }
        __syncthreads();
        {
            const int row = tid >> 1, half = tid & 1, which = row >> 6, d = row & 63, g = which & 1;
            bf16_t* dst = ((which < 2) ? vst : vwt) + (((size_t)b * 2 + g) * 64 + d) * S + s0 + half * 32;
            const LAS bf16_t* src = vs + row * 72 + half * 32;
#pragma unroll
            for (int c = 0; c < 4; ++c) *(u32x4*)(dst + c * 8) = *(const LAS u32x4*)(src + c * 8);
        }
        __syncthreads();
    }
}
__device__ __forceinline__ void phase_p3b(const Params& p, LAS unsigned char* lds) {
    const int tid = ltid(), lane = tid & 63, wave = tid >> 6;
    const int gw = blockIdx.x * 8 + wave, NGW = gridDim.x * 8;
    const bf16_t* qraw = (const bf16_t*)(p.ws + R_H);
    const bf16_t* kvraw = (const bf16_t*)(p.ws + R_H + (size_t)T * 2048);
    const bf16_t* krope = (const bf16_t*)(p.ws + R_XA + A_KROPE);
    const float* rope = (const float*)(p.ws + SM_ROPE);
    bf16_t* qm = (bf16_t*)((unsigned char*)p.out + O_QM); bf16_t* km = (bf16_t*)((unsigned char*)p.out + O_KM); bf16_t* vmt = (bf16_t*)((unsigned char*)p.out + O_VMT);
    const float* q_norm = p.in[13]; const float* k_norm = p.in[14];
    LAS bf16_t* vs = (LAS bf16_t*)lds;
    LAS float* w2s = (LAS float*)(lds + 73728);
    for (int kv = 0; kv < 2; ++kv) {
        __syncthreads();
        for (int i = tid; i < 256 * 64; i += 512) w2s[i] = p.in[8][kv * 16384 + i];
        __syncthreads();
        const bf16_t* hid = (const bf16_t*)(p.ws + SM_HID) + (size_t)kv * NB * 512 * 256;
        for (int row = gw; row < NB * 512; row += NGW) {
            const u32x2 hv = *(const u32x2*)(hid + (size_t)row * 256 + lane * 4);
            const float h0 = bflo(hv.x), h1 = bfhi(hv.x), h2 = bflo(hv.y), h3 = bfhi(hv.y);
            float acc = 0.f;
#pragma unroll 8
            for (int k4 = 0; k4 < 64; ++k4) {
                acc += __shfl(h0, k4) * w2s[(k4 * 4 + 0) * 64 + lane]; acc += __shfl(h1, k4) * w2s[(k4 * 4 + 1) * 64 + lane];
                acc += __shfl(h2, k4) * w2s[(k4 * 4 + 2) * 64 + lane]; acc += __shfl(h3, k4) * w2s[(k4 * 4 + 3) * 64 + lane];
            }
            if (kv == 0) { const float r = rsqrtf(wsum(acc * acc) * (1.f / 64.f) + EPS); ((bf16_t*)(p.ws + SM_KC))[(size_t)row * 64 + lane] = f2bf(acc * r * p.in[5][lane]); }
            else { const int c = row & 255; ((bf16_t*)(p.ws + SM_VCT))[((size_t)(row >> 8) * 64 + lane) * 256 + ((c & ~15) | perm16(c & 15))] = f2bf(acc); }
        }
    }
    __syncthreads();
    const float QS = 0.10206207261596577f * LOG2E;
    const int c = lane & 15, hl = lane >> 4;
    float qg[8], kg[8];
    load8f(q_norm + (c < 12 ? c * 8 : 0), qg, QS);
    load8f(k_norm + (c < 12 ? c * 8 : 0), kg, 1.f);
    for (int tile = blockIdx.x; tile < T / 64; tile += gridDim.x) {
        const int b = tile / (S / 64), s0 = (tile % (S / 64)) * 64;
#pragma unroll 4
        for (int tt = 0; tt < 8; ++tt) {
            const int sl = wave * 8 + tt, s = s0 + sl; const size_t t = (size_t)b * S + s;
            const int pp = (sl & ~15) | perm16(sl & 15);
            u32x4 Q[2], KV[2];
#pragma unroll
            for (int ld = 0; ld < 2; ++ld) { Q[ld] = *(const u32x4*)(qraw + t * 1024 + ld * 512 + lane * 8); KV[ld] = *(const u32x4*)(kvraw + t * 1024 + ld * 512 + lane * 8); }
            u32x4 KR = {0u, 0u, 0u, 0u}; f32x4 cs0 = {0.f, 0.f, 0.f, 0.f}, cs1 = cs0, sn0 = cs0, sn1 = cs0;
            if (c >= 8 && c < 12) { KR = *(const u32x4*)(krope + t * 32 + (c - 8) * 8);
                const float* rp = rope + s * 32 + (c & 1) * 8; cs0 = *(const f32x4*)rp; cs1 = *(const f32x4*)(rp + 4); sn0 = *(const f32x4*)(rp + 16); sn1 = *(const f32x4*)(rp + 20); }
            const float cs[8] = {cs0.x, cs0.y, cs0.z, cs0.w, cs1.x, cs1.y, cs1.z, cs1.w}, sn[8] = {sn0.x, sn0.y, sn0.z, sn0.w, sn1.x, sn1.y, sn1.z, sn1.w};
            float kr[8]; unpack8(KR, kr);
            const float krs = ss8f(kr);
#pragma unroll
            for (int ld = 0; ld < 2; ++ld) {
                const int hh = ld * 4 + hl;
                {
                    float x[8]; unpack8(Q[ld], x);
                    float ss = c < 12 ? ss8f(x) : 0.f;
#pragma unroll
                    for (int o = 1; o < 16; o <<= 1) ss += __shfl_xor(ss, o);
                    const float r = rsqrtf(ss * (1.f / 96.f) + EPS); float y[8], z[8];
#pragma unroll
                    for (int j = 0; j < 8; ++j) y[j] = x[j] * r * qg[j];
#pragma unroll
                    for (int j = 0; j < 8; ++j) { const float pb = __shfl_xor(y[j], 2); z[j] = (c < 8) ? y[j] : ((c < 10) ? (y[j] * cs[j] - pb * sn[j]) : (pb * sn[j] + y[j] * cs[j])); }
                    if (c < 12) *(u32x4*)(qm + (t * 8 + hh) * 96 + c * 8) = pack8(z);
                }
                {
                    float x[8]; unpack8(KV[ld], x);
                    float ss = c < 8 ? ss8f(x) : krs;
#pragma unroll
                    for (int o = 1; o < 16; o <<= 1) ss += __shfl_xor(ss, o);
                    const float r = rsqrtf(ss * (1.f / 96.f) + EPS); float y[8], z[8];
#pragma unroll
                    for (int j = 0; j < 8; ++j) y[j] = (c < 8 ? x[j] : kr[j]) * r * kg[j];
#pragma unroll
                    for (int j = 0; j < 8; ++j) { const float pb = __shfl_xor(y[j], 2); z[j] = (c < 8) ? y[j] : ((c < 10) ? (y[j] * cs[j] - pb * sn[j]) : (pb * sn[j] + y[j] * cs[j])); }
                    if (c < 12) *(u32x4*)(km + (((size_t)b * 8 + hh) * S + s) * 96 + c * 8) = pack8(z);
                    if (c >= 8) {
#pragma unroll
                        for (int j = 0; j < 8; ++j) vs[(hh * 64 + (c - 8) * 8 + j) * 72 + pp] = (bf16_t)((j & 1) ? (KV[ld][j >> 1] >> 16) : (KV[ld][j >> 1] & 0xffffu)); }
                }
            }
        }
        __syncthreads();
        {
            const int hh = tid >> 6, d = tid & 63;
            bf16_t* dst = vmt + (((size_t)b * 8 + hh) * 64 + d) * S + s0;
            const LAS bf16_t* src = vs + tid * 72;
#pragma unroll
            for (int cc = 0; cc < 8; ++cc) *(u32x4*)(dst + cc * 8) = *(const LAS u32x4*)(src + cc * 8);
        }
        __syncthreads();
    }
}

__device__ const unsigned short UNIT_TYPES[256] = {63,127,62,126,61,125,527,591,655,719,783,847,911,975,60,124,59,123,58,122,57,121,56,120,526,590,654,718,782,846,910,974,55,119,54,118,53,117,52,116,51,115,525,589,653,717,781,845,909,973,50,114,49,113,48,112,47,111,524,588,652,716,780,844,908,972,46,110,45,109,44,108,43,107,523,587,651,715,779,843,907,971,42,106,41,105,40,104,39,103,38,102,522,586,650,714,778,842,906,970,37,101,36,100,35,99,34,98,33,97,521,585,649,713,777,841,905,969,32,96,31,95,30,94,520,584,648,712,776,840,904,968,29,93,28,92,27,91,26,90,25,89,519,583,647,711,775,839,903,967,24,88,23,87,22,86,21,85,20,84,518,582,646,710,774,838,902,966,19,83,18,82,17,81,16,80,15,79,517,581,645,709,773,837,901,965,14,78,13,77,12,76,516,580,644,708,772,836,900,964,11,75,10,74,9,73,8,72,515,579,643,707,771,835,899,963,7,71,6,70,5,69,514,578,642,706,770,834,898,962,4,68,3,67,513,577,641,705,769,833,897,961,2,66,1,65,0,64,512,576,640,704,768,832,896,960};
__device__ __forceinline__ int crow(int r, int hi) { return (r & 3) + 8 * (r >> 2) + 4 * hi; }
struct Flash { f32x16 o0, o1; float l; };
__device__ __forceinline__ void flash_init(Flash& st) {
#pragma unroll
    for (int r = 0; r < 16; ++r) { st.o0[r] = 0.f; st.o1[r] = 0.f; }
    st.l = 0.f;
}
constexpr int AL_KB = 0, AL_KBSZ = 64 * 208, AL_VB = 2 * AL_KBSZ, AL_VBSZ = 64 * 144, AL_IMP = AL_VB + 2 * AL_VBSZ, AL_SELB = AL_IMP + 64 * 65 * 4, AL_UNI = AL_SELB + 512, AL_TL = AL_UNI + 64, AL_BL = AL_TL + 128,
              AL_OT = AL_BL + 4 * 132 * 4, AL_END = AL_OT + 8 * 32 * 64 * 4;
static_assert(AL_END <= 131072, "attention LDS");

template <int DK, int KP> __device__ __forceinline__ void qk_tile(f32x16& p0, f32x16& p1, const LAS unsigned char* Kt, const bf16x8* qf, const f32x16& negm, int r32, int hi) {
#pragma unroll
    for (int s = 0; s < DK / 16; ++s) {
        const bf16x8 a0 = *(const LAS bf16x8*)(Kt + r32 * KP + (16 * s + 8 * hi) * 2);
        const bf16x8 a1 = *(const LAS bf16x8*)(Kt + (32 + r32) * KP + (16 * s + 8 * hi) * 2);
        if (s == 0) { p0 = __builtin_amdgcn_mfma_f32_32x32x16_bf16(a0, qf[0], negm, 0, 0, 0); p1 = __builtin_amdgcn_mfma_f32_32x32x16_bf16(a1, qf[0], negm, 0, 0, 0); }
        else { p0 = __builtin_amdgcn_mfma_f32_32x32x16_bf16(a0, qf[s], p0, 0, 0, 0); p1 = __builtin_amdgcn_mfma_f32_32x32x16_bf16(a1, qf[s], p1, 0, 0, 0); }
    }
}
template <bool LANEMASK, class F> __device__ __forceinline__ void softmax_pv(Flash& st, f32x16& p0, f32x16& p1, const LAS unsigned char* Vt, int r32, int hi, bool mine, F f) {
    float ls = 0.f;
#pragma unroll
    for (int r = 0; r < 16; ++r) {
        float x0 = p0[r], x1 = p1[r]; const bool v0 = f(r, 0, x0), v1 = f(r, 1, x1);
        const float e0 = fexp2(x0), e1 = fexp2(x1);
        p0[r] = v0 ? e0 : 0.f; p1[r] = v1 ? e1 : 0.f; ls += p0[r] + p1[r];
    }
    if (LANEMASK) ls = mine ? ls : 0.f;
    st.l += ls;
#pragma unroll
    for (int s = 0; s < 4; ++s) {
        u32x4 w;
        if (s < 2) { w.x = cvtpk(p0[8 * s + 0], p0[8 * s + 1]); w.y = cvtpk(p0[8 * s + 2], p0[8 * s + 3]); w.z = cvtpk(p0[8 * s + 4], p0[8 * s + 5]); w.w = cvtpk(p0[8 * s + 6], p0[8 * s + 7]); }
        else { const int q = s - 2; w.x = cvtpk(p1[8 * q + 0], p1[8 * q + 1]); w.y = cvtpk(p1[8 * q + 2], p1[8 * q + 3]); w.z = cvtpk(p1[8 * q + 4], p1[8 * q + 5]); w.w = cvtpk(p1[8 * q + 6], p1[8 * q + 7]); }
        if (LANEMASK) { w.x = mine ? w.x : 0u; w.y = mine ? w.y : 0u; w.z = mine ? w.z : 0u; w.w = mine ? w.w : 0u; }
        const bf16x8 pa = __builtin_bit_cast(bf16x8, w);
        const bf16x8 vb0 = *(const LAS bf16x8*)(Vt + r32 * 144 + (16 * s + 8 * hi) * 2);
        const bf16x8 vb1 = *(const LAS bf16x8*)(Vt + (32 + r32) * 144 + (16 * s + 8 * hi) * 2);
        st.o0 = __builtin_amdgcn_mfma_f32_32x32x16_bf16(pa, vb0, st.o0, 0, 0, 0);
        st.o1 = __builtin_amdgcn_mfma_f32_32x32x16_bf16(pa, vb1, st.o1, 0, 0, 0);
    }
}
template <bool FIRST> __device__ __forceinline__ void flash_accum(LAS float* otl, const Flash& st, float gate, int hi, int lane) {
    const float lt = st.l + __shfl_xor(st.l, 32);
    const float f = lt > 0.f ? gate * frcp(lt) : 0.f;
#pragma unroll
    for (int r = 0; r < 16; ++r) { const float fr_ = __shfl(f, crow(r, hi));
        if (FIRST) { otl[r * 64 + lane] = fr_ * st.o0[r]; otl[(16 + r) * 64 + lane] = fr_ * st.o1[r]; }
        else { otl[r * 64 + lane] += fr_ * st.o0[r]; otl[(16 + r) * 64 + lane] += fr_ * st.o1[r]; } }
}
template <int NS> __device__ __forceinline__ float qnorm2(const bf16x8* qf) {
    float s = 0.f;
#pragma unroll
    for (int i = 0; i < NS; ++i)
#pragma unroll
        for (int j = 0; j < 8; ++j) { const float x = bf2f((bf16_t)qf[i][j]); s += x * x; }
    return s + __shfl_xor(s, 32);
}
__device__ __forceinline__ float wmax(float v) {
#pragma unroll
    for (int o = 1; o < 64; o <<= 1) v = fmaxf(v, __shfl_xor(v, o));
    return v;
}

template <int RB> struct TileRegs { u32x4 a, b; };
template <int RB> __device__ __forceinline__ void tile_load(TileRegs<RB>& R, const unsigned char* g, size_t gs, int tid) {
    constexpr int CPR = RB / 16;
    asm volatile("" : "+v"(tid));
    { const int row = tid / CPR, c = tid % CPR; R.a = *(const u32x4*)(g + (size_t)row * gs + c * 16); }
    if (RB == 192) { const int id = (tid < 256) ? tid + 512 : tid; const int row = id / CPR, c = id % CPR; R.b = *(const u32x4*)(g + (size_t)row * gs + c * 16); }
}
template <int RB, int P> __device__ __forceinline__ void tile_store(const TileRegs<RB>& R, LAS unsigned char* l, int tid) {
    constexpr int CPR = RB / 16;
    asm volatile("" : "+v"(tid));
    { const int row = tid / CPR, c = tid % CPR; *(LAS u32x4*)(l + row * P + c * 16) = R.a; }
    if (RB == 192) { const int id = tid + 512; if (id < 768) { const int row = id / CPR, c = id % CPR; *(LAS u32x4*)(l + row * P + c * 16) = R.b; } }
}
template <int RBK, int PK, bool HASV, class SrcK, class SrcV, class Comp>
__device__ __forceinline__ void run_tiles(int n, LAS unsigned char* lds, int tid, size_t gsK, size_t gsV, SrcK srcK, SrcV srcV, Comp comp) {
    TileRegs<RBK> k0, k1, k2; TileRegs<128> v0, v1, v2;
    const int nl = n - 1;
    { tile_load<RBK>(k0, srcK(0), gsK, tid); if (HASV) tile_load<128>(v0, srcV(0), gsV, tid); }
    { const int t1 = nl < 1 ? nl : 1; tile_load<RBK>(k1, srcK(t1), gsK, tid); if (HASV) tile_load<128>(v1, srcV(t1), gsV, tid); }
    { const int t2 = nl < 2 ? nl : 2; tile_load<RBK>(k2, srcK(t2), gsK, tid); if (HASV) tile_load<128>(v2, srcV(t2), gsV, tid); }
#define RT_STEP(KR, VR, ii) do { const int i_ = (ii); \
        LAS unsigned char* kb = lds + AL_KB + (i_ & 1) * AL_KBSZ; LAS unsigned char* vb = lds + AL_VB + (i_ & 1) * AL_VBSZ; \
        tile_store<RBK, PK>(KR, kb, tid); if (HASV) tile_store<128, 144>(VR, vb, tid); \
        __syncthreads(); \
        { const int tn = (i_ + 3 < nl) ? i_ + 3 : nl; tile_load<RBK>(KR, srcK(tn), gsK, tid); if (HASV) tile_load<128>(VR, srcV(tn), gsV, tid); } \
        if (i_ < n) comp(i_, kb, vb); } while (0)
    for (int i = 0; i < n; i += 3) { RT_STEP(k0, v0, i); RT_STEP(k1, v1, i + 1); RT_STEP(k2, v2, i + 2); }
#undef RT_STEP
    __syncthreads();
}

__device__ __forceinline__ void mla_unit(const Params& p, LAS unsigned char* lds, int b, int h, int qb) {
    int tid = threadIdx.x; asm volatile("" : "+v"(tid));
    const int lane = tid & 63, w = __builtin_amdgcn_readfirstlane(tid >> 6), r32 = lane & 31, hi = lane >> 5;
    const bf16_t* qm = (const bf16_t*)((const unsigned char*)p.out + O_QM);
    const unsigned char* km = (const unsigned char*)p.out + O_KM + (((size_t)b * 8 + h) * S) * 192;
    const unsigned char* vmt = (const unsigned char*)p.out + O_VMT + (((size_t)b * 8 + h) * 64) * (size_t)S * 2;
    bf16_t* ocat = (bf16_t*)(p.ws + R_XN);
    const int tq = qb * 256 + 32 * w + r32;
    bf16x8 qf[6];
#pragma unroll
    for (int s = 0; s < 6; ++s) qf[s] = *(const bf16x8*)(qm + (((size_t)b * S + tq) * 8 + h) * 96 + 16 * s + 8 * hi);
    const float kn = 9.797958971f * 1.01f * wmax(fmaxf(fabsf(p.in[14][lane]), lane < 32 ? fabsf(p.in[14][64 + lane]) : 0.f));
    const float mref = sqrtf(qnorm2<6>(qf)) * kn;
    f32x16 negm;
#pragma unroll
    for (int r = 0; r < 16; ++r) negm[r] = -mref;
    Flash st; flash_init(st);
    const int ntile = 4 * qb + 4, dt = 4 * qb + (w >> 1);
    run_tiles<192, 208, true>(ntile, lds, tid, 192, (size_t)S * 2,
        [&](int i) { return km + (size_t)i * 64 * 192; }, [&](int i) { return vmt + (size_t)i * 128; },
        [&](int i, LAS unsigned char* kb, LAS unsigned char* vb) {
            if (i <= dt) {
                f32x16 p0, p1; qk_tile<96, 208>(p0, p1, kb, qf, negm, r32, hi);
                if (i < dt) softmax_pv<false>(st, p0, p1, vb, r32, hi, true, [&](int r, int half, float& x) { return true; });
                else { const int kb0 = 64 * i + 4 * hi; softmax_pv<false>(st, p0, p1, vb, r32, hi, true, [&](int r, int half, float& x) { return (kb0 + 32 * half + (r & 3) + 8 * (r >> 2)) <= tq; }); }
            }
        });
    {
        const float lt = st.l + __shfl_xor(st.l, 32); const float f = lt > 0.f ? frcp(lt) : 0.f;
#pragma unroll
        for (int r = 0; r < 16; ++r) { const float fr_ = __shfl(f, crow(r, hi)); const size_t ro = ((size_t)b * S + qb * 256 + 32 * w + crow(r, hi)) * 1024 + 512 + h * 64 + r32; ocat[ro] = f2bf(st.o0[r] * fr_); ocat[ro + 32] = f2bf(st.o1[r] * fr_); }
    }
}

__device__ __forceinline__ void nsa_unit(const Params& p, LAS unsigned char* lds, int b, int g, int jt) {
    int tid = threadIdx.x; asm volatile("" : "+v"(tid));
    const int lane = tid & 63, w = __builtin_amdgcn_readfirstlane(tid >> 6), r32 = lane & 31, hi = lane >> 5;
    const int rh = w >> 1, qh = w & 1, h = 4 * g + rh, q0 = 64 * jt, ql = 32 * qh + r32, tq = q0 + ql;
    const unsigned char* xa = p.ws + R_XA;
    const bf16_t* qn = (const bf16_t*)(xa + A_QN);
    const size_t bg = (size_t)b * 2 + g;
    const unsigned char* ksn = xa + A_KSN + bg * S * 128; const unsigned char* kwn = xa + A_KWN + bg * S * 128;
    const unsigned char* vst = xa + A_VST + bg * 64 * (size_t)S * 2; const unsigned char* vwt = xa + A_VWT + bg * 64 * (size_t)S * 2;
    const unsigned char* kc = p.ws + SM_KC + bg * 256 * 128; const unsigned char* vct = p.ws + SM_VCT + bg * 64 * 512;
    const float* gates = (const float*)(xa + A_GATES) + ((size_t)b * S + tq) * 24 + h * 3;
    bf16_t* ocat = (bf16_t*)(p.ws + R_XN);
    LAS float* imp = (LAS float*)(lds + AL_IMP); LAS unsigned char* selb = lds + AL_SELB; LAS unsigned* uni = (LAS unsigned*)(lds + AL_UNI); LAS unsigned char* tl = lds + AL_TL; LAS float* bls = (LAS float*)(lds + AL_BL);
    const float* blg = (const float*)(p.ws + SM_BL) + h * 132;
    const float cb = blg[128];
    const float bmax = wmax(fmaxf(fmaxf(blg[lane], blg[64 + lane]), cb));
    if (qh == 0) { bls[rh * 132 + lane] = blg[lane] - cb; bls[rh * 132 + 64 + lane] = blg[64 + lane] - cb; if (lane == 0) bls[rh * 132 + 128] = 0.f; }
    const LAS float* blh = bls + rh * 132;
    bf16x8 qf[4];
#pragma unroll
    for (int s = 0; s < 4; ++s) qf[s] = *(const bf16x8*)(qn + (((size_t)b * S + tq) * 8 + h) * 64 + 16 * s + 8 * hi);
    const float kn = 8.f * 1.01f * wmax(fmaxf(fmaxf(fabsf(p.in[5][lane]), fabsf(p.in[5][64 + lane])), fabsf(p.in[5][128 + lane])));
    const float mref = sqrtf(qnorm2<4>(qf)) * kn + bmax;
    f32x16 negm;
#pragma unroll
    for (int r = 0; r < 16; ++r) negm[r] = cb - mref;
    float g0 = gates[0], g1 = gates[1], g2 = gates[2];
    if (p.dbg_branch >= 0) { g0 = p.dbg_branch == 0 ? 1.f : 0.f; g1 = p.dbg_branch == 1 ? 1.f : 0.f; g2 = p.dbg_branch == 2 ? 1.f : 0.f; }
    LAS float* otl = (LAS float*)(lds + AL_OT) + w * 2048;
    const int nvmax = (q0 + 63 - 31) / 16 + 1, ntc = (nvmax + 63) / 64;
    Flash st; flash_init(st);
    run_tiles<128, 144, true>(ntc, lds, tid, 128, 512,
        [&](int i) { return kc + (size_t)i * 64 * 128; }, [&](int i) { return vct + (size_t)i * 128; },
        [&](int i, LAS unsigned char* kb, LAS unsigned char* vb) {
            f32x16 p0, p1; qk_tile<64, 144>(p0, p1, kb, qf, negm, r32, hi);
            const int cb0 = 64 * i + 4 * hi;
            softmax_pv<false>(st, p0, p1, vb, r32, hi, true, [&](int r, int half, float& x) {
                const int c = cb0 + 32 * half + (r & 3) + 8 * (r >> 2); const int dist = tq - 16 * c - 31; x += blh[dist < 0 ? 0 : (dist > 128 ? 128 : dist)]; return dist >= 0; });
        });
    flash_accum<true>(otl, st, g0, hi, lane);
    unsigned mlo, mhi;
    int nsel;
    if (jt < 16) { const unsigned long long mk = (1ull << (jt + 1)) - 1ull; mlo = (unsigned)mk; mhi = (unsigned)(mk >> 32); nsel = jt + 1; if (tid <= jt) tl[tid] = (unsigned char)tid; }
    else {
        for (int i = tid; i < 64 * 65; i += 512) imp[i] = 0.f;
        const float lt = st.l + __shfl_xor(st.l, 32); const float linv = lt > 0.f ? frcp(lt) : 0.f;
        float xlast = 0.f;
        run_tiles<128, 144, false>(ntc, lds, tid, 128, 0,
            [&](int i) { return kc + (size_t)i * 64 * 128; }, [&](int i) { return kc; },
            [&](int i, LAS unsigned char* kb, LAS unsigned char* vb) {
                f32x16 p0, p1; qk_tile<64, 144>(p0, p1, kb, qf, negm, r32, hi);
                const int cb0 = 64 * i + 4 * hi;
                float sm[2][4], cr[2][4];
#pragma unroll
                for (int half = 0; half < 2; ++half)
#pragma unroll
                    for (int a = 0; a < 4; ++a) {
                        float s4 = 0.f, last = 0.f;
#pragma unroll
                        for (int k = 0; k < 4; ++k) {
                            const int r = 4 * a + k; const int c = cb0 + 32 * half + k + 8 * a; const int dist = tq - 16 * c - 31;
                            const float sc = (half ? p1[r] : p0[r]) + blh[dist < 0 ? 0 : (dist > 128 ? 128 : dist)];
                            const float pv = dist >= 0 ? fexp2(sc) * linv : 0.f;
                            s4 += pv; last = pv;
                        }
                        sm[half][a] = s4; cr[half][a] = last;
                    }
                float tot[2][4];
#pragma unroll
                for (int half = 0; half < 2; ++half)
#pragma unroll
                    for (int a = 0; a < 4; ++a) {
                        const float xs_ = __shfl_xor(cr[half][a], 32);
                        const float xp_ = (a > 0) ? __shfl_xor(cr[half][a > 0 ? a - 1 : 0], 32) : (half ? __shfl_xor(cr[0][3], 32) : xlast);
                        tot[half][a] = sm[half][a] + (hi ? xs_ : xp_);
                    }
                xlast = __shfl_xor(cr[1][3], 32);
                for (int rr = 0; rr < 4; ++rr) {
                    if (rh == rr) {
#pragma unroll
                        for (int half = 0; half < 2; ++half)
#pragma unroll
                            for (int a = 0; a < 4; ++a) { const int j = 16 * i + 8 * half + 2 * a + hi; imp[ql * 65 + j] += tot[half][a]; }
                    }
                    __syncthreads();
                }
            });
        if (p.dbg_branch == 1) { for (int i = tid; i < 4096; i += 512) ((float*)(p.ws + R_H))[((size_t)g * S + q0 + (i >> 6)) * 64 + (i & 63)] = imp[(i >> 6) * 65 + (i & 63)]; }
        {
            const int q = tid >> 3, jg = tid & 7;
            unsigned byte = 0;
#pragma unroll 1
            for (int jj = 0; jj < 8; ++jj) {
                const int j = jg * 8 + jj;
                if (j <= jt) {
                    const float x = imp[q * 65 + j]; const float vj = (j == jt || j == 0) ? 1e9f : x;
                    int rank = 0;
#pragma unroll 8
                    for (int i = 0; i < 64; ++i) { const float xi = imp[q * 65 + i]; const float vi = (i > jt) ? -1.f : ((i == jt || i == 0) ? 1e9f : xi); rank += (vi > vj || (vi == vj && i < j)) ? 1 : 0; }
                    if (rank < 16) byte |= 1u << jj;
                }
            }
            selb[q * 8 + jg] = (unsigned char)byte;
        }
        __syncthreads();
        if (w == 0) {
            unsigned a = ((const LAS unsigned*)selb)[lane * 2], c = ((const LAS unsigned*)selb)[lane * 2 + 1];
#pragma unroll
            for (int o = 1; o < 64; o <<= 1) { a |= __shfl_xor(a, o); c |= __shfl_xor(c, o); }
            const unsigned long long um = ((unsigned long long)c << 32) | a;
            if ((um >> lane) & 1ull) tl[__builtin_popcountll(um & ((1ull << lane) - 1ull))] = (unsigned char)lane;
            if (lane == 0) uni[0] = (unsigned)__builtin_popcountll(um);
        }
        __syncthreads();
        mlo = ((const LAS unsigned*)selb)[ql * 2]; mhi = ((const LAS unsigned*)selb)[ql * 2 + 1];
        nsel = (int)uni[0];
    }
    if (p.dbg_branch == 1 && rh == 0) { if (hi == 0) ((unsigned long long*)(p.ws + R_H + 4 * 1048576))[(size_t)g * S + tq] = ((unsigned long long)mhi << 32) | mlo; }
    __syncthreads();
    {
        const unsigned long long mymask = ((unsigned long long)mhi << 32) | mlo;
        nsel = __builtin_amdgcn_readfirstlane(nsel);
        flash_init(st);
        run_tiles<128, 144, true>(nsel, lds, tid, 128, (size_t)S * 2,
            [&](int i) { return ksn + (size_t)tl[i] * 64 * 128; }, [&](int i) { return vst + (size_t)tl[i] * 128; },
            [&](int i, LAS unsigned char* kb, LAS unsigned char* vb) {
                const int j = __builtin_amdgcn_readfirstlane((int)tl[i]);
                f32x16 p0, p1; qk_tile<64, 144>(p0, p1, kb, qf, negm, r32, hi);
                const bool mine = (mymask >> j) & 1ull;
                if (q0 + 32 * qh - (64 * j + 63) >= 128) softmax_pv<true>(st, p0, p1, vb, r32, hi, mine, [&](int r, int half, float& x) { return true; });
                else { const int kb0 = 64 * j + 4 * hi;
                    softmax_pv<true>(st, p0, p1, vb, r32, hi, mine, [&](int r, int half, float& x) { const int dist = tq - (kb0 + 32 * half + (r & 3) + 8 * (r >> 2)); x += blh[dist < 0 ? 0 : (dist > 128 ? 128 : dist)]; return dist >= 0; }); }
            });
        flash_accum<false>(otl, st, g1, hi, lane);
    }
    {
        const int j0 = jt >= 8 ? jt - 8 : 0, nw = jt - j0 + 1;
        flash_init(st);
        run_tiles<128, 144, true>(nw, lds, tid, 128, (size_t)S * 2,
            [&](int i) { return kwn + (size_t)(j0 + i) * 64 * 128; }, [&](int i) { return vwt + (size_t)(j0 + i) * 128; },
            [&](int i, LAS unsigned char* kb, LAS unsigned char* vb) {
                f32x16 p0, p1; qk_tile<64, 144>(p0, p1, kb, qf, negm, r32, hi);
                const int kb0 = 64 * (j0 + i) + 4 * hi;
                softmax_pv<false>(st, p0, p1, vb, r32, hi, true, [&](int r, int half, float& x) { const int dist = tq - (kb0 + 32 * half + (r & 3) + 8 * (r >> 2)); x += blh[dist < 0 ? 0 : (dist > 128 ? 128 : dist)]; return dist >= 0 && dist < 512; });
            });
        flash_accum<false>(otl, st, g2, hi, lane);
    }
#pragma unroll
    for (int r = 0; r < 16; ++r) { const size_t ro = ((size_t)b * S + q0 + 32 * qh + crow(r, hi)) * 1024 + h * 64 + r32; ocat[ro] = f2bf(otl[r * 64 + lane]); ocat[ro + 32] = f2bf(otl[(16 + r) * 64 + lane]); }
    __syncthreads();
}

__device__ __forceinline__ void phase_p4(const Params& p, LAS unsigned char* lds) {
    const int G = gridDim.x, c = blockIdx.x, nunits = 256 * NB;
#if NB == 8
    if (G == 256) {
        const int b = c & 7, idx = c >> 3, pi = idx & 7, hq = idx >> 3;
#pragma unroll 1
        for (int u = 0; u < 8; ++u) {
            if (u < 4) nsa_unit(p, lds, b, u >> 1, (u & 1) ? idx : 63 - idx);
            else mla_unit(p, lds, b, ((u - 4) >> 1) * 4 + hq, (u & 1) ? pi : 15 - pi);
        }
        return;
    }
#endif
    for (int j = 0;; ++j) {
        const int k = j * G + ((j & 1) ? (G - 1 - c) : c);
        if (j * G >= nunits) break;
        if (k >= nunits) continue;
        const int ty = UNIT_TYPES[k / NB], b = k % NB, kind = ty >> 9, a = (ty >> 6) & 7, cc = ty & 63;
        if (kind == 0) nsa_unit(p, lds, b, a, cc); else mla_unit(p, lds, b, a, cc);
    }
}
__device__ __forceinline__ void phase_norm(const float* x, const float* g, bf16_t* xn) {
    const int tid_ = ltid(); const int lane = tid_ & 63, gw = blockIdx.x * 8 + (tid_ >> 6), NGW = gridDim.x * 8;
    for (int m = gw; m < T; m += NGW) rms_row_to_bf16(x + (size_t)m * D, g, xn + (size_t)m * D, lane);
}
__device__ __forceinline__ void phase_conv(const Params& p) {
    const int tid = ltid(), lane = tid & 63, gw = blockIdx.x * 8 + (tid >> 6), NGW = gridDim.x * 8;
    const bf16_t* hh = (const bf16_t*)(p.ws + R_H); bf16_t* v = (bf16_t*)(p.ws + R_XN); const float* cw = p.in[22];
    constexpr int RUN = 16;
    float w0[2][8], w1[2][8], w2[2][8];
#pragma unroll
    for (int j = 0; j < 2; ++j) { const int d = 8 * lane + 512 * j; load8f(cw + d, w0[j], 1.f); load8f(cw + 1024 + d, w1[j], 1.f); load8f(cw + 2048 + d, w2[j], 1.f); }
    for (int run = gw; run < T / RUN; run += NGW) {
        const int m0 = run * RUN, s0 = m0 & (S - 1);
        float pm2[2][8], pm1[2][8];
#pragma unroll
        for (int j = 0; j < 2; ++j) { const int d = 8 * lane + 512 * j;
#pragma unroll
            for (int q = 0; q < 2; ++q) {
                float (&dst)[8] = q ? pm1[j] : pm2[j];
                if (s0 - 2 + q >= 0) { const bf16_t* r = hh + (size_t)(m0 - 2 + q) * 3072; float c[8], u[8]; unpack8(*(const u32x4*)(r + 1024 + d), c); unpack8(*(const u32x4*)(r + 2048 + d), u);
#pragma unroll
                    for (int i = 0; i < 8; ++i) dst[i] = c[i] * u[i]; }
                else {
#pragma unroll
                    for (int i = 0; i < 8; ++i) dst[i] = 0.f; }
            } }
#pragma unroll 4
        for (int rr = 0; rr < RUN; ++rr) {
            const int m = m0 + rr; const bf16_t* r = hh + (size_t)m * 3072;
#pragma unroll
            for (int j = 0; j < 2; ++j) { const int d = 8 * lane + 512 * j;
                float b[8], c[8], u[8], y[8]; unpack8(*(const u32x4*)(r + d), b); unpack8(*(const u32x4*)(r + 1024 + d), c); unpack8(*(const u32x4*)(r + 2048 + d), u);
#pragma unroll
                for (int i = 0; i < 8; ++i) { const float cu = c[i] * u[i]; y[i] = b[i] * (w0[j][i] * pm2[j][i] + w1[j][i] * pm1[j][i] + w2[j][i] * cu); pm2[j][i] = pm1[j][i]; pm1[j][i] = cu; }
                *(u32x4*)(v + (size_t)m * 1024 + d) = pack8(y); }
        }
    }
}
__device__ __forceinline__ void phase_norm_router(const Params& p, LAS unsigned char* lds) {
    const int tid = ltid(), lane = tid & 63, wave = tid >> 6, gw = blockIdx.x * 8 + wave, NGW = gridDim.x * 8;
    const float* x3 = p.out; const float* g = p.in[24]; bf16_t* xn = (bf16_t*)(p.ws + R_XN);
    LAS float* wr = (LAS float*)lds;
    LAS int* lcnt = (LAS int*)(lds + 32768); LAS int* gb = lcnt + 8;
    int* te = (int*)(p.ws + SM_TE); float* tw = (float*)(p.ws + SM_TW); int* rank = (int*)(p.ws + SM_RANK); int* cnt = (int*)(p.ws + SM_CTL);
    for (int i = tid; i < 8192; i += 512) wr[i] = p.in[25][i];
    if (tid < 8) lcnt[tid] = 0;
    __syncthreads();
    for (int m = gw; m < T; m += NGW) {
        const f32x4* xr = (const f32x4*)(x3 + (size_t)m * D) + lane; const f32x4* gr = (const f32x4*)g + lane;
        f32x4 v[4]; float s = 0.f;
#pragma unroll
        for (int j = 0; j < 4; ++j) { v[j] = xr[64 * j]; s += (v[j].x * v[j].x + v[j].y * v[j].y) + (v[j].z * v[j].z + v[j].w * v[j].w); }
        const float r = rsqrtf(wsum(s) * (1.f / 1024.f) + EPS);
        float lg[8];
#pragma unroll
        for (int e = 0; e < 8; ++e) lg[e] = 0.f;
        u32x2* o8 = (u32x2*)(xn + (size_t)m * D) + lane;
#pragma unroll
        for (int j = 0; j < 4; ++j) { const f32x4 gg = gr[64 * j]; const f32x4 y = {v[j].x * r * gg.x, v[j].y * r * gg.y, v[j].z * r * gg.z, v[j].w * r * gg.w};
            u32x2 w; w.x = cvtpk(y.x, y.y); w.y = cvtpk(y.z, y.w); o8[64 * j] = w;
#pragma unroll
            for (int i = 0; i < 4; ++i) { const int d = 4 * lane + 256 * j + i; const f32x4 w0 = *(const LAS f32x4*)(wr + d * 8), w1 = *(const LAS f32x4*)(wr + d * 8 + 4);
                lg[0] += y[i] * w0.x; lg[1] += y[i] * w0.y; lg[2] += y[i] * w0.z; lg[3] += y[i] * w0.w; lg[4] += y[i] * w1.x; lg[5] += y[i] * w1.y; lg[6] += y[i] * w1.z; lg[7] += y[i] * w1.w; } }
#pragma unroll
        for (int e = 0; e < 8; ++e) lg[e] = wsum(lg[e]) + p.in[26][e];
        int e1 = 0; float l1 = lg[0];
#pragma unroll
        for (int e = 1; e < 8; ++e) if (lg[e] > l1) { l1 = lg[e]; e1 = e; }
        int e2 = -1; float l2 = -3e38f;
#pragma unroll
        for (int e = 0; e < 8; ++e) if (e != e1 && lg[e] > l2) { l2 = lg[e]; e2 = e; }
        if (lane == 0) {
            const float w1 = 1.f / (1.f + __expf(l2 - l1));
            te[m * 2] = e1; te[m * 2 + 1] = e2; tw[m * 2] = w1; tw[m * 2 + 1] = 1.f - w1;
            rank[m * 2] = __hip_atomic_fetch_add(&lcnt[e1], 1, __ATOMIC_RELAXED, __HIP_MEMORY_SCOPE_WORKGROUP); rank[m * 2 + 1] = __hip_atomic_fetch_add(&lcnt[e2], 1, __ATOMIC_RELAXED, __HIP_MEMORY_SCOPE_WORKGROUP);
        }
    }
    __syncthreads();
    if (tid < 8) gb[tid] = atomicAdd(&cnt[tid], lcnt[tid]);
    __syncthreads();
    for (int m = gw; m < T; m += NGW) if (lane < 2) rank[m * 2 + lane] += gb[te[m * 2 + lane]];
}
__device__ __forceinline__ void phase_moe_gather(const Params& p) {
    const int tid = ltid(), lane = tid & 63, gw = blockIdx.x * 8 + (tid >> 6), NGW = gridDim.x * 8;
    const int* cnt = (const int*)(p.ws + SM_CTL); const int* te = (const int*)(p.ws + SM_TE); const float* tw = (const float*)(p.ws + SM_TW); const int* rank = (const int*)(p.ws + SM_RANK);
    int* pos = (int*)(p.ws + SM_POS); float* roww = (float*)(p.ws + SM_ROWW); int* tile_e = (int*)(p.ws + SM_TILEE);
    int* rowtok = (int*)(p.ws + SM_ROWTOK);
    int off[9]; off[0] = 0;
#pragma unroll
    for (int e = 0; e < 8; ++e) off[e + 1] = off[e] + ((cnt[e] + 255) & ~255);
    if (blockIdx.x == 0) {
        for (int i = tid; i < ROWS_MAX / 256; i += 512) { int e = -1;
#pragma unroll
            for (int k = 0; k < 8; ++k) if (i * 256 >= off[k] && i * 256 < off[k + 1]) e = k;
            tile_e[i] = e < 0 ? 0 : e; }
        if (tid == 0) ((int*)(p.ws + SM_CTL))[8] = off[8];
    }
    if (blockIdx.x < 8 && tid < 256) {
#pragma unroll
        for (int e = 0; e < 8; ++e) if (e == (int)blockIdx.x) { const int c = cnt[e]; if (c + tid < off[e + 1] - off[e]) { roww[off[e] + c + tid] = 0.f; rowtok[off[e] + c + tid] = -1; } }
    }
    for (int pi0 = gw * 4; pi0 < 2 * T; pi0 += NGW * 4) {
        int r[4]; float w[4];
#pragma unroll
        for (int q = 0; q < 4; ++q) { const int e = te[pi0 + q]; int o = 0;
#pragma unroll
            for (int k = 0; k < 8; ++k) if (k == e) o = off[k];
            r[q] = o + rank[pi0 + q]; w[q] = tw[pi0 + q]; }
#pragma unroll
        for (int q = 0; q < 4; ++q) if (lane == q) { pos[pi0 + q] = r[q]; roww[r[q]] = w[q]; rowtok[r[q]] = (pi0 + q) >> 1; }
    }
}
__device__ __forceinline__ void phase_moe_combine(const Params& p) {
    const int tid_ = ltid(); const int lane = tid_ & 63, gw = blockIdx.x * 8 + (tid_ >> 6), NGW = gridDim.x * 8;
    const int* pos = (const int*)(p.ws + SM_POS); const bf16_t* ym = (const bf16_t*)(p.ws + R_XA);
    for (int m0 = gw * 2; m0 < T; m0 += NGW * 2) {
        int ps[4];
#pragma unroll
        for (int q = 0; q < 4; ++q) ps[q] = pos[m0 * 2 + q];
        f32x4 x[2][4]; u32x2 ya[2][4], yc[2][4];
#pragma unroll
        for (int q = 0; q < 2; ++q)
#pragma unroll
            for (int j = 0; j < 4; ++j) { const int d = 4 * lane + 256 * j;
                x[q][j] = *(const f32x4*)(p.out + (size_t)(m0 + q) * D + d); ya[q][j] = *(const u32x2*)(ym + (size_t)ps[2 * q] * D + d); yc[q][j] = *(const u32x2*)(ym + (size_t)ps[2 * q + 1] * D + d); }
#pragma unroll
        for (int q = 0; q < 2; ++q)
#pragma unroll
            for (int j = 0; j < 4; ++j) { const int d = 4 * lane + 256 * j; f32x4 o = x[q][j]; const u32x2 a = ya[q][j], c = yc[q][j];
                o.x += bflo(a.x) + bflo(c.x); o.y += bfhi(a.x) + bfhi(c.x); o.z += bflo(a.y) + bflo(c.y); o.w += bfhi(a.y) + bfhi(c.y);
                *(f32x4*)(p.out + (size_t)(m0 + q) * D + d) = o; }
    }
}

#define XB_TMO      128
#define XB_XCNT(j)  (256  + 64 * (j))
#define XB_XSUB(j)  (1280 + 64 * (j))
#define XB_XGEN(j)  (2304 + 64 * (j))
#define XB_TOP      3328
#define XB_TOPGEN   3392
#define XCD_BAR_WORDS 3456
#define XB_SPIN_CAP (1u << 18)

__device__ __forceinline__ unsigned xb_ld(unsigned* p)              { return __hip_atomic_load(p, __ATOMIC_RELAXED, __HIP_MEMORY_SCOPE_AGENT); }
__device__ __forceinline__ unsigned xb_add(unsigned* p, unsigned v) { return __hip_atomic_fetch_add(p, v, __ATOMIC_RELAXED, __HIP_MEMORY_SCOPE_AGENT); }
__device__ __forceinline__ unsigned xb_xcc_id() { return (unsigned)__builtin_amdgcn_s_getreg((3 << 11) | 20) & 0xFu; }
#define XB_SPIN(cond, bar) do { unsigned _sp = 0; while (cond) { __builtin_amdgcn_s_sleep(1); \
    if ((++_sp & 255u) == 0u) { if (xb_ld(&(bar)[XB_TMO])) break; if (_sp > XB_SPIN_CAP) { atomicAdd(&(bar)[XB_TMO], 1u); break; } } } } while (0)

struct XcdBarrier {
    unsigned* bar; unsigned x;
    volatile LAS unsigned* st;
};

__device__ __forceinline__ XcdBarrier xcd_barrier_post(unsigned* bar, volatile LAS unsigned* st) {
    XcdBarrier b; b.bar = bar; b.x = xb_xcc_id(); b.st = st;
    if (threadIdx.x == 0) (void)xb_add(&bar[XB_XCNT(b.x)], 1u);
    return b;
}
__device__ __forceinline__ void xcd_barrier_complete(unsigned* bar, unsigned x, unsigned& nloc, unsigned& nx) {
    const unsigned G = gridDim.x * gridDim.y * gridDim.z;
    unsigned sum, cnt, mine, sp = 0u;
    for (;;) {
        sum = 0u; cnt = 0u; mine = 0u;
#pragma unroll
        for (unsigned j = 0; j < 16; ++j) { const unsigned c = xb_ld(&bar[XB_XCNT(j)]); sum += c; cnt += (c > 0u) ? 1u : 0u; mine = (j == x) ? c : mine; }
        if (sum == G) break;
        __builtin_amdgcn_s_sleep(1);
        if ((++sp & 255u) == 0u) { if (xb_ld(&bar[XB_TMO])) break; if (sp > XB_SPIN_CAP) { atomicAdd(&bar[XB_TMO], 1u); break; } }
    }
    nloc = mine > 0u ? mine : 1u; nx = cnt > 0u ? cnt : 1u;
}

__device__ __forceinline__ void xcd_barrier(const XcdBarrier& b) {
    asm volatile("s_waitcnt vmcnt(0)" ::: "memory");
    __syncthreads();
    if (threadIdx.x == 0) {
        unsigned* bar = b.bar;
        __builtin_amdgcn_s_waitcnt(0);
        unsigned nloc = b.st[0], nx = b.st[1];
        if (nloc == 0u) { xcd_barrier_complete(bar, b.x, nloc, nx); b.st[0] = nloc; b.st[1] = nx; }
        const unsigned old = xb_add(&bar[XB_XSUB(b.x)], 1u);
        const unsigned gen = old / nloc;
        if (old + 1u == (gen + 1u) * nloc) {
            __builtin_amdgcn_fence(__ATOMIC_RELEASE, "agent");
            asm volatile("s_waitcnt vmcnt(0)" ::: "memory");
            const unsigned og = xb_add(&bar[XB_TOP], 1u);
            const unsigned tg = og / nx;
            if (og + 1u == (tg + 1u) * nx) xb_add(&bar[XB_TOPGEN], 1u);
            else XB_SPIN(xb_ld(&bar[XB_TOPGEN]) == tg, bar);
            __builtin_amdgcn_fence(__ATOMIC_ACQUIRE, "agent");
            xb_add(&bar[XB_XGEN(b.x)], 1u);
            asm volatile("s_waitcnt vmcnt(0)" ::: "memory");
        } else {
            XB_SPIN(xb_ld(&bar[XB_XGEN(b.x)]) == gen, bar);
            __builtin_amdgcn_fence(__ATOMIC_ACQUIRE, "agent");
            asm volatile("s_waitcnt vmcnt(0)" ::: "memory");
        }
    }
    __syncthreads();
}


__global__ void __launch_bounds__(512) mega_fwd(Params p) {
    extern __shared__ __attribute__((aligned(16))) unsigned char lds_raw[];
    LAS unsigned char* lds = (LAS unsigned char*)lds_raw;
    cg::grid_group grid = cg::this_grid();
    volatile LAS unsigned* bst = (volatile LAS unsigned*)(lds + 140032);
    if (threadIdx.x == 0) { bst[0] = 0u; bst[1] = 0u; const unsigned long long ba = (unsigned long long)(p.ws + SM_BAR); bst[2] = (unsigned)ba; bst[3] = (unsigned)(ba >> 32); }
    __syncthreads();
    (void)xcd_barrier_post((unsigned*)(p.ws + SM_BAR), bst);
#define GSYNC() do { XcdBarrier xb_; volatile LAS unsigned* st_ = (volatile LAS unsigned*)(lds + 140032); xb_.bar = (unsigned*)(((unsigned long long)st_[3] << 32) | st_[2]); xb_.x = xb_xcc_id(); xb_.st = st_; xcd_barrier(xb_); } while (0)
    const int G = gridDim.x, c = blockIdx.x;
#define LP() bf16_t* W = (bf16_t*)p.ws; bf16_t* xn = (bf16_t*)(p.ws + R_XN); float* x1 = (float*)(p.ws + R_XA); pg8::StaticOrder SO; (void)W; (void)xn; (void)x1; (void)SO
#ifndef PHMASK
#define PHMASK 0xFFFFFFFFu
#endif
#ifndef REPEAT_MASK
#define REPEAT_MASK 0u
#endif
#define PH(k) if (((PHMASK >> (k)) & 1u) && (k) >= p.ph_lo && (k) <= p.ph_hi)
#define RPT(k) if ((REPEAT_MASK >> (k)) & 1u)
    PH(0) { LP(); phase_p0(p, lds); }
    GSYNC();
    if (p.ph_lo == -12345) grid.sync();
    RPT(0) { { LP(); phase_p0(p, lds); } GSYNC(); }
    PH(1) { LP();
        pg8::Gemm g{xn, W + W_IN_E / 2, T, 1792, 1024, 1024, nullptr, 0, nullptr}; SO.init(T, 1792, G, c);
        pg8::EpiBf16<0> E{(bf16_t*)(p.ws + R_H), 1792, nullptr, nullptr};
        pg8::gemm_phase<pg8::EpiBf16<0>, true>(lds, g, SO, E);
    }
    GSYNC();
    PH(2) { LP(); phase_p2(p, lds); }
    GSYNC();
    RPT(2) { { LP(); phase_p2(p, lds); } GSYNC(); }
    PH(3) { LP();
        const int nCu = 2 * (NB * 512 / 256), Gc = (nCu < G / 2) ? nCu : 0;
        if (Gc == 0 || c < Gc) {
            for (int kv = 0; kv < 2; ++kv) {
                pg8::Gemm g{(const bf16_t*)(p.ws + R_XA + (kv ? A_VCIN : A_KCIN)), W + W_CW1 / 2 + (size_t)kv * 256 * 2048, NB * 512, 256, 2048, 1024, nullptr, 0, nullptr};
                if (Gc) SO.init(NB * 512, 256, Gc / 2, c - kv * (Gc / 2)); else SO.init(NB * 512, 256, G, c);
                pg8::EpiBf16<2> E{(bf16_t*)(p.ws + SM_HID) + (size_t)kv * NB * 512 * 256, 256, (const float*)(p.ws + SM_B1) + kv * 256, nullptr};
                if (Gc == 0 || (c / (Gc / 2)) == kv) pg8::gemm_phase<pg8::EpiBf16<2>, true>(lds, g, SO, E);
            }
        }
        if (Gc == 0 || c >= Gc) {
            {
                pg8::Gemm g{(const bf16_t*)(p.ws + R_XA + A_CQN), W + W_UQ / 2, T, 1024, 256, 256, nullptr, 0, nullptr}; SO.init(T, 1024, G - Gc, c - Gc);
                pg8::EpiBf16<0> E{(bf16_t*)(p.ws + R_H), 1024, nullptr, nullptr};
                pg8::gemm_phase<pg8::EpiBf16<0>, true>(lds, g, SO, E);
            }
            {
                pg8::Gemm g{(const bf16_t*)(p.ws + R_XA + A_CKVN), W + W_UKV / 2, T, 1024, 128, 128, nullptr, 0, nullptr}; SO.init(T, 1024, G - Gc, c - Gc);
                pg8::EpiBf16<0> E{(bf16_t*)(p.ws + R_H + (size_t)T * 2048), 1024, nullptr, nullptr};
                pg8::gemm_phase<pg8::EpiBf16<0>, true>(lds, g, SO, E);
            }
        }
    }
    GSYNC();
    PH(4) { LP(); phase_p3b(p, lds); }
    GSYNC();
    RPT(4) { { LP(); phase_p3b(p, lds); } GSYNC(); }
    PH(5) { LP(); phase_p4(p, lds); }
    GSYNC();
    RPT(5) { { LP(); phase_p4(p, lds); } GSYNC(); }
    PH(6) { LP();
        pg8::Gemm g{xn, W + W_OUT_E / 2, T, 1024, 1024, 1024, nullptr, 0, nullptr}; SO.init(T, 1024, G, c);
        pg8::EpiResF32Stat E{p.in[0], x1, (bf16_t*)p.out, (float*)(p.ws + SM_SSP1), 1024};
        pg8::gemm_phase<pg8::EpiResF32Stat, true>(lds, g, SO, E);
    }
    GSYNC();
    PH(7) { }
    PH(8) { LP();
        pg8::Gemm g{(const bf16_t*)p.out, W + W_GU / 2, T, 5632, 1024, 1024, nullptr, 0, nullptr}; SO.init(T, 5632, G, c);
        pg8::EpiSwiGLU E{(bf16_t*)(p.ws + R_H), 2816, (const float*)(p.ws + SM_SSP1)};
        pg8::gemm_phase<pg8::EpiSwiGLU, true>(lds, g, SO, E);
    }
    GSYNC();
    PH(9) { LP();
        pg8::Gemm g{(const bf16_t*)(p.ws + R_H), W + W_D / 2, T, 1024, 2816, 2816, nullptr, 0, nullptr}; SO.init(T, 1024, G, c);
        pg8::EpiResF32Stat E{x1, p.out, xn, (float*)(p.ws + SM_SSP2), 1024};
        pg8::gemm_phase<pg8::EpiResF32Stat, true>(lds, g, SO, E);
    }
    GSYNC();
    PH(10) { }
    PH(11) { LP();
        pg8::Gemm g{xn, W + W_IN_O / 2, T, 3072, 1024, 1024, nullptr, 0, nullptr}; SO.init(T, 3072, G, c);
        pg8::EpiBf16<0> E{(bf16_t*)(p.ws + R_H), 3072, nullptr, (const float*)(p.ws + SM_SSP2)};
        pg8::gemm_phase<pg8::EpiBf16<0>, true>(lds, g, SO, E);
    }
    GSYNC();
    PH(12) { LP(); phase_conv(p); }
    GSYNC();
    RPT(12) { { LP(); phase_conv(p); } GSYNC(); }
    PH(13) { LP();
        pg8::Gemm g{xn, W + W_OUT_O / 2, T, 1024, 1024, 1024, nullptr, 0, nullptr}; SO.init(T, 1024, G, c);
        pg8::EpiResF32 E{p.out, p.out, 1024};
        pg8::gemm_phase<pg8::EpiResF32, true>(lds, g, SO, E);
    }
    GSYNC();
    PH(14) { LP(); phase_norm_router(p, lds); }
    GSYNC();
    PH(15) { LP(); phase_moe_gather(p); }
    GSYNC();
    PH(16) { LP(); const int mrows = ((const int*)(p.ws + SM_CTL))[8];
        pg8::Gemm g{xn, W + W_MGU / 2, mrows, 2816, 1024, 1024, (const int*)(p.ws + SM_TILEE), (size_t)2816 * 1024, (const int*)(p.ws + SM_ROWTOK)}; SO.init(mrows, 2816, G, c);
        pg8::EpiSwiGLU E{(bf16_t*)(p.ws + R_H), 1408, nullptr};
        pg8::gemm_phase<pg8::EpiSwiGLU, true, true>(lds, g, SO, E);
    }
    GSYNC();
    PH(17) { LP(); const int mrows = ((const int*)(p.ws + SM_CTL))[8];
        pg8::Gemm g{(const bf16_t*)(p.ws + R_H), W + W_MD / 2, mrows, 1024, 1408, 1408, (const int*)(p.ws + SM_TILEE), (size_t)1024 * 1408, nullptr}; SO.init(mrows, 1024, G, c);
        pg8::EpiRowScaleBf16 E{(bf16_t*)(p.ws + R_XA), 1024, (const float*)(p.ws + SM_ROWW)};
        pg8::gemm_phase<pg8::EpiRowScaleBf16, true>(lds, g, SO, E);
    }
    GSYNC();
    PH(18) { LP(); phase_moe_combine(p); }
#undef PH
}

inline void launch(void* const* d_in, float* d_out, void* d_ws, size_t ws_size, hipStream_t stream, int ph_lo = 0, int ph_hi = 99, int dbg_branch = -1) {
    static int grid = 0;
    if (grid == 0) {
        int dev = 0, cus = 0, per_cu = 0;
        hipGetDevice(&dev); hipDeviceGetAttribute(&cus, hipDeviceAttributeMultiprocessorCount, dev);
        hipFuncSetAttribute((const void*)mega_fwd, hipFuncAttributeMaxDynamicSharedMemorySize, LDS_BYTES);
        hipOccupancyMaxActiveBlocksPerMultiprocessor(&per_cu, (const void*)mega_fwd, 512, LDS_BYTES);
        if (per_cu < 1) { fprintf(stderr, "occupancy query says %d blocks/CU\n", per_cu); per_cu = 1; }
        grid = cus;
        if (WS_FAST_END > ws_size) { fprintf(stderr, "ws too small: need %zu have %zu\n", (size_t)WS_FAST_END, ws_size); grid = -1; }
    }
    if (grid < 0) return;
    if (ph_lo <= 14 && ph_hi >= 14) hipMemsetAsync((char*)d_ws + SM_CTL, 0, 4096, stream);
    hipMemsetAsync((char*)d_ws + SM_BAR, 0, 16384, stream);
    Params p{};
    for (int i = 0; i < 30; ++i) p.in[i] = (const float*)d_in[i];
    p.out = d_out; p.ws = (unsigned char*)d_ws; p.ph_lo = ph_lo; p.ph_hi = ph_hi; p.dbg_branch = dbg_branch;
    void* args[] = {&p};
    hipError_t e = hipLaunchCooperativeKernel((const void*)mega_fwd, dim3(grid), dim3(512), args, LDS_BYTES, stream);
    if (e != hipSuccess) fprintf(stderr, "cooperative launch failed: %s (grid %d)\n", hipGetErrorString(e), grid);
}
}
extern "C" void kernel_launch(void* const* d_in, const int* in_sizes, int n_in, void* d_out, int out_size, void* d_ws, size_t ws_size, hipStream_t stream) {
    fast::launch(d_in, (float*)d_out, d_ws, ws_size, stream);
}
```

```cpp
#include <hip/hip_runtime.h>
#include <hip/hip_bf16.h>
#include <stdint.h>
#include <stdio.h>
#include <string.h>
#include <hip/hip_cooperative_groups.h>
namespace cg = cooperative_groups;
#define NB 8
#define REPEAT_MASK 0x0u
namespace gold {
constexpr int S = 4096, D = 1024, HW = 1720;
constexpr float EPS = 1e-6f;

__device__ const unsigned char T5B[128] = {0, 1, 2, 3, 4, 5, 6, 7, 8, 9, 10, 11, 12, 13, 14, 15, 16, 16, 16, 17, 17, 18, 18, 18, 19, 19, 19, 20, 20, 20, 20, 21, 21, 21, 21, 22, 22, 22, 22, 22, 23, 23, 23, 23, 23, 23, 24, 24, 24, 24, 24, 24, 25, 25, 25, 25, 25, 25, 25, 26, 26, 26, 26, 26, 26, 26, 26, 27, 27, 27, 27, 27, 27, 27, 27, 27, 27, 28, 28, 28, 28, 28, 28, 28, 28, 28, 28, 29, 29, 29, 29, 29, 29, 29, 29, 29, 29, 29, 29, 30, 30, 30, 30, 30, 30, 30, 30, 30, 30, 30, 30, 30, 30, 31, 31, 31, 31, 31, 31, 31, 31, 31, 31, 31, 31, 31, 31};
}
#ifndef NB
#define NB 8
#endif
namespace fast {
#define LAS __attribute__((address_space(3)))
typedef unsigned short bf16_t;
typedef short bf16x8 __attribute__((ext_vector_type(8)));
typedef float f32x4 __attribute__((ext_vector_type(4)));
typedef float f32x2 __attribute__((ext_vector_type(2)));
typedef float f32x16 __attribute__((ext_vector_type(16)));
typedef unsigned u32x4 __attribute__((ext_vector_type(4)));
typedef unsigned u32x2 __attribute__((ext_vector_type(2)));
typedef __bf16 bf16x2_t __attribute__((ext_vector_type(2)));

constexpr int S = 4096, T = NB * S, D = 1024;
constexpr float EPS = 1e-6f, LOG2E = 1.4426950408889634f;

__device__ __forceinline__ unsigned cvtpk(float lo, float hi) { f32x2 v = {lo, hi}; bf16x2_t b = __builtin_convertvector(v, bf16x2_t); return __builtin_bit_cast(unsigned, b); }
__device__ __forceinline__ bf16_t f2bf(float f) { return (bf16_t)(cvtpk(f, 0.f) & 0xffffu); }
__device__ __forceinline__ float bf2f(bf16_t u) { return __builtin_bit_cast(float, (unsigned)u << 16); }
__device__ __forceinline__ float bflo(unsigned u) { return __builtin_bit_cast(float, u << 16); }
__device__ __forceinline__ float bfhi(unsigned u) { return __builtin_bit_cast(float, u & 0xffff0000u); }
__device__ __forceinline__ float wsum(float v) {
#pragma unroll
    for (int o = 1; o < 64; o <<= 1) v += __shfl_xor(v, o);
    return v;
}
__device__ __forceinline__ float fexp2(float x) { return __builtin_amdgcn_exp2f(x); }
__device__ __forceinline__ float frcp(float x) { return __builtin_amdgcn_rcpf(x); }
__device__ __forceinline__ float silu_f(float x) { return x * frcp(1.f + fexp2(-x * LOG2E)); }
__device__ __forceinline__ float gelu_tanh_f(float x) {
    const float u = 0.7978845608028654f * (x + 0.044715f * x * x * x);
    return x * frcp(1.f + fexp2(-2.f * LOG2E * u));
}

namespace pg8 {
constexpr int BM = 256, BK = 64, HALF = 128, HTB = HALF * BK * 2, STAGE_BYTES = 8 * HTB, NXCD = 8, WGM = 8;
__host__ __device__ __forceinline__ int lds_byte(int r, int c) { const int st = (r >> 4) * 2 + (c >> 5), rr = r & 15, cc = c & 31, ob = rr * 64 + cc * 2; return st * 1024 + (ob ^ (((ob >> 9) & 1) << 5)); }
__host__ __device__ __forceinline__ void stage_rc(int b, int& R, int& C) { const int st = b / 1024, sb = b % 1024, swz = sb ^ (((sb >> 9) & 1) << 5); R = (st >> 1) * 16 + swz / 64; C = (st & 1) * 32 + (swz % 64) / 2; }
__host__ __device__ __forceinline__ int perm32(int rho) { const int n = rho >> 4, i = rho & 15; return 8 * (i >> 2) + 4 * n + (i & 3); }

struct Unit { int pm, pn; };
struct Gemm { const bf16_t* A; const bf16_t* Bt; int M, N, K, lda; const int* tile_e; size_t estride; const int* rowidx; };

struct StaticOrder {
    int nM, nN, nwg, G, c;
    __device__ void init(int M, int N, int G_, int c_) { nM = M / BM; nN = N / BM; nwg = nM * nN; G = G_; c = c_; }
    __device__ bool next(int i, Unit& u) const {
        const long L = (long)i * G + c; if (L >= nwg) return false;
        int wgid = (int)L; { const int q = nwg / NXCD, r = nwg % NXCD, xcd = wgid % NXCD, off = wgid / NXCD; wgid = (xcd < r ? xcd * (q + 1) : r * (q + 1) + (xcd - r) * q) + off; }
        const int nig = WGM * nN, gid = wgid / nig, fm = gid * WGM, gsz = (nM - fm) < WGM ? (nM - fm) : WGM;
        u.pm = fm + ((wgid % nig) % gsz); u.pn = (wgid % nig) / gsz; return true;
    }
};

template <class Epi, bool ALIGN_EPI, bool GATHER = false>
__device__ __forceinline__ void gemm_phase(LAS unsigned char* lds, const Gemm g, const StaticOrder& S, const Epi& E) {
    int tid = threadIdx.x; asm volatile("" : "+v"(tid));
    const int wid = __builtin_amdgcn_readfirstlane(tid >> 6), lane = tid & 63, wr = wid >> 2, wc = wid & 3, fr = lane & 15, fq = lane >> 4;
    const int K = g.K, nt = K / BK, lda = g.lda;
    unsigned voffA[2], voffB[2];
#pragma unroll
    for (int i = 0; i < 2; ++i) { int R, C; stage_rc(tid * 16 + i * 8192, R, C); const int Rb = Epi::PERM ? ((R & ~31) + perm32(R & 31)) : R;
        voffA[i] = (unsigned)(R * lda + C) * 2u; voffB[i] = (unsigned)(Rb * K + C) * 2u; }
    const size_t kstep = (size_t)(BK * 2);
    const size_t hsA = GATHER ? 0 : (size_t)HALF * lda * 2, tsA = 2 * hsA, hsB = (size_t)HALF * K * 2, tsB = 2 * hsB;
    unsigned vgc[2][2], vgn[2][2];
#define PG8_GOFF(pm_, vg) do { _Pragma("unroll") for (int h_ = 0; h_ < 2; ++h_) _Pragma("unroll") for (int i_ = 0; i_ < 2; ++i_) { int R_, C_; stage_rc(tid * 16 + i_ * 8192, R_, C_); \
        int tok_ = g.rowidx[(pm_) * BM + h_ * HALF + R_]; tok_ = tok_ < 0 ? 0 : tok_; vg[h_][i_] = (unsigned)(tok_ * lda + C_) * 2u; } } while (0)
#define PG8_STAGE_A(bufoff, gbase, h, nx) do { unsigned va_[2]; _Pragma("unroll") for (int i_ = 0; i_ < 2; ++i_) va_[i_] = GATHER ? ((nx) ? vgn[h][i_] : vgc[h][i_]) : voffA[i_]; PG8_STAGE(bufoff, gbase, va_); } while (0)
    const unsigned ldsw = (unsigned)wid * 1024u;
    const int aoff = lds_byte(wr * 64 + fr, fq * 8), boff = lds_byte(wc * 32 + fr, fq * 8);
#define PG8_SA(b, h) (((b) * 2 + (h)) * HTB)
#define PG8_SB(b, h) ((4 + (b) * 2 + (h)) * HTB)
#define PG8_STAGE(bufoff, gbase, voff) do { _Pragma("unroll") for (int _i = 0; _i < 2; ++_i) \
        __builtin_amdgcn_global_load_lds((const unsigned*)((const char*)(gbase) + (voff)[_i]), (LAS unsigned*)(lds + (bufoff) + ldsw + _i * 8192), 16, 0, 0); } while (0)
#define PG8_LDA(dst, b, h) do { _Pragma("unroll") for (int m = 0; m < 4; ++m) _Pragma("unroll") for (int k = 0; k < 2; ++k) dst[m][k] = *(const LAS bf16x8*)(lds + PG8_SA(b, h) + aoff + m * 2048 + k * 1024); } while (0)
#define PG8_LDB(dst, b, h) do { _Pragma("unroll") for (int n = 0; n < 2; ++n) _Pragma("unroll") for (int k = 0; k < 2; ++k) dst[n][k] = *(const LAS bf16x8*)(lds + PG8_SB(b, h) + boff + n * 2048 + k * 1024); } while (0)
#define PG8_MMA(ai, bj, At, Bt) do { __builtin_amdgcn_s_setprio(1); _Pragma("unroll") for (int m = 0; m < 4; ++m) _Pragma("unroll") for (int n = 0; n < 2; ++n) _Pragma("unroll") for (int k = 0; k < 2; ++k) \
        acc[ai][bj][m][n] = __builtin_amdgcn_mfma_f32_16x16x32_bf16(Bt[n][k], At[m][k], acc[ai][bj][m][n], 0, 0, 0); __builtin_amdgcn_s_setprio(0); } while (0)
#define PG8_WAIT_V(n) asm volatile("s_waitcnt vmcnt(" #n ")" ::: "memory")
#define PG8_WAIT_L(n) asm volatile("s_waitcnt lgkmcnt(" #n ")" ::: "memory")
#define PG8_BAR __builtin_amdgcn_s_barrier()
#define PG8_SCHED __builtin_amdgcn_sched_barrier(0)
#define PG8_EOFF(pm_) (g.tile_e ? (size_t)g.tile_e[pm_] * g.estride * 2 : (size_t)0)
    Unit cur, nxt; int ui = 0;
    if (!S.next(0, cur)) return;
    f32x4 acc[2][2][4][2];
#pragma unroll
    for (int a = 0; a < 2; ++a)
#pragma unroll
        for (int b = 0; b < 2; ++b)
#pragma unroll
            for (int m = 0; m < 4; ++m)
#pragma unroll
                for (int n = 0; n < 2; ++n) acc[a][b][m][n] = (f32x4){0.f, 0.f, 0.f, 0.f};
    bf16x8 At[4][2], B0[2][2], B1[2][2];
    const char* cA = (const char*)g.A + (size_t)cur.pm * tsA; const char* cB = (const char*)g.Bt + PG8_EOFF(cur.pm) + (size_t)cur.pn * tsB;
    if constexpr (GATHER) PG8_GOFF(cur.pm, vgc);
    PG8_STAGE(PG8_SB(0, 0), cB, voffB); PG8_STAGE(PG8_SB(0, 1), cB + hsB, voffB); PG8_STAGE_A(PG8_SA(0, 0), cA, 0, false); PG8_STAGE_A(PG8_SA(0, 1), cA + hsA, 1, false);
    if (wr == 1) PG8_BAR;
    PG8_WAIT_V(2); PG8_BAR;
    PG8_STAGE(PG8_SB(1, 0), cB + kstep, voffB); PG8_STAGE_A(PG8_SA(1, 0), cA + kstep, 0, false); PG8_STAGE(PG8_SB(1, 1), cB + hsB + kstep, voffB);
    PG8_WAIT_V(6); PG8_BAR;
    for (;;) {
        const bool has_next = S.next(ui + 1, nxt);
        if constexpr (GATHER) { if (has_next) PG8_GOFF(nxt.pm, vgn); else { vgn[0][0] = vgc[0][0]; vgn[0][1] = vgc[0][1]; vgn[1][0] = vgc[1][0]; vgn[1][1] = vgc[1][1]; } }
        const char* nA = has_next ? (const char*)g.A + (size_t)nxt.pm * tsA : cA;
        const char* nB = has_next ? (const char*)g.Bt + PG8_EOFF(nxt.pm) + (size_t)nxt.pn * tsB : cB;
        for (int t = 0; t < nt; t += 2) {
            const bool last = (t == nt - 2);
            const char* a1 = cA + (size_t)(t + 1) * kstep;
            const char* a2 = last ? nA : cA + (size_t)(t + 2) * kstep; const char* b2 = last ? nB : cB + (size_t)(t + 2) * kstep;
            const char* a3 = a2 + kstep; const char* b3 = b2 + kstep;
            PG8_LDB(B0, 0, 0); PG8_LDB(B1, 0, 1); PG8_SCHED; PG8_LDA(At, 0, 0); PG8_STAGE_A(PG8_SA(1, 1), a1 + hsA, 1, false);
            PG8_WAIT_V(8); PG8_WAIT_L(0); PG8_BAR; PG8_MMA(0, 0, At, B0); PG8_MMA(0, 1, At, B1); PG8_BAR; PG8_SCHED;
            PG8_LDA(At, 0, 1); PG8_STAGE(PG8_SB(0, 0), b2, voffB); PG8_STAGE(PG8_SB(0, 1), b2 + hsB, voffB); PG8_STAGE_A(PG8_SA(0, 0), a2, 0, last);
            PG8_WAIT_V(8); PG8_WAIT_L(0); PG8_BAR; PG8_MMA(1, 0, At, B0); PG8_MMA(1, 1, At, B1); PG8_BAR; PG8_SCHED;
            PG8_LDB(B0, 1, 0); PG8_LDB(B1, 1, 1); PG8_SCHED; PG8_LDA(At, 1, 0); PG8_STAGE_A(PG8_SA(0, 1), a2 + hsA, 1, last);
            PG8_WAIT_V(8); PG8_WAIT_L(0); PG8_BAR; PG8_MMA(0, 0, At, B0); PG8_MMA(0, 1, At, B1); PG8_BAR; PG8_SCHED;
            PG8_LDA(At, 1, 1); PG8_STAGE(PG8_SB(1, 0), b3, voffB); PG8_STAGE(PG8_SB(1, 1), b3 + hsB, voffB); PG8_STAGE_A(PG8_SA(1, 0), a3, 0, last);
            PG8_WAIT_V(8); PG8_WAIT_L(0); PG8_BAR; PG8_MMA(1, 0, At, B0); PG8_MMA(1, 1, At, B1); PG8_BAR; PG8_SCHED;
        }
        if constexpr (ALIGN_EPI) { if (wr == 0) PG8_BAR; }
        E(acc, cur, wr, wc, fr, fq);
        if (!has_next) break;
#pragma unroll
        for (int a = 0; a < 2; ++a)
#pragma unroll
            for (int b = 0; b < 2; ++b)
#pragma unroll
                for (int m = 0; m < 4; ++m)
#pragma unroll
                    for (int n = 0; n < 2; ++n) acc[a][b][m][n] = (f32x4){0.f, 0.f, 0.f, 0.f};
        cur = nxt; cA = nA; cB = nB; ++ui;
        if constexpr (GATHER) { vgc[0][0] = vgn[0][0]; vgc[0][1] = vgn[0][1]; vgc[1][0] = vgn[1][0]; vgc[1][1] = vgn[1][1]; }
        if constexpr (ALIGN_EPI) { if (wr == 1) PG8_BAR; }
    }
    PG8_WAIT_V(0);
    if constexpr (!ALIGN_EPI) { if (wr == 0) PG8_BAR; }
    PG8_BAR;
#undef PG8_SA
#undef PG8_SB
#undef PG8_STAGE
#undef PG8_LDA
#undef PG8_LDB
#undef PG8_MMA
#undef PG8_WAIT_V
#undef PG8_WAIT_L
#undef PG8_BAR
#undef PG8_SCHED
#undef PG8_EOFF
#undef PG8_GOFF
#undef PG8_STAGE_A
}

__device__ __forceinline__ float row_rstd(const float* ssp, int row);
template <int ACT> struct EpiBf16 {
    static constexpr bool PERM = true;
    bf16_t* O; int ldc; const float* bias; const float* ssp;
    __device__ __forceinline__ void operator()(const f32x4 (&acc)[2][2][4][2], const Unit& u, int wr, int wc, int fr, int fq) const {
        const int row0 = u.pm * BM + wr * 64 + fr, col0 = u.pn * BM + wc * 32 + 8 * fq;
        f32x4 bv[2][2];
#pragma unroll
        for (int bj = 0; bj < 2; ++bj)
#pragma unroll
            for (int n = 0; n < 2; ++n) bv[bj][n] = bias ? *(const f32x4*)(bias + col0 + bj * HALF + 4 * n) : (f32x4){0.f, 0.f, 0.f, 0.f};
#pragma unroll
        for (int ai = 0; ai < 2; ++ai)
#pragma unroll
            for (int m = 0; m < 4; ++m) { bf16_t* rowp = O + (size_t)(row0 + ai * HALF + m * 16) * ldc + col0;
                const float rs = (ACT == 0 && ssp) ? row_rstd(ssp, row0 + ai * HALF + m * 16) : 1.f;
#pragma unroll
                for (int bj = 0; bj < 2; ++bj) { f32x4 v0 = acc[ai][bj][m][0] * rs + bv[bj][0], v1 = acc[ai][bj][m][1] * rs + bv[bj][1];
                    if (ACT == 2) {
#pragma unroll
                        for (int i = 0; i < 4; ++i) { v0[i] = gelu_tanh_f(v0[i]); v1[i] = gelu_tanh_f(v1[i]); } }
                    u32x4 w; w.x = cvtpk(v0[0], v0[1]); w.y = cvtpk(v0[2], v0[3]); w.z = cvtpk(v1[0], v1[1]); w.w = cvtpk(v1[2], v1[3]);
                    *(u32x4*)(rowp + bj * HALF) = w; } }
    }
};
struct EpiResF32 {
    static constexpr bool PERM = false;
    const float* base; float* out; int ldc;
    __device__ __forceinline__ void operator()(const f32x4 (&acc)[2][2][4][2], const Unit& u, int wr, int wc, int fr, int fq) const {
        const int col0 = u.pn * BM + wc * 32 + 4 * fq;
#pragma unroll
        for (int ai = 0; ai < 2; ++ai)
#pragma unroll
            for (int m = 0; m < 4; ++m) { const size_t off = (size_t)(u.pm * BM + ai * HALF + wr * 64 + m * 16 + fr) * ldc + col0;
#pragma unroll
                for (int bj = 0; bj < 2; ++bj)
#pragma unroll
                    for (int n = 0; n < 2; ++n) { const f32x4 bs = *(const f32x4*)(base + off + bj * HALF + n * 16); *(f32x4*)(out + off + bj * HALF + n * 16) = bs + acc[ai][bj][m][n]; } }
    }
};
template <bool BASE_BF16> struct EpiResStat {
    static constexpr bool PERM = false;
    const void* base; bf16_t* xb; float* ssp; int ldc;
    __device__ __forceinline__ void operator()(const f32x4 (&acc)[2][2][4][2], const Unit& u, int wr, int wc, int fr, int fq) const {
        const int col0 = u.pn * BM + wc * 32 + 4 * fq;
#pragma unroll
        for (int ai = 0; ai < 2; ++ai)
#pragma unroll
            for (int m = 0; m < 4; ++m) { const int row = u.pm * BM + ai * HALF + wr * 64 + m * 16 + fr; const size_t off = (size_t)row * ldc + col0; float ss = 0.f;
#pragma unroll
                for (int bj = 0; bj < 2; ++bj)
#pragma unroll
                    for (int n = 0; n < 2; ++n) { f32x4 bs;
                        if (BASE_BF16) { const u32x2 t = *(const u32x2*)((const bf16_t*)base + off + bj * HALF + n * 16); bs = (f32x4){bflo(t.x), bfhi(t.x), bflo(t.y), bfhi(t.y)}; }
                        else bs = *(const f32x4*)((const float*)base + off + bj * HALF + n * 16);
                        const f32x4 v = bs + acc[ai][bj][m][n];
                        u32x2 w; w.x = cvtpk(v.x, v.y); w.y = cvtpk(v.z, v.w); *(u32x2*)(xb + off + bj * HALF + n * 16) = w; ss += (v.x * v.x + v.y * v.y) + (v.z * v.z + v.w * v.w); }
                ss += __shfl_xor(ss, 16); ss += __shfl_xor(ss, 32);
                if (fq == 0) ssp[(size_t)row * 16 + u.pn * 4 + wc] = ss; }
    }
};
struct EpiResF32B {
    static constexpr bool PERM = false;
    const bf16_t* base; float* out; int ldc;
    __device__ __forceinline__ void operator()(const f32x4 (&acc)[2][2][4][2], const Unit& u, int wr, int wc, int fr, int fq) const {
        const int col0 = u.pn * BM + wc * 32 + 4 * fq;
#pragma unroll
        for (int ai = 0; ai < 2; ++ai)
#pragma unroll
            for (int m = 0; m < 4; ++m) { const size_t off = (size_t)(u.pm * BM + ai * HALF + wr * 64 + m * 16 + fr) * ldc + col0;
#pragma unroll
                for (int bj = 0; bj < 2; ++bj)
#pragma unroll
                    for (int n = 0; n < 2; ++n) { const u32x2 t = *(const u32x2*)(base + off + bj * HALF + n * 16); const f32x4 bs = {bflo(t.x), bfhi(t.x), bflo(t.y), bfhi(t.y)};
                        *(f32x4*)(out + off + bj * HALF + n * 16) = bs + acc[ai][bj][m][n]; } }
    }
};
__device__ __forceinline__ float row_rstd(const float* ssp, int row) {
    const f32x4* q = (const f32x4*)(ssp + (size_t)row * 16); const f32x4 a = q[0], b = q[1], c = q[2], d = q[3];
    const float s = ((a.x + a.y) + (a.z + a.w)) + ((b.x + b.y) + (b.z + b.w)) + ((c.x + c.y) + (c.z + c.w)) + ((d.x + d.y) + (d.z + d.w));
    return rsqrtf(s * (1.f / 1024.f) + EPS);
}
struct EpiSwiGLU {
    static constexpr bool PERM = true;
    bf16_t* O; int ldc; const float* ssp;
    __device__ __forceinline__ void operator()(const f32x4 (&acc)[2][2][4][2], const Unit& u, int wr, int wc, int fr, int fq) const {
        const int row0 = u.pm * BM + wr * 64 + fr, col0 = u.pn * HALF + wc * 32 + 8 * fq;
#pragma unroll
        for (int ai = 0; ai < 2; ++ai)
#pragma unroll
            for (int m = 0; m < 4; ++m) { bf16_t* rowp = O + (size_t)(row0 + ai * HALF + m * 16) * ldc + col0;
                const float rs = ssp ? row_rstd(ssp, row0 + ai * HALF + m * 16) : 1.f;
                float h[8];
#pragma unroll
                for (int n = 0; n < 2; ++n)
#pragma unroll
                    for (int i = 0; i < 4; ++i) h[n * 4 + i] = silu_f(acc[ai][0][m][n][i] * rs) * (acc[ai][1][m][n][i] * rs);
                u32x4 w; w.x = cvtpk(h[0], h[1]); w.y = cvtpk(h[2], h[3]); w.z = cvtpk(h[4], h[5]); w.w = cvtpk(h[6], h[7]);
                *(u32x4*)rowp = w; }
    }
};
struct EpiRowScaleBf16 {
    static constexpr bool PERM = true;
    bf16_t* O; int ldc; const float* roww;
    __device__ __forceinline__ void operator()(const f32x4 (&acc)[2][2][4][2], const Unit& u, int wr, int wc, int fr, int fq) const {
        const int row0 = u.pm * BM + wr * 64 + fr, col0 = u.pn * BM + wc * 32 + 8 * fq;
#pragma unroll
        for (int ai = 0; ai < 2; ++ai)
#pragma unroll
            for (int m = 0; m < 4; ++m) { const int row = row0 + ai * HALF + m * 16; const float sc = roww[row]; bf16_t* rowp = O + (size_t)row * ldc + col0;
#pragma unroll
                for (int bj = 0; bj < 2; ++bj) { const f32x4 v0 = acc[ai][bj][m][0] * sc, v1 = acc[ai][bj][m][1] * sc;
                    u32x4 w; w.x = cvtpk(v0[0], v0[1]); w.y = cvtpk(v0[2], v0[3]); w.z = cvtpk(v1[0], v1[1]); w.w = cvtpk(v1[2], v1[3]);
                    *(u32x4*)(rowp + bj * HALF) = w; } }
    }
};
}
constexpr int ROWS_MAX = 2 * T + 8 * 256;
constexpr size_t al256(size_t x) { return (x + 255) & ~(size_t)255; }
constexpr size_t W_IN_E = 0;
constexpr size_t W_CW1 = W_IN_E + (size_t)1792 * 1024 * 2;
constexpr size_t W_UQ = W_CW1 + (size_t)2 * 256 * 2048 * 2;
constexpr size_t W_UKV = W_UQ + (size_t)1024 * 256 * 2;
constexpr size_t W_OUT_E = W_UKV + (size_t)1024 * 128 * 2;
constexpr size_t W_GU = W_OUT_E + (size_t)1024 * 1024 * 2;
constexpr size_t W_D = W_GU + (size_t)5632 * 1024 * 2;
constexpr size_t W_IN_O = W_D + (size_t)1024 * 2816 * 2;
constexpr size_t W_OUT_O = W_IN_O + (size_t)3072 * 1024 * 2;
constexpr size_t W_MGU = W_OUT_O + (size_t)1024 * 1024 * 2;
constexpr size_t W_MD = W_MGU + (size_t)8 * 2816 * 1024 * 2;
constexpr size_t W_END = W_MD + (size_t)8 * 1024 * 1408 * 2;
constexpr size_t SM_CTL = al256(W_END);
constexpr size_t SM_BAR = SM_CTL + 4096;
constexpr size_t SM_B1P = SM_BAR + 16384;
constexpr size_t SM_B1 = SM_B1P + 32 * 512 * 4;
constexpr size_t SM_ROPE = SM_B1 + 512 * 4;
constexpr size_t SM_BL = SM_ROPE + (size_t)S * 32 * 4;
constexpr size_t SM_HID = SM_BL + 8 * 132 * 4;
constexpr size_t SM_KC = SM_HID + (size_t)2 * NB * 512 * 256 * 2;
constexpr size_t SM_VCT = SM_KC + (size_t)NB * 512 * 64 * 2;
constexpr size_t SM_TE = SM_VCT + (size_t)NB * 512 * 64 * 2;
constexpr size_t SM_TW = SM_TE + (size_t)T * 8;
constexpr size_t SM_RANK = SM_TW + (size_t)T * 8;
constexpr size_t SM_POS = SM_RANK + (size_t)T * 8;
constexpr size_t SM_ROWW = SM_POS + (size_t)T * 8;
constexpr size_t SM_TILEE = SM_ROWW + (size_t)ROWS_MAX * 4;
constexpr size_t SM_ROWTOK = al256(SM_TILEE + (size_t)(ROWS_MAX / 256 + 8) * 4);
constexpr size_t SM_SSP1 = al256(SM_ROWTOK + (size_t)ROWS_MAX * 4);
constexpr size_t SM_SSP2 = SM_SSP1 + (size_t)T * 64;
constexpr size_t SM_END = SM_SSP2 + (size_t)T * 64;
constexpr size_t R_XA = al256(SM_END);
constexpr size_t SZ_XA = (size_t)T * 4096 + (size_t)4 * 1048576;
constexpr size_t R_XN = R_XA + SZ_XA;
constexpr size_t SZ_XN = (size_t)T * 2048;
constexpr size_t R_H = R_XN + SZ_XN;
constexpr size_t SZ_H = ((size_t)T * 6144 > (size_t)ROWS_MAX * 2816) ? (size_t)T * 6144 : (size_t)ROWS_MAX * 2816;
constexpr size_t WS_FAST_END = R_H + SZ_H;
constexpr size_t A_QN = 0;
constexpr size_t A_KSN = A_QN + (size_t)T * 1024;
constexpr size_t A_KWN = A_KSN + (size_t)T * 256;
constexpr size_t A_VST = A_KWN + (size_t)T * 256;
constexpr size_t A_VWT = A_VST + (size_t)T * 256;
constexpr size_t A_KCIN = A_VWT + (size_t)T * 256;
constexpr size_t A_VCIN = A_KCIN + (size_t)T * 256 + 2048;
constexpr size_t A_CQN = A_VCIN + (size_t)T * 256 + 2048;
constexpr size_t A_CKVN = A_CQN + (size_t)T * 512;
constexpr size_t A_KROPE = A_CKVN + (size_t)T * 256;
constexpr size_t A_GATES = A_KROPE + (size_t)T * 64;
constexpr size_t A_END = A_GATES + (size_t)T * 96;
static_assert(A_END <= SZ_XA, "attention inputs fit R_XA");
constexpr size_t O_QM = 0;
constexpr size_t O_KM = O_QM + (size_t)T * 1536;
constexpr size_t O_VMT = O_KM + (size_t)T * 1536;
static_assert(O_VMT + (size_t)T * 1024 <= (size_t)T * 4096, "d_out scratch");

struct Params {
    const float* in[30];
    float* out;
    unsigned char* ws;
    int ph_lo, ph_hi, dbg_branch, pad_;
};

constexpr int LDS_BYTES = 147456;

__device__ __forceinline__ int ltid() { int t = threadIdx.x; asm volatile("" : "+v"(t)); return t; }
__device__ __forceinline__ int perm16(int k) { return (k & ~12) | ((k & 4) << 1) | ((k & 8) >> 1); }

struct WDesc { int in_idx, K, N, rep, map, row_off; size_t src_stride, dst_off, dst_stride; int gain_idx, pad_; };
__device__ const WDesc WDESC[12] = {
    {3, 1024, 1720, 1, 2, 0, 0, W_IN_E / 2, 0, -1, 0},
    {7, 2048, 256, 2, 0, 0, (size_t)2048 * 256, W_CW1 / 2, (size_t)256 * 2048, -1, 0},
    {11, 256, 768, 1, 3, 0, 0, W_UQ / 2, 0, -1, 0},
    {12, 128, 1024, 1, 0, 0, 0, W_UKV / 2, 0, -1, 0},
    {15, 1024, 1024, 1, 0, 0, 0, W_OUT_E / 2, 0, -1, 0},
    {17, 1024, 2816, 1, 1, 0, 0, W_GU / 2, 0, 16, 0},
    {18, 1024, 2816, 1, 1, 128, 0, W_GU / 2, 0, 16, 0},
    {19, 2816, 1024, 1, 0, 0, 0, W_D / 2, 0, -1, 0},
    {21, 1024, 3072, 1, 0, 0, 0, W_IN_O / 2, 0, 20, 0},
    {23, 1024, 1024, 1, 0, 0, 0, W_OUT_O / 2, 0, -1, 0},
    {27, 1024, 1408, 8, 1, 0, (size_t)1024 * 1408, W_MGU / 2, (size_t)2816 * 1024, -1, 0},
    {28, 1024, 1408, 8, 1, 128, (size_t)1024 * 1408, W_MGU / 2, (size_t)2816 * 1024, -1, 0},
};
__device__ const WDesc WDESC_MD = {29, 1408, 1024, 8, 0, 0, (size_t)1408 * 1024, W_MD / 2, (size_t)1024 * 1408, -1, 0};

__device__ __forceinline__ void transpose_item(const float* W, int K, int N, bf16_t* WT, int map, int row_off, const float* gain, LAS float* scr, int item, int lane) {
    const int nblk = (N + 31) / 32, kb = item / nblk, nb = item % nblk, k0 = 64 * kb, n0 = 32 * nb;
    const int n4 = (lane & 7) * 4; const bool nok = (n0 + n4) < N;
    f32x4 v[8];
#pragma unroll
    for (int i = 0; i < 8; ++i) { const int kk = (lane >> 3) + 8 * i; v[i] = nok ? *(const f32x4*)(W + (size_t)(k0 + kk) * N + n0 + n4) : (f32x4){0.f, 0.f, 0.f, 0.f}; if (gain) v[i] = v[i] * gain[k0 + kk]; }
#pragma unroll
    for (int i = 0; i < 8; ++i) { const int kk = (lane >> 3) + 8 * i; LAS float* d = scr + kk * 33 + n4; d[0] = v[i].x; d[1] = v[i].y; d[2] = v[i].z; d[3] = v[i].w; }
    asm volatile("s_waitcnt lgkmcnt(0)" ::: "memory");
    const int c = lane & 7;
#pragma unroll
    for (int j = 0; j < 4; ++j) { const int n = (lane >> 3) + 8 * j; const LAS float* s = scr + (8 * c) * 33 + n;
        u32x4 o; o.x = cvtpk(s[0 * 33], s[1 * 33]); o.y = cvtpk(s[2 * 33], s[3 * 33]); o.z = cvtpk(s[4 * 33], s[5 * 33]); o.w = cvtpk(s[6 * 33], s[7 * 33]);
        const int nn = n0 + n;
        if (nn < N) { const int row = (map == 1) ? (256 * (nn >> 7) + (nn & 127) + row_off) : (map == 2) ? (nn < 1280 ? nn : (nn < 1304 ? nn + 416 : nn - 24)) : (map == 3) ? ((nn / 96) * 128 + nn % 96) : (nn + row_off);
            *(u32x4*)(WT + (size_t)row * K + k0 + 8 * c) = o; } }
    asm volatile("s_waitcnt lgkmcnt(0)" ::: "memory");
}
__device__ __forceinline__ void do_wdesc(const Params& p, const WDesc& d, int it, LAS float* scr, int lane) {
    const int per = (d.K / 64) * ((d.N + 31) / 32); const int r = it / per, ii = it % per;
    transpose_item(p.in[d.in_idx] + (size_t)r * d.src_stride, d.K, d.N, (bf16_t*)p.ws + d.dst_off + (size_t)r * d.dst_stride, d.map, d.row_off, d.gain_idx >= 0 ? p.in[d.gain_idx] : nullptr, scr, ii, lane);
}
__device__ __forceinline__ void rms_row_to_bf16(const float* xrow, const float* g, bf16_t* orow, int lane) {
    const f32x4* xr = (const f32x4*)xrow + lane; const f32x4* gr = (const f32x4*)g + lane;
    f32x4 v[4]; float s = 0.f;
#pragma unroll
    for (int j = 0; j < 4; ++j) { v[j] = xr[64 * j]; s += (v[j].x * v[j].x + v[j].y * v[j].y) + (v[j].z * v[j].z + v[j].w * v[j].w); }
    const float r = rsqrtf(wsum(s) * (1.f / 1024.f) + EPS);
    u32x2* o8 = (u32x2*)orow + lane;
#pragma unroll
    for (int j = 0; j < 4; ++j) { const f32x4 gg = gr[64 * j]; u32x2 w; w.x = cvtpk(v[j].x * r * gg.x, v[j].y * r * gg.y); w.y = cvtpk(v[j].z * r * gg.z, v[j].w * r * gg.w); o8[64 * j] = w; }
}
__device__ __forceinline__ void phase_p0(const Params& p, LAS unsigned char* lds) {
    const int tid = ltid(), lane = tid & 63, wave = tid >> 6;
    const int gw = blockIdx.x * 8 + wave, NGW = gridDim.x * 8;
    LAS float* scr = (LAS float*)(lds + wave * 16384);
    int base = 0;
#pragma unroll 1
    for (int d = 0; d < 13; ++d) {
        const WDesc& wd = (d < 12) ? WDESC[d] : WDESC_MD;
        const int n_it = wd.rep * (wd.K / 64) * ((wd.N + 31) / 32);
        int first = (gw - (base % NGW) + NGW) % NGW;
        for (int it = first; it < n_it; it += NGW) do_wdesc(p, wd, it, scr, lane);
        base += n_it;
    }
    bf16_t* xn = (bf16_t*)(p.ws + R_XN);
    for (int m = gw; m < T; m += 2 * NGW) { rms_row_to_bf16(p.in[0] + (size_t)m * D, p.in[2], xn + (size_t)m * D, lane); if (m + NGW < T) rms_row_to_bf16(p.in[0] + (size_t)(m + NGW) * D, p.in[2], xn + (size_t)(m + NGW) * D, lane); }
    for (int u = gw; u < 256; u += NGW) {
        const int kc = u >> 3, kv = (u >> 2) & 1, nb = u & 3; float s = 0.f;
        const float* pos = p.in[6] + kv * 2048 + kc * 64; const float* w1 = p.in[7] + ((size_t)kv * 2048 + kc * 64) * 256 + nb * 64 + lane;
#pragma unroll 8
        for (int k = 0; k < 64; ++k) s += pos[k] * w1[(size_t)k * 256];
        ((float*)(p.ws + SM_B1P))[kc * 512 + kv * 256 + nb * 64 + lane] = s;
    }
    for (int i = blockIdx.x * 512 + tid; i < S * 16; i += gridDim.x * 512) {
        const int t = i >> 4, f = i & 15; const float ang = (float)t * powf(10000.f, -(float)f / 16.f);
        float* rp = (float*)(p.ws + SM_ROPE) + t * 32; rp[f] = cosf(ang); rp[16 + f] = sinf(ang);
    }
    if (blockIdx.x == 0) for (int i = tid; i < 8 * 129; i += 512) { const int h = i / 129, dd = i % 129; ((float*)(p.ws + SM_BL))[h * 132 + dd] = p.in[1][(dd < 128 ? (int)gold::T5B[dd] : 31) * 8 + h] * LOG2E; }
}

__device__ __forceinline__ void unpack8(const u32x4 v, float (&x)[8]) { x[0] = bflo(v.x); x[1] = bfhi(v.x); x[2] = bflo(v.y); x[3] = bfhi(v.y); x[4] = bflo(v.z); x[5] = bfhi(v.z); x[6] = bflo(v.w); x[7] = bfhi(v.w); }
__device__ __forceinline__ u32x4 pack8(const float (&x)[8]) { u32x4 w; w.x = cvtpk(x[0], x[1]); w.y = cvtpk(x[2], x[3]); w.z = cvtpk(x[4], x[5]); w.w = cvtpk(x[6], x[7]); return w; }
__device__ __forceinline__ float ss8f(const float (&x)[8]) { return ((x[0] * x[0] + x[1] * x[1]) + (x[2] * x[2] + x[3] * x[3])) + ((x[4] * x[4] + x[5] * x[5]) + (x[6] * x[6] + x[7] * x[7])); }
__device__ __forceinline__ void load8f(const float* g, float (&x)[8], float sc) { const f32x4 a = *(const f32x4*)g, b = *(const f32x4*)(g + 4); x[0] = a.x * sc; x[1] = a.y * sc; x[2] = a.z * sc; x[3] = a.w * sc; x[4] = b.x * sc; x[5] = b.y * sc; x[6] = b.z * sc; x[7] = b.w * sc; }
__device__ __forceinline__ void phase_p2(const Params& p, LAS unsigned char* lds) {
    const int tid = ltid(), lane = tid & 63, wave = tid >> 6;
    const bf16_t* hb = (const bf16_t*)(p.ws + R_H);
    unsigned char* xa = p.ws + R_XA;
    bf16_t* qn = (bf16_t*)(xa + A_QN); bf16_t* ksn = (bf16_t*)(xa + A_KSN); bf16_t* kwn = (bf16_t*)(xa + A_KWN);
    bf16_t* vst = (bf16_t*)(xa + A_VST); bf16_t* vwt = (bf16_t*)(xa + A_VWT); bf16_t* kcin = (bf16_t*)(xa + A_KCIN); bf16_t* vcin = (bf16_t*)(xa + A_VCIN);
    bf16_t* cqn = (bf16_t*)(xa + A_CQN); bf16_t* ckvn = (bf16_t*)(xa + A_CKVN); bf16_t* krope = (bf16_t*)(xa + A_KROPE); float* gates = (float*)(xa + A_GATES);
    LAS bf16_t* vs = (LAS bf16_t*)lds;
    if (blockIdx.x == 0) {
        { float s = 0.f; for (int k = 0; k < 32; ++k) s += ((const float*)(p.ws + SM_B1P))[k * 512 + tid]; ((float*)(p.ws + SM_B1))[tid] = s; }
        for (int i = tid; i < 1024; i += 512) { kcin[(size_t)T * 128 + i] = 0; vcin[(size_t)T * 128 + i] = 0; }
    }
    const int c8 = (lane & 7) * 8, seg = lane >> 3;
    float qg[8], ksg[8], kwg[8], cqg[8], ckvg[8];
    load8f(p.in[4] + c8, qg, 0.125f * LOG2E); load8f(p.in[5] + 64 + c8, ksg, 1.f); load8f(p.in[5] + 128 + c8, kwg, 1.f);
    load8f(p.in[9] + (lane & 31) * 8, cqg, 1.f); load8f(p.in[10] + (lane & 15) * 8, ckvg, 1.f);
    for (int tile = blockIdx.x; tile < T / 64; tile += gridDim.x) {
        const int b = tile / (S / 64), s0 = (tile % (S / 64)) * 64;
#pragma unroll 4
        for (int tt = 0; tt < 8; ++tt) {
            const int sl = wave * 8 + tt, s = s0 + sl; const size_t t = (size_t)b * S + s;
            const bf16_t* hr = hb + t * 1792 + lane * 8;
            const u32x4 L0 = *(const u32x4*)hr, L1 = *(const u32x4*)(hr + 512), L2 = *(const u32x4*)(hr + 1024);
            u32x4 L3 = {0u, 0u, 0u, 0u}; if (lane < 32) L3 = *(const u32x4*)(hr + 1536);
            float x0[8], x1[8], x2[8], x3[8];
            unpack8(L0, x0); unpack8(L1, x1); unpack8(L2, x2); unpack8(L3, x3);
            float a0 = ss8f(x0), a1 = ss8f(x1), a2 = ss8f(x2), a3 = ss8f(x3);
#pragma unroll
            for (int o = 1; o < 8; o <<= 1) { a0 += __shfl_xor(a0, o); a1 += __shfl_xor(a1, o); a2 += __shfl_xor(a2, o); a3 += __shfl_xor(a3, o); }
            float a2w = a2 + __shfl_xor(a2, 8); a2w += __shfl_xor(a2w, 16);
            const float a3w = a3 + __shfl_xor(a3, 8);
            const int pp = (sl & ~15) | perm16(sl & 15);
            {
                const float r = rsqrtf(a0 * (1.f / 64.f) + EPS); float y[8];
#pragma unroll
                for (int j = 0; j < 8; ++j) y[j] = x0[j] * r * qg[j];
                *(u32x4*)(qn + t * 512 + lane * 8) = pack8(y);
            }
            {
                const int g = seg & 1; const size_t gm = (((size_t)b * 2 + g) * S + s) * 64 + c8;
                if (seg < 2) *(u32x4*)(kcin + gm) = L1;
                else if (seg < 4) *(u32x4*)(vcin + gm) = L1;
                else if (seg < 6) { const float r = rsqrtf(a1 * (1.f / 64.f) + EPS); float y[8];
#pragma unroll
                    for (int j = 0; j < 8; ++j) y[j] = x1[j] * r * ksg[j];
                    *(u32x4*)(ksn + gm) = pack8(y); }
                else {
#pragma unroll
                    for (int j = 0; j < 8; ++j) vs[((0 + g) * 64 + c8 + j) * 72 + pp] = (bf16_t)((j & 1) ? (L1[j >> 1] >> 16) : (L1[j >> 1] & 0xffffu)); }
            }
            {
                const int g = seg & 1; const size_t gm = (((size_t)b * 2 + g) * S + s) * 64 + c8;
                if (seg < 2) { const float r = rsqrtf(a2 * (1.f / 64.f) + EPS); float y[8];
#pragma unroll
                    for (int j = 0; j < 8; ++j) y[j] = x2[j] * r * kwg[j];
                    *(u32x4*)(kwn + gm) = pack8(y); }
                else if (seg < 4) {
#pragma unroll
                    for (int j = 0; j < 8; ++j) vs[((2 + g) * 64 + c8 + j) * 72 + pp] = (bf16_t)((j & 1) ? (L2[j >> 1] >> 16) : (L2[j >> 1] & 0xffffu)); }
                else { const float r = rsqrtf(a2w * (1.f / 256.f) + EPS); float y[8];
#pragma unroll
                    for (int j = 0; j < 8; ++j) y[j] = x2[j] * r * cqg[j];
                    *(u32x4*)(cqn + t * 256 + (lane - 32) * 8) = pack8(y); }
            }
            {
                if (lane < 16) { const float r = rsqrtf(a3w * (1.f / 128.f) + EPS); float y[8];
#pragma unroll
                    for (int j = 0; j < 8; ++j) y[j] = x3[j] * r * ckvg[j];
                    *(u32x4*)(ckvn + t * 128 + lane * 8) = pack8(y); }
                else if (lane < 20) *(u32x4*)(krope + t * 32 + (lane - 16) * 8) = L3;
                else if (lane < 23) { float y[8];
#pragma unroll
                    for (int j = 0; j < 8; ++j) y[j] = frcp(1.f + fexp2(-x3[j] * LOG2E));
                    float* gp = gates + t * 24 + (lane - 20) * 8; *(f32x4*)gp = (f32x4){y[0], y[1], y[2], y[3]}; *(f32x4*)(gp + 4) = (f32x4){y[4], y[5], y[6], y[7]}; }
            }
        }
        __syncthreads();
        {
            const int row = tid >> 1, half = tid & 1, which = row >> 6, d = row & 63, g = which & 1;
            bf16_t* dst = ((which < 2) ? vst : vwt) + (((size_t)b * 2 + g) * 64 + d) * S + s0 + half * 32;
            const LAS bf16_t* src = vs + row * 72 + half * 32;
#pragma unroll
            for (int c = 0; c < 4; ++c) *(u32x4*)(dst + c * 8) = *(const LAS u32x4*)(src + c * 8);
        }
        __syncthreads();
    }
}
__device__ __forceinline__ void phase_p3b(const Params& p, LAS unsigned char* lds) {
    const int tid = ltid(), lane = tid & 63, wave = tid >> 6;
    const int gw = blockIdx.x * 8 + wave, NGW = gridDim.x * 8;
    const bf16_t* qraw = (const bf16_t*)(p.ws + R_H);
    const bf16_t* kvraw = (const bf16_t*)(p.ws + R_H + (size_t)T * 2048);
    const bf16_t* krope = (const bf16_t*)(p.ws + R_XA + A_KROPE);
    const float* rope = (const float*)(p.ws + SM_ROPE);
    bf16_t* qm = (bf16_t*)((unsigned char*)p.out + O_QM); bf16_t* km = (bf16_t*)((unsigned char*)p.out + O_KM); bf16_t* vmt = (bf16_t*)((unsigned char*)p.out + O_VMT);
    const float* q_norm = p.in[13]; const float* k_norm = p.in[14];
    LAS bf16_t* vs = (LAS bf16_t*)lds;
    LAS float* w2s = (LAS float*)(lds + 73728);
    for (int kv = 0; kv < 2; ++kv) {
        __syncthreads();
        for (int i = tid; i < 256 * 64; i += 512) w2s[i] = p.in[8][kv * 16384 + i];
        __syncthreads();
        const bf16_t* hid = (const bf16_t*)(p.ws + SM_HID) + (size_t)kv * NB * 512 * 256;
        for (int row = gw; row < NB * 512; row += NGW) {
            const u32x2 hv = *(const u32x2*)(hid + (size_t)row * 256 + lane * 4);
            const float h0 = bflo(hv.x), h1 = bfhi(hv.x), h2 = bflo(hv.y), h3 = bfhi(hv.y);
            float acc = 0.f;
#pragma unroll 8
            for (int k4 = 0; k4 < 64; ++k4) {
                acc += __shfl(h0, k4) * w2s[(k4 * 4 + 0) * 64 + lane]; acc += __shfl(h1, k4) * w2s[(k4 * 4 + 1) * 64 + lane];
                acc += __shfl(h2, k4) * w2s[(k4 * 4 + 2) * 64 + lane]; acc += __shfl(h3, k4) * w2s[(k4 * 4 + 3) * 64 + lane];
            }
            if (kv == 0) { const float r = rsqrtf(wsum(acc * acc) * (1.f / 64.f) + EPS); ((bf16_t*)(p.ws + SM_KC))[(size_t)row * 64 + lane] = f2bf(acc * r * p.in[5][lane]); }
            else { const int c = row & 255; ((bf16_t*)(p.ws + SM_VCT))[((size_t)(row >> 8) * 64 + lane) * 256 + ((c & ~15) | perm16(c & 15))] = f2bf(acc); }
        }
    }
    __syncthreads();
    const float QS = 0.10206207261596577f * LOG2E;
    const int c = lane & 15, hl = lane >> 4;
    float qg[8], kg[8];
    load8f(q_norm + (c < 12 ? c * 8 : 0), qg, QS);
    load8f(k_norm + (c < 12 ? c * 8 : 0), kg, 1.f);
    for (int tile = blockIdx.x; tile < T / 64; tile += gridDim.x) {
        const int b = tile / (S / 64), s0 = (tile % (S / 64)) * 64;
#pragma unroll 4
        for (int tt = 0; tt < 8; ++tt) {
            const int sl = wave * 8 + tt, s = s0 + sl; const size_t t = (size_t)b * S + s;
            const int pp = (sl & ~15) | perm16(sl & 15);
            u32x4 Q[2], KV[2];
#pragma unroll
            for (int ld = 0; ld < 2; ++ld) { Q[ld] = *(const u32x4*)(qraw + t * 1024 + ld * 512 + lane * 8); KV[ld] = *(const u32x4*)(kvraw + t * 1024 + ld * 512 + lane * 8); }
            u32x4 KR = {0u, 0u, 0u, 0u}; f32x4 cs0 = {0.f, 0.f, 0.f, 0.f}, cs1 = cs0, sn0 = cs0, sn1 = cs0;
            if (c >= 8 && c < 12) { KR = *(const u32x4*)(krope + t * 32 + (c - 8) * 8);
                const float* rp = rope + s * 32 + (c & 1) * 8; cs0 = *(const f32x4*)rp; cs1 = *(const f32x4*)(rp + 4); sn0 = *(const f32x4*)(rp + 16); sn1 = *(const f32x4*)(rp + 20); }
            const float cs[8] = {cs0.x, cs0.y, cs0.z, cs0.w, cs1.x, cs1.y, cs1.z, cs1.w}, sn[8] = {sn0.x, sn0.y, sn0.z, sn0.w, sn1.x, sn1.y, sn1.z, sn1.w};
            float kr[8]; unpack8(KR, kr);
            const float krs = ss8f(kr);
#pragma unroll
            for (int ld = 0; ld < 2; ++ld) {
                const int hh = ld * 4 + hl;
                {
                    float x[8]; unpack8(Q[ld], x);
                    float ss = c < 12 ? ss8f(x) : 0.f;
#pragma unroll
                    for (int o = 1; o < 16; o <<= 1) ss += __shfl_xor(ss, o);
                    const float r = rsqrtf(ss * (1.f / 96.f) + EPS); float y[8], z[8];
#pragma unroll
                    for (int j = 0; j < 8; ++j) y[j] = x[j] * r * qg[j];
#pragma unroll
                    for (int j = 0; j < 8; ++j) { const float pb = __shfl_xor(y[j], 2); z[j] = (c < 8) ? y[j] : ((c < 10) ? (y[j] * cs[j] - pb * sn[j]) : (pb * sn[j] + y[j] * cs[j])); }
                    if (c < 12) *(u32x4*)(qm + (t * 8 + hh) * 96 + c * 8) = pack8(z);
                }
                {
                    float x[8]; unpack8(KV[ld], x);
                    float ss = c < 8 ? ss8f(x) : krs;
#pragma unroll
                    for (int o = 1; o < 16; o <<= 1) ss += __shfl_xor(ss, o);
                    const float r = rsqrtf(ss * (1.f / 96.f) + EPS); float y[8], z[8];
#pragma unroll
                    for (int j = 0; j < 8; ++j) y[j] = (c < 8 ? x[j] : kr[j]) * r * kg[j];
#pragma unroll
                    for (int j = 0; j < 8; ++j) { const float pb = __shfl_xor(y[j], 2); z[j] = (c < 8) ? y[j] : ((c < 10) ? (y[j] * cs[j] - pb * sn[j]) : (pb * sn[j] + y[j] * cs[j])); }
                    if (c < 12) *(u32x4*)(km + (((size_t)b * 8 + hh) * S + s) * 96 + c * 8) = pack8(z);
                    if (c >= 8) {
#pragma unroll
                        for (int j = 0; j < 8; ++j) vs[(hh * 64 + (c - 8) * 8 + j) * 72 + pp] = (bf16_t)((j & 1) ? (KV[ld][j >> 1] >> 16) : (KV[ld][j >> 1] & 0xffffu)); }
                }
            }
        }
        __syncthreads();
        {
            const int hh = tid >> 6, d = tid & 63;
            bf16_t* dst = vmt + (((size_t)b * 8 + hh) * 64 + d) * S + s0;
            const LAS bf16_t* src = vs + tid * 72;
#pragma unroll
            for (int cc = 0; cc < 8; ++cc) *(u32x4*)(dst + cc * 8) = *(const LAS u32x4*)(src + cc * 8);
        }
        __syncthreads();
    }
}

__device__ const unsigned short UNIT_TYPES[256] = {63,127,62,126,61,125,527,591,655,719,783,847,911,975,60,124,59,123,58,122,57,121,56,120,526,590,654,718,782,846,910,974,55,119,54,118,53,117,52,116,51,115,525,589,653,717,781,845,909,973,50,114,49,113,48,112,47,111,524,588,652,716,780,844,908,972,46,110,45,109,44,108,43,107,523,587,651,715,779,843,907,971,42,106,41,105,40,104,39,103,38,102,522,586,650,714,778,842,906,970,37,101,36,100,35,99,34,98,33,97,521,585,649,713,777,841,905,969,32,96,31,95,30,94,520,584,648,712,776,840,904,968,29,93,28,92,27,91,26,90,25,89,519,583,647,711,775,839,903,967,24,88,23,87,22,86,21,85,20,84,518,582,646,710,774,838,902,966,19,83,18,82,17,81,16,80,15,79,517,581,645,709,773,837,901,965,14,78,13,77,12,76,516,580,644,708,772,836,900,964,11,75,10,74,9,73,8,72,515,579,643,707,771,835,899,963,7,71,6,70,5,69,514,578,642,706,770,834,898,962,4,68,3,67,513,577,641,705,769,833,897,961,2,66,1,65,0,64,512,576,640,704,768,832,896,960};
__device__ __forceinline__ int crow(int r, int hi) { return (r & 3) + 8 * (r >> 2) + 4 * hi; }
struct Flash { f32x16 o0, o1; float l; };
__device__ __forceinline__ void flash_init(Flash& st) {
#pragma unroll
    for (int r = 0; r < 16; ++r) { st.o0[r] = 0.f; st.o1[r] = 0.f; }
    st.l = 0.f;
}
constexpr int AL_KB = 0, AL_KBSZ = 64 * 208, AL_VB = 2 * AL_KBSZ, AL_VBSZ = 64 * 144, AL_IMP = AL_VB + 2 * AL_VBSZ, AL_SELB = AL_IMP + 64 * 65 * 4, AL_UNI = AL_SELB + 512, AL_TL = AL_UNI + 64, AL_BL = AL_TL + 128,
              AL_OT = AL_BL + 4 * 132 * 4, AL_END = AL_OT + 8 * 32 * 64 * 4;
static_assert(AL_END <= 131072, "attention LDS");

template <int DK, int KP> __device__ __forceinline__ void qk_tile(f32x16& p0, f32x16& p1, const LAS unsigned char* Kt, const bf16x8* qf, const f32x16& negm, int r32, int hi) {
#pragma unroll
    for (int s = 0; s < DK / 16; ++s) {
        const bf16x8 a0 = *(const LAS bf16x8*)(Kt + r32 * KP + (16 * s + 8 * hi) * 2);
        const bf16x8 a1 = *(const LAS bf16x8*)(Kt + (32 + r32) * KP + (16 * s + 8 * hi) * 2);
        if (s == 0) { p0 = __builtin_amdgcn_mfma_f32_32x32x16_bf16(a0, qf[0], negm, 0, 0, 0); p1 = __builtin_amdgcn_mfma_f32_32x32x16_bf16(a1, qf[0], negm, 0, 0, 0); }
        else { p0 = __builtin_amdgcn_mfma_f32_32x32x16_bf16(a0, qf[s], p0, 0, 0, 0); p1 = __builtin_amdgcn_mfma_f32_32x32x16_bf16(a1, qf[s], p1, 0, 0, 0); }
    }
}
template <bool LANEMASK, class F> __device__ __forceinline__ void softmax_pv(Flash& st, f32x16& p0, f32x16& p1, const LAS unsigned char* Vt, int r32, int hi, bool mine, F f) {
    float ls = 0.f;
#pragma unroll
    for (int r = 0; r < 16; ++r) {
        float x0 = p0[r], x1 = p1[r]; const bool v0 = f(r, 0, x0), v1 = f(r, 1, x1);
        const float e0 = fexp2(x0), e1 = fexp2(x1);
        p0[r] = v0 ? e0 : 0.f; p1[r] = v1 ? e1 : 0.f; ls += p0[r] + p1[r];
    }
    if (LANEMASK) ls = mine ? ls : 0.f;
    st.l += ls;
#pragma unroll
    for (int s = 0; s < 4; ++s) {
        u32x4 w;
        if (s < 2) { w.x = cvtpk(p0[8 * s + 0], p0[8 * s + 1]); w.y = cvtpk(p0[8 * s + 2], p0[8 * s + 3]); w.z = cvtpk(p0[8 * s + 4], p0[8 * s + 5]); w.w = cvtpk(p0[8 * s + 6], p0[8 * s + 7]); }
        else { const int q = s - 2; w.x = cvtpk(p1[8 * q + 0], p1[8 * q + 1]); w.y = cvtpk(p1[8 * q + 2], p1[8 * q + 3]); w.z = cvtpk(p1[8 * q + 4], p1[8 * q + 5]); w.w = cvtpk(p1[8 * q + 6], p1[8 * q + 7]); }
        if (LANEMASK) { w.x = mine ? w.x : 0u; w.y = mine ? w.y : 0u; w.z = mine ? w.z : 0u; w.w = mine ? w.w : 0u; }
        const bf16x8 pa = __builtin_bit_cast(bf16x8, w);
        const bf16x8 vb0 = *(const LAS bf16x8*)(Vt + r32 * 144 + (16 * s + 8 * hi) * 2);
        const bf16x8 vb1 = *(const LAS bf16x8*)(Vt + (32 + r32) * 144 + (16 * s + 8 * hi) * 2);
        st.o0 = __builtin_amdgcn_mfma_f32_32x32x16_bf16(pa, vb0, st.o0, 0, 0, 0);
        st.o1 = __builtin_amdgcn_mfma_f32_32x32x16_bf16(pa, vb1, st.o1, 0, 0, 0);
    }
}
template <bool FIRST> __device__ __forceinline__ void flash_accum(LAS float* otl, const Flash& st, float gate, int hi, int lane) {
    const float lt = st.l + __shfl_xor(st.l, 32);
    const float f = lt > 0.f ? gate * frcp(lt) : 0.f;
#pragma unroll
    for (int r = 0; r < 16; ++r) { const float fr_ = __shfl(f, crow(r, hi));
        if (FIRST) { otl[r * 64 + lane] = fr_ * st.o0[r]; otl[(16 + r) * 64 + lane] = fr_ * st.o1[r]; }
        else { otl[r * 64 + lane] += fr_ * st.o0[r]; otl[(16 + r) * 64 + lane] += fr_ * st.o1[r]; } }
}
template <int NS> __device__ __forceinline__ float qnorm2(const bf16x8* qf) {
    float s = 0.f;
#pragma unroll
    for (int i = 0; i < NS; ++i)
#pragma unroll
        for (int j = 0; j < 8; ++j) { const float x = bf2f((bf16_t)qf[i][j]); s += x * x; }
    return s + __shfl_xor(s, 32);
}
__device__ __forceinline__ float wmax(float v) {
#pragma unroll
    for (int o = 1; o < 64; o <<= 1) v = fmaxf(v, __shfl_xor(v, o));
    return v;
}

template <int RB> struct TileRegs { u32x4 a, b; };
template <int RB> __device__ __forceinline__ void tile_load(TileRegs<RB>& R, const unsigned char* g, size_t gs, int tid) {
    constexpr int CPR = RB / 16;
    asm volatile("" : "+v"(tid));
    { const int row = tid / CPR, c = tid % CPR; R.a = *(const u32x4*)(g + (size_t)row * gs + c * 16); }
    if (RB == 192) { const int id = (tid < 256) ? tid + 512 : tid; const int row = id / CPR, c = id % CPR; R.b = *(const u32x4*)(g + (size_t)row * gs + c * 16); }
}
template <int RB, int P> __device__ __forceinline__ void tile_store(const TileRegs<RB>& R, LAS unsigned char* l, int tid) {
    constexpr int CPR = RB / 16;
    asm volatile("" : "+v"(tid));
    { const int row = tid / CPR, c = tid % CPR; *(LAS u32x4*)(l + row * P + c * 16) = R.a; }
    if (RB == 192) { const int id = tid + 512; if (id < 768) { const int row = id / CPR, c = id % CPR; *(LAS u32x4*)(l + row * P + c * 16) = R.b; } }
}
template <int RBK, int PK, bool HASV, class SrcK, class SrcV, class Comp>
__device__ __forceinline__ void run_tiles(int n, LAS unsigned char* lds, int tid, size_t gsK, size_t gsV, SrcK srcK, SrcV srcV, Comp comp) {
    TileRegs<RBK> k0, k1, k2; TileRegs<128> v0, v1, v2;
    const int nl = n - 1;
    { tile_load<RBK>(k0, srcK(0), gsK, tid); if (HASV) tile_load<128>(v0, srcV(0), gsV, tid); }
    { const int t1 = nl < 1 ? nl : 1; tile_load<RBK>(k1, srcK(t1), gsK, tid); if (HASV) tile_load<128>(v1, srcV(t1), gsV, tid); }
    { const int t2 = nl < 2 ? nl : 2; tile_load<RBK>(k2, srcK(t2), gsK, tid); if (HASV) tile_load<128>(v2, srcV(t2), gsV, tid); }
#define RT_STEP(KR, VR, ii) do { const int i_ = (ii); \
        LAS unsigned char* kb = lds + AL_KB + (i_ & 1) * AL_KBSZ; LAS unsigned char* vb = lds + AL_VB + (i_ & 1) * AL_VBSZ; \
        tile_store<RBK, PK>(KR, kb, tid); if (HASV) tile_store<128, 144>(VR, vb, tid); \
        __syncthreads(); \
        { const int tn = (i_ + 3 < nl) ? i_ + 3 : nl; tile_load<RBK>(KR, srcK(tn), gsK, tid); if (HASV) tile_load<128>(VR, srcV(tn), gsV, tid); } \
        if (i_ < n) comp(i_, kb, vb); } while (0)
    for (int i = 0; i < n; i += 3) { RT_STEP(k0, v0, i); RT_STEP(k1, v1, i + 1); RT_STEP(k2, v2, i + 2); }
#undef RT_STEP
    __syncthreads();
}

__device__ __forceinline__ void mla_unit(const Params& p, LAS unsigned char* lds, int b, int h, int qb) {
    int tid = threadIdx.x; asm volatile("" : "+v"(tid));
    const int lane = tid & 63, w = __builtin_amdgcn_readfirstlane(tid >> 6), r32 = lane & 31, hi = lane >> 5;
    const bf16_t* qm = (const bf16_t*)((const unsigned char*)p.out + O_QM);
    const unsigned char* km = (const unsigned char*)p.out + O_KM + (((size_t)b * 8 + h) * S) * 192;
    const unsigned char* vmt = (const unsigned char*)p.out + O_VMT + (((size_t)b * 8 + h) * 64) * (size_t)S * 2;
    bf16_t* ocat = (bf16_t*)(p.ws + R_XN);
    const int tq = qb * 256 + 32 * w + r32;
    bf16x8 qf[6];
#pragma unroll
    for (int s = 0; s < 6; ++s) qf[s] = *(const bf16x8*)(qm + (((size_t)b * S + tq) * 8 + h) * 96 + 16 * s + 8 * hi);
    const float kn = 9.797958971f * 1.01f * wmax(fmaxf(fabsf(p.in[14][lane]), lane < 32 ? fabsf(p.in[14][64 + lane]) : 0.f));
    const float mref = sqrtf(qnorm2<6>(qf)) * kn;
    f32x16 negm;
#pragma unroll
    for (int r = 0; r < 16; ++r) negm[r] = -mref;
    Flash st; flash_init(st);
    const int ntile = 4 * qb + 4, dt = 4 * qb + (w >> 1);
    run_tiles<192, 208, true>(ntile, lds, tid, 192, (size_t)S * 2,
        [&](int i) { return km + (size_t)i * 64 * 192; }, [&](int i) { return vmt + (size_t)i * 128; },
        [&](int i, LAS unsigned char* kb, LAS unsigned char* vb) {
            if (i <= dt) {
                f32x16 p0, p1; qk_tile<96, 208>(p0, p1, kb, qf, negm, r32, hi);
                if (i < dt) softmax_pv<false>(st, p0, p1, vb, r32, hi, true, [&](int r, int half, float& x) { return true; });
                else { const int kb0 = 64 * i + 4 * hi; softmax_pv<false>(st, p0, p1, vb, r32, hi, true, [&](int r, int half, float& x) { return (kb0 + 32 * half + (r & 3) + 8 * (r >> 2)) <= tq; }); }
            }
        });
    {
        const float lt = st.l + __shfl_xor(st.l, 32); const float f = lt > 0.f ? frcp(lt) : 0.f;
#pragma unroll
        for (int r = 0; r < 16; ++r) { const float fr_ = __shfl(f, crow(r, hi)); const size_t ro = ((size_t)b * S + qb * 256 + 32 * w + crow(r, hi)) * 1024 + 512 + h * 64 + r32; ocat[ro] = f2bf(st.o0[r] * fr_); ocat[ro + 32] = f2bf(st.o1[r] * fr_); }
    }
}

__device__ __forceinline__ void nsa_unit(const Params& p, LAS unsigned char* lds, int b, int g, int jt) {
    int tid = threadIdx.x; asm volatile("" : "+v"(tid));
    const int lane = tid & 63, w = __builtin_amdgcn_readfirstlane(tid >> 6), r32 = lane & 31, hi = lane >> 5;
    const int rh = w >> 1, qh = w & 1, h = 4 * g + rh, q0 = 64 * jt, ql = 32 * qh + r32, tq = q0 + ql;
    const unsigned char* xa = p.ws + R_XA;
    const bf16_t* qn = (const bf16_t*)(xa + A_QN);
    const size_t bg = (size_t)b * 2 + g;
    const unsigned char* ksn = xa + A_KSN + bg * S * 128; const unsigned char* kwn = xa + A_KWN + bg * S * 128;
    const unsigned char* vst = xa + A_VST + bg * 64 * (size_t)S * 2; const unsigned char* vwt = xa + A_VWT + bg * 64 * (size_t)S * 2;
    const unsigned char* kc = p.ws + SM_KC + bg * 256 * 128; const unsigned char* vct = p.ws + SM_VCT + bg * 64 * 512;
    const float* gates = (const float*)(xa + A_GATES) + ((size_t)b * S + tq) * 24 + h * 3;
    bf16_t* ocat = (bf16_t*)(p.ws + R_XN);
    LAS float* imp = (LAS float*)(lds + AL_IMP); LAS unsigned char* selb = lds + AL_SELB; LAS unsigned* uni = (LAS unsigned*)(lds + AL_UNI); LAS unsigned char* tl = lds + AL_TL; LAS float* bls = (LAS float*)(lds + AL_BL);
    const float* blg = (const float*)(p.ws + SM_BL) + h * 132;
    const float cb = blg[128];
    const float bmax = wmax(fmaxf(fmaxf(blg[lane], blg[64 + lane]), cb));
    if (qh == 0) { bls[rh * 132 + lane] = blg[lane] - cb; bls[rh * 132 + 64 + lane] = blg[64 + lane] - cb; if (lane == 0) bls[rh * 132 + 128] = 0.f; }
    const LAS float* blh = bls + rh * 132;
    bf16x8 qf[4];
#pragma unroll
    for (int s = 0; s < 4; ++s) qf[s] = *(const bf16x8*)(qn + (((size_t)b * S + tq) * 8 + h) * 64 + 16 * s + 8 * hi);
    const float kn = 8.f * 1.01f * wmax(fmaxf(fmaxf(fabsf(p.in[5][lane]), fabsf(p.in[5][64 + lane])), fabsf(p.in[5][128 + lane])));
    const float mref = sqrtf(qnorm2<4>(qf)) * kn + bmax;
    f32x16 negm;
#pragma unroll
    for (int r = 0; r < 16; ++r) negm[r] = cb - mref;
    float g0 = gates[0], g1 = gates[1], g2 = gates[2];
    if (p.dbg_branch >= 0) { g0 = p.dbg_branch == 0 ? 1.f : 0.f; g1 = p.dbg_branch == 1 ? 1.f : 0.f; g2 = p.dbg_branch == 2 ? 1.f : 0.f; }
    LAS float* otl = (LAS float*)(lds + AL_OT) + w * 2048;
    const int nvmax = (q0 + 63 - 31) / 16 + 1, ntc = (nvmax + 63) / 64;
    Flash st; flash_init(st);
    run_tiles<128, 144, true>(ntc, lds, tid, 128, 512,
        [&](int i) { return kc + (size_t)i * 64 * 128; }, [&](int i) { return vct + (size_t)i * 128; },
        [&](int i, LAS unsigned char* kb, LAS unsigned char* vb) {
            f32x16 p0, p1; qk_tile<64, 144>(p0, p1, kb, qf, negm, r32, hi);
            const int cb0 = 64 * i + 4 * hi;
            softmax_pv<false>(st, p0, p1, vb, r32, hi, true, [&](int r, int half, float& x) {
                const int c = cb0 + 32 * half + (r & 3) + 8 * (r >> 2); const int dist = tq - 16 * c - 31; x += blh[dist < 0 ? 0 : (dist > 128 ? 128 : dist)]; return dist >= 0; });
        });
    flash_accum<true>(otl, st, g0, hi, lane);
    unsigned mlo, mhi;
    int nsel;
    if (jt < 16) { const unsigned long long mk = (1ull << (jt + 1)) - 1ull; mlo = (unsigned)mk; mhi = (unsigned)(mk >> 32); nsel = jt + 1; if (tid <= jt) tl[tid] = (unsigned char)tid; }
    else {
        for (int i = tid; i < 64 * 65; i += 512) imp[i] = 0.f;
        const float lt = st.l + __shfl_xor(st.l, 32); const float linv = lt > 0.f ? frcp(lt) : 0.f;
        float xlast = 0.f;
        run_tiles<128, 144, false>(ntc, lds, tid, 128, 0,
            [&](int i) { return kc + (size_t)i * 64 * 128; }, [&](int i) { return kc; },
            [&](int i, LAS unsigned char* kb, LAS unsigned char* vb) {
                f32x16 p0, p1; qk_tile<64, 144>(p0, p1, kb, qf, negm, r32, hi);
                const int cb0 = 64 * i + 4 * hi;
                float sm[2][4], cr[2][4];
#pragma unroll
                for (int half = 0; half < 2; ++half)
#pragma unroll
                    for (int a = 0; a < 4; ++a) {
                        float s4 = 0.f, last = 0.f;
#pragma unroll
                        for (int k = 0; k < 4; ++k) {
                            const int r = 4 * a + k; const int c = cb0 + 32 * half + k + 8 * a; const int dist = tq - 16 * c - 31;
                            const float sc = (half ? p1[r] : p0[r]) + blh[dist < 0 ? 0 : (dist > 128 ? 128 : dist)];
                            const float pv = dist >= 0 ? fexp2(sc) * linv : 0.f;
                            s4 += pv; last = pv;
                        }
                        sm[half][a] = s4; cr[half][a] = last;
                    }
                float tot[2][4];
#pragma unroll
                for (int half = 0; half < 2; ++half)
#pragma unroll
                    for (int a = 0; a < 4; ++a) {
                        const float xs_ = __shfl_xor(cr[half][a], 32);
                        const float xp_ = (a > 0) ? __shfl_xor(cr[half][a > 0 ? a - 1 : 0], 32) : (half ? __shfl_xor(cr[0][3], 32) : xlast);
                        tot[half][a] = sm[half][a] + (hi ? xs_ : xp_);
                    }
                xlast = __shfl_xor(cr[1][3], 32);
                for (int rr = 0; rr < 4; ++rr) {
                    if (rh == rr) {
#pragma unroll
                        for (int half = 0; half < 2; ++half)
#pragma unroll
                            for (int a = 0; a < 4; ++a) { const int j = 16 * i + 8 * half + 2 * a + hi; imp[ql * 65 + j] += tot[half][a]; }
                    }
                    __syncthreads();
                }
            });
        if (p.dbg_branch == 1) { for (int i = tid; i < 4096; i += 512) ((float*)(p.ws + R_H))[((size_t)g * S + q0 + (i >> 6)) * 64 + (i & 63)] = imp[(i >> 6) * 65 + (i & 63)]; }
        {
            const int q = tid >> 3, jg = tid & 7;
            unsigned byte = 0;
#pragma unroll 1
            for (int jj = 0; jj < 8; ++jj) {
                const int j = jg * 8 + jj;
                if (j <= jt) {
                    const float x = imp[q * 65 + j]; const float vj = (j == jt || j == 0) ? 1e9f : x;
                    int rank = 0;
#pragma unroll 8
                    for (int i = 0; i < 64; ++i) { const float xi = imp[q * 65 + i]; const float vi = (i > jt) ? -1.f : ((i == jt || i == 0) ? 1e9f : xi); rank += (vi > vj || (vi == vj && i < j)) ? 1 : 0; }
                    if (rank < 16) byte |= 1u << jj;
                }
            }
            selb[q * 8 + jg] = (unsigned char)byte;
        }
        __syncthreads();
        if (w == 0) {
            unsigned a = ((const LAS unsigned*)selb)[lane * 2], c = ((const LAS unsigned*)selb)[lane * 2 + 1];
#pragma unroll
            for (int o = 1; o < 64; o <<= 1) { a |= __shfl_xor(a, o); c |= __shfl_xor(c, o); }
            const unsigned long long um = ((unsigned long long)c << 32) | a;
            if ((um >> lane) & 1ull) tl[__builtin_popcountll(um & ((1ull << lane) - 1ull))] = (unsigned char)lane;
            if (lane == 0) uni[0] = (unsigned)__builtin_popcountll(um);
        }
        __syncthreads();
        mlo = ((const LAS unsigned*)selb)[ql * 2]; mhi = ((const LAS unsigned*)selb)[ql * 2 + 1];
        nsel = (int)uni[0];
    }
    if (p.dbg_branch == 1 && rh == 0) { if (hi == 0) ((unsigned long long*)(p.ws + R_H + 4 * 1048576))[(size_t)g * S + tq] = ((unsigned long long)mhi << 32) | mlo; }
    __syncthreads();
    {
        const unsigned long long mymask = ((unsigned long long)mhi << 32) | mlo;
        nsel = __builtin_amdgcn_readfirstlane(nsel);
        flash_init(st);
        run_tiles<128, 144, true>(nsel, lds, tid, 128, (size_t)S * 2,
            [&](int i) { return ksn + (size_t)tl[i] * 64 * 128; }, [&](int i) { return vst + (size_t)tl[i] * 128; },
            [&](int i, LAS unsigned char* kb, LAS unsigned char* vb) {
                const int j = __builtin_amdgcn_readfirstlane((int)tl[i]);
                f32x16 p0, p1; qk_tile<64, 144>(p0, p1, kb, qf, negm, r32, hi);
                const bool mine = (mymask >> j) & 1ull;
                if (q0 + 32 * qh - (64 * j + 63) >= 128) softmax_pv<true>(st, p0, p1, vb, r32, hi, mine, [&](int r, int half, float& x) { return true; });
                else { const int kb0 = 64 * j + 4 * hi;
                    softmax_pv<true>(st, p0, p1, vb, r32, hi, mine, [&](int r, int half, float& x) { const int dist = tq - (kb0 + 32 * half + (r & 3) + 8 * (r >> 2)); x += blh[dist < 0 ? 0 : (dist > 128 ? 128 : dist)]; return dist >= 0; }); }
            });
        flash_accum<false>(otl, st, g1, hi, lane);
    }
    {
        const int j0 = jt >= 8 ? jt - 8 : 0, nw = jt - j0 + 1;
        flash_init(st);
        run_tiles<128, 144, true>(nw, lds, tid, 128, (size_t)S * 2,
            [&](int i) { return kwn + (size_t)(j0 + i) * 64 * 128; }, [&](int i) { return vwt + (size_t)(j0 + i) * 128; },
            [&](int i, LAS unsigned char* kb, LAS unsigned char* vb) {
                f32x16 p0, p1; qk_tile<64, 144>(p0, p1, kb, qf, negm, r32, hi);
                const int kb0 = 64 * (j0 + i) + 4 * hi;
                softmax_pv<false>(st, p0, p1, vb, r32, hi, true, [&](int r, int half, float& x) { const int dist = tq - (kb0 + 32 * half + (r & 3) + 8 * (r >> 2)); x += blh[dist < 0 ? 0 : (dist > 128 ? 128 : dist)]; return dist >= 0 && dist < 512; });
            });
        flash_accum<false>(otl, st, g2, hi, lane);
    }
#pragma unroll
    for (int r = 0; r < 16; ++r) { const size_t ro = ((size_t)b * S + q0 + 32 * qh + crow(r, hi)) * 1024 + h * 64 + r32; ocat[ro] = f2bf(otl[r * 64 + lane]); ocat[ro + 32] = f2bf(otl[(16 + r) * 64 + lane]); }
    __syncthreads();
}

__device__ __forceinline__ void phase_p4(const Params& p, LAS unsigned char* lds) {
    const int G = gridDim.x, c = blockIdx.x, nunits = 256 * NB;
#if NB == 8
    if (G == 256) {
        const int b = c & 7, idx = c >> 3, pi = idx & 7, hq = idx >> 3;
#pragma unroll 1
        for (int u = 0; u < 8; ++u) {
            if (u < 4) nsa_unit(p, lds, b, u >> 1, (u & 1) ? idx : 63 - idx);
            else mla_unit(p, lds, b, ((u - 4) >> 1) * 4 + hq, (u & 1) ? pi : 15 - pi);
        }
        return;
    }
#endif
    for (int j = 0;; ++j) {
        const int k = j * G + ((j & 1) ? (G - 1 - c) : c);
        if (j * G >= nunits) break;
        if (k >= nunits) continue;
        const int ty = UNIT_TYPES[k / NB], b = k % NB, kind = ty >> 9, a = (ty >> 6) & 7, cc = ty & 63;
        if (kind == 0) nsa_unit(p, lds, b, a, cc); else mla_unit(p, lds, b, a, cc);
    }
}
__device__ __forceinline__ void phase_norm(const float* x, const float* g, bf16_t* xn) {
    const int tid_ = ltid(); const int lane = tid_ & 63, gw = blockIdx.x * 8 + (tid_ >> 6), NGW = gridDim.x * 8;
    for (int m = gw; m < T; m += NGW) rms_row_to_bf16(x + (size_t)m * D, g, xn + (size_t)m * D, lane);
}
__device__ __forceinline__ void phase_conv(const Params& p) {
    const int tid = ltid(), lane = tid & 63, gw = blockIdx.x * 8 + (tid >> 6), NGW = gridDim.x * 8;
    const bf16_t* hh = (const bf16_t*)(p.ws + R_H); bf16_t* v = (bf16_t*)(p.ws + R_XA); const float* cw = p.in[22];
    constexpr int RUN = 16;
    float w0[2][8], w1[2][8], w2[2][8];
#pragma unroll
    for (int j = 0; j < 2; ++j) { const int d = 8 * lane + 512 * j; load8f(cw + d, w0[j], 1.f); load8f(cw + 1024 + d, w1[j], 1.f); load8f(cw + 2048 + d, w2[j], 1.f); }
    for (int run = gw; run < T / RUN; run += NGW) {
        const int m0 = run * RUN, s0 = m0 & (S - 1);
        float pm2[2][8], pm1[2][8];
#pragma unroll
        for (int j = 0; j < 2; ++j) { const int d = 8 * lane + 512 * j;
#pragma unroll
            for (int q = 0; q < 2; ++q) {
                float (&dst)[8] = q ? pm1[j] : pm2[j];
                if (s0 - 2 + q >= 0) { const bf16_t* r = hh + (size_t)(m0 - 2 + q) * 3072; float c[8], u[8]; unpack8(*(const u32x4*)(r + 1024 + d), c); unpack8(*(const u32x4*)(r + 2048 + d), u);
#pragma unroll
                    for (int i = 0; i < 8; ++i) dst[i] = c[i] * u[i]; }
                else {
#pragma unroll
                    for (int i = 0; i < 8; ++i) dst[i] = 0.f; }
            } }
#pragma unroll 4
        for (int rr = 0; rr < RUN; ++rr) {
            const int m = m0 + rr; const bf16_t* r = hh + (size_t)m * 3072;
#pragma unroll
            for (int j = 0; j < 2; ++j) { const int d = 8 * lane + 512 * j;
                float b[8], c[8], u[8], y[8]; unpack8(*(const u32x4*)(r + d), b); unpack8(*(const u32x4*)(r + 1024 + d), c); unpack8(*(const u32x4*)(r + 2048 + d), u);
#pragma unroll
                for (int i = 0; i < 8; ++i) { const float cu = c[i] * u[i]; y[i] = b[i] * (w0[j][i] * pm2[j][i] + w1[j][i] * pm1[j][i] + w2[j][i] * cu); pm2[j][i] = pm1[j][i]; pm1[j][i] = cu; }
                *(u32x4*)(v + (size_t)m * 1024 + d) = pack8(y); }
        }
    }
}
__device__ __forceinline__ void phase_norm_router(const Params& p, LAS unsigned char* lds) {
    const int tid = ltid(), lane = tid & 63, wave = tid >> 6, gw = blockIdx.x * 8 + wave, NGW = gridDim.x * 8;
    const float* x3 = p.out; const float* g = p.in[24]; bf16_t* xn = (bf16_t*)(p.ws + R_XN);
    LAS float* wr = (LAS float*)lds;
    LAS int* lcnt = (LAS int*)(lds + 32768); LAS int* gb = lcnt + 8;
    int* te = (int*)(p.ws + SM_TE); float* tw = (float*)(p.ws + SM_TW); int* rank = (int*)(p.ws + SM_RANK); int* cnt = (int*)(p.ws + SM_CTL);
    for (int i = tid; i < 8192; i += 512) wr[i] = p.in[25][i];
    if (tid < 8) lcnt[tid] = 0;
    __syncthreads();
    for (int m = gw; m < T; m += NGW) {
        const f32x4* xr = (const f32x4*)(x3 + (size_t)m * D) + lane; const f32x4* gr = (const f32x4*)g + lane;
        f32x4 v[4]; float s = 0.f;
#pragma unroll
        for (int j = 0; j < 4; ++j) { v[j] = xr[64 * j]; s += (v[j].x * v[j].x + v[j].y * v[j].y) + (v[j].z * v[j].z + v[j].w * v[j].w); }
        const float r = rsqrtf(wsum(s) * (1.f / 1024.f) + EPS);
        float lg[8];
#pragma unroll
        for (int e = 0; e < 8; ++e) lg[e] = 0.f;
        u32x2* o8 = (u32x2*)(xn + (size_t)m * D) + lane;
#pragma unroll
        for (int j = 0; j < 4; ++j) { const f32x4 gg = gr[64 * j]; const f32x4 y = {v[j].x * r * gg.x, v[j].y * r * gg.y, v[j].z * r * gg.z, v[j].w * r * gg.w};
            u32x2 w; w.x = cvtpk(y.x, y.y); w.y = cvtpk(y.z, y.w); o8[64 * j] = w;
#pragma unroll
            for (int i = 0; i < 4; ++i) { const int d = 4 * lane + 256 * j + i; const f32x4 w0 = *(const LAS f32x4*)(wr + d * 8), w1 = *(const LAS f32x4*)(wr + d * 8 + 4);
                lg[0] += y[i] * w0.x; lg[1] += y[i] * w0.y; lg[2] += y[i] * w0.z; lg[3] += y[i] * w0.w; lg[4] += y[i] * w1.x; lg[5] += y[i] * w1.y; lg[6] += y[i] * w1.z; lg[7] += y[i] * w1.w; } }
#pragma unroll
        for (int e = 0; e < 8; ++e) lg[e] = wsum(lg[e]) + p.in[26][e];
        int e1 = 0; float l1 = lg[0];
#pragma unroll
        for (int e = 1; e < 8; ++e) if (lg[e] > l1) { l1 = lg[e]; e1 = e; }
        int e2 = -1; float l2 = -3e38f;
#pragma unroll
        for (int e = 0; e < 8; ++e) if (e != e1 && lg[e] > l2) { l2 = lg[e]; e2 = e; }
        if (lane == 0) {
            const float w1 = 1.f / (1.f + __expf(l2 - l1));
            te[m * 2] = e1; te[m * 2 + 1] = e2; tw[m * 2] = w1; tw[m * 2 + 1] = 1.f - w1;
            rank[m * 2] = __hip_atomic_fetch_add(&lcnt[e1], 1, __ATOMIC_RELAXED, __HIP_MEMORY_SCOPE_WORKGROUP); rank[m * 2 + 1] = __hip_atomic_fetch_add(&lcnt[e2], 1, __ATOMIC_RELAXED, __HIP_MEMORY_SCOPE_WORKGROUP);
        }
    }
    __syncthreads();
    if (tid < 8) gb[tid] = atomicAdd(&cnt[tid], lcnt[tid]);
    __syncthreads();
    for (int m = gw; m < T; m += NGW) if (lane < 2) rank[m * 2 + lane] += gb[te[m * 2 + lane]];
}
__device__ __forceinline__ void phase_moe_gather(const Params& p) {
    const int tid = ltid(), lane = tid & 63, gw = blockIdx.x * 8 + (tid >> 6), NGW = gridDim.x * 8;
    const int* cnt = (const int*)(p.ws + SM_CTL); const int* te = (const int*)(p.ws + SM_TE); const float* tw = (const float*)(p.ws + SM_TW); const int* rank = (const int*)(p.ws + SM_RANK);
    int* pos = (int*)(p.ws + SM_POS); float* roww = (float*)(p.ws + SM_ROWW); int* tile_e = (int*)(p.ws + SM_TILEE);
    int* rowtok = (int*)(p.ws + SM_ROWTOK);
    int off[9]; off[0] = 0;
#pragma unroll
    for (int e = 0; e < 8; ++e) off[e + 1] = off[e] + ((cnt[e] + 255) & ~255);
    if (blockIdx.x == 0) {
        for (int i = tid; i < ROWS_MAX / 256; i += 512) { int e = -1;
#pragma unroll
            for (int k = 0; k < 8; ++k) if (i * 256 >= off[k] && i * 256 < off[k + 1]) e = k;
            tile_e[i] = e < 0 ? 0 : e; }
        if (tid == 0) ((int*)(p.ws + SM_CTL))[8] = off[8];
    }
    if (blockIdx.x < 8 && tid < 256) {
#pragma unroll
        for (int e = 0; e < 8; ++e) if (e == (int)blockIdx.x) { const int c = cnt[e]; if (c + tid < off[e + 1] - off[e]) { roww[off[e] + c + tid] = 0.f; rowtok[off[e] + c + tid] = -1; } }
    }
    for (int pi0 = gw * 4; pi0 < 2 * T; pi0 += NGW * 4) {
        int r[4]; float w[4];
#pragma unroll
        for (int q = 0; q < 4; ++q) { const int e = te[pi0 + q]; int o = 0;
#pragma unroll
            for (int k = 0; k < 8; ++k) if (k == e) o = off[k];
            r[q] = o + rank[pi0 + q]; w[q] = tw[pi0 + q]; }
#pragma unroll
        for (int q = 0; q < 4; ++q) if (lane == q) { pos[pi0 + q] = r[q]; roww[r[q]] = w[q]; rowtok[r[q]] = (pi0 + q) >> 1; }
    }
}
__device__ __forceinline__ void phase_moe_combine(const Params& p) {
    const int tid_ = ltid(); const int lane = tid_ & 63, gw = blockIdx.x * 8 + (tid_ >> 6), NGW = gridDim.x * 8;
    const int* pos = (const int*)(p.ws + SM_POS); const bf16_t* ym = (const bf16_t*)(p.ws + R_XA);
    for (int m0 = gw * 2; m0 < T; m0 += NGW * 2) {
        int ps[4];
#pragma unroll
        for (int q = 0; q < 4; ++q) ps[q] = pos[m0 * 2 + q];
        f32x4 x[2][4]; u32x2 ya[2][4], yc[2][4];
#pragma unroll
        for (int q = 0; q < 2; ++q)
#pragma unroll
            for (int j = 0; j < 4; ++j) { const int d = 4 * lane + 256 * j;
                x[q][j] = *(const f32x4*)(p.out + (size_t)(m0 + q) * D + d); ya[q][j] = *(const u32x2*)(ym + (size_t)ps[2 * q] * D + d); yc[q][j] = *(const u32x2*)(ym + (size_t)ps[2 * q + 1] * D + d); }
#pragma unroll
        for (int q = 0; q < 2; ++q)
#pragma unroll
            for (int j = 0; j < 4; ++j) { const int d = 4 * lane + 256 * j; f32x4 o = x[q][j]; const u32x2 a = ya[q][j], c = yc[q][j];
                o.x += bflo(a.x) + bflo(c.x); o.y += bfhi(a.x) + bfhi(c.x); o.z += bflo(a.y) + bflo(c.y); o.w += bfhi(a.y) + bfhi(c.y);
                *(f32x4*)(p.out + (size_t)(m0 + q) * D + d) = o; }
    }
}

#define XB_TMO      128
#define XB_XCNT(j)  (256  + 64 * (j))
#define XB_XSUB(j)  (1280 + 64 * (j))
#define XB_XGEN(j)  (2304 + 64 * (j))
#define XB_TOP      3328
#define XB_TOPGEN   3392
#define XCD_BAR_WORDS 3456
#define XB_SPIN_CAP (1u << 18)

__device__ __forceinline__ unsigned xb_ld(unsigned* p)              { return __hip_atomic_load(p, __ATOMIC_RELAXED, __HIP_MEMORY_SCOPE_AGENT); }
__device__ __forceinline__ unsigned xb_add(unsigned* p, unsigned v) { return __hip_atomic_fetch_add(p, v, __ATOMIC_RELAXED, __HIP_MEMORY_SCOPE_AGENT); }
__device__ __forceinline__ unsigned xb_xcc_id() { return (unsigned)__builtin_amdgcn_s_getreg((3 << 11) | 20) & 0xFu; }
#define XB_SPIN(cond, bar) do { unsigned _sp = 0; while (cond) { __builtin_amdgcn_s_sleep(1); \
    if ((++_sp & 255u) == 0u) { if (xb_ld(&(bar)[XB_TMO])) break; if (_sp > XB_SPIN_CAP) { atomicAdd(&(bar)[XB_TMO], 1u); break; } } } } while (0)

struct XcdBarrier {
    unsigned* bar; unsigned x;
    volatile LAS unsigned* st;
};

__device__ __forceinline__ XcdBarrier xcd_barrier_post(unsigned* bar, volatile LAS unsigned* st) {
    XcdBarrier b; b.bar = bar; b.x = xb_xcc_id(); b.st = st;
    if (threadIdx.x == 0) (void)xb_add(&bar[XB_XCNT(b.x)], 1u);
    return b;
}
__device__ __forceinline__ void xcd_barrier_complete(unsigned* bar, unsigned x, unsigned& nloc, unsigned& nx) {
    const unsigned G = gridDim.x * gridDim.y * gridDim.z;
    unsigned sum, cnt, mine, sp = 0u;
    for (;;) {
        sum = 0u; cnt = 0u; mine = 0u;
#pragma unroll
        for (unsigned j = 0; j < 16; ++j) { const unsigned c = xb_ld(&bar[XB_XCNT(j)]); sum += c; cnt += (c > 0u) ? 1u : 0u; mine = (j == x) ? c : mine; }
        if (sum == G) break;
        __builtin_amdgcn_s_sleep(1);
        if ((++sp & 255u) == 0u) { if (xb_ld(&bar[XB_TMO])) break; if (sp > XB_SPIN_CAP) { atomicAdd(&bar[XB_TMO], 1u); break; } }
    }
    nloc = mine > 0u ? mine : 1u; nx = cnt > 0u ? cnt : 1u;
}

__device__ __forceinline__ void xcd_barrier(const XcdBarrier& b) {
    asm volatile("s_waitcnt vmcnt(0)" ::: "memory");
    __syncthreads();
    if (threadIdx.x == 0) {
        unsigned* bar = b.bar;
        __builtin_amdgcn_s_waitcnt(0);
        unsigned nloc = b.st[0], nx = b.st[1];
        if (nloc == 0u) { xcd_barrier_complete(bar, b.x, nloc, nx); b.st[0] = nloc; b.st[1] = nx; }
        const unsigned old = xb_add(&bar[XB_XSUB(b.x)], 1u);
        const unsigned gen = old / nloc;
        if (old + 1u == (gen + 1u) * nloc) {
            __builtin_amdgcn_fence(__ATOMIC_RELEASE, "agent");
            asm volatile("s_waitcnt vmcnt(0)" ::: "memory");
            const unsigned og = xb_add(&bar[XB_TOP], 1u);
            const unsigned tg = og / nx;
            if (og + 1u == (tg + 1u) * nx) xb_add(&bar[XB_TOPGEN], 1u);
            else XB_SPIN(xb_ld(&bar[XB_TOPGEN]) == tg, bar);
            __builtin_amdgcn_fence(__ATOMIC_ACQUIRE, "agent");
            xb_add(&bar[XB_XGEN(b.x)], 1u);
            asm volatile("s_waitcnt vmcnt(0)" ::: "memory");
        } else {
            XB_SPIN(xb_ld(&bar[XB_XGEN(b.x)]) == gen, bar);
            __builtin_amdgcn_fence(__ATOMIC_ACQUIRE, "agent");
            asm volatile("s_waitcnt vmcnt(0)" ::: "memory");
        }
    }
    __syncthreads();
}


__global__ void __launch_bounds__(512) mega_fwd(Params p) {
    extern __shared__ __attribute__((aligned(16))) unsigned char lds_raw[];
    LAS unsigned char* lds = (LAS unsigned char*)lds_raw;
    cg::grid_group grid = cg::this_grid();
    volatile LAS unsigned* bst = (volatile LAS unsigned*)(lds + 140032);
    if (threadIdx.x == 0) { bst[0] = 0u; bst[1] = 0u; const unsigned long long ba = (unsigned long long)(p.ws + SM_BAR); bst[2] = (unsigned)ba; bst[3] = (unsigned)(ba >> 32); }
    __syncthreads();
    (void)xcd_barrier_post((unsigned*)(p.ws + SM_BAR), bst);
#define GSYNC() do { XcdBarrier xb_; volatile LAS unsigned* st_ = (volatile LAS unsigned*)(lds + 140032); xb_.bar = (unsigned*)(((unsigned long long)st_[3] << 32) | st_[2]); xb_.x = xb_xcc_id(); xb_.st = st_; xcd_barrier(xb_); } while (0)
    const int G = gridDim.x, c = blockIdx.x;
#define LP() bf16_t* W = (bf16_t*)p.ws; bf16_t* xn = (bf16_t*)(p.ws + R_XN); float* x1 = (float*)(p.ws + R_XA); pg8::StaticOrder SO; (void)W; (void)xn; (void)x1; (void)SO
#ifndef PHMASK
#define PHMASK 0xFFFFFFFFu
#endif
#ifndef REPEAT_MASK
#define REPEAT_MASK 0u
#endif
#define PH(k) if (((PHMASK >> (k)) & 1u) && (k) >= p.ph_lo && (k) <= p.ph_hi)
#define RPT(k) if ((REPEAT_MASK >> (k)) & 1u)
    PH(0) { LP(); phase_p0(p, lds); }
    GSYNC();
    if (p.ph_lo == -12345) grid.sync();
    RPT(0) { { LP(); phase_p0(p, lds); } GSYNC(); }
    PH(1) { LP();
        pg8::Gemm g{xn, W + W_IN_E / 2, T, 1792, 1024, 1024, nullptr, 0, nullptr}; SO.init(T, 1792, G, c);
        pg8::EpiBf16<0> E{(bf16_t*)(p.ws + R_H), 1792, nullptr, nullptr};
        pg8::gemm_phase<pg8::EpiBf16<0>, true>(lds, g, SO, E);
    }
    GSYNC();
    PH(2) { LP(); phase_p2(p, lds); }
    GSYNC();
    RPT(2) { { LP(); phase_p2(p, lds); } GSYNC(); }
    PH(3) { LP();
        const int nCu = 2 * (NB * 512 / 256), Gc = (nCu < G / 2) ? nCu : 0;
        if (Gc == 0 || c < Gc) {
            for (int kv = 0; kv < 2; ++kv) {
                pg8::Gemm g{(const bf16_t*)(p.ws + R_XA + (kv ? A_VCIN : A_KCIN)), W + W_CW1 / 2 + (size_t)kv * 256 * 2048, NB * 512, 256, 2048, 1024, nullptr, 0, nullptr};
                if (Gc) SO.init(NB * 512, 256, Gc / 2, c - kv * (Gc / 2)); else SO.init(NB * 512, 256, G, c);
                pg8::EpiBf16<2> E{(bf16_t*)(p.ws + SM_HID) + (size_t)kv * NB * 512 * 256, 256, (const float*)(p.ws + SM_B1) + kv * 256, nullptr};
                if (Gc == 0 || (c / (Gc / 2)) == kv) pg8::gemm_phase<pg8::EpiBf16<2>, true>(lds, g, SO, E);
            }
        }
        if (Gc == 0 || c >= Gc) {
            {
                pg8::Gemm g{(const bf16_t*)(p.ws + R_XA + A_CQN), W + W_UQ / 2, T, 1024, 256, 256, nullptr, 0, nullptr}; SO.init(T, 1024, G - Gc, c - Gc);
                pg8::EpiBf16<0> E{(bf16_t*)(p.ws + R_H), 1024, nullptr, nullptr};
                pg8::gemm_phase<pg8::EpiBf16<0>, true>(lds, g, SO, E);
            }
            {
                pg8::Gemm g{(const bf16_t*)(p.ws + R_XA + A_CKVN), W + W_UKV / 2, T, 1024, 128, 128, nullptr, 0, nullptr}; SO.init(T, 1024, G - Gc, c - Gc);
                pg8::EpiBf16<0> E{(bf16_t*)(p.ws + R_H + (size_t)T * 2048), 1024, nullptr, nullptr};
                pg8::gemm_phase<pg8::EpiBf16<0>, true>(lds, g, SO, E);
            }
        }
    }
    GSYNC();
    PH(4) { LP(); phase_p3b(p, lds); }
    GSYNC();
    RPT(4) { { LP(); phase_p3b(p, lds); } GSYNC(); }
    PH(5) { LP(); phase_p4(p, lds); }
    GSYNC();
    RPT(5) { { LP(); phase_p4(p, lds); } GSYNC(); }
    PH(6) { LP();
        pg8::Gemm g{xn, W + W_OUT_E / 2, T, 1024, 1024, 1024, nullptr, 0, nullptr}; SO.init(T, 1024, G, c);
        pg8::EpiResStat<false> E{p.in[0], (bf16_t*)p.out, (float*)(p.ws + SM_SSP1), 1024};
        pg8::gemm_phase<pg8::EpiResStat<false>, true>(lds, g, SO, E);
    }
    GSYNC();
    PH(7) { }
    PH(8) { LP();
        pg8::Gemm g{(const bf16_t*)p.out, W + W_GU / 2, T, 5632, 1024, 1024, nullptr, 0, nullptr}; SO.init(T, 5632, G, c);
        pg8::EpiSwiGLU E{(bf16_t*)(p.ws + R_H), 2816, (const float*)(p.ws + SM_SSP1)};
        pg8::gemm_phase<pg8::EpiSwiGLU, true>(lds, g, SO, E);
    }
    GSYNC();
    PH(9) { LP();
        pg8::Gemm g{(const bf16_t*)(p.ws + R_H), W + W_D / 2, T, 1024, 2816, 2816, nullptr, 0, nullptr}; SO.init(T, 1024, G, c);
        pg8::EpiResStat<true> E{(const bf16_t*)p.out, xn, (float*)(p.ws + SM_SSP2), 1024};
        pg8::gemm_phase<pg8::EpiResStat<true>, true>(lds, g, SO, E);
    }
    GSYNC();
    PH(10) { }
    PH(11) { LP();
        pg8::Gemm g{xn, W + W_IN_O / 2, T, 3072, 1024, 1024, nullptr, 0, nullptr}; SO.init(T, 3072, G, c);
        pg8::EpiBf16<0> E{(bf16_t*)(p.ws + R_H), 3072, nullptr, (const float*)(p.ws + SM_SSP2)};
        pg8::gemm_phase<pg8::EpiBf16<0>, true>(lds, g, SO, E);
    }
    GSYNC();
    PH(12) { LP(); phase_conv(p); }
    GSYNC();
    RPT(12) { { LP(); phase_conv(p); } GSYNC(); }
    PH(13) { LP();
        pg8::Gemm g{(const bf16_t*)x1, W + W_OUT_O / 2, T, 1024, 1024, 1024, nullptr, 0, nullptr}; SO.init(T, 1024, G, c);
        pg8::EpiResF32B E{xn, p.out, 1024};
        pg8::gemm_phase<pg8::EpiResF32B, true>(lds, g, SO, E);
    }
    GSYNC();
    PH(14) { LP(); phase_norm_router(p, lds); }
    GSYNC();
    PH(15) { LP(); phase_moe_gather(p); }
    GSYNC();
    PH(16) { LP(); const int mrows = ((const int*)(p.ws + SM_CTL))[8];
        pg8::Gemm g{xn, W + W_MGU / 2, mrows, 2816, 1024, 1024, (const int*)(p.ws + SM_TILEE), (size_t)2816 * 1024, (const int*)(p.ws + SM_ROWTOK)}; SO.init(mrows, 2816, G, c);
        pg8::EpiSwiGLU E{(bf16_t*)(p.ws + R_H), 1408, nullptr};
        pg8::gemm_phase<pg8::EpiSwiGLU, true, true>(lds, g, SO, E);
    }
    GSYNC();
    PH(17) { LP(); const int mrows = ((const int*)(p.ws + SM_CTL))[8];
        pg8::Gemm g{(const bf16_t*)(p.ws + R_H), W + W_MD / 2, mrows, 1024, 1408, 1408, (const int*)(p.ws + SM_TILEE), (size_t)1024 * 1408, nullptr}; SO.init(mrows, 1024, G, c);
        pg8::EpiRowScaleBf16 E{(bf16_t*)(p.ws + R_XA), 1024, (const float*)(p.ws + SM_ROWW)};
        pg8::gemm_phase<pg8::EpiRowScaleBf16, true>(lds, g, SO, E);
    }
    GSYNC();
    PH(18) { LP(); phase_moe_combine(p); }
#undef PH
}

inline void launch(void* const* d_in, float* d_out, void* d_ws, size_t ws_size, hipStream_t stream, int ph_lo = 0, int ph_hi = 99, int dbg_branch = -1) {
    static int grid = 0;
    if (grid == 0) {
        int dev = 0, cus = 0, per_cu = 0;
        hipGetDevice(&dev); hipDeviceGetAttribute(&cus, hipDeviceAttributeMultiprocessorCount, dev);
        hipFuncSetAttribute((const void*)mega_fwd, hipFuncAttributeMaxDynamicSharedMemorySize, LDS_BYTES);
        hipOccupancyMaxActiveBlocksPerMultiprocessor(&per_cu, (const void*)mega_fwd, 512, LDS_BYTES);
        if (per_cu < 1) { fprintf(stderr, "occupancy query says %d blocks/CU\n", per_cu); per_cu = 1; }
        grid = cus;
        if (WS_FAST_END > ws_size) { fprintf(stderr, "ws too small: need %zu have %zu\n", (size_t)WS_FAST_END, ws_size); grid = -1; }
    }
    if (grid < 0) return;
    if (ph_lo <= 14 && ph_hi >= 14) hipMemsetAsync((char*)d_ws + SM_CTL, 0, 4096, stream);
    hipMemsetAsync((char*)d_ws + SM_BAR, 0, 16384, stream);
    Params p{};
    for (int i = 0; i < 30; ++i) p.in[i] = (const float*)d_in[i];
    p.out = d_out; p.ws = (unsigned char*)d_ws; p.ph_lo = ph_lo; p.ph_hi = ph_hi; p.dbg_branch = dbg_branch;
    void* args[] = {&p};
    hipError_t e = hipLaunchCooperativeKernel((const void*)mega_fwd, dim3(grid), dim3(512), args, LDS_BYTES, stream);
    if (e != hipSuccess) fprintf(stderr, "cooperative launch failed: %s (grid %d)\n", hipGetErrorString(e), grid);
}
}
extern "C" void kernel_launch(void* const* d_in, const int* in_sizes, int n_in, void* d_out, int out_size, void* d_ws, size_t ws_size, hipStream_t stream) {
    fast::launch(d_in, (float*)d_out, d_ws, ws_size, stream);
}
```

```cpp
#include <hip/hip_runtime.h>
#include <hip/hip_bf16.h>
#include <stdint.h>
#include <stdio.h>
#include <string.h>
#include <hip/hip_cooperative_groups.h>
namespace cg = cooperative_groups;
#define NB 8
#define REPEAT_MASK 0x0u
namespace gold {
constexpr int S = 4096, D = 1024, HW = 1720;
constexpr float EPS = 1e-6f;

__device__ const unsigned char T5B[128] = {0, 1, 2, 3, 4, 5, 6, 7, 8, 9, 10, 11, 12, 13, 14, 15, 16, 16, 16, 17, 17, 18, 18, 18, 19, 19, 19, 20, 20, 20, 20, 21, 21, 21, 21, 22, 22, 22, 22, 22, 23, 23, 23, 23, 23, 23, 24, 24, 24, 24, 24, 24, 25, 25, 25, 25, 25, 25, 25, 26, 26, 26, 26, 26, 26, 26, 26, 27, 27, 27, 27, 27, 27, 27, 27, 27, 27, 28, 28, 28, 28, 28, 28, 28, 28, 28, 28, 29, 29, 29, 29, 29, 29, 29, 29, 29, 29, 29, 29, 30, 30, 30, 30, 30, 30, 30, 30, 30, 30, 30, 30, 30, 30, 31, 31, 31, 31, 31, 31, 31, 31, 31, 31, 31, 31, 31, 31};
}
#ifndef NB
#define NB 8
#endif
namespace fast {
#define LAS __attribute__((address_space(3)))
typedef unsigned short bf16_t;
typedef short bf16x8 __attribute__((ext_vector_type(8)));
typedef float f32x4 __attribute__((ext_vector_type(4)));
typedef float f32x2 __attribute__((ext_vector_type(2)));
typedef float f32x16 __attribute__((ext_vector_type(16)));
typedef unsigned u32x4 __attribute__((ext_vector_type(4)));
typedef unsigned u32x2 __attribute__((ext_vector_type(2)));
typedef __bf16 bf16x2_t __attribute__((ext_vector_type(2)));

constexpr int S = 4096, T = NB * S, D = 1024;
constexpr float EPS = 1e-6f, LOG2E = 1.4426950408889634f;

__device__ __forceinline__ unsigned cvtpk(float lo, float hi) { f32x2 v = {lo, hi}; bf16x2_t b = __builtin_convertvector(v, bf16x2_t); return __builtin_bit_cast(unsigned, b); }
__device__ __forceinline__ bf16_t f2bf(float f) { return (bf16_t)(cvtpk(f, 0.f) & 0xffffu); }
__device__ __forceinline__ float bf2f(bf16_t u) { return __builtin_bit_cast(float, (unsigned)u << 16); }
__device__ __forceinline__ float bflo(unsigned u) { return __builtin_bit_cast(float, u << 16); }
__device__ __forceinline__ float bfhi(unsigned u) { return __builtin_bit_cast(float, u & 0xffff0000u); }
__device__ __forceinline__ float wsum(float v) {
#pragma unroll
    for (int o = 1; o < 64; o <<= 1) v += __shfl_xor(v, o);
    return v;
}
__device__ __forceinline__ float fexp2(float x) { return __builtin_amdgcn_exp2f(x); }
__device__ __forceinline__ float frcp(float x) { return __builtin_amdgcn_rcpf(x); }
__device__ __forceinline__ float silu_f(float x) { return x * frcp(1.f + fexp2(-x * LOG2E)); }
__device__ __forceinline__ float gelu_tanh_f(float x) {
    const float u = 0.7978845608028654f * (x + 0.044715f * x * x * x);
    return x * frcp(1.f + fexp2(-2.f * LOG2E * u));
}

namespace pg8 {
constexpr int BM = 256, BK = 64, HALF = 128, HTB = HALF * BK * 2, STAGE_BYTES = 8 * HTB, NXCD = 8, WGM = 8;
__host__ __device__ __forceinline__ int lds_byte(int r, int c) { const int st = (r >> 4) * 2 + (c >> 5), rr = r & 15, cc = c & 31, ob = rr * 64 + cc * 2; return st * 1024 + (ob ^ (((ob >> 9) & 1) << 5)); }
__host__ __device__ __forceinline__ void stage_rc(int b, int& R, int& C) { const int st = b / 1024, sb = b % 1024, swz = sb ^ (((sb >> 9) & 1) << 5); R = (st >> 1) * 16 + swz / 64; C = (st & 1) * 32 + (swz % 64) / 2; }
__host__ __device__ __forceinline__ int perm32(int rho) { const int n = rho >> 4, i = rho & 15; return 8 * (i >> 2) + 4 * n + (i & 3); }

struct Unit { int pm, pn; };
struct Gemm { const bf16_t* A; const bf16_t* Bt; int M, N, K, lda; const int* tile_e; size_t estride; const int* rowidx; };

struct StaticOrder {
    int nM, nN, nwg, G, c;
    __device__ void init(int M, int N, int G_, int c_) { nM = M / BM; nN = N / BM; nwg = nM * nN; G = G_; c = c_; }
    __device__ bool next(int i, Unit& u) const {
        const long L = (long)i * G + c; if (L >= nwg) return false;
        int wgid = (int)L; { const int q = nwg / NXCD, r = nwg % NXCD, xcd = wgid % NXCD, off = wgid / NXCD; wgid = (xcd < r ? xcd * (q + 1) : r * (q + 1) + (xcd - r) * q) + off; }
        const int nig = WGM * nN, gid = wgid / nig, fm = gid * WGM, gsz = (nM - fm) < WGM ? (nM - fm) : WGM;
        u.pm = fm + ((wgid % nig) % gsz); u.pn = (wgid % nig) / gsz; return true;
    }
};

template <class Epi, bool ALIGN_EPI, bool GATHER = false>
__device__ __forceinline__ void gemm_phase(LAS unsigned char* lds, const Gemm g, const StaticOrder& S, const Epi& E) {
    int tid = threadIdx.x; asm volatile("" : "+v"(tid));
    const int wid = __builtin_amdgcn_readfirstlane(tid >> 6), lane = tid & 63, wr = wid >> 2, wc = wid & 3, fr = lane & 15, fq = lane >> 4;
    const int K = g.K, nt = K / BK, lda = g.lda;
    unsigned voffA[2], voffB[2];
#pragma unroll
    for (int i = 0; i < 2; ++i) { int R, C; stage_rc(tid * 16 + i * 8192, R, C); const int Rb = Epi::PERM ? ((R & ~31) + perm32(R & 31)) : R;
        voffA[i] = (unsigned)(R * lda + C) * 2u; voffB[i] = (unsigned)(Rb * K + C) * 2u; }
    const size_t kstep = (size_t)(BK * 2);
    const size_t hsA = GATHER ? 0 : (size_t)HALF * lda * 2, tsA = 2 * hsA, hsB = (size_t)HALF * K * 2, tsB = 2 * hsB;
    unsigned vgc[2][2], vgn[2][2];
#define PG8_GOFF(pm_, vg) do { _Pragma("unroll") for (int h_ = 0; h_ < 2; ++h_) _Pragma("unroll") for (int i_ = 0; i_ < 2; ++i_) { int R_, C_; stage_rc(tid * 16 + i_ * 8192, R_, C_); \
        int tok_ = g.rowidx[(pm_) * BM + h_ * HALF + R_]; tok_ = tok_ < 0 ? 0 : tok_; vg[h_][i_] = (unsigned)(tok_ * lda + C_) * 2u; } } while (0)
#define PG8_STAGE_A(bufoff, gbase, h, nx) do { unsigned va_[2]; _Pragma("unroll") for (int i_ = 0; i_ < 2; ++i_) va_[i_] = GATHER ? ((nx) ? vgn[h][i_] : vgc[h][i_]) : voffA[i_]; PG8_STAGE(bufoff, gbase, va_); } while (0)
    const unsigned ldsw = (unsigned)wid * 1024u;
    const int aoff = lds_byte(wr * 64 + fr, fq * 8), boff = lds_byte(wc * 32 + fr, fq * 8);
#define PG8_SA(b, h) (((b) * 2 + (h)) * HTB)
#define PG8_SB(b, h) ((4 + (b) * 2 + (h)) * HTB)
#define PG8_STAGE(bufoff, gbase, voff) do { _Pragma("unroll") for (int _i = 0; _i < 2; ++_i) \
        __builtin_amdgcn_global_load_lds((const unsigned*)((const char*)(gbase) + (voff)[_i]), (LAS unsigned*)(lds + (bufoff) + ldsw + _i * 8192), 16, 0, 0); } while (0)
#define PG8_LDA(dst, b, h) do { _Pragma("unroll") for (int m = 0; m < 4; ++m) _Pragma("unroll") for (int k = 0; k < 2; ++k) dst[m][k] = *(const LAS bf16x8*)(lds + PG8_SA(b, h) + aoff + m * 2048 + k * 1024); } while (0)
#define PG8_LDB(dst, b, h) do { _Pragma("unroll") for (int n = 0; n < 2; ++n) _Pragma("unroll") for (int k = 0; k < 2; ++k) dst[n][k] = *(const LAS bf16x8*)(lds + PG8_SB(b, h) + boff + n * 2048 + k * 1024); } while (0)
#define PG8_MMA(ai, bj, At, Bt) do { __builtin_amdgcn_s_setprio(1); _Pragma("unroll") for (int m = 0; m < 4; ++m) _Pragma("unroll") for (int n = 0; n < 2; ++n) _Pragma("unroll") for (int k = 0; k < 2; ++k) \
        acc[ai][bj][m][n] = __builtin_amdgcn_mfma_f32_16x16x32_bf16(Bt[n][k], At[m][k], acc[ai][bj][m][n], 0, 0, 0); __builtin_amdgcn_s_setprio(0); } while (0)
#define PG8_WAIT_V(n) asm volatile("s_waitcnt vmcnt(" #n ")" ::: "memory")
#define PG8_WAIT_L(n) asm volatile("s_waitcnt lgkmcnt(" #n ")" ::: "memory")
#define PG8_BAR __builtin_amdgcn_s_barrier()
#define PG8_SCHED __builtin_amdgcn_sched_barrier(0)
#define PG8_EOFF(pm_) (g.tile_e ? (size_t)g.tile_e[pm_] * g.estride * 2 : (size_t)0)
    Unit cur, nxt; int ui = 0;
    if (!S.next(0, cur)) return;
    f32x4 acc[2][2][4][2];
#pragma unroll
    for (int a = 0; a < 2; ++a)
#pragma unroll
        for (int b = 0; b < 2; ++b)
#pragma unroll
            for (int m = 0; m < 4; ++m)
#pragma unroll
                for (int n = 0; n < 2; ++n) acc[a][b][m][n] = (f32x4){0.f, 0.f, 0.f, 0.f};
    bf16x8 At[4][2], B0[2][2], B1[2][2];
    const char* cA = (const char*)g.A + (size_t)cur.pm * tsA; const char* cB = (const char*)g.Bt + PG8_EOFF(cur.pm) + (size_t)cur.pn * tsB;
    if constexpr (GATHER) PG8_GOFF(cur.pm, vgc);
    PG8_STAGE(PG8_SB(0, 0), cB, voffB); PG8_STAGE(PG8_SB(0, 1), cB + hsB, voffB); PG8_STAGE_A(PG8_SA(0, 0), cA, 0, false); PG8_STAGE_A(PG8_SA(0, 1), cA + hsA, 1, false);
    if (wr == 1) PG8_BAR;
    PG8_WAIT_V(2); PG8_BAR;
    PG8_STAGE(PG8_SB(1, 0), cB + kstep, voffB); PG8_STAGE_A(PG8_SA(1, 0), cA + kstep, 0, false); PG8_STAGE(PG8_SB(1, 1), cB + hsB + kstep, voffB);
    PG8_WAIT_V(6); PG8_BAR;
    for (;;) {
        const bool has_next = S.next(ui + 1, nxt);
        if constexpr (GATHER) { if (has_next) PG8_GOFF(nxt.pm, vgn); else { vgn[0][0] = vgc[0][0]; vgn[0][1] = vgc[0][1]; vgn[1][0] = vgc[1][0]; vgn[1][1] = vgc[1][1]; } }
        const char* nA = has_next ? (const char*)g.A + (size_t)nxt.pm * tsA : cA;
        const char* nB = has_next ? (const char*)g.Bt + PG8_EOFF(nxt.pm) + (size_t)nxt.pn * tsB : cB;
        for (int t = 0; t < nt; t += 2) {
            const bool last = (t == nt - 2);
            const char* a1 = cA + (size_t)(t + 1) * kstep;
            const char* a2 = last ? nA : cA + (size_t)(t + 2) * kstep; const char* b2 = last ? nB : cB + (size_t)(t + 2) * kstep;
            const char* a3 = a2 + kstep; const char* b3 = b2 + kstep;
            PG8_LDB(B0, 0, 0); PG8_LDB(B1, 0, 1); PG8_SCHED; PG8_LDA(At, 0, 0); PG8_STAGE_A(PG8_SA(1, 1), a1 + hsA, 1, false);
            PG8_WAIT_V(8); PG8_WAIT_L(0); PG8_BAR; PG8_MMA(0, 0, At, B0); PG8_MMA(0, 1, At, B1); PG8_BAR; PG8_SCHED;
            PG8_LDA(At, 0, 1); PG8_STAGE(PG8_SB(0, 0), b2, voffB); PG8_STAGE(PG8_SB(0, 1), b2 + hsB, voffB); PG8_STAGE_A(PG8_SA(0, 0), a2, 0, last);
            PG8_WAIT_V(8); PG8_WAIT_L(0); PG8_BAR; PG8_MMA(1, 0, At, B0); PG8_MMA(1, 1, At, B1); PG8_BAR; PG8_SCHED;
            PG8_LDB(B0, 1, 0); PG8_LDB(B1, 1, 1); PG8_SCHED; PG8_LDA(At, 1, 0); PG8_STAGE_A(PG8_SA(0, 1), a2 + hsA, 1, last);
            PG8_WAIT_V(8); PG8_WAIT_L(0); PG8_BAR; PG8_MMA(0, 0, At, B0); PG8_MMA(0, 1, At, B1); PG8_BAR; PG8_SCHED;
            PG8_LDA(At, 1, 1); PG8_STAGE(PG8_SB(1, 0), b3, voffB); PG8_STAGE(PG8_SB(1, 1), b3 + hsB, voffB); PG8_STAGE_A(PG8_SA(1, 0), a3, 0, last);
            PG8_WAIT_V(8); PG8_WAIT_L(0); PG8_BAR; PG8_MMA(1, 0, At, B0); PG8_MMA(1, 1, At, B1); PG8_BAR; PG8_SCHED;
        }
        if constexpr (ALIGN_EPI) { if (wr == 0) PG8_BAR; }
        E(acc, cur, wr, wc, fr, fq);
        if (!has_next) break;
#pragma unroll
        for (int a = 0; a < 2; ++a)
#pragma unroll
            for (int b = 0; b < 2; ++b)
#pragma unroll
                for (int m = 0; m < 4; ++m)
#pragma unroll
                    for (int n = 0; n < 2; ++n) acc[a][b][m][n] = (f32x4){0.f, 0.f, 0.f, 0.f};
        cur = nxt; cA = nA; cB = nB; ++ui;
        if constexpr (GATHER) { vgc[0][0] = vgn[0][0]; vgc[0][1] = vgn[0][1]; vgc[1][0] = vgn[1][0]; vgc[1][1] = vgn[1][1]; }
        if constexpr (ALIGN_EPI) { if (wr == 1) PG8_BAR; }
    }
    PG8_WAIT_V(0);
    if constexpr (!ALIGN_EPI) { if (wr == 0) PG8_BAR; }
    PG8_BAR;
#undef PG8_SA
#undef PG8_SB
#undef PG8_STAGE
#undef PG8_LDA
#undef PG8_LDB
#undef PG8_MMA
#undef PG8_WAIT_V
#undef PG8_WAIT_L
#undef PG8_BAR
#undef PG8_SCHED
#undef PG8_EOFF
#undef PG8_GOFF
#undef PG8_STAGE_A
}

__device__ __forceinline__ float row_rstd(const float* ssp, int row);
template <int ACT> struct EpiBf16 {
    static constexpr bool PERM = true;
    bf16_t* O; int ldc; const float* bias; const float* ssp;
    __device__ __forceinline__ void operator()(const f32x4 (&acc)[2][2][4][2], const Unit& u, int wr, int wc, int fr, int fq) const {
        const int row0 = u.pm * BM + wr * 64 + fr, col0 = u.pn * BM + wc * 32 + 8 * fq;
        f32x4 bv[2][2];
#pragma unroll
        for (int bj = 0; bj < 2; ++bj)
#pragma unroll
            for (int n = 0; n < 2; ++n) bv[bj][n] = bias ? *(const f32x4*)(bias + col0 + bj * HALF + 4 * n) : (f32x4){0.f, 0.f, 0.f, 0.f};
#pragma unroll
        for (int ai = 0; ai < 2; ++ai)
#pragma unroll
            for (int m = 0; m < 4; ++m) { bf16_t* rowp = O + (size_t)(row0 + ai * HALF + m * 16) * ldc + col0;
                const float rs = (ACT == 0 && ssp) ? row_rstd(ssp, row0 + ai * HALF + m * 16) : 1.f;
#pragma unroll
                for (int bj = 0; bj < 2; ++bj) { f32x4 v0 = acc[ai][bj][m][0] * rs + bv[bj][0], v1 = acc[ai][bj][m][1] * rs + bv[bj][1];
                    if (ACT == 2) {
#pragma unroll
                        for (int i = 0; i < 4; ++i) { v0[i] = gelu_tanh_f(v0[i]); v1[i] = gelu_tanh_f(v1[i]); } }
                    u32x4 w; w.x = cvtpk(v0[0], v0[1]); w.y = cvtpk(v0[2], v0[3]); w.z = cvtpk(v1[0], v1[1]); w.w = cvtpk(v1[2], v1[3]);
                    *(u32x4*)(rowp + bj * HALF) = w; } }
    }
};
struct EpiResF32 {
    static constexpr bool PERM = false;
    const float* base; float* out; int ldc;
    __device__ __forceinline__ void operator()(const f32x4 (&acc)[2][2][4][2], const Unit& u, int wr, int wc, int fr, int fq) const {
        const int col0 = u.pn * BM + wc * 32 + 4 * fq;
#pragma unroll
        for (int ai = 0; ai < 2; ++ai)
#pragma unroll
            for (int m = 0; m < 4; ++m) { const size_t off = (size_t)(u.pm * BM + ai * HALF + wr * 64 + m * 16 + fr) * ldc + col0;
#pragma unroll
                for (int bj = 0; bj < 2; ++bj)
#pragma unroll
                    for (int n = 0; n < 2; ++n) { const f32x4 bs = *(const f32x4*)(base + off + bj * HALF + n * 16); *(f32x4*)(out + off + bj * HALF + n * 16) = bs + acc[ai][bj][m][n]; } }
    }
};
template <bool BASE_BF16> struct EpiResStat {
    static constexpr bool PERM = false;
    const void* base; bf16_t* xb; float* ssp; int ldc;
    __device__ __forceinline__ void operator()(const f32x4 (&acc)[2][2][4][2], const Unit& u, int wr, int wc, int fr, int fq) const {
        const int col0 = u.pn * BM + wc * 32 + 4 * fq;
#pragma unroll
        for (int ai = 0; ai < 2; ++ai)
#pragma unroll
            for (int m = 0; m < 4; ++m) { const int row = u.pm * BM + ai * HALF + wr * 64 + m * 16 + fr; const size_t off = (size_t)row * ldc + col0; float ss = 0.f;
#pragma unroll
                for (int bj = 0; bj < 2; ++bj)
#pragma unroll
                    for (int n = 0; n < 2; ++n) { f32x4 bs;
                        if (BASE_BF16) { const u32x2 t = *(const u32x2*)((const bf16_t*)base + off + bj * HALF + n * 16); bs = (f32x4){bflo(t.x), bfhi(t.x), bflo(t.y), bfhi(t.y)}; }
                        else bs = *(const f32x4*)((const float*)base + off + bj * HALF + n * 16);
                        const f32x4 v = bs + acc[ai][bj][m][n];
                        u32x2 w; w.x = cvtpk(v.x, v.y); w.y = cvtpk(v.z, v.w); *(u32x2*)(xb + off + bj * HALF + n * 16) = w; ss += (v.x * v.x + v.y * v.y) + (v.z * v.z + v.w * v.w); }
                ss += __shfl_xor(ss, 16); ss += __shfl_xor(ss, 32);
                if (fq == 0) ssp[(size_t)row * 16 + u.pn * 4 + wc] = ss; }
    }
};
struct EpiResF32B {
    static constexpr bool PERM = false;
    const bf16_t* base; float* out; int ldc;
    __device__ __forceinline__ void operator()(const f32x4 (&acc)[2][2][4][2], const Unit& u, int wr, int wc, int fr, int fq) const {
        const int col0 = u.pn * BM + wc * 32 + 4 * fq;
#pragma unroll
        for (int ai = 0; ai < 2; ++ai)
#pragma unroll
            for (int m = 0; m < 4; ++m) { const size_t off = (size_t)(u.pm * BM + ai * HALF + wr * 64 + m * 16 + fr) * ldc + col0;
#pragma unroll
                for (int bj = 0; bj < 2; ++bj)
#pragma unroll
                    for (int n = 0; n < 2; ++n) { const u32x2 t = *(const u32x2*)(base + off + bj * HALF + n * 16); const f32x4 bs = {bflo(t.x), bfhi(t.x), bflo(t.y), bfhi(t.y)};
                        *(f32x4*)(out + off + bj * HALF + n * 16) = bs + acc[ai][bj][m][n]; } }
    }
};
__device__ __forceinline__ float row_rstd(const float* ssp, int row) {
    const f32x4* q = (const f32x4*)(ssp + (size_t)row * 16); const f32x4 a = q[0], b = q[1], c = q[2], d = q[3];
    const float s = ((a.x + a.y) + (a.z + a.w)) + ((b.x + b.y) + (b.z + b.w)) + ((c.x + c.y) + (c.z + c.w)) + ((d.x + d.y) + (d.z + d.w));
    return rsqrtf(s * (1.f / 1024.f) + EPS);
}
struct EpiSwiGLU {
    static constexpr bool PERM = true;
    bf16_t* O; int ldc; const float* ssp;
    __device__ __forceinline__ void operator()(const f32x4 (&acc)[2][2][4][2], const Unit& u, int wr, int wc, int fr, int fq) const {
        const int row0 = u.pm * BM + wr * 64 + fr, col0 = u.pn * HALF + wc * 32 + 8 * fq;
#pragma unroll
        for (int ai = 0; ai < 2; ++ai)
#pragma unroll
            for (int m = 0; m < 4; ++m) { bf16_t* rowp = O + (size_t)(row0 + ai * HALF + m * 16) * ldc + col0;
                const float rs = ssp ? row_rstd(ssp, row0 + ai * HALF + m * 16) : 1.f;
                float h[8];
#pragma unroll
                for (int n = 0; n < 2; ++n)
#pragma unroll
                    for (int i = 0; i < 4; ++i) h[n * 4 + i] = silu_f(acc[ai][0][m][n][i] * rs) * (acc[ai][1][m][n][i] * rs);
                u32x4 w; w.x = cvtpk(h[0], h[1]); w.y = cvtpk(h[2], h[3]); w.z = cvtpk(h[4], h[5]); w.w = cvtpk(h[6], h[7]);
                *(u32x4*)rowp = w; }
    }
};
struct EpiRowScaleBf16 {
    static constexpr bool PERM = true;
    bf16_t* O; int ldc; const float* roww;
    __device__ __forceinline__ void operator()(const f32x4 (&acc)[2][2][4][2], const Unit& u, int wr, int wc, int fr, int fq) const {
        const int row0 = u.pm * BM + wr * 64 + fr, col0 = u.pn * BM + wc * 32 + 8 * fq;
#pragma unroll
        for (int ai = 0; ai < 2; ++ai)
#pragma unroll
            for (int m = 0; m < 4; ++m) { const int row = row0 + ai * HALF + m * 16; const float sc = roww[row]; bf16_t* rowp = O + (size_t)row * ldc + col0;
#pragma unroll
                for (int bj = 0; bj < 2; ++bj) { const f32x4 v0 = acc[ai][bj][m][0] * sc, v1 = acc[ai][bj][m][1] * sc;
                    u32x4 w; w.x = cvtpk(v0[0], v0[1]); w.y = cvtpk(v0[2], v0[3]); w.z = cvtpk(v1[0], v1[1]); w.w = cvtpk(v1[2], v1[3]);
                    *(u32x4*)(rowp + bj * HALF) = w; } }
    }
};
}
constexpr int ROWS_MAX = 2 * T + 8 * 256;
constexpr size_t al256(size_t x) { return (x + 255) & ~(size_t)255; }
constexpr size_t W_IN_E = 0;
constexpr size_t W_CW1 = W_IN_E + (size_t)1792 * 1024 * 2;
constexpr size_t W_UQ = W_CW1 + (size_t)2 * 256 * 2048 * 2;
constexpr size_t W_UKV = W_UQ + (size_t)1024 * 256 * 2;
constexpr size_t W_OUT_E = W_UKV + (size_t)1024 * 128 * 2;
constexpr size_t W_GU = W_OUT_E + (size_t)1024 * 1024 * 2;
constexpr size_t W_D = W_GU + (size_t)5632 * 1024 * 2;
constexpr size_t W_IN_O = W_D + (size_t)1024 * 2816 * 2;
constexpr size_t W_OUT_O = W_IN_O + (size_t)3072 * 1024 * 2;
constexpr size_t W_MGU = W_OUT_O + (size_t)1024 * 1024 * 2;
constexpr size_t W_MD = W_MGU + (size_t)8 * 2816 * 1024 * 2;
constexpr size_t W_END = W_MD + (size_t)8 * 1024 * 1408 * 2;
constexpr size_t SM_CTL = al256(W_END);
constexpr size_t SM_BAR = SM_CTL + 4096;
constexpr size_t SM_B1P = SM_BAR + 16384;
constexpr size_t SM_B1 = SM_B1P + 32 * 512 * 4;
constexpr size_t SM_ROPE = SM_B1 + 512 * 4;
constexpr size_t SM_BL = SM_ROPE + (size_t)S * 32 * 4;
constexpr size_t SM_HID = SM_BL + 8 * 132 * 4;
constexpr size_t SM_KC = SM_HID + (size_t)2 * NB * 512 * 256 * 2;
constexpr size_t SM_VCT = SM_KC + (size_t)NB * 512 * 64 * 2;
constexpr size_t SM_TE = SM_VCT + (size_t)NB * 512 * 64 * 2;
constexpr size_t SM_TW = SM_TE + (size_t)T * 8;
constexpr size_t SM_RANK = SM_TW + (size_t)T * 8;
constexpr size_t SM_POS = SM_RANK + (size_t)T * 8;
constexpr size_t SM_ROWW = SM_POS + (size_t)T * 8;
constexpr size_t SM_TILEE = SM_ROWW + (size_t)ROWS_MAX * 4;
constexpr size_t SM_ROWTOK = al256(SM_TILEE + (size_t)(ROWS_MAX / 256 + 8) * 4);
constexpr size_t SM_SSP1 = al256(SM_ROWTOK + (size_t)ROWS_MAX * 4);
constexpr size_t SM_SSP2 = SM_SSP1 + (size_t)T * 64;
constexpr size_t SM_END = SM_SSP2 + (size_t)T * 64;
constexpr size_t R_XA = al256(SM_END);
constexpr size_t SZ_XA = (size_t)T * 4096 + (size_t)4 * 1048576;
constexpr size_t R_XN = R_XA + SZ_XA;
constexpr size_t SZ_XN = (size_t)T * 2048;
constexpr size_t R_H = R_XN + SZ_XN;
constexpr size_t SZ_H = ((size_t)T * 6144 > (size_t)ROWS_MAX * 2816) ? (size_t)T * 6144 : (size_t)ROWS_MAX * 2816;
constexpr size_t WS_FAST_END = R_H + SZ_H;
constexpr size_t A_QN = 0;
constexpr size_t A_KSN = A_QN + (size_t)T * 1024;
constexpr size_t A_KWN = A_KSN + (size_t)T * 256;
constexpr size_t A_VST = A_KWN + (size_t)T * 256;
constexpr size_t A_VWT = A_VST + (size_t)T * 256;
constexpr size_t A_KCIN = A_VWT + (size_t)T * 256;
constexpr size_t A_VCIN = A_KCIN + (size_t)T * 256 + 2048;
constexpr size_t A_CQN = A_VCIN + (size_t)T * 256 + 2048;
constexpr size_t A_CKVN = A_CQN + (size_t)T * 512;
constexpr size_t A_KROPE = A_CKVN + (size_t)T * 256;
constexpr size_t A_GATES = A_KROPE + (size_t)T * 64;
constexpr size_t A_END = A_GATES + (size_t)T * 96;
static_assert(A_END <= SZ_XA, "attention inputs fit R_XA");
constexpr size_t O_QM = 0;
constexpr size_t O_KM = O_QM + (size_t)T * 1536;
constexpr size_t O_VMT = O_KM + (size_t)T * 1536;
static_assert(O_VMT + (size_t)T * 1024 <= (size_t)T * 4096, "d_out scratch");

struct Params {
    const float* in[30];
    float* out;
    unsigned char* ws;
    int ph_lo, ph_hi, dbg_branch, pad_;
};

#ifdef PROF_SEL
#define PROF_SLOT(k) ((unsigned long long*)(p.ws + SM_CTL + 2048) + (k))
#define PROF_ON(cond) ((cond) && threadIdx.x == 0)
#ifndef PROF_WAVE
#define PROF_WAVE 0
#endif
#endif
constexpr int LDS_BYTES = 147456;

__device__ __forceinline__ int ltid() { int t = threadIdx.x; asm volatile("" : "+v"(t)); return t; }
__device__ __forceinline__ int perm16(int k) { return (k & ~12) | ((k & 4) << 1) | ((k & 8) >> 1); }

struct WDesc { int in_idx, K, N, rep, map, row_off; size_t src_stride, dst_off, dst_stride; int gain_idx, pad_; };
__device__ const WDesc WDESC[12] = {
    {3, 1024, 1720, 1, 2, 0, 0, W_IN_E / 2, 0, -1, 0},
    {7, 2048, 256, 2, 0, 0, (size_t)2048 * 256, W_CW1 / 2, (size_t)256 * 2048, -1, 0},
    {11, 256, 768, 1, 3, 0, 0, W_UQ / 2, 0, -1, 0},
    {12, 128, 1024, 1, 0, 0, 0, W_UKV / 2, 0, -1, 0},
    {15, 1024, 1024, 1, 0, 0, 0, W_OUT_E / 2, 0, -1, 0},
    {17, 1024, 2816, 1, 1, 0, 0, W_GU / 2, 0, 16, 0},
    {18, 1024, 2816, 1, 1, 128, 0, W_GU / 2, 0, 16, 0},
    {19, 2816, 1024, 1, 0, 0, 0, W_D / 2, 0, -1, 0},
    {21, 1024, 3072, 1, 0, 0, 0, W_IN_O / 2, 0, 20, 0},
    {23, 1024, 1024, 1, 0, 0, 0, W_OUT_O / 2, 0, -1, 0},
    {27, 1024, 1408, 8, 1, 0, (size_t)1024 * 1408, W_MGU / 2, (size_t)2816 * 1024, -1, 0},
    {28, 1024, 1408, 8, 1, 128, (size_t)1024 * 1408, W_MGU / 2, (size_t)2816 * 1024, -1, 0},
};
__device__ const WDesc WDESC_MD = {29, 1408, 1024, 8, 0, 0, (size_t)1408 * 1024, W_MD / 2, (size_t)1024 * 1408, -1, 0};

__device__ __forceinline__ void transpose_item(const float* W, int K, int N, bf16_t* WT, int map, int row_off, const float* gain, LAS float* scr, int item, int lane) {
    const int nblk = (N + 31) / 32, kb = item / nblk, nb = item % nblk, k0 = 64 * kb, n0 = 32 * nb;
    const int n4 = (lane & 7) * 4; const bool nok = (n0 + n4) < N;
    f32x4 v[8];
#pragma unroll
    for (int i = 0; i < 8; ++i) { const int kk = (lane >> 3) + 8 * i; v[i] = nok ? *(const f32x4*)(W + (size_t)(k0 + kk) * N + n0 + n4) : (f32x4){0.f, 0.f, 0.f, 0.f}; if (gain) v[i] = v[i] * gain[k0 + kk]; }
#pragma unroll
    for (int i = 0; i < 8; ++i) { const int kk = (lane >> 3) + 8 * i; LAS float* d = scr + kk * 33 + n4; d[0] = v[i].x; d[1] = v[i].y; d[2] = v[i].z; d[3] = v[i].w; }
    asm volatile("s_waitcnt lgkmcnt(0)" ::: "memory");
    const int c = lane & 7;
#pragma unroll
    for (int j = 0; j < 4; ++j) { const int n = (lane >> 3) + 8 * j; const LAS float* s = scr + (8 * c) * 33 + n;
        u32x4 o; o.x = cvtpk(s[0 * 33], s[1 * 33]); o.y = cvtpk(s[2 * 33], s[3 * 33]); o.z = cvtpk(s[4 * 33], s[5 * 33]); o.w = cvtpk(s[6 * 33], s[7 * 33]);
        const int nn = n0 + n;
        if (nn < N) { const int row = (map == 1) ? (256 * (nn >> 7) + (nn & 127) + row_off) : (map == 2) ? (nn < 1280 ? nn : (nn < 1304 ? nn + 416 : nn - 24)) : (map == 3) ? ((nn / 96) * 128 + nn % 96) : (nn + row_off);
            *(u32x4*)(WT + (size_t)row * K + k0 + 8 * c) = o; } }
    asm volatile("s_waitcnt lgkmcnt(0)" ::: "memory");
}
__device__ __forceinline__ void do_wdesc(const Params& p, const WDesc& d, int it, LAS float* scr, int lane) {
    const int per = (d.K / 64) * ((d.N + 31) / 32); const int r = it / per, ii = it % per;
    transpose_item(p.in[d.in_idx] + (size_t)r * d.src_stride, d.K, d.N, (bf16_t*)p.ws + d.dst_off + (size_t)r * d.dst_stride, d.map, d.row_off, d.gain_idx >= 0 ? p.in[d.gain_idx] : nullptr, scr, ii, lane);
}
__device__ __forceinline__ void rms_row_to_bf16(const float* xrow, const float* g, bf16_t* orow, int lane) {
    const f32x4* xr = (const f32x4*)xrow + lane; const f32x4* gr = (const f32x4*)g + lane;
    f32x4 v[4]; float s = 0.f;
#pragma unroll
    for (int j = 0; j < 4; ++j) { v[j] = xr[64 * j]; s += (v[j].x * v[j].x + v[j].y * v[j].y) + (v[j].z * v[j].z + v[j].w * v[j].w); }
    const float r = rsqrtf(wsum(s) * (1.f / 1024.f) + EPS);
    u32x2* o8 = (u32x2*)orow + lane;
#pragma unroll
    for (int j = 0; j < 4; ++j) { const f32x4 gg = gr[64 * j]; u32x2 w; w.x = cvtpk(v[j].x * r * gg.x, v[j].y * r * gg.y); w.y = cvtpk(v[j].z * r * gg.z, v[j].w * r * gg.w); o8[64 * j] = w; }
}
__device__ __forceinline__ void phase_p0(const Params& p, LAS unsigned char* lds) {
    const int tid = ltid(), lane = tid & 63, wave = tid >> 6;
    const int gw = blockIdx.x * 8 + wave, NGW = gridDim.x * 8;
    LAS float* scr = (LAS float*)(lds + wave * 16384);
    int base = 0;
#pragma unroll 1
    for (int d = 0; d < 13; ++d) {
        const WDesc& wd = (d < 12) ? WDESC[d] : WDESC_MD;
        const int n_it = wd.rep * (wd.K / 64) * ((wd.N + 31) / 32);
        int first = (gw - (base % NGW) + NGW) % NGW;
        for (int it = first; it < n_it; it += NGW) do_wdesc(p, wd, it, scr, lane);
        base += n_it;
    }
    bf16_t* xn = (bf16_t*)(p.ws + R_XN);
    for (int m = gw; m < T; m += 2 * NGW) { rms_row_to_bf16(p.in[0] + (size_t)m * D, p.in[2], xn + (size_t)m * D, lane); if (m + NGW < T) rms_row_to_bf16(p.in[0] + (size_t)(m + NGW) * D, p.in[2], xn + (size_t)(m + NGW) * D, lane); }
    for (int u = gw; u < 256; u += NGW) {
        const int kc = u >> 3, kv = (u >> 2) & 1, nb = u & 3; float s = 0.f;
        const float* pos = p.in[6] + kv * 2048 + kc * 64; const float* w1 = p.in[7] + ((size_t)kv * 2048 + kc * 64) * 256 + nb * 64 + lane;
#pragma unroll 8
        for (int k = 0; k < 64; ++k) s += pos[k] * w1[(size_t)k * 256];
        ((float*)(p.ws + SM_B1P))[kc * 512 + kv * 256 + nb * 64 + lane] = s;
    }
    for (int i = blockIdx.x * 512 + tid; i < S * 16; i += gridDim.x * 512) {
        const int t = i >> 4, f = i & 15; const float ang = (float)t * powf(10000.f, -(float)f / 16.f);
        float* rp = (float*)(p.ws + SM_ROPE) + t * 32; rp[f] = cosf(ang); rp[16 + f] = sinf(ang);
    }
    if (blockIdx.x == 0) for (int i = tid; i < 8 * 129; i += 512) { const int h = i / 129, dd = i % 129; ((float*)(p.ws + SM_BL))[h * 132 + dd] = p.in[1][(dd < 128 ? (int)gold::T5B[dd] : 31) * 8 + h] * LOG2E; }
}

__device__ __forceinline__ void unpack8(const u32x4 v, float (&x)[8]) { x[0] = bflo(v.x); x[1] = bfhi(v.x); x[2] = bflo(v.y); x[3] = bfhi(v.y); x[4] = bflo(v.z); x[5] = bfhi(v.z); x[6] = bflo(v.w); x[7] = bfhi(v.w); }
__device__ __forceinline__ u32x4 pack8(const float (&x)[8]) { u32x4 w; w.x = cvtpk(x[0], x[1]); w.y = cvtpk(x[2], x[3]); w.z = cvtpk(x[4], x[5]); w.w = cvtpk(x[6], x[7]); return w; }
__device__ __forceinline__ float ss8f(const float (&x)[8]) { return ((x[0] * x[0] + x[1] * x[1]) + (x[2] * x[2] + x[3] * x[3])) + ((x[4] * x[4] + x[5] * x[5]) + (x[6] * x[6] + x[7] * x[7])); }
__device__ __forceinline__ void load8f(const float* g, float (&x)[8], float sc) { const f32x4 a = *(const f32x4*)g, b = *(const f32x4*)(g + 4); x[0] = a.x * sc; x[1] = a.y * sc; x[2] = a.z * sc; x[3] = a.w * sc; x[4] = b.x * sc; x[5] = b.y * sc; x[6] = b.z * sc; x[7] = b.w * sc; }
__device__ __forceinline__ void phase_p2(const Params& p, LAS unsigned char* lds) {
    const int tid = ltid(), lane = tid & 63, wave = tid >> 6;
    const bf16_t* hb = (const bf16_t*)(p.ws + R_H);
    unsigned char* xa = p.ws + R_XA;
    bf16_t* qn = (bf16_t*)(xa + A_QN); bf16_t* ksn = (bf16_t*)(xa + A_KSN); bf16_t* kwn = (bf16_t*)(xa + A_KWN);
    bf16_t* vst = (bf16_t*)(xa + A_VST); bf16_t* vwt = (bf16_t*)(xa + A_VWT); bf16_t* kcin = (bf16_t*)(xa + A_KCIN); bf16_t* vcin = (bf16_t*)(xa + A_VCIN);
    bf16_t* cqn = (bf16_t*)(xa + A_CQN); bf16_t* ckvn = (bf16_t*)(xa + A_CKVN); bf16_t* krope = (bf16_t*)(xa + A_KROPE); float* gates = (float*)(xa + A_GATES);
    LAS bf16_t* vs = (LAS bf16_t*)lds;
    if (blockIdx.x == 0) {
        { float s = 0.f; for (int k = 0; k < 32; ++k) s += ((const float*)(p.ws + SM_B1P))[k * 512 + tid]; ((float*)(p.ws + SM_B1))[tid] = s; }
        for (int i = tid; i < 1024; i += 512) { kcin[(size_t)T * 128 + i] = 0; vcin[(size_t)T * 128 + i] = 0; }
    }
    const int c8 = (lane & 7) * 8, seg = lane >> 3;
    float qg[8], ksg[8], kwg[8], cqg[8], ckvg[8];
    load8f(p.in[4] + c8, qg, 0.125f * LOG2E); load8f(p.in[5] + 64 + c8, ksg, 1.f); load8f(p.in[5] + 128 + c8, kwg, 1.f);
    load8f(p.in[9] + (lane & 31) * 8, cqg, 1.f); load8f(p.in[10] + (lane & 15) * 8, ckvg, 1.f);
    for (int tile = blockIdx.x; tile < T / 64; tile += gridDim.x) {
        const int b = tile / (S / 64), s0 = (tile % (S / 64)) * 64;
#pragma unroll 4
        for (int tt = 0; tt < 8; ++tt) {
            const int sl = wave * 8 + tt, s = s0 + sl; const size_t t = (size_t)b * S + s;
            const bf16_t* hr = hb + t * 1792 + lane * 8;
            const u32x4 L0 = *(const u32x4*)hr, L1 = *(const u32x4*)(hr + 512), L2 = *(const u32x4*)(hr + 1024);
            u32x4 L3 = {0u, 0u, 0u, 0u}; if (lane < 32) L3 = *(const u32x4*)(hr + 1536);
            float x0[8], x1[8], x2[8], x3[8];
            unpack8(L0, x0); unpack8(L1, x1); unpack8(L2, x2); unpack8(L3, x3);
            float a0 = ss8f(x0), a1 = ss8f(x1), a2 = ss8f(x2), a3 = ss8f(x3);
#pragma unroll
            for (int o = 1; o < 8; o <<= 1) { a0 += __shfl_xor(a0, o); a1 += __shfl_xor(a1, o); a2 += __shfl_xor(a2, o); a3 += __shfl_xor(a3, o); }
            float a2w = a2 + __shfl_xor(a2, 8); a2w += __shfl_xor(a2w, 16);
            const float a3w = a3 + __shfl_xor(a3, 8);
            const int pp = (sl & ~15) | perm16(sl & 15);
            {
                const float r = rsqrtf(a0 * (1.f / 64.f) + EPS); float y[8];
#pragma unroll
                for (int j = 0; j < 8; ++j) y[j] = x0[j] * r * qg[j];
                *(u32x4*)(qn + t * 512 + lane * 8) = pack8(y);
            }
            {
                const int g = seg & 1; const size_t gm = (((size_t)b * 2 + g) * S + s) * 64 + c8;
                if (seg < 2) *(u32x4*)(kcin + gm) = L1;
                else if (seg < 4) *(u32x4*)(vcin + gm) = L1;
                else if (seg < 6) { const float r = rsqrtf(a1 * (1.f / 64.f) + EPS); float y[8];
#pragma unroll
                    for (int j = 0; j < 8; ++j) y[j] = x1[j] * r * ksg[j];
                    *(u32x4*)(ksn + gm) = pack8(y); }
                else {
#pragma unroll
                    for (int j = 0; j < 8; ++j) vs[((0 + g) * 64 + c8 + j) * 72 + pp] = (bf16_t)((j & 1) ? (L1[j >> 1] >> 16) : (L1[j >> 1] & 0xffffu)); }
            }
            {
                const int g = seg & 1; const size_t gm = (((size_t)b * 2 + g) * S + s) * 64 + c8;
                if (seg < 2) { const float r = rsqrtf(a2 * (1.f / 64.f) + EPS); float y[8];
#pragma unroll
                    for (int j = 0; j < 8; ++j) y[j] = x2[j] * r * kwg[j];
                    *(u32x4*)(kwn + gm) = pack8(y); }
                else if (seg < 4) {
#pragma unroll
                    for (int j = 0; j < 8; ++j) vs[((2 + g) * 64 + c8 + j) * 72 + pp] = (bf16_t)((j & 1) ? (L2[j >> 1] >> 16) : (L2[j >> 1] & 0xffffu)); }
                else { const float r = rsqrtf(a2w * (1.f / 256.f) + EPS); float y[8];
#pragma unroll
                    for (int j = 0; j < 8; ++j) y[j] = x2[j] * r * cqg[j];
                    *(u32x4*)(cqn + t * 256 + (lane - 32) * 8) = pack8(y); }
            }
            {
                if (lane < 16) { const float r = rsqrtf(a3w * (1.f / 128.f) + EPS); float y[8];
#pragma unroll
                    for (int j = 0; j < 8; ++j) y[j] = x3[j] * r * ckvg[j];
                    *(u32x4*)(ckvn + t * 128 + lane * 8) = pack8(y); }
                else if (lane < 20) *(u32x4*)(krope + t * 32 + (lane - 16) * 8) = L3;
                else if (lane < 23) { float y[8];
#pragma unroll
                    for (int j = 0; j < 8; ++j) y[j] = frcp(1.f + fexp2(-x3[j] * LOG2E));
                    float* gp = gates + t * 24 + (lane - 20) * 8; *(f32x4*)gp = (f32x4){y[0], y[1], y[2], y[3]}; *(f32x4*)(gp + 4) = (f32x4){y[4], y[5], y[6], y[7]}; }
            }
        }
        __syncthreads();
        {
            const int row = tid >> 1, half = tid & 1, which = row >> 6, d = row & 63, g = which & 1;
            bf16_t* dst = ((which < 2) ? vst : vwt) + (((size_t)b * 2 + g) * 64 + d) * S + s0 + half * 32;
            const LAS bf16_t* src = vs + row * 72 + half * 32;
#pragma unroll
            for (int c = 0; c < 4; ++c) *(u32x4*)(dst + c * 8) = *(const LAS u32x4*)(src + c * 8);
        }
        __syncthreads();
    }
}
__device__ __forceinline__ void phase_p3b(const Params& p, LAS unsigned char* lds) {
    const int tid = ltid(), lane = tid & 63, wave = tid >> 6;
    const int gw = blockIdx.x * 8 + wave, NGW = gridDim.x * 8;
    const bf16_t* qraw = (const bf16_t*)(p.ws + R_H);
    const bf16_t* kvraw = (const bf16_t*)(p.ws + R_H + (size_t)T * 2048);
    const bf16_t* krope = (const bf16_t*)(p.ws + R_XA + A_KROPE);
    const float* rope = (const float*)(p.ws + SM_ROPE);
    bf16_t* qm = (bf16_t*)((unsigned char*)p.out + O_QM); bf16_t* km = (bf16_t*)((unsigned char*)p.out + O_KM); bf16_t* vmt = (bf16_t*)((unsigned char*)p.out + O_VMT);
    const float* q_norm = p.in[13]; const float* k_norm = p.in[14];
    LAS bf16_t* vs = (LAS bf16_t*)lds;
    LAS float* w2s = (LAS float*)(lds + 73728);
    for (int kv = 0; kv < 2; ++kv) {
        __syncthreads();
        for (int i = tid; i < 256 * 64; i += 512) w2s[i] = p.in[8][kv * 16384 + i];
        __syncthreads();
        const bf16_t* hid = (const bf16_t*)(p.ws + SM_HID) + (size_t)kv * NB * 512 * 256;
        for (int row = gw; row < NB * 512; row += NGW) {
            const u32x2 hv = *(const u32x2*)(hid + (size_t)row * 256 + lane * 4);
            const float h0 = bflo(hv.x), h1 = bfhi(hv.x), h2 = bflo(hv.y), h3 = bfhi(hv.y);
            float acc = 0.f;
#pragma unroll 8
            for (int k4 = 0; k4 < 64; ++k4) {
                acc += __shfl(h0, k4) * w2s[(k4 * 4 + 0) * 64 + lane]; acc += __shfl(h1, k4) * w2s[(k4 * 4 + 1) * 64 + lane];
                acc += __shfl(h2, k4) * w2s[(k4 * 4 + 2) * 64 + lane]; acc += __shfl(h3, k4) * w2s[(k4 * 4 + 3) * 64 + lane];
            }
            if (kv == 0) { const float r = rsqrtf(wsum(acc * acc) * (1.f / 64.f) + EPS); ((bf16_t*)(p.ws + SM_KC))[(size_t)row * 64 + lane] = f2bf(acc * r * p.in[5][lane]); }
            else { const int c = row & 255; ((bf16_t*)(p.ws + SM_VCT))[((size_t)(row >> 8) * 64 + lane) * 256 + ((c & ~15) | perm16(c & 15))] = f2bf(acc); }
        }
    }
    __syncthreads();
    const float QS = 0.10206207261596577f * LOG2E;
    const int c = lane & 15, hl = lane >> 4;
    float qg[8], kg[8];
    load8f(q_norm + (c < 12 ? c * 8 : 0), qg, QS);
    load8f(k_norm + (c < 12 ? c * 8 : 0), kg, 1.f);
    for (int tile = blockIdx.x; tile < T / 64; tile += gridDim.x) {
        const int b = tile / (S / 64), s0 = (tile % (S / 64)) * 64;
#pragma unroll 4
        for (int tt = 0; tt < 8; ++tt) {
            const int sl = wave * 8 + tt, s = s0 + sl; const size_t t = (size_t)b * S + s;
            const int pp = (sl & ~15) | perm16(sl & 15);
            u32x4 Q[2], KV[2];
#pragma unroll
            for (int ld = 0; ld < 2; ++ld) { Q[ld] = *(const u32x4*)(qraw + t * 1024 + ld * 512 + lane * 8); KV[ld] = *(const u32x4*)(kvraw + t * 1024 + ld * 512 + lane * 8); }
            u32x4 KR = {0u, 0u, 0u, 0u}; f32x4 cs0 = {0.f, 0.f, 0.f, 0.f}, cs1 = cs0, sn0 = cs0, sn1 = cs0;
            if (c >= 8 && c < 12) { KR = *(const u32x4*)(krope + t * 32 + (c - 8) * 8);
                const float* rp = rope + s * 32 + (c & 1) * 8; cs0 = *(const f32x4*)rp; cs1 = *(const f32x4*)(rp + 4); sn0 = *(const f32x4*)(rp + 16); sn1 = *(const f32x4*)(rp + 20); }
            const float cs[8] = {cs0.x, cs0.y, cs0.z, cs0.w, cs1.x, cs1.y, cs1.z, cs1.w}, sn[8] = {sn0.x, sn0.y, sn0.z, sn0.w, sn1.x, sn1.y, sn1.z, sn1.w};
            float kr[8]; unpack8(KR, kr);
            const float krs = ss8f(kr);
#pragma unroll
            for (int ld = 0; ld < 2; ++ld) {
                const int hh = ld * 4 + hl;
                {
                    float x[8]; unpack8(Q[ld], x);
                    float ss = c < 12 ? ss8f(x) : 0.f;
#pragma unroll
                    for (int o = 1; o < 16; o <<= 1) ss += __shfl_xor(ss, o);
                    const float r = rsqrtf(ss * (1.f / 96.f) + EPS); float y[8], z[8];
#pragma unroll
                    for (int j = 0; j < 8; ++j) y[j] = x[j] * r * qg[j];
#pragma unroll
                    for (int j = 0; j < 8; ++j) { const float pb = __shfl_xor(y[j], 2); z[j] = (c < 8) ? y[j] : ((c < 10) ? (y[j] * cs[j] - pb * sn[j]) : (pb * sn[j] + y[j] * cs[j])); }
                    if (c < 12) *(u32x4*)(qm + (t * 8 + hh) * 96 + c * 8) = pack8(z);
                }
                {
                    float x[8]; unpack8(KV[ld], x);
                    float ss = c < 8 ? ss8f(x) : krs;
#pragma unroll
                    for (int o = 1; o < 16; o <<= 1) ss += __shfl_xor(ss, o);
                    const float r = rsqrtf(ss * (1.f / 96.f) + EPS); float y[8], z[8];
#pragma unroll
                    for (int j = 0; j < 8; ++j) y[j] = (c < 8 ? x[j] : kr[j]) * r * kg[j];
#pragma unroll
                    for (int j = 0; j < 8; ++j) { const float pb = __shfl_xor(y[j], 2); z[j] = (c < 8) ? y[j] : ((c < 10) ? (y[j] * cs[j] - pb * sn[j]) : (pb * sn[j] + y[j] * cs[j])); }
                    if (c < 12) *(u32x4*)(km + (((size_t)b * 8 + hh) * S + s) * 96 + c * 8) = pack8(z);
                    if (c >= 8) {
#pragma unroll
                        for (int j = 0; j < 8; ++j) vs[(hh * 64 + (c - 8) * 8 + j) * 72 + pp] = (bf16_t)((j & 1) ? (KV[ld][j >> 1] >> 16) : (KV[ld][j >> 1] & 0xffffu)); }
                }
            }
        }
        __syncthreads();
        {
            const int hh = tid >> 6, d = tid & 63;
            bf16_t* dst = vmt + (((size_t)b * 8 + hh) * 64 + d) * S + s0;
            const LAS bf16_t* src = vs + tid * 72;
#pragma unroll
            for (int cc = 0; cc < 8; ++cc) *(u32x4*)(dst + cc * 8) = *(const LAS u32x4*)(src + cc * 8);
        }
        __syncthreads();
    }
}

__device__ const unsigned short UNIT_TYPES[256] = {63,127,62,126,61,125,527,591,655,719,783,847,911,975,60,124,59,123,58,122,57,121,56,120,526,590,654,718,782,846,910,974,55,119,54,118,53,117,52,116,51,115,525,589,653,717,781,845,909,973,50,114,49,113,48,112,47,111,524,588,652,716,780,844,908,972,46,110,45,109,44,108,43,107,523,587,651,715,779,843,907,971,42,106,41,105,40,104,39,103,38,102,522,586,650,714,778,842,906,970,37,101,36,100,35,99,34,98,33,97,521,585,649,713,777,841,905,969,32,96,31,95,30,94,520,584,648,712,776,840,904,968,29,93,28,92,27,91,26,90,25,89,519,583,647,711,775,839,903,967,24,88,23,87,22,86,21,85,20,84,518,582,646,710,774,838,902,966,19,83,18,82,17,81,16,80,15,79,517,581,645,709,773,837,901,965,14,78,13,77,12,76,516,580,644,708,772,836,900,964,11,75,10,74,9,73,8,72,515,579,643,707,771,835,899,963,7,71,6,70,5,69,514,578,642,706,770,834,898,962,4,68,3,67,513,577,641,705,769,833,897,961,2,66,1,65,0,64,512,576,640,704,768,832,896,960};
__device__ __forceinline__ int crow(int r, int hi) { return (r & 3) + 8 * (r >> 2) + 4 * hi; }
struct Flash { f32x16 o0, o1; float l; };
__device__ __forceinline__ void flash_init(Flash& st) {
#pragma unroll
    for (int r = 0; r < 16; ++r) { st.o0[r] = 0.f; st.o1[r] = 0.f; }
    st.l = 0.f;
}
constexpr int AL_K64 = 0, AL_V64 = 3 * 8192;
constexpr int AL_K96 = 0, AL_V96 = 3 * 16384;
constexpr int AL_IMP = 49152, AL_SELB = AL_IMP + 64 * 65 * 4, AL_UNI = AL_SELB + 512, AL_TL = AL_UNI + 64, AL_BL = AL_TL + 128, AL_OT = AL_BL + 4 * 132 * 4, AL_END = AL_OT + 8 * 32 * 64 * 4;
static_assert(AL_END <= 139264 && AL_V96 + 3 * 8192 <= 139264, "attention LDS");

template <int RB> struct DmaLane { unsigned g0, g1; };
template <int RB> __device__ __forceinline__ void dma_setup(DmaLane<RB>& L, int w, int lane, unsigned gs) {
    if (RB == 128) { const int r = 8 * w + (lane >> 3), c = (lane & 7) ^ ((r >> 1) & 7); L.g0 = (unsigned)r * gs + c * 16; L.g1 = 0; }
    else {
        { const int r = 8 * w + (lane >> 4); int c = (lane & 15) ^ (r & 15); c = c >= 12 ? c - 4 : c; L.g0 = (unsigned)r * gs + c * 16; }
        { const int r = 8 * w + 4 + (lane >> 4); int c = (lane & 15) ^ (r & 15); c = c >= 12 ? c - 4 : c; L.g1 = (unsigned)r * gs + c * 16; }
    }
}
template <int RB> __device__ __forceinline__ void dma_issue(const unsigned char* tile, const DmaLane<RB>& L, LAS unsigned char* buf, int w) {
    if (RB == 128) __builtin_amdgcn_global_load_lds((const unsigned*)(tile + L.g0), (LAS unsigned*)(buf + w * 1024), 16, 0, 0);
    else { __builtin_amdgcn_global_load_lds((const unsigned*)(tile + L.g0), (LAS unsigned*)(buf + w * 2048), 16, 0, 0);
           __builtin_amdgcn_global_load_lds((const unsigned*)(tile + L.g1), (LAS unsigned*)(buf + w * 2048 + 1024), 16, 0, 0); }
}
template <int DK> __device__ __forceinline__ void frag_offsets(unsigned (&kl)[DK / 16], unsigned (&vl)[4], int r32, int hi) {
#pragma unroll
    for (int s = 0; s < DK / 16; ++s) kl[s] = (DK == 64) ? (unsigned)(r32 * 128 + (((2 * s + hi) ^ ((r32 >> 1) & 7)) << 4)) : (unsigned)(r32 * 256 + (((2 * s + hi) ^ (r32 & 15)) << 4));
#pragma unroll
    for (int s = 0; s < 4; ++s) vl[s] = (unsigned)(r32 * 128 + (((2 * s + hi) ^ ((r32 >> 1) & 7)) << 4));
}

template <int DK, int KP, bool LANEMASK, class F>
__device__ __forceinline__ void tile_compute(Flash& st, const LAS unsigned char* Kt, const LAS unsigned char* Vt, const bf16x8* qf, const f32x16& negm, const unsigned (&kl)[DK / 16], const unsigned (&vl)[4], bool mine, F f) {
    constexpr int NS = DK / 16; constexpr int KH = 32 * KP;
    bf16x8 ka[NS], kh[NS];
#pragma unroll
    for (int s = 0; s < NS; ++s) ka[s] = *(const LAS bf16x8*)(Kt + kl[s]);
#pragma unroll
    for (int s = 0; s < NS; ++s) kh[s] = *(const LAS bf16x8*)(Kt + kl[s] + KH);
    __builtin_amdgcn_sched_barrier(0);
    f32x16 p0, p1;
#pragma unroll
    for (int s = 0; s < NS; ++s) p0 = (s == 0) ? __builtin_amdgcn_mfma_f32_32x32x16_bf16(ka[0], qf[0], negm, 0, 0, 0) : __builtin_amdgcn_mfma_f32_32x32x16_bf16(ka[s], qf[s], p0, 0, 0, 0);
#pragma unroll
    for (int s = 0; s < NS; ++s) p1 = (s == 0) ? __builtin_amdgcn_mfma_f32_32x32x16_bf16(kh[0], qf[0], negm, 0, 0, 0) : __builtin_amdgcn_mfma_f32_32x32x16_bf16(kh[s], qf[s], p1, 0, 0, 0);
    bf16x8 va[4], vh[4];
#pragma unroll
    for (int s = 0; s < 4; ++s) { va[s] = *(const LAS bf16x8*)(Vt + vl[s]); vh[s] = *(const LAS bf16x8*)(Vt + vl[s] + 4096); }
    __builtin_amdgcn_sched_barrier(0);
    float ls = 0.f;
    u32x4 w0, w1, w2, w3;
    {
#pragma unroll
        for (int r = 0; r < 16; ++r) { float x = p0[r]; const bool v = f(r, 0, x); const float e = fexp2(x); p0[r] = v ? e : 0.f; ls += p0[r]; }
        w0.x = cvtpk(p0[0], p0[1]); w0.y = cvtpk(p0[2], p0[3]); w0.z = cvtpk(p0[4], p0[5]); w0.w = cvtpk(p0[6], p0[7]);
        w1.x = cvtpk(p0[8], p0[9]); w1.y = cvtpk(p0[10], p0[11]); w1.z = cvtpk(p0[12], p0[13]); w1.w = cvtpk(p0[14], p0[15]);
        if (LANEMASK) { w0.x = mine ? w0.x : 0u; w0.y = mine ? w0.y : 0u; w0.z = mine ? w0.z : 0u; w0.w = mine ? w0.w : 0u; w1.x = mine ? w1.x : 0u; w1.y = mine ? w1.y : 0u; w1.z = mine ? w1.z : 0u; w1.w = mine ? w1.w : 0u; }
    }
#pragma unroll
    for (int s = 0; s < 2; ++s) {
        const bf16x8 pa = __builtin_bit_cast(bf16x8, s ? w1 : w0);
        st.o0 = __builtin_amdgcn_mfma_f32_32x32x16_bf16(pa, va[s], st.o0, 0, 0, 0);
        st.o1 = __builtin_amdgcn_mfma_f32_32x32x16_bf16(pa, vh[s], st.o1, 0, 0, 0);
    }
    {
#pragma unroll
        for (int r = 0; r < 16; ++r) { float x = p1[r]; const bool v = f(r, 1, x); const float e = fexp2(x); p1[r] = v ? e : 0.f; ls += p1[r]; }
        w2.x = cvtpk(p1[0], p1[1]); w2.y = cvtpk(p1[2], p1[3]); w2.z = cvtpk(p1[4], p1[5]); w2.w = cvtpk(p1[6], p1[7]);
        w3.x = cvtpk(p1[8], p1[9]); w3.y = cvtpk(p1[10], p1[11]); w3.z = cvtpk(p1[12], p1[13]); w3.w = cvtpk(p1[14], p1[15]);
        if (LANEMASK) { w2.x = mine ? w2.x : 0u; w2.y = mine ? w2.y : 0u; w2.z = mine ? w2.z : 0u; w2.w = mine ? w2.w : 0u; w3.x = mine ? w3.x : 0u; w3.y = mine ? w3.y : 0u; w3.z = mine ? w3.z : 0u; w3.w = mine ? w3.w : 0u; }
    }
    if (LANEMASK) ls = mine ? ls : 0.f;
    st.l += ls;
#pragma unroll
    for (int s = 2; s < 4; ++s) {
        const bf16x8 pa = __builtin_bit_cast(bf16x8, (s == 3) ? w3 : w2);
        st.o0 = __builtin_amdgcn_mfma_f32_32x32x16_bf16(pa, va[s], st.o0, 0, 0, 0);
        st.o1 = __builtin_amdgcn_mfma_f32_32x32x16_bf16(pa, vh[s], st.o1, 0, 0, 0);
    }
}
template <int DK, int KP> __device__ __forceinline__ void qk_tile(f32x16& p0, f32x16& p1, const LAS unsigned char* Kt, const bf16x8* qf, const f32x16& negm, const unsigned (&kl)[DK / 16]) {
#pragma unroll
    for (int s = 0; s < DK / 16; ++s) {
        const bf16x8 a0 = *(const LAS bf16x8*)(Kt + kl[s]);
        const bf16x8 a1 = *(const LAS bf16x8*)(Kt + kl[s] + 32 * KP);
        if (s == 0) { p0 = __builtin_amdgcn_mfma_f32_32x32x16_bf16(a0, qf[0], negm, 0, 0, 0); p1 = __builtin_amdgcn_mfma_f32_32x32x16_bf16(a1, qf[0], negm, 0, 0, 0); }
        else { p0 = __builtin_amdgcn_mfma_f32_32x32x16_bf16(a0, qf[s], p0, 0, 0, 0); p1 = __builtin_amdgcn_mfma_f32_32x32x16_bf16(a1, qf[s], p1, 0, 0, 0); }
    }
}
template <bool FIRST> __device__ __forceinline__ void flash_accum(LAS float* otl, const Flash& st, float gate, int hi, int lane) {
    const float lt = st.l + __shfl_xor(st.l, 32);
    const float f = lt > 0.f ? gate * frcp(lt) : 0.f;
#pragma unroll
    for (int r = 0; r < 16; ++r) { const float fr_ = __shfl(f, crow(r, hi));
        if (FIRST) { otl[r * 64 + lane] = fr_ * st.o0[r]; otl[(16 + r) * 64 + lane] = fr_ * st.o1[r]; }
        else { otl[r * 64 + lane] += fr_ * st.o0[r]; otl[(16 + r) * 64 + lane] += fr_ * st.o1[r]; } }
}
template <int NS> __device__ __forceinline__ float qnorm2(const bf16x8* qf) {
    float s = 0.f;
#pragma unroll
    for (int i = 0; i < NS; ++i)
#pragma unroll
        for (int j = 0; j < 8; ++j) { const float x = bf2f((bf16_t)qf[i][j]); s += x * x; }
    return s + __shfl_xor(s, 32);
}
__device__ __forceinline__ float wmax(float v) {
#pragma unroll
    for (int o = 1; o < 64; o <<= 1) v = fmaxf(v, __shfl_xor(v, o));
    return v;
}

template <int RBK, bool HASV, int KOFF, int KSZ, int VOFF, class SrcK, class SrcV, class Comp>
__device__ __forceinline__ void run_tiles(int n, LAS unsigned char* lds, int w, int lane, unsigned gsK, unsigned gsV, SrcK srcK, SrcV srcV, Comp comp) {
    DmaLane<RBK> LK; dma_setup<RBK>(LK, w, lane, gsK);
    DmaLane<128> LV; LV.g0 = 0; LV.g1 = 0; if (HASV) dma_setup<128>(LV, w, lane, gsV);
    const int nl = n - 1, t1 = nl < 1 ? nl : 1;
    dma_issue<RBK>(srcK(0), LK, lds + KOFF, w); if (HASV) dma_issue<128>(srcV(0), LV, lds + VOFF, w);
    dma_issue<RBK>(srcK(t1), LK, lds + KOFF + KSZ, w); if (HASV) dma_issue<128>(srcV(t1), LV, lds + VOFF + 8192, w);
    constexpr int P = (RBK == 128 ? 1 : 2) + (HASV ? 1 : 0);
#define RT_STEP(bi, ii) do { const int i_ = (ii); \
        if (P == 1) asm volatile("s_waitcnt vmcnt(1)" ::: "memory"); else if (P == 2) asm volatile("s_waitcnt vmcnt(2)" ::: "memory"); else asm volatile("s_waitcnt vmcnt(3)" ::: "memory"); \
        __builtin_amdgcn_s_barrier(); asm volatile("" ::: "memory"); \
        { const int tn = (i_ + 2 < nl) ? i_ + 2 : nl; constexpr int b2 = ((bi) + 2) % 3; \
          dma_issue<RBK>(srcK(tn), LK, lds + KOFF + b2 * KSZ, w); if (HASV) dma_issue<128>(srcV(tn), LV, lds + VOFF + b2 * 8192, w); } \
        if (i_ < n) comp(i_, lds + KOFF + (bi) * KSZ, lds + VOFF + (bi) * 8192); } while (0)
    for (int i = 0; i < n; i += 3) { RT_STEP(0, i); RT_STEP(1, i + 1); RT_STEP(2, i + 2); }
#undef RT_STEP
    asm volatile("s_waitcnt vmcnt(0)" ::: "memory");
    __syncthreads();
}

__device__ __forceinline__ void mla_unit(const Params& p, LAS unsigned char* lds, int b, int h, int qb) {
    int tid = threadIdx.x; asm volatile("" : "+v"(tid));
    const int lane = tid & 63, w = __builtin_amdgcn_readfirstlane(tid >> 6), r32 = lane & 31, hi = lane >> 5;
    const bf16_t* qm = (const bf16_t*)((const unsigned char*)p.out + O_QM);
    const unsigned char* km = (const unsigned char*)p.out + O_KM + (((size_t)b * 8 + h) * S) * 192;
    const unsigned char* vmt = (const unsigned char*)p.out + O_VMT + (((size_t)b * 8 + h) * 64) * (size_t)S * 2;
    bf16_t* ocat = (bf16_t*)(p.ws + R_XN);
    const int tq = qb * 256 + 32 * w + r32;
    bf16x8 qf[6];
#pragma unroll
    for (int s = 0; s < 6; ++s) qf[s] = *(const bf16x8*)(qm + (((size_t)b * S + tq) * 8 + h) * 96 + 16 * s + 8 * hi);
    const float kn = 9.797958971f * 1.01f * wmax(fmaxf(fabsf(p.in[14][lane]), lane < 32 ? fabsf(p.in[14][64 + lane]) : 0.f));
    const float mref = sqrtf(qnorm2<6>(qf)) * kn;
    f32x16 negm;
#pragma unroll
    for (int r = 0; r < 16; ++r) negm[r] = -mref;
    Flash st; flash_init(st);
    const int ntile = 4 * qb + 4, dt = 4 * qb + (w >> 1);
#ifdef PROF_SEL
    if (b == 0 && h == 0 && qb == 15 && threadIdx.x == 0) { *PROF_SLOT(36) -= __builtin_amdgcn_s_memtime(); *PROF_SLOT(37) -= __builtin_amdgcn_s_memrealtime(); }
#endif
    unsigned kl[6], vl[4]; frag_offsets<96>(kl, vl, r32, hi);
    run_tiles<192, true, AL_K96, 16384, AL_V96>(ntile, lds, w, lane, 192u, (unsigned)(S * 2),
        [&](int i) { return km + (size_t)i * 64 * 192; }, [&](int i) { return vmt + (size_t)i * 128; },
        [&](int i, LAS unsigned char* kb, LAS unsigned char* vb) {
            if (i <= dt) {
                if (i < dt) tile_compute<96, 256, false>(st, kb, vb, qf, negm, kl, vl, true, [&](int r, int half, float& x) { return true; });
                else { const int kb0 = 64 * i + 4 * hi; tile_compute<96, 256, false>(st, kb, vb, qf, negm, kl, vl, true, [&](int r, int half, float& x) { return (kb0 + 32 * half + (r & 3) + 8 * (r >> 2)) <= tq; }); }
            }
        });
#ifdef PROF_SEL
    if (b == 0 && h == 0 && qb == 15 && threadIdx.x == 0) { *PROF_SLOT(36) += __builtin_amdgcn_s_memtime(); *PROF_SLOT(37) += __builtin_amdgcn_s_memrealtime(); }
#endif
    {
        const float lt = st.l + __shfl_xor(st.l, 32); const float f = lt > 0.f ? frcp(lt) : 0.f;
#pragma unroll
        for (int r = 0; r < 16; ++r) { const float fr_ = __shfl(f, crow(r, hi)); const size_t ro = ((size_t)b * S + qb * 256 + 32 * w + crow(r, hi)) * 1024 + 512 + h * 64 + r32; ocat[ro] = f2bf(st.o0[r] * fr_); ocat[ro + 32] = f2bf(st.o1[r] * fr_); }
    }
}

__device__ __forceinline__ void nsa_unit(const Params& p, LAS unsigned char* lds, int b, int g, int jt) {
    int tid = threadIdx.x; asm volatile("" : "+v"(tid));
    const int lane = tid & 63, w = __builtin_amdgcn_readfirstlane(tid >> 6), r32 = lane & 31, hi = lane >> 5;
    const int rh = w >> 1, qh = w & 1, h = 4 * g + rh, q0 = 64 * jt, ql = 32 * qh + r32, tq = q0 + ql;
    const unsigned char* xa = p.ws + R_XA;
    const bf16_t* qn = (const bf16_t*)(xa + A_QN);
    const size_t bg = (size_t)b * 2 + g;
    const unsigned char* ksn = xa + A_KSN + bg * S * 128; const unsigned char* kwn = xa + A_KWN + bg * S * 128;
    const unsigned char* vst = xa + A_VST + bg * 64 * (size_t)S * 2; const unsigned char* vwt = xa + A_VWT + bg * 64 * (size_t)S * 2;
    const unsigned char* kc = p.ws + SM_KC + bg * 256 * 128; const unsigned char* vct = p.ws + SM_VCT + bg * 64 * 512;
    const float* gates = (const float*)(xa + A_GATES) + ((size_t)b * S + tq) * 24 + h * 3;
    bf16_t* ocat = (bf16_t*)(p.ws + R_XN);
    LAS float* imp = (LAS float*)(lds + AL_IMP); LAS unsigned char* selb = lds + AL_SELB; LAS unsigned* uni = (LAS unsigned*)(lds + AL_UNI); LAS unsigned char* tl = lds + AL_TL; LAS float* bls = (LAS float*)(lds + AL_BL);
    const float* blg = (const float*)(p.ws + SM_BL) + h * 132;
    const float cb = blg[128];
    const float bmax = wmax(fmaxf(fmaxf(blg[lane], blg[64 + lane]), cb));
    if (qh == 0) { bls[rh * 132 + lane] = blg[lane] - cb; bls[rh * 132 + 64 + lane] = blg[64 + lane] - cb; if (lane == 0) bls[rh * 132 + 128] = 0.f; }
    const LAS float* blh = bls + rh * 132;
    bf16x8 qf[4];
#pragma unroll
    for (int s = 0; s < 4; ++s) qf[s] = *(const bf16x8*)(qn + (((size_t)b * S + tq) * 8 + h) * 64 + 16 * s + 8 * hi);
    const float kn = 8.f * 1.01f * wmax(fmaxf(fmaxf(fabsf(p.in[5][lane]), fabsf(p.in[5][64 + lane])), fabsf(p.in[5][128 + lane])));
    const float mref = sqrtf(qnorm2<4>(qf)) * kn + bmax;
    f32x16 negm;
#pragma unroll
    for (int r = 0; r < 16; ++r) negm[r] = cb - mref;
    float g0 = gates[0], g1 = gates[1], g2 = gates[2];
    if (p.dbg_branch >= 0) { g0 = p.dbg_branch == 0 ? 1.f : 0.f; g1 = p.dbg_branch == 1 ? 1.f : 0.f; g2 = p.dbg_branch == 2 ? 1.f : 0.f; }
    LAS float* otl = (LAS float*)(lds + AL_OT) + w * 2048;
#ifdef PROF_SEL
    if (b == 0 && g == 0 && jt == 63 && threadIdx.x == 0) *PROF_SLOT(48) -= __builtin_amdgcn_s_memtime();
#endif
    const int nvmax = (q0 + 63 - 31) / 16 + 1, ntc = (nvmax + 63) / 64;
    Flash st; flash_init(st);
    unsigned kl[4], vl[4]; frag_offsets<64>(kl, vl, r32, hi);
    run_tiles<128, true, AL_K64, 8192, AL_V64>(ntc, lds, w, lane, 128u, 512u,
        [&](int i) { return kc + (size_t)i * 64 * 128; }, [&](int i) { return vct + (size_t)i * 128; },
        [&](int i, LAS unsigned char* kb, LAS unsigned char* vb) {
            const int cb0 = 64 * i + 4 * hi;
            tile_compute<64, 128, false>(st, kb, vb, qf, negm, kl, vl, true, [&](int r, int half, float& x) {
                const int c = cb0 + 32 * half + (r & 3) + 8 * (r >> 2); const int dist = tq - 16 * c - 31; x += blh[dist < 0 ? 0 : (dist > 128 ? 128 : dist)]; return dist >= 0; });
        });
    flash_accum<true>(otl, st, g0, hi, lane);
    unsigned mlo, mhi;
    int nsel;
    if (jt < 16) { const unsigned long long mk = (1ull << (jt + 1)) - 1ull; mlo = (unsigned)mk; mhi = (unsigned)(mk >> 32); nsel = jt + 1; if (tid <= jt) tl[tid] = (unsigned char)tid; }
    else {
        for (int i = tid; i < 64 * 65; i += 512) imp[i] = 0.f;
        const float lt = st.l + __shfl_xor(st.l, 32); const float linv = lt > 0.f ? frcp(lt) : 0.f;
        float xlast = 0.f;
        run_tiles<128, false, AL_K64, 8192, AL_V64>(ntc, lds, w, lane, 128u, 0u,
            [&](int i) { return kc + (size_t)i * 64 * 128; }, [&](int i) { return kc; },
            [&](int i, LAS unsigned char* kb, LAS unsigned char* vb) {
                f32x16 p0, p1; qk_tile<64, 128>(p0, p1, kb, qf, negm, kl);
                const int cb0 = 64 * i + 4 * hi;
                float sm[2][4], cr[2][4];
#pragma unroll
                for (int half = 0; half < 2; ++half)
#pragma unroll
                    for (int a = 0; a < 4; ++a) {
                        float s4 = 0.f, last = 0.f;
#pragma unroll
                        for (int k = 0; k < 4; ++k) {
                            const int r = 4 * a + k; const int c = cb0 + 32 * half + k + 8 * a; const int dist = tq - 16 * c - 31;
                            const float sc = (half ? p1[r] : p0[r]) + blh[dist < 0 ? 0 : (dist > 128 ? 128 : dist)];
                            const float pv = dist >= 0 ? fexp2(sc) * linv : 0.f;
                            s4 += pv; last = pv;
                        }
                        sm[half][a] = s4; cr[half][a] = last;
                    }
                float tot[2][4];
#pragma unroll
                for (int half = 0; half < 2; ++half)
#pragma unroll
                    for (int a = 0; a < 4; ++a) {
                        const float xs_ = __shfl_xor(cr[half][a], 32);
                        const float xp_ = (a > 0) ? __shfl_xor(cr[half][a > 0 ? a - 1 : 0], 32) : (half ? __shfl_xor(cr[0][3], 32) : xlast);
                        tot[half][a] = sm[half][a] + (hi ? xs_ : xp_);
                    }
                xlast = __shfl_xor(cr[1][3], 32);
                for (int rr = 0; rr < 4; ++rr) {
                    if (rh == rr) {
#pragma unroll
                        for (int half = 0; half < 2; ++half)
#pragma unroll
                            for (int a = 0; a < 4; ++a) { const int j = 16 * i + 8 * half + 2 * a + hi; imp[ql * 65 + j] += tot[half][a]; }
                    }
                    __syncthreads();
                }
            });
        if (p.dbg_branch == 1) { for (int i = tid; i < 4096; i += 512) ((float*)(p.ws + R_H))[((size_t)g * S + q0 + (i >> 6)) * 64 + (i & 63)] = imp[(i >> 6) * 65 + (i & 63)]; }
        {
            const int q = tid >> 3, jg = tid & 7;
            unsigned byte = 0;
#pragma unroll 1
            for (int jj = 0; jj < 8; ++jj) {
                const int j = jg * 8 + jj;
                if (j <= jt) {
                    const float x = imp[q * 65 + j]; const float vj = (j == jt || j == 0) ? 1e9f : x;
                    int rank = 0;
#pragma unroll 8
                    for (int i = 0; i < 64; ++i) { const float xi = imp[q * 65 + i]; const float vi = (i > jt) ? -1.f : ((i == jt || i == 0) ? 1e9f : xi); rank += (vi > vj || (vi == vj && i < j)) ? 1 : 0; }
                    if (rank < 16) byte |= 1u << jj;
                }
            }
            selb[q * 8 + jg] = (unsigned char)byte;
        }
        __syncthreads();
        if (w == 0) {
            unsigned a = ((const LAS unsigned*)selb)[lane * 2], c = ((const LAS unsigned*)selb)[lane * 2 + 1];
#pragma unroll
            for (int o = 1; o < 64; o <<= 1) { a |= __shfl_xor(a, o); c |= __shfl_xor(c, o); }
            const unsigned long long um = ((unsigned long long)c << 32) | a;
            if ((um >> lane) & 1ull) tl[__builtin_popcountll(um & ((1ull << lane) - 1ull))] = (unsigned char)lane;
            if (lane == 0) uni[0] = (unsigned)__builtin_popcountll(um);
        }
        __syncthreads();
        mlo = ((const LAS unsigned*)selb)[ql * 2]; mhi = ((const LAS unsigned*)selb)[ql * 2 + 1];
        nsel = (int)uni[0];
    }
    if (p.dbg_branch == 1 && rh == 0) { if (hi == 0) ((unsigned long long*)(p.ws + R_H + 4 * 1048576))[(size_t)g * S + tq] = ((unsigned long long)mhi << 32) | mlo; }
    __syncthreads();
    {
        const unsigned long long mymask = ((unsigned long long)mhi << 32) | mlo;
        nsel = __builtin_amdgcn_readfirstlane(nsel);
        flash_init(st);
        run_tiles<128, true, AL_K64, 8192, AL_V64>(nsel, lds, w, lane, 128u, (unsigned)(S * 2),
            [&](int i) { return ksn + (size_t)__builtin_amdgcn_readfirstlane((int)tl[i]) * 64 * 128; }, [&](int i) { return vst + (size_t)__builtin_amdgcn_readfirstlane((int)tl[i]) * 128; },
            [&](int i, LAS unsigned char* kb, LAS unsigned char* vb) {
                const int j = __builtin_amdgcn_readfirstlane((int)tl[i]);
                const bool mine = (mymask >> j) & 1ull;
                if (q0 + 32 * qh - (64 * j + 63) >= 128) tile_compute<64, 128, true>(st, kb, vb, qf, negm, kl, vl, mine, [&](int r, int half, float& x) { return true; });
                else { const int kb0 = 64 * j + 4 * hi;
                    tile_compute<64, 128, true>(st, kb, vb, qf, negm, kl, vl, mine, [&](int r, int half, float& x) { const int dist = tq - (kb0 + 32 * half + (r & 3) + 8 * (r >> 2)); x += blh[dist < 0 ? 0 : (dist > 128 ? 128 : dist)]; return dist >= 0; }); }
            });
        flash_accum<false>(otl, st, g1, hi, lane);
    }
    {
        const int j0 = jt >= 8 ? jt - 8 : 0, nw = jt - j0 + 1;
        flash_init(st);
        run_tiles<128, true, AL_K64, 8192, AL_V64>(nw, lds, w, lane, 128u, (unsigned)(S * 2),
            [&](int i) { return kwn + (size_t)(j0 + i) * 64 * 128; }, [&](int i) { return vwt + (size_t)(j0 + i) * 128; },
            [&](int i, LAS unsigned char* kb, LAS unsigned char* vb) {
                const int kb0 = 64 * (j0 + i) + 4 * hi;
                tile_compute<64, 128, false>(st, kb, vb, qf, negm, kl, vl, true, [&](int r, int half, float& x) { const int dist = tq - (kb0 + 32 * half + (r & 3) + 8 * (r >> 2)); x += blh[dist < 0 ? 0 : (dist > 128 ? 128 : dist)]; return dist >= 0 && dist < 512; });
            });
        flash_accum<false>(otl, st, g2, hi, lane);
    }
#pragma unroll
    for (int r = 0; r < 16; ++r) { const size_t ro = ((size_t)b * S + q0 + 32 * qh + crow(r, hi)) * 1024 + h * 64 + r32; ocat[ro] = f2bf(otl[r * 64 + lane]); ocat[ro + 32] = f2bf(otl[(16 + r) * 64 + lane]); }
    __syncthreads();
#ifdef PROF_SEL
    if (b == 0 && g == 0 && jt == 63 && threadIdx.x == 0) *PROF_SLOT(48) += __builtin_amdgcn_s_memtime();
#endif
}

__device__ __forceinline__ void phase_p4(const Params& p, LAS unsigned char* lds) {
    const int G = gridDim.x, c = blockIdx.x, nunits = 256 * NB;
#if NB == 8
    if (G == 256) {
        const int b = c & 7, idx = c >> 3, pi = idx & 7, hq = idx >> 3;
#pragma unroll 1
        for (int u = 0; u < 8; ++u) {
            if (u < 4) nsa_unit(p, lds, b, u >> 1, (u & 1) ? idx : 63 - idx);
            else mla_unit(p, lds, b, ((u - 4) >> 1) * 4 + hq, (u & 1) ? pi : 15 - pi);
        }
        return;
    }
#endif
    for (int j = 0;; ++j) {
        const int k = j * G + ((j & 1) ? (G - 1 - c) : c);
        if (j * G >= nunits) break;
        if (k >= nunits) continue;
        const int ty = UNIT_TYPES[k / NB], b = k % NB, kind = ty >> 9, a = (ty >> 6) & 7, cc = ty & 63;
        if (kind == 0) nsa_unit(p, lds, b, a, cc); else mla_unit(p, lds, b, a, cc);
    }
}
__device__ __forceinline__ void phase_norm(const float* x, const float* g, bf16_t* xn) {
    const int tid_ = ltid(); const int lane = tid_ & 63, gw = blockIdx.x * 8 + (tid_ >> 6), NGW = gridDim.x * 8;
    for (int m = gw; m < T; m += NGW) rms_row_to_bf16(x + (size_t)m * D, g, xn + (size_t)m * D, lane);
}
__device__ __forceinline__ void phase_conv(const Params& p) {
    const int tid = ltid(), lane = tid & 63, gw = blockIdx.x * 8 + (tid >> 6), NGW = gridDim.x * 8;
    const bf16_t* hh = (const bf16_t*)(p.ws + R_H); bf16_t* v = (bf16_t*)(p.ws + R_XA); const float* cw = p.in[22];
    constexpr int RUN = 16;
    float w0[2][8], w1[2][8], w2[2][8];
#pragma unroll
    for (int j = 0; j < 2; ++j) { const int d = 8 * lane + 512 * j; load8f(cw + d, w0[j], 1.f); load8f(cw + 1024 + d, w1[j], 1.f); load8f(cw + 2048 + d, w2[j], 1.f); }
    for (int run = gw; run < T / RUN; run += NGW) {
        const int m0 = run * RUN, s0 = m0 & (S - 1);
        float pm2[2][8], pm1[2][8];
#pragma unroll
        for (int j = 0; j < 2; ++j) { const int d = 8 * lane + 512 * j;
#pragma unroll
            for (int q = 0; q < 2; ++q) {
                float (&dst)[8] = q ? pm1[j] : pm2[j];
                if (s0 - 2 + q >= 0) { const bf16_t* r = hh + (size_t)(m0 - 2 + q) * 3072; float c[8], u[8]; unpack8(*(const u32x4*)(r + 1024 + d), c); unpack8(*(const u32x4*)(r + 2048 + d), u);
#pragma unroll
                    for (int i = 0; i < 8; ++i) dst[i] = c[i] * u[i]; }
                else {
#pragma unroll
                    for (int i = 0; i < 8; ++i) dst[i] = 0.f; }
            } }
#pragma unroll 4
        for (int rr = 0; rr < RUN; ++rr) {
            const int m = m0 + rr; const bf16_t* r = hh + (size_t)m * 3072;
#pragma unroll
            for (int j = 0; j < 2; ++j) { const int d = 8 * lane + 512 * j;
                float b[8], c[8], u[8], y[8]; unpack8(*(const u32x4*)(r + d), b); unpack8(*(const u32x4*)(r + 1024 + d), c); unpack8(*(const u32x4*)(r + 2048 + d), u);
#pragma unroll
                for (int i = 0; i < 8; ++i) { const float cu = c[i] * u[i]; y[i] = b[i] * (w0[j][i] * pm2[j][i] + w1[j][i] * pm1[j][i] + w2[j][i] * cu); pm2[j][i] = pm1[j][i]; pm1[j][i] = cu; }
                *(u32x4*)(v + (size_t)m * 1024 + d) = pack8(y); }
        }
    }
}
__device__ __forceinline__ void phase_norm_router(const Params& p, LAS unsigned char* lds) {
    const int tid = ltid(), lane = tid & 63, wave = tid >> 6, gw = blockIdx.x * 8 + wave, NGW = gridDim.x * 8;
    const float* x3 = p.out; const float* g = p.in[24]; bf16_t* xn = (bf16_t*)(p.ws + R_XN);
    LAS float* wr = (LAS float*)lds;
    LAS int* lcnt = (LAS int*)(lds + 32768); LAS int* gb = lcnt + 8;
    int* te = (int*)(p.ws + SM_TE); float* tw = (float*)(p.ws + SM_TW); int* rank = (int*)(p.ws + SM_RANK); int* cnt = (int*)(p.ws + SM_CTL);
    for (int i = tid; i < 8192; i += 512) wr[i] = p.in[25][i];
    if (tid < 8) lcnt[tid] = 0;
    __syncthreads();
    for (int m = gw; m < T; m += NGW) {
        const f32x4* xr = (const f32x4*)(x3 + (size_t)m * D) + lane; const f32x4* gr = (const f32x4*)g + lane;
        f32x4 v[4]; float s = 0.f;
#pragma unroll
        for (int j = 0; j < 4; ++j) { v[j] = xr[64 * j]; s += (v[j].x * v[j].x + v[j].y * v[j].y) + (v[j].z * v[j].z + v[j].w * v[j].w); }
        const float r = rsqrtf(wsum(s) * (1.f / 1024.f) + EPS);
        float lg[8];
#pragma unroll
        for (int e = 0; e < 8; ++e) lg[e] = 0.f;
        u32x2* o8 = (u32x2*)(xn + (size_t)m * D) + lane;
#pragma unroll
        for (int j = 0; j < 4; ++j) { const f32x4 gg = gr[64 * j]; const f32x4 y = {v[j].x * r * gg.x, v[j].y * r * gg.y, v[j].z * r * gg.z, v[j].w * r * gg.w};
            u32x2 w; w.x = cvtpk(y.x, y.y); w.y = cvtpk(y.z, y.w); o8[64 * j] = w;
#pragma unroll
            for (int i = 0; i < 4; ++i) { const int d = 4 * lane + 256 * j + i; const f32x4 w0 = *(const LAS f32x4*)(wr + d * 8), w1 = *(const LAS f32x4*)(wr + d * 8 + 4);
                lg[0] += y[i] * w0.x; lg[1] += y[i] * w0.y; lg[2] += y[i] * w0.z; lg[3] += y[i] * w0.w; lg[4] += y[i] * w1.x; lg[5] += y[i] * w1.y; lg[6] += y[i] * w1.z; lg[7] += y[i] * w1.w; } }
#pragma unroll
        for (int e = 0; e < 8; ++e) lg[e] = wsum(lg[e]) + p.in[26][e];
        int e1 = 0; float l1 = lg[0];
#pragma unroll
        for (int e = 1; e < 8; ++e) if (lg[e] > l1) { l1 = lg[e]; e1 = e; }
        int e2 = -1; float l2 = -3e38f;
#pragma unroll
        for (int e = 0; e < 8; ++e) if (e != e1 && lg[e] > l2) { l2 = lg[e]; e2 = e; }
        if (lane == 0) {
            const float w1 = 1.f / (1.f + __expf(l2 - l1));
            te[m * 2] = e1; te[m * 2 + 1] = e2; tw[m * 2] = w1; tw[m * 2 + 1] = 1.f - w1;
            rank[m * 2] = __hip_atomic_fetch_add(&lcnt[e1], 1, __ATOMIC_RELAXED, __HIP_MEMORY_SCOPE_WORKGROUP); rank[m * 2 + 1] = __hip_atomic_fetch_add(&lcnt[e2], 1, __ATOMIC_RELAXED, __HIP_MEMORY_SCOPE_WORKGROUP);
        }
    }
    __syncthreads();
    if (tid < 8) gb[tid] = atomicAdd(&cnt[tid], lcnt[tid]);
    __syncthreads();
    for (int m = gw; m < T; m += NGW) if (lane < 2) rank[m * 2 + lane] += gb[te[m * 2 + lane]];
}
__device__ __forceinline__ void phase_moe_gather(const Params& p) {
    const int tid = ltid(), lane = tid & 63, gw = blockIdx.x * 8 + (tid >> 6), NGW = gridDim.x * 8;
    const int* cnt = (const int*)(p.ws + SM_CTL); const int* te = (const int*)(p.ws + SM_TE); const float* tw = (const float*)(p.ws + SM_TW); const int* rank = (const int*)(p.ws + SM_RANK);
    int* pos = (int*)(p.ws + SM_POS); float* roww = (float*)(p.ws + SM_ROWW); int* tile_e = (int*)(p.ws + SM_TILEE);
    int* rowtok = (int*)(p.ws + SM_ROWTOK);
    int off[9]; off[0] = 0;
#pragma unroll
    for (int e = 0; e < 8; ++e) off[e + 1] = off[e] + ((cnt[e] + 255) & ~255);
    if (blockIdx.x == 0) {
        for (int i = tid; i < ROWS_MAX / 256; i += 512) { int e = -1;
#pragma unroll
            for (int k = 0; k < 8; ++k) if (i * 256 >= off[k] && i * 256 < off[k + 1]) e = k;
            tile_e[i] = e < 0 ? 0 : e; }
        if (tid == 0) ((int*)(p.ws + SM_CTL))[8] = off[8];
    }
    if (blockIdx.x < 8 && tid < 256) {
#pragma unroll
        for (int e = 0; e < 8; ++e) if (e == (int)blockIdx.x) { const int c = cnt[e]; if (c + tid < off[e + 1] - off[e]) { roww[off[e] + c + tid] = 0.f; rowtok[off[e] + c + tid] = -1; } }
    }
    for (int pi0 = gw * 4; pi0 < 2 * T; pi0 += NGW * 4) {
        int r[4]; float w[4];
#pragma unroll
        for (int q = 0; q < 4; ++q) { const int e = te[pi0 + q]; int o = 0;
#pragma unroll
            for (int k = 0; k < 8; ++k) if (k == e) o = off[k];
            r[q] = o + rank[pi0 + q]; w[q] = tw[pi0 + q]; }
#pragma unroll
        for (int q = 0; q < 4; ++q) if (lane == q) { pos[pi0 + q] = r[q]; roww[r[q]] = w[q]; rowtok[r[q]] = (pi0 + q) >> 1; }
    }
}
__device__ __forceinline__ void phase_moe_combine(const Params& p) {
    const int tid_ = ltid(); const int lane = tid_ & 63, gw = blockIdx.x * 8 + (tid_ >> 6), NGW = gridDim.x * 8;
    const int* pos = (const int*)(p.ws + SM_POS); const bf16_t* ym = (const bf16_t*)(p.ws + R_XA);
    for (int m0 = gw * 2; m0 < T; m0 += NGW * 2) {
        int ps[4];
#pragma unroll
        for (int q = 0; q < 4; ++q) ps[q] = pos[m0 * 2 + q];
        f32x4 x[2][4]; u32x2 ya[2][4], yc[2][4];
#pragma unroll
        for (int q = 0; q < 2; ++q)
#pragma unroll
            for (int j = 0; j < 4; ++j) { const int d = 4 * lane + 256 * j;
                x[q][j] = *(const f32x4*)(p.out + (size_t)(m0 + q) * D + d); ya[q][j] = *(const u32x2*)(ym + (size_t)ps[2 * q] * D + d); yc[q][j] = *(const u32x2*)(ym + (size_t)ps[2 * q + 1] * D + d); }
#pragma unroll
        for (int q = 0; q < 2; ++q)
#pragma unroll
            for (int j = 0; j < 4; ++j) { const int d = 4 * lane + 256 * j; f32x4 o = x[q][j]; const u32x2 a = ya[q][j], c = yc[q][j];
                o.x += bflo(a.x) + bflo(c.x); o.y += bfhi(a.x) + bfhi(c.x); o.z += bflo(a.y) + bflo(c.y); o.w += bfhi(a.y) + bfhi(c.y);
                *(f32x4*)(p.out + (size_t)(m0 + q) * D + d) = o; }
    }
}

#define XB_TMO      128
#define XB_XCNT(j)  (256  + 64 * (j))
#define XB_XSUB(j)  (1280 + 64 * (j))
#define XB_XGEN(j)  (2304 + 64 * (j))
#define XB_TOP      3328
#define XB_TOPGEN   3392
#define XCD_BAR_WORDS 3456
#define XB_SPIN_CAP (1u << 18)

__device__ __forceinline__ unsigned xb_ld(unsigned* p)              { return __hip_atomic_load(p, __ATOMIC_RELAXED, __HIP_MEMORY_SCOPE_AGENT); }
__device__ __forceinline__ unsigned xb_add(unsigned* p, unsigned v) { return __hip_atomic_fetch_add(p, v, __ATOMIC_RELAXED, __HIP_MEMORY_SCOPE_AGENT); }
__device__ __forceinline__ unsigned xb_xcc_id() { return (unsigned)__builtin_amdgcn_s_getreg((3 << 11) | 20) & 0xFu; }
#define XB_SPIN(cond, bar) do { unsigned _sp = 0; while (cond) { __builtin_amdgcn_s_sleep(1); \
    if ((++_sp & 255u) == 0u) { if (xb_ld(&(bar)[XB_TMO])) break; if (_sp > XB_SPIN_CAP) { atomicAdd(&(bar)[XB_TMO], 1u); break; } } } } while (0)

struct XcdBarrier {
    unsigned* bar; unsigned x;
    volatile LAS unsigned* st;
};

__device__ __forceinline__ XcdBarrier xcd_barrier_post(unsigned* bar, volatile LAS unsigned* st) {
    XcdBarrier b; b.bar = bar; b.x = xb_xcc_id(); b.st = st;
    if (threadIdx.x == 0) (void)xb_add(&bar[XB_XCNT(b.x)], 1u);
    return b;
}
__device__ __forceinline__ void xcd_barrier_complete(unsigned* bar, unsigned x, unsigned& nloc, unsigned& nx) {
    const unsigned G = gridDim.x * gridDim.y * gridDim.z;
    unsigned sum, cnt, mine, sp = 0u;
    for (;;) {
        sum = 0u; cnt = 0u; mine = 0u;
#pragma unroll
        for (unsigned j = 0; j < 16; ++j) { const unsigned c = xb_ld(&bar[XB_XCNT(j)]); sum += c; cnt += (c > 0u) ? 1u : 0u; mine = (j == x) ? c : mine; }
        if (sum == G) break;
        __builtin_amdgcn_s_sleep(1);
        if ((++sp & 255u) == 0u) { if (xb_ld(&bar[XB_TMO])) break; if (sp > XB_SPIN_CAP) { atomicAdd(&bar[XB_TMO], 1u); break; } }
    }
    nloc = mine > 0u ? mine : 1u; nx = cnt > 0u ? cnt : 1u;
}

__device__ __forceinline__ void xcd_barrier(const XcdBarrier& b) {
    asm volatile("s_waitcnt vmcnt(0)" ::: "memory");
    __syncthreads();
    if (threadIdx.x == 0) {
        unsigned* bar = b.bar;
        __builtin_amdgcn_s_waitcnt(0);
        unsigned nloc = b.st[0], nx = b.st[1];
        if (nloc == 0u) { xcd_barrier_complete(bar, b.x, nloc, nx); b.st[0] = nloc; b.st[1] = nx; }
        const unsigned old = xb_add(&bar[XB_XSUB(b.x)], 1u);
        const unsigned gen = old / nloc;
        if (old + 1u == (gen + 1u) * nloc) {
            __builtin_amdgcn_fence(__ATOMIC_RELEASE, "agent");
            asm volatile("s_waitcnt vmcnt(0)" ::: "memory");
            const unsigned og = xb_add(&bar[XB_TOP], 1u);
            const unsigned tg = og / nx;
            if (og + 1u == (tg + 1u) * nx) xb_add(&bar[XB_TOPGEN], 1u);
            else XB_SPIN(xb_ld(&bar[XB_TOPGEN]) == tg, bar);
            __builtin_amdgcn_fence(__ATOMIC_ACQUIRE, "agent");
            xb_add(&bar[XB_XGEN(b.x)], 1u);
            asm volatile("s_waitcnt vmcnt(0)" ::: "memory");
        } else {
            XB_SPIN(xb_ld(&bar[XB_XGEN(b.x)]) == gen, bar);
            __builtin_amdgcn_fence(__ATOMIC_ACQUIRE, "agent");
            asm volatile("s_waitcnt vmcnt(0)" ::: "memory");
        }
    }
    __syncthreads();
}


__global__ void __launch_bounds__(512) mega_fwd(Params p) {
    extern __shared__ __attribute__((aligned(16))) unsigned char lds_raw[];
    LAS unsigned char* lds = (LAS unsigned char*)lds_raw;
    cg::grid_group grid = cg::this_grid();
    volatile LAS unsigned* bst = (volatile LAS unsigned*)(lds + 140032);
    if (threadIdx.x == 0) { bst[0] = 0u; bst[1] = 0u; const unsigned long long ba = (unsigned long long)(p.ws + SM_BAR); bst[2] = (unsigned)ba; bst[3] = (unsigned)(ba >> 32); }
    __syncthreads();
    (void)xcd_barrier_post((unsigned*)(p.ws + SM_BAR), bst);
#ifdef PROF_SEL
#define PSTAMP(k) do { if (blockIdx.x == 0 && threadIdx.x == 0) { volatile LAS unsigned* pl_ = (volatile LAS unsigned*)(lds + 140032 + 16); const unsigned long long now_ = __builtin_amdgcn_s_memrealtime(); const unsigned long long last_ = ((unsigned long long)pl_[1] << 32) | pl_[0]; *PROF_SLOT(k) += now_ - last_; pl_[0] = (unsigned)now_; pl_[1] = (unsigned)(now_ >> 32); } } while (0)
#else
#define PSTAMP(k)
#endif
#define GSYNC() do { XcdBarrier xb_; volatile LAS unsigned* st_ = (volatile LAS unsigned*)(lds + 140032); xb_.bar = (unsigned*)(((unsigned long long)st_[3] << 32) | st_[2]); xb_.x = xb_xcc_id(); xb_.st = st_; xcd_barrier(xb_); } while (0)
#ifdef PROF_SEL
    if (threadIdx.x == 0) { volatile LAS unsigned* pl_ = (volatile LAS unsigned*)(lds + 140032 + 16); const unsigned long long now_ = __builtin_amdgcn_s_memrealtime(); pl_[0] = (unsigned)now_; pl_[1] = (unsigned)(now_ >> 32); }
#endif
    const int G = gridDim.x, c = blockIdx.x;
#define LP() bf16_t* W = (bf16_t*)p.ws; bf16_t* xn = (bf16_t*)(p.ws + R_XN); float* x1 = (float*)(p.ws + R_XA); pg8::StaticOrder SO; (void)W; (void)xn; (void)x1; (void)SO
#ifndef PHMASK
#define PHMASK 0xFFFFFFFFu
#endif
#ifndef REPEAT_MASK
#define REPEAT_MASK 0u
#endif
#define PH(k) if (((PHMASK >> (k)) & 1u) && (k) >= p.ph_lo && (k) <= p.ph_hi)
#define RPT(k) if ((REPEAT_MASK >> (k)) & 1u)
    PH(0) { LP(); phase_p0(p, lds); }
    GSYNC(); PSTAMP(0);
    if (p.ph_lo == -12345) grid.sync();
    RPT(0) { { LP(); phase_p0(p, lds); } GSYNC(); }
    PH(1) { LP();
        pg8::Gemm g{xn, W + W_IN_E / 2, T, 1792, 1024, 1024, nullptr, 0, nullptr}; SO.init(T, 1792, G, c);
        pg8::EpiBf16<0> E{(bf16_t*)(p.ws + R_H), 1792, nullptr, nullptr};
        pg8::gemm_phase<pg8::EpiBf16<0>, true>(lds, g, SO, E);
    }
    GSYNC(); PSTAMP(1);
    PH(2) { LP(); phase_p2(p, lds); }
    GSYNC(); PSTAMP(2);
    RPT(2) { { LP(); phase_p2(p, lds); } GSYNC(); }
    PH(3) { LP();
        const int nCu = 2 * (NB * 512 / 256), Gc = (nCu < G / 2) ? nCu : 0;
        if (Gc == 0 || c < Gc) {
            for (int kv = 0; kv < 2; ++kv) {
                pg8::Gemm g{(const bf16_t*)(p.ws + R_XA + (kv ? A_VCIN : A_KCIN)), W + W_CW1 / 2 + (size_t)kv * 256 * 2048, NB * 512, 256, 2048, 1024, nullptr, 0, nullptr};
                if (Gc) SO.init(NB * 512, 256, Gc / 2, c - kv * (Gc / 2)); else SO.init(NB * 512, 256, G, c);
                pg8::EpiBf16<2> E{(bf16_t*)(p.ws + SM_HID) + (size_t)kv * NB * 512 * 256, 256, (const float*)(p.ws + SM_B1) + kv * 256, nullptr};
                if (Gc == 0 || (c / (Gc / 2)) == kv) pg8::gemm_phase<pg8::EpiBf16<2>, true>(lds, g, SO, E);
            }
        }
        if (Gc == 0 || c >= Gc) {
            {
                pg8::Gemm g{(const bf16_t*)(p.ws + R_XA + A_CQN), W + W_UQ / 2, T, 1024, 256, 256, nullptr, 0, nullptr}; SO.init(T, 1024, G - Gc, c - Gc);
                pg8::EpiBf16<0> E{(bf16_t*)(p.ws + R_H), 1024, nullptr, nullptr};
                pg8::gemm_phase<pg8::EpiBf16<0>, true>(lds, g, SO, E);
            }
            {
                pg8::Gemm g{(const bf16_t*)(p.ws + R_XA + A_CKVN), W + W_UKV / 2, T, 1024, 128, 128, nullptr, 0, nullptr}; SO.init(T, 1024, G - Gc, c - Gc);
                pg8::EpiBf16<0> E{(bf16_t*)(p.ws + R_H + (size_t)T * 2048), 1024, nullptr, nullptr};
                pg8::gemm_phase<pg8::EpiBf16<0>, true>(lds, g, SO, E);
            }
        }
    }
    GSYNC(); PSTAMP(3);
    PH(4) { LP(); phase_p3b(p, lds); }
    GSYNC(); PSTAMP(4);
    RPT(4) { { LP(); phase_p3b(p, lds); } GSYNC(); }
    PH(5) { LP(); phase_p4(p, lds); }
    GSYNC(); PSTAMP(5);
    RPT(5) { { LP(); phase_p4(p, lds); } GSYNC(); }
    PH(6) { LP();
        pg8::Gemm g{xn, W + W_OUT_E / 2, T, 1024, 1024, 1024, nullptr, 0, nullptr}; SO.init(T, 1024, G, c);
        pg8::EpiResStat<false> E{p.in[0], (bf16_t*)p.out, (float*)(p.ws + SM_SSP1), 1024};
        pg8::gemm_phase<pg8::EpiResStat<false>, true>(lds, g, SO, E);
    }
    GSYNC(); PSTAMP(6);
    PH(7) { }
    PH(8) { LP();
        pg8::Gemm g{(const bf16_t*)p.out, W + W_GU / 2, T, 5632, 1024, 1024, nullptr, 0, nullptr}; SO.init(T, 5632, G, c);
        pg8::EpiSwiGLU E{(bf16_t*)(p.ws + R_H), 2816, (const float*)(p.ws + SM_SSP1)};
        pg8::gemm_phase<pg8::EpiSwiGLU, true>(lds, g, SO, E);
    }
    GSYNC(); PSTAMP(8);
    PH(9) { LP();
        pg8::Gemm g{(const bf16_t*)(p.ws + R_H), W + W_D / 2, T, 1024, 2816, 2816, nullptr, 0, nullptr}; SO.init(T, 1024, G, c);
        pg8::EpiResStat<true> E{(const bf16_t*)p.out, xn, (float*)(p.ws + SM_SSP2), 1024};
        pg8::gemm_phase<pg8::EpiResStat<true>, true>(lds, g, SO, E);
    }
    GSYNC(); PSTAMP(9);
    PH(10) { }
    PH(11) { LP();
        pg8::Gemm g{xn, W + W_IN_O / 2, T, 3072, 1024, 1024, nullptr, 0, nullptr}; SO.init(T, 3072, G, c);
        pg8::EpiBf16<0> E{(bf16_t*)(p.ws + R_H), 3072, nullptr, (const float*)(p.ws + SM_SSP2)};
        pg8::gemm_phase<pg8::EpiBf16<0>, true>(lds, g, SO, E);
    }
    GSYNC(); PSTAMP(11);
    PH(12) { LP(); phase_conv(p); }
    GSYNC(); PSTAMP(12);
    RPT(12) { { LP(); phase_conv(p); } GSYNC(); }
    PH(13) { LP();
        pg8::Gemm g{(const bf16_t*)x1, W + W_OUT_O / 2, T, 1024, 1024, 1024, nullptr, 0, nullptr}; SO.init(T, 1024, G, c);
        pg8::EpiResF32B E{xn, p.out, 1024};
        pg8::gemm_phase<pg8::EpiResF32B, true>(lds, g, SO, E);
    }
    GSYNC(); PSTAMP(13);
    PH(14) { LP(); phase_norm_router(p, lds); }
    GSYNC(); PSTAMP(14);
    PH(15) { LP(); phase_moe_gather(p); }
    GSYNC(); PSTAMP(15);
    PH(16) { LP(); const int mrows = ((const int*)(p.ws + SM_CTL))[8];
        pg8::Gemm g{xn, W + W_MGU / 2, mrows, 2816, 1024, 1024, (const int*)(p.ws + SM_TILEE), (size_t)2816 * 1024, (const int*)(p.ws + SM_ROWTOK)}; SO.init(mrows, 2816, G, c);
        pg8::EpiSwiGLU E{(bf16_t*)(p.ws + R_H), 1408, nullptr};
        pg8::gemm_phase<pg8::EpiSwiGLU, true, true>(lds, g, SO, E);
    }
    GSYNC(); PSTAMP(16);
    PH(17) { LP(); const int mrows = ((const int*)(p.ws + SM_CTL))[8];
        pg8::Gemm g{(const bf16_t*)(p.ws + R_H), W + W_MD / 2, mrows, 1024, 1408, 1408, (const int*)(p.ws + SM_TILEE), (size_t)1024 * 1408, nullptr}; SO.init(mrows, 1024, G, c);
        pg8::EpiRowScaleBf16 E{(bf16_t*)(p.ws + R_XA), 1024, (const float*)(p.ws + SM_ROWW)};
        pg8::gemm_phase<pg8::EpiRowScaleBf16, true>(lds, g, SO, E);
    }
    GSYNC(); PSTAMP(17);
    PH(18) { LP(); phase_moe_combine(p); }
#ifdef PROF_SEL
    GSYNC(); PSTAMP(18);
    GSYNC();
    {
        unsigned long long v_ = *PROF_SLOT(PROF_SEL);
#ifdef PROF_DIV
        const unsigned long long dv_ = *PROF_SLOT(PROF_DIV); v_ = dv_ ? v_ / dv_ : 0ull;
#endif
        unsigned long long a_ = v_ / (unsigned long long)(PROF_UNIT); if (a_ > 27ull) a_ = 27ull;
        const float sc_ = 1.f + (float)a_;
        for (size_t i = (size_t)blockIdx.x * 512 + threadIdx.x; i < (size_t)S * 1024 / 4; i += (size_t)gridDim.x * 512) { f32x4* o = (f32x4*)p.out + i; *o = *o * sc_; }
    }
#endif
#undef PH
}

inline void launch(void* const* d_in, float* d_out, void* d_ws, size_t ws_size, hipStream_t stream, int ph_lo = 0, int ph_hi = 99, int dbg_branch = -1) {
    static int grid = 0;
    if (grid == 0) {
        int dev = 0, cus = 0, per_cu = 0;
        hipGetDevice(&dev); hipDeviceGetAttribute(&cus, hipDeviceAttributeMultiprocessorCount, dev);
        hipFuncSetAttribute((const void*)mega_fwd, hipFuncAttributeMaxDynamicSharedMemorySize, LDS_BYTES);
        hipOccupancyMaxActiveBlocksPerMultiprocessor(&per_cu, (const void*)mega_fwd, 512, LDS_BYTES);
        if (per_cu < 1) { fprintf(stderr, "occupancy query says %d blocks/CU\n", per_cu); per_cu = 1; }
        grid = cus;
        if (WS_FAST_END > ws_size) { fprintf(stderr, "ws too small: need %zu have %zu\n", (size_t)WS_FAST_END, ws_size); grid = -1; }
    }
    if (grid < 0) return;
    if (ph_lo <= 14 && ph_hi >= 14) hipMemsetAsync((char*)d_ws + SM_CTL, 0, 4096, stream);
    hipMemsetAsync((char*)d_ws + SM_BAR, 0, 16384, stream);
    Params p{};
    for (int i = 0; i < 30; ++i) p.in[i] = (const float*)d_in[i];
    p.out = d_out; p.ws = (unsigned char*)d_ws; p.ph_lo = ph_lo; p.ph_hi = ph_hi; p.dbg_branch = dbg_branch;
    void* args[] = {&p};
    hipError_t e = hipLaunchCooperativeKernel((const void*)mega_fwd, dim3(grid), dim3(512), args, LDS_BYTES, stream);
    if (e != hipSuccess) fprintf(stderr, "cooperative launch failed: %s (grid %d)\n", hipGetErrorString(e), grid);
}
}
extern "C" void kernel_launch(void* const* d_in, const int* in_sizes, int n_in, void* d_out, int out_size, void* d_ws, size_t ws_size, hipStream_t stream) {
    fast::launch(d_in, (float*)d_out, d_ws, ws_size, stream);
}
```

```cpp
#include <hip/hip_runtime.h>
#include <hip/hip_bf16.h>
#include <stdint.h>
#include <stdio.h>
#include <string.h>
#include <hip/hip_cooperative_groups.h>
namespace cg = cooperative_groups;
#define NB 8
#define REPEAT_MASK 0x0u
namespace gold {
constexpr int S = 4096, D = 1024, HW = 1720;
constexpr float EPS = 1e-6f;

__device__ const unsigned char T5B[128] = {0, 1, 2, 3, 4, 5, 6, 7, 8, 9, 10, 11, 12, 13, 14, 15, 16, 16, 16, 17, 17, 18, 18, 18, 19, 19, 19, 20, 20, 20, 20, 21, 21, 21, 21, 22, 22, 22, 22, 22, 23, 23, 23, 23, 23, 23, 24, 24, 24, 24, 24, 24, 25, 25, 25, 25, 25, 25, 25, 26, 26, 26, 26, 26, 26, 26, 26, 27, 27, 27, 27, 27, 27, 27, 27, 27, 27, 28, 28, 28, 28, 28, 28, 28, 28, 28, 28, 29, 29, 29, 29, 29, 29, 29, 29, 29, 29, 29, 29, 30, 30, 30, 30, 30, 30, 30, 30, 30, 30, 30, 30, 30, 30, 31, 31, 31, 31, 31, 31, 31, 31, 31, 31, 31, 31, 31, 31};
}
#ifndef NB
#define NB 8
#endif
namespace fast {
#define LAS __attribute__((address_space(3)))
typedef unsigned short bf16_t;
typedef short bf16x8 __attribute__((ext_vector_type(8)));
typedef float f32x4 __attribute__((ext_vector_type(4)));
typedef float f32x2 __attribute__((ext_vector_type(2)));
typedef float f32x16 __attribute__((ext_vector_type(16)));
typedef unsigned u32x4 __attribute__((ext_vector_type(4)));
typedef unsigned u32x2 __attribute__((ext_vector_type(2)));
typedef __bf16 bf16x2_t __attribute__((ext_vector_type(2)));

constexpr int S = 4096, T = NB * S, D = 1024;
constexpr float EPS = 1e-6f, LOG2E = 1.4426950408889634f;

__device__ __forceinline__ unsigned cvtpk(float lo, float hi) { f32x2 v = {lo, hi}; bf16x2_t b = __builtin_convertvector(v, bf16x2_t); return __builtin_bit_cast(unsigned, b); }
__device__ __forceinline__ bf16_t f2bf(float f) { return (bf16_t)(cvtpk(f, 0.f) & 0xffffu); }
__device__ __forceinline__ float bf2f(bf16_t u) { return __builtin_bit_cast(float, (unsigned)u << 16); }
__device__ __forceinline__ float bflo(unsigned u) { return __builtin_bit_cast(float, u << 16); }
__device__ __forceinline__ float bfhi(unsigned u) { return __builtin_bit_cast(float, u & 0xffff0000u); }
__device__ __forceinline__ float wsum(float v) {
#pragma unroll
    for (int o = 1; o < 64; o <<= 1) v += __shfl_xor(v, o);
    return v;
}
__device__ __forceinline__ float fexp2(float x) { return __builtin_amdgcn_exp2f(x); }
__device__ __forceinline__ float frcp(float x) { return __builtin_amdgcn_rcpf(x); }
__device__ __forceinline__ float silu_f(float x) { return x * frcp(1.f + fexp2(-x * LOG2E)); }
__device__ __forceinline__ float gelu_tanh_f(float x) {
    const float u = 0.7978845608028654f * (x + 0.044715f * x * x * x);
    return x * frcp(1.f + fexp2(-2.f * LOG2E * u));
}

namespace pg8 {
constexpr int BM = 256, BK = 64, HALF = 128, HTB = HALF * BK * 2, STAGE_BYTES = 8 * HTB, NXCD = 8, WGM = 8;
__host__ __device__ __forceinline__ int lds_byte(int r, int c) { const int st = (r >> 4) * 2 + (c >> 5), rr = r & 15, cc = c & 31, ob = rr * 64 + cc * 2; return st * 1024 + (ob ^ (((ob >> 9) & 1) << 5)); }
__host__ __device__ __forceinline__ void stage_rc(int b, int& R, int& C) { const int st = b / 1024, sb = b % 1024, swz = sb ^ (((sb >> 9) & 1) << 5); R = (st >> 1) * 16 + swz / 64; C = (st & 1) * 32 + (swz % 64) / 2; }
__host__ __device__ __forceinline__ int perm32(int rho) { const int n = rho >> 4, i = rho & 15; return 8 * (i >> 2) + 4 * n + (i & 3); }

struct Unit { int pm, pn; };
struct Gemm { const bf16_t* A; const bf16_t* Bt; int M, N, K, lda; const int* tile_e; size_t estride; const int* rowidx; };

struct StaticOrder {
    int nM, nN, nwg, G, c;
    __device__ void init(int M, int N, int G_, int c_) { nM = M / BM; nN = N / BM; nwg = nM * nN; G = G_; c = c_; }
    __device__ bool next(int i, Unit& u) const {
        const long L = (long)i * G + c; if (L >= nwg) return false;
        int wgid = (int)L; { const int q = nwg / NXCD, r = nwg % NXCD, xcd = wgid % NXCD, off = wgid / NXCD; wgid = (xcd < r ? xcd * (q + 1) : r * (q + 1) + (xcd - r) * q) + off; }
        const int nig = WGM * nN, gid = wgid / nig, fm = gid * WGM, gsz = (nM - fm) < WGM ? (nM - fm) : WGM;
        u.pm = fm + ((wgid % nig) % gsz); u.pn = (wgid % nig) / gsz; return true;
    }
};

template <class Epi, bool ALIGN_EPI, bool GATHER = false>
__device__ __forceinline__ void gemm_phase(LAS unsigned char* lds, const Gemm g, const StaticOrder& S, const Epi& E) {
    int tid = threadIdx.x; asm volatile("" : "+v"(tid));
    const int wid = __builtin_amdgcn_readfirstlane(tid >> 6), lane = tid & 63, wr = wid >> 2, wc = wid & 3, fr = lane & 15, fq = lane >> 4;
    const int K = g.K, nt = K / BK, lda = g.lda;
    unsigned voffA[2], voffB[2];
#pragma unroll
    for (int i = 0; i < 2; ++i) { int R, C; stage_rc(tid * 16 + i * 8192, R, C); const int Rb = Epi::PERM ? ((R & ~31) + perm32(R & 31)) : R;
        voffA[i] = (unsigned)(R * lda + C) * 2u; voffB[i] = (unsigned)(Rb * K + C) * 2u; }
    const size_t kstep = (size_t)(BK * 2);
    const size_t hsA = GATHER ? 0 : (size_t)HALF * lda * 2, tsA = 2 * hsA, hsB = (size_t)HALF * K * 2, tsB = 2 * hsB;
    unsigned vgc[2][2], vgn[2][2];
#define PG8_GOFF(pm_, vg) do { _Pragma("unroll") for (int h_ = 0; h_ < 2; ++h_) _Pragma("unroll") for (int i_ = 0; i_ < 2; ++i_) { int R_, C_; stage_rc(tid * 16 + i_ * 8192, R_, C_); \
        int tok_ = g.rowidx[(pm_) * BM + h_ * HALF + R_]; tok_ = tok_ < 0 ? 0 : tok_; vg[h_][i_] = (unsigned)(tok_ * lda + C_) * 2u; } } while (0)
#define PG8_STAGE_A(bufoff, gbase, h, nx) do { unsigned va_[2]; _Pragma("unroll") for (int i_ = 0; i_ < 2; ++i_) va_[i_] = GATHER ? ((nx) ? vgn[h][i_] : vgc[h][i_]) : voffA[i_]; PG8_STAGE(bufoff, gbase, va_); } while (0)
    const unsigned ldsw = (unsigned)wid * 1024u;
    const int aoff = lds_byte(wr * 64 + fr, fq * 8), boff = lds_byte(wc * 32 + fr, fq * 8);
#define PG8_SA(b, h) (((b) * 2 + (h)) * HTB)
#define PG8_SB(b, h) ((4 + (b) * 2 + (h)) * HTB)
#define PG8_STAGE(bufoff, gbase, voff) do { _Pragma("unroll") for (int _i = 0; _i < 2; ++_i) \
        __builtin_amdgcn_global_load_lds((const unsigned*)((const char*)(gbase) + (voff)[_i]), (LAS unsigned*)(lds + (bufoff) + ldsw + _i * 8192), 16, 0, 0); } while (0)
#define PG8_LDA(dst, b, h) do { _Pragma("unroll") for (int m = 0; m < 4; ++m) _Pragma("unroll") for (int k = 0; k < 2; ++k) dst[m][k] = *(const LAS bf16x8*)(lds + PG8_SA(b, h) + aoff + m * 2048 + k * 1024); } while (0)
#define PG8_LDB(dst, b, h) do { _Pragma("unroll") for (int n = 0; n < 2; ++n) _Pragma("unroll") for (int k = 0; k < 2; ++k) dst[n][k] = *(const LAS bf16x8*)(lds + PG8_SB(b, h) + boff + n * 2048 + k * 1024); } while (0)
#define PG8_MMA(ai, bj, At, Bt) do { __builtin_amdgcn_s_setprio(1); _Pragma("unroll") for (int m = 0; m < 4; ++m) _Pragma("unroll") for (int n = 0; n < 2; ++n) _Pragma("unroll") for (int k = 0; k < 2; ++k) \
        acc[ai][bj][m][n] = __builtin_amdgcn_mfma_f32_16x16x32_bf16(Bt[n][k], At[m][k], acc[ai][bj][m][n], 0, 0, 0); __builtin_amdgcn_s_setprio(0); } while (0)
#define PG8_WAIT_V(n) asm volatile("s_waitcnt vmcnt(" #n ")" ::: "memory")
#define PG8_WAIT_L(n) asm volatile("s_waitcnt lgkmcnt(" #n ")" ::: "memory")
#define PG8_BAR __builtin_amdgcn_s_barrier()
#define PG8_SCHED __builtin_amdgcn_sched_barrier(0)
#define PG8_EOFF(pm_) (g.tile_e ? (size_t)g.tile_e[pm_] * g.estride * 2 : (size_t)0)
    Unit cur, nxt; int ui = 0;
    if (!S.next(0, cur)) return;
    f32x4 acc[2][2][4][2];
#pragma unroll
    for (int a = 0; a < 2; ++a)
#pragma unroll
        for (int b = 0; b < 2; ++b)
#pragma unroll
            for (int m = 0; m < 4; ++m)
#pragma unroll
                for (int n = 0; n < 2; ++n) acc[a][b][m][n] = (f32x4){0.f, 0.f, 0.f, 0.f};
    bf16x8 At[4][2], B0[2][2], B1[2][2];
    const char* cA = (const char*)g.A + (size_t)cur.pm * tsA; const char* cB = (const char*)g.Bt + PG8_EOFF(cur.pm) + (size_t)cur.pn * tsB;
    if constexpr (GATHER) PG8_GOFF(cur.pm, vgc);
    PG8_STAGE(PG8_SB(0, 0), cB, voffB); PG8_STAGE(PG8_SB(0, 1), cB + hsB, voffB); PG8_STAGE_A(PG8_SA(0, 0), cA, 0, false); PG8_STAGE_A(PG8_SA(0, 1), cA + hsA, 1, false);
    if (wr == 1) PG8_BAR;
    PG8_WAIT_V(2); PG8_BAR;
    PG8_STAGE(PG8_SB(1, 0), cB + kstep, voffB); PG8_STAGE_A(PG8_SA(1, 0), cA + kstep, 0, false); PG8_STAGE(PG8_SB(1, 1), cB + hsB + kstep, voffB);
    PG8_WAIT_V(6); PG8_BAR;
    for (;;) {
        const bool has_next = S.next(ui + 1, nxt);
        if constexpr (GATHER) { if (has_next) PG8_GOFF(nxt.pm, vgn); else { vgn[0][0] = vgc[0][0]; vgn[0][1] = vgc[0][1]; vgn[1][0] = vgc[1][0]; vgn[1][1] = vgc[1][1]; } }
        const char* nA = has_next ? (const char*)g.A + (size_t)nxt.pm * tsA : cA;
        const char* nB = has_next ? (const char*)g.Bt + PG8_EOFF(nxt.pm) + (size_t)nxt.pn * tsB : cB;
        for (int t = 0; t < nt; t += 2) {
            const bool last = (t == nt - 2);
            const char* a1 = cA + (size_t)(t + 1) * kstep;
            const char* a2 = last ? nA : cA + (size_t)(t + 2) * kstep; const char* b2 = last ? nB : cB + (size_t)(t + 2) * kstep;
            const char* a3 = a2 + kstep; const char* b3 = b2 + kstep;
            PG8_LDB(B0, 0, 0); PG8_LDB(B1, 0, 1); PG8_SCHED; PG8_LDA(At, 0, 0); PG8_STAGE_A(PG8_SA(1, 1), a1 + hsA, 1, false);
            PG8_WAIT_V(8); PG8_WAIT_L(0); PG8_BAR; PG8_MMA(0, 0, At, B0); PG8_MMA(0, 1, At, B1); PG8_BAR; PG8_SCHED;
            PG8_LDA(At, 0, 1); PG8_STAGE(PG8_SB(0, 0), b2, voffB); PG8_STAGE(PG8_SB(0, 1), b2 + hsB, voffB); PG8_STAGE_A(PG8_SA(0, 0), a2, 0, last);
            PG8_WAIT_V(8); PG8_WAIT_L(0); PG8_BAR; PG8_MMA(1, 0, At, B0); PG8_MMA(1, 1, At, B1); PG8_BAR; PG8_SCHED;
            PG8_LDB(B0, 1, 0); PG8_LDB(B1, 1, 1); PG8_SCHED; PG8_LDA(At, 1, 0); PG8_STAGE_A(PG8_SA(0, 1), a2 + hsA, 1, last);
            PG8_WAIT_V(8); PG8_WAIT_L(0); PG8_BAR; PG8_MMA(0, 0, At, B0); PG8_MMA(0, 1, At, B1); PG8_BAR; PG8_SCHED;
            PG8_LDA(At, 1, 1); PG8_STAGE(PG8_SB(1, 0), b3, voffB); PG8_STAGE(PG8_SB(1, 1), b3 + hsB, voffB); PG8_STAGE_A(PG8_SA(1, 0), a3, 0, last);
            PG8_WAIT_V(8); PG8_WAIT_L(0); PG8_BAR; PG8_MMA(1, 0, At, B0); PG8_MMA(1, 1, At, B1); PG8_BAR; PG8_SCHED;
        }
        if constexpr (ALIGN_EPI) { if (wr == 0) PG8_BAR; }
        E(acc, cur, wr, wc, fr, fq);
        if (!has_next) break;
#pragma unroll
        for (int a = 0; a < 2; ++a)
#pragma unroll
            for (int b = 0; b < 2; ++b)
#pragma unroll
                for (int m = 0; m < 4; ++m)
#pragma unroll
                    for (int n = 0; n < 2; ++n) acc[a][b][m][n] = (f32x4){0.f, 0.f, 0.f, 0.f};
        cur = nxt; cA = nA; cB = nB; ++ui;
        if constexpr (GATHER) { vgc[0][0] = vgn[0][0]; vgc[0][1] = vgn[0][1]; vgc[1][0] = vgn[1][0]; vgc[1][1] = vgn[1][1]; }
        if constexpr (ALIGN_EPI) { if (wr == 1) PG8_BAR; }
    }
    PG8_WAIT_V(0);
    if constexpr (!ALIGN_EPI) { if (wr == 0) PG8_BAR; }
    PG8_BAR;
#undef PG8_SA
#undef PG8_SB
#undef PG8_STAGE
#undef PG8_LDA
#undef PG8_LDB
#undef PG8_MMA
#undef PG8_WAIT_V
#undef PG8_WAIT_L
#undef PG8_BAR
#undef PG8_SCHED
#undef PG8_EOFF
#undef PG8_GOFF
#undef PG8_STAGE_A
}

__device__ __forceinline__ float row_rstd(const float* ssp, int row);
template <int ACT> struct EpiBf16 {
    static constexpr bool PERM = true;
    bf16_t* O; int ldc; const float* bias; const float* ssp;
    __device__ __forceinline__ void operator()(const f32x4 (&acc)[2][2][4][2], const Unit& u, int wr, int wc, int fr, int fq) const {
        const int row0 = u.pm * BM + wr * 64 + fr, col0 = u.pn * BM + wc * 32 + 8 * fq;
        f32x4 bv[2][2];
#pragma unroll
        for (int bj = 0; bj < 2; ++bj)
#pragma unroll
            for (int n = 0; n < 2; ++n) bv[bj][n] = bias ? *(const f32x4*)(bias + col0 + bj * HALF + 4 * n) : (f32x4){0.f, 0.f, 0.f, 0.f};
#pragma unroll
        for (int ai = 0; ai < 2; ++ai)
#pragma unroll
            for (int m = 0; m < 4; ++m) { bf16_t* rowp = O + (size_t)(row0 + ai * HALF + m * 16) * ldc + col0;
                const float rs = (ACT == 0 && ssp) ? row_rstd(ssp, row0 + ai * HALF + m * 16) : 1.f;
#pragma unroll
                for (int bj = 0; bj < 2; ++bj) { f32x4 v0 = acc[ai][bj][m][0] * rs + bv[bj][0], v1 = acc[ai][bj][m][1] * rs + bv[bj][1];
                    if (ACT == 2) {
#pragma unroll
                        for (int i = 0; i < 4; ++i) { v0[i] = gelu_tanh_f(v0[i]); v1[i] = gelu_tanh_f(v1[i]); } }
                    u32x4 w; w.x = cvtpk(v0[0], v0[1]); w.y = cvtpk(v0[2], v0[3]); w.z = cvtpk(v1[0], v1[1]); w.w = cvtpk(v1[2], v1[3]);
                    *(u32x4*)(rowp + bj * HALF) = w; } }
    }
};
struct EpiResF32 {
    static constexpr bool PERM = false;
    const float* base; float* out; int ldc;
    __device__ __forceinline__ void operator()(const f32x4 (&acc)[2][2][4][2], const Unit& u, int wr, int wc, int fr, int fq) const {
        const int col0 = u.pn * BM + wc * 32 + 4 * fq;
#pragma unroll
        for (int ai = 0; ai < 2; ++ai)
#pragma unroll
            for (int m = 0; m < 4; ++m) { const size_t off = (size_t)(u.pm * BM + ai * HALF + wr * 64 + m * 16 + fr) * ldc + col0;
#pragma unroll
                for (int bj = 0; bj < 2; ++bj)
#pragma unroll
                    for (int n = 0; n < 2; ++n) { const f32x4 bs = *(const f32x4*)(base + off + bj * HALF + n * 16); *(f32x4*)(out + off + bj * HALF + n * 16) = bs + acc[ai][bj][m][n]; } }
    }
};
template <bool BASE_BF16> struct EpiResStat {
    static constexpr bool PERM = false;
    const void* base; bf16_t* xb; float* ssp; int ldc;
    __device__ __forceinline__ void operator()(const f32x4 (&acc)[2][2][4][2], const Unit& u, int wr, int wc, int fr, int fq) const {
        const int col0 = u.pn * BM + wc * 32 + 4 * fq;
#pragma unroll
        for (int ai = 0; ai < 2; ++ai)
#pragma unroll
            for (int m = 0; m < 4; ++m) { const int row = u.pm * BM + ai * HALF + wr * 64 + m * 16 + fr; const size_t off = (size_t)row * ldc + col0; float ss = 0.f;
#pragma unroll
                for (int bj = 0; bj < 2; ++bj)
#pragma unroll
                    for (int n = 0; n < 2; ++n) { f32x4 bs;
                        if (BASE_BF16) { const u32x2 t = *(const u32x2*)((const bf16_t*)base + off + bj * HALF + n * 16); bs = (f32x4){bflo(t.x), bfhi(t.x), bflo(t.y), bfhi(t.y)}; }
                        else bs = *(const f32x4*)((const float*)base + off + bj * HALF + n * 16);
                        const f32x4 v = bs + acc[ai][bj][m][n];
                        u32x2 w; w.x = cvtpk(v.x, v.y); w.y = cvtpk(v.z, v.w); *(u32x2*)(xb + off + bj * HALF + n * 16) = w; ss += (v.x * v.x + v.y * v.y) + (v.z * v.z + v.w * v.w); }
                ss += __shfl_xor(ss, 16); ss += __shfl_xor(ss, 32);
                if (fq == 0) ssp[(size_t)row * 16 + u.pn * 4 + wc] = ss; }
    }
};
struct EpiResF32B {
    static constexpr bool PERM = false;
    const bf16_t* base; float* out; int ldc;
    __device__ __forceinline__ void operator()(const f32x4 (&acc)[2][2][4][2], const Unit& u, int wr, int wc, int fr, int fq) const {
        const int col0 = u.pn * BM + wc * 32 + 4 * fq;
#pragma unroll
        for (int ai = 0; ai < 2; ++ai)
#pragma unroll
            for (int m = 0; m < 4; ++m) { const size_t off = (size_t)(u.pm * BM + ai * HALF + wr * 64 + m * 16 + fr) * ldc + col0;
#pragma unroll
                for (int bj = 0; bj < 2; ++bj)
#pragma unroll
                    for (int n = 0; n < 2; ++n) { const u32x2 t = *(const u32x2*)(base + off + bj * HALF + n * 16); const f32x4 bs = {bflo(t.x), bfhi(t.x), bflo(t.y), bfhi(t.y)};
                        *(f32x4*)(out + off + bj * HALF + n * 16) = bs + acc[ai][bj][m][n]; } }
    }
};
__device__ __forceinline__ float row_rstd(const float* ssp, int row) {
    const f32x4* q = (const f32x4*)(ssp + (size_t)row * 16); const f32x4 a = q[0], b = q[1], c = q[2], d = q[3];
    const float s = ((a.x + a.y) + (a.z + a.w)) + ((b.x + b.y) + (b.z + b.w)) + ((c.x + c.y) + (c.z + c.w)) + ((d.x + d.y) + (d.z + d.w));
    return rsqrtf(s * (1.f / 1024.f) + EPS);
}
struct EpiSwiGLU {
    static constexpr bool PERM = true;
    bf16_t* O; int ldc; const float* ssp;
    __device__ __forceinline__ void operator()(const f32x4 (&acc)[2][2][4][2], const Unit& u, int wr, int wc, int fr, int fq) const {
        const int row0 = u.pm * BM + wr * 64 + fr, col0 = u.pn * HALF + wc * 32 + 8 * fq;
#pragma unroll
        for (int ai = 0; ai < 2; ++ai)
#pragma unroll
            for (int m = 0; m < 4; ++m) { bf16_t* rowp = O + (size_t)(row0 + ai * HALF + m * 16) * ldc + col0;
                const float rs = ssp ? row_rstd(ssp, row0 + ai * HALF + m * 16) : 1.f;
                float h[8];
#pragma unroll
                for (int n = 0; n < 2; ++n)
#pragma unroll
                    for (int i = 0; i < 4; ++i) h[n * 4 + i] = silu_f(acc[ai][0][m][n][i] * rs) * (acc[ai][1][m][n][i] * rs);
                u32x4 w; w.x = cvtpk(h[0], h[1]); w.y = cvtpk(h[2], h[3]); w.z = cvtpk(h[4], h[5]); w.w = cvtpk(h[6], h[7]);
                *(u32x4*)rowp = w; }
    }
};
struct EpiRowScaleBf16 {
    static constexpr bool PERM = true;
    bf16_t* O; int ldc; const float* roww;
    __device__ __forceinline__ void operator()(const f32x4 (&acc)[2][2][4][2], const Unit& u, int wr, int wc, int fr, int fq) const {
        const int row0 = u.pm * BM + wr * 64 + fr, col0 = u.pn * BM + wc * 32 + 8 * fq;
#pragma unroll
        for (int ai = 0; ai < 2; ++ai)
#pragma unroll
            for (int m = 0; m < 4; ++m) { const int row = row0 + ai * HALF + m * 16; const float sc = roww[row]; bf16_t* rowp = O + (size_t)row * ldc + col0;
#pragma unroll
                for (int bj = 0; bj < 2; ++bj) { const f32x4 v0 = acc[ai][bj][m][0] * sc, v1 = acc[ai][bj][m][1] * sc;
                    u32x4 w; w.x = cvtpk(v0[0], v0[1]); w.y = cvtpk(v0[2], v0[3]); w.z = cvtpk(v1[0], v1[1]); w.w = cvtpk(v1[2], v1[3]);
                    *(u32x4*)(rowp + bj * HALF) = w; } }
    }
};
}
constexpr int ROWS_MAX = 2 * T + 8 * 256;
constexpr size_t al256(size_t x) { return (x + 255) & ~(size_t)255; }
constexpr size_t W_IN_E = 0;
constexpr size_t W_CW1 = W_IN_E + (size_t)1792 * 1024 * 2;
constexpr size_t W_UQ = W_CW1 + (size_t)2 * 256 * 2048 * 2;
constexpr size_t W_UKV = W_UQ + (size_t)1024 * 256 * 2;
constexpr size_t W_OUT_E = W_UKV + (size_t)1024 * 128 * 2;
constexpr size_t W_GU = W_OUT_E + (size_t)1024 * 1024 * 2;
constexpr size_t W_D = W_GU + (size_t)5632 * 1024 * 2;
constexpr size_t W_IN_O = W_D + (size_t)1024 * 2816 * 2;
constexpr size_t W_OUT_O = W_IN_O + (size_t)3072 * 1024 * 2;
constexpr size_t W_MGU = W_OUT_O + (size_t)1024 * 1024 * 2;
constexpr size_t W_MD = W_MGU + (size_t)8 * 2816 * 1024 * 2;
constexpr size_t W_END = W_MD + (size_t)8 * 1024 * 1408 * 2;
constexpr size_t SM_CTL = al256(W_END);
constexpr size_t SM_BAR = SM_CTL + 4096;
constexpr size_t SM_B1P = SM_BAR + 16384;
constexpr size_t SM_B1 = SM_B1P + 32 * 512 * 4;
constexpr size_t SM_ROPE = SM_B1 + 512 * 4;
constexpr size_t SM_BL = SM_ROPE + (size_t)S * 32 * 4;
constexpr size_t SM_HID = SM_BL + 8 * 132 * 4;
constexpr size_t SM_KC = SM_HID + (size_t)2 * NB * 512 * 512 * 2;
constexpr size_t SM_VCT = SM_KC + (size_t)NB * 512 * 64 * 2;
constexpr size_t SM_TE = SM_VCT + (size_t)NB * 512 * 64 * 2;
constexpr size_t SM_TW = SM_TE + (size_t)T * 8;
constexpr size_t SM_RANK = SM_TW + (size_t)T * 8;
constexpr size_t SM_POS = SM_RANK + (size_t)T * 8;
constexpr size_t SM_ROWW = SM_POS + (size_t)T * 8;
constexpr size_t SM_TILEE = SM_ROWW + (size_t)ROWS_MAX * 4;
constexpr size_t SM_ROWTOK = al256(SM_TILEE + (size_t)(ROWS_MAX / 256 + 8) * 4);
constexpr size_t SM_SSP1 = al256(SM_ROWTOK + (size_t)ROWS_MAX * 4);
constexpr size_t SM_SSP2 = SM_SSP1 + (size_t)T * 64;
constexpr size_t SM_END = SM_SSP2 + (size_t)T * 64;
constexpr size_t R_XA = al256(SM_END);
constexpr size_t SZ_XA = (size_t)T * 4096 + (size_t)4 * 1048576;
constexpr size_t R_XN = R_XA + SZ_XA;
constexpr size_t SZ_XN = (size_t)T * 2048;
constexpr size_t R_H = R_XN + SZ_XN;
constexpr size_t SZ_H = ((size_t)T * 6144 > (size_t)ROWS_MAX * 2816) ? (size_t)T * 6144 : (size_t)ROWS_MAX * 2816;
constexpr size_t WS_FAST_END = R_H + SZ_H;
constexpr size_t A_QN = 0;
constexpr size_t A_KSN = A_QN + (size_t)T * 1024;
constexpr size_t A_KWN = A_KSN + (size_t)T * 256;
constexpr size_t A_VST = A_KWN + (size_t)T * 256;
constexpr size_t A_VWT = A_VST + (size_t)T * 256;
constexpr size_t A_KCIN = A_VWT + (size_t)T * 256;
constexpr size_t A_VCIN = A_KCIN + (size_t)T * 256 + 2048;
constexpr size_t A_CQN = A_VCIN + (size_t)T * 256 + 2048;
constexpr size_t A_CKVN = A_CQN + (size_t)T * 512;
constexpr size_t A_KROPE = A_CKVN + (size_t)T * 256;
constexpr size_t A_GATES = A_KROPE + (size_t)T * 64;
constexpr size_t A_END = A_GATES + (size_t)T * 96;
static_assert(A_END <= SZ_XA, "attention inputs fit R_XA");
constexpr size_t O_QM = 0;
constexpr size_t O_KM = O_QM + (size_t)T * 1536;
constexpr size_t O_VMT = O_KM + (size_t)T * 1536;
static_assert(O_VMT + (size_t)T * 1024 <= (size_t)T * 4096, "d_out scratch");

struct Params {
    const float* in[30];
    float* out;
    unsigned char* ws;
    int ph_lo, ph_hi, dbg_branch, pad_;
};

#ifdef PROF_SEL
#define PROF_SLOT(k) ((unsigned long long*)(p.ws + SM_CTL + 2048) + (k))
#define PROF_ON(cond) ((cond) && threadIdx.x == 0)
#ifndef PROF_WAVE
#define PROF_WAVE 0
#endif
#endif
constexpr int LDS_BYTES = 147456;

__device__ __forceinline__ int ltid() { int t = threadIdx.x; asm volatile("" : "+v"(t)); return t; }
__device__ __forceinline__ int perm16(int k) { return (k & ~12) | ((k & 4) << 1) | ((k & 8) >> 1); }

struct WDesc { int in_idx, K, N, rep, map, row_off; size_t src_stride, dst_off, dst_stride; int gain_idx, pad_; size_t src_off; };
__device__ const WDesc WDESC[13] = {
    {3, 1024, 1720, 1, 2, 0, 0, W_IN_E / 2, 0, -1, 0},
    {7, 1024, 256, 2, 0, 0, (size_t)2048 * 256, W_CW1 / 2, (size_t)512 * 1024, -1, 0, 0},
    {7, 1024, 256, 2, 0, 256, (size_t)2048 * 256, W_CW1 / 2, (size_t)512 * 1024, -1, 0, (size_t)1024 * 256},
    {11, 256, 768, 1, 3, 0, 0, W_UQ / 2, 0, -1, 0},
    {12, 128, 1024, 1, 0, 0, 0, W_UKV / 2, 0, -1, 0},
    {15, 1024, 1024, 1, 0, 0, 0, W_OUT_E / 2, 0, -1, 0},
    {17, 1024, 2816, 1, 1, 0, 0, W_GU / 2, 0, 16, 0},
    {18, 1024, 2816, 1, 1, 128, 0, W_GU / 2, 0, 16, 0},
    {19, 2816, 1024, 1, 0, 0, 0, W_D / 2, 0, -1, 0},
    {21, 1024, 3072, 1, 0, 0, 0, W_IN_O / 2, 0, 20, 0},
    {23, 1024, 1024, 1, 0, 0, 0, W_OUT_O / 2, 0, -1, 0},
    {27, 1024, 1408, 8, 1, 0, (size_t)1024 * 1408, W_MGU / 2, (size_t)2816 * 1024, -1, 0},
    {28, 1024, 1408, 8, 1, 128, (size_t)1024 * 1408, W_MGU / 2, (size_t)2816 * 1024, -1, 0},
};
__device__ const WDesc WDESC_MD = {29, 1408, 1024, 8, 0, 0, (size_t)1408 * 1024, W_MD / 2, (size_t)1024 * 1408, -1, 0};

__device__ __forceinline__ void transpose_item(const float* W, int K, int N, bf16_t* WT, int map, int row_off, const float* gain, LAS float* scr, int item, int lane) {
    const int nblk = (N + 31) / 32, kb = item / nblk, nb = item % nblk, k0 = 64 * kb, n0 = 32 * nb;
    const int n4 = (lane & 7) * 4; const bool nok = (n0 + n4) < N;
    f32x4 v[8];
#pragma unroll
    for (int i = 0; i < 8; ++i) { const int kk = (lane >> 3) + 8 * i; v[i] = nok ? *(const f32x4*)(W + (size_t)(k0 + kk) * N + n0 + n4) : (f32x4){0.f, 0.f, 0.f, 0.f}; if (gain) v[i] = v[i] * gain[k0 + kk]; }
#pragma unroll
    for (int i = 0; i < 8; ++i) { const int kk = (lane >> 3) + 8 * i; LAS float* d = scr + kk * 33 + n4; d[0] = v[i].x; d[1] = v[i].y; d[2] = v[i].z; d[3] = v[i].w; }
    asm volatile("s_waitcnt lgkmcnt(0)" ::: "memory");
    const int c = lane & 7;
#pragma unroll
    for (int j = 0; j < 4; ++j) { const int n = (lane >> 3) + 8 * j; const LAS float* s = scr + (8 * c) * 33 + n;
        u32x4 o; o.x = cvtpk(s[0 * 33], s[1 * 33]); o.y = cvtpk(s[2 * 33], s[3 * 33]); o.z = cvtpk(s[4 * 33], s[5 * 33]); o.w = cvtpk(s[6 * 33], s[7 * 33]);
        const int nn = n0 + n;
        if (nn < N) { const int row = (map == 1) ? (256 * (nn >> 7) + (nn & 127) + row_off) : (map == 2) ? (nn < 1280 ? nn : (nn < 1304 ? nn + 416 : nn - 24)) : (map == 3) ? ((nn / 96) * 128 + nn % 96) : (nn + row_off);
            *(u32x4*)(WT + (size_t)row * K + k0 + 8 * c) = o; } }
    asm volatile("s_waitcnt lgkmcnt(0)" ::: "memory");
}
__device__ __forceinline__ void do_wdesc(const Params& p, const WDesc& d, int it, LAS float* scr, int lane) {
    const int per = (d.K / 64) * ((d.N + 31) / 32); const int r = it / per, ii = it % per;
    transpose_item(p.in[d.in_idx] + d.src_off + (size_t)r * d.src_stride, d.K, d.N, (bf16_t*)p.ws + d.dst_off + (size_t)r * d.dst_stride, d.map, d.row_off, d.gain_idx >= 0 ? p.in[d.gain_idx] : nullptr, scr, ii, lane);
}
__device__ __forceinline__ void rms_row_to_bf16(const float* xrow, const float* g, bf16_t* orow, int lane) {
    const f32x4* xr = (const f32x4*)xrow + lane; const f32x4* gr = (const f32x4*)g + lane;
    f32x4 v[4]; float s = 0.f;
#pragma unroll
    for (int j = 0; j < 4; ++j) { v[j] = xr[64 * j]; s += (v[j].x * v[j].x + v[j].y * v[j].y) + (v[j].z * v[j].z + v[j].w * v[j].w); }
    const float r = rsqrtf(wsum(s) * (1.f / 1024.f) + EPS);
    u32x2* o8 = (u32x2*)orow + lane;
#pragma unroll
    for (int j = 0; j < 4; ++j) { const f32x4 gg = gr[64 * j]; u32x2 w; w.x = cvtpk(v[j].x * r * gg.x, v[j].y * r * gg.y); w.y = cvtpk(v[j].z * r * gg.z, v[j].w * r * gg.w); o8[64 * j] = w; }
}
__device__ __forceinline__ void phase_p0(const Params& p, LAS unsigned char* lds) {
    const int tid = ltid(), lane = tid & 63, wave = tid >> 6;
    const int gw = blockIdx.x * 8 + wave, NGW = gridDim.x * 8;
    LAS float* scr = (LAS float*)(lds + wave * 16384);
    int base = 0;
#pragma unroll 1
    for (int d = 0; d < 14; ++d) {
        const WDesc& wd = (d < 13) ? WDESC[d] : WDESC_MD;
        const int n_it = wd.rep * (wd.K / 64) * ((wd.N + 31) / 32);
        int first = (gw - (base % NGW) + NGW) % NGW;
        for (int it = first; it < n_it; it += NGW) do_wdesc(p, wd, it, scr, lane);
        base += n_it;
    }
    bf16_t* xn = (bf16_t*)(p.ws + R_XN);
    for (int m = gw; m < T; m += 2 * NGW) { rms_row_to_bf16(p.in[0] + (size_t)m * D, p.in[2], xn + (size_t)m * D, lane); if (m + NGW < T) rms_row_to_bf16(p.in[0] + (size_t)(m + NGW) * D, p.in[2], xn + (size_t)(m + NGW) * D, lane); }
    for (int u = gw; u < 256; u += NGW) {
        const int kc = u >> 3, kv = (u >> 2) & 1, nb = u & 3; float s = 0.f;
        const float* pos = p.in[6] + kv * 2048 + kc * 64; const float* w1 = p.in[7] + ((size_t)kv * 2048 + kc * 64) * 256 + nb * 64 + lane;
#pragma unroll 8
        for (int k = 0; k < 64; ++k) s += pos[k] * w1[(size_t)k * 256];
        ((float*)(p.ws + SM_B1P))[kc * 512 + kv * 256 + nb * 64 + lane] = s;
    }
    for (int i = blockIdx.x * 512 + tid; i < S * 16; i += gridDim.x * 512) {
        const int t = i >> 4, f = i & 15; const float ang = (float)t * powf(10000.f, -(float)f / 16.f);
        float* rp = (float*)(p.ws + SM_ROPE) + t * 32; rp[f] = cosf(ang); rp[16 + f] = sinf(ang);
    }
    if (blockIdx.x == 0) for (int i = tid; i < 8 * 129; i += 512) { const int h = i / 129, dd = i % 129; ((float*)(p.ws + SM_BL))[h * 132 + dd] = p.in[1][(dd < 128 ? (int)gold::T5B[dd] : 31) * 8 + h] * LOG2E; }
}

__device__ __forceinline__ void unpack8(const u32x4 v, float (&x)[8]) { x[0] = bflo(v.x); x[1] = bfhi(v.x); x[2] = bflo(v.y); x[3] = bfhi(v.y); x[4] = bflo(v.z); x[5] = bfhi(v.z); x[6] = bflo(v.w); x[7] = bfhi(v.w); }
__device__ __forceinline__ u32x4 pack8(const float (&x)[8]) { u32x4 w; w.x = cvtpk(x[0], x[1]); w.y = cvtpk(x[2], x[3]); w.z = cvtpk(x[4], x[5]); w.w = cvtpk(x[6], x[7]); return w; }
__device__ __forceinline__ float ss8f(const float (&x)[8]) { return ((x[0] * x[0] + x[1] * x[1]) + (x[2] * x[2] + x[3] * x[3])) + ((x[4] * x[4] + x[5] * x[5]) + (x[6] * x[6] + x[7] * x[7])); }
__device__ __forceinline__ void load8f(const float* g, float (&x)[8], float sc) { const f32x4 a = *(const f32x4*)g, b = *(const f32x4*)(g + 4); x[0] = a.x * sc; x[1] = a.y * sc; x[2] = a.z * sc; x[3] = a.w * sc; x[4] = b.x * sc; x[5] = b.y * sc; x[6] = b.z * sc; x[7] = b.w * sc; }
__device__ __forceinline__ void phase_p2(const Params& p, LAS unsigned char* lds) {
    const int tid = ltid(), lane = tid & 63, wave = tid >> 6;
    const bf16_t* hb = (const bf16_t*)(p.ws + R_H);
    unsigned char* xa = p.ws + R_XA;
    bf16_t* qn = (bf16_t*)(xa + A_QN); bf16_t* ksn = (bf16_t*)(xa + A_KSN); bf16_t* kwn = (bf16_t*)(xa + A_KWN);
    bf16_t* vst = (bf16_t*)(xa + A_VST); bf16_t* vwt = (bf16_t*)(xa + A_VWT); bf16_t* kcin = (bf16_t*)(xa + A_KCIN); bf16_t* vcin = (bf16_t*)(xa + A_VCIN);
    bf16_t* cqn = (bf16_t*)(xa + A_CQN); bf16_t* ckvn = (bf16_t*)(xa + A_CKVN); bf16_t* krope = (bf16_t*)(xa + A_KROPE); float* gates = (float*)(xa + A_GATES);
    LAS bf16_t* vs = (LAS bf16_t*)lds;
    if (blockIdx.x == 0) {
        { float s = 0.f; for (int k = 0; k < 32; ++k) s += ((const float*)(p.ws + SM_B1P))[k * 512 + tid]; ((float*)(p.ws + SM_B1))[tid] = s; }
        for (int i = tid; i < 1024; i += 512) { kcin[(size_t)T * 128 + i] = 0; vcin[(size_t)T * 128 + i] = 0; }
    }
    const int c8 = (lane & 7) * 8, seg = lane >> 3;
    float qg[8], ksg[8], kwg[8], cqg[8], ckvg[8];
    load8f(p.in[4] + c8, qg, 0.125f * LOG2E); load8f(p.in[5] + 64 + c8, ksg, 1.f); load8f(p.in[5] + 128 + c8, kwg, 1.f);
    load8f(p.in[9] + (lane & 31) * 8, cqg, 1.f); load8f(p.in[10] + (lane & 15) * 8, ckvg, 1.f);
    for (int tile = blockIdx.x; tile < T / 64; tile += gridDim.x) {
        const int b = tile / (S / 64), s0 = (tile % (S / 64)) * 64;
#pragma unroll 4
        for (int tt = 0; tt < 8; ++tt) {
            const int sl = wave * 8 + tt, s = s0 + sl; const size_t t = (size_t)b * S + s;
            const bf16_t* hr = hb + t * 1792 + lane * 8;
            const u32x4 L0 = *(const u32x4*)hr, L1 = *(const u32x4*)(hr + 512), L2 = *(const u32x4*)(hr + 1024);
            u32x4 L3 = {0u, 0u, 0u, 0u}; if (lane < 32) L3 = *(const u32x4*)(hr + 1536);
            float x0[8], x1[8], x2[8], x3[8];
            unpack8(L0, x0); unpack8(L1, x1); unpack8(L2, x2); unpack8(L3, x3);
            float a0 = ss8f(x0), a1 = ss8f(x1), a2 = ss8f(x2), a3 = ss8f(x3);
#pragma unroll
            for (int o = 1; o < 8; o <<= 1) { a0 += __shfl_xor(a0, o); a1 += __shfl_xor(a1, o); a2 += __shfl_xor(a2, o); a3 += __shfl_xor(a3, o); }
            float a2w = a2 + __shfl_xor(a2, 8); a2w += __shfl_xor(a2w, 16);
            const float a3w = a3 + __shfl_xor(a3, 8);
            const int pp = (sl & ~15) | perm16(sl & 15);
            {
                const float r = rsqrtf(a0 * (1.f / 64.f) + EPS); float y[8];
#pragma unroll
                for (int j = 0; j < 8; ++j) y[j] = x0[j] * r * qg[j];
                *(u32x4*)(qn + t * 512 + lane * 8) = pack8(y);
            }
            {
                const int g = seg & 1; const size_t gm = (((size_t)b * 2 + g) * S + s) * 64 + c8;
                if (seg < 2) *(u32x4*)(kcin + gm) = L1;
                else if (seg < 4) *(u32x4*)(vcin + gm) = L1;
                else if (seg < 6) { const float r = rsqrtf(a1 * (1.f / 64.f) + EPS); float y[8];
#pragma unroll
                    for (int j = 0; j < 8; ++j) y[j] = x1[j] * r * ksg[j];
                    *(u32x4*)(ksn + gm) = pack8(y); }
                else {
#pragma unroll
                    for (int j = 0; j < 8; ++j) vs[((0 + g) * 64 + c8 + j) * 72 + pp] = (bf16_t)((j & 1) ? (L1[j >> 1] >> 16) : (L1[j >> 1] & 0xffffu)); }
            }
            {
                const int g = seg & 1; const size_t gm = (((size_t)b * 2 + g) * S + s) * 64 + c8;
                if (seg < 2) { const float r = rsqrtf(a2 * (1.f / 64.f) + EPS); float y[8];
#pragma unroll
                    for (int j = 0; j < 8; ++j) y[j] = x2[j] * r * kwg[j];
                    *(u32x4*)(kwn + gm) = pack8(y); }
                else if (seg < 4) {
#pragma unroll
                    for (int j = 0; j < 8; ++j) vs[((2 + g) * 64 + c8 + j) * 72 + pp] = (bf16_t)((j & 1) ? (L2[j >> 1] >> 16) : (L2[j >> 1] & 0xffffu)); }
                else { const float r = rsqrtf(a2w * (1.f / 256.f) + EPS); float y[8];
#pragma unroll
                    for (int j = 0; j < 8; ++j) y[j] = x2[j] * r * cqg[j];
                    *(u32x4*)(cqn + t * 256 + (lane - 32) * 8) = pack8(y); }
            }
            {
                if (lane < 16) { const float r = rsqrtf(a3w * (1.f / 128.f) + EPS); float y[8];
#pragma unroll
                    for (int j = 0; j < 8; ++j) y[j] = x3[j] * r * ckvg[j];
                    *(u32x4*)(ckvn + t * 128 + lane * 8) = pack8(y); }
                else if (lane < 20) *(u32x4*)(krope + t * 32 + (lane - 16) * 8) = L3;
                else if (lane < 23) { float y[8];
#pragma unroll
                    for (int j = 0; j < 8; ++j) y[j] = frcp(1.f + fexp2(-x3[j] * LOG2E));
                    float* gp = gates + t * 24 + (lane - 20) * 8; *(f32x4*)gp = (f32x4){y[0], y[1], y[2], y[3]}; *(f32x4*)(gp + 4) = (f32x4){y[4], y[5], y[6], y[7]}; }
            }
        }
        __syncthreads();
        {
            const int row = tid >> 1, half = tid & 1, which = row >> 6, d = row & 63, g = which & 1;
            bf16_t* dst = ((which < 2) ? vst : vwt) + (((size_t)b * 2 + g) * 64 + d) * S + s0 + half * 32;
            const LAS bf16_t* src = vs + row * 72 + half * 32;
#pragma unroll
            for (int c = 0; c < 4; ++c) *(u32x4*)(dst + c * 8) = *(const LAS u32x4*)(src + c * 8);
        }
        __syncthreads();
    }
}
__device__ __forceinline__ void phase_p3b(const Params& p, LAS unsigned char* lds) {
    const int tid = ltid(), lane = tid & 63, wave = tid >> 6;
    const int gw = blockIdx.x * 8 + wave, NGW = gridDim.x * 8;
    const bf16_t* qraw = (const bf16_t*)(p.ws + R_H);
    const bf16_t* kvraw = (const bf16_t*)(p.ws + R_H + (size_t)T * 2048);
    const bf16_t* krope = (const bf16_t*)(p.ws + R_XA + A_KROPE);
    const float* rope = (const float*)(p.ws + SM_ROPE);
    bf16_t* qm = (bf16_t*)((unsigned char*)p.out + O_QM); bf16_t* km = (bf16_t*)((unsigned char*)p.out + O_KM); bf16_t* vmt = (bf16_t*)((unsigned char*)p.out + O_VMT);
    const float* q_norm = p.in[13]; const float* k_norm = p.in[14];
    LAS bf16_t* vs = (LAS bf16_t*)lds;
    LAS float* w2s = (LAS float*)(lds + 73728);
    for (int kv = 0; kv < 2; ++kv) {
        __syncthreads();
        for (int i = tid; i < 256 * 64; i += 512) w2s[i] = p.in[8][kv * 16384 + i];
        __syncthreads();
        const bf16_t* P = (const bf16_t*)(p.ws + SM_HID) + (size_t)kv * NB * 512 * 512;
        const f32x4 bs = *(const f32x4*)((const float*)(p.ws + SM_B1) + kv * 256 + lane * 4);
        for (int row = gw; row < NB * 512; row += NGW) {
            const int row1 = row + 1 < NB * 512 ? row + 1 : row;
            const u32x2 pa = *(const u32x2*)(P + (size_t)row * 512 + lane * 4), pb = *(const u32x2*)(P + (size_t)row1 * 512 + 256 + lane * 4);
            const float h0 = gelu_tanh_f(bflo(pa.x) + bflo(pb.x) + bs.x), h1 = gelu_tanh_f(bfhi(pa.x) + bfhi(pb.x) + bs.y), h2 = gelu_tanh_f(bflo(pa.y) + bflo(pb.y) + bs.z), h3 = gelu_tanh_f(bfhi(pa.y) + bfhi(pb.y) + bs.w);
            float acc = 0.f;
#pragma unroll 8
            for (int k4 = 0; k4 < 64; ++k4) {
                acc += __shfl(h0, k4) * w2s[(k4 * 4 + 0) * 64 + lane]; acc += __shfl(h1, k4) * w2s[(k4 * 4 + 1) * 64 + lane];
                acc += __shfl(h2, k4) * w2s[(k4 * 4 + 2) * 64 + lane]; acc += __shfl(h3, k4) * w2s[(k4 * 4 + 3) * 64 + lane];
            }
            if (kv == 0) { const float r = rsqrtf(wsum(acc * acc) * (1.f / 64.f) + EPS); ((bf16_t*)(p.ws + SM_KC))[(size_t)row * 64 + lane] = f2bf(acc * r * p.in[5][lane]); }
            else { const int c = row & 255; ((bf16_t*)(p.ws + SM_VCT))[((size_t)(row >> 8) * 64 + lane) * 256 + ((c & ~15) | perm16(c & 15))] = f2bf(acc); }
        }
    }
    __syncthreads();
    const float QS = 0.10206207261596577f * LOG2E;
    const int c = lane & 15, hl = lane >> 4;
    float qg[8], kg[8];
    load8f(q_norm + (c < 12 ? c * 8 : 0), qg, QS);
    load8f(k_norm + (c < 12 ? c * 8 : 0), kg, 1.f);
    for (int tile = blockIdx.x; tile < T / 64; tile += gridDim.x) {
        const int b = tile / (S / 64), s0 = (tile % (S / 64)) * 64;
#pragma unroll 4
        for (int tt = 0; tt < 8; ++tt) {
            const int sl = wave * 8 + tt, s = s0 + sl; const size_t t = (size_t)b * S + s;
            const int pp = (sl & ~15) | perm16(sl & 15);
            u32x4 Q[2], KV[2];
#pragma unroll
            for (int ld = 0; ld < 2; ++ld) { Q[ld] = *(const u32x4*)(qraw + t * 1024 + ld * 512 + lane * 8); KV[ld] = *(const u32x4*)(kvraw + t * 1024 + ld * 512 + lane * 8); }
            u32x4 KR = {0u, 0u, 0u, 0u}; f32x4 cs0 = {0.f, 0.f, 0.f, 0.f}, cs1 = cs0, sn0 = cs0, sn1 = cs0;
            if (c >= 8 && c < 12) { KR = *(const u32x4*)(krope + t * 32 + (c - 8) * 8);
                const float* rp = rope + s * 32 + (c & 1) * 8; cs0 = *(const f32x4*)rp; cs1 = *(const f32x4*)(rp + 4); sn0 = *(const f32x4*)(rp + 16); sn1 = *(const f32x4*)(rp + 20); }
            const float cs[8] = {cs0.x, cs0.y, cs0.z, cs0.w, cs1.x, cs1.y, cs1.z, cs1.w}, sn[8] = {sn0.x, sn0.y, sn0.z, sn0.w, sn1.x, sn1.y, sn1.z, sn1.w};
            float kr[8]; unpack8(KR, kr);
            const float krs = ss8f(kr);
#pragma unroll
            for (int ld = 0; ld < 2; ++ld) {
                const int hh = ld * 4 + hl;
                {
                    float x[8]; unpack8(Q[ld], x);
                    float ss = c < 12 ? ss8f(x) : 0.f;
#pragma unroll
                    for (int o = 1; o < 16; o <<= 1) ss += __shfl_xor(ss, o);
                    const float r = rsqrtf(ss * (1.f / 96.f) + EPS); float y[8], z[8];
#pragma unroll
                    for (int j = 0; j < 8; ++j) y[j] = x[j] * r * qg[j];
#pragma unroll
                    for (int j = 0; j < 8; ++j) { const float pb = __shfl_xor(y[j], 2); z[j] = (c < 8) ? y[j] : ((c < 10) ? (y[j] * cs[j] - pb * sn[j]) : (pb * sn[j] + y[j] * cs[j])); }
                    if (c < 12) *(u32x4*)(qm + (t * 8 + hh) * 96 + c * 8) = pack8(z);
                }
                {
                    float x[8]; unpack8(KV[ld], x);
                    float ss = c < 8 ? ss8f(x) : krs;
#pragma unroll
                    for (int o = 1; o < 16; o <<= 1) ss += __shfl_xor(ss, o);
                    const float r = rsqrtf(ss * (1.f / 96.f) + EPS); float y[8], z[8];
#pragma unroll
                    for (int j = 0; j < 8; ++j) y[j] = (c < 8 ? x[j] : kr[j]) * r * kg[j];
#pragma unroll
                    for (int j = 0; j < 8; ++j) { const float pb = __shfl_xor(y[j], 2); z[j] = (c < 8) ? y[j] : ((c < 10) ? (y[j] * cs[j] - pb * sn[j]) : (pb * sn[j] + y[j] * cs[j])); }
                    if (c < 12) *(u32x4*)(km + (((size_t)b * 8 + hh) * S + s) * 96 + c * 8) = pack8(z);
                    if (c >= 8) {
#pragma unroll
                        for (int j = 0; j < 8; ++j) vs[(hh * 64 + (c - 8) * 8 + j) * 72 + pp] = (bf16_t)((j & 1) ? (KV[ld][j >> 1] >> 16) : (KV[ld][j >> 1] & 0xffffu)); }
                }
            }
        }
        __syncthreads();
        {
            const int hh = tid >> 6, d = tid & 63;
            bf16_t* dst = vmt + (((size_t)b * 8 + hh) * 64 + d) * S + s0;
            const LAS bf16_t* src = vs + tid * 72;
#pragma unroll
            for (int cc = 0; cc < 8; ++cc) *(u32x4*)(dst + cc * 8) = *(const LAS u32x4*)(src + cc * 8);
        }
        __syncthreads();
    }
}

__device__ const unsigned short UNIT_TYPES[256] = {63,127,62,126,61,125,527,591,655,719,783,847,911,975,60,124,59,123,58,122,57,121,56,120,526,590,654,718,782,846,910,974,55,119,54,118,53,117,52,116,51,115,525,589,653,717,781,845,909,973,50,114,49,113,48,112,47,111,524,588,652,716,780,844,908,972,46,110,45,109,44,108,43,107,523,587,651,715,779,843,907,971,42,106,41,105,40,104,39,103,38,102,522,586,650,714,778,842,906,970,37,101,36,100,35,99,34,98,33,97,521,585,649,713,777,841,905,969,32,96,31,95,30,94,520,584,648,712,776,840,904,968,29,93,28,92,27,91,26,90,25,89,519,583,647,711,775,839,903,967,24,88,23,87,22,86,21,85,20,84,518,582,646,710,774,838,902,966,19,83,18,82,17,81,16,80,15,79,517,581,645,709,773,837,901,965,14,78,13,77,12,76,516,580,644,708,772,836,900,964,11,75,10,74,9,73,8,72,515,579,643,707,771,835,899,963,7,71,6,70,5,69,514,578,642,706,770,834,898,962,4,68,3,67,513,577,641,705,769,833,897,961,2,66,1,65,0,64,512,576,640,704,768,832,896,960};
__device__ __forceinline__ int crow(int r, int hi) { return (r & 3) + 8 * (r >> 2) + 4 * hi; }
struct Flash { f32x16 o0, o1; float l; };
__device__ __forceinline__ void flash_init(Flash& st) {
#pragma unroll
    for (int r = 0; r < 16; ++r) { st.o0[r] = 0.f; st.o1[r] = 0.f; }
    st.l = 0.f;
}
constexpr int AL_K64 = 0, AL_V64 = 3 * 8192;
constexpr int AL_K96 = 0, AL_V96 = 3 * 16384;
constexpr int AL_IMP = 49152, AL_SELB = AL_IMP + 64 * 65 * 4, AL_UNI = AL_SELB + 512, AL_TL = AL_UNI + 64, AL_BL = AL_TL + 128, AL_OT = AL_BL + 4 * 132 * 4, AL_END = AL_OT + 8 * 32 * 64 * 4;
static_assert(AL_END <= 139264 && AL_V96 + 3 * 8192 <= 139264, "attention LDS");

template <int RB> struct DmaLane { unsigned g0, g1; };
template <int RB> __device__ __forceinline__ void dma_setup(DmaLane<RB>& L, int w, int lane, unsigned gs) {
    if (RB == 128) { const int r = 8 * w + (lane >> 3), c = (lane & 7) ^ ((r >> 1) & 7); L.g0 = (unsigned)r * gs + c * 16; L.g1 = 0; }
    else {
        { const int r = 8 * w + (lane >> 4); int c = (lane & 15) ^ (r & 15); c = c >= 12 ? c - 4 : c; L.g0 = (unsigned)r * gs + c * 16; }
        { const int r = 8 * w + 4 + (lane >> 4); int c = (lane & 15) ^ (r & 15); c = c >= 12 ? c - 4 : c; L.g1 = (unsigned)r * gs + c * 16; }
    }
}
template <int RB> __device__ __forceinline__ void dma_issue(const unsigned char* tile, const DmaLane<RB>& L, LAS unsigned char* buf, int w) {
    if (RB == 128) __builtin_amdgcn_global_load_lds((const unsigned*)(tile + L.g0), (LAS unsigned*)(buf + w * 1024), 16, 0, 0);
    else { __builtin_amdgcn_global_load_lds((const unsigned*)(tile + L.g0), (LAS unsigned*)(buf + w * 2048), 16, 0, 0);
           __builtin_amdgcn_global_load_lds((const unsigned*)(tile + L.g1), (LAS unsigned*)(buf + w * 2048 + 1024), 16, 0, 0); }
}
template <int DK> __device__ __forceinline__ void frag_offsets(unsigned (&kl)[DK / 16], unsigned (&vl)[4], int r32, int hi) {
#pragma unroll
    for (int s = 0; s < DK / 16; ++s) kl[s] = (DK == 64) ? (unsigned)(r32 * 128 + (((2 * s + hi) ^ ((r32 >> 1) & 7)) << 4)) : (unsigned)(r32 * 256 + (((2 * s + hi) ^ (r32 & 15)) << 4));
#pragma unroll
    for (int s = 0; s < 4; ++s) vl[s] = (unsigned)(r32 * 128 + (((2 * s + hi) ^ ((r32 >> 1) & 7)) << 4));
}

template <int DK, int KP, bool LANEMASK, class F>
__device__ __forceinline__ void tile_compute(Flash& st, const LAS unsigned char* Kt, const LAS unsigned char* Vt, const bf16x8* qf, const f32x16& negm, const unsigned (&kl)[DK / 16], const unsigned (&vl)[4], bool mine, F f) {
    constexpr int NS = DK / 16; constexpr int KH = 32 * KP;
    bf16x8 ka[NS], kh[NS];
#pragma unroll
    for (int s = 0; s < NS; ++s) ka[s] = *(const LAS bf16x8*)(Kt + kl[s]);
#pragma unroll
    for (int s = 0; s < NS; ++s) kh[s] = *(const LAS bf16x8*)(Kt + kl[s] + KH);
    __builtin_amdgcn_sched_barrier(0);
    f32x16 p0, p1;
#pragma unroll
    for (int s = 0; s < NS; ++s) p0 = (s == 0) ? __builtin_amdgcn_mfma_f32_32x32x16_bf16(ka[0], qf[0], negm, 0, 0, 0) : __builtin_amdgcn_mfma_f32_32x32x16_bf16(ka[s], qf[s], p0, 0, 0, 0);
#pragma unroll
    for (int s = 0; s < NS; ++s) p1 = (s == 0) ? __builtin_amdgcn_mfma_f32_32x32x16_bf16(kh[0], qf[0], negm, 0, 0, 0) : __builtin_amdgcn_mfma_f32_32x32x16_bf16(kh[s], qf[s], p1, 0, 0, 0);
    bf16x8 va[4], vh[4];
#pragma unroll
    for (int s = 0; s < 4; ++s) { va[s] = *(const LAS bf16x8*)(Vt + vl[s]); vh[s] = *(const LAS bf16x8*)(Vt + vl[s] + 4096); }
    __builtin_amdgcn_sched_barrier(0);
    float ls = 0.f;
    u32x4 w0, w1, w2, w3;
    {
#pragma unroll
        for (int r = 0; r < 16; ++r) { float x = p0[r]; const bool v = f(r, 0, x); const float e = fexp2(x); p0[r] = v ? e : 0.f; ls += p0[r]; }
        w0.x = cvtpk(p0[0], p0[1]); w0.y = cvtpk(p0[2], p0[3]); w0.z = cvtpk(p0[4], p0[5]); w0.w = cvtpk(p0[6], p0[7]);
        w1.x = cvtpk(p0[8], p0[9]); w1.y = cvtpk(p0[10], p0[11]); w1.z = cvtpk(p0[12], p0[13]); w1.w = cvtpk(p0[14], p0[15]);
        if (LANEMASK) { w0.x = mine ? w0.x : 0u; w0.y = mine ? w0.y : 0u; w0.z = mine ? w0.z : 0u; w0.w = mine ? w0.w : 0u; w1.x = mine ? w1.x : 0u; w1.y = mine ? w1.y : 0u; w1.z = mine ? w1.z : 0u; w1.w = mine ? w1.w : 0u; }
    }
#pragma unroll
    for (int s = 0; s < 2; ++s) {
        const bf16x8 pa = __builtin_bit_cast(bf16x8, s ? w1 : w0);
        st.o0 = __builtin_amdgcn_mfma_f32_32x32x16_bf16(pa, va[s], st.o0, 0, 0, 0);
        st.o1 = __builtin_amdgcn_mfma_f32_32x32x16_bf16(pa, vh[s], st.o1, 0, 0, 0);
    }
    {
#pragma unroll
        for (int r = 0; r < 16; ++r) { float x = p1[r]; const bool v = f(r, 1, x); const float e = fexp2(x); p1[r] = v ? e : 0.f; ls += p1[r]; }
        w2.x = cvtpk(p1[0], p1[1]); w2.y = cvtpk(p1[2], p1[3]); w2.z = cvtpk(p1[4], p1[5]); w2.w = cvtpk(p1[6], p1[7]);
        w3.x = cvtpk(p1[8], p1[9]); w3.y = cvtpk(p1[10], p1[11]); w3.z = cvtpk(p1[12], p1[13]); w3.w = cvtpk(p1[14], p1[15]);
        if (LANEMASK) { w2.x = mine ? w2.x : 0u; w2.y = mine ? w2.y : 0u; w2.z = mine ? w2.z : 0u; w2.w = mine ? w2.w : 0u; w3.x = mine ? w3.x : 0u; w3.y = mine ? w3.y : 0u; w3.z = mine ? w3.z : 0u; w3.w = mine ? w3.w : 0u; }
    }
    if (LANEMASK) ls = mine ? ls : 0.f;
    st.l += ls;
#pragma unroll
    for (int s = 2; s < 4; ++s) {
        const bf16x8 pa = __builtin_bit_cast(bf16x8, (s == 3) ? w3 : w2);
        st.o0 = __builtin_amdgcn_mfma_f32_32x32x16_bf16(pa, va[s], st.o0, 0, 0, 0);
        st.o1 = __builtin_amdgcn_mfma_f32_32x32x16_bf16(pa, vh[s], st.o1, 0, 0, 0);
    }
}
template <int DK, int KP> __device__ __forceinline__ void qk_tile(f32x16& p0, f32x16& p1, const LAS unsigned char* Kt, const bf16x8* qf, const f32x16& negm, const unsigned (&kl)[DK / 16]) {
#pragma unroll
    for (int s = 0; s < DK / 16; ++s) {
        const bf16x8 a0 = *(const LAS bf16x8*)(Kt + kl[s]);
        const bf16x8 a1 = *(const LAS bf16x8*)(Kt + kl[s] + 32 * KP);
        if (s == 0) { p0 = __builtin_amdgcn_mfma_f32_32x32x16_bf16(a0, qf[0], negm, 0, 0, 0); p1 = __builtin_amdgcn_mfma_f32_32x32x16_bf16(a1, qf[0], negm, 0, 0, 0); }
        else { p0 = __builtin_amdgcn_mfma_f32_32x32x16_bf16(a0, qf[s], p0, 0, 0, 0); p1 = __builtin_amdgcn_mfma_f32_32x32x16_bf16(a1, qf[s], p1, 0, 0, 0); }
    }
}
template <bool FIRST> __device__ __forceinline__ void flash_accum(LAS float* otl, const Flash& st, float gate, int hi, int lane) {
    const float lt = st.l + __shfl_xor(st.l, 32);
    const float f = lt > 0.f ? gate * frcp(lt) : 0.f;
#pragma unroll
    for (int r = 0; r < 16; ++r) { const float fr_ = __shfl(f, crow(r, hi));
        if (FIRST) { otl[r * 64 + lane] = fr_ * st.o0[r]; otl[(16 + r) * 64 + lane] = fr_ * st.o1[r]; }
        else { otl[r * 64 + lane] += fr_ * st.o0[r]; otl[(16 + r) * 64 + lane] += fr_ * st.o1[r]; } }
}
template <int NS> __device__ __forceinline__ float qnorm2(const bf16x8* qf) {
    float s = 0.f;
#pragma unroll
    for (int i = 0; i < NS; ++i)
#pragma unroll
        for (int j = 0; j < 8; ++j) { const float x = bf2f((bf16_t)qf[i][j]); s += x * x; }
    return s + __shfl_xor(s, 32);
}
__device__ __forceinline__ float wmax(float v) {
#pragma unroll
    for (int o = 1; o < 64; o <<= 1) v = fmaxf(v, __shfl_xor(v, o));
    return v;
}

template <int RBK, bool HASV, int KOFF, int KSZ, int VOFF, class SrcK, class SrcV, class Comp>
__device__ __forceinline__ void run_tiles(int n, LAS unsigned char* lds, int w, int lane, unsigned gsK, unsigned gsV, SrcK srcK, SrcV srcV, Comp comp) {
    DmaLane<RBK> LK; dma_setup<RBK>(LK, w, lane, gsK);
    DmaLane<128> LV; LV.g0 = 0; LV.g1 = 0; if (HASV) dma_setup<128>(LV, w, lane, gsV);
    const int nl = n - 1, t1 = nl < 1 ? nl : 1;
    dma_issue<RBK>(srcK(0), LK, lds + KOFF, w); if (HASV) dma_issue<128>(srcV(0), LV, lds + VOFF, w);
    dma_issue<RBK>(srcK(t1), LK, lds + KOFF + KSZ, w); if (HASV) dma_issue<128>(srcV(t1), LV, lds + VOFF + 8192, w);
    constexpr int P = (RBK == 128 ? 1 : 2) + (HASV ? 1 : 0);
#define RT_STEP(bi, ii) do { const int i_ = (ii); \
        if (P == 1) asm volatile("s_waitcnt vmcnt(1)" ::: "memory"); else if (P == 2) asm volatile("s_waitcnt vmcnt(2)" ::: "memory"); else asm volatile("s_waitcnt vmcnt(3)" ::: "memory"); \
        __builtin_amdgcn_s_barrier(); asm volatile("" ::: "memory"); \
        { const int tn = (i_ + 2 < nl) ? i_ + 2 : nl; constexpr int b2 = ((bi) + 2) % 3; \
          dma_issue<RBK>(srcK(tn), LK, lds + KOFF + b2 * KSZ, w); if (HASV) dma_issue<128>(srcV(tn), LV, lds + VOFF + b2 * 8192, w); } \
        if (i_ < n) comp(i_, lds + KOFF + (bi) * KSZ, lds + VOFF + (bi) * 8192); } while (0)
    for (int i = 0; i < n; i += 3) { RT_STEP(0, i); RT_STEP(1, i + 1); RT_STEP(2, i + 2); }
#undef RT_STEP
    asm volatile("s_waitcnt vmcnt(0)" ::: "memory");
    __syncthreads();
}

__device__ __forceinline__ void mla_unit(const Params& p, LAS unsigned char* lds, int b, int h, int qb) {
    int tid = threadIdx.x; asm volatile("" : "+v"(tid));
    const int lane = tid & 63, w = __builtin_amdgcn_readfirstlane(tid >> 6), r32 = lane & 31, hi = lane >> 5;
    const bf16_t* qm = (const bf16_t*)((const unsigned char*)p.out + O_QM);
    const unsigned char* km = (const unsigned char*)p.out + O_KM + (((size_t)b * 8 + h) * S) * 192;
    const unsigned char* vmt = (const unsigned char*)p.out + O_VMT + (((size_t)b * 8 + h) * 64) * (size_t)S * 2;
    bf16_t* ocat = (bf16_t*)(p.ws + R_XN);
    const int tq = qb * 256 + 32 * w + r32;
    bf16x8 qf[6];
#pragma unroll
    for (int s = 0; s < 6; ++s) qf[s] = *(const bf16x8*)(qm + (((size_t)b * S + tq) * 8 + h) * 96 + 16 * s + 8 * hi);
    const float kn = 9.797958971f * 1.01f * wmax(fmaxf(fabsf(p.in[14][lane]), lane < 32 ? fabsf(p.in[14][64 + lane]) : 0.f));
    const float mref = sqrtf(qnorm2<6>(qf)) * kn;
    f32x16 negm;
#pragma unroll
    for (int r = 0; r < 16; ++r) negm[r] = -mref;
    Flash st; flash_init(st);
    const int ntile = 4 * qb + 4, dt = 4 * qb + (w >> 1);
#ifdef PROF_SEL
    if (b == 0 && h == 0 && qb == 15 && threadIdx.x == 0) { *PROF_SLOT(36) -= __builtin_amdgcn_s_memtime(); *PROF_SLOT(37) -= __builtin_amdgcn_s_memrealtime(); }
#endif
    unsigned kl[6], vl[4]; frag_offsets<96>(kl, vl, r32, hi);
    run_tiles<192, true, AL_K96, 16384, AL_V96>(ntile, lds, w, lane, 192u, (unsigned)(S * 2),
        [&](int i) { return km + (size_t)i * 64 * 192; }, [&](int i) { return vmt + (size_t)i * 128; },
        [&](int i, LAS unsigned char* kb, LAS unsigned char* vb) {
            if (i <= dt) {
                if (i < dt) tile_compute<96, 256, false>(st, kb, vb, qf, negm, kl, vl, true, [&](int r, int half, float& x) { return true; });
                else { const int kb0 = 64 * i + 4 * hi; tile_compute<96, 256, false>(st, kb, vb, qf, negm, kl, vl, true, [&](int r, int half, float& x) { return (kb0 + 32 * half + (r & 3) + 8 * (r >> 2)) <= tq; }); }
            }
        });
#ifdef PROF_SEL
    if (b == 0 && h == 0 && qb == 15 && threadIdx.x == 0) { *PROF_SLOT(36) += __builtin_amdgcn_s_memtime(); *PROF_SLOT(37) += __builtin_amdgcn_s_memrealtime(); }
#endif
    {
        const float lt = st.l + __shfl_xor(st.l, 32); const float f = lt > 0.f ? frcp(lt) : 0.f;
#pragma unroll
        for (int r = 0; r < 16; ++r) { const float fr_ = __shfl(f, crow(r, hi)); const size_t ro = ((size_t)b * S + qb * 256 + 32 * w + crow(r, hi)) * 1024 + 512 + h * 64 + r32; ocat[ro] = f2bf(st.o0[r] * fr_); ocat[ro + 32] = f2bf(st.o1[r] * fr_); }
    }
}

__device__ __forceinline__ void nsa_unit(const Params& p, LAS unsigned char* lds, int b, int g, int jt) {
    int tid = threadIdx.x; asm volatile("" : "+v"(tid));
    const int lane = tid & 63, w = __builtin_amdgcn_readfirstlane(tid >> 6), r32 = lane & 31, hi = lane >> 5;
    const int rh = w >> 1, qh = w & 1, h = 4 * g + rh, q0 = 64 * jt, ql = 32 * qh + r32, tq = q0 + ql;
    const unsigned char* xa = p.ws + R_XA;
    const bf16_t* qn = (const bf16_t*)(xa + A_QN);
    const size_t bg = (size_t)b * 2 + g;
    const unsigned char* ksn = xa + A_KSN + bg * S * 128; const unsigned char* kwn = xa + A_KWN + bg * S * 128;
    const unsigned char* vst = xa + A_VST + bg * 64 * (size_t)S * 2; const unsigned char* vwt = xa + A_VWT + bg * 64 * (size_t)S * 2;
    const unsigned char* kc = p.ws + SM_KC + bg * 256 * 128; const unsigned char* vct = p.ws + SM_VCT + bg * 64 * 512;
    const float* gates = (const float*)(xa + A_GATES) + ((size_t)b * S + tq) * 24 + h * 3;
    bf16_t* ocat = (bf16_t*)(p.ws + R_XN);
    LAS float* imp = (LAS float*)(lds + AL_IMP); LAS unsigned char* selb = lds + AL_SELB; LAS unsigned* uni = (LAS unsigned*)(lds + AL_UNI); LAS unsigned char* tl = lds + AL_TL; LAS float* bls = (LAS float*)(lds + AL_BL);
    const float* blg = (const float*)(p.ws + SM_BL) + h * 132;
    const float cb = blg[128];
    const float bmax = wmax(fmaxf(fmaxf(blg[lane], blg[64 + lane]), cb));
    if (qh == 0) { bls[rh * 132 + lane] = blg[lane] - cb; bls[rh * 132 + 64 + lane] = blg[64 + lane] - cb; if (lane == 0) bls[rh * 132 + 128] = 0.f; }
    const LAS float* blh = bls + rh * 132;
    bf16x8 qf[4];
#pragma unroll
    for (int s = 0; s < 4; ++s) qf[s] = *(const bf16x8*)(qn + (((size_t)b * S + tq) * 8 + h) * 64 + 16 * s + 8 * hi);
    const float kn = 8.f * 1.01f * wmax(fmaxf(fmaxf(fabsf(p.in[5][lane]), fabsf(p.in[5][64 + lane])), fabsf(p.in[5][128 + lane])));
    const float mref = sqrtf(qnorm2<4>(qf)) * kn + bmax;
    f32x16 negm;
#pragma unroll
    for (int r = 0; r < 16; ++r) negm[r] = cb - mref;
    float g0 = gates[0], g1 = gates[1], g2 = gates[2];
    if (p.dbg_branch >= 0) { g0 = p.dbg_branch == 0 ? 1.f : 0.f; g1 = p.dbg_branch == 1 ? 1.f : 0.f; g2 = p.dbg_branch == 2 ? 1.f : 0.f; }
    LAS float* otl = (LAS float*)(lds + AL_OT) + w * 2048;
#ifdef PROF_SEL
    if (b == 0 && g == 0 && jt == 63 && threadIdx.x == 0) *PROF_SLOT(48) -= __builtin_amdgcn_s_memtime();
#endif
    const int nvmax = (q0 + 63 - 31) / 16 + 1, ntc = (nvmax + 63) / 64;
    Flash st; flash_init(st);
    unsigned kl[4], vl[4]; frag_offsets<64>(kl, vl, r32, hi);
    run_tiles<128, true, AL_K64, 8192, AL_V64>(ntc, lds, w, lane, 128u, 512u,
        [&](int i) { return kc + (size_t)i * 64 * 128; }, [&](int i) { return vct + (size_t)i * 128; },
        [&](int i, LAS unsigned char* kb, LAS unsigned char* vb) {
            const int cb0 = 64 * i + 4 * hi;
            tile_compute<64, 128, false>(st, kb, vb, qf, negm, kl, vl, true, [&](int r, int half, float& x) {
                const int c = cb0 + 32 * half + (r & 3) + 8 * (r >> 2); const int dist = tq - 16 * c - 31; x += blh[dist < 0 ? 0 : (dist > 128 ? 128 : dist)]; return dist >= 0; });
        });
    flash_accum<true>(otl, st, g0, hi, lane);
    unsigned mlo, mhi;
    int nsel;
    if (jt < 16) { const unsigned long long mk = (1ull << (jt + 1)) - 1ull; mlo = (unsigned)mk; mhi = (unsigned)(mk >> 32); nsel = jt + 1; if (tid <= jt) tl[tid] = (unsigned char)tid; }
    else {
        for (int i = tid; i < 64 * 65; i += 512) imp[i] = 0.f;
        const float lt = st.l + __shfl_xor(st.l, 32); const float linv = lt > 0.f ? frcp(lt) : 0.f;
        float xlast = 0.f;
        run_tiles<128, false, AL_K64, 8192, AL_V64>(ntc, lds, w, lane, 128u, 0u,
            [&](int i) { return kc + (size_t)i * 64 * 128; }, [&](int i) { return kc; },
            [&](int i, LAS unsigned char* kb, LAS unsigned char* vb) {
                f32x16 p0, p1; qk_tile<64, 128>(p0, p1, kb, qf, negm, kl);
                const int cb0 = 64 * i + 4 * hi;
                float sm[2][4], cr[2][4];
#pragma unroll
                for (int half = 0; half < 2; ++half)
#pragma unroll
                    for (int a = 0; a < 4; ++a) {
                        float s4 = 0.f, last = 0.f;
#pragma unroll
                        for (int k = 0; k < 4; ++k) {
                            const int r = 4 * a + k; const int c = cb0 + 32 * half + k + 8 * a; const int dist = tq - 16 * c - 31;
                            const float sc = (half ? p1[r] : p0[r]) + blh[dist < 0 ? 0 : (dist > 128 ? 128 : dist)];
                            const float pv = dist >= 0 ? fexp2(sc) * linv : 0.f;
                            s4 += pv; last = pv;
                        }
                        sm[half][a] = s4; cr[half][a] = last;
                    }
                float tot[2][4];
#pragma unroll
                for (int half = 0; half < 2; ++half)
#pragma unroll
                    for (int a = 0; a < 4; ++a) {
                        const float xs_ = __shfl_xor(cr[half][a], 32);
                        const float xp_ = (a > 0) ? __shfl_xor(cr[half][a > 0 ? a - 1 : 0], 32) : (half ? __shfl_xor(cr[0][3], 32) : xlast);
                        tot[half][a] = sm[half][a] + (hi ? xs_ : xp_);
                    }
                xlast = __shfl_xor(cr[1][3], 32);
                for (int rr = 0; rr < 4; ++rr) {
                    if (rh == rr) {
#pragma unroll
                        for (int half = 0; half < 2; ++half)
#pragma unroll
                            for (int a = 0; a < 4; ++a) { const int j = 16 * i + 8 * half + 2 * a + hi; imp[ql * 65 + j] += tot[half][a]; }
                    }
                    __syncthreads();
                }
            });
        if (p.dbg_branch == 1) { for (int i = tid; i < 4096; i += 512) ((float*)(p.ws + R_H))[((size_t)g * S + q0 + (i >> 6)) * 64 + (i & 63)] = imp[(i >> 6) * 65 + (i & 63)]; }
        {
            const int q = tid >> 3, jg = tid & 7;
            float vj[8]; int rk[8];
#pragma unroll
            for (int jj = 0; jj < 8; ++jj) { const int j = jg * 8 + jj; const float x = imp[q * 65 + j]; vj[jj] = (j > jt) ? -1.f : ((j == jt || j == 0) ? 1e9f : x); rk[jj] = 0; }
#pragma unroll 4
            for (int i = 0; i < 64; ++i) {
                const float xi = imp[q * 65 + i]; const float vi = (i > jt) ? -1.f : ((i == jt || i == 0) ? 1e9f : xi);
#pragma unroll
                for (int jj = 0; jj < 8; ++jj) rk[jj] += (vi > vj[jj] || (vi == vj[jj] && i < jg * 8 + jj)) ? 1 : 0;
            }
            unsigned byte = 0;
#pragma unroll
            for (int jj = 0; jj < 8; ++jj) if (jg * 8 + jj <= jt && rk[jj] < 16) byte |= 1u << jj;
            selb[q * 8 + jg] = (unsigned char)byte;
        }
        __syncthreads();
        if (w == 0) {
            unsigned a = ((const LAS unsigned*)selb)[lane * 2], c = ((const LAS unsigned*)selb)[lane * 2 + 1];
#pragma unroll
            for (int o = 1; o < 64; o <<= 1) { a |= __shfl_xor(a, o); c |= __shfl_xor(c, o); }
            const unsigned long long um = ((unsigned long long)c << 32) | a;
            if ((um >> lane) & 1ull) tl[__builtin_popcountll(um & ((1ull << lane) - 1ull))] = (unsigned char)lane;
            if (lane == 0) uni[0] = (unsigned)__builtin_popcountll(um);
        }
        __syncthreads();
        mlo = ((const LAS unsigned*)selb)[ql * 2]; mhi = ((const LAS unsigned*)selb)[ql * 2 + 1];
        nsel = (int)uni[0];
    }
    if (p.dbg_branch == 1 && rh == 0) { if (hi == 0) ((unsigned long long*)(p.ws + R_H + 4 * 1048576))[(size_t)g * S + tq] = ((unsigned long long)mhi << 32) | mlo; }
    __syncthreads();
    {
        const unsigned long long mymask = ((unsigned long long)mhi << 32) | mlo;
        nsel = __builtin_amdgcn_readfirstlane(nsel);
        flash_init(st);
        run_tiles<128, true, AL_K64, 8192, AL_V64>(nsel, lds, w, lane, 128u, (unsigned)(S * 2),
            [&](int i) { return ksn + (size_t)__builtin_amdgcn_readfirstlane((int)tl[i]) * 64 * 128; }, [&](int i) { return vst + (size_t)__builtin_amdgcn_readfirstlane((int)tl[i]) * 128; },
            [&](int i, LAS unsigned char* kb, LAS unsigned char* vb) {
                const int j = __builtin_amdgcn_readfirstlane((int)tl[i]);
                const bool mine = (mymask >> j) & 1ull;
                if (q0 + 32 * qh - (64 * j + 63) >= 128) tile_compute<64, 128, true>(st, kb, vb, qf, negm, kl, vl, mine, [&](int r, int half, float& x) { return true; });
                else { const int kb0 = 64 * j + 4 * hi;
                    tile_compute<64, 128, true>(st, kb, vb, qf, negm, kl, vl, mine, [&](int r, int half, float& x) { const int dist = tq - (kb0 + 32 * half + (r & 3) + 8 * (r >> 2)); x += blh[dist < 0 ? 0 : (dist > 128 ? 128 : dist)]; return dist >= 0; }); }
            });
        flash_accum<false>(otl, st, g1, hi, lane);
    }
    {
        const int j0 = jt >= 8 ? jt - 8 : 0, nw = jt - j0 + 1;
        flash_init(st);
        run_tiles<128, true, AL_K64, 8192, AL_V64>(nw, lds, w, lane, 128u, (unsigned)(S * 2),
            [&](int i) { return kwn + (size_t)(j0 + i) * 64 * 128; }, [&](int i) { return vwt + (size_t)(j0 + i) * 128; },
            [&](int i, LAS unsigned char* kb, LAS unsigned char* vb) {
                const int kb0 = 64 * (j0 + i) + 4 * hi;
                tile_compute<64, 128, false>(st, kb, vb, qf, negm, kl, vl, true, [&](int r, int half, float& x) { const int dist = tq - (kb0 + 32 * half + (r & 3) + 8 * (r >> 2)); x += blh[dist < 0 ? 0 : (dist > 128 ? 128 : dist)]; return dist >= 0 && dist < 512; });
            });
        flash_accum<false>(otl, st, g2, hi, lane);
    }
#pragma unroll
    for (int r = 0; r < 16; ++r) { const size_t ro = ((size_t)b * S + q0 + 32 * qh + crow(r, hi)) * 1024 + h * 64 + r32; ocat[ro] = f2bf(otl[r * 64 + lane]); ocat[ro + 32] = f2bf(otl[(16 + r) * 64 + lane]); }
    __syncthreads();
#ifdef PROF_SEL
    if (b == 0 && g == 0 && jt == 63 && threadIdx.x == 0) *PROF_SLOT(48) += __builtin_amdgcn_s_memtime();
#endif
}

__device__ __forceinline__ void phase_p4(const Params& p, LAS unsigned char* lds) {
    const int G = gridDim.x, c = blockIdx.x, nunits = 256 * NB;
#if NB == 8
    if (G == 256) {
        const int b = c & 7, idx = c >> 3, pi = idx & 7, hq = idx >> 3;
#pragma unroll 1
        for (int u = 0; u < 8; ++u) {
            if (u < 4) nsa_unit(p, lds, b, u >> 1, (u & 1) ? idx : 63 - idx);
            else mla_unit(p, lds, b, ((u - 4) >> 1) * 4 + hq, (u & 1) ? pi : 15 - pi);
        }
        return;
    }
#endif
    for (int j = 0;; ++j) {
        const int k = j * G + ((j & 1) ? (G - 1 - c) : c);
        if (j * G >= nunits) break;
        if (k >= nunits) continue;
        const int ty = UNIT_TYPES[k / NB], b = k % NB, kind = ty >> 9, a = (ty >> 6) & 7, cc = ty & 63;
        if (kind == 0) nsa_unit(p, lds, b, a, cc); else mla_unit(p, lds, b, a, cc);
    }
}
__device__ __forceinline__ void phase_norm(const float* x, const float* g, bf16_t* xn) {
    const int tid_ = ltid(); const int lane = tid_ & 63, gw = blockIdx.x * 8 + (tid_ >> 6), NGW = gridDim.x * 8;
    for (int m = gw; m < T; m += NGW) rms_row_to_bf16(x + (size_t)m * D, g, xn + (size_t)m * D, lane);
}
__device__ __forceinline__ void phase_conv(const Params& p) {
    const int tid = ltid(), lane = tid & 63, gw = blockIdx.x * 8 + (tid >> 6), NGW = gridDim.x * 8;
    const bf16_t* hh = (const bf16_t*)(p.ws + R_H); bf16_t* v = (bf16_t*)(p.ws + R_XA); const float* cw = p.in[22];
    constexpr int RUN = 16;
    float w0[2][8], w1[2][8], w2[2][8];
#pragma unroll
    for (int j = 0; j < 2; ++j) { const int d = 8 * lane + 512 * j; load8f(cw + d, w0[j], 1.f); load8f(cw + 1024 + d, w1[j], 1.f); load8f(cw + 2048 + d, w2[j], 1.f); }
    for (int run = gw; run < T / RUN; run += NGW) {
        const int m0 = run * RUN, s0 = m0 & (S - 1);
        float pm2[2][8], pm1[2][8];
#pragma unroll
        for (int j = 0; j < 2; ++j) { const int d = 8 * lane + 512 * j;
#pragma unroll
            for (int q = 0; q < 2; ++q) {
                float (&dst)[8] = q ? pm1[j] : pm2[j];
                if (s0 - 2 + q >= 0) { const bf16_t* r = hh + (size_t)(m0 - 2 + q) * 3072; float c[8], u[8]; unpack8(*(const u32x4*)(r + 1024 + d), c); unpack8(*(const u32x4*)(r + 2048 + d), u);
#pragma unroll
                    for (int i = 0; i < 8; ++i) dst[i] = c[i] * u[i]; }
                else {
#pragma unroll
                    for (int i = 0; i < 8; ++i) dst[i] = 0.f; }
            } }
#pragma unroll 4
        for (int rr = 0; rr < RUN; ++rr) {
            const int m = m0 + rr; const bf16_t* r = hh + (size_t)m * 3072;
#pragma unroll
            for (int j = 0; j < 2; ++j) { const int d = 8 * lane + 512 * j;
                float b[8], c[8], u[8], y[8]; unpack8(*(const u32x4*)(r + d), b); unpack8(*(const u32x4*)(r + 1024 + d), c); unpack8(*(const u32x4*)(r + 2048 + d), u);
#pragma unroll
                for (int i = 0; i < 8; ++i) { const float cu = c[i] * u[i]; y[i] = b[i] * (w0[j][i] * pm2[j][i] + w1[j][i] * pm1[j][i] + w2[j][i] * cu); pm2[j][i] = pm1[j][i]; pm1[j][i] = cu; }
                *(u32x4*)(v + (size_t)m * 1024 + d) = pack8(y); }
        }
    }
}
__device__ __forceinline__ void phase_norm_router(const Params& p, LAS unsigned char* lds) {
    const int tid = ltid(), lane = tid & 63, wave = tid >> 6, gw = blockIdx.x * 8 + wave, NGW = gridDim.x * 8;
    const float* x3 = p.out; const float* g = p.in[24]; bf16_t* xn = (bf16_t*)(p.ws + R_XN);
    LAS float* wr = (LAS float*)lds;
    LAS int* lcnt = (LAS int*)(lds + 32768); LAS int* gb = lcnt + 8;
    int* te = (int*)(p.ws + SM_TE); float* tw = (float*)(p.ws + SM_TW); int* rank = (int*)(p.ws + SM_RANK); int* cnt = (int*)(p.ws + SM_CTL);
    for (int i = tid; i < 8192; i += 512) wr[i] = p.in[25][i];
    if (tid < 8) lcnt[tid] = 0;
    __syncthreads();
    for (int m = gw; m < T; m += NGW) {
        const f32x4* xr = (const f32x4*)(x3 + (size_t)m * D) + lane; const f32x4* gr = (const f32x4*)g + lane;
        f32x4 v[4]; float s = 0.f;
#pragma unroll
        for (int j = 0; j < 4; ++j) { v[j] = xr[64 * j]; s += (v[j].x * v[j].x + v[j].y * v[j].y) + (v[j].z * v[j].z + v[j].w * v[j].w); }
        const float r = rsqrtf(wsum(s) * (1.f / 1024.f) + EPS);
        float lg[8];
#pragma unroll
        for (int e = 0; e < 8; ++e) lg[e] = 0.f;
        u32x2* o8 = (u32x2*)(xn + (size_t)m * D) + lane;
#pragma unroll
        for (int j = 0; j < 4; ++j) { const f32x4 gg = gr[64 * j]; const f32x4 y = {v[j].x * r * gg.x, v[j].y * r * gg.y, v[j].z * r * gg.z, v[j].w * r * gg.w};
            u32x2 w; w.x = cvtpk(y.x, y.y); w.y = cvtpk(y.z, y.w); o8[64 * j] = w;
#pragma unroll
            for (int i = 0; i < 4; ++i) { const int d = 4 * lane + 256 * j + i; const f32x4 w0 = *(const LAS f32x4*)(wr + d * 8), w1 = *(const LAS f32x4*)(wr + d * 8 + 4);
                lg[0] += y[i] * w0.x; lg[1] += y[i] * w0.y; lg[2] += y[i] * w0.z; lg[3] += y[i] * w0.w; lg[4] += y[i] * w1.x; lg[5] += y[i] * w1.y; lg[6] += y[i] * w1.z; lg[7] += y[i] * w1.w; } }
#pragma unroll
        for (int e = 0; e < 8; ++e) lg[e] = wsum(lg[e]) + p.in[26][e];
        int e1 = 0; float l1 = lg[0];
#pragma unroll
        for (int e = 1; e < 8; ++e) if (lg[e] > l1) { l1 = lg[e]; e1 = e; }
        int e2 = -1; float l2 = -3e38f;
#pragma unroll
        for (int e = 0; e < 8; ++e) if (e != e1 && lg[e] > l2) { l2 = lg[e]; e2 = e; }
        if (lane == 0) {
            const float w1 = 1.f / (1.f + __expf(l2 - l1));
            te[m * 2] = e1; te[m * 2 + 1] = e2; tw[m * 2] = w1; tw[m * 2 + 1] = 1.f - w1;
            rank[m * 2] = __hip_atomic_fetch_add(&lcnt[e1], 1, __ATOMIC_RELAXED, __HIP_MEMORY_SCOPE_WORKGROUP); rank[m * 2 + 1] = __hip_atomic_fetch_add(&lcnt[e2], 1, __ATOMIC_RELAXED, __HIP_MEMORY_SCOPE_WORKGROUP);
        }
    }
    __syncthreads();
    if (tid < 8) gb[tid] = atomicAdd(&cnt[tid], lcnt[tid]);
    __syncthreads();
    for (int m = gw; m < T; m += NGW) if (lane < 2) rank[m * 2 + lane] += gb[te[m * 2 + lane]];
}
__device__ __forceinline__ void phase_moe_gather(const Params& p) {
    const int tid = ltid(), lane = tid & 63, gw = blockIdx.x * 8 + (tid >> 6), NGW = gridDim.x * 8;
    const int* cnt = (const int*)(p.ws + SM_CTL); const int* te = (const int*)(p.ws + SM_TE); const float* tw = (const float*)(p.ws + SM_TW); const int* rank = (const int*)(p.ws + SM_RANK);
    int* pos = (int*)(p.ws + SM_POS); float* roww = (float*)(p.ws + SM_ROWW); int* tile_e = (int*)(p.ws + SM_TILEE);
    int* rowtok = (int*)(p.ws + SM_ROWTOK);
    int off[9]; off[0] = 0;
#pragma unroll
    for (int e = 0; e < 8; ++e) off[e + 1] = off[e] + ((cnt[e] + 255) & ~255);
    if (blockIdx.x == 0) {
        for (int i = tid; i < ROWS_MAX / 256; i += 512) { int e = -1;
#pragma unroll
            for (int k = 0; k < 8; ++k) if (i * 256 >= off[k] && i * 256 < off[k + 1]) e = k;
            tile_e[i] = e < 0 ? 0 : e; }
        if (tid == 0) ((int*)(p.ws + SM_CTL))[8] = off[8];
    }
    if (blockIdx.x < 8 && tid < 256) {
#pragma unroll
        for (int e = 0; e < 8; ++e) if (e == (int)blockIdx.x) { const int c = cnt[e]; if (c + tid < off[e + 1] - off[e]) { roww[off[e] + c + tid] = 0.f; rowtok[off[e] + c + tid] = -1; } }
    }
    for (int pi0 = gw * 4; pi0 < 2 * T; pi0 += NGW * 4) {
        int r[4]; float w[4];
#pragma unroll
        for (int q = 0; q < 4; ++q) { const int e = te[pi0 + q]; int o = 0;
#pragma unroll
            for (int k = 0; k < 8; ++k) if (k == e) o = off[k];
            r[q] = o + rank[pi0 + q]; w[q] = tw[pi0 + q]; }
#pragma unroll
        for (int q = 0; q < 4; ++q) if (lane == q) { pos[pi0 + q] = r[q]; roww[r[q]] = w[q]; rowtok[r[q]] = (pi0 + q) >> 1; }
    }
}
__device__ __forceinline__ void phase_moe_combine(const Params& p) {
    const int tid_ = ltid(); const int lane = tid_ & 63, gw = blockIdx.x * 8 + (tid_ >> 6), NGW = gridDim.x * 8;
    const int* pos = (const int*)(p.ws + SM_POS); const bf16_t* ym = (const bf16_t*)(p.ws + R_XA);
    for (int m0 = gw * 2; m0 < T; m0 += NGW * 2) {
        int ps[4];
#pragma unroll
        for (int q = 0; q < 4; ++q) ps[q] = pos[m0 * 2 + q];
        f32x4 x[2][4]; u32x2 ya[2][4], yc[2][4];
#pragma unroll
        for (int q = 0; q < 2; ++q)
#pragma unroll
            for (int j = 0; j < 4; ++j) { const int d = 4 * lane + 256 * j;
                x[q][j] = *(const f32x4*)(p.out + (size_t)(m0 + q) * D + d); ya[q][j] = *(const u32x2*)(ym + (size_t)ps[2 * q] * D + d); yc[q][j] = *(const u32x2*)(ym + (size_t)ps[2 * q + 1] * D + d); }
#pragma unroll
        for (int q = 0; q < 2; ++q)
#pragma unroll
            for (int j = 0; j < 4; ++j) { const int d = 4 * lane + 256 * j; f32x4 o = x[q][j]; const u32x2 a = ya[q][j], c = yc[q][j];
                o.x += bflo(a.x) + bflo(c.x); o.y += bfhi(a.x) + bfhi(c.x); o.z += bflo(a.y) + bflo(c.y); o.w += bfhi(a.y) + bfhi(c.y);
                *(f32x4*)(p.out + (size_t)(m0 + q) * D + d) = o; }
    }
}

#define XB_TMO      128
#define XB_XCNT(j)  (256  + 64 * (j))
#define XB_XSUB(j)  (1280 + 64 * (j))
#define XB_XGEN(j)  (2304 + 64 * (j))
#define XB_TOP      3328
#define XB_TOPGEN   3392
#define XCD_BAR_WORDS 3456
#define XB_SPIN_CAP (1u << 18)

__device__ __forceinline__ unsigned xb_ld(unsigned* p)              { return __hip_atomic_load(p, __ATOMIC_RELAXED, __HIP_MEMORY_SCOPE_AGENT); }
__device__ __forceinline__ unsigned xb_add(unsigned* p, unsigned v) { return __hip_atomic_fetch_add(p, v, __ATOMIC_RELAXED, __HIP_MEMORY_SCOPE_AGENT); }
__device__ __forceinline__ unsigned xb_xcc_id() { return (unsigned)__builtin_amdgcn_s_getreg((3 << 11) | 20) & 0xFu; }
#define XB_SPIN(cond, bar) do { unsigned _sp = 0; while (cond) { __builtin_amdgcn_s_sleep(1); \
    if ((++_sp & 255u) == 0u) { if (xb_ld(&(bar)[XB_TMO])) break; if (_sp > XB_SPIN_CAP) { atomicAdd(&(bar)[XB_TMO], 1u); break; } } } } while (0)

struct XcdBarrier {
    unsigned* bar; unsigned x;
    volatile LAS unsigned* st;
};

__device__ __forceinline__ XcdBarrier xcd_barrier_post(unsigned* bar, volatile LAS unsigned* st) {
    XcdBarrier b; b.bar = bar; b.x = xb_xcc_id(); b.st = st;
    if (threadIdx.x == 0) (void)xb_add(&bar[XB_XCNT(b.x)], 1u);
    return b;
}
__device__ __forceinline__ void xcd_barrier_complete(unsigned* bar, unsigned x, unsigned& nloc, unsigned& nx) {
    const unsigned G = gridDim.x * gridDim.y * gridDim.z;
    unsigned sum, cnt, mine, sp = 0u;
    for (;;) {
        sum = 0u; cnt = 0u; mine = 0u;
#pragma unroll
        for (unsigned j = 0; j < 16; ++j) { const unsigned c = xb_ld(&bar[XB_XCNT(j)]); sum += c; cnt += (c > 0u) ? 1u : 0u; mine = (j == x) ? c : mine; }
        if (sum == G) break;
        __builtin_amdgcn_s_sleep(1);
        if ((++sp & 255u) == 0u) { if (xb_ld(&bar[XB_TMO])) break; if (sp > XB_SPIN_CAP) { atomicAdd(&bar[XB_TMO], 1u); break; } }
    }
    nloc = mine > 0u ? mine : 1u; nx = cnt > 0u ? cnt : 1u;
}

__device__ __forceinline__ void xcd_barrier(const XcdBarrier& b) {
    asm volatile("s_waitcnt vmcnt(0)" ::: "memory");
    __syncthreads();
    if (threadIdx.x == 0) {
        unsigned* bar = b.bar;
        __builtin_amdgcn_s_waitcnt(0);
        unsigned nloc = b.st[0], nx = b.st[1];
        if (nloc == 0u) { xcd_barrier_complete(bar, b.x, nloc, nx); b.st[0] = nloc; b.st[1] = nx; }
        const unsigned old = xb_add(&bar[XB_XSUB(b.x)], 1u);
        const unsigned gen = old / nloc;
        if (old + 1u == (gen + 1u) * nloc) {
            __builtin_amdgcn_fence(__ATOMIC_RELEASE, "agent");
            asm volatile("s_waitcnt vmcnt(0)" ::: "memory");
            const unsigned og = xb_add(&bar[XB_TOP], 1u);
            const unsigned tg = og / nx;
            if (og + 1u == (tg + 1u) * nx) xb_add(&bar[XB_TOPGEN], 1u);
            else XB_SPIN(xb_ld(&bar[XB_TOPGEN]) == tg, bar);
            __builtin_amdgcn_fence(__ATOMIC_ACQUIRE, "agent");
            xb_add(&bar[XB_XGEN(b.x)], 1u);
            asm volatile("s_waitcnt vmcnt(0)" ::: "memory");
        } else {
            XB_SPIN(xb_ld(&bar[XB_XGEN(b.x)]) == gen, bar);
            __builtin_amdgcn_fence(__ATOMIC_ACQUIRE, "agent");
            asm volatile("s_waitcnt vmcnt(0)" ::: "memory");
        }
    }
    __syncthreads();
}


__global__ void __launch_bounds__(512) mega_fwd(Params p) {
    extern __shared__ __attribute__((aligned(16))) unsigned char lds_raw[];
    LAS unsigned char* lds = (LAS unsigned char*)lds_raw;
    cg::grid_group grid = cg::this_grid();
    volatile LAS unsigned* bst = (volatile LAS unsigned*)(lds + 140032);
    if (threadIdx.x == 0) { bst[0] = 0u; bst[1] = 0u; const unsigned long long ba = (unsigned long long)(p.ws + SM_BAR); bst[2] = (unsigned)ba; bst[3] = (unsigned)(ba >> 32); }
    __syncthreads();
    (void)xcd_barrier_post((unsigned*)(p.ws + SM_BAR), bst);
#ifdef PROF_SEL
#define PSTAMP(k) do { if (blockIdx.x == 0 && threadIdx.x == 0) { volatile LAS unsigned* pl_ = (volatile LAS unsigned*)(lds + 140032 + 16); const unsigned long long now_ = __builtin_amdgcn_s_memrealtime(); const unsigned long long last_ = ((unsigned long long)pl_[1] << 32) | pl_[0]; *PROF_SLOT(k) += now_ - last_; pl_[0] = (unsigned)now_; pl_[1] = (unsigned)(now_ >> 32); } } while (0)
#else
#define PSTAMP(k)
#endif
#define GSYNC() do { XcdBarrier xb_; volatile LAS unsigned* st_ = (volatile LAS unsigned*)(lds + 140032); xb_.bar = (unsigned*)(((unsigned long long)st_[3] << 32) | st_[2]); xb_.x = xb_xcc_id(); xb_.st = st_; xcd_barrier(xb_); } while (0)
#ifdef PROF_SEL
    if (threadIdx.x == 0) { volatile LAS unsigned* pl_ = (volatile LAS unsigned*)(lds + 140032 + 16); const unsigned long long now_ = __builtin_amdgcn_s_memrealtime(); pl_[0] = (unsigned)now_; pl_[1] = (unsigned)(now_ >> 32); }
#endif
    const int G = gridDim.x, c = blockIdx.x;
#define LP() bf16_t* W = (bf16_t*)p.ws; bf16_t* xn = (bf16_t*)(p.ws + R_XN); float* x1 = (float*)(p.ws + R_XA); pg8::StaticOrder SO; (void)W; (void)xn; (void)x1; (void)SO
#ifndef PHMASK
#define PHMASK 0xFFFFFFFFu
#endif
#ifndef REPEAT_MASK
#define REPEAT_MASK 0u
#endif
#define PH(k) if (((PHMASK >> (k)) & 1u) && (k) >= p.ph_lo && (k) <= p.ph_hi)
#define RPT(k) if ((REPEAT_MASK >> (k)) & 1u)
    PH(0) { LP(); phase_p0(p, lds); }
    GSYNC(); PSTAMP(0);
    if (p.ph_lo == -12345) grid.sync();
    RPT(0) { { LP(); phase_p0(p, lds); } GSYNC(); }
    PH(1) { LP();
        pg8::Gemm g{xn, W + W_IN_E / 2, T, 1792, 1024, 1024, nullptr, 0, nullptr}; SO.init(T, 1792, G, c);
        pg8::EpiBf16<0> E{(bf16_t*)(p.ws + R_H), 1792, nullptr, nullptr};
        pg8::gemm_phase<pg8::EpiBf16<0>, true>(lds, g, SO, E);
    }
    GSYNC(); PSTAMP(1);
    PH(2) { LP(); phase_p2(p, lds); }
    GSYNC(); PSTAMP(2);
    RPT(2) { { LP(); phase_p2(p, lds); } GSYNC(); }
    PH(3) { LP();
        const int nCu = 2 * (NB * 512 / 256) * 2, Gc = (nCu < G / 2) ? nCu : 0;
        if (Gc == 0 || c < Gc) {
            for (int kv = 0; kv < 2; ++kv) {
                pg8::Gemm g{(const bf16_t*)(p.ws + R_XA + (kv ? A_VCIN : A_KCIN)), W + W_CW1 / 2 + (size_t)kv * 512 * 1024, NB * 512, 512, 1024, 1024, nullptr, 0, nullptr};
                if (Gc) SO.init(NB * 512, 512, Gc / 2, c - kv * (Gc / 2)); else SO.init(NB * 512, 512, G, c);
                pg8::EpiBf16<0> E{(bf16_t*)(p.ws + SM_HID) + (size_t)kv * NB * 512 * 512, 512, nullptr, nullptr};
                if (Gc == 0 || (c / (Gc / 2)) == kv) pg8::gemm_phase<pg8::EpiBf16<0>, true>(lds, g, SO, E);
            }
        }
        if (Gc == 0 || c >= Gc) {
            {
                pg8::Gemm g{(const bf16_t*)(p.ws + R_XA + A_CQN), W + W_UQ / 2, T, 1024, 256, 256, nullptr, 0, nullptr}; SO.init(T, 1024, G - Gc, c - Gc);
                pg8::EpiBf16<0> E{(bf16_t*)(p.ws + R_H), 1024, nullptr, nullptr};
                pg8::gemm_phase<pg8::EpiBf16<0>, true>(lds, g, SO, E);
            }
            {
                pg8::Gemm g{(const bf16_t*)(p.ws + R_XA + A_CKVN), W + W_UKV / 2, T, 1024, 128, 128, nullptr, 0, nullptr}; SO.init(T, 1024, G - Gc, c - Gc);
                pg8::EpiBf16<0> E{(bf16_t*)(p.ws + R_H + (size_t)T * 2048), 1024, nullptr, nullptr};
                pg8::gemm_phase<pg8::EpiBf16<0>, true>(lds, g, SO, E);
            }
        }
    }
    GSYNC(); PSTAMP(3);
    PH(4) { LP(); phase_p3b(p, lds); }
    GSYNC(); PSTAMP(4);
    RPT(4) { { LP(); phase_p3b(p, lds); } GSYNC(); }
    PH(5) { LP(); phase_p4(p, lds); }
    GSYNC(); PSTAMP(5);
    RPT(5) { { LP(); phase_p4(p, lds); } GSYNC(); }
    PH(6) { LP();
        pg8::Gemm g{xn, W + W_OUT_E / 2, T, 1024, 1024, 1024, nullptr, 0, nullptr}; SO.init(T, 1024, G, c);
        pg8::EpiResStat<false> E{p.in[0], (bf16_t*)p.out, (float*)(p.ws + SM_SSP1), 1024};
        pg8::gemm_phase<pg8::EpiResStat<false>, true>(lds, g, SO, E);
    }
    GSYNC(); PSTAMP(6);
    PH(7) { }
    PH(8) { LP();
        pg8::Gemm g{(const bf16_t*)p.out, W + W_GU / 2, T, 5632, 1024, 1024, nullptr, 0, nullptr}; SO.init(T, 5632, G, c);
        pg8::EpiSwiGLU E{(bf16_t*)(p.ws + R_H), 2816, (const float*)(p.ws + SM_SSP1)};
        pg8::gemm_phase<pg8::EpiSwiGLU, true>(lds, g, SO, E);
    }
    GSYNC(); PSTAMP(8);
    PH(9) { LP();
        pg8::Gemm g{(const bf16_t*)(p.ws + R_H), W + W_D / 2, T, 1024, 2816, 2816, nullptr, 0, nullptr}; SO.init(T, 1024, G, c);
        pg8::EpiResStat<true> E{(const bf16_t*)p.out, xn, (float*)(p.ws + SM_SSP2), 1024};
        pg8::gemm_phase<pg8::EpiResStat<true>, true>(lds, g, SO, E);
    }
    GSYNC(); PSTAMP(9);
    PH(10) { }
    PH(11) { LP();
        pg8::Gemm g{xn, W + W_IN_O / 2, T, 3072, 1024, 1024, nullptr, 0, nullptr}; SO.init(T, 3072, G, c);
        pg8::EpiBf16<0> E{(bf16_t*)(p.ws + R_H), 3072, nullptr, (const float*)(p.ws + SM_SSP2)};
        pg8::gemm_phase<pg8::EpiBf16<0>, true>(lds, g, SO, E);
    }
    GSYNC(); PSTAMP(11);
    PH(12) { LP(); phase_conv(p); }
    GSYNC(); PSTAMP(12);
    RPT(12) { { LP(); phase_conv(p); } GSYNC(); }
    PH(13) { LP();
        pg8::Gemm g{(const bf16_t*)x1, W + W_OUT_O / 2, T, 1024, 1024, 1024, nullptr, 0, nullptr}; SO.init(T, 1024, G, c);
        pg8::EpiResF32B E{xn, p.out, 1024};
        pg8::gemm_phase<pg8::EpiResF32B, true>(lds, g, SO, E);
    }
    GSYNC(); PSTAMP(13);
    PH(14) { LP(); phase_norm_router(p, lds); }
    GSYNC(); PSTAMP(14);
    PH(15) { LP(); phase_moe_gather(p); }
    GSYNC(); PSTAMP(15);
    PH(16) { LP(); const int mrows = ((const int*)(p.ws + SM_CTL))[8];
        pg8::Gemm g{xn, W + W_MGU / 2, mrows, 2816, 1024, 1024, (const int*)(p.ws + SM_TILEE), (size_t)2816 * 1024, (const int*)(p.ws + SM_ROWTOK)}; SO.init(mrows, 2816, G, c);
        pg8::EpiSwiGLU E{(bf16_t*)(p.ws + R_H), 1408, nullptr};
        pg8::gemm_phase<pg8::EpiSwiGLU, true, true>(lds, g, SO, E);
    }
    GSYNC(); PSTAMP(16);
    PH(17) { LP(); const int mrows = ((const int*)(p.ws + SM_CTL))[8];
        pg8::Gemm g{(const bf16_t*)(p.ws + R_H), W + W_MD / 2, mrows, 1024, 1408, 1408, (const int*)(p.ws + SM_TILEE), (size_t)1024 * 1408, nullptr}; SO.init(mrows, 1024, G, c);
        pg8::EpiRowScaleBf16 E{(bf16_t*)(p.ws + R_XA), 1024, (const float*)(p.ws + SM_ROWW)};
        pg8::gemm_phase<pg8::EpiRowScaleBf16, true>(lds, g, SO, E);
    }
    GSYNC(); PSTAMP(17);
    PH(18) { LP(); phase_moe_combine(p); }
#ifdef PROF_SEL
    GSYNC(); PSTAMP(18);
    GSYNC();
    {
        unsigned long long v_ = *PROF_SLOT(PROF_SEL);
#ifdef PROF_DIV
        const unsigned long long dv_ = *PROF_SLOT(PROF_DIV); v_ = dv_ ? v_ / dv_ : 0ull;
#endif
        unsigned long long a_ = v_ / (unsigned long long)(PROF_UNIT); if (a_ > 27ull) a_ = 27ull;
        const float sc_ = 1.f + (float)a_;
        for (size_t i = (size_t)blockIdx.x * 512 + threadIdx.x; i < (size_t)S * 1024 / 4; i += (size_t)gridDim.x * 512) { f32x4* o = (f32x4*)p.out + i; *o = *o * sc_; }
    }
#endif
#undef PH
}

inline void launch(void* const* d_in, float* d_out, void* d_ws, size_t ws_size, hipStream_t stream, int ph_lo = 0, int ph_hi = 99, int dbg_branch = -1) {
    static int grid = 0;
    if (grid == 0) {
        int dev = 0, cus = 0, per_cu = 0;
        hipGetDevice(&dev); hipDeviceGetAttribute(&cus, hipDeviceAttributeMultiprocessorCount, dev);
        hipFuncSetAttribute((const void*)mega_fwd, hipFuncAttributeMaxDynamicSharedMemorySize, LDS_BYTES);
        hipOccupancyMaxActiveBlocksPerMultiprocessor(&per_cu, (const void*)mega_fwd, 512, LDS_BYTES);
        if (per_cu < 1) { fprintf(stderr, "occupancy query says %d blocks/CU\n", per_cu); per_cu = 1; }
        grid = cus;
        if (WS_FAST_END > ws_size) { fprintf(stderr, "ws too small: need %zu have %zu\n", (size_t)WS_FAST_END, ws_size); grid = -1; }
    }
    if (grid < 0) return;
    if (ph_lo <= 14 && ph_hi >= 14) hipMemsetAsync((char*)d_ws + SM_CTL, 0, 4096, stream);
    hipMemsetAsync((char*)d_ws + SM_BAR, 0, 16384, stream);
    Params p{};
    for (int i = 0; i < 30; ++i) p.in[i] = (const float*)d_in[i];
    p.out = d_out; p.ws = (unsigned char*)d_ws; p.ph_lo = ph_lo; p.ph_hi = ph_hi; p.dbg_branch = dbg_branch;
    void* args[] = {&p};
    hipError_t e = hipLaunchCooperativeKernel((const void*)mega_fwd, dim3(grid), dim3(512), args, LDS_BYTES, stream);
    if (e != hipSuccess) fprintf(stderr, "cooperative launch failed: %s (grid %d)\n", hipGetErrorString(e), grid);
}
}
extern "C" void kernel_launch(void* const* d_in, const int* in_sizes, int n_in, void* d_out, int out_size, void* d_ws, size_t ws_size, hipStream_t stream) {
    fast::launch(d_in, (float*)d_out, d_ws, ws_size, stream);
}
```

```cpp
#include <hip/hip_runtime.h>
#include <hip/hip_bf16.h>
#include <stdint.h>
#include <stdio.h>
#include <string.h>
#include <hip/hip_cooperative_groups.h>
namespace cg = cooperative_groups;
#define NB 8
#define REPEAT_MASK 0x0u
namespace gold {
constexpr int S = 4096, D = 1024, HW = 1720;
constexpr float EPS = 1e-6f;

__device__ const unsigned char T5B[128] = {0, 1, 2, 3, 4, 5, 6, 7, 8, 9, 10, 11, 12, 13, 14, 15, 16, 16, 16, 17, 17, 18, 18, 18, 19, 19, 19, 20, 20, 20, 20, 21, 21, 21, 21, 22, 22, 22, 22, 22, 23, 23, 23, 23, 23, 23, 24, 24, 24, 24, 24, 24, 25, 25, 25, 25, 25, 25, 25, 26, 26, 26, 26, 26, 26, 26, 26, 27, 27, 27, 27, 27, 27, 27, 27, 27, 27, 28, 28, 28, 28, 28, 28, 28, 28, 28, 28, 29, 29, 29, 29, 29, 29, 29, 29, 29, 29, 29, 29, 30, 30, 30, 30, 30, 30, 30, 30, 30, 30, 30, 30, 30, 30, 31, 31, 31, 31, 31, 31, 31, 31, 31, 31, 31, 31, 31, 31};
}
#ifndef NB
#define NB 8
#endif
namespace fast {
#define LAS __attribute__((address_space(3)))
typedef unsigned short bf16_t;
typedef short bf16x8 __attribute__((ext_vector_type(8)));
typedef float f32x4 __attribute__((ext_vector_type(4)));
typedef float f32x2 __attribute__((ext_vector_type(2)));
typedef float f32x16 __attribute__((ext_vector_type(16)));
typedef unsigned u32x4 __attribute__((ext_vector_type(4)));
typedef unsigned u32x2 __attribute__((ext_vector_type(2)));
typedef __bf16 bf16x2_t __attribute__((ext_vector_type(2)));

constexpr int S = 4096, T = NB * S, D = 1024;
constexpr float EPS = 1e-6f, LOG2E = 1.4426950408889634f;

__device__ __forceinline__ unsigned cvtpk(float lo, float hi) { f32x2 v = {lo, hi}; bf16x2_t b = __builtin_convertvector(v, bf16x2_t); return __builtin_bit_cast(unsigned, b); }
__device__ __forceinline__ bf16_t f2bf(float f) { return (bf16_t)(cvtpk(f, 0.f) & 0xffffu); }
__device__ __forceinline__ float bf2f(bf16_t u) { return __builtin_bit_cast(float, (unsigned)u << 16); }
__device__ __forceinline__ float bflo(unsigned u) { return __builtin_bit_cast(float, u << 16); }
__device__ __forceinline__ float bfhi(unsigned u) { return __builtin_bit_cast(float, u & 0xffff0000u); }
__device__ __forceinline__ float wsum(float v) {
#pragma unroll
    for (int o = 1; o < 64; o <<= 1) v += __shfl_xor(v, o);
    return v;
}
__device__ __forceinline__ float fexp2(float x) { return __builtin_amdgcn_exp2f(x); }
__device__ __forceinline__ float frcp(float x) { return __builtin_amdgcn_rcpf(x); }
__device__ __forceinline__ float silu_f(float x) { return x * frcp(1.f + fexp2(-x * LOG2E)); }
__device__ __forceinline__ float gelu_tanh_f(float x) {
    const float u = 0.7978845608028654f * (x + 0.044715f * x * x * x);
    return x * frcp(1.f + fexp2(-2.f * LOG2E * u));
}

namespace pg8 {
constexpr int BM = 256, BK = 64, HALF = 128, HTB = HALF * BK * 2, STAGE_BYTES = 8 * HTB, NXCD = 8, WGM = 8;
__host__ __device__ __forceinline__ int lds_byte(int r, int c) { const int st = (r >> 4) * 2 + (c >> 5), rr = r & 15, cc = c & 31, ob = rr * 64 + cc * 2; return st * 1024 + (ob ^ (((ob >> 9) & 1) << 5)); }
__host__ __device__ __forceinline__ void stage_rc(int b, int& R, int& C) { const int st = b / 1024, sb = b % 1024, swz = sb ^ (((sb >> 9) & 1) << 5); R = (st >> 1) * 16 + swz / 64; C = (st & 1) * 32 + (swz % 64) / 2; }
__host__ __device__ __forceinline__ int perm32(int rho) { const int n = rho >> 4, i = rho & 15; return 8 * (i >> 2) + 4 * n + (i & 3); }

struct Unit { int pm, pn; };
struct Gemm { const bf16_t* A; const bf16_t* Bt; int M, N, K, lda; const int* tile_e; size_t estride; const int* rowidx; };

struct StaticOrder {
    int nM, nN, nwg, G, c;
    __device__ void init(int M, int N, int G_, int c_) { nM = M / BM; nN = N / BM; nwg = nM * nN; G = G_; c = c_; }
    __device__ bool next(int i, Unit& u) const {
        const long L = (long)i * G + c; if (L >= nwg) return false;
        int wgid = (int)L; { const int q = nwg / NXCD, r = nwg % NXCD, xcd = wgid % NXCD, off = wgid / NXCD; wgid = (xcd < r ? xcd * (q + 1) : r * (q + 1) + (xcd - r) * q) + off; }
        const int nig = WGM * nN, gid = wgid / nig, fm = gid * WGM, gsz = (nM - fm) < WGM ? (nM - fm) : WGM;
        u.pm = fm + ((wgid % nig) % gsz); u.pn = (wgid % nig) / gsz; return true;
    }
};

template <class Epi, bool ALIGN_EPI, bool GATHER = false>
__device__ __forceinline__ void gemm_phase(LAS unsigned char* lds, const Gemm g, const StaticOrder& S, const Epi& E) {
    int tid = threadIdx.x; asm volatile("" : "+v"(tid));
    const int wid = __builtin_amdgcn_readfirstlane(tid >> 6), lane = tid & 63, wr = wid >> 2, wc = wid & 3, fr = lane & 15, fq = lane >> 4;
    const int K = g.K, nt = K / BK, lda = g.lda;
    unsigned voffA[2], voffB[2];
#pragma unroll
    for (int i = 0; i < 2; ++i) { int R, C; stage_rc(tid * 16 + i * 8192, R, C); const int Rb = Epi::PERM ? ((R & ~31) + perm32(R & 31)) : R;
        voffA[i] = (unsigned)(R * lda + C) * 2u; voffB[i] = (unsigned)(Rb * K + C) * 2u; }
    const size_t kstep = (size_t)(BK * 2);
    const size_t hsA = GATHER ? 0 : (size_t)HALF * lda * 2, tsA = 2 * hsA, hsB = (size_t)HALF * K * 2, tsB = 2 * hsB;
    unsigned vgc[2][2], vgn[2][2];
#define PG8_GOFF(pm_, vg) do { _Pragma("unroll") for (int h_ = 0; h_ < 2; ++h_) _Pragma("unroll") for (int i_ = 0; i_ < 2; ++i_) { int R_, C_; stage_rc(tid * 16 + i_ * 8192, R_, C_); \
        int tok_ = g.rowidx[(pm_) * BM + h_ * HALF + R_]; tok_ = tok_ < 0 ? 0 : tok_; vg[h_][i_] = (unsigned)(tok_ * lda + C_) * 2u; } } while (0)
#define PG8_STAGE_A(bufoff, gbase, h, nx) do { unsigned va_[2]; _Pragma("unroll") for (int i_ = 0; i_ < 2; ++i_) va_[i_] = GATHER ? ((nx) ? vgn[h][i_] : vgc[h][i_]) : voffA[i_]; PG8_STAGE(bufoff, gbase, va_); } while (0)
    const unsigned ldsw = (unsigned)wid * 1024u;
    const int aoff = lds_byte(wr * 64 + fr, fq * 8), boff = lds_byte(wc * 32 + fr, fq * 8);
#define PG8_SA(b, h) (((b) * 2 + (h)) * HTB)
#define PG8_SB(b, h) ((4 + (b) * 2 + (h)) * HTB)
#define PG8_STAGE(bufoff, gbase, voff) do { _Pragma("unroll") for (int _i = 0; _i < 2; ++_i) \
        __builtin_amdgcn_global_load_lds((const unsigned*)((const char*)(gbase) + (voff)[_i]), (LAS unsigned*)(lds + (bufoff) + ldsw + _i * 8192), 16, 0, 0); } while (0)
#define PG8_LDA(dst, b, h) do { _Pragma("unroll") for (int m = 0; m < 4; ++m) _Pragma("unroll") for (int k = 0; k < 2; ++k) dst[m][k] = *(const LAS bf16x8*)(lds + PG8_SA(b, h) + aoff + m * 2048 + k * 1024); } while (0)
#define PG8_LDB(dst, b, h) do { _Pragma("unroll") for (int n = 0; n < 2; ++n) _Pragma("unroll") for (int k = 0; k < 2; ++k) dst[n][k] = *(const LAS bf16x8*)(lds + PG8_SB(b, h) + boff + n * 2048 + k * 1024); } while (0)
#define PG8_MMA(ai, bj, At, Bt) do { __builtin_amdgcn_s_setprio(1); _Pragma("unroll") for (int m = 0; m < 4; ++m) _Pragma("unroll") for (int n = 0; n < 2; ++n) _Pragma("unroll") for (int k = 0; k < 2; ++k) \
        acc[ai][bj][m][n] = __builtin_amdgcn_mfma_f32_16x16x32_bf16(Bt[n][k], At[m][k], acc[ai][bj][m][n], 0, 0, 0); __builtin_amdgcn_s_setprio(0); } while (0)
#define PG8_WAIT_V(n) asm volatile("s_waitcnt vmcnt(" #n ")" ::: "memory")
#define PG8_WAIT_L(n) asm volatile("s_waitcnt lgkmcnt(" #n ")" ::: "memory")
#define PG8_BAR __builtin_amdgcn_s_barrier()
#define PG8_SCHED __builtin_amdgcn_sched_barrier(0)
#define PG8_EOFF(pm_) (g.tile_e ? (size_t)g.tile_e[pm_] * g.estride * 2 : (size_t)0)
    Unit cur, nxt; int ui = 0;
    if (!S.next(0, cur)) return;
    f32x4 acc[2][2][4][2];
#pragma unroll
    for (int a = 0; a < 2; ++a)
#pragma unroll
        for (int b = 0; b < 2; ++b)
#pragma unroll
            for (int m = 0; m < 4; ++m)
#pragma unroll
                for (int n = 0; n < 2; ++n) acc[a][b][m][n] = (f32x4){0.f, 0.f, 0.f, 0.f};
    bf16x8 At[4][2], B0[2][2], B1[2][2];
    const char* cA = (const char*)g.A + (size_t)cur.pm * tsA; const char* cB = (const char*)g.Bt + PG8_EOFF(cur.pm) + (size_t)cur.pn * tsB;
    if constexpr (GATHER) PG8_GOFF(cur.pm, vgc);
    PG8_STAGE(PG8_SB(0, 0), cB, voffB); PG8_STAGE(PG8_SB(0, 1), cB + hsB, voffB); PG8_STAGE_A(PG8_SA(0, 0), cA, 0, false); PG8_STAGE_A(PG8_SA(0, 1), cA + hsA, 1, false);
    if (wr == 1) PG8_BAR;
    PG8_WAIT_V(2); PG8_BAR;
    PG8_STAGE(PG8_SB(1, 0), cB + kstep, voffB); PG8_STAGE_A(PG8_SA(1, 0), cA + kstep, 0, false); PG8_STAGE(PG8_SB(1, 1), cB + hsB + kstep, voffB);
    PG8_WAIT_V(6); PG8_BAR;
    for (;;) {
        const bool has_next = S.next(ui + 1, nxt);
        if constexpr (GATHER) { if (has_next) PG8_GOFF(nxt.pm, vgn); else { vgn[0][0] = vgc[0][0]; vgn[0][1] = vgc[0][1]; vgn[1][0] = vgc[1][0]; vgn[1][1] = vgc[1][1]; } }
        const char* nA = has_next ? (const char*)g.A + (size_t)nxt.pm * tsA : cA;
        const char* nB = has_next ? (const char*)g.Bt + PG8_EOFF(nxt.pm) + (size_t)nxt.pn * tsB : cB;
        for (int t = 0; t < nt; t += 2) {
            const bool last = (t == nt - 2);
            const char* a1 = cA + (size_t)(t + 1) * kstep;
            const char* a2 = last ? nA : cA + (size_t)(t + 2) * kstep; const char* b2 = last ? nB : cB + (size_t)(t + 2) * kstep;
            const char* a3 = a2 + kstep; const char* b3 = b2 + kstep;
            PG8_LDB(B0, 0, 0); PG8_LDB(B1, 0, 1); PG8_SCHED; PG8_LDA(At, 0, 0); PG8_STAGE_A(PG8_SA(1, 1), a1 + hsA, 1, false);
            PG8_WAIT_V(8); PG8_WAIT_L(0); PG8_BAR; PG8_MMA(0, 0, At, B0); PG8_MMA(0, 1, At, B1); PG8_BAR; PG8_SCHED;
            PG8_LDA(At, 0, 1); PG8_STAGE(PG8_SB(0, 0), b2, voffB); PG8_STAGE(PG8_SB(0, 1), b2 + hsB, voffB); PG8_STAGE_A(PG8_SA(0, 0), a2, 0, last);
            PG8_WAIT_V(8); PG8_WAIT_L(0); PG8_BAR; PG8_MMA(1, 0, At, B0); PG8_MMA(1, 1, At, B1); PG8_BAR; PG8_SCHED;
            PG8_LDB(B0, 1, 0); PG8_LDB(B1, 1, 1); PG8_SCHED; PG8_LDA(At, 1, 0); PG8_STAGE_A(PG8_SA(0, 1), a2 + hsA, 1, last);
            PG8_WAIT_V(8); PG8_WAIT_L(0); PG8_BAR; PG8_MMA(0, 0, At, B0); PG8_MMA(0, 1, At, B1); PG8_BAR; PG8_SCHED;
            PG8_LDA(At, 1, 1); PG8_STAGE(PG8_SB(1, 0), b3, voffB); PG8_STAGE(PG8_SB(1, 1), b3 + hsB, voffB); PG8_STAGE_A(PG8_SA(1, 0), a3, 0, last);
            PG8_WAIT_V(8); PG8_WAIT_L(0); PG8_BAR; PG8_MMA(1, 0, At, B0); PG8_MMA(1, 1, At, B1); PG8_BAR; PG8_SCHED;
        }
        if constexpr (ALIGN_EPI) { if (wr == 0) PG8_BAR; }
        E(acc, cur, wr, wc, fr, fq);
        if (!has_next) break;
#pragma unroll
        for (int a = 0; a < 2; ++a)
#pragma unroll
            for (int b = 0; b < 2; ++b)
#pragma unroll
                for (int m = 0; m < 4; ++m)
#pragma unroll
                    for (int n = 0; n < 2; ++n) acc[a][b][m][n] = (f32x4){0.f, 0.f, 0.f, 0.f};
        cur = nxt; cA = nA; cB = nB; ++ui;
        if constexpr (GATHER) { vgc[0][0] = vgn[0][0]; vgc[0][1] = vgn[0][1]; vgc[1][0] = vgn[1][0]; vgc[1][1] = vgn[1][1]; }
        if constexpr (ALIGN_EPI) { if (wr == 1) PG8_BAR; }
    }
    PG8_WAIT_V(0);
    if constexpr (!ALIGN_EPI) { if (wr == 0) PG8_BAR; }
    PG8_BAR;
#undef PG8_SA
#undef PG8_SB
#undef PG8_STAGE
#undef PG8_LDA
#undef PG8_LDB
#undef PG8_MMA
#undef PG8_WAIT_V
#undef PG8_WAIT_L
#undef PG8_BAR
#undef PG8_SCHED
#undef PG8_EOFF
#undef PG8_GOFF
#undef PG8_STAGE_A
}

__device__ __forceinline__ float row_rstd(const float* ssp, int row);
template <int ACT> struct EpiBf16 {
    static constexpr bool PERM = true;
    bf16_t* O; int ldc; const float* bias; const float* ssp;
    __device__ __forceinline__ void operator()(const f32x4 (&acc)[2][2][4][2], const Unit& u, int wr, int wc, int fr, int fq) const {
        const int row0 = u.pm * BM + wr * 64 + fr, col0 = u.pn * BM + wc * 32 + 8 * fq;
        f32x4 bv[2][2];
#pragma unroll
        for (int bj = 0; bj < 2; ++bj)
#pragma unroll
            for (int n = 0; n < 2; ++n) bv[bj][n] = bias ? *(const f32x4*)(bias + col0 + bj * HALF + 4 * n) : (f32x4){0.f, 0.f, 0.f, 0.f};
#pragma unroll
        for (int ai = 0; ai < 2; ++ai)
#pragma unroll
            for (int m = 0; m < 4; ++m) { bf16_t* rowp = O + (size_t)(row0 + ai * HALF + m * 16) * ldc + col0;
                const float rs = (ACT == 0 && ssp) ? row_rstd(ssp, row0 + ai * HALF + m * 16) : 1.f;
#pragma unroll
                for (int bj = 0; bj < 2; ++bj) { f32x4 v0 = acc[ai][bj][m][0] * rs + bv[bj][0], v1 = acc[ai][bj][m][1] * rs + bv[bj][1];
                    if (ACT == 2) {
#pragma unroll
                        for (int i = 0; i < 4; ++i) { v0[i] = gelu_tanh_f(v0[i]); v1[i] = gelu_tanh_f(v1[i]); } }
                    u32x4 w; w.x = cvtpk(v0[0], v0[1]); w.y = cvtpk(v0[2], v0[3]); w.z = cvtpk(v1[0], v1[1]); w.w = cvtpk(v1[2], v1[3]);
                    *(u32x4*)(rowp + bj * HALF) = w; } }
    }
};
struct EpiResF32 {
    static constexpr bool PERM = false;
    const float* base; float* out; int ldc;
    __device__ __forceinline__ void operator()(const f32x4 (&acc)[2][2][4][2], const Unit& u, int wr, int wc, int fr, int fq) const {
        const int col0 = u.pn * BM + wc * 32 + 4 * fq;
#pragma unroll
        for (int ai = 0; ai < 2; ++ai)
#pragma unroll
            for (int m = 0; m < 4; ++m) { const size_t off = (size_t)(u.pm * BM + ai * HALF + wr * 64 + m * 16 + fr) * ldc + col0;
#pragma unroll
                for (int bj = 0; bj < 2; ++bj)
#pragma unroll
                    for (int n = 0; n < 2; ++n) { const f32x4 bs = *(const f32x4*)(base + off + bj * HALF + n * 16); *(f32x4*)(out + off + bj * HALF + n * 16) = bs + acc[ai][bj][m][n]; } }
    }
};
template <bool BASE_BF16> struct EpiResStat {
    static constexpr bool PERM = false;
    const void* base; bf16_t* xb; float* ssp; int ldc;
    __device__ __forceinline__ void operator()(const f32x4 (&acc)[2][2][4][2], const Unit& u, int wr, int wc, int fr, int fq) const {
        const int col0 = u.pn * BM + wc * 32 + 4 * fq;
#pragma unroll
        for (int ai = 0; ai < 2; ++ai)
#pragma unroll
            for (int m = 0; m < 4; ++m) { const int row = u.pm * BM + ai * HALF + wr * 64 + m * 16 + fr; const size_t off = (size_t)row * ldc + col0; float ss = 0.f;
#pragma unroll
                for (int bj = 0; bj < 2; ++bj)
#pragma unroll
                    for (int n = 0; n < 2; ++n) { f32x4 bs;
                        if (BASE_BF16) { const u32x2 t = *(const u32x2*)((const bf16_t*)base + off + bj * HALF + n * 16); bs = (f32x4){bflo(t.x), bfhi(t.x), bflo(t.y), bfhi(t.y)}; }
                        else bs = *(const f32x4*)((const float*)base + off + bj * HALF + n * 16);
                        const f32x4 v = bs + acc[ai][bj][m][n];
                        u32x2 w; w.x = cvtpk(v.x, v.y); w.y = cvtpk(v.z, v.w); *(u32x2*)(xb + off + bj * HALF + n * 16) = w; ss += (v.x * v.x + v.y * v.y) + (v.z * v.z + v.w * v.w); }
                ss += __shfl_xor(ss, 16); ss += __shfl_xor(ss, 32);
                if (fq == 0) ssp[(size_t)row * 16 + u.pn * 4 + wc] = ss; }
    }
};
struct EpiResF32B {
    static constexpr bool PERM = false;
    const bf16_t* base; float* out; int ldc;
    __device__ __forceinline__ void operator()(const f32x4 (&acc)[2][2][4][2], const Unit& u, int wr, int wc, int fr, int fq) const {
        const int col0 = u.pn * BM + wc * 32 + 4 * fq;
#pragma unroll
        for (int ai = 0; ai < 2; ++ai)
#pragma unroll
            for (int m = 0; m < 4; ++m) { const size_t off = (size_t)(u.pm * BM + ai * HALF + wr * 64 + m * 16 + fr) * ldc + col0;
#pragma unroll
                for (int bj = 0; bj < 2; ++bj)
#pragma unroll
                    for (int n = 0; n < 2; ++n) { const u32x2 t = *(const u32x2*)(base + off + bj * HALF + n * 16); const f32x4 bs = {bflo(t.x), bfhi(t.x), bflo(t.y), bfhi(t.y)};
                        *(f32x4*)(out + off + bj * HALF + n * 16) = bs + acc[ai][bj][m][n]; } }
    }
};
__device__ __forceinline__ float row_rstd(const float* ssp, int row) {
    const f32x4* q = (const f32x4*)(ssp + (size_t)row * 16); const f32x4 a = q[0], b = q[1], c = q[2], d = q[3];
    const float s = ((a.x + a.y) + (a.z + a.w)) + ((b.x + b.y) + (b.z + b.w)) + ((c.x + c.y) + (c.z + c.w)) + ((d.x + d.y) + (d.z + d.w));
    return rsqrtf(s * (1.f / 1024.f) + EPS);
}
struct EpiSwiGLU {
    static constexpr bool PERM = true;
    bf16_t* O; int ldc; const float* ssp;
    __device__ __forceinline__ void operator()(const f32x4 (&acc)[2][2][4][2], const Unit& u, int wr, int wc, int fr, int fq) const {
        const int row0 = u.pm * BM + wr * 64 + fr, col0 = u.pn * HALF + wc * 32 + 8 * fq;
#pragma unroll
        for (int ai = 0; ai < 2; ++ai)
#pragma unroll
            for (int m = 0; m < 4; ++m) { bf16_t* rowp = O + (size_t)(row0 + ai * HALF + m * 16) * ldc + col0;
                const float rs = ssp ? row_rstd(ssp, row0 + ai * HALF + m * 16) : 1.f;
                float h[8];
#pragma unroll
                for (int n = 0; n < 2; ++n)
#pragma unroll
                    for (int i = 0; i < 4; ++i) h[n * 4 + i] = silu_f(acc[ai][0][m][n][i] * rs) * (acc[ai][1][m][n][i] * rs);
                u32x4 w; w.x = cvtpk(h[0], h[1]); w.y = cvtpk(h[2], h[3]); w.z = cvtpk(h[4], h[5]); w.w = cvtpk(h[6], h[7]);
                *(u32x4*)rowp = w; }
    }
};
struct EpiRowScaleBf16 {
    static constexpr bool PERM = true;
    bf16_t* O; int ldc; const float* roww;
    __device__ __forceinline__ void operator()(const f32x4 (&acc)[2][2][4][2], const Unit& u, int wr, int wc, int fr, int fq) const {
        const int row0 = u.pm * BM + wr * 64 + fr, col0 = u.pn * BM + wc * 32 + 8 * fq;
#pragma unroll
        for (int ai = 0; ai < 2; ++ai)
#pragma unroll
            for (int m = 0; m < 4; ++m) { const int row = row0 + ai * HALF + m * 16; const float sc = roww[row]; bf16_t* rowp = O + (size_t)row * ldc + col0;
#pragma unroll
                for (int bj = 0; bj < 2; ++bj) { const f32x4 v0 = acc[ai][bj][m][0] * sc, v1 = acc[ai][bj][m][1] * sc;
                    u32x4 w; w.x = cvtpk(v0[0], v0[1]); w.y = cvtpk(v0[2], v0[3]); w.z = cvtpk(v1[0], v1[1]); w.w = cvtpk(v1[2], v1[3]);
                    *(u32x4*)(rowp + bj * HALF) = w; } }
    }
};
}
constexpr int ROWS_MAX = 2 * T + 8 * 256;
constexpr size_t al256(size_t x) { return (x + 255) & ~(size_t)255; }
constexpr size_t W_IN_E = 0;
constexpr size_t W_CW1 = W_IN_E + (size_t)1792 * 1024 * 2;
constexpr size_t W_UQ = W_CW1 + (size_t)2 * 256 * 2048 * 2;
constexpr size_t W_UKV = W_UQ + (size_t)1024 * 256 * 2;
constexpr size_t W_OUT_E = W_UKV + (size_t)1024 * 128 * 2;
constexpr size_t W_GU = W_OUT_E + (size_t)1024 * 1024 * 2;
constexpr size_t W_D = W_GU + (size_t)5632 * 1024 * 2;
constexpr size_t W_IN_O = W_D + (size_t)1024 * 2816 * 2;
constexpr size_t W_OUT_O = W_IN_O + (size_t)3072 * 1024 * 2;
constexpr size_t W_MGU = W_OUT_O + (size_t)1024 * 1024 * 2;
constexpr size_t W_MD = W_MGU + (size_t)8 * 2816 * 1024 * 2;
constexpr size_t W_END = W_MD + (size_t)8 * 1024 * 1408 * 2;
constexpr size_t SM_CTL = al256(W_END);
constexpr size_t SM_BAR = SM_CTL + 4096;
constexpr size_t SM_B1P = SM_BAR + 16384;
constexpr size_t SM_B1 = SM_B1P + 32 * 512 * 4;
constexpr size_t SM_ROPE = SM_B1 + 512 * 4;
constexpr size_t SM_BL = SM_ROPE + (size_t)S * 32 * 4;
constexpr size_t SM_HID = SM_BL + 8 * 132 * 4;
constexpr size_t SM_KC = SM_HID + (size_t)2 * NB * 512 * 512 * 2;
constexpr size_t SM_VCT = SM_KC + (size_t)NB * 512 * 64 * 2;
constexpr size_t SM_TE = SM_VCT + (size_t)NB * 512 * 64 * 2;
constexpr size_t SM_TW = SM_TE + (size_t)T * 8;
constexpr size_t SM_RANK = SM_TW + (size_t)T * 8;
constexpr size_t SM_POS = SM_RANK + (size_t)T * 8;
constexpr size_t SM_ROWW = SM_POS + (size_t)T * 8;
constexpr size_t SM_TILEE = SM_ROWW + (size_t)ROWS_MAX * 4;
constexpr size_t SM_ROWTOK = al256(SM_TILEE + (size_t)(ROWS_MAX / 256 + 8) * 4);
constexpr size_t SM_SSP1 = al256(SM_ROWTOK + (size_t)ROWS_MAX * 4);
constexpr size_t SM_SSP2 = SM_SSP1 + (size_t)T * 64;
constexpr size_t SM_END = SM_SSP2 + (size_t)T * 64;
constexpr size_t R_XA = al256(SM_END);
constexpr size_t SZ_XA = (size_t)T * 4096 + (size_t)4 * 1048576;
constexpr size_t R_XN = R_XA + SZ_XA;
constexpr size_t SZ_XN = (size_t)T * 2048;
constexpr size_t R_H = R_XN + SZ_XN;
constexpr size_t SZ_H = ((size_t)T * 6144 > (size_t)ROWS_MAX * 2816) ? (size_t)T * 6144 : (size_t)ROWS_MAX * 2816;
constexpr size_t WS_FAST_END = R_H + SZ_H;
constexpr size_t A_QN = 0;
constexpr size_t A_KSN = A_QN + (size_t)T * 1024;
constexpr size_t A_KWN = A_KSN + (size_t)T * 256;
constexpr size_t A_VST = A_KWN + (size_t)T * 256;
constexpr size_t A_VWT = A_VST + (size_t)T * 256;
constexpr size_t A_KCIN = A_VWT + (size_t)T * 256;
constexpr size_t A_VCIN = A_KCIN + (size_t)T * 256 + 2048;
constexpr size_t A_CQN = A_VCIN + (size_t)T * 256 + 2048;
constexpr size_t A_CKVN = A_CQN + (size_t)T * 512;
constexpr size_t A_KROPE = A_CKVN + (size_t)T * 256;
constexpr size_t A_GATES = A_KROPE + (size_t)T * 64;
constexpr size_t A_END = A_GATES + (size_t)T * 96;
static_assert(A_END <= SZ_XA, "attention inputs fit R_XA");
constexpr size_t O_QM = 0;
constexpr size_t O_KM = O_QM + (size_t)T * 1536;
constexpr size_t O_VMT = O_KM + (size_t)T * 1536;
static_assert(O_VMT + (size_t)T * 1024 <= (size_t)T * 4096, "d_out scratch");

struct Params {
    const float* in[30];
    float* out;
    unsigned char* ws;
    int ph_lo, ph_hi, dbg_branch, pad_;
};

#ifdef PROF_SEL
#define PROF_SLOT(k) ((unsigned long long*)(p.ws + SM_CTL + 2048) + (k))
#define PROF_ON(cond) ((cond) && threadIdx.x == 0)
#ifndef PROF_WAVE
#define PROF_WAVE 0
#endif
#endif
constexpr int LDS_BYTES = 147456;

__device__ __forceinline__ int ltid() { int t = threadIdx.x; asm volatile("" : "+v"(t)); return t; }
__device__ __forceinline__ int perm16(int k) { return (k & ~12) | ((k & 4) << 1) | ((k & 8) >> 1); }

struct WDesc { int in_idx, K, N, rep, map, row_off; size_t src_stride, dst_off, dst_stride; int gain_idx, pad_; size_t src_off; };
__device__ const WDesc WDESC[13] = {
    {3, 1024, 1720, 1, 2, 0, 0, W_IN_E / 2, 0, -1, 0},
    {7, 1024, 256, 2, 0, 0, (size_t)2048 * 256, W_CW1 / 2, (size_t)512 * 1024, -1, 0, 0},
    {7, 1024, 256, 2, 0, 256, (size_t)2048 * 256, W_CW1 / 2, (size_t)512 * 1024, -1, 0, (size_t)1024 * 256},
    {11, 256, 768, 1, 3, 0, 0, W_UQ / 2, 0, -1, 0},
    {12, 128, 1024, 1, 0, 0, 0, W_UKV / 2, 0, -1, 0},
    {15, 1024, 1024, 1, 0, 0, 0, W_OUT_E / 2, 0, -1, 0},
    {17, 1024, 2816, 1, 1, 0, 0, W_GU / 2, 0, 16, 0},
    {18, 1024, 2816, 1, 1, 128, 0, W_GU / 2, 0, 16, 0},
    {19, 2816, 1024, 1, 0, 0, 0, W_D / 2, 0, -1, 0},
    {21, 1024, 3072, 1, 0, 0, 0, W_IN_O / 2, 0, 20, 0},
    {23, 1024, 1024, 1, 0, 0, 0, W_OUT_O / 2, 0, -1, 0},
    {27, 1024, 1408, 8, 1, 0, (size_t)1024 * 1408, W_MGU / 2, (size_t)2816 * 1024, -1, 0},
    {28, 1024, 1408, 8, 1, 128, (size_t)1024 * 1408, W_MGU / 2, (size_t)2816 * 1024, -1, 0},
};
__device__ const WDesc WDESC_MD = {29, 1408, 1024, 8, 0, 0, (size_t)1408 * 1024, W_MD / 2, (size_t)1024 * 1408, -1, 0};

__device__ __forceinline__ void transpose_item(const float* W, int K, int N, bf16_t* WT, int map, int row_off, const float* gain, LAS float* scr, int item, int lane) {
    const int nblk = (N + 31) / 32, kb = item / nblk, nb = item % nblk, k0 = 64 * kb, n0 = 32 * nb;
    const int n4 = (lane & 7) * 4; const bool nok = (n0 + n4) < N;
    f32x4 v[8];
#pragma unroll
    for (int i = 0; i < 8; ++i) { const int kk = (lane >> 3) + 8 * i; v[i] = nok ? *(const f32x4*)(W + (size_t)(k0 + kk) * N + n0 + n4) : (f32x4){0.f, 0.f, 0.f, 0.f}; if (gain) v[i] = v[i] * gain[k0 + kk]; }
#pragma unroll
    for (int i = 0; i < 8; ++i) { const int kk = (lane >> 3) + 8 * i; LAS float* d = scr + kk * 33 + n4; d[0] = v[i].x; d[1] = v[i].y; d[2] = v[i].z; d[3] = v[i].w; }
    asm volatile("s_waitcnt lgkmcnt(0)" ::: "memory");
    const int c = lane & 7;
#pragma unroll
    for (int j = 0; j < 4; ++j) { const int n = (lane >> 3) + 8 * j; const LAS float* s = scr + (8 * c) * 33 + n;
        u32x4 o; o.x = cvtpk(s[0 * 33], s[1 * 33]); o.y = cvtpk(s[2 * 33], s[3 * 33]); o.z = cvtpk(s[4 * 33], s[5 * 33]); o.w = cvtpk(s[6 * 33], s[7 * 33]);
        const int nn = n0 + n;
        if (nn < N) { const int row = (map == 1) ? (256 * (nn >> 7) + (nn & 127) + row_off) : (map == 2) ? (nn < 1280 ? nn : (nn < 1304 ? nn + 416 : nn - 24)) : (map == 3) ? ((nn / 96) * 128 + nn % 96) : (nn + row_off);
            *(u32x4*)(WT + (size_t)row * K + k0 + 8 * c) = o; } }
    asm volatile("s_waitcnt lgkmcnt(0)" ::: "memory");
}
__device__ __forceinline__ void do_wdesc(const Params& p, const WDesc& d, int it, LAS float* scr, int lane) {
    const int per = (d.K / 64) * ((d.N + 31) / 32); const int r = it / per, ii = it % per;
    transpose_item(p.in[d.in_idx] + d.src_off + (size_t)r * d.src_stride, d.K, d.N, (bf16_t*)p.ws + d.dst_off + (size_t)r * d.dst_stride, d.map, d.row_off, d.gain_idx >= 0 ? p.in[d.gain_idx] : nullptr, scr, ii, lane);
}
__device__ __forceinline__ void rms_row_to_bf16(const float* xrow, const float* g, bf16_t* orow, int lane) {
    const f32x4* xr = (const f32x4*)xrow + lane; const f32x4* gr = (const f32x4*)g + lane;
    f32x4 v[4]; float s = 0.f;
#pragma unroll
    for (int j = 0; j < 4; ++j) { v[j] = xr[64 * j]; s += (v[j].x * v[j].x + v[j].y * v[j].y) + (v[j].z * v[j].z + v[j].w * v[j].w); }
    const float r = rsqrtf(wsum(s) * (1.f / 1024.f) + EPS);
    u32x2* o8 = (u32x2*)orow + lane;
#pragma unroll
    for (int j = 0; j < 4; ++j) { const f32x4 gg = gr[64 * j]; u32x2 w; w.x = cvtpk(v[j].x * r * gg.x, v[j].y * r * gg.y); w.y = cvtpk(v[j].z * r * gg.z, v[j].w * r * gg.w); o8[64 * j] = w; }
}
__device__ __forceinline__ void phase_p0(const Params& p, LAS unsigned char* lds) {
    const int tid = ltid(), lane = tid & 63, wave = tid >> 6;
    const int gw = blockIdx.x * 8 + wave, NGW = gridDim.x * 8;
    LAS float* scr = (LAS float*)(lds + wave * 16384);
    int base = 0;
#pragma unroll 1
    for (int d = 0; d < 14; ++d) {
        const WDesc& wd = (d < 13) ? WDESC[d] : WDESC_MD;
        const int n_it = wd.rep * (wd.K / 64) * ((wd.N + 31) / 32);
        int first = (gw - (base % NGW) + NGW) % NGW;
        for (int it = first; it < n_it; it += NGW) do_wdesc(p, wd, it, scr, lane);
        base += n_it;
    }
    bf16_t* xn = (bf16_t*)(p.ws + R_XN);
    for (int m = gw; m < T; m += 2 * NGW) { rms_row_to_bf16(p.in[0] + (size_t)m * D, p.in[2], xn + (size_t)m * D, lane); if (m + NGW < T) rms_row_to_bf16(p.in[0] + (size_t)(m + NGW) * D, p.in[2], xn + (size_t)(m + NGW) * D, lane); }
    for (int u = gw; u < 256; u += NGW) {
        const int kc = u >> 3, kv = (u >> 2) & 1, nb = u & 3; float s = 0.f;
        const float* pos = p.in[6] + kv * 2048 + kc * 64; const float* w1 = p.in[7] + ((size_t)kv * 2048 + kc * 64) * 256 + nb * 64 + lane;
#pragma unroll 8
        for (int k = 0; k < 64; ++k) s += pos[k] * w1[(size_t)k * 256];
        ((float*)(p.ws + SM_B1P))[kc * 512 + kv * 256 + nb * 64 + lane] = s;
    }
    for (int i = blockIdx.x * 512 + tid; i < S * 16; i += gridDim.x * 512) {
        const int t = i >> 4, f = i & 15; const float ang = (float)t * powf(10000.f, -(float)f / 16.f);
        float* rp = (float*)(p.ws + SM_ROPE) + t * 32; rp[f] = cosf(ang); rp[16 + f] = sinf(ang);
    }
    if (blockIdx.x == 0) for (int i = tid; i < 8 * 129; i += 512) { const int h = i / 129, dd = i % 129; ((float*)(p.ws + SM_BL))[h * 132 + dd] = p.in[1][(dd < 128 ? (int)gold::T5B[dd] : 31) * 8 + h] * LOG2E; }
}

__device__ __forceinline__ void unpack8(const u32x4 v, float (&x)[8]) { x[0] = bflo(v.x); x[1] = bfhi(v.x); x[2] = bflo(v.y); x[3] = bfhi(v.y); x[4] = bflo(v.z); x[5] = bfhi(v.z); x[6] = bflo(v.w); x[7] = bfhi(v.w); }
__device__ __forceinline__ u32x4 pack8(const float (&x)[8]) { u32x4 w; w.x = cvtpk(x[0], x[1]); w.y = cvtpk(x[2], x[3]); w.z = cvtpk(x[4], x[5]); w.w = cvtpk(x[6], x[7]); return w; }
__device__ __forceinline__ float ss8f(const float (&x)[8]) { return ((x[0] * x[0] + x[1] * x[1]) + (x[2] * x[2] + x[3] * x[3])) + ((x[4] * x[4] + x[5] * x[5]) + (x[6] * x[6] + x[7] * x[7])); }
__device__ __forceinline__ void load8f(const float* g, float (&x)[8], float sc) { const f32x4 a = *(const f32x4*)g, b = *(const f32x4*)(g + 4); x[0] = a.x * sc; x[1] = a.y * sc; x[2] = a.z * sc; x[3] = a.w * sc; x[4] = b.x * sc; x[5] = b.y * sc; x[6] = b.z * sc; x[7] = b.w * sc; }
__device__ __forceinline__ void phase_p2(const Params& p, LAS unsigned char* lds) {
    const int tid = ltid(), lane = tid & 63, wave = tid >> 6;
    const bf16_t* hb = (const bf16_t*)(p.ws + R_H);
    unsigned char* xa = p.ws + R_XA;
    bf16_t* qn = (bf16_t*)(xa + A_QN); bf16_t* ksn = (bf16_t*)(xa + A_KSN); bf16_t* kwn = (bf16_t*)(xa + A_KWN);
    bf16_t* vst = (bf16_t*)(xa + A_VST); bf16_t* vwt = (bf16_t*)(xa + A_VWT); bf16_t* kcin = (bf16_t*)(xa + A_KCIN); bf16_t* vcin = (bf16_t*)(xa + A_VCIN);
    bf16_t* cqn = (bf16_t*)(xa + A_CQN); bf16_t* ckvn = (bf16_t*)(xa + A_CKVN); bf16_t* krope = (bf16_t*)(xa + A_KROPE); float* gates = (float*)(xa + A_GATES);
    LAS bf16_t* vs = (LAS bf16_t*)lds;
    if (blockIdx.x == 0) {
        { float s = 0.f; for (int k = 0; k < 32; ++k) s += ((const float*)(p.ws + SM_B1P))[k * 512 + tid]; ((float*)(p.ws + SM_B1))[tid] = s; }
        for (int i = tid; i < 1024; i += 512) { kcin[(size_t)T * 128 + i] = 0; vcin[(size_t)T * 128 + i] = 0; }
    }
    const int c8 = (lane & 7) * 8, seg = lane >> 3;
    float qg[8], ksg[8], kwg[8], cqg[8], ckvg[8];
    load8f(p.in[4] + c8, qg, 0.125f * LOG2E); load8f(p.in[5] + 64 + c8, ksg, 1.f); load8f(p.in[5] + 128 + c8, kwg, 1.f);
    load8f(p.in[9] + (lane & 31) * 8, cqg, 1.f); load8f(p.in[10] + (lane & 15) * 8, ckvg, 1.f);
    for (int tile = blockIdx.x; tile < T / 64; tile += gridDim.x) {
        const int b = tile / (S / 64), s0 = (tile % (S / 64)) * 64;
#pragma unroll 4
        for (int tt = 0; tt < 8; ++tt) {
            const int sl = wave * 8 + tt, s = s0 + sl; const size_t t = (size_t)b * S + s;
            const bf16_t* hr = hb + t * 1792 + lane * 8;
            const u32x4 L0 = *(const u32x4*)hr, L1 = *(const u32x4*)(hr + 512), L2 = *(const u32x4*)(hr + 1024);
            u32x4 L3 = {0u, 0u, 0u, 0u}; if (lane < 32) L3 = *(const u32x4*)(hr + 1536);
            float x0[8], x1[8], x2[8], x3[8];
            unpack8(L0, x0); unpack8(L1, x1); unpack8(L2, x2); unpack8(L3, x3);
            float a0 = ss8f(x0), a1 = ss8f(x1), a2 = ss8f(x2), a3 = ss8f(x3);
#pragma unroll
            for (int o = 1; o < 8; o <<= 1) { a0 += __shfl_xor(a0, o); a1 += __shfl_xor(a1, o); a2 += __shfl_xor(a2, o); a3 += __shfl_xor(a3, o); }
            float a2w = a2 + __shfl_xor(a2, 8); a2w += __shfl_xor(a2w, 16);
            const float a3w = a3 + __shfl_xor(a3, 8);
            const int pp0 = (sl & ~15) | perm16(sl & 15);
            const int pp = (((pp0 >> 3) ^ (lane & 7)) << 3) | (pp0 & 7);
            {
                const float r = rsqrtf(a0 * (1.f / 64.f) + EPS); float y[8];
#pragma unroll
                for (int j = 0; j < 8; ++j) y[j] = x0[j] * r * qg[j];
                *(u32x4*)(qn + t * 512 + lane * 8) = pack8(y);
            }
            {
                const int g = seg & 1; const size_t gm = (((size_t)b * 2 + g) * S + s) * 64 + c8;
                if (seg < 2) *(u32x4*)(kcin + gm) = L1;
                else if (seg < 4) *(u32x4*)(vcin + gm) = L1;
                else if (seg < 6) { const float r = rsqrtf(a1 * (1.f / 64.f) + EPS); float y[8];
#pragma unroll
                    for (int j = 0; j < 8; ++j) y[j] = x1[j] * r * ksg[j];
                    *(u32x4*)(ksn + gm) = pack8(y); }
                else {
#pragma unroll
                    for (int j = 0; j < 8; ++j) vs[((0 + g) * 64 + c8 + j) * 72 + pp] = (bf16_t)((j & 1) ? (L1[j >> 1] >> 16) : (L1[j >> 1] & 0xffffu)); }
            }
            {
                const int g = seg & 1; const size_t gm = (((size_t)b * 2 + g) * S + s) * 64 + c8;
                if (seg < 2) { const float r = rsqrtf(a2 * (1.f / 64.f) + EPS); float y[8];
#pragma unroll
                    for (int j = 0; j < 8; ++j) y[j] = x2[j] * r * kwg[j];
                    *(u32x4*)(kwn + gm) = pack8(y); }
                else if (seg < 4) {
#pragma unroll
                    for (int j = 0; j < 8; ++j) vs[((2 + g) * 64 + c8 + j) * 72 + pp] = (bf16_t)((j & 1) ? (L2[j >> 1] >> 16) : (L2[j >> 1] & 0xffffu)); }
                else { const float r = rsqrtf(a2w * (1.f / 256.f) + EPS); float y[8];
#pragma unroll
                    for (int j = 0; j < 8; ++j) y[j] = x2[j] * r * cqg[j];
                    *(u32x4*)(cqn + t * 256 + (lane - 32) * 8) = pack8(y); }
            }
            {
                if (lane < 16) { const float r = rsqrtf(a3w * (1.f / 128.f) + EPS); float y[8];
#pragma unroll
                    for (int j = 0; j < 8; ++j) y[j] = x3[j] * r * ckvg[j];
                    *(u32x4*)(ckvn + t * 128 + lane * 8) = pack8(y); }
                else if (lane < 20) *(u32x4*)(krope + t * 32 + (lane - 16) * 8) = L3;
                else if (lane < 23) { float y[8];
#pragma unroll
                    for (int j = 0; j < 8; ++j) y[j] = frcp(1.f + fexp2(-x3[j] * LOG2E));
                    float* gp = gates + t * 24 + (lane - 20) * 8; *(f32x4*)gp = (f32x4){y[0], y[1], y[2], y[3]}; *(f32x4*)(gp + 4) = (f32x4){y[4], y[5], y[6], y[7]}; }
            }
        }
        __syncthreads();
        {
            const int row = tid >> 1, half = tid & 1, which = row >> 6, d = row & 63, g = which & 1;
            bf16_t* dst = ((which < 2) ? vst : vwt) + (((size_t)b * 2 + g) * 64 + d) * S + s0 + half * 32;
            const LAS bf16_t* src = vs + row * 72; const int sx = (row >> 3) & 7;
#pragma unroll
            for (int c = 0; c < 4; ++c) *(u32x4*)(dst + c * 8) = *(const LAS u32x4*)(src + (((half * 4 + c) ^ sx) << 3));
        }
        __syncthreads();
    }
}
__device__ __forceinline__ void phase_p3b(const Params& p, LAS unsigned char* lds) {
    const int tid = ltid(), lane = tid & 63, wave = tid >> 6;
    const int gw = blockIdx.x * 8 + wave, NGW = gridDim.x * 8;
    const bf16_t* qraw = (const bf16_t*)(p.ws + R_H);
    const bf16_t* kvraw = (const bf16_t*)(p.ws + R_H + (size_t)T * 2048);
    const bf16_t* krope = (const bf16_t*)(p.ws + R_XA + A_KROPE);
    const float* rope = (const float*)(p.ws + SM_ROPE);
    bf16_t* qm = (bf16_t*)((unsigned char*)p.out + O_QM); bf16_t* km = (bf16_t*)((unsigned char*)p.out + O_KM); bf16_t* vmt = (bf16_t*)((unsigned char*)p.out + O_VMT);
    const float* q_norm = p.in[13]; const float* k_norm = p.in[14];
    LAS bf16_t* vs = (LAS bf16_t*)lds;
    LAS float* w2s = (LAS float*)(lds + 73728);
    for (int kv = 0; kv < 2; ++kv) {
        __syncthreads();
        for (int i = tid; i < 256 * 64; i += 512) w2s[i] = p.in[8][kv * 16384 + i];
        __syncthreads();
        const bf16_t* P = (const bf16_t*)(p.ws + SM_HID) + (size_t)kv * NB * 512 * 512;
        const f32x4 bs = *(const f32x4*)((const float*)(p.ws + SM_B1) + kv * 256 + lane * 4);
        for (int row = gw; row < NB * 512; row += NGW) {
            const int row1 = row + 1 < NB * 512 ? row + 1 : row;
            const u32x2 pa = *(const u32x2*)(P + (size_t)row * 512 + lane * 4), pb = *(const u32x2*)(P + (size_t)row1 * 512 + 256 + lane * 4);
            const float h0 = gelu_tanh_f(bflo(pa.x) + bflo(pb.x) + bs.x), h1 = gelu_tanh_f(bfhi(pa.x) + bfhi(pb.x) + bs.y), h2 = gelu_tanh_f(bflo(pa.y) + bflo(pb.y) + bs.z), h3 = gelu_tanh_f(bfhi(pa.y) + bfhi(pb.y) + bs.w);
            float acc = 0.f;
#pragma unroll 8
            for (int k4 = 0; k4 < 64; ++k4) {
                acc += __shfl(h0, k4) * w2s[(k4 * 4 + 0) * 64 + lane]; acc += __shfl(h1, k4) * w2s[(k4 * 4 + 1) * 64 + lane];
                acc += __shfl(h2, k4) * w2s[(k4 * 4 + 2) * 64 + lane]; acc += __shfl(h3, k4) * w2s[(k4 * 4 + 3) * 64 + lane];
            }
            if (kv == 0) { const float r = rsqrtf(wsum(acc * acc) * (1.f / 64.f) + EPS); ((bf16_t*)(p.ws + SM_KC))[(size_t)row * 64 + lane] = f2bf(acc * r * p.in[5][lane]); }
            else { const int c = row & 255; ((bf16_t*)(p.ws + SM_VCT))[((size_t)(row >> 8) * 64 + lane) * 256 + ((c & ~15) | perm16(c & 15))] = f2bf(acc); }
        }
    }
    __syncthreads();
    const float QS = 0.10206207261596577f * LOG2E;
    const int c = lane & 15, hl = lane >> 4;
    float qg[8], kg[8];
    load8f(q_norm + (c < 12 ? c * 8 : 0), qg, QS);
    load8f(k_norm + (c < 12 ? c * 8 : 0), kg, 1.f);
    for (int tile = blockIdx.x; tile < T / 64; tile += gridDim.x) {
        const int b = tile / (S / 64), s0 = (tile % (S / 64)) * 64;
#pragma unroll 4
        for (int tt = 0; tt < 8; ++tt) {
            const int sl = wave * 8 + tt, s = s0 + sl; const size_t t = (size_t)b * S + s;
            const int pp0 = (sl & ~15) | perm16(sl & 15);
            const int pp = (((pp0 >> 3) ^ ((c - 8) & 7)) << 3) | (pp0 & 7);
            u32x4 Q[2], KV[2];
#pragma unroll
            for (int ld = 0; ld < 2; ++ld) { Q[ld] = *(const u32x4*)(qraw + t * 1024 + ld * 512 + lane * 8); KV[ld] = *(const u32x4*)(kvraw + t * 1024 + ld * 512 + lane * 8); }
            u32x4 KR = {0u, 0u, 0u, 0u}; f32x4 cs0 = {0.f, 0.f, 0.f, 0.f}, cs1 = cs0, sn0 = cs0, sn1 = cs0;
            if (c >= 8 && c < 12) { KR = *(const u32x4*)(krope + t * 32 + (c - 8) * 8);
                const float* rp = rope + s * 32 + (c & 1) * 8; cs0 = *(const f32x4*)rp; cs1 = *(const f32x4*)(rp + 4); sn0 = *(const f32x4*)(rp + 16); sn1 = *(const f32x4*)(rp + 20); }
            const float cs[8] = {cs0.x, cs0.y, cs0.z, cs0.w, cs1.x, cs1.y, cs1.z, cs1.w}, sn[8] = {sn0.x, sn0.y, sn0.z, sn0.w, sn1.x, sn1.y, sn1.z, sn1.w};
            float kr[8]; unpack8(KR, kr);
            const float krs = ss8f(kr);
#pragma unroll
            for (int ld = 0; ld < 2; ++ld) {
                const int hh = ld * 4 + hl;
                {
                    float x[8]; unpack8(Q[ld], x);
                    float ss = c < 12 ? ss8f(x) : 0.f;
#pragma unroll
                    for (int o = 1; o < 16; o <<= 1) ss += __shfl_xor(ss, o);
                    const float r = rsqrtf(ss * (1.f / 96.f) + EPS); float y[8], z[8];
#pragma unroll
                    for (int j = 0; j < 8; ++j) y[j] = x[j] * r * qg[j];
#pragma unroll
                    for (int j = 0; j < 8; ++j) { const float pb = __shfl_xor(y[j], 2); z[j] = (c < 8) ? y[j] : ((c < 10) ? (y[j] * cs[j] - pb * sn[j]) : (pb * sn[j] + y[j] * cs[j])); }
                    if (c < 12) *(u32x4*)(qm + (t * 8 + hh) * 96 + c * 8) = pack8(z);
                }
                {
                    float x[8]; unpack8(KV[ld], x);
                    float ss = c < 8 ? ss8f(x) : krs;
#pragma unroll
                    for (int o = 1; o < 16; o <<= 1) ss += __shfl_xor(ss, o);
                    const float r = rsqrtf(ss * (1.f / 96.f) + EPS); float y[8], z[8];
#pragma unroll
                    for (int j = 0; j < 8; ++j) y[j] = (c < 8 ? x[j] : kr[j]) * r * kg[j];
#pragma unroll
                    for (int j = 0; j < 8; ++j) { const float pb = __shfl_xor(y[j], 2); z[j] = (c < 8) ? y[j] : ((c < 10) ? (y[j] * cs[j] - pb * sn[j]) : (pb * sn[j] + y[j] * cs[j])); }
                    if (c < 12) *(u32x4*)(km + (((size_t)b * 8 + hh) * S + s) * 96 + c * 8) = pack8(z);
                    if (c >= 8) {
#pragma unroll
                        for (int j = 0; j < 8; ++j) vs[(hh * 64 + (c - 8) * 8 + j) * 72 + pp] = (bf16_t)((j & 1) ? (KV[ld][j >> 1] >> 16) : (KV[ld][j >> 1] & 0xffffu)); }
                }
            }
        }
        __syncthreads();
        {
            const int hh = tid >> 6, d = tid & 63;
            bf16_t* dst = vmt + (((size_t)b * 8 + hh) * 64 + d) * S + s0;
            const LAS bf16_t* src = vs + tid * 72; const int sx = (tid >> 3) & 7;
#pragma unroll
            for (int cc = 0; cc < 8; ++cc) *(u32x4*)(dst + cc * 8) = *(const LAS u32x4*)(src + ((cc ^ sx) << 3));
        }
        __syncthreads();
    }
}

__device__ const unsigned short UNIT_TYPES[256] = {63,127,62,126,61,125,527,591,655,719,783,847,911,975,60,124,59,123,58,122,57,121,56,120,526,590,654,718,782,846,910,974,55,119,54,118,53,117,52,116,51,115,525,589,653,717,781,845,909,973,50,114,49,113,48,112,47,111,524,588,652,716,780,844,908,972,46,110,45,109,44,108,43,107,523,587,651,715,779,843,907,971,42,106,41,105,40,104,39,103,38,102,522,586,650,714,778,842,906,970,37,101,36,100,35,99,34,98,33,97,521,585,649,713,777,841,905,969,32,96,31,95,30,94,520,584,648,712,776,840,904,968,29,93,28,92,27,91,26,90,25,89,519,583,647,711,775,839,903,967,24,88,23,87,22,86,21,85,20,84,518,582,646,710,774,838,902,966,19,83,18,82,17,81,16,80,15,79,517,581,645,709,773,837,901,965,14,78,13,77,12,76,516,580,644,708,772,836,900,964,11,75,10,74,9,73,8,72,515,579,643,707,771,835,899,963,7,71,6,70,5,69,514,578,642,706,770,834,898,962,4,68,3,67,513,577,641,705,769,833,897,961,2,66,1,65,0,64,512,576,640,704,768,832,896,960};
__device__ __forceinline__ int crow(int r, int hi) { return (r & 3) + 8 * (r >> 2) + 4 * hi; }
struct Flash { f32x16 o0, o1; float l; };
__device__ __forceinline__ void flash_init(Flash& st) {
#pragma unroll
    for (int r = 0; r < 16; ++r) { st.o0[r] = 0.f; st.o1[r] = 0.f; }
    st.l = 0.f;
}
constexpr int AL_K64 = 0, AL_V64 = 3 * 8192;
constexpr int AL_K96 = 0, AL_V96 = 3 * 16384;
constexpr int AL_IMP = 49152, AL_SELB = AL_IMP + 64 * 65 * 4, AL_UNI = AL_SELB + 512, AL_TL = AL_UNI + 64, AL_BL = AL_TL + 128, AL_OT = AL_BL + 4 * 132 * 4, AL_END = AL_OT + 8 * 32 * 64 * 4;
static_assert(AL_END <= 139264 && AL_V96 + 3 * 8192 <= 139264, "attention LDS");

template <int RB> struct DmaLane { unsigned g0, g1; };
template <int RB> __device__ __forceinline__ void dma_setup(DmaLane<RB>& L, int w, int lane, unsigned gs) {
    if (RB == 128) { const int r = 8 * w + (lane >> 3), c = (lane & 7) ^ ((r >> 1) & 7); L.g0 = (unsigned)r * gs + c * 16; L.g1 = 0; }
    else {
        { const int r = 8 * w + (lane >> 4); int c = (lane & 15) ^ (r & 15); c = c >= 12 ? c - 4 : c; L.g0 = (unsigned)r * gs + c * 16; }
        { const int r = 8 * w + 4 + (lane >> 4); int c = (lane & 15) ^ (r & 15); c = c >= 12 ? c - 4 : c; L.g1 = (unsigned)r * gs + c * 16; }
    }
}
template <int RB> __device__ __forceinline__ void dma_issue(const unsigned char* tile, const DmaLane<RB>& L, LAS unsigned char* buf, int w) {
    if (RB == 128) __builtin_amdgcn_global_load_lds((const unsigned*)(tile + L.g0), (LAS unsigned*)(buf + w * 1024), 16, 0, 0);
    else { __builtin_amdgcn_global_load_lds((const unsigned*)(tile + L.g0), (LAS unsigned*)(buf + w * 2048), 16, 0, 0);
           __builtin_amdgcn_global_load_lds((const unsigned*)(tile + L.g1), (LAS unsigned*)(buf + w * 2048 + 1024), 16, 0, 0); }
}
template <int DK> __device__ __forceinline__ void frag_offsets(unsigned (&kl)[DK / 16], unsigned (&vl)[4], int r32, int hi) {
#pragma unroll
    for (int s = 0; s < DK / 16; ++s) kl[s] = (DK == 64) ? (unsigned)(r32 * 128 + (((2 * s + hi) ^ ((r32 >> 1) & 7)) << 4)) : (unsigned)(r32 * 256 + (((2 * s + hi) ^ (r32 & 15)) << 4));
#pragma unroll
    for (int s = 0; s < 4; ++s) vl[s] = (unsigned)(r32 * 128 + (((2 * s + hi) ^ ((r32 >> 1) & 7)) << 4));
}

template <int DK, int KP, bool LANEMASK, class F>
__device__ __forceinline__ void tile_compute(Flash& st, const LAS unsigned char* Kt, const LAS unsigned char* Vt, const bf16x8* qf, const f32x16& negm, const unsigned (&kl)[DK / 16], const unsigned (&vl)[4], bool mine, F f) {
    constexpr int NS = DK / 16; constexpr int KH = 32 * KP;
    bf16x8 ka[NS], kh[NS];
#pragma unroll
    for (int s = 0; s < NS; ++s) ka[s] = *(const LAS bf16x8*)(Kt + kl[s]);
#pragma unroll
    for (int s = 0; s < NS; ++s) kh[s] = *(const LAS bf16x8*)(Kt + kl[s] + KH);
    __builtin_amdgcn_sched_barrier(0);
    f32x16 p0, p1;
#pragma unroll
    for (int s = 0; s < NS; ++s) p0 = (s == 0) ? __builtin_amdgcn_mfma_f32_32x32x16_bf16(ka[0], qf[0], negm, 0, 0, 0) : __builtin_amdgcn_mfma_f32_32x32x16_bf16(ka[s], qf[s], p0, 0, 0, 0);
#pragma unroll
    for (int s = 0; s < NS; ++s) p1 = (s == 0) ? __builtin_amdgcn_mfma_f32_32x32x16_bf16(kh[0], qf[0], negm, 0, 0, 0) : __builtin_amdgcn_mfma_f32_32x32x16_bf16(kh[s], qf[s], p1, 0, 0, 0);
    bf16x8 va[4], vh[4];
#pragma unroll
    for (int s = 0; s < 4; ++s) { va[s] = *(const LAS bf16x8*)(Vt + vl[s]); vh[s] = *(const LAS bf16x8*)(Vt + vl[s] + 4096); }
    __builtin_amdgcn_sched_barrier(0);
    float ls = 0.f;
    u32x4 w0, w1, w2, w3;
    {
#pragma unroll
        for (int r = 0; r < 16; ++r) { float x = p0[r]; const bool v = f(r, 0, x); const float e = fexp2(x); p0[r] = v ? e : 0.f; ls += p0[r]; }
        w0.x = cvtpk(p0[0], p0[1]); w0.y = cvtpk(p0[2], p0[3]); w0.z = cvtpk(p0[4], p0[5]); w0.w = cvtpk(p0[6], p0[7]);
        w1.x = cvtpk(p0[8], p0[9]); w1.y = cvtpk(p0[10], p0[11]); w1.z = cvtpk(p0[12], p0[13]); w1.w = cvtpk(p0[14], p0[15]);
        if (LANEMASK) { w0.x = mine ? w0.x : 0u; w0.y = mine ? w0.y : 0u; w0.z = mine ? w0.z : 0u; w0.w = mine ? w0.w : 0u; w1.x = mine ? w1.x : 0u; w1.y = mine ? w1.y : 0u; w1.z = mine ? w1.z : 0u; w1.w = mine ? w1.w : 0u; }
    }
#pragma unroll
    for (int s = 0; s < 2; ++s) {
        const bf16x8 pa = __builtin_bit_cast(bf16x8, s ? w1 : w0);
        st.o0 = __builtin_amdgcn_mfma_f32_32x32x16_bf16(pa, va[s], st.o0, 0, 0, 0);
        st.o1 = __builtin_amdgcn_mfma_f32_32x32x16_bf16(pa, vh[s], st.o1, 0, 0, 0);
    }
    {
#pragma unroll
        for (int r = 0; r < 16; ++r) { float x = p1[r]; const bool v = f(r, 1, x); const float e = fexp2(x); p1[r] = v ? e : 0.f; ls += p1[r]; }
        w2.x = cvtpk(p1[0], p1[1]); w2.y = cvtpk(p1[2], p1[3]); w2.z = cvtpk(p1[4], p1[5]); w2.w = cvtpk(p1[6], p1[7]);
        w3.x = cvtpk(p1[8], p1[9]); w3.y = cvtpk(p1[10], p1[11]); w3.z = cvtpk(p1[12], p1[13]); w3.w = cvtpk(p1[14], p1[15]);
        if (LANEMASK) { w2.x = mine ? w2.x : 0u; w2.y = mine ? w2.y : 0u; w2.z = mine ? w2.z : 0u; w2.w = mine ? w2.w : 0u; w3.x = mine ? w3.x : 0u; w3.y = mine ? w3.y : 0u; w3.z = mine ? w3.z : 0u; w3.w = mine ? w3.w : 0u; }
    }
    if (LANEMASK) ls = mine ? ls : 0.f;
    st.l += ls;
#pragma unroll
    for (int s = 2; s < 4; ++s) {
        const bf16x8 pa = __builtin_bit_cast(bf16x8, (s == 3) ? w3 : w2);
        st.o0 = __builtin_amdgcn_mfma_f32_32x32x16_bf16(pa, va[s], st.o0, 0, 0, 0);
        st.o1 = __builtin_amdgcn_mfma_f32_32x32x16_bf16(pa, vh[s], st.o1, 0, 0, 0);
    }
}
template <int DK, int KP> __device__ __forceinline__ void qk_tile(f32x16& p0, f32x16& p1, const LAS unsigned char* Kt, const bf16x8* qf, const f32x16& negm, const unsigned (&kl)[DK / 16]) {
#pragma unroll
    for (int s = 0; s < DK / 16; ++s) {
        const bf16x8 a0 = *(const LAS bf16x8*)(Kt + kl[s]);
        const bf16x8 a1 = *(const LAS bf16x8*)(Kt + kl[s] + 32 * KP);
        if (s == 0) { p0 = __builtin_amdgcn_mfma_f32_32x32x16_bf16(a0, qf[0], negm, 0, 0, 0); p1 = __builtin_amdgcn_mfma_f32_32x32x16_bf16(a1, qf[0], negm, 0, 0, 0); }
        else { p0 = __builtin_amdgcn_mfma_f32_32x32x16_bf16(a0, qf[s], p0, 0, 0, 0); p1 = __builtin_amdgcn_mfma_f32_32x32x16_bf16(a1, qf[s], p1, 0, 0, 0); }
    }
}
template <bool FIRST> __device__ __forceinline__ void flash_accum(LAS float* otl, const Flash& st, float gate, int hi, int lane) {
    const float lt = st.l + __shfl_xor(st.l, 32);
    const float f = lt > 0.f ? gate * frcp(lt) : 0.f;
#pragma unroll
    for (int r = 0; r < 16; ++r) { const float fr_ = __shfl(f, crow(r, hi));
        if (FIRST) { otl[r * 64 + lane] = fr_ * st.o0[r]; otl[(16 + r) * 64 + lane] = fr_ * st.o1[r]; }
        else { otl[r * 64 + lane] += fr_ * st.o0[r]; otl[(16 + r) * 64 + lane] += fr_ * st.o1[r]; } }
}
template <int NS> __device__ __forceinline__ float qnorm2(const bf16x8* qf) {
    float s = 0.f;
#pragma unroll
    for (int i = 0; i < NS; ++i)
#pragma unroll
        for (int j = 0; j < 8; ++j) { const float x = bf2f((bf16_t)qf[i][j]); s += x * x; }
    return s + __shfl_xor(s, 32);
}
__device__ __forceinline__ float wmax(float v) {
#pragma unroll
    for (int o = 1; o < 64; o <<= 1) v = fmaxf(v, __shfl_xor(v, o));
    return v;
}

template <int RBK, bool HASV, int KOFF, int KSZ, int VOFF, class SrcK, class SrcV, class Comp>
__device__ __forceinline__ void run_tiles(int n, LAS unsigned char* lds, int w, int lane, unsigned gsK, unsigned gsV, SrcK srcK, SrcV srcV, Comp comp) {
    DmaLane<RBK> LK; dma_setup<RBK>(LK, w, lane, gsK);
    DmaLane<128> LV; LV.g0 = 0; LV.g1 = 0; if (HASV) dma_setup<128>(LV, w, lane, gsV);
    const int nl = n - 1, t1 = nl < 1 ? nl : 1;
    dma_issue<RBK>(srcK(0), LK, lds + KOFF, w); if (HASV) dma_issue<128>(srcV(0), LV, lds + VOFF, w);
    dma_issue<RBK>(srcK(t1), LK, lds + KOFF + KSZ, w); if (HASV) dma_issue<128>(srcV(t1), LV, lds + VOFF + 8192, w);
    constexpr int P = (RBK == 128 ? 1 : 2) + (HASV ? 1 : 0);
#define RT_STEP(bi, ii) do { const int i_ = (ii); \
        if (P == 1) asm volatile("s_waitcnt vmcnt(1)" ::: "memory"); else if (P == 2) asm volatile("s_waitcnt vmcnt(2)" ::: "memory"); else asm volatile("s_waitcnt vmcnt(3)" ::: "memory"); \
        __builtin_amdgcn_s_barrier(); asm volatile("" ::: "memory"); \
        { const int tn = (i_ + 2 < nl) ? i_ + 2 : nl; constexpr int b2 = ((bi) + 2) % 3; \
          dma_issue<RBK>(srcK(tn), LK, lds + KOFF + b2 * KSZ, w); if (HASV) dma_issue<128>(srcV(tn), LV, lds + VOFF + b2 * 8192, w); } \
        if (i_ < n) comp(i_, lds + KOFF + (bi) * KSZ, lds + VOFF + (bi) * 8192); } while (0)
    for (int i = 0; i < n; i += 3) { RT_STEP(0, i); RT_STEP(1, i + 1); RT_STEP(2, i + 2); }
#undef RT_STEP
    asm volatile("s_waitcnt vmcnt(0)" ::: "memory");
    __syncthreads();
}

__device__ __forceinline__ void mla_unit(const Params& p, LAS unsigned char* lds, int b, int h, int qb) {
    int tid = threadIdx.x; asm volatile("" : "+v"(tid));
    const int lane = tid & 63, w = __builtin_amdgcn_readfirstlane(tid >> 6), r32 = lane & 31, hi = lane >> 5;
    const bf16_t* qm = (const bf16_t*)((const unsigned char*)p.out + O_QM);
    const unsigned char* km = (const unsigned char*)p.out + O_KM + (((size_t)b * 8 + h) * S) * 192;
    const unsigned char* vmt = (const unsigned char*)p.out + O_VMT + (((size_t)b * 8 + h) * 64) * (size_t)S * 2;
    bf16_t* ocat = (bf16_t*)(p.ws + R_XN);
    const int tq = qb * 256 + 32 * w + r32;
    bf16x8 qf[6];
#pragma unroll
    for (int s = 0; s < 6; ++s) qf[s] = *(const bf16x8*)(qm + (((size_t)b * S + tq) * 8 + h) * 96 + 16 * s + 8 * hi);
    const float kn = 9.797958971f * 1.01f * wmax(fmaxf(fabsf(p.in[14][lane]), lane < 32 ? fabsf(p.in[14][64 + lane]) : 0.f));
    const float mref = sqrtf(qnorm2<6>(qf)) * kn;
    f32x16 negm;
#pragma unroll
    for (int r = 0; r < 16; ++r) negm[r] = -mref;
    Flash st; flash_init(st);
    const int ntile = 4 * qb + 4, dt = 4 * qb + (w >> 1);
#ifdef PROF_SEL
    if (b == 0 && h == 0 && qb == 15 && threadIdx.x == 0) { *PROF_SLOT(36) -= __builtin_amdgcn_s_memtime(); *PROF_SLOT(37) -= __builtin_amdgcn_s_memrealtime(); }
#endif
    unsigned kl[6], vl[4]; frag_offsets<96>(kl, vl, r32, hi);
    run_tiles<192, true, AL_K96, 16384, AL_V96>(ntile, lds, w, lane, 192u, (unsigned)(S * 2),
        [&](int i) { return km + (size_t)i * 64 * 192; }, [&](int i) { return vmt + (size_t)i * 128; },
        [&](int i, LAS unsigned char* kb, LAS unsigned char* vb) {
            if (i <= dt) {
                if (i < dt) tile_compute<96, 256, false>(st, kb, vb, qf, negm, kl, vl, true, [&](int r, int half, float& x) { return true; });
                else { const int kb0 = 64 * i + 4 * hi; tile_compute<96, 256, false>(st, kb, vb, qf, negm, kl, vl, true, [&](int r, int half, float& x) { return (kb0 + 32 * half + (r & 3) + 8 * (r >> 2)) <= tq; }); }
            }
        });
#ifdef PROF_SEL
    if (b == 0 && h == 0 && qb == 15 && threadIdx.x == 0) { *PROF_SLOT(36) += __builtin_amdgcn_s_memtime(); *PROF_SLOT(37) += __builtin_amdgcn_s_memrealtime(); }
#endif
    {
        const float lt = st.l + __shfl_xor(st.l, 32); const float f = lt > 0.f ? frcp(lt) : 0.f;
#pragma unroll
        for (int r = 0; r < 16; ++r) { const float fr_ = __shfl(f, crow(r, hi)); const size_t ro = ((size_t)b * S + qb * 256 + 32 * w + crow(r, hi)) * 1024 + 512 + h * 64 + r32; ocat[ro] = f2bf(st.o0[r] * fr_); ocat[ro + 32] = f2bf(st.o1[r] * fr_); }
    }
}

__device__ __forceinline__ void nsa_unit(const Params& p, LAS unsigned char* lds, int b, int g, int jt) {
    int tid = threadIdx.x; asm volatile("" : "+v"(tid));
    const int lane = tid & 63, w = __builtin_amdgcn_readfirstlane(tid >> 6), r32 = lane & 31, hi = lane >> 5;
    const int rh = w >> 1, qh = w & 1, h = 4 * g + rh, q0 = 64 * jt, ql = 32 * qh + r32, tq = q0 + ql;
    const unsigned char* xa = p.ws + R_XA;
    const bf16_t* qn = (const bf16_t*)(xa + A_QN);
    const size_t bg = (size_t)b * 2 + g;
    const unsigned char* ksn = xa + A_KSN + bg * S * 128; const unsigned char* kwn = xa + A_KWN + bg * S * 128;
    const unsigned char* vst = xa + A_VST + bg * 64 * (size_t)S * 2; const unsigned char* vwt = xa + A_VWT + bg * 64 * (size_t)S * 2;
    const unsigned char* kc = p.ws + SM_KC + bg * 256 * 128; const unsigned char* vct = p.ws + SM_VCT + bg * 64 * 512;
    const float* gates = (const float*)(xa + A_GATES) + ((size_t)b * S + tq) * 24 + h * 3;
    bf16_t* ocat = (bf16_t*)(p.ws + R_XN);
    LAS float* imp = (LAS float*)(lds + AL_IMP); LAS unsigned char* selb = lds + AL_SELB; LAS unsigned* uni = (LAS unsigned*)(lds + AL_UNI); LAS unsigned char* tl = lds + AL_TL; LAS float* bls = (LAS float*)(lds + AL_BL);
    const float* blg = (const float*)(p.ws + SM_BL) + h * 132;
    const float cb = blg[128];
    const float bmax = wmax(fmaxf(fmaxf(blg[lane], blg[64 + lane]), cb));
    if (qh == 0) { bls[rh * 132 + lane] = blg[lane] - cb; bls[rh * 132 + 64 + lane] = blg[64 + lane] - cb; if (lane == 0) bls[rh * 132 + 128] = 0.f; }
    const LAS float* blh = bls + rh * 132;
    bf16x8 qf[4];
#pragma unroll
    for (int s = 0; s < 4; ++s) qf[s] = *(const bf16x8*)(qn + (((size_t)b * S + tq) * 8 + h) * 64 + 16 * s + 8 * hi);
    const float kn = 8.f * 1.01f * wmax(fmaxf(fmaxf(fabsf(p.in[5][lane]), fabsf(p.in[5][64 + lane])), fabsf(p.in[5][128 + lane])));
    const float mref = sqrtf(qnorm2<4>(qf)) * kn + bmax;
    f32x16 negm;
#pragma unroll
    for (int r = 0; r < 16; ++r) negm[r] = cb - mref;
    float g0 = gates[0], g1 = gates[1], g2 = gates[2];
    if (p.dbg_branch >= 0) { g0 = p.dbg_branch == 0 ? 1.f : 0.f; g1 = p.dbg_branch == 1 ? 1.f : 0.f; g2 = p.dbg_branch == 2 ? 1.f : 0.f; }
    LAS float* otl = (LAS float*)(lds + AL_OT) + w * 2048;
#ifdef PROF_SEL
    if (b == 0 && g == 0 && jt == 63 && threadIdx.x == 0) *PROF_SLOT(48) -= __builtin_amdgcn_s_memtime();
#endif
    const int nvmax = (q0 + 63 - 31) / 16 + 1, ntc = (nvmax + 63) / 64;
    Flash st; flash_init(st);
    unsigned kl[4], vl[4]; frag_offsets<64>(kl, vl, r32, hi);
    run_tiles<128, true, AL_K64, 8192, AL_V64>(ntc, lds, w, lane, 128u, 512u,
        [&](int i) { return kc + (size_t)i * 64 * 128; }, [&](int i) { return vct + (size_t)i * 128; },
        [&](int i, LAS unsigned char* kb, LAS unsigned char* vb) {
            const int cb0 = 64 * i + 4 * hi;
            tile_compute<64, 128, false>(st, kb, vb, qf, negm, kl, vl, true, [&](int r, int half, float& x) {
                const int c = cb0 + 32 * half + (r & 3) + 8 * (r >> 2); const int dist = tq - 16 * c - 31; x += blh[dist < 0 ? 0 : (dist > 128 ? 128 : dist)]; return dist >= 0; });
        });
    flash_accum<true>(otl, st, g0, hi, lane);
    unsigned mlo, mhi;
    int nsel;
    if (jt < 16) { const unsigned long long mk = (1ull << (jt + 1)) - 1ull; mlo = (unsigned)mk; mhi = (unsigned)(mk >> 32); nsel = jt + 1; if (tid <= jt) tl[tid] = (unsigned char)tid; }
    else {
        for (int i = tid; i < 64 * 65; i += 512) imp[i] = 0.f;
        const float lt = st.l + __shfl_xor(st.l, 32); const float linv = lt > 0.f ? frcp(lt) : 0.f;
        float xlast = 0.f;
        run_tiles<128, false, AL_K64, 8192, AL_V64>(ntc, lds, w, lane, 128u, 0u,
            [&](int i) { return kc + (size_t)i * 64 * 128; }, [&](int i) { return kc; },
            [&](int i, LAS unsigned char* kb, LAS unsigned char* vb) {
                f32x16 p0, p1; qk_tile<64, 128>(p0, p1, kb, qf, negm, kl);
                const int cb0 = 64 * i + 4 * hi;
                float sm[2][4], cr[2][4];
#pragma unroll
                for (int half = 0; half < 2; ++half)
#pragma unroll
                    for (int a = 0; a < 4; ++a) {
                        float s4 = 0.f, last = 0.f;
#pragma unroll
                        for (int k = 0; k < 4; ++k) {
                            const int r = 4 * a + k; const int c = cb0 + 32 * half + k + 8 * a; const int dist = tq - 16 * c - 31;
                            const float sc = (half ? p1[r] : p0[r]) + blh[dist < 0 ? 0 : (dist > 128 ? 128 : dist)];
                            const float pv = dist >= 0 ? fexp2(sc) * linv : 0.f;
                            s4 += pv; last = pv;
                        }
                        sm[half][a] = s4; cr[half][a] = last;
                    }
                float tot[2][4];
#pragma unroll
                for (int half = 0; half < 2; ++half)
#pragma unroll
                    for (int a = 0; a < 4; ++a) {
                        const float xs_ = __shfl_xor(cr[half][a], 32);
                        const float xp_ = (a > 0) ? __shfl_xor(cr[half][a > 0 ? a - 1 : 0], 32) : (half ? __shfl_xor(cr[0][3], 32) : xlast);
                        tot[half][a] = sm[half][a] + (hi ? xs_ : xp_);
                    }
                xlast = __shfl_xor(cr[1][3], 32);
                for (int rr = 0; rr < 4; ++rr) {
                    if (rh == rr) {
#pragma unroll
                        for (int half = 0; half < 2; ++half)
#pragma unroll
                            for (int a = 0; a < 4; ++a) { const int j = 16 * i + 8 * half + 2 * a + hi; imp[ql * 65 + j] += tot[half][a]; }
                    }
                    __syncthreads();
                }
            });
        if (p.dbg_branch == 1) { for (int i = tid; i < 4096; i += 512) ((float*)(p.ws + R_H))[((size_t)g * S + q0 + (i >> 6)) * 64 + (i & 63)] = imp[(i >> 6) * 65 + (i & 63)]; }
        {
            const int q = tid >> 3, jg = tid & 7;
            float vj[8]; int rk[8];
#pragma unroll
            for (int jj = 0; jj < 8; ++jj) { const int j = jg * 8 + jj; const float x = imp[q * 65 + j]; vj[jj] = (j > jt) ? -1.f : ((j == jt || j == 0) ? 1e9f : x); rk[jj] = 0; }
#pragma unroll 4
            for (int i = 0; i < 64; ++i) {
                const float xi = imp[q * 65 + i]; const float vi = (i > jt) ? -1.f : ((i == jt || i == 0) ? 1e9f : xi);
#pragma unroll
                for (int jj = 0; jj < 8; ++jj) rk[jj] += (vi > vj[jj] || (vi == vj[jj] && i < jg * 8 + jj)) ? 1 : 0;
            }
            unsigned byte = 0;
#pragma unroll
            for (int jj = 0; jj < 8; ++jj) if (jg * 8 + jj <= jt && rk[jj] < 16) byte |= 1u << jj;
            selb[q * 8 + jg] = (unsigned char)byte;
        }
        __syncthreads();
        if (w == 0) {
            unsigned a = ((const LAS unsigned*)selb)[lane * 2], c = ((const LAS unsigned*)selb)[lane * 2 + 1];
#pragma unroll
            for (int o = 1; o < 64; o <<= 1) { a |= __shfl_xor(a, o); c |= __shfl_xor(c, o); }
            const unsigned long long um = ((unsigned long long)c << 32) | a;
            if ((um >> lane) & 1ull) tl[__builtin_popcountll(um & ((1ull << lane) - 1ull))] = (unsigned char)lane;
            if (lane == 0) uni[0] = (unsigned)__builtin_popcountll(um);
        }
        __syncthreads();
        mlo = ((const LAS unsigned*)selb)[ql * 2]; mhi = ((const LAS unsigned*)selb)[ql * 2 + 1];
        nsel = (int)uni[0];
    }
    if (p.dbg_branch == 1 && rh == 0) { if (hi == 0) ((unsigned long long*)(p.ws + R_H + 4 * 1048576))[(size_t)g * S + tq] = ((unsigned long long)mhi << 32) | mlo; }
    __syncthreads();
    {
        const unsigned long long mymask = ((unsigned long long)mhi << 32) | mlo;
        nsel = __builtin_amdgcn_readfirstlane(nsel);
        flash_init(st);
        run_tiles<128, true, AL_K64, 8192, AL_V64>(nsel, lds, w, lane, 128u, (unsigned)(S * 2),
            [&](int i) { return ksn + (size_t)__builtin_amdgcn_readfirstlane((int)tl[i]) * 64 * 128; }, [&](int i) { return vst + (size_t)__builtin_amdgcn_readfirstlane((int)tl[i]) * 128; },
            [&](int i, LAS unsigned char* kb, LAS unsigned char* vb) {
                const int j = __builtin_amdgcn_readfirstlane((int)tl[i]);
                const bool mine = (mymask >> j) & 1ull;
                if (q0 + 32 * qh - (64 * j + 63) >= 128) tile_compute<64, 128, true>(st, kb, vb, qf, negm, kl, vl, mine, [&](int r, int half, float& x) { return true; });
                else { const int kb0 = 64 * j + 4 * hi;
                    tile_compute<64, 128, true>(st, kb, vb, qf, negm, kl, vl, mine, [&](int r, int half, float& x) { const int dist = tq - (kb0 + 32 * half + (r & 3) + 8 * (r >> 2)); x += blh[dist < 0 ? 0 : (dist > 128 ? 128 : dist)]; return dist >= 0; }); }
            });
        flash_accum<false>(otl, st, g1, hi, lane);
    }
    {
        const int j0 = jt >= 8 ? jt - 8 : 0, nw = jt - j0 + 1;
        flash_init(st);
        run_tiles<128, true, AL_K64, 8192, AL_V64>(nw, lds, w, lane, 128u, (unsigned)(S * 2),
            [&](int i) { return kwn + (size_t)(j0 + i) * 64 * 128; }, [&](int i) { return vwt + (size_t)(j0 + i) * 128; },
            [&](int i, LAS unsigned char* kb, LAS unsigned char* vb) {
                const int kb0 = 64 * (j0 + i) + 4 * hi;
                tile_compute<64, 128, false>(st, kb, vb, qf, negm, kl, vl, true, [&](int r, int half, float& x) { const int dist = tq - (kb0 + 32 * half + (r & 3) + 8 * (r >> 2)); x += blh[dist < 0 ? 0 : (dist > 128 ? 128 : dist)]; return dist >= 0 && dist < 512; });
            });
        flash_accum<false>(otl, st, g2, hi, lane);
    }
#pragma unroll
    for (int r = 0; r < 16; ++r) { const size_t ro = ((size_t)b * S + q0 + 32 * qh + crow(r, hi)) * 1024 + h * 64 + r32; ocat[ro] = f2bf(otl[r * 64 + lane]); ocat[ro + 32] = f2bf(otl[(16 + r) * 64 + lane]); }
    __syncthreads();
#ifdef PROF_SEL
    if (b == 0 && g == 0 && jt == 63 && threadIdx.x == 0) *PROF_SLOT(48) += __builtin_amdgcn_s_memtime();
#endif
}

__device__ __forceinline__ void phase_p4(const Params& p, LAS unsigned char* lds) {
    const int G = gridDim.x, c = blockIdx.x, nunits = 256 * NB;
#if NB == 8
    if (G == 256) {
        const int b = c & 7, idx = c >> 3, pi = idx & 7, hq = idx >> 3;
#pragma unroll 1
        for (int u = 0; u < 8; ++u) {
            if (u < 4) { const int ix = (u >> 1) ? ((idx + 16) & 31) : idx;
                nsa_unit(p, lds, b, u >> 1, (u & 1) ? ix : 63 - ix); }
            else mla_unit(p, lds, b, ((u - 4) >> 1) * 4 + hq, (u & 1) ? pi : 15 - pi);
        }
        return;
    }
#endif
    for (int j = 0;; ++j) {
        const int k = j * G + ((j & 1) ? (G - 1 - c) : c);
        if (j * G >= nunits) break;
        if (k >= nunits) continue;
        const int ty = UNIT_TYPES[k / NB], b = k % NB, kind = ty >> 9, a = (ty >> 6) & 7, cc = ty & 63;
        if (kind == 0) nsa_unit(p, lds, b, a, cc); else mla_unit(p, lds, b, a, cc);
    }
}
__device__ __forceinline__ void phase_norm(const float* x, const float* g, bf16_t* xn) {
    const int tid_ = ltid(); const int lane = tid_ & 63, gw = blockIdx.x * 8 + (tid_ >> 6), NGW = gridDim.x * 8;
    for (int m = gw; m < T; m += NGW) rms_row_to_bf16(x + (size_t)m * D, g, xn + (size_t)m * D, lane);
}
__device__ __forceinline__ void phase_conv(const Params& p) {
    const int tid = ltid(), lane = tid & 63, gw = blockIdx.x * 8 + (tid >> 6), NGW = gridDim.x * 8;
    const bf16_t* hh = (const bf16_t*)(p.ws + R_H); bf16_t* v = (bf16_t*)(p.ws + R_XA); const float* cw = p.in[22];
    constexpr int RUN = 16;
    float w0[2][8], w1[2][8], w2[2][8];
#pragma unroll
    for (int j = 0; j < 2; ++j) { const int d = 8 * lane + 512 * j; load8f(cw + d, w0[j], 1.f); load8f(cw + 1024 + d, w1[j], 1.f); load8f(cw + 2048 + d, w2[j], 1.f); }
    for (int run = gw; run < T / RUN; run += NGW) {
        const int m0 = run * RUN, s0 = m0 & (S - 1);
        float pm2[2][8], pm1[2][8];
#pragma unroll
        for (int j = 0; j < 2; ++j) { const int d = 8 * lane + 512 * j;
#pragma unroll
            for (int q = 0; q < 2; ++q) {
                float (&dst)[8] = q ? pm1[j] : pm2[j];
                if (s0 - 2 + q >= 0) { const bf16_t* r = hh + (size_t)(m0 - 2 + q) * 3072; float c[8], u[8]; unpack8(*(const u32x4*)(r + 1024 + d), c); unpack8(*(const u32x4*)(r + 2048 + d), u);
#pragma unroll
                    for (int i = 0; i < 8; ++i) dst[i] = c[i] * u[i]; }
                else {
#pragma unroll
                    for (int i = 0; i < 8; ++i) dst[i] = 0.f; }
            } }
#pragma unroll 4
        for (int rr = 0; rr < RUN; ++rr) {
            const int m = m0 + rr; const bf16_t* r = hh + (size_t)m * 3072;
#pragma unroll
            for (int j = 0; j < 2; ++j) { const int d = 8 * lane + 512 * j;
                float b[8], c[8], u[8], y[8]; unpack8(*(const u32x4*)(r + d), b); unpack8(*(const u32x4*)(r + 1024 + d), c); unpack8(*(const u32x4*)(r + 2048 + d), u);
#pragma unroll
                for (int i = 0; i < 8; ++i) { const float cu = c[i] * u[i]; y[i] = b[i] * (w0[j][i] * pm2[j][i] + w1[j][i] * pm1[j][i] + w2[j][i] * cu); pm2[j][i] = pm1[j][i]; pm1[j][i] = cu; }
                *(u32x4*)(v + (size_t)m * 1024 + d) = pack8(y); }
        }
    }
}
__device__ __forceinline__ void phase_norm_router(const Params& p, LAS unsigned char* lds) {
    const int tid = ltid(), lane = tid & 63, wave = tid >> 6, gw = blockIdx.x * 8 + wave, NGW = gridDim.x * 8;
    const float* x3 = p.out; const float* g = p.in[24]; bf16_t* xn = (bf16_t*)(p.ws + R_XN);
    LAS float* wr = (LAS float*)lds;
    LAS int* lcnt = (LAS int*)(lds + 40960); LAS int* gb = lcnt + 8;
    int* te = (int*)(p.ws + SM_TE); float* tw = (float*)(p.ws + SM_TW); int* rank = (int*)(p.ws + SM_RANK); int* cnt = (int*)(p.ws + SM_CTL);
    for (int i = tid; i < 8192; i += 512) { const int dd = i >> 3; wr[dd * 8 + (dd >> 2) * 4 + (i & 7)] = p.in[25][i]; }
    if (tid < 8) lcnt[tid] = 0;
    __syncthreads();
    for (int m = gw; m < T; m += NGW) {
        const f32x4* xr = (const f32x4*)(x3 + (size_t)m * D) + lane; const f32x4* gr = (const f32x4*)g + lane;
        f32x4 v[4]; float s = 0.f;
#pragma unroll
        for (int j = 0; j < 4; ++j) { v[j] = xr[64 * j]; s += (v[j].x * v[j].x + v[j].y * v[j].y) + (v[j].z * v[j].z + v[j].w * v[j].w); }
        const float r = rsqrtf(wsum(s) * (1.f / 1024.f) + EPS);
        float lg[8];
#pragma unroll
        for (int e = 0; e < 8; ++e) lg[e] = 0.f;
        u32x2* o8 = (u32x2*)(xn + (size_t)m * D) + lane;
#pragma unroll
        for (int j = 0; j < 4; ++j) { const f32x4 gg = gr[64 * j]; const f32x4 y = {v[j].x * r * gg.x, v[j].y * r * gg.y, v[j].z * r * gg.z, v[j].w * r * gg.w};
            u32x2 w; w.x = cvtpk(y.x, y.y); w.y = cvtpk(y.z, y.w); o8[64 * j] = w;
#pragma unroll
            for (int i = 0; i < 4; ++i) { const int d = 4 * lane + 256 * j + i; const f32x4 w0 = *(const LAS f32x4*)(wr + d * 8 + (d >> 2) * 4), w1 = *(const LAS f32x4*)(wr + d * 8 + (d >> 2) * 4 + 4);
                lg[0] += y[i] * w0.x; lg[1] += y[i] * w0.y; lg[2] += y[i] * w0.z; lg[3] += y[i] * w0.w; lg[4] += y[i] * w1.x; lg[5] += y[i] * w1.y; lg[6] += y[i] * w1.z; lg[7] += y[i] * w1.w; } }
#pragma unroll
        for (int e = 0; e < 8; ++e) lg[e] = wsum(lg[e]) + p.in[26][e];
        int e1 = 0; float l1 = lg[0];
#pragma unroll
        for (int e = 1; e < 8; ++e) if (lg[e] > l1) { l1 = lg[e]; e1 = e; }
        int e2 = -1; float l2 = -3e38f;
#pragma unroll
        for (int e = 0; e < 8; ++e) if (e != e1 && lg[e] > l2) { l2 = lg[e]; e2 = e; }
        if (lane == 0) {
            const float w1 = 1.f / (1.f + __expf(l2 - l1));
            te[m * 2] = e1; te[m * 2 + 1] = e2; tw[m * 2] = w1; tw[m * 2 + 1] = 1.f - w1;
            rank[m * 2] = __hip_atomic_fetch_add(&lcnt[e1], 1, __ATOMIC_RELAXED, __HIP_MEMORY_SCOPE_WORKGROUP); rank[m * 2 + 1] = __hip_atomic_fetch_add(&lcnt[e2], 1, __ATOMIC_RELAXED, __HIP_MEMORY_SCOPE_WORKGROUP);
        }
    }
    __syncthreads();
    if (tid < 8) gb[tid] = atomicAdd(&cnt[tid], lcnt[tid]);
    __syncthreads();
    for (int m = gw; m < T; m += NGW) if (lane < 2) rank[m * 2 + lane] += gb[te[m * 2 + lane]];
}
__device__ __forceinline__ void phase_moe_gather(const Params& p) {
    const int tid = ltid(), lane = tid & 63, gw = blockIdx.x * 8 + (tid >> 6), NGW = gridDim.x * 8;
    const int* cnt = (const int*)(p.ws + SM_CTL); const int* te = (const int*)(p.ws + SM_TE); const float* tw = (const float*)(p.ws + SM_TW); const int* rank = (const int*)(p.ws + SM_RANK);
    int* pos = (int*)(p.ws + SM_POS); float* roww = (float*)(p.ws + SM_ROWW); int* tile_e = (int*)(p.ws + SM_TILEE);
    int* rowtok = (int*)(p.ws + SM_ROWTOK);
    int off[9]; off[0] = 0;
#pragma unroll
    for (int e = 0; e < 8; ++e) off[e + 1] = off[e] + ((cnt[e] + 255) & ~255);
    if (blockIdx.x == 0) {
        for (int i = tid; i < ROWS_MAX / 256; i += 512) { int e = -1;
#pragma unroll
            for (int k = 0; k < 8; ++k) if (i * 256 >= off[k] && i * 256 < off[k + 1]) e = k;
            tile_e[i] = e < 0 ? 0 : e; }
        if (tid == 0) ((int*)(p.ws + SM_CTL))[8] = off[8];
    }
    if (blockIdx.x < 8 && tid < 256) {
#pragma unroll
        for (int e = 0; e < 8; ++e) if (e == (int)blockIdx.x) { const int c = cnt[e]; if (c + tid < off[e + 1] - off[e]) { roww[off[e] + c + tid] = 0.f; rowtok[off[e] + c + tid] = -1; } }
    }
    for (int pi0 = gw * 4; pi0 < 2 * T; pi0 += NGW * 4) {
        int r[4]; float w[4];
#pragma unroll
        for (int q = 0; q < 4; ++q) { const int e = te[pi0 + q]; int o = 0;
#pragma unroll
            for (int k = 0; k < 8; ++k) if (k == e) o = off[k];
            r[q] = o + rank[pi0 + q]; w[q] = tw[pi0 + q]; }
#pragma unroll
        for (int q = 0; q < 4; ++q) if (lane == q) { pos[pi0 + q] = r[q]; roww[r[q]] = w[q]; rowtok[r[q]] = (pi0 + q) >> 1; }
    }
}
__device__ __forceinline__ void phase_moe_combine(const Params& p) {
    const int tid_ = ltid(); const int lane = tid_ & 63, gw = blockIdx.x * 8 + (tid_ >> 6), NGW = gridDim.x * 8;
    const int* pos = (const int*)(p.ws + SM_POS); const bf16_t* ym = (const bf16_t*)(p.ws + R_XA);
    for (int m0 = gw * 2; m0 < T; m0 += NGW * 2) {
        int ps[4];
#pragma unroll
        for (int q = 0; q < 4; ++q) ps[q] = pos[m0 * 2 + q];
        f32x4 x[2][4]; u32x2 ya[2][4], yc[2][4];
#pragma unroll
        for (int q = 0; q < 2; ++q)
#pragma unroll
            for (int j = 0; j < 4; ++j) { const int d = 4 * lane + 256 * j;
                x[q][j] = *(const f32x4*)(p.out + (size_t)(m0 + q) * D + d); ya[q][j] = *(const u32x2*)(ym + (size_t)ps[2 * q] * D + d); yc[q][j] = *(const u32x2*)(ym + (size_t)ps[2 * q + 1] * D + d); }
#pragma unroll
        for (int q = 0; q < 2; ++q)
#pragma unroll
            for (int j = 0; j < 4; ++j) { const int d = 4 * lane + 256 * j; f32x4 o = x[q][j]; const u32x2 a = ya[q][j], c = yc[q][j];
                o.x += bflo(a.x) + bflo(c.x); o.y += bfhi(a.x) + bfhi(c.x); o.z += bflo(a.y) + bflo(c.y); o.w += bfhi(a.y) + bfhi(c.y);
                *(f32x4*)(p.out + (size_t)(m0 + q) * D + d) = o; }
    }
}

#define XB_TMO      128
#define XB_XCNT(j)  (256  + 64 * (j))
#define XB_XSUB(j)  (1280 + 64 * (j))
#define XB_XGEN(j)  (2304 + 64 * (j))
#define XB_TOP      3328
#define XB_TOPGEN   3392
#define XCD_BAR_WORDS 3456
#define XB_SPIN_CAP (1u << 18)

__device__ __forceinline__ unsigned xb_ld(unsigned* p)              { return __hip_atomic_load(p, __ATOMIC_RELAXED, __HIP_MEMORY_SCOPE_AGENT); }
__device__ __forceinline__ unsigned xb_add(unsigned* p, unsigned v) { return __hip_atomic_fetch_add(p, v, __ATOMIC_RELAXED, __HIP_MEMORY_SCOPE_AGENT); }
__device__ __forceinline__ unsigned xb_xcc_id() { return (unsigned)__builtin_amdgcn_s_getreg((3 << 11) | 20) & 0xFu; }
#define XB_SPIN(cond, bar) do { unsigned _sp = 0; while (cond) { __builtin_amdgcn_s_sleep(1); \
    if ((++_sp & 255u) == 0u) { if (xb_ld(&(bar)[XB_TMO])) break; if (_sp > XB_SPIN_CAP) { atomicAdd(&(bar)[XB_TMO], 1u); break; } } } } while (0)

struct XcdBarrier {
    unsigned* bar; unsigned x;
    volatile LAS unsigned* st;
};

__device__ __forceinline__ XcdBarrier xcd_barrier_post(unsigned* bar, volatile LAS unsigned* st) {
    XcdBarrier b; b.bar = bar; b.x = xb_xcc_id(); b.st = st;
    if (threadIdx.x == 0) (void)xb_add(&bar[XB_XCNT(b.x)], 1u);
    return b;
}
__device__ __forceinline__ void xcd_barrier_complete(unsigned* bar, unsigned x, unsigned& nloc, unsigned& nx) {
    const unsigned G = gridDim.x * gridDim.y * gridDim.z;
    unsigned sum, cnt, mine, sp = 0u;
    for (;;) {
        sum = 0u; cnt = 0u; mine = 0u;
#pragma unroll
        for (unsigned j = 0; j < 16; ++j) { const unsigned c = xb_ld(&bar[XB_XCNT(j)]); sum += c; cnt += (c > 0u) ? 1u : 0u; mine = (j == x) ? c : mine; }
        if (sum == G) break;
        __builtin_amdgcn_s_sleep(1);
        if ((++sp & 255u) == 0u) { if (xb_ld(&bar[XB_TMO])) break; if (sp > XB_SPIN_CAP) { atomicAdd(&bar[XB_TMO], 1u); break; } }
    }
    nloc = mine > 0u ? mine : 1u; nx = cnt > 0u ? cnt : 1u;
}

__device__ __forceinline__ void xcd_barrier(const XcdBarrier& b) {
    asm volatile("s_waitcnt vmcnt(0)" ::: "memory");
    __syncthreads();
    if (threadIdx.x == 0) {
        unsigned* bar = b.bar;
        __builtin_amdgcn_s_waitcnt(0);
        unsigned nloc = b.st[0], nx = b.st[1];
        if (nloc == 0u) { xcd_barrier_complete(bar, b.x, nloc, nx); b.st[0] = nloc; b.st[1] = nx; }
        const unsigned old = xb_add(&bar[XB_XSUB(b.x)], 1u);
        const unsigned gen = old / nloc;
        if (old + 1u == (gen + 1u) * nloc) {
            __builtin_amdgcn_fence(__ATOMIC_RELEASE, "agent");
            asm volatile("s_waitcnt vmcnt(0)" ::: "memory");
            const unsigned og = xb_add(&bar[XB_TOP], 1u);
            const unsigned tg = og / nx;
            if (og + 1u == (tg + 1u) * nx) xb_add(&bar[XB_TOPGEN], 1u);
            else XB_SPIN(xb_ld(&bar[XB_TOPGEN]) == tg, bar);
            __builtin_amdgcn_fence(__ATOMIC_ACQUIRE, "agent");
            xb_add(&bar[XB_XGEN(b.x)], 1u);
            asm volatile("s_waitcnt vmcnt(0)" ::: "memory");
        } else {
            XB_SPIN(xb_ld(&bar[XB_XGEN(b.x)]) == gen, bar);
            __builtin_amdgcn_fence(__ATOMIC_ACQUIRE, "agent");
            asm volatile("s_waitcnt vmcnt(0)" ::: "memory");
        }
    }
    __syncthreads();
}


__global__ void __launch_bounds__(512) mega_fwd(Params p) {
    extern __shared__ __attribute__((aligned(16))) unsigned char lds_raw[];
    LAS unsigned char* lds = (LAS unsigned char*)lds_raw;
    cg::grid_group grid = cg::this_grid();
    volatile LAS unsigned* bst = (volatile LAS unsigned*)(lds + 140032);
    if (threadIdx.x == 0) { bst[0] = 0u; bst[1] = 0u; const unsigned long long ba = (unsigned long long)(p.ws + SM_BAR); bst[2] = (unsigned)ba; bst[3] = (unsigned)(ba >> 32); }
    __syncthreads();
    (void)xcd_barrier_post((unsigned*)(p.ws + SM_BAR), bst);
#ifdef PROF_SEL
#define PSTAMP(k) do { if (blockIdx.x == 0 && threadIdx.x == 0) { volatile LAS unsigned* pl_ = (volatile LAS unsigned*)(lds + 140032 + 16); const unsigned long long now_ = __builtin_amdgcn_s_memrealtime(); const unsigned long long last_ = ((unsigned long long)pl_[1] << 32) | pl_[0]; *PROF_SLOT(k) += now_ - last_; pl_[0] = (unsigned)now_; pl_[1] = (unsigned)(now_ >> 32); } } while (0)
#else
#define PSTAMP(k)
#endif
#define GSYNC() do { XcdBarrier xb_; volatile LAS unsigned* st_ = (volatile LAS unsigned*)(lds + 140032); xb_.bar = (unsigned*)(((unsigned long long)st_[3] << 32) | st_[2]); xb_.x = xb_xcc_id(); xb_.st = st_; xcd_barrier(xb_); } while (0)
#ifdef PROF_SEL
    if (threadIdx.x == 0) { volatile LAS unsigned* pl_ = (volatile LAS unsigned*)(lds + 140032 + 16); const unsigned long long now_ = __builtin_amdgcn_s_memrealtime(); pl_[0] = (unsigned)now_; pl_[1] = (unsigned)(now_ >> 32); }
#endif
    const int G = gridDim.x, c = blockIdx.x;
#define LP() bf16_t* W = (bf16_t*)p.ws; bf16_t* xn = (bf16_t*)(p.ws + R_XN); float* x1 = (float*)(p.ws + R_XA); pg8::StaticOrder SO; (void)W; (void)xn; (void)x1; (void)SO
#ifndef PHMASK
#define PHMASK 0xFFFFFFFFu
#endif
#ifndef REPEAT_MASK
#define REPEAT_MASK 0u
#endif
#define PH(k) if (((PHMASK >> (k)) & 1u) && (k) >= p.ph_lo && (k) <= p.ph_hi)
#define RPT(k) if ((REPEAT_MASK >> (k)) & 1u)
    PH(0) { LP(); phase_p0(p, lds); }
    GSYNC(); PSTAMP(0);
    if (p.ph_lo == -12345) grid.sync();
    RPT(0) { { LP(); phase_p0(p, lds); } GSYNC(); }
    PH(1) { LP();
        pg8::Gemm g{xn, W + W_IN_E / 2, T, 1792, 1024, 1024, nullptr, 0, nullptr}; SO.init(T, 1792, G, c);
        pg8::EpiBf16<0> E{(bf16_t*)(p.ws + R_H), 1792, nullptr, nullptr};
        pg8::gemm_phase<pg8::EpiBf16<0>, true>(lds, g, SO, E);
    }
    GSYNC(); PSTAMP(1);
    PH(2) { LP(); phase_p2(p, lds); }
    GSYNC(); PSTAMP(2);
    RPT(2) { { LP(); phase_p2(p, lds); } GSYNC(); }
    PH(3) { LP();
        const int nCu = 2 * (NB * 512 / 256) * 2, Gc = (nCu < G / 2) ? nCu : 0;
        if (Gc == 0 || c < Gc) {
            for (int kv = 0; kv < 2; ++kv) {
                pg8::Gemm g{(const bf16_t*)(p.ws + R_XA + (kv ? A_VCIN : A_KCIN)), W + W_CW1 / 2 + (size_t)kv * 512 * 1024, NB * 512, 512, 1024, 1024, nullptr, 0, nullptr};
                if (Gc) SO.init(NB * 512, 512, Gc / 2, c - kv * (Gc / 2)); else SO.init(NB * 512, 512, G, c);
                pg8::EpiBf16<0> E{(bf16_t*)(p.ws + SM_HID) + (size_t)kv * NB * 512 * 512, 512, nullptr, nullptr};
                if (Gc == 0 || (c / (Gc / 2)) == kv) pg8::gemm_phase<pg8::EpiBf16<0>, true>(lds, g, SO, E);
            }
        }
        if (Gc == 0 || c >= Gc) {
            {
                pg8::Gemm g{(const bf16_t*)(p.ws + R_XA + A_CQN), W + W_UQ / 2, T, 1024, 256, 256, nullptr, 0, nullptr}; SO.init(T, 1024, G - Gc, c - Gc);
                pg8::EpiBf16<0> E{(bf16_t*)(p.ws + R_H), 1024, nullptr, nullptr};
                pg8::gemm_phase<pg8::EpiBf16<0>, true>(lds, g, SO, E);
            }
            {
                pg8::Gemm g{(const bf16_t*)(p.ws + R_XA + A_CKVN), W + W_UKV / 2, T, 1024, 128, 128, nullptr, 0, nullptr}; SO.init(T, 1024, G - Gc, c - Gc);
                pg8::EpiBf16<0> E{(bf16_t*)(p.ws + R_H + (size_t)T * 2048), 1024, nullptr, nullptr};
                pg8::gemm_phase<pg8::EpiBf16<0>, true>(lds, g, SO, E);
            }
        }
    }
    GSYNC(); PSTAMP(3);
    PH(4) { LP(); phase_p3b(p, lds); }
    GSYNC(); PSTAMP(4);
    RPT(4) { { LP(); phase_p3b(p, lds); } GSYNC(); }
    PH(5) { LP(); phase_p4(p, lds); }
    GSYNC(); PSTAMP(5);
    RPT(5) { { LP(); phase_p4(p, lds); } GSYNC(); }
    PH(6) { LP();
        pg8::Gemm g{xn, W + W_OUT_E / 2, T, 1024, 1024, 1024, nullptr, 0, nullptr}; SO.init(T, 1024, G, c);
        pg8::EpiResStat<false> E{p.in[0], (bf16_t*)p.out, (float*)(p.ws + SM_SSP1), 1024};
        pg8::gemm_phase<pg8::EpiResStat<false>, true>(lds, g, SO, E);
    }
    GSYNC(); PSTAMP(6);
    PH(7) { }
    PH(8) { LP();
        pg8::Gemm g{(const bf16_t*)p.out, W + W_GU / 2, T, 5632, 1024, 1024, nullptr, 0, nullptr}; SO.init(T, 5632, G, c);
        pg8::EpiSwiGLU E{(bf16_t*)(p.ws + R_H), 2816, (const float*)(p.ws + SM_SSP1)};
        pg8::gemm_phase<pg8::EpiSwiGLU, true>(lds, g, SO, E);
    }
    GSYNC(); PSTAMP(8);
    PH(9) { LP();
        pg8::Gemm g{(const bf16_t*)(p.ws + R_H), W + W_D / 2, T, 1024, 2816, 2816, nullptr, 0, nullptr}; SO.init(T, 1024, G, c);
        pg8::EpiResStat<true> E{(const bf16_t*)p.out, xn, (float*)(p.ws + SM_SSP2), 1024};
        pg8::gemm_phase<pg8::EpiResStat<true>, true>(lds, g, SO, E);
    }
    GSYNC(); PSTAMP(9);
    PH(10) { }
    PH(11) { LP();
        pg8::Gemm g{xn, W + W_IN_O / 2, T, 3072, 1024, 1024, nullptr, 0, nullptr}; SO.init(T, 3072, G, c);
        pg8::EpiBf16<0> E{(bf16_t*)(p.ws + R_H), 3072, nullptr, (const float*)(p.ws + SM_SSP2)};
        pg8::gemm_phase<pg8::EpiBf16<0>, true>(lds, g, SO, E);
    }
    GSYNC(); PSTAMP(11);
    PH(12) { LP(); phase_conv(p); }
    GSYNC(); PSTAMP(12);
    RPT(12) { { LP(); phase_conv(p); } GSYNC(); }
    PH(13) { LP();
        pg8::Gemm g{(const bf16_t*)x1, W + W_OUT_O / 2, T, 1024, 1024, 1024, nullptr, 0, nullptr}; SO.init(T, 1024, G, c);
        pg8::EpiResF32B E{xn, p.out, 1024};
        pg8::gemm_phase<pg8::EpiResF32B, true>(lds, g, SO, E);
    }
    GSYNC(); PSTAMP(13);
    PH(14) { LP(); phase_norm_router(p, lds); }
    GSYNC(); PSTAMP(14);
    PH(15) { LP(); phase_moe_gather(p); }
    GSYNC(); PSTAMP(15);
    PH(16) { LP(); const int mrows = ((const int*)(p.ws + SM_CTL))[8];
        pg8::Gemm g{xn, W + W_MGU / 2, mrows, 2816, 1024, 1024, (const int*)(p.ws + SM_TILEE), (size_t)2816 * 1024, (const int*)(p.ws + SM_ROWTOK)}; SO.init(mrows, 2816, G, c);
        pg8::EpiSwiGLU E{(bf16_t*)(p.ws + R_H), 1408, nullptr};
        pg8::gemm_phase<pg8::EpiSwiGLU, true, true>(lds, g, SO, E);
    }
    GSYNC(); PSTAMP(16);
    PH(17) { LP(); const int mrows = ((const int*)(p.ws + SM_CTL))[8];
        pg8::Gemm g{(const bf16_t*)(p.ws + R_H), W + W_MD / 2, mrows, 1024, 1408, 1408, (const int*)(p.ws + SM_TILEE), (size_t)1024 * 1408, nullptr}; SO.init(mrows, 1024, G, c);
        pg8::EpiRowScaleBf16 E{(bf16_t*)(p.ws + R_XA), 1024, (const float*)(p.ws + SM_ROWW)};
        pg8::gemm_phase<pg8::EpiRowScaleBf16, true>(lds, g, SO, E);
    }
    GSYNC(); PSTAMP(17);
    PH(18) { LP(); phase_moe_combine(p); }
#ifdef PROF_SEL
    GSYNC(); PSTAMP(18);
    GSYNC();
    {
        unsigned long long v_ = *PROF_SLOT(PROF_SEL);
#ifdef PROF_DIV
        const unsigned long long dv_ = *PROF_SLOT(PROF_DIV); v_ = dv_ ? v_ / dv_ : 0ull;
#endif
        unsigned long long a_ = v_ / (unsigned long long)(PROF_UNIT); if (a_ > 27ull) a_ = 27ull;
        const float sc_ = 1.f + (float)a_;
        for (size_t i = (size_t)blockIdx.x * 512 + threadIdx.x; i < (size_t)S * 1024 / 4; i += (size_t)gridDim.x * 512) { f32x4* o = (f32x4*)p.out + i; *o = *o * sc_; }
    }
#endif
#undef PH
}

inline void launch(void* const* d_in, float* d_out, void* d_ws, size_t ws_size, hipStream_t stream, int ph_lo = 0, int ph_hi = 99, int dbg_branch = -1) {
    static int grid = 0;
    if (grid == 0) {
        int dev = 0, cus = 0, per_cu = 0;
        hipGetDevice(&dev); hipDeviceGetAttribute(&cus, hipDeviceAttributeMultiprocessorCount, dev);
        hipFuncSetAttribute((const void*)mega_fwd, hipFuncAttributeMaxDynamicSharedMemorySize, LDS_BYTES);
        hipOccupancyMaxActiveBlocksPerMultiprocessor(&per_cu, (const void*)mega_fwd, 512, LDS_BYTES);
        if (per_cu < 1) { fprintf(stderr, "occupancy query says %d blocks/CU\n", per_cu); per_cu = 1; }
        grid = cus;
        if (WS_FAST_END > ws_size) { fprintf(stderr, "ws too small: need %zu have %zu\n", (size_t)WS_FAST_END, ws_size); grid = -1; }
    }
    if (grid < 0) return;
    if (ph_lo <= 14 && ph_hi >= 14) hipMemsetAsync((char*)d_ws + SM_CTL, 0, 4096, stream);
    hipMemsetAsync((char*)d_ws + SM_BAR, 0, 16384, stream);
    Params p{};
    for (int i = 0; i < 30; ++i) p.in[i] = (const float*)d_in[i];
    p.out = d_out; p.ws = (unsigned char*)d_ws; p.ph_lo = ph_lo; p.ph_hi = ph_hi; p.dbg_branch = dbg_branch;
    void* args[] = {&p};
    hipError_t e = hipLaunchCooperativeKernel((const void*)mega_fwd, dim3(grid), dim3(512), args, LDS_BYTES, stream);
    if (e != hipSuccess) fprintf(stderr, "cooperative launch failed: %s (grid %d)\n", hipGetErrorString(e), grid);
}
}
extern "C" void kernel_launch(void* const* d_in, const int* in_sizes, int n_in, void* d_out, int out_size, void* d_ws, size_t ws_size, hipStream_t stream) {
    fast::launch(d_in, (float*)d_out, d_ws, ws_size, stream);
}
```

```cpp
#include <hip/hip_runtime.h>
#include <hip/hip_bf16.h>
#include <stdint.h>
#include <stdio.h>
#include <string.h>
#include <hip/hip_cooperative_groups.h>
namespace cg = cooperative_groups;
#define NB 8
#define REPEAT_MASK 0x0u
namespace gold {
constexpr int S = 4096, D = 1024, HW = 1720;
constexpr float EPS = 1e-6f;

__device__ const unsigned char T5B[128] = {0, 1, 2, 3, 4, 5, 6, 7, 8, 9, 10, 11, 12, 13, 14, 15, 16, 16, 16, 17, 17, 18, 18, 18, 19, 19, 19, 20, 20, 20, 20, 21, 21, 21, 21, 22, 22, 22, 22, 22, 23, 23, 23, 23, 23, 23, 24, 24, 24, 24, 24, 24, 25, 25, 25, 25, 25, 25, 25, 26, 26, 26, 26, 26, 26, 26, 26, 27, 27, 27, 27, 27, 27, 27, 27, 27, 27, 28, 28, 28, 28, 28, 28, 28, 28, 28, 28, 29, 29, 29, 29, 29, 29, 29, 29, 29, 29, 29, 29, 30, 30, 30, 30, 30, 30, 30, 30, 30, 30, 30, 30, 30, 30, 31, 31, 31, 31, 31, 31, 31, 31, 31, 31, 31, 31, 31, 31};
}
#ifndef NB
#define NB 8
#endif
namespace fast {
#define LAS __attribute__((address_space(3)))
typedef unsigned short bf16_t;
typedef short bf16x8 __attribute__((ext_vector_type(8)));
typedef float f32x4 __attribute__((ext_vector_type(4)));
typedef float f32x2 __attribute__((ext_vector_type(2)));
typedef float f32x16 __attribute__((ext_vector_type(16)));
typedef unsigned u32x4 __attribute__((ext_vector_type(4)));
typedef unsigned u32x2 __attribute__((ext_vector_type(2)));
typedef __bf16 bf16x2_t __attribute__((ext_vector_type(2)));

constexpr int S = 4096, T = NB * S, D = 1024;
constexpr float EPS = 1e-6f, LOG2E = 1.4426950408889634f;

__device__ __forceinline__ unsigned cvtpk(float lo, float hi) { f32x2 v = {lo, hi}; bf16x2_t b = __builtin_convertvector(v, bf16x2_t); return __builtin_bit_cast(unsigned, b); }
__device__ __forceinline__ bf16_t f2bf(float f) { return (bf16_t)(cvtpk(f, 0.f) & 0xffffu); }
__device__ __forceinline__ float bf2f(bf16_t u) { return __builtin_bit_cast(float, (unsigned)u << 16); }
__device__ __forceinline__ float bflo(unsigned u) { return __builtin_bit_cast(float, u << 16); }
__device__ __forceinline__ float bfhi(unsigned u) { return __builtin_bit_cast(float, u & 0xffff0000u); }
__device__ __forceinline__ float wsum(float v) {
#pragma unroll
    for (int o = 1; o < 64; o <<= 1) v += __shfl_xor(v, o);
    return v;
}
__device__ __forceinline__ float fexp2(float x) { return __builtin_amdgcn_exp2f(x); }
__device__ __forceinline__ float frcp(float x) { return __builtin_amdgcn_rcpf(x); }
__device__ __forceinline__ float silu_f(float x) { return x * frcp(1.f + fexp2(-x * LOG2E)); }
__device__ __forceinline__ float gelu_tanh_f(float x) {
    const float u = 0.7978845608028654f * (x + 0.044715f * x * x * x);
    return x * frcp(1.f + fexp2(-2.f * LOG2E * u));
}

namespace pg8 {
constexpr int BM = 256, BK = 64, HALF = 128, HTB = HALF * BK * 2, STAGE_BYTES = 8 * HTB, NXCD = 8, WGM = 8;
__host__ __device__ __forceinline__ int lds_byte(int r, int c) { const int st = (r >> 4) * 2 + (c >> 5), rr = r & 15, cc = c & 31, ob = rr * 64 + cc * 2; return st * 1024 + (ob ^ (((ob >> 9) & 1) << 5)); }
__host__ __device__ __forceinline__ void stage_rc(int b, int& R, int& C) { const int st = b / 1024, sb = b % 1024, swz = sb ^ (((sb >> 9) & 1) << 5); R = (st >> 1) * 16 + swz / 64; C = (st & 1) * 32 + (swz % 64) / 2; }
__host__ __device__ __forceinline__ int perm32(int rho) { const int n = rho >> 4, i = rho & 15; return 8 * (i >> 2) + 4 * n + (i & 3); }

struct Unit { int pm, pn; };
struct Gemm { const bf16_t* A; const bf16_t* Bt; int M, N, K, lda; const int* tile_e; size_t estride; const int* rowidx; };

struct StaticOrder {
    int nM, nN, nwg, G, c;
    __device__ void init(int M, int N, int G_, int c_) { nM = M / BM; nN = N / BM; nwg = nM * nN; G = G_; c = c_; }
    __device__ bool next(int i, Unit& u) const {
        const long L = (long)i * G + c; if (L >= nwg) return false;
        int wgid = (int)L; { const int q = nwg / NXCD, r = nwg % NXCD, xcd = wgid % NXCD, off = wgid / NXCD; wgid = (xcd < r ? xcd * (q + 1) : r * (q + 1) + (xcd - r) * q) + off; }
        const int nig = WGM * nN, gid = wgid / nig, fm = gid * WGM, gsz = (nM - fm) < WGM ? (nM - fm) : WGM;
        u.pm = fm + ((wgid % nig) % gsz); u.pn = (wgid % nig) / gsz; return true;
    }
};

template <class Epi, bool ALIGN_EPI, bool GATHER = false>
__device__ __forceinline__ void gemm_phase(LAS unsigned char* lds, const Gemm g, const StaticOrder& S, const Epi& E) {
    int tid = threadIdx.x; asm volatile("" : "+v"(tid));
    const int wid = __builtin_amdgcn_readfirstlane(tid >> 6), lane = tid & 63, wr = wid >> 2, wc = wid & 3, fr = lane & 15, fq = lane >> 4;
    const int K = g.K, nt = K / BK, lda = g.lda;
    unsigned voffA[2], voffB[2];
#pragma unroll
    for (int i = 0; i < 2; ++i) { int R, C; stage_rc(tid * 16 + i * 8192, R, C); const int Rb = Epi::PERM ? ((R & ~31) + perm32(R & 31)) : R;
        voffA[i] = (unsigned)(R * lda + C) * 2u; voffB[i] = (unsigned)(Rb * K + C) * 2u; }
    const size_t kstep = (size_t)(BK * 2);
    const size_t hsA = GATHER ? 0 : (size_t)HALF * lda * 2, tsA = 2 * hsA, hsB = (size_t)HALF * K * 2, tsB = 2 * hsB;
    unsigned vgc[2][2], vgn[2][2];
#define PG8_GOFF(pm_, vg) do { _Pragma("unroll") for (int h_ = 0; h_ < 2; ++h_) _Pragma("unroll") for (int i_ = 0; i_ < 2; ++i_) { int R_, C_; stage_rc(tid * 16 + i_ * 8192, R_, C_); \
        int tok_ = g.rowidx[(pm_) * BM + h_ * HALF + R_]; tok_ = tok_ < 0 ? 0 : tok_; vg[h_][i_] = (unsigned)(tok_ * lda + C_) * 2u; } } while (0)
#define PG8_STAGE_A(bufoff, gbase, h, nx) do { unsigned va_[2]; _Pragma("unroll") for (int i_ = 0; i_ < 2; ++i_) va_[i_] = GATHER ? ((nx) ? vgn[h][i_] : vgc[h][i_]) : voffA[i_]; PG8_STAGE(bufoff, gbase, va_); } while (0)
    const unsigned ldsw = (unsigned)wid * 1024u;
    const int aoff = lds_byte(wr * 64 + fr, fq * 8), boff = lds_byte(wc * 32 + fr, fq * 8);
#define PG8_SA(b, h) (((b) * 2 + (h)) * HTB)
#define PG8_SB(b, h) ((4 + (b) * 2 + (h)) * HTB)
#define PG8_STAGE(bufoff, gbase, voff) do { _Pragma("unroll") for (int _i = 0; _i < 2; ++_i) \
        __builtin_amdgcn_global_load_lds((const unsigned*)((const char*)(gbase) + (voff)[_i]), (LAS unsigned*)(lds + (bufoff) + ldsw + _i * 8192), 16, 0, 0); } while (0)
#define PG8_LDA(dst, b, h) do { _Pragma("unroll") for (int m = 0; m < 4; ++m) _Pragma("unroll") for (int k = 0; k < 2; ++k) dst[m][k] = *(const LAS bf16x8*)(lds + PG8_SA(b, h) + aoff + m * 2048 + k * 1024); } while (0)
#define PG8_LDB(dst, b, h) do { _Pragma("unroll") for (int n = 0; n < 2; ++n) _Pragma("unroll") for (int k = 0; k < 2; ++k) dst[n][k] = *(const LAS bf16x8*)(lds + PG8_SB(b, h) + boff + n * 2048 + k * 1024); } while (0)
#define PG8_MMA(ai, bj, At, Bt) do { __builtin_amdgcn_s_setprio(1); _Pragma("unroll") for (int m = 0; m < 4; ++m) _Pragma("unroll") for (int n = 0; n < 2; ++n) _Pragma("unroll") for (int k = 0; k < 2; ++k) \
        acc[ai][bj][m][n] = __builtin_amdgcn_mfma_f32_16x16x32_bf16(Bt[n][k], At[m][k], acc[ai][bj][m][n], 0, 0, 0); __builtin_amdgcn_s_setprio(0); } while (0)
#define PG8_WAIT_V(n) asm volatile("s_waitcnt vmcnt(" #n ")" ::: "memory")
#define PG8_WAIT_L(n) asm volatile("s_waitcnt lgkmcnt(" #n ")" ::: "memory")
#define PG8_BAR __builtin_amdgcn_s_barrier()
#define PG8_SCHED __builtin_amdgcn_sched_barrier(0)
#define PG8_EOFF(pm_) (g.tile_e ? (size_t)g.tile_e[pm_] * g.estride * 2 : (size_t)0)
    Unit cur, nxt; int ui = 0;
    if (!S.next(0, cur)) return;
    f32x4 acc[2][2][4][2];
#pragma unroll
    for (int a = 0; a < 2; ++a)
#pragma unroll
        for (int b = 0; b < 2; ++b)
#pragma unroll
            for (int m = 0; m < 4; ++m)
#pragma unroll
                for (int n = 0; n < 2; ++n) acc[a][b][m][n] = (f32x4){0.f, 0.f, 0.f, 0.f};
    bf16x8 At[4][2], B0[2][2], B1[2][2];
    const char* cA = (const char*)g.A + (size_t)cur.pm * tsA; const char* cB = (const char*)g.Bt + PG8_EOFF(cur.pm) + (size_t)cur.pn * tsB;
    if constexpr (GATHER) PG8_GOFF(cur.pm, vgc);
    PG8_STAGE(PG8_SB(0, 0), cB, voffB); PG8_STAGE(PG8_SB(0, 1), cB + hsB, voffB); PG8_STAGE_A(PG8_SA(0, 0), cA, 0, false); PG8_STAGE_A(PG8_SA(0, 1), cA + hsA, 1, false);
    if (wr == 1) PG8_BAR;
    PG8_WAIT_V(2); PG8_BAR;
    PG8_STAGE(PG8_SB(1, 0), cB + kstep, voffB); PG8_STAGE_A(PG8_SA(1, 0), cA + kstep, 0, false); PG8_STAGE(PG8_SB(1, 1), cB + hsB + kstep, voffB);
    PG8_WAIT_V(6); PG8_BAR;
    for (;;) {
        const bool has_next = S.next(ui + 1, nxt);
        if constexpr (GATHER) { if (has_next) PG8_GOFF(nxt.pm, vgn); else { vgn[0][0] = vgc[0][0]; vgn[0][1] = vgc[0][1]; vgn[1][0] = vgc[1][0]; vgn[1][1] = vgc[1][1]; } }
        const char* nA = has_next ? (const char*)g.A + (size_t)nxt.pm * tsA : cA;
        const char* nB = has_next ? (const char*)g.Bt + PG8_EOFF(nxt.pm) + (size_t)nxt.pn * tsB : cB;
        for (int t = 0; t < nt; t += 2) {
            const bool last = (t == nt - 2);
            const char* a1 = cA + (size_t)(t + 1) * kstep;
            const char* a2 = last ? nA : cA + (size_t)(t + 2) * kstep; const char* b2 = last ? nB : cB + (size_t)(t + 2) * kstep;
            const char* a3 = a2 + kstep; const char* b3 = b2 + kstep;
            PG8_LDB(B0, 0, 0); PG8_LDB(B1, 0, 1); PG8_SCHED; PG8_LDA(At, 0, 0); PG8_STAGE_A(PG8_SA(1, 1), a1 + hsA, 1, false);
            PG8_WAIT_V(8); PG8_WAIT_L(0); PG8_BAR; PG8_MMA(0, 0, At, B0); PG8_MMA(0, 1, At, B1); PG8_BAR; PG8_SCHED;
            PG8_LDA(At, 0, 1); PG8_STAGE(PG8_SB(0, 0), b2, voffB); PG8_STAGE(PG8_SB(0, 1), b2 + hsB, voffB); PG8_STAGE_A(PG8_SA(0, 0), a2, 0, last);
            PG8_WAIT_V(8); PG8_WAIT_L(0); PG8_BAR; PG8_MMA(1, 0, At, B0); PG8_MMA(1, 1, At, B1); PG8_BAR; PG8_SCHED;
            PG8_LDB(B0, 1, 0); PG8_LDB(B1, 1, 1); PG8_SCHED; PG8_LDA(At, 1, 0); PG8_STAGE_A(PG8_SA(0, 1), a2 + hsA, 1, last);
            PG8_WAIT_V(8); PG8_WAIT_L(0); PG8_BAR; PG8_MMA(0, 0, At, B0); PG8_MMA(0, 1, At, B1); PG8_BAR; PG8_SCHED;
            PG8_LDA(At, 1, 1); PG8_STAGE(PG8_SB(1, 0), b3, voffB); PG8_STAGE(PG8_SB(1, 1), b3 + hsB, voffB); PG8_STAGE_A(PG8_SA(1, 0), a3, 0, last);
            PG8_WAIT_V(8); PG8_WAIT_L(0); PG8_BAR; PG8_MMA(1, 0, At, B0); PG8_MMA(1, 1, At, B1); PG8_BAR; PG8_SCHED;
        }
        if constexpr (ALIGN_EPI) { if (wr == 0) PG8_BAR; }
        E(acc, cur, wr, wc, fr, fq);
        if (!has_next) break;
#pragma unroll
        for (int a = 0; a < 2; ++a)
#pragma unroll
            for (int b = 0; b < 2; ++b)
#pragma unroll
                for (int m = 0; m < 4; ++m)
#pragma unroll
                    for (int n = 0; n < 2; ++n) acc[a][b][m][n] = (f32x4){0.f, 0.f, 0.f, 0.f};
        cur = nxt; cA = nA; cB = nB; ++ui;
        if constexpr (GATHER) { vgc[0][0] = vgn[0][0]; vgc[0][1] = vgn[0][1]; vgc[1][0] = vgn[1][0]; vgc[1][1] = vgn[1][1]; }
        if constexpr (ALIGN_EPI) { if (wr == 1) PG8_BAR; }
    }
    PG8_WAIT_V(0);
    if constexpr (!ALIGN_EPI) { if (wr == 0) PG8_BAR; }
    PG8_BAR;
#undef PG8_SA
#undef PG8_SB
#undef PG8_STAGE
#undef PG8_LDA
#undef PG8_LDB
#undef PG8_MMA
#undef PG8_WAIT_V
#undef PG8_WAIT_L
#undef PG8_BAR
#undef PG8_SCHED
#undef PG8_EOFF
#undef PG8_GOFF
#undef PG8_STAGE_A
}

__device__ __forceinline__ float row_rstd(const float* ssp, int row);
template <int ACT> struct EpiBf16 {
    static constexpr bool PERM = true;
    bf16_t* O; int ldc; const float* bias; const float* ssp;
    __device__ __forceinline__ void operator()(const f32x4 (&acc)[2][2][4][2], const Unit& u, int wr, int wc, int fr, int fq) const {
        const int row0 = u.pm * BM + wr * 64 + fr, col0 = u.pn * BM + wc * 32 + 8 * fq;
        f32x4 bv[2][2];
#pragma unroll
        for (int bj = 0; bj < 2; ++bj)
#pragma unroll
            for (int n = 0; n < 2; ++n) bv[bj][n] = bias ? *(const f32x4*)(bias + col0 + bj * HALF + 4 * n) : (f32x4){0.f, 0.f, 0.f, 0.f};
#pragma unroll
        for (int ai = 0; ai < 2; ++ai)
#pragma unroll
            for (int m = 0; m < 4; ++m) { bf16_t* rowp = O + (size_t)(row0 + ai * HALF + m * 16) * ldc + col0;
                const float rs = (ACT == 0 && ssp) ? row_rstd(ssp, row0 + ai * HALF + m * 16) : 1.f;
#pragma unroll
                for (int bj = 0; bj < 2; ++bj) { f32x4 v0 = acc[ai][bj][m][0] * rs + bv[bj][0], v1 = acc[ai][bj][m][1] * rs + bv[bj][1];
                    if (ACT == 2) {
#pragma unroll
                        for (int i = 0; i < 4; ++i) { v0[i] = gelu_tanh_f(v0[i]); v1[i] = gelu_tanh_f(v1[i]); } }
                    u32x4 w; w.x = cvtpk(v0[0], v0[1]); w.y = cvtpk(v0[2], v0[3]); w.z = cvtpk(v1[0], v1[1]); w.w = cvtpk(v1[2], v1[3]);
                    *(u32x4*)(rowp + bj * HALF) = w; } }
    }
};
struct EpiResF32 {
    static constexpr bool PERM = false;
    const float* base; float* out; int ldc;
    __device__ __forceinline__ void operator()(const f32x4 (&acc)[2][2][4][2], const Unit& u, int wr, int wc, int fr, int fq) const {
        const int col0 = u.pn * BM + wc * 32 + 4 * fq;
#pragma unroll
        for (int ai = 0; ai < 2; ++ai)
#pragma unroll
            for (int m = 0; m < 4; ++m) { const size_t off = (size_t)(u.pm * BM + ai * HALF + wr * 64 + m * 16 + fr) * ldc + col0;
#pragma unroll
                for (int bj = 0; bj < 2; ++bj)
#pragma unroll
                    for (int n = 0; n < 2; ++n) { const f32x4 bs = *(const f32x4*)(base + off + bj * HALF + n * 16); *(f32x4*)(out + off + bj * HALF + n * 16) = bs + acc[ai][bj][m][n]; } }
    }
};
template <bool BASE_BF16> struct EpiResStat {
    static constexpr bool PERM = false;
    const void* base; bf16_t* xb; float* ssp; int ldc;
    __device__ __forceinline__ void operator()(const f32x4 (&acc)[2][2][4][2], const Unit& u, int wr, int wc, int fr, int fq) const {
        const int col0 = u.pn * BM + wc * 32 + 4 * fq;
#pragma unroll
        for (int ai = 0; ai < 2; ++ai)
#pragma unroll
            for (int m = 0; m < 4; ++m) { const int row = u.pm * BM + ai * HALF + wr * 64 + m * 16 + fr; const size_t off = (size_t)row * ldc + col0; float ss = 0.f;
#pragma unroll
                for (int bj = 0; bj < 2; ++bj)
#pragma unroll
                    for (int n = 0; n < 2; ++n) { f32x4 bs;
                        if (BASE_BF16) { const u32x2 t = *(const u32x2*)((const bf16_t*)base + off + bj * HALF + n * 16); bs = (f32x4){bflo(t.x), bfhi(t.x), bflo(t.y), bfhi(t.y)}; }
                        else bs = *(const f32x4*)((const float*)base + off + bj * HALF + n * 16);
                        const f32x4 v = bs + acc[ai][bj][m][n];
                        u32x2 w; w.x = cvtpk(v.x, v.y); w.y = cvtpk(v.z, v.w); *(u32x2*)(xb + off + bj * HALF + n * 16) = w; ss += (v.x * v.x + v.y * v.y) + (v.z * v.z + v.w * v.w); }
                ss += __shfl_xor(ss, 16); ss += __shfl_xor(ss, 32);
                if (fq == 0) ssp[(size_t)row * 16 + u.pn * 4 + wc] = ss; }
    }
};
struct EpiResBf16B {
    static constexpr bool PERM = false;
    const bf16_t* base; bf16_t* out; int ldc;
    __device__ __forceinline__ void operator()(const f32x4 (&acc)[2][2][4][2], const Unit& u, int wr, int wc, int fr, int fq) const {
        const int col0 = u.pn * BM + wc * 32 + 4 * fq;
#pragma unroll
        for (int ai = 0; ai < 2; ++ai)
#pragma unroll
            for (int m = 0; m < 4; ++m) { const size_t off = (size_t)(u.pm * BM + ai * HALF + wr * 64 + m * 16 + fr) * ldc + col0;
#pragma unroll
                for (int bj = 0; bj < 2; ++bj)
#pragma unroll
                    for (int n = 0; n < 2; ++n) { const u32x2 t = *(const u32x2*)(base + off + bj * HALF + n * 16); const f32x4 v = (f32x4){bflo(t.x), bfhi(t.x), bflo(t.y), bfhi(t.y)} + acc[ai][bj][m][n];
                        u32x2 w; w.x = cvtpk(v.x, v.y); w.y = cvtpk(v.z, v.w); *(u32x2*)(out + off + bj * HALF + n * 16) = w; } }
    }
};
struct EpiResF32B {
    static constexpr bool PERM = false;
    const bf16_t* base; float* out; int ldc;
    __device__ __forceinline__ void operator()(const f32x4 (&acc)[2][2][4][2], const Unit& u, int wr, int wc, int fr, int fq) const {
        const int col0 = u.pn * BM + wc * 32 + 4 * fq;
#pragma unroll
        for (int ai = 0; ai < 2; ++ai)
#pragma unroll
            for (int m = 0; m < 4; ++m) { const size_t off = (size_t)(u.pm * BM + ai * HALF + wr * 64 + m * 16 + fr) * ldc + col0;
#pragma unroll
                for (int bj = 0; bj < 2; ++bj)
#pragma unroll
                    for (int n = 0; n < 2; ++n) { const u32x2 t = *(const u32x2*)(base + off + bj * HALF + n * 16); const f32x4 bs = {bflo(t.x), bfhi(t.x), bflo(t.y), bfhi(t.y)};
                        *(f32x4*)(out + off + bj * HALF + n * 16) = bs + acc[ai][bj][m][n]; } }
    }
};
__device__ __forceinline__ float row_rstd(const float* ssp, int row) {
    const f32x4* q = (const f32x4*)(ssp + (size_t)row * 16); const f32x4 a = q[0], b = q[1], c = q[2], d = q[3];
    const float s = ((a.x + a.y) + (a.z + a.w)) + ((b.x + b.y) + (b.z + b.w)) + ((c.x + c.y) + (c.z + c.w)) + ((d.x + d.y) + (d.z + d.w));
    return rsqrtf(s * (1.f / 1024.f) + EPS);
}
struct EpiSwiGLU {
    static constexpr bool PERM = true;
    bf16_t* O; int ldc; const float* ssp;
    __device__ __forceinline__ void operator()(const f32x4 (&acc)[2][2][4][2], const Unit& u, int wr, int wc, int fr, int fq) const {
        const int row0 = u.pm * BM + wr * 64 + fr, col0 = u.pn * HALF + wc * 32 + 8 * fq;
#pragma unroll
        for (int ai = 0; ai < 2; ++ai)
#pragma unroll
            for (int m = 0; m < 4; ++m) { bf16_t* rowp = O + (size_t)(row0 + ai * HALF + m * 16) * ldc + col0;
                const float rs = ssp ? row_rstd(ssp, row0 + ai * HALF + m * 16) : 1.f;
                float h[8];
#pragma unroll
                for (int n = 0; n < 2; ++n)
#pragma unroll
                    for (int i = 0; i < 4; ++i) h[n * 4 + i] = silu_f(acc[ai][0][m][n][i] * rs) * (acc[ai][1][m][n][i] * rs);
                u32x4 w; w.x = cvtpk(h[0], h[1]); w.y = cvtpk(h[2], h[3]); w.z = cvtpk(h[4], h[5]); w.w = cvtpk(h[6], h[7]);
                *(u32x4*)rowp = w; }
    }
};
struct EpiRowScaleBf16 {
    static constexpr bool PERM = true;
    bf16_t* O; int ldc; const float* roww;
    __device__ __forceinline__ void operator()(const f32x4 (&acc)[2][2][4][2], const Unit& u, int wr, int wc, int fr, int fq) const {
        const int row0 = u.pm * BM + wr * 64 + fr, col0 = u.pn * BM + wc * 32 + 8 * fq;
#pragma unroll
        for (int ai = 0; ai < 2; ++ai)
#pragma unroll
            for (int m = 0; m < 4; ++m) { const int row = row0 + ai * HALF + m * 16; const float sc = roww[row]; bf16_t* rowp = O + (size_t)row * ldc + col0;
#pragma unroll
                for (int bj = 0; bj < 2; ++bj) { const f32x4 v0 = acc[ai][bj][m][0] * sc, v1 = acc[ai][bj][m][1] * sc;
                    u32x4 w; w.x = cvtpk(v0[0], v0[1]); w.y = cvtpk(v0[2], v0[3]); w.z = cvtpk(v1[0], v1[1]); w.w = cvtpk(v1[2], v1[3]);
                    *(u32x4*)(rowp + bj * HALF) = w; } }
    }
};
}
constexpr int ROWS_MAX = 2 * T + 8 * 256;
constexpr size_t al256(size_t x) { return (x + 255) & ~(size_t)255; }
constexpr size_t W_IN_E = 0;
constexpr size_t W_CW1 = W_IN_E + (size_t)1792 * 1024 * 2;
constexpr size_t W_UQ = W_CW1 + (size_t)2 * 256 * 2048 * 2;
constexpr size_t W_UKV = W_UQ + (size_t)1024 * 256 * 2;
constexpr size_t W_OUT_E = W_UKV + (size_t)1024 * 128 * 2;
constexpr size_t W_GU = W_OUT_E + (size_t)1024 * 1024 * 2;
constexpr size_t W_D = W_GU + (size_t)5632 * 1024 * 2;
constexpr size_t W_IN_O = W_D + (size_t)1024 * 2816 * 2;
constexpr size_t W_OUT_O = W_IN_O + (size_t)3072 * 1024 * 2;
constexpr size_t W_MGU = W_OUT_O + (size_t)1024 * 1024 * 2;
constexpr size_t W_MD = W_MGU + (size_t)8 * 2816 * 1024 * 2;
constexpr size_t W_END = W_MD + (size_t)8 * 1024 * 1408 * 2;
constexpr size_t SM_CTL = al256(W_END);
constexpr size_t SM_BAR = SM_CTL + 4096;
constexpr size_t SM_B1P = SM_BAR + 16384;
constexpr size_t SM_B1 = SM_B1P + 32 * 512 * 4;
constexpr size_t SM_ROPE = SM_B1 + 512 * 4;
constexpr size_t SM_BL = SM_ROPE + (size_t)S * 32 * 4;
constexpr size_t SM_HID = SM_BL + 8 * 132 * 4;
constexpr size_t SM_KC = SM_HID + (size_t)2 * NB * 512 * 512 * 2;
constexpr size_t SM_VCT = SM_KC + (size_t)NB * 512 * 64 * 2;
constexpr size_t SM_TE = SM_VCT + (size_t)NB * 512 * 64 * 2;
constexpr size_t SM_TW = SM_TE + (size_t)T * 8;
constexpr size_t SM_RANK = SM_TW + (size_t)T * 8;
constexpr size_t SM_POS = SM_RANK + (size_t)T * 8;
constexpr size_t SM_ROWW = SM_POS + (size_t)T * 8;
constexpr size_t SM_TILEE = SM_ROWW + (size_t)ROWS_MAX * 4;
constexpr size_t SM_ROWTOK = al256(SM_TILEE + (size_t)(ROWS_MAX / 256 + 8) * 4);
constexpr size_t SM_SSP1 = al256(SM_ROWTOK + (size_t)ROWS_MAX * 4);
constexpr size_t SM_SSP2 = SM_SSP1 + (size_t)T * 64;
constexpr size_t SM_END = SM_SSP2 + (size_t)T * 64;
constexpr size_t R_XA = al256(SM_END);
constexpr size_t SZ_XA = (size_t)T * 4096 + (size_t)4 * 1048576;
constexpr size_t R_XN = R_XA + SZ_XA;
constexpr size_t SZ_XN = (size_t)T * 2048;
constexpr size_t R_H = R_XN + SZ_XN;
constexpr size_t SZ_H = ((size_t)T * 6144 > (size_t)ROWS_MAX * 2816) ? (size_t)T * 6144 : (size_t)ROWS_MAX * 2816;
constexpr size_t WS_FAST_END = R_H + SZ_H;
constexpr size_t A_QN = 0;
constexpr size_t A_KSN = A_QN + (size_t)T * 1024;
constexpr size_t A_KWN = A_KSN + (size_t)T * 256;
constexpr size_t A_VST = A_KWN + (size_t)T * 256;
constexpr size_t A_VWT = A_VST + (size_t)T * 256;
constexpr size_t A_KCIN = A_VWT + (size_t)T * 256;
constexpr size_t A_VCIN = A_KCIN + (size_t)T * 256 + 2048;
constexpr size_t A_CQN = A_VCIN + (size_t)T * 256 + 2048;
constexpr size_t A_CKVN = A_CQN + (size_t)T * 512;
constexpr size_t A_KROPE = A_CKVN + (size_t)T * 256;
constexpr size_t A_GATES = A_KROPE + (size_t)T * 64;
constexpr size_t A_END = A_GATES + (size_t)T * 96;
static_assert(A_END <= SZ_XA, "attention inputs fit R_XA");
constexpr size_t O_QM = 0;
constexpr size_t O_KM = O_QM + (size_t)T * 1536;
constexpr size_t O_VMT = O_KM + (size_t)T * 1536;
static_assert(O_VMT + (size_t)T * 1024 <= (size_t)T * 4096, "d_out scratch");

struct Params {
    const float* in[30];
    float* out;
    unsigned char* ws;
    int ph_lo, ph_hi, dbg_branch, pad_;
};

#ifdef PROF_SEL
#define PROF_SLOT(k) ((unsigned long long*)(p.ws + SM_CTL + 2048) + (k))
#define PROF_ON(cond) ((cond) && threadIdx.x == 0)
#ifndef PROF_WAVE
#define PROF_WAVE 0
#endif
#endif
constexpr int LDS_BYTES = 147456;

__device__ __forceinline__ int ltid() { int t = threadIdx.x; asm volatile("" : "+v"(t)); return t; }
__device__ __forceinline__ int perm16(int k) { return (k & ~12) | ((k & 4) << 1) | ((k & 8) >> 1); }

struct WDesc { int in_idx, K, N, rep, map, row_off; size_t src_stride, dst_off, dst_stride; int gain_idx, pad_; size_t src_off; };
__device__ const WDesc WDESC[13] = {
    {3, 1024, 1720, 1, 2, 0, 0, W_IN_E / 2, 0, -1, 0},
    {7, 1024, 256, 2, 0, 0, (size_t)2048 * 256, W_CW1 / 2, (size_t)512 * 1024, -1, 0, 0},
    {7, 1024, 256, 2, 0, 256, (size_t)2048 * 256, W_CW1 / 2, (size_t)512 * 1024, -1, 0, (size_t)1024 * 256},
    {11, 256, 768, 1, 3, 0, 0, W_UQ / 2, 0, -1, 0},
    {12, 128, 1024, 1, 0, 0, 0, W_UKV / 2, 0, -1, 0},
    {15, 1024, 1024, 1, 0, 0, 0, W_OUT_E / 2, 0, -1, 0},
    {17, 1024, 2816, 1, 1, 0, 0, W_GU / 2, 0, 16, 0},
    {18, 1024, 2816, 1, 1, 128, 0, W_GU / 2, 0, 16, 0},
    {19, 2816, 1024, 1, 0, 0, 0, W_D / 2, 0, -1, 0},
    {21, 1024, 3072, 1, 0, 0, 0, W_IN_O / 2, 0, 20, 0},
    {23, 1024, 1024, 1, 0, 0, 0, W_OUT_O / 2, 0, -1, 0},
    {27, 1024, 1408, 8, 1, 0, (size_t)1024 * 1408, W_MGU / 2, (size_t)2816 * 1024, -1, 0},
    {28, 1024, 1408, 8, 1, 128, (size_t)1024 * 1408, W_MGU / 2, (size_t)2816 * 1024, -1, 0},
};
__device__ const WDesc WDESC_MD = {29, 1408, 1024, 8, 0, 0, (size_t)1408 * 1024, W_MD / 2, (size_t)1024 * 1408, -1, 0};

__device__ __forceinline__ void transpose_item(const float* W, int K, int N, bf16_t* WT, int map, int row_off, const float* gain, LAS float* scr, int item, int lane) {
    const int nblk = (N + 31) / 32, kb = item / nblk, nb = item % nblk, k0 = 64 * kb, n0 = 32 * nb;
    const int n4 = (lane & 7) * 4; const bool nok = (n0 + n4) < N;
    f32x4 v[8];
#pragma unroll
    for (int i = 0; i < 8; ++i) { const int kk = (lane >> 3) + 8 * i; v[i] = nok ? *(const f32x4*)(W + (size_t)(k0 + kk) * N + n0 + n4) : (f32x4){0.f, 0.f, 0.f, 0.f}; if (gain) v[i] = v[i] * gain[k0 + kk]; }
#pragma unroll
    for (int i = 0; i < 8; ++i) { const int kk = (lane >> 3) + 8 * i; LAS float* d = scr + kk * 33 + n4; d[0] = v[i].x; d[1] = v[i].y; d[2] = v[i].z; d[3] = v[i].w; }
    asm volatile("s_waitcnt lgkmcnt(0)" ::: "memory");
    const int c = lane & 7;
#pragma unroll
    for (int j = 0; j < 4; ++j) { const int n = (lane >> 3) + 8 * j; const LAS float* s = scr + (8 * c) * 33 + n;
        u32x4 o; o.x = cvtpk(s[0 * 33], s[1 * 33]); o.y = cvtpk(s[2 * 33], s[3 * 33]); o.z = cvtpk(s[4 * 33], s[5 * 33]); o.w = cvtpk(s[6 * 33], s[7 * 33]);
        const int nn = n0 + n;
        if (nn < N) { const int row = (map == 1) ? (256 * (nn >> 7) + (nn & 127) + row_off) : (map == 2) ? (nn < 1280 ? nn : (nn < 1304 ? nn + 416 : nn - 24)) : (map == 3) ? ((nn / 96) * 128 + nn % 96) : (nn + row_off);
            *(u32x4*)(WT + (size_t)row * K + k0 + 8 * c) = o; } }
    asm volatile("s_waitcnt lgkmcnt(0)" ::: "memory");
}
__device__ __forceinline__ void do_wdesc(const Params& p, const WDesc& d, int it, LAS float* scr, int lane) {
    const int per = (d.K / 64) * ((d.N + 31) / 32); const int r = it / per, ii = it % per;
    transpose_item(p.in[d.in_idx] + d.src_off + (size_t)r * d.src_stride, d.K, d.N, (bf16_t*)p.ws + d.dst_off + (size_t)r * d.dst_stride, d.map, d.row_off, d.gain_idx >= 0 ? p.in[d.gain_idx] : nullptr, scr, ii, lane);
}
__device__ __forceinline__ void rms_row_to_bf16(const float* xrow, const float* g, bf16_t* orow, int lane) {
    const f32x4* xr = (const f32x4*)xrow + lane; const f32x4* gr = (const f32x4*)g + lane;
    f32x4 v[4]; float s = 0.f;
#pragma unroll
    for (int j = 0; j < 4; ++j) { v[j] = xr[64 * j]; s += (v[j].x * v[j].x + v[j].y * v[j].y) + (v[j].z * v[j].z + v[j].w * v[j].w); }
    const float r = rsqrtf(wsum(s) * (1.f / 1024.f) + EPS);
    u32x2* o8 = (u32x2*)orow + lane;
#pragma unroll
    for (int j = 0; j < 4; ++j) { const f32x4 gg = gr[64 * j]; u32x2 w; w.x = cvtpk(v[j].x * r * gg.x, v[j].y * r * gg.y); w.y = cvtpk(v[j].z * r * gg.z, v[j].w * r * gg.w); o8[64 * j] = w; }
}
__device__ __forceinline__ void phase_p0(const Params& p, LAS unsigned char* lds) {
    const int tid = ltid(), lane = tid & 63, wave = tid >> 6;
    const int gw = blockIdx.x * 8 + wave, NGW = gridDim.x * 8;
    LAS float* scr = (LAS float*)(lds + wave * 16384);
    int base = 0;
#pragma unroll 1
    for (int d = 0; d < 14; ++d) {
        const WDesc& wd = (d < 13) ? WDESC[d] : WDESC_MD;
        const int n_it = wd.rep * (wd.K / 64) * ((wd.N + 31) / 32);
        int first = (gw - (base % NGW) + NGW) % NGW;
        for (int it = first; it < n_it; it += NGW) do_wdesc(p, wd, it, scr, lane);
        base += n_it;
    }
    bf16_t* xn = (bf16_t*)(p.ws + R_XN);
    for (int m = gw; m < T; m += 2 * NGW) { rms_row_to_bf16(p.in[0] + (size_t)m * D, p.in[2], xn + (size_t)m * D, lane); if (m + NGW < T) rms_row_to_bf16(p.in[0] + (size_t)(m + NGW) * D, p.in[2], xn + (size_t)(m + NGW) * D, lane); }
    for (int u = gw; u < 256; u += NGW) {
        const int kc = u >> 3, kv = (u >> 2) & 1, nb = u & 3; float s = 0.f;
        const float* pos = p.in[6] + kv * 2048 + kc * 64; const float* w1 = p.in[7] + ((size_t)kv * 2048 + kc * 64) * 256 + nb * 64 + lane;
#pragma unroll 8
        for (int k = 0; k < 64; ++k) s += pos[k] * w1[(size_t)k * 256];
        ((float*)(p.ws + SM_B1P))[kc * 512 + kv * 256 + nb * 64 + lane] = s;
    }
    for (int i = blockIdx.x * 512 + tid; i < S * 16; i += gridDim.x * 512) {
        const int t = i >> 4, f = i & 15; const float ang = (float)t * powf(10000.f, -(float)f / 16.f);
        float* rp = (float*)(p.ws + SM_ROPE) + t * 32; rp[f] = cosf(ang); rp[16 + f] = sinf(ang);
    }
    if (blockIdx.x == 0) for (int i = tid; i < 8 * 129; i += 512) { const int h = i / 129, dd = i % 129; ((float*)(p.ws + SM_BL))[h * 132 + dd] = p.in[1][(dd < 128 ? (int)gold::T5B[dd] : 31) * 8 + h] * LOG2E; }
}

__device__ __forceinline__ void unpack8(const u32x4 v, float (&x)[8]) { x[0] = bflo(v.x); x[1] = bfhi(v.x); x[2] = bflo(v.y); x[3] = bfhi(v.y); x[4] = bflo(v.z); x[5] = bfhi(v.z); x[6] = bflo(v.w); x[7] = bfhi(v.w); }
__device__ __forceinline__ u32x4 pack8(const float (&x)[8]) { u32x4 w; w.x = cvtpk(x[0], x[1]); w.y = cvtpk(x[2], x[3]); w.z = cvtpk(x[4], x[5]); w.w = cvtpk(x[6], x[7]); return w; }
__device__ __forceinline__ float ss8f(const float (&x)[8]) { return ((x[0] * x[0] + x[1] * x[1]) + (x[2] * x[2] + x[3] * x[3])) + ((x[4] * x[4] + x[5] * x[5]) + (x[6] * x[6] + x[7] * x[7])); }
__device__ __forceinline__ void load8f(const float* g, float (&x)[8], float sc) { const f32x4 a = *(const f32x4*)g, b = *(const f32x4*)(g + 4); x[0] = a.x * sc; x[1] = a.y * sc; x[2] = a.z * sc; x[3] = a.w * sc; x[4] = b.x * sc; x[5] = b.y * sc; x[6] = b.z * sc; x[7] = b.w * sc; }
__device__ __forceinline__ void phase_p2(const Params& p, LAS unsigned char* lds) {
    const int tid = ltid(), lane = tid & 63, wave = tid >> 6;
    const bf16_t* hb = (const bf16_t*)(p.ws + R_H);
    unsigned char* xa = p.ws + R_XA;
    bf16_t* qn = (bf16_t*)(xa + A_QN); bf16_t* ksn = (bf16_t*)(xa + A_KSN); bf16_t* kwn = (bf16_t*)(xa + A_KWN);
    bf16_t* vst = (bf16_t*)(xa + A_VST); bf16_t* vwt = (bf16_t*)(xa + A_VWT); bf16_t* kcin = (bf16_t*)(xa + A_KCIN); bf16_t* vcin = (bf16_t*)(xa + A_VCIN);
    bf16_t* cqn = (bf16_t*)(xa + A_CQN); bf16_t* ckvn = (bf16_t*)(xa + A_CKVN); bf16_t* krope = (bf16_t*)(xa + A_KROPE); float* gates = (float*)(xa + A_GATES);
    LAS bf16_t* vs = (LAS bf16_t*)lds;
    if (blockIdx.x == 0) {
        { float s = 0.f; for (int k = 0; k < 32; ++k) s += ((const float*)(p.ws + SM_B1P))[k * 512 + tid]; ((float*)(p.ws + SM_B1))[tid] = s; }
        for (int i = tid; i < 1024; i += 512) { kcin[(size_t)T * 128 + i] = 0; vcin[(size_t)T * 128 + i] = 0; }
    }
    const int c8 = (lane & 7) * 8, seg = lane >> 3;
    float qg[8], ksg[8], kwg[8], cqg[8], ckvg[8];
    load8f(p.in[4] + c8, qg, 0.125f * LOG2E); load8f(p.in[5] + 64 + c8, ksg, 1.f); load8f(p.in[5] + 128 + c8, kwg, 1.f);
    load8f(p.in[9] + (lane & 31) * 8, cqg, 1.f); load8f(p.in[10] + (lane & 15) * 8, ckvg, 1.f);
    for (int tile = blockIdx.x; tile < T / 64; tile += gridDim.x) {
        const int b = tile / (S / 64), s0 = (tile % (S / 64)) * 64;
#pragma unroll 4
        for (int tt = 0; tt < 8; ++tt) {
            const int sl = wave * 8 + tt, s = s0 + sl; const size_t t = (size_t)b * S + s;
            const bf16_t* hr = hb + t * 1792 + lane * 8;
            const u32x4 L0 = *(const u32x4*)hr, L1 = *(const u32x4*)(hr + 512), L2 = *(const u32x4*)(hr + 1024);
            u32x4 L3 = {0u, 0u, 0u, 0u}; if (lane < 32) L3 = *(const u32x4*)(hr + 1536);
            float x0[8], x1[8], x2[8], x3[8];
            unpack8(L0, x0); unpack8(L1, x1); unpack8(L2, x2); unpack8(L3, x3);
            float a0 = ss8f(x0), a1 = ss8f(x1), a2 = ss8f(x2), a3 = ss8f(x3);
#pragma unroll
            for (int o = 1; o < 8; o <<= 1) { a0 += __shfl_xor(a0, o); a1 += __shfl_xor(a1, o); a2 += __shfl_xor(a2, o); a3 += __shfl_xor(a3, o); }
            float a2w = a2 + __shfl_xor(a2, 8); a2w += __shfl_xor(a2w, 16);
            const float a3w = a3 + __shfl_xor(a3, 8);
            const int pp0 = (sl & ~15) | perm16(sl & 15);
            const int pp = (((pp0 >> 3) ^ (lane & 7)) << 3) | (pp0 & 7);
            {
                const float r = rsqrtf(a0 * (1.f / 64.f) + EPS); float y[8];
#pragma unroll
                for (int j = 0; j < 8; ++j) y[j] = x0[j] * r * qg[j];
                *(u32x4*)(qn + t * 512 + lane * 8) = pack8(y);
            }
            {
                const int g = seg & 1; const size_t gm = (((size_t)b * 2 + g) * S + s) * 64 + c8;
                if (seg < 2) *(u32x4*)(kcin + gm) = L1;
                else if (seg < 4) *(u32x4*)(vcin + gm) = L1;
                else if (seg < 6) { const float r = rsqrtf(a1 * (1.f / 64.f) + EPS); float y[8];
#pragma unroll
                    for (int j = 0; j < 8; ++j) y[j] = x1[j] * r * ksg[j];
                    *(u32x4*)(ksn + gm) = pack8(y); }
                else {
#pragma unroll
                    for (int j = 0; j < 8; ++j) vs[((0 + g) * 64 + c8 + j) * 72 + pp] = (bf16_t)((j & 1) ? (L1[j >> 1] >> 16) : (L1[j >> 1] & 0xffffu)); }
            }
            {
                const int g = seg & 1; const size_t gm = (((size_t)b * 2 + g) * S + s) * 64 + c8;
                if (seg < 2) { const float r = rsqrtf(a2 * (1.f / 64.f) + EPS); float y[8];
#pragma unroll
                    for (int j = 0; j < 8; ++j) y[j] = x2[j] * r * kwg[j];
                    *(u32x4*)(kwn + gm) = pack8(y); }
                else if (seg < 4) {
#pragma unroll
                    for (int j = 0; j < 8; ++j) vs[((2 + g) * 64 + c8 + j) * 72 + pp] = (bf16_t)((j & 1) ? (L2[j >> 1] >> 16) : (L2[j >> 1] & 0xffffu)); }
                else { const float r = rsqrtf(a2w * (1.f / 256.f) + EPS); float y[8];
#pragma unroll
                    for (int j = 0; j < 8; ++j) y[j] = x2[j] * r * cqg[j];
                    *(u32x4*)(cqn + t * 256 + (lane - 32) * 8) = pack8(y); }
            }
            {
                if (lane < 16) { const float r = rsqrtf(a3w * (1.f / 128.f) + EPS); float y[8];
#pragma unroll
                    for (int j = 0; j < 8; ++j) y[j] = x3[j] * r * ckvg[j];
                    *(u32x4*)(ckvn + t * 128 + lane * 8) = pack8(y); }
                else if (lane < 20) *(u32x4*)(krope + t * 32 + (lane - 16) * 8) = L3;
                else if (lane < 23) { float y[8];
#pragma unroll
                    for (int j = 0; j < 8; ++j) y[j] = frcp(1.f + fexp2(-x3[j] * LOG2E));
                    float* gp = gates + t * 24 + (lane - 20) * 8; *(f32x4*)gp = (f32x4){y[0], y[1], y[2], y[3]}; *(f32x4*)(gp + 4) = (f32x4){y[4], y[5], y[6], y[7]}; }
            }
        }
        __syncthreads();
        {
            const int row = tid >> 1, half = tid & 1, which = row >> 6, d = row & 63, g = which & 1;
            bf16_t* dst = ((which < 2) ? vst : vwt) + (((size_t)b * 2 + g) * 64 + d) * S + s0 + half * 32;
            const LAS bf16_t* src = vs + row * 72; const int sx = (row >> 3) & 7;
#pragma unroll
            for (int c = 0; c < 4; ++c) *(u32x4*)(dst + c * 8) = *(const LAS u32x4*)(src + (((half * 4 + c) ^ sx) << 3));
        }
        __syncthreads();
    }
}
__device__ __forceinline__ void phase_p3b(const Params& p, LAS unsigned char* lds) {
    const int tid = ltid(), lane = tid & 63, wave = tid >> 6;
    const int gw = blockIdx.x * 8 + wave, NGW = gridDim.x * 8;
    const bf16_t* qraw = (const bf16_t*)(p.ws + R_H);
    const bf16_t* kvraw = (const bf16_t*)(p.ws + R_H + (size_t)T * 2048);
    const bf16_t* krope = (const bf16_t*)(p.ws + R_XA + A_KROPE);
    const float* rope = (const float*)(p.ws + SM_ROPE);
    bf16_t* qm = (bf16_t*)((unsigned char*)p.out + O_QM); bf16_t* km = (bf16_t*)((unsigned char*)p.out + O_KM); bf16_t* vmt = (bf16_t*)((unsigned char*)p.out + O_VMT);
    const float* q_norm = p.in[13]; const float* k_norm = p.in[14];
    LAS bf16_t* vs = (LAS bf16_t*)lds;
    LAS float* w2s = (LAS float*)(lds + 73728);
    for (int kv = 0; kv < 2; ++kv) {
        __syncthreads();
        for (int i = tid; i < 256 * 64; i += 512) w2s[i] = p.in[8][kv * 16384 + i];
        __syncthreads();
        const bf16_t* P = (const bf16_t*)(p.ws + SM_HID) + (size_t)kv * NB * 512 * 512;
        const f32x4 bs = *(const f32x4*)((const float*)(p.ws + SM_B1) + kv * 256 + lane * 4);
        for (int row = gw; row < NB * 512; row += NGW) {
            const int row1 = row + 1 < NB * 512 ? row + 1 : row;
            const u32x2 pa = *(const u32x2*)(P + (size_t)row * 512 + lane * 4), pb = *(const u32x2*)(P + (size_t)row1 * 512 + 256 + lane * 4);
            const float h0 = gelu_tanh_f(bflo(pa.x) + bflo(pb.x) + bs.x), h1 = gelu_tanh_f(bfhi(pa.x) + bfhi(pb.x) + bs.y), h2 = gelu_tanh_f(bflo(pa.y) + bflo(pb.y) + bs.z), h3 = gelu_tanh_f(bfhi(pa.y) + bfhi(pb.y) + bs.w);
            float acc = 0.f;
#pragma unroll 8
            for (int k4 = 0; k4 < 64; ++k4) {
                acc += __shfl(h0, k4) * w2s[(k4 * 4 + 0) * 64 + lane]; acc += __shfl(h1, k4) * w2s[(k4 * 4 + 1) * 64 + lane];
                acc += __shfl(h2, k4) * w2s[(k4 * 4 + 2) * 64 + lane]; acc += __shfl(h3, k4) * w2s[(k4 * 4 + 3) * 64 + lane];
            }
            if (kv == 0) { const float r = rsqrtf(wsum(acc * acc) * (1.f / 64.f) + EPS); ((bf16_t*)(p.ws + SM_KC))[(size_t)row * 64 + lane] = f2bf(acc * r * p.in[5][lane]); }
            else { const int c = row & 255; ((bf16_t*)(p.ws + SM_VCT))[((size_t)(row >> 8) * 64 + lane) * 256 + ((c & ~15) | perm16(c & 15))] = f2bf(acc); }
        }
    }
    __syncthreads();
    const float QS = 0.10206207261596577f * LOG2E;
    const int c = lane & 15, hl = lane >> 4;
    float qg[8], kg[8];
    load8f(q_norm + (c < 12 ? c * 8 : 0), qg, QS);
    load8f(k_norm + (c < 12 ? c * 8 : 0), kg, 1.f);
    for (int tile = blockIdx.x; tile < T / 64; tile += gridDim.x) {
        const int b = tile / (S / 64), s0 = (tile % (S / 64)) * 64;
#pragma unroll 4
        for (int tt = 0; tt < 8; ++tt) {
            const int sl = wave * 8 + tt, s = s0 + sl; const size_t t = (size_t)b * S + s;
            const int pp0 = (sl & ~15) | perm16(sl & 15);
            const int pp = (((pp0 >> 3) ^ ((c - 8) & 7)) << 3) | (pp0 & 7);
            u32x4 Q[2], KV[2];
#pragma unroll
            for (int ld = 0; ld < 2; ++ld) { Q[ld] = *(const u32x4*)(qraw + t * 1024 + ld * 512 + lane * 8); KV[ld] = *(const u32x4*)(kvraw + t * 1024 + ld * 512 + lane * 8); }
            u32x4 KR = {0u, 0u, 0u, 0u}; f32x4 cs0 = {0.f, 0.f, 0.f, 0.f}, cs1 = cs0, sn0 = cs0, sn1 = cs0;
            if (c >= 8 && c < 12) { KR = *(const u32x4*)(krope + t * 32 + (c - 8) * 8);
                const float* rp = rope + s * 32 + (c & 1) * 8; cs0 = *(const f32x4*)rp; cs1 = *(const f32x4*)(rp + 4); sn0 = *(const f32x4*)(rp + 16); sn1 = *(const f32x4*)(rp + 20); }
            const float cs[8] = {cs0.x, cs0.y, cs0.z, cs0.w, cs1.x, cs1.y, cs1.z, cs1.w}, sn[8] = {sn0.x, sn0.y, sn0.z, sn0.w, sn1.x, sn1.y, sn1.z, sn1.w};
            float kr[8]; unpack8(KR, kr);
            const float krs = ss8f(kr);
#pragma unroll
            for (int ld = 0; ld < 2; ++ld) {
                const int hh = ld * 4 + hl;
                {
                    float x[8]; unpack8(Q[ld], x);
                    float ss = c < 12 ? ss8f(x) : 0.f;
#pragma unroll
                    for (int o = 1; o < 16; o <<= 1) ss += __shfl_xor(ss, o);
                    const float r = rsqrtf(ss * (1.f / 96.f) + EPS); float y[8], z[8];
#pragma unroll
                    for (int j = 0; j < 8; ++j) y[j] = x[j] * r * qg[j];
#pragma unroll
                    for (int j = 0; j < 8; ++j) { const float pb = __shfl_xor(y[j], 2); z[j] = (c < 8) ? y[j] : ((c < 10) ? (y[j] * cs[j] - pb * sn[j]) : (pb * sn[j] + y[j] * cs[j])); }
                    if (c < 12) *(u32x4*)(qm + (t * 8 + hh) * 96 + c * 8) = pack8(z);
                }
                {
                    float x[8]; unpack8(KV[ld], x);
                    float ss = c < 8 ? ss8f(x) : krs;
#pragma unroll
                    for (int o = 1; o < 16; o <<= 1) ss += __shfl_xor(ss, o);
                    const float r = rsqrtf(ss * (1.f / 96.f) + EPS); float y[8], z[8];
#pragma unroll
                    for (int j = 0; j < 8; ++j) y[j] = (c < 8 ? x[j] : kr[j]) * r * kg[j];
#pragma unroll
                    for (int j = 0; j < 8; ++j) { const float pb = __shfl_xor(y[j], 2); z[j] = (c < 8) ? y[j] : ((c < 10) ? (y[j] * cs[j] - pb * sn[j]) : (pb * sn[j] + y[j] * cs[j])); }
                    if (c < 12) *(u32x4*)(km + (((size_t)b * 8 + hh) * S + s) * 96 + c * 8) = pack8(z);
                    if (c >= 8) {
#pragma unroll
                        for (int j = 0; j < 8; ++j) vs[(hh * 64 + (c - 8) * 8 + j) * 72 + pp] = (bf16_t)((j & 1) ? (KV[ld][j >> 1] >> 16) : (KV[ld][j >> 1] & 0xffffu)); }
                }
            }
        }
        __syncthreads();
        {
            const int hh = tid >> 6, d = tid & 63;
            bf16_t* dst = vmt + (((size_t)b * 8 + hh) * 64 + d) * S + s0;
            const LAS bf16_t* src = vs + tid * 72; const int sx = (tid >> 3) & 7;
#pragma unroll
            for (int cc = 0; cc < 8; ++cc) *(u32x4*)(dst + cc * 8) = *(const LAS u32x4*)(src + ((cc ^ sx) << 3));
        }
        __syncthreads();
    }
}

__device__ const unsigned short UNIT_TYPES[256] = {63,127,62,126,61,125,527,591,655,719,783,847,911,975,60,124,59,123,58,122,57,121,56,120,526,590,654,718,782,846,910,974,55,119,54,118,53,117,52,116,51,115,525,589,653,717,781,845,909,973,50,114,49,113,48,112,47,111,524,588,652,716,780,844,908,972,46,110,45,109,44,108,43,107,523,587,651,715,779,843,907,971,42,106,41,105,40,104,39,103,38,102,522,586,650,714,778,842,906,970,37,101,36,100,35,99,34,98,33,97,521,585,649,713,777,841,905,969,32,96,31,95,30,94,520,584,648,712,776,840,904,968,29,93,28,92,27,91,26,90,25,89,519,583,647,711,775,839,903,967,24,88,23,87,22,86,21,85,20,84,518,582,646,710,774,838,902,966,19,83,18,82,17,81,16,80,15,79,517,581,645,709,773,837,901,965,14,78,13,77,12,76,516,580,644,708,772,836,900,964,11,75,10,74,9,73,8,72,515,579,643,707,771,835,899,963,7,71,6,70,5,69,514,578,642,706,770,834,898,962,4,68,3,67,513,577,641,705,769,833,897,961,2,66,1,65,0,64,512,576,640,704,768,832,896,960};
__device__ __forceinline__ int crow(int r, int hi) { return (r & 3) + 8 * (r >> 2) + 4 * hi; }
struct Flash { f32x16 o0, o1; float l; };
__device__ __forceinline__ void flash_init(Flash& st) {
#pragma unroll
    for (int r = 0; r < 16; ++r) { st.o0[r] = 0.f; st.o1[r] = 0.f; }
    st.l = 0.f;
}
constexpr int AL_K64 = 0, AL_V64 = 3 * 8192;
constexpr int AL_K96 = 0, AL_V96 = 3 * 16384;
constexpr int AL_IMP = 49152, AL_SELB = AL_IMP + 64 * 65 * 4, AL_UNI = AL_SELB + 512, AL_TL = AL_UNI + 64, AL_BL = AL_TL + 128, AL_OT = AL_BL + 4 * 132 * 4, AL_END = AL_OT + 8 * 32 * 64 * 4;
static_assert(AL_END <= 139264 && AL_V96 + 3 * 8192 <= 139264, "attention LDS");

template <int RB> struct DmaLane { unsigned g0, g1; };
template <int RB> __device__ __forceinline__ void dma_setup(DmaLane<RB>& L, int w, int lane, unsigned gs) {
    if (RB == 128) { const int r = 8 * w + (lane >> 3), c = (lane & 7) ^ ((r >> 1) & 7); L.g0 = (unsigned)r * gs + c * 16; L.g1 = 0; }
    else {
        { const int r = 8 * w + (lane >> 4); int c = (lane & 15) ^ (r & 15); c = c >= 12 ? c - 4 : c; L.g0 = (unsigned)r * gs + c * 16; }
        { const int r = 8 * w + 4 + (lane >> 4); int c = (lane & 15) ^ (r & 15); c = c >= 12 ? c - 4 : c; L.g1 = (unsigned)r * gs + c * 16; }
    }
}
template <int RB> __device__ __forceinline__ void dma_issue(const unsigned char* tile, const DmaLane<RB>& L, LAS unsigned char* buf, int w) {
    if (RB == 128) __builtin_amdgcn_global_load_lds((const unsigned*)(tile + L.g0), (LAS unsigned*)(buf + w * 1024), 16, 0, 0);
    else { __builtin_amdgcn_global_load_lds((const unsigned*)(tile + L.g0), (LAS unsigned*)(buf + w * 2048), 16, 0, 0);
           __builtin_amdgcn_global_load_lds((const unsigned*)(tile + L.g1), (LAS unsigned*)(buf + w * 2048 + 1024), 16, 0, 0); }
}
template <int DK> __device__ __forceinline__ void frag_offsets(unsigned (&kl)[DK / 16], unsigned (&vl)[4], int r32, int hi) {
#pragma unroll
    for (int s = 0; s < DK / 16; ++s) kl[s] = (DK == 64) ? (unsigned)(r32 * 128 + (((2 * s + hi) ^ ((r32 >> 1) & 7)) << 4)) : (unsigned)(r32 * 256 + (((2 * s + hi) ^ (r32 & 15)) << 4));
#pragma unroll
    for (int s = 0; s < 4; ++s) vl[s] = (unsigned)(r32 * 128 + (((2 * s + hi) ^ ((r32 >> 1) & 7)) << 4));
}

template <int DK, int KP, bool LANEMASK, class F>
__device__ __forceinline__ void tile_compute(Flash& st, const LAS unsigned char* Kt, const LAS unsigned char* Vt, const bf16x8* qf, const f32x16& negm, const unsigned (&kl)[DK / 16], const unsigned (&vl)[4], bool mine, F f) {
    constexpr int NS = DK / 16; constexpr int KH = 32 * KP;
    bf16x8 ka[NS], kh[NS];
#pragma unroll
    for (int s = 0; s < NS; ++s) ka[s] = *(const LAS bf16x8*)(Kt + kl[s]);
#pragma unroll
    for (int s = 0; s < NS; ++s) kh[s] = *(const LAS bf16x8*)(Kt + kl[s] + KH);
    __builtin_amdgcn_sched_barrier(0);
    f32x16 p0, p1;
#pragma unroll
    for (int s = 0; s < NS; ++s) p0 = (s == 0) ? __builtin_amdgcn_mfma_f32_32x32x16_bf16(ka[0], qf[0], negm, 0, 0, 0) : __builtin_amdgcn_mfma_f32_32x32x16_bf16(ka[s], qf[s], p0, 0, 0, 0);
#pragma unroll
    for (int s = 0; s < NS; ++s) p1 = (s == 0) ? __builtin_amdgcn_mfma_f32_32x32x16_bf16(kh[0], qf[0], negm, 0, 0, 0) : __builtin_amdgcn_mfma_f32_32x32x16_bf16(kh[s], qf[s], p1, 0, 0, 0);
    bf16x8 va[4], vh[4];
#pragma unroll
    for (int s = 0; s < 4; ++s) { va[s] = *(const LAS bf16x8*)(Vt + vl[s]); vh[s] = *(const LAS bf16x8*)(Vt + vl[s] + 4096); }
    __builtin_amdgcn_sched_barrier(0);
    float ls = 0.f;
    u32x4 w0, w1, w2, w3;
    {
#pragma unroll
        for (int r = 0; r < 16; ++r) { float x = p0[r]; const bool v = f(r, 0, x); const float e = fexp2(x); p0[r] = v ? e : 0.f; ls += p0[r]; }
        w0.x = cvtpk(p0[0], p0[1]); w0.y = cvtpk(p0[2], p0[3]); w0.z = cvtpk(p0[4], p0[5]); w0.w = cvtpk(p0[6], p0[7]);
        w1.x = cvtpk(p0[8], p0[9]); w1.y = cvtpk(p0[10], p0[11]); w1.z = cvtpk(p0[12], p0[13]); w1.w = cvtpk(p0[14], p0[15]);
        if (LANEMASK) { w0.x = mine ? w0.x : 0u; w0.y = mine ? w0.y : 0u; w0.z = mine ? w0.z : 0u; w0.w = mine ? w0.w : 0u; w1.x = mine ? w1.x : 0u; w1.y = mine ? w1.y : 0u; w1.z = mine ? w1.z : 0u; w1.w = mine ? w1.w : 0u; }
    }
#pragma unroll
    for (int s = 0; s < 2; ++s) {
        const bf16x8 pa = __builtin_bit_cast(bf16x8, s ? w1 : w0);
        st.o0 = __builtin_amdgcn_mfma_f32_32x32x16_bf16(pa, va[s], st.o0, 0, 0, 0);
        st.o1 = __builtin_amdgcn_mfma_f32_32x32x16_bf16(pa, vh[s], st.o1, 0, 0, 0);
    }
    {
#pragma unroll
        for (int r = 0; r < 16; ++r) { float x = p1[r]; const bool v = f(r, 1, x); const float e = fexp2(x); p1[r] = v ? e : 0.f; ls += p1[r]; }
        w2.x = cvtpk(p1[0], p1[1]); w2.y = cvtpk(p1[2], p1[3]); w2.z = cvtpk(p1[4], p1[5]); w2.w = cvtpk(p1[6], p1[7]);
        w3.x = cvtpk(p1[8], p1[9]); w3.y = cvtpk(p1[10], p1[11]); w3.z = cvtpk(p1[12], p1[13]); w3.w = cvtpk(p1[14], p1[15]);
        if (LANEMASK) { w2.x = mine ? w2.x : 0u; w2.y = mine ? w2.y : 0u; w2.z = mine ? w2.z : 0u; w2.w = mine ? w2.w : 0u; w3.x = mine ? w3.x : 0u; w3.y = mine ? w3.y : 0u; w3.z = mine ? w3.z : 0u; w3.w = mine ? w3.w : 0u; }
    }
    if (LANEMASK) ls = mine ? ls : 0.f;
    st.l += ls;
#pragma unroll
    for (int s = 2; s < 4; ++s) {
        const bf16x8 pa = __builtin_bit_cast(bf16x8, (s == 3) ? w3 : w2);
        st.o0 = __builtin_amdgcn_mfma_f32_32x32x16_bf16(pa, va[s], st.o0, 0, 0, 0);
        st.o1 = __builtin_amdgcn_mfma_f32_32x32x16_bf16(pa, vh[s], st.o1, 0, 0, 0);
    }
}
template <int DK, int KP> __device__ __forceinline__ void qk_tile(f32x16& p0, f32x16& p1, const LAS unsigned char* Kt, const bf16x8* qf, const f32x16& negm, const unsigned (&kl)[DK / 16]) {
#pragma unroll
    for (int s = 0; s < DK / 16; ++s) {
        const bf16x8 a0 = *(const LAS bf16x8*)(Kt + kl[s]);
        const bf16x8 a1 = *(const LAS bf16x8*)(Kt + kl[s] + 32 * KP);
        if (s == 0) { p0 = __builtin_amdgcn_mfma_f32_32x32x16_bf16(a0, qf[0], negm, 0, 0, 0); p1 = __builtin_amdgcn_mfma_f32_32x32x16_bf16(a1, qf[0], negm, 0, 0, 0); }
        else { p0 = __builtin_amdgcn_mfma_f32_32x32x16_bf16(a0, qf[s], p0, 0, 0, 0); p1 = __builtin_amdgcn_mfma_f32_32x32x16_bf16(a1, qf[s], p1, 0, 0, 0); }
    }
}
template <bool FIRST> __device__ __forceinline__ void flash_accum(LAS float* otl, const Flash& st, float gate, int hi, int lane) {
    const float lt = st.l + __shfl_xor(st.l, 32);
    const float f = lt > 0.f ? gate * frcp(lt) : 0.f;
#pragma unroll
    for (int r = 0; r < 16; ++r) { const float fr_ = __shfl(f, crow(r, hi));
        if (FIRST) { otl[r * 64 + lane] = fr_ * st.o0[r]; otl[(16 + r) * 64 + lane] = fr_ * st.o1[r]; }
        else { otl[r * 64 + lane] += fr_ * st.o0[r]; otl[(16 + r) * 64 + lane] += fr_ * st.o1[r]; } }
}
template <int NS> __device__ __forceinline__ float qnorm2(const bf16x8* qf) {
    float s = 0.f;
#pragma unroll
    for (int i = 0; i < NS; ++i)
#pragma unroll
        for (int j = 0; j < 8; ++j) { const float x = bf2f((bf16_t)qf[i][j]); s += x * x; }
    return s + __shfl_xor(s, 32);
}
__device__ __forceinline__ float wmax(float v) {
#pragma unroll
    for (int o = 1; o < 64; o <<= 1) v = fmaxf(v, __shfl_xor(v, o));
    return v;
}

template <int RBK, bool HASV, int KOFF, int KSZ, int VOFF, class SrcK, class SrcV, class Comp>
__device__ __forceinline__ void run_tiles(int n, LAS unsigned char* lds, int w, int lane, unsigned gsK, unsigned gsV, SrcK srcK, SrcV srcV, Comp comp) {
    DmaLane<RBK> LK; dma_setup<RBK>(LK, w, lane, gsK);
    DmaLane<128> LV; LV.g0 = 0; LV.g1 = 0; if (HASV) dma_setup<128>(LV, w, lane, gsV);
    const int nl = n - 1, t1 = nl < 1 ? nl : 1;
    dma_issue<RBK>(srcK(0), LK, lds + KOFF, w); if (HASV) dma_issue<128>(srcV(0), LV, lds + VOFF, w);
    dma_issue<RBK>(srcK(t1), LK, lds + KOFF + KSZ, w); if (HASV) dma_issue<128>(srcV(t1), LV, lds + VOFF + 8192, w);
    constexpr int P = (RBK == 128 ? 1 : 2) + (HASV ? 1 : 0);
#define RT_STEP(bi, ii) do { const int i_ = (ii); \
        if (P == 1) asm volatile("s_waitcnt vmcnt(1)" ::: "memory"); else if (P == 2) asm volatile("s_waitcnt vmcnt(2)" ::: "memory"); else asm volatile("s_waitcnt vmcnt(3)" ::: "memory"); \
        __builtin_amdgcn_s_barrier(); asm volatile("" ::: "memory"); \
        { const int tn = (i_ + 2 < nl) ? i_ + 2 : nl; constexpr int b2 = ((bi) + 2) % 3; \
          dma_issue<RBK>(srcK(tn), LK, lds + KOFF + b2 * KSZ, w); if (HASV) dma_issue<128>(srcV(tn), LV, lds + VOFF + b2 * 8192, w); } \
        if (i_ < n) comp(i_, lds + KOFF + (bi) * KSZ, lds + VOFF + (bi) * 8192); } while (0)
    for (int i = 0; i < n; i += 3) { RT_STEP(0, i); RT_STEP(1, i + 1); RT_STEP(2, i + 2); }
#undef RT_STEP
    asm volatile("s_waitcnt vmcnt(0)" ::: "memory");
    __syncthreads();
}

__device__ __forceinline__ void mla_unit(const Params& p, LAS unsigned char* lds, int b, int h, int qb) {
    int tid = threadIdx.x; asm volatile("" : "+v"(tid));
    const int lane = tid & 63, w = __builtin_amdgcn_readfirstlane(tid >> 6), r32 = lane & 31, hi = lane >> 5;
    const bf16_t* qm = (const bf16_t*)((const unsigned char*)p.out + O_QM);
    const unsigned char* km = (const unsigned char*)p.out + O_KM + (((size_t)b * 8 + h) * S) * 192;
    const unsigned char* vmt = (const unsigned char*)p.out + O_VMT + (((size_t)b * 8 + h) * 64) * (size_t)S * 2;
    bf16_t* ocat = (bf16_t*)(p.ws + R_XN);
    const int tq = qb * 256 + 32 * w + r32;
    bf16x8 qf[6];
#pragma unroll
    for (int s = 0; s < 6; ++s) qf[s] = *(const bf16x8*)(qm + (((size_t)b * S + tq) * 8 + h) * 96 + 16 * s + 8 * hi);
    const float kn = 9.797958971f * 1.01f * wmax(fmaxf(fabsf(p.in[14][lane]), lane < 32 ? fabsf(p.in[14][64 + lane]) : 0.f));
    const float mref = sqrtf(qnorm2<6>(qf)) * kn;
    f32x16 negm;
#pragma unroll
    for (int r = 0; r < 16; ++r) negm[r] = -mref;
    Flash st; flash_init(st);
    const int ntile = 4 * qb + 4, dt = 4 * qb + (w >> 1);
#ifdef PROF_SEL
    if (b == 0 && h == 0 && qb == 15 && threadIdx.x == 0) { *PROF_SLOT(36) -= __builtin_amdgcn_s_memtime(); *PROF_SLOT(37) -= __builtin_amdgcn_s_memrealtime(); }
#endif
    unsigned kl[6], vl[4]; frag_offsets<96>(kl, vl, r32, hi);
    run_tiles<192, true, AL_K96, 16384, AL_V96>(ntile, lds, w, lane, 192u, (unsigned)(S * 2),
        [&](int i) { return km + (size_t)i * 64 * 192; }, [&](int i) { return vmt + (size_t)i * 128; },
        [&](int i, LAS unsigned char* kb, LAS unsigned char* vb) {
            if (i <= dt) {
                if (i < dt) tile_compute<96, 256, false>(st, kb, vb, qf, negm, kl, vl, true, [&](int r, int half, float& x) { return true; });
                else { const int kb0 = 64 * i + 4 * hi; tile_compute<96, 256, false>(st, kb, vb, qf, negm, kl, vl, true, [&](int r, int half, float& x) { return (kb0 + 32 * half + (r & 3) + 8 * (r >> 2)) <= tq; }); }
            }
        });
#ifdef PROF_SEL
    if (b == 0 && h == 0 && qb == 15 && threadIdx.x == 0) { *PROF_SLOT(36) += __builtin_amdgcn_s_memtime(); *PROF_SLOT(37) += __builtin_amdgcn_s_memrealtime(); }
#endif
    {
        const float lt = st.l + __shfl_xor(st.l, 32); const float f = lt > 0.f ? frcp(lt) : 0.f;
#pragma unroll
        for (int r = 0; r < 16; ++r) { const float fr_ = __shfl(f, crow(r, hi)); const size_t ro = ((size_t)b * S + qb * 256 + 32 * w + crow(r, hi)) * 1024 + 512 + h * 64 + r32; ocat[ro] = f2bf(st.o0[r] * fr_); ocat[ro + 32] = f2bf(st.o1[r] * fr_); }
    }
}

__device__ __forceinline__ void nsa_unit(const Params& p, LAS unsigned char* lds, int b, int g, int jt) {
    int tid = threadIdx.x; asm volatile("" : "+v"(tid));
    const int lane = tid & 63, w = __builtin_amdgcn_readfirstlane(tid >> 6), r32 = lane & 31, hi = lane >> 5;
    const int rh = w >> 1, qh = w & 1, h = 4 * g + rh, q0 = 64 * jt, ql = 32 * qh + r32, tq = q0 + ql;
    const unsigned char* xa = p.ws + R_XA;
    const bf16_t* qn = (const bf16_t*)(xa + A_QN);
    const size_t bg = (size_t)b * 2 + g;
    const unsigned char* ksn = xa + A_KSN + bg * S * 128; const unsigned char* kwn = xa + A_KWN + bg * S * 128;
    const unsigned char* vst = xa + A_VST + bg * 64 * (size_t)S * 2; const unsigned char* vwt = xa + A_VWT + bg * 64 * (size_t)S * 2;
    const unsigned char* kc = p.ws + SM_KC + bg * 256 * 128; const unsigned char* vct = p.ws + SM_VCT + bg * 64 * 512;
    const float* gates = (const float*)(xa + A_GATES) + ((size_t)b * S + tq) * 24 + h * 3;
    bf16_t* ocat = (bf16_t*)(p.ws + R_XN);
    LAS float* imp = (LAS float*)(lds + AL_IMP); LAS unsigned char* selb = lds + AL_SELB; LAS unsigned* uni = (LAS unsigned*)(lds + AL_UNI); LAS unsigned char* tl = lds + AL_TL; LAS float* bls = (LAS float*)(lds + AL_BL);
    const float* blg = (const float*)(p.ws + SM_BL) + h * 132;
    const float cb = blg[128];
    const float bmax = wmax(fmaxf(fmaxf(blg[lane], blg[64 + lane]), cb));
    if (qh == 0) { bls[rh * 132 + lane] = blg[lane] - cb; bls[rh * 132 + 64 + lane] = blg[64 + lane] - cb; if (lane == 0) bls[rh * 132 + 128] = 0.f; }
    const LAS float* blh = bls + rh * 132;
    bf16x8 qf[4];
#pragma unroll
    for (int s = 0; s < 4; ++s) qf[s] = *(const bf16x8*)(qn + (((size_t)b * S + tq) * 8 + h) * 64 + 16 * s + 8 * hi);
    const float kn = 8.f * 1.01f * wmax(fmaxf(fmaxf(fabsf(p.in[5][lane]), fabsf(p.in[5][64 + lane])), fabsf(p.in[5][128 + lane])));
    const float mref = sqrtf(qnorm2<4>(qf)) * kn + bmax;
    f32x16 negm;
#pragma unroll
    for (int r = 0; r < 16; ++r) negm[r] = cb - mref;
    float g0 = gates[0], g1 = gates[1], g2 = gates[2];
    if (p.dbg_branch >= 0) { g0 = p.dbg_branch == 0 ? 1.f : 0.f; g1 = p.dbg_branch == 1 ? 1.f : 0.f; g2 = p.dbg_branch == 2 ? 1.f : 0.f; }
    LAS float* otl = (LAS float*)(lds + AL_OT) + w * 2048;
#ifdef PROF_SEL
    if (b == 0 && g == 0 && jt == 63 && threadIdx.x == 0) *PROF_SLOT(48) -= __builtin_amdgcn_s_memtime();
#endif
    const int nvmax = (q0 + 63 - 31) / 16 + 1, ntc = (nvmax + 63) / 64;
    Flash st; flash_init(st);
    unsigned kl[4], vl[4]; frag_offsets<64>(kl, vl, r32, hi);
    run_tiles<128, true, AL_K64, 8192, AL_V64>(ntc, lds, w, lane, 128u, 512u,
        [&](int i) { return kc + (size_t)i * 64 * 128; }, [&](int i) { return vct + (size_t)i * 128; },
        [&](int i, LAS unsigned char* kb, LAS unsigned char* vb) {
            const int cb0 = 64 * i + 4 * hi;
            if (q0 + 32 * qh - (16 * (64 * i + 63) + 31) >= 128) tile_compute<64, 128, false>(st, kb, vb, qf, negm, kl, vl, true, [&](int r, int half, float& x) { return true; });
            else tile_compute<64, 128, false>(st, kb, vb, qf, negm, kl, vl, true, [&](int r, int half, float& x) {
                const int c = cb0 + 32 * half + (r & 3) + 8 * (r >> 2); const int dist = tq - 16 * c - 31; x += blh[dist < 0 ? 0 : (dist > 128 ? 128 : dist)]; return dist >= 0; });
        });
    flash_accum<true>(otl, st, g0, hi, lane);
    unsigned mlo, mhi;
    int nsel;
    if (jt < 16) { const unsigned long long mk = (1ull << (jt + 1)) - 1ull; mlo = (unsigned)mk; mhi = (unsigned)(mk >> 32); nsel = jt + 1; if (tid <= jt) tl[tid] = (unsigned char)tid; }
    else {
        for (int i = tid; i < 64 * 65; i += 512) imp[i] = 0.f;
        const float lt = st.l + __shfl_xor(st.l, 32); const float linv = lt > 0.f ? frcp(lt) : 0.f;
        float xlast = 0.f;
        run_tiles<128, false, AL_K64, 8192, AL_V64>(ntc, lds, w, lane, 128u, 0u,
            [&](int i) { return kc + (size_t)i * 64 * 128; }, [&](int i) { return kc; },
            [&](int i, LAS unsigned char* kb, LAS unsigned char* vb) {
                f32x16 p0, p1; qk_tile<64, 128>(p0, p1, kb, qf, negm, kl);
                const int cb0 = 64 * i + 4 * hi;
                float sm[2][4], cr[2][4];
#pragma unroll
                for (int half = 0; half < 2; ++half)
#pragma unroll
                    for (int a = 0; a < 4; ++a) {
                        float s4 = 0.f, last = 0.f;
#pragma unroll
                        for (int k = 0; k < 4; ++k) {
                            const int r = 4 * a + k; const int c = cb0 + 32 * half + k + 8 * a; const int dist = tq - 16 * c - 31;
                            const float sc = (half ? p1[r] : p0[r]) + blh[dist < 0 ? 0 : (dist > 128 ? 128 : dist)];
                            const float pv = dist >= 0 ? fexp2(sc) * linv : 0.f;
                            s4 += pv; last = pv;
                        }
                        sm[half][a] = s4; cr[half][a] = last;
                    }
                float tot[2][4];
#pragma unroll
                for (int half = 0; half < 2; ++half)
#pragma unroll
                    for (int a = 0; a < 4; ++a) {
                        const float xs_ = __shfl_xor(cr[half][a], 32);
                        const float xp_ = (a > 0) ? __shfl_xor(cr[half][a > 0 ? a - 1 : 0], 32) : (half ? __shfl_xor(cr[0][3], 32) : xlast);
                        tot[half][a] = sm[half][a] + (hi ? xs_ : xp_);
                    }
                xlast = __shfl_xor(cr[1][3], 32);
                for (int rr = 0; rr < 4; ++rr) {
                    if (rh == rr) {
#pragma unroll
                        for (int half = 0; half < 2; ++half)
#pragma unroll
                            for (int a = 0; a < 4; ++a) { const int j = 16 * i + 8 * half + 2 * a + hi; imp[ql * 65 + j] += tot[half][a]; }
                    }
                    __syncthreads();
                }
            });
        if (p.dbg_branch == 1) { for (int i = tid; i < 4096; i += 512) ((float*)(p.ws + R_H))[((size_t)g * S + q0 + (i >> 6)) * 64 + (i & 63)] = imp[(i >> 6) * 65 + (i & 63)]; }
        {
            const int q = tid >> 3, jg = tid & 7;
            float vj[8]; int rk[8];
#pragma unroll
            for (int jj = 0; jj < 8; ++jj) { const int j = jg * 8 + jj; const float x = imp[q * 65 + j]; vj[jj] = (j > jt) ? -1.f : ((j == jt || j == 0) ? 1e9f : x); rk[jj] = 0; }
#pragma unroll 4
            for (int i = 0; i < 64; ++i) {
                const float xi = imp[q * 65 + i]; const float vi = (i > jt) ? -1.f : ((i == jt || i == 0) ? 1e9f : xi);
#pragma unroll
                for (int jj = 0; jj < 8; ++jj) rk[jj] += (vi > vj[jj] || (vi == vj[jj] && i < jg * 8 + jj)) ? 1 : 0;
            }
            unsigned byte = 0;
#pragma unroll
            for (int jj = 0; jj < 8; ++jj) if (jg * 8 + jj <= jt && rk[jj] < 16) byte |= 1u << jj;
            selb[q * 8 + jg] = (unsigned char)byte;
        }
        __syncthreads();
        if (w == 0) {
            unsigned a = ((const LAS unsigned*)selb)[lane * 2], c = ((const LAS unsigned*)selb)[lane * 2 + 1];
#pragma unroll
            for (int o = 1; o < 64; o <<= 1) { a |= __shfl_xor(a, o); c |= __shfl_xor(c, o); }
            const unsigned long long um = ((unsigned long long)c << 32) | a;
            if ((um >> lane) & 1ull) tl[__builtin_popcountll(um & ((1ull << lane) - 1ull))] = (unsigned char)lane;
            if (lane == 0) uni[0] = (unsigned)__builtin_popcountll(um);
        }
        __syncthreads();
        mlo = ((const LAS unsigned*)selb)[ql * 2]; mhi = ((const LAS unsigned*)selb)[ql * 2 + 1];
        nsel = (int)uni[0];
    }
    if (p.dbg_branch == 1 && rh == 0) { if (hi == 0) ((unsigned long long*)(p.ws + R_H + 4 * 1048576))[(size_t)g * S + tq] = ((unsigned long long)mhi << 32) | mlo; }
    __syncthreads();
    {
        const unsigned long long mymask = ((unsigned long long)mhi << 32) | mlo;
        nsel = __builtin_amdgcn_readfirstlane(nsel);
        const int mytl = (int)tl[lane];
        flash_init(st);
        run_tiles<128, true, AL_K64, 8192, AL_V64>(nsel, lds, w, lane, 128u, (unsigned)(S * 2),
            [&](int i) { return ksn + (size_t)__builtin_amdgcn_readlane(mytl, i) * 64 * 128; }, [&](int i) { return vst + (size_t)__builtin_amdgcn_readlane(mytl, i) * 128; },
            [&](int i, LAS unsigned char* kb, LAS unsigned char* vb) {
                const int j = __builtin_amdgcn_readlane(mytl, i);
                const bool mine = (mymask >> j) & 1ull;
                if (q0 + 32 * qh - (64 * j + 63) >= 128) tile_compute<64, 128, true>(st, kb, vb, qf, negm, kl, vl, mine, [&](int r, int half, float& x) { return true; });
                else { const int kb0 = 64 * j + 4 * hi;
                    tile_compute<64, 128, true>(st, kb, vb, qf, negm, kl, vl, mine, [&](int r, int half, float& x) { const int dist = tq - (kb0 + 32 * half + (r & 3) + 8 * (r >> 2)); x += blh[dist < 0 ? 0 : (dist > 128 ? 128 : dist)]; return dist >= 0; }); }
            });
        flash_accum<false>(otl, st, g1, hi, lane);
    }
    {
        const int j0 = jt >= 8 ? jt - 8 : 0, nw = jt - j0 + 1;
        flash_init(st);
        run_tiles<128, true, AL_K64, 8192, AL_V64>(nw, lds, w, lane, 128u, (unsigned)(S * 2),
            [&](int i) { return kwn + (size_t)(j0 + i) * 64 * 128; }, [&](int i) { return vwt + (size_t)(j0 + i) * 128; },
            [&](int i, LAS unsigned char* kb, LAS unsigned char* vb) {
                const int j = j0 + i, kb0 = 64 * j + 4 * hi;
                if (q0 + 32 * qh - (64 * j + 63) >= 128 && q0 + 32 * qh + 31 - 64 * j < 512) tile_compute<64, 128, false>(st, kb, vb, qf, negm, kl, vl, true, [&](int r, int half, float& x) { return true; });
                else tile_compute<64, 128, false>(st, kb, vb, qf, negm, kl, vl, true, [&](int r, int half, float& x) { const int dist = tq - (kb0 + 32 * half + (r & 3) + 8 * (r >> 2)); x += blh[dist < 0 ? 0 : (dist > 128 ? 128 : dist)]; return dist >= 0 && dist < 512; });
            });
        flash_accum<false>(otl, st, g2, hi, lane);
    }
#pragma unroll
    for (int r = 0; r < 16; ++r) { const size_t ro = ((size_t)b * S + q0 + 32 * qh + crow(r, hi)) * 1024 + h * 64 + r32; ocat[ro] = f2bf(otl[r * 64 + lane]); ocat[ro + 32] = f2bf(otl[(16 + r) * 64 + lane]); }
    __syncthreads();
#ifdef PROF_SEL
    if (b == 0 && g == 0 && jt == 63 && threadIdx.x == 0) *PROF_SLOT(48) += __builtin_amdgcn_s_memtime();
#endif
}

__device__ __forceinline__ void phase_p4(const Params& p, LAS unsigned char* lds) {
    const int G = gridDim.x, c = blockIdx.x, nunits = 256 * NB;
#if NB == 8
    if (G == 256) {
        const int b = c & 7, idx = c >> 3, pi = idx & 7, hq = idx >> 3;
#pragma unroll 1
        for (int u = 0; u < 8; ++u) {
            if (u < 4) { const int ix = (u >> 1) ? ((idx + 16) & 31) : idx;
                nsa_unit(p, lds, b, u >> 1, (u & 1) ? ix : 63 - ix); }
            else mla_unit(p, lds, b, ((u - 4) >> 1) * 4 + hq, (u & 1) ? pi : 15 - pi);
        }
        return;
    }
#endif
    for (int j = 0;; ++j) {
        const int k = j * G + ((j & 1) ? (G - 1 - c) : c);
        if (j * G >= nunits) break;
        if (k >= nunits) continue;
        const int ty = UNIT_TYPES[k / NB], b = k % NB, kind = ty >> 9, a = (ty >> 6) & 7, cc = ty & 63;
        if (kind == 0) nsa_unit(p, lds, b, a, cc); else mla_unit(p, lds, b, a, cc);
    }
}
__device__ __forceinline__ void phase_norm(const float* x, const float* g, bf16_t* xn) {
    const int tid_ = ltid(); const int lane = tid_ & 63, gw = blockIdx.x * 8 + (tid_ >> 6), NGW = gridDim.x * 8;
    for (int m = gw; m < T; m += NGW) rms_row_to_bf16(x + (size_t)m * D, g, xn + (size_t)m * D, lane);
}
__device__ __forceinline__ void phase_conv(const Params& p) {
    const int tid = ltid(), lane = tid & 63, gw = blockIdx.x * 8 + (tid >> 6), NGW = gridDim.x * 8;
    const bf16_t* hh = (const bf16_t*)(p.ws + R_H); bf16_t* v = (bf16_t*)(p.ws + R_XA); const float* cw = p.in[22];
    constexpr int RUN = 16;
    float w0[2][8], w1[2][8], w2[2][8];
#pragma unroll
    for (int j = 0; j < 2; ++j) { const int d = 8 * lane + 512 * j; load8f(cw + d, w0[j], 1.f); load8f(cw + 1024 + d, w1[j], 1.f); load8f(cw + 2048 + d, w2[j], 1.f); }
    for (int run = gw; run < T / RUN; run += NGW) {
        const int m0 = run * RUN, s0 = m0 & (S - 1);
        float pm2[2][8], pm1[2][8];
#pragma unroll
        for (int j = 0; j < 2; ++j) { const int d = 8 * lane + 512 * j;
#pragma unroll
            for (int q = 0; q < 2; ++q) {
                float (&dst)[8] = q ? pm1[j] : pm2[j];
                if (s0 - 2 + q >= 0) { const bf16_t* r = hh + (size_t)(m0 - 2 + q) * 3072; float c[8], u[8]; unpack8(*(const u32x4*)(r + 1024 + d), c); unpack8(*(const u32x4*)(r + 2048 + d), u);
#pragma unroll
                    for (int i = 0; i < 8; ++i) dst[i] = c[i] * u[i]; }
                else {
#pragma unroll
                    for (int i = 0; i < 8; ++i) dst[i] = 0.f; }
            } }
#pragma unroll 4
        for (int rr = 0; rr < RUN; ++rr) {
            const int m = m0 + rr; const bf16_t* r = hh + (size_t)m * 3072;
#pragma unroll
            for (int j = 0; j < 2; ++j) { const int d = 8 * lane + 512 * j;
                float b[8], c[8], u[8], y[8]; unpack8(*(const u32x4*)(r + d), b); unpack8(*(const u32x4*)(r + 1024 + d), c); unpack8(*(const u32x4*)(r + 2048 + d), u);
#pragma unroll
                for (int i = 0; i < 8; ++i) { const float cu = c[i] * u[i]; y[i] = b[i] * (w0[j][i] * pm2[j][i] + w1[j][i] * pm1[j][i] + w2[j][i] * cu); pm2[j][i] = pm1[j][i]; pm1[j][i] = cu; }
                *(u32x4*)(v + (size_t)m * 1024 + d) = pack8(y); }
        }
    }
}
__device__ __forceinline__ void phase_norm_router(const Params& p, LAS unsigned char* lds) {
    const int tid = ltid(), lane = tid & 63, wave = tid >> 6, gw = blockIdx.x * 8 + wave, NGW = gridDim.x * 8;
    const bf16_t* x3 = (const bf16_t*)(p.ws + R_XN); const float* g = p.in[24]; bf16_t* xn = (bf16_t*)(p.ws + R_XA);
    LAS float* wr = (LAS float*)lds;
    LAS int* lcnt = (LAS int*)(lds + 40960); LAS int* gb = lcnt + 8;
    int* te = (int*)(p.ws + SM_TE); float* tw = (float*)(p.ws + SM_TW); int* rank = (int*)(p.ws + SM_RANK); int* cnt = (int*)(p.ws + SM_CTL);
    for (int i = tid; i < 8192; i += 512) { const int dd = i >> 3; wr[dd * 8 + (dd >> 2) * 4 + (i & 7)] = p.in[25][i]; }
    if (tid < 8) lcnt[tid] = 0;
    __syncthreads();
    for (int m = gw; m < T; m += NGW) {
        const u32x2* xr = (const u32x2*)(x3 + (size_t)m * D) + lane; const f32x4* gr = (const f32x4*)g + lane;
        f32x4 v[4]; float s = 0.f;
#pragma unroll
        for (int j = 0; j < 4; ++j) { const u32x2 t = xr[64 * j]; v[j] = (f32x4){bflo(t.x), bfhi(t.x), bflo(t.y), bfhi(t.y)}; s += (v[j].x * v[j].x + v[j].y * v[j].y) + (v[j].z * v[j].z + v[j].w * v[j].w); }
        const float r = rsqrtf(wsum(s) * (1.f / 1024.f) + EPS);
        float lg[8];
#pragma unroll
        for (int e = 0; e < 8; ++e) lg[e] = 0.f;
        u32x2* o8 = (u32x2*)(xn + (size_t)m * D) + lane;
#pragma unroll
        for (int j = 0; j < 4; ++j) { const f32x4 gg = gr[64 * j]; const f32x4 y = {v[j].x * r * gg.x, v[j].y * r * gg.y, v[j].z * r * gg.z, v[j].w * r * gg.w};
            u32x2 w; w.x = cvtpk(y.x, y.y); w.y = cvtpk(y.z, y.w); o8[64 * j] = w;
#pragma unroll
            for (int i = 0; i < 4; ++i) { const int d = 4 * lane + 256 * j + i; const f32x4 w0 = *(const LAS f32x4*)(wr + d * 8 + (d >> 2) * 4), w1 = *(const LAS f32x4*)(wr + d * 8 + (d >> 2) * 4 + 4);
                lg[0] += y[i] * w0.x; lg[1] += y[i] * w0.y; lg[2] += y[i] * w0.z; lg[3] += y[i] * w0.w; lg[4] += y[i] * w1.x; lg[5] += y[i] * w1.y; lg[6] += y[i] * w1.z; lg[7] += y[i] * w1.w; } }
#pragma unroll
        for (int e = 0; e < 8; ++e) lg[e] = wsum(lg[e]) + p.in[26][e];
        int e1 = 0; float l1 = lg[0];
#pragma unroll
        for (int e = 1; e < 8; ++e) if (lg[e] > l1) { l1 = lg[e]; e1 = e; }
        int e2 = -1; float l2 = -3e38f;
#pragma unroll
        for (int e = 0; e < 8; ++e) if (e != e1 && lg[e] > l2) { l2 = lg[e]; e2 = e; }
        if (lane == 0) {
            const float w1 = 1.f / (1.f + __expf(l2 - l1));
            te[m * 2] = e1; te[m * 2 + 1] = e2; tw[m * 2] = w1; tw[m * 2 + 1] = 1.f - w1;
            rank[m * 2] = __hip_atomic_fetch_add(&lcnt[e1], 1, __ATOMIC_RELAXED, __HIP_MEMORY_SCOPE_WORKGROUP); rank[m * 2 + 1] = __hip_atomic_fetch_add(&lcnt[e2], 1, __ATOMIC_RELAXED, __HIP_MEMORY_SCOPE_WORKGROUP);
        }
    }
    __syncthreads();
    if (tid < 8) gb[tid] = atomicAdd(&cnt[tid], lcnt[tid]);
    __syncthreads();
    for (int m = gw; m < T; m += NGW) if (lane < 2) rank[m * 2 + lane] += gb[te[m * 2 + lane]];
}
__device__ __forceinline__ void phase_moe_gather(const Params& p) {
    const int tid = ltid(), lane = tid & 63, gw = blockIdx.x * 8 + (tid >> 6), NGW = gridDim.x * 8;
    const int* cnt = (const int*)(p.ws + SM_CTL); const int* te = (const int*)(p.ws + SM_TE); const float* tw = (const float*)(p.ws + SM_TW); const int* rank = (const int*)(p.ws + SM_RANK);
    int* pos = (int*)(p.ws + SM_POS); float* roww = (float*)(p.ws + SM_ROWW); int* tile_e = (int*)(p.ws + SM_TILEE);
    int* rowtok = (int*)(p.ws + SM_ROWTOK);
    int off[9]; off[0] = 0;
#pragma unroll
    for (int e = 0; e < 8; ++e) off[e + 1] = off[e] + ((cnt[e] + 255) & ~255);
    if (blockIdx.x == 0) {
        for (int i = tid; i < ROWS_MAX / 256; i += 512) { int e = -1;
#pragma unroll
            for (int k = 0; k < 8; ++k) if (i * 256 >= off[k] && i * 256 < off[k + 1]) e = k;
            tile_e[i] = e < 0 ? 0 : e; }
        if (tid == 0) ((int*)(p.ws + SM_CTL))[8] = off[8];
    }
    if (blockIdx.x < 8 && tid < 256) {
#pragma unroll
        for (int e = 0; e < 8; ++e) if (e == (int)blockIdx.x) { const int c = cnt[e]; if (c + tid < off[e + 1] - off[e]) { roww[off[e] + c + tid] = 0.f; rowtok[off[e] + c + tid] = -1; } }
    }
    for (int pi0 = gw * 4; pi0 < 2 * T; pi0 += NGW * 4) {
        int r[4]; float w[4];
#pragma unroll
        for (int q = 0; q < 4; ++q) { const int e = te[pi0 + q]; int o = 0;
#pragma unroll
            for (int k = 0; k < 8; ++k) if (k == e) o = off[k];
            r[q] = o + rank[pi0 + q]; w[q] = tw[pi0 + q]; }
#pragma unroll
        for (int q = 0; q < 4; ++q) if (lane == q) { pos[pi0 + q] = r[q]; roww[r[q]] = w[q]; rowtok[r[q]] = (pi0 + q) >> 1; }
    }
}
__device__ __forceinline__ void phase_moe_combine(const Params& p) {
    const int tid_ = ltid(); const int lane = tid_ & 63, gw = blockIdx.x * 8 + (tid_ >> 6), NGW = gridDim.x * 8;
    const int* pos = (const int*)(p.ws + SM_POS); const bf16_t* ym = (const bf16_t*)(p.ws + R_XA); const bf16_t* x3 = (const bf16_t*)(p.ws + R_XN);
    for (int m0 = gw * 2; m0 < T; m0 += NGW * 2) {
        int ps[4];
#pragma unroll
        for (int q = 0; q < 4; ++q) ps[q] = pos[m0 * 2 + q];
        f32x4 x[2][4]; u32x2 ya[2][4], yc[2][4];
#pragma unroll
        for (int q = 0; q < 2; ++q)
#pragma unroll
            for (int j = 0; j < 4; ++j) { const int d = 4 * lane + 256 * j;
                { const u32x2 t = *(const u32x2*)(x3 + (size_t)(m0 + q) * D + d); x[q][j] = (f32x4){bflo(t.x), bfhi(t.x), bflo(t.y), bfhi(t.y)}; } ya[q][j] = *(const u32x2*)(ym + (size_t)ps[2 * q] * D + d); yc[q][j] = *(const u32x2*)(ym + (size_t)ps[2 * q + 1] * D + d); }
#pragma unroll
        for (int q = 0; q < 2; ++q)
#pragma unroll
            for (int j = 0; j < 4; ++j) { const int d = 4 * lane + 256 * j; f32x4 o = x[q][j]; const u32x2 a = ya[q][j], c = yc[q][j];
                o.x += bflo(a.x) + bflo(c.x); o.y += bfhi(a.x) + bfhi(c.x); o.z += bflo(a.y) + bflo(c.y); o.w += bfhi(a.y) + bfhi(c.y);
                *(f32x4*)(p.out + (size_t)(m0 + q) * D + d) = o; }
    }
}

#define XB_TMO      128
#define XB_XCNT(j)  (256  + 64 * (j))
#define XB_XSUB(j)  (1280 + 64 * (j))
#define XB_XGEN(j)  (2304 + 64 * (j))
#define XB_TOP      3328
#define XB_TOPGEN   3392
#define XCD_BAR_WORDS 3456
#define XB_SPIN_CAP (1u << 18)

__device__ __forceinline__ unsigned xb_ld(unsigned* p)              { return __hip_atomic_load(p, __ATOMIC_RELAXED, __HIP_MEMORY_SCOPE_AGENT); }
__device__ __forceinline__ unsigned xb_add(unsigned* p, unsigned v) { return __hip_atomic_fetch_add(p, v, __ATOMIC_RELAXED, __HIP_MEMORY_SCOPE_AGENT); }
__device__ __forceinline__ unsigned xb_xcc_id() { return (unsigned)__builtin_amdgcn_s_getreg((3 << 11) | 20) & 0xFu; }
#define XB_SPIN(cond, bar) do { unsigned _sp = 0; while (cond) { __builtin_amdgcn_s_sleep(1); \
    if ((++_sp & 255u) == 0u) { if (xb_ld(&(bar)[XB_TMO])) break; if (_sp > XB_SPIN_CAP) { atomicAdd(&(bar)[XB_TMO], 1u); break; } } } } while (0)

struct XcdBarrier {
    unsigned* bar; unsigned x;
    volatile LAS unsigned* st;
};

__device__ __forceinline__ XcdBarrier xcd_barrier_post(unsigned* bar, volatile LAS unsigned* st) {
    XcdBarrier b; b.bar = bar; b.x = xb_xcc_id(); b.st = st;
    if (threadIdx.x == 0) (void)xb_add(&bar[XB_XCNT(b.x)], 1u);
    return b;
}
__device__ __forceinline__ void xcd_barrier_complete(unsigned* bar, unsigned x, unsigned& nloc, unsigned& nx) {
    const unsigned G = gridDim.x * gridDim.y * gridDim.z;
    unsigned sum, cnt, mine, sp = 0u;
    for (;;) {
        sum = 0u; cnt = 0u; mine = 0u;
#pragma unroll
        for (unsigned j = 0; j < 16; ++j) { const unsigned c = xb_ld(&bar[XB_XCNT(j)]); sum += c; cnt += (c > 0u) ? 1u : 0u; mine = (j == x) ? c : mine; }
        if (sum == G) break;
        __builtin_amdgcn_s_sleep(1);
        if ((++sp & 255u) == 0u) { if (xb_ld(&bar[XB_TMO])) break; if (sp > XB_SPIN_CAP) { atomicAdd(&bar[XB_TMO], 1u); break; } }
    }
    nloc = mine > 0u ? mine : 1u; nx = cnt > 0u ? cnt : 1u;
}

__device__ __forceinline__ void xcd_barrier(const XcdBarrier& b) {
    asm volatile("s_waitcnt vmcnt(0)" ::: "memory");
    __syncthreads();
    if (threadIdx.x == 0) {
        unsigned* bar = b.bar;
        __builtin_amdgcn_s_waitcnt(0);
        unsigned nloc = b.st[0], nx = b.st[1];
        if (nloc == 0u) { xcd_barrier_complete(bar, b.x, nloc, nx); b.st[0] = nloc; b.st[1] = nx; }
        const unsigned old = xb_add(&bar[XB_XSUB(b.x)], 1u);
        const unsigned gen = old / nloc;
        if (old + 1u == (gen + 1u) * nloc) {
            __builtin_amdgcn_fence(__ATOMIC_RELEASE, "agent");
            asm volatile("s_waitcnt vmcnt(0)" ::: "memory");
            const unsigned og = xb_add(&bar[XB_TOP], 1u);
            const unsigned tg = og / nx;
            if (og + 1u == (tg + 1u) * nx) xb_add(&bar[XB_TOPGEN], 1u);
            else XB_SPIN(xb_ld(&bar[XB_TOPGEN]) == tg, bar);
            __builtin_amdgcn_fence(__ATOMIC_ACQUIRE, "agent");
            xb_add(&bar[XB_XGEN(b.x)], 1u);
            asm volatile("s_waitcnt vmcnt(0)" ::: "memory");
        } else {
            XB_SPIN(xb_ld(&bar[XB_XGEN(b.x)]) == gen, bar);
            __builtin_amdgcn_fence(__ATOMIC_ACQUIRE, "agent");
            asm volatile("s_waitcnt vmcnt(0)" ::: "memory");
        }
    }
    __syncthreads();
}


__global__ void __launch_bounds__(512) mega_fwd(Params p) {
    extern __shared__ __attribute__((aligned(16))) unsigned char lds_raw[];
    LAS unsigned char* lds = (LAS unsigned char*)lds_raw;
    cg::grid_group grid = cg::this_grid();
    volatile LAS unsigned* bst = (volatile LAS unsigned*)(lds + 140032);
    if (threadIdx.x == 0) { bst[0] = 0u; bst[1] = 0u; const unsigned long long ba = (unsigned long long)(p.ws + SM_BAR); bst[2] = (unsigned)ba; bst[3] = (unsigned)(ba >> 32); }
    __syncthreads();
    (void)xcd_barrier_post((unsigned*)(p.ws + SM_BAR), bst);
#ifdef PROF_SEL
#define PSTAMP(k) do { if (blockIdx.x == 0 && threadIdx.x == 0) { volatile LAS unsigned* pl_ = (volatile LAS unsigned*)(lds + 140032 + 16); const unsigned long long now_ = __builtin_amdgcn_s_memrealtime(); const unsigned long long last_ = ((unsigned long long)pl_[1] << 32) | pl_[0]; *PROF_SLOT(k) += now_ - last_; pl_[0] = (unsigned)now_; pl_[1] = (unsigned)(now_ >> 32); } } while (0)
#else
#define PSTAMP(k)
#endif
#define GSYNC() do { XcdBarrier xb_; volatile LAS unsigned* st_ = (volatile LAS unsigned*)(lds + 140032); xb_.bar = (unsigned*)(((unsigned long long)st_[3] << 32) | st_[2]); xb_.x = xb_xcc_id(); xb_.st = st_; xcd_barrier(xb_); } while (0)
#ifdef PROF_SEL
    if (threadIdx.x == 0) { volatile LAS unsigned* pl_ = (volatile LAS unsigned*)(lds + 140032 + 16); const unsigned long long now_ = __builtin_amdgcn_s_memrealtime(); pl_[0] = (unsigned)now_; pl_[1] = (unsigned)(now_ >> 32); }
#endif
    const int G = gridDim.x, c = blockIdx.x;
#define LP() bf16_t* W = (bf16_t*)p.ws; bf16_t* xn = (bf16_t*)(p.ws + R_XN); float* x1 = (float*)(p.ws + R_XA); pg8::StaticOrder SO; (void)W; (void)xn; (void)x1; (void)SO
#ifndef PHMASK
#define PHMASK 0xFFFFFFFFu
#endif
#ifndef REPEAT_MASK
#define REPEAT_MASK 0u
#endif
#define PH(k) if (((PHMASK >> (k)) & 1u) && (k) >= p.ph_lo && (k) <= p.ph_hi)
#define RPT(k) if ((REPEAT_MASK >> (k)) & 1u)
    PH(0) { LP(); phase_p0(p, lds); }
    GSYNC(); PSTAMP(0);
    if (p.ph_lo == -12345) grid.sync();
    RPT(0) { { LP(); phase_p0(p, lds); } GSYNC(); }
    PH(1) { LP();
        pg8::Gemm g{xn, W + W_IN_E / 2, T, 1792, 1024, 1024, nullptr, 0, nullptr}; SO.init(T, 1792, G, c);
        pg8::EpiBf16<0> E{(bf16_t*)(p.ws + R_H), 1792, nullptr, nullptr};
        pg8::gemm_phase<pg8::EpiBf16<0>, true>(lds, g, SO, E);
    }
    GSYNC(); PSTAMP(1);
    PH(2) { LP(); phase_p2(p, lds); }
    GSYNC(); PSTAMP(2);
    RPT(2) { { LP(); phase_p2(p, lds); } GSYNC(); }
    PH(3) { LP();
        const int nCu = 2 * (NB * 512 / 256) * 2, Gc = (nCu < G / 2) ? nCu : 0;
        if (Gc == 0 || c < Gc) {
            for (int kv = 0; kv < 2; ++kv) {
                pg8::Gemm g{(const bf16_t*)(p.ws + R_XA + (kv ? A_VCIN : A_KCIN)), W + W_CW1 / 2 + (size_t)kv * 512 * 1024, NB * 512, 512, 1024, 1024, nullptr, 0, nullptr};
                if (Gc) SO.init(NB * 512, 512, Gc / 2, c - kv * (Gc / 2)); else SO.init(NB * 512, 512, G, c);
                pg8::EpiBf16<0> E{(bf16_t*)(p.ws + SM_HID) + (size_t)kv * NB * 512 * 512, 512, nullptr, nullptr};
                if (Gc == 0 || (c / (Gc / 2)) == kv) pg8::gemm_phase<pg8::EpiBf16<0>, true>(lds, g, SO, E);
            }
        }
        if (Gc == 0 || c >= Gc) {
            {
                pg8::Gemm g{(const bf16_t*)(p.ws + R_XA + A_CQN), W + W_UQ / 2, T, 1024, 256, 256, nullptr, 0, nullptr}; SO.init(T, 1024, G - Gc, c - Gc);
                pg8::EpiBf16<0> E{(bf16_t*)(p.ws + R_H), 1024, nullptr, nullptr};
                pg8::gemm_phase<pg8::EpiBf16<0>, true>(lds, g, SO, E);
            }
            {
                pg8::Gemm g{(const bf16_t*)(p.ws + R_XA + A_CKVN), W + W_UKV / 2, T, 1024, 128, 128, nullptr, 0, nullptr}; SO.init(T, 1024, G - Gc, c - Gc);
                pg8::EpiBf16<0> E{(bf16_t*)(p.ws + R_H + (size_t)T * 2048), 1024, nullptr, nullptr};
                pg8::gemm_phase<pg8::EpiBf16<0>, true>(lds, g, SO, E);
            }
        }
    }
    GSYNC(); PSTAMP(3);
    PH(4) { LP(); phase_p3b(p, lds); }
    GSYNC(); PSTAMP(4);
    RPT(4) { { LP(); phase_p3b(p, lds); } GSYNC(); }
    PH(5) { LP(); phase_p4(p, lds); }
    GSYNC(); PSTAMP(5);
    RPT(5) { { LP(); phase_p4(p, lds); } GSYNC(); }
    PH(6) { LP();
        pg8::Gemm g{xn, W + W_OUT_E / 2, T, 1024, 1024, 1024, nullptr, 0, nullptr}; SO.init(T, 1024, G, c);
        pg8::EpiResStat<false> E{p.in[0], (bf16_t*)p.out, (float*)(p.ws + SM_SSP1), 1024};
        pg8::gemm_phase<pg8::EpiResStat<false>, true>(lds, g, SO, E);
    }
    GSYNC(); PSTAMP(6);
    PH(7) { }
    PH(8) { LP();
        pg8::Gemm g{(const bf16_t*)p.out, W + W_GU / 2, T, 5632, 1024, 1024, nullptr, 0, nullptr}; SO.init(T, 5632, G, c);
        pg8::EpiSwiGLU E{(bf16_t*)(p.ws + R_H), 2816, (const float*)(p.ws + SM_SSP1)};
        pg8::gemm_phase<pg8::EpiSwiGLU, true>(lds, g, SO, E);
    }
    GSYNC(); PSTAMP(8);
    PH(9) { LP();
        pg8::Gemm g{(const bf16_t*)(p.ws + R_H), W + W_D / 2, T, 1024, 2816, 2816, nullptr, 0, nullptr}; SO.init(T, 1024, G, c);
        pg8::EpiResStat<true> E{(const bf16_t*)p.out, xn, (float*)(p.ws + SM_SSP2), 1024};
        pg8::gemm_phase<pg8::EpiResStat<true>, true>(lds, g, SO, E);
    }
    GSYNC(); PSTAMP(9);
    PH(10) { }
    PH(11) { LP();
        pg8::Gemm g{xn, W + W_IN_O / 2, T, 3072, 1024, 1024, nullptr, 0, nullptr}; SO.init(T, 3072, G, c);
        pg8::EpiBf16<0> E{(bf16_t*)(p.ws + R_H), 3072, nullptr, (const float*)(p.ws + SM_SSP2)};
        pg8::gemm_phase<pg8::EpiBf16<0>, true>(lds, g, SO, E);
    }
    GSYNC(); PSTAMP(11);
    PH(12) { LP(); phase_conv(p); }
    GSYNC(); PSTAMP(12);
    RPT(12) { { LP(); phase_conv(p); } GSYNC(); }
    PH(13) { LP();
        pg8::Gemm g{(const bf16_t*)x1, W + W_OUT_O / 2, T, 1024, 1024, 1024, nullptr, 0, nullptr}; SO.init(T, 1024, G, c);
        pg8::EpiResBf16B E{xn, xn, 1024};
        pg8::gemm_phase<pg8::EpiResBf16B, true>(lds, g, SO, E);
    }
    GSYNC(); PSTAMP(13);
    PH(14) { LP(); phase_norm_router(p, lds); }
    GSYNC(); PSTAMP(14);
    PH(15) { LP(); phase_moe_gather(p); }
    GSYNC(); PSTAMP(15);
    PH(16) { LP(); const int mrows = ((const int*)(p.ws + SM_CTL))[8];
        pg8::Gemm g{(const bf16_t*)x1, W + W_MGU / 2, mrows, 2816, 1024, 1024, (const int*)(p.ws + SM_TILEE), (size_t)2816 * 1024, (const int*)(p.ws + SM_ROWTOK)}; SO.init(mrows, 2816, G, c);
        pg8::EpiSwiGLU E{(bf16_t*)(p.ws + R_H), 1408, nullptr};
        pg8::gemm_phase<pg8::EpiSwiGLU, true, true>(lds, g, SO, E);
    }
    GSYNC(); PSTAMP(16);
    PH(17) { LP(); const int mrows = ((const int*)(p.ws + SM_CTL))[8];
        pg8::Gemm g{(const bf16_t*)(p.ws + R_H), W + W_MD / 2, mrows, 1024, 1408, 1408, (const int*)(p.ws + SM_TILEE), (size_t)1024 * 1408, nullptr}; SO.init(mrows, 1024, G, c);
        pg8::EpiRowScaleBf16 E{(bf16_t*)(p.ws + R_XA), 1024, (const float*)(p.ws + SM_ROWW)};
        pg8::gemm_phase<pg8::EpiRowScaleBf16, true>(lds, g, SO, E);
    }
    GSYNC(); PSTAMP(17);
    PH(18) { LP(); phase_moe_combine(p); }
#ifdef PROF_SEL
    GSYNC(); PSTAMP(18);
    GSYNC();
    {
        unsigned long long v_ = *PROF_SLOT(PROF_SEL);
#ifdef PROF_DIV
        const unsigned long long dv_ = *PROF_SLOT(PROF_DIV); v_ = dv_ ? v_ / dv_ : 0ull;
#endif
        unsigned long long a_ = v_ / (unsigned long long)(PROF_UNIT); if (a_ > 27ull) a_ = 27ull;
        const float sc_ = 1.f + (float)a_;
        for (size_t i = (size_t)blockIdx.x * 512 + threadIdx.x; i < (size_t)S * 1024 / 4; i += (size_t)gridDim.x * 512) { f32x4* o = (f32x4*)p.out + i; *o = *o * sc_; }
    }
#endif
#undef PH
}

inline void launch(void* const* d_in, float* d_out, void* d_ws, size_t ws_size, hipStream_t stream, int ph_lo = 0, int ph_hi = 99, int dbg_branch = -1) {
    static int grid = 0;
    if (grid == 0) {
        int dev = 0, cus = 0, per_cu = 0;
        hipGetDevice(&dev); hipDeviceGetAttribute(&cus, hipDeviceAttributeMultiprocessorCount, dev);
        hipFuncSetAttribute((const void*)mega_fwd, hipFuncAttributeMaxDynamicSharedMemorySize, LDS_BYTES);
        hipOccupancyMaxActiveBlocksPerMultiprocessor(&per_cu, (const void*)mega_fwd, 512, LDS_BYTES);
        if (per_cu < 1) { fprintf(stderr, "occupancy query says %d blocks/CU\n", per_cu); per_cu = 1; }
        grid = cus;
        if (WS_FAST_END > ws_size) { fprintf(stderr, "ws too small: need %zu have %zu\n", (size_t)WS_FAST_END, ws_size); grid = -1; }
    }
    if (grid < 0) return;
    if (ph_lo <= 14 && ph_hi >= 14) hipMemsetAsync((char*)d_ws + SM_CTL, 0, 4096, stream);
    hipMemsetAsync((char*)d_ws + SM_BAR, 0, 16384, stream);
    Params p{};
    for (int i = 0; i < 30; ++i) p.in[i] = (const float*)d_in[i];
    p.out = d_out; p.ws = (unsigned char*)d_ws; p.ph_lo = ph_lo; p.ph_hi = ph_hi; p.dbg_branch = dbg_branch;
    void* args[] = {&p};
    hipError_t e = hipLaunchCooperativeKernel((const void*)mega_fwd, dim3(grid), dim3(512), args, LDS_BYTES, stream);
    if (e != hipSuccess) fprintf(stderr, "cooperative launch failed: %s (grid %d)\n", hipGetErrorString(e), grid);
}
}
extern "C" void kernel_launch(void* const* d_in, const int* in_sizes, int n_in, void* d_out, int out_size, void* d_ws, size_t ws_size, hipStream_t stream) {
    fast::launch(d_in, (float*)d_out, d_ws, ws_size, stream);
}
```

```cpp
#include <hip/hip_runtime.h>
#include <hip/hip_bf16.h>
#include <stdint.h>
#include <stdio.h>
#include <string.h>
#include <hip/hip_cooperative_groups.h>
namespace cg = cooperative_groups;
#define NB 8
#define REPEAT_MASK 0x0u
namespace gold {
constexpr int S = 4096, D = 1024, HW = 1720;
constexpr float EPS = 1e-6f;

__device__ const unsigned char T5B[128] = {0, 1, 2, 3, 4, 5, 6, 7, 8, 9, 10, 11, 12, 13, 14, 15, 16, 16, 16, 17, 17, 18, 18, 18, 19, 19, 19, 20, 20, 20, 20, 21, 21, 21, 21, 22, 22, 22, 22, 22, 23, 23, 23, 23, 23, 23, 24, 24, 24, 24, 24, 24, 25, 25, 25, 25, 25, 25, 25, 26, 26, 26, 26, 26, 26, 26, 26, 27, 27, 27, 27, 27, 27, 27, 27, 27, 27, 28, 28, 28, 28, 28, 28, 28, 28, 28, 28, 29, 29, 29, 29, 29, 29, 29, 29, 29, 29, 29, 29, 30, 30, 30, 30, 30, 30, 30, 30, 30, 30, 30, 30, 30, 30, 31, 31, 31, 31, 31, 31, 31, 31, 31, 31, 31, 31, 31, 31};
}
#ifndef NB
#define NB 8
#endif
namespace fast {
#define LAS __attribute__((address_space(3)))
typedef unsigned short bf16_t;
typedef short bf16x8 __attribute__((ext_vector_type(8)));
typedef float f32x4 __attribute__((ext_vector_type(4)));
typedef float f32x2 __attribute__((ext_vector_type(2)));
typedef float f32x16 __attribute__((ext_vector_type(16)));
typedef unsigned u32x4 __attribute__((ext_vector_type(4)));
typedef unsigned u32x2 __attribute__((ext_vector_type(2)));
typedef __bf16 bf16x2_t __attribute__((ext_vector_type(2)));

constexpr int S = 4096, T = NB * S, D = 1024;
constexpr float EPS = 1e-6f, LOG2E = 1.4426950408889634f;

__device__ __forceinline__ unsigned cvtpk(float lo, float hi) { f32x2 v = {lo, hi}; bf16x2_t b = __builtin_convertvector(v, bf16x2_t); return __builtin_bit_cast(unsigned, b); }
__device__ __forceinline__ bf16_t f2bf(float f) { return (bf16_t)(cvtpk(f, 0.f) & 0xffffu); }
__device__ __forceinline__ float bf2f(bf16_t u) { return __builtin_bit_cast(float, (unsigned)u << 16); }
__device__ __forceinline__ float bflo(unsigned u) { return __builtin_bit_cast(float, u << 16); }
__device__ __forceinline__ float bfhi(unsigned u) { return __builtin_bit_cast(float, u & 0xffff0000u); }
__device__ __forceinline__ float wsum(float v) {
#pragma unroll
    for (int o = 1; o < 64; o <<= 1) v += __shfl_xor(v, o);
    return v;
}
__device__ __forceinline__ float fexp2(float x) { return __builtin_amdgcn_exp2f(x); }
__device__ __forceinline__ float frcp(float x) { return __builtin_amdgcn_rcpf(x); }
__device__ __forceinline__ float silu_f(float x) { return x * frcp(1.f + fexp2(-x * LOG2E)); }
__device__ __forceinline__ float gelu_tanh_f(float x) {
    const float u = 0.7978845608028654f * (x + 0.044715f * x * x * x);
    return x * frcp(1.f + fexp2(-2.f * LOG2E * u));
}

namespace pg8 {
constexpr int BM = 256, BK = 64, HALF = 128, HTB = HALF * BK * 2, STAGE_BYTES = 8 * HTB, NXCD = 8, WGM = 8;
__host__ __device__ __forceinline__ int lds_byte(int r, int c) { const int st = (r >> 4) * 2 + (c >> 5), rr = r & 15, cc = c & 31, ob = rr * 64 + cc * 2; return st * 1024 + (ob ^ (((ob >> 9) & 1) << 5)); }
__host__ __device__ __forceinline__ void stage_rc(int b, int& R, int& C) { const int st = b / 1024, sb = b % 1024, swz = sb ^ (((sb >> 9) & 1) << 5); R = (st >> 1) * 16 + swz / 64; C = (st & 1) * 32 + (swz % 64) / 2; }
__host__ __device__ __forceinline__ int perm32(int rho) { const int n = rho >> 4, i = rho & 15; return 8 * (i >> 2) + 4 * n + (i & 3); }

struct Unit { int pm, pn; };
struct Gemm { const bf16_t* A; const bf16_t* Bt; int M, N, K, lda; const int* tile_e; size_t estride; const int* rowidx; };

struct StaticOrder {
    int nM, nN, nwg, G, c;
    __device__ void init(int M, int N, int G_, int c_) { nM = M / BM; nN = N / BM; nwg = nM * nN; G = G_; c = c_; }
    __device__ bool next(int i, Unit& u) const {
        const long L = (long)i * G + c; if (L >= nwg) return false;
        int wgid = (int)L; { const int q = nwg / NXCD, r = nwg % NXCD, xcd = wgid % NXCD, off = wgid / NXCD; wgid = (xcd < r ? xcd * (q + 1) : r * (q + 1) + (xcd - r) * q) + off; }
        const int nig = WGM * nN, gid = wgid / nig, fm = gid * WGM, gsz = (nM - fm) < WGM ? (nM - fm) : WGM;
        u.pm = fm + ((wgid % nig) % gsz); u.pn = (wgid % nig) / gsz; return true;
    }
};

template <class Epi, bool ALIGN_EPI, bool GATHER = false>
__device__ __forceinline__ void gemm_phase(LAS unsigned char* lds, const Gemm g, const StaticOrder& S, const Epi& E) {
    int tid = threadIdx.x; asm volatile("" : "+v"(tid));
    const int wid = __builtin_amdgcn_readfirstlane(tid >> 6), lane = tid & 63, wr = wid >> 2, wc = wid & 3, fr = lane & 15, fq = lane >> 4;
    const int K = g.K, nt = K / BK, lda = g.lda;
    unsigned voffA[2], voffB[2];
#pragma unroll
    for (int i = 0; i < 2; ++i) { int R, C; stage_rc(tid * 16 + i * 8192, R, C); const int Rb = Epi::PERM ? ((R & ~31) + perm32(R & 31)) : R;
        voffA[i] = (unsigned)(R * lda + C) * 2u; voffB[i] = (unsigned)(Rb * K + C) * 2u; }
    const size_t kstep = (size_t)(BK * 2);
    const size_t hsA = GATHER ? 0 : (size_t)HALF * lda * 2, tsA = 2 * hsA, hsB = (size_t)HALF * K * 2, tsB = 2 * hsB;
    unsigned vgc[2][2], vgn[2][2];
#define PG8_GOFF(pm_, vg) do { _Pragma("unroll") for (int h_ = 0; h_ < 2; ++h_) _Pragma("unroll") for (int i_ = 0; i_ < 2; ++i_) { int R_, C_; stage_rc(tid * 16 + i_ * 8192, R_, C_); \
        int tok_ = g.rowidx[(pm_) * BM + h_ * HALF + R_]; tok_ = tok_ < 0 ? 0 : tok_; vg[h_][i_] = (unsigned)(tok_ * lda + C_) * 2u; } } while (0)
#define PG8_STAGE_A(bufoff, gbase, h, nx) do { unsigned va_[2]; _Pragma("unroll") for (int i_ = 0; i_ < 2; ++i_) va_[i_] = GATHER ? ((nx) ? vgn[h][i_] : vgc[h][i_]) : voffA[i_]; PG8_STAGE(bufoff, gbase, va_); } while (0)
    const unsigned ldsw = (unsigned)wid * 1024u;
    const int aoff = lds_byte(wr * 64 + fr, fq * 8), boff = lds_byte(wc * 32 + fr, fq * 8);
#define PG8_SA(b, h) (((b) * 2 + (h)) * HTB)
#define PG8_SB(b, h) ((4 + (b) * 2 + (h)) * HTB)
#define PG8_STAGE(bufoff, gbase, voff) do { _Pragma("unroll") for (int _i = 0; _i < 2; ++_i) \
        __builtin_amdgcn_global_load_lds((const unsigned*)((const char*)(gbase) + (voff)[_i]), (LAS unsigned*)(lds + (bufoff) + ldsw + _i * 8192), 16, 0, 0); } while (0)
#define PG8_LDA(dst, b, h) do { _Pragma("unroll") for (int m = 0; m < 4; ++m) _Pragma("unroll") for (int k = 0; k < 2; ++k) dst[m][k] = *(const LAS bf16x8*)(lds + PG8_SA(b, h) + aoff + m * 2048 + k * 1024); } while (0)
#define PG8_LDB(dst, b, h) do { _Pragma("unroll") for (int n = 0; n < 2; ++n) _Pragma("unroll") for (int k = 0; k < 2; ++k) dst[n][k] = *(const LAS bf16x8*)(lds + PG8_SB(b, h) + boff + n * 2048 + k * 1024); } while (0)
#define PG8_MMA(ai, bj, At, Bt) do { __builtin_amdgcn_s_setprio(1); _Pragma("unroll") for (int m = 0; m < 4; ++m) _Pragma("unroll") for (int n = 0; n < 2; ++n) _Pragma("unroll") for (int k = 0; k < 2; ++k) \
        acc[ai][bj][m][n] = __builtin_amdgcn_mfma_f32_16x16x32_bf16(Bt[n][k], At[m][k], acc[ai][bj][m][n], 0, 0, 0); __builtin_amdgcn_s_setprio(0); } while (0)
#define PG8_WAIT_V(n) asm volatile("s_waitcnt vmcnt(" #n ")" ::: "memory")
#define PG8_WAIT_L(n) asm volatile("s_waitcnt lgkmcnt(" #n ")" ::: "memory")
#define PG8_BAR __builtin_amdgcn_s_barrier()
#define PG8_SCHED __builtin_amdgcn_sched_barrier(0)
#define PG8_EOFF(pm_) (g.tile_e ? (size_t)g.tile_e[pm_] * g.estride * 2 : (size_t)0)
    Unit cur, nxt; int ui = 0;
    if (!S.next(0, cur)) return;
    f32x4 acc[2][2][4][2];
#pragma unroll
    for (int a = 0; a < 2; ++a)
#pragma unroll
        for (int b = 0; b < 2; ++b)
#pragma unroll
            for (int m = 0; m < 4; ++m)
#pragma unroll
                for (int n = 0; n < 2; ++n) acc[a][b][m][n] = (f32x4){0.f, 0.f, 0.f, 0.f};
    bf16x8 At[4][2], B0[2][2], B1[2][2];
    const char* cA = (const char*)g.A + (size_t)cur.pm * tsA; const char* cB = (const char*)g.Bt + PG8_EOFF(cur.pm) + (size_t)cur.pn * tsB;
    if constexpr (GATHER) PG8_GOFF(cur.pm, vgc);
    PG8_STAGE(PG8_SB(0, 0), cB, voffB); PG8_STAGE(PG8_SB(0, 1), cB + hsB, voffB); PG8_STAGE_A(PG8_SA(0, 0), cA, 0, false); PG8_STAGE_A(PG8_SA(0, 1), cA + hsA, 1, false);
    if (wr == 1) PG8_BAR;
    PG8_WAIT_V(2); PG8_BAR;
    PG8_STAGE(PG8_SB(1, 0), cB + kstep, voffB); PG8_STAGE_A(PG8_SA(1, 0), cA + kstep, 0, false); PG8_STAGE(PG8_SB(1, 1), cB + hsB + kstep, voffB);
    PG8_WAIT_V(6); PG8_BAR;
    for (;;) {
        const bool has_next = S.next(ui + 1, nxt);
        if constexpr (GATHER) { if (has_next) PG8_GOFF(nxt.pm, vgn); else { vgn[0][0] = vgc[0][0]; vgn[0][1] = vgc[0][1]; vgn[1][0] = vgc[1][0]; vgn[1][1] = vgc[1][1]; } }
        const char* nA = has_next ? (const char*)g.A + (size_t)nxt.pm * tsA : cA;
        const char* nB = has_next ? (const char*)g.Bt + PG8_EOFF(nxt.pm) + (size_t)nxt.pn * tsB : cB;
        for (int t = 0; t < nt; t += 2) {
            const bool last = (t == nt - 2);
            const char* a1 = cA + (size_t)(t + 1) * kstep;
            const char* a2 = last ? nA : cA + (size_t)(t + 2) * kstep; const char* b2 = last ? nB : cB + (size_t)(t + 2) * kstep;
            const char* a3 = a2 + kstep; const char* b3 = b2 + kstep;
            PG8_LDB(B0, 0, 0); PG8_LDB(B1, 0, 1); PG8_SCHED; PG8_LDA(At, 0, 0); PG8_STAGE_A(PG8_SA(1, 1), a1 + hsA, 1, false);
            PG8_WAIT_V(8); PG8_WAIT_L(0); PG8_BAR; PG8_MMA(0, 0, At, B0); PG8_MMA(0, 1, At, B1); PG8_BAR; PG8_SCHED;
            PG8_LDA(At, 0, 1); PG8_STAGE(PG8_SB(0, 0), b2, voffB); PG8_STAGE(PG8_SB(0, 1), b2 + hsB, voffB); PG8_STAGE_A(PG8_SA(0, 0), a2, 0, last);
            PG8_WAIT_V(8); PG8_WAIT_L(0); PG8_BAR; PG8_MMA(1, 0, At, B0); PG8_MMA(1, 1, At, B1); PG8_BAR; PG8_SCHED;
            PG8_LDB(B0, 1, 0); PG8_LDB(B1, 1, 1); PG8_SCHED; PG8_LDA(At, 1, 0); PG8_STAGE_A(PG8_SA(0, 1), a2 + hsA, 1, last);
            PG8_WAIT_V(8); PG8_WAIT_L(0); PG8_BAR; PG8_MMA(0, 0, At, B0); PG8_MMA(0, 1, At, B1); PG8_BAR; PG8_SCHED;
            PG8_LDA(At, 1, 1); PG8_STAGE(PG8_SB(1, 0), b3, voffB); PG8_STAGE(PG8_SB(1, 1), b3 + hsB, voffB); PG8_STAGE_A(PG8_SA(1, 0), a3, 0, last);
            PG8_WAIT_V(8); PG8_WAIT_L(0); PG8_BAR; PG8_MMA(1, 0, At, B0); PG8_MMA(1, 1, At, B1); PG8_BAR; PG8_SCHED;
        }
        if constexpr (ALIGN_EPI) { if (wr == 0) PG8_BAR; }
        E(acc, cur, wr, wc, fr, fq);
        if (!has_next) break;
#pragma unroll
        for (int a = 0; a < 2; ++a)
#pragma unroll
            for (int b = 0; b < 2; ++b)
#pragma unroll
                for (int m = 0; m < 4; ++m)
#pragma unroll
                    for (int n = 0; n < 2; ++n) acc[a][b][m][n] = (f32x4){0.f, 0.f, 0.f, 0.f};
        cur = nxt; cA = nA; cB = nB; ++ui;
        if constexpr (GATHER) { vgc[0][0] = vgn[0][0]; vgc[0][1] = vgn[0][1]; vgc[1][0] = vgn[1][0]; vgc[1][1] = vgn[1][1]; }
        if constexpr (ALIGN_EPI) { if (wr == 1) PG8_BAR; }
    }
    PG8_WAIT_V(0);
    if constexpr (!ALIGN_EPI) { if (wr == 0) PG8_BAR; }
    PG8_BAR;
#undef PG8_SA
#undef PG8_SB
#undef PG8_STAGE
#undef PG8_LDA
#undef PG8_LDB
#undef PG8_MMA
#undef PG8_WAIT_V
#undef PG8_WAIT_L
#undef PG8_BAR
#undef PG8_SCHED
#undef PG8_EOFF
#undef PG8_GOFF
#undef PG8_STAGE_A
}

__device__ __forceinline__ float row_rstd(const float* ssp, int row);
template <int ACT> struct EpiBf16 {
    static constexpr bool PERM = true;
    bf16_t* O; int ldc; const float* bias; const float* ssp;
    __device__ __forceinline__ void operator()(const f32x4 (&acc)[2][2][4][2], const Unit& u, int wr, int wc, int fr, int fq) const {
        const int row0 = u.pm * BM + wr * 64 + fr, col0 = u.pn * BM + wc * 32 + 8 * fq;
        f32x4 bv[2][2];
#pragma unroll
        for (int bj = 0; bj < 2; ++bj)
#pragma unroll
            for (int n = 0; n < 2; ++n) bv[bj][n] = bias ? *(const f32x4*)(bias + col0 + bj * HALF + 4 * n) : (f32x4){0.f, 0.f, 0.f, 0.f};
#pragma unroll
        for (int ai = 0; ai < 2; ++ai)
#pragma unroll
            for (int m = 0; m < 4; ++m) { bf16_t* rowp = O + (size_t)(row0 + ai * HALF + m * 16) * ldc + col0;
                const float rs = (ACT == 0 && ssp) ? row_rstd(ssp, row0 + ai * HALF + m * 16) : 1.f;
#pragma unroll
                for (int bj = 0; bj < 2; ++bj) { f32x4 v0 = acc[ai][bj][m][0] * rs + bv[bj][0], v1 = acc[ai][bj][m][1] * rs + bv[bj][1];
                    if (ACT == 2) {
#pragma unroll
                        for (int i = 0; i < 4; ++i) { v0[i] = gelu_tanh_f(v0[i]); v1[i] = gelu_tanh_f(v1[i]); } }
                    u32x4 w; w.x = cvtpk(v0[0], v0[1]); w.y = cvtpk(v0[2], v0[3]); w.z = cvtpk(v1[0], v1[1]); w.w = cvtpk(v1[2], v1[3]);
                    *(u32x4*)(rowp + bj * HALF) = w; } }
    }
};
struct EpiResF32 {
    static constexpr bool PERM = false;
    const float* base; float* out; int ldc;
    __device__ __forceinline__ void operator()(const f32x4 (&acc)[2][2][4][2], const Unit& u, int wr, int wc, int fr, int fq) const {
        const int col0 = u.pn * BM + wc * 32 + 4 * fq;
#pragma unroll
        for (int ai = 0; ai < 2; ++ai)
#pragma unroll
            for (int m = 0; m < 4; ++m) { const size_t off = (size_t)(u.pm * BM + ai * HALF + wr * 64 + m * 16 + fr) * ldc + col0;
#pragma unroll
                for (int bj = 0; bj < 2; ++bj)
#pragma unroll
                    for (int n = 0; n < 2; ++n) { const f32x4 bs = *(const f32x4*)(base + off + bj * HALF + n * 16); *(f32x4*)(out + off + bj * HALF + n * 16) = bs + acc[ai][bj][m][n]; } }
    }
};
template <bool BASE_BF16> struct EpiResStat {
    static constexpr bool PERM = false;
    const void* base; bf16_t* xb; float* ssp; int ldc;
    __device__ __forceinline__ void operator()(const f32x4 (&acc)[2][2][4][2], const Unit& u, int wr, int wc, int fr, int fq) const {
        const int col0 = u.pn * BM + wc * 32 + 4 * fq;
#pragma unroll
        for (int ai = 0; ai < 2; ++ai)
#pragma unroll
            for (int m = 0; m < 4; ++m) { const int row = u.pm * BM + ai * HALF + wr * 64 + m * 16 + fr; const size_t off = (size_t)row * ldc + col0; float ss = 0.f;
#pragma unroll
                for (int bj = 0; bj < 2; ++bj)
#pragma unroll
                    for (int n = 0; n < 2; ++n) { f32x4 bs;
                        if (BASE_BF16) { const u32x2 t = *(const u32x2*)((const bf16_t*)base + off + bj * HALF + n * 16); bs = (f32x4){bflo(t.x), bfhi(t.x), bflo(t.y), bfhi(t.y)}; }
                        else bs = *(const f32x4*)((const float*)base + off + bj * HALF + n * 16);
                        const f32x4 v = bs + acc[ai][bj][m][n];
                        u32x2 w; w.x = cvtpk(v.x, v.y); w.y = cvtpk(v.z, v.w); *(u32x2*)(xb + off + bj * HALF + n * 16) = w; ss += (v.x * v.x + v.y * v.y) + (v.z * v.z + v.w * v.w); }
                ss += __shfl_xor(ss, 16); ss += __shfl_xor(ss, 32);
                if (fq == 0) ssp[(size_t)row * 16 + u.pn * 4 + wc] = ss; }
    }
};
struct EpiResBf16B {
    static constexpr bool PERM = false;
    const bf16_t* base; bf16_t* out; int ldc;
    __device__ __forceinline__ void operator()(const f32x4 (&acc)[2][2][4][2], const Unit& u, int wr, int wc, int fr, int fq) const {
        const int col0 = u.pn * BM + wc * 32 + 4 * fq;
#pragma unroll
        for (int ai = 0; ai < 2; ++ai)
#pragma unroll
            for (int m = 0; m < 4; ++m) { const size_t off = (size_t)(u.pm * BM + ai * HALF + wr * 64 + m * 16 + fr) * ldc + col0;
#pragma unroll
                for (int bj = 0; bj < 2; ++bj)
#pragma unroll
                    for (int n = 0; n < 2; ++n) { const u32x2 t = *(const u32x2*)(base + off + bj * HALF + n * 16); const f32x4 v = (f32x4){bflo(t.x), bfhi(t.x), bflo(t.y), bfhi(t.y)} + acc[ai][bj][m][n];
                        u32x2 w; w.x = cvtpk(v.x, v.y); w.y = cvtpk(v.z, v.w); *(u32x2*)(out + off + bj * HALF + n * 16) = w; } }
    }
};
struct EpiResF32B {
    static constexpr bool PERM = false;
    const bf16_t* base; float* out; int ldc;
    __device__ __forceinline__ void operator()(const f32x4 (&acc)[2][2][4][2], const Unit& u, int wr, int wc, int fr, int fq) const {
        const int col0 = u.pn * BM + wc * 32 + 4 * fq;
#pragma unroll
        for (int ai = 0; ai < 2; ++ai)
#pragma unroll
            for (int m = 0; m < 4; ++m) { const size_t off = (size_t)(u.pm * BM + ai * HALF + wr * 64 + m * 16 + fr) * ldc + col0;
#pragma unroll
                for (int bj = 0; bj < 2; ++bj)
#pragma unroll
                    for (int n = 0; n < 2; ++n) { const u32x2 t = *(const u32x2*)(base + off + bj * HALF + n * 16); const f32x4 bs = {bflo(t.x), bfhi(t.x), bflo(t.y), bfhi(t.y)};
                        *(f32x4*)(out + off + bj * HALF + n * 16) = bs + acc[ai][bj][m][n]; } }
    }
};
__device__ __forceinline__ float row_rstd(const float* ssp, int row) {
    const f32x4* q = (const f32x4*)(ssp + (size_t)row * 16); const f32x4 a = q[0], b = q[1], c = q[2], d = q[3];
    const float s = ((a.x + a.y) + (a.z + a.w)) + ((b.x + b.y) + (b.z + b.w)) + ((c.x + c.y) + (c.z + c.w)) + ((d.x + d.y) + (d.z + d.w));
    return rsqrtf(s * (1.f / 1024.f) + EPS);
}
struct EpiSwiGLU {
    static constexpr bool PERM = true;
    bf16_t* O; int ldc; const float* ssp;
    __device__ __forceinline__ void operator()(const f32x4 (&acc)[2][2][4][2], const Unit& u, int wr, int wc, int fr, int fq) const {
        const int row0 = u.pm * BM + wr * 64 + fr, col0 = u.pn * HALF + wc * 32 + 8 * fq;
#pragma unroll
        for (int ai = 0; ai < 2; ++ai)
#pragma unroll
            for (int m = 0; m < 4; ++m) { bf16_t* rowp = O + (size_t)(row0 + ai * HALF + m * 16) * ldc + col0;
                const float rs = ssp ? row_rstd(ssp, row0 + ai * HALF + m * 16) : 1.f;
                float h[8];
#pragma unroll
                for (int n = 0; n < 2; ++n)
#pragma unroll
                    for (int i = 0; i < 4; ++i) h[n * 4 + i] = silu_f(acc[ai][0][m][n][i] * rs) * (acc[ai][1][m][n][i] * rs);
                u32x4 w; w.x = cvtpk(h[0], h[1]); w.y = cvtpk(h[2], h[3]); w.z = cvtpk(h[4], h[5]); w.w = cvtpk(h[6], h[7]);
                *(u32x4*)rowp = w; }
    }
};
struct EpiConvIn {
    static constexpr bool PERM = true;
    bf16_t* Bg; bf16_t* CU; const float* ssp;
    __device__ __forceinline__ void operator()(const f32x4 (&acc)[2][2][4][2], const Unit& u, int wr, int wc, int fr, int fq) const {
        const int row0 = u.pm * BM + wr * 64 + fr;
#pragma unroll
        for (int ai = 0; ai < 2; ++ai)
#pragma unroll
            for (int m = 0; m < 4; ++m) { const int row = row0 + ai * HALF + m * 16; const float rs = row_rstd(ssp, row);
                if (u.pn < 4) {
#pragma unroll
                    for (int bj = 0; bj < 2; ++bj) { const f32x4 v0 = acc[ai][bj][m][0] * rs, v1 = acc[ai][bj][m][1] * rs;
                        u32x4 w; w.x = cvtpk(v0[0], v0[1]); w.y = cvtpk(v0[2], v0[3]); w.z = cvtpk(v1[0], v1[1]); w.w = cvtpk(v1[2], v1[3]);
                        *(u32x4*)(Bg + (size_t)row * 1024 + u.pn * BM + bj * HALF + wc * 32 + 8 * fq) = w; }
                } else { const float r2 = rs * rs; float h[8];
#pragma unroll
                    for (int n = 0; n < 2; ++n)
#pragma unroll
                        for (int i = 0; i < 4; ++i) h[n * 4 + i] = acc[ai][0][m][n][i] * acc[ai][1][m][n][i] * r2;
                    u32x4 w; w.x = cvtpk(h[0], h[1]); w.y = cvtpk(h[2], h[3]); w.z = cvtpk(h[4], h[5]); w.w = cvtpk(h[6], h[7]);
                    *(u32x4*)(CU + (size_t)row * 1024 + (u.pn - 4) * HALF + wc * 32 + 8 * fq) = w; } }
    }
};
struct EpiRowScaleBf16 {
    static constexpr bool PERM = true;
    bf16_t* O; int ldc; const float* roww;
    __device__ __forceinline__ void operator()(const f32x4 (&acc)[2][2][4][2], const Unit& u, int wr, int wc, int fr, int fq) const {
        const int row0 = u.pm * BM + wr * 64 + fr, col0 = u.pn * BM + wc * 32 + 8 * fq;
#pragma unroll
        for (int ai = 0; ai < 2; ++ai)
#pragma unroll
            for (int m = 0; m < 4; ++m) { const int row = row0 + ai * HALF + m * 16; const float sc = roww[row]; bf16_t* rowp = O + (size_t)row * ldc + col0;
#pragma unroll
                for (int bj = 0; bj < 2; ++bj) { const f32x4 v0 = acc[ai][bj][m][0] * sc, v1 = acc[ai][bj][m][1] * sc;
                    u32x4 w; w.x = cvtpk(v0[0], v0[1]); w.y = cvtpk(v0[2], v0[3]); w.z = cvtpk(v1[0], v1[1]); w.w = cvtpk(v1[2], v1[3]);
                    *(u32x4*)(rowp + bj * HALF) = w; } }
    }
};
}
constexpr int ROWS_MAX = 2 * T + 8 * 256;
constexpr size_t al256(size_t x) { return (x + 255) & ~(size_t)255; }
constexpr size_t W_IN_E = 0;
constexpr size_t W_CW1 = W_IN_E + (size_t)1792 * 1024 * 2;
constexpr size_t W_UQ = W_CW1 + (size_t)2 * 256 * 2048 * 2;
constexpr size_t W_UKV = W_UQ + (size_t)1024 * 256 * 2;
constexpr size_t W_OUT_E = W_UKV + (size_t)1024 * 128 * 2;
constexpr size_t W_GU = W_OUT_E + (size_t)1024 * 1024 * 2;
constexpr size_t W_D = W_GU + (size_t)5632 * 1024 * 2;
constexpr size_t W_IN_O = W_D + (size_t)1024 * 2816 * 2;
constexpr size_t W_OUT_O = W_IN_O + (size_t)3072 * 1024 * 2;
constexpr size_t W_MGU = W_OUT_O + (size_t)1024 * 1024 * 2;
constexpr size_t W_MD = W_MGU + (size_t)8 * 2816 * 1024 * 2;
constexpr size_t W_END = W_MD + (size_t)8 * 1024 * 1408 * 2;
constexpr size_t SM_CTL = al256(W_END);
constexpr size_t SM_BAR = SM_CTL + 4096;
constexpr size_t SM_B1P = SM_BAR + 16384;
constexpr size_t SM_B1 = SM_B1P + 32 * 512 * 4;
constexpr size_t SM_ROPE = SM_B1 + 512 * 4;
constexpr size_t SM_BL = SM_ROPE + (size_t)S * 32 * 4;
constexpr size_t SM_HID = SM_BL + 8 * 132 * 4;
constexpr size_t SM_KC = SM_HID + (size_t)2 * NB * 512 * 512 * 2;
constexpr size_t SM_VCT = SM_KC + (size_t)NB * 512 * 64 * 2;
constexpr size_t SM_TE = SM_VCT + (size_t)NB * 512 * 64 * 2;
constexpr size_t SM_TW = SM_TE + (size_t)T * 8;
constexpr size_t SM_RANK = SM_TW + (size_t)T * 8;
constexpr size_t SM_POS = SM_RANK + (size_t)T * 8;
constexpr size_t SM_ROWW = SM_POS + (size_t)T * 8;
constexpr size_t SM_TILEE = SM_ROWW + (size_t)ROWS_MAX * 4;
constexpr size_t SM_ROWTOK = al256(SM_TILEE + (size_t)(ROWS_MAX / 256 + 8) * 4);
constexpr size_t SM_SSP1 = al256(SM_ROWTOK + (size_t)ROWS_MAX * 4);
constexpr size_t SM_SSP2 = SM_SSP1 + (size_t)T * 64;
constexpr size_t SM_END = SM_SSP2 + (size_t)T * 64;
constexpr size_t R_XA = al256(SM_END);
constexpr size_t SZ_XA = (size_t)T * 4096 + (size_t)4 * 1048576;
constexpr size_t R_XN = R_XA + SZ_XA;
constexpr size_t SZ_XN = (size_t)T * 2048;
constexpr size_t R_H = R_XN + SZ_XN;
constexpr size_t SZ_H = ((size_t)T * 6144 > (size_t)ROWS_MAX * 2816) ? (size_t)T * 6144 : (size_t)ROWS_MAX * 2816;
constexpr size_t WS_FAST_END = R_H + SZ_H;
constexpr size_t A_QN = 0;
constexpr size_t A_KSN = A_QN + (size_t)T * 1024;
constexpr size_t A_KWN = A_KSN + (size_t)T * 256;
constexpr size_t A_VST = A_KWN + (size_t)T * 256;
constexpr size_t A_VWT = A_VST + (size_t)T * 256;
constexpr size_t A_KCIN = A_VWT + (size_t)T * 256;
constexpr size_t A_VCIN = A_KCIN + (size_t)T * 256 + 2048;
constexpr size_t A_CQN = A_VCIN + (size_t)T * 256 + 2048;
constexpr size_t A_CKVN = A_CQN + (size_t)T * 512;
constexpr size_t A_KROPE = A_CKVN + (size_t)T * 256;
constexpr size_t A_GATES = A_KROPE + (size_t)T * 64;
constexpr size_t A_END = A_GATES + (size_t)T * 96;
static_assert(A_END <= SZ_XA, "attention inputs fit R_XA");
constexpr size_t O_QM = 0;
constexpr size_t O_KM = O_QM + (size_t)T * 1536;
constexpr size_t O_VMT = O_KM + (size_t)T * 1536;
static_assert(O_VMT + (size_t)T * 1024 <= (size_t)T * 4096, "d_out scratch");

struct Params {
    const float* in[30];
    float* out;
    unsigned char* ws;
    int ph_lo, ph_hi, dbg_branch, pad_;
};

#ifdef PROF_SEL
#define PROF_SLOT(k) ((unsigned long long*)(p.ws + SM_CTL + 2048) + (k))
#define PROF_ON(cond) ((cond) && threadIdx.x == 0)
#ifndef PROF_WAVE
#define PROF_WAVE 0
#endif
#endif
constexpr int LDS_BYTES = 147456;

__device__ __forceinline__ int ltid() { int t = threadIdx.x; asm volatile("" : "+v"(t)); return t; }
__device__ __forceinline__ int perm16(int k) { return (k & ~12) | ((k & 4) << 1) | ((k & 8) >> 1); }

struct WDesc { int in_idx, K, N, rep, map, row_off; size_t src_stride, dst_off, dst_stride; int gain_idx, pad_; size_t src_off; };
__device__ const WDesc WDESC[13] = {
    {3, 1024, 1720, 1, 2, 0, 0, W_IN_E / 2, 0, -1, 0},
    {7, 1024, 256, 2, 0, 0, (size_t)2048 * 256, W_CW1 / 2, (size_t)512 * 1024, -1, 0, 0},
    {7, 1024, 256, 2, 0, 256, (size_t)2048 * 256, W_CW1 / 2, (size_t)512 * 1024, -1, 0, (size_t)1024 * 256},
    {11, 256, 768, 1, 3, 0, 0, W_UQ / 2, 0, -1, 0},
    {12, 128, 1024, 1, 0, 0, 0, W_UKV / 2, 0, -1, 0},
    {15, 1024, 1024, 1, 0, 0, 0, W_OUT_E / 2, 0, -1, 0},
    {17, 1024, 2816, 1, 1, 0, 0, W_GU / 2, 0, 16, 0},
    {18, 1024, 2816, 1, 1, 128, 0, W_GU / 2, 0, 16, 0},
    {19, 2816, 1024, 1, 0, 0, 0, W_D / 2, 0, -1, 0},
    {21, 1024, 3072, 1, 4, 0, 0, W_IN_O / 2, 0, 20, 0},
    {23, 1024, 1024, 1, 0, 0, 0, W_OUT_O / 2, 0, -1, 0},
    {27, 1024, 1408, 8, 1, 0, (size_t)1024 * 1408, W_MGU / 2, (size_t)2816 * 1024, -1, 0},
    {28, 1024, 1408, 8, 1, 128, (size_t)1024 * 1408, W_MGU / 2, (size_t)2816 * 1024, -1, 0},
};
__device__ const WDesc WDESC_MD = {29, 1408, 1024, 8, 0, 0, (size_t)1408 * 1024, W_MD / 2, (size_t)1024 * 1408, -1, 0};

__device__ __forceinline__ void transpose_item(const float* W, int K, int N, bf16_t* WT, int map, int row_off, const float* gain, LAS float* scr, int item, int lane) {
    const int nblk = (N + 31) / 32, kb = item / nblk, nb = item % nblk, k0 = 64 * kb, n0 = 32 * nb;
    const int n4 = (lane & 7) * 4; const bool nok = (n0 + n4) < N;
    f32x4 v[8];
#pragma unroll
    for (int i = 0; i < 8; ++i) { const int kk = (lane >> 3) + 8 * i; v[i] = nok ? *(const f32x4*)(W + (size_t)(k0 + kk) * N + n0 + n4) : (f32x4){0.f, 0.f, 0.f, 0.f}; if (gain) v[i] = v[i] * gain[k0 + kk]; }
#pragma unroll
    for (int i = 0; i < 8; ++i) { const int kk = (lane >> 3) + 8 * i; LAS float* d = scr + kk * 33 + n4; d[0] = v[i].x; d[1] = v[i].y; d[2] = v[i].z; d[3] = v[i].w; }
    asm volatile("s_waitcnt lgkmcnt(0)" ::: "memory");
    const int c = lane & 7;
#pragma unroll
    for (int j = 0; j < 4; ++j) { const int n = (lane >> 3) + 8 * j; const LAS float* s = scr + (8 * c) * 33 + n;
        u32x4 o; o.x = cvtpk(s[0 * 33], s[1 * 33]); o.y = cvtpk(s[2 * 33], s[3 * 33]); o.z = cvtpk(s[4 * 33], s[5 * 33]); o.w = cvtpk(s[6 * 33], s[7 * 33]);
        const int nn = n0 + n;
        if (nn < N) { const int row = (map == 1) ? (256 * (nn >> 7) + (nn & 127) + row_off) : (map == 2) ? (nn < 1280 ? nn : (nn < 1304 ? nn + 416 : nn - 24)) : (map == 3) ? ((nn / 96) * 128 + nn % 96) : (map == 4) ? (nn < 1024 ? nn : (nn < 2048 ? 1024 + 256 * ((nn - 1024) >> 7) + ((nn - 1024) & 127) : 1024 + 256 * ((nn - 2048) >> 7) + 128 + ((nn - 2048) & 127))) : (nn + row_off);
            *(u32x4*)(WT + (size_t)row * K + k0 + 8 * c) = o; } }
    asm volatile("s_waitcnt lgkmcnt(0)" ::: "memory");
}
__device__ __forceinline__ void do_wdesc(const Params& p, const WDesc& d, int it, LAS float* scr, int lane) {
    const int per = (d.K / 64) * ((d.N + 31) / 32); const int r = it / per, ii = it % per;
    transpose_item(p.in[d.in_idx] + d.src_off + (size_t)r * d.src_stride, d.K, d.N, (bf16_t*)p.ws + d.dst_off + (size_t)r * d.dst_stride, d.map, d.row_off, d.gain_idx >= 0 ? p.in[d.gain_idx] : nullptr, scr, ii, lane);
}
__device__ __forceinline__ void rms_row_to_bf16(const float* xrow, const float* g, bf16_t* orow, int lane) {
    const f32x4* xr = (const f32x4*)xrow + lane; const f32x4* gr = (const f32x4*)g + lane;
    f32x4 v[4]; float s = 0.f;
#pragma unroll
    for (int j = 0; j < 4; ++j) { v[j] = xr[64 * j]; s += (v[j].x * v[j].x + v[j].y * v[j].y) + (v[j].z * v[j].z + v[j].w * v[j].w); }
    const float r = rsqrtf(wsum(s) * (1.f / 1024.f) + EPS);
    u32x2* o8 = (u32x2*)orow + lane;
#pragma unroll
    for (int j = 0; j < 4; ++j) { const f32x4 gg = gr[64 * j]; u32x2 w; w.x = cvtpk(v[j].x * r * gg.x, v[j].y * r * gg.y); w.y = cvtpk(v[j].z * r * gg.z, v[j].w * r * gg.w); o8[64 * j] = w; }
}
__device__ __forceinline__ void phase_p0(const Params& p, LAS unsigned char* lds) {
    const int tid = ltid(), lane = tid & 63, wave = tid >> 6;
    const int gw = blockIdx.x * 8 + wave, NGW = gridDim.x * 8;
    LAS float* scr = (LAS float*)(lds + wave * 16384);
    int base = 0;
#pragma unroll 1
    for (int d = 0; d < 14; ++d) {
        const WDesc& wd = (d < 13) ? WDESC[d] : WDESC_MD;
        const int n_it = wd.rep * (wd.K / 64) * ((wd.N + 31) / 32);
        int first = (gw - (base % NGW) + NGW) % NGW;
        for (int it = first; it < n_it; it += NGW) do_wdesc(p, wd, it, scr, lane);
        base += n_it;
    }
    bf16_t* xn = (bf16_t*)(p.ws + R_XN);
    for (int m = gw; m < T; m += 2 * NGW) { rms_row_to_bf16(p.in[0] + (size_t)m * D, p.in[2], xn + (size_t)m * D, lane); if (m + NGW < T) rms_row_to_bf16(p.in[0] + (size_t)(m + NGW) * D, p.in[2], xn + (size_t)(m + NGW) * D, lane); }
    for (int u = gw; u < 256; u += NGW) {
        const int kc = u >> 3, kv = (u >> 2) & 1, nb = u & 3; float s = 0.f;
        const float* pos = p.in[6] + kv * 2048 + kc * 64; const float* w1 = p.in[7] + ((size_t)kv * 2048 + kc * 64) * 256 + nb * 64 + lane;
#pragma unroll 8
        for (int k = 0; k < 64; ++k) s += pos[k] * w1[(size_t)k * 256];
        ((float*)(p.ws + SM_B1P))[kc * 512 + kv * 256 + nb * 64 + lane] = s;
    }
    for (int i = blockIdx.x * 512 + tid; i < S * 16; i += gridDim.x * 512) {
        const int t = i >> 4, f = i & 15; const float ang = (float)t * powf(10000.f, -(float)f / 16.f);
        float* rp = (float*)(p.ws + SM_ROPE) + t * 32; rp[f] = cosf(ang); rp[16 + f] = sinf(ang);
    }
    if (blockIdx.x == 0) for (int i = tid; i < 8 * 129; i += 512) { const int h = i / 129, dd = i % 129; ((float*)(p.ws + SM_BL))[h * 132 + dd] = p.in[1][(dd < 128 ? (int)gold::T5B[dd] : 31) * 8 + h] * LOG2E; }
}

__device__ __forceinline__ void unpack8(const u32x4 v, float (&x)[8]) { x[0] = bflo(v.x); x[1] = bfhi(v.x); x[2] = bflo(v.y); x[3] = bfhi(v.y); x[4] = bflo(v.z); x[5] = bfhi(v.z); x[6] = bflo(v.w); x[7] = bfhi(v.w); }
__device__ __forceinline__ u32x4 pack8(const float (&x)[8]) { u32x4 w; w.x = cvtpk(x[0], x[1]); w.y = cvtpk(x[2], x[3]); w.z = cvtpk(x[4], x[5]); w.w = cvtpk(x[6], x[7]); return w; }
__device__ __forceinline__ float ss8f(const float (&x)[8]) { return ((x[0] * x[0] + x[1] * x[1]) + (x[2] * x[2] + x[3] * x[3])) + ((x[4] * x[4] + x[5] * x[5]) + (x[6] * x[6] + x[7] * x[7])); }
__device__ __forceinline__ void load8f(const float* g, float (&x)[8], float sc) { const f32x4 a = *(const f32x4*)g, b = *(const f32x4*)(g + 4); x[0] = a.x * sc; x[1] = a.y * sc; x[2] = a.z * sc; x[3] = a.w * sc; x[4] = b.x * sc; x[5] = b.y * sc; x[6] = b.z * sc; x[7] = b.w * sc; }
__device__ __forceinline__ void phase_p2(const Params& p, LAS unsigned char* lds) {
    const int tid = ltid(), lane = tid & 63, wave = tid >> 6;
    const bf16_t* hb = (const bf16_t*)(p.ws + R_H);
    unsigned char* xa = p.ws + R_XA;
    bf16_t* qn = (bf16_t*)(xa + A_QN); bf16_t* ksn = (bf16_t*)(xa + A_KSN); bf16_t* kwn = (bf16_t*)(xa + A_KWN);
    bf16_t* vst = (bf16_t*)(xa + A_VST); bf16_t* vwt = (bf16_t*)(xa + A_VWT); bf16_t* kcin = (bf16_t*)(xa + A_KCIN); bf16_t* vcin = (bf16_t*)(xa + A_VCIN);
    bf16_t* cqn = (bf16_t*)(xa + A_CQN); bf16_t* ckvn = (bf16_t*)(xa + A_CKVN); bf16_t* krope = (bf16_t*)(xa + A_KROPE); float* gates = (float*)(xa + A_GATES);
    LAS bf16_t* vs = (LAS bf16_t*)lds;
    if (blockIdx.x == 0) {
        { float s = 0.f; for (int k = 0; k < 32; ++k) s += ((const float*)(p.ws + SM_B1P))[k * 512 + tid]; ((float*)(p.ws + SM_B1))[tid] = s; }
        for (int i = tid; i < 1024; i += 512) { kcin[(size_t)T * 128 + i] = 0; vcin[(size_t)T * 128 + i] = 0; }
    }
    const int c8 = (lane & 7) * 8, seg = lane >> 3;
    float qg[8], ksg[8], kwg[8], cqg[8], ckvg[8];
    load8f(p.in[4] + c8, qg, 0.125f * LOG2E); load8f(p.in[5] + 64 + c8, ksg, 1.f); load8f(p.in[5] + 128 + c8, kwg, 1.f);
    load8f(p.in[9] + (lane & 31) * 8, cqg, 1.f); load8f(p.in[10] + (lane & 15) * 8, ckvg, 1.f);
    for (int tile = blockIdx.x; tile < T / 64; tile += gridDim.x) {
        const int b = tile / (S / 64), s0 = (tile % (S / 64)) * 64;
#pragma unroll 4
        for (int tt = 0; tt < 8; ++tt) {
            const int sl = wave * 8 + tt, s = s0 + sl; const size_t t = (size_t)b * S + s;
            const bf16_t* hr = hb + t * 1792 + lane * 8;
            const u32x4 L0 = *(const u32x4*)hr, L1 = *(const u32x4*)(hr + 512), L2 = *(const u32x4*)(hr + 1024);
            u32x4 L3 = {0u, 0u, 0u, 0u}; if (lane < 32) L3 = *(const u32x4*)(hr + 1536);
            float x0[8], x1[8], x2[8], x3[8];
            unpack8(L0, x0); unpack8(L1, x1); unpack8(L2, x2); unpack8(L3, x3);
            float a0 = ss8f(x0), a1 = ss8f(x1), a2 = ss8f(x2), a3 = ss8f(x3);
#pragma unroll
            for (int o = 1; o < 8; o <<= 1) { a0 += __shfl_xor(a0, o); a1 += __shfl_xor(a1, o); a2 += __shfl_xor(a2, o); a3 += __shfl_xor(a3, o); }
            float a2w = a2 + __shfl_xor(a2, 8); a2w += __shfl_xor(a2w, 16);
            const float a3w = a3 + __shfl_xor(a3, 8);
            const int pp0 = (sl & ~15) | perm16(sl & 15);
            const int pp = (((pp0 >> 3) ^ (lane & 7)) << 3) | (pp0 & 7);
            {
                const float r = rsqrtf(a0 * (1.f / 64.f) + EPS); float y[8];
#pragma unroll
                for (int j = 0; j < 8; ++j) y[j] = x0[j] * r * qg[j];
                *(u32x4*)(qn + t * 512 + lane * 8) = pack8(y);
            }
            {
                const int g = seg & 1; const size_t gm = (((size_t)b * 2 + g) * S + s) * 64 + c8;
                if (seg < 2) *(u32x4*)(kcin + gm) = L1;
                else if (seg < 4) *(u32x4*)(vcin + gm) = L1;
                else if (seg < 6) { const float r = rsqrtf(a1 * (1.f / 64.f) + EPS); float y[8];
#pragma unroll
                    for (int j = 0; j < 8; ++j) y[j] = x1[j] * r * ksg[j];
                    *(u32x4*)(ksn + gm) = pack8(y); }
                else {
#pragma unroll
                    for (int j = 0; j < 8; ++j) vs[((0 + g) * 64 + c8 + j) * 72 + pp] = (bf16_t)((j & 1) ? (L1[j >> 1] >> 16) : (L1[j >> 1] & 0xffffu)); }
            }
            {
                const int g = seg & 1; const size_t gm = (((size_t)b * 2 + g) * S + s) * 64 + c8;
                if (seg < 2) { const float r = rsqrtf(a2 * (1.f / 64.f) + EPS); float y[8];
#pragma unroll
                    for (int j = 0; j < 8; ++j) y[j] = x2[j] * r * kwg[j];
                    *(u32x4*)(kwn + gm) = pack8(y); }
                else if (seg < 4) {
#pragma unroll
                    for (int j = 0; j < 8; ++j) vs[((2 + g) * 64 + c8 + j) * 72 + pp] = (bf16_t)((j & 1) ? (L2[j >> 1] >> 16) : (L2[j >> 1] & 0xffffu)); }
                else { const float r = rsqrtf(a2w * (1.f / 256.f) + EPS); float y[8];
#pragma unroll
                    for (int j = 0; j < 8; ++j) y[j] = x2[j] * r * cqg[j];
                    *(u32x4*)(cqn + t * 256 + (lane - 32) * 8) = pack8(y); }
            }
            {
                if (lane < 16) { const float r = rsqrtf(a3w * (1.f / 128.f) + EPS); float y[8];
#pragma unroll
                    for (int j = 0; j < 8; ++j) y[j] = x3[j] * r * ckvg[j];
                    *(u32x4*)(ckvn + t * 128 + lane * 8) = pack8(y); }
                else if (lane < 20) *(u32x4*)(krope + t * 32 + (lane - 16) * 8) = L3;
                else if (lane < 23) { float y[8];
#pragma unroll
                    for (int j = 0; j < 8; ++j) y[j] = frcp(1.f + fexp2(-x3[j] * LOG2E));
                    float* gp = gates + t * 24 + (lane - 20) * 8; *(f32x4*)gp = (f32x4){y[0], y[1], y[2], y[3]}; *(f32x4*)(gp + 4) = (f32x4){y[4], y[5], y[6], y[7]}; }
            }
        }
        __syncthreads();
        {
            const int row = tid >> 1, half = tid & 1, which = row >> 6, d = row & 63, g = which & 1;
            bf16_t* dst = ((which < 2) ? vst : vwt) + (((size_t)b * 2 + g) * 64 + d) * S + s0 + half * 32;
            const LAS bf16_t* src = vs + row * 72; const int sx = (row >> 3) & 7;
#pragma unroll
            for (int c = 0; c < 4; ++c) *(u32x4*)(dst + c * 8) = *(const LAS u32x4*)(src + (((half * 4 + c) ^ sx) << 3));
        }
        __syncthreads();
    }
}
__device__ __forceinline__ void phase_p3b(const Params& p, LAS unsigned char* lds) {
    const int tid = ltid(), lane = tid & 63, wave = tid >> 6;
    const int gw = blockIdx.x * 8 + wave, NGW = gridDim.x * 8;
    const bf16_t* qraw = (const bf16_t*)(p.ws + R_H);
    const bf16_t* kvraw = (const bf16_t*)(p.ws + R_H + (size_t)T * 2048);
    const bf16_t* krope = (const bf16_t*)(p.ws + R_XA + A_KROPE);
    const float* rope = (const float*)(p.ws + SM_ROPE);
    bf16_t* qm = (bf16_t*)((unsigned char*)p.out + O_QM); bf16_t* km = (bf16_t*)((unsigned char*)p.out + O_KM); bf16_t* vmt = (bf16_t*)((unsigned char*)p.out + O_VMT);
    const float* q_norm = p.in[13]; const float* k_norm = p.in[14];
    LAS bf16_t* vs = (LAS bf16_t*)lds;
    LAS float* w2s = (LAS float*)(lds + 73728);
    for (int kv = 0; kv < 2; ++kv) {
        __syncthreads();
        for (int i = tid; i < 256 * 64; i += 512) w2s[i] = p.in[8][kv * 16384 + i];
        __syncthreads();
        const bf16_t* P = (const bf16_t*)(p.ws + SM_HID) + (size_t)kv * NB * 512 * 512;
        const f32x4 bs = *(const f32x4*)((const float*)(p.ws + SM_B1) + kv * 256 + lane * 4);
        for (int row = gw; row < NB * 512; row += NGW) {
            const int row1 = row + 1 < NB * 512 ? row + 1 : row;
            const u32x2 pa = *(const u32x2*)(P + (size_t)row * 512 + lane * 4), pb = *(const u32x2*)(P + (size_t)row1 * 512 + 256 + lane * 4);
            const float h0 = gelu_tanh_f(bflo(pa.x) + bflo(pb.x) + bs.x), h1 = gelu_tanh_f(bfhi(pa.x) + bfhi(pb.x) + bs.y), h2 = gelu_tanh_f(bflo(pa.y) + bflo(pb.y) + bs.z), h3 = gelu_tanh_f(bfhi(pa.y) + bfhi(pb.y) + bs.w);
            float acc = 0.f;
#pragma unroll 8
            for (int k4 = 0; k4 < 64; ++k4) {
                acc += __shfl(h0, k4) * w2s[(k4 * 4 + 0) * 64 + lane]; acc += __shfl(h1, k4) * w2s[(k4 * 4 + 1) * 64 + lane];
                acc += __shfl(h2, k4) * w2s[(k4 * 4 + 2) * 64 + lane]; acc += __shfl(h3, k4) * w2s[(k4 * 4 + 3) * 64 + lane];
            }
            if (kv == 0) { const float r = rsqrtf(wsum(acc * acc) * (1.f / 64.f) + EPS); ((bf16_t*)(p.ws + SM_KC))[(size_t)row * 64 + lane] = f2bf(acc * r * p.in[5][lane]); }
            else { const int c = row & 255; ((bf16_t*)(p.ws + SM_VCT))[((size_t)(row >> 8) * 64 + lane) * 256 + ((c & ~15) | perm16(c & 15))] = f2bf(acc); }
        }
    }
    __syncthreads();
    const float QS = 0.10206207261596577f * LOG2E;
    const int c = lane & 15, hl = lane >> 4;
    float qg[8], kg[8];
    load8f(q_norm + (c < 12 ? c * 8 : 0), qg, QS);
    load8f(k_norm + (c < 12 ? c * 8 : 0), kg, 1.f);
    for (int tile = blockIdx.x; tile < T / 64; tile += gridDim.x) {
        const int b = tile / (S / 64), s0 = (tile % (S / 64)) * 64;
#pragma unroll 4
        for (int tt = 0; tt < 8; ++tt) {
            const int sl = wave * 8 + tt, s = s0 + sl; const size_t t = (size_t)b * S + s;
            const int pp0 = (sl & ~15) | perm16(sl & 15);
            const int pp = (((pp0 >> 3) ^ ((c - 8) & 7)) << 3) | (pp0 & 7);
            u32x4 Q[2], KV[2];
#pragma unroll
            for (int ld = 0; ld < 2; ++ld) { Q[ld] = *(const u32x4*)(qraw + t * 1024 + ld * 512 + lane * 8); KV[ld] = *(const u32x4*)(kvraw + t * 1024 + ld * 512 + lane * 8); }
            u32x4 KR = {0u, 0u, 0u, 0u}; f32x4 cs0 = {0.f, 0.f, 0.f, 0.f}, cs1 = cs0, sn0 = cs0, sn1 = cs0;
            if (c >= 8 && c < 12) { KR = *(const u32x4*)(krope + t * 32 + (c - 8) * 8);
                const float* rp = rope + s * 32 + (c & 1) * 8; cs0 = *(const f32x4*)rp; cs1 = *(const f32x4*)(rp + 4); sn0 = *(const f32x4*)(rp + 16); sn1 = *(const f32x4*)(rp + 20); }
            const float cs[8] = {cs0.x, cs0.y, cs0.z, cs0.w, cs1.x, cs1.y, cs1.z, cs1.w}, sn[8] = {sn0.x, sn0.y, sn0.z, sn0.w, sn1.x, sn1.y, sn1.z, sn1.w};
            float kr[8]; unpack8(KR, kr);
            const float krs = ss8f(kr);
#pragma unroll
            for (int ld = 0; ld < 2; ++ld) {
                const int hh = ld * 4 + hl;
                {
                    float x[8]; unpack8(Q[ld], x);
                    float ss = c < 12 ? ss8f(x) : 0.f;
#pragma unroll
                    for (int o = 1; o < 16; o <<= 1) ss += __shfl_xor(ss, o);
                    const float r = rsqrtf(ss * (1.f / 96.f) + EPS); float y[8], z[8];
#pragma unroll
                    for (int j = 0; j < 8; ++j) y[j] = x[j] * r * qg[j];
#pragma unroll
                    for (int j = 0; j < 8; ++j) { const float pb = __shfl_xor(y[j], 2); z[j] = (c < 8) ? y[j] : ((c < 10) ? (y[j] * cs[j] - pb * sn[j]) : (pb * sn[j] + y[j] * cs[j])); }
                    if (c < 12) *(u32x4*)(qm + (t * 8 + hh) * 96 + c * 8) = pack8(z);
                }
                {
                    float x[8]; unpack8(KV[ld], x);
                    float ss = c < 8 ? ss8f(x) : krs;
#pragma unroll
                    for (int o = 1; o < 16; o <<= 1) ss += __shfl_xor(ss, o);
                    const float r = rsqrtf(ss * (1.f / 96.f) + EPS); float y[8], z[8];
#pragma unroll
                    for (int j = 0; j < 8; ++j) y[j] = (c < 8 ? x[j] : kr[j]) * r * kg[j];
#pragma unroll
                    for (int j = 0; j < 8; ++j) { const float pb = __shfl_xor(y[j], 2); z[j] = (c < 8) ? y[j] : ((c < 10) ? (y[j] * cs[j] - pb * sn[j]) : (pb * sn[j] + y[j] * cs[j])); }
                    if (c < 12) *(u32x4*)(km + (((size_t)b * 8 + hh) * S + s) * 96 + c * 8) = pack8(z);
                    if (c >= 8) {
#pragma unroll
                        for (int j = 0; j < 8; ++j) vs[(hh * 64 + (c - 8) * 8 + j) * 72 + pp] = (bf16_t)((j & 1) ? (KV[ld][j >> 1] >> 16) : (KV[ld][j >> 1] & 0xffffu)); }
                }
            }
        }
        __syncthreads();
        {
            const int hh = tid >> 6, d = tid & 63;
            bf16_t* dst = vmt + (((size_t)b * 8 + hh) * 64 + d) * S + s0;
            const LAS bf16_t* src = vs + tid * 72; const int sx = (tid >> 3) & 7;
#pragma unroll
            for (int cc = 0; cc < 8; ++cc) *(u32x4*)(dst + cc * 8) = *(const LAS u32x4*)(src + ((cc ^ sx) << 3));
        }
        __syncthreads();
    }
}

__device__ const unsigned short UNIT_TYPES[256] = {63,127,62,126,61,125,527,591,655,719,783,847,911,975,60,124,59,123,58,122,57,121,56,120,526,590,654,718,782,846,910,974,55,119,54,118,53,117,52,116,51,115,525,589,653,717,781,845,909,973,50,114,49,113,48,112,47,111,524,588,652,716,780,844,908,972,46,110,45,109,44,108,43,107,523,587,651,715,779,843,907,971,42,106,41,105,40,104,39,103,38,102,522,586,650,714,778,842,906,970,37,101,36,100,35,99,34,98,33,97,521,585,649,713,777,841,905,969,32,96,31,95,30,94,520,584,648,712,776,840,904,968,29,93,28,92,27,91,26,90,25,89,519,583,647,711,775,839,903,967,24,88,23,87,22,86,21,85,20,84,518,582,646,710,774,838,902,966,19,83,18,82,17,81,16,80,15,79,517,581,645,709,773,837,901,965,14,78,13,77,12,76,516,580,644,708,772,836,900,964,11,75,10,74,9,73,8,72,515,579,643,707,771,835,899,963,7,71,6,70,5,69,514,578,642,706,770,834,898,962,4,68,3,67,513,577,641,705,769,833,897,961,2,66,1,65,0,64,512,576,640,704,768,832,896,960};
__device__ __forceinline__ int crow(int r, int hi) { return (r & 3) + 8 * (r >> 2) + 4 * hi; }
struct Flash { f32x16 o0, o1; float l; };
__device__ __forceinline__ void flash_init(Flash& st) {
#pragma unroll
    for (int r = 0; r < 16; ++r) { st.o0[r] = 0.f; st.o1[r] = 0.f; }
    st.l = 0.f;
}
constexpr int AL_K64 = 0, AL_V64 = 3 * 8192;
constexpr int AL_K96 = 0, AL_V96 = 3 * 16384;
constexpr int AL_IMP = 49152, AL_SELB = AL_IMP + 64 * 65 * 4, AL_UNI = AL_SELB + 512, AL_TL = AL_UNI + 64, AL_BL = AL_TL + 128, AL_OT = AL_BL + 4 * 132 * 4, AL_END = AL_OT + 8 * 32 * 64 * 4;
static_assert(AL_END <= 139264 && AL_V96 + 3 * 8192 <= 139264, "attention LDS");

template <int RB> struct DmaLane { unsigned g0, g1; };
template <int RB> __device__ __forceinline__ void dma_setup(DmaLane<RB>& L, int w, int lane, unsigned gs) {
    if (RB == 128) { const int r = 8 * w + (lane >> 3), c = (lane & 7) ^ ((r >> 1) & 7); L.g0 = (unsigned)r * gs + c * 16; L.g1 = 0; }
    else {
        { const int r = 8 * w + (lane >> 4); int c = (lane & 15) ^ (r & 15); c = c >= 12 ? c - 4 : c; L.g0 = (unsigned)r * gs + c * 16; }
        { const int r = 8 * w + 4 + (lane >> 4); int c = (lane & 15) ^ (r & 15); c = c >= 12 ? c - 4 : c; L.g1 = (unsigned)r * gs + c * 16; }
    }
}
template <int RB> __device__ __forceinline__ void dma_issue(const unsigned char* tile, const DmaLane<RB>& L, LAS unsigned char* buf, int w) {
    if (RB == 128) __builtin_amdgcn_global_load_lds((const unsigned*)(tile + L.g0), (LAS unsigned*)(buf + w * 1024), 16, 0, 0);
    else { __builtin_amdgcn_global_load_lds((const unsigned*)(tile + L.g0), (LAS unsigned*)(buf + w * 2048), 16, 0, 0);
           __builtin_amdgcn_global_load_lds((const unsigned*)(tile + L.g1), (LAS unsigned*)(buf + w * 2048 + 1024), 16, 0, 0); }
}
template <int DK> __device__ __forceinline__ void frag_offsets(unsigned (&kl)[DK / 16], unsigned (&vl)[4], int r32, int hi) {
#pragma unroll
    for (int s = 0; s < DK / 16; ++s) kl[s] = (DK == 64) ? (unsigned)(r32 * 128 + (((2 * s + hi) ^ ((r32 >> 1) & 7)) << 4)) : (unsigned)(r32 * 256 + (((2 * s + hi) ^ (r32 & 15)) << 4));
#pragma unroll
    for (int s = 0; s < 4; ++s) vl[s] = (unsigned)(r32 * 128 + (((2 * s + hi) ^ ((r32 >> 1) & 7)) << 4));
}

template <int DK, int KP, bool LANEMASK, class F>
__device__ __forceinline__ void tile_compute(Flash& st, const LAS unsigned char* Kt, const LAS unsigned char* Vt, const bf16x8* qf, const f32x16& negm, const unsigned (&kl)[DK / 16], const unsigned (&vl)[4], bool mine, F f) {
    constexpr int NS = DK / 16; constexpr int KH = 32 * KP;
    bf16x8 ka[NS], kh[NS];
#pragma unroll
    for (int s = 0; s < NS; ++s) ka[s] = *(const LAS bf16x8*)(Kt + kl[s]);
#pragma unroll
    for (int s = 0; s < NS; ++s) kh[s] = *(const LAS bf16x8*)(Kt + kl[s] + KH);
    __builtin_amdgcn_sched_barrier(0);
    f32x16 p0, p1;
#pragma unroll
    for (int s = 0; s < NS; ++s) p0 = (s == 0) ? __builtin_amdgcn_mfma_f32_32x32x16_bf16(ka[0], qf[0], negm, 0, 0, 0) : __builtin_amdgcn_mfma_f32_32x32x16_bf16(ka[s], qf[s], p0, 0, 0, 0);
#pragma unroll
    for (int s = 0; s < NS; ++s) p1 = (s == 0) ? __builtin_amdgcn_mfma_f32_32x32x16_bf16(kh[0], qf[0], negm, 0, 0, 0) : __builtin_amdgcn_mfma_f32_32x32x16_bf16(kh[s], qf[s], p1, 0, 0, 0);
    bf16x8 va[4], vh[4];
#pragma unroll
    for (int s = 0; s < 4; ++s) { va[s] = *(const LAS bf16x8*)(Vt + vl[s]); vh[s] = *(const LAS bf16x8*)(Vt + vl[s] + 4096); }
    __builtin_amdgcn_sched_barrier(0);
    float ls = 0.f;
    u32x4 w0, w1, w2, w3;
    {
#pragma unroll
        for (int r = 0; r < 16; ++r) { float x = p0[r]; const bool v = f(r, 0, x); const float e = fexp2(x); p0[r] = v ? e : 0.f; ls += p0[r]; }
        w0.x = cvtpk(p0[0], p0[1]); w0.y = cvtpk(p0[2], p0[3]); w0.z = cvtpk(p0[4], p0[5]); w0.w = cvtpk(p0[6], p0[7]);
        w1.x = cvtpk(p0[8], p0[9]); w1.y = cvtpk(p0[10], p0[11]); w1.z = cvtpk(p0[12], p0[13]); w1.w = cvtpk(p0[14], p0[15]);
        if (LANEMASK) { w0.x = mine ? w0.x : 0u; w0.y = mine ? w0.y : 0u; w0.z = mine ? w0.z : 0u; w0.w = mine ? w0.w : 0u; w1.x = mine ? w1.x : 0u; w1.y = mine ? w1.y : 0u; w1.z = mine ? w1.z : 0u; w1.w = mine ? w1.w : 0u; }
    }
#pragma unroll
    for (int s = 0; s < 2; ++s) {
        const bf16x8 pa = __builtin_bit_cast(bf16x8, s ? w1 : w0);
        st.o0 = __builtin_amdgcn_mfma_f32_32x32x16_bf16(pa, va[s], st.o0, 0, 0, 0);
        st.o1 = __builtin_amdgcn_mfma_f32_32x32x16_bf16(pa, vh[s], st.o1, 0, 0, 0);
    }
    {
#pragma unroll
        for (int r = 0; r < 16; ++r) { float x = p1[r]; const bool v = f(r, 1, x); const float e = fexp2(x); p1[r] = v ? e : 0.f; ls += p1[r]; }
        w2.x = cvtpk(p1[0], p1[1]); w2.y = cvtpk(p1[2], p1[3]); w2.z = cvtpk(p1[4], p1[5]); w2.w = cvtpk(p1[6], p1[7]);
        w3.x = cvtpk(p1[8], p1[9]); w3.y = cvtpk(p1[10], p1[11]); w3.z = cvtpk(p1[12], p1[13]); w3.w = cvtpk(p1[14], p1[15]);
        if (LANEMASK) { w2.x = mine ? w2.x : 0u; w2.y = mine ? w2.y : 0u; w2.z = mine ? w2.z : 0u; w2.w = mine ? w2.w : 0u; w3.x = mine ? w3.x : 0u; w3.y = mine ? w3.y : 0u; w3.z = mine ? w3.z : 0u; w3.w = mine ? w3.w : 0u; }
    }
    if (LANEMASK) ls = mine ? ls : 0.f;
    st.l += ls;
#pragma unroll
    for (int s = 2; s < 4; ++s) {
        const bf16x8 pa = __builtin_bit_cast(bf16x8, (s == 3) ? w3 : w2);
        st.o0 = __builtin_amdgcn_mfma_f32_32x32x16_bf16(pa, va[s], st.o0, 0, 0, 0);
        st.o1 = __builtin_amdgcn_mfma_f32_32x32x16_bf16(pa, vh[s], st.o1, 0, 0, 0);
    }
}
template <int DK, int KP> __device__ __forceinline__ void qk_tile(f32x16& p0, f32x16& p1, const LAS unsigned char* Kt, const bf16x8* qf, const f32x16& negm, const unsigned (&kl)[DK / 16]) {
#pragma unroll
    for (int s = 0; s < DK / 16; ++s) {
        const bf16x8 a0 = *(const LAS bf16x8*)(Kt + kl[s]);
        const bf16x8 a1 = *(const LAS bf16x8*)(Kt + kl[s] + 32 * KP);
        if (s == 0) { p0 = __builtin_amdgcn_mfma_f32_32x32x16_bf16(a0, qf[0], negm, 0, 0, 0); p1 = __builtin_amdgcn_mfma_f32_32x32x16_bf16(a1, qf[0], negm, 0, 0, 0); }
        else { p0 = __builtin_amdgcn_mfma_f32_32x32x16_bf16(a0, qf[s], p0, 0, 0, 0); p1 = __builtin_amdgcn_mfma_f32_32x32x16_bf16(a1, qf[s], p1, 0, 0, 0); }
    }
}
template <bool FIRST> __device__ __forceinline__ void flash_accum(LAS float* otl, const Flash& st, float gate, int hi, int lane) {
    const float lt = st.l + __shfl_xor(st.l, 32);
    const float f = lt > 0.f ? gate * frcp(lt) : 0.f;
#pragma unroll
    for (int r = 0; r < 16; ++r) { const float fr_ = __shfl(f, crow(r, hi));
        if (FIRST) { otl[r * 64 + lane] = fr_ * st.o0[r]; otl[(16 + r) * 64 + lane] = fr_ * st.o1[r]; }
        else { otl[r * 64 + lane] += fr_ * st.o0[r]; otl[(16 + r) * 64 + lane] += fr_ * st.o1[r]; } }
}
template <int NS> __device__ __forceinline__ float qnorm2(const bf16x8* qf) {
    float s = 0.f;
#pragma unroll
    for (int i = 0; i < NS; ++i)
#pragma unroll
        for (int j = 0; j < 8; ++j) { const float x = bf2f((bf16_t)qf[i][j]); s += x * x; }
    return s + __shfl_xor(s, 32);
}
__device__ __forceinline__ float wmax(float v) {
#pragma unroll
    for (int o = 1; o < 64; o <<= 1) v = fmaxf(v, __shfl_xor(v, o));
    return v;
}

template <int RBK, bool HASV, int KOFF, int KSZ, int VOFF, class SrcK, class SrcV, class Comp>
__device__ __forceinline__ void run_tiles(int n, LAS unsigned char* lds, int w, int lane, unsigned gsK, unsigned gsV, SrcK srcK, SrcV srcV, Comp comp) {
    DmaLane<RBK> LK; dma_setup<RBK>(LK, w, lane, gsK);
    DmaLane<128> LV; LV.g0 = 0; LV.g1 = 0; if (HASV) dma_setup<128>(LV, w, lane, gsV);
    const int nl = n - 1, t1 = nl < 1 ? nl : 1;
    dma_issue<RBK>(srcK(0), LK, lds + KOFF, w); if (HASV) dma_issue<128>(srcV(0), LV, lds + VOFF, w);
    dma_issue<RBK>(srcK(t1), LK, lds + KOFF + KSZ, w); if (HASV) dma_issue<128>(srcV(t1), LV, lds + VOFF + 8192, w);
    constexpr int P = (RBK == 128 ? 1 : 2) + (HASV ? 1 : 0);
#define RT_STEP(bi, ii) do { const int i_ = (ii); \
        if (P == 1) asm volatile("s_waitcnt vmcnt(1)" ::: "memory"); else if (P == 2) asm volatile("s_waitcnt vmcnt(2)" ::: "memory"); else asm volatile("s_waitcnt vmcnt(3)" ::: "memory"); \
        __builtin_amdgcn_s_barrier(); asm volatile("" ::: "memory"); \
        { const int tn = (i_ + 2 < nl) ? i_ + 2 : nl; constexpr int b2 = ((bi) + 2) % 3; \
          dma_issue<RBK>(srcK(tn), LK, lds + KOFF + b2 * KSZ, w); if (HASV) dma_issue<128>(srcV(tn), LV, lds + VOFF + b2 * 8192, w); } \
        if (i_ < n) comp(i_, lds + KOFF + (bi) * KSZ, lds + VOFF + (bi) * 8192); } while (0)
    for (int i = 0; i < n; i += 3) { RT_STEP(0, i); RT_STEP(1, i + 1); RT_STEP(2, i + 2); }
#undef RT_STEP
    asm volatile("s_waitcnt vmcnt(0)" ::: "memory");
    __syncthreads();
}

__device__ __forceinline__ void mla_unit(const Params& p, LAS unsigned char* lds, int b, int h, int qb) {
    int tid = threadIdx.x; asm volatile("" : "+v"(tid));
    const int lane = tid & 63, w = __builtin_amdgcn_readfirstlane(tid >> 6), r32 = lane & 31, hi = lane >> 5;
    const bf16_t* qm = (const bf16_t*)((const unsigned char*)p.out + O_QM);
    const unsigned char* km = (const unsigned char*)p.out + O_KM + (((size_t)b * 8 + h) * S) * 192;
    const unsigned char* vmt = (const unsigned char*)p.out + O_VMT + (((size_t)b * 8 + h) * 64) * (size_t)S * 2;
    bf16_t* ocat = (bf16_t*)(p.ws + R_XN);
    const int tq = qb * 256 + 32 * w + r32;
    bf16x8 qf[6];
#pragma unroll
    for (int s = 0; s < 6; ++s) qf[s] = *(const bf16x8*)(qm + (((size_t)b * S + tq) * 8 + h) * 96 + 16 * s + 8 * hi);
    const float kn = 9.797958971f * 1.01f * wmax(fmaxf(fabsf(p.in[14][lane]), lane < 32 ? fabsf(p.in[14][64 + lane]) : 0.f));
    const float mref = sqrtf(qnorm2<6>(qf)) * kn;
    f32x16 negm;
#pragma unroll
    for (int r = 0; r < 16; ++r) negm[r] = -mref;
    Flash st; flash_init(st);
    const int ntile = 4 * qb + 4, dt = 4 * qb + (w >> 1);
#ifdef PROF_SEL
    if (b == 0 && h == 0 && qb == 15 && threadIdx.x == 0) { *PROF_SLOT(36) -= __builtin_amdgcn_s_memtime(); *PROF_SLOT(37) -= __builtin_amdgcn_s_memrealtime(); }
#endif
    unsigned kl[6], vl[4]; frag_offsets<96>(kl, vl, r32, hi);
    run_tiles<192, true, AL_K96, 16384, AL_V96>(ntile, lds, w, lane, 192u, (unsigned)(S * 2),
        [&](int i) { return km + (size_t)i * 64 * 192; }, [&](int i) { return vmt + (size_t)i * 128; },
        [&](int i, LAS unsigned char* kb, LAS unsigned char* vb) {
            if (i <= dt) {
                if (i < dt) tile_compute<96, 256, false>(st, kb, vb, qf, negm, kl, vl, true, [&](int r, int half, float& x) { return true; });
                else { const int kb0 = 64 * i + 4 * hi; tile_compute<96, 256, false>(st, kb, vb, qf, negm, kl, vl, true, [&](int r, int half, float& x) { return (kb0 + 32 * half + (r & 3) + 8 * (r >> 2)) <= tq; }); }
            }
        });
#ifdef PROF_SEL
    if (b == 0 && h == 0 && qb == 15 && threadIdx.x == 0) { *PROF_SLOT(36) += __builtin_amdgcn_s_memtime(); *PROF_SLOT(37) += __builtin_amdgcn_s_memrealtime(); }
#endif
    {
        const float lt = st.l + __shfl_xor(st.l, 32); const float f = lt > 0.f ? frcp(lt) : 0.f;
#pragma unroll
        for (int r = 0; r < 16; ++r) { const float fr_ = __shfl(f, crow(r, hi)); const size_t ro = ((size_t)b * S + qb * 256 + 32 * w + crow(r, hi)) * 1024 + 512 + h * 64 + r32; ocat[ro] = f2bf(st.o0[r] * fr_); ocat[ro + 32] = f2bf(st.o1[r] * fr_); }
    }
}

__device__ __forceinline__ void nsa_unit(const Params& p, LAS unsigned char* lds, int b, int g, int jt) {
    int tid = threadIdx.x; asm volatile("" : "+v"(tid));
    const int lane = tid & 63, w = __builtin_amdgcn_readfirstlane(tid >> 6), r32 = lane & 31, hi = lane >> 5;
    const int rh = w >> 1, qh = w & 1, h = 4 * g + rh, q0 = 64 * jt, ql = 32 * qh + r32, tq = q0 + ql;
    const unsigned char* xa = p.ws + R_XA;
    const bf16_t* qn = (const bf16_t*)(xa + A_QN);
    const size_t bg = (size_t)b * 2 + g;
    const unsigned char* ksn = xa + A_KSN + bg * S * 128; const unsigned char* kwn = xa + A_KWN + bg * S * 128;
    const unsigned char* vst = xa + A_VST + bg * 64 * (size_t)S * 2; const unsigned char* vwt = xa + A_VWT + bg * 64 * (size_t)S * 2;
    const unsigned char* kc = p.ws + SM_KC + bg * 256 * 128; const unsigned char* vct = p.ws + SM_VCT + bg * 64 * 512;
    const float* gates = (const float*)(xa + A_GATES) + ((size_t)b * S + tq) * 24 + h * 3;
    bf16_t* ocat = (bf16_t*)(p.ws + R_XN);
    LAS float* imp = (LAS float*)(lds + AL_IMP); LAS unsigned char* selb = lds + AL_SELB; LAS unsigned* uni = (LAS unsigned*)(lds + AL_UNI); LAS unsigned char* tl = lds + AL_TL; LAS float* bls = (LAS float*)(lds + AL_BL);
    const float* blg = (const float*)(p.ws + SM_BL) + h * 132;
    const float cb = blg[128];
    const float bmax = wmax(fmaxf(fmaxf(blg[lane], blg[64 + lane]), cb));
    if (qh == 0) { bls[rh * 132 + lane] = blg[lane] - cb; bls[rh * 132 + 64 + lane] = blg[64 + lane] - cb; if (lane == 0) bls[rh * 132 + 128] = 0.f; }
    const LAS float* blh = bls + rh * 132;
    bf16x8 qf[4];
#pragma unroll
    for (int s = 0; s < 4; ++s) qf[s] = *(const bf16x8*)(qn + (((size_t)b * S + tq) * 8 + h) * 64 + 16 * s + 8 * hi);
    const float kn = 8.f * 1.01f * wmax(fmaxf(fmaxf(fabsf(p.in[5][lane]), fabsf(p.in[5][64 + lane])), fabsf(p.in[5][128 + lane])));
    const float mref = sqrtf(qnorm2<4>(qf)) * kn + bmax;
    f32x16 negm;
#pragma unroll
    for (int r = 0; r < 16; ++r) negm[r] = cb - mref;
    float g0 = gates[0], g1 = gates[1], g2 = gates[2];
    if (p.dbg_branch >= 0) { g0 = p.dbg_branch == 0 ? 1.f : 0.f; g1 = p.dbg_branch == 1 ? 1.f : 0.f; g2 = p.dbg_branch == 2 ? 1.f : 0.f; }
    LAS float* otl = (LAS float*)(lds + AL_OT) + w * 2048;
#ifdef PROF_SEL
    if (b == 0 && g == 0 && jt == 63 && threadIdx.x == 0) *PROF_SLOT(48) -= __builtin_amdgcn_s_memtime();
#endif
    const int nvmax = (q0 + 63 - 31) / 16 + 1, ntc = (nvmax + 63) / 64;
    Flash st; flash_init(st);
    unsigned kl[4], vl[4]; frag_offsets<64>(kl, vl, r32, hi);
    run_tiles<128, true, AL_K64, 8192, AL_V64>(ntc, lds, w, lane, 128u, 512u,
        [&](int i) { return kc + (size_t)i * 64 * 128; }, [&](int i) { return vct + (size_t)i * 128; },
        [&](int i, LAS unsigned char* kb, LAS unsigned char* vb) {
            const int cb0 = 64 * i + 4 * hi;
            if (q0 + 32 * qh - (16 * (64 * i + 63) + 31) >= 128) tile_compute<64, 128, false>(st, kb, vb, qf, negm, kl, vl, true, [&](int r, int half, float& x) { return true; });
            else tile_compute<64, 128, false>(st, kb, vb, qf, negm, kl, vl, true, [&](int r, int half, float& x) {
                const int c = cb0 + 32 * half + (r & 3) + 8 * (r >> 2); const int dist = tq - 16 * c - 31; x += blh[dist < 0 ? 0 : (dist > 128 ? 128 : dist)]; return dist >= 0; });
        });
    flash_accum<true>(otl, st, g0, hi, lane);
    unsigned mlo, mhi;
    int nsel;
    if (jt < 16) { const unsigned long long mk = (1ull << (jt + 1)) - 1ull; mlo = (unsigned)mk; mhi = (unsigned)(mk >> 32); nsel = jt + 1; if (tid <= jt) tl[tid] = (unsigned char)tid; }
    else {
        for (int i = tid; i < 64 * 65; i += 512) imp[i] = 0.f;
        const float lt = st.l + __shfl_xor(st.l, 32); const float linv = lt > 0.f ? frcp(lt) : 0.f;
        float xlast = 0.f;
        run_tiles<128, false, AL_K64, 8192, AL_V64>(ntc, lds, w, lane, 128u, 0u,
            [&](int i) { return kc + (size_t)i * 64 * 128; }, [&](int i) { return kc; },
            [&](int i, LAS unsigned char* kb, LAS unsigned char* vb) {
                f32x16 p0, p1; qk_tile<64, 128>(p0, p1, kb, qf, negm, kl);
                const int cb0 = 64 * i + 4 * hi;
                float sm[2][4], cr[2][4];
#pragma unroll
                for (int half = 0; half < 2; ++half)
#pragma unroll
                    for (int a = 0; a < 4; ++a) {
                        float s4 = 0.f, last = 0.f;
#pragma unroll
                        for (int k = 0; k < 4; ++k) {
                            const int r = 4 * a + k; const int c = cb0 + 32 * half + k + 8 * a; const int dist = tq - 16 * c - 31;
                            const float sc = (half ? p1[r] : p0[r]) + blh[dist < 0 ? 0 : (dist > 128 ? 128 : dist)];
                            const float pv = dist >= 0 ? fexp2(sc) * linv : 0.f;
                            s4 += pv; last = pv;
                        }
                        sm[half][a] = s4; cr[half][a] = last;
                    }
                float tot[2][4];
#pragma unroll
                for (int half = 0; half < 2; ++half)
#pragma unroll
                    for (int a = 0; a < 4; ++a) {
                        const float xs_ = __shfl_xor(cr[half][a], 32);
                        const float xp_ = (a > 0) ? __shfl_xor(cr[half][a > 0 ? a - 1 : 0], 32) : (half ? __shfl_xor(cr[0][3], 32) : xlast);
                        tot[half][a] = sm[half][a] + (hi ? xs_ : xp_);
                    }
                xlast = __shfl_xor(cr[1][3], 32);
                for (int rr = 0; rr < 4; ++rr) {
                    if (rh == rr) {
#pragma unroll
                        for (int half = 0; half < 2; ++half)
#pragma unroll
                            for (int a = 0; a < 4; ++a) { const int j = 16 * i + 8 * half + 2 * a + hi; imp[ql * 65 + j] += tot[half][a]; }
                    }
                    __syncthreads();
                }
            });
        if (p.dbg_branch == 1) { for (int i = tid; i < 4096; i += 512) ((float*)(p.ws + R_H))[((size_t)g * S + q0 + (i >> 6)) * 64 + (i & 63)] = imp[(i >> 6) * 65 + (i & 63)]; }
        {
            const int q = tid >> 3, jg = tid & 7;
            float vj[8]; int rk[8];
#pragma unroll
            for (int jj = 0; jj < 8; ++jj) { const int j = jg * 8 + jj; const float x = imp[q * 65 + j]; vj[jj] = (j > jt) ? -1.f : ((j == jt || j == 0) ? 1e9f : x); rk[jj] = 0; }
#pragma unroll 4
            for (int i = 0; i < 64; ++i) {
                const float xi = imp[q * 65 + i]; const float vi = (i > jt) ? -1.f : ((i == jt || i == 0) ? 1e9f : xi);
#pragma unroll
                for (int jj = 0; jj < 8; ++jj) rk[jj] += (vi > vj[jj] || (vi == vj[jj] && i < jg * 8 + jj)) ? 1 : 0;
            }
            unsigned byte = 0;
#pragma unroll
            for (int jj = 0; jj < 8; ++jj) if (jg * 8 + jj <= jt && rk[jj] < 16) byte |= 1u << jj;
            selb[q * 8 + jg] = (unsigned char)byte;
        }
        __syncthreads();
        if (w == 0) {
            unsigned a = ((const LAS unsigned*)selb)[lane * 2], c = ((const LAS unsigned*)selb)[lane * 2 + 1];
#pragma unroll
            for (int o = 1; o < 64; o <<= 1) { a |= __shfl_xor(a, o); c |= __shfl_xor(c, o); }
            const unsigned long long um = ((unsigned long long)c << 32) | a;
            if ((um >> lane) & 1ull) tl[__builtin_popcountll(um & ((1ull << lane) - 1ull))] = (unsigned char)lane;
            if (lane == 0) uni[0] = (unsigned)__builtin_popcountll(um);
        }
        __syncthreads();
        mlo = ((const LAS unsigned*)selb)[ql * 2]; mhi = ((const LAS unsigned*)selb)[ql * 2 + 1];
        nsel = (int)uni[0];
    }
    if (p.dbg_branch == 1 && rh == 0) { if (hi == 0) ((unsigned long long*)(p.ws + R_H + 4 * 1048576))[(size_t)g * S + tq] = ((unsigned long long)mhi << 32) | mlo; }
    __syncthreads();
    {
        const unsigned long long mymask = ((unsigned long long)mhi << 32) | mlo;
        nsel = __builtin_amdgcn_readfirstlane(nsel);
        const int mytl = (int)tl[lane];
        flash_init(st);
        run_tiles<128, true, AL_K64, 8192, AL_V64>(nsel, lds, w, lane, 128u, (unsigned)(S * 2),
            [&](int i) { return ksn + (size_t)__builtin_amdgcn_readlane(mytl, i) * 64 * 128; }, [&](int i) { return vst + (size_t)__builtin_amdgcn_readlane(mytl, i) * 128; },
            [&](int i, LAS unsigned char* kb, LAS unsigned char* vb) {
                const int j = __builtin_amdgcn_readlane(mytl, i);
                const bool mine = (mymask >> j) & 1ull;
                if (q0 + 32 * qh - (64 * j + 63) >= 128) tile_compute<64, 128, true>(st, kb, vb, qf, negm, kl, vl, mine, [&](int r, int half, float& x) { return true; });
                else { const int kb0 = 64 * j + 4 * hi;
                    tile_compute<64, 128, true>(st, kb, vb, qf, negm, kl, vl, mine, [&](int r, int half, float& x) { const int dist = tq - (kb0 + 32 * half + (r & 3) + 8 * (r >> 2)); x += blh[dist < 0 ? 0 : (dist > 128 ? 128 : dist)]; return dist >= 0; }); }
            });
        flash_accum<false>(otl, st, g1, hi, lane);
    }
    {
        const int j0 = jt >= 8 ? jt - 8 : 0, nw = jt - j0 + 1;
        flash_init(st);
        run_tiles<128, true, AL_K64, 8192, AL_V64>(nw, lds, w, lane, 128u, (unsigned)(S * 2),
            [&](int i) { return kwn + (size_t)(j0 + i) * 64 * 128; }, [&](int i) { return vwt + (size_t)(j0 + i) * 128; },
            [&](int i, LAS unsigned char* kb, LAS unsigned char* vb) {
                const int j = j0 + i, kb0 = 64 * j + 4 * hi;
                if (q0 + 32 * qh - (64 * j + 63) >= 128 && q0 + 32 * qh + 31 - 64 * j < 512) tile_compute<64, 128, false>(st, kb, vb, qf, negm, kl, vl, true, [&](int r, int half, float& x) { return true; });
                else tile_compute<64, 128, false>(st, kb, vb, qf, negm, kl, vl, true, [&](int r, int half, float& x) { const int dist = tq - (kb0 + 32 * half + (r & 3) + 8 * (r >> 2)); x += blh[dist < 0 ? 0 : (dist > 128 ? 128 : dist)]; return dist >= 0 && dist < 512; });
            });
        flash_accum<false>(otl, st, g2, hi, lane);
    }
#pragma unroll
    for (int r = 0; r < 16; ++r) { const size_t ro = ((size_t)b * S + q0 + 32 * qh + crow(r, hi)) * 1024 + h * 64 + r32; ocat[ro] = f2bf(otl[r * 64 + lane]); ocat[ro + 32] = f2bf(otl[(16 + r) * 64 + lane]); }
    __syncthreads();
#ifdef PROF_SEL
    if (b == 0 && g == 0 && jt == 63 && threadIdx.x == 0) *PROF_SLOT(48) += __builtin_amdgcn_s_memtime();
#endif
}

__device__ __forceinline__ void phase_p4(const Params& p, LAS unsigned char* lds) {
    const int G = gridDim.x, c = blockIdx.x, nunits = 256 * NB;
#if NB == 8
    if (G == 256) {
        const int b = c & 7, idx = c >> 3, pi = idx & 7, hq = idx >> 3;
#pragma unroll 1
        for (int u = 0; u < 8; ++u) {
            if (u < 4) { const int ix = (u >> 1) ? ((idx + 16) & 31) : idx;
                nsa_unit(p, lds, b, u >> 1, (u & 1) ? ix : 63 - ix); }
            else mla_unit(p, lds, b, ((u - 4) >> 1) * 4 + hq, (u & 1) ? pi : 15 - pi);
        }
        return;
    }
#endif
    for (int j = 0;; ++j) {
        const int k = j * G + ((j & 1) ? (G - 1 - c) : c);
        if (j * G >= nunits) break;
        if (k >= nunits) continue;
        const int ty = UNIT_TYPES[k / NB], b = k % NB, kind = ty >> 9, a = (ty >> 6) & 7, cc = ty & 63;
        if (kind == 0) nsa_unit(p, lds, b, a, cc); else mla_unit(p, lds, b, a, cc);
    }
}
__device__ __forceinline__ void phase_norm(const float* x, const float* g, bf16_t* xn) {
    const int tid_ = ltid(); const int lane = tid_ & 63, gw = blockIdx.x * 8 + (tid_ >> 6), NGW = gridDim.x * 8;
    for (int m = gw; m < T; m += NGW) rms_row_to_bf16(x + (size_t)m * D, g, xn + (size_t)m * D, lane);
}
__device__ __forceinline__ void phase_conv(const Params& p) {
    const int tid = ltid(), lane = tid & 63, gw = blockIdx.x * 8 + (tid >> 6), NGW = gridDim.x * 8;
    const bf16_t* bg = (const bf16_t*)(p.ws + R_H); const bf16_t* cu = (const bf16_t*)(p.ws + R_H + (size_t)T * 2048); bf16_t* v = (bf16_t*)(p.ws + R_XA); const float* cw = p.in[22];
    constexpr int RUN = 16;
    float w0[2][8], w1[2][8], w2[2][8];
#pragma unroll
    for (int j = 0; j < 2; ++j) { const int d = 8 * lane + 512 * j; load8f(cw + d, w0[j], 1.f); load8f(cw + 1024 + d, w1[j], 1.f); load8f(cw + 2048 + d, w2[j], 1.f); }
    for (int run = gw; run < T / RUN; run += NGW) {
        const int m0 = run * RUN, s0 = m0 & (S - 1);
        float pm2[2][8], pm1[2][8];
#pragma unroll
        for (int j = 0; j < 2; ++j) { const int d = 8 * lane + 512 * j;
#pragma unroll
            for (int q = 0; q < 2; ++q) {
                float (&dst)[8] = q ? pm1[j] : pm2[j];
                if (s0 - 2 + q >= 0) unpack8(*(const u32x4*)(cu + (size_t)(m0 - 2 + q) * 1024 + d), dst);
                else {
#pragma unroll
                    for (int i = 0; i < 8; ++i) dst[i] = 0.f; }
            } }
#pragma unroll 4
        for (int rr = 0; rr < RUN; ++rr) {
            const int m = m0 + rr;
#pragma unroll
            for (int j = 0; j < 2; ++j) { const int d = 8 * lane + 512 * j;
                float b[8], c[8], y[8]; unpack8(*(const u32x4*)(bg + (size_t)m * 1024 + d), b); unpack8(*(const u32x4*)(cu + (size_t)m * 1024 + d), c);
#pragma unroll
                for (int i = 0; i < 8; ++i) { y[i] = b[i] * (w0[j][i] * pm2[j][i] + w1[j][i] * pm1[j][i] + w2[j][i] * c[i]); pm2[j][i] = pm1[j][i]; pm1[j][i] = c[i]; }
                *(u32x4*)(v + (size_t)m * 1024 + d) = pack8(y); }
        }
    }
}
__device__ __forceinline__ void phase_norm_router(const Params& p, LAS unsigned char* lds) {
    const int tid = ltid(), lane = tid & 63, wave = tid >> 6, gw = blockIdx.x * 8 + wave, NGW = gridDim.x * 8;
    const bf16_t* x3 = (const bf16_t*)(p.ws + R_XN); const float* g = p.in[24]; bf16_t* xn = (bf16_t*)(p.ws + R_XA);
    LAS float* wr = (LAS float*)lds;
    LAS int* lcnt = (LAS int*)(lds + 40960); LAS int* gb = lcnt + 8;
    int* te = (int*)(p.ws + SM_TE); float* tw = (float*)(p.ws + SM_TW); int* rank = (int*)(p.ws + SM_RANK); int* cnt = (int*)(p.ws + SM_CTL);
    for (int i = tid; i < 8192; i += 512) { const int dd = i >> 3; wr[dd * 8 + (dd >> 2) * 4 + (i & 7)] = p.in[25][i]; }
    if (tid < 8) lcnt[tid] = 0;
    __syncthreads();
    for (int m = gw; m < T; m += NGW) {
        const u32x2* xr = (const u32x2*)(x3 + (size_t)m * D) + lane; const f32x4* gr = (const f32x4*)g + lane;
        f32x4 v[4]; float s = 0.f;
#pragma unroll
        for (int j = 0; j < 4; ++j) { const u32x2 t = xr[64 * j]; v[j] = (f32x4){bflo(t.x), bfhi(t.x), bflo(t.y), bfhi(t.y)}; s += (v[j].x * v[j].x + v[j].y * v[j].y) + (v[j].z * v[j].z + v[j].w * v[j].w); }
        const float r = rsqrtf(wsum(s) * (1.f / 1024.f) + EPS);
        float lg[8];
#pragma unroll
        for (int e = 0; e < 8; ++e) lg[e] = 0.f;
        u32x2* o8 = (u32x2*)(xn + (size_t)m * D) + lane;
#pragma unroll
        for (int j = 0; j < 4; ++j) { const f32x4 gg = gr[64 * j]; const f32x4 y = {v[j].x * r * gg.x, v[j].y * r * gg.y, v[j].z * r * gg.z, v[j].w * r * gg.w};
            u32x2 w; w.x = cvtpk(y.x, y.y); w.y = cvtpk(y.z, y.w); o8[64 * j] = w;
#pragma unroll
            for (int i = 0; i < 4; ++i) { const int d = 4 * lane + 256 * j + i; const f32x4 w0 = *(const LAS f32x4*)(wr + d * 8 + (d >> 2) * 4), w1 = *(const LAS f32x4*)(wr + d * 8 + (d >> 2) * 4 + 4);
                lg[0] += y[i] * w0.x; lg[1] += y[i] * w0.y; lg[2] += y[i] * w0.z; lg[3] += y[i] * w0.w; lg[4] += y[i] * w1.x; lg[5] += y[i] * w1.y; lg[6] += y[i] * w1.z; lg[7] += y[i] * w1.w; } }
#pragma unroll
        for (int e = 0; e < 8; ++e) lg[e] = wsum(lg[e]) + p.in[26][e];
        int e1 = 0; float l1 = lg[0];
#pragma unroll
        for (int e = 1; e < 8; ++e) if (lg[e] > l1) { l1 = lg[e]; e1 = e; }
        int e2 = -1; float l2 = -3e38f;
#pragma unroll
        for (int e = 0; e < 8; ++e) if (e != e1 && lg[e] > l2) { l2 = lg[e]; e2 = e; }
        if (lane == 0) {
            const float w1 = 1.f / (1.f + __expf(l2 - l1));
            te[m * 2] = e1; te[m * 2 + 1] = e2; tw[m * 2] = w1; tw[m * 2 + 1] = 1.f - w1;
            rank[m * 2] = __hip_atomic_fetch_add(&lcnt[e1], 1, __ATOMIC_RELAXED, __HIP_MEMORY_SCOPE_WORKGROUP); rank[m * 2 + 1] = __hip_atomic_fetch_add(&lcnt[e2], 1, __ATOMIC_RELAXED, __HIP_MEMORY_SCOPE_WORKGROUP);
        }
    }
    __syncthreads();
    if (tid < 8) gb[tid] = atomicAdd(&cnt[tid], lcnt[tid]);
    __syncthreads();
    for (int m = gw; m < T; m += NGW) if (lane < 2) rank[m * 2 + lane] += gb[te[m * 2 + lane]];
}
__device__ __forceinline__ void phase_moe_gather(const Params& p) {
    const int tid = ltid(), lane = tid & 63, gw = blockIdx.x * 8 + (tid >> 6), NGW = gridDim.x * 8;
    const int* cnt = (const int*)(p.ws + SM_CTL); const int* te = (const int*)(p.ws + SM_TE); const float* tw = (const float*)(p.ws + SM_TW); const int* rank = (const int*)(p.ws + SM_RANK);
    int* pos = (int*)(p.ws + SM_POS); float* roww = (float*)(p.ws + SM_ROWW); int* tile_e = (int*)(p.ws + SM_TILEE);
    int* rowtok = (int*)(p.ws + SM_ROWTOK);
    int off[9]; off[0] = 0;
#pragma unroll
    for (int e = 0; e < 8; ++e) off[e + 1] = off[e] + ((cnt[e] + 255) & ~255);
    if (blockIdx.x == 0) {
        for (int i = tid; i < ROWS_MAX / 256; i += 512) { int e = -1;
#pragma unroll
            for (int k = 0; k < 8; ++k) if (i * 256 >= off[k] && i * 256 < off[k + 1]) e = k;
            tile_e[i] = e < 0 ? 0 : e; }
        if (tid == 0) ((int*)(p.ws + SM_CTL))[8] = off[8];
    }
    if (blockIdx.x < 8 && tid < 256) {
#pragma unroll
        for (int e = 0; e < 8; ++e) if (e == (int)blockIdx.x) { const int c = cnt[e]; if (c + tid < off[e + 1] - off[e]) { roww[off[e] + c + tid] = 0.f; rowtok[off[e] + c + tid] = -1; } }
    }
    for (int pi0 = gw * 4; pi0 < 2 * T; pi0 += NGW * 4) {
        int r[4]; float w[4];
#pragma unroll
        for (int q = 0; q < 4; ++q) { const int e = te[pi0 + q]; int o = 0;
#pragma unroll
            for (int k = 0; k < 8; ++k) if (k == e) o = off[k];
            r[q] = o + rank[pi0 + q]; w[q] = tw[pi0 + q]; }
#pragma unroll
        for (int q = 0; q < 4; ++q) if (lane == q) { pos[pi0 + q] = r[q]; roww[r[q]] = w[q]; rowtok[r[q]] = (pi0 + q) >> 1; }
    }
}
__device__ __forceinline__ void phase_moe_combine(const Params& p) {
    const int tid_ = ltid(); const int lane = tid_ & 63, gw = blockIdx.x * 8 + (tid_ >> 6), NGW = gridDim.x * 8;
    const int* pos = (const int*)(p.ws + SM_POS); const bf16_t* ym = (const bf16_t*)(p.ws + R_XA); const bf16_t* x3 = (const bf16_t*)(p.ws + R_XN);
    for (int m0 = gw * 2; m0 < T; m0 += NGW * 2) {
        int ps[4];
#pragma unroll
        for (int q = 0; q < 4; ++q) ps[q] = pos[m0 * 2 + q];
        f32x4 x[2][4]; u32x2 ya[2][4], yc[2][4];
#pragma unroll
        for (int q = 0; q < 2; ++q)
#pragma unroll
            for (int j = 0; j < 4; ++j) { const int d = 4 * lane + 256 * j;
                { const u32x2 t = *(const u32x2*)(x3 + (size_t)(m0 + q) * D + d); x[q][j] = (f32x4){bflo(t.x), bfhi(t.x), bflo(t.y), bfhi(t.y)}; } ya[q][j] = *(const u32x2*)(ym + (size_t)ps[2 * q] * D + d); yc[q][j] = *(const u32x2*)(ym + (size_t)ps[2 * q + 1] * D + d); }
#pragma unroll
        for (int q = 0; q < 2; ++q)
#pragma unroll
            for (int j = 0; j < 4; ++j) { const int d = 4 * lane + 256 * j; f32x4 o = x[q][j]; const u32x2 a = ya[q][j], c = yc[q][j];
                o.x += bflo(a.x) + bflo(c.x); o.y += bfhi(a.x) + bfhi(c.x); o.z += bflo(a.y) + bflo(c.y); o.w += bfhi(a.y) + bfhi(c.y);
                *(f32x4*)(p.out + (size_t)(m0 + q) * D + d) = o; }
    }
}

#define XB_TMO      128
#define XB_XCNT(j)  (256  + 64 * (j))
#define XB_XSUB(j)  (1280 + 64 * (j))
#define XB_XGEN(j)  (2304 + 64 * (j))
#define XB_TOP      3328
#define XB_TOPGEN   3392
#define XCD_BAR_WORDS 3456
#define XB_SPIN_CAP (1u << 18)

__device__ __forceinline__ unsigned xb_ld(unsigned* p)              { return __hip_atomic_load(p, __ATOMIC_RELAXED, __HIP_MEMORY_SCOPE_AGENT); }
__device__ __forceinline__ unsigned xb_add(unsigned* p, unsigned v) { return __hip_atomic_fetch_add(p, v, __ATOMIC_RELAXED, __HIP_MEMORY_SCOPE_AGENT); }
__device__ __forceinline__ unsigned xb_xcc_id() { return (unsigned)__builtin_amdgcn_s_getreg((3 << 11) | 20) & 0xFu; }
#define XB_SPIN(cond, bar) do { unsigned _sp = 0; while (cond) { __builtin_amdgcn_s_sleep(1); \
    if ((++_sp & 255u) == 0u) { if (xb_ld(&(bar)[XB_TMO])) break; if (_sp > XB_SPIN_CAP) { atomicAdd(&(bar)[XB_TMO], 1u); break; } } } } while (0)

struct XcdBarrier {
    unsigned* bar; unsigned x;
    volatile LAS unsigned* st;
};

__device__ __forceinline__ XcdBarrier xcd_barrier_post(unsigned* bar, volatile LAS unsigned* st) {
    XcdBarrier b; b.bar = bar; b.x = xb_xcc_id(); b.st = st;
    if (threadIdx.x == 0) (void)xb_add(&bar[XB_XCNT(b.x)], 1u);
    return b;
}
__device__ __forceinline__ void xcd_barrier_complete(unsigned* bar, unsigned x, unsigned& nloc, unsigned& nx) {
    const unsigned G = gridDim.x * gridDim.y * gridDim.z;
    unsigned sum, cnt, mine, sp = 0u;
    for (;;) {
        sum = 0u; cnt = 0u; mine = 0u;
#pragma unroll
        for (unsigned j = 0; j < 16; ++j) { const unsigned c = xb_ld(&bar[XB_XCNT(j)]); sum += c; cnt += (c > 0u) ? 1u : 0u; mine = (j == x) ? c : mine; }
        if (sum == G) break;
        __builtin_amdgcn_s_sleep(1);
        if ((++sp & 255u) == 0u) { if (xb_ld(&bar[XB_TMO])) break; if (sp > XB_SPIN_CAP) { atomicAdd(&bar[XB_TMO], 1u); break; } }
    }
    nloc = mine > 0u ? mine : 1u; nx = cnt > 0u ? cnt : 1u;
}

__device__ __forceinline__ void xcd_barrier(const XcdBarrier& b) {
    asm volatile("s_waitcnt vmcnt(0)" ::: "memory");
    __syncthreads();
    if (threadIdx.x == 0) {
        unsigned* bar = b.bar;
        __builtin_amdgcn_s_waitcnt(0);
        unsigned nloc = b.st[0], nx = b.st[1];
        if (nloc == 0u) { xcd_barrier_complete(bar, b.x, nloc, nx); b.st[0] = nloc; b.st[1] = nx; }
        const unsigned old = xb_add(&bar[XB_XSUB(b.x)], 1u);
        const unsigned gen = old / nloc;
        if (old + 1u == (gen + 1u) * nloc) {
            __builtin_amdgcn_fence(__ATOMIC_RELEASE, "agent");
            asm volatile("s_waitcnt vmcnt(0)" ::: "memory");
            const unsigned og = xb_add(&bar[XB_TOP], 1u);
            const unsigned tg = og / nx;
            if (og + 1u == (tg + 1u) * nx) xb_add(&bar[XB_TOPGEN], 1u);
            else XB_SPIN(xb_ld(&bar[XB_TOPGEN]) == tg, bar);
            __builtin_amdgcn_fence(__ATOMIC_ACQUIRE, "agent");
            xb_add(&bar[XB_XGEN(b.x)], 1u);
            asm volatile("s_waitcnt vmcnt(0)" ::: "memory");
        } else {
            XB_SPIN(xb_ld(&bar[XB_XGEN(b.x)]) == gen, bar);
            __builtin_amdgcn_fence(__ATOMIC_ACQUIRE, "agent");
            asm volatile("s_waitcnt vmcnt(0)" ::: "memory");
        }
    }
    __syncthreads();
}


__global__ void __launch_bounds__(512) mega_fwd(Params p) {
    extern __shared__ __attribute__((aligned(16))) unsigned char lds_raw[];
    LAS unsigned char* lds = (LAS unsigned char*)lds_raw;
    cg::grid_group grid = cg::this_grid();
    volatile LAS unsigned* bst = (volatile LAS unsigned*)(lds + 140032);
    if (threadIdx.x == 0) { bst[0] = 0u; bst[1] = 0u; const unsigned long long ba = (unsigned long long)(p.ws + SM_BAR); bst[2] = (unsigned)ba; bst[3] = (unsigned)(ba >> 32); }
    __syncthreads();
    (void)xcd_barrier_post((unsigned*)(p.ws + SM_BAR), bst);
#ifdef PROF_SEL
#define PSTAMP(k) do { if (blockIdx.x == 0 && threadIdx.x == 0) { volatile LAS unsigned* pl_ = (volatile LAS unsigned*)(lds + 140032 + 16); const unsigned long long now_ = __builtin_amdgcn_s_memrealtime(); const unsigned long long last_ = ((unsigned long long)pl_[1] << 32) | pl_[0]; *PROF_SLOT(k) += now_ - last_; pl_[0] = (unsigned)now_; pl_[1] = (unsigned)(now_ >> 32); } } while (0)
#else
#define PSTAMP(k)
#endif
#define GSYNC() do { XcdBarrier xb_; volatile LAS unsigned* st_ = (volatile LAS unsigned*)(lds + 140032); xb_.bar = (unsigned*)(((unsigned long long)st_[3] << 32) | st_[2]); xb_.x = xb_xcc_id(); xb_.st = st_; xcd_barrier(xb_); } while (0)
#ifdef PROF_SEL
    if (threadIdx.x == 0) { volatile LAS unsigned* pl_ = (volatile LAS unsigned*)(lds + 140032 + 16); const unsigned long long now_ = __builtin_amdgcn_s_memrealtime(); pl_[0] = (unsigned)now_; pl_[1] = (unsigned)(now_ >> 32); }
#endif
    const int G = gridDim.x, c = blockIdx.x;
#define LP() bf16_t* W = (bf16_t*)p.ws; bf16_t* xn = (bf16_t*)(p.ws + R_XN); float* x1 = (float*)(p.ws + R_XA); pg8::StaticOrder SO; (void)W; (void)xn; (void)x1; (void)SO
#ifndef PHMASK
#define PHMASK 0xFFFFFFFFu
#endif
#ifndef REPEAT_MASK
#define REPEAT_MASK 0u
#endif
#define PH(k) if (((PHMASK >> (k)) & 1u) && (k) >= p.ph_lo && (k) <= p.ph_hi)
#define RPT(k) if ((REPEAT_MASK >> (k)) & 1u)
    PH(0) { LP(); phase_p0(p, lds); }
    GSYNC(); PSTAMP(0);
    if (p.ph_lo == -12345) grid.sync();
    RPT(0) { { LP(); phase_p0(p, lds); } GSYNC(); }
    PH(1) { LP();
        pg8::Gemm g{xn, W + W_IN_E / 2, T, 1792, 1024, 1024, nullptr, 0, nullptr}; SO.init(T, 1792, G, c);
        pg8::EpiBf16<0> E{(bf16_t*)(p.ws + R_H), 1792, nullptr, nullptr};
        pg8::gemm_phase<pg8::EpiBf16<0>, true>(lds, g, SO, E);
    }
    GSYNC(); PSTAMP(1);
    PH(2) { LP(); phase_p2(p, lds); }
    GSYNC(); PSTAMP(2);
    RPT(2) { { LP(); phase_p2(p, lds); } GSYNC(); }
    PH(3) { LP();
        const int nCu = 2 * (NB * 512 / 256) * 2, Gc = (nCu < G / 2) ? nCu : 0;
        if (Gc == 0 || c < Gc) {
            for (int kv = 0; kv < 2; ++kv) {
                pg8::Gemm g{(const bf16_t*)(p.ws + R_XA + (kv ? A_VCIN : A_KCIN)), W + W_CW1 / 2 + (size_t)kv * 512 * 1024, NB * 512, 512, 1024, 1024, nullptr, 0, nullptr};
                if (Gc) SO.init(NB * 512, 512, Gc / 2, c - kv * (Gc / 2)); else SO.init(NB * 512, 512, G, c);
                pg8::EpiBf16<0> E{(bf16_t*)(p.ws + SM_HID) + (size_t)kv * NB * 512 * 512, 512, nullptr, nullptr};
                if (Gc == 0 || (c / (Gc / 2)) == kv) pg8::gemm_phase<pg8::EpiBf16<0>, true>(lds, g, SO, E);
            }
        }
        if (Gc == 0 || c >= Gc) {
            {
                pg8::Gemm g{(const bf16_t*)(p.ws + R_XA + A_CQN), W + W_UQ / 2, T, 1024, 256, 256, nullptr, 0, nullptr}; SO.init(T, 1024, G - Gc, c - Gc);
                pg8::EpiBf16<0> E{(bf16_t*)(p.ws + R_H), 1024, nullptr, nullptr};
                pg8::gemm_phase<pg8::EpiBf16<0>, true>(lds, g, SO, E);
            }
            {
                pg8::Gemm g{(const bf16_t*)(p.ws + R_XA + A_CKVN), W + W_UKV / 2, T, 1024, 128, 128, nullptr, 0, nullptr}; SO.init(T, 1024, G - Gc, c - Gc);
                pg8::EpiBf16<0> E{(bf16_t*)(p.ws + R_H + (size_t)T * 2048), 1024, nullptr, nullptr};
                pg8::gemm_phase<pg8::EpiBf16<0>, true>(lds, g, SO, E);
            }
        }
    }
    GSYNC(); PSTAMP(3);
    PH(4) { LP(); phase_p3b(p, lds); }
    GSYNC(); PSTAMP(4);
    RPT(4) { { LP(); phase_p3b(p, lds); } GSYNC(); }
    PH(5) { LP(); phase_p4(p, lds); }
    GSYNC(); PSTAMP(5);
    RPT(5) { { LP(); phase_p4(p, lds); } GSYNC(); }
    PH(6) { LP();
        pg8::Gemm g{xn, W + W_OUT_E / 2, T, 1024, 1024, 1024, nullptr, 0, nullptr}; SO.init(T, 1024, G, c);
        pg8::EpiResStat<false> E{p.in[0], (bf16_t*)p.out, (float*)(p.ws + SM_SSP1), 1024};
        pg8::gemm_phase<pg8::EpiResStat<false>, true>(lds, g, SO, E);
    }
    GSYNC(); PSTAMP(6);
    PH(7) { }
    PH(8) { LP();
        pg8::Gemm g{(const bf16_t*)p.out, W + W_GU / 2, T, 5632, 1024, 1024, nullptr, 0, nullptr}; SO.init(T, 5632, G, c);
        pg8::EpiSwiGLU E{(bf16_t*)(p.ws + R_H), 2816, (const float*)(p.ws + SM_SSP1)};
        pg8::gemm_phase<pg8::EpiSwiGLU, true>(lds, g, SO, E);
    }
    GSYNC(); PSTAMP(8);
    PH(9) { LP();
        pg8::Gemm g{(const bf16_t*)(p.ws + R_H), W + W_D / 2, T, 1024, 2816, 2816, nullptr, 0, nullptr}; SO.init(T, 1024, G, c);
        pg8::EpiResStat<true> E{(const bf16_t*)p.out, xn, (float*)(p.ws + SM_SSP2), 1024};
        pg8::gemm_phase<pg8::EpiResStat<true>, true>(lds, g, SO, E);
    }
    GSYNC(); PSTAMP(9);
    PH(10) { }
    PH(11) { LP();
        pg8::Gemm g{xn, W + W_IN_O / 2, T, 3072, 1024, 1024, nullptr, 0, nullptr}; SO.init(T, 3072, G, c);
        pg8::EpiConvIn E{(bf16_t*)(p.ws + R_H), (bf16_t*)(p.ws + R_H + (size_t)T * 2048), (const float*)(p.ws + SM_SSP2)};
        pg8::gemm_phase<pg8::EpiConvIn, true>(lds, g, SO, E);
    }
    GSYNC(); PSTAMP(11);
    PH(12) { LP(); phase_conv(p); }
    GSYNC(); PSTAMP(12);
    RPT(12) { { LP(); phase_conv(p); } GSYNC(); }
    PH(13) { LP();
        pg8::Gemm g{(const bf16_t*)x1, W + W_OUT_O / 2, T, 1024, 1024, 1024, nullptr, 0, nullptr}; SO.init(T, 1024, G, c);
        pg8::EpiResBf16B E{xn, xn, 1024};
        pg8::gemm_phase<pg8::EpiResBf16B, true>(lds, g, SO, E);
    }
    GSYNC(); PSTAMP(13);
    PH(14) { LP(); phase_norm_router(p, lds); }
    GSYNC(); PSTAMP(14);
    PH(15) { LP(); phase_moe_gather(p); }
    GSYNC(); PSTAMP(15);
    PH(16) { LP(); const int mrows = ((const int*)(p.ws + SM_CTL))[8];
        pg8::Gemm g{(const bf16_t*)x1, W + W_MGU / 2, mrows, 2816, 1024, 1024, (const int*)(p.ws + SM_TILEE), (size_t)2816 * 1024, (const int*)(p.ws + SM_ROWTOK)}; SO.init(mrows, 2816, G, c);
        pg8::EpiSwiGLU E{(bf16_t*)(p.ws + R_H), 1408, nullptr};
        pg8::gemm_phase<pg8::EpiSwiGLU, true, true>(lds, g, SO, E);
    }
    GSYNC(); PSTAMP(16);
    PH(17) { LP(); const int mrows = ((const int*)(p.ws + SM_CTL))[8];
        pg8::Gemm g{(const bf16_t*)(p.ws + R_H), W + W_MD / 2, mrows, 1024, 1408, 1408, (const int*)(p.ws + SM_TILEE), (size_t)1024 * 1408, nullptr}; SO.init(mrows, 1024, G, c);
        pg8::EpiRowScaleBf16 E{(bf16_t*)(p.ws + R_XA), 1024, (const float*)(p.ws + SM_ROWW)};
        pg8::gemm_phase<pg8::EpiRowScaleBf16, true>(lds, g, SO, E);
    }
    GSYNC(); PSTAMP(17);
    PH(18) { LP(); phase_moe_combine(p); }
#ifdef PROF_SEL
    GSYNC(); PSTAMP(18);
    GSYNC();
    {
        unsigned long long v_ = *PROF_SLOT(PROF_SEL);
#ifdef PROF_DIV
        const unsigned long long dv_ = *PROF_SLOT(PROF_DIV); v_ = dv_ ? v_ / dv_ : 0ull;
#endif
        unsigned long long a_ = v_ / (unsigned long long)(PROF_UNIT); if (a_ > 27ull) a_ = 27ull;
        const float sc_ = 1.f + (float)a_;
        for (size_t i = (size_t)blockIdx.x * 512 + threadIdx.x; i < (size_t)S * 1024 / 4; i += (size_t)gridDim.x * 512) { f32x4* o = (f32x4*)p.out + i; *o = *o * sc_; }
    }
#endif
#undef PH
}

inline void launch(void* const* d_in, float* d_out, void* d_ws, size_t ws_size, hipStream_t stream, int ph_lo = 0, int ph_hi = 99, int dbg_branch = -1) {
    static int grid = 0;
    if (grid == 0) {
        int dev = 0, cus = 0, per_cu = 0;
        hipGetDevice(&dev); hipDeviceGetAttribute(&cus, hipDeviceAttributeMultiprocessorCount, dev);
        hipFuncSetAttribute((const void*)mega_fwd, hipFuncAttributeMaxDynamicSharedMemorySize, LDS_BYTES);
        hipOccupancyMaxActiveBlocksPerMultiprocessor(&per_cu, (const void*)mega_fwd, 512, LDS_BYTES);
        if (per_cu < 1) { fprintf(stderr, "occupancy query says %d blocks/CU\n", per_cu); per_cu = 1; }
        grid = cus;
        if (WS_FAST_END > ws_size) { fprintf(stderr, "ws too small: need %zu have %zu\n", (size_t)WS_FAST_END, ws_size); grid = -1; }
    }
    if (grid < 0) return;
    if (ph_lo <= 14 && ph_hi >= 14) hipMemsetAsync((char*)d_ws + SM_CTL, 0, 4096, stream);
    hipMemsetAsync((char*)d_ws + SM_BAR, 0, 16384, stream);
    Params p{};
    for (int i = 0; i < 30; ++i) p.in[i] = (const float*)d_in[i];
    p.out = d_out; p.ws = (unsigned char*)d_ws; p.ph_lo = ph_lo; p.ph_hi = ph_hi; p.dbg_branch = dbg_branch;
    void* args[] = {&p};
    hipError_t e = hipLaunchCooperativeKernel((const void*)mega_fwd, dim3(grid), dim3(512), args, LDS_BYTES, stream);
    if (e != hipSuccess) fprintf(stderr, "cooperative launch failed: %s (grid %d)\n", hipGetErrorString(e), grid);
}
}
extern "C" void kernel_launch(void* const* d_in, const int* in_sizes, int n_in, void* d_out, int out_size, void* d_ws, size_t ws_size, hipStream_t stream) {
    fast::launch(d_in, (float*)d_out, d_ws, ws_size, stream);
}
```

```cpp
#include <hip/hip_runtime.h>
#include <hip/hip_bf16.h>
#include <stdint.h>
#include <stdio.h>
#include <string.h>
#include <hip/hip_cooperative_groups.h>
namespace cg = cooperative_groups;
#define NB 8
#define REPEAT_MASK 0x0u
namespace gold {
constexpr int S = 4096, D = 1024, HW = 1720;
constexpr float EPS = 1e-6f;

__device__ const unsigned char T5B[128] = {0, 1, 2, 3, 4, 5, 6, 7, 8, 9, 10, 11, 12, 13, 14, 15, 16, 16, 16, 17, 17, 18, 18, 18, 19, 19, 19, 20, 20, 20, 20, 21, 21, 21, 21, 22, 22, 22, 22, 22, 23, 23, 23, 23, 23, 23, 24, 24, 24, 24, 24, 24, 25, 25, 25, 25, 25, 25, 25, 26, 26, 26, 26, 26, 26, 26, 26, 27, 27, 27, 27, 27, 27, 27, 27, 27, 27, 28, 28, 28, 28, 28, 28, 28, 28, 28, 28, 29, 29, 29, 29, 29, 29, 29, 29, 29, 29, 29, 29, 30, 30, 30, 30, 30, 30, 30, 30, 30, 30, 30, 30, 30, 30, 31, 31, 31, 31, 31, 31, 31, 31, 31, 31, 31, 31, 31, 31};
}
#ifndef NB
#define NB 8
#endif
namespace fast {
#define LAS __attribute__((address_space(3)))
typedef unsigned short bf16_t;
typedef short bf16x8 __attribute__((ext_vector_type(8)));
typedef float f32x4 __attribute__((ext_vector_type(4)));
typedef float f32x2 __attribute__((ext_vector_type(2)));
typedef float f32x16 __attribute__((ext_vector_type(16)));
typedef unsigned u32x4 __attribute__((ext_vector_type(4)));
typedef unsigned u32x2 __attribute__((ext_vector_type(2)));
typedef __bf16 bf16x2_t __attribute__((ext_vector_type(2)));

constexpr int S = 4096, T = NB * S, D = 1024;
constexpr float EPS = 1e-6f, LOG2E = 1.4426950408889634f;

__device__ __forceinline__ unsigned cvtpk(float lo, float hi) { f32x2 v = {lo, hi}; bf16x2_t b = __builtin_convertvector(v, bf16x2_t); return __builtin_bit_cast(unsigned, b); }
__device__ __forceinline__ bf16_t f2bf(float f) { return (bf16_t)(cvtpk(f, 0.f) & 0xffffu); }
__device__ __forceinline__ float bf2f(bf16_t u) { return __builtin_bit_cast(float, (unsigned)u << 16); }
__device__ __forceinline__ float bflo(unsigned u) { return __builtin_bit_cast(float, u << 16); }
__device__ __forceinline__ float bfhi(unsigned u) { return __builtin_bit_cast(float, u & 0xffff0000u); }
__device__ __forceinline__ float wsum(float v) {
#pragma unroll
    for (int o = 1; o < 64; o <<= 1) v += __shfl_xor(v, o);
    return v;
}
__device__ __forceinline__ float fexp2(float x) { return __builtin_amdgcn_exp2f(x); }
__device__ __forceinline__ float frcp(float x) { return __builtin_amdgcn_rcpf(x); }
__device__ __forceinline__ float silu_f(float x) { return x * frcp(1.f + fexp2(-x * LOG2E)); }
__device__ __forceinline__ float gelu_tanh_f(float x) {
    const float u = 0.7978845608028654f * (x + 0.044715f * x * x * x);
    return x * frcp(1.f + fexp2(-2.f * LOG2E * u));
}

namespace pg8 {
constexpr int BM = 256, BK = 64, HALF = 128, HTB = HALF * BK * 2, STAGE_BYTES = 8 * HTB, NXCD = 8, WGM = 8;
__host__ __device__ __forceinline__ int lds_byte(int r, int c) { const int st = (r >> 4) * 2 + (c >> 5), rr = r & 15, cc = c & 31, ob = rr * 64 + cc * 2; return st * 1024 + (ob ^ (((ob >> 9) & 1) << 5)); }
__host__ __device__ __forceinline__ void stage_rc(int b, int& R, int& C) { const int st = b / 1024, sb = b % 1024, swz = sb ^ (((sb >> 9) & 1) << 5); R = (st >> 1) * 16 + swz / 64; C = (st & 1) * 32 + (swz % 64) / 2; }
__host__ __device__ __forceinline__ int perm32(int rho) { const int n = rho >> 4, i = rho & 15; return 8 * (i >> 2) + 4 * n + (i & 3); }

struct Unit { int pm, pn; };
struct Gemm { const bf16_t* A; const bf16_t* Bt; int M, N, K, lda; const int* tile_e; size_t estride; const int* rowidx; };

struct StaticOrder {
    int nM, nN, nwg, G, c;
    __device__ void init(int M, int N, int G_, int c_) { nM = M / BM; nN = N / BM; nwg = nM * nN; G = G_; c = c_; }
    __device__ bool next(int i, Unit& u) const {
        const long L = (long)i * G + c; if (L >= nwg) return false;
        int wgid = (int)L; { const int q = nwg / NXCD, r = nwg % NXCD, xcd = wgid % NXCD, off = wgid / NXCD; wgid = (xcd < r ? xcd * (q + 1) : r * (q + 1) + (xcd - r) * q) + off; }
        const int nig = WGM * nN, gid = wgid / nig, fm = gid * WGM, gsz = (nM - fm) < WGM ? (nM - fm) : WGM;
        u.pm = fm + ((wgid % nig) % gsz); u.pn = (wgid % nig) / gsz; return true;
    }
};

template <class Epi, bool ALIGN_EPI, bool GATHER = false>
__device__ __forceinline__ void gemm_phase(LAS unsigned char* lds, const Gemm g, const StaticOrder& S, const Epi& E) {
    int tid = threadIdx.x; asm volatile("" : "+v"(tid));
    const int wid = __builtin_amdgcn_readfirstlane(tid >> 6), lane = tid & 63, wr = wid >> 2, wc = wid & 3, fr = lane & 15, fq = lane >> 4;
    const int K = g.K, nt = K / BK, lda = g.lda;
    unsigned voffA[2], voffB[2];
#pragma unroll
    for (int i = 0; i < 2; ++i) { int R, C; stage_rc(tid * 16 + i * 8192, R, C); const int Rb = Epi::PERM ? ((R & ~31) + perm32(R & 31)) : R;
        voffA[i] = (unsigned)(R * lda + C) * 2u; voffB[i] = (unsigned)(Rb * K + C) * 2u; }
    const size_t kstep = (size_t)(BK * 2);
    const size_t hsA = GATHER ? 0 : (size_t)HALF * lda * 2, tsA = 2 * hsA, hsB = (size_t)HALF * K * 2, tsB = 2 * hsB;
    unsigned vgc[2][2], vgn[2][2];
#define PG8_GOFF(pm_, vg) do { _Pragma("unroll") for (int h_ = 0; h_ < 2; ++h_) _Pragma("unroll") for (int i_ = 0; i_ < 2; ++i_) { int R_, C_; stage_rc(tid * 16 + i_ * 8192, R_, C_); \
        int tok_ = g.rowidx[(pm_) * BM + h_ * HALF + R_]; tok_ = tok_ < 0 ? 0 : tok_; vg[h_][i_] = (unsigned)(tok_ * lda + C_) * 2u; } } while (0)
#define PG8_STAGE_A(bufoff, gbase, h, nx) do { unsigned va_[2]; _Pragma("unroll") for (int i_ = 0; i_ < 2; ++i_) va_[i_] = GATHER ? ((nx) ? vgn[h][i_] : vgc[h][i_]) : voffA[i_]; PG8_STAGE(bufoff, gbase, va_); } while (0)
    const unsigned ldsw = (unsigned)wid * 1024u;
    const int aoff = lds_byte(wr * 64 + fr, fq * 8), boff = lds_byte(wc * 32 + fr, fq * 8);
#define PG8_SA(b, h) (((b) * 2 + (h)) * HTB)
#define PG8_SB(b, h) ((4 + (b) * 2 + (h)) * HTB)
#define PG8_STAGE(bufoff, gbase, voff) do { _Pragma("unroll") for (int _i = 0; _i < 2; ++_i) \
        __builtin_amdgcn_global_load_lds((const unsigned*)((const char*)(gbase) + (voff)[_i]), (LAS unsigned*)(lds + (bufoff) + ldsw + _i * 8192), 16, 0, 0); } while (0)
#define PG8_LDA(dst, b, h) do { _Pragma("unroll") for (int m = 0; m < 4; ++m) _Pragma("unroll") for (int k = 0; k < 2; ++k) dst[m][k] = *(const LAS bf16x8*)(lds + PG8_SA(b, h) + aoff + m * 2048 + k * 1024); } while (0)
#define PG8_LDB(dst, b, h) do { _Pragma("unroll") for (int n = 0; n < 2; ++n) _Pragma("unroll") for (int k = 0; k < 2; ++k) dst[n][k] = *(const LAS bf16x8*)(lds + PG8_SB(b, h) + boff + n * 2048 + k * 1024); } while (0)
#define PG8_MMA(ai, bj, At, Bt) do { __builtin_amdgcn_s_setprio(1); _Pragma("unroll") for (int m = 0; m < 4; ++m) _Pragma("unroll") for (int n = 0; n < 2; ++n) _Pragma("unroll") for (int k = 0; k < 2; ++k) \
        acc[ai][bj][m][n] = __builtin_amdgcn_mfma_f32_16x16x32_bf16(Bt[n][k], At[m][k], acc[ai][bj][m][n], 0, 0, 0); __builtin_amdgcn_s_setprio(0); } while (0)
#define PG8_WAIT_V(n) asm volatile("s_waitcnt vmcnt(" #n ")" ::: "memory")
#define PG8_WAIT_L(n) asm volatile("s_waitcnt lgkmcnt(" #n ")" ::: "memory")
#define PG8_BAR __builtin_amdgcn_s_barrier()
#define PG8_SCHED __builtin_amdgcn_sched_barrier(0)
#define PG8_EOFF(pm_) (g.tile_e ? (size_t)g.tile_e[pm_] * g.estride * 2 : (size_t)0)
    Unit cur, nxt; int ui = 0;
    if (!S.next(0, cur)) return;
    f32x4 acc[2][2][4][2];
#pragma unroll
    for (int a = 0; a < 2; ++a)
#pragma unroll
        for (int b = 0; b < 2; ++b)
#pragma unroll
            for (int m = 0; m < 4; ++m)
#pragma unroll
                for (int n = 0; n < 2; ++n) acc[a][b][m][n] = (f32x4){0.f, 0.f, 0.f, 0.f};
    bf16x8 At[4][2], B0[2][2], B1[2][2];
    const char* cA = (const char*)g.A + (size_t)cur.pm * tsA; const char* cB = (const char*)g.Bt + PG8_EOFF(cur.pm) + (size_t)cur.pn * tsB;
    if constexpr (GATHER) PG8_GOFF(cur.pm, vgc);
    PG8_STAGE(PG8_SB(0, 0), cB, voffB); PG8_STAGE(PG8_SB(0, 1), cB + hsB, voffB); PG8_STAGE_A(PG8_SA(0, 0), cA, 0, false); PG8_STAGE_A(PG8_SA(0, 1), cA + hsA, 1, false);
    if (wr == 1) PG8_BAR;
    PG8_WAIT_V(2); PG8_BAR;
    PG8_STAGE(PG8_SB(1, 0), cB + kstep, voffB); PG8_STAGE_A(PG8_SA(1, 0), cA + kstep, 0, false); PG8_STAGE(PG8_SB(1, 1), cB + hsB + kstep, voffB);
    PG8_WAIT_V(6); PG8_BAR;
    for (;;) {
        const bool has_next = S.next(ui + 1, nxt);
        if constexpr (GATHER) { if (has_next) PG8_GOFF(nxt.pm, vgn); else { vgn[0][0] = vgc[0][0]; vgn[0][1] = vgc[0][1]; vgn[1][0] = vgc[1][0]; vgn[1][1] = vgc[1][1]; } }
        const char* nA = has_next ? (const char*)g.A + (size_t)nxt.pm * tsA : cA;
        const char* nB = has_next ? (const char*)g.Bt + PG8_EOFF(nxt.pm) + (size_t)nxt.pn * tsB : cB;
        for (int t = 0; t < nt; t += 2) {
            const bool last = (t == nt - 2);
            const char* a1 = cA + (size_t)(t + 1) * kstep;
            const char* a2 = last ? nA : cA + (size_t)(t + 2) * kstep; const char* b2 = last ? nB : cB + (size_t)(t + 2) * kstep;
            const char* a3 = a2 + kstep; const char* b3 = b2 + kstep;
            PG8_LDB(B0, 0, 0); PG8_LDB(B1, 0, 1); PG8_SCHED; PG8_LDA(At, 0, 0); PG8_STAGE_A(PG8_SA(1, 1), a1 + hsA, 1, false);
            PG8_WAIT_V(8); PG8_WAIT_L(0); PG8_BAR; PG8_MMA(0, 0, At, B0); PG8_MMA(0, 1, At, B1); PG8_BAR; PG8_SCHED;
            PG8_LDA(At, 0, 1); PG8_STAGE(PG8_SB(0, 0), b2, voffB); PG8_STAGE(PG8_SB(0, 1), b2 + hsB, voffB); PG8_STAGE_A(PG8_SA(0, 0), a2, 0, last);
            PG8_WAIT_V(8); PG8_WAIT_L(0); PG8_BAR; PG8_MMA(1, 0, At, B0); PG8_MMA(1, 1, At, B1); PG8_BAR; PG8_SCHED;
            PG8_LDB(B0, 1, 0); PG8_LDB(B1, 1, 1); PG8_SCHED; PG8_LDA(At, 1, 0); PG8_STAGE_A(PG8_SA(0, 1), a2 + hsA, 1, last);
            PG8_WAIT_V(8); PG8_WAIT_L(0); PG8_BAR; PG8_MMA(0, 0, At, B0); PG8_MMA(0, 1, At, B1); PG8_BAR; PG8_SCHED;
            PG8_LDA(At, 1, 1); PG8_STAGE(PG8_SB(1, 0), b3, voffB); PG8_STAGE(PG8_SB(1, 1), b3 + hsB, voffB); PG8_STAGE_A(PG8_SA(1, 0), a3, 0, last);
            PG8_WAIT_V(8); PG8_WAIT_L(0); PG8_BAR; PG8_MMA(1, 0, At, B0); PG8_MMA(1, 1, At, B1); PG8_BAR; PG8_SCHED;
        }
        if constexpr (ALIGN_EPI) { if (wr == 0) PG8_BAR; }
        E(acc, cur, wr, wc, fr, fq);
        if (!has_next) break;
#pragma unroll
        for (int a = 0; a < 2; ++a)
#pragma unroll
            for (int b = 0; b < 2; ++b)
#pragma unroll
                for (int m = 0; m < 4; ++m)
#pragma unroll
                    for (int n = 0; n < 2; ++n) acc[a][b][m][n] = (f32x4){0.f, 0.f, 0.f, 0.f};
        cur = nxt; cA = nA; cB = nB; ++ui;
        if constexpr (GATHER) { vgc[0][0] = vgn[0][0]; vgc[0][1] = vgn[0][1]; vgc[1][0] = vgn[1][0]; vgc[1][1] = vgn[1][1]; }
        if constexpr (ALIGN_EPI) { if (wr == 1) PG8_BAR; }
    }
    PG8_WAIT_V(0);
    if constexpr (!ALIGN_EPI) { if (wr == 0) PG8_BAR; }
    PG8_BAR;
#undef PG8_SA
#undef PG8_SB
#undef PG8_STAGE
#undef PG8_LDA
#undef PG8_LDB
#undef PG8_MMA
#undef PG8_WAIT_V
#undef PG8_WAIT_L
#undef PG8_BAR
#undef PG8_SCHED
#undef PG8_EOFF
#undef PG8_GOFF
#undef PG8_STAGE_A
}

__device__ __forceinline__ float row_rstd(const float* ssp, int row);
template <int ACT> struct EpiBf16 {
    static constexpr bool PERM = true;
    bf16_t* O; int ldc; const float* bias; const float* ssp;
    __device__ __forceinline__ void operator()(const f32x4 (&acc)[2][2][4][2], const Unit& u, int wr, int wc, int fr, int fq) const {
        const int row0 = u.pm * BM + wr * 64 + fr, col0 = u.pn * BM + wc * 32 + 8 * fq;
        f32x4 bv[2][2];
#pragma unroll
        for (int bj = 0; bj < 2; ++bj)
#pragma unroll
            for (int n = 0; n < 2; ++n) bv[bj][n] = bias ? *(const f32x4*)(bias + col0 + bj * HALF + 4 * n) : (f32x4){0.f, 0.f, 0.f, 0.f};
#pragma unroll
        for (int ai = 0; ai < 2; ++ai)
#pragma unroll
            for (int m = 0; m < 4; ++m) { bf16_t* rowp = O + (size_t)(row0 + ai * HALF + m * 16) * ldc + col0;
                const float rs = (ACT == 0 && ssp) ? row_rstd(ssp, row0 + ai * HALF + m * 16) : 1.f;
#pragma unroll
                for (int bj = 0; bj < 2; ++bj) { f32x4 v0 = acc[ai][bj][m][0] * rs + bv[bj][0], v1 = acc[ai][bj][m][1] * rs + bv[bj][1];
                    if (ACT == 2) {
#pragma unroll
                        for (int i = 0; i < 4; ++i) { v0[i] = gelu_tanh_f(v0[i]); v1[i] = gelu_tanh_f(v1[i]); } }
                    u32x4 w; w.x = cvtpk(v0[0], v0[1]); w.y = cvtpk(v0[2], v0[3]); w.z = cvtpk(v1[0], v1[1]); w.w = cvtpk(v1[2], v1[3]);
                    *(u32x4*)(rowp + bj * HALF) = w; } }
    }
};
struct EpiResF32 {
    static constexpr bool PERM = false;
    const float* base; float* out; int ldc;
    __device__ __forceinline__ void operator()(const f32x4 (&acc)[2][2][4][2], const Unit& u, int wr, int wc, int fr, int fq) const {
        const int col0 = u.pn * BM + wc * 32 + 4 * fq;
#pragma unroll
        for (int ai = 0; ai < 2; ++ai)
#pragma unroll
            for (int m = 0; m < 4; ++m) { const size_t off = (size_t)(u.pm * BM + ai * HALF + wr * 64 + m * 16 + fr) * ldc + col0;
#pragma unroll
                for (int bj = 0; bj < 2; ++bj)
#pragma unroll
                    for (int n = 0; n < 2; ++n) { const f32x4 bs = *(const f32x4*)(base + off + bj * HALF + n * 16); *(f32x4*)(out + off + bj * HALF + n * 16) = bs + acc[ai][bj][m][n]; } }
    }
};
template <bool BASE_BF16> struct EpiResStat {
    static constexpr bool PERM = false;
    const void* base; bf16_t* xb; float* ssp; int ldc;
    __device__ __forceinline__ void operator()(const f32x4 (&acc)[2][2][4][2], const Unit& u, int wr, int wc, int fr, int fq) const {
        const int col0 = u.pn * BM + wc * 32 + 4 * fq;
#pragma unroll
        for (int ai = 0; ai < 2; ++ai)
#pragma unroll
            for (int m = 0; m < 4; ++m) { const int row = u.pm * BM + ai * HALF + wr * 64 + m * 16 + fr; const size_t off = (size_t)row * ldc + col0; float ss = 0.f;
#pragma unroll
                for (int bj = 0; bj < 2; ++bj)
#pragma unroll
                    for (int n = 0; n < 2; ++n) { f32x4 bs;
                        if (BASE_BF16) { const u32x2 t = *(const u32x2*)((const bf16_t*)base + off + bj * HALF + n * 16); bs = (f32x4){bflo(t.x), bfhi(t.x), bflo(t.y), bfhi(t.y)}; }
                        else bs = *(const f32x4*)((const float*)base + off + bj * HALF + n * 16);
                        const f32x4 v = bs + acc[ai][bj][m][n];
                        u32x2 w; w.x = cvtpk(v.x, v.y); w.y = cvtpk(v.z, v.w); *(u32x2*)(xb + off + bj * HALF + n * 16) = w; ss += (v.x * v.x + v.y * v.y) + (v.z * v.z + v.w * v.w); }
                ss += __shfl_xor(ss, 16); ss += __shfl_xor(ss, 32);
                if (fq == 0) ssp[(size_t)row * 16 + u.pn * 4 + wc] = ss; }
    }
};
struct EpiResBf16B {
    static constexpr bool PERM = false;
    const bf16_t* base; bf16_t* out; int ldc;
    __device__ __forceinline__ void operator()(const f32x4 (&acc)[2][2][4][2], const Unit& u, int wr, int wc, int fr, int fq) const {
        const int col0 = u.pn * BM + wc * 32 + 4 * fq;
#pragma unroll
        for (int ai = 0; ai < 2; ++ai)
#pragma unroll
            for (int m = 0; m < 4; ++m) { const size_t off = (size_t)(u.pm * BM + ai * HALF + wr * 64 + m * 16 + fr) * ldc + col0;
#pragma unroll
                for (int bj = 0; bj < 2; ++bj)
#pragma unroll
                    for (int n = 0; n < 2; ++n) { const u32x2 t = *(const u32x2*)(base + off + bj * HALF + n * 16); const f32x4 v = (f32x4){bflo(t.x), bfhi(t.x), bflo(t.y), bfhi(t.y)} + acc[ai][bj][m][n];
                        u32x2 w; w.x = cvtpk(v.x, v.y); w.y = cvtpk(v.z, v.w); *(u32x2*)(out + off + bj * HALF + n * 16) = w; } }
    }
};
struct EpiResF32B {
    static constexpr bool PERM = false;
    const bf16_t* base; float* out; int ldc;
    __device__ __forceinline__ void operator()(const f32x4 (&acc)[2][2][4][2], const Unit& u, int wr, int wc, int fr, int fq) const {
        const int col0 = u.pn * BM + wc * 32 + 4 * fq;
#pragma unroll
        for (int ai = 0; ai < 2; ++ai)
#pragma unroll
            for (int m = 0; m < 4; ++m) { const size_t off = (size_t)(u.pm * BM + ai * HALF + wr * 64 + m * 16 + fr) * ldc + col0;
#pragma unroll
                for (int bj = 0; bj < 2; ++bj)
#pragma unroll
                    for (int n = 0; n < 2; ++n) { const u32x2 t = *(const u32x2*)(base + off + bj * HALF + n * 16); const f32x4 bs = {bflo(t.x), bfhi(t.x), bflo(t.y), bfhi(t.y)};
                        *(f32x4*)(out + off + bj * HALF + n * 16) = bs + acc[ai][bj][m][n]; } }
    }
};
__device__ __forceinline__ float row_rstd(const float* ssp, int row) {
    const f32x4* q = (const f32x4*)(ssp + (size_t)row * 16); const f32x4 a = q[0], b = q[1], c = q[2], d = q[3];
    const float s = ((a.x + a.y) + (a.z + a.w)) + ((b.x + b.y) + (b.z + b.w)) + ((c.x + c.y) + (c.z + c.w)) + ((d.x + d.y) + (d.z + d.w));
    return rsqrtf(s * (1.f / 1024.f) + EPS);
}
struct EpiSwiGLU {
    static constexpr bool PERM = true;
    bf16_t* O; int ldc; const float* ssp;
    __device__ __forceinline__ void operator()(const f32x4 (&acc)[2][2][4][2], const Unit& u, int wr, int wc, int fr, int fq) const {
        const int row0 = u.pm * BM + wr * 64 + fr, col0 = u.pn * HALF + wc * 32 + 8 * fq;
#pragma unroll
        for (int ai = 0; ai < 2; ++ai)
#pragma unroll
            for (int m = 0; m < 4; ++m) { bf16_t* rowp = O + (size_t)(row0 + ai * HALF + m * 16) * ldc + col0;
                const float rs = ssp ? row_rstd(ssp, row0 + ai * HALF + m * 16) : 1.f;
                float h[8];
#pragma unroll
                for (int n = 0; n < 2; ++n)
#pragma unroll
                    for (int i = 0; i < 4; ++i) h[n * 4 + i] = silu_f(acc[ai][0][m][n][i] * rs) * (acc[ai][1][m][n][i] * rs);
                u32x4 w; w.x = cvtpk(h[0], h[1]); w.y = cvtpk(h[2], h[3]); w.z = cvtpk(h[4], h[5]); w.w = cvtpk(h[6], h[7]);
                *(u32x4*)rowp = w; }
    }
};
struct EpiConvIn {
    static constexpr bool PERM = true;
    bf16_t* Bg; bf16_t* CU; const float* ssp;
    __device__ __forceinline__ void operator()(const f32x4 (&acc)[2][2][4][2], const Unit& u, int wr, int wc, int fr, int fq) const {
        const int row0 = u.pm * BM + wr * 64 + fr;
#pragma unroll
        for (int ai = 0; ai < 2; ++ai)
#pragma unroll
            for (int m = 0; m < 4; ++m) { const int row = row0 + ai * HALF + m * 16; const float rs = row_rstd(ssp, row);
                if (u.pn < 4) {
#pragma unroll
                    for (int bj = 0; bj < 2; ++bj) { const f32x4 v0 = acc[ai][bj][m][0] * rs, v1 = acc[ai][bj][m][1] * rs;
                        u32x4 w; w.x = cvtpk(v0[0], v0[1]); w.y = cvtpk(v0[2], v0[3]); w.z = cvtpk(v1[0], v1[1]); w.w = cvtpk(v1[2], v1[3]);
                        *(u32x4*)(Bg + (size_t)row * 1024 + u.pn * BM + bj * HALF + wc * 32 + 8 * fq) = w; }
                } else { const float r2 = rs * rs; float h[8];
#pragma unroll
                    for (int n = 0; n < 2; ++n)
#pragma unroll
                        for (int i = 0; i < 4; ++i) h[n * 4 + i] = acc[ai][0][m][n][i] * acc[ai][1][m][n][i] * r2;
                    u32x4 w; w.x = cvtpk(h[0], h[1]); w.y = cvtpk(h[2], h[3]); w.z = cvtpk(h[4], h[5]); w.w = cvtpk(h[6], h[7]);
                    *(u32x4*)(CU + (size_t)row * 1024 + (u.pn - 4) * HALF + wc * 32 + 8 * fq) = w; } }
    }
};
struct EpiRowScaleBf16 {
    static constexpr bool PERM = true;
    bf16_t* O; int ldc; const float* roww;
    __device__ __forceinline__ void operator()(const f32x4 (&acc)[2][2][4][2], const Unit& u, int wr, int wc, int fr, int fq) const {
        const int row0 = u.pm * BM + wr * 64 + fr, col0 = u.pn * BM + wc * 32 + 8 * fq;
#pragma unroll
        for (int ai = 0; ai < 2; ++ai)
#pragma unroll
            for (int m = 0; m < 4; ++m) { const int row = row0 + ai * HALF + m * 16; const float sc = roww[row]; bf16_t* rowp = O + (size_t)row * ldc + col0;
#pragma unroll
                for (int bj = 0; bj < 2; ++bj) { const f32x4 v0 = acc[ai][bj][m][0] * sc, v1 = acc[ai][bj][m][1] * sc;
                    u32x4 w; w.x = cvtpk(v0[0], v0[1]); w.y = cvtpk(v0[2], v0[3]); w.z = cvtpk(v1[0], v1[1]); w.w = cvtpk(v1[2], v1[3]);
                    *(u32x4*)(rowp + bj * HALF) = w; } }
    }
};
}
constexpr int ROWS_MAX = 2 * T + 8 * 256;
constexpr size_t al256(size_t x) { return (x + 255) & ~(size_t)255; }
constexpr size_t W_IN_E = 0;
constexpr size_t W_CW1 = W_IN_E + (size_t)1792 * 1024 * 2;
constexpr size_t W_UQ = W_CW1 + (size_t)2 * 256 * 2048 * 2;
constexpr size_t W_UKV = W_UQ + (size_t)1024 * 256 * 2;
constexpr size_t W_OUT_E = W_UKV + (size_t)1024 * 128 * 2;
constexpr size_t W_GU = W_OUT_E + (size_t)1024 * 1024 * 2;
constexpr size_t W_D = W_GU + (size_t)5632 * 1024 * 2;
constexpr size_t W_IN_O = W_D + (size_t)1024 * 2816 * 2;
constexpr size_t W_OUT_O = W_IN_O + (size_t)3072 * 1024 * 2;
constexpr size_t W_MGU = W_OUT_O + (size_t)1024 * 1024 * 2;
constexpr size_t W_MD = W_MGU + (size_t)8 * 2816 * 1024 * 2;
constexpr size_t W_END = W_MD + (size_t)8 * 1024 * 1408 * 2;
constexpr size_t SM_CTL = al256(W_END);
constexpr size_t SM_BAR = SM_CTL + 4096;
constexpr size_t SM_B1P = SM_BAR + 16384;
constexpr size_t SM_B1 = SM_B1P + 32 * 512 * 4;
constexpr size_t SM_ROPE = SM_B1 + 512 * 4;
constexpr size_t SM_BL = SM_ROPE + (size_t)S * 32 * 4;
constexpr size_t SM_HID = SM_BL + 8 * 132 * 4;
constexpr size_t SM_KC = SM_HID + (size_t)2 * NB * 512 * 512 * 2;
constexpr size_t SM_VCT = SM_KC + (size_t)NB * 512 * 64 * 2;
constexpr size_t SM_TE = SM_VCT + (size_t)NB * 512 * 64 * 2;
constexpr size_t SM_TW = SM_TE + (size_t)T * 8;
constexpr size_t SM_RANK = SM_TW + (size_t)T * 8;
constexpr size_t SM_POS = SM_RANK + (size_t)T * 8;
constexpr size_t SM_ROWW = SM_POS + (size_t)T * 8;
constexpr size_t SM_TILEE = SM_ROWW + (size_t)ROWS_MAX * 4;
constexpr size_t SM_ROWTOK = al256(SM_TILEE + (size_t)(ROWS_MAX / 256 + 8) * 4);
constexpr size_t SM_SSP1 = al256(SM_ROWTOK + (size_t)ROWS_MAX * 4);
constexpr size_t SM_SSP2 = SM_SSP1 + (size_t)T * 64;
constexpr size_t SM_END = SM_SSP2 + (size_t)T * 64;
constexpr size_t R_XA = al256(SM_END);
constexpr size_t SZ_XA = (size_t)T * 4096 + (size_t)4 * 1048576;
constexpr size_t R_XN = R_XA + SZ_XA;
constexpr size_t SZ_XN = (size_t)T * 2048;
constexpr size_t R_H = R_XN + SZ_XN;
constexpr size_t SZ_H = ((size_t)T * 6144 > (size_t)ROWS_MAX * 2816) ? (size_t)T * 6144 : (size_t)ROWS_MAX * 2816;
constexpr size_t WS_FAST_END = R_H + SZ_H;
constexpr size_t A_QN = 0;
constexpr size_t A_KSN = A_QN + (size_t)T * 1024;
constexpr size_t A_KWN = A_KSN + (size_t)T * 256;
constexpr size_t A_VST = A_KWN + (size_t)T * 256;
constexpr size_t A_VWT = A_VST + (size_t)T * 256;
constexpr size_t A_KCIN = A_VWT + (size_t)T * 256;
constexpr size_t A_VCIN = A_KCIN + (size_t)T * 256 + 2048;
constexpr size_t A_CQN = A_VCIN + (size_t)T * 256 + 2048;
constexpr size_t A_CKVN = A_CQN + (size_t)T * 512;
constexpr size_t A_KROPE = A_CKVN + (size_t)T * 256;
constexpr size_t A_GATES = A_KROPE + (size_t)T * 64;
constexpr size_t A_END = A_GATES + (size_t)T * 96;
static_assert(A_END <= SZ_XA, "attention inputs fit R_XA");
constexpr size_t O_QM = 0;
constexpr size_t O_KM = O_QM + (size_t)T * 1536;
constexpr size_t O_VMT = O_KM + (size_t)T * 1536;
static_assert(O_VMT + (size_t)T * 1024 <= (size_t)T * 4096, "d_out scratch");

struct Params {
    const float* in[30];
    float* out;
    unsigned char* ws;
    int ph_lo, ph_hi, dbg_branch, pad_;
};

#ifdef PROF_SEL
#define PROF_SLOT(k) ((unsigned long long*)(p.ws + SM_CTL + 2048) + (k))
#define PROF_ON(cond) ((cond) && threadIdx.x == 0)
#ifndef PROF_WAVE
#define PROF_WAVE 0
#endif
#endif
constexpr int LDS_BYTES = 147456;

__device__ __forceinline__ int ltid() { int t = threadIdx.x; asm volatile("" : "+v"(t)); return t; }
__device__ __forceinline__ int perm16(int k) { return (k & ~12) | ((k & 4) << 1) | ((k & 8) >> 1); }

struct WDesc { int in_idx, K, N, rep, map, row_off; size_t src_stride, dst_off, dst_stride; int gain_idx, pad_; size_t src_off; };
__device__ const WDesc WDESC[13] = {
    {3, 1024, 1720, 1, 2, 0, 0, W_IN_E / 2, 0, -1, 0},
    {7, 1024, 256, 2, 0, 0, (size_t)2048 * 256, W_CW1 / 2, (size_t)512 * 1024, -1, 0, 0},
    {7, 1024, 256, 2, 0, 256, (size_t)2048 * 256, W_CW1 / 2, (size_t)512 * 1024, -1, 0, (size_t)1024 * 256},
    {11, 256, 768, 1, 3, 0, 0, W_UQ / 2, 0, -1, 0},
    {12, 128, 1024, 1, 0, 0, 0, W_UKV / 2, 0, -1, 0},
    {15, 1024, 1024, 1, 0, 0, 0, W_OUT_E / 2, 0, -1, 0},
    {17, 1024, 2816, 1, 1, 0, 0, W_GU / 2, 0, 16, 0},
    {18, 1024, 2816, 1, 1, 128, 0, W_GU / 2, 0, 16, 0},
    {19, 2816, 1024, 1, 0, 0, 0, W_D / 2, 0, -1, 0},
    {21, 1024, 3072, 1, 4, 0, 0, W_IN_O / 2, 0, 20, 0},
    {23, 1024, 1024, 1, 0, 0, 0, W_OUT_O / 2, 0, -1, 0},
    {27, 1024, 1408, 8, 1, 0, (size_t)1024 * 1408, W_MGU / 2, (size_t)2816 * 1024, -1, 0},
    {28, 1024, 1408, 8, 1, 128, (size_t)1024 * 1408, W_MGU / 2, (size_t)2816 * 1024, -1, 0},
};
__device__ const WDesc WDESC_MD = {29, 1408, 1024, 8, 0, 0, (size_t)1408 * 1024, W_MD / 2, (size_t)1024 * 1408, -1, 0};

__device__ __forceinline__ void transpose_item(const float* W, int K, int N, bf16_t* WT, int map, int row_off, const float* gain, LAS float* scr, int item, int lane) {
    const int nblk = (N + 31) / 32, kb = item / nblk, nb = item % nblk, k0 = 64 * kb, n0 = 32 * nb;
    const int n4 = (lane & 7) * 4; const bool nok = (n0 + n4) < N;
    f32x4 v[8];
#pragma unroll
    for (int i = 0; i < 8; ++i) { const int kk = (lane >> 3) + 8 * i; v[i] = nok ? *(const f32x4*)(W + (size_t)(k0 + kk) * N + n0 + n4) : (f32x4){0.f, 0.f, 0.f, 0.f}; if (gain) v[i] = v[i] * gain[k0 + kk]; }
#pragma unroll
    for (int i = 0; i < 8; ++i) { const int kk = (lane >> 3) + 8 * i; LAS float* d = scr + kk * 33 + n4; d[0] = v[i].x; d[1] = v[i].y; d[2] = v[i].z; d[3] = v[i].w; }
    asm volatile("s_waitcnt lgkmcnt(0)" ::: "memory");
    const int c = lane & 7;
#pragma unroll
    for (int j = 0; j < 4; ++j) { const int n = (lane >> 3) + 8 * j; const LAS float* s = scr + (8 * c) * 33 + n;
        u32x4 o; o.x = cvtpk(s[0 * 33], s[1 * 33]); o.y = cvtpk(s[2 * 33], s[3 * 33]); o.z = cvtpk(s[4 * 33], s[5 * 33]); o.w = cvtpk(s[6 * 33], s[7 * 33]);
        const int nn = n0 + n;
        if (nn < N) { const int row = (map == 1) ? (256 * (nn >> 7) + (nn & 127) + row_off) : (map == 2) ? (nn < 1280 ? nn : (nn < 1304 ? nn + 416 : nn - 24)) : (map == 3) ? ((nn / 96) * 128 + nn % 96) : (map == 4) ? (nn < 1024 ? nn : (nn < 2048 ? 1024 + 256 * ((nn - 1024) >> 7) + ((nn - 1024) & 127) : 1024 + 256 * ((nn - 2048) >> 7) + 128 + ((nn - 2048) & 127))) : (nn + row_off);
            *(u32x4*)(WT + (size_t)row * K + k0 + 8 * c) = o; } }
    asm volatile("s_waitcnt lgkmcnt(0)" ::: "memory");
}
__device__ __forceinline__ void do_wdesc(const Params& p, const WDesc& d, int it, LAS float* scr, int lane) {
    const int per = (d.K / 64) * ((d.N + 31) / 32); const int r = it / per, ii = it % per;
    transpose_item(p.in[d.in_idx] + d.src_off + (size_t)r * d.src_stride, d.K, d.N, (bf16_t*)p.ws + d.dst_off + (size_t)r * d.dst_stride, d.map, d.row_off, d.gain_idx >= 0 ? p.in[d.gain_idx] : nullptr, scr, ii, lane);
}
__device__ __forceinline__ void rms_row_to_bf16(const float* xrow, const float* g, bf16_t* orow, int lane) {
    const f32x4* xr = (const f32x4*)xrow + lane; const f32x4* gr = (const f32x4*)g + lane;
    f32x4 v[4]; float s = 0.f;
#pragma unroll
    for (int j = 0; j < 4; ++j) { v[j] = xr[64 * j]; s += (v[j].x * v[j].x + v[j].y * v[j].y) + (v[j].z * v[j].z + v[j].w * v[j].w); }
    const float r = rsqrtf(wsum(s) * (1.f / 1024.f) + EPS);
    u32x2* o8 = (u32x2*)orow + lane;
#pragma unroll
    for (int j = 0; j < 4; ++j) { const f32x4 gg = gr[64 * j]; u32x2 w; w.x = cvtpk(v[j].x * r * gg.x, v[j].y * r * gg.y); w.y = cvtpk(v[j].z * r * gg.z, v[j].w * r * gg.w); o8[64 * j] = w; }
}
__device__ __forceinline__ void phase_p0(const Params& p, LAS unsigned char* lds) {
    const int tid = ltid(), lane = tid & 63, wave = tid >> 6;
    const int gw = blockIdx.x * 8 + wave, NGW = gridDim.x * 8;
    LAS float* scr = (LAS float*)(lds + wave * 16384);
    int base = 0;
#pragma unroll 1
    for (int d = 0; d < 14; ++d) {
        const WDesc& wd = (d < 13) ? WDESC[d] : WDESC_MD;
        const int n_it = wd.rep * (wd.K / 64) * ((wd.N + 31) / 32);
        int first = (gw - (base % NGW) + NGW) % NGW;
        for (int it = first; it < n_it; it += NGW) do_wdesc(p, wd, it, scr, lane);
        base += n_it;
    }
    bf16_t* xn = (bf16_t*)(p.ws + R_XN);
    for (int m = gw; m < T; m += 2 * NGW) { rms_row_to_bf16(p.in[0] + (size_t)m * D, p.in[2], xn + (size_t)m * D, lane); if (m + NGW < T) rms_row_to_bf16(p.in[0] + (size_t)(m + NGW) * D, p.in[2], xn + (size_t)(m + NGW) * D, lane); }
    for (int u = gw; u < 256; u += NGW) {
        const int kc = u >> 3, kv = (u >> 2) & 1, nb = u & 3; float s = 0.f;
        const float* pos = p.in[6] + kv * 2048 + kc * 64; const float* w1 = p.in[7] + ((size_t)kv * 2048 + kc * 64) * 256 + nb * 64 + lane;
#pragma unroll 8
        for (int k = 0; k < 64; ++k) s += pos[k] * w1[(size_t)k * 256];
        ((float*)(p.ws + SM_B1P))[kc * 512 + kv * 256 + nb * 64 + lane] = s;
    }
    for (int i = blockIdx.x * 512 + tid; i < S * 16; i += gridDim.x * 512) {
        const int t = i >> 4, f = i & 15; const float ang = (float)t * powf(10000.f, -(float)f / 16.f);
        float* rp = (float*)(p.ws + SM_ROPE) + t * 32; rp[f] = cosf(ang); rp[16 + f] = sinf(ang);
    }
    if (blockIdx.x == 0) for (int i = tid; i < 8 * 129; i += 512) { const int h = i / 129, dd = i % 129; ((float*)(p.ws + SM_BL))[h * 132 + dd] = p.in[1][(dd < 128 ? (int)gold::T5B[dd] : 31) * 8 + h] * LOG2E; }
}

__device__ __forceinline__ void unpack8(const u32x4 v, float (&x)[8]) { x[0] = bflo(v.x); x[1] = bfhi(v.x); x[2] = bflo(v.y); x[3] = bfhi(v.y); x[4] = bflo(v.z); x[5] = bfhi(v.z); x[6] = bflo(v.w); x[7] = bfhi(v.w); }
__device__ __forceinline__ u32x4 pack8(const float (&x)[8]) { u32x4 w; w.x = cvtpk(x[0], x[1]); w.y = cvtpk(x[2], x[3]); w.z = cvtpk(x[4], x[5]); w.w = cvtpk(x[6], x[7]); return w; }
__device__ __forceinline__ float ss8f(const float (&x)[8]) { return ((x[0] * x[0] + x[1] * x[1]) + (x[2] * x[2] + x[3] * x[3])) + ((x[4] * x[4] + x[5] * x[5]) + (x[6] * x[6] + x[7] * x[7])); }
__device__ __forceinline__ void load8f(const float* g, float (&x)[8], float sc) { const f32x4 a = *(const f32x4*)g, b = *(const f32x4*)(g + 4); x[0] = a.x * sc; x[1] = a.y * sc; x[2] = a.z * sc; x[3] = a.w * sc; x[4] = b.x * sc; x[5] = b.y * sc; x[6] = b.z * sc; x[7] = b.w * sc; }
__device__ __forceinline__ void phase_p2(const Params& p, LAS unsigned char* lds) {
    const int tid = ltid(), lane = tid & 63, wave = tid >> 6;
    const bf16_t* hb = (const bf16_t*)(p.ws + R_H);
    unsigned char* xa = p.ws + R_XA;
    bf16_t* qn = (bf16_t*)(xa + A_QN); bf16_t* ksn = (bf16_t*)(xa + A_KSN); bf16_t* kwn = (bf16_t*)(xa + A_KWN);
    bf16_t* vst = (bf16_t*)(xa + A_VST); bf16_t* vwt = (bf16_t*)(xa + A_VWT); bf16_t* kcin = (bf16_t*)(xa + A_KCIN); bf16_t* vcin = (bf16_t*)(xa + A_VCIN);
    bf16_t* cqn = (bf16_t*)(xa + A_CQN); bf16_t* ckvn = (bf16_t*)(xa + A_CKVN); bf16_t* krope = (bf16_t*)(xa + A_KROPE); float* gates = (float*)(xa + A_GATES);
    LAS bf16_t* vs = (LAS bf16_t*)lds;
    if (blockIdx.x == 0) {
        { float s = 0.f; for (int k = 0; k < 32; ++k) s += ((const float*)(p.ws + SM_B1P))[k * 512 + tid]; ((float*)(p.ws + SM_B1))[tid] = s; }
        for (int i = tid; i < 1024; i += 512) { kcin[(size_t)T * 128 + i] = 0; vcin[(size_t)T * 128 + i] = 0; }
    }
    const int c8 = (lane & 7) * 8, seg = lane >> 3;
    float qg[8], ksg[8], kwg[8], cqg[8], ckvg[8];
    load8f(p.in[4] + c8, qg, 0.125f * LOG2E); load8f(p.in[5] + 64 + c8, ksg, 1.f); load8f(p.in[5] + 128 + c8, kwg, 1.f);
    load8f(p.in[9] + (lane & 31) * 8, cqg, 1.f); load8f(p.in[10] + (lane & 15) * 8, ckvg, 1.f);
    for (int tile = blockIdx.x; tile < T / 64; tile += gridDim.x) {
        const int b = tile / (S / 64), s0 = (tile % (S / 64)) * 64;
#pragma unroll 4
        for (int tt = 0; tt < 8; ++tt) {
            const int sl = wave * 8 + tt, s = s0 + sl; const size_t t = (size_t)b * S + s;
            const bf16_t* hr = hb + t * 1792 + lane * 8;
            const u32x4 L0 = *(const u32x4*)hr, L1 = *(const u32x4*)(hr + 512), L2 = *(const u32x4*)(hr + 1024);
            u32x4 L3 = {0u, 0u, 0u, 0u}; if (lane < 32) L3 = *(const u32x4*)(hr + 1536);
            float x0[8], x1[8], x2[8], x3[8];
            unpack8(L0, x0); unpack8(L1, x1); unpack8(L2, x2); unpack8(L3, x3);
            float a0 = ss8f(x0), a1 = ss8f(x1), a2 = ss8f(x2), a3 = ss8f(x3);
#pragma unroll
            for (int o = 1; o < 8; o <<= 1) { a0 += __shfl_xor(a0, o); a1 += __shfl_xor(a1, o); a2 += __shfl_xor(a2, o); a3 += __shfl_xor(a3, o); }
            float a2w = a2 + __shfl_xor(a2, 8); a2w += __shfl_xor(a2w, 16);
            const float a3w = a3 + __shfl_xor(a3, 8);
            const int pp0 = (sl & ~15) | perm16(sl & 15);
            const int pp = (((pp0 >> 3) ^ (lane & 7)) << 3) | (pp0 & 7);
            {
                const float r = rsqrtf(a0 * (1.f / 64.f) + EPS); float y[8];
#pragma unroll
                for (int j = 0; j < 8; ++j) y[j] = x0[j] * r * qg[j];
                *(u32x4*)(qn + t * 512 + lane * 8) = pack8(y);
            }
            {
                const int g = seg & 1; const size_t gm = (((size_t)b * 2 + g) * S + s) * 64 + c8;
                if (seg < 2) *(u32x4*)(kcin + gm) = L1;
                else if (seg < 4) *(u32x4*)(vcin + gm) = L1;
                else if (seg < 6) { const float r = rsqrtf(a1 * (1.f / 64.f) + EPS); float y[8];
#pragma unroll
                    for (int j = 0; j < 8; ++j) y[j] = x1[j] * r * ksg[j];
                    *(u32x4*)(ksn + gm) = pack8(y); }
                else {
#pragma unroll
                    for (int j = 0; j < 8; ++j) vs[((0 + g) * 64 + c8 + j) * 72 + pp] = (bf16_t)((j & 1) ? (L1[j >> 1] >> 16) : (L1[j >> 1] & 0xffffu)); }
            }
            {
                const int g = seg & 1; const size_t gm = (((size_t)b * 2 + g) * S + s) * 64 + c8;
                if (seg < 2) { const float r = rsqrtf(a2 * (1.f / 64.f) + EPS); float y[8];
#pragma unroll
                    for (int j = 0; j < 8; ++j) y[j] = x2[j] * r * kwg[j];
                    *(u32x4*)(kwn + gm) = pack8(y); }
                else if (seg < 4) {
#pragma unroll
                    for (int j = 0; j < 8; ++j) vs[((2 + g) * 64 + c8 + j) * 72 + pp] = (bf16_t)((j & 1) ? (L2[j >> 1] >> 16) : (L2[j >> 1] & 0xffffu)); }
                else { const float r = rsqrtf(a2w * (1.f / 256.f) + EPS); float y[8];
#pragma unroll
                    for (int j = 0; j < 8; ++j) y[j] = x2[j] * r * cqg[j];
                    *(u32x4*)(cqn + t * 256 + (lane - 32) * 8) = pack8(y); }
            }
            {
                if (lane < 16) { const float r = rsqrtf(a3w * (1.f / 128.f) + EPS); float y[8];
#pragma unroll
                    for (int j = 0; j < 8; ++j) y[j] = x3[j] * r * ckvg[j];
                    *(u32x4*)(ckvn + t * 128 + lane * 8) = pack8(y); }
                else if (lane < 20) *(u32x4*)(krope + t * 32 + (lane - 16) * 8) = L3;
                else if (lane < 23) { float y[8];
#pragma unroll
                    for (int j = 0; j < 8; ++j) y[j] = frcp(1.f + fexp2(-x3[j] * LOG2E));
                    float* gp = gates + t * 24 + (lane - 20) * 8; *(f32x4*)gp = (f32x4){y[0], y[1], y[2], y[3]}; *(f32x4*)(gp + 4) = (f32x4){y[4], y[5], y[6], y[7]}; }
            }
        }
        __syncthreads();
        {
            const int row = tid >> 1, half = tid & 1, which = row >> 6, d = row & 63, g = which & 1;
            bf16_t* dst = ((which < 2) ? vst : vwt) + (((size_t)b * 2 + g) * 64 + d) * S + s0 + half * 32;
            const LAS bf16_t* src = vs + row * 72; const int sx = (row >> 3) & 7;
#pragma unroll
            for (int c = 0; c < 4; ++c) *(u32x4*)(dst + c * 8) = *(const LAS u32x4*)(src + (((half * 4 + c) ^ sx) << 3));
        }
        __syncthreads();
    }
}
__device__ __forceinline__ void phase_p3b(const Params& p, LAS unsigned char* lds) {
    const int tid = ltid(), lane = tid & 63, wave = tid >> 6;
    const int gw = blockIdx.x * 8 + wave, NGW = gridDim.x * 8;
    const bf16_t* qraw = (const bf16_t*)(p.ws + R_H);
    const bf16_t* kvraw = (const bf16_t*)(p.ws + R_H + (size_t)T * 2048);
    const bf16_t* krope = (const bf16_t*)(p.ws + R_XA + A_KROPE);
    const float* rope = (const float*)(p.ws + SM_ROPE);
    bf16_t* qm = (bf16_t*)((unsigned char*)p.out + O_QM); bf16_t* km = (bf16_t*)((unsigned char*)p.out + O_KM); bf16_t* vmt = (bf16_t*)((unsigned char*)p.out + O_VMT);
    const float* q_norm = p.in[13]; const float* k_norm = p.in[14];
    LAS bf16_t* vs = (LAS bf16_t*)lds;
    LAS float* w2s = (LAS float*)(lds + 73728);
    for (int kv = 0; kv < 2; ++kv) {
        __syncthreads();
        for (int i = tid; i < 256 * 64; i += 512) w2s[i] = p.in[8][kv * 16384 + i];
        __syncthreads();
        const bf16_t* P = (const bf16_t*)(p.ws + SM_HID) + (size_t)kv * NB * 512 * 512;
        const f32x4 bs = *(const f32x4*)((const float*)(p.ws + SM_B1) + kv * 256 + lane * 4);
        for (int row = gw; row < NB * 512; row += NGW) {
            const int row1 = row + 1 < NB * 512 ? row + 1 : row;
            const u32x2 pa = *(const u32x2*)(P + (size_t)row * 512 + lane * 4), pb = *(const u32x2*)(P + (size_t)row1 * 512 + 256 + lane * 4);
            const float h0 = gelu_tanh_f(bflo(pa.x) + bflo(pb.x) + bs.x), h1 = gelu_tanh_f(bfhi(pa.x) + bfhi(pb.x) + bs.y), h2 = gelu_tanh_f(bflo(pa.y) + bflo(pb.y) + bs.z), h3 = gelu_tanh_f(bfhi(pa.y) + bfhi(pb.y) + bs.w);
            float acc = 0.f;
#pragma unroll 8
            for (int k4 = 0; k4 < 64; ++k4) {
                acc += __shfl(h0, k4) * w2s[(k4 * 4 + 0) * 64 + lane]; acc += __shfl(h1, k4) * w2s[(k4 * 4 + 1) * 64 + lane];
                acc += __shfl(h2, k4) * w2s[(k4 * 4 + 2) * 64 + lane]; acc += __shfl(h3, k4) * w2s[(k4 * 4 + 3) * 64 + lane];
            }
            if (kv == 0) { const float r = rsqrtf(wsum(acc * acc) * (1.f / 64.f) + EPS); ((bf16_t*)(p.ws + SM_KC))[(size_t)row * 64 + lane] = f2bf(acc * r * p.in[5][lane]); }
            else { const int c = row & 255; ((bf16_t*)(p.ws + SM_VCT))[((size_t)(row >> 8) * 64 + lane) * 256 + ((c & ~15) | perm16(c & 15))] = f2bf(acc); }
        }
    }
    __syncthreads();
    const float QS = 0.10206207261596577f * LOG2E;
    const int c = lane & 15, hl = lane >> 4;
    float qg[8], kg[8];
    load8f(q_norm + (c < 12 ? c * 8 : 0), qg, QS);
    load8f(k_norm + (c < 12 ? c * 8 : 0), kg, 1.f);
    for (int tile = blockIdx.x; tile < T / 64; tile += gridDim.x) {
        const int b = tile / (S / 64), s0 = (tile % (S / 64)) * 64;
#pragma unroll 4
        for (int tt = 0; tt < 8; ++tt) {
            const int sl = wave * 8 + tt, s = s0 + sl; const size_t t = (size_t)b * S + s;
            const int pp0 = (sl & ~15) | perm16(sl & 15);
            const int pp = (((pp0 >> 3) ^ ((c - 8) & 7)) << 3) | (pp0 & 7);
            u32x4 Q[2], KV[2];
#pragma unroll
            for (int ld = 0; ld < 2; ++ld) { Q[ld] = *(const u32x4*)(qraw + t * 1024 + ld * 512 + lane * 8); KV[ld] = *(const u32x4*)(kvraw + t * 1024 + ld * 512 + lane * 8); }
            u32x4 KR = {0u, 0u, 0u, 0u}; f32x4 cs0 = {0.f, 0.f, 0.f, 0.f}, cs1 = cs0, sn0 = cs0, sn1 = cs0;
            if (c >= 8 && c < 12) { KR = *(const u32x4*)(krope + t * 32 + (c - 8) * 8);
                const float* rp = rope + s * 32 + (c & 1) * 8; cs0 = *(const f32x4*)rp; cs1 = *(const f32x4*)(rp + 4); sn0 = *(const f32x4*)(rp + 16); sn1 = *(const f32x4*)(rp + 20); }
            const float cs[8] = {cs0.x, cs0.y, cs0.z, cs0.w, cs1.x, cs1.y, cs1.z, cs1.w}, sn[8] = {sn0.x, sn0.y, sn0.z, sn0.w, sn1.x, sn1.y, sn1.z, sn1.w};
            float kr[8]; unpack8(KR, kr);
            const float krs = ss8f(kr);
#pragma unroll
            for (int ld = 0; ld < 2; ++ld) {
                const int hh = ld * 4 + hl;
                {
                    float x[8]; unpack8(Q[ld], x);
                    float ss = c < 12 ? ss8f(x) : 0.f;
#pragma unroll
                    for (int o = 1; o < 16; o <<= 1) ss += __shfl_xor(ss, o);
                    const float r = rsqrtf(ss * (1.f / 96.f) + EPS); float y[8], z[8];
#pragma unroll
                    for (int j = 0; j < 8; ++j) y[j] = x[j] * r * qg[j];
#pragma unroll
                    for (int j = 0; j < 8; ++j) { const float pb = __shfl_xor(y[j], 2); z[j] = (c < 8) ? y[j] : ((c < 10) ? (y[j] * cs[j] - pb * sn[j]) : (pb * sn[j] + y[j] * cs[j])); }
                    if (c < 12) *(u32x4*)(qm + (t * 8 + hh) * 96 + c * 8) = pack8(z);
                }
                {
                    float x[8]; unpack8(KV[ld], x);
                    float ss = c < 8 ? ss8f(x) : krs;
#pragma unroll
                    for (int o = 1; o < 16; o <<= 1) ss += __shfl_xor(ss, o);
                    const float r = rsqrtf(ss * (1.f / 96.f) + EPS); float y[8], z[8];
#pragma unroll
                    for (int j = 0; j < 8; ++j) y[j] = (c < 8 ? x[j] : kr[j]) * r * kg[j];
#pragma unroll
                    for (int j = 0; j < 8; ++j) { const float pb = __shfl_xor(y[j], 2); z[j] = (c < 8) ? y[j] : ((c < 10) ? (y[j] * cs[j] - pb * sn[j]) : (pb * sn[j] + y[j] * cs[j])); }
                    if (c < 12) *(u32x4*)(km + (((size_t)b * 8 + hh) * S + s) * 96 + c * 8) = pack8(z);
                    if (c >= 8) {
#pragma unroll
                        for (int j = 0; j < 8; ++j) vs[(hh * 64 + (c - 8) * 8 + j) * 72 + pp] = (bf16_t)((j & 1) ? (KV[ld][j >> 1] >> 16) : (KV[ld][j >> 1] & 0xffffu)); }
                }
            }
        }
        __syncthreads();
        {
            const int hh = tid >> 6, d = tid & 63;
            bf16_t* dst = vmt + (((size_t)b * 8 + hh) * 64 + d) * S + s0;
            const LAS bf16_t* src = vs + tid * 72; const int sx = (tid >> 3) & 7;
#pragma unroll
            for (int cc = 0; cc < 8; ++cc) *(u32x4*)(dst + cc * 8) = *(const LAS u32x4*)(src + ((cc ^ sx) << 3));
        }
        __syncthreads();
    }
}

__device__ const unsigned short UNIT_TYPES[256] = {63,127,62,126,61,125,527,591,655,719,783,847,911,975,60,124,59,123,58,122,57,121,56,120,526,590,654,718,782,846,910,974,55,119,54,118,53,117,52,116,51,115,525,589,653,717,781,845,909,973,50,114,49,113,48,112,47,111,524,588,652,716,780,844,908,972,46,110,45,109,44,108,43,107,523,587,651,715,779,843,907,971,42,106,41,105,40,104,39,103,38,102,522,586,650,714,778,842,906,970,37,101,36,100,35,99,34,98,33,97,521,585,649,713,777,841,905,969,32,96,31,95,30,94,520,584,648,712,776,840,904,968,29,93,28,92,27,91,26,90,25,89,519,583,647,711,775,839,903,967,24,88,23,87,22,86,21,85,20,84,518,582,646,710,774,838,902,966,19,83,18,82,17,81,16,80,15,79,517,581,645,709,773,837,901,965,14,78,13,77,12,76,516,580,644,708,772,836,900,964,11,75,10,74,9,73,8,72,515,579,643,707,771,835,899,963,7,71,6,70,5,69,514,578,642,706,770,834,898,962,4,68,3,67,513,577,641,705,769,833,897,961,2,66,1,65,0,64,512,576,640,704,768,832,896,960};
__device__ __forceinline__ int crow(int r, int hi) { return (r & 3) + 8 * (r >> 2) + 4 * hi; }
struct Flash { f32x16 o0, o1; float l; };
__device__ __forceinline__ void flash_init(Flash& st) {
#pragma unroll
    for (int r = 0; r < 16; ++r) { st.o0[r] = 0.f; st.o1[r] = 0.f; }
    st.l = 0.f;
}
constexpr int AL_K64 = 0, AL_V64 = 3 * 8192;
constexpr int AL_K96 = 0, AL_V96 = 3 * 16384;
constexpr int AL_IMP = 49152, AL_SELB = AL_IMP + 64 * 65 * 4, AL_UNI = AL_SELB + 512, AL_TL = AL_UNI + 64, AL_BL = AL_TL + 128, AL_OT = AL_BL + 4 * 132 * 4, AL_END = AL_OT + 8 * 32 * 64 * 4;
static_assert(AL_END <= 139264 && AL_V96 + 3 * 8192 <= 139264, "attention LDS");

template <int RB> struct DmaLane { unsigned g0, g1; };
template <int RB> __device__ __forceinline__ void dma_setup(DmaLane<RB>& L, int w, int lane, unsigned gs) {
    if (RB == 128) { const int r = 8 * w + (lane >> 3), c = (lane & 7) ^ ((r >> 1) & 7); L.g0 = (unsigned)r * gs + c * 16; L.g1 = 0; }
    else {
        { const int r = 8 * w + (lane >> 4); int c = (lane & 15) ^ (r & 15); c = c >= 12 ? c - 4 : c; L.g0 = (unsigned)r * gs + c * 16; }
        { const int r = 8 * w + 4 + (lane >> 4); int c = (lane & 15) ^ (r & 15); c = c >= 12 ? c - 4 : c; L.g1 = (unsigned)r * gs + c * 16; }
    }
}
template <int RB> __device__ __forceinline__ void dma_issue(const unsigned char* tile, const DmaLane<RB>& L, LAS unsigned char* buf, int w) {
    if (RB == 128) __builtin_amdgcn_global_load_lds((const unsigned*)(tile + L.g0), (LAS unsigned*)(buf + w * 1024), 16, 0, 0);
    else { __builtin_amdgcn_global_load_lds((const unsigned*)(tile + L.g0), (LAS unsigned*)(buf + w * 2048), 16, 0, 0);
           __builtin_amdgcn_global_load_lds((const unsigned*)(tile + L.g1), (LAS unsigned*)(buf + w * 2048 + 1024), 16, 0, 0); }
}
template <int DK> __device__ __forceinline__ void frag_offsets(unsigned (&kl)[DK / 16], unsigned (&vl)[4], int r32, int hi) {
#pragma unroll
    for (int s = 0; s < DK / 16; ++s) kl[s] = (DK == 64) ? (unsigned)(r32 * 128 + (((2 * s + hi) ^ ((r32 >> 1) & 7)) << 4)) : (unsigned)(r32 * 256 + (((2 * s + hi) ^ (r32 & 15)) << 4));
#pragma unroll
    for (int s = 0; s < 4; ++s) vl[s] = (unsigned)(r32 * 128 + (((2 * s + hi) ^ ((r32 >> 1) & 7)) << 4));
}

template <int DK, int KP, bool LANEMASK, class F>
__device__ __forceinline__ void tile_compute(Flash& st, const LAS unsigned char* Kt, const LAS unsigned char* Vt, const bf16x8* qf, const f32x16& negm, const unsigned (&kl)[DK / 16], const unsigned (&vl)[4], bool mine, F f) {
    constexpr int NS = DK / 16; constexpr int KH = 32 * KP;
    bf16x8 ka[NS], kh[NS];
#pragma unroll
    for (int s = 0; s < NS; ++s) ka[s] = *(const LAS bf16x8*)(Kt + kl[s]);
#pragma unroll
    for (int s = 0; s < NS; ++s) kh[s] = *(const LAS bf16x8*)(Kt + kl[s] + KH);
    __builtin_amdgcn_sched_barrier(0);
    f32x16 p0, p1;
#pragma unroll
    for (int s = 0; s < NS; ++s) p0 = (s == 0) ? __builtin_amdgcn_mfma_f32_32x32x16_bf16(ka[0], qf[0], negm, 0, 0, 0) : __builtin_amdgcn_mfma_f32_32x32x16_bf16(ka[s], qf[s], p0, 0, 0, 0);
#pragma unroll
    for (int s = 0; s < NS; ++s) p1 = (s == 0) ? __builtin_amdgcn_mfma_f32_32x32x16_bf16(kh[0], qf[0], negm, 0, 0, 0) : __builtin_amdgcn_mfma_f32_32x32x16_bf16(kh[s], qf[s], p1, 0, 0, 0);
    bf16x8 va[4], vh[4];
#pragma unroll
    for (int s = 0; s < 4; ++s) { va[s] = *(const LAS bf16x8*)(Vt + vl[s]); vh[s] = *(const LAS bf16x8*)(Vt + vl[s] + 4096); }
    __builtin_amdgcn_sched_barrier(0);
    float ls = 0.f;
    u32x4 w0, w1, w2, w3;
    {
#pragma unroll
        for (int r = 0; r < 16; ++r) { float x = p0[r]; const bool v = f(r, 0, x); const float e = fexp2(x); p0[r] = v ? e : 0.f; ls += p0[r]; }
        w0.x = cvtpk(p0[0], p0[1]); w0.y = cvtpk(p0[2], p0[3]); w0.z = cvtpk(p0[4], p0[5]); w0.w = cvtpk(p0[6], p0[7]);
        w1.x = cvtpk(p0[8], p0[9]); w1.y = cvtpk(p0[10], p0[11]); w1.z = cvtpk(p0[12], p0[13]); w1.w = cvtpk(p0[14], p0[15]);
        if (LANEMASK) { w0.x = mine ? w0.x : 0u; w0.y = mine ? w0.y : 0u; w0.z = mine ? w0.z : 0u; w0.w = mine ? w0.w : 0u; w1.x = mine ? w1.x : 0u; w1.y = mine ? w1.y : 0u; w1.z = mine ? w1.z : 0u; w1.w = mine ? w1.w : 0u; }
    }
#pragma unroll
    for (int s = 0; s < 2; ++s) {
        const bf16x8 pa = __builtin_bit_cast(bf16x8, s ? w1 : w0);
        st.o0 = __builtin_amdgcn_mfma_f32_32x32x16_bf16(pa, va[s], st.o0, 0, 0, 0);
        st.o1 = __builtin_amdgcn_mfma_f32_32x32x16_bf16(pa, vh[s], st.o1, 0, 0, 0);
    }
    {
#pragma unroll
        for (int r = 0; r < 16; ++r) { float x = p1[r]; const bool v = f(r, 1, x); const float e = fexp2(x); p1[r] = v ? e : 0.f; ls += p1[r]; }
        w2.x = cvtpk(p1[0], p1[1]); w2.y = cvtpk(p1[2], p1[3]); w2.z = cvtpk(p1[4], p1[5]); w2.w = cvtpk(p1[6], p1[7]);
        w3.x = cvtpk(p1[8], p1[9]); w3.y = cvtpk(p1[10], p1[11]); w3.z = cvtpk(p1[12], p1[13]); w3.w = cvtpk(p1[14], p1[15]);
        if (LANEMASK) { w2.x = mine ? w2.x : 0u; w2.y = mine ? w2.y : 0u; w2.z = mine ? w2.z : 0u; w2.w = mine ? w2.w : 0u; w3.x = mine ? w3.x : 0u; w3.y = mine ? w3.y : 0u; w3.z = mine ? w3.z : 0u; w3.w = mine ? w3.w : 0u; }
    }
    if (LANEMASK) ls = mine ? ls : 0.f;
    st.l += ls;
#pragma unroll
    for (int s = 2; s < 4; ++s) {
        const bf16x8 pa = __builtin_bit_cast(bf16x8, (s == 3) ? w3 : w2);
        st.o0 = __builtin_amdgcn_mfma_f32_32x32x16_bf16(pa, va[s], st.o0, 0, 0, 0);
        st.o1 = __builtin_amdgcn_mfma_f32_32x32x16_bf16(pa, vh[s], st.o1, 0, 0, 0);
    }
}
template <int DK, int KP> __device__ __forceinline__ void qk_tile(f32x16& p0, f32x16& p1, const LAS unsigned char* Kt, const bf16x8* qf, const f32x16& negm, const unsigned (&kl)[DK / 16]) {
#pragma unroll
    for (int s = 0; s < DK / 16; ++s) {
        const bf16x8 a0 = *(const LAS bf16x8*)(Kt + kl[s]);
        const bf16x8 a1 = *(const LAS bf16x8*)(Kt + kl[s] + 32 * KP);
        if (s == 0) { p0 = __builtin_amdgcn_mfma_f32_32x32x16_bf16(a0, qf[0], negm, 0, 0, 0); p1 = __builtin_amdgcn_mfma_f32_32x32x16_bf16(a1, qf[0], negm, 0, 0, 0); }
        else { p0 = __builtin_amdgcn_mfma_f32_32x32x16_bf16(a0, qf[s], p0, 0, 0, 0); p1 = __builtin_amdgcn_mfma_f32_32x32x16_bf16(a1, qf[s], p1, 0, 0, 0); }
    }
}
template <bool FIRST> __device__ __forceinline__ void flash_accum(LAS float* otl, const Flash& st, float gate, int hi, int lane) {
    const float lt = st.l + __shfl_xor(st.l, 32);
    const float f = lt > 0.f ? gate * frcp(lt) : 0.f;
#pragma unroll
    for (int r = 0; r < 16; ++r) { const float fr_ = __shfl(f, crow(r, hi));
        if (FIRST) { otl[r * 64 + lane] = fr_ * st.o0[r]; otl[(16 + r) * 64 + lane] = fr_ * st.o1[r]; }
        else { otl[r * 64 + lane] += fr_ * st.o0[r]; otl[(16 + r) * 64 + lane] += fr_ * st.o1[r]; } }
}
template <int NS> __device__ __forceinline__ float qnorm2(const bf16x8* qf) {
    float s = 0.f;
#pragma unroll
    for (int i = 0; i < NS; ++i)
#pragma unroll
        for (int j = 0; j < 8; ++j) { const float x = bf2f((bf16_t)qf[i][j]); s += x * x; }
    return s + __shfl_xor(s, 32);
}
__device__ __forceinline__ float wmax(float v) {
#pragma unroll
    for (int o = 1; o < 64; o <<= 1) v = fmaxf(v, __shfl_xor(v, o));
    return v;
}

template <int RBK, bool HASV, int KOFF, int KSZ, int VOFF, class SrcK, class SrcV, class Comp>
__device__ __forceinline__ void run_tiles(int n, LAS unsigned char* lds, int w, int lane, unsigned gsK, unsigned gsV, SrcK srcK, SrcV srcV, Comp comp) {
    DmaLane<RBK> LK; dma_setup<RBK>(LK, w, lane, gsK);
    DmaLane<128> LV; LV.g0 = 0; LV.g1 = 0; if (HASV) dma_setup<128>(LV, w, lane, gsV);
    const int nl = n - 1, t1 = nl < 1 ? nl : 1;
    dma_issue<RBK>(srcK(0), LK, lds + KOFF, w); if (HASV) dma_issue<128>(srcV(0), LV, lds + VOFF, w);
    dma_issue<RBK>(srcK(t1), LK, lds + KOFF + KSZ, w); if (HASV) dma_issue<128>(srcV(t1), LV, lds + VOFF + 8192, w);
    constexpr int P = (RBK == 128 ? 1 : 2) + (HASV ? 1 : 0);
#define RT_STEP(bi, ii) do { const int i_ = (ii); \
        if (P == 1) asm volatile("s_waitcnt vmcnt(1)" ::: "memory"); else if (P == 2) asm volatile("s_waitcnt vmcnt(2)" ::: "memory"); else asm volatile("s_waitcnt vmcnt(3)" ::: "memory"); \
        __builtin_amdgcn_s_barrier(); asm volatile("" ::: "memory"); \
        { const int tn = (i_ + 2 < nl) ? i_ + 2 : nl; constexpr int b2 = ((bi) + 2) % 3; \
          dma_issue<RBK>(srcK(tn), LK, lds + KOFF + b2 * KSZ, w); if (HASV) dma_issue<128>(srcV(tn), LV, lds + VOFF + b2 * 8192, w); } \
        if (i_ < n) comp(i_, lds + KOFF + (bi) * KSZ, lds + VOFF + (bi) * 8192); } while (0)
    for (int i = 0; i < n; i += 3) { RT_STEP(0, i); RT_STEP(1, i + 1); RT_STEP(2, i + 2); }
#undef RT_STEP
    asm volatile("s_waitcnt vmcnt(0)" ::: "memory");
    __syncthreads();
}

__device__ __forceinline__ void mla_unit(const Params& p, LAS unsigned char* lds, int b, int h, int qb) {
    int tid = threadIdx.x; asm volatile("" : "+v"(tid));
    const int lane = tid & 63, w = __builtin_amdgcn_readfirstlane(tid >> 6), r32 = lane & 31, hi = lane >> 5;
    const bf16_t* qm = (const bf16_t*)((const unsigned char*)p.out + O_QM);
    const unsigned char* km = (const unsigned char*)p.out + O_KM + (((size_t)b * 8 + h) * S) * 192;
    const unsigned char* vmt = (const unsigned char*)p.out + O_VMT + (((size_t)b * 8 + h) * 64) * (size_t)S * 2;
    bf16_t* ocat = (bf16_t*)(p.ws + R_XN);
    const int tq = qb * 256 + 32 * w + r32;
    bf16x8 qf[6];
#pragma unroll
    for (int s = 0; s < 6; ++s) qf[s] = *(const bf16x8*)(qm + (((size_t)b * S + tq) * 8 + h) * 96 + 16 * s + 8 * hi);
    const float kn = 9.797958971f * 1.01f * wmax(fmaxf(fabsf(p.in[14][lane]), lane < 32 ? fabsf(p.in[14][64 + lane]) : 0.f));
    const float mref = sqrtf(qnorm2<6>(qf)) * kn;
    f32x16 negm;
#pragma unroll
    for (int r = 0; r < 16; ++r) negm[r] = -mref;
    Flash st; flash_init(st);
    const int ntile = 4 * qb + 4, dt = 4 * qb + (w >> 1);
#ifdef PROF_SEL
    if (b == 0 && h == 0 && qb == 15 && threadIdx.x == 0) { *PROF_SLOT(36) -= __builtin_amdgcn_s_memtime(); *PROF_SLOT(37) -= __builtin_amdgcn_s_memrealtime(); }
#endif
    unsigned kl[6], vl[4]; frag_offsets<96>(kl, vl, r32, hi);
    run_tiles<192, true, AL_K96, 16384, AL_V96>(ntile, lds, w, lane, 192u, (unsigned)(S * 2),
        [&](int i) { return km + (size_t)i * 64 * 192; }, [&](int i) { return vmt + (size_t)i * 128; },
        [&](int i, LAS unsigned char* kb, LAS unsigned char* vb) {
            if (i <= dt) {
                if (i < dt) tile_compute<96, 256, false>(st, kb, vb, qf, negm, kl, vl, true, [&](int r, int half, float& x) { return true; });
                else { const int kb0 = 64 * i + 4 * hi; tile_compute<96, 256, false>(st, kb, vb, qf, negm, kl, vl, true, [&](int r, int half, float& x) { return (kb0 + 32 * half + (r & 3) + 8 * (r >> 2)) <= tq; }); }
            }
        });
#ifdef PROF_SEL
    if (b == 0 && h == 0 && qb == 15 && threadIdx.x == 0) { *PROF_SLOT(36) += __builtin_amdgcn_s_memtime(); *PROF_SLOT(37) += __builtin_amdgcn_s_memrealtime(); }
#endif
    {
        const float lt = st.l + __shfl_xor(st.l, 32); const float f = lt > 0.f ? frcp(lt) : 0.f;
#pragma unroll
        for (int r = 0; r < 16; ++r) { const float fr_ = __shfl(f, crow(r, hi)); const size_t ro = ((size_t)b * S + qb * 256 + 32 * w + crow(r, hi)) * 1024 + 512 + h * 64 + r32; ocat[ro] = f2bf(st.o0[r] * fr_); ocat[ro + 32] = f2bf(st.o1[r] * fr_); }
    }
}

__device__ __forceinline__ void nsa_unit(const Params& p, LAS unsigned char* lds, int b, int g, int jt) {
    int tid = threadIdx.x; asm volatile("" : "+v"(tid));
    const int lane = tid & 63, w = __builtin_amdgcn_readfirstlane(tid >> 6), r32 = lane & 31, hi = lane >> 5;
    const int rh = w >> 1, qh = w & 1, h = 4 * g + rh, q0 = 64 * jt, ql = 32 * qh + r32, tq = q0 + ql;
    const unsigned char* xa = p.ws + R_XA;
    const bf16_t* qn = (const bf16_t*)(xa + A_QN);
    const size_t bg = (size_t)b * 2 + g;
    const unsigned char* ksn = xa + A_KSN + bg * S * 128; const unsigned char* kwn = xa + A_KWN + bg * S * 128;
    const unsigned char* vst = xa + A_VST + bg * 64 * (size_t)S * 2; const unsigned char* vwt = xa + A_VWT + bg * 64 * (size_t)S * 2;
    const unsigned char* kc = p.ws + SM_KC + bg * 256 * 128; const unsigned char* vct = p.ws + SM_VCT + bg * 64 * 512;
    const float* gates = (const float*)(xa + A_GATES) + ((size_t)b * S + tq) * 24 + h * 3;
    bf16_t* ocat = (bf16_t*)(p.ws + R_XN);
    LAS float* imp = (LAS float*)(lds + AL_IMP); LAS unsigned char* selb = lds + AL_SELB; LAS unsigned* uni = (LAS unsigned*)(lds + AL_UNI); LAS unsigned char* tl = lds + AL_TL; LAS float* bls = (LAS float*)(lds + AL_BL);
    const float* blg = (const float*)(p.ws + SM_BL) + h * 132;
    const float cb = blg[128];
    const float bmax = wmax(fmaxf(fmaxf(blg[lane], blg[64 + lane]), cb));
    if (qh == 0) { bls[rh * 132 + lane] = blg[lane] - cb; bls[rh * 132 + 64 + lane] = blg[64 + lane] - cb; if (lane == 0) bls[rh * 132 + 128] = 0.f; }
    const LAS float* blh = bls + rh * 132;
    bf16x8 qf[4];
#pragma unroll
    for (int s = 0; s < 4; ++s) qf[s] = *(const bf16x8*)(qn + (((size_t)b * S + tq) * 8 + h) * 64 + 16 * s + 8 * hi);
    const float kn = 8.f * 1.01f * wmax(fmaxf(fmaxf(fabsf(p.in[5][lane]), fabsf(p.in[5][64 + lane])), fabsf(p.in[5][128 + lane])));
    const float mref = sqrtf(qnorm2<4>(qf)) * kn + bmax;
    f32x16 negm;
#pragma unroll
    for (int r = 0; r < 16; ++r) negm[r] = cb - mref;
    float g0 = gates[0], g1 = gates[1], g2 = gates[2];
    if (p.dbg_branch >= 0) { g0 = p.dbg_branch == 0 ? 1.f : 0.f; g1 = p.dbg_branch == 1 ? 1.f : 0.f; g2 = p.dbg_branch == 2 ? 1.f : 0.f; }
    LAS float* otl = (LAS float*)(lds + AL_OT) + w * 2048;
#ifdef PROF_SEL
    if (b == 0 && g == 0 && jt == 63 && threadIdx.x == 0) *PROF_SLOT(48) -= __builtin_amdgcn_s_memtime();
#endif
    const int nvmax = (q0 + 63 - 31) / 16 + 1, ntc = (nvmax + 63) / 64;
    Flash st; flash_init(st);
    unsigned kl[4], vl[4]; frag_offsets<64>(kl, vl, r32, hi);
    run_tiles<128, true, AL_K64, 8192, AL_V64>(ntc, lds, w, lane, 128u, 512u,
        [&](int i) { return kc + (size_t)i * 64 * 128; }, [&](int i) { return vct + (size_t)i * 128; },
        [&](int i, LAS unsigned char* kb, LAS unsigned char* vb) {
            const int cb0 = 64 * i + 4 * hi;
            if (q0 + 32 * qh - (16 * (64 * i + 63) + 31) >= 128) tile_compute<64, 128, false>(st, kb, vb, qf, negm, kl, vl, true, [&](int r, int half, float& x) { return true; });
            else tile_compute<64, 128, false>(st, kb, vb, qf, negm, kl, vl, true, [&](int r, int half, float& x) {
                const int c = cb0 + 32 * half + (r & 3) + 8 * (r >> 2); const int dist = tq - 16 * c - 31; x += blh[dist < 0 ? 0 : (dist > 128 ? 128 : dist)]; return dist >= 0; });
        });
    flash_accum<true>(otl, st, g0, hi, lane);
    unsigned mlo, mhi;
    int nsel;
    if (jt < 16) { const unsigned long long mk = (1ull << (jt + 1)) - 1ull; mlo = (unsigned)mk; mhi = (unsigned)(mk >> 32); nsel = jt + 1; if (tid <= jt) tl[tid] = (unsigned char)tid; }
    else {
        for (int i = tid; i < 64 * 65; i += 512) imp[i] = 0.f;
        const float lt = st.l + __shfl_xor(st.l, 32); const float linv = lt > 0.f ? frcp(lt) : 0.f;
        float xlast = 0.f;
        run_tiles<128, false, AL_K64, 8192, AL_V64>(ntc, lds, w, lane, 128u, 0u,
            [&](int i) { return kc + (size_t)i * 64 * 128; }, [&](int i) { return kc; },
            [&](int i, LAS unsigned char* kb, LAS unsigned char* vb) {
                f32x16 p0, p1; qk_tile<64, 128>(p0, p1, kb, qf, negm, kl);
                const int cb0 = 64 * i + 4 * hi;
                float sm[2][4], cr[2][4];
#pragma unroll
                for (int half = 0; half < 2; ++half)
#pragma unroll
                    for (int a = 0; a < 4; ++a) {
                        float s4 = 0.f, last = 0.f;
#pragma unroll
                        for (int k = 0; k < 4; ++k) {
                            const int r = 4 * a + k; const int c = cb0 + 32 * half + k + 8 * a; const int dist = tq - 16 * c - 31;
                            const float sc = (half ? p1[r] : p0[r]) + blh[dist < 0 ? 0 : (dist > 128 ? 128 : dist)];
                            const float pv = dist >= 0 ? fexp2(sc) * linv : 0.f;
                            s4 += pv; last = pv;
                        }
                        sm[half][a] = s4; cr[half][a] = last;
                    }
                float tot[2][4];
#pragma unroll
                for (int half = 0; half < 2; ++half)
#pragma unroll
                    for (int a = 0; a < 4; ++a) {
                        const float xs_ = __shfl_xor(cr[half][a], 32);
                        const float xp_ = (a > 0) ? __shfl_xor(cr[half][a > 0 ? a - 1 : 0], 32) : (half ? __shfl_xor(cr[0][3], 32) : xlast);
                        tot[half][a] = sm[half][a] + (hi ? xs_ : xp_);
                    }
                xlast = __shfl_xor(cr[1][3], 32);
                for (int rr = 0; rr < 4; ++rr) {
                    if (rh == rr) {
#pragma unroll
                        for (int half = 0; half < 2; ++half)
#pragma unroll
                            for (int a = 0; a < 4; ++a) { const int j = 16 * i + 8 * half + 2 * a + hi; imp[ql * 65 + j] += tot[half][a]; }
                    }
                    __syncthreads();
                }
            });
        if (p.dbg_branch == 1) { for (int i = tid; i < 4096; i += 512) ((float*)(p.ws + R_H))[((size_t)g * S + q0 + (i >> 6)) * 64 + (i & 63)] = imp[(i >> 6) * 65 + (i & 63)]; }
        {
            const int q = tid >> 3, jg = tid & 7;
            float vj[8]; int rk[8];
#pragma unroll
            for (int jj = 0; jj < 8; ++jj) { const int j = jg * 8 + jj; const float x = imp[q * 65 + j]; vj[jj] = (j > jt) ? -1.f : ((j == jt || j == 0) ? 1e9f : x); rk[jj] = 0; }
#pragma unroll 4
            for (int i = 0; i < 64; ++i) {
                const float xi = imp[q * 65 + i]; const float vi = (i > jt) ? -1.f : ((i == jt || i == 0) ? 1e9f : xi);
#pragma unroll
                for (int jj = 0; jj < 8; ++jj) rk[jj] += (vi > vj[jj] || (vi == vj[jj] && i < jg * 8 + jj)) ? 1 : 0;
            }
            unsigned byte = 0;
#pragma unroll
            for (int jj = 0; jj < 8; ++jj) if (jg * 8 + jj <= jt && rk[jj] < 16) byte |= 1u << jj;
            selb[q * 8 + jg] = (unsigned char)byte;
        }
        __syncthreads();
        if (w == 0) {
            unsigned a = ((const LAS unsigned*)selb)[lane * 2], c = ((const LAS unsigned*)selb)[lane * 2 + 1];
#pragma unroll
            for (int o = 1; o < 64; o <<= 1) { a |= __shfl_xor(a, o); c |= __shfl_xor(c, o); }
            const unsigned long long um = ((unsigned long long)c << 32) | a;
            if ((um >> lane) & 1ull) tl[__builtin_popcountll(um & ((1ull << lane) - 1ull))] = (unsigned char)lane;
            if (lane == 0) uni[0] = (unsigned)__builtin_popcountll(um);
        }
        __syncthreads();
        mlo = ((const LAS unsigned*)selb)[ql * 2]; mhi = ((const LAS unsigned*)selb)[ql * 2 + 1];
        nsel = (int)uni[0];
    }
    if (p.dbg_branch == 1 && rh == 0) { if (hi == 0) ((unsigned long long*)(p.ws + R_H + 4 * 1048576))[(size_t)g * S + tq] = ((unsigned long long)mhi << 32) | mlo; }
    __syncthreads();
    {
        const unsigned long long mymask = ((unsigned long long)mhi << 32) | mlo;
        nsel = __builtin_amdgcn_readfirstlane(nsel);
        const int mytl = (int)tl[lane];
        flash_init(st);
        run_tiles<128, true, AL_K64, 8192, AL_V64>(nsel, lds, w, lane, 128u, (unsigned)(S * 2),
            [&](int i) { return ksn + (size_t)__builtin_amdgcn_readlane(mytl, i) * 64 * 128; }, [&](int i) { return vst + (size_t)__builtin_amdgcn_readlane(mytl, i) * 128; },
            [&](int i, LAS unsigned char* kb, LAS unsigned char* vb) {
                const int j = __builtin_amdgcn_readlane(mytl, i);
                const bool mine = (mymask >> j) & 1ull;
                if (q0 + 32 * qh - (64 * j + 63) >= 128) tile_compute<64, 128, true>(st, kb, vb, qf, negm, kl, vl, mine, [&](int r, int half, float& x) { return true; });
                else { const int kb0 = 64 * j + 4 * hi;
                    tile_compute<64, 128, true>(st, kb, vb, qf, negm, kl, vl, mine, [&](int r, int half, float& x) { const int dist = tq - (kb0 + 32 * half + (r & 3) + 8 * (r >> 2)); x += blh[dist < 0 ? 0 : (dist > 128 ? 128 : dist)]; return dist >= 0; }); }
            });
        flash_accum<false>(otl, st, g1, hi, lane);
    }
    {
        const int j0 = jt >= 8 ? jt - 8 : 0, nw = jt - j0 + 1;
        flash_init(st);
        run_tiles<128, true, AL_K64, 8192, AL_V64>(nw, lds, w, lane, 128u, (unsigned)(S * 2),
            [&](int i) { return kwn + (size_t)(j0 + i) * 64 * 128; }, [&](int i) { return vwt + (size_t)(j0 + i) * 128; },
            [&](int i, LAS unsigned char* kb, LAS unsigned char* vb) {
                const int j = j0 + i, kb0 = 64 * j + 4 * hi;
                if (q0 + 32 * qh - (64 * j + 63) >= 128 && q0 + 32 * qh + 31 - 64 * j < 512) tile_compute<64, 128, false>(st, kb, vb, qf, negm, kl, vl, true, [&](int r, int half, float& x) { return true; });
                else tile_compute<64, 128, false>(st, kb, vb, qf, negm, kl, vl, true, [&](int r, int half, float& x) { const int dist = tq - (kb0 + 32 * half + (r & 3) + 8 * (r >> 2)); x += blh[dist < 0 ? 0 : (dist > 128 ? 128 : dist)]; return dist >= 0 && dist < 512; });
            });
        flash_accum<false>(otl, st, g2, hi, lane);
    }
#pragma unroll
    for (int r = 0; r < 16; ++r) { const size_t ro = ((size_t)b * S + q0 + 32 * qh + crow(r, hi)) * 1024 + h * 64 + r32; ocat[ro] = f2bf(otl[r * 64 + lane]); ocat[ro + 32] = f2bf(otl[(16 + r) * 64 + lane]); }
    __syncthreads();
#ifdef PROF_SEL
    if (b == 0 && g == 0 && jt == 63 && threadIdx.x == 0) *PROF_SLOT(48) += __builtin_amdgcn_s_memtime();
#endif
}

__device__ __forceinline__ void phase_p4(const Params& p, LAS unsigned char* lds) {
    const int G = gridDim.x, c = blockIdx.x, nunits = 256 * NB;
#if NB == 8
    if (G == 256) {
        const int b = c & 7, idx = c >> 3, pi = idx & 7, hq = idx >> 3;
#pragma unroll 1
        for (int u = 0; u < 8; ++u) {
            if (u < 4) { const int ix = (u >> 1) ? ((idx + 16) & 31) : idx;
                nsa_unit(p, lds, b, u >> 1, (u & 1) ? ix : 63 - ix); }
            else mla_unit(p, lds, b, ((u - 4) >> 1) * 4 + hq, (u & 1) ? pi : 15 - pi);
        }
        return;
    }
#endif
    for (int j = 0;; ++j) {
        const int k = j * G + ((j & 1) ? (G - 1 - c) : c);
        if (j * G >= nunits) break;
        if (k >= nunits) continue;
        const int ty = UNIT_TYPES[k / NB], b = k % NB, kind = ty >> 9, a = (ty >> 6) & 7, cc = ty & 63;
        if (kind == 0) nsa_unit(p, lds, b, a, cc); else mla_unit(p, lds, b, a, cc);
    }
}
__device__ __forceinline__ void phase_norm(const float* x, const float* g, bf16_t* xn) {
    const int tid_ = ltid(); const int lane = tid_ & 63, gw = blockIdx.x * 8 + (tid_ >> 6), NGW = gridDim.x * 8;
    for (int m = gw; m < T; m += NGW) rms_row_to_bf16(x + (size_t)m * D, g, xn + (size_t)m * D, lane);
}
__device__ __forceinline__ void phase_conv(const Params& p) {
    const int tid = ltid(), lane = tid & 63, gw = blockIdx.x * 8 + (tid >> 6), NGW = gridDim.x * 8;
    const bf16_t* bg = (const bf16_t*)(p.ws + R_H); const bf16_t* cu = (const bf16_t*)(p.ws + R_H + (size_t)T * 2048); bf16_t* v = (bf16_t*)(p.ws + R_XA); const float* cw = p.in[22];
    constexpr int RUN = 16;
    float w0[2][8], w1[2][8], w2[2][8];
#pragma unroll
    for (int j = 0; j < 2; ++j) { const int d = 8 * lane + 512 * j; load8f(cw + d, w0[j], 1.f); load8f(cw + 1024 + d, w1[j], 1.f); load8f(cw + 2048 + d, w2[j], 1.f); }
    for (int run = gw; run < T / RUN; run += NGW) {
        const int m0 = run * RUN, s0 = m0 & (S - 1);
        float pm2[2][8], pm1[2][8];
#pragma unroll
        for (int j = 0; j < 2; ++j) { const int d = 8 * lane + 512 * j;
#pragma unroll
            for (int q = 0; q < 2; ++q) {
                float (&dst)[8] = q ? pm1[j] : pm2[j];
                if (s0 - 2 + q >= 0) unpack8(*(const u32x4*)(cu + (size_t)(m0 - 2 + q) * 1024 + d), dst);
                else {
#pragma unroll
                    for (int i = 0; i < 8; ++i) dst[i] = 0.f; }
            } }
#pragma unroll 4
        for (int rr = 0; rr < RUN; ++rr) {
            const int m = m0 + rr;
#pragma unroll
            for (int j = 0; j < 2; ++j) { const int d = 8 * lane + 512 * j;
                float b[8], c[8], y[8]; unpack8(*(const u32x4*)(bg + (size_t)m * 1024 + d), b); unpack8(*(const u32x4*)(cu + (size_t)m * 1024 + d), c);
#pragma unroll
                for (int i = 0; i < 8; ++i) { y[i] = b[i] * (w0[j][i] * pm2[j][i] + w1[j][i] * pm1[j][i] + w2[j][i] * c[i]); pm2[j][i] = pm1[j][i]; pm1[j][i] = c[i]; }
                *(u32x4*)(v + (size_t)m * 1024 + d) = pack8(y); }
        }
    }
}
__device__ __forceinline__ void phase_norm_router(const Params& p, LAS unsigned char* lds) {
    const int tid = ltid(), lane = tid & 63, wave = tid >> 6, gw = blockIdx.x * 8 + wave, NGW = gridDim.x * 8;
    const bf16_t* x3 = (const bf16_t*)(p.ws + R_XN); const float* g = p.in[24]; bf16_t* xn = (bf16_t*)(p.ws + R_XA);
    LAS float* wr = (LAS float*)lds;
    LAS int* lcnt = (LAS int*)(lds + 40960); LAS int* gb = lcnt + 8;
    int* te = (int*)(p.ws + SM_TE); float* tw = (float*)(p.ws + SM_TW); int* rank = (int*)(p.ws + SM_RANK); int* cnt = (int*)(p.ws + SM_CTL);
    for (int i = tid; i < 8192; i += 512) { const int dd = i >> 3; wr[dd * 8 + (dd >> 2) * 4 + (i & 7)] = p.in[25][i]; }
    if (tid < 8) lcnt[tid] = 0;
    __syncthreads();
    u32x2 nx[4];
#pragma unroll
    for (int j = 0; j < 4; ++j) nx[j] = ((const u32x2*)(x3 + (size_t)(gw < T ? gw : 0) * D) + lane)[64 * j];
    for (int m = gw; m < T; m += NGW) {
        const f32x4* gr = (const f32x4*)g + lane;
        f32x4 v[4]; float s = 0.f;
#pragma unroll
        for (int j = 0; j < 4; ++j) { const u32x2 t = nx[j]; v[j] = (f32x4){bflo(t.x), bfhi(t.x), bflo(t.y), bfhi(t.y)}; s += (v[j].x * v[j].x + v[j].y * v[j].y) + (v[j].z * v[j].z + v[j].w * v[j].w); }
        { const int mn = m + NGW < T ? m + NGW : m;
#pragma unroll
            for (int j = 0; j < 4; ++j) nx[j] = ((const u32x2*)(x3 + (size_t)mn * D) + lane)[64 * j]; }
        const float r = rsqrtf(wsum(s) * (1.f / 1024.f) + EPS);
        float lg[8];
#pragma unroll
        for (int e = 0; e < 8; ++e) lg[e] = 0.f;
        u32x2* o8 = (u32x2*)(xn + (size_t)m * D) + lane;
#pragma unroll
        for (int j = 0; j < 4; ++j) { const f32x4 gg = gr[64 * j]; const f32x4 y = {v[j].x * r * gg.x, v[j].y * r * gg.y, v[j].z * r * gg.z, v[j].w * r * gg.w};
            u32x2 w; w.x = cvtpk(y.x, y.y); w.y = cvtpk(y.z, y.w); o8[64 * j] = w;
#pragma unroll
            for (int i = 0; i < 4; ++i) { const int d = 4 * lane + 256 * j + i; const f32x4 w0 = *(const LAS f32x4*)(wr + d * 8 + (d >> 2) * 4), w1 = *(const LAS f32x4*)(wr + d * 8 + (d >> 2) * 4 + 4);
                lg[0] += y[i] * w0.x; lg[1] += y[i] * w0.y; lg[2] += y[i] * w0.z; lg[3] += y[i] * w0.w; lg[4] += y[i] * w1.x; lg[5] += y[i] * w1.y; lg[6] += y[i] * w1.z; lg[7] += y[i] * w1.w; } }
#pragma unroll
        for (int e = 0; e < 8; ++e) lg[e] = wsum(lg[e]) + p.in[26][e];
        int e1 = 0; float l1 = lg[0];
#pragma unroll
        for (int e = 1; e < 8; ++e) if (lg[e] > l1) { l1 = lg[e]; e1 = e; }
        int e2 = -1; float l2 = -3e38f;
#pragma unroll
        for (int e = 0; e < 8; ++e) if (e != e1 && lg[e] > l2) { l2 = lg[e]; e2 = e; }
        if (lane == 0) {
            const float w1 = 1.f / (1.f + __expf(l2 - l1));
            te[m * 2] = e1; te[m * 2 + 1] = e2; tw[m * 2] = w1; tw[m * 2 + 1] = 1.f - w1;
            rank[m * 2] = __hip_atomic_fetch_add(&lcnt[e1], 1, __ATOMIC_RELAXED, __HIP_MEMORY_SCOPE_WORKGROUP); rank[m * 2 + 1] = __hip_atomic_fetch_add(&lcnt[e2], 1, __ATOMIC_RELAXED, __HIP_MEMORY_SCOPE_WORKGROUP);
        }
    }
    __syncthreads();
    if (tid < 8) gb[tid] = atomicAdd(&cnt[tid], lcnt[tid]);
    __syncthreads();
    for (int m = gw; m < T; m += NGW) if (lane < 2) rank[m * 2 + lane] += gb[te[m * 2 + lane]];
}
__device__ __forceinline__ void phase_moe_gather(const Params& p) {
    const int tid = ltid(), lane = tid & 63, gw = blockIdx.x * 8 + (tid >> 6), NGW = gridDim.x * 8;
    const int* cnt = (const int*)(p.ws + SM_CTL); const int* te = (const int*)(p.ws + SM_TE); const float* tw = (const float*)(p.ws + SM_TW); const int* rank = (const int*)(p.ws + SM_RANK);
    int* pos = (int*)(p.ws + SM_POS); float* roww = (float*)(p.ws + SM_ROWW); int* tile_e = (int*)(p.ws + SM_TILEE);
    int* rowtok = (int*)(p.ws + SM_ROWTOK);
    int off[9]; off[0] = 0;
#pragma unroll
    for (int e = 0; e < 8; ++e) off[e + 1] = off[e] + ((cnt[e] + 255) & ~255);
    if (blockIdx.x == 0) {
        for (int i = tid; i < ROWS_MAX / 256; i += 512) { int e = -1;
#pragma unroll
            for (int k = 0; k < 8; ++k) if (i * 256 >= off[k] && i * 256 < off[k + 1]) e = k;
            tile_e[i] = e < 0 ? 0 : e; }
        if (tid == 0) ((int*)(p.ws + SM_CTL))[8] = off[8];
    }
    if (blockIdx.x < 8 && tid < 256) {
#pragma unroll
        for (int e = 0; e < 8; ++e) if (e == (int)blockIdx.x) { const int c = cnt[e]; if (c + tid < off[e + 1] - off[e]) { roww[off[e] + c + tid] = 0.f; rowtok[off[e] + c + tid] = -1; } }
    }
    for (int pi0 = gw * 4; pi0 < 2 * T; pi0 += NGW * 4) {
        int r[4]; float w[4];
#pragma unroll
        for (int q = 0; q < 4; ++q) { const int e = te[pi0 + q]; int o = 0;
#pragma unroll
            for (int k = 0; k < 8; ++k) if (k == e) o = off[k];
            r[q] = o + rank[pi0 + q]; w[q] = tw[pi0 + q]; }
#pragma unroll
        for (int q = 0; q < 4; ++q) if (lane == q) { pos[pi0 + q] = r[q]; roww[r[q]] = w[q]; rowtok[r[q]] = (pi0 + q) >> 1; }
    }
}
__device__ __forceinline__ void phase_moe_combine(const Params& p) {
    const int tid_ = ltid(); const int lane = tid_ & 63, gw = blockIdx.x * 8 + (tid_ >> 6), NGW = gridDim.x * 8;
    const int* pos = (const int*)(p.ws + SM_POS); const bf16_t* ym = (const bf16_t*)(p.ws + R_XA); const bf16_t* x3 = (const bf16_t*)(p.ws + R_XN);
    for (int m0 = gw * 2; m0 < T; m0 += NGW * 2) {
        int ps[4];
#pragma unroll
        for (int q = 0; q < 4; ++q) ps[q] = pos[m0 * 2 + q];
        f32x4 x[2][4]; u32x2 ya[2][4], yc[2][4];
#pragma unroll
        for (int q = 0; q < 2; ++q)
#pragma unroll
            for (int j = 0; j < 4; ++j) { const int d = 4 * lane + 256 * j;
                { const u32x2 t = *(const u32x2*)(x3 + (size_t)(m0 + q) * D + d); x[q][j] = (f32x4){bflo(t.x), bfhi(t.x), bflo(t.y), bfhi(t.y)}; } ya[q][j] = *(const u32x2*)(ym + (size_t)ps[2 * q] * D + d); yc[q][j] = *(const u32x2*)(ym + (size_t)ps[2 * q + 1] * D + d); }
#pragma unroll
        for (int q = 0; q < 2; ++q)
#pragma unroll
            for (int j = 0; j < 4; ++j) { const int d = 4 * lane + 256 * j; f32x4 o = x[q][j]; const u32x2 a = ya[q][j], c = yc[q][j];
                o.x += bflo(a.x) + bflo(c.x); o.y += bfhi(a.x) + bfhi(c.x); o.z += bflo(a.y) + bflo(c.y); o.w += bfhi(a.y) + bfhi(c.y);
                *(f32x4*)(p.out + (size_t)(m0 + q) * D + d) = o; }
    }
}

#define XB_TMO      128
#define XB_XCNT(j)  (256  + 64 * (j))
#define XB_XSUB(j)  (1280 + 64 * (j))
#define XB_XGEN(j)  (2304 + 64 * (j))
#define XB_TOP      3328
#define XB_TOPGEN   3392
#define XCD_BAR_WORDS 3456
#define XB_SPIN_CAP (1u << 18)

__device__ __forceinline__ unsigned xb_ld(unsigned* p)              { return __hip_atomic_load(p, __ATOMIC_RELAXED, __HIP_MEMORY_SCOPE_AGENT); }
__device__ __forceinline__ unsigned xb_add(unsigned* p, unsigned v) { return __hip_atomic_fetch_add(p, v, __ATOMIC_RELAXED, __HIP_MEMORY_SCOPE_AGENT); }
__device__ __forceinline__ unsigned xb_xcc_id() { return (unsigned)__builtin_amdgcn_s_getreg((3 << 11) | 20) & 0xFu; }
#define XB_SPIN(cond, bar) do { unsigned _sp = 0; while (cond) { __builtin_amdgcn_s_sleep(1); \
    if ((++_sp & 255u) == 0u) { if (xb_ld(&(bar)[XB_TMO])) break; if (_sp > XB_SPIN_CAP) { atomicAdd(&(bar)[XB_TMO], 1u); break; } } } } while (0)

struct XcdBarrier {
    unsigned* bar; unsigned x;
    volatile LAS unsigned* st;
};

__device__ __forceinline__ XcdBarrier xcd_barrier_post(unsigned* bar, volatile LAS unsigned* st) {
    XcdBarrier b; b.bar = bar; b.x = xb_xcc_id(); b.st = st;
    if (threadIdx.x == 0) (void)xb_add(&bar[XB_XCNT(b.x)], 1u);
    return b;
}
__device__ __forceinline__ void xcd_barrier_complete(unsigned* bar, unsigned x, unsigned& nloc, unsigned& nx) {
    const unsigned G = gridDim.x * gridDim.y * gridDim.z;
    unsigned sum, cnt, mine, sp = 0u;
    for (;;) {
        sum = 0u; cnt = 0u; mine = 0u;
#pragma unroll
        for (unsigned j = 0; j < 16; ++j) { const unsigned c = xb_ld(&bar[XB_XCNT(j)]); sum += c; cnt += (c > 0u) ? 1u : 0u; mine = (j == x) ? c : mine; }
        if (sum == G) break;
        __builtin_amdgcn_s_sleep(1);
        if ((++sp & 255u) == 0u) { if (xb_ld(&bar[XB_TMO])) break; if (sp > XB_SPIN_CAP) { atomicAdd(&bar[XB_TMO], 1u); break; } }
    }
    nloc = mine > 0u ? mine : 1u; nx = cnt > 0u ? cnt : 1u;
}

__device__ __forceinline__ void xcd_barrier(const XcdBarrier& b) {
    asm volatile("s_waitcnt vmcnt(0)" ::: "memory");
    __syncthreads();
    if (threadIdx.x == 0) {
        unsigned* bar = b.bar;
        __builtin_amdgcn_s_waitcnt(0);
        unsigned nloc = b.st[0], nx = b.st[1];
        if (nloc == 0u) { xcd_barrier_complete(bar, b.x, nloc, nx); b.st[0] = nloc; b.st[1] = nx; }
        const unsigned old = xb_add(&bar[XB_XSUB(b.x)], 1u);
        const unsigned gen = old / nloc;
        if (old + 1u == (gen + 1u) * nloc) {
            __builtin_amdgcn_fence(__ATOMIC_RELEASE, "agent");
            asm volatile("s_waitcnt vmcnt(0)" ::: "memory");
            const unsigned og = xb_add(&bar[XB_TOP], 1u);
            const unsigned tg = og / nx;
            if (og + 1u == (tg + 1u) * nx) xb_add(&bar[XB_TOPGEN], 1u);
            else XB_SPIN(xb_ld(&bar[XB_TOPGEN]) == tg, bar);
            __builtin_amdgcn_fence(__ATOMIC_ACQUIRE, "agent");
            xb_add(&bar[XB_XGEN(b.x)], 1u);
            asm volatile("s_waitcnt vmcnt(0)" ::: "memory");
        } else {
            XB_SPIN(xb_ld(&bar[XB_XGEN(b.x)]) == gen, bar);
            __builtin_amdgcn_fence(__ATOMIC_ACQUIRE, "agent");
            asm volatile("s_waitcnt vmcnt(0)" ::: "memory");
        }
    }
    __syncthreads();
}


__global__ void __launch_bounds__(512) mega_fwd(Params p) {
    extern __shared__ __attribute__((aligned(16))) unsigned char lds_raw[];
    LAS unsigned char* lds = (LAS unsigned char*)lds_raw;
    cg::grid_group grid = cg::this_grid();
    volatile LAS unsigned* bst = (volatile LAS unsigned*)(lds + 140032);
    if (threadIdx.x == 0) { bst[0] = 0u; bst[1] = 0u; const unsigned long long ba = (unsigned long long)(p.ws + SM_BAR); bst[2] = (unsigned)ba; bst[3] = (unsigned)(ba >> 32); }
    __syncthreads();
    (void)xcd_barrier_post((unsigned*)(p.ws + SM_BAR), bst);
#ifdef PROF_SEL
#define PSTAMP(k) do { if (blockIdx.x == 0 && threadIdx.x == 0) { volatile LAS unsigned* pl_ = (volatile LAS unsigned*)(lds + 140032 + 16); const unsigned long long now_ = __builtin_amdgcn_s_memrealtime(); const unsigned long long last_ = ((unsigned long long)pl_[1] << 32) | pl_[0]; *PROF_SLOT(k) += now_ - last_; pl_[0] = (unsigned)now_; pl_[1] = (unsigned)(now_ >> 32); } } while (0)
#else
#define PSTAMP(k)
#endif
#define GSYNC() do { XcdBarrier xb_; volatile LAS unsigned* st_ = (volatile LAS unsigned*)(lds + 140032); xb_.bar = (unsigned*)(((unsigned long long)st_[3] << 32) | st_[2]); xb_.x = xb_xcc_id(); xb_.st = st_; xcd_barrier(xb_); } while (0)
#ifdef PROF_SEL
    if (threadIdx.x == 0) { volatile LAS unsigned* pl_ = (volatile LAS unsigned*)(lds + 140032 + 16); const unsigned long long now_ = __builtin_amdgcn_s_memrealtime(); pl_[0] = (unsigned)now_; pl_[1] = (unsigned)(now_ >> 32); }
#endif
    const int G = gridDim.x, c = blockIdx.x;
#define LP() bf16_t* W = (bf16_t*)p.ws; bf16_t* xn = (bf16_t*)(p.ws + R_XN); float* x1 = (float*)(p.ws + R_XA); pg8::StaticOrder SO; (void)W; (void)xn; (void)x1; (void)SO
#ifndef PHMASK
#define PHMASK 0xFFFFFFFFu
#endif
#ifndef REPEAT_MASK
#define REPEAT_MASK 0u
#endif
#define PH(k) if (((PHMASK >> (k)) & 1u) && (k) >= p.ph_lo && (k) <= p.ph_hi)
#define RPT(k) if ((REPEAT_MASK >> (k)) & 1u)
    PH(0) { LP(); phase_p0(p, lds); }
    GSYNC(); PSTAMP(0);
    if (p.ph_lo == -12345) grid.sync();
    RPT(0) { { LP(); phase_p0(p, lds); } GSYNC(); }
    PH(1) { LP();
        pg8::Gemm g{xn, W + W_IN_E / 2, T, 1792, 1024, 1024, nullptr, 0, nullptr}; SO.init(T, 1792, G, c);
        pg8::EpiBf16<0> E{(bf16_t*)(p.ws + R_H), 1792, nullptr, nullptr};
        pg8::gemm_phase<pg8::EpiBf16<0>, true>(lds, g, SO, E);
    }
    GSYNC(); PSTAMP(1);
    PH(2) { LP(); phase_p2(p, lds); }
    GSYNC(); PSTAMP(2);
    RPT(2) { { LP(); phase_p2(p, lds); } GSYNC(); }
    PH(3) { LP();
        const int nCu = 2 * (NB * 512 / 256) * 2, Gc = (nCu < G / 2) ? nCu : 0;
        if (Gc == 0 || c < Gc) {
            for (int kv = 0; kv < 2; ++kv) {
                pg8::Gemm g{(const bf16_t*)(p.ws + R_XA + (kv ? A_VCIN : A_KCIN)), W + W_CW1 / 2 + (size_t)kv * 512 * 1024, NB * 512, 512, 1024, 1024, nullptr, 0, nullptr};
                if (Gc) SO.init(NB * 512, 512, Gc / 2, c - kv * (Gc / 2)); else SO.init(NB * 512, 512, G, c);
                pg8::EpiBf16<0> E{(bf16_t*)(p.ws + SM_HID) + (size_t)kv * NB * 512 * 512, 512, nullptr, nullptr};
                if (Gc == 0 || (c / (Gc / 2)) == kv) pg8::gemm_phase<pg8::EpiBf16<0>, true>(lds, g, SO, E);
            }
        }
        if (Gc == 0 || c >= Gc) {
            {
                pg8::Gemm g{(const bf16_t*)(p.ws + R_XA + A_CQN), W + W_UQ / 2, T, 1024, 256, 256, nullptr, 0, nullptr}; SO.init(T, 1024, G - Gc, c - Gc);
                pg8::EpiBf16<0> E{(bf16_t*)(p.ws + R_H), 1024, nullptr, nullptr};
                pg8::gemm_phase<pg8::EpiBf16<0>, true>(lds, g, SO, E);
            }
            {
                pg8::Gemm g{(const bf16_t*)(p.ws + R_XA + A_CKVN), W + W_UKV / 2, T, 1024, 128, 128, nullptr, 0, nullptr}; SO.init(T, 1024, G - Gc, c - Gc);
                pg8::EpiBf16<0> E{(bf16_t*)(p.ws + R_H + (size_t)T * 2048), 1024, nullptr, nullptr};
                pg8::gemm_phase<pg8::EpiBf16<0>, true>(lds, g, SO, E);
            }
        }
    }
    GSYNC(); PSTAMP(3);
    PH(4) { LP(); phase_p3b(p, lds); }
    GSYNC(); PSTAMP(4);
    RPT(4) { { LP(); phase_p3b(p, lds); } GSYNC(); }
    PH(5) { LP(); phase_p4(p, lds); }
    GSYNC(); PSTAMP(5);
    RPT(5) { { LP(); phase_p4(p, lds); } GSYNC(); }
    PH(6) { LP();
        pg8::Gemm g{xn, W + W_OUT_E / 2, T, 1024, 1024, 1024, nullptr, 0, nullptr}; SO.init(T, 1024, G, c);
        pg8::EpiResStat<false> E{p.in[0], (bf16_t*)p.out, (float*)(p.ws + SM_SSP1), 1024};
        pg8::gemm_phase<pg8::EpiResStat<false>, true>(lds, g, SO, E);
    }
    GSYNC(); PSTAMP(6);
    PH(7) { }
    PH(8) { LP();
        pg8::Gemm g{(const bf16_t*)p.out, W + W_GU / 2, T, 5632, 1024, 1024, nullptr, 0, nullptr}; SO.init(T, 5632, G, c);
        pg8::EpiSwiGLU E{(bf16_t*)(p.ws + R_H), 2816, (const float*)(p.ws + SM_SSP1)};
        pg8::gemm_phase<pg8::EpiSwiGLU, true>(lds, g, SO, E);
    }
    GSYNC(); PSTAMP(8);
    PH(9) { LP();
        pg8::Gemm g{(const bf16_t*)(p.ws + R_H), W + W_D / 2, T, 1024, 2816, 2816, nullptr, 0, nullptr}; SO.init(T, 1024, G, c);
        pg8::EpiResStat<true> E{(const bf16_t*)p.out, xn, (float*)(p.ws + SM_SSP2), 1024};
        pg8::gemm_phase<pg8::EpiResStat<true>, true>(lds, g, SO, E);
    }
    GSYNC(); PSTAMP(9);
    PH(10) { }
    PH(11) { LP();
        pg8::Gemm g{xn, W + W_IN_O / 2, T, 3072, 1024, 1024, nullptr, 0, nullptr}; SO.init(T, 3072, G, c);
        pg8::EpiConvIn E{(bf16_t*)(p.ws + R_H), (bf16_t*)(p.ws + R_H + (size_t)T * 2048), (const float*)(p.ws + SM_SSP2)};
        pg8::gemm_phase<pg8::EpiConvIn, true>(lds, g, SO, E);
    }
    GSYNC(); PSTAMP(11);
    PH(12) { LP(); phase_conv(p); }
    GSYNC(); PSTAMP(12);
    RPT(12) { { LP(); phase_conv(p); } GSYNC(); }
    PH(13) { LP();
        pg8::Gemm g{(const bf16_t*)x1, W + W_OUT_O / 2, T, 1024, 1024, 1024, nullptr, 0, nullptr}; SO.init(T, 1024, G, c);
        pg8::EpiResBf16B E{xn, xn, 1024};
        pg8::gemm_phase<pg8::EpiResBf16B, true>(lds, g, SO, E);
    }
    GSYNC(); PSTAMP(13);
    PH(14) { LP(); phase_norm_router(p, lds); }
    GSYNC(); PSTAMP(14);
    PH(15) { LP(); phase_moe_gather(p); }
    GSYNC(); PSTAMP(15);
    PH(16) { LP(); const int mrows = ((const int*)(p.ws + SM_CTL))[8];
        pg8::Gemm g{(const bf16_t*)x1, W + W_MGU / 2, mrows, 2816, 1024, 1024, (const int*)(p.ws + SM_TILEE), (size_t)2816 * 1024, (const int*)(p.ws + SM_ROWTOK)}; SO.init(mrows, 2816, G, c);
        pg8::EpiSwiGLU E{(bf16_t*)(p.ws + R_H), 1408, nullptr};
        pg8::gemm_phase<pg8::EpiSwiGLU, true, true>(lds, g, SO, E);
    }
    GSYNC(); PSTAMP(16);
    PH(17) { LP(); const int mrows = ((const int*)(p.ws + SM_CTL))[8];
        pg8::Gemm g{(const bf16_t*)(p.ws + R_H), W + W_MD / 2, mrows, 1024, 1408, 1408, (const int*)(p.ws + SM_TILEE), (size_t)1024 * 1408, nullptr}; SO.init(mrows, 1024, G, c);
        pg8::EpiRowScaleBf16 E{(bf16_t*)(p.ws + R_XA), 1024, (const float*)(p.ws + SM_ROWW)};
        pg8::gemm_phase<pg8::EpiRowScaleBf16, true>(lds, g, SO, E);
    }
    GSYNC(); PSTAMP(17);
    PH(18) { LP(); phase_moe_combine(p); }
#ifdef PROF_SEL
    GSYNC(); PSTAMP(18);
    GSYNC();
    {
        unsigned long long v_ = *PROF_SLOT(PROF_SEL);
#ifdef PROF_DIV
        const unsigned long long dv_ = *PROF_SLOT(PROF_DIV); v_ = dv_ ? v_ / dv_ : 0ull;
#endif
        unsigned long long a_ = v_ / (unsigned long long)(PROF_UNIT); if (a_ > 27ull) a_ = 27ull;
        const float sc_ = 1.f + (float)a_;
        for (size_t i = (size_t)blockIdx.x * 512 + threadIdx.x; i < (size_t)S * 1024 / 4; i += (size_t)gridDim.x * 512) { f32x4* o = (f32x4*)p.out + i; *o = *o * sc_; }
    }
#endif
#undef PH
}

inline void launch(void* const* d_in, float* d_out, void* d_ws, size_t ws_size, hipStream_t stream, int ph_lo = 0, int ph_hi = 99, int dbg_branch = -1) {
    static int grid = 0;
    if (grid == 0) {
        int dev = 0, cus = 0, per_cu = 0;
        hipGetDevice(&dev); hipDeviceGetAttribute(&cus, hipDeviceAttributeMultiprocessorCount, dev);
        hipFuncSetAttribute((const void*)mega_fwd, hipFuncAttributeMaxDynamicSharedMemorySize, LDS_BYTES);
        hipOccupancyMaxActiveBlocksPerMultiprocessor(&per_cu, (const void*)mega_fwd, 512, LDS_BYTES);
        if (per_cu < 1) { fprintf(stderr, "occupancy query says %d blocks/CU\n", per_cu); per_cu = 1; }
        grid = cus;
        if (WS_FAST_END > ws_size) { fprintf(stderr, "ws too small: need %zu have %zu\n", (size_t)WS_FAST_END, ws_size); grid = -1; }
    }
    if (grid < 0) return;
    if (ph_lo <= 14 && ph_hi >= 14) hipMemsetAsync((char*)d_ws + SM_CTL, 0, 4096, stream);
    hipMemsetAsync((char*)d_ws + SM_BAR, 0, 16384, stream);
    Params p{};
    for (int i = 0; i < 30; ++i) p.in[i] = (const float*)d_in[i];
    p.out = d_out; p.ws = (unsigned char*)d_ws; p.ph_lo = ph_lo; p.ph_hi = ph_hi; p.dbg_branch = dbg_branch;
    void* args[] = {&p};
    hipError_t e = hipLaunchCooperativeKernel((const void*)mega_fwd, dim3(grid), dim3(512), args, LDS_BYTES, stream);
    if (e != hipSuccess) fprintf(stderr, "cooperative launch failed: %s (grid %d)\n", hipGetErrorString(e), grid);
}
}
extern "C" void kernel_launch(void* const* d_in, const int* in_sizes, int n_in, void* d_out, int out_size, void* d_ws, size_t ws_size, hipStream_t stream) {
    fast::launch(d_in, (float*)d_out, d_ws, ws_size, stream);
}
```

```cpp
#include <hip/hip_runtime.h>
#include <hip/hip_bf16.h>
#include <stdint.h>
#include <stdio.h>
#include <string.h>
#include <hip/hip_cooperative_groups.h>
namespace cg = cooperative_groups;
#define NB 8
#define REPEAT_MASK 0x0u
namespace gold {
constexpr int S = 4096, D = 1024, HW = 1720;
constexpr float EPS = 1e-6f;

__device__ const unsigned char T5B[128] = {0, 1, 2, 3, 4, 5, 6, 7, 8, 9, 10, 11, 12, 13, 14, 15, 16, 16, 16, 17, 17, 18, 18, 18, 19, 19, 19, 20, 20, 20, 20, 21, 21, 21, 21, 22, 22, 22, 22, 22, 23, 23, 23, 23, 23, 23, 24, 24, 24, 24, 24, 24, 25, 25, 25, 25, 25, 25, 25, 26, 26, 26, 26, 26, 26, 26, 26, 27, 27, 27, 27, 27, 27, 27, 27, 27, 27, 28, 28, 28, 28, 28, 28, 28, 28, 28, 28, 29, 29, 29, 29, 29, 29, 29, 29, 29, 29, 29, 29, 30, 30, 30, 30, 30, 30, 30, 30, 30, 30, 30, 30, 30, 30, 31, 31, 31, 31, 31, 31, 31, 31, 31, 31, 31, 31, 31, 31};
}
#ifndef NB
#define NB 8
#endif
namespace fast {
#define LAS __attribute__((address_space(3)))
typedef unsigned short bf16_t;
typedef short bf16x8 __attribute__((ext_vector_type(8)));
typedef float f32x4 __attribute__((ext_vector_type(4)));
typedef float f32x2 __attribute__((ext_vector_type(2)));
typedef float f32x16 __attribute__((ext_vector_type(16)));
typedef unsigned u32x4 __attribute__((ext_vector_type(4)));
typedef unsigned u32x2 __attribute__((ext_vector_type(2)));
typedef __bf16 bf16x2_t __attribute__((ext_vector_type(2)));

constexpr int S = 4096, T = NB * S, D = 1024;
constexpr float EPS = 1e-6f, LOG2E = 1.4426950408889634f;

__device__ __forceinline__ unsigned cvtpk(float lo, float hi) { f32x2 v = {lo, hi}; bf16x2_t b = __builtin_convertvector(v, bf16x2_t); return __builtin_bit_cast(unsigned, b); }
__device__ __forceinline__ bf16_t f2bf(float f) { return (bf16_t)(cvtpk(f, 0.f) & 0xffffu); }
__device__ __forceinline__ float bf2f(bf16_t u) { return __builtin_bit_cast(float, (unsigned)u << 16); }
__device__ __forceinline__ float bflo(unsigned u) { return __builtin_bit_cast(float, u << 16); }
__device__ __forceinline__ float bfhi(unsigned u) { return __builtin_bit_cast(float, u & 0xffff0000u); }
__device__ __forceinline__ float wsum(float v) {
#pragma unroll
    for (int o = 1; o < 64; o <<= 1) v += __shfl_xor(v, o);
    return v;
}
__device__ __forceinline__ float fexp2(float x) { return __builtin_amdgcn_exp2f(x); }
__device__ __forceinline__ float frcp(float x) { return __builtin_amdgcn_rcpf(x); }
__device__ __forceinline__ float silu_f(float x) { return x * frcp(1.f + fexp2(-x * LOG2E)); }
__device__ __forceinline__ float gelu_tanh_f(float x) {
    const float u = 0.7978845608028654f * (x + 0.044715f * x * x * x);
    return x * frcp(1.f + fexp2(-2.f * LOG2E * u));
}

namespace pg8 {
constexpr int BM = 256, BK = 64, HALF = 128, HTB = HALF * BK * 2, STAGE_BYTES = 8 * HTB, NXCD = 8, WGM = 8;
__host__ __device__ __forceinline__ int lds_byte(int r, int c) { const int st = (r >> 4) * 2 + (c >> 5), rr = r & 15, cc = c & 31, ob = rr * 64 + cc * 2; return st * 1024 + (ob ^ (((ob >> 9) & 1) << 5)); }
__host__ __device__ __forceinline__ void stage_rc(int b, int& R, int& C) { const int st = b / 1024, sb = b % 1024, swz = sb ^ (((sb >> 9) & 1) << 5); R = (st >> 1) * 16 + swz / 64; C = (st & 1) * 32 + (swz % 64) / 2; }
__host__ __device__ __forceinline__ int perm32(int rho) { const int n = rho >> 4, i = rho & 15; return 8 * (i >> 2) + 4 * n + (i & 3); }

struct Unit { int pm, pn; };
struct Gemm { const bf16_t* A; const bf16_t* Bt; int M, N, K, lda; const int* tile_e; size_t estride; const int* rowidx; };

struct StaticOrder {
    int nM, nN, nwg, G, c;
    __device__ void init(int M, int N, int G_, int c_) { nM = M / BM; nN = N / BM; nwg = nM * nN; G = G_; c = c_; }
    __device__ bool next(int i, Unit& u) const {
        const long L = (long)i * G + c; if (L >= nwg) return false;
        int wgid = (int)L; { const int q = nwg / NXCD, r = nwg % NXCD, xcd = wgid % NXCD, off = wgid / NXCD; wgid = (xcd < r ? xcd * (q + 1) : r * (q + 1) + (xcd - r) * q) + off; }
        const int nig = WGM * nN, gid = wgid / nig, fm = gid * WGM, gsz = (nM - fm) < WGM ? (nM - fm) : WGM;
        u.pm = fm + ((wgid % nig) % gsz); u.pn = (wgid % nig) / gsz; return true;
    }
};

template <class Epi, bool ALIGN_EPI, bool GATHER = false>
__device__ __forceinline__ void gemm_phase(LAS unsigned char* lds, const Gemm g, const StaticOrder& S, const Epi& E) {
    int tid = threadIdx.x; asm volatile("" : "+v"(tid));
    const int wid = __builtin_amdgcn_readfirstlane(tid >> 6), lane = tid & 63, wr = wid >> 2, wc = wid & 3, fr = lane & 15, fq = lane >> 4;
    const int K = g.K, nt = K / BK, lda = g.lda;
    unsigned voffA[2], voffB[2];
#pragma unroll
    for (int i = 0; i < 2; ++i) { int R, C; stage_rc(tid * 16 + i * 8192, R, C); const int Rb = Epi::PERM ? ((R & ~31) + perm32(R & 31)) : R;
        voffA[i] = (unsigned)(R * lda + C) * 2u; voffB[i] = (unsigned)(Rb * K + C) * 2u; }
    const size_t kstep = (size_t)(BK * 2);
    const size_t hsA = GATHER ? 0 : (size_t)HALF * lda * 2, tsA = 2 * hsA, hsB = (size_t)HALF * K * 2, tsB = 2 * hsB;
    unsigned vgc[2][2], vgn[2][2];
#define PG8_GOFF(pm_, vg) do { _Pragma("unroll") for (int h_ = 0; h_ < 2; ++h_) _Pragma("unroll") for (int i_ = 0; i_ < 2; ++i_) { int R_, C_; stage_rc(tid * 16 + i_ * 8192, R_, C_); \
        int tok_ = g.rowidx[(pm_) * BM + h_ * HALF + R_]; tok_ = tok_ < 0 ? 0 : tok_; vg[h_][i_] = (unsigned)(tok_ * lda + C_) * 2u; } } while (0)
#define PG8_STAGE_A(bufoff, gbase, h, nx) do { unsigned va_[2]; _Pragma("unroll") for (int i_ = 0; i_ < 2; ++i_) va_[i_] = GATHER ? ((nx) ? vgn[h][i_] : vgc[h][i_]) : voffA[i_]; PG8_STAGE(bufoff, gbase, va_); } while (0)
    const unsigned ldsw = (unsigned)wid * 1024u;
    const int aoff = lds_byte(wr * 64 + fr, fq * 8), boff = lds_byte(wc * 32 + fr, fq * 8);
#define PG8_SA(b, h) (((b) * 2 + (h)) * HTB)
#define PG8_SB(b, h) ((4 + (b) * 2 + (h)) * HTB)
#define PG8_STAGE(bufoff, gbase, voff) do { _Pragma("unroll") for (int _i = 0; _i < 2; ++_i) \
        __builtin_amdgcn_global_load_lds((const unsigned*)((const char*)(gbase) + (voff)[_i]), (LAS unsigned*)(lds + (bufoff) + ldsw + _i * 8192), 16, 0, 0); } while (0)
#define PG8_LDA(dst, b, h) do { _Pragma("unroll") for (int m = 0; m < 4; ++m) _Pragma("unroll") for (int k = 0; k < 2; ++k) dst[m][k] = *(const LAS bf16x8*)(lds + PG8_SA(b, h) + aoff + m * 2048 + k * 1024); } while (0)
#define PG8_LDB(dst, b, h) do { _Pragma("unroll") for (int n = 0; n < 2; ++n) _Pragma("unroll") for (int k = 0; k < 2; ++k) dst[n][k] = *(const LAS bf16x8*)(lds + PG8_SB(b, h) + boff + n * 2048 + k * 1024); } while (0)
#define PG8_MMA(ai, bj, At, Bt) do { __builtin_amdgcn_s_setprio(1); _Pragma("unroll") for (int m = 0; m < 4; ++m) _Pragma("unroll") for (int n = 0; n < 2; ++n) _Pragma("unroll") for (int k = 0; k < 2; ++k) \
        acc[ai][bj][m][n] = __builtin_amdgcn_mfma_f32_16x16x32_bf16(Bt[n][k], At[m][k], acc[ai][bj][m][n], 0, 0, 0); __builtin_amdgcn_s_setprio(0); } while (0)
#define PG8_WAIT_V(n) asm volatile("s_waitcnt vmcnt(" #n ")" ::: "memory")
#define PG8_WAIT_L(n) asm volatile("s_waitcnt lgkmcnt(" #n ")" ::: "memory")
#define PG8_BAR __builtin_amdgcn_s_barrier()
#define PG8_SCHED __builtin_amdgcn_sched_barrier(0)
#define PG8_EOFF(pm_) (g.tile_e ? (size_t)g.tile_e[pm_] * g.estride * 2 : (size_t)0)
    Unit cur, nxt; int ui = 0;
    if (!S.next(0, cur)) return;
    f32x4 acc[2][2][4][2];
#pragma unroll
    for (int a = 0; a < 2; ++a)
#pragma unroll
        for (int b = 0; b < 2; ++b)
#pragma unroll
            for (int m = 0; m < 4; ++m)
#pragma unroll
                for (int n = 0; n < 2; ++n) acc[a][b][m][n] = (f32x4){0.f, 0.f, 0.f, 0.f};
    bf16x8 At[4][2], B0[2][2], B1[2][2];
    const char* cA = (const char*)g.A + (size_t)cur.pm * tsA; const char* cB = (const char*)g.Bt + PG8_EOFF(cur.pm) + (size_t)cur.pn * tsB;
    if constexpr (GATHER) PG8_GOFF(cur.pm, vgc);
    PG8_STAGE(PG8_SB(0, 0), cB, voffB); PG8_STAGE(PG8_SB(0, 1), cB + hsB, voffB); PG8_STAGE_A(PG8_SA(0, 0), cA, 0, false); PG8_STAGE_A(PG8_SA(0, 1), cA + hsA, 1, false);
    if (wr == 1) PG8_BAR;
    PG8_WAIT_V(2); PG8_BAR;
    PG8_STAGE(PG8_SB(1, 0), cB + kstep, voffB); PG8_STAGE_A(PG8_SA(1, 0), cA + kstep, 0, false); PG8_STAGE(PG8_SB(1, 1), cB + hsB + kstep, voffB);
    PG8_WAIT_V(6); PG8_BAR;
    for (;;) {
        const bool has_next = S.next(ui + 1, nxt);
        if constexpr (GATHER) { if (has_next) PG8_GOFF(nxt.pm, vgn); else { vgn[0][0] = vgc[0][0]; vgn[0][1] = vgc[0][1]; vgn[1][0] = vgc[1][0]; vgn[1][1] = vgc[1][1]; } }
        const char* nA = has_next ? (const char*)g.A + (size_t)nxt.pm * tsA : cA;
        const char* nB = has_next ? (const char*)g.Bt + PG8_EOFF(nxt.pm) + (size_t)nxt.pn * tsB : cB;
        for (int t = 0; t < nt; t += 2) {
            const bool last = (t == nt - 2);
            const char* a1 = cA + (size_t)(t + 1) * kstep;
            const char* a2 = last ? nA : cA + (size_t)(t + 2) * kstep; const char* b2 = last ? nB : cB + (size_t)(t + 2) * kstep;
            const char* a3 = a2 + kstep; const char* b3 = b2 + kstep;
            PG8_LDB(B0, 0, 0); PG8_LDB(B1, 0, 1); PG8_SCHED; PG8_LDA(At, 0, 0); PG8_STAGE_A(PG8_SA(1, 1), a1 + hsA, 1, false);
            PG8_WAIT_V(8); PG8_WAIT_L(0); PG8_BAR; PG8_MMA(0, 0, At, B0); PG8_MMA(0, 1, At, B1); PG8_BAR; PG8_SCHED;
            PG8_LDA(At, 0, 1); PG8_STAGE(PG8_SB(0, 0), b2, voffB); PG8_STAGE(PG8_SB(0, 1), b2 + hsB, voffB); PG8_STAGE_A(PG8_SA(0, 0), a2, 0, last);
            PG8_WAIT_V(8); PG8_WAIT_L(0); PG8_BAR; PG8_MMA(1, 0, At, B0); PG8_MMA(1, 1, At, B1); PG8_BAR; PG8_SCHED;
            PG8_LDB(B0, 1, 0); PG8_LDB(B1, 1, 1); PG8_SCHED; PG8_LDA(At, 1, 0); PG8_STAGE_A(PG8_SA(0, 1), a2 + hsA, 1, last);
            PG8_WAIT_V(8); PG8_WAIT_L(0); PG8_BAR; PG8_MMA(0, 0, At, B0); PG8_MMA(0, 1, At, B1); PG8_BAR; PG8_SCHED;
            PG8_LDA(At, 1, 1); PG8_STAGE(PG8_SB(1, 0), b3, voffB); PG8_STAGE(PG8_SB(1, 1), b3 + hsB, voffB); PG8_STAGE_A(PG8_SA(1, 0), a3, 0, last);
            PG8_WAIT_V(8); PG8_WAIT_L(0); PG8_BAR; PG8_MMA(1, 0, At, B0); PG8_MMA(1, 1, At, B1); PG8_BAR; PG8_SCHED;
        }
        if constexpr (ALIGN_EPI) { if (wr == 0) PG8_BAR; }
        E(acc, cur, wr, wc, fr, fq);
        if (!has_next) break;
#pragma unroll
        for (int a = 0; a < 2; ++a)
#pragma unroll
            for (int b = 0; b < 2; ++b)
#pragma unroll
                for (int m = 0; m < 4; ++m)
#pragma unroll
                    for (int n = 0; n < 2; ++n) acc[a][b][m][n] = (f32x4){0.f, 0.f, 0.f, 0.f};
        cur = nxt; cA = nA; cB = nB; ++ui;
        if constexpr (GATHER) { vgc[0][0] = vgn[0][0]; vgc[0][1] = vgn[0][1]; vgc[1][0] = vgn[1][0]; vgc[1][1] = vgn[1][1]; }
        if constexpr (ALIGN_EPI) { if (wr == 1) PG8_BAR; }
    }
    PG8_WAIT_V(0);
    if constexpr (!ALIGN_EPI) { if (wr == 0) PG8_BAR; }
    PG8_BAR;
#undef PG8_SA
#undef PG8_SB
#undef PG8_STAGE
#undef PG8_LDA
#undef PG8_LDB
#undef PG8_MMA
#undef PG8_WAIT_V
#undef PG8_WAIT_L
#undef PG8_BAR
#undef PG8_SCHED
#undef PG8_EOFF
#undef PG8_GOFF
#undef PG8_STAGE_A
}

__device__ __forceinline__ float row_rstd(const float* ssp, int row);
template <int ACT> struct EpiBf16 {
    static constexpr bool PERM = true;
    bf16_t* O; int ldc; const float* bias; const float* ssp;
    __device__ __forceinline__ void operator()(const f32x4 (&acc)[2][2][4][2], const Unit& u, int wr, int wc, int fr, int fq) const {
        const int row0 = u.pm * BM + wr * 64 + fr, col0 = u.pn * BM + wc * 32 + 8 * fq;
        f32x4 bv[2][2];
#pragma unroll
        for (int bj = 0; bj < 2; ++bj)
#pragma unroll
            for (int n = 0; n < 2; ++n) bv[bj][n] = bias ? *(const f32x4*)(bias + col0 + bj * HALF + 4 * n) : (f32x4){0.f, 0.f, 0.f, 0.f};
#pragma unroll
        for (int ai = 0; ai < 2; ++ai)
#pragma unroll
            for (int m = 0; m < 4; ++m) { bf16_t* rowp = O + (size_t)(row0 + ai * HALF + m * 16) * ldc + col0;
                const float rs = (ACT == 0 && ssp) ? row_rstd(ssp, row0 + ai * HALF + m * 16) : 1.f;
#pragma unroll
                for (int bj = 0; bj < 2; ++bj) { f32x4 v0 = acc[ai][bj][m][0] * rs + bv[bj][0], v1 = acc[ai][bj][m][1] * rs + bv[bj][1];
                    if (ACT == 2) {
#pragma unroll
                        for (int i = 0; i < 4; ++i) { v0[i] = gelu_tanh_f(v0[i]); v1[i] = gelu_tanh_f(v1[i]); } }
                    u32x4 w; w.x = cvtpk(v0[0], v0[1]); w.y = cvtpk(v0[2], v0[3]); w.z = cvtpk(v1[0], v1[1]); w.w = cvtpk(v1[2], v1[3]);
                    *(u32x4*)(rowp + bj * HALF) = w; } }
    }
};
struct EpiResF32 {
    static constexpr bool PERM = false;
    const float* base; float* out; int ldc;
    __device__ __forceinline__ void operator()(const f32x4 (&acc)[2][2][4][2], const Unit& u, int wr, int wc, int fr, int fq) const {
        const int col0 = u.pn * BM + wc * 32 + 4 * fq;
#pragma unroll
        for (int ai = 0; ai < 2; ++ai)
#pragma unroll
            for (int m = 0; m < 4; ++m) { const size_t off = (size_t)(u.pm * BM + ai * HALF + wr * 64 + m * 16 + fr) * ldc + col0;
#pragma unroll
                for (int bj = 0; bj < 2; ++bj)
#pragma unroll
                    for (int n = 0; n < 2; ++n) { const f32x4 bs = *(const f32x4*)(base + off + bj * HALF + n * 16); *(f32x4*)(out + off + bj * HALF + n * 16) = bs + acc[ai][bj][m][n]; } }
    }
};
template <bool BASE_BF16> struct EpiResStat {
    static constexpr bool PERM = false;
    const void* base; bf16_t* xb; float* ssp; int ldc;
    __device__ __forceinline__ void operator()(const f32x4 (&acc)[2][2][4][2], const Unit& u, int wr, int wc, int fr, int fq) const {
        const int col0 = u.pn * BM + wc * 32 + 4 * fq;
#pragma unroll
        for (int ai = 0; ai < 2; ++ai)
#pragma unroll
            for (int m = 0; m < 4; ++m) { const int row = u.pm * BM + ai * HALF + wr * 64 + m * 16 + fr; const size_t off = (size_t)row * ldc + col0; float ss = 0.f;
#pragma unroll
                for (int bj = 0; bj < 2; ++bj)
#pragma unroll
                    for (int n = 0; n < 2; ++n) { f32x4 bs;
                        if (BASE_BF16) { const u32x2 t = *(const u32x2*)((const bf16_t*)base + off + bj * HALF + n * 16); bs = (f32x4){bflo(t.x), bfhi(t.x), bflo(t.y), bfhi(t.y)}; }
                        else bs = *(const f32x4*)((const float*)base + off + bj * HALF + n * 16);
                        const f32x4 v = bs + acc[ai][bj][m][n];
                        u32x2 w; w.x = cvtpk(v.x, v.y); w.y = cvtpk(v.z, v.w); *(u32x2*)(xb + off + bj * HALF + n * 16) = w; ss += (v.x * v.x + v.y * v.y) + (v.z * v.z + v.w * v.w); }
                ss += __shfl_xor(ss, 16); ss += __shfl_xor(ss, 32);
                if (fq == 0) ssp[(size_t)row * 16 + u.pn * 4 + wc] = ss; }
    }
};
struct EpiResBf16B {
    static constexpr bool PERM = false;
    const bf16_t* base; bf16_t* out; int ldc;
    __device__ __forceinline__ void operator()(const f32x4 (&acc)[2][2][4][2], const Unit& u, int wr, int wc, int fr, int fq) const {
        const int col0 = u.pn * BM + wc * 32 + 4 * fq;
#pragma unroll
        for (int ai = 0; ai < 2; ++ai)
#pragma unroll
            for (int m = 0; m < 4; ++m) { const size_t off = (size_t)(u.pm * BM + ai * HALF + wr * 64 + m * 16 + fr) * ldc + col0;
#pragma unroll
                for (int bj = 0; bj < 2; ++bj)
#pragma unroll
                    for (int n = 0; n < 2; ++n) { const u32x2 t = *(const u32x2*)(base + off + bj * HALF + n * 16); const f32x4 v = (f32x4){bflo(t.x), bfhi(t.x), bflo(t.y), bfhi(t.y)} + acc[ai][bj][m][n];
                        u32x2 w; w.x = cvtpk(v.x, v.y); w.y = cvtpk(v.z, v.w); *(u32x2*)(out + off + bj * HALF + n * 16) = w; } }
    }
};
struct EpiResF32B {
    static constexpr bool PERM = false;
    const bf16_t* base; float* out; int ldc;
    __device__ __forceinline__ void operator()(const f32x4 (&acc)[2][2][4][2], const Unit& u, int wr, int wc, int fr, int fq) const {
        const int col0 = u.pn * BM + wc * 32 + 4 * fq;
#pragma unroll
        for (int ai = 0; ai < 2; ++ai)
#pragma unroll
            for (int m = 0; m < 4; ++m) { const size_t off = (size_t)(u.pm * BM + ai * HALF + wr * 64 + m * 16 + fr) * ldc + col0;
#pragma unroll
                for (int bj = 0; bj < 2; ++bj)
#pragma unroll
                    for (int n = 0; n < 2; ++n) { const u32x2 t = *(const u32x2*)(base + off + bj * HALF + n * 16); const f32x4 bs = {bflo(t.x), bfhi(t.x), bflo(t.y), bfhi(t.y)};
                        *(f32x4*)(out + off + bj * HALF + n * 16) = bs + acc[ai][bj][m][n]; } }
    }
};
__device__ __forceinline__ float row_rstd(const float* ssp, int row) {
    const f32x4* q = (const f32x4*)(ssp + (size_t)row * 16); const f32x4 a = q[0], b = q[1], c = q[2], d = q[3];
    const float s = ((a.x + a.y) + (a.z + a.w)) + ((b.x + b.y) + (b.z + b.w)) + ((c.x + c.y) + (c.z + c.w)) + ((d.x + d.y) + (d.z + d.w));
    return rsqrtf(s * (1.f / 1024.f) + EPS);
}
struct EpiSwiGLU {
    static constexpr bool PERM = true;
    bf16_t* O; int ldc; const float* ssp;
    __device__ __forceinline__ void operator()(const f32x4 (&acc)[2][2][4][2], const Unit& u, int wr, int wc, int fr, int fq) const {
        const int row0 = u.pm * BM + wr * 64 + fr, col0 = u.pn * HALF + wc * 32 + 8 * fq;
#pragma unroll
        for (int ai = 0; ai < 2; ++ai)
#pragma unroll
            for (int m = 0; m < 4; ++m) { bf16_t* rowp = O + (size_t)(row0 + ai * HALF + m * 16) * ldc + col0;
                const float rs = ssp ? row_rstd(ssp, row0 + ai * HALF + m * 16) : 1.f;
                float h[8];
#pragma unroll
                for (int n = 0; n < 2; ++n)
#pragma unroll
                    for (int i = 0; i < 4; ++i) h[n * 4 + i] = silu_f(acc[ai][0][m][n][i] * rs) * (acc[ai][1][m][n][i] * rs);
                u32x4 w; w.x = cvtpk(h[0], h[1]); w.y = cvtpk(h[2], h[3]); w.z = cvtpk(h[4], h[5]); w.w = cvtpk(h[6], h[7]);
                *(u32x4*)rowp = w; }
    }
};
struct EpiConvIn {
    static constexpr bool PERM = true;
    bf16_t* Bg; bf16_t* CU; const float* ssp;
    __device__ __forceinline__ void operator()(const f32x4 (&acc)[2][2][4][2], const Unit& u, int wr, int wc, int fr, int fq) const {
        const int row0 = u.pm * BM + wr * 64 + fr;
#pragma unroll
        for (int ai = 0; ai < 2; ++ai)
#pragma unroll
            for (int m = 0; m < 4; ++m) { const int row = row0 + ai * HALF + m * 16; const float rs = row_rstd(ssp, row);
                if (u.pn < 4) {
#pragma unroll
                    for (int bj = 0; bj < 2; ++bj) { const f32x4 v0 = acc[ai][bj][m][0] * rs, v1 = acc[ai][bj][m][1] * rs;
                        u32x4 w; w.x = cvtpk(v0[0], v0[1]); w.y = cvtpk(v0[2], v0[3]); w.z = cvtpk(v1[0], v1[1]); w.w = cvtpk(v1[2], v1[3]);
                        *(u32x4*)(Bg + (size_t)row * 1024 + u.pn * BM + bj * HALF + wc * 32 + 8 * fq) = w; }
                } else { const float r2 = rs * rs; float h[8];
#pragma unroll
                    for (int n = 0; n < 2; ++n)
#pragma unroll
                        for (int i = 0; i < 4; ++i) h[n * 4 + i] = acc[ai][0][m][n][i] * acc[ai][1][m][n][i] * r2;
                    u32x4 w; w.x = cvtpk(h[0], h[1]); w.y = cvtpk(h[2], h[3]); w.z = cvtpk(h[4], h[5]); w.w = cvtpk(h[6], h[7]);
                    *(u32x4*)(CU + (size_t)row * 1024 + (u.pn - 4) * HALF + wc * 32 + 8 * fq) = w; } }
    }
};
struct EpiRowScaleBf16 {
    static constexpr bool PERM = true;
    bf16_t* O; int ldc; const float* roww;
    __device__ __forceinline__ void operator()(const f32x4 (&acc)[2][2][4][2], const Unit& u, int wr, int wc, int fr, int fq) const {
        const int row0 = u.pm * BM + wr * 64 + fr, col0 = u.pn * BM + wc * 32 + 8 * fq;
#pragma unroll
        for (int ai = 0; ai < 2; ++ai)
#pragma unroll
            for (int m = 0; m < 4; ++m) { const int row = row0 + ai * HALF + m * 16; const float sc = roww[row]; bf16_t* rowp = O + (size_t)row * ldc + col0;
#pragma unroll
                for (int bj = 0; bj < 2; ++bj) { const f32x4 v0 = acc[ai][bj][m][0] * sc, v1 = acc[ai][bj][m][1] * sc;
                    u32x4 w; w.x = cvtpk(v0[0], v0[1]); w.y = cvtpk(v0[2], v0[3]); w.z = cvtpk(v1[0], v1[1]); w.w = cvtpk(v1[2], v1[3]);
                    *(u32x4*)(rowp + bj * HALF) = w; } }
    }
};
}
constexpr int ROWS_MAX = 2 * T + 8 * 256;
constexpr size_t al256(size_t x) { return (x + 255) & ~(size_t)255; }
constexpr size_t W_IN_E = 0;
constexpr size_t W_CW1 = W_IN_E + (size_t)1792 * 1024 * 2;
constexpr size_t W_UQ = W_CW1 + (size_t)2 * 256 * 2048 * 2;
constexpr size_t W_UKV = W_UQ + (size_t)1024 * 256 * 2;
constexpr size_t W_OUT_E = W_UKV + (size_t)1024 * 128 * 2;
constexpr size_t W_GU = W_OUT_E + (size_t)1024 * 1024 * 2;
constexpr size_t W_D = W_GU + (size_t)5632 * 1024 * 2;
constexpr size_t W_IN_O = W_D + (size_t)1024 * 2816 * 2;
constexpr size_t W_OUT_O = W_IN_O + (size_t)3072 * 1024 * 2;
constexpr size_t W_MGU = W_OUT_O + (size_t)1024 * 1024 * 2;
constexpr size_t W_MD = W_MGU + (size_t)8 * 2816 * 1024 * 2;
constexpr size_t W_END = W_MD + (size_t)8 * 1024 * 1408 * 2;
constexpr size_t SM_CTL = al256(W_END);
constexpr size_t SM_BAR = SM_CTL + 4096;
constexpr size_t SM_B1P = SM_BAR + 16384;
constexpr size_t SM_B1 = SM_B1P + 32 * 512 * 4;
constexpr size_t SM_ROPE = SM_B1 + 512 * 4;
constexpr size_t SM_BL = SM_ROPE + (size_t)S * 32 * 4;
constexpr size_t SM_HID = SM_BL + 8 * 132 * 4;
constexpr size_t SM_KC = SM_HID + (size_t)2 * NB * 512 * 512 * 2;
constexpr size_t SM_VCT = SM_KC + (size_t)NB * 512 * 64 * 2;
constexpr size_t SM_TE = SM_VCT + (size_t)NB * 512 * 64 * 2;
constexpr size_t SM_TW = SM_TE + (size_t)T * 8;
constexpr size_t SM_RANK = SM_TW + (size_t)T * 8;
constexpr size_t SM_POS = SM_RANK + (size_t)T * 8;
constexpr size_t SM_ROWW = SM_POS + (size_t)T * 8;
constexpr size_t SM_TILEE = SM_ROWW + (size_t)ROWS_MAX * 4;
constexpr size_t SM_ROWTOK = al256(SM_TILEE + (size_t)(ROWS_MAX / 256 + 8) * 4);
constexpr size_t SM_SSP1 = al256(SM_ROWTOK + (size_t)ROWS_MAX * 4);
constexpr size_t SM_SSP2 = SM_SSP1 + (size_t)T * 64;
constexpr size_t SM_END = SM_SSP2 + (size_t)T * 64;
constexpr size_t R_XA = al256(SM_END);
constexpr size_t SZ_XA = (size_t)T * 4096 + (size_t)4 * 1048576;
constexpr size_t R_XN = R_XA + SZ_XA;
constexpr size_t SZ_XN = (size_t)T * 2048;
constexpr size_t R_H = R_XN + SZ_XN;
constexpr size_t SZ_H = ((size_t)T * 6144 > (size_t)ROWS_MAX * 2816) ? (size_t)T * 6144 : (size_t)ROWS_MAX * 2816;
constexpr size_t WS_FAST_END = R_H + SZ_H;
constexpr size_t A_QN = 0;
constexpr size_t A_KSN = A_QN + (size_t)T * 1024;
constexpr size_t A_KWN = A_KSN + (size_t)T * 256;
constexpr size_t A_VST = A_KWN + (size_t)T * 256;
constexpr size_t A_VWT = A_VST + (size_t)T * 256;
constexpr size_t A_KCIN = A_VWT + (size_t)T * 256;
constexpr size_t A_VCIN = A_KCIN + (size_t)T * 256 + 2048;
constexpr size_t A_CQN = A_VCIN + (size_t)T * 256 + 2048;
constexpr size_t A_CKVN = A_CQN + (size_t)T * 512;
constexpr size_t A_KROPE = A_CKVN + (size_t)T * 256;
constexpr size_t A_GATES = A_KROPE + (size_t)T * 64;
constexpr size_t A_END = A_GATES + (size_t)T * 96;
static_assert(A_END <= SZ_XA, "attention inputs fit R_XA");
constexpr size_t O_QM = 0;
constexpr size_t O_KM = O_QM + (size_t)T * 1536;
constexpr size_t O_VMT = O_KM + (size_t)T * 1536;
static_assert(O_VMT + (size_t)T * 1024 <= (size_t)T * 4096, "d_out scratch");

struct Params {
    const float* in[30];
    float* out;
    unsigned char* ws;
    int ph_lo, ph_hi, dbg_branch, pad_;
};

#ifdef PROF_SEL
#define PROF_SLOT(k) ((unsigned long long*)(p.ws + SM_CTL + 2048) + (k))
#define PROF_ON(cond) ((cond) && threadIdx.x == 0)
#ifndef PROF_WAVE
#define PROF_WAVE 0
#endif
#endif
constexpr int LDS_BYTES = 147456;

__device__ __forceinline__ int ltid() { int t = threadIdx.x; asm volatile("" : "+v"(t)); return t; }
__device__ __forceinline__ int perm16(int k) { return (k & ~12) | ((k & 4) << 1) | ((k & 8) >> 1); }

struct WDesc { int in_idx, K, N, rep, map, row_off; size_t src_stride, dst_off, dst_stride; int gain_idx, pad_; size_t src_off; };
__device__ const WDesc WDESC[13] = {
    {3, 1024, 1720, 1, 2, 0, 0, W_IN_E / 2, 0, -1, 0},
    {7, 1024, 256, 2, 0, 0, (size_t)2048 * 256, W_CW1 / 2, (size_t)512 * 1024, -1, 0, 0},
    {7, 1024, 256, 2, 0, 256, (size_t)2048 * 256, W_CW1 / 2, (size_t)512 * 1024, -1, 0, (size_t)1024 * 256},
    {11, 256, 768, 1, 3, 0, 0, W_UQ / 2, 0, -1, 0},
    {12, 128, 1024, 1, 0, 0, 0, W_UKV / 2, 0, -1, 0},
    {15, 1024, 1024, 1, 0, 0, 0, W_OUT_E / 2, 0, -1, 0},
    {17, 1024, 2816, 1, 1, 0, 0, W_GU / 2, 0, 16, 0},
    {18, 1024, 2816, 1, 1, 128, 0, W_GU / 2, 0, 16, 0},
    {19, 2816, 1024, 1, 0, 0, 0, W_D / 2, 0, -1, 0},
    {21, 1024, 3072, 1, 4, 0, 0, W_IN_O / 2, 0, 20, 0},
    {23, 1024, 1024, 1, 0, 0, 0, W_OUT_O / 2, 0, -1, 0},
    {27, 1024, 1408, 8, 1, 0, (size_t)1024 * 1408, W_MGU / 2, (size_t)2816 * 1024, -1, 0},
    {28, 1024, 1408, 8, 1, 128, (size_t)1024 * 1408, W_MGU / 2, (size_t)2816 * 1024, -1, 0},
};
__device__ const WDesc WDESC_MD = {29, 1408, 1024, 8, 0, 0, (size_t)1408 * 1024, W_MD / 2, (size_t)1024 * 1408, -1, 0};

struct WItem { f32x4 v[8]; };
__device__ __forceinline__ void item_load(WItem& I, const float* W, int K, int N, const float* gain, int item, int lane) {
    const int nblk = (N + 31) / 32, kb = item / nblk, nb = item % nblk, k0 = 64 * kb, n0 = 32 * nb;
    const int n4 = (lane & 7) * 4; const bool nok = (n0 + n4) < N;
#pragma unroll
    for (int i = 0; i < 8; ++i) { const int kk = (lane >> 3) + 8 * i; I.v[i] = nok ? *(const f32x4*)(W + (size_t)(k0 + kk) * N + n0 + n4) : (f32x4){0.f, 0.f, 0.f, 0.f}; if (gain) I.v[i] = I.v[i] * gain[k0 + kk]; }
}
__device__ __forceinline__ void item_finish(const WItem& I, int K, int N, bf16_t* WT, int map, int row_off, LAS float* scr, int item, int lane) {
    const int nblk = (N + 31) / 32, kb = item / nblk, nb = item % nblk, k0 = 64 * kb, n0 = 32 * nb;
    const int n4 = (lane & 7) * 4;
#pragma unroll
    for (int i = 0; i < 8; ++i) { const int kk = (lane >> 3) + 8 * i; LAS float* d = scr + kk * 33 + n4; d[0] = I.v[i].x; d[1] = I.v[i].y; d[2] = I.v[i].z; d[3] = I.v[i].w; }
    asm volatile("s_waitcnt lgkmcnt(0)" ::: "memory");
    const int c = lane & 7;
#pragma unroll
    for (int j = 0; j < 4; ++j) { const int n = (lane >> 3) + 8 * j; const LAS float* s = scr + (8 * c) * 33 + n;
        u32x4 o; o.x = cvtpk(s[0 * 33], s[1 * 33]); o.y = cvtpk(s[2 * 33], s[3 * 33]); o.z = cvtpk(s[4 * 33], s[5 * 33]); o.w = cvtpk(s[6 * 33], s[7 * 33]);
        const int nn = n0 + n;
        if (nn < N) { const int row = (map == 1) ? (256 * (nn >> 7) + (nn & 127) + row_off) : (map == 2) ? (nn < 1280 ? nn : (nn < 1304 ? nn + 416 : nn - 24)) : (map == 3) ? ((nn / 96) * 128 + nn % 96) : (map == 4) ? (nn < 1024 ? nn : (nn < 2048 ? 1024 + 256 * ((nn - 1024) >> 7) + ((nn - 1024) & 127) : 1024 + 256 * ((nn - 2048) >> 7) + 128 + ((nn - 2048) & 127))) : (nn + row_off);
            *(u32x4*)(WT + (size_t)row * K + k0 + 8 * c) = o; } }
    asm volatile("s_waitcnt lgkmcnt(0)" ::: "memory");
}
__device__ __forceinline__ void rms_row_to_bf16(const float* xrow, const float* g, bf16_t* orow, int lane) {
    const f32x4* xr = (const f32x4*)xrow + lane; const f32x4* gr = (const f32x4*)g + lane;
    f32x4 v[4]; float s = 0.f;
#pragma unroll
    for (int j = 0; j < 4; ++j) { v[j] = xr[64 * j]; s += (v[j].x * v[j].x + v[j].y * v[j].y) + (v[j].z * v[j].z + v[j].w * v[j].w); }
    const float r = rsqrtf(wsum(s) * (1.f / 1024.f) + EPS);
    u32x2* o8 = (u32x2*)orow + lane;
#pragma unroll
    for (int j = 0; j < 4; ++j) { const f32x4 gg = gr[64 * j]; u32x2 w; w.x = cvtpk(v[j].x * r * gg.x, v[j].y * r * gg.y); w.y = cvtpk(v[j].z * r * gg.z, v[j].w * r * gg.w); o8[64 * j] = w; }
}
constexpr int WD_EARLY = 6;
__device__ __forceinline__ void convert_weights(const Params& p, LAS unsigned char* lds, int d_lo, int d_hi) {
    const int tid = ltid(), lane = tid & 63, wave = tid >> 6;
    const int gw = blockIdx.x * 8 + wave, NGW = gridDim.x * 8;
    LAS float* scr = (LAS float*)(lds + wave * 16384);
    int base = 0;
#pragma unroll 1
    for (int d = d_lo; d < d_hi; ++d) {
        const WDesc& wd = (d < 13) ? WDESC[d] : WDESC_MD;
        const int n_it = wd.rep * (wd.K / 64) * ((wd.N + 31) / 32);
        int first = (gw - (base % NGW) + NGW) % NGW;
        const int per = (wd.K / 64) * ((wd.N + 31) / 32); const float* gain = wd.gain_idx >= 0 ? p.in[wd.gain_idx] : nullptr;
        for (int it = first; it < n_it; it += 4 * NGW) {
            WItem I[4];
#pragma unroll
            for (int q = 0; q < 4; ++q) { const int iq = it + q * NGW; if (iq < n_it) { const int r = iq / per; item_load(I[q], p.in[wd.in_idx] + wd.src_off + (size_t)r * wd.src_stride, wd.K, wd.N, gain, iq % per, lane); } }
#pragma unroll
            for (int q = 0; q < 4; ++q) { const int iq = it + q * NGW; if (iq < n_it) { const int r = iq / per; item_finish(I[q], wd.K, wd.N, (bf16_t*)p.ws + wd.dst_off + (size_t)r * wd.dst_stride, wd.map, wd.row_off, scr, iq % per, lane); } }
        }
        base += n_it;
    }
}
__device__ __forceinline__ void phase_p0(const Params& p, LAS unsigned char* lds) {
    const int tid = ltid(), lane = tid & 63, wave = tid >> 6;
    const int gw = blockIdx.x * 8 + wave, NGW = gridDim.x * 8;
    convert_weights(p, lds, 0, WD_EARLY);
    bf16_t* xn = (bf16_t*)(p.ws + R_XN);
    for (int m = gw; m < T; m += 2 * NGW) { rms_row_to_bf16(p.in[0] + (size_t)m * D, p.in[2], xn + (size_t)m * D, lane); if (m + NGW < T) rms_row_to_bf16(p.in[0] + (size_t)(m + NGW) * D, p.in[2], xn + (size_t)(m + NGW) * D, lane); }
    for (int u = gw; u < 256; u += NGW) {
        const int kc = u >> 3, kv = (u >> 2) & 1, nb = u & 3; float s = 0.f;
        const float* pos = p.in[6] + kv * 2048 + kc * 64; const float* w1 = p.in[7] + ((size_t)kv * 2048 + kc * 64) * 256 + nb * 64 + lane;
#pragma unroll 8
        for (int k = 0; k < 64; ++k) s += pos[k] * w1[(size_t)k * 256];
        ((float*)(p.ws + SM_B1P))[kc * 512 + kv * 256 + nb * 64 + lane] = s;
    }
    for (int i = blockIdx.x * 512 + tid; i < S * 16; i += gridDim.x * 512) {
        const int t = i >> 4, f = i & 15; const float ang = (float)t * powf(10000.f, -(float)f / 16.f);
        float* rp = (float*)(p.ws + SM_ROPE) + t * 32; rp[f] = cosf(ang); rp[16 + f] = sinf(ang);
    }
    if (blockIdx.x == 0) for (int i = tid; i < 8 * 129; i += 512) { const int h = i / 129, dd = i % 129; ((float*)(p.ws + SM_BL))[h * 132 + dd] = p.in[1][(dd < 128 ? (int)gold::T5B[dd] : 31) * 8 + h] * LOG2E; }
}

__device__ __forceinline__ void unpack8(const u32x4 v, float (&x)[8]) { x[0] = bflo(v.x); x[1] = bfhi(v.x); x[2] = bflo(v.y); x[3] = bfhi(v.y); x[4] = bflo(v.z); x[5] = bfhi(v.z); x[6] = bflo(v.w); x[7] = bfhi(v.w); }
__device__ __forceinline__ u32x4 pack8(const float (&x)[8]) { u32x4 w; w.x = cvtpk(x[0], x[1]); w.y = cvtpk(x[2], x[3]); w.z = cvtpk(x[4], x[5]); w.w = cvtpk(x[6], x[7]); return w; }
__device__ __forceinline__ float ss8f(const float (&x)[8]) { return ((x[0] * x[0] + x[1] * x[1]) + (x[2] * x[2] + x[3] * x[3])) + ((x[4] * x[4] + x[5] * x[5]) + (x[6] * x[6] + x[7] * x[7])); }
__device__ __forceinline__ void load8f(const float* g, float (&x)[8], float sc) { const f32x4 a = *(const f32x4*)g, b = *(const f32x4*)(g + 4); x[0] = a.x * sc; x[1] = a.y * sc; x[2] = a.z * sc; x[3] = a.w * sc; x[4] = b.x * sc; x[5] = b.y * sc; x[6] = b.z * sc; x[7] = b.w * sc; }
__device__ __forceinline__ void phase_p2(const Params& p, LAS unsigned char* lds) {
    const int tid = ltid(), lane = tid & 63, wave = tid >> 6;
    const bf16_t* hb = (const bf16_t*)(p.ws + R_H);
    unsigned char* xa = p.ws + R_XA;
    bf16_t* qn = (bf16_t*)(xa + A_QN); bf16_t* ksn = (bf16_t*)(xa + A_KSN); bf16_t* kwn = (bf16_t*)(xa + A_KWN);
    bf16_t* vst = (bf16_t*)(xa + A_VST); bf16_t* vwt = (bf16_t*)(xa + A_VWT); bf16_t* kcin = (bf16_t*)(xa + A_KCIN); bf16_t* vcin = (bf16_t*)(xa + A_VCIN);
    bf16_t* cqn = (bf16_t*)(xa + A_CQN); bf16_t* ckvn = (bf16_t*)(xa + A_CKVN); bf16_t* krope = (bf16_t*)(xa + A_KROPE); float* gates = (float*)(xa + A_GATES);
    LAS bf16_t* vs = (LAS bf16_t*)lds;
    if (blockIdx.x == 0) {
        { float s = 0.f; for (int k = 0; k < 32; ++k) s += ((const float*)(p.ws + SM_B1P))[k * 512 + tid]; ((float*)(p.ws + SM_B1))[tid] = s; }
        for (int i = tid; i < 1024; i += 512) { kcin[(size_t)T * 128 + i] = 0; vcin[(size_t)T * 128 + i] = 0; }
    }
    const int c8 = (lane & 7) * 8, seg = lane >> 3;
    float qg[8], ksg[8], kwg[8], cqg[8], ckvg[8];
    load8f(p.in[4] + c8, qg, 0.125f * LOG2E); load8f(p.in[5] + 64 + c8, ksg, 1.f); load8f(p.in[5] + 128 + c8, kwg, 1.f);
    load8f(p.in[9] + (lane & 31) * 8, cqg, 1.f); load8f(p.in[10] + (lane & 15) * 8, ckvg, 1.f);
    for (int tile = blockIdx.x; tile < T / 64; tile += gridDim.x) {
        const int b = tile / (S / 64), s0 = (tile % (S / 64)) * 64;
#pragma unroll 4
        for (int tt = 0; tt < 8; ++tt) {
            const int sl = wave * 8 + tt, s = s0 + sl; const size_t t = (size_t)b * S + s;
            const bf16_t* hr = hb + t * 1792 + lane * 8;
            const u32x4 L0 = *(const u32x4*)hr, L1 = *(const u32x4*)(hr + 512), L2 = *(const u32x4*)(hr + 1024);
            u32x4 L3 = {0u, 0u, 0u, 0u}; if (lane < 32) L3 = *(const u32x4*)(hr + 1536);
            float x0[8], x1[8], x2[8], x3[8];
            unpack8(L0, x0); unpack8(L1, x1); unpack8(L2, x2); unpack8(L3, x3);
            float a0 = ss8f(x0), a1 = ss8f(x1), a2 = ss8f(x2), a3 = ss8f(x3);
#pragma unroll
            for (int o = 1; o < 8; o <<= 1) { a0 += __shfl_xor(a0, o); a1 += __shfl_xor(a1, o); a2 += __shfl_xor(a2, o); a3 += __shfl_xor(a3, o); }
            float a2w = a2 + __shfl_xor(a2, 8); a2w += __shfl_xor(a2w, 16);
            const float a3w = a3 + __shfl_xor(a3, 8);
            const int pp0 = (sl & ~15) | perm16(sl & 15);
            const int pp = (((pp0 >> 3) ^ (lane & 7)) << 3) | (pp0 & 7);
            {
                const float r = rsqrtf(a0 * (1.f / 64.f) + EPS); float y[8];
#pragma unroll
                for (int j = 0; j < 8; ++j) y[j] = x0[j] * r * qg[j];
                *(u32x4*)(qn + t * 512 + lane * 8) = pack8(y);
            }
            {
                const int g = seg & 1; const size_t gm = (((size_t)b * 2 + g) * S + s) * 64 + c8;
                if (seg < 2) *(u32x4*)(kcin + gm) = L1;
                else if (seg < 4) *(u32x4*)(vcin + gm) = L1;
                else if (seg < 6) { const float r = rsqrtf(a1 * (1.f / 64.f) + EPS); float y[8];
#pragma unroll
                    for (int j = 0; j < 8; ++j) y[j] = x1[j] * r * ksg[j];
                    *(u32x4*)(ksn + gm) = pack8(y); }
                else {
#pragma unroll
                    for (int j = 0; j < 8; ++j) vs[((0 + g) * 64 + c8 + j) * 72 + pp] = (bf16_t)((j & 1) ? (L1[j >> 1] >> 16) : (L1[j >> 1] & 0xffffu)); }
            }
            {
                const int g = seg & 1; const size_t gm = (((size_t)b * 2 + g) * S + s) * 64 + c8;
                if (seg < 2) { const float r = rsqrtf(a2 * (1.f / 64.f) + EPS); float y[8];
#pragma unroll
                    for (int j = 0; j < 8; ++j) y[j] = x2[j] * r * kwg[j];
                    *(u32x4*)(kwn + gm) = pack8(y); }
                else if (seg < 4) {
#pragma unroll
                    for (int j = 0; j < 8; ++j) vs[((2 + g) * 64 + c8 + j) * 72 + pp] = (bf16_t)((j & 1) ? (L2[j >> 1] >> 16) : (L2[j >> 1] & 0xffffu)); }
                else { const float r = rsqrtf(a2w * (1.f / 256.f) + EPS); float y[8];
#pragma unroll
                    for (int j = 0; j < 8; ++j) y[j] = x2[j] * r * cqg[j];
                    *(u32x4*)(cqn + t * 256 + (lane - 32) * 8) = pack8(y); }
            }
            {
                if (lane < 16) { const float r = rsqrtf(a3w * (1.f / 128.f) + EPS); float y[8];
#pragma unroll
                    for (int j = 0; j < 8; ++j) y[j] = x3[j] * r * ckvg[j];
                    *(u32x4*)(ckvn + t * 128 + lane * 8) = pack8(y); }
                else if (lane < 20) *(u32x4*)(krope + t * 32 + (lane - 16) * 8) = L3;
                else if (lane < 23) { float y[8];
#pragma unroll
                    for (int j = 0; j < 8; ++j) y[j] = frcp(1.f + fexp2(-x3[j] * LOG2E));
                    float* gp = gates + t * 24 + (lane - 20) * 8; *(f32x4*)gp = (f32x4){y[0], y[1], y[2], y[3]}; *(f32x4*)(gp + 4) = (f32x4){y[4], y[5], y[6], y[7]}; }
            }
        }
        __syncthreads();
        {
            const int row = tid >> 1, half = tid & 1, which = row >> 6, d = row & 63, g = which & 1;
            bf16_t* dst = ((which < 2) ? vst : vwt) + (((size_t)b * 2 + g) * 64 + d) * S + s0 + half * 32;
            const LAS bf16_t* src = vs + row * 72; const int sx = (row >> 3) & 7;
#pragma unroll
            for (int c = 0; c < 4; ++c) *(u32x4*)(dst + c * 8) = *(const LAS u32x4*)(src + (((half * 4 + c) ^ sx) << 3));
        }
        __syncthreads();
    }
}
__device__ __forceinline__ void phase_p3b(const Params& p, LAS unsigned char* lds) {
    const int tid = ltid(), lane = tid & 63, wave = tid >> 6;
    const int gw = blockIdx.x * 8 + wave, NGW = gridDim.x * 8;
    const bf16_t* qraw = (const bf16_t*)(p.ws + R_H);
    const bf16_t* kvraw = (const bf16_t*)(p.ws + R_H + (size_t)T * 2048);
    const bf16_t* krope = (const bf16_t*)(p.ws + R_XA + A_KROPE);
    const float* rope = (const float*)(p.ws + SM_ROPE);
    bf16_t* qm = (bf16_t*)((unsigned char*)p.out + O_QM); bf16_t* km = (bf16_t*)((unsigned char*)p.out + O_KM); bf16_t* vmt = (bf16_t*)((unsigned char*)p.out + O_VMT);
    const float* q_norm = p.in[13]; const float* k_norm = p.in[14];
    LAS bf16_t* vs = (LAS bf16_t*)lds;
    LAS float* w2s = (LAS float*)(lds + 73728);
    for (int kv = 0; kv < 2; ++kv) {
        __syncthreads();
        for (int i = tid; i < 256 * 64; i += 512) w2s[i] = p.in[8][kv * 16384 + i];
        __syncthreads();
        const bf16_t* P = (const bf16_t*)(p.ws + SM_HID) + (size_t)kv * NB * 512 * 512;
        const f32x4 bs = *(const f32x4*)((const float*)(p.ws + SM_B1) + kv * 256 + lane * 4);
        for (int row = gw; row < NB * 512; row += NGW) {
            const int row1 = row + 1 < NB * 512 ? row + 1 : row;
            const u32x2 pa = *(const u32x2*)(P + (size_t)row * 512 + lane * 4), pb = *(const u32x2*)(P + (size_t)row1 * 512 + 256 + lane * 4);
            const float h0 = gelu_tanh_f(bflo(pa.x) + bflo(pb.x) + bs.x), h1 = gelu_tanh_f(bfhi(pa.x) + bfhi(pb.x) + bs.y), h2 = gelu_tanh_f(bflo(pa.y) + bflo(pb.y) + bs.z), h3 = gelu_tanh_f(bfhi(pa.y) + bfhi(pb.y) + bs.w);
            float acc = 0.f;
#pragma unroll 8
            for (int k4 = 0; k4 < 64; ++k4) {
                acc += __shfl(h0, k4) * w2s[(k4 * 4 + 0) * 64 + lane]; acc += __shfl(h1, k4) * w2s[(k4 * 4 + 1) * 64 + lane];
                acc += __shfl(h2, k4) * w2s[(k4 * 4 + 2) * 64 + lane]; acc += __shfl(h3, k4) * w2s[(k4 * 4 + 3) * 64 + lane];
            }
            if (kv == 0) { const float r = rsqrtf(wsum(acc * acc) * (1.f / 64.f) + EPS); ((bf16_t*)(p.ws + SM_KC))[(size_t)row * 64 + lane] = f2bf(acc * r * p.in[5][lane]); }
            else { const int c = row & 255; ((bf16_t*)(p.ws + SM_VCT))[((size_t)(row >> 8) * 64 + lane) * 256 + ((c & ~15) | perm16(c & 15))] = f2bf(acc); }
        }
    }
    __syncthreads();
    const float QS = 0.10206207261596577f * LOG2E;
    const int c = lane & 15, hl = lane >> 4;
    float qg[8], kg[8];
    load8f(q_norm + (c < 12 ? c * 8 : 0), qg, QS);
    load8f(k_norm + (c < 12 ? c * 8 : 0), kg, 1.f);
    for (int tile = blockIdx.x; tile < T / 64; tile += gridDim.x) {
        const int b = tile / (S / 64), s0 = (tile % (S / 64)) * 64;
#pragma unroll 4
        for (int tt = 0; tt < 8; ++tt) {
            const int sl = wave * 8 + tt, s = s0 + sl; const size_t t = (size_t)b * S + s;
            const int pp0 = (sl & ~15) | perm16(sl & 15);
            const int pp = (((pp0 >> 3) ^ ((c - 8) & 7)) << 3) | (pp0 & 7);
            u32x4 Q[2], KV[2];
#pragma unroll
            for (int ld = 0; ld < 2; ++ld) { Q[ld] = *(const u32x4*)(qraw + t * 1024 + ld * 512 + lane * 8); KV[ld] = *(const u32x4*)(kvraw + t * 1024 + ld * 512 + lane * 8); }
            u32x4 KR = {0u, 0u, 0u, 0u}; f32x4 cs0 = {0.f, 0.f, 0.f, 0.f}, cs1 = cs0, sn0 = cs0, sn1 = cs0;
            if (c >= 8 && c < 12) { KR = *(const u32x4*)(krope + t * 32 + (c - 8) * 8);
                const float* rp = rope + s * 32 + (c & 1) * 8; cs0 = *(const f32x4*)rp; cs1 = *(const f32x4*)(rp + 4); sn0 = *(const f32x4*)(rp + 16); sn1 = *(const f32x4*)(rp + 20); }
            const float cs[8] = {cs0.x, cs0.y, cs0.z, cs0.w, cs1.x, cs1.y, cs1.z, cs1.w}, sn[8] = {sn0.x, sn0.y, sn0.z, sn0.w, sn1.x, sn1.y, sn1.z, sn1.w};
            float kr[8]; unpack8(KR, kr);
            const float krs = ss8f(kr);
#pragma unroll
            for (int ld = 0; ld < 2; ++ld) {
                const int hh = ld * 4 + hl;
                {
                    float x[8]; unpack8(Q[ld], x);
                    float ss = c < 12 ? ss8f(x) : 0.f;
#pragma unroll
                    for (int o = 1; o < 16; o <<= 1) ss += __shfl_xor(ss, o);
                    const float r = rsqrtf(ss * (1.f / 96.f) + EPS); float y[8], z[8];
#pragma unroll
                    for (int j = 0; j < 8; ++j) y[j] = x[j] * r * qg[j];
#pragma unroll
                    for (int j = 0; j < 8; ++j) { const float pb = __shfl_xor(y[j], 2); z[j] = (c < 8) ? y[j] : ((c < 10) ? (y[j] * cs[j] - pb * sn[j]) : (pb * sn[j] + y[j] * cs[j])); }
                    if (c < 12) *(u32x4*)(qm + (t * 8 + hh) * 96 + c * 8) = pack8(z);
                }
                {
                    float x[8]; unpack8(KV[ld], x);
                    float ss = c < 8 ? ss8f(x) : krs;
#pragma unroll
                    for (int o = 1; o < 16; o <<= 1) ss += __shfl_xor(ss, o);
                    const float r = rsqrtf(ss * (1.f / 96.f) + EPS); float y[8], z[8];
#pragma unroll
                    for (int j = 0; j < 8; ++j) y[j] = (c < 8 ? x[j] : kr[j]) * r * kg[j];
#pragma unroll
                    for (int j = 0; j < 8; ++j) { const float pb = __shfl_xor(y[j], 2); z[j] = (c < 8) ? y[j] : ((c < 10) ? (y[j] * cs[j] - pb * sn[j]) : (pb * sn[j] + y[j] * cs[j])); }
                    if (c < 12) *(u32x4*)(km + (((size_t)b * 8 + hh) * S + s) * 96 + c * 8) = pack8(z);
                    if (c >= 8) {
#pragma unroll
                        for (int j = 0; j < 8; ++j) vs[(hh * 64 + (c - 8) * 8 + j) * 72 + pp] = (bf16_t)((j & 1) ? (KV[ld][j >> 1] >> 16) : (KV[ld][j >> 1] & 0xffffu)); }
                }
            }
        }
        __syncthreads();
        {
            const int hh = tid >> 6, d = tid & 63;
            bf16_t* dst = vmt + (((size_t)b * 8 + hh) * 64 + d) * S + s0;
            const LAS bf16_t* src = vs + tid * 72; const int sx = (tid >> 3) & 7;
#pragma unroll
            for (int cc = 0; cc < 8; ++cc) *(u32x4*)(dst + cc * 8) = *(const LAS u32x4*)(src + ((cc ^ sx) << 3));
        }
        __syncthreads();
    }
}

__device__ const unsigned short UNIT_TYPES[256] = {63,127,62,126,61,125,527,591,655,719,783,847,911,975,60,124,59,123,58,122,57,121,56,120,526,590,654,718,782,846,910,974,55,119,54,118,53,117,52,116,51,115,525,589,653,717,781,845,909,973,50,114,49,113,48,112,47,111,524,588,652,716,780,844,908,972,46,110,45,109,44,108,43,107,523,587,651,715,779,843,907,971,42,106,41,105,40,104,39,103,38,102,522,586,650,714,778,842,906,970,37,101,36,100,35,99,34,98,33,97,521,585,649,713,777,841,905,969,32,96,31,95,30,94,520,584,648,712,776,840,904,968,29,93,28,92,27,91,26,90,25,89,519,583,647,711,775,839,903,967,24,88,23,87,22,86,21,85,20,84,518,582,646,710,774,838,902,966,19,83,18,82,17,81,16,80,15,79,517,581,645,709,773,837,901,965,14,78,13,77,12,76,516,580,644,708,772,836,900,964,11,75,10,74,9,73,8,72,515,579,643,707,771,835,899,963,7,71,6,70,5,69,514,578,642,706,770,834,898,962,4,68,3,67,513,577,641,705,769,833,897,961,2,66,1,65,0,64,512,576,640,704,768,832,896,960};
__device__ __forceinline__ int crow(int r, int hi) { return (r & 3) + 8 * (r >> 2) + 4 * hi; }
struct Flash { f32x16 o0, o1; float l; };
__device__ __forceinline__ void flash_init(Flash& st) {
#pragma unroll
    for (int r = 0; r < 16; ++r) { st.o0[r] = 0.f; st.o1[r] = 0.f; }
    st.l = 0.f;
}
constexpr int AL_K64 = 0, AL_V64 = 3 * 8192;
constexpr int AL_K96 = 0, AL_V96 = 3 * 16384;
constexpr int AL_IMP = 49152, AL_SELB = AL_IMP + 64 * 65 * 4, AL_UNI = AL_SELB + 512, AL_TL = AL_UNI + 64, AL_BL = AL_TL + 128, AL_OT = AL_BL + 4 * 132 * 4, AL_END = AL_OT + 8 * 32 * 64 * 4;
static_assert(AL_END <= 139264 && AL_V96 + 3 * 8192 <= 139264, "attention LDS");

template <int RB> struct DmaLane { unsigned g0, g1; };
template <int RB> __device__ __forceinline__ void dma_setup(DmaLane<RB>& L, int w, int lane, unsigned gs) {
    if (RB == 128) { const int r = 8 * w + (lane >> 3), c = (lane & 7) ^ ((r >> 1) & 7); L.g0 = (unsigned)r * gs + c * 16; L.g1 = 0; }
    else {
        { const int r = 8 * w + (lane >> 4); int c = (lane & 15) ^ (r & 15); c = c >= 12 ? c - 4 : c; L.g0 = (unsigned)r * gs + c * 16; }
        { const int r = 8 * w + 4 + (lane >> 4); int c = (lane & 15) ^ (r & 15); c = c >= 12 ? c - 4 : c; L.g1 = (unsigned)r * gs + c * 16; }
    }
}
template <int RB> __device__ __forceinline__ void dma_issue(const unsigned char* tile, const DmaLane<RB>& L, LAS unsigned char* buf, int w) {
    if (RB == 128) __builtin_amdgcn_global_load_lds((const unsigned*)(tile + L.g0), (LAS unsigned*)(buf + w * 1024), 16, 0, 0);
    else { __builtin_amdgcn_global_load_lds((const unsigned*)(tile + L.g0), (LAS unsigned*)(buf + w * 2048), 16, 0, 0);
           __builtin_amdgcn_global_load_lds((const unsigned*)(tile + L.g1), (LAS unsigned*)(buf + w * 2048 + 1024), 16, 0, 0); }
}
template <int DK> __device__ __forceinline__ void frag_offsets(unsigned (&kl)[DK / 16], unsigned (&vl)[4], int r32, int hi) {
#pragma unroll
    for (int s = 0; s < DK / 16; ++s) kl[s] = (DK == 64) ? (unsigned)(r32 * 128 + (((2 * s + hi) ^ ((r32 >> 1) & 7)) << 4)) : (unsigned)(r32 * 256 + (((2 * s + hi) ^ (r32 & 15)) << 4));
#pragma unroll
    for (int s = 0; s < 4; ++s) vl[s] = (unsigned)(r32 * 128 + (((2 * s + hi) ^ ((r32 >> 1) & 7)) << 4));
}

template <int DK, int KP, bool LANEMASK, class F>
__device__ __forceinline__ void tile_compute(Flash& st, const LAS unsigned char* Kt, const LAS unsigned char* Vt, const bf16x8* qf, const f32x16& negm, const unsigned (&kl)[DK / 16], const unsigned (&vl)[4], bool mine, F f) {
    constexpr int NS = DK / 16; constexpr int KH = 32 * KP;
    bf16x8 ka[NS], kh[NS];
#pragma unroll
    for (int s = 0; s < NS; ++s) ka[s] = *(const LAS bf16x8*)(Kt + kl[s]);
#pragma unroll
    for (int s = 0; s < NS; ++s) kh[s] = *(const LAS bf16x8*)(Kt + kl[s] + KH);
    __builtin_amdgcn_sched_barrier(0);
    f32x16 p0, p1;
#pragma unroll
    for (int s = 0; s < NS; ++s) p0 = (s == 0) ? __builtin_amdgcn_mfma_f32_32x32x16_bf16(ka[0], qf[0], negm, 0, 0, 0) : __builtin_amdgcn_mfma_f32_32x32x16_bf16(ka[s], qf[s], p0, 0, 0, 0);
#pragma unroll
    for (int s = 0; s < NS; ++s) p1 = (s == 0) ? __builtin_amdgcn_mfma_f32_32x32x16_bf16(kh[0], qf[0], negm, 0, 0, 0) : __builtin_amdgcn_mfma_f32_32x32x16_bf16(kh[s], qf[s], p1, 0, 0, 0);
    bf16x8 va[4], vh[4];
#pragma unroll
    for (int s = 0; s < 4; ++s) { va[s] = *(const LAS bf16x8*)(Vt + vl[s]); vh[s] = *(const LAS bf16x8*)(Vt + vl[s] + 4096); }
    __builtin_amdgcn_sched_barrier(0);
    float ls = 0.f;
    u32x4 w0, w1, w2, w3;
    {
#pragma unroll
        for (int r = 0; r < 16; ++r) { float x = p0[r]; const bool v = f(r, 0, x); const float e = fexp2(x); p0[r] = v ? e : 0.f; ls += p0[r]; }
        w0.x = cvtpk(p0[0], p0[1]); w0.y = cvtpk(p0[2], p0[3]); w0.z = cvtpk(p0[4], p0[5]); w0.w = cvtpk(p0[6], p0[7]);
        w1.x = cvtpk(p0[8], p0[9]); w1.y = cvtpk(p0[10], p0[11]); w1.z = cvtpk(p0[12], p0[13]); w1.w = cvtpk(p0[14], p0[15]);
        if (LANEMASK) { w0.x = mine ? w0.x : 0u; w0.y = mine ? w0.y : 0u; w0.z = mine ? w0.z : 0u; w0.w = mine ? w0.w : 0u; w1.x = mine ? w1.x : 0u; w1.y = mine ? w1.y : 0u; w1.z = mine ? w1.z : 0u; w1.w = mine ? w1.w : 0u; }
    }
#pragma unroll
    for (int s = 0; s < 2; ++s) {
        const bf16x8 pa = __builtin_bit_cast(bf16x8, s ? w1 : w0);
        st.o0 = __builtin_amdgcn_mfma_f32_32x32x16_bf16(pa, va[s], st.o0, 0, 0, 0);
        st.o1 = __builtin_amdgcn_mfma_f32_32x32x16_bf16(pa, vh[s], st.o1, 0, 0, 0);
    }
    {
#pragma unroll
        for (int r = 0; r < 16; ++r) { float x = p1[r]; const bool v = f(r, 1, x); const float e = fexp2(x); p1[r] = v ? e : 0.f; ls += p1[r]; }
        w2.x = cvtpk(p1[0], p1[1]); w2.y = cvtpk(p1[2], p1[3]); w2.z = cvtpk(p1[4], p1[5]); w2.w = cvtpk(p1[6], p1[7]);
        w3.x = cvtpk(p1[8], p1[9]); w3.y = cvtpk(p1[10], p1[11]); w3.z = cvtpk(p1[12], p1[13]); w3.w = cvtpk(p1[14], p1[15]);
        if (LANEMASK) { w2.x = mine ? w2.x : 0u; w2.y = mine ? w2.y : 0u; w2.z = mine ? w2.z : 0u; w2.w = mine ? w2.w : 0u; w3.x = mine ? w3.x : 0u; w3.y = mine ? w3.y : 0u; w3.z = mine ? w3.z : 0u; w3.w = mine ? w3.w : 0u; }
    }
    if (LANEMASK) ls = mine ? ls : 0.f;
    st.l += ls;
#pragma unroll
    for (int s = 2; s < 4; ++s) {
        const bf16x8 pa = __builtin_bit_cast(bf16x8, (s == 3) ? w3 : w2);
        st.o0 = __builtin_amdgcn_mfma_f32_32x32x16_bf16(pa, va[s], st.o0, 0, 0, 0);
        st.o1 = __builtin_amdgcn_mfma_f32_32x32x16_bf16(pa, vh[s], st.o1, 0, 0, 0);
    }
}
template <int DK, int KP> __device__ __forceinline__ void qk_tile(f32x16& p0, f32x16& p1, const LAS unsigned char* Kt, const bf16x8* qf, const f32x16& negm, const unsigned (&kl)[DK / 16]) {
#pragma unroll
    for (int s = 0; s < DK / 16; ++s) {
        const bf16x8 a0 = *(const LAS bf16x8*)(Kt + kl[s]);
        const bf16x8 a1 = *(const LAS bf16x8*)(Kt + kl[s] + 32 * KP);
        if (s == 0) { p0 = __builtin_amdgcn_mfma_f32_32x32x16_bf16(a0, qf[0], negm, 0, 0, 0); p1 = __builtin_amdgcn_mfma_f32_32x32x16_bf16(a1, qf[0], negm, 0, 0, 0); }
        else { p0 = __builtin_amdgcn_mfma_f32_32x32x16_bf16(a0, qf[s], p0, 0, 0, 0); p1 = __builtin_amdgcn_mfma_f32_32x32x16_bf16(a1, qf[s], p1, 0, 0, 0); }
    }
}
template <bool FIRST> __device__ __forceinline__ void flash_accum(LAS float* otl, const Flash& st, float gate, int hi, int lane) {
    const float lt = st.l + __shfl_xor(st.l, 32);
    const float f = lt > 0.f ? gate * frcp(lt) : 0.f;
#pragma unroll
    for (int r = 0; r < 16; ++r) { const float fr_ = __shfl(f, crow(r, hi));
        if (FIRST) { otl[r * 64 + lane] = fr_ * st.o0[r]; otl[(16 + r) * 64 + lane] = fr_ * st.o1[r]; }
        else { otl[r * 64 + lane] += fr_ * st.o0[r]; otl[(16 + r) * 64 + lane] += fr_ * st.o1[r]; } }
}
template <int NS> __device__ __forceinline__ float qnorm2(const bf16x8* qf) {
    float s = 0.f;
#pragma unroll
    for (int i = 0; i < NS; ++i)
#pragma unroll
        for (int j = 0; j < 8; ++j) { const float x = bf2f((bf16_t)qf[i][j]); s += x * x; }
    return s + __shfl_xor(s, 32);
}
__device__ __forceinline__ float wmax(float v) {
#pragma unroll
    for (int o = 1; o < 64; o <<= 1) v = fmaxf(v, __shfl_xor(v, o));
    return v;
}

template <int RBK, bool HASV, int KOFF, int KSZ, int VOFF, class SrcK, class SrcV, class Comp>
__device__ __forceinline__ void run_tiles(int n, LAS unsigned char* lds, int w, int lane, unsigned gsK, unsigned gsV, SrcK srcK, SrcV srcV, Comp comp) {
    DmaLane<RBK> LK; dma_setup<RBK>(LK, w, lane, gsK);
    DmaLane<128> LV; LV.g0 = 0; LV.g1 = 0; if (HASV) dma_setup<128>(LV, w, lane, gsV);
    const int nl = n - 1, t1 = nl < 1 ? nl : 1;
    dma_issue<RBK>(srcK(0), LK, lds + KOFF, w); if (HASV) dma_issue<128>(srcV(0), LV, lds + VOFF, w);
    dma_issue<RBK>(srcK(t1), LK, lds + KOFF + KSZ, w); if (HASV) dma_issue<128>(srcV(t1), LV, lds + VOFF + 8192, w);
    constexpr int P = (RBK == 128 ? 1 : 2) + (HASV ? 1 : 0);
#define RT_STEP(bi, ii) do { const int i_ = (ii); \
        if (P == 1) asm volatile("s_waitcnt vmcnt(1)" ::: "memory"); else if (P == 2) asm volatile("s_waitcnt vmcnt(2)" ::: "memory"); else asm volatile("s_waitcnt vmcnt(3)" ::: "memory"); \
        __builtin_amdgcn_s_barrier(); asm volatile("" ::: "memory"); \
        { const int tn = (i_ + 2 < nl) ? i_ + 2 : nl; constexpr int b2 = ((bi) + 2) % 3; \
          dma_issue<RBK>(srcK(tn), LK, lds + KOFF + b2 * KSZ, w); if (HASV) dma_issue<128>(srcV(tn), LV, lds + VOFF + b2 * 8192, w); } \
        if (i_ < n) comp(i_, lds + KOFF + (bi) * KSZ, lds + VOFF + (bi) * 8192); } while (0)
    for (int i = 0; i < n; i += 3) { RT_STEP(0, i); RT_STEP(1, i + 1); RT_STEP(2, i + 2); }
#undef RT_STEP
    asm volatile("s_waitcnt vmcnt(0)" ::: "memory");
    __syncthreads();
}

__device__ __forceinline__ void mla_unit(const Params& p, LAS unsigned char* lds, int b, int h, int qb) {
    int tid = threadIdx.x; asm volatile("" : "+v"(tid));
    const int lane = tid & 63, w = __builtin_amdgcn_readfirstlane(tid >> 6), r32 = lane & 31, hi = lane >> 5;
    const bf16_t* qm = (const bf16_t*)((const unsigned char*)p.out + O_QM);
    const unsigned char* km = (const unsigned char*)p.out + O_KM + (((size_t)b * 8 + h) * S) * 192;
    const unsigned char* vmt = (const unsigned char*)p.out + O_VMT + (((size_t)b * 8 + h) * 64) * (size_t)S * 2;
    bf16_t* ocat = (bf16_t*)(p.ws + R_XN);
    const int tq = qb * 256 + 32 * w + r32;
    bf16x8 qf[6];
#pragma unroll
    for (int s = 0; s < 6; ++s) qf[s] = *(const bf16x8*)(qm + (((size_t)b * S + tq) * 8 + h) * 96 + 16 * s + 8 * hi);
    const float kn = 9.797958971f * 1.01f * wmax(fmaxf(fabsf(p.in[14][lane]), lane < 32 ? fabsf(p.in[14][64 + lane]) : 0.f));
    const float mref = sqrtf(qnorm2<6>(qf)) * kn;
    f32x16 negm;
#pragma unroll
    for (int r = 0; r < 16; ++r) negm[r] = -mref;
    Flash st; flash_init(st);
    const int ntile = 4 * qb + 4, dt = 4 * qb + (w >> 1);
#ifdef PROF_SEL
    if (b == 0 && h == 0 && qb == 15 && threadIdx.x == 0) { *PROF_SLOT(36) -= __builtin_amdgcn_s_memtime(); *PROF_SLOT(37) -= __builtin_amdgcn_s_memrealtime(); }
#endif
    unsigned kl[6], vl[4]; frag_offsets<96>(kl, vl, r32, hi);
    run_tiles<192, true, AL_K96, 16384, AL_V96>(ntile, lds, w, lane, 192u, (unsigned)(S * 2),
        [&](int i) { return km + (size_t)i * 64 * 192; }, [&](int i) { return vmt + (size_t)i * 128; },
        [&](int i, LAS unsigned char* kb, LAS unsigned char* vb) {
            if (i <= dt) {
                if (i < dt) tile_compute<96, 256, false>(st, kb, vb, qf, negm, kl, vl, true, [&](int r, int half, float& x) { return true; });
                else { const int kb0 = 64 * i + 4 * hi; tile_compute<96, 256, false>(st, kb, vb, qf, negm, kl, vl, true, [&](int r, int half, float& x) { return (kb0 + 32 * half + (r & 3) + 8 * (r >> 2)) <= tq; }); }
            }
        });
#ifdef PROF_SEL
    if (b == 0 && h == 0 && qb == 15 && threadIdx.x == 0) { *PROF_SLOT(36) += __builtin_amdgcn_s_memtime(); *PROF_SLOT(37) += __builtin_amdgcn_s_memrealtime(); }
#endif
    {
        const float lt = st.l + __shfl_xor(st.l, 32); const float f = lt > 0.f ? frcp(lt) : 0.f;
#pragma unroll
        for (int r = 0; r < 16; ++r) { const float fr_ = __shfl(f, crow(r, hi)); const size_t ro = ((size_t)b * S + qb * 256 + 32 * w + crow(r, hi)) * 1024 + 512 + h * 64 + r32; ocat[ro] = f2bf(st.o0[r] * fr_); ocat[ro + 32] = f2bf(st.o1[r] * fr_); }
    }
}

__device__ __forceinline__ void nsa_unit(const Params& p, LAS unsigned char* lds, int b, int g, int jt) {
    int tid = threadIdx.x; asm volatile("" : "+v"(tid));
    const int lane = tid & 63, w = __builtin_amdgcn_readfirstlane(tid >> 6), r32 = lane & 31, hi = lane >> 5;
    const int rh = w >> 1, qh = w & 1, h = 4 * g + rh, q0 = 64 * jt, ql = 32 * qh + r32, tq = q0 + ql;
    const unsigned char* xa = p.ws + R_XA;
    const bf16_t* qn = (const bf16_t*)(xa + A_QN);
    const size_t bg = (size_t)b * 2 + g;
    const unsigned char* ksn = xa + A_KSN + bg * S * 128; const unsigned char* kwn = xa + A_KWN + bg * S * 128;
    const unsigned char* vst = xa + A_VST + bg * 64 * (size_t)S * 2; const unsigned char* vwt = xa + A_VWT + bg * 64 * (size_t)S * 2;
    const unsigned char* kc = p.ws + SM_KC + bg * 256 * 128; const unsigned char* vct = p.ws + SM_VCT + bg * 64 * 512;
    const float* gates = (const float*)(xa + A_GATES) + ((size_t)b * S + tq) * 24 + h * 3;
    bf16_t* ocat = (bf16_t*)(p.ws + R_XN);
    LAS float* imp = (LAS float*)(lds + AL_IMP); LAS unsigned char* selb = lds + AL_SELB; LAS unsigned* uni = (LAS unsigned*)(lds + AL_UNI); LAS unsigned char* tl = lds + AL_TL; LAS float* bls = (LAS float*)(lds + AL_BL);
    const float* blg = (const float*)(p.ws + SM_BL) + h * 132;
    const float cb = blg[128];
    const float bmax = wmax(fmaxf(fmaxf(blg[lane], blg[64 + lane]), cb));
    if (qh == 0) { bls[rh * 132 + lane] = blg[lane] - cb; bls[rh * 132 + 64 + lane] = blg[64 + lane] - cb; if (lane == 0) bls[rh * 132 + 128] = 0.f; }
    const LAS float* blh = bls + rh * 132;
    bf16x8 qf[4];
#pragma unroll
    for (int s = 0; s < 4; ++s) qf[s] = *(const bf16x8*)(qn + (((size_t)b * S + tq) * 8 + h) * 64 + 16 * s + 8 * hi);
    const float kn = 8.f * 1.01f * wmax(fmaxf(fmaxf(fabsf(p.in[5][lane]), fabsf(p.in[5][64 + lane])), fabsf(p.in[5][128 + lane])));
    const float mref = sqrtf(qnorm2<4>(qf)) * kn + bmax;
    f32x16 negm;
#pragma unroll
    for (int r = 0; r < 16; ++r) negm[r] = cb - mref;
    float g0 = gates[0], g1 = gates[1], g2 = gates[2];
    if (p.dbg_branch >= 0) { g0 = p.dbg_branch == 0 ? 1.f : 0.f; g1 = p.dbg_branch == 1 ? 1.f : 0.f; g2 = p.dbg_branch == 2 ? 1.f : 0.f; }
    LAS float* otl = (LAS float*)(lds + AL_OT) + w * 2048;
#ifdef PROF_SEL
    if (b == 0 && g == 0 && jt == 63 && threadIdx.x == 0) *PROF_SLOT(48) -= __builtin_amdgcn_s_memtime();
#endif
    const int nvmax = (q0 + 63 - 31) / 16 + 1, ntc = (nvmax + 63) / 64;
    Flash st; flash_init(st);
    unsigned kl[4], vl[4]; frag_offsets<64>(kl, vl, r32, hi);
    run_tiles<128, true, AL_K64, 8192, AL_V64>(ntc, lds, w, lane, 128u, 512u,
        [&](int i) { return kc + (size_t)i * 64 * 128; }, [&](int i) { return vct + (size_t)i * 128; },
        [&](int i, LAS unsigned char* kb, LAS unsigned char* vb) {
            const int cb0 = 64 * i + 4 * hi;
            if (q0 + 32 * qh - (16 * (64 * i + 63) + 31) >= 128) tile_compute<64, 128, false>(st, kb, vb, qf, negm, kl, vl, true, [&](int r, int half, float& x) { return true; });
            else tile_compute<64, 128, false>(st, kb, vb, qf, negm, kl, vl, true, [&](int r, int half, float& x) {
                const int c = cb0 + 32 * half + (r & 3) + 8 * (r >> 2); const int dist = tq - 16 * c - 31; x += blh[dist < 0 ? 0 : (dist > 128 ? 128 : dist)]; return dist >= 0; });
        });
    flash_accum<true>(otl, st, g0, hi, lane);
    unsigned mlo, mhi;
    int nsel;
    if (jt < 16) { const unsigned long long mk = (1ull << (jt + 1)) - 1ull; mlo = (unsigned)mk; mhi = (unsigned)(mk >> 32); nsel = jt + 1; if (tid <= jt) tl[tid] = (unsigned char)tid; }
    else {
        for (int i = tid; i < 64 * 65; i += 512) imp[i] = 0.f;
        const float lt = st.l + __shfl_xor(st.l, 32); const float linv = lt > 0.f ? frcp(lt) : 0.f;
        float xlast = 0.f;
        run_tiles<128, false, AL_K64, 8192, AL_V64>(ntc, lds, w, lane, 128u, 0u,
            [&](int i) { return kc + (size_t)i * 64 * 128; }, [&](int i) { return kc; },
            [&](int i, LAS unsigned char* kb, LAS unsigned char* vb) {
                f32x16 p0, p1; qk_tile<64, 128>(p0, p1, kb, qf, negm, kl);
                const int cb0 = 64 * i + 4 * hi;
                float sm[2][4], cr[2][4];
#pragma unroll
                for (int half = 0; half < 2; ++half)
#pragma unroll
                    for (int a = 0; a < 4; ++a) {
                        float s4 = 0.f, last = 0.f;
#pragma unroll
                        for (int k = 0; k < 4; ++k) {
                            const int r = 4 * a + k; const int c = cb0 + 32 * half + k + 8 * a; const int dist = tq - 16 * c - 31;
                            const float sc = (half ? p1[r] : p0[r]) + blh[dist < 0 ? 0 : (dist > 128 ? 128 : dist)];
                            const float pv = dist >= 0 ? fexp2(sc) * linv : 0.f;
                            s4 += pv; last = pv;
                        }
                        sm[half][a] = s4; cr[half][a] = last;
                    }
                float tot[2][4];
#pragma unroll
                for (int half = 0; half < 2; ++half)
#pragma unroll
                    for (int a = 0; a < 4; ++a) {
                        const float xs_ = __shfl_xor(cr[half][a], 32);
                        const float xp_ = (a > 0) ? __shfl_xor(cr[half][a > 0 ? a - 1 : 0], 32) : (half ? __shfl_xor(cr[0][3], 32) : xlast);
                        tot[half][a] = sm[half][a] + (hi ? xs_ : xp_);
                    }
                xlast = __shfl_xor(cr[1][3], 32);
                for (int rr = 0; rr < 4; ++rr) {
                    if (rh == rr) {
#pragma unroll
                        for (int half = 0; half < 2; ++half)
#pragma unroll
                            for (int a = 0; a < 4; ++a) { const int j = 16 * i + 8 * half + 2 * a + hi; imp[ql * 65 + j] += tot[half][a]; }
                    }
                    __syncthreads();
                }
            });
        if (p.dbg_branch == 1) { for (int i = tid; i < 4096; i += 512) ((float*)(p.ws + R_H))[((size_t)g * S + q0 + (i >> 6)) * 64 + (i & 63)] = imp[(i >> 6) * 65 + (i & 63)]; }
        {
            const int q = tid >> 3, jg = tid & 7;
            float vj[8]; int rk[8];
#pragma unroll
            for (int jj = 0; jj < 8; ++jj) { const int j = jg * 8 + jj; const float x = imp[q * 65 + j]; vj[jj] = (j > jt) ? -1.f : ((j == jt || j == 0) ? 1e9f : x); rk[jj] = 0; }
#pragma unroll 4
            for (int i = 0; i < 64; ++i) {
                const float xi = imp[q * 65 + i]; const float vi = (i > jt) ? -1.f : ((i == jt || i == 0) ? 1e9f : xi);
#pragma unroll
                for (int jj = 0; jj < 8; ++jj) rk[jj] += (vi > vj[jj] || (vi == vj[jj] && i < jg * 8 + jj)) ? 1 : 0;
            }
            unsigned byte = 0;
#pragma unroll
            for (int jj = 0; jj < 8; ++jj) if (jg * 8 + jj <= jt && rk[jj] < 16) byte |= 1u << jj;
            selb[q * 8 + jg] = (unsigned char)byte;
        }
        __syncthreads();
        if (w == 0) {
            unsigned a = ((const LAS unsigned*)selb)[lane * 2], c = ((const LAS unsigned*)selb)[lane * 2 + 1];
#pragma unroll
            for (int o = 1; o < 64; o <<= 1) { a |= __shfl_xor(a, o); c |= __shfl_xor(c, o); }
            const unsigned long long um = ((unsigned long long)c << 32) | a;
            if ((um >> lane) & 1ull) tl[__builtin_popcountll(um & ((1ull << lane) - 1ull))] = (unsigned char)lane;
            if (lane == 0) uni[0] = (unsigned)__builtin_popcountll(um);
        }
        __syncthreads();
        mlo = ((const LAS unsigned*)selb)[ql * 2]; mhi = ((const LAS unsigned*)selb)[ql * 2 + 1];
        nsel = (int)uni[0];
    }
    if (p.dbg_branch == 1 && rh == 0) { if (hi == 0) ((unsigned long long*)(p.ws + R_H + 4 * 1048576))[(size_t)g * S + tq] = ((unsigned long long)mhi << 32) | mlo; }
    __syncthreads();
    {
        const unsigned long long mymask = ((unsigned long long)mhi << 32) | mlo;
        nsel = __builtin_amdgcn_readfirstlane(nsel);
        const int mytl = (int)tl[lane];
        flash_init(st);
        run_tiles<128, true, AL_K64, 8192, AL_V64>(nsel, lds, w, lane, 128u, (unsigned)(S * 2),
            [&](int i) { return ksn + (size_t)__builtin_amdgcn_readlane(mytl, i) * 64 * 128; }, [&](int i) { return vst + (size_t)__builtin_amdgcn_readlane(mytl, i) * 128; },
            [&](int i, LAS unsigned char* kb, LAS unsigned char* vb) {
                const int j = __builtin_amdgcn_readlane(mytl, i);
                const bool mine = (mymask >> j) & 1ull;
                if (q0 + 32 * qh - (64 * j + 63) >= 128) tile_compute<64, 128, true>(st, kb, vb, qf, negm, kl, vl, mine, [&](int r, int half, float& x) { return true; });
                else { const int kb0 = 64 * j + 4 * hi;
                    tile_compute<64, 128, true>(st, kb, vb, qf, negm, kl, vl, mine, [&](int r, int half, float& x) { const int dist = tq - (kb0 + 32 * half + (r & 3) + 8 * (r >> 2)); x += blh[dist < 0 ? 0 : (dist > 128 ? 128 : dist)]; return dist >= 0; }); }
            });
        flash_accum<false>(otl, st, g1, hi, lane);
    }
    {
        const int j0 = jt >= 8 ? jt - 8 : 0, nw = jt - j0 + 1;
        flash_init(st);
        run_tiles<128, true, AL_K64, 8192, AL_V64>(nw, lds, w, lane, 128u, (unsigned)(S * 2),
            [&](int i) { return kwn + (size_t)(j0 + i) * 64 * 128; }, [&](int i) { return vwt + (size_t)(j0 + i) * 128; },
            [&](int i, LAS unsigned char* kb, LAS unsigned char* vb) {
                const int j = j0 + i, kb0 = 64 * j + 4 * hi;
                if (q0 + 32 * qh - (64 * j + 63) >= 128 && q0 + 32 * qh + 31 - 64 * j < 512) tile_compute<64, 128, false>(st, kb, vb, qf, negm, kl, vl, true, [&](int r, int half, float& x) { return true; });
                else tile_compute<64, 128, false>(st, kb, vb, qf, negm, kl, vl, true, [&](int r, int half, float& x) { const int dist = tq - (kb0 + 32 * half + (r & 3) + 8 * (r >> 2)); x += blh[dist < 0 ? 0 : (dist > 128 ? 128 : dist)]; return dist >= 0 && dist < 512; });
            });
        flash_accum<false>(otl, st, g2, hi, lane);
    }
#pragma unroll
    for (int r = 0; r < 16; ++r) { const size_t ro = ((size_t)b * S + q0 + 32 * qh + crow(r, hi)) * 1024 + h * 64 + r32; ocat[ro] = f2bf(otl[r * 64 + lane]); ocat[ro + 32] = f2bf(otl[(16 + r) * 64 + lane]); }
    __syncthreads();
#ifdef PROF_SEL
    if (b == 0 && g == 0 && jt == 63 && threadIdx.x == 0) *PROF_SLOT(48) += __builtin_amdgcn_s_memtime();
#endif
}

__device__ __forceinline__ void phase_p4(const Params& p, LAS unsigned char* lds) {
    const int G = gridDim.x, c = blockIdx.x, nunits = 256 * NB;
#if NB == 8
    if (G == 256) {
        const int b = c & 7, idx = c >> 3, pi = idx & 7, hq = idx >> 3;
#pragma unroll 1
        for (int u = 0; u < 8; ++u) {
            if (u == (idx & 7)) { convert_weights(p, lds, WD_EARLY, 14); __syncthreads(); }
            if (u < 4) { const int ix = (u >> 1) ? ((idx + 16) & 31) : idx;
                nsa_unit(p, lds, b, u >> 1, (u & 1) ? ix : 63 - ix); }
            else mla_unit(p, lds, b, ((u - 4) >> 1) * 4 + hq, (u & 1) ? pi : 15 - pi);
        }
        return;
    }
#endif
    convert_weights(p, lds, WD_EARLY, 14); __syncthreads();
    for (int j = 0;; ++j) {
        const int k = j * G + ((j & 1) ? (G - 1 - c) : c);
        if (j * G >= nunits) break;
        if (k >= nunits) continue;
        const int ty = UNIT_TYPES[k / NB], b = k % NB, kind = ty >> 9, a = (ty >> 6) & 7, cc = ty & 63;
        if (kind == 0) nsa_unit(p, lds, b, a, cc); else mla_unit(p, lds, b, a, cc);
    }
}
__device__ __forceinline__ void phase_norm(const float* x, const float* g, bf16_t* xn) {
    const int tid_ = ltid(); const int lane = tid_ & 63, gw = blockIdx.x * 8 + (tid_ >> 6), NGW = gridDim.x * 8;
    for (int m = gw; m < T; m += NGW) rms_row_to_bf16(x + (size_t)m * D, g, xn + (size_t)m * D, lane);
}
__device__ __forceinline__ void phase_conv(const Params& p) {
    const int tid = ltid(), lane = tid & 63, gw = blockIdx.x * 8 + (tid >> 6), NGW = gridDim.x * 8;
    const bf16_t* bg = (const bf16_t*)(p.ws + R_H); const bf16_t* cu = (const bf16_t*)(p.ws + R_H + (size_t)T * 2048); bf16_t* v = (bf16_t*)(p.ws + R_XA); const float* cw = p.in[22];
    constexpr int RUN = 16;
    float w0[2][8], w1[2][8], w2[2][8];
#pragma unroll
    for (int j = 0; j < 2; ++j) { const int d = 8 * lane + 512 * j; load8f(cw + d, w0[j], 1.f); load8f(cw + 1024 + d, w1[j], 1.f); load8f(cw + 2048 + d, w2[j], 1.f); }
    for (int run = gw; run < T / RUN; run += NGW) {
        const int m0 = run * RUN, s0 = m0 & (S - 1);
        float pm2[2][8], pm1[2][8];
#pragma unroll
        for (int j = 0; j < 2; ++j) { const int d = 8 * lane + 512 * j;
#pragma unroll
            for (int q = 0; q < 2; ++q) {
                float (&dst)[8] = q ? pm1[j] : pm2[j];
                if (s0 - 2 + q >= 0) unpack8(*(const u32x4*)(cu + (size_t)(m0 - 2 + q) * 1024 + d), dst);
                else {
#pragma unroll
                    for (int i = 0; i < 8; ++i) dst[i] = 0.f; }
            } }
#pragma unroll 4
        for (int rr = 0; rr < RUN; ++rr) {
            const int m = m0 + rr;
#pragma unroll
            for (int j = 0; j < 2; ++j) { const int d = 8 * lane + 512 * j;
                float b[8], c[8], y[8]; unpack8(*(const u32x4*)(bg + (size_t)m * 1024 + d), b); unpack8(*(const u32x4*)(cu + (size_t)m * 1024 + d), c);
#pragma unroll
                for (int i = 0; i < 8; ++i) { y[i] = b[i] * (w0[j][i] * pm2[j][i] + w1[j][i] * pm1[j][i] + w2[j][i] * c[i]); pm2[j][i] = pm1[j][i]; pm1[j][i] = c[i]; }
                *(u32x4*)(v + (size_t)m * 1024 + d) = pack8(y); }
        }
    }
}
__device__ __forceinline__ void phase_norm_router(const Params& p, LAS unsigned char* lds) {
    const int tid = ltid(), lane = tid & 63, wave = tid >> 6, gw = blockIdx.x * 8 + wave, NGW = gridDim.x * 8;
    const bf16_t* x3 = (const bf16_t*)(p.ws + R_XN); const float* g = p.in[24]; bf16_t* xn = (bf16_t*)(p.ws + R_XA);
    LAS float* wr = (LAS float*)lds;
    LAS int* lcnt = (LAS int*)(lds + 40960); LAS int* gb = lcnt + 8;
    int* te = (int*)(p.ws + SM_TE); float* tw = (float*)(p.ws + SM_TW); int* rank = (int*)(p.ws + SM_RANK); int* cnt = (int*)(p.ws + SM_CTL);
    for (int i = tid; i < 8192; i += 512) { const int dd = i >> 3; wr[dd * 8 + (dd >> 2) * 4 + (i & 7)] = p.in[25][i]; }
    if (tid < 8) lcnt[tid] = 0;
    __syncthreads();
    u32x2 nx[4];
#pragma unroll
    for (int j = 0; j < 4; ++j) nx[j] = ((const u32x2*)(x3 + (size_t)(gw < T ? gw : 0) * D) + lane)[64 * j];
    for (int m = gw; m < T; m += NGW) {
        const f32x4* gr = (const f32x4*)g + lane;
        f32x4 v[4]; float s = 0.f;
#pragma unroll
        for (int j = 0; j < 4; ++j) { const u32x2 t = nx[j]; v[j] = (f32x4){bflo(t.x), bfhi(t.x), bflo(t.y), bfhi(t.y)}; s += (v[j].x * v[j].x + v[j].y * v[j].y) + (v[j].z * v[j].z + v[j].w * v[j].w); }
        { const int mn = m + NGW < T ? m + NGW : m;
#pragma unroll
            for (int j = 0; j < 4; ++j) nx[j] = ((const u32x2*)(x3 + (size_t)mn * D) + lane)[64 * j]; }
        const float r = rsqrtf(wsum(s) * (1.f / 1024.f) + EPS);
        float lg[8];
#pragma unroll
        for (int e = 0; e < 8; ++e) lg[e] = 0.f;
        u32x2* o8 = (u32x2*)(xn + (size_t)m * D) + lane;
#pragma unroll
        for (int j = 0; j < 4; ++j) { const f32x4 gg = gr[64 * j]; const f32x4 y = {v[j].x * r * gg.x, v[j].y * r * gg.y, v[j].z * r * gg.z, v[j].w * r * gg.w};
            u32x2 w; w.x = cvtpk(y.x, y.y); w.y = cvtpk(y.z, y.w); o8[64 * j] = w;
#pragma unroll
            for (int i = 0; i < 4; ++i) { const int d = 4 * lane + 256 * j + i; const f32x4 w0 = *(const LAS f32x4*)(wr + d * 8 + (d >> 2) * 4), w1 = *(const LAS f32x4*)(wr + d * 8 + (d >> 2) * 4 + 4);
                lg[0] += y[i] * w0.x; lg[1] += y[i] * w0.y; lg[2] += y[i] * w0.z; lg[3] += y[i] * w0.w; lg[4] += y[i] * w1.x; lg[5] += y[i] * w1.y; lg[6] += y[i] * w1.z; lg[7] += y[i] * w1.w; } }
#pragma unroll
        for (int e = 0; e < 8; ++e) lg[e] = wsum(lg[e]) + p.in[26][e];
        int e1 = 0; float l1 = lg[0];
#pragma unroll
        for (int e = 1; e < 8; ++e) if (lg[e] > l1) { l1 = lg[e]; e1 = e; }
        int e2 = -1; float l2 = -3e38f;
#pragma unroll
        for (int e = 0; e < 8; ++e) if (e != e1 && lg[e] > l2) { l2 = lg[e]; e2 = e; }
        if (lane == 0) {
            const float w1 = 1.f / (1.f + __expf(l2 - l1));
            te[m * 2] = e1; te[m * 2 + 1] = e2; tw[m * 2] = w1; tw[m * 2 + 1] = 1.f - w1;
            rank[m * 2] = __hip_atomic_fetch_add(&lcnt[e1], 1, __ATOMIC_RELAXED, __HIP_MEMORY_SCOPE_WORKGROUP); rank[m * 2 + 1] = __hip_atomic_fetch_add(&lcnt[e2], 1, __ATOMIC_RELAXED, __HIP_MEMORY_SCOPE_WORKGROUP);
        }
    }
    __syncthreads();
    if (tid < 8) gb[tid] = atomicAdd(&cnt[tid], lcnt[tid]);
    __syncthreads();
    for (int m = gw; m < T; m += NGW) if (lane < 2) rank[m * 2 + lane] += gb[te[m * 2 + lane]];
}
__device__ __forceinline__ void phase_moe_gather(const Params& p) {
    const int tid = ltid(), lane = tid & 63, gw = blockIdx.x * 8 + (tid >> 6), NGW = gridDim.x * 8;
    const int* cnt = (const int*)(p.ws + SM_CTL); const int* te = (const int*)(p.ws + SM_TE); const float* tw = (const float*)(p.ws + SM_TW); const int* rank = (const int*)(p.ws + SM_RANK);
    int* pos = (int*)(p.ws + SM_POS); float* roww = (float*)(p.ws + SM_ROWW); int* tile_e = (int*)(p.ws + SM_TILEE);
    int* rowtok = (int*)(p.ws + SM_ROWTOK);
    int off[9]; off[0] = 0;
#pragma unroll
    for (int e = 0; e < 8; ++e) off[e + 1] = off[e] + ((cnt[e] + 255) & ~255);
    if (blockIdx.x == 0) {
        for (int i = tid; i < ROWS_MAX / 256; i += 512) { int e = -1;
#pragma unroll
            for (int k = 0; k < 8; ++k) if (i * 256 >= off[k] && i * 256 < off[k + 1]) e = k;
            tile_e[i] = e < 0 ? 0 : e; }
        if (tid == 0) ((int*)(p.ws + SM_CTL))[8] = off[8];
    }
    if (blockIdx.x < 8 && tid < 256) {
#pragma unroll
        for (int e = 0; e < 8; ++e) if (e == (int)blockIdx.x) { const int c = cnt[e]; if (c + tid < off[e + 1] - off[e]) { roww[off[e] + c + tid] = 0.f; rowtok[off[e] + c + tid] = -1; } }
    }
    for (int pi0 = gw * 4; pi0 < 2 * T; pi0 += NGW * 4) {
        int r[4]; float w[4];
#pragma unroll
        for (int q = 0; q < 4; ++q) { const int e = te[pi0 + q]; int o = 0;
#pragma unroll
            for (int k = 0; k < 8; ++k) if (k == e) o = off[k];
            r[q] = o + rank[pi0 + q]; w[q] = tw[pi0 + q]; }
#pragma unroll
        for (int q = 0; q < 4; ++q) if (lane == q) { pos[pi0 + q] = r[q]; roww[r[q]] = w[q]; rowtok[r[q]] = (pi0 + q) >> 1; }
    }
}
__device__ __forceinline__ void phase_moe_combine(const Params& p) {
    const int tid_ = ltid(); const int lane = tid_ & 63, gw = blockIdx.x * 8 + (tid_ >> 6), NGW = gridDim.x * 8;
    const int* pos = (const int*)(p.ws + SM_POS); const bf16_t* ym = (const bf16_t*)(p.ws + R_XA); const bf16_t* x3 = (const bf16_t*)(p.ws + R_XN);
    for (int m0 = gw * 2; m0 < T; m0 += NGW * 2) {
        int ps[4];
#pragma unroll
        for (int q = 0; q < 4; ++q) ps[q] = pos[m0 * 2 + q];
        f32x4 x[2][4]; u32x2 ya[2][4], yc[2][4];
#pragma unroll
        for (int q = 0; q < 2; ++q)
#pragma unroll
            for (int j = 0; j < 4; ++j) { const int d = 4 * lane + 256 * j;
                { const u32x2 t = *(const u32x2*)(x3 + (size_t)(m0 + q) * D + d); x[q][j] = (f32x4){bflo(t.x), bfhi(t.x), bflo(t.y), bfhi(t.y)}; } ya[q][j] = *(const u32x2*)(ym + (size_t)ps[2 * q] * D + d); yc[q][j] = *(const u32x2*)(ym + (size_t)ps[2 * q + 1] * D + d); }
#pragma unroll
        for (int q = 0; q < 2; ++q)
#pragma unroll
            for (int j = 0; j < 4; ++j) { const int d = 4 * lane + 256 * j; f32x4 o = x[q][j]; const u32x2 a = ya[q][j], c = yc[q][j];
                o.x += bflo(a.x) + bflo(c.x); o.y += bfhi(a.x) + bfhi(c.x); o.z += bflo(a.y) + bflo(c.y); o.w += bfhi(a.y) + bfhi(c.y);
                *(f32x4*)(p.out + (size_t)(m0 + q) * D + d) = o; }
    }
}

#define XB_TMO      128
#define XB_XCNT(j)  (256  + 64 * (j))
#define XB_XSUB(j)  (1280 + 64 * (j))
#define XB_XGEN(j)  (2304 + 64 * (j))
#define XB_TOP      3328
#define XB_TOPGEN   3392
#define XCD_BAR_WORDS 3456
#define XB_SPIN_CAP (1u << 18)

__device__ __forceinline__ unsigned xb_ld(unsigned* p)              { return __hip_atomic_load(p, __ATOMIC_RELAXED, __HIP_MEMORY_SCOPE_AGENT); }
__device__ __forceinline__ unsigned xb_add(unsigned* p, unsigned v) { return __hip_atomic_fetch_add(p, v, __ATOMIC_RELAXED, __HIP_MEMORY_SCOPE_AGENT); }
__device__ __forceinline__ unsigned xb_xcc_id() { return (unsigned)__builtin_amdgcn_s_getreg((3 << 11) | 20) & 0xFu; }
#define XB_SPIN(cond, bar) do { unsigned _sp = 0; while (cond) { __builtin_amdgcn_s_sleep(1); \
    if ((++_sp & 255u) == 0u) { if (xb_ld(&(bar)[XB_TMO])) break; if (_sp > XB_SPIN_CAP) { atomicAdd(&(bar)[XB_TMO], 1u); break; } } } } while (0)

struct XcdBarrier {
    unsigned* bar; unsigned x;
    volatile LAS unsigned* st;
};

__device__ __forceinline__ XcdBarrier xcd_barrier_post(unsigned* bar, volatile LAS unsigned* st) {
    XcdBarrier b; b.bar = bar; b.x = xb_xcc_id(); b.st = st;
    if (threadIdx.x == 0) (void)xb_add(&bar[XB_XCNT(b.x)], 1u);
    return b;
}
__device__ __forceinline__ void xcd_barrier_complete(unsigned* bar, unsigned x, unsigned& nloc, unsigned& nx) {
    const unsigned G = gridDim.x * gridDim.y * gridDim.z;
    unsigned sum, cnt, mine, sp = 0u;
    for (;;) {
        sum = 0u; cnt = 0u; mine = 0u;
#pragma unroll
        for (unsigned j = 0; j < 16; ++j) { const unsigned c = xb_ld(&bar[XB_XCNT(j)]); sum += c; cnt += (c > 0u) ? 1u : 0u; mine = (j == x) ? c : mine; }
        if (sum == G) break;
        __builtin_amdgcn_s_sleep(1);
        if ((++sp & 255u) == 0u) { if (xb_ld(&bar[XB_TMO])) break; if (sp > XB_SPIN_CAP) { atomicAdd(&bar[XB_TMO], 1u); break; } }
    }
    nloc = mine > 0u ? mine : 1u; nx = cnt > 0u ? cnt : 1u;
}

__device__ __forceinline__ void xcd_barrier(const XcdBarrier& b) {
    asm volatile("s_waitcnt vmcnt(0)" ::: "memory");
    __syncthreads();
    if (threadIdx.x == 0) {
        unsigned* bar = b.bar;
        __builtin_amdgcn_s_waitcnt(0);
        unsigned nloc = b.st[0], nx = b.st[1];
        if (nloc == 0u) { xcd_barrier_complete(bar, b.x, nloc, nx); b.st[0] = nloc; b.st[1] = nx; }
        const unsigned old = xb_add(&bar[XB_XSUB(b.x)], 1u);
        const unsigned gen = old / nloc;
        if (old + 1u == (gen + 1u) * nloc) {
            __builtin_amdgcn_fence(__ATOMIC_RELEASE, "agent");
            asm volatile("s_waitcnt vmcnt(0)" ::: "memory");
            const unsigned og = xb_add(&bar[XB_TOP], 1u);
            const unsigned tg = og / nx;
            if (og + 1u == (tg + 1u) * nx) xb_add(&bar[XB_TOPGEN], 1u);
            else XB_SPIN(xb_ld(&bar[XB_TOPGEN]) == tg, bar);
            __builtin_amdgcn_fence(__ATOMIC_ACQUIRE, "agent");
            xb_add(&bar[XB_XGEN(b.x)], 1u);
            asm volatile("s_waitcnt vmcnt(0)" ::: "memory");
        } else {
            XB_SPIN(xb_ld(&bar[XB_XGEN(b.x)]) == gen, bar);
            __builtin_amdgcn_fence(__ATOMIC_ACQUIRE, "agent");
            asm volatile("s_waitcnt vmcnt(0)" ::: "memory");
        }
    }
    __syncthreads();
}


__global__ void __launch_bounds__(512) mega_fwd(Params p) {
    extern __shared__ __attribute__((aligned(16))) unsigned char lds_raw[];
    LAS unsigned char* lds = (LAS unsigned char*)lds_raw;
    cg::grid_group grid = cg::this_grid();
    volatile LAS unsigned* bst = (volatile LAS unsigned*)(lds + 140032);
    if (threadIdx.x == 0) { bst[0] = 0u; bst[1] = 0u; const unsigned long long ba = (unsigned long long)(p.ws + SM_BAR); bst[2] = (unsigned)ba; bst[3] = (unsigned)(ba >> 32); }
    __syncthreads();
    (void)xcd_barrier_post((unsigned*)(p.ws + SM_BAR), bst);
#ifdef PROF_SEL
#define PSTAMP(k) do { if (blockIdx.x == 0 && threadIdx.x == 0) { volatile LAS unsigned* pl_ = (volatile LAS unsigned*)(lds + 140032 + 16); const unsigned long long now_ = __builtin_amdgcn_s_memrealtime(); const unsigned long long last_ = ((unsigned long long)pl_[1] << 32) | pl_[0]; *PROF_SLOT(k) += now_ - last_; pl_[0] = (unsigned)now_; pl_[1] = (unsigned)(now_ >> 32); } } while (0)
#else
#define PSTAMP(k)
#endif
#define GSYNC() do { XcdBarrier xb_; volatile LAS unsigned* st_ = (volatile LAS unsigned*)(lds + 140032); xb_.bar = (unsigned*)(((unsigned long long)st_[3] << 32) | st_[2]); xb_.x = xb_xcc_id(); xb_.st = st_; xcd_barrier(xb_); } while (0)
#ifdef PROF_SEL
    if (threadIdx.x == 0) { volatile LAS unsigned* pl_ = (volatile LAS unsigned*)(lds + 140032 + 16); const unsigned long long now_ = __builtin_amdgcn_s_memrealtime(); pl_[0] = (unsigned)now_; pl_[1] = (unsigned)(now_ >> 32); }
#endif
    const int G = gridDim.x, c = blockIdx.x;
#define LP() bf16_t* W = (bf16_t*)p.ws; bf16_t* xn = (bf16_t*)(p.ws + R_XN); float* x1 = (float*)(p.ws + R_XA); pg8::StaticOrder SO; (void)W; (void)xn; (void)x1; (void)SO
#ifndef PHMASK
#define PHMASK 0xFFFFFFFFu
#endif
#ifndef REPEAT_MASK
#define REPEAT_MASK 0u
#endif
#define PH(k) if (((PHMASK >> (k)) & 1u) && (k) >= p.ph_lo && (k) <= p.ph_hi)
#define RPT(k) if ((REPEAT_MASK >> (k)) & 1u)
    PH(0) { LP(); phase_p0(p, lds); }
    GSYNC(); PSTAMP(0);
    if (p.ph_lo == -12345) grid.sync();
    RPT(0) { { LP(); phase_p0(p, lds); } GSYNC(); }
    PH(1) { LP();
        pg8::Gemm g{xn, W + W_IN_E / 2, T, 1792, 1024, 1024, nullptr, 0, nullptr}; SO.init(T, 1792, G, c);
        pg8::EpiBf16<0> E{(bf16_t*)(p.ws + R_H), 1792, nullptr, nullptr};
        pg8::gemm_phase<pg8::EpiBf16<0>, true>(lds, g, SO, E);
    }
    GSYNC(); PSTAMP(1);
    PH(2) { LP(); phase_p2(p, lds); }
    GSYNC(); PSTAMP(2);
    RPT(2) { { LP(); phase_p2(p, lds); } GSYNC(); }
    PH(3) { LP();
        const int nCu = 2 * (NB * 512 / 256) * 2, Gc = (nCu < G / 2) ? nCu : 0;
        if (Gc == 0 || c < Gc) {
            for (int kv = 0; kv < 2; ++kv) {
                pg8::Gemm g{(const bf16_t*)(p.ws + R_XA + (kv ? A_VCIN : A_KCIN)), W + W_CW1 / 2 + (size_t)kv * 512 * 1024, NB * 512, 512, 1024, 1024, nullptr, 0, nullptr};
                if (Gc) SO.init(NB * 512, 512, Gc / 2, c - kv * (Gc / 2)); else SO.init(NB * 512, 512, G, c);
                pg8::EpiBf16<0> E{(bf16_t*)(p.ws + SM_HID) + (size_t)kv * NB * 512 * 512, 512, nullptr, nullptr};
                if (Gc == 0 || (c / (Gc / 2)) == kv) pg8::gemm_phase<pg8::EpiBf16<0>, true>(lds, g, SO, E);
            }
        }
        if (Gc == 0 || c >= Gc) {
            {
                pg8::Gemm g{(const bf16_t*)(p.ws + R_XA + A_CQN), W + W_UQ / 2, T, 1024, 256, 256, nullptr, 0, nullptr}; SO.init(T, 1024, G - Gc, c - Gc);
                pg8::EpiBf16<0> E{(bf16_t*)(p.ws + R_H), 1024, nullptr, nullptr};
                pg8::gemm_phase<pg8::EpiBf16<0>, true>(lds, g, SO, E);
            }
            {
                pg8::Gemm g{(const bf16_t*)(p.ws + R_XA + A_CKVN), W + W_UKV / 2, T, 1024, 128, 128, nullptr, 0, nullptr}; SO.init(T, 1024, G - Gc, c - Gc);
                pg8::EpiBf16<0> E{(bf16_t*)(p.ws + R_H + (size_t)T * 2048), 1024, nullptr, nullptr};
                pg8::gemm_phase<pg8::EpiBf16<0>, true>(lds, g, SO, E);
            }
        }
    }
    GSYNC(); PSTAMP(3);
    PH(4) { LP(); phase_p3b(p, lds); }
    GSYNC(); PSTAMP(4);
    RPT(4) { { LP(); phase_p3b(p, lds); } GSYNC(); }
    PH(5) { LP(); phase_p4(p, lds); }
    GSYNC(); PSTAMP(5);
    RPT(5) { { LP(); phase_p4(p, lds); } GSYNC(); }
    PH(6) { LP();
        pg8::Gemm g{xn, W + W_OUT_E / 2, T, 1024, 1024, 1024, nullptr, 0, nullptr}; SO.init(T, 1024, G, c);
        pg8::EpiResStat<false> E{p.in[0], (bf16_t*)p.out, (float*)(p.ws + SM_SSP1), 1024};
        pg8::gemm_phase<pg8::EpiResStat<false>, true>(lds, g, SO, E);
    }
    GSYNC(); PSTAMP(6);
    PH(7) { }
    PH(8) { LP();
        pg8::Gemm g{(const bf16_t*)p.out, W + W_GU / 2, T, 5632, 1024, 1024, nullptr, 0, nullptr}; SO.init(T, 5632, G, c);
        pg8::EpiSwiGLU E{(bf16_t*)(p.ws + R_H), 2816, (const float*)(p.ws + SM_SSP1)};
        pg8::gemm_phase<pg8::EpiSwiGLU, true>(lds, g, SO, E);
    }
    GSYNC(); PSTAMP(8);
    PH(9) { LP();
        pg8::Gemm g{(const bf16_t*)(p.ws + R_H), W + W_D / 2, T, 1024, 2816, 2816, nullptr, 0, nullptr}; SO.init(T, 1024, G, c);
        pg8::EpiResStat<true> E{(const bf16_t*)p.out, xn, (float*)(p.ws + SM_SSP2), 1024};
        pg8::gemm_phase<pg8::EpiResStat<true>, true>(lds, g, SO, E);
    }
    GSYNC(); PSTAMP(9);
    PH(10) { }
    PH(11) { LP();
        pg8::Gemm g{xn, W + W_IN_O / 2, T, 3072, 1024, 1024, nullptr, 0, nullptr}; SO.init(T, 3072, G, c);
        pg8::EpiConvIn E{(bf16_t*)(p.ws + R_H), (bf16_t*)(p.ws + R_H + (size_t)T * 2048), (const float*)(p.ws + SM_SSP2)};
        pg8::gemm_phase<pg8::EpiConvIn, true>(lds, g, SO, E);
    }
    GSYNC(); PSTAMP(11);
    PH(12) { LP(); phase_conv(p); }
    GSYNC(); PSTAMP(12);
    RPT(12) { { LP(); phase_conv(p); } GSYNC(); }
    PH(13) { LP();
        pg8::Gemm g{(const bf16_t*)x1, W + W_OUT_O / 2, T, 1024, 1024, 1024, nullptr, 0, nullptr}; SO.init(T, 1024, G, c);
        pg8::EpiResBf16B E{xn, xn, 1024};
        pg8::gemm_phase<pg8::EpiResBf16B, true>(lds, g, SO, E);
    }
    GSYNC(); PSTAMP(13);
    PH(14) { LP(); phase_norm_router(p, lds); }
    GSYNC(); PSTAMP(14);
    PH(15) { LP(); phase_moe_gather(p); }
    GSYNC(); PSTAMP(15);
    PH(16) { LP(); const int mrows = ((const int*)(p.ws + SM_CTL))[8];
        pg8::Gemm g{(const bf16_t*)x1, W + W_MGU / 2, mrows, 2816, 1024, 1024, (const int*)(p.ws + SM_TILEE), (size_t)2816 * 1024, (const int*)(p.ws + SM_ROWTOK)}; SO.init(mrows, 2816, G, c);
        pg8::EpiSwiGLU E{(bf16_t*)(p.ws + R_H), 1408, nullptr};
        pg8::gemm_phase<pg8::EpiSwiGLU, true, true>(lds, g, SO, E);
    }
    GSYNC(); PSTAMP(16);
    PH(17) { LP(); const int mrows = ((const int*)(p.ws + SM_CTL))[8];
        pg8::Gemm g{(const bf16_t*)(p.ws + R_H), W + W_MD / 2, mrows, 1024, 1408, 1408, (const int*)(p.ws + SM_TILEE), (size_t)1024 * 1408, nullptr}; SO.init(mrows, 1024, G, c);
        pg8::EpiRowScaleBf16 E{(bf16_t*)(p.ws + R_XA), 1024, (const float*)(p.ws + SM_ROWW)};
        pg8::gemm_phase<pg8::EpiRowScaleBf16, true>(lds, g, SO, E);
    }
    GSYNC(); PSTAMP(17);
    PH(18) { LP(); phase_moe_combine(p); }
#ifdef PROF_SEL
    GSYNC(); PSTAMP(18);
    GSYNC();
    {
        unsigned long long v_ = *PROF_SLOT(PROF_SEL);
#ifdef PROF_DIV
        const unsigned long long dv_ = *PROF_SLOT(PROF_DIV); v_ = dv_ ? v_ / dv_ : 0ull;
#endif
        unsigned long long a_ = v_ / (unsigned long long)(PROF_UNIT); if (a_ > 27ull) a_ = 27ull;
        const float sc_ = 1.f + (float)a_;
        for (size_t i = (size_t)blockIdx.x * 512 + threadIdx.x; i < (size_t)S * 1024 / 4; i += (size_t)gridDim.x * 512) { f32x4* o = (f32x4*)p.out + i; *o = *o * sc_; }
    }
#endif
#undef PH
}

inline void launch(void* const* d_in, float* d_out, void* d_ws, size_t ws_size, hipStream_t stream, int ph_lo = 0, int ph_hi = 99, int dbg_branch = -1) {
    static int grid = 0;
    if (grid == 0) {
        int dev = 0, cus = 0, per_cu = 0;
        hipGetDevice(&dev); hipDeviceGetAttribute(&cus, hipDeviceAttributeMultiprocessorCount, dev);
        hipFuncSetAttribute((const void*)mega_fwd, hipFuncAttributeMaxDynamicSharedMemorySize, LDS_BYTES);
        hipOccupancyMaxActiveBlocksPerMultiprocessor(&per_cu, (const void*)mega_fwd, 512, LDS_BYTES);
        if (per_cu < 1) { fprintf(stderr, "occupancy query says %d blocks/CU\n", per_cu); per_cu = 1; }
        grid = cus;
        if (WS_FAST_END > ws_size) { fprintf(stderr, "ws too small: need %zu have %zu\n", (size_t)WS_FAST_END, ws_size); grid = -1; }
    }
    if (grid < 0) return;
    if (ph_lo <= 14 && ph_hi >= 14) hipMemsetAsync((char*)d_ws + SM_CTL, 0, 4096, stream);
    hipMemsetAsync((char*)d_ws + SM_BAR, 0, 16384, stream);
    Params p{};
    for (int i = 0; i < 30; ++i) p.in[i] = (const float*)d_in[i];
    p.out = d_out; p.ws = (unsigned char*)d_ws; p.ph_lo = ph_lo; p.ph_hi = ph_hi; p.dbg_branch = dbg_branch;
    void* args[] = {&p};
    hipError_t e = hipLaunchCooperativeKernel((const void*)mega_fwd, dim3(grid), dim3(512), args, LDS_BYTES, stream);
    if (e != hipSuccess) fprintf(stderr, "cooperative launch failed: %s (grid %d)\n", hipGetErrorString(e), grid);
}
}
extern "C" void kernel_launch(void* const* d_in, const int* in_sizes, int n_in, void* d_out, int out_size, void* d_ws, size_t ws_size, hipStream_t stream) {
    fast::launch(d_in, (float*)d_out, d_ws, ws_size, stream);
}
```

```cpp
#include <hip/hip_runtime.h>
#include <hip/hip_bf16.h>
#include <stdint.h>
#include <stdio.h>
#include <string.h>
#include <hip/hip_cooperative_groups.h>
namespace cg = cooperative_groups;
#define NB 8
#define REPEAT_MASK 0x0u
namespace gold {
constexpr int S = 4096, D = 1024, HW = 1720;
constexpr float EPS = 1e-6f;

__device__ const unsigned char T5B[128] = {0, 1, 2, 3, 4, 5, 6, 7, 8, 9, 10, 11, 12, 13, 14, 15, 16, 16, 16, 17, 17, 18, 18, 18, 19, 19, 19, 20, 20, 20, 20, 21, 21, 21, 21, 22, 22, 22, 22, 22, 23, 23, 23, 23, 23, 23, 24, 24, 24, 24, 24, 24, 25, 25, 25, 25, 25, 25, 25, 26, 26, 26, 26, 26, 26, 26, 26, 27, 27, 27, 27, 27, 27, 27, 27, 27, 27, 28, 28, 28, 28, 28, 28, 28, 28, 28, 28, 29, 29, 29, 29, 29, 29, 29, 29, 29, 29, 29, 29, 30, 30, 30, 30, 30, 30, 30, 30, 30, 30, 30, 30, 30, 30, 31, 31, 31, 31, 31, 31, 31, 31, 31, 31, 31, 31, 31, 31};
}
#ifndef NB
#define NB 8
#endif
namespace fast {
#define LAS __attribute__((address_space(3)))
typedef unsigned short bf16_t;
typedef short bf16x8 __attribute__((ext_vector_type(8)));
typedef float f32x4 __attribute__((ext_vector_type(4)));
typedef float f32x2 __attribute__((ext_vector_type(2)));
typedef float f32x16 __attribute__((ext_vector_type(16)));
typedef unsigned u32x4 __attribute__((ext_vector_type(4)));
typedef unsigned u32x2 __attribute__((ext_vector_type(2)));
typedef __bf16 bf16x2_t __attribute__((ext_vector_type(2)));

constexpr int S = 4096, T = NB * S, D = 1024;
constexpr float EPS = 1e-6f, LOG2E = 1.4426950408889634f;

__device__ __forceinline__ unsigned cvtpk(float lo, float hi) { f32x2 v = {lo, hi}; bf16x2_t b = __builtin_convertvector(v, bf16x2_t); return __builtin_bit_cast(unsigned, b); }
__device__ __forceinline__ bf16_t f2bf(float f) { return (bf16_t)(cvtpk(f, 0.f) & 0xffffu); }
__device__ __forceinline__ float bf2f(bf16_t u) { return __builtin_bit_cast(float, (unsigned)u << 16); }
__device__ __forceinline__ float bflo(unsigned u) { return __builtin_bit_cast(float, u << 16); }
__device__ __forceinline__ float bfhi(unsigned u) { return __builtin_bit_cast(float, u & 0xffff0000u); }
__device__ __forceinline__ float wsum(float v) {
#pragma unroll
    for (int o = 1; o < 64; o <<= 1) v += __shfl_xor(v, o);
    return v;
}
__device__ __forceinline__ float fexp2(float x) { return __builtin_amdgcn_exp2f(x); }
__device__ __forceinline__ float frcp(float x) { return __builtin_amdgcn_rcpf(x); }
__device__ __forceinline__ float silu_f(float x) { return x * frcp(1.f + fexp2(-x * LOG2E)); }
__device__ __forceinline__ float gelu_tanh_f(float x) {
    const float u = 0.7978845608028654f * (x + 0.044715f * x * x * x);
    return x * frcp(1.f + fexp2(-2.f * LOG2E * u));
}

namespace pg8 {
constexpr int BM = 256, BK = 64, HALF = 128, HTB = HALF * BK * 2, STAGE_BYTES = 8 * HTB, NXCD = 8, WGM = 8;
__host__ __device__ __forceinline__ int lds_byte(int r, int c) { const int st = (r >> 4) * 2 + (c >> 5), rr = r & 15, cc = c & 31, ob = rr * 64 + cc * 2; return st * 1024 + (ob ^ (((ob >> 9) & 1) << 5)); }
__host__ __device__ __forceinline__ void stage_rc(int b, int& R, int& C) { const int st = b / 1024, sb = b % 1024, swz = sb ^ (((sb >> 9) & 1) << 5); R = (st >> 1) * 16 + swz / 64; C = (st & 1) * 32 + (swz % 64) / 2; }
__host__ __device__ __forceinline__ int perm32(int rho) { const int n = rho >> 4, i = rho & 15; return 8 * (i >> 2) + 4 * n + (i & 3); }

struct Unit { int pm, pn; };
struct Gemm { const bf16_t* A; const bf16_t* Bt; int M, N, K, lda; const int* tile_e; size_t estride; const int* rowidx; };

struct StaticOrder {
    int nM, nN, nwg, G, c;
    __device__ void init(int M, int N, int G_, int c_) { nM = M / BM; nN = N / BM; nwg = nM * nN; G = G_; c = c_; }
    __device__ bool next(int i, Unit& u) const {
        const long L = (long)i * G + c; if (L >= nwg) return false;
        int wgid = (int)L; { const int q = nwg / NXCD, r = nwg % NXCD, xcd = wgid % NXCD, off = wgid / NXCD; wgid = (xcd < r ? xcd * (q + 1) : r * (q + 1) + (xcd - r) * q) + off; }
        const int nig = WGM * nN, gid = wgid / nig, fm = gid * WGM, gsz = (nM - fm) < WGM ? (nM - fm) : WGM;
        u.pm = fm + ((wgid % nig) % gsz); u.pn = (wgid % nig) / gsz; return true;
    }
};

template <class Epi, bool ALIGN_EPI, bool GATHER = false>
__device__ __forceinline__ void gemm_phase(LAS unsigned char* lds, const Gemm g, const StaticOrder& S, const Epi& E) {
    int tid = threadIdx.x; asm volatile("" : "+v"(tid));
    const int wid = __builtin_amdgcn_readfirstlane(tid >> 6), lane = tid & 63, wr = wid >> 2, wc = wid & 3, fr = lane & 15, fq = lane >> 4;
    const int K = g.K, nt = K / BK, lda = g.lda;
    unsigned voffA[2], voffB[2];
#pragma unroll
    for (int i = 0; i < 2; ++i) { int R, C; stage_rc(tid * 16 + i * 8192, R, C); const int Rb = Epi::PERM ? ((R & ~31) + perm32(R & 31)) : R;
        voffA[i] = (unsigned)(R * lda + C) * 2u; voffB[i] = (unsigned)(Rb * K + C) * 2u; }
    const size_t kstep = (size_t)(BK * 2);
    const size_t hsA = GATHER ? 0 : (size_t)HALF * lda * 2, tsA = 2 * hsA, hsB = (size_t)HALF * K * 2, tsB = 2 * hsB;
    unsigned vgc[2][2], vgn[2][2];
#define PG8_GOFF(pm_, vg) do { _Pragma("unroll") for (int h_ = 0; h_ < 2; ++h_) _Pragma("unroll") for (int i_ = 0; i_ < 2; ++i_) { int R_, C_; stage_rc(tid * 16 + i_ * 8192, R_, C_); \
        int tok_ = g.rowidx[(pm_) * BM + h_ * HALF + R_]; tok_ = tok_ < 0 ? 0 : tok_; vg[h_][i_] = (unsigned)(tok_ * lda + C_) * 2u; } } while (0)
#define PG8_STAGE_A(bufoff, gbase, h, nx) do { unsigned va_[2]; _Pragma("unroll") for (int i_ = 0; i_ < 2; ++i_) va_[i_] = GATHER ? ((nx) ? vgn[h][i_] : vgc[h][i_]) : voffA[i_]; PG8_STAGE(bufoff, gbase, va_); } while (0)
    const unsigned ldsw = (unsigned)wid * 1024u;
    const int aoff = lds_byte(wr * 64 + fr, fq * 8), boff = lds_byte(wc * 32 + fr, fq * 8);
#define PG8_SA(b, h) (((b) * 2 + (h)) * HTB)
#define PG8_SB(b, h) ((4 + (b) * 2 + (h)) * HTB)
#define PG8_STAGE(bufoff, gbase, voff) do { _Pragma("unroll") for (int _i = 0; _i < 2; ++_i) \
        __builtin_amdgcn_global_load_lds((const unsigned*)((const char*)(gbase) + (voff)[_i]), (LAS unsigned*)(lds + (bufoff) + ldsw + _i * 8192), 16, 0, 0); } while (0)
#define PG8_LDA(dst, b, h) do { _Pragma("unroll") for (int m = 0; m < 4; ++m) _Pragma("unroll") for (int k = 0; k < 2; ++k) dst[m][k] = *(const LAS bf16x8*)(lds + PG8_SA(b, h) + aoff + m * 2048 + k * 1024); } while (0)
#define PG8_LDB(dst, b, h) do { _Pragma("unroll") for (int n = 0; n < 2; ++n) _Pragma("unroll") for (int k = 0; k < 2; ++k) dst[n][k] = *(const LAS bf16x8*)(lds + PG8_SB(b, h) + boff + n * 2048 + k * 1024); } while (0)
#define PG8_MMA(ai, bj, At, Bt) do { __builtin_amdgcn_s_setprio(1); _Pragma("unroll") for (int m = 0; m < 4; ++m) _Pragma("unroll") for (int n = 0; n < 2; ++n) _Pragma("unroll") for (int k = 0; k < 2; ++k) \
        acc[ai][bj][m][n] = __builtin_amdgcn_mfma_f32_16x16x32_bf16(Bt[n][k], At[m][k], acc[ai][bj][m][n], 0, 0, 0); __builtin_amdgcn_s_setprio(0); } while (0)
#define PG8_WAIT_V(n) asm volatile("s_waitcnt vmcnt(" #n ")" ::: "memory")
#define PG8_WAIT_L(n) asm volatile("s_waitcnt lgkmcnt(" #n ")" ::: "memory")
#define PG8_BAR __builtin_amdgcn_s_barrier()
#define PG8_SCHED __builtin_amdgcn_sched_barrier(0)
#define PG8_EOFF(pm_) (g.tile_e ? (size_t)g.tile_e[pm_] * g.estride * 2 : (size_t)0)
    Unit cur, nxt; int ui = 0;
    if (!S.next(0, cur)) return;
    f32x4 acc[2][2][4][2];
#pragma unroll
    for (int a = 0; a < 2; ++a)
#pragma unroll
        for (int b = 0; b < 2; ++b)
#pragma unroll
            for (int m = 0; m < 4; ++m)
#pragma unroll
                for (int n = 0; n < 2; ++n) acc[a][b][m][n] = (f32x4){0.f, 0.f, 0.f, 0.f};
    bf16x8 At[4][2], B0[2][2], B1[2][2];
    const char* cA = (const char*)g.A + (size_t)cur.pm * tsA; const char* cB = (const char*)g.Bt + PG8_EOFF(cur.pm) + (size_t)cur.pn * tsB;
    if constexpr (GATHER) PG8_GOFF(cur.pm, vgc);
    PG8_STAGE(PG8_SB(0, 0), cB, voffB); PG8_STAGE(PG8_SB(0, 1), cB + hsB, voffB); PG8_STAGE_A(PG8_SA(0, 0), cA, 0, false); PG8_STAGE_A(PG8_SA(0, 1), cA + hsA, 1, false);
    if (wr == 1) PG8_BAR;
    PG8_WAIT_V(2); PG8_BAR;
    PG8_STAGE(PG8_SB(1, 0), cB + kstep, voffB); PG8_STAGE_A(PG8_SA(1, 0), cA + kstep, 0, false); PG8_STAGE(PG8_SB(1, 1), cB + hsB + kstep, voffB);
    PG8_WAIT_V(6); PG8_BAR;
    for (;;) {
        const bool has_next = S.next(ui + 1, nxt);
        if constexpr (GATHER) { if (has_next) PG8_GOFF(nxt.pm, vgn); else { vgn[0][0] = vgc[0][0]; vgn[0][1] = vgc[0][1]; vgn[1][0] = vgc[1][0]; vgn[1][1] = vgc[1][1]; } }
        const char* nA = has_next ? (const char*)g.A + (size_t)nxt.pm * tsA : cA;
        const char* nB = has_next ? (const char*)g.Bt + PG8_EOFF(nxt.pm) + (size_t)nxt.pn * tsB : cB;
        for (int t = 0; t < nt; t += 2) {
            const bool last = (t == nt - 2);
            const char* a1 = cA + (size_t)(t + 1) * kstep;
            const char* a2 = last ? nA : cA + (size_t)(t + 2) * kstep; const char* b2 = last ? nB : cB + (size_t)(t + 2) * kstep;
            const char* a3 = a2 + kstep; const char* b3 = b2 + kstep;
            PG8_LDB(B0, 0, 0); PG8_LDB(B1, 0, 1); PG8_SCHED; PG8_LDA(At, 0, 0); PG8_STAGE_A(PG8_SA(1, 1), a1 + hsA, 1, false);
            PG8_WAIT_V(8); PG8_WAIT_L(0); PG8_BAR; PG8_MMA(0, 0, At, B0); PG8_MMA(0, 1, At, B1); PG8_BAR; PG8_SCHED;
            PG8_LDA(At, 0, 1); PG8_STAGE(PG8_SB(0, 0), b2, voffB); PG8_STAGE(PG8_SB(0, 1), b2 + hsB, voffB); PG8_STAGE_A(PG8_SA(0, 0), a2, 0, last);
            PG8_WAIT_V(8); PG8_WAIT_L(0); PG8_BAR; PG8_MMA(1, 0, At, B0); PG8_MMA(1, 1, At, B1); PG8_BAR; PG8_SCHED;
            PG8_LDB(B0, 1, 0); PG8_LDB(B1, 1, 1); PG8_SCHED; PG8_LDA(At, 1, 0); PG8_STAGE_A(PG8_SA(0, 1), a2 + hsA, 1, last);
            PG8_WAIT_V(8); PG8_WAIT_L(0); PG8_BAR; PG8_MMA(0, 0, At, B0); PG8_MMA(0, 1, At, B1); PG8_BAR; PG8_SCHED;
            PG8_LDA(At, 1, 1); PG8_STAGE(PG8_SB(1, 0), b3, voffB); PG8_STAGE(PG8_SB(1, 1), b3 + hsB, voffB); PG8_STAGE_A(PG8_SA(1, 0), a3, 0, last);
            PG8_WAIT_V(8); PG8_WAIT_L(0); PG8_BAR; PG8_MMA(1, 0, At, B0); PG8_MMA(1, 1, At, B1); PG8_BAR; PG8_SCHED;
        }
        if constexpr (ALIGN_EPI) { if (wr == 0) PG8_BAR; }
        E(acc, cur, wr, wc, fr, fq);
        if (!has_next) break;
#pragma unroll
        for (int a = 0; a < 2; ++a)
#pragma unroll
            for (int b = 0; b < 2; ++b)
#pragma unroll
                for (int m = 0; m < 4; ++m)
#pragma unroll
                    for (int n = 0; n < 2; ++n) acc[a][b][m][n] = (f32x4){0.f, 0.f, 0.f, 0.f};
        cur = nxt; cA = nA; cB = nB; ++ui;
        if constexpr (GATHER) { vgc[0][0] = vgn[0][0]; vgc[0][1] = vgn[0][1]; vgc[1][0] = vgn[1][0]; vgc[1][1] = vgn[1][1]; }
        if constexpr (ALIGN_EPI) { if (wr == 1) PG8_BAR; }
    }
    PG8_WAIT_V(0);
    if constexpr (!ALIGN_EPI) { if (wr == 0) PG8_BAR; }
    PG8_BAR;
#undef PG8_SA
#undef PG8_SB
#undef PG8_STAGE
#undef PG8_LDA
#undef PG8_LDB
#undef PG8_MMA
#undef PG8_WAIT_V
#undef PG8_WAIT_L
#undef PG8_BAR
#undef PG8_SCHED
#undef PG8_EOFF
#undef PG8_GOFF
#undef PG8_STAGE_A
}

__device__ __forceinline__ float row_rstd(const float* ssp, int row);
template <int ACT> struct EpiBf16 {
    static constexpr bool PERM = true;
    bf16_t* O; int ldc; const float* bias; const float* ssp;
    __device__ __forceinline__ void operator()(const f32x4 (&acc)[2][2][4][2], const Unit& u, int wr, int wc, int fr, int fq) const {
        const int row0 = u.pm * BM + wr * 64 + fr, col0 = u.pn * BM + wc * 32 + 8 * fq;
        f32x4 bv[2][2];
#pragma unroll
        for (int bj = 0; bj < 2; ++bj)
#pragma unroll
            for (int n = 0; n < 2; ++n) bv[bj][n] = bias ? *(const f32x4*)(bias + col0 + bj * HALF + 4 * n) : (f32x4){0.f, 0.f, 0.f, 0.f};
#pragma unroll
        for (int ai = 0; ai < 2; ++ai)
#pragma unroll
            for (int m = 0; m < 4; ++m) { bf16_t* rowp = O + (size_t)(row0 + ai * HALF + m * 16) * ldc + col0;
                const float rs = (ACT == 0 && ssp) ? row_rstd(ssp, row0 + ai * HALF + m * 16) : 1.f;
#pragma unroll
                for (int bj = 0; bj < 2; ++bj) { f32x4 v0 = acc[ai][bj][m][0] * rs + bv[bj][0], v1 = acc[ai][bj][m][1] * rs + bv[bj][1];
                    if (ACT == 2) {
#pragma unroll
                        for (int i = 0; i < 4; ++i) { v0[i] = gelu_tanh_f(v0[i]); v1[i] = gelu_tanh_f(v1[i]); } }
                    u32x4 w; w.x = cvtpk(v0[0], v0[1]); w.y = cvtpk(v0[2], v0[3]); w.z = cvtpk(v1[0], v1[1]); w.w = cvtpk(v1[2], v1[3]);
                    *(u32x4*)(rowp + bj * HALF) = w; } }
    }
};
struct EpiResF32 {
    static constexpr bool PERM = false;
    const float* base; float* out; int ldc;
    __device__ __forceinline__ void operator()(const f32x4 (&acc)[2][2][4][2], const Unit& u, int wr, int wc, int fr, int fq) const {
        const int col0 = u.pn * BM + wc * 32 + 4 * fq;
#pragma unroll
        for (int ai = 0; ai < 2; ++ai)
#pragma unroll
            for (int m = 0; m < 4; ++m) { const size_t off = (size_t)(u.pm * BM + ai * HALF + wr * 64 + m * 16 + fr) * ldc + col0;
#pragma unroll
                for (int bj = 0; bj < 2; ++bj)
#pragma unroll
                    for (int n = 0; n < 2; ++n) { const f32x4 bs = *(const f32x4*)(base + off + bj * HALF + n * 16); *(f32x4*)(out + off + bj * HALF + n * 16) = bs + acc[ai][bj][m][n]; } }
    }
};
template <bool BASE_BF16> struct EpiResStat {
    static constexpr bool PERM = false;
    const void* base; bf16_t* xb; float* ssp; int ldc;
    __device__ __forceinline__ void operator()(const f32x4 (&acc)[2][2][4][2], const Unit& u, int wr, int wc, int fr, int fq) const {
        const int col0 = u.pn * BM + wc * 32 + 4 * fq;
#pragma unroll
        for (int ai = 0; ai < 2; ++ai)
#pragma unroll
            for (int m = 0; m < 4; ++m) { const int row = u.pm * BM + ai * HALF + wr * 64 + m * 16 + fr; const size_t off = (size_t)row * ldc + col0; float ss = 0.f;
#pragma unroll
                for (int bj = 0; bj < 2; ++bj)
#pragma unroll
                    for (int n = 0; n < 2; ++n) { f32x4 bs;
                        if (BASE_BF16) { const u32x2 t = *(const u32x2*)((const bf16_t*)base + off + bj * HALF + n * 16); bs = (f32x4){bflo(t.x), bfhi(t.x), bflo(t.y), bfhi(t.y)}; }
                        else bs = *(const f32x4*)((const float*)base + off + bj * HALF + n * 16);
                        const f32x4 v = bs + acc[ai][bj][m][n];
                        u32x2 w; w.x = cvtpk(v.x, v.y); w.y = cvtpk(v.z, v.w); *(u32x2*)(xb + off + bj * HALF + n * 16) = w; ss += (v.x * v.x + v.y * v.y) + (v.z * v.z + v.w * v.w); }
                ss += __shfl_xor(ss, 16); ss += __shfl_xor(ss, 32);
                if (fq == 0) ssp[(size_t)row * 16 + u.pn * 4 + wc] = ss; }
    }
};
struct EpiResBf16B {
    static constexpr bool PERM = false;
    const bf16_t* base; bf16_t* out; int ldc;
    __device__ __forceinline__ void operator()(const f32x4 (&acc)[2][2][4][2], const Unit& u, int wr, int wc, int fr, int fq) const {
        const int col0 = u.pn * BM + wc * 32 + 4 * fq;
#pragma unroll
        for (int ai = 0; ai < 2; ++ai)
#pragma unroll
            for (int m = 0; m < 4; ++m) { const size_t off = (size_t)(u.pm * BM + ai * HALF + wr * 64 + m * 16 + fr) * ldc + col0;
#pragma unroll
                for (int bj = 0; bj < 2; ++bj)
#pragma unroll
                    for (int n = 0; n < 2; ++n) { const u32x2 t = *(const u32x2*)(base + off + bj * HALF + n * 16); const f32x4 v = (f32x4){bflo(t.x), bfhi(t.x), bflo(t.y), bfhi(t.y)} + acc[ai][bj][m][n];
                        u32x2 w; w.x = cvtpk(v.x, v.y); w.y = cvtpk(v.z, v.w); *(u32x2*)(out + off + bj * HALF + n * 16) = w; } }
    }
};
struct EpiResF32B {
    static constexpr bool PERM = false;
    const bf16_t* base; float* out; int ldc;
    __device__ __forceinline__ void operator()(const f32x4 (&acc)[2][2][4][2], const Unit& u, int wr, int wc, int fr, int fq) const {
        const int col0 = u.pn * BM + wc * 32 + 4 * fq;
#pragma unroll
        for (int ai = 0; ai < 2; ++ai)
#pragma unroll
            for (int m = 0; m < 4; ++m) { const size_t off = (size_t)(u.pm * BM + ai * HALF + wr * 64 + m * 16 + fr) * ldc + col0;
#pragma unroll
                for (int bj = 0; bj < 2; ++bj)
#pragma unroll
                    for (int n = 0; n < 2; ++n) { const u32x2 t = *(const u32x2*)(base + off + bj * HALF + n * 16); const f32x4 bs = {bflo(t.x), bfhi(t.x), bflo(t.y), bfhi(t.y)};
                        *(f32x4*)(out + off + bj * HALF + n * 16) = bs + acc[ai][bj][m][n]; } }
    }
};
__device__ __forceinline__ float row_rstd(const float* ssp, int row) {
    const f32x4* q = (const f32x4*)(ssp + (size_t)row * 16); const f32x4 a = q[0], b = q[1], c = q[2], d = q[3];
    const float s = ((a.x + a.y) + (a.z + a.w)) + ((b.x + b.y) + (b.z + b.w)) + ((c.x + c.y) + (c.z + c.w)) + ((d.x + d.y) + (d.z + d.w));
    return rsqrtf(s * (1.f / 1024.f) + EPS);
}
struct EpiSwiGLU {
    static constexpr bool PERM = true;
    bf16_t* O; int ldc; const float* ssp;
    __device__ __forceinline__ void operator()(const f32x4 (&acc)[2][2][4][2], const Unit& u, int wr, int wc, int fr, int fq) const {
        const int row0 = u.pm * BM + wr * 64 + fr, col0 = u.pn * HALF + wc * 32 + 8 * fq;
#pragma unroll
        for (int ai = 0; ai < 2; ++ai)
#pragma unroll
            for (int m = 0; m < 4; ++m) { bf16_t* rowp = O + (size_t)(row0 + ai * HALF + m * 16) * ldc + col0;
                const float rs = ssp ? row_rstd(ssp, row0 + ai * HALF + m * 16) : 1.f;
                float h[8];
#pragma unroll
                for (int n = 0; n < 2; ++n)
#pragma unroll
                    for (int i = 0; i < 4; ++i) h[n * 4 + i] = silu_f(acc[ai][0][m][n][i] * rs) * (acc[ai][1][m][n][i] * rs);
                u32x4 w; w.x = cvtpk(h[0], h[1]); w.y = cvtpk(h[2], h[3]); w.z = cvtpk(h[4], h[5]); w.w = cvtpk(h[6], h[7]);
                *(u32x4*)rowp = w; }
    }
};
struct EpiConvIn {
    static constexpr bool PERM = true;
    bf16_t* Bg; bf16_t* CU; const float* ssp;
    __device__ __forceinline__ void operator()(const f32x4 (&acc)[2][2][4][2], const Unit& u, int wr, int wc, int fr, int fq) const {
        const int row0 = u.pm * BM + wr * 64 + fr;
#pragma unroll
        for (int ai = 0; ai < 2; ++ai)
#pragma unroll
            for (int m = 0; m < 4; ++m) { const int row = row0 + ai * HALF + m * 16; const float rs = row_rstd(ssp, row);
                if (u.pn < 4) {
#pragma unroll
                    for (int bj = 0; bj < 2; ++bj) { const f32x4 v0 = acc[ai][bj][m][0] * rs, v1 = acc[ai][bj][m][1] * rs;
                        u32x4 w; w.x = cvtpk(v0[0], v0[1]); w.y = cvtpk(v0[2], v0[3]); w.z = cvtpk(v1[0], v1[1]); w.w = cvtpk(v1[2], v1[3]);
                        *(u32x4*)(Bg + (size_t)row * 1024 + u.pn * BM + bj * HALF + wc * 32 + 8 * fq) = w; }
                } else { const float r2 = rs * rs; float h[8];
#pragma unroll
                    for (int n = 0; n < 2; ++n)
#pragma unroll
                        for (int i = 0; i < 4; ++i) h[n * 4 + i] = acc[ai][0][m][n][i] * acc[ai][1][m][n][i] * r2;
                    u32x4 w; w.x = cvtpk(h[0], h[1]); w.y = cvtpk(h[2], h[3]); w.z = cvtpk(h[4], h[5]); w.w = cvtpk(h[6], h[7]);
                    *(u32x4*)(CU + (size_t)row * 1024 + (u.pn - 4) * HALF + wc * 32 + 8 * fq) = w; } }
    }
};
struct EpiRowScaleBf16 {
    static constexpr bool PERM = true;
    bf16_t* O; int ldc; const float* roww;
    __device__ __forceinline__ void operator()(const f32x4 (&acc)[2][2][4][2], const Unit& u, int wr, int wc, int fr, int fq) const {
        const int row0 = u.pm * BM + wr * 64 + fr, col0 = u.pn * BM + wc * 32 + 8 * fq;
#pragma unroll
        for (int ai = 0; ai < 2; ++ai)
#pragma unroll
            for (int m = 0; m < 4; ++m) { const int row = row0 + ai * HALF + m * 16; const float sc = roww[row]; bf16_t* rowp = O + (size_t)row * ldc + col0;
#pragma unroll
                for (int bj = 0; bj < 2; ++bj) { const f32x4 v0 = acc[ai][bj][m][0] * sc, v1 = acc[ai][bj][m][1] * sc;
                    u32x4 w; w.x = cvtpk(v0[0], v0[1]); w.y = cvtpk(v0[2], v0[3]); w.z = cvtpk(v1[0], v1[1]); w.w = cvtpk(v1[2], v1[3]);
                    *(u32x4*)(rowp + bj * HALF) = w; } }
    }
};
}
constexpr int ROWS_MAX = 2 * T + 8 * 256;
constexpr size_t al256(size_t x) { return (x + 255) & ~(size_t)255; }
constexpr size_t W_IN_E = 0;
constexpr size_t W_CW1 = W_IN_E + (size_t)1792 * 1024 * 2;
constexpr size_t W_UQ = W_CW1 + (size_t)2 * 256 * 2048 * 2;
constexpr size_t W_UKV = W_UQ + (size_t)1024 * 256 * 2;
constexpr size_t W_OUT_E = W_UKV + (size_t)1024 * 128 * 2;
constexpr size_t W_GU = W_OUT_E + (size_t)1024 * 1024 * 2;
constexpr size_t W_D = W_GU + (size_t)5632 * 1024 * 2;
constexpr size_t W_IN_O = W_D + (size_t)1024 * 2816 * 2;
constexpr size_t W_OUT_O = W_IN_O + (size_t)3072 * 1024 * 2;
constexpr size_t W_MGU = W_OUT_O + (size_t)1024 * 1024 * 2;
constexpr size_t W_MD = W_MGU + (size_t)8 * 2816 * 1024 * 2;
constexpr size_t W_END = W_MD + (size_t)8 * 1024 * 1408 * 2;
constexpr size_t SM_CTL = al256(W_END);
constexpr size_t SM_BAR = SM_CTL + 4096;
constexpr size_t SM_B1P = SM_BAR + 16384;
constexpr size_t SM_B1 = SM_B1P + 32 * 512 * 4;
constexpr size_t SM_ROPE = SM_B1 + 512 * 4;
constexpr size_t SM_BL = SM_ROPE + (size_t)S * 32 * 4;
constexpr size_t SM_HID = SM_BL + 8 * 132 * 4;
constexpr size_t SM_KC = SM_HID + (size_t)2 * NB * 512 * 512 * 2;
constexpr size_t SM_VCT = SM_KC + (size_t)NB * 512 * 64 * 2;
constexpr size_t SM_TE = SM_VCT + (size_t)NB * 512 * 64 * 2;
constexpr size_t SM_TW = SM_TE + (size_t)T * 8;
constexpr size_t SM_RANK = SM_TW + (size_t)T * 8;
constexpr size_t SM_POS = SM_RANK + (size_t)T * 8;
constexpr size_t SM_ROWW = SM_POS + (size_t)T * 8;
constexpr size_t SM_TILEE = SM_ROWW + (size_t)ROWS_MAX * 4;
constexpr size_t SM_ROWTOK = al256(SM_TILEE + (size_t)(ROWS_MAX / 256 + 8) * 4);
constexpr size_t SM_SSP1 = al256(SM_ROWTOK + (size_t)ROWS_MAX * 4);
constexpr size_t SM_SSP2 = SM_SSP1 + (size_t)T * 64;
constexpr size_t SM_END = SM_SSP2 + (size_t)T * 64;
constexpr size_t R_XA = al256(SM_END);
constexpr size_t SZ_XA = (size_t)T * 4096 + (size_t)4 * 1048576;
constexpr size_t R_XN = R_XA + SZ_XA;
constexpr size_t SZ_XN = (size_t)T * 2048;
constexpr size_t R_H = R_XN + SZ_XN;
constexpr size_t SZ_H = ((size_t)T * 6144 > (size_t)ROWS_MAX * 2816) ? (size_t)T * 6144 : (size_t)ROWS_MAX * 2816;
constexpr size_t WS_FAST_END = R_H + SZ_H;
constexpr size_t A_QN = 0;
constexpr size_t A_KSN = A_QN + (size_t)T * 1024;
constexpr size_t A_KWN = A_KSN + (size_t)T * 256;
constexpr size_t A_VST = A_KWN + (size_t)T * 256;
constexpr size_t A_VWT = A_VST + (size_t)T * 256;
constexpr size_t A_KCIN = A_VWT + (size_t)T * 256;
constexpr size_t A_VCIN = A_KCIN + (size_t)T * 256 + 2048;
constexpr size_t A_CQN = A_VCIN + (size_t)T * 256 + 2048;
constexpr size_t A_CKVN = A_CQN + (size_t)T * 512;
constexpr size_t A_KROPE = A_CKVN + (size_t)T * 256;
constexpr size_t A_GATES = A_KROPE + (size_t)T * 64;
constexpr size_t A_END = A_GATES + (size_t)T * 96;
static_assert(A_END <= SZ_XA, "attention inputs fit R_XA");
constexpr size_t O_QM = 0;
constexpr size_t O_KM = O_QM + (size_t)T * 1536;
constexpr size_t O_VMT = O_KM + (size_t)T * 1536;
static_assert(O_VMT + (size_t)T * 1024 <= (size_t)T * 4096, "d_out scratch");

struct Params {
    const float* in[30];
    float* out;
    unsigned char* ws;
    int ph_lo, ph_hi, dbg_branch, pad_;
};

#ifdef PROF_SEL
#define PROF_SLOT(k) ((unsigned long long*)(p.ws + SM_CTL + 2048) + (k))
#define PROF_ON(cond) ((cond) && threadIdx.x == 0)
#ifndef PROF_WAVE
#define PROF_WAVE 0
#endif
#endif
constexpr int LDS_BYTES = 147456;

__device__ __forceinline__ int ltid() { int t = threadIdx.x; asm volatile("" : "+v"(t)); return t; }
__device__ __forceinline__ int perm16(int k) { return (k & ~12) | ((k & 4) << 1) | ((k & 8) >> 1); }

struct WDesc { int in_idx, K, N, rep, map, row_off; size_t src_stride, dst_off, dst_stride; int gain_idx, pad_; size_t src_off; };
__device__ const WDesc WDESC[13] = {
    {3, 1024, 1720, 1, 2, 0, 0, W_IN_E / 2, 0, -1, 0},
    {7, 1024, 256, 2, 0, 0, (size_t)2048 * 256, W_CW1 / 2, (size_t)512 * 1024, -1, 0, 0},
    {7, 1024, 256, 2, 0, 256, (size_t)2048 * 256, W_CW1 / 2, (size_t)512 * 1024, -1, 0, (size_t)1024 * 256},
    {11, 256, 768, 1, 3, 0, 0, W_UQ / 2, 0, -1, 0},
    {12, 128, 1024, 1, 0, 0, 0, W_UKV / 2, 0, -1, 0},
    {15, 1024, 1024, 1, 0, 0, 0, W_OUT_E / 2, 0, -1, 0},
    {17, 1024, 2816, 1, 1, 0, 0, W_GU / 2, 0, 16, 0},
    {18, 1024, 2816, 1, 1, 128, 0, W_GU / 2, 0, 16, 0},
    {19, 2816, 1024, 1, 0, 0, 0, W_D / 2, 0, -1, 0},
    {21, 1024, 3072, 1, 4, 0, 0, W_IN_O / 2, 0, 20, 0},
    {23, 1024, 1024, 1, 0, 0, 0, W_OUT_O / 2, 0, -1, 0},
    {27, 1024, 1408, 8, 1, 0, (size_t)1024 * 1408, W_MGU / 2, (size_t)2816 * 1024, -1, 0},
    {28, 1024, 1408, 8, 1, 128, (size_t)1024 * 1408, W_MGU / 2, (size_t)2816 * 1024, -1, 0},
};
__device__ const WDesc WDESC_MD = {29, 1408, 1024, 8, 0, 0, (size_t)1408 * 1024, W_MD / 2, (size_t)1024 * 1408, -1, 0};

struct WItem { f32x4 v[8]; };
__device__ __forceinline__ void item_load(WItem& I, const float* W, int K, int N, const float* gain, int item, int lane) {
    const int nblk = (N + 31) / 32, kb = item / nblk, nb = item % nblk, k0 = 64 * kb, n0 = 32 * nb;
    const int n4 = (lane & 7) * 4; const bool nok = (n0 + n4) < N;
#pragma unroll
    for (int i = 0; i < 8; ++i) { const int kk = (lane >> 3) + 8 * i; I.v[i] = nok ? *(const f32x4*)(W + (size_t)(k0 + kk) * N + n0 + n4) : (f32x4){0.f, 0.f, 0.f, 0.f}; if (gain) I.v[i] = I.v[i] * gain[k0 + kk]; }
}
__device__ __forceinline__ void item_finish(const WItem& I, int K, int N, bf16_t* WT, int map, int row_off, LAS float* scr, int item, int lane) {
    const int nblk = (N + 31) / 32, kb = item / nblk, nb = item % nblk, k0 = 64 * kb, n0 = 32 * nb;
    const int n4 = (lane & 7) * 4;
#pragma unroll
    for (int i = 0; i < 8; ++i) { const int kk = (lane >> 3) + 8 * i; LAS float* d = scr + kk * 33 + n4; d[0] = I.v[i].x; d[1] = I.v[i].y; d[2] = I.v[i].z; d[3] = I.v[i].w; }
    asm volatile("s_waitcnt lgkmcnt(0)" ::: "memory");
    const int c = lane & 7;
#pragma unroll
    for (int j = 0; j < 4; ++j) { const int n = (lane >> 3) + 8 * j; const LAS float* s = scr + (8 * c) * 33 + n;
        u32x4 o; o.x = cvtpk(s[0 * 33], s[1 * 33]); o.y = cvtpk(s[2 * 33], s[3 * 33]); o.z = cvtpk(s[4 * 33], s[5 * 33]); o.w = cvtpk(s[6 * 33], s[7 * 33]);
        const int nn = n0 + n;
        if (nn < N) { const int row = (map == 1) ? (256 * (nn >> 7) + (nn & 127) + row_off) : (map == 2) ? (nn < 1280 ? nn : (nn < 1304 ? nn + 416 : nn - 24)) : (map == 3) ? ((nn / 96) * 128 + nn % 96) : (map == 4) ? (nn < 1024 ? nn : (nn < 2048 ? 1024 + 256 * ((nn - 1024) >> 7) + ((nn - 1024) & 127) : 1024 + 256 * ((nn - 2048) >> 7) + 128 + ((nn - 2048) & 127))) : (nn + row_off);
            *(u32x4*)(WT + (size_t)row * K + k0 + 8 * c) = o; } }
    asm volatile("s_waitcnt lgkmcnt(0)" ::: "memory");
}
__device__ __forceinline__ void rms_row_to_bf16(const float* xrow, const float* g, bf16_t* orow, int lane) {
    const f32x4* xr = (const f32x4*)xrow + lane; const f32x4* gr = (const f32x4*)g + lane;
    f32x4 v[4]; float s = 0.f;
#pragma unroll
    for (int j = 0; j < 4; ++j) { v[j] = xr[64 * j]; s += (v[j].x * v[j].x + v[j].y * v[j].y) + (v[j].z * v[j].z + v[j].w * v[j].w); }
    const float r = rsqrtf(wsum(s) * (1.f / 1024.f) + EPS);
    u32x2* o8 = (u32x2*)orow + lane;
#pragma unroll
    for (int j = 0; j < 4; ++j) { const f32x4 gg = gr[64 * j]; u32x2 w; w.x = cvtpk(v[j].x * r * gg.x, v[j].y * r * gg.y); w.y = cvtpk(v[j].z * r * gg.z, v[j].w * r * gg.w); o8[64 * j] = w; }
}
constexpr int WD_EARLY = 6;
__device__ __forceinline__ void convert_weights(const Params& p, LAS unsigned char* lds, int d_lo, int d_hi) {
    const int tid = ltid(), lane = tid & 63, wave = tid >> 6;
    const int gw = blockIdx.x * 8 + wave, NGW = gridDim.x * 8;
    LAS float* scr = (LAS float*)(lds + wave * 16384);
    int base = 0;
#pragma unroll 1
    for (int d = d_lo; d < d_hi; ++d) {
        const WDesc& wd = (d < 13) ? WDESC[d] : WDESC_MD;
        const int n_it = wd.rep * (wd.K / 64) * ((wd.N + 31) / 32);
        int first = (gw - (base % NGW) + NGW) % NGW;
        const int per = (wd.K / 64) * ((wd.N + 31) / 32); const float* gain = wd.gain_idx >= 0 ? p.in[wd.gain_idx] : nullptr;
        for (int it = first; it < n_it; it += 4 * NGW) {
            WItem I[4];
#pragma unroll
            for (int q = 0; q < 4; ++q) { const int iq = it + q * NGW; if (iq < n_it) { const int r = iq / per; item_load(I[q], p.in[wd.in_idx] + wd.src_off + (size_t)r * wd.src_stride, wd.K, wd.N, gain, iq % per, lane); } }
#pragma unroll
            for (int q = 0; q < 4; ++q) { const int iq = it + q * NGW; if (iq < n_it) { const int r = iq / per; item_finish(I[q], wd.K, wd.N, (bf16_t*)p.ws + wd.dst_off + (size_t)r * wd.dst_stride, wd.map, wd.row_off, scr, iq % per, lane); } }
        }
        base += n_it;
    }
}
__device__ __forceinline__ void phase_p0(const Params& p, LAS unsigned char* lds) {
    const int tid = ltid(), lane = tid & 63, wave = tid >> 6;
    const int gw = blockIdx.x * 8 + wave, NGW = gridDim.x * 8;
    convert_weights(p, lds, 0, WD_EARLY);
    bf16_t* xn = (bf16_t*)(p.ws + R_XN);
    for (int m = gw; m < T; m += 2 * NGW) { rms_row_to_bf16(p.in[0] + (size_t)m * D, p.in[2], xn + (size_t)m * D, lane); if (m + NGW < T) rms_row_to_bf16(p.in[0] + (size_t)(m + NGW) * D, p.in[2], xn + (size_t)(m + NGW) * D, lane); }
    for (int u = gw; u < 256; u += NGW) {
        const int kc = u >> 3, kv = (u >> 2) & 1, nb = u & 3; float s = 0.f;
        const float* pos = p.in[6] + kv * 2048 + kc * 64; const float* w1 = p.in[7] + ((size_t)kv * 2048 + kc * 64) * 256 + nb * 64 + lane;
#pragma unroll 8
        for (int k = 0; k < 64; ++k) s += pos[k] * w1[(size_t)k * 256];
        ((float*)(p.ws + SM_B1P))[kc * 512 + kv * 256 + nb * 64 + lane] = s;
    }
    for (int i = blockIdx.x * 512 + tid; i < S * 16; i += gridDim.x * 512) {
        const int t = i >> 4, f = i & 15; const float ang = (float)t * powf(10000.f, -(float)f / 16.f);
        float* rp = (float*)(p.ws + SM_ROPE) + t * 32; rp[f] = cosf(ang); rp[16 + f] = sinf(ang);
    }
    if (blockIdx.x == 0) for (int i = tid; i < 8 * 129; i += 512) { const int h = i / 129, dd = i % 129; ((float*)(p.ws + SM_BL))[h * 132 + dd] = p.in[1][(dd < 128 ? (int)gold::T5B[dd] : 31) * 8 + h] * LOG2E; }
}

__device__ __forceinline__ void unpack8(const u32x4 v, float (&x)[8]) { x[0] = bflo(v.x); x[1] = bfhi(v.x); x[2] = bflo(v.y); x[3] = bfhi(v.y); x[4] = bflo(v.z); x[5] = bfhi(v.z); x[6] = bflo(v.w); x[7] = bfhi(v.w); }
__device__ __forceinline__ u32x4 pack8(const float (&x)[8]) { u32x4 w; w.x = cvtpk(x[0], x[1]); w.y = cvtpk(x[2], x[3]); w.z = cvtpk(x[4], x[5]); w.w = cvtpk(x[6], x[7]); return w; }
__device__ __forceinline__ float ss8f(const float (&x)[8]) { return ((x[0] * x[0] + x[1] * x[1]) + (x[2] * x[2] + x[3] * x[3])) + ((x[4] * x[4] + x[5] * x[5]) + (x[6] * x[6] + x[7] * x[7])); }
__device__ __forceinline__ void load8f(const float* g, float (&x)[8], float sc) { const f32x4 a = *(const f32x4*)g, b = *(const f32x4*)(g + 4); x[0] = a.x * sc; x[1] = a.y * sc; x[2] = a.z * sc; x[3] = a.w * sc; x[4] = b.x * sc; x[5] = b.y * sc; x[6] = b.z * sc; x[7] = b.w * sc; }
__device__ __forceinline__ void phase_p2(const Params& p, LAS unsigned char* lds) {
    const int tid = ltid(), lane = tid & 63, wave = tid >> 6;
    const bf16_t* hb = (const bf16_t*)(p.ws + R_H);
    unsigned char* xa = p.ws + R_XA;
    bf16_t* qn = (bf16_t*)(xa + A_QN); bf16_t* ksn = (bf16_t*)(xa + A_KSN); bf16_t* kwn = (bf16_t*)(xa + A_KWN);
    bf16_t* vst = (bf16_t*)(xa + A_VST); bf16_t* vwt = (bf16_t*)(xa + A_VWT); bf16_t* kcin = (bf16_t*)(xa + A_KCIN); bf16_t* vcin = (bf16_t*)(xa + A_VCIN);
    bf16_t* cqn = (bf16_t*)(xa + A_CQN); bf16_t* ckvn = (bf16_t*)(xa + A_CKVN); bf16_t* krope = (bf16_t*)(xa + A_KROPE); float* gates = (float*)(xa + A_GATES);
    LAS bf16_t* vs = (LAS bf16_t*)lds;
    if (blockIdx.x == 0) {
        { float s = 0.f; for (int k = 0; k < 32; ++k) s += ((const float*)(p.ws + SM_B1P))[k * 512 + tid]; ((float*)(p.ws + SM_B1))[tid] = s; }
        for (int i = tid; i < 1024; i += 512) { kcin[(size_t)T * 128 + i] = 0; vcin[(size_t)T * 128 + i] = 0; }
    }
    const int c8 = (lane & 7) * 8, seg = lane >> 3;
    float qg[8], ksg[8], kwg[8], cqg[8], ckvg[8];
    load8f(p.in[4] + c8, qg, 0.125f * LOG2E); load8f(p.in[5] + 64 + c8, ksg, 1.f); load8f(p.in[5] + 128 + c8, kwg, 1.f);
    load8f(p.in[9] + (lane & 31) * 8, cqg, 1.f); load8f(p.in[10] + (lane & 15) * 8, ckvg, 1.f);
    for (int tile = blockIdx.x; tile < T / 64; tile += gridDim.x) {
        const int b = tile / (S / 64), s0 = (tile % (S / 64)) * 64;
#pragma unroll 4
        for (int tt = 0; tt < 8; ++tt) {
            const int sl = wave * 8 + tt, s = s0 + sl; const size_t t = (size_t)b * S + s;
            const bf16_t* hr = hb + t * 1792 + lane * 8;
            const u32x4 L0 = *(const u32x4*)hr, L1 = *(const u32x4*)(hr + 512), L2 = *(const u32x4*)(hr + 1024);
            u32x4 L3 = {0u, 0u, 0u, 0u}; if (lane < 32) L3 = *(const u32x4*)(hr + 1536);
            float x0[8], x1[8], x2[8], x3[8];
            unpack8(L0, x0); unpack8(L1, x1); unpack8(L2, x2); unpack8(L3, x3);
            float a0 = ss8f(x0), a1 = ss8f(x1), a2 = ss8f(x2), a3 = ss8f(x3);
#pragma unroll
            for (int o = 1; o < 8; o <<= 1) { a0 += __shfl_xor(a0, o); a1 += __shfl_xor(a1, o); a2 += __shfl_xor(a2, o); a3 += __shfl_xor(a3, o); }
            float a2w = a2 + __shfl_xor(a2, 8); a2w += __shfl_xor(a2w, 16);
            const float a3w = a3 + __shfl_xor(a3, 8);
            const int pp0 = (sl & ~15) | perm16(sl & 15);
            const int pp = (((pp0 >> 3) ^ (lane & 7)) << 3) | (pp0 & 7);
            {
                const float r = rsqrtf(a0 * (1.f / 64.f) + EPS); float y[8];
#pragma unroll
                for (int j = 0; j < 8; ++j) y[j] = x0[j] * r * qg[j];
                *(u32x4*)(qn + t * 512 + lane * 8) = pack8(y);
            }
            {
                const int g = seg & 1; const size_t gm = (((size_t)b * 2 + g) * S + s) * 64 + c8;
                if (seg < 2) *(u32x4*)(kcin + gm) = L1;
                else if (seg < 4) *(u32x4*)(vcin + gm) = L1;
                else if (seg < 6) { const float r = rsqrtf(a1 * (1.f / 64.f) + EPS); float y[8];
#pragma unroll
                    for (int j = 0; j < 8; ++j) y[j] = x1[j] * r * ksg[j];
                    *(u32x4*)(ksn + gm) = pack8(y); }
                else {
#pragma unroll
                    for (int j = 0; j < 8; ++j) vs[((0 + g) * 64 + c8 + j) * 72 + pp] = (bf16_t)((j & 1) ? (L1[j >> 1] >> 16) : (L1[j >> 1] & 0xffffu)); }
            }
            {
                const int g = seg & 1; const size_t gm = (((size_t)b * 2 + g) * S + s) * 64 + c8;
                if (seg < 2) { const float r = rsqrtf(a2 * (1.f / 64.f) + EPS); float y[8];
#pragma unroll
                    for (int j = 0; j < 8; ++j) y[j] = x2[j] * r * kwg[j];
                    *(u32x4*)(kwn + gm) = pack8(y); }
                else if (seg < 4) {
#pragma unroll
                    for (int j = 0; j < 8; ++j) vs[((2 + g) * 64 + c8 + j) * 72 + pp] = (bf16_t)((j & 1) ? (L2[j >> 1] >> 16) : (L2[j >> 1] & 0xffffu)); }
                else { const float r = rsqrtf(a2w * (1.f / 256.f) + EPS); float y[8];
#pragma unroll
                    for (int j = 0; j < 8; ++j) y[j] = x2[j] * r * cqg[j];
                    *(u32x4*)(cqn + t * 256 + (lane - 32) * 8) = pack8(y); }
            }
            {
                if (lane < 16) { const float r = rsqrtf(a3w * (1.f / 128.f) + EPS); float y[8];
#pragma unroll
                    for (int j = 0; j < 8; ++j) y[j] = x3[j] * r * ckvg[j];
                    *(u32x4*)(ckvn + t * 128 + lane * 8) = pack8(y); }
                else if (lane < 20) *(u32x4*)(krope + t * 32 + (lane - 16) * 8) = L3;
                else if (lane < 23) { float y[8];
#pragma unroll
                    for (int j = 0; j < 8; ++j) y[j] = frcp(1.f + fexp2(-x3[j] * LOG2E));
                    float* gp = gates + t * 24 + (lane - 20) * 8; *(f32x4*)gp = (f32x4){y[0], y[1], y[2], y[3]}; *(f32x4*)(gp + 4) = (f32x4){y[4], y[5], y[6], y[7]}; }
            }
        }
        __syncthreads();
        {
            const int row = tid >> 1, half = tid & 1, which = row >> 6, d = row & 63, g = which & 1;
            bf16_t* dst = ((which < 2) ? vst : vwt) + (((size_t)b * 2 + g) * 64 + d) * S + s0 + half * 32;
            const LAS bf16_t* src = vs + row * 72; const int sx = (row >> 3) & 7;
#pragma unroll
            for (int c = 0; c < 4; ++c) *(u32x4*)(dst + c * 8) = *(const LAS u32x4*)(src + (((half * 4 + c) ^ sx) << 3));
        }
        __syncthreads();
    }
}
__device__ __forceinline__ void phase_p3b(const Params& p, LAS unsigned char* lds) {
    const int tid = ltid(), lane = tid & 63, wave = tid >> 6;
    const int gw = blockIdx.x * 8 + wave, NGW = gridDim.x * 8;
    const bf16_t* qraw = (const bf16_t*)(p.ws + R_H);
    const bf16_t* kvraw = (const bf16_t*)(p.ws + R_H + (size_t)T * 2048);
    const bf16_t* krope = (const bf16_t*)(p.ws + R_XA + A_KROPE);
    const float* rope = (const float*)(p.ws + SM_ROPE);
    bf16_t* qm = (bf16_t*)((unsigned char*)p.out + O_QM); bf16_t* km = (bf16_t*)((unsigned char*)p.out + O_KM); bf16_t* vmt = (bf16_t*)((unsigned char*)p.out + O_VMT);
    const float* q_norm = p.in[13]; const float* k_norm = p.in[14];
    LAS bf16_t* vs = (LAS bf16_t*)lds;
    LAS float* w2s = (LAS float*)(lds + 73728);
    for (int kv = 0; kv < 2; ++kv) {
        __syncthreads();
        for (int i = tid; i < 256 * 64; i += 512) w2s[i] = p.in[8][kv * 16384 + i];
        __syncthreads();
        const bf16_t* P = (const bf16_t*)(p.ws + SM_HID) + (size_t)kv * NB * 512 * 512;
        const f32x4 bs = *(const f32x4*)((const float*)(p.ws + SM_B1) + kv * 256 + lane * 4);
        for (int row = gw; row < NB * 512; row += NGW) {
            const int row1 = row + 1 < NB * 512 ? row + 1 : row;
            const u32x2 pa = *(const u32x2*)(P + (size_t)row * 512 + lane * 4), pb = *(const u32x2*)(P + (size_t)row1 * 512 + 256 + lane * 4);
            const float h0 = gelu_tanh_f(bflo(pa.x) + bflo(pb.x) + bs.x), h1 = gelu_tanh_f(bfhi(pa.x) + bfhi(pb.x) + bs.y), h2 = gelu_tanh_f(bflo(pa.y) + bflo(pb.y) + bs.z), h3 = gelu_tanh_f(bfhi(pa.y) + bfhi(pb.y) + bs.w);
            float acc = 0.f;
#pragma unroll 8
            for (int k4 = 0; k4 < 64; ++k4) {
                acc += __shfl(h0, k4) * w2s[(k4 * 4 + 0) * 64 + lane]; acc += __shfl(h1, k4) * w2s[(k4 * 4 + 1) * 64 + lane];
                acc += __shfl(h2, k4) * w2s[(k4 * 4 + 2) * 64 + lane]; acc += __shfl(h3, k4) * w2s[(k4 * 4 + 3) * 64 + lane];
            }
            if (kv == 0) { const float r = rsqrtf(wsum(acc * acc) * (1.f / 64.f) + EPS); ((bf16_t*)(p.ws + SM_KC))[(size_t)row * 64 + lane] = f2bf(acc * r * p.in[5][lane]); }
            else { const int c = row & 255; ((bf16_t*)(p.ws + SM_VCT))[((size_t)(row >> 8) * 64 + lane) * 256 + ((c & ~15) | perm16(c & 15))] = f2bf(acc); }
        }
    }
    __syncthreads();
    const float QS = 0.10206207261596577f * LOG2E;
    const int c = lane & 15, hl = lane >> 4;
    float qg[8], kg[8];
    load8f(q_norm + (c < 12 ? c * 8 : 0), qg, QS);
    load8f(k_norm + (c < 12 ? c * 8 : 0), kg, 1.f);
    for (int tile = blockIdx.x; tile < T / 64; tile += gridDim.x) {
        const int b = tile / (S / 64), s0 = (tile % (S / 64)) * 64;
#pragma unroll 4
        for (int tt = 0; tt < 8; ++tt) {
            const int sl = wave * 8 + tt, s = s0 + sl; const size_t t = (size_t)b * S + s;
            const int pp0 = (sl & ~15) | perm16(sl & 15);
            const int pp = (((pp0 >> 3) ^ ((c - 8) & 7)) << 3) | (pp0 & 7);
            u32x4 Q[2], KV[2];
#pragma unroll
            for (int ld = 0; ld < 2; ++ld) { Q[ld] = *(const u32x4*)(qraw + t * 1024 + ld * 512 + lane * 8); KV[ld] = *(const u32x4*)(kvraw + t * 1024 + ld * 512 + lane * 8); }
            u32x4 KR = {0u, 0u, 0u, 0u}; f32x4 cs0 = {0.f, 0.f, 0.f, 0.f}, cs1 = cs0, sn0 = cs0, sn1 = cs0;
            if (c >= 8 && c < 12) { KR = *(const u32x4*)(krope + t * 32 + (c - 8) * 8);
                const float* rp = rope + s * 32 + (c & 1) * 8; cs0 = *(const f32x4*)rp; cs1 = *(const f32x4*)(rp + 4); sn0 = *(const f32x4*)(rp + 16); sn1 = *(const f32x4*)(rp + 20); }
            const float cs[8] = {cs0.x, cs0.y, cs0.z, cs0.w, cs1.x, cs1.y, cs1.z, cs1.w}, sn[8] = {sn0.x, sn0.y, sn0.z, sn0.w, sn1.x, sn1.y, sn1.z, sn1.w};
            float kr[8]; unpack8(KR, kr);
            const float krs = ss8f(kr);
#pragma unroll
            for (int ld = 0; ld < 2; ++ld) {
                const int hh = ld * 4 + hl;
                {
                    float x[8]; unpack8(Q[ld], x);
                    float ss = c < 12 ? ss8f(x) : 0.f;
#pragma unroll
                    for (int o = 1; o < 16; o <<= 1) ss += __shfl_xor(ss, o);
                    const float r = rsqrtf(ss * (1.f / 96.f) + EPS); float y[8], z[8];
#pragma unroll
                    for (int j = 0; j < 8; ++j) y[j] = x[j] * r * qg[j];
#pragma unroll
                    for (int j = 0; j < 8; ++j) { const float pb = __shfl_xor(y[j], 2); z[j] = (c < 8) ? y[j] : ((c < 10) ? (y[j] * cs[j] - pb * sn[j]) : (pb * sn[j] + y[j] * cs[j])); }
                    if (c < 12) *(u32x4*)(qm + (t * 8 + hh) * 96 + c * 8) = pack8(z);
                }
                {
                    float x[8]; unpack8(KV[ld], x);
                    float ss = c < 8 ? ss8f(x) : krs;
#pragma unroll
                    for (int o = 1; o < 16; o <<= 1) ss += __shfl_xor(ss, o);
                    const float r = rsqrtf(ss * (1.f / 96.f) + EPS); float y[8], z[8];
#pragma unroll
                    for (int j = 0; j < 8; ++j) y[j] = (c < 8 ? x[j] : kr[j]) * r * kg[j];
#pragma unroll
                    for (int j = 0; j < 8; ++j) { const float pb = __shfl_xor(y[j], 2); z[j] = (c < 8) ? y[j] : ((c < 10) ? (y[j] * cs[j] - pb * sn[j]) : (pb * sn[j] + y[j] * cs[j])); }
                    if (c < 12) *(u32x4*)(km + (((size_t)b * 8 + hh) * S + s) * 96 + c * 8) = pack8(z);
                    if (c >= 8) {
#pragma unroll
                        for (int j = 0; j < 8; ++j) vs[(hh * 64 + (c - 8) * 8 + j) * 72 + pp] = (bf16_t)((j & 1) ? (KV[ld][j >> 1] >> 16) : (KV[ld][j >> 1] & 0xffffu)); }
                }
            }
        }
        __syncthreads();
        {
            const int hh = tid >> 6, d = tid & 63;
            bf16_t* dst = vmt + (((size_t)b * 8 + hh) * 64 + d) * S + s0;
            const LAS bf16_t* src = vs + tid * 72; const int sx = (tid >> 3) & 7;
#pragma unroll
            for (int cc = 0; cc < 8; ++cc) *(u32x4*)(dst + cc * 8) = *(const LAS u32x4*)(src + ((cc ^ sx) << 3));
        }
        __syncthreads();
    }
}

__device__ const unsigned short UNIT_TYPES[256] = {63,127,62,126,61,125,527,591,655,719,783,847,911,975,60,124,59,123,58,122,57,121,56,120,526,590,654,718,782,846,910,974,55,119,54,118,53,117,52,116,51,115,525,589,653,717,781,845,909,973,50,114,49,113,48,112,47,111,524,588,652,716,780,844,908,972,46,110,45,109,44,108,43,107,523,587,651,715,779,843,907,971,42,106,41,105,40,104,39,103,38,102,522,586,650,714,778,842,906,970,37,101,36,100,35,99,34,98,33,97,521,585,649,713,777,841,905,969,32,96,31,95,30,94,520,584,648,712,776,840,904,968,29,93,28,92,27,91,26,90,25,89,519,583,647,711,775,839,903,967,24,88,23,87,22,86,21,85,20,84,518,582,646,710,774,838,902,966,19,83,18,82,17,81,16,80,15,79,517,581,645,709,773,837,901,965,14,78,13,77,12,76,516,580,644,708,772,836,900,964,11,75,10,74,9,73,8,72,515,579,643,707,771,835,899,963,7,71,6,70,5,69,514,578,642,706,770,834,898,962,4,68,3,67,513,577,641,705,769,833,897,961,2,66,1,65,0,64,512,576,640,704,768,832,896,960};
__device__ __forceinline__ int crow(int r, int hi) { return (r & 3) + 8 * (r >> 2) + 4 * hi; }
struct Flash { f32x16 o0, o1; float l; };
__device__ __forceinline__ void flash_init(Flash& st) {
#pragma unroll
    for (int r = 0; r < 16; ++r) { st.o0[r] = 0.f; st.o1[r] = 0.f; }
    st.l = 0.f;
}
constexpr int AL_K64 = 0, AL_V64 = 3 * 8192;
constexpr int AL_K96 = 0, AL_V96 = 3 * 16384;
constexpr int AL_IMP = 49152, AL_SELB = AL_IMP + 64 * 65 * 4, AL_UNI = AL_SELB + 512, AL_TL = AL_UNI + 64, AL_BL = AL_TL + 128, AL_OT = AL_BL + 4 * 132 * 4, AL_END = AL_OT + 8 * 32 * 64 * 4;
static_assert(AL_END <= 139264 && AL_V96 + 3 * 8192 <= 139264, "attention LDS");

template <int RB> struct DmaLane { unsigned g0, g1; };
template <int RB> __device__ __forceinline__ void dma_setup(DmaLane<RB>& L, int w, int lane, unsigned gs) {
    if (RB == 128) { const int r = 8 * w + (lane >> 3), c = (lane & 7) ^ ((r >> 1) & 7); L.g0 = (unsigned)r * gs + c * 16; L.g1 = 0; }
    else {
        { const int r = 8 * w + (lane >> 4); int c = (lane & 15) ^ (r & 15); c = c >= 12 ? c - 4 : c; L.g0 = (unsigned)r * gs + c * 16; }
        { const int r = 8 * w + 4 + (lane >> 4); int c = (lane & 15) ^ (r & 15); c = c >= 12 ? c - 4 : c; L.g1 = (unsigned)r * gs + c * 16; }
    }
}
template <int RB> __device__ __forceinline__ void dma_issue(const unsigned char* tile, const DmaLane<RB>& L, LAS unsigned char* buf, int w) {
    if (RB == 128) __builtin_amdgcn_global_load_lds((const unsigned*)(tile + L.g0), (LAS unsigned*)(buf + w * 1024), 16, 0, 0);
    else { __builtin_amdgcn_global_load_lds((const unsigned*)(tile + L.g0), (LAS unsigned*)(buf + w * 2048), 16, 0, 0);
           __builtin_amdgcn_global_load_lds((const unsigned*)(tile + L.g1), (LAS unsigned*)(buf + w * 2048 + 1024), 16, 0, 0); }
}
template <int DK> __device__ __forceinline__ void frag_offsets(unsigned (&kl)[DK / 16], unsigned (&vl)[4], int r32, int hi) {
#pragma unroll
    for (int s = 0; s < DK / 16; ++s) kl[s] = (DK == 64) ? (unsigned)(r32 * 128 + (((2 * s + hi) ^ ((r32 >> 1) & 7)) << 4)) : (unsigned)(r32 * 256 + (((2 * s + hi) ^ (r32 & 15)) << 4));
#pragma unroll
    for (int s = 0; s < 4; ++s) vl[s] = (unsigned)(r32 * 128 + (((2 * s + hi) ^ ((r32 >> 1) & 7)) << 4));
}

template <int DK, int KP, bool LANEMASK, class F>
__device__ __forceinline__ void tile_compute(Flash& st, const LAS unsigned char* Kt, const LAS unsigned char* Vt, const bf16x8* qf, const f32x16& negm, const unsigned (&kl)[DK / 16], const unsigned (&vl)[4], bool mine, F f) {
    constexpr int NS = DK / 16; constexpr int KH = 32 * KP;
    bf16x8 ka[NS], kh[NS];
#pragma unroll
    for (int s = 0; s < NS; ++s) ka[s] = *(const LAS bf16x8*)(Kt + kl[s]);
#pragma unroll
    for (int s = 0; s < NS; ++s) kh[s] = *(const LAS bf16x8*)(Kt + kl[s] + KH);
    __builtin_amdgcn_sched_barrier(0);
    f32x16 p0, p1;
#pragma unroll
    for (int s = 0; s < NS; ++s) p0 = (s == 0) ? __builtin_amdgcn_mfma_f32_32x32x16_bf16(ka[0], qf[0], negm, 0, 0, 0) : __builtin_amdgcn_mfma_f32_32x32x16_bf16(ka[s], qf[s], p0, 0, 0, 0);
#pragma unroll
    for (int s = 0; s < NS; ++s) p1 = (s == 0) ? __builtin_amdgcn_mfma_f32_32x32x16_bf16(kh[0], qf[0], negm, 0, 0, 0) : __builtin_amdgcn_mfma_f32_32x32x16_bf16(kh[s], qf[s], p1, 0, 0, 0);
    bf16x8 va[4], vh[4];
#pragma unroll
    for (int s = 0; s < 4; ++s) { va[s] = *(const LAS bf16x8*)(Vt + vl[s]); vh[s] = *(const LAS bf16x8*)(Vt + vl[s] + 4096); }
    __builtin_amdgcn_sched_barrier(0);
    float ls = 0.f, ls1 = 0.f;
    u32x4 w0, w1, w2, w3;
    {
#pragma unroll
        for (int r = 0; r < 16; ++r) { float x = p0[r]; const bool v = f(r, 0, x); const float e = fexp2(x); p0[r] = v ? e : 0.f; ls += p0[r]; }
        w0.x = cvtpk(p0[0], p0[1]); w0.y = cvtpk(p0[2], p0[3]); w0.z = cvtpk(p0[4], p0[5]); w0.w = cvtpk(p0[6], p0[7]);
        w1.x = cvtpk(p0[8], p0[9]); w1.y = cvtpk(p0[10], p0[11]); w1.z = cvtpk(p0[12], p0[13]); w1.w = cvtpk(p0[14], p0[15]);
        if (LANEMASK) { w0.x = mine ? w0.x : 0u; w0.y = mine ? w0.y : 0u; w0.z = mine ? w0.z : 0u; w0.w = mine ? w0.w : 0u; w1.x = mine ? w1.x : 0u; w1.y = mine ? w1.y : 0u; w1.z = mine ? w1.z : 0u; w1.w = mine ? w1.w : 0u; }
    }
#pragma unroll
    for (int s = 0; s < 2; ++s) {
        const bf16x8 pa = __builtin_bit_cast(bf16x8, s ? w1 : w0);
        st.o0 = __builtin_amdgcn_mfma_f32_32x32x16_bf16(pa, va[s], st.o0, 0, 0, 0);
        st.o1 = __builtin_amdgcn_mfma_f32_32x32x16_bf16(pa, vh[s], st.o1, 0, 0, 0);
    }
    {
#pragma unroll
        for (int r = 0; r < 16; ++r) { float x = p1[r]; const bool v = f(r, 1, x); const float e = fexp2(x); p1[r] = v ? e : 0.f; ls1 += p1[r]; }
        w2.x = cvtpk(p1[0], p1[1]); w2.y = cvtpk(p1[2], p1[3]); w2.z = cvtpk(p1[4], p1[5]); w2.w = cvtpk(p1[6], p1[7]);
        w3.x = cvtpk(p1[8], p1[9]); w3.y = cvtpk(p1[10], p1[11]); w3.z = cvtpk(p1[12], p1[13]); w3.w = cvtpk(p1[14], p1[15]);
        if (LANEMASK) { w2.x = mine ? w2.x : 0u; w2.y = mine ? w2.y : 0u; w2.z = mine ? w2.z : 0u; w2.w = mine ? w2.w : 0u; w3.x = mine ? w3.x : 0u; w3.y = mine ? w3.y : 0u; w3.z = mine ? w3.z : 0u; w3.w = mine ? w3.w : 0u; }
    }
    ls += ls1;
    if (LANEMASK) ls = mine ? ls : 0.f;
    st.l += ls;
#pragma unroll
    for (int s = 2; s < 4; ++s) {
        const bf16x8 pa = __builtin_bit_cast(bf16x8, (s == 3) ? w3 : w2);
        st.o0 = __builtin_amdgcn_mfma_f32_32x32x16_bf16(pa, va[s], st.o0, 0, 0, 0);
        st.o1 = __builtin_amdgcn_mfma_f32_32x32x16_bf16(pa, vh[s], st.o1, 0, 0, 0);
    }
}
template <int DK, int KP> __device__ __forceinline__ void qk_tile(f32x16& p0, f32x16& p1, const LAS unsigned char* Kt, const bf16x8* qf, const f32x16& negm, const unsigned (&kl)[DK / 16]) {
#pragma unroll
    for (int s = 0; s < DK / 16; ++s) {
        const bf16x8 a0 = *(const LAS bf16x8*)(Kt + kl[s]);
        const bf16x8 a1 = *(const LAS bf16x8*)(Kt + kl[s] + 32 * KP);
        if (s == 0) { p0 = __builtin_amdgcn_mfma_f32_32x32x16_bf16(a0, qf[0], negm, 0, 0, 0); p1 = __builtin_amdgcn_mfma_f32_32x32x16_bf16(a1, qf[0], negm, 0, 0, 0); }
        else { p0 = __builtin_amdgcn_mfma_f32_32x32x16_bf16(a0, qf[s], p0, 0, 0, 0); p1 = __builtin_amdgcn_mfma_f32_32x32x16_bf16(a1, qf[s], p1, 0, 0, 0); }
    }
}
template <bool FIRST> __device__ __forceinline__ void flash_accum(LAS float* otl, const Flash& st, float gate, int hi, int lane) {
    const float lt = st.l + __shfl_xor(st.l, 32);
    const float f = lt > 0.f ? gate * frcp(lt) : 0.f;
#pragma unroll
    for (int r = 0; r < 16; ++r) { const float fr_ = __shfl(f, crow(r, hi));
        if (FIRST) { otl[r * 64 + lane] = fr_ * st.o0[r]; otl[(16 + r) * 64 + lane] = fr_ * st.o1[r]; }
        else { otl[r * 64 + lane] += fr_ * st.o0[r]; otl[(16 + r) * 64 + lane] += fr_ * st.o1[r]; } }
}
template <int NS> __device__ __forceinline__ float qnorm2(const bf16x8* qf) {
    float s = 0.f;
#pragma unroll
    for (int i = 0; i < NS; ++i)
#pragma unroll
        for (int j = 0; j < 8; ++j) { const float x = bf2f((bf16_t)qf[i][j]); s += x * x; }
    return s + __shfl_xor(s, 32);
}
__device__ __forceinline__ float wmax(float v) {
#pragma unroll
    for (int o = 1; o < 64; o <<= 1) v = fmaxf(v, __shfl_xor(v, o));
    return v;
}

struct NoComp {};
template <class T> struct is_nocomp { static constexpr bool v = false; };
template <> struct is_nocomp<NoComp> { static constexpr bool v = true; };
template <class C> __device__ __forceinline__ void rt_call(C& c, int t, LAS unsigned char* kb, LAS unsigned char* vb) { c(t, kb, vb); }
__device__ __forceinline__ void rt_call(NoComp&, int, LAS unsigned char*, LAS unsigned char*) {}
template <int RBK, bool HASV, int KOFF, int KSZ, int VOFF, class SrcK, class SrcV, class C0, class C1, class C2>
__device__ __forceinline__ void run_tiles(int n, int e0, int e1, int e2, LAS unsigned char* lds, int w, int lane, unsigned gsK, unsigned gsV, SrcK srcK, SrcV srcV, C0 c0, C1 c1, C2 c2) {
    DmaLane<RBK> LK; dma_setup<RBK>(LK, w, lane, gsK);
    DmaLane<128> LV; LV.g0 = 0; LV.g1 = 0; if (HASV) dma_setup<128>(LV, w, lane, gsV);
    const int nl = n - 1, t1 = nl < 1 ? nl : 1;
    e0 = __builtin_amdgcn_readfirstlane(e0); e1 = __builtin_amdgcn_readfirstlane(e1); e2 = __builtin_amdgcn_readfirstlane(e2);
    dma_issue<RBK>(srcK(0), LK, lds + KOFF, w); if (HASV) dma_issue<128>(srcV(0), LV, lds + VOFF, w);
    dma_issue<RBK>(srcK(t1), LK, lds + KOFF + KSZ, w); if (HASV) dma_issue<128>(srcV(t1), LV, lds + VOFF + 8192, w);
    constexpr int P = (RBK == 128 ? 1 : 2) + (HASV ? 1 : 0);
    int t = 0, slot = 0;
#define RT_HEAD() do { \
        if (P == 1) asm volatile("s_waitcnt vmcnt(1)" ::: "memory"); else if (P == 2) asm volatile("s_waitcnt vmcnt(2)" ::: "memory"); else asm volatile("s_waitcnt vmcnt(3)" ::: "memory"); \
        __builtin_amdgcn_s_barrier(); asm volatile("" ::: "memory"); \
        { const int tn = (t + 2 < nl) ? t + 2 : nl; const int s2 = slot == 0 ? 2 : slot - 1; \
          dma_issue<RBK>(srcK(tn), LK, lds + KOFF + s2 * KSZ, w); if (HASV) dma_issue<128>(srcV(tn), LV, lds + VOFF + s2 * 8192, w); } } while (0)
#define RT_SEG(cc, ee) if (!is_nocomp<decltype(cc)>::v) { _Pragma("unroll 1") for (; t < (ee); ++t) { RT_HEAD(); rt_call(cc, t, lds + KOFF + slot * KSZ, lds + VOFF + slot * 8192); slot = slot == 2 ? 0 : slot + 1; } }
    RT_SEG(c0, e0)
    RT_SEG(c1, e1)
    RT_SEG(c2, e2)
#pragma unroll 1
    for (; t < n; ++t) { RT_HEAD(); slot = slot == 2 ? 0 : slot + 1; }
#undef RT_SEG
#undef RT_HEAD
    asm volatile("s_waitcnt vmcnt(0)" ::: "memory");
    __syncthreads();
}

__device__ __forceinline__ void mla_unit(const Params& p, LAS unsigned char* lds, int b, int h, int qb) {
    int tid = threadIdx.x; asm volatile("" : "+v"(tid));
    const int lane = tid & 63, w = __builtin_amdgcn_readfirstlane(tid >> 6), r32 = lane & 31, hi = lane >> 5;
    const bf16_t* qm = (const bf16_t*)((const unsigned char*)p.out + O_QM);
    const unsigned char* km = (const unsigned char*)p.out + O_KM + (((size_t)b * 8 + h) * S) * 192;
    const unsigned char* vmt = (const unsigned char*)p.out + O_VMT + (((size_t)b * 8 + h) * 64) * (size_t)S * 2;
    bf16_t* ocat = (bf16_t*)(p.ws + R_XN);
    const int tq = qb * 256 + 32 * w + r32;
    bf16x8 qf[6];
#pragma unroll
    for (int s = 0; s < 6; ++s) qf[s] = *(const bf16x8*)(qm + (((size_t)b * S + tq) * 8 + h) * 96 + 16 * s + 8 * hi);
    const float kn = 9.797958971f * 1.01f * wmax(fmaxf(fabsf(p.in[14][lane]), lane < 32 ? fabsf(p.in[14][64 + lane]) : 0.f));
    const float mref = sqrtf(qnorm2<6>(qf)) * kn;
    f32x16 negm;
#pragma unroll
    for (int r = 0; r < 16; ++r) negm[r] = -mref;
    Flash st; flash_init(st);
    const int ntile = 4 * qb + 4, dt = 4 * qb + (w >> 1);
#ifdef PROF_SEL
    if (b == 0 && h == 0 && qb == 15 && threadIdx.x == 0) { *PROF_SLOT(36) -= __builtin_amdgcn_s_memtime(); *PROF_SLOT(37) -= __builtin_amdgcn_s_memrealtime(); }
#endif
    unsigned kl[6], vl[4]; frag_offsets<96>(kl, vl, r32, hi);
    run_tiles<192, true, AL_K96, 16384, AL_V96>(ntile, dt, dt + 1, dt + 1, lds, w, lane, 192u, (unsigned)(S * 2),
        [&](int i) { return km + (size_t)i * 64 * 192; }, [&](int i) { return vmt + (size_t)i * 128; },
        [&](int i, LAS unsigned char* kb, LAS unsigned char* vb) { tile_compute<96, 256, false>(st, kb, vb, qf, negm, kl, vl, true, [&](int r, int half, float& x) { return true; }); },
        [&](int i, LAS unsigned char* kb, LAS unsigned char* vb) { const int kb0 = 64 * i + 4 * hi; tile_compute<96, 256, false>(st, kb, vb, qf, negm, kl, vl, true, [&](int r, int half, float& x) { return (kb0 + 32 * half + (r & 3) + 8 * (r >> 2)) <= tq; }); },
        NoComp{});
#ifdef PROF_SEL
    if (b == 0 && h == 0 && qb == 15 && threadIdx.x == 0) { *PROF_SLOT(36) += __builtin_amdgcn_s_memtime(); *PROF_SLOT(37) += __builtin_amdgcn_s_memrealtime(); }
#endif
    {
        const float lt = st.l + __shfl_xor(st.l, 32); const float f = lt > 0.f ? frcp(lt) : 0.f;
#pragma unroll
        for (int r = 0; r < 16; ++r) { const float fr_ = __shfl(f, crow(r, hi)); const size_t ro = ((size_t)b * S + qb * 256 + 32 * w + crow(r, hi)) * 1024 + 512 + h * 64 + r32; ocat[ro] = f2bf(st.o0[r] * fr_); ocat[ro + 32] = f2bf(st.o1[r] * fr_); }
    }
}

__device__ __forceinline__ void nsa_unit(const Params& p, LAS unsigned char* lds, int b, int g, int jt) {
    int tid = threadIdx.x; asm volatile("" : "+v"(tid));
    const int lane = tid & 63, w = __builtin_amdgcn_readfirstlane(tid >> 6), r32 = lane & 31, hi = lane >> 5;
    const int rh = w >> 1, qh = w & 1, h = 4 * g + rh, q0 = 64 * jt, ql = 32 * qh + r32, tq = q0 + ql;
    const unsigned char* xa = p.ws + R_XA;
    const bf16_t* qn = (const bf16_t*)(xa + A_QN);
    const size_t bg = (size_t)b * 2 + g;
    const unsigned char* ksn = xa + A_KSN + bg * S * 128; const unsigned char* kwn = xa + A_KWN + bg * S * 128;
    const unsigned char* vst = xa + A_VST + bg * 64 * (size_t)S * 2; const unsigned char* vwt = xa + A_VWT + bg * 64 * (size_t)S * 2;
    const unsigned char* kc = p.ws + SM_KC + bg * 256 * 128; const unsigned char* vct = p.ws + SM_VCT + bg * 64 * 512;
    const float* gates = (const float*)(xa + A_GATES) + ((size_t)b * S + tq) * 24 + h * 3;
    bf16_t* ocat = (bf16_t*)(p.ws + R_XN);
    LAS float* imp = (LAS float*)(lds + AL_IMP); LAS unsigned char* selb = lds + AL_SELB; LAS unsigned* uni = (LAS unsigned*)(lds + AL_UNI); LAS unsigned char* tl = lds + AL_TL; LAS float* bls = (LAS float*)(lds + AL_BL);
    const float* blg = (const float*)(p.ws + SM_BL) + h * 132;
    const float cb = blg[128];
    const float bmax = wmax(fmaxf(fmaxf(blg[lane], blg[64 + lane]), cb));
    if (qh == 0) { bls[rh * 132 + lane] = blg[lane] - cb; bls[rh * 132 + 64 + lane] = blg[64 + lane] - cb; if (lane == 0) bls[rh * 132 + 128] = 0.f; }
    const LAS float* blh = bls + rh * 132;
    bf16x8 qf[4];
#pragma unroll
    for (int s = 0; s < 4; ++s) qf[s] = *(const bf16x8*)(qn + (((size_t)b * S + tq) * 8 + h) * 64 + 16 * s + 8 * hi);
    const float kn = 8.f * 1.01f * wmax(fmaxf(fmaxf(fabsf(p.in[5][lane]), fabsf(p.in[5][64 + lane])), fabsf(p.in[5][128 + lane])));
    const float mref = sqrtf(qnorm2<4>(qf)) * kn + bmax;
    f32x16 negm;
#pragma unroll
    for (int r = 0; r < 16; ++r) negm[r] = cb - mref;
    float g0 = gates[0], g1 = gates[1], g2 = gates[2];
    if (p.dbg_branch >= 0) { g0 = p.dbg_branch == 0 ? 1.f : 0.f; g1 = p.dbg_branch == 1 ? 1.f : 0.f; g2 = p.dbg_branch == 2 ? 1.f : 0.f; }
    LAS float* otl = (LAS float*)(lds + AL_OT) + w * 2048;
#ifdef PROF_SEL
    if (b == 0 && g == 0 && jt == 63 && threadIdx.x == 0) *PROF_SLOT(48) -= __builtin_amdgcn_s_memtime();
#endif
    const int nvmax = (q0 + 63 - 31) / 16 + 1, ntc = (nvmax + 63) / 64;
    Flash st; flash_init(st);
    unsigned kl[4], vl[4]; frag_offsets<64>(kl, vl, r32, hi);
    const int qb32 = q0 + 32 * qh;
    int ecf = 0;
    for (int i = 0; i < ntc; ++i) if (qb32 - (16 * (64 * i + 63) + 31) >= 128) ecf = i + 1;
    run_tiles<128, true, AL_K64, 8192, AL_V64>(ntc, ecf, ntc, ntc, lds, w, lane, 128u, 512u,
        [&](int i) { return kc + (size_t)i * 64 * 128; }, [&](int i) { return vct + (size_t)i * 128; },
        [&](int i, LAS unsigned char* kb, LAS unsigned char* vb) { tile_compute<64, 128, false>(st, kb, vb, qf, negm, kl, vl, true, [&](int r, int half, float& x) { return true; }); },
        [&](int i, LAS unsigned char* kb, LAS unsigned char* vb) {
            const int cb0 = 64 * i + 4 * hi;
            tile_compute<64, 128, false>(st, kb, vb, qf, negm, kl, vl, true, [&](int r, int half, float& x) {
                const int c = cb0 + 32 * half + (r & 3) + 8 * (r >> 2); const int dist = tq - 16 * c - 31; x += blh[dist < 0 ? 0 : (dist > 128 ? 128 : dist)]; return dist >= 0; });
        },
        NoComp{});
    flash_accum<true>(otl, st, g0, hi, lane);
    unsigned mlo, mhi;
    int nsel;
    if (jt < 16) { const unsigned long long mk = (1ull << (jt + 1)) - 1ull; mlo = (unsigned)mk; mhi = (unsigned)(mk >> 32); nsel = jt + 1; if (tid <= jt) tl[tid] = (unsigned char)tid; }
    else {
        for (int i = tid; i < 64 * 65; i += 512) imp[i] = 0.f;
        const float lt = st.l + __shfl_xor(st.l, 32); const float linv = lt > 0.f ? frcp(lt) : 0.f;
        float xlast = 0.f;
        run_tiles<128, false, AL_K64, 8192, AL_V64>(ntc, ntc, ntc, ntc, lds, w, lane, 128u, 0u,
            [&](int i) { return kc + (size_t)i * 64 * 128; }, [&](int i) { return kc; },
            [&](int i, LAS unsigned char* kb, LAS unsigned char* vb) {
                f32x16 p0, p1; qk_tile<64, 128>(p0, p1, kb, qf, negm, kl);
                const int cb0 = 64 * i + 4 * hi;
                float sm[2][4], cr[2][4];
#pragma unroll
                for (int half = 0; half < 2; ++half)
#pragma unroll
                    for (int a = 0; a < 4; ++a) {
                        float s4 = 0.f, last = 0.f;
#pragma unroll
                        for (int k = 0; k < 4; ++k) {
                            const int r = 4 * a + k; const int c = cb0 + 32 * half + k + 8 * a; const int dist = tq - 16 * c - 31;
                            const float sc = (half ? p1[r] : p0[r]) + blh[dist < 0 ? 0 : (dist > 128 ? 128 : dist)];
                            const float pv = dist >= 0 ? fexp2(sc) * linv : 0.f;
                            s4 += pv; last = pv;
                        }
                        sm[half][a] = s4; cr[half][a] = last;
                    }
                float tot[2][4];
#pragma unroll
                for (int half = 0; half < 2; ++half)
#pragma unroll
                    for (int a = 0; a < 4; ++a) {
                        const float xs_ = __shfl_xor(cr[half][a], 32);
                        const float xp_ = (a > 0) ? __shfl_xor(cr[half][a > 0 ? a - 1 : 0], 32) : (half ? __shfl_xor(cr[0][3], 32) : xlast);
                        tot[half][a] = sm[half][a] + (hi ? xs_ : xp_);
                    }
                xlast = __shfl_xor(cr[1][3], 32);
                for (int rr = 0; rr < 4; ++rr) {
                    if (rh == rr) {
#pragma unroll
                        for (int half = 0; half < 2; ++half)
#pragma unroll
                            for (int a = 0; a < 4; ++a) { const int j = 16 * i + 8 * half + 2 * a + hi; imp[ql * 65 + j] += tot[half][a]; }
                    }
                    __syncthreads();
                }
            }, NoComp{}, NoComp{});
        if (p.dbg_branch == 1) { for (int i = tid; i < 4096; i += 512) ((float*)(p.ws + R_H))[((size_t)g * S + q0 + (i >> 6)) * 64 + (i & 63)] = imp[(i >> 6) * 65 + (i & 63)]; }
        {
            const int q = tid >> 3, jg = tid & 7;
            float vj[8]; int rk[8];
#pragma unroll
            for (int jj = 0; jj < 8; ++jj) { const int j = jg * 8 + jj; const float x = imp[q * 65 + j]; vj[jj] = (j > jt) ? -1.f : ((j == jt || j == 0) ? 1e9f : x); rk[jj] = 0; }
#pragma unroll 4
            for (int i = 0; i < 64; ++i) {
                const float xi = imp[q * 65 + i]; const float vi = (i > jt) ? -1.f : ((i == jt || i == 0) ? 1e9f : xi);
#pragma unroll
                for (int jj = 0; jj < 8; ++jj) rk[jj] += (vi > vj[jj] || (vi == vj[jj] && i < jg * 8 + jj)) ? 1 : 0;
            }
            unsigned byte = 0;
#pragma unroll
            for (int jj = 0; jj < 8; ++jj) if (jg * 8 + jj <= jt && rk[jj] < 16) byte |= 1u << jj;
            selb[q * 8 + jg] = (unsigned char)byte;
        }
        __syncthreads();
        if (w == 0) {
            unsigned a = ((const LAS unsigned*)selb)[lane * 2], c = ((const LAS unsigned*)selb)[lane * 2 + 1];
#pragma unroll
            for (int o = 1; o < 64; o <<= 1) { a |= __shfl_xor(a, o); c |= __shfl_xor(c, o); }
            const unsigned long long um = ((unsigned long long)c << 32) | a;
            if ((um >> lane) & 1ull) tl[__builtin_popcountll(um & ((1ull << lane) - 1ull))] = (unsigned char)lane;
            if (lane == 0) uni[0] = (unsigned)__builtin_popcountll(um);
        }
        __syncthreads();
        mlo = ((const LAS unsigned*)selb)[ql * 2]; mhi = ((const LAS unsigned*)selb)[ql * 2 + 1];
        nsel = (int)uni[0];
    }
    if (p.dbg_branch == 1 && rh == 0) { if (hi == 0) ((unsigned long long*)(p.ws + R_H + 4 * 1048576))[(size_t)g * S + tq] = ((unsigned long long)mhi << 32) | mlo; }
    __syncthreads();
    {
        const unsigned long long mymask = ((unsigned long long)mhi << 32) | mlo;
        nsel = __builtin_amdgcn_readfirstlane(nsel);
        const int mytl = (int)tl[lane];
        flash_init(st);
        const int jfar = qb32 >= 191 ? (qb32 - 191) >> 6 : -1;
        const int nfar = (int)__builtin_popcountll(__ballot(lane < nsel && mytl <= jfar));
        run_tiles<128, true, AL_K64, 8192, AL_V64>(nsel, nfar, nsel, nsel, lds, w, lane, 128u, (unsigned)(S * 2),
            [&](int i) { return ksn + (size_t)__builtin_amdgcn_readlane(mytl, i) * 64 * 128; }, [&](int i) { return vst + (size_t)__builtin_amdgcn_readlane(mytl, i) * 128; },
            [&](int i, LAS unsigned char* kb, LAS unsigned char* vb) {
                const int j = __builtin_amdgcn_readlane(mytl, i);
                const bool mine = (mymask >> j) & 1ull;
                tile_compute<64, 128, true>(st, kb, vb, qf, negm, kl, vl, mine, [&](int r, int half, float& x) { return true; });
            },
            [&](int i, LAS unsigned char* kb, LAS unsigned char* vb) {
                const int j = __builtin_amdgcn_readlane(mytl, i);
                const bool mine = (mymask >> j) & 1ull;
                const int kb0 = 64 * j + 4 * hi;
                tile_compute<64, 128, true>(st, kb, vb, qf, negm, kl, vl, mine, [&](int r, int half, float& x) { const int dist = tq - (kb0 + 32 * half + (r & 3) + 8 * (r >> 2)); x += blh[dist < 0 ? 0 : (dist > 128 ? 128 : dist)]; return dist >= 0; });
            },
            NoComp{});
        flash_accum<false>(otl, st, g1, hi, lane);
    }
    {
        const int j0 = jt >= 8 ? jt - 8 : 0, nw = jt - j0 + 1;
        flash_init(st);
        const int jfar = qb32 >= 191 ? (qb32 - 191) >> 6 : -1, jin = qb32 >= 481 ? ((qb32 - 481) >> 6) + 1 : 0;
        int ew0 = jin - j0; ew0 = ew0 < 0 ? 0 : (ew0 > nw ? nw : ew0);
        int ew1 = jfar + 1 - j0; ew1 = ew1 < ew0 ? ew0 : (ew1 > nw ? nw : ew1);
        auto wedge = [&](int i, LAS unsigned char* kb, LAS unsigned char* vb) {
            const int j = j0 + i, kb0 = 64 * j + 4 * hi;
            tile_compute<64, 128, false>(st, kb, vb, qf, negm, kl, vl, true, [&](int r, int half, float& x) { const int dist = tq - (kb0 + 32 * half + (r & 3) + 8 * (r >> 2)); x += blh[dist < 0 ? 0 : (dist > 128 ? 128 : dist)]; return dist >= 0 && dist < 512; });
        };
        run_tiles<128, true, AL_K64, 8192, AL_V64>(nw, ew0, ew1, nw, lds, w, lane, 128u, (unsigned)(S * 2),
            [&](int i) { return kwn + (size_t)(j0 + i) * 64 * 128; }, [&](int i) { return vwt + (size_t)(j0 + i) * 128; },
            wedge,
            [&](int i, LAS unsigned char* kb, LAS unsigned char* vb) { tile_compute<64, 128, false>(st, kb, vb, qf, negm, kl, vl, true, [&](int r, int half, float& x) { return true; }); },
            wedge);
        flash_accum<false>(otl, st, g2, hi, lane);
    }
#pragma unroll
    for (int r = 0; r < 16; ++r) { const size_t ro = ((size_t)b * S + q0 + 32 * qh + crow(r, hi)) * 1024 + h * 64 + r32; ocat[ro] = f2bf(otl[r * 64 + lane]); ocat[ro + 32] = f2bf(otl[(16 + r) * 64 + lane]); }
    __syncthreads();
#ifdef PROF_SEL
    if (b == 0 && g == 0 && jt == 63 && threadIdx.x == 0) *PROF_SLOT(48) += __builtin_amdgcn_s_memtime();
#endif
}

__device__ __forceinline__ void phase_p4(const Params& p, LAS unsigned char* lds) {
    const int G = gridDim.x, c = blockIdx.x, nunits = 256 * NB;
#if NB == 8
    if (G == 256) {
        const int b = c & 7, idx = c >> 3, pi = idx & 7, hq = idx >> 3;
#pragma unroll 1
        for (int u = 0; u < 8; ++u) {
            if (u == (idx & 7)) { convert_weights(p, lds, WD_EARLY, 14); __syncthreads(); }
            if (u < 4) { const int ix = (u >> 1) ? ((idx + 16) & 31) : idx;
                nsa_unit(p, lds, b, u >> 1, (u & 1) ? ix : 63 - ix); }
            else mla_unit(p, lds, b, ((u - 4) >> 1) * 4 + hq, (u & 1) ? pi : 15 - pi);
        }
        return;
    }
#endif
    convert_weights(p, lds, WD_EARLY, 14); __syncthreads();
    for (int j = 0;; ++j) {
        const int k = j * G + ((j & 1) ? (G - 1 - c) : c);
        if (j * G >= nunits) break;
        if (k >= nunits) continue;
        const int ty = UNIT_TYPES[k / NB], b = k % NB, kind = ty >> 9, a = (ty >> 6) & 7, cc = ty & 63;
        if (kind == 0) nsa_unit(p, lds, b, a, cc); else mla_unit(p, lds, b, a, cc);
    }
}
__device__ __forceinline__ void phase_norm(const float* x, const float* g, bf16_t* xn) {
    const int tid_ = ltid(); const int lane = tid_ & 63, gw = blockIdx.x * 8 + (tid_ >> 6), NGW = gridDim.x * 8;
    for (int m = gw; m < T; m += NGW) rms_row_to_bf16(x + (size_t)m * D, g, xn + (size_t)m * D, lane);
}
__device__ __forceinline__ void phase_conv(const Params& p) {
    const int tid = ltid(), lane = tid & 63, gw = blockIdx.x * 8 + (tid >> 6), NGW = gridDim.x * 8;
    const bf16_t* bg = (const bf16_t*)(p.ws + R_H); const bf16_t* cu = (const bf16_t*)(p.ws + R_H + (size_t)T * 2048); bf16_t* v = (bf16_t*)(p.ws + R_XA); const float* cw = p.in[22];
    constexpr int RUN = 16;
    float w0[2][8], w1[2][8], w2[2][8];
#pragma unroll
    for (int j = 0; j < 2; ++j) { const int d = 8 * lane + 512 * j; load8f(cw + d, w0[j], 1.f); load8f(cw + 1024 + d, w1[j], 1.f); load8f(cw + 2048 + d, w2[j], 1.f); }
    for (int run = gw; run < T / RUN; run += NGW) {
        const int m0 = run * RUN, s0 = m0 & (S - 1);
        float pm2[2][8], pm1[2][8];
#pragma unroll
        for (int j = 0; j < 2; ++j) { const int d = 8 * lane + 512 * j;
#pragma unroll
            for (int q = 0; q < 2; ++q) {
                float (&dst)[8] = q ? pm1[j] : pm2[j];
                if (s0 - 2 + q >= 0) unpack8(*(const u32x4*)(cu + (size_t)(m0 - 2 + q) * 1024 + d), dst);
                else {
#pragma unroll
                    for (int i = 0; i < 8; ++i) dst[i] = 0.f; }
            } }
#pragma unroll 4
        for (int rr = 0; rr < RUN; ++rr) {
            const int m = m0 + rr;
#pragma unroll
            for (int j = 0; j < 2; ++j) { const int d = 8 * lane + 512 * j;
                float b[8], c[8], y[8]; unpack8(*(const u32x4*)(bg + (size_t)m * 1024 + d), b); unpack8(*(const u32x4*)(cu + (size_t)m * 1024 + d), c);
#pragma unroll
                for (int i = 0; i < 8; ++i) { y[i] = b[i] * (w0[j][i] * pm2[j][i] + w1[j][i] * pm1[j][i] + w2[j][i] * c[i]); pm2[j][i] = pm1[j][i]; pm1[j][i] = c[i]; }
                *(u32x4*)(v + (size_t)m * 1024 + d) = pack8(y); }
        }
    }
}
__device__ __forceinline__ void phase_norm_router(const Params& p, LAS unsigned char* lds) {
    const int tid = ltid(), lane = tid & 63, wave = tid >> 6, gw = blockIdx.x * 8 + wave, NGW = gridDim.x * 8;
    const bf16_t* x3 = (const bf16_t*)(p.ws + R_XN); const float* g = p.in[24]; bf16_t* xn = (bf16_t*)(p.ws + R_XA);
    LAS float* wr = (LAS float*)lds;
    LAS int* lcnt = (LAS int*)(lds + 40960); LAS int* gb = lcnt + 8;
    int* te = (int*)(p.ws + SM_TE); float* tw = (float*)(p.ws + SM_TW); int* rank = (int*)(p.ws + SM_RANK); int* cnt = (int*)(p.ws + SM_CTL);
    for (int i = tid; i < 8192; i += 512) { const int dd = i >> 3; wr[dd * 8 + (dd >> 2) * 4 + (i & 7)] = p.in[25][i]; }
    if (tid < 8) lcnt[tid] = 0;
    __syncthreads();
    u32x2 nx[4];
#pragma unroll
    for (int j = 0; j < 4; ++j) nx[j] = ((const u32x2*)(x3 + (size_t)(gw < T ? gw : 0) * D) + lane)[64 * j];
    for (int m = gw; m < T; m += NGW) {
        const f32x4* gr = (const f32x4*)g + lane;
        f32x4 v[4]; float s = 0.f;
#pragma unroll
        for (int j = 0; j < 4; ++j) { const u32x2 t = nx[j]; v[j] = (f32x4){bflo(t.x), bfhi(t.x), bflo(t.y), bfhi(t.y)}; s += (v[j].x * v[j].x + v[j].y * v[j].y) + (v[j].z * v[j].z + v[j].w * v[j].w); }
        { const int mn = m + NGW < T ? m + NGW : m;
#pragma unroll
            for (int j = 0; j < 4; ++j) nx[j] = ((const u32x2*)(x3 + (size_t)mn * D) + lane)[64 * j]; }
        const float r = rsqrtf(wsum(s) * (1.f / 1024.f) + EPS);
        float lg[8];
#pragma unroll
        for (int e = 0; e < 8; ++e) lg[e] = 0.f;
        u32x2* o8 = (u32x2*)(xn + (size_t)m * D) + lane;
#pragma unroll
        for (int j = 0; j < 4; ++j) { const f32x4 gg = gr[64 * j]; const f32x4 y = {v[j].x * r * gg.x, v[j].y * r * gg.y, v[j].z * r * gg.z, v[j].w * r * gg.w};
            u32x2 w; w.x = cvtpk(y.x, y.y); w.y = cvtpk(y.z, y.w); o8[64 * j] = w;
#pragma unroll
            for (int i = 0; i < 4; ++i) { const int d = 4 * lane + 256 * j + i; const f32x4 w0 = *(const LAS f32x4*)(wr + d * 8 + (d >> 2) * 4), w1 = *(const LAS f32x4*)(wr + d * 8 + (d >> 2) * 4 + 4);
                lg[0] += y[i] * w0.x; lg[1] += y[i] * w0.y; lg[2] += y[i] * w0.z; lg[3] += y[i] * w0.w; lg[4] += y[i] * w1.x; lg[5] += y[i] * w1.y; lg[6] += y[i] * w1.z; lg[7] += y[i] * w1.w; } }
#pragma unroll
        for (int e = 0; e < 8; ++e) lg[e] = wsum(lg[e]) + p.in[26][e];
        int e1 = 0; float l1 = lg[0];
#pragma unroll
        for (int e = 1; e < 8; ++e) if (lg[e] > l1) { l1 = lg[e]; e1 = e; }
        int e2 = -1; float l2 = -3e38f;
#pragma unroll
        for (int e = 0; e < 8; ++e) if (e != e1 && lg[e] > l2) { l2 = lg[e]; e2 = e; }
        if (lane == 0) {
            const float w1 = 1.f / (1.f + __expf(l2 - l1));
            te[m * 2] = e1; te[m * 2 + 1] = e2; tw[m * 2] = w1; tw[m * 2 + 1] = 1.f - w1;
            rank[m * 2] = __hip_atomic_fetch_add(&lcnt[e1], 1, __ATOMIC_RELAXED, __HIP_MEMORY_SCOPE_WORKGROUP); rank[m * 2 + 1] = __hip_atomic_fetch_add(&lcnt[e2], 1, __ATOMIC_RELAXED, __HIP_MEMORY_SCOPE_WORKGROUP);
        }
    }
    __syncthreads();
    if (tid < 8) gb[tid] = atomicAdd(&cnt[tid], lcnt[tid]);
    __syncthreads();
    for (int m = gw; m < T; m += NGW) if (lane < 2) rank[m * 2 + lane] += gb[te[m * 2 + lane]];
}
__device__ __forceinline__ void phase_moe_gather(const Params& p) {
    const int tid = ltid(), lane = tid & 63, gw = blockIdx.x * 8 + (tid >> 6), NGW = gridDim.x * 8;
    const int* cnt = (const int*)(p.ws + SM_CTL); const int* te = (const int*)(p.ws + SM_TE); const float* tw = (const float*)(p.ws + SM_TW); const int* rank = (const int*)(p.ws + SM_RANK);
    int* pos = (int*)(p.ws + SM_POS); float* roww = (float*)(p.ws + SM_ROWW); int* tile_e = (int*)(p.ws + SM_TILEE);
    int* rowtok = (int*)(p.ws + SM_ROWTOK);
    int off[9]; off[0] = 0;
#pragma unroll
    for (int e = 0; e < 8; ++e) off[e + 1] = off[e] + ((cnt[e] + 255) & ~255);
    if (blockIdx.x == 0) {
        for (int i = tid; i < ROWS_MAX / 256; i += 512) { int e = -1;
#pragma unroll
            for (int k = 0; k < 8; ++k) if (i * 256 >= off[k] && i * 256 < off[k + 1]) e = k;
            tile_e[i] = e < 0 ? 0 : e; }
        if (tid == 0) ((int*)(p.ws + SM_CTL))[8] = off[8];
    }
    if (blockIdx.x < 8 && tid < 256) {
#pragma unroll
        for (int e = 0; e < 8; ++e) if (e == (int)blockIdx.x) { const int c = cnt[e]; if (c + tid < off[e + 1] - off[e]) { roww[off[e] + c + tid] = 0.f; rowtok[off[e] + c + tid] = -1; } }
    }
    for (int pi0 = gw * 4; pi0 < 2 * T; pi0 += NGW * 4) {
        int r[4]; float w[4];
#pragma unroll
        for (int q = 0; q < 4; ++q) { const int e = te[pi0 + q]; int o = 0;
#pragma unroll
            for (int k = 0; k < 8; ++k) if (k == e) o = off[k];
            r[q] = o + rank[pi0 + q]; w[q] = tw[pi0 + q]; }
#pragma unroll
        for (int q = 0; q < 4; ++q) if (lane == q) { pos[pi0 + q] = r[q]; roww[r[q]] = w[q]; rowtok[r[q]] = (pi0 + q) >> 1; }
    }
}
__device__ __forceinline__ void phase_moe_combine(const Params& p) {
    const int tid_ = ltid(); const int lane = tid_ & 63, gw = blockIdx.x * 8 + (tid_ >> 6), NGW = gridDim.x * 8;
    const int* pos = (const int*)(p.ws + SM_POS); const bf16_t* ym = (const bf16_t*)(p.ws + R_XA); const bf16_t* x3 = (const bf16_t*)(p.ws + R_XN);
    for (int m0 = gw * 2; m0 < T; m0 += NGW * 2) {
        int ps[4];
#pragma unroll
        for (int q = 0; q < 4; ++q) ps[q] = pos[m0 * 2 + q];
        f32x4 x[2][4]; u32x2 ya[2][4], yc[2][4];
#pragma unroll
        for (int q = 0; q < 2; ++q)
#pragma unroll
            for (int j = 0; j < 4; ++j) { const int d = 4 * lane + 256 * j;
                { const u32x2 t = *(const u32x2*)(x3 + (size_t)(m0 + q) * D + d); x[q][j] = (f32x4){bflo(t.x), bfhi(t.x), bflo(t.y), bfhi(t.y)}; } ya[q][j] = *(const u32x2*)(ym + (size_t)ps[2 * q] * D + d); yc[q][j] = *(const u32x2*)(ym + (size_t)ps[2 * q + 1] * D + d); }
#pragma unroll
        for (int q = 0; q < 2; ++q)
#pragma unroll
            for (int j = 0; j < 4; ++j) { const int d = 4 * lane + 256 * j; f32x4 o = x[q][j]; const u32x2 a = ya[q][j], c = yc[q][j];
                o.x += bflo(a.x) + bflo(c.x); o.y += bfhi(a.x) + bfhi(c.x); o.z += bflo(a.y) + bflo(c.y); o.w += bfhi(a.y) + bfhi(c.y);
                *(f32x4*)(p.out + (size_t)(m0 + q) * D + d) = o; }
    }
}

#define XB_TMO      128
#define XB_XCNT(j)  (256  + 64 * (j))
#define XB_XSUB(j)  (1280 + 64 * (j))
#define XB_XGEN(j)  (2304 + 64 * (j))
#define XB_TOP      3328
#define XB_TOPGEN   3392
#define XCD_BAR_WORDS 3456
#define XB_SPIN_CAP (1u << 18)

__device__ __forceinline__ unsigned xb_ld(unsigned* p)              { return __hip_atomic_load(p, __ATOMIC_RELAXED, __HIP_MEMORY_SCOPE_AGENT); }
__device__ __forceinline__ unsigned xb_add(unsigned* p, unsigned v) { return __hip_atomic_fetch_add(p, v, __ATOMIC_RELAXED, __HIP_MEMORY_SCOPE_AGENT); }
__device__ __forceinline__ unsigned xb_xcc_id() { return (unsigned)__builtin_amdgcn_s_getreg((3 << 11) | 20) & 0xFu; }
#define XB_SPIN(cond, bar) do { unsigned _sp = 0; while (cond) { __builtin_amdgcn_s_sleep(1); \
    if ((++_sp & 255u) == 0u) { if (xb_ld(&(bar)[XB_TMO])) break; if (_sp > XB_SPIN_CAP) { atomicAdd(&(bar)[XB_TMO], 1u); break; } } } } while (0)

struct XcdBarrier {
    unsigned* bar; unsigned x;
    volatile LAS unsigned* st;
};

__device__ __forceinline__ XcdBarrier xcd_barrier_post(unsigned* bar, volatile LAS unsigned* st) {
    XcdBarrier b; b.bar = bar; b.x = xb_xcc_id(); b.st = st;
    if (threadIdx.x == 0) (void)xb_add(&bar[XB_XCNT(b.x)], 1u);
    return b;
}
__device__ __forceinline__ void xcd_barrier_complete(unsigned* bar, unsigned x, unsigned& nloc, unsigned& nx) {
    const unsigned G = gridDim.x * gridDim.y * gridDim.z;
    unsigned sum, cnt, mine, sp = 0u;
    for (;;) {
        sum = 0u; cnt = 0u; mine = 0u;
#pragma unroll
        for (unsigned j = 0; j < 16; ++j) { const unsigned c = xb_ld(&bar[XB_XCNT(j)]); sum += c; cnt += (c > 0u) ? 1u : 0u; mine = (j == x) ? c : mine; }
        if (sum == G) break;
        __builtin_amdgcn_s_sleep(1);
        if ((++sp & 255u) == 0u) { if (xb_ld(&bar[XB_TMO])) break; if (sp > XB_SPIN_CAP) { atomicAdd(&bar[XB_TMO], 1u); break; } }
    }
    nloc = mine > 0u ? mine : 1u; nx = cnt > 0u ? cnt : 1u;
}

__device__ __forceinline__ void xcd_barrier(const XcdBarrier& b) {
    asm volatile("s_waitcnt vmcnt(0)" ::: "memory");
    __syncthreads();
    if (threadIdx.x == 0) {
        unsigned* bar = b.bar;
        __builtin_amdgcn_s_waitcnt(0);
        unsigned nloc = b.st[0], nx = b.st[1];
        if (nloc == 0u) { xcd_barrier_complete(bar, b.x, nloc, nx); b.st[0] = nloc; b.st[1] = nx; }
        const unsigned old = xb_add(&bar[XB_XSUB(b.x)], 1u);
        const unsigned gen = old / nloc;
        if (old + 1u == (gen + 1u) * nloc) {
            __builtin_amdgcn_fence(__ATOMIC_RELEASE, "agent");
            asm volatile("s_waitcnt vmcnt(0)" ::: "memory");
            const unsigned og = xb_add(&bar[XB_TOP], 1u);
            const unsigned tg = og / nx;
            if (og + 1u == (tg + 1u) * nx) xb_add(&bar[XB_TOPGEN], 1u);
            else XB_SPIN(xb_ld(&bar[XB_TOPGEN]) == tg, bar);
            __builtin_amdgcn_fence(__ATOMIC_ACQUIRE, "agent");
            xb_add(&bar[XB_XGEN(b.x)], 1u);
            asm volatile("s_waitcnt vmcnt(0)" ::: "memory");
        } else {
            XB_SPIN(xb_ld(&bar[XB_XGEN(b.x)]) == gen, bar);
            __builtin_amdgcn_fence(__ATOMIC_ACQUIRE, "agent");
            asm volatile("s_waitcnt vmcnt(0)" ::: "memory");
        }
    }
    __syncthreads();
}


__global__ void __launch_bounds__(512) mega_fwd(Params p) {
    extern __shared__ __attribute__((aligned(16))) unsigned char lds_raw[];
    LAS unsigned char* lds = (LAS unsigned char*)lds_raw;
    cg::grid_group grid = cg::this_grid();
    volatile LAS unsigned* bst = (volatile LAS unsigned*)(lds + 140032);
    if (threadIdx.x == 0) { bst[0] = 0u; bst[1] = 0u; const unsigned long long ba = (unsigned long long)(p.ws + SM_BAR); bst[2] = (unsigned)ba; bst[3] = (unsigned)(ba >> 32); }
    __syncthreads();
    (void)xcd_barrier_post((unsigned*)(p.ws + SM_BAR), bst);
#ifdef PROF_SEL
#define PSTAMP(k) do { if (blockIdx.x == 0 && threadIdx.x == 0) { volatile LAS unsigned* pl_ = (volatile LAS unsigned*)(lds + 140032 + 16); const unsigned long long now_ = __builtin_amdgcn_s_memrealtime(); const unsigned long long last_ = ((unsigned long long)pl_[1] << 32) | pl_[0]; *PROF_SLOT(k) += now_ - last_; pl_[0] = (unsigned)now_; pl_[1] = (unsigned)(now_ >> 32); } } while (0)
#else
#define PSTAMP(k)
#endif
#define GSYNC() do { XcdBarrier xb_; volatile LAS unsigned* st_ = (volatile LAS unsigned*)(lds + 140032); xb_.bar = (unsigned*)(((unsigned long long)st_[3] << 32) | st_[2]); xb_.x = xb_xcc_id(); xb_.st = st_; xcd_barrier(xb_); } while (0)
#ifdef PROF_SEL
    if (threadIdx.x == 0) { volatile LAS unsigned* pl_ = (volatile LAS unsigned*)(lds + 140032 + 16); const unsigned long long now_ = __builtin_amdgcn_s_memrealtime(); pl_[0] = (unsigned)now_; pl_[1] = (unsigned)(now_ >> 32); }
#endif
    const int G = gridDim.x, c = blockIdx.x;
#define LP() bf16_t* W = (bf16_t*)p.ws; bf16_t* xn = (bf16_t*)(p.ws + R_XN); float* x1 = (float*)(p.ws + R_XA); pg8::StaticOrder SO; (void)W; (void)xn; (void)x1; (void)SO
#ifndef PHMASK
#define PHMASK 0xFFFFFFFFu
#endif
#ifndef REPEAT_MASK
#define REPEAT_MASK 0u
#endif
#define PH(k) if (((PHMASK >> (k)) & 1u) && (k) >= p.ph_lo && (k) <= p.ph_hi)
#define RPT(k) if ((REPEAT_MASK >> (k)) & 1u)
    PH(0) { LP(); phase_p0(p, lds); }
    GSYNC(); PSTAMP(0);
    if (p.ph_lo == -12345) grid.sync();
    RPT(0) { { LP(); phase_p0(p, lds); } GSYNC(); }
    PH(1) { LP();
        pg8::Gemm g{xn, W + W_IN_E / 2, T, 1792, 1024, 1024, nullptr, 0, nullptr}; SO.init(T, 1792, G, c);
        pg8::EpiBf16<0> E{(bf16_t*)(p.ws + R_H), 1792, nullptr, nullptr};
        pg8::gemm_phase<pg8::EpiBf16<0>, true>(lds, g, SO, E);
    }
    GSYNC(); PSTAMP(1);
    PH(2) { LP(); phase_p2(p, lds); }
    GSYNC(); PSTAMP(2);
    RPT(2) { { LP(); phase_p2(p, lds); } GSYNC(); }
    PH(3) { LP();
        const int nCu = 2 * (NB * 512 / 256) * 2, Gc = (nCu < G / 2) ? nCu : 0;
        if (Gc == 0 || c < Gc) {
            for (int kv = 0; kv < 2; ++kv) {
                pg8::Gemm g{(const bf16_t*)(p.ws + R_XA + (kv ? A_VCIN : A_KCIN)), W + W_CW1 / 2 + (size_t)kv * 512 * 1024, NB * 512, 512, 1024, 1024, nullptr, 0, nullptr};
                if (Gc) SO.init(NB * 512, 512, Gc / 2, c - kv * (Gc / 2)); else SO.init(NB * 512, 512, G, c);
                pg8::EpiBf16<0> E{(bf16_t*)(p.ws + SM_HID) + (size_t)kv * NB * 512 * 512, 512, nullptr, nullptr};
                if (Gc == 0 || (c / (Gc / 2)) == kv) pg8::gemm_phase<pg8::EpiBf16<0>, true>(lds, g, SO, E);
            }
        }
        if (Gc == 0 || c >= Gc) {
            {
                pg8::Gemm g{(const bf16_t*)(p.ws + R_XA + A_CQN), W + W_UQ / 2, T, 1024, 256, 256, nullptr, 0, nullptr}; SO.init(T, 1024, G - Gc, c - Gc);
                pg8::EpiBf16<0> E{(bf16_t*)(p.ws + R_H), 1024, nullptr, nullptr};
                pg8::gemm_phase<pg8::EpiBf16<0>, true>(lds, g, SO, E);
            }
            {
                pg8::Gemm g{(const bf16_t*)(p.ws + R_XA + A_CKVN), W + W_UKV / 2, T, 1024, 128, 128, nullptr, 0, nullptr}; SO.init(T, 1024, G - Gc, c - Gc);
                pg8::EpiBf16<0> E{(bf16_t*)(p.ws + R_H + (size_t)T * 2048), 1024, nullptr, nullptr};
                pg8::gemm_phase<pg8::EpiBf16<0>, true>(lds, g, SO, E);
            }
        }
    }
    GSYNC(); PSTAMP(3);
    PH(4) { LP(); phase_p3b(p, lds); }
    GSYNC(); PSTAMP(4);
    RPT(4) { { LP(); phase_p3b(p, lds); } GSYNC(); }
    PH(5) { LP(); phase_p4(p, lds); }
    GSYNC(); PSTAMP(5);
    RPT(5) { { LP(); phase_p4(p, lds); } GSYNC(); }
    PH(6) { LP();
        pg8::Gemm g{xn, W + W_OUT_E / 2, T, 1024, 1024, 1024, nullptr, 0, nullptr}; SO.init(T, 1024, G, c);
        pg8::EpiResStat<false> E{p.in[0], (bf16_t*)p.out, (float*)(p.ws + SM_SSP1), 1024};
        pg8::gemm_phase<pg8::EpiResStat<false>, true>(lds, g, SO, E);
    }
    GSYNC(); PSTAMP(6);
    PH(7) { }
    PH(8) { LP();
        pg8::Gemm g{(const bf16_t*)p.out, W + W_GU / 2, T, 5632, 1024, 1024, nullptr, 0, nullptr}; SO.init(T, 5632, G, c);
        pg8::EpiSwiGLU E{(bf16_t*)(p.ws + R_H), 2816, (const float*)(p.ws + SM_SSP1)};
        pg8::gemm_phase<pg8::EpiSwiGLU, true>(lds, g, SO, E);
    }
    GSYNC(); PSTAMP(8);
    PH(9) { LP();
        pg8::Gemm g{(const bf16_t*)(p.ws + R_H), W + W_D / 2, T, 1024, 2816, 2816, nullptr, 0, nullptr}; SO.init(T, 1024, G, c);
        pg8::EpiResStat<true> E{(const bf16_t*)p.out, xn, (float*)(p.ws + SM_SSP2), 1024};
        pg8::gemm_phase<pg8::EpiResStat<true>, true>(lds, g, SO, E);
    }
    GSYNC(); PSTAMP(9);
    PH(10) { }
    PH(11) { LP();
        pg8::Gemm g{xn, W + W_IN_O / 2, T, 3072, 1024, 1024, nullptr, 0, nullptr}; SO.init(T, 3072, G, c);
        pg8::EpiConvIn E{(bf16_t*)(p.ws + R_H), (bf16_t*)(p.ws + R_H + (size_t)T * 2048), (const float*)(p.ws + SM_SSP2)};
        pg8::gemm_phase<pg8::EpiConvIn, true>(lds, g, SO, E);
    }
    GSYNC(); PSTAMP(11);
    PH(12) { LP(); phase_conv(p); }
    GSYNC(); PSTAMP(12);
    RPT(12) { { LP(); phase_conv(p); } GSYNC(); }
    PH(13) { LP();
        pg8::Gemm g{(const bf16_t*)x1, W + W_OUT_O / 2, T, 1024, 1024, 1024, nullptr, 0, nullptr}; SO.init(T, 1024, G, c);
        pg8::EpiResBf16B E{xn, xn, 1024};
        pg8::gemm_phase<pg8::EpiResBf16B, true>(lds, g, SO, E);
    }
    GSYNC(); PSTAMP(13);
    PH(14) { LP(); phase_norm_router(p, lds); }
    GSYNC(); PSTAMP(14);
    PH(15) { LP(); phase_moe_gather(p); }
    GSYNC(); PSTAMP(15);
    PH(16) { LP(); const int mrows = ((const int*)(p.ws + SM_CTL))[8];
        pg8::Gemm g{(const bf16_t*)x1, W + W_MGU / 2, mrows, 2816, 1024, 1024, (const int*)(p.ws + SM_TILEE), (size_t)2816 * 1024, (const int*)(p.ws + SM_ROWTOK)}; SO.init(mrows, 2816, G, c);
        pg8::EpiSwiGLU E{(bf16_t*)(p.ws + R_H), 1408, nullptr};
        pg8::gemm_phase<pg8::EpiSwiGLU, true, true>(lds, g, SO, E);
    }
    GSYNC(); PSTAMP(16);
    PH(17) { LP(); const int mrows = ((const int*)(p.ws + SM_CTL))[8];
        pg8::Gemm g{(const bf16_t*)(p.ws + R_H), W + W_MD / 2, mrows, 1024, 1408, 1408, (const int*)(p.ws + SM_TILEE), (size_t)1024 * 1408, nullptr}; SO.init(mrows, 1024, G, c);
        pg8::EpiRowScaleBf16 E{(bf16_t*)(p.ws + R_XA), 1024, (const float*)(p.ws + SM_ROWW)};
        pg8::gemm_phase<pg8::EpiRowScaleBf16, true>(lds, g, SO, E);
    }
    GSYNC(); PSTAMP(17);
    PH(18) { LP(); phase_moe_combine(p); }
#ifdef PROF_SEL
    GSYNC(); PSTAMP(18);
    GSYNC();
    {
        unsigned long long v_ = *PROF_SLOT(PROF_SEL);
#ifdef PROF_DIV
        const unsigned long long dv_ = *PROF_SLOT(PROF_DIV); v_ = dv_ ? v_ / dv_ : 0ull;
#endif
        unsigned long long a_ = v_ / (unsigned long long)(PROF_UNIT); if (a_ > 27ull) a_ = 27ull;
        const float sc_ = 1.f + (float)a_;
        for (size_t i = (size_t)blockIdx.x * 512 + threadIdx.x; i < (size_t)S * 1024 / 4; i += (size_t)gridDim.x * 512) { f32x4* o = (f32x4*)p.out + i; *o = *o * sc_; }
    }
#endif
#undef PH
}

inline void launch(void* const* d_in, float* d_out, void* d_ws, size_t ws_size, hipStream_t stream, int ph_lo = 0, int ph_hi = 99, int dbg_branch = -1) {
    static int grid = 0;
    if (grid == 0) {
        int dev = 0, cus = 0, per_cu = 0;
        hipGetDevice(&dev); hipDeviceGetAttribute(&cus, hipDeviceAttributeMultiprocessorCount, dev);
        hipFuncSetAttribute((const void*)mega_fwd, hipFuncAttributeMaxDynamicSharedMemorySize, LDS_BYTES);
        hipOccupancyMaxActiveBlocksPerMultiprocessor(&per_cu, (const void*)mega_fwd, 512, LDS_BYTES);
        if (per_cu < 1) { fprintf(stderr, "occupancy query says %d blocks/CU\n", per_cu); per_cu = 1; }
        grid = cus;
        if (WS_FAST_END > ws_size) { fprintf(stderr, "ws too small: need %zu have %zu\n", (size_t)WS_FAST_END, ws_size); grid = -1; }
    }
    if (grid < 0) return;
    if (ph_lo <= 14 && ph_hi >= 14) hipMemsetAsync((char*)d_ws + SM_CTL, 0, 4096, stream);
    hipMemsetAsync((char*)d_ws + SM_BAR, 0, 16384, stream);
    Params p{};
    for (int i = 0; i < 30; ++i) p.in[i] = (const float*)d_in[i];
    p.out = d_out; p.ws = (unsigned char*)d_ws; p.ph_lo = ph_lo; p.ph_hi = ph_hi; p.dbg_branch = dbg_branch;
    void* args[] = {&p};
    hipError_t e = hipLaunchCooperativeKernel((const void*)mega_fwd, dim3(grid), dim3(512), args, LDS_BYTES, stream);
    if (e != hipSuccess) fprintf(stderr, "cooperative launch failed: %s (grid %d)\n", hipGetErrorString(e), grid);
}
}
extern "C" void kernel_launch(void* const* d_in, const int* in_sizes, int n_in, void* d_out, int out_size, void* d_ws, size_t ws_size, hipStream_t stream) {
    fast::launch(d_in, (float*)d_out, d_ws, ws_size, stream);
}
```

```cpp
#include <hip/hip_runtime.h>
#include <hip/hip_bf16.h>
#include <stdint.h>
#include <stdio.h>
#include <string.h>
#include <hip/hip_cooperative_groups.h>
namespace cg = cooperative_groups;
#define NB 8
#define REPEAT_MASK 0x0u
namespace gold {
constexpr int S = 4096, D = 1024, HW = 1720;
constexpr float EPS = 1e-6f;

__device__ const unsigned char T5B[128] = {0, 1, 2, 3, 4, 5, 6, 7, 8, 9, 10, 11, 12, 13, 14, 15, 16, 16, 16, 17, 17, 18, 18, 18, 19, 19, 19, 20, 20, 20, 20, 21, 21, 21, 21, 22, 22, 22, 22, 22, 23, 23, 23, 23, 23, 23, 24, 24, 24, 24, 24, 24, 25, 25, 25, 25, 25, 25, 25, 26, 26, 26, 26, 26, 26, 26, 26, 27, 27, 27, 27, 27, 27, 27, 27, 27, 27, 28, 28, 28, 28, 28, 28, 28, 28, 28, 28, 29, 29, 29, 29, 29, 29, 29, 29, 29, 29, 29, 29, 30, 30, 30, 30, 30, 30, 30, 30, 30, 30, 30, 30, 30, 30, 31, 31, 31, 31, 31, 31, 31, 31, 31, 31, 31, 31, 31, 31};
}
#ifndef NB
#define NB 8
#endif
namespace fast {
#define LAS __attribute__((address_space(3)))
typedef unsigned short bf16_t;
typedef short bf16x8 __attribute__((ext_vector_type(8)));
typedef float f32x4 __attribute__((ext_vector_type(4)));
typedef float f32x2 __attribute__((ext_vector_type(2)));
typedef float f32x16 __attribute__((ext_vector_type(16)));
typedef unsigned u32x4 __attribute__((ext_vector_type(4)));
typedef unsigned u32x2 __attribute__((ext_vector_type(2)));
typedef __bf16 bf16x2_t __attribute__((ext_vector_type(2)));

constexpr int S = 4096, T = NB * S, D = 1024;
constexpr float EPS = 1e-6f, LOG2E = 1.4426950408889634f;

__device__ __forceinline__ unsigned cvtpk(float lo, float hi) { f32x2 v = {lo, hi}; bf16x2_t b = __builtin_convertvector(v, bf16x2_t); return __builtin_bit_cast(unsigned, b); }
__device__ __forceinline__ bf16_t f2bf(float f) { return (bf16_t)(cvtpk(f, 0.f) & 0xffffu); }
__device__ __forceinline__ float bf2f(bf16_t u) { return __builtin_bit_cast(float, (unsigned)u << 16); }
__device__ __forceinline__ float bflo(unsigned u) { return __builtin_bit_cast(float, u << 16); }
__device__ __forceinline__ float bfhi(unsigned u) { return __builtin_bit_cast(float, u & 0xffff0000u); }
__device__ __forceinline__ float wsum(float v) {
#pragma unroll
    for (int o = 1; o < 64; o <<= 1) v += __shfl_xor(v, o);
    return v;
}
__device__ __forceinline__ float fexp2(float x) { return __builtin_amdgcn_exp2f(x); }
__device__ __forceinline__ float frcp(float x) { return __builtin_amdgcn_rcpf(x); }
__device__ __forceinline__ float silu_f(float x) { return x * frcp(1.f + fexp2(-x * LOG2E)); }
__device__ __forceinline__ float gelu_tanh_f(float x) {
    const float u = 0.7978845608028654f * (x + 0.044715f * x * x * x);
    return x * frcp(1.f + fexp2(-2.f * LOG2E * u));
}

namespace pg8 {
constexpr int BM = 256, BK = 64, HALF = 128, HTB = HALF * BK * 2, STAGE_BYTES = 8 * HTB, NXCD = 8, WGM = 8;
__host__ __device__ __forceinline__ int lds_byte(int r, int c) { const int st = (r >> 4) * 2 + (c >> 5), rr = r & 15, cc = c & 31, ob = rr * 64 + cc * 2; return st * 1024 + (ob ^ (((ob >> 9) & 1) << 5)); }
__host__ __device__ __forceinline__ void stage_rc(int b, int& R, int& C) { const int st = b / 1024, sb = b % 1024, swz = sb ^ (((sb >> 9) & 1) << 5); R = (st >> 1) * 16 + swz / 64; C = (st & 1) * 32 + (swz % 64) / 2; }
__host__ __device__ __forceinline__ int perm32(int rho) { const int n = rho >> 4, i = rho & 15; return 8 * (i >> 2) + 4 * n + (i & 3); }

struct Unit { int pm, pn; };
struct Gemm { const bf16_t* A; const bf16_t* Bt; int M, N, K, lda; const int* tile_e; size_t estride; const int* rowidx; };

struct StaticOrder {
    int nM, nN, nwg, G, c;
    __device__ void init(int M, int N, int G_, int c_) { nM = M / BM; nN = N / BM; nwg = nM * nN; G = G_; c = c_; }
    __device__ bool next(int i, Unit& u) const {
        const long L = (long)i * G + c; if (L >= nwg) return false;
        int wgid = (int)L; { const int q = nwg / NXCD, r = nwg % NXCD, xcd = wgid % NXCD, off = wgid / NXCD; wgid = (xcd < r ? xcd * (q + 1) : r * (q + 1) + (xcd - r) * q) + off; }
        const int nig = WGM * nN, gid = wgid / nig, fm = gid * WGM, gsz = (nM - fm) < WGM ? (nM - fm) : WGM;
        u.pm = fm + ((wgid % nig) % gsz); u.pn = (wgid % nig) / gsz; return true;
    }
};

template <class Epi, bool ALIGN_EPI, bool GATHER = false>
__device__ __forceinline__ void gemm_phase(LAS unsigned char* lds, const Gemm g, const StaticOrder& S, const Epi& E) {
    int tid = threadIdx.x; asm volatile("" : "+v"(tid));
    const int wid = __builtin_amdgcn_readfirstlane(tid >> 6), lane = tid & 63, wr = wid >> 2, wc = wid & 3, fr = lane & 15, fq = lane >> 4;
    const int K = g.K, nt = K / BK, lda = g.lda;
    unsigned voffA[2], voffB[2];
#pragma unroll
    for (int i = 0; i < 2; ++i) { int R, C; stage_rc(tid * 16 + i * 8192, R, C); const int Rb = Epi::PERM ? ((R & ~31) + perm32(R & 31)) : R;
        voffA[i] = (unsigned)(R * lda + C) * 2u; voffB[i] = (unsigned)(Rb * K + C) * 2u; }
    const size_t kstep = (size_t)(BK * 2);
    const size_t hsA = GATHER ? 0 : (size_t)HALF * lda * 2, tsA = 2 * hsA, hsB = (size_t)HALF * K * 2, tsB = 2 * hsB;
    unsigned vgc[2][2], vgn[2][2];
#define PG8_GOFF(pm_, vg) do { _Pragma("unroll") for (int h_ = 0; h_ < 2; ++h_) _Pragma("unroll") for (int i_ = 0; i_ < 2; ++i_) { int R_, C_; stage_rc(tid * 16 + i_ * 8192, R_, C_); \
        int tok_ = g.rowidx[(pm_) * BM + h_ * HALF + R_]; tok_ = tok_ < 0 ? 0 : tok_; vg[h_][i_] = (unsigned)(tok_ * lda + C_) * 2u; } } while (0)
#define PG8_STAGE_A(bufoff, gbase, h, nx) do { unsigned va_[2]; _Pragma("unroll") for (int i_ = 0; i_ < 2; ++i_) va_[i_] = GATHER ? ((nx) ? vgn[h][i_] : vgc[h][i_]) : voffA[i_]; PG8_STAGE(bufoff, gbase, va_); } while (0)
    const unsigned ldsw = (unsigned)wid * 1024u;
    const int aoff = lds_byte(wr * 64 + fr, fq * 8), boff = lds_byte(wc * 32 + fr, fq * 8);
#define PG8_SA(b, h) (((b) * 2 + (h)) * HTB)
#define PG8_SB(b, h) ((4 + (b) * 2 + (h)) * HTB)
#define PG8_STAGE(bufoff, gbase, voff) do { _Pragma("unroll") for (int _i = 0; _i < 2; ++_i) \
        __builtin_amdgcn_global_load_lds((const unsigned*)((const char*)(gbase) + (voff)[_i]), (LAS unsigned*)(lds + (bufoff) + ldsw + _i * 8192), 16, 0, 0); } while (0)
#define PG8_LDA(dst, b, h) do { _Pragma("unroll") for (int m = 0; m < 4; ++m) _Pragma("unroll") for (int k = 0; k < 2; ++k) dst[m][k] = *(const LAS bf16x8*)(lds + PG8_SA(b, h) + aoff + m * 2048 + k * 1024); } while (0)
#define PG8_LDB(dst, b, h) do { _Pragma("unroll") for (int n = 0; n < 2; ++n) _Pragma("unroll") for (int k = 0; k < 2; ++k) dst[n][k] = *(const LAS bf16x8*)(lds + PG8_SB(b, h) + boff + n * 2048 + k * 1024); } while (0)
#define PG8_MMA(ai, bj, At, Bt) do { __builtin_amdgcn_s_setprio(1); _Pragma("unroll") for (int m = 0; m < 4; ++m) _Pragma("unroll") for (int n = 0; n < 2; ++n) _Pragma("unroll") for (int k = 0; k < 2; ++k) \
        acc[ai][bj][m][n] = __builtin_amdgcn_mfma_f32_16x16x32_bf16(Bt[n][k], At[m][k], acc[ai][bj][m][n], 0, 0, 0); __builtin_amdgcn_s_setprio(0); } while (0)
#define PG8_WAIT_V(n) asm volatile("s_waitcnt vmcnt(" #n ")" ::: "memory")
#define PG8_WAIT_L(n) asm volatile("s_waitcnt lgkmcnt(" #n ")" ::: "memory")
#define PG8_BAR __builtin_amdgcn_s_barrier()
#define PG8_SCHED __builtin_amdgcn_sched_barrier(0)
#define PG8_EOFF(pm_) (g.tile_e ? (size_t)g.tile_e[pm_] * g.estride * 2 : (size_t)0)
    Unit cur, nxt; int ui = 0;
    if (!S.next(0, cur)) return;
    f32x4 acc[2][2][4][2];
#pragma unroll
    for (int a = 0; a < 2; ++a)
#pragma unroll
        for (int b = 0; b < 2; ++b)
#pragma unroll
            for (int m = 0; m < 4; ++m)
#pragma unroll
                for (int n = 0; n < 2; ++n) acc[a][b][m][n] = (f32x4){0.f, 0.f, 0.f, 0.f};
    bf16x8 At[4][2], B0[2][2], B1[2][2];
    const char* cA = (const char*)g.A + (size_t)cur.pm * tsA; const char* cB = (const char*)g.Bt + PG8_EOFF(cur.pm) + (size_t)cur.pn * tsB;
    if constexpr (GATHER) PG8_GOFF(cur.pm, vgc);
    PG8_STAGE(PG8_SB(0, 0), cB, voffB); PG8_STAGE(PG8_SB(0, 1), cB + hsB, voffB); PG8_STAGE_A(PG8_SA(0, 0), cA, 0, false); PG8_STAGE_A(PG8_SA(0, 1), cA + hsA, 1, false);
    if (wr == 1) PG8_BAR;
    PG8_WAIT_V(2); PG8_BAR;
    PG8_STAGE(PG8_SB(1, 0), cB + kstep, voffB); PG8_STAGE_A(PG8_SA(1, 0), cA + kstep, 0, false); PG8_STAGE(PG8_SB(1, 1), cB + hsB + kstep, voffB);
    PG8_WAIT_V(6); PG8_BAR;
    for (;;) {
        const bool has_next = S.next(ui + 1, nxt);
        if constexpr (GATHER) { if (has_next) PG8_GOFF(nxt.pm, vgn); else { vgn[0][0] = vgc[0][0]; vgn[0][1] = vgc[0][1]; vgn[1][0] = vgc[1][0]; vgn[1][1] = vgc[1][1]; } }
        const char* nA = has_next ? (const char*)g.A + (size_t)nxt.pm * tsA : cA;
        const char* nB = has_next ? (const char*)g.Bt + PG8_EOFF(nxt.pm) + (size_t)nxt.pn * tsB : cB;
        for (int t = 0; t < nt; t += 2) {
            const bool last = (t == nt - 2);
            const char* a1 = cA + (size_t)(t + 1) * kstep;
            const char* a2 = last ? nA : cA + (size_t)(t + 2) * kstep; const char* b2 = last ? nB : cB + (size_t)(t + 2) * kstep;
            const char* a3 = a2 + kstep; const char* b3 = b2 + kstep;
            PG8_LDB(B0, 0, 0); PG8_LDB(B1, 0, 1); PG8_SCHED; PG8_LDA(At, 0, 0); PG8_STAGE_A(PG8_SA(1, 1), a1 + hsA, 1, false);
            PG8_WAIT_V(8); PG8_WAIT_L(0); PG8_BAR; PG8_MMA(0, 0, At, B0); PG8_MMA(0, 1, At, B1); PG8_BAR; PG8_SCHED;
            PG8_LDA(At, 0, 1); PG8_STAGE(PG8_SB(0, 0), b2, voffB); PG8_STAGE(PG8_SB(0, 1), b2 + hsB, voffB); PG8_STAGE_A(PG8_SA(0, 0), a2, 0, last);
            PG8_WAIT_V(8); PG8_WAIT_L(0); PG8_BAR; PG8_MMA(1, 0, At, B0); PG8_MMA(1, 1, At, B1); PG8_BAR; PG8_SCHED;
            PG8_LDB(B0, 1, 0); PG8_LDB(B1, 1, 1); PG8_SCHED; PG8_LDA(At, 1, 0); PG8_STAGE_A(PG8_SA(0, 1), a2 + hsA, 1, last);
            PG8_WAIT_V(8); PG8_WAIT_L(0); PG8_BAR; PG8_MMA(0, 0, At, B0); PG8_MMA(0, 1, At, B1); PG8_BAR; PG8_SCHED;
            PG8_LDA(At, 1, 1); PG8_STAGE(PG8_SB(1, 0), b3, voffB); PG8_STAGE(PG8_SB(1, 1), b3 + hsB, voffB); PG8_STAGE_A(PG8_SA(1, 0), a3, 0, last);
            PG8_WAIT_V(8); PG8_WAIT_L(0); PG8_BAR; PG8_MMA(1, 0, At, B0); PG8_MMA(1, 1, At, B1); PG8_BAR; PG8_SCHED;
        }
        if constexpr (ALIGN_EPI) { if (wr == 0) PG8_BAR; }
        E(acc, cur, wr, wc, fr, fq);
        if (!has_next) break;
#pragma unroll
        for (int a = 0; a < 2; ++a)
#pragma unroll
            for (int b = 0; b < 2; ++b)
#pragma unroll
                for (int m = 0; m < 4; ++m)
#pragma unroll
                    for (int n = 0; n < 2; ++n) acc[a][b][m][n] = (f32x4){0.f, 0.f, 0.f, 0.f};
        cur = nxt; cA = nA; cB = nB; ++ui;
        if constexpr (GATHER) { vgc[0][0] = vgn[0][0]; vgc[0][1] = vgn[0][1]; vgc[1][0] = vgn[1][0]; vgc[1][1] = vgn[1][1]; }
        if constexpr (ALIGN_EPI) { if (wr == 1) PG8_BAR; }
    }
    PG8_WAIT_V(0);
    if constexpr (!ALIGN_EPI) { if (wr == 0) PG8_BAR; }
    PG8_BAR;
#undef PG8_SA
#undef PG8_SB
#undef PG8_STAGE
#undef PG8_LDA
#undef PG8_LDB
#undef PG8_MMA
#undef PG8_WAIT_V
#undef PG8_WAIT_L
#undef PG8_BAR
#undef PG8_SCHED
#undef PG8_EOFF
#undef PG8_GOFF
#undef PG8_STAGE_A
}

__device__ __forceinline__ float row_rstd(const float* ssp, int row);
template <int ACT> struct EpiBf16 {
    static constexpr bool PERM = true;
    bf16_t* O; int ldc; const float* bias; const float* ssp;
    __device__ __forceinline__ void operator()(const f32x4 (&acc)[2][2][4][2], const Unit& u, int wr, int wc, int fr, int fq) const {
        const int row0 = u.pm * BM + wr * 64 + fr, col0 = u.pn * BM + wc * 32 + 8 * fq;
        f32x4 bv[2][2];
#pragma unroll
        for (int bj = 0; bj < 2; ++bj)
#pragma unroll
            for (int n = 0; n < 2; ++n) bv[bj][n] = bias ? *(const f32x4*)(bias + col0 + bj * HALF + 4 * n) : (f32x4){0.f, 0.f, 0.f, 0.f};
#pragma unroll
        for (int ai = 0; ai < 2; ++ai)
#pragma unroll
            for (int m = 0; m < 4; ++m) { bf16_t* rowp = O + (size_t)(row0 + ai * HALF + m * 16) * ldc + col0;
                const float rs = (ACT == 0 && ssp) ? row_rstd(ssp, row0 + ai * HALF + m * 16) : 1.f;
#pragma unroll
                for (int bj = 0; bj < 2; ++bj) { f32x4 v0 = acc[ai][bj][m][0] * rs + bv[bj][0], v1 = acc[ai][bj][m][1] * rs + bv[bj][1];
                    if (ACT == 2) {
#pragma unroll
                        for (int i = 0; i < 4; ++i) { v0[i] = gelu_tanh_f(v0[i]); v1[i] = gelu_tanh_f(v1[i]); } }
                    u32x4 w; w.x = cvtpk(v0[0], v0[1]); w.y = cvtpk(v0[2], v0[3]); w.z = cvtpk(v1[0], v1[1]); w.w = cvtpk(v1[2], v1[3]);
                    *(u32x4*)(rowp + bj * HALF) = w; } }
    }
};
struct EpiResF32 {
    static constexpr bool PERM = false;
    const float* base; float* out; int ldc;
    __device__ __forceinline__ void operator()(const f32x4 (&acc)[2][2][4][2], const Unit& u, int wr, int wc, int fr, int fq) const {
        const int col0 = u.pn * BM + wc * 32 + 4 * fq;
#pragma unroll
        for (int ai = 0; ai < 2; ++ai)
#pragma unroll
            for (int m = 0; m < 4; ++m) { const size_t off = (size_t)(u.pm * BM + ai * HALF + wr * 64 + m * 16 + fr) * ldc + col0;
#pragma unroll
                for (int bj = 0; bj < 2; ++bj)
#pragma unroll
                    for (int n = 0; n < 2; ++n) { const f32x4 bs = *(const f32x4*)(base + off + bj * HALF + n * 16); *(f32x4*)(out + off + bj * HALF + n * 16) = bs + acc[ai][bj][m][n]; } }
    }
};
template <bool BASE_BF16> struct EpiResStat {
    static constexpr bool PERM = false;
    const void* base; bf16_t* xb; float* ssp; int ldc;
    __device__ __forceinline__ void operator()(const f32x4 (&acc)[2][2][4][2], const Unit& u, int wr, int wc, int fr, int fq) const {
        const int col0 = u.pn * BM + wc * 32 + 4 * fq;
#pragma unroll
        for (int ai = 0; ai < 2; ++ai)
#pragma unroll
            for (int m = 0; m < 4; ++m) { const int row = u.pm * BM + ai * HALF + wr * 64 + m * 16 + fr; const size_t off = (size_t)row * ldc + col0; float ss = 0.f;
#pragma unroll
                for (int bj = 0; bj < 2; ++bj)
#pragma unroll
                    for (int n = 0; n < 2; ++n) { f32x4 bs;
                        if (BASE_BF16) { const u32x2 t = *(const u32x2*)((const bf16_t*)base + off + bj * HALF + n * 16); bs = (f32x4){bflo(t.x), bfhi(t.x), bflo(t.y), bfhi(t.y)}; }
                        else bs = *(const f32x4*)((const float*)base + off + bj * HALF + n * 16);
                        const f32x4 v = bs + acc[ai][bj][m][n];
                        u32x2 w; w.x = cvtpk(v.x, v.y); w.y = cvtpk(v.z, v.w); *(u32x2*)(xb + off + bj * HALF + n * 16) = w; ss += (v.x * v.x + v.y * v.y) + (v.z * v.z + v.w * v.w); }
                ss += __shfl_xor(ss, 16); ss += __shfl_xor(ss, 32);
                if (fq == 0) ssp[(size_t)row * 16 + u.pn * 4 + wc] = ss; }
    }
};
struct EpiResBf16B {
    static constexpr bool PERM = false;
    const bf16_t* base; bf16_t* out; int ldc;
    __device__ __forceinline__ void operator()(const f32x4 (&acc)[2][2][4][2], const Unit& u, int wr, int wc, int fr, int fq) const {
        const int col0 = u.pn * BM + wc * 32 + 4 * fq;
#pragma unroll
        for (int ai = 0; ai < 2; ++ai)
#pragma unroll
            for (int m = 0; m < 4; ++m) { const size_t off = (size_t)(u.pm * BM + ai * HALF + wr * 64 + m * 16 + fr) * ldc + col0;
#pragma unroll
                for (int bj = 0; bj < 2; ++bj)
#pragma unroll
                    for (int n = 0; n < 2; ++n) { const u32x2 t = *(const u32x2*)(base + off + bj * HALF + n * 16); const f32x4 v = (f32x4){bflo(t.x), bfhi(t.x), bflo(t.y), bfhi(t.y)} + acc[ai][bj][m][n];
                        u32x2 w; w.x = cvtpk(v.x, v.y); w.y = cvtpk(v.z, v.w); *(u32x2*)(out + off + bj * HALF + n * 16) = w; } }
    }
};
struct EpiResF32B {
    static constexpr bool PERM = false;
    const bf16_t* base; float* out; int ldc;
    __device__ __forceinline__ void operator()(const f32x4 (&acc)[2][2][4][2], const Unit& u, int wr, int wc, int fr, int fq) const {
        const int col0 = u.pn * BM + wc * 32 + 4 * fq;
#pragma unroll
        for (int ai = 0; ai < 2; ++ai)
#pragma unroll
            for (int m = 0; m < 4; ++m) { const size_t off = (size_t)(u.pm * BM + ai * HALF + wr * 64 + m * 16 + fr) * ldc + col0;
#pragma unroll
                for (int bj = 0; bj < 2; ++bj)
#pragma unroll
                    for (int n = 0; n < 2; ++n) { const u32x2 t = *(const u32x2*)(base + off + bj * HALF + n * 16); const f32x4 bs = {bflo(t.x), bfhi(t.x), bflo(t.y), bfhi(t.y)};
                        *(f32x4*)(out + off + bj * HALF + n * 16) = bs + acc[ai][bj][m][n]; } }
    }
};
__device__ __forceinline__ float row_rstd(const float* ssp, int row) {
    const f32x4* q = (const f32x4*)(ssp + (size_t)row * 16); const f32x4 a = q[0], b = q[1], c = q[2], d = q[3];
    const float s = ((a.x + a.y) + (a.z + a.w)) + ((b.x + b.y) + (b.z + b.w)) + ((c.x + c.y) + (c.z + c.w)) + ((d.x + d.y) + (d.z + d.w));
    return rsqrtf(s * (1.f / 1024.f) + EPS);
}
struct EpiSwiGLU {
    static constexpr bool PERM = true;
    bf16_t* O; int ldc; const float* ssp;
    __device__ __forceinline__ void operator()(const f32x4 (&acc)[2][2][4][2], const Unit& u, int wr, int wc, int fr, int fq) const {
        const int row0 = u.pm * BM + wr * 64 + fr, col0 = u.pn * HALF + wc * 32 + 8 * fq;
#pragma unroll
        for (int ai = 0; ai < 2; ++ai)
#pragma unroll
            for (int m = 0; m < 4; ++m) { bf16_t* rowp = O + (size_t)(row0 + ai * HALF + m * 16) * ldc + col0;
                const float rs = ssp ? row_rstd(ssp, row0 + ai * HALF + m * 16) : 1.f;
                float h[8];
#pragma unroll
                for (int n = 0; n < 2; ++n)
#pragma unroll
                    for (int i = 0; i < 4; ++i) h[n * 4 + i] = silu_f(acc[ai][0][m][n][i] * rs) * (acc[ai][1][m][n][i] * rs);
                u32x4 w; w.x = cvtpk(h[0], h[1]); w.y = cvtpk(h[2], h[3]); w.z = cvtpk(h[4], h[5]); w.w = cvtpk(h[6], h[7]);
                *(u32x4*)rowp = w; }
    }
};
struct EpiConvIn {
    static constexpr bool PERM = true;
    bf16_t* Bg; bf16_t* CU; const float* ssp;
    __device__ __forceinline__ void operator()(const f32x4 (&acc)[2][2][4][2], const Unit& u, int wr, int wc, int fr, int fq) const {
        const int row0 = u.pm * BM + wr * 64 + fr;
#pragma unroll
        for (int ai = 0; ai < 2; ++ai)
#pragma unroll
            for (int m = 0; m < 4; ++m) { const int row = row0 + ai * HALF + m * 16; const float rs = row_rstd(ssp, row);
                if (u.pn < 4) {
#pragma unroll
                    for (int bj = 0; bj < 2; ++bj) { const f32x4 v0 = acc[ai][bj][m][0] * rs, v1 = acc[ai][bj][m][1] * rs;
                        u32x4 w; w.x = cvtpk(v0[0], v0[1]); w.y = cvtpk(v0[2], v0[3]); w.z = cvtpk(v1[0], v1[1]); w.w = cvtpk(v1[2], v1[3]);
                        *(u32x4*)(Bg + (size_t)row * 1024 + u.pn * BM + bj * HALF + wc * 32 + 8 * fq) = w; }
                } else { const float r2 = rs * rs; float h[8];
#pragma unroll
                    for (int n = 0; n < 2; ++n)
#pragma unroll
                        for (int i = 0; i < 4; ++i) h[n * 4 + i] = acc[ai][0][m][n][i] * acc[ai][1][m][n][i] * r2;
                    u32x4 w; w.x = cvtpk(h[0], h[1]); w.y = cvtpk(h[2], h[3]); w.z = cvtpk(h[4], h[5]); w.w = cvtpk(h[6], h[7]);
                    *(u32x4*)(CU + (size_t)row * 1024 + (u.pn - 4) * HALF + wc * 32 + 8 * fq) = w; } }
    }
};
struct EpiRowScaleBf16 {
    static constexpr bool PERM = true;
    bf16_t* O; int ldc; const float* roww;
    __device__ __forceinline__ void operator()(const f32x4 (&acc)[2][2][4][2], const Unit& u, int wr, int wc, int fr, int fq) const {
        const int row0 = u.pm * BM + wr * 64 + fr, col0 = u.pn * BM + wc * 32 + 8 * fq;
#pragma unroll
        for (int ai = 0; ai < 2; ++ai)
#pragma unroll
            for (int m = 0; m < 4; ++m) { const int row = row0 + ai * HALF + m * 16; const float sc = roww[row]; bf16_t* rowp = O + (size_t)row * ldc + col0;
#pragma unroll
                for (int bj = 0; bj < 2; ++bj) { const f32x4 v0 = acc[ai][bj][m][0] * sc, v1 = acc[ai][bj][m][1] * sc;
                    u32x4 w; w.x = cvtpk(v0[0], v0[1]); w.y = cvtpk(v0[2], v0[3]); w.z = cvtpk(v1[0], v1[1]); w.w = cvtpk(v1[2], v1[3]);
                    *(u32x4*)(rowp + bj * HALF) = w; } }
    }
};
}
constexpr int ROWS_MAX = 2 * T + 8 * 256;
constexpr size_t al256(size_t x) { return (x + 255) & ~(size_t)255; }
constexpr size_t W_IN_E = 0;
constexpr size_t W_CW1 = W_IN_E + (size_t)1792 * 1024 * 2;
constexpr size_t W_UQ = W_CW1 + (size_t)2 * 256 * 2048 * 2;
constexpr size_t W_UKV = W_UQ + (size_t)1024 * 256 * 2;
constexpr size_t W_OUT_E = W_UKV + (size_t)1024 * 128 * 2;
constexpr size_t W_GU = W_OUT_E + (size_t)1024 * 1024 * 2;
constexpr size_t W_D = W_GU + (size_t)5632 * 1024 * 2;
constexpr size_t W_IN_O = W_D + (size_t)1024 * 2816 * 2;
constexpr size_t W_OUT_O = W_IN_O + (size_t)3072 * 1024 * 2;
constexpr size_t W_MGU = W_OUT_O + (size_t)1024 * 1024 * 2;
constexpr size_t W_MD = W_MGU + (size_t)8 * 2816 * 1024 * 2;
constexpr size_t W_END = W_MD + (size_t)8 * 1024 * 1408 * 2;
constexpr size_t SM_CTL = al256(W_END);
constexpr size_t SM_BAR = SM_CTL + 4096;
constexpr size_t SM_B1P = SM_BAR + 16384;
constexpr size_t SM_B1 = SM_B1P + 32 * 512 * 4;
constexpr size_t SM_ROPE = SM_B1 + 512 * 4;
constexpr size_t SM_BL = SM_ROPE + (size_t)S * 32 * 4;
constexpr size_t SM_HID = SM_BL + 8 * 132 * 4;
constexpr size_t SM_KC = SM_HID + (size_t)2 * NB * 512 * 512 * 2;
constexpr size_t SM_VCT = SM_KC + (size_t)NB * 512 * 64 * 2;
constexpr size_t SM_TE = SM_VCT + (size_t)NB * 512 * 64 * 2;
constexpr size_t SM_TW = SM_TE + (size_t)T * 8;
constexpr size_t SM_RANK = SM_TW + (size_t)T * 8;
constexpr size_t SM_POS = SM_RANK + (size_t)T * 8;
constexpr size_t SM_ROWW = SM_POS + (size_t)T * 8;
constexpr size_t SM_TILEE = SM_ROWW + (size_t)ROWS_MAX * 4;
constexpr size_t SM_ROWTOK = al256(SM_TILEE + (size_t)(ROWS_MAX / 256 + 8) * 4);
constexpr size_t SM_SSP1 = al256(SM_ROWTOK + (size_t)ROWS_MAX * 4);
constexpr size_t SM_SSP2 = SM_SSP1 + (size_t)T * 64;
constexpr size_t SM_END = SM_SSP2 + (size_t)T * 64;
constexpr size_t R_XA = al256(SM_END);
constexpr size_t SZ_XA = (size_t)T * 4096 + (size_t)4 * 1048576;
constexpr size_t R_XN = R_XA + SZ_XA;
constexpr size_t SZ_XN = (size_t)T * 2048;
constexpr size_t R_H = R_XN + SZ_XN;
constexpr size_t SZ_H = ((size_t)T * 6144 > (size_t)ROWS_MAX * 2816) ? (size_t)T * 6144 : (size_t)ROWS_MAX * 2816;
constexpr size_t WS_FAST_END = R_H + SZ_H;
constexpr size_t A_QN = 0;
constexpr size_t A_KSN = A_QN + (size_t)T * 1024;
constexpr size_t A_KWN = A_KSN + (size_t)T * 256;
constexpr size_t A_VST = A_KWN + (size_t)T * 256;
constexpr size_t A_VWT = A_VST + (size_t)T * 256;
constexpr size_t A_KCIN = A_VWT + (size_t)T * 256;
constexpr size_t A_VCIN = A_KCIN + (size_t)T * 256 + 2048;
constexpr size_t A_CQN = A_VCIN + (size_t)T * 256 + 2048;
constexpr size_t A_CKVN = A_CQN + (size_t)T * 512;
constexpr size_t A_KROPE = A_CKVN + (size_t)T * 256;
constexpr size_t A_GATES = A_KROPE + (size_t)T * 64;
constexpr size_t A_END = A_GATES + (size_t)T * 96;
static_assert(A_END <= SZ_XA, "attention inputs fit R_XA");
constexpr size_t O_QM = 0;
constexpr size_t O_KM = O_QM + (size_t)T * 1536;
constexpr size_t O_VMT = O_KM + (size_t)T * 1536;
static_assert(O_VMT + (size_t)T * 1024 <= (size_t)T * 4096, "d_out scratch");

struct Params {
    const float* in[30];
    float* out;
    unsigned char* ws;
    int ph_lo, ph_hi, dbg_branch, pad_;
};

#ifdef PROF_SEL
#define PROF_SLOT(k) ((unsigned long long*)(p.ws + SM_CTL + 2048) + (k))
#define PROF_ON(cond) ((cond) && threadIdx.x == 0)
#ifndef PROF_WAVE
#define PROF_WAVE 0
#endif
#endif
constexpr int LDS_BYTES = 163840;

__device__ __forceinline__ int ltid() { int t = threadIdx.x; asm volatile("" : "+v"(t)); return t; }
__device__ __forceinline__ int perm16(int k) { return (k & ~12) | ((k & 4) << 1) | ((k & 8) >> 1); }

struct WDesc { int in_idx, K, N, rep, map, row_off; size_t src_stride, dst_off, dst_stride; int gain_idx, pad_; size_t src_off; };
__device__ const WDesc WDESC[13] = {
    {3, 1024, 1720, 1, 2, 0, 0, W_IN_E / 2, 0, -1, 0},
    {7, 1024, 256, 2, 0, 0, (size_t)2048 * 256, W_CW1 / 2, (size_t)512 * 1024, -1, 0, 0},
    {7, 1024, 256, 2, 0, 256, (size_t)2048 * 256, W_CW1 / 2, (size_t)512 * 1024, -1, 0, (size_t)1024 * 256},
    {11, 256, 768, 1, 3, 0, 0, W_UQ / 2, 0, -1, 0},
    {12, 128, 1024, 1, 0, 0, 0, W_UKV / 2, 0, -1, 0},
    {15, 1024, 1024, 1, 0, 0, 0, W_OUT_E / 2, 0, -1, 0},
    {17, 1024, 2816, 1, 1, 0, 0, W_GU / 2, 0, 16, 0},
    {18, 1024, 2816, 1, 1, 128, 0, W_GU / 2, 0, 16, 0},
    {19, 2816, 1024, 1, 0, 0, 0, W_D / 2, 0, -1, 0},
    {21, 1024, 3072, 1, 4, 0, 0, W_IN_O / 2, 0, 20, 0},
    {23, 1024, 1024, 1, 0, 0, 0, W_OUT_O / 2, 0, -1, 0},
    {27, 1024, 1408, 8, 1, 0, (size_t)1024 * 1408, W_MGU / 2, (size_t)2816 * 1024, -1, 0},
    {28, 1024, 1408, 8, 1, 128, (size_t)1024 * 1408, W_MGU / 2, (size_t)2816 * 1024, -1, 0},
};
__device__ const WDesc WDESC_MD = {29, 1408, 1024, 8, 0, 0, (size_t)1408 * 1024, W_MD / 2, (size_t)1024 * 1408, -1, 0};

struct WItem { f32x4 v[8]; };
__device__ __forceinline__ void item_load(WItem& I, const float* W, int K, int N, const float* gain, int item, int lane) {
    const int nblk = (N + 31) / 32, kb = item / nblk, nb = item % nblk, k0 = 64 * kb, n0 = 32 * nb;
    const int n4 = (lane & 7) * 4; const bool nok = (n0 + n4) < N;
#pragma unroll
    for (int i = 0; i < 8; ++i) { const int kk = (lane >> 3) + 8 * i; I.v[i] = nok ? *(const f32x4*)(W + (size_t)(k0 + kk) * N + n0 + n4) : (f32x4){0.f, 0.f, 0.f, 0.f}; if (gain) I.v[i] = I.v[i] * gain[k0 + kk]; }
}
__device__ __forceinline__ void item_finish(const WItem& I, int K, int N, bf16_t* WT, int map, int row_off, LAS float* scr, int item, int lane) {
    const int nblk = (N + 31) / 32, kb = item / nblk, nb = item % nblk, k0 = 64 * kb, n0 = 32 * nb;
    const int n4 = (lane & 7) * 4;
#pragma unroll
    for (int i = 0; i < 8; ++i) { const int kk = (lane >> 3) + 8 * i; LAS float* d = scr + kk * 33 + n4; d[0] = I.v[i].x; d[1] = I.v[i].y; d[2] = I.v[i].z; d[3] = I.v[i].w; }
    asm volatile("s_waitcnt lgkmcnt(0)" ::: "memory");
    const int c = lane & 7;
#pragma unroll
    for (int j = 0; j < 4; ++j) { const int n = (lane >> 3) + 8 * j; const LAS float* s = scr + (8 * c) * 33 + n;
        u32x4 o; o.x = cvtpk(s[0 * 33], s[1 * 33]); o.y = cvtpk(s[2 * 33], s[3 * 33]); o.z = cvtpk(s[4 * 33], s[5 * 33]); o.w = cvtpk(s[6 * 33], s[7 * 33]);
        const int nn = n0 + n;
        if (nn < N) { const int row = (map == 1) ? (256 * (nn >> 7) + (nn & 127) + row_off) : (map == 2) ? (nn < 1280 ? nn : (nn < 1304 ? nn + 416 : nn - 24)) : (map == 3) ? ((nn / 96) * 128 + nn % 96) : (map == 4) ? (nn < 1024 ? nn : (nn < 2048 ? 1024 + 256 * ((nn - 1024) >> 7) + ((nn - 1024) & 127) : 1024 + 256 * ((nn - 2048) >> 7) + 128 + ((nn - 2048) & 127))) : (nn + row_off);
            *(u32x4*)(WT + (size_t)row * K + k0 + 8 * c) = o; } }
    asm volatile("s_waitcnt lgkmcnt(0)" ::: "memory");
}
__device__ __forceinline__ void rms_row_to_bf16(const float* xrow, const float* g, bf16_t* orow, int lane) {
    const f32x4* xr = (const f32x4*)xrow + lane; const f32x4* gr = (const f32x4*)g + lane;
    f32x4 v[4]; float s = 0.f;
#pragma unroll
    for (int j = 0; j < 4; ++j) { v[j] = xr[64 * j]; s += (v[j].x * v[j].x + v[j].y * v[j].y) + (v[j].z * v[j].z + v[j].w * v[j].w); }
    const float r = rsqrtf(wsum(s) * (1.f / 1024.f) + EPS);
    u32x2* o8 = (u32x2*)orow + lane;
#pragma unroll
    for (int j = 0; j < 4; ++j) { const f32x4 gg = gr[64 * j]; u32x2 w; w.x = cvtpk(v[j].x * r * gg.x, v[j].y * r * gg.y); w.y = cvtpk(v[j].z * r * gg.z, v[j].w * r * gg.w); o8[64 * j] = w; }
}
constexpr int WD_EARLY = 6;
__device__ __forceinline__ void convert_weights(const Params& p, LAS unsigned char* lds, int d_lo, int d_hi) {
    const int tid = ltid(), lane = tid & 63, wave = tid >> 6;
    const int gw = blockIdx.x * 8 + wave, NGW = gridDim.x * 8;
    LAS float* scr = (LAS float*)(lds + wave * 16384);
    int base = 0;
#pragma unroll 1
    for (int d = d_lo; d < d_hi; ++d) {
        const WDesc& wd = (d < 13) ? WDESC[d] : WDESC_MD;
        const int n_it = wd.rep * (wd.K / 64) * ((wd.N + 31) / 32);
        int first = (gw - (base % NGW) + NGW) % NGW;
        const int per = (wd.K / 64) * ((wd.N + 31) / 32); const float* gain = wd.gain_idx >= 0 ? p.in[wd.gain_idx] : nullptr;
        for (int it = first; it < n_it; it += 4 * NGW) {
            WItem I[4];
#pragma unroll
            for (int q = 0; q < 4; ++q) { const int iq = it + q * NGW; if (iq < n_it) { const int r = iq / per; item_load(I[q], p.in[wd.in_idx] + wd.src_off + (size_t)r * wd.src_stride, wd.K, wd.N, gain, iq % per, lane); } }
#pragma unroll
            for (int q = 0; q < 4; ++q) { const int iq = it + q * NGW; if (iq < n_it) { const int r = iq / per; item_finish(I[q], wd.K, wd.N, (bf16_t*)p.ws + wd.dst_off + (size_t)r * wd.dst_stride, wd.map, wd.row_off, scr, iq % per, lane); } }
        }
        base += n_it;
    }
}
__device__ __forceinline__ void phase_p0(const Params& p, LAS unsigned char* lds) {
    const int tid = ltid(), lane = tid & 63, wave = tid >> 6;
    const int gw = blockIdx.x * 8 + wave, NGW = gridDim.x * 8;
    convert_weights(p, lds, 0, WD_EARLY);
    bf16_t* xn = (bf16_t*)(p.ws + R_XN);
    for (int m = gw; m < T; m += 2 * NGW) { rms_row_to_bf16(p.in[0] + (size_t)m * D, p.in[2], xn + (size_t)m * D, lane); if (m + NGW < T) rms_row_to_bf16(p.in[0] + (size_t)(m + NGW) * D, p.in[2], xn + (size_t)(m + NGW) * D, lane); }
    for (int u = gw; u < 256; u += NGW) {
        const int kc = u >> 3, kv = (u >> 2) & 1, nb = u & 3; float s = 0.f;
        const float* pos = p.in[6] + kv * 2048 + kc * 64; const float* w1 = p.in[7] + ((size_t)kv * 2048 + kc * 64) * 256 + nb * 64 + lane;
#pragma unroll 8
        for (int k = 0; k < 64; ++k) s += pos[k] * w1[(size_t)k * 256];
        ((float*)(p.ws + SM_B1P))[kc * 512 + kv * 256 + nb * 64 + lane] = s;
    }
    for (int i = blockIdx.x * 512 + tid; i < S * 16; i += gridDim.x * 512) {
        const int t = i >> 4, f = i & 15; const float ang = (float)t * powf(10000.f, -(float)f / 16.f);
        float* rp = (float*)(p.ws + SM_ROPE) + t * 32; rp[f] = cosf(ang); rp[16 + f] = sinf(ang);
    }
    if (blockIdx.x == 0) for (int i = tid; i < 8 * 129; i += 512) { const int h = i / 129, dd = i % 129; ((float*)(p.ws + SM_BL))[h * 132 + dd] = p.in[1][(dd < 128 ? (int)gold::T5B[dd] : 31) * 8 + h] * LOG2E; }
}

__device__ __forceinline__ void unpack8(const u32x4 v, float (&x)[8]) { x[0] = bflo(v.x); x[1] = bfhi(v.x); x[2] = bflo(v.y); x[3] = bfhi(v.y); x[4] = bflo(v.z); x[5] = bfhi(v.z); x[6] = bflo(v.w); x[7] = bfhi(v.w); }
__device__ __forceinline__ u32x4 pack8(const float (&x)[8]) { u32x4 w; w.x = cvtpk(x[0], x[1]); w.y = cvtpk(x[2], x[3]); w.z = cvtpk(x[4], x[5]); w.w = cvtpk(x[6], x[7]); return w; }
__device__ __forceinline__ float ss8f(const float (&x)[8]) { return ((x[0] * x[0] + x[1] * x[1]) + (x[2] * x[2] + x[3] * x[3])) + ((x[4] * x[4] + x[5] * x[5]) + (x[6] * x[6] + x[7] * x[7])); }
__device__ __forceinline__ void load8f(const float* g, float (&x)[8], float sc) { const f32x4 a = *(const f32x4*)g, b = *(const f32x4*)(g + 4); x[0] = a.x * sc; x[1] = a.y * sc; x[2] = a.z * sc; x[3] = a.w * sc; x[4] = b.x * sc; x[5] = b.y * sc; x[6] = b.z * sc; x[7] = b.w * sc; }
__device__ __forceinline__ void phase_p2(const Params& p, LAS unsigned char* lds) {
    const int tid = ltid(), lane = tid & 63, wave = tid >> 6;
    const bf16_t* hb = (const bf16_t*)(p.ws + R_H);
    unsigned char* xa = p.ws + R_XA;
    bf16_t* qn = (bf16_t*)(xa + A_QN); bf16_t* ksn = (bf16_t*)(xa + A_KSN); bf16_t* kwn = (bf16_t*)(xa + A_KWN);
    bf16_t* vst = (bf16_t*)(xa + A_VST); bf16_t* vwt = (bf16_t*)(xa + A_VWT); bf16_t* kcin = (bf16_t*)(xa + A_KCIN); bf16_t* vcin = (bf16_t*)(xa + A_VCIN);
    bf16_t* cqn = (bf16_t*)(xa + A_CQN); bf16_t* ckvn = (bf16_t*)(xa + A_CKVN); bf16_t* krope = (bf16_t*)(xa + A_KROPE); float* gates = (float*)(xa + A_GATES);
    LAS bf16_t* vs = (LAS bf16_t*)lds;
    if (blockIdx.x == 0) {
        { float s = 0.f; for (int k = 0; k < 32; ++k) s += ((const float*)(p.ws + SM_B1P))[k * 512 + tid]; ((float*)(p.ws + SM_B1))[tid] = s; }
        for (int i = tid; i < 1024; i += 512) { kcin[(size_t)T * 128 + i] = 0; vcin[(size_t)T * 128 + i] = 0; }
    }
    const int c8 = (lane & 7) * 8, seg = lane >> 3;
    float qg[8], ksg[8], kwg[8], cqg[8], ckvg[8];
    load8f(p.in[4] + c8, qg, 0.125f * LOG2E); load8f(p.in[5] + 64 + c8, ksg, 1.f); load8f(p.in[5] + 128 + c8, kwg, 1.f);
    load8f(p.in[9] + (lane & 31) * 8, cqg, 1.f); load8f(p.in[10] + (lane & 15) * 8, ckvg, 1.f);
    for (int tile = blockIdx.x; tile < T / 64; tile += gridDim.x) {
        const int b = tile / (S / 64), s0 = (tile % (S / 64)) * 64;
#pragma unroll 4
        for (int tt = 0; tt < 8; ++tt) {
            const int sl = wave * 8 + tt, s = s0 + sl; const size_t t = (size_t)b * S + s;
            const bf16_t* hr = hb + t * 1792 + lane * 8;
            const u32x4 L0 = *(const u32x4*)hr, L1 = *(const u32x4*)(hr + 512), L2 = *(const u32x4*)(hr + 1024);
            u32x4 L3 = {0u, 0u, 0u, 0u}; if (lane < 32) L3 = *(const u32x4*)(hr + 1536);
            float x0[8], x1[8], x2[8], x3[8];
            unpack8(L0, x0); unpack8(L1, x1); unpack8(L2, x2); unpack8(L3, x3);
            float a0 = ss8f(x0), a1 = ss8f(x1), a2 = ss8f(x2), a3 = ss8f(x3);
#pragma unroll
            for (int o = 1; o < 8; o <<= 1) { a0 += __shfl_xor(a0, o); a1 += __shfl_xor(a1, o); a2 += __shfl_xor(a2, o); a3 += __shfl_xor(a3, o); }
            float a2w = a2 + __shfl_xor(a2, 8); a2w += __shfl_xor(a2w, 16);
            const float a3w = a3 + __shfl_xor(a3, 8);
            const int pp0 = (sl & ~15) | perm16(sl & 15);
            const int pp = (((pp0 >> 3) ^ (lane & 7)) << 3) | (pp0 & 7);
            {
                const float r = rsqrtf(a0 * (1.f / 64.f) + EPS); float y[8];
#pragma unroll
                for (int j = 0; j < 8; ++j) y[j] = x0[j] * r * qg[j];
                *(u32x4*)(qn + t * 512 + lane * 8) = pack8(y);
            }
            {
                const int g = seg & 1; const size_t gm = (((size_t)b * 2 + g) * S + s) * 64 + c8;
                if (seg < 2) *(u32x4*)(kcin + gm) = L1;
                else if (seg < 4) *(u32x4*)(vcin + gm) = L1;
                else if (seg < 6) { const float r = rsqrtf(a1 * (1.f / 64.f) + EPS); float y[8];
#pragma unroll
                    for (int j = 0; j < 8; ++j) y[j] = x1[j] * r * ksg[j];
                    *(u32x4*)(ksn + gm) = pack8(y); }
                else {
#pragma unroll
                    for (int j = 0; j < 8; ++j) vs[((0 + g) * 64 + c8 + j) * 72 + pp] = (bf16_t)((j & 1) ? (L1[j >> 1] >> 16) : (L1[j >> 1] & 0xffffu)); }
            }
            {
                const int g = seg & 1; const size_t gm = (((size_t)b * 2 + g) * S + s) * 64 + c8;
                if (seg < 2) { const float r = rsqrtf(a2 * (1.f / 64.f) + EPS); float y[8];
#pragma unroll
                    for (int j = 0; j < 8; ++j) y[j] = x2[j] * r * kwg[j];
                    *(u32x4*)(kwn + gm) = pack8(y); }
                else if (seg < 4) {
#pragma unroll
                    for (int j = 0; j < 8; ++j) vs[((2 + g) * 64 + c8 + j) * 72 + pp] = (bf16_t)((j & 1) ? (L2[j >> 1] >> 16) : (L2[j >> 1] & 0xffffu)); }
                else { const float r = rsqrtf(a2w * (1.f / 256.f) + EPS); float y[8];
#pragma unroll
                    for (int j = 0; j < 8; ++j) y[j] = x2[j] * r * cqg[j];
                    *(u32x4*)(cqn + t * 256 + (lane - 32) * 8) = pack8(y); }
            }
            {
                if (lane < 16) { const float r = rsqrtf(a3w * (1.f / 128.f) + EPS); float y[8];
#pragma unroll
                    for (int j = 0; j < 8; ++j) y[j] = x3[j] * r * ckvg[j];
                    *(u32x4*)(ckvn + t * 128 + lane * 8) = pack8(y); }
                else if (lane < 20) *(u32x4*)(krope + t * 32 + (lane - 16) * 8) = L3;
                else if (lane < 23) { float y[8];
#pragma unroll
                    for (int j = 0; j < 8; ++j) y[j] = frcp(1.f + fexp2(-x3[j] * LOG2E));
                    float* gp = gates + t * 24 + (lane - 20) * 8; *(f32x4*)gp = (f32x4){y[0], y[1], y[2], y[3]}; *(f32x4*)(gp + 4) = (f32x4){y[4], y[5], y[6], y[7]}; }
            }
        }
        __syncthreads();
        {
            const int row = tid >> 1, half = tid & 1, which = row >> 6, d = row & 63, g = which & 1;
            bf16_t* dst = ((which < 2) ? vst : vwt) + (((size_t)b * 2 + g) * 64 + d) * S + s0 + half * 32;
            const LAS bf16_t* src = vs + row * 72; const int sx = (row >> 3) & 7;
#pragma unroll
            for (int c = 0; c < 4; ++c) *(u32x4*)(dst + c * 8) = *(const LAS u32x4*)(src + (((half * 4 + c) ^ sx) << 3));
        }
        __syncthreads();
    }
}
__device__ __forceinline__ void phase_p3b(const Params& p, LAS unsigned char* lds) {
    const int tid = ltid(), lane = tid & 63, wave = tid >> 6;
    const int gw = blockIdx.x * 8 + wave, NGW = gridDim.x * 8;
    const bf16_t* qraw = (const bf16_t*)(p.ws + R_H);
    const bf16_t* kvraw = (const bf16_t*)(p.ws + R_H + (size_t)T * 2048);
    const bf16_t* krope = (const bf16_t*)(p.ws + R_XA + A_KROPE);
    const float* rope = (const float*)(p.ws + SM_ROPE);
    bf16_t* qm = (bf16_t*)((unsigned char*)p.out + O_QM); bf16_t* km = (bf16_t*)((unsigned char*)p.out + O_KM); bf16_t* vmt = (bf16_t*)((unsigned char*)p.out + O_VMT);
    const float* q_norm = p.in[13]; const float* k_norm = p.in[14];
    LAS bf16_t* vs = (LAS bf16_t*)lds;
    LAS float* w2s = (LAS float*)(lds + 73728);
    for (int kv = 0; kv < 2; ++kv) {
        __syncthreads();
        for (int i = tid; i < 256 * 64; i += 512) w2s[i] = p.in[8][kv * 16384 + i];
        __syncthreads();
        const bf16_t* P = (const bf16_t*)(p.ws + SM_HID) + (size_t)kv * NB * 512 * 512;
        const f32x4 bs = *(const f32x4*)((const float*)(p.ws + SM_B1) + kv * 256 + lane * 4);
        for (int row = gw; row < NB * 512; row += NGW) {
            const int row1 = row + 1 < NB * 512 ? row + 1 : row;
            const u32x2 pa = *(const u32x2*)(P + (size_t)row * 512 + lane * 4), pb = *(const u32x2*)(P + (size_t)row1 * 512 + 256 + lane * 4);
            const float h0 = gelu_tanh_f(bflo(pa.x) + bflo(pb.x) + bs.x), h1 = gelu_tanh_f(bfhi(pa.x) + bfhi(pb.x) + bs.y), h2 = gelu_tanh_f(bflo(pa.y) + bflo(pb.y) + bs.z), h3 = gelu_tanh_f(bfhi(pa.y) + bfhi(pb.y) + bs.w);
            float acc = 0.f;
#pragma unroll 8
            for (int k4 = 0; k4 < 64; ++k4) {
                acc += __shfl(h0, k4) * w2s[(k4 * 4 + 0) * 64 + lane]; acc += __shfl(h1, k4) * w2s[(k4 * 4 + 1) * 64 + lane];
                acc += __shfl(h2, k4) * w2s[(k4 * 4 + 2) * 64 + lane]; acc += __shfl(h3, k4) * w2s[(k4 * 4 + 3) * 64 + lane];
            }
            if (kv == 0) { const float r = rsqrtf(wsum(acc * acc) * (1.f / 64.f) + EPS); ((bf16_t*)(p.ws + SM_KC))[(size_t)row * 64 + lane] = f2bf(acc * r * p.in[5][lane]); }
            else { const int c = row & 255; ((bf16_t*)(p.ws + SM_VCT))[((size_t)(row >> 8) * 64 + lane) * 256 + ((c & ~15) | perm16(c & 15))] = f2bf(acc); }
        }
    }
    __syncthreads();
    const float QS = 0.10206207261596577f * LOG2E;
    const int c = lane & 15, hl = lane >> 4;
    float qg[8], kg[8];
    load8f(q_norm + (c < 12 ? c * 8 : 0), qg, QS);
    load8f(k_norm + (c < 12 ? c * 8 : 0), kg, 1.f);
    for (int tile = blockIdx.x; tile < T / 64; tile += gridDim.x) {
        const int b = tile / (S / 64), s0 = (tile % (S / 64)) * 64;
#pragma unroll 4
        for (int tt = 0; tt < 8; ++tt) {
            const int sl = wave * 8 + tt, s = s0 + sl; const size_t t = (size_t)b * S + s;
            const int pp0 = (sl & ~15) | perm16(sl & 15);
            const int pp = (((pp0 >> 3) ^ ((c - 8) & 7)) << 3) | (pp0 & 7);
            u32x4 Q[2], KV[2];
#pragma unroll
            for (int ld = 0; ld < 2; ++ld) { Q[ld] = *(const u32x4*)(qraw + t * 1024 + ld * 512 + lane * 8); KV[ld] = *(const u32x4*)(kvraw + t * 1024 + ld * 512 + lane * 8); }
            u32x4 KR = {0u, 0u, 0u, 0u}; f32x4 cs0 = {0.f, 0.f, 0.f, 0.f}, cs1 = cs0, sn0 = cs0, sn1 = cs0;
            if (c >= 8 && c < 12) { KR = *(const u32x4*)(krope + t * 32 + (c - 8) * 8);
                const float* rp = rope + s * 32 + (c & 1) * 8; cs0 = *(const f32x4*)rp; cs1 = *(const f32x4*)(rp + 4); sn0 = *(const f32x4*)(rp + 16); sn1 = *(const f32x4*)(rp + 20); }
            const float cs[8] = {cs0.x, cs0.y, cs0.z, cs0.w, cs1.x, cs1.y, cs1.z, cs1.w}, sn[8] = {sn0.x, sn0.y, sn0.z, sn0.w, sn1.x, sn1.y, sn1.z, sn1.w};
            float kr[8]; unpack8(KR, kr);
            const float krs = ss8f(kr);
#pragma unroll
            for (int ld = 0; ld < 2; ++ld) {
                const int hh = ld * 4 + hl;
                {
                    float x[8]; unpack8(Q[ld], x);
                    float ss = c < 12 ? ss8f(x) : 0.f;
#pragma unroll
                    for (int o = 1; o < 16; o <<= 1) ss += __shfl_xor(ss, o);
                    const float r = rsqrtf(ss * (1.f / 96.f) + EPS); float y[8], z[8];
#pragma unroll
                    for (int j = 0; j < 8; ++j) y[j] = x[j] * r * qg[j];
#pragma unroll
                    for (int j = 0; j < 8; ++j) { const float pb = __shfl_xor(y[j], 2); z[j] = (c < 8) ? y[j] : ((c < 10) ? (y[j] * cs[j] - pb * sn[j]) : (pb * sn[j] + y[j] * cs[j])); }
                    if (c < 12) *(u32x4*)(qm + (t * 8 + hh) * 96 + c * 8) = pack8(z);
                }
                {
                    float x[8]; unpack8(KV[ld], x);
                    float ss = c < 8 ? ss8f(x) : krs;
#pragma unroll
                    for (int o = 1; o < 16; o <<= 1) ss += __shfl_xor(ss, o);
                    const float r = rsqrtf(ss * (1.f / 96.f) + EPS); float y[8], z[8];
#pragma unroll
                    for (int j = 0; j < 8; ++j) y[j] = (c < 8 ? x[j] : kr[j]) * r * kg[j];
#pragma unroll
                    for (int j = 0; j < 8; ++j) { const float pb = __shfl_xor(y[j], 2); z[j] = (c < 8) ? y[j] : ((c < 10) ? (y[j] * cs[j] - pb * sn[j]) : (pb * sn[j] + y[j] * cs[j])); }
                    if (c < 12) *(u32x4*)(km + (((size_t)b * 8 + hh) * S + s) * 96 + c * 8) = pack8(z);
                    if (c >= 8) {
#pragma unroll
                        for (int j = 0; j < 8; ++j) vs[(hh * 64 + (c - 8) * 8 + j) * 72 + pp] = (bf16_t)((j & 1) ? (KV[ld][j >> 1] >> 16) : (KV[ld][j >> 1] & 0xffffu)); }
                }
            }
        }
        __syncthreads();
        {
            const int hh = tid >> 6, d = tid & 63;
            bf16_t* dst = vmt + (((size_t)b * 8 + hh) * 64 + d) * S + s0;
            const LAS bf16_t* src = vs + tid * 72; const int sx = (tid >> 3) & 7;
#pragma unroll
            for (int cc = 0; cc < 8; ++cc) *(u32x4*)(dst + cc * 8) = *(const LAS u32x4*)(src + ((cc ^ sx) << 3));
        }
        __syncthreads();
    }
}

__device__ const unsigned short UNIT_TYPES[256] = {63,127,62,126,61,125,527,591,655,719,783,847,911,975,60,124,59,123,58,122,57,121,56,120,526,590,654,718,782,846,910,974,55,119,54,118,53,117,52,116,51,115,525,589,653,717,781,845,909,973,50,114,49,113,48,112,47,111,524,588,652,716,780,844,908,972,46,110,45,109,44,108,43,107,523,587,651,715,779,843,907,971,42,106,41,105,40,104,39,103,38,102,522,586,650,714,778,842,906,970,37,101,36,100,35,99,34,98,33,97,521,585,649,713,777,841,905,969,32,96,31,95,30,94,520,584,648,712,776,840,904,968,29,93,28,92,27,91,26,90,25,89,519,583,647,711,775,839,903,967,24,88,23,87,22,86,21,85,20,84,518,582,646,710,774,838,902,966,19,83,18,82,17,81,16,80,15,79,517,581,645,709,773,837,901,965,14,78,13,77,12,76,516,580,644,708,772,836,900,964,11,75,10,74,9,73,8,72,515,579,643,707,771,835,899,963,7,71,6,70,5,69,514,578,642,706,770,834,898,962,4,68,3,67,513,577,641,705,769,833,897,961,2,66,1,65,0,64,512,576,640,704,768,832,896,960};
__device__ __forceinline__ int crow(int r, int hi) { return (r & 3) + 8 * (r >> 2) + 4 * hi; }
struct Flash { f32x16 o0, o1; float l; };
__device__ __forceinline__ void flash_init(Flash& st) {
#pragma unroll
    for (int r = 0; r < 16; ++r) { st.o0[r] = 0.f; st.o1[r] = 0.f; }
    st.l = 0.f;
}
constexpr int AL_K64 = 0, AL_V64 = 4 * 8192;
constexpr int AL_K96 = 0, AL_V96 = 4 * 16384;
constexpr int AL_IMP = 65536, AL_SELB = AL_IMP + 64 * 65 * 4, AL_UNI = AL_SELB + 512, AL_TL = AL_UNI + 64, AL_BL = AL_TL + 128, AL_OT = AL_BL + 4 * 132 * 4, AL_END = AL_OT + 8 * 32 * 64 * 4;
static_assert(AL_END <= 163328 && AL_V96 + 4 * 8192 <= 163328, "attention LDS");

template <int RB> struct DmaLane { unsigned g0, g1; };
template <int RB> __device__ __forceinline__ void dma_setup(DmaLane<RB>& L, int w, int lane, unsigned gs) {
    if (RB == 128) { const int r = 8 * w + (lane >> 3), c = (lane & 7) ^ ((r >> 1) & 7); L.g0 = (unsigned)r * gs + c * 16; L.g1 = 0; }
    else {
        { const int r = 8 * w + (lane >> 4); int c = (lane & 15) ^ (r & 15); c = c >= 12 ? c - 4 : c; L.g0 = (unsigned)r * gs + c * 16; }
        { const int r = 8 * w + 4 + (lane >> 4); int c = (lane & 15) ^ (r & 15); c = c >= 12 ? c - 4 : c; L.g1 = (unsigned)r * gs + c * 16; }
    }
}
template <int RB> __device__ __forceinline__ void dma_issue(const unsigned char* tile, const DmaLane<RB>& L, LAS unsigned char* buf, int w) {
    if (RB == 128) __builtin_amdgcn_global_load_lds((const unsigned*)(tile + L.g0), (LAS unsigned*)(buf + w * 1024), 16, 0, 0);
    else { __builtin_amdgcn_global_load_lds((const unsigned*)(tile + L.g0), (LAS unsigned*)(buf + w * 2048), 16, 0, 0);
           __builtin_amdgcn_global_load_lds((const unsigned*)(tile + L.g1), (LAS unsigned*)(buf + w * 2048 + 1024), 16, 0, 0); }
}
template <int DK> __device__ __forceinline__ void frag_offsets(unsigned (&kl)[DK / 16], unsigned (&vl)[4], int r32, int hi) {
#pragma unroll
    for (int s = 0; s < DK / 16; ++s) kl[s] = (DK == 64) ? (unsigned)(r32 * 128 + (((2 * s + hi) ^ ((r32 >> 1) & 7)) << 4)) : (unsigned)(r32 * 256 + (((2 * s + hi) ^ (r32 & 15)) << 4));
#pragma unroll
    for (int s = 0; s < 4; ++s) vl[s] = (unsigned)(r32 * 128 + (((2 * s + hi) ^ ((r32 >> 1) & 7)) << 4));
}

template <int DK, int KP, bool LANEMASK, class F>
__device__ __forceinline__ void tile_compute(Flash& st, const LAS unsigned char* Kt, const LAS unsigned char* Vt, const bf16x8* qf, const f32x16& negm, const unsigned (&kl)[DK / 16], const unsigned (&vl)[4], bool mine, F f) {
    constexpr int NS = DK / 16; constexpr int KH = 32 * KP;
    bf16x8 ka[NS], kh[NS];
#pragma unroll
    for (int s = 0; s < NS; ++s) ka[s] = *(const LAS bf16x8*)(Kt + kl[s]);
#pragma unroll
    for (int s = 0; s < NS; ++s) kh[s] = *(const LAS bf16x8*)(Kt + kl[s] + KH);
    __builtin_amdgcn_sched_barrier(0);
    f32x16 p0, p1;
#pragma unroll
    for (int s = 0; s < NS; ++s) p0 = (s == 0) ? __builtin_amdgcn_mfma_f32_32x32x16_bf16(ka[0], qf[0], negm, 0, 0, 0) : __builtin_amdgcn_mfma_f32_32x32x16_bf16(ka[s], qf[s], p0, 0, 0, 0);
#pragma unroll
    for (int s = 0; s < NS; ++s) p1 = (s == 0) ? __builtin_amdgcn_mfma_f32_32x32x16_bf16(kh[0], qf[0], negm, 0, 0, 0) : __builtin_amdgcn_mfma_f32_32x32x16_bf16(kh[s], qf[s], p1, 0, 0, 0);
    bf16x8 va[4], vh[4];
#pragma unroll
    for (int s = 0; s < 4; ++s) { va[s] = *(const LAS bf16x8*)(Vt + vl[s]); vh[s] = *(const LAS bf16x8*)(Vt + vl[s] + 4096); }
    __builtin_amdgcn_sched_barrier(0);
    float ls = 0.f, ls1 = 0.f;
    u32x4 w0, w1, w2, w3;
    {
#pragma unroll
        for (int r = 0; r < 16; ++r) { float x = p0[r]; const bool v = f(r, 0, x); const float e = fexp2(x); p0[r] = v ? e : 0.f; ls += p0[r]; }
        w0.x = cvtpk(p0[0], p0[1]); w0.y = cvtpk(p0[2], p0[3]); w0.z = cvtpk(p0[4], p0[5]); w0.w = cvtpk(p0[6], p0[7]);
        w1.x = cvtpk(p0[8], p0[9]); w1.y = cvtpk(p0[10], p0[11]); w1.z = cvtpk(p0[12], p0[13]); w1.w = cvtpk(p0[14], p0[15]);
        if (LANEMASK) { w0.x = mine ? w0.x : 0u; w0.y = mine ? w0.y : 0u; w0.z = mine ? w0.z : 0u; w0.w = mine ? w0.w : 0u; w1.x = mine ? w1.x : 0u; w1.y = mine ? w1.y : 0u; w1.z = mine ? w1.z : 0u; w1.w = mine ? w1.w : 0u; }
    }
#pragma unroll
    for (int s = 0; s < 2; ++s) {
        const bf16x8 pa = __builtin_bit_cast(bf16x8, s ? w1 : w0);
        st.o0 = __builtin_amdgcn_mfma_f32_32x32x16_bf16(pa, va[s], st.o0, 0, 0, 0);
        st.o1 = __builtin_amdgcn_mfma_f32_32x32x16_bf16(pa, vh[s], st.o1, 0, 0, 0);
    }
    {
#pragma unroll
        for (int r = 0; r < 16; ++r) { float x = p1[r]; const bool v = f(r, 1, x); const float e = fexp2(x); p1[r] = v ? e : 0.f; ls1 += p1[r]; }
        w2.x = cvtpk(p1[0], p1[1]); w2.y = cvtpk(p1[2], p1[3]); w2.z = cvtpk(p1[4], p1[5]); w2.w = cvtpk(p1[6], p1[7]);
        w3.x = cvtpk(p1[8], p1[9]); w3.y = cvtpk(p1[10], p1[11]); w3.z = cvtpk(p1[12], p1[13]); w3.w = cvtpk(p1[14], p1[15]);
        if (LANEMASK) { w2.x = mine ? w2.x : 0u; w2.y = mine ? w2.y : 0u; w2.z = mine ? w2.z : 0u; w2.w = mine ? w2.w : 0u; w3.x = mine ? w3.x : 0u; w3.y = mine ? w3.y : 0u; w3.z = mine ? w3.z : 0u; w3.w = mine ? w3.w : 0u; }
    }
    ls += ls1;
    if (LANEMASK) ls = mine ? ls : 0.f;
    st.l += ls;
#pragma unroll
    for (int s = 2; s < 4; ++s) {
        const bf16x8 pa = __builtin_bit_cast(bf16x8, (s == 3) ? w3 : w2);
        st.o0 = __builtin_amdgcn_mfma_f32_32x32x16_bf16(pa, va[s], st.o0, 0, 0, 0);
        st.o1 = __builtin_amdgcn_mfma_f32_32x32x16_bf16(pa, vh[s], st.o1, 0, 0, 0);
    }
}
template <int DK, int KP> __device__ __forceinline__ void qk_tile(f32x16& p0, f32x16& p1, const LAS unsigned char* Kt, const bf16x8* qf, const f32x16& negm, const unsigned (&kl)[DK / 16]) {
#pragma unroll
    for (int s = 0; s < DK / 16; ++s) {
        const bf16x8 a0 = *(const LAS bf16x8*)(Kt + kl[s]);
        const bf16x8 a1 = *(const LAS bf16x8*)(Kt + kl[s] + 32 * KP);
        if (s == 0) { p0 = __builtin_amdgcn_mfma_f32_32x32x16_bf16(a0, qf[0], negm, 0, 0, 0); p1 = __builtin_amdgcn_mfma_f32_32x32x16_bf16(a1, qf[0], negm, 0, 0, 0); }
        else { p0 = __builtin_amdgcn_mfma_f32_32x32x16_bf16(a0, qf[s], p0, 0, 0, 0); p1 = __builtin_amdgcn_mfma_f32_32x32x16_bf16(a1, qf[s], p1, 0, 0, 0); }
    }
}
template <bool FIRST> __device__ __forceinline__ void flash_accum(LAS float* otl, const Flash& st, float gate, int hi, int lane) {
    const float lt = st.l + __shfl_xor(st.l, 32);
    const float f = lt > 0.f ? gate * frcp(lt) : 0.f;
#pragma unroll
    for (int r = 0; r < 16; ++r) { const float fr_ = __shfl(f, crow(r, hi));
        if (FIRST) { otl[r * 64 + lane] = fr_ * st.o0[r]; otl[(16 + r) * 64 + lane] = fr_ * st.o1[r]; }
        else { otl[r * 64 + lane] += fr_ * st.o0[r]; otl[(16 + r) * 64 + lane] += fr_ * st.o1[r]; } }
}
template <int NS> __device__ __forceinline__ float qnorm2(const bf16x8* qf) {
    float s = 0.f;
#pragma unroll
    for (int i = 0; i < NS; ++i)
#pragma unroll
        for (int j = 0; j < 8; ++j) { const float x = bf2f((bf16_t)qf[i][j]); s += x * x; }
    return s + __shfl_xor(s, 32);
}
__device__ __forceinline__ float wmax(float v) {
#pragma unroll
    for (int o = 1; o < 64; o <<= 1) v = fmaxf(v, __shfl_xor(v, o));
    return v;
}

struct NoComp {};
template <class T> struct is_nocomp { static constexpr bool v = false; };
template <> struct is_nocomp<NoComp> { static constexpr bool v = true; };
template <class C> __device__ __forceinline__ void rt_call(C& c, int t, LAS unsigned char* kb, LAS unsigned char* vb) { c(t, kb, vb); }
__device__ __forceinline__ void rt_call(NoComp&, int, LAS unsigned char*, LAS unsigned char*) {}
template <int RBK, bool HASV, int KOFF, int KSZ, int VOFF, class SrcK, class SrcV, class C0, class C1, class C2>
__device__ __forceinline__ void run_tiles(int n, int e0, int e1, int e2, LAS unsigned char* lds, int w, int lane, unsigned gsK, unsigned gsV, SrcK srcK, SrcV srcV, C0 c0, C1 c1, C2 c2) {
    DmaLane<RBK> LK; dma_setup<RBK>(LK, w, lane, gsK);
    DmaLane<128> LV; LV.g0 = 0; LV.g1 = 0; if (HASV) dma_setup<128>(LV, w, lane, gsV);
    const int nl = n - 1, t1 = nl < 1 ? nl : 1, t2 = nl < 2 ? nl : 2;
    e0 = __builtin_amdgcn_readfirstlane(e0); e1 = __builtin_amdgcn_readfirstlane(e1); e2 = __builtin_amdgcn_readfirstlane(e2);
    dma_issue<RBK>(srcK(0), LK, lds + KOFF, w); if (HASV) dma_issue<128>(srcV(0), LV, lds + VOFF, w);
    dma_issue<RBK>(srcK(t1), LK, lds + KOFF + KSZ, w); if (HASV) dma_issue<128>(srcV(t1), LV, lds + VOFF + 8192, w);
    dma_issue<RBK>(srcK(t2), LK, lds + KOFF + 2 * KSZ, w); if (HASV) dma_issue<128>(srcV(t2), LV, lds + VOFF + 2 * 8192, w);
    constexpr int P = (RBK == 128 ? 1 : 2) + (HASV ? 1 : 0);
    int t = 0, slot = 0;
#define RT_HEAD() do { \
        if (P == 1) asm volatile("s_waitcnt vmcnt(2)" ::: "memory"); else if (P == 2) asm volatile("s_waitcnt vmcnt(4)" ::: "memory"); else asm volatile("s_waitcnt vmcnt(6)" ::: "memory"); \
        __builtin_amdgcn_s_barrier(); asm volatile("" ::: "memory"); \
        { const int tn = (t + 3 < nl) ? t + 3 : nl; const int s2 = (slot + 3) & 3; \
          dma_issue<RBK>(srcK(tn), LK, lds + KOFF + s2 * KSZ, w); if (HASV) dma_issue<128>(srcV(tn), LV, lds + VOFF + s2 * 8192, w); } } while (0)
#define RT_SEG(cc, ee) if (!is_nocomp<decltype(cc)>::v) { _Pragma("unroll 1") for (; t < (ee); ++t) { RT_HEAD(); rt_call(cc, t, lds + KOFF + slot * KSZ, lds + VOFF + slot * 8192); slot = (slot + 1) & 3; } }
    RT_SEG(c0, e0)
    RT_SEG(c1, e1)
    RT_SEG(c2, e2)
#pragma unroll 1
    for (; t < n; ++t) { RT_HEAD(); slot = (slot + 1) & 3; }
#undef RT_SEG
#undef RT_HEAD
    asm volatile("s_waitcnt vmcnt(0)" ::: "memory");
    __syncthreads();
}

__device__ __forceinline__ void mla_unit(const Params& p, LAS unsigned char* lds, int b, int h, int qb) {
    int tid = threadIdx.x; asm volatile("" : "+v"(tid));
    const int lane = tid & 63, w = __builtin_amdgcn_readfirstlane(tid >> 6), r32 = lane & 31, hi = lane >> 5;
    const bf16_t* qm = (const bf16_t*)((const unsigned char*)p.out + O_QM);
    const unsigned char* km = (const unsigned char*)p.out + O_KM + (((size_t)b * 8 + h) * S) * 192;
    const unsigned char* vmt = (const unsigned char*)p.out + O_VMT + (((size_t)b * 8 + h) * 64) * (size_t)S * 2;
    bf16_t* ocat = (bf16_t*)(p.ws + R_XN);
    const int tq = qb * 256 + 32 * w + r32;
    bf16x8 qf[6];
#pragma unroll
    for (int s = 0; s < 6; ++s) qf[s] = *(const bf16x8*)(qm + (((size_t)b * S + tq) * 8 + h) * 96 + 16 * s + 8 * hi);
    const float kn = 9.797958971f * 1.01f * wmax(fmaxf(fabsf(p.in[14][lane]), lane < 32 ? fabsf(p.in[14][64 + lane]) : 0.f));
    const float mref = sqrtf(qnorm2<6>(qf)) * kn;
    f32x16 negm;
#pragma unroll
    for (int r = 0; r < 16; ++r) negm[r] = -mref;
    Flash st; flash_init(st);
    const int ntile = 4 * qb + 4, dt = 4 * qb + (w >> 1);
#ifdef PROF_SEL
    if (b == 0 && h == 0 && qb == 15 && threadIdx.x == 0) { *PROF_SLOT(36) -= __builtin_amdgcn_s_memtime(); *PROF_SLOT(37) -= __builtin_amdgcn_s_memrealtime(); }
#endif
    unsigned kl[6], vl[4]; frag_offsets<96>(kl, vl, r32, hi);
    run_tiles<192, true, AL_K96, 16384, AL_V96>(ntile, dt, dt + 1, dt + 1, lds, w, lane, 192u, (unsigned)(S * 2),
        [&](int i) { return km + (size_t)i * 64 * 192; }, [&](int i) { return vmt + (size_t)i * 128; },
        [&](int i, LAS unsigned char* kb, LAS unsigned char* vb) { tile_compute<96, 256, false>(st, kb, vb, qf, negm, kl, vl, true, [&](int r, int half, float& x) { return true; }); },
        [&](int i, LAS unsigned char* kb, LAS unsigned char* vb) { const int kb0 = 64 * i + 4 * hi; tile_compute<96, 256, false>(st, kb, vb, qf, negm, kl, vl, true, [&](int r, int half, float& x) { return (kb0 + 32 * half + (r & 3) + 8 * (r >> 2)) <= tq; }); },
        NoComp{});
#ifdef PROF_SEL
    if (b == 0 && h == 0 && qb == 15 && threadIdx.x == 0) { *PROF_SLOT(36) += __builtin_amdgcn_s_memtime(); *PROF_SLOT(37) += __builtin_amdgcn_s_memrealtime(); }
#endif
    {
        const float lt = st.l + __shfl_xor(st.l, 32); const float f = lt > 0.f ? frcp(lt) : 0.f;
#pragma unroll
        for (int r = 0; r < 16; ++r) { const float fr_ = __shfl(f, crow(r, hi)); const size_t ro = ((size_t)b * S + qb * 256 + 32 * w + crow(r, hi)) * 1024 + 512 + h * 64 + r32; ocat[ro] = f2bf(st.o0[r] * fr_); ocat[ro + 32] = f2bf(st.o1[r] * fr_); }
    }
}

__device__ __forceinline__ void nsa_unit(const Params& p, LAS unsigned char* lds, int b, int g, int jt) {
    int tid = threadIdx.x; asm volatile("" : "+v"(tid));
    const int lane = tid & 63, w = __builtin_amdgcn_readfirstlane(tid >> 6), r32 = lane & 31, hi = lane >> 5;
    const int rh = w >> 1, qh = w & 1, h = 4 * g + rh, q0 = 64 * jt, ql = 32 * qh + r32, tq = q0 + ql;
    const unsigned char* xa = p.ws + R_XA;
    const bf16_t* qn = (const bf16_t*)(xa + A_QN);
    const size_t bg = (size_t)b * 2 + g;
    const unsigned char* ksn = xa + A_KSN + bg * S * 128; const unsigned char* kwn = xa + A_KWN + bg * S * 128;
    const unsigned char* vst = xa + A_VST + bg * 64 * (size_t)S * 2; const unsigned char* vwt = xa + A_VWT + bg * 64 * (size_t)S * 2;
    const unsigned char* kc = p.ws + SM_KC + bg * 256 * 128; const unsigned char* vct = p.ws + SM_VCT + bg * 64 * 512;
    const float* gates = (const float*)(xa + A_GATES) + ((size_t)b * S + tq) * 24 + h * 3;
    bf16_t* ocat = (bf16_t*)(p.ws + R_XN);
    LAS float* imp = (LAS float*)(lds + AL_IMP); LAS unsigned char* selb = lds + AL_SELB; LAS unsigned* uni = (LAS unsigned*)(lds + AL_UNI); LAS unsigned char* tl = lds + AL_TL; LAS float* bls = (LAS float*)(lds + AL_BL);
    const float* blg = (const float*)(p.ws + SM_BL) + h * 132;
    const float cb = blg[128];
    const float bmax = wmax(fmaxf(fmaxf(blg[lane], blg[64 + lane]), cb));
    if (qh == 0) { bls[rh * 132 + lane] = blg[lane] - cb; bls[rh * 132 + 64 + lane] = blg[64 + lane] - cb; if (lane == 0) bls[rh * 132 + 128] = 0.f; }
    const LAS float* blh = bls + rh * 132;
    bf16x8 qf[4];
#pragma unroll
    for (int s = 0; s < 4; ++s) qf[s] = *(const bf16x8*)(qn + (((size_t)b * S + tq) * 8 + h) * 64 + 16 * s + 8 * hi);
    const float kn = 8.f * 1.01f * wmax(fmaxf(fmaxf(fabsf(p.in[5][lane]), fabsf(p.in[5][64 + lane])), fabsf(p.in[5][128 + lane])));
    const float mref = sqrtf(qnorm2<4>(qf)) * kn + bmax;
    f32x16 negm;
#pragma unroll
    for (int r = 0; r < 16; ++r) negm[r] = cb - mref;
    float g0 = gates[0], g1 = gates[1], g2 = gates[2];
    if (p.dbg_branch >= 0) { g0 = p.dbg_branch == 0 ? 1.f : 0.f; g1 = p.dbg_branch == 1 ? 1.f : 0.f; g2 = p.dbg_branch == 2 ? 1.f : 0.f; }
    LAS float* otl = (LAS float*)(lds + AL_OT) + w * 2048;
#ifdef PROF_SEL
    if (b == 0 && g == 0 && jt == 63 && threadIdx.x == 0) *PROF_SLOT(48) -= __builtin_amdgcn_s_memtime();
#endif
    const int nvmax = (q0 + 63 - 31) / 16 + 1, ntc = (nvmax + 63) / 64;
    Flash st; flash_init(st);
    unsigned kl[4], vl[4]; frag_offsets<64>(kl, vl, r32, hi);
    const int qb32 = q0 + 32 * qh;
    int ecf = 0;
    for (int i = 0; i < ntc; ++i) if (qb32 - (16 * (64 * i + 63) + 31) >= 128) ecf = i + 1;
    run_tiles<128, true, AL_K64, 8192, AL_V64>(ntc, ecf, ntc, ntc, lds, w, lane, 128u, 512u,
        [&](int i) { return kc + (size_t)i * 64 * 128; }, [&](int i) { return vct + (size_t)i * 128; },
        [&](int i, LAS unsigned char* kb, LAS unsigned char* vb) { tile_compute<64, 128, false>(st, kb, vb, qf, negm, kl, vl, true, [&](int r, int half, float& x) { return true; }); },
        [&](int i, LAS unsigned char* kb, LAS unsigned char* vb) {
            const int cb0 = 64 * i + 4 * hi;
            tile_compute<64, 128, false>(st, kb, vb, qf, negm, kl, vl, true, [&](int r, int half, float& x) {
                const int c = cb0 + 32 * half + (r & 3) + 8 * (r >> 2); const int dist = tq - 16 * c - 31; x += blh[dist < 0 ? 0 : (dist > 128 ? 128 : dist)]; return dist >= 0; });
        },
        NoComp{});
    flash_accum<true>(otl, st, g0, hi, lane);
    unsigned mlo, mhi;
    int nsel;
    if (jt < 16) { const unsigned long long mk = (1ull << (jt + 1)) - 1ull; mlo = (unsigned)mk; mhi = (unsigned)(mk >> 32); nsel = jt + 1; if (tid <= jt) tl[tid] = (unsigned char)tid; }
    else {
        for (int i = tid; i < 64 * 65; i += 512) imp[i] = 0.f;
        const float lt = st.l + __shfl_xor(st.l, 32); const float linv = lt > 0.f ? frcp(lt) : 0.f;
        float xlast = 0.f;
        run_tiles<128, false, AL_K64, 8192, AL_V64>(ntc, ntc, ntc, ntc, lds, w, lane, 128u, 0u,
            [&](int i) { return kc + (size_t)i * 64 * 128; }, [&](int i) { return kc; },
            [&](int i, LAS unsigned char* kb, LAS unsigned char* vb) {
                f32x16 p0, p1; qk_tile<64, 128>(p0, p1, kb, qf, negm, kl);
                const int cb0 = 64 * i + 4 * hi;
                float sm[2][4], cr[2][4];
#pragma unroll
                for (int half = 0; half < 2; ++half)
#pragma unroll
                    for (int a = 0; a < 4; ++a) {
                        float s4 = 0.f, last = 0.f;
#pragma unroll
                        for (int k = 0; k < 4; ++k) {
                            const int r = 4 * a + k; const int c = cb0 + 32 * half + k + 8 * a; const int dist = tq - 16 * c - 31;
                            const float sc = (half ? p1[r] : p0[r]) + blh[dist < 0 ? 0 : (dist > 128 ? 128 : dist)];
                            const float pv = dist >= 0 ? fexp2(sc) * linv : 0.f;
                            s4 += pv; last = pv;
                        }
                        sm[half][a] = s4; cr[half][a] = last;
                    }
                float tot[2][4];
#pragma unroll
                for (int half = 0; half < 2; ++half)
#pragma unroll
                    for (int a = 0; a < 4; ++a) {
                        const float xs_ = __shfl_xor(cr[half][a], 32);
                        const float xp_ = (a > 0) ? __shfl_xor(cr[half][a > 0 ? a - 1 : 0], 32) : (half ? __shfl_xor(cr[0][3], 32) : xlast);
                        tot[half][a] = sm[half][a] + (hi ? xs_ : xp_);
                    }
                xlast = __shfl_xor(cr[1][3], 32);
                for (int rr = 0; rr < 4; ++rr) {
                    if (rh == rr) {
#pragma unroll
                        for (int half = 0; half < 2; ++half)
#pragma unroll
                            for (int a = 0; a < 4; ++a) { const int j = 16 * i + 8 * half + 2 * a + hi; imp[ql * 65 + j] += tot[half][a]; }
                    }
                    __syncthreads();
                }
            }, NoComp{}, NoComp{});
        if (p.dbg_branch == 1) { for (int i = tid; i < 4096; i += 512) ((float*)(p.ws + R_H))[((size_t)g * S + q0 + (i >> 6)) * 64 + (i & 63)] = imp[(i >> 6) * 65 + (i & 63)]; }
        {
            const int q = tid >> 3, jg = tid & 7;
            float vj[8]; int rk[8];
#pragma unroll
            for (int jj = 0; jj < 8; ++jj) { const int j = jg * 8 + jj; const float x = imp[q * 65 + j]; vj[jj] = (j > jt) ? -1.f : ((j == jt || j == 0) ? 1e9f : x); rk[jj] = 0; }
#pragma unroll 4
            for (int i = 0; i < 64; ++i) {
                const float xi = imp[q * 65 + i]; const float vi = (i > jt) ? -1.f : ((i == jt || i == 0) ? 1e9f : xi);
#pragma unroll
                for (int jj = 0; jj < 8; ++jj) rk[jj] += (vi > vj[jj] || (vi == vj[jj] && i < jg * 8 + jj)) ? 1 : 0;
            }
            unsigned byte = 0;
#pragma unroll
            for (int jj = 0; jj < 8; ++jj) if (jg * 8 + jj <= jt && rk[jj] < 16) byte |= 1u << jj;
            selb[q * 8 + jg] = (unsigned char)byte;
        }
        __syncthreads();
        if (w == 0) {
            unsigned a = ((const LAS unsigned*)selb)[lane * 2], c = ((const LAS unsigned*)selb)[lane * 2 + 1];
#pragma unroll
            for (int o = 1; o < 64; o <<= 1) { a |= __shfl_xor(a, o); c |= __shfl_xor(c, o); }
            const unsigned long long um = ((unsigned long long)c << 32) | a;
            if ((um >> lane) & 1ull) tl[__builtin_popcountll(um & ((1ull << lane) - 1ull))] = (unsigned char)lane;
            if (lane == 0) uni[0] = (unsigned)__builtin_popcountll(um);
        }
        __syncthreads();
        mlo = ((const LAS unsigned*)selb)[ql * 2]; mhi = ((const LAS unsigned*)selb)[ql * 2 + 1];
        nsel = (int)uni[0];
    }
    if (p.dbg_branch == 1 && rh == 0) { if (hi == 0) ((unsigned long long*)(p.ws + R_H + 4 * 1048576))[(size_t)g * S + tq] = ((unsigned long long)mhi << 32) | mlo; }
    __syncthreads();
    {
        const unsigned long long mymask = ((unsigned long long)mhi << 32) | mlo;
        nsel = __builtin_amdgcn_readfirstlane(nsel);
        const int mytl = (int)tl[lane];
        flash_init(st);
        const int jfar = qb32 >= 191 ? (qb32 - 191) >> 6 : -1;
        const int nfar = (int)__builtin_popcountll(__ballot(lane < nsel && mytl <= jfar));
        run_tiles<128, true, AL_K64, 8192, AL_V64>(nsel, nfar, nsel, nsel, lds, w, lane, 128u, (unsigned)(S * 2),
            [&](int i) { return ksn + (size_t)__builtin_amdgcn_readlane(mytl, i) * 64 * 128; }, [&](int i) { return vst + (size_t)__builtin_amdgcn_readlane(mytl, i) * 128; },
            [&](int i, LAS unsigned char* kb, LAS unsigned char* vb) {
                const int j = __builtin_amdgcn_readlane(mytl, i);
                const bool mine = (mymask >> j) & 1ull;
                tile_compute<64, 128, true>(st, kb, vb, qf, negm, kl, vl, mine, [&](int r, int half, float& x) { return true; });
            },
            [&](int i, LAS unsigned char* kb, LAS unsigned char* vb) {
                const int j = __builtin_amdgcn_readlane(mytl, i);
                const bool mine = (mymask >> j) & 1ull;
                const int kb0 = 64 * j + 4 * hi;
                tile_compute<64, 128, true>(st, kb, vb, qf, negm, kl, vl, mine, [&](int r, int half, float& x) { const int dist = tq - (kb0 + 32 * half + (r & 3) + 8 * (r >> 2)); x += blh[dist < 0 ? 0 : (dist > 128 ? 128 : dist)]; return dist >= 0; });
            },
            NoComp{});
        flash_accum<false>(otl, st, g1, hi, lane);
    }
    {
        const int j0 = jt >= 8 ? jt - 8 : 0, nw = jt - j0 + 1;
        flash_init(st);
        const int jfar = qb32 >= 191 ? (qb32 - 191) >> 6 : -1, jin = qb32 >= 481 ? ((qb32 - 481) >> 6) + 1 : 0;
        int ew0 = jin - j0; ew0 = ew0 < 0 ? 0 : (ew0 > nw ? nw : ew0);
        int ew1 = jfar + 1 - j0; ew1 = ew1 < ew0 ? ew0 : (ew1 > nw ? nw : ew1);
        auto wedge = [&](int i, LAS unsigned char* kb, LAS unsigned char* vb) {
            const int j = j0 + i, kb0 = 64 * j + 4 * hi;
            tile_compute<64, 128, false>(st, kb, vb, qf, negm, kl, vl, true, [&](int r, int half, float& x) { const int dist = tq - (kb0 + 32 * half + (r & 3) + 8 * (r >> 2)); x += blh[dist < 0 ? 0 : (dist > 128 ? 128 : dist)]; return dist >= 0 && dist < 512; });
        };
        run_tiles<128, true, AL_K64, 8192, AL_V64>(nw, ew0, ew1, nw, lds, w, lane, 128u, (unsigned)(S * 2),
            [&](int i) { return kwn + (size_t)(j0 + i) * 64 * 128; }, [&](int i) { return vwt + (size_t)(j0 + i) * 128; },
            wedge,
            [&](int i, LAS unsigned char* kb, LAS unsigned char* vb) { tile_compute<64, 128, false>(st, kb, vb, qf, negm, kl, vl, true, [&](int r, int half, float& x) { return true; }); },
            wedge);
        flash_accum<false>(otl, st, g2, hi, lane);
    }
#pragma unroll
    for (int r = 0; r < 16; ++r) { const size_t ro = ((size_t)b * S + q0 + 32 * qh + crow(r, hi)) * 1024 + h * 64 + r32; ocat[ro] = f2bf(otl[r * 64 + lane]); ocat[ro + 32] = f2bf(otl[(16 + r) * 64 + lane]); }
    __syncthreads();
#ifdef PROF_SEL
    if (b == 0 && g == 0 && jt == 63 && threadIdx.x == 0) *PROF_SLOT(48) += __builtin_amdgcn_s_memtime();
#endif
}

__device__ __forceinline__ void phase_p4(const Params& p, LAS unsigned char* lds) {
    const int G = gridDim.x, c = blockIdx.x, nunits = 256 * NB;
#if NB == 8
    if (G == 256) {
        const int b = c & 7, idx = c >> 3, pi = idx & 7, hq = idx >> 3;
#pragma unroll 1
        for (int u = 0; u < 8; ++u) {
            if (u == (idx & 7)) { convert_weights(p, lds, WD_EARLY, 14); __syncthreads(); }
            if (u < 4) { const int ix = (u >> 1) ? ((idx + 16) & 31) : idx;
                nsa_unit(p, lds, b, u >> 1, (u & 1) ? ix : 63 - ix); }
            else mla_unit(p, lds, b, ((u - 4) >> 1) * 4 + hq, (u & 1) ? pi : 15 - pi);
        }
        return;
    }
#endif
    convert_weights(p, lds, WD_EARLY, 14); __syncthreads();
    for (int j = 0;; ++j) {
        const int k = j * G + ((j & 1) ? (G - 1 - c) : c);
        if (j * G >= nunits) break;
        if (k >= nunits) continue;
        const int ty = UNIT_TYPES[k / NB], b = k % NB, kind = ty >> 9, a = (ty >> 6) & 7, cc = ty & 63;
        if (kind == 0) nsa_unit(p, lds, b, a, cc); else mla_unit(p, lds, b, a, cc);
    }
}
__device__ __forceinline__ void phase_norm(const float* x, const float* g, bf16_t* xn) {
    const int tid_ = ltid(); const int lane = tid_ & 63, gw = blockIdx.x * 8 + (tid_ >> 6), NGW = gridDim.x * 8;
    for (int m = gw; m < T; m += NGW) rms_row_to_bf16(x + (size_t)m * D, g, xn + (size_t)m * D, lane);
}
__device__ __forceinline__ void phase_conv(const Params& p) {
    const int tid = ltid(), lane = tid & 63, gw = blockIdx.x * 8 + (tid >> 6), NGW = gridDim.x * 8;
    const bf16_t* bg = (const bf16_t*)(p.ws + R_H); const bf16_t* cu = (const bf16_t*)(p.ws + R_H + (size_t)T * 2048); bf16_t* v = (bf16_t*)(p.ws + R_XA); const float* cw = p.in[22];
    constexpr int RUN = 16;
    float w0[2][8], w1[2][8], w2[2][8];
#pragma unroll
    for (int j = 0; j < 2; ++j) { const int d = 8 * lane + 512 * j; load8f(cw + d, w0[j], 1.f); load8f(cw + 1024 + d, w1[j], 1.f); load8f(cw + 2048 + d, w2[j], 1.f); }
    for (int run = gw; run < T / RUN; run += NGW) {
        const int m0 = run * RUN, s0 = m0 & (S - 1);
        float pm2[2][8], pm1[2][8];
#pragma unroll
        for (int j = 0; j < 2; ++j) { const int d = 8 * lane + 512 * j;
#pragma unroll
            for (int q = 0; q < 2; ++q) {
                float (&dst)[8] = q ? pm1[j] : pm2[j];
                if (s0 - 2 + q >= 0) unpack8(*(const u32x4*)(cu + (size_t)(m0 - 2 + q) * 1024 + d), dst);
                else {
#pragma unroll
                    for (int i = 0; i < 8; ++i) dst[i] = 0.f; }
            } }
#pragma unroll 4
        for (int rr = 0; rr < RUN; ++rr) {
            const int m = m0 + rr;
#pragma unroll
            for (int j = 0; j < 2; ++j) { const int d = 8 * lane + 512 * j;
                float b[8], c[8], y[8]; unpack8(*(const u32x4*)(bg + (size_t)m * 1024 + d), b); unpack8(*(const u32x4*)(cu + (size_t)m * 1024 + d), c);
#pragma unroll
                for (int i = 0; i < 8; ++i) { y[i] = b[i] * (w0[j][i] * pm2[j][i] + w1[j][i] * pm1[j][i] + w2[j][i] * c[i]); pm2[j][i] = pm1[j][i]; pm1[j][i] = c[i]; }
                *(u32x4*)(v + (size_t)m * 1024 + d) = pack8(y); }
        }
    }
}
__device__ __forceinline__ void phase_norm_router(const Params& p, LAS unsigned char* lds) {
    const int tid = ltid(), lane = tid & 63, wave = tid >> 6, gw = blockIdx.x * 8 + wave, NGW = gridDim.x * 8;
    const bf16_t* x3 = (const bf16_t*)(p.ws + R_XN); const float* g = p.in[24]; bf16_t* xn = (bf16_t*)(p.ws + R_XA);
    LAS float* wr = (LAS float*)lds;
    LAS int* lcnt = (LAS int*)(lds + 40960); LAS int* gb = lcnt + 8;
    int* te = (int*)(p.ws + SM_TE); float* tw = (float*)(p.ws + SM_TW); int* rank = (int*)(p.ws + SM_RANK); int* cnt = (int*)(p.ws + SM_CTL);
    for (int i = tid; i < 8192; i += 512) { const int dd = i >> 3; wr[dd * 8 + (dd >> 2) * 4 + (i & 7)] = p.in[25][i]; }
    if (tid < 8) lcnt[tid] = 0;
    __syncthreads();
    u32x2 nx[4];
#pragma unroll
    for (int j = 0; j < 4; ++j) nx[j] = ((const u32x2*)(x3 + (size_t)(gw < T ? gw : 0) * D) + lane)[64 * j];
    for (int m = gw; m < T; m += NGW) {
        const f32x4* gr = (const f32x4*)g + lane;
        f32x4 v[4]; float s = 0.f;
#pragma unroll
        for (int j = 0; j < 4; ++j) { const u32x2 t = nx[j]; v[j] = (f32x4){bflo(t.x), bfhi(t.x), bflo(t.y), bfhi(t.y)}; s += (v[j].x * v[j].x + v[j].y * v[j].y) + (v[j].z * v[j].z + v[j].w * v[j].w); }
        { const int mn = m + NGW < T ? m + NGW : m;
#pragma unroll
            for (int j = 0; j < 4; ++j) nx[j] = ((const u32x2*)(x3 + (size_t)mn * D) + lane)[64 * j]; }
        const float r = rsqrtf(wsum(s) * (1.f / 1024.f) + EPS);
        float lg[8];
#pragma unroll
        for (int e = 0; e < 8; ++e) lg[e] = 0.f;
        u32x2* o8 = (u32x2*)(xn + (size_t)m * D) + lane;
#pragma unroll
        for (int j = 0; j < 4; ++j) { const f32x4 gg = gr[64 * j]; const f32x4 y = {v[j].x * r * gg.x, v[j].y * r * gg.y, v[j].z * r * gg.z, v[j].w * r * gg.w};
            u32x2 w; w.x = cvtpk(y.x, y.y); w.y = cvtpk(y.z, y.w); o8[64 * j] = w;
#pragma unroll
            for (int i = 0; i < 4; ++i) { const int d = 4 * lane + 256 * j + i; const f32x4 w0 = *(const LAS f32x4*)(wr + d * 8 + (d >> 2) * 4), w1 = *(const LAS f32x4*)(wr + d * 8 + (d >> 2) * 4 + 4);
                lg[0] += y[i] * w0.x; lg[1] += y[i] * w0.y; lg[2] += y[i] * w0.z; lg[3] += y[i] * w0.w; lg[4] += y[i] * w1.x; lg[5] += y[i] * w1.y; lg[6] += y[i] * w1.z; lg[7] += y[i] * w1.w; } }
#pragma unroll
        for (int e = 0; e < 8; ++e) lg[e] = wsum(lg[e]) + p.in[26][e];
        int e1 = 0; float l1 = lg[0];
#pragma unroll
        for (int e = 1; e < 8; ++e) if (lg[e] > l1) { l1 = lg[e]; e1 = e; }
        int e2 = -1; float l2 = -3e38f;
#pragma unroll
        for (int e = 0; e < 8; ++e) if (e != e1 && lg[e] > l2) { l2 = lg[e]; e2 = e; }
        if (lane == 0) {
            const float w1 = 1.f / (1.f + __expf(l2 - l1));
            te[m * 2] = e1; te[m * 2 + 1] = e2; tw[m * 2] = w1; tw[m * 2 + 1] = 1.f - w1;
            rank[m * 2] = __hip_atomic_fetch_add(&lcnt[e1], 1, __ATOMIC_RELAXED, __HIP_MEMORY_SCOPE_WORKGROUP); rank[m * 2 + 1] = __hip_atomic_fetch_add(&lcnt[e2], 1, __ATOMIC_RELAXED, __HIP_MEMORY_SCOPE_WORKGROUP);
        }
    }
    __syncthreads();
    if (tid < 8) gb[tid] = atomicAdd(&cnt[tid], lcnt[tid]);
    __syncthreads();
    for (int m = gw; m < T; m += NGW) if (lane < 2) rank[m * 2 + lane] += gb[te[m * 2 + lane]];
}
__device__ __forceinline__ void phase_moe_gather(const Params& p) {
    const int tid = ltid(), lane = tid & 63, gw = blockIdx.x * 8 + (tid >> 6), NGW = gridDim.x * 8;
    const int* cnt = (const int*)(p.ws + SM_CTL); const int* te = (const int*)(p.ws + SM_TE); const float* tw = (const float*)(p.ws + SM_TW); const int* rank = (const int*)(p.ws + SM_RANK);
    int* pos = (int*)(p.ws + SM_POS); float* roww = (float*)(p.ws + SM_ROWW); int* tile_e = (int*)(p.ws + SM_TILEE);
    int* rowtok = (int*)(p.ws + SM_ROWTOK);
    int off[9]; off[0] = 0;
#pragma unroll
    for (int e = 0; e < 8; ++e) off[e + 1] = off[e] + ((cnt[e] + 255) & ~255);
    if (blockIdx.x == 0) {
        for (int i = tid; i < ROWS_MAX / 256; i += 512) { int e = -1;
#pragma unroll
            for (int k = 0; k < 8; ++k) if (i * 256 >= off[k] && i * 256 < off[k + 1]) e = k;
            tile_e[i] = e < 0 ? 0 : e; }
        if (tid == 0) ((int*)(p.ws + SM_CTL))[8] = off[8];
    }
    if (blockIdx.x < 8 && tid < 256) {
#pragma unroll
        for (int e = 0; e < 8; ++e) if (e == (int)blockIdx.x) { const int c = cnt[e]; if (c + tid < off[e + 1] - off[e]) { roww[off[e] + c + tid] = 0.f; rowtok[off[e] + c + tid] = -1; } }
    }
    for (int pi0 = gw * 4; pi0 < 2 * T; pi0 += NGW * 4) {
        int r[4]; float w[4];
#pragma unroll
        for (int q = 0; q < 4; ++q) { const int e = te[pi0 + q]; int o = 0;
#pragma unroll
            for (int k = 0; k < 8; ++k) if (k == e) o = off[k];
            r[q] = o + rank[pi0 + q]; w[q] = tw[pi0 + q]; }
#pragma unroll
        for (int q = 0; q < 4; ++q) if (lane == q) { pos[pi0 + q] = r[q]; roww[r[q]] = w[q]; rowtok[r[q]] = (pi0 + q) >> 1; }
    }
}
__device__ __forceinline__ void phase_moe_combine(const Params& p) {
    const int tid_ = ltid(); const int lane = tid_ & 63, gw = blockIdx.x * 8 + (tid_ >> 6), NGW = gridDim.x * 8;
    const int* pos = (const int*)(p.ws + SM_POS); const bf16_t* ym = (const bf16_t*)(p.ws + R_XA); const bf16_t* x3 = (const bf16_t*)(p.ws + R_XN);
    for (int m0 = gw * 2; m0 < T; m0 += NGW * 2) {
        int ps[4];
#pragma unroll
        for (int q = 0; q < 4; ++q) ps[q] = pos[m0 * 2 + q];
        f32x4 x[2][4]; u32x2 ya[2][4], yc[2][4];
#pragma unroll
        for (int q = 0; q < 2; ++q)
#pragma unroll
            for (int j = 0; j < 4; ++j) { const int d = 4 * lane + 256 * j;
                { const u32x2 t = *(const u32x2*)(x3 + (size_t)(m0 + q) * D + d); x[q][j] = (f32x4){bflo(t.x), bfhi(t.x), bflo(t.y), bfhi(t.y)}; } ya[q][j] = *(const u32x2*)(ym + (size_t)ps[2 * q] * D + d); yc[q][j] = *(const u32x2*)(ym + (size_t)ps[2 * q + 1] * D + d); }
#pragma unroll
        for (int q = 0; q < 2; ++q)
#pragma unroll
            for (int j = 0; j < 4; ++j) { const int d = 4 * lane + 256 * j; f32x4 o = x[q][j]; const u32x2 a = ya[q][j], c = yc[q][j];
                o.x += bflo(a.x) + bflo(c.x); o.y += bfhi(a.x) + bfhi(c.x); o.z += bflo(a.y) + bflo(c.y); o.w += bfhi(a.y) + bfhi(c.y);
                *(f32x4*)(p.out + (size_t)(m0 + q) * D + d) = o; }
    }
}

#define XB_TMO      128
#define XB_XCNT(j)  (256  + 64 * (j))
#define XB_XSUB(j)  (1280 + 64 * (j))
#define XB_XGEN(j)  (2304 + 64 * (j))
#define XB_TOP      3328
#define XB_TOPGEN   3392
#define XCD_BAR_WORDS 3456
#define XB_SPIN_CAP (1u << 18)

__device__ __forceinline__ unsigned xb_ld(unsigned* p)              { return __hip_atomic_load(p, __ATOMIC_RELAXED, __HIP_MEMORY_SCOPE_AGENT); }
__device__ __forceinline__ unsigned xb_add(unsigned* p, unsigned v) { return __hip_atomic_fetch_add(p, v, __ATOMIC_RELAXED, __HIP_MEMORY_SCOPE_AGENT); }
__device__ __forceinline__ unsigned xb_xcc_id() { return (unsigned)__builtin_amdgcn_s_getreg((3 << 11) | 20) & 0xFu; }
#define XB_SPIN(cond, bar) do { unsigned _sp = 0; while (cond) { __builtin_amdgcn_s_sleep(1); \
    if ((++_sp & 255u) == 0u) { if (xb_ld(&(bar)[XB_TMO])) break; if (_sp > XB_SPIN_CAP) { atomicAdd(&(bar)[XB_TMO], 1u); break; } } } } while (0)

struct XcdBarrier {
    unsigned* bar; unsigned x;
    volatile LAS unsigned* st;
};

__device__ __forceinline__ XcdBarrier xcd_barrier_post(unsigned* bar, volatile LAS unsigned* st) {
    XcdBarrier b; b.bar = bar; b.x = xb_xcc_id(); b.st = st;
    if (threadIdx.x == 0) (void)xb_add(&bar[XB_XCNT(b.x)], 1u);
    return b;
}
__device__ __forceinline__ void xcd_barrier_complete(unsigned* bar, unsigned x, unsigned& nloc, unsigned& nx) {
    const unsigned G = gridDim.x * gridDim.y * gridDim.z;
    unsigned sum, cnt, mine, sp = 0u;
    for (;;) {
        sum = 0u; cnt = 0u; mine = 0u;
#pragma unroll
        for (unsigned j = 0; j < 16; ++j) { const unsigned c = xb_ld(&bar[XB_XCNT(j)]); sum += c; cnt += (c > 0u) ? 1u : 0u; mine = (j == x) ? c : mine; }
        if (sum == G) break;
        __builtin_amdgcn_s_sleep(1);
        if ((++sp & 255u) == 0u) { if (xb_ld(&bar[XB_TMO])) break; if (sp > XB_SPIN_CAP) { atomicAdd(&bar[XB_TMO], 1u); break; } }
    }
    nloc = mine > 0u ? mine : 1u; nx = cnt > 0u ? cnt : 1u;
}

__device__ __forceinline__ void xcd_barrier(const XcdBarrier& b) {
    asm volatile("s_waitcnt vmcnt(0)" ::: "memory");
    __syncthreads();
    if (threadIdx.x == 0) {
        unsigned* bar = b.bar;
        __builtin_amdgcn_s_waitcnt(0);
        unsigned nloc = b.st[0], nx = b.st[1];
        if (nloc == 0u) { xcd_barrier_complete(bar, b.x, nloc, nx); b.st[0] = nloc; b.st[1] = nx; }
        const unsigned old = xb_add(&bar[XB_XSUB(b.x)], 1u);
        const unsigned gen = old / nloc;
        if (old + 1u == (gen + 1u) * nloc) {
            __builtin_amdgcn_fence(__ATOMIC_RELEASE, "agent");
            asm volatile("s_waitcnt vmcnt(0)" ::: "memory");
            const unsigned og = xb_add(&bar[XB_TOP], 1u);
            const unsigned tg = og / nx;
            if (og + 1u == (tg + 1u) * nx) xb_add(&bar[XB_TOPGEN], 1u);
            else XB_SPIN(xb_ld(&bar[XB_TOPGEN]) == tg, bar);
            __builtin_amdgcn_fence(__ATOMIC_ACQUIRE, "agent");
            xb_add(&bar[XB_XGEN(b.x)], 1u);
            asm volatile("s_waitcnt vmcnt(0)" ::: "memory");
        } else {
            XB_SPIN(xb_ld(&bar[XB_XGEN(b.x)]) == gen, bar);
            __builtin_amdgcn_fence(__ATOMIC_ACQUIRE, "agent");
            asm volatile("s_waitcnt vmcnt(0)" ::: "memory");
        }
    }
    __syncthreads();
}


__global__ void __launch_bounds__(512) mega_fwd(Params p) {
    extern __shared__ __attribute__((aligned(16))) unsigned char lds_raw[];
    LAS unsigned char* lds = (LAS unsigned char*)lds_raw;
    cg::grid_group grid = cg::this_grid();
    volatile LAS unsigned* bst = (volatile LAS unsigned*)(lds + 163328);
    if (threadIdx.x == 0) { bst[0] = 0u; bst[1] = 0u; const unsigned long long ba = (unsigned long long)(p.ws + SM_BAR); bst[2] = (unsigned)ba; bst[3] = (unsigned)(ba >> 32); }
    __syncthreads();
    (void)xcd_barrier_post((unsigned*)(p.ws + SM_BAR), bst);
#ifdef PROF_SEL
#define PSTAMP(k) do { if (blockIdx.x == 0 && threadIdx.x == 0) { volatile LAS unsigned* pl_ = (volatile LAS unsigned*)(lds + 163328 + 16); const unsigned long long now_ = __builtin_amdgcn_s_memrealtime(); const unsigned long long last_ = ((unsigned long long)pl_[1] << 32) | pl_[0]; *PROF_SLOT(k) += now_ - last_; pl_[0] = (unsigned)now_; pl_[1] = (unsigned)(now_ >> 32); } } while (0)
#else
#define PSTAMP(k)
#endif
#define GSYNC() do { XcdBarrier xb_; volatile LAS unsigned* st_ = (volatile LAS unsigned*)(lds + 163328); xb_.bar = (unsigned*)(((unsigned long long)st_[3] << 32) | st_[2]); xb_.x = xb_xcc_id(); xb_.st = st_; xcd_barrier(xb_); } while (0)
#ifdef PROF_SEL
    if (threadIdx.x == 0) { volatile LAS unsigned* pl_ = (volatile LAS unsigned*)(lds + 163328 + 16); const unsigned long long now_ = __builtin_amdgcn_s_memrealtime(); pl_[0] = (unsigned)now_; pl_[1] = (unsigned)(now_ >> 32); }
#endif
    const int G = gridDim.x, c = blockIdx.x;
#define LP() bf16_t* W = (bf16_t*)p.ws; bf16_t* xn = (bf16_t*)(p.ws + R_XN); float* x1 = (float*)(p.ws + R_XA); pg8::StaticOrder SO; (void)W; (void)xn; (void)x1; (void)SO
#ifndef PHMASK
#define PHMASK 0xFFFFFFFFu
#endif
#ifndef REPEAT_MASK
#define REPEAT_MASK 0u
#endif
#define PH(k) if (((PHMASK >> (k)) & 1u) && (k) >= p.ph_lo && (k) <= p.ph_hi)
#define RPT(k) if ((REPEAT_MASK >> (k)) & 1u)
    PH(0) { LP(); phase_p0(p, lds); }
    GSYNC(); PSTAMP(0);
    if (p.ph_lo == -12345) grid.sync();
    RPT(0) { { LP(); phase_p0(p, lds); } GSYNC(); }
    PH(1) { LP();
        pg8::Gemm g{xn, W + W_IN_E / 2, T, 1792, 1024, 1024, nullptr, 0, nullptr}; SO.init(T, 1792, G, c);
        pg8::EpiBf16<0> E{(bf16_t*)(p.ws + R_H), 1792, nullptr, nullptr};
        pg8::gemm_phase<pg8::EpiBf16<0>, true>(lds, g, SO, E);
    }
    GSYNC(); PSTAMP(1);
    PH(2) { LP(); phase_p2(p, lds); }
    GSYNC(); PSTAMP(2);
    RPT(2) { { LP(); phase_p2(p, lds); } GSYNC(); }
    PH(3) { LP();
        const int nCu = 2 * (NB * 512 / 256) * 2, Gc = (nCu < G / 2) ? nCu : 0;
        if (Gc == 0 || c < Gc) {
            for (int kv = 0; kv < 2; ++kv) {
                pg8::Gemm g{(const bf16_t*)(p.ws + R_XA + (kv ? A_VCIN : A_KCIN)), W + W_CW1 / 2 + (size_t)kv * 512 * 1024, NB * 512, 512, 1024, 1024, nullptr, 0, nullptr};
                if (Gc) SO.init(NB * 512, 512, Gc / 2, c - kv * (Gc / 2)); else SO.init(NB * 512, 512, G, c);
                pg8::EpiBf16<0> E{(bf16_t*)(p.ws + SM_HID) + (size_t)kv * NB * 512 * 512, 512, nullptr, nullptr};
                if (Gc == 0 || (c / (Gc / 2)) == kv) pg8::gemm_phase<pg8::EpiBf16<0>, true>(lds, g, SO, E);
            }
        }
        if (Gc == 0 || c >= Gc) {
            {
                pg8::Gemm g{(const bf16_t*)(p.ws + R_XA + A_CQN), W + W_UQ / 2, T, 1024, 256, 256, nullptr, 0, nullptr}; SO.init(T, 1024, G - Gc, c - Gc);
                pg8::EpiBf16<0> E{(bf16_t*)(p.ws + R_H), 1024, nullptr, nullptr};
                pg8::gemm_phase<pg8::EpiBf16<0>, true>(lds, g, SO, E);
            }
            {
                pg8::Gemm g{(const bf16_t*)(p.ws + R_XA + A_CKVN), W + W_UKV / 2, T, 1024, 128, 128, nullptr, 0, nullptr}; SO.init(T, 1024, G - Gc, c - Gc);
                pg8::EpiBf16<0> E{(bf16_t*)(p.ws + R_H + (size_t)T * 2048), 1024, nullptr, nullptr};
                pg8::gemm_phase<pg8::EpiBf16<0>, true>(lds, g, SO, E);
            }
        }
    }
    GSYNC(); PSTAMP(3);
    PH(4) { LP(); phase_p3b(p, lds); }
    GSYNC(); PSTAMP(4);
    RPT(4) { { LP(); phase_p3b(p, lds); } GSYNC(); }
    PH(5) { LP(); phase_p4(p, lds); }
    GSYNC(); PSTAMP(5);
    RPT(5) { { LP(); phase_p4(p, lds); } GSYNC(); }
    PH(6) { LP();
        pg8::Gemm g{xn, W + W_OUT_E / 2, T, 1024, 1024, 1024, nullptr, 0, nullptr}; SO.init(T, 1024, G, c);
        pg8::EpiResStat<false> E{p.in[0], (bf16_t*)p.out, (float*)(p.ws + SM_SSP1), 1024};
        pg8::gemm_phase<pg8::EpiResStat<false>, true>(lds, g, SO, E);
    }
    GSYNC(); PSTAMP(6);
    PH(7) { }
    PH(8) { LP();
        pg8::Gemm g{(const bf16_t*)p.out, W + W_GU / 2, T, 5632, 1024, 1024, nullptr, 0, nullptr}; SO.init(T, 5632, G, c);
        pg8::EpiSwiGLU E{(bf16_t*)(p.ws + R_H), 2816, (const float*)(p.ws + SM_SSP1)};
        pg8::gemm_phase<pg8::EpiSwiGLU, true>(lds, g, SO, E);
    }
    GSYNC(); PSTAMP(8);
    PH(9) { LP();
        pg8::Gemm g{(const bf16_t*)(p.ws + R_H), W + W_D / 2, T, 1024, 2816, 2816, nullptr, 0, nullptr}; SO.init(T, 1024, G, c);
        pg8::EpiResStat<true> E{(const bf16_t*)p.out, xn, (float*)(p.ws + SM_SSP2), 1024};
        pg8::gemm_phase<pg8::EpiResStat<true>, true>(lds, g, SO, E);
    }
    GSYNC(); PSTAMP(9);
    PH(10) { }
    PH(11) { LP();
        pg8::Gemm g{xn, W + W_IN_O / 2, T, 3072, 1024, 1024, nullptr, 0, nullptr}; SO.init(T, 3072, G, c);
        pg8::EpiConvIn E{(bf16_t*)(p.ws + R_H), (bf16_t*)(p.ws + R_H + (size_t)T * 2048), (const float*)(p.ws + SM_SSP2)};
        pg8::gemm_phase<pg8::EpiConvIn, true>(lds, g, SO, E);
    }
    GSYNC(); PSTAMP(11);
    PH(12) { LP(); phase_conv(p); }
    GSYNC(); PSTAMP(12);
    RPT(12) { { LP(); phase_conv(p); } GSYNC(); }
    PH(13) { LP();
        pg8::Gemm g{(const bf16_t*)x1, W + W_OUT_O / 2, T, 1024, 1024, 1024, nullptr, 0, nullptr}; SO.init(T, 1024, G, c);
        pg8::EpiResBf16B E{xn, xn, 1024};
        pg8::gemm_phase<pg8::EpiResBf16B, true>(lds, g, SO, E);
    }
    GSYNC(); PSTAMP(13);
    PH(14) { LP(); phase_norm_router(p, lds); }
    GSYNC(); PSTAMP(14);
    PH(15) { LP(); phase_moe_gather(p); }
    GSYNC(); PSTAMP(15);
    PH(16) { LP(); const int mrows = ((const int*)(p.ws + SM_CTL))[8];
        pg8::Gemm g{(const bf16_t*)x1, W + W_MGU / 2, mrows, 2816, 1024, 1024, (const int*)(p.ws + SM_TILEE), (size_t)2816 * 1024, (const int*)(p.ws + SM_ROWTOK)}; SO.init(mrows, 2816, G, c);
        pg8::EpiSwiGLU E{(bf16_t*)(p.ws + R_H), 1408, nullptr};
        pg8::gemm_phase<pg8::EpiSwiGLU, true, true>(lds, g, SO, E);
    }
    GSYNC(); PSTAMP(16);
    PH(17) { LP(); const int mrows = ((const int*)(p.ws + SM_CTL))[8];
        pg8::Gemm g{(const bf16_t*)(p.ws + R_H), W + W_MD / 2, mrows, 1024, 1408, 1408, (const int*)(p.ws + SM_TILEE), (size_t)1024 * 1408, nullptr}; SO.init(mrows, 1024, G, c);
        pg8::EpiRowScaleBf16 E{(bf16_t*)(p.ws + R_XA), 1024, (const float*)(p.ws + SM_ROWW)};
        pg8::gemm_phase<pg8::EpiRowScaleBf16, true>(lds, g, SO, E);
    }
    GSYNC(); PSTAMP(17);
    PH(18) { LP(); phase_moe_combine(p); }
#ifdef PROF_SEL
    GSYNC(); PSTAMP(18);
    GSYNC();
    {
        unsigned long long v_ = *PROF_SLOT(PROF_SEL);
#ifdef PROF_DIV
        const unsigned long long dv_ = *PROF_SLOT(PROF_DIV); v_ = dv_ ? v_ / dv_ : 0ull;
#endif
        unsigned long long a_ = v_ / (unsigned long long)(PROF_UNIT); if (a_ > 27ull) a_ = 27ull;
        const float sc_ = 1.f + (float)a_;
        for (size_t i = (size_t)blockIdx.x * 512 + threadIdx.x; i < (size_t)S * 1024 / 4; i += (size_t)gridDim.x * 512) { f32x4* o = (f32x4*)p.out + i; *o = *o * sc_; }
    }
#endif
#undef PH
}

inline void launch(void* const* d_in, float* d_out, void* d_ws, size_t ws_size, hipStream_t stream, int ph_lo = 0, int ph_hi = 99, int dbg_branch = -1) {
    static int grid = 0;
    if (grid == 0) {
        int dev = 0, cus = 0, per_cu = 0;
        hipGetDevice(&dev); hipDeviceGetAttribute(&cus, hipDeviceAttributeMultiprocessorCount, dev);
        hipFuncSetAttribute((const void*)mega_fwd, hipFuncAttributeMaxDynamicSharedMemorySize, LDS_BYTES);
        hipOccupancyMaxActiveBlocksPerMultiprocessor(&per_cu, (const void*)mega_fwd, 512, LDS_BYTES);
        if (per_cu < 1) { fprintf(stderr, "occupancy query says %d blocks/CU\n", per_cu); per_cu = 1; }
        grid = cus;
        if (WS_FAST_END > ws_size) { fprintf(stderr, "ws too small: need %zu have %zu\n", (size_t)WS_FAST_END, ws_size); grid = -1; }
    }
    if (grid < 0) return;
    if (ph_lo <= 14 && ph_hi >= 14) hipMemsetAsync((char*)d_ws + SM_CTL, 0, 4096, stream);
    hipMemsetAsync((char*)d_ws + SM_BAR, 0, 16384, stream);
    Params p{};
    for (int i = 0; i < 30; ++i) p.in[i] = (const float*)d_in[i];
    p.out = d_out; p.ws = (unsigned char*)d_ws; p.ph_lo = ph_lo; p.ph_hi = ph_hi; p.dbg_branch = dbg_branch;
    void* args[] = {&p};
    hipError_t e = hipLaunchCooperativeKernel((const void*)mega_fwd, dim3(grid), dim3(512), args, LDS_BYTES, stream);
    if (e != hipSuccess) fprintf(stderr, "cooperative launch failed: %s (grid %d)\n", hipGetErrorString(e), grid);
}
}
extern "C" void kernel_launch(void* const* d_in, const int* in_sizes, int n_in, void* d_out, int out_size, void* d_ws, size_t ws_size, hipStream_t stream) {
    fast::launch(d_in, (float*)d_out, d_ws, ws_size, stream);
}
```

```cpp
#include <hip/hip_runtime.h>
#include <hip/hip_bf16.h>
#include <stdint.h>
#include <stdio.h>
#include <string.h>
#include <hip/hip_cooperative_groups.h>
namespace cg = cooperative_groups;
#define NB 8
#define REPEAT_MASK 0x0u
namespace gold {
constexpr int S = 4096, D = 1024, HW = 1720;
constexpr float EPS = 1e-6f;

__device__ const unsigned char T5B[128] = {0, 1, 2, 3, 4, 5, 6, 7, 8, 9, 10, 11, 12, 13, 14, 15, 16, 16, 16, 17, 17, 18, 18, 18, 19, 19, 19, 20, 20, 20, 20, 21, 21, 21, 21, 22, 22, 22, 22, 22, 23, 23, 23, 23, 23, 23, 24, 24, 24, 24, 24, 24, 25, 25, 25, 25, 25, 25, 25, 26, 26, 26, 26, 26, 26, 26, 26, 27, 27, 27, 27, 27, 27, 27, 27, 27, 27, 28, 28, 28, 28, 28, 28, 28, 28, 28, 28, 29, 29, 29, 29, 29, 29, 29, 29, 29, 29, 29, 29, 30, 30, 30, 30, 30, 30, 30, 30, 30, 30, 30, 30, 30, 30, 31, 31, 31, 31, 31, 31, 31, 31, 31, 31, 31, 31, 31, 31};
}
#ifndef NB
#define NB 8
#endif
namespace fast {
#define LAS __attribute__((address_space(3)))
typedef unsigned short bf16_t;
typedef short bf16x8 __attribute__((ext_vector_type(8)));
typedef float f32x4 __attribute__((ext_vector_type(4)));
typedef float f32x2 __attribute__((ext_vector_type(2)));
typedef float f32x16 __attribute__((ext_vector_type(16)));
typedef unsigned u32x4 __attribute__((ext_vector_type(4)));
typedef unsigned u32x2 __attribute__((ext_vector_type(2)));
typedef __bf16 bf16x2_t __attribute__((ext_vector_type(2)));

constexpr int S = 4096, T = NB * S, D = 1024;
constexpr float EPS = 1e-6f, LOG2E = 1.4426950408889634f;

__device__ __forceinline__ unsigned cvtpk(float lo, float hi) { f32x2 v = {lo, hi}; bf16x2_t b = __builtin_convertvector(v, bf16x2_t); return __builtin_bit_cast(unsigned, b); }
__device__ __forceinline__ bf16_t f2bf(float f) { return (bf16_t)(cvtpk(f, 0.f) & 0xffffu); }
__device__ __forceinline__ float bf2f(bf16_t u) { return __builtin_bit_cast(float, (unsigned)u << 16); }
__device__ __forceinline__ float bflo(unsigned u) { return __builtin_bit_cast(float, u << 16); }
__device__ __forceinline__ float bfhi(unsigned u) { return __builtin_bit_cast(float, u & 0xffff0000u); }
__device__ __forceinline__ float wsum(float v) {
#pragma unroll
    for (int o = 1; o < 64; o <<= 1) v += __shfl_xor(v, o);
    return v;
}
__device__ __forceinline__ float fexp2(float x) { return __builtin_amdgcn_exp2f(x); }
__device__ __forceinline__ float frcp(float x) { return __builtin_amdgcn_rcpf(x); }
__device__ __forceinline__ float silu_f(float x) { return x * frcp(1.f + fexp2(-x * LOG2E)); }
__device__ __forceinline__ float gelu_tanh_f(float x) {
    const float u = 0.7978845608028654f * (x + 0.044715f * x * x * x);
    return x * frcp(1.f + fexp2(-2.f * LOG2E * u));
}

namespace pg8 {
constexpr int BM = 256, BK = 64, HALF = 128, HTB = HALF * BK * 2, STAGE_BYTES = 8 * HTB, NXCD = 8, WGM = 8;
__host__ __device__ __forceinline__ int lds_byte(int r, int c) { const int st = (r >> 4) * 2 + (c >> 5), rr = r & 15, cc = c & 31, ob = rr * 64 + cc * 2; return st * 1024 + (ob ^ (((ob >> 9) & 1) << 5)); }
__host__ __device__ __forceinline__ void stage_rc(int b, int& R, int& C) { const int st = b / 1024, sb = b % 1024, swz = sb ^ (((sb >> 9) & 1) << 5); R = (st >> 1) * 16 + swz / 64; C = (st & 1) * 32 + (swz % 64) / 2; }
__host__ __device__ __forceinline__ int perm32(int rho) { const int n = rho >> 4, i = rho & 15; return 8 * (i >> 2) + 4 * n + (i & 3); }

struct Unit { int pm, pn; };
struct Gemm { const bf16_t* A; const bf16_t* Bt; int M, N, K, lda; const int* tile_e; size_t estride; const int* rowidx; };

struct StaticOrder {
    int nM, nN, nwg, G, c;
    __device__ void init(int M, int N, int G_, int c_) { nM = M / BM; nN = N / BM; nwg = nM * nN; G = G_; c = c_; }
    __device__ bool next(int i, Unit& u) const {
        const long L = (long)i * G + c; if (L >= nwg) return false;
        int wgid = (int)L; { const int q = nwg / NXCD, r = nwg % NXCD, xcd = wgid % NXCD, off = wgid / NXCD; wgid = (xcd < r ? xcd * (q + 1) : r * (q + 1) + (xcd - r) * q) + off; }
        const int nig = WGM * nN, gid = wgid / nig, fm = gid * WGM, gsz = (nM - fm) < WGM ? (nM - fm) : WGM;
        u.pm = fm + ((wgid % nig) % gsz); u.pn = (wgid % nig) / gsz; return true;
    }
};

template <class Epi, bool ALIGN_EPI, bool GATHER = false>
__device__ __forceinline__ void gemm_phase(LAS unsigned char* lds, const Gemm g, const StaticOrder& S, const Epi& E) {
    int tid = threadIdx.x; asm volatile("" : "+v"(tid));
    const int wid = __builtin_amdgcn_readfirstlane(tid >> 6), lane = tid & 63, wr = wid >> 2, wc = wid & 3, fr = lane & 15, fq = lane >> 4;
    const int K = g.K, nt = K / BK, lda = g.lda;
    unsigned voffA[2], voffB[2];
#pragma unroll
    for (int i = 0; i < 2; ++i) { int R, C; stage_rc(tid * 16 + i * 8192, R, C); const int Rb = Epi::PERM ? ((R & ~31) + perm32(R & 31)) : R;
        voffA[i] = (unsigned)(R * lda + C) * 2u; voffB[i] = (unsigned)(Rb * K + C) * 2u; }
    const size_t kstep = (size_t)(BK * 2);
    const size_t hsA = GATHER ? 0 : (size_t)HALF * lda * 2, tsA = 2 * hsA, hsB = (size_t)HALF * K * 2, tsB = 2 * hsB;
    unsigned vgc[2][2], vgn[2][2];
#define PG8_GOFF(pm_, vg) do { _Pragma("unroll") for (int h_ = 0; h_ < 2; ++h_) _Pragma("unroll") for (int i_ = 0; i_ < 2; ++i_) { int R_, C_; stage_rc(tid * 16 + i_ * 8192, R_, C_); \
        int tok_ = g.rowidx[(pm_) * BM + h_ * HALF + R_]; tok_ = tok_ < 0 ? 0 : tok_; vg[h_][i_] = (unsigned)(tok_ * lda + C_) * 2u; } } while (0)
#define PG8_STAGE_A(bufoff, gbase, h, nx) do { unsigned va_[2]; _Pragma("unroll") for (int i_ = 0; i_ < 2; ++i_) va_[i_] = GATHER ? ((nx) ? vgn[h][i_] : vgc[h][i_]) : voffA[i_]; PG8_STAGE(bufoff, gbase, va_); } while (0)
    const unsigned ldsw = (unsigned)wid * 1024u;
    const int aoff = lds_byte(wr * 64 + fr, fq * 8), boff = lds_byte(wc * 32 + fr, fq * 8);
#define PG8_SA(b, h) (((b) * 2 + (h)) * HTB)
#define PG8_SB(b, h) ((4 + (b) * 2 + (h)) * HTB)
#define PG8_STAGE(bufoff, gbase, voff) do { _Pragma("unroll") for (int _i = 0; _i < 2; ++_i) \
        __builtin_amdgcn_global_load_lds((const unsigned*)((const char*)(gbase) + (voff)[_i]), (LAS unsigned*)(lds + (bufoff) + ldsw + _i * 8192), 16, 0, 0); } while (0)
#define PG8_LDA(dst, b, h) do { _Pragma("unroll") for (int m = 0; m < 4; ++m) _Pragma("unroll") for (int k = 0; k < 2; ++k) dst[m][k] = *(const LAS bf16x8*)(lds + PG8_SA(b, h) + aoff + m * 2048 + k * 1024); } while (0)
#define PG8_LDB(dst, b, h) do { _Pragma("unroll") for (int n = 0; n < 2; ++n) _Pragma("unroll") for (int k = 0; k < 2; ++k) dst[n][k] = *(const LAS bf16x8*)(lds + PG8_SB(b, h) + boff + n * 2048 + k * 1024); } while (0)
#define PG8_MMA(ai, bj, At, Bt) do { __builtin_amdgcn_s_setprio(1); _Pragma("unroll") for (int m = 0; m < 4; ++m) _Pragma("unroll") for (int n = 0; n < 2; ++n) _Pragma("unroll") for (int k = 0; k < 2; ++k) \
        acc[ai][bj][m][n] = __builtin_amdgcn_mfma_f32_16x16x32_bf16(Bt[n][k], At[m][k], acc[ai][bj][m][n], 0, 0, 0); __builtin_amdgcn_s_setprio(0); } while (0)
#define PG8_WAIT_V(n) asm volatile("s_waitcnt vmcnt(" #n ")" ::: "memory")
#define PG8_WAIT_L(n) asm volatile("s_waitcnt lgkmcnt(" #n ")" ::: "memory")
#define PG8_BAR __builtin_amdgcn_s_barrier()
#define PG8_SCHED __builtin_amdgcn_sched_barrier(0)
#define PG8_EOFF(pm_) (g.tile_e ? (size_t)g.tile_e[pm_] * g.estride * 2 : (size_t)0)
    Unit cur, nxt; int ui = 0;
    if (!S.next(0, cur)) return;
    f32x4 acc[2][2][4][2];
#pragma unroll
    for (int a = 0; a < 2; ++a)
#pragma unroll
        for (int b = 0; b < 2; ++b)
#pragma unroll
            for (int m = 0; m < 4; ++m)
#pragma unroll
                for (int n = 0; n < 2; ++n) acc[a][b][m][n] = (f32x4){0.f, 0.f, 0.f, 0.f};
    bf16x8 At[4][2], B0[2][2], B1[2][2];
    const char* cA = (const char*)g.A + (size_t)cur.pm * tsA; const char* cB = (const char*)g.Bt + PG8_EOFF(cur.pm) + (size_t)cur.pn * tsB;
    if constexpr (GATHER) PG8_GOFF(cur.pm, vgc);
    PG8_STAGE(PG8_SB(0, 0), cB, voffB); PG8_STAGE(PG8_SB(0, 1), cB + hsB, voffB); PG8_STAGE_A(PG8_SA(0, 0), cA, 0, false); PG8_STAGE_A(PG8_SA(0, 1), cA + hsA, 1, false);
    if (wr == 1) PG8_BAR;
    PG8_WAIT_V(2); PG8_BAR;
    PG8_STAGE(PG8_SB(1, 0), cB + kstep, voffB); PG8_STAGE_A(PG8_SA(1, 0), cA + kstep, 0, false); PG8_STAGE(PG8_SB(1, 1), cB + hsB + kstep, voffB);
    PG8_WAIT_V(6); PG8_BAR;
    for (;;) {
        const bool has_next = S.next(ui + 1, nxt);
        if constexpr (GATHER) { if (has_next) PG8_GOFF(nxt.pm, vgn); else { vgn[0][0] = vgc[0][0]; vgn[0][1] = vgc[0][1]; vgn[1][0] = vgc[1][0]; vgn[1][1] = vgc[1][1]; } }
        const char* nA = has_next ? (const char*)g.A + (size_t)nxt.pm * tsA : cA;
        const char* nB = has_next ? (const char*)g.Bt + PG8_EOFF(nxt.pm) + (size_t)nxt.pn * tsB : cB;
        for (int t = 0; t < nt; t += 2) {
            const bool last = (t == nt - 2);
            const char* a1 = cA + (size_t)(t + 1) * kstep;
            const char* a2 = last ? nA : cA + (size_t)(t + 2) * kstep; const char* b2 = last ? nB : cB + (size_t)(t + 2) * kstep;
            const char* a3 = a2 + kstep; const char* b3 = b2 + kstep;
            PG8_LDB(B0, 0, 0); PG8_LDB(B1, 0, 1); PG8_SCHED; PG8_LDA(At, 0, 0); PG8_STAGE_A(PG8_SA(1, 1), a1 + hsA, 1, false);
            PG8_WAIT_V(8); PG8_WAIT_L(0); PG8_BAR; PG8_MMA(0, 0, At, B0); PG8_MMA(0, 1, At, B1); PG8_BAR; PG8_SCHED;
            PG8_LDA(At, 0, 1); PG8_STAGE(PG8_SB(0, 0), b2, voffB); PG8_STAGE(PG8_SB(0, 1), b2 + hsB, voffB); PG8_STAGE_A(PG8_SA(0, 0), a2, 0, last);
            PG8_WAIT_V(8); PG8_WAIT_L(0); PG8_BAR; PG8_MMA(1, 0, At, B0); PG8_MMA(1, 1, At, B1); PG8_BAR; PG8_SCHED;
            PG8_LDB(B0, 1, 0); PG8_LDB(B1, 1, 1); PG8_SCHED; PG8_LDA(At, 1, 0); PG8_STAGE_A(PG8_SA(0, 1), a2 + hsA, 1, last);
            PG8_WAIT_V(8); PG8_WAIT_L(0); PG8_BAR; PG8_MMA(0, 0, At, B0); PG8_MMA(0, 1, At, B1); PG8_BAR; PG8_SCHED;
            PG8_LDA(At, 1, 1); PG8_STAGE(PG8_SB(1, 0), b3, voffB); PG8_STAGE(PG8_SB(1, 1), b3 + hsB, voffB); PG8_STAGE_A(PG8_SA(1, 0), a3, 0, last);
            PG8_WAIT_V(8); PG8_WAIT_L(0); PG8_BAR; PG8_MMA(1, 0, At, B0); PG8_MMA(1, 1, At, B1); PG8_BAR; PG8_SCHED;
        }
        if constexpr (ALIGN_EPI) { if (wr == 0) PG8_BAR; }
        E(acc, cur, wr, wc, fr, fq);
        if (!has_next) break;
#pragma unroll
        for (int a = 0; a < 2; ++a)
#pragma unroll
            for (int b = 0; b < 2; ++b)
#pragma unroll
                for (int m = 0; m < 4; ++m)
#pragma unroll
                    for (int n = 0; n < 2; ++n) acc[a][b][m][n] = (f32x4){0.f, 0.f, 0.f, 0.f};
        cur = nxt; cA = nA; cB = nB; ++ui;
        if constexpr (GATHER) { vgc[0][0] = vgn[0][0]; vgc[0][1] = vgn[0][1]; vgc[1][0] = vgn[1][0]; vgc[1][1] = vgn[1][1]; }
        if constexpr (ALIGN_EPI) { if (wr == 1) PG8_BAR; }
    }
    PG8_WAIT_V(0);
    if constexpr (!ALIGN_EPI) { if (wr == 0) PG8_BAR; }
    PG8_BAR;
#undef PG8_SA
#undef PG8_SB
#undef PG8_STAGE
#undef PG8_LDA
#undef PG8_LDB
#undef PG8_MMA
#undef PG8_WAIT_V
#undef PG8_WAIT_L
#undef PG8_BAR
#undef PG8_SCHED
#undef PG8_EOFF
#undef PG8_GOFF
#undef PG8_STAGE_A
}

__device__ __forceinline__ float row_rstd(const float* ssp, int row);
template <int ACT> struct EpiBf16 {
    static constexpr bool PERM = true;
    bf16_t* O; int ldc; const float* bias; const float* ssp;
    __device__ __forceinline__ void operator()(const f32x4 (&acc)[2][2][4][2], const Unit& u, int wr, int wc, int fr, int fq) const {
        const int row0 = u.pm * BM + wr * 64 + fr, col0 = u.pn * BM + wc * 32 + 8 * fq;
        f32x4 bv[2][2];
#pragma unroll
        for (int bj = 0; bj < 2; ++bj)
#pragma unroll
            for (int n = 0; n < 2; ++n) bv[bj][n] = bias ? *(const f32x4*)(bias + col0 + bj * HALF + 4 * n) : (f32x4){0.f, 0.f, 0.f, 0.f};
#pragma unroll
        for (int ai = 0; ai < 2; ++ai)
#pragma unroll
            for (int m = 0; m < 4; ++m) { bf16_t* rowp = O + (size_t)(row0 + ai * HALF + m * 16) * ldc + col0;
                const float rs = (ACT == 0 && ssp) ? row_rstd(ssp, row0 + ai * HALF + m * 16) : 1.f;
#pragma unroll
                for (int bj = 0; bj < 2; ++bj) { f32x4 v0 = acc[ai][bj][m][0] * rs + bv[bj][0], v1 = acc[ai][bj][m][1] * rs + bv[bj][1];
                    if (ACT == 2) {
#pragma unroll
                        for (int i = 0; i < 4; ++i) { v0[i] = gelu_tanh_f(v0[i]); v1[i] = gelu_tanh_f(v1[i]); } }
                    u32x4 w; w.x = cvtpk(v0[0], v0[1]); w.y = cvtpk(v0[2], v0[3]); w.z = cvtpk(v1[0], v1[1]); w.w = cvtpk(v1[2], v1[3]);
                    *(u32x4*)(rowp + bj * HALF) = w; } }
    }
};
struct EpiResF32 {
    static constexpr bool PERM = false;
    const float* base; float* out; int ldc;
    __device__ __forceinline__ void operator()(const f32x4 (&acc)[2][2][4][2], const Unit& u, int wr, int wc, int fr, int fq) const {
        const int col0 = u.pn * BM + wc * 32 + 4 * fq;
#pragma unroll
        for (int ai = 0; ai < 2; ++ai)
#pragma unroll
            for (int m = 0; m < 4; ++m) { const size_t off = (size_t)(u.pm * BM + ai * HALF + wr * 64 + m * 16 + fr) * ldc + col0;
#pragma unroll
                for (int bj = 0; bj < 2; ++bj)
#pragma unroll
                    for (int n = 0; n < 2; ++n) { const f32x4 bs = *(const f32x4*)(base + off + bj * HALF + n * 16); *(f32x4*)(out + off + bj * HALF + n * 16) = bs + acc[ai][bj][m][n]; } }
    }
};
template <bool BASE_BF16> struct EpiResStat {
    static constexpr bool PERM = false;
    const void* base; bf16_t* xb; float* ssp; int ldc;
    __device__ __forceinline__ void operator()(const f32x4 (&acc)[2][2][4][2], const Unit& u, int wr, int wc, int fr, int fq) const {
        const int col0 = u.pn * BM + wc * 32 + 4 * fq;
#pragma unroll
        for (int ai = 0; ai < 2; ++ai)
#pragma unroll
            for (int m = 0; m < 4; ++m) { const int row = u.pm * BM + ai * HALF + wr * 64 + m * 16 + fr; const size_t off = (size_t)row * ldc + col0; float ss = 0.f;
#pragma unroll
                for (int bj = 0; bj < 2; ++bj)
#pragma unroll
                    for (int n = 0; n < 2; ++n) { f32x4 bs;
                        if (BASE_BF16) { const u32x2 t = *(const u32x2*)((const bf16_t*)base + off + bj * HALF + n * 16); bs = (f32x4){bflo(t.x), bfhi(t.x), bflo(t.y), bfhi(t.y)}; }
                        else bs = *(const f32x4*)((const float*)base + off + bj * HALF + n * 16);
                        const f32x4 v = bs + acc[ai][bj][m][n];
                        u32x2 w; w.x = cvtpk(v.x, v.y); w.y = cvtpk(v.z, v.w); *(u32x2*)(xb + off + bj * HALF + n * 16) = w; ss += (v.x * v.x + v.y * v.y) + (v.z * v.z + v.w * v.w); }
                ss += __shfl_xor(ss, 16); ss += __shfl_xor(ss, 32);
                if (fq == 0) ssp[(size_t)row * 16 + u.pn * 4 + wc] = ss; }
    }
};
struct EpiResBf16B {
    static constexpr bool PERM = false;
    const bf16_t* base; bf16_t* out; int ldc;
    __device__ __forceinline__ void operator()(const f32x4 (&acc)[2][2][4][2], const Unit& u, int wr, int wc, int fr, int fq) const {
        const int col0 = u.pn * BM + wc * 32 + 4 * fq;
#pragma unroll
        for (int ai = 0; ai < 2; ++ai)
#pragma unroll
            for (int m = 0; m < 4; ++m) { const size_t off = (size_t)(u.pm * BM + ai * HALF + wr * 64 + m * 16 + fr) * ldc + col0;
#pragma unroll
                for (int bj = 0; bj < 2; ++bj)
#pragma unroll
                    for (int n = 0; n < 2; ++n) { const u32x2 t = *(const u32x2*)(base + off + bj * HALF + n * 16); const f32x4 v = (f32x4){bflo(t.x), bfhi(t.x), bflo(t.y), bfhi(t.y)} + acc[ai][bj][m][n];
                        u32x2 w; w.x = cvtpk(v.x, v.y); w.y = cvtpk(v.z, v.w); *(u32x2*)(out + off + bj * HALF + n * 16) = w; } }
    }
};
struct EpiResF32B {
    static constexpr bool PERM = false;
    const bf16_t* base; float* out; int ldc;
    __device__ __forceinline__ void operator()(const f32x4 (&acc)[2][2][4][2], const Unit& u, int wr, int wc, int fr, int fq) const {
        const int col0 = u.pn * BM + wc * 32 + 4 * fq;
#pragma unroll
        for (int ai = 0; ai < 2; ++ai)
#pragma unroll
            for (int m = 0; m < 4; ++m) { const size_t off = (size_t)(u.pm * BM + ai * HALF + wr * 64 + m * 16 + fr) * ldc + col0;
#pragma unroll
                for (int bj = 0; bj < 2; ++bj)
#pragma unroll
                    for (int n = 0; n < 2; ++n) { const u32x2 t = *(const u32x2*)(base + off + bj * HALF + n * 16); const f32x4 bs = {bflo(t.x), bfhi(t.x), bflo(t.y), bfhi(t.y)};
                        *(f32x4*)(out + off + bj * HALF + n * 16) = bs + acc[ai][bj][m][n]; } }
    }
};
__device__ __forceinline__ float row_rstd(const float* ssp, int row) {
    const f32x4* q = (const f32x4*)(ssp + (size_t)row * 16); const f32x4 a = q[0], b = q[1], c = q[2], d = q[3];
    const float s = ((a.x + a.y) + (a.z + a.w)) + ((b.x + b.y) + (b.z + b.w)) + ((c.x + c.y) + (c.z + c.w)) + ((d.x + d.y) + (d.z + d.w));
    return rsqrtf(s * (1.f / 1024.f) + EPS);
}
struct EpiSwiGLU {
    static constexpr bool PERM = true;
    bf16_t* O; int ldc; const float* ssp;
    __device__ __forceinline__ void operator()(const f32x4 (&acc)[2][2][4][2], const Unit& u, int wr, int wc, int fr, int fq) const {
        const int row0 = u.pm * BM + wr * 64 + fr, col0 = u.pn * HALF + wc * 32 + 8 * fq;
#pragma unroll
        for (int ai = 0; ai < 2; ++ai)
#pragma unroll
            for (int m = 0; m < 4; ++m) { bf16_t* rowp = O + (size_t)(row0 + ai * HALF + m * 16) * ldc + col0;
                const float rs = ssp ? row_rstd(ssp, row0 + ai * HALF + m * 16) : 1.f;
                float h[8];
#pragma unroll
                for (int n = 0; n < 2; ++n)
#pragma unroll
                    for (int i = 0; i < 4; ++i) h[n * 4 + i] = silu_f(acc[ai][0][m][n][i] * rs) * (acc[ai][1][m][n][i] * rs);
                u32x4 w; w.x = cvtpk(h[0], h[1]); w.y = cvtpk(h[2], h[3]); w.z = cvtpk(h[4], h[5]); w.w = cvtpk(h[6], h[7]);
                *(u32x4*)rowp = w; }
    }
};
struct EpiConvIn {
    static constexpr bool PERM = true;
    bf16_t* Bg; bf16_t* CU; const float* ssp;
    __device__ __forceinline__ void operator()(const f32x4 (&acc)[2][2][4][2], const Unit& u, int wr, int wc, int fr, int fq) const {
        const int row0 = u.pm * BM + wr * 64 + fr;
#pragma unroll
        for (int ai = 0; ai < 2; ++ai)
#pragma unroll
            for (int m = 0; m < 4; ++m) { const int row = row0 + ai * HALF + m * 16; const float rs = row_rstd(ssp, row);
                if (u.pn < 4) {
#pragma unroll
                    for (int bj = 0; bj < 2; ++bj) { const f32x4 v0 = acc[ai][bj][m][0] * rs, v1 = acc[ai][bj][m][1] * rs;
                        u32x4 w; w.x = cvtpk(v0[0], v0[1]); w.y = cvtpk(v0[2], v0[3]); w.z = cvtpk(v1[0], v1[1]); w.w = cvtpk(v1[2], v1[3]);
                        *(u32x4*)(Bg + (size_t)row * 1024 + u.pn * BM + bj * HALF + wc * 32 + 8 * fq) = w; }
                } else { const float r2 = rs * rs; float h[8];
#pragma unroll
                    for (int n = 0; n < 2; ++n)
#pragma unroll
                        for (int i = 0; i < 4; ++i) h[n * 4 + i] = acc[ai][0][m][n][i] * acc[ai][1][m][n][i] * r2;
                    u32x4 w; w.x = cvtpk(h[0], h[1]); w.y = cvtpk(h[2], h[3]); w.z = cvtpk(h[4], h[5]); w.w = cvtpk(h[6], h[7]);
                    *(u32x4*)(CU + (size_t)row * 1024 + (u.pn - 4) * HALF + wc * 32 + 8 * fq) = w; } }
    }
};
struct EpiRowScaleBf16 {
    static constexpr bool PERM = true;
    bf16_t* O; int ldc; const float* roww;
    __device__ __forceinline__ void operator()(const f32x4 (&acc)[2][2][4][2], const Unit& u, int wr, int wc, int fr, int fq) const {
        const int row0 = u.pm * BM + wr * 64 + fr, col0 = u.pn * BM + wc * 32 + 8 * fq;
#pragma unroll
        for (int ai = 0; ai < 2; ++ai)
#pragma unroll
            for (int m = 0; m < 4; ++m) { const int row = row0 + ai * HALF + m * 16; const float sc = roww[row]; bf16_t* rowp = O + (size_t)row * ldc + col0;
#pragma unroll
                for (int bj = 0; bj < 2; ++bj) { const f32x4 v0 = acc[ai][bj][m][0] * sc, v1 = acc[ai][bj][m][1] * sc;
                    u32x4 w; w.x = cvtpk(v0[0], v0[1]); w.y = cvtpk(v0[2], v0[3]); w.z = cvtpk(v1[0], v1[1]); w.w = cvtpk(v1[2], v1[3]);
                    *(u32x4*)(rowp + bj * HALF) = w; } }
    }
};
}
constexpr int ROWS_MAX = 2 * T + 8 * 256;
constexpr size_t al256(size_t x) { return (x + 255) & ~(size_t)255; }
constexpr size_t W_IN_E = 0;
constexpr size_t W_CW1 = W_IN_E + (size_t)1792 * 1024 * 2;
constexpr size_t W_UQ = W_CW1 + (size_t)2 * 256 * 2048 * 2;
constexpr size_t W_UKV = W_UQ + (size_t)1024 * 256 * 2;
constexpr size_t W_OUT_E = W_UKV + (size_t)1024 * 128 * 2;
constexpr size_t W_GU = W_OUT_E + (size_t)1024 * 1024 * 2;
constexpr size_t W_D = W_GU + (size_t)5632 * 1024 * 2;
constexpr size_t W_IN_O = W_D + (size_t)1024 * 2816 * 2;
constexpr size_t W_OUT_O = W_IN_O + (size_t)3072 * 1024 * 2;
constexpr size_t W_MGU = W_OUT_O + (size_t)1024 * 1024 * 2;
constexpr size_t W_MD = W_MGU + (size_t)8 * 2816 * 1024 * 2;
constexpr size_t W_END = W_MD + (size_t)8 * 1024 * 1408 * 2;
constexpr size_t SM_CTL = al256(W_END);
constexpr size_t SM_BAR = SM_CTL + 4096;
constexpr size_t SM_B1P = SM_BAR + 16384;
constexpr size_t SM_B1 = SM_B1P + 32 * 512 * 4;
constexpr size_t SM_ROPE = SM_B1 + 512 * 4;
constexpr size_t SM_BL = SM_ROPE + (size_t)S * 32 * 4;
constexpr size_t SM_HID = SM_BL + 8 * 132 * 4;
constexpr size_t SM_KC = SM_HID + (size_t)2 * NB * 512 * 512 * 2;
constexpr size_t SM_VCT = SM_KC + (size_t)NB * 512 * 64 * 2;
constexpr size_t SM_TE = SM_VCT + (size_t)NB * 512 * 64 * 2;
constexpr size_t SM_TW = SM_TE + (size_t)T * 8;
constexpr size_t SM_RANK = SM_TW + (size_t)T * 8;
constexpr size_t SM_POS = SM_RANK + (size_t)T * 8;
constexpr size_t SM_ROWW = SM_POS + (size_t)T * 8;
constexpr size_t SM_TILEE = SM_ROWW + (size_t)ROWS_MAX * 4;
constexpr size_t SM_ROWTOK = al256(SM_TILEE + (size_t)(ROWS_MAX / 256 + 8) * 4);
constexpr size_t SM_SSP1 = al256(SM_ROWTOK + (size_t)ROWS_MAX * 4);
constexpr size_t SM_SSP2 = SM_SSP1 + (size_t)T * 64;
constexpr size_t SM_END = SM_SSP2 + (size_t)T * 64;
constexpr size_t R_XA = al256(SM_END);
constexpr size_t SZ_XA = (size_t)T * 4096 + (size_t)4 * 1048576;
constexpr size_t R_XN = R_XA + SZ_XA;
constexpr size_t SZ_XN = (size_t)T * 2048;
constexpr size_t R_H = R_XN + SZ_XN;
constexpr size_t SZ_H = ((size_t)T * 6144 > (size_t)ROWS_MAX * 2816) ? (size_t)T * 6144 : (size_t)ROWS_MAX * 2816;
constexpr size_t WS_FAST_END = R_H + SZ_H;
constexpr size_t A_QN = 0;
constexpr size_t A_KSN = A_QN + (size_t)T * 1024;
constexpr size_t A_KWN = A_KSN + (size_t)T * 256;
constexpr size_t A_VST = A_KWN + (size_t)T * 256;
constexpr size_t A_VWT = A_VST + (size_t)T * 256;
constexpr size_t A_KCIN = A_VWT + (size_t)T * 256;
constexpr size_t A_VCIN = A_KCIN + (size_t)T * 256 + 2048;
constexpr size_t A_CQN = A_VCIN + (size_t)T * 256 + 2048;
constexpr size_t A_CKVN = A_CQN + (size_t)T * 512;
constexpr size_t A_KROPE = A_CKVN + (size_t)T * 256;
constexpr size_t A_GATES = A_KROPE + (size_t)T * 64;
constexpr size_t A_END = A_GATES + (size_t)T * 96;
static_assert(A_END <= SZ_XA, "attention inputs fit R_XA");
constexpr size_t O_QM = 0;
constexpr size_t O_KM = O_QM + (size_t)T * 1536;
constexpr size_t O_VMT = O_KM + (size_t)T * 1536;
static_assert(O_VMT + (size_t)T * 1024 <= (size_t)T * 4096, "d_out scratch");

struct Params {
    const float* in[30];
    float* out;
    unsigned char* ws;
    int ph_lo, ph_hi, dbg_branch, pad_;
};

#ifdef PROF_SEL
#define PROF_SLOT(k) ((unsigned long long*)(p.ws + SM_CTL + 2048) + (k))
#define PROF_ON(cond) ((cond) && threadIdx.x == 0)
#ifndef PROF_WAVE
#define PROF_WAVE 0
#endif
#endif
constexpr int LDS_BYTES = 163840;

__device__ __forceinline__ int ltid() { int t = threadIdx.x; asm volatile("" : "+v"(t)); return t; }
__device__ __forceinline__ int perm16(int k) { return (k & ~12) | ((k & 4) << 1) | ((k & 8) >> 1); }

struct WDesc { int in_idx, K, N, rep, map, row_off; size_t src_stride, dst_off, dst_stride; int gain_idx, pad_; size_t src_off; };
__device__ const WDesc WDESC[13] = {
    {3, 1024, 1720, 1, 2, 0, 0, W_IN_E / 2, 0, -1, 0},
    {7, 1024, 256, 2, 0, 0, (size_t)2048 * 256, W_CW1 / 2, (size_t)512 * 1024, -1, 0, 0},
    {7, 1024, 256, 2, 0, 256, (size_t)2048 * 256, W_CW1 / 2, (size_t)512 * 1024, -1, 0, (size_t)1024 * 256},
    {11, 256, 768, 1, 3, 0, 0, W_UQ / 2, 0, -1, 0},
    {12, 128, 1024, 1, 0, 0, 0, W_UKV / 2, 0, -1, 0},
    {15, 1024, 1024, 1, 0, 0, 0, W_OUT_E / 2, 0, -1, 0},
    {17, 1024, 2816, 1, 1, 0, 0, W_GU / 2, 0, 16, 0},
    {18, 1024, 2816, 1, 1, 128, 0, W_GU / 2, 0, 16, 0},
    {19, 2816, 1024, 1, 0, 0, 0, W_D / 2, 0, -1, 0},
    {21, 1024, 3072, 1, 4, 0, 0, W_IN_O / 2, 0, 20, 0},
    {23, 1024, 1024, 1, 0, 0, 0, W_OUT_O / 2, 0, -1, 0},
    {27, 1024, 1408, 8, 1, 0, (size_t)1024 * 1408, W_MGU / 2, (size_t)2816 * 1024, -1, 0},
    {28, 1024, 1408, 8, 1, 128, (size_t)1024 * 1408, W_MGU / 2, (size_t)2816 * 1024, -1, 0},
};
__device__ const WDesc WDESC_MD = {29, 1408, 1024, 8, 0, 0, (size_t)1408 * 1024, W_MD / 2, (size_t)1024 * 1408, -1, 0};

struct WItem { f32x4 v[8]; };
__device__ __forceinline__ void item_load(WItem& I, const float* W, int K, int N, const float* gain, int item, int lane) {
    const int nblk = (N + 31) / 32, kb = item / nblk, nb = item % nblk, k0 = 64 * kb, n0 = 32 * nb;
    const int n4 = (lane & 7) * 4; const bool nok = (n0 + n4) < N;
#pragma unroll
    for (int i = 0; i < 8; ++i) { const int kk = (lane >> 3) + 8 * i; I.v[i] = nok ? *(const f32x4*)(W + (size_t)(k0 + kk) * N + n0 + n4) : (f32x4){0.f, 0.f, 0.f, 0.f}; if (gain) I.v[i] = I.v[i] * gain[k0 + kk]; }
}
__device__ __forceinline__ void item_finish(const WItem& I, int K, int N, bf16_t* WT, int map, int row_off, LAS float* scr, int item, int lane) {
    const int nblk = (N + 31) / 32, kb = item / nblk, nb = item % nblk, k0 = 64 * kb, n0 = 32 * nb;
    const int n4 = (lane & 7) * 4;
#pragma unroll
    for (int i = 0; i < 8; ++i) { const int kk = (lane >> 3) + 8 * i; LAS float* d = scr + kk * 33 + n4; d[0] = I.v[i].x; d[1] = I.v[i].y; d[2] = I.v[i].z; d[3] = I.v[i].w; }
    asm volatile("s_waitcnt lgkmcnt(0)" ::: "memory");
    const int c = lane & 7;
#pragma unroll
    for (int j = 0; j < 4; ++j) { const int n = (lane >> 3) + 8 * j; const LAS float* s = scr + (8 * c) * 33 + n;
        u32x4 o; o.x = cvtpk(s[0 * 33], s[1 * 33]); o.y = cvtpk(s[2 * 33], s[3 * 33]); o.z = cvtpk(s[4 * 33], s[5 * 33]); o.w = cvtpk(s[6 * 33], s[7 * 33]);
        const int nn = n0 + n;
        if (nn < N) { const int row = (map == 1) ? (256 * (nn >> 7) + (nn & 127) + row_off) : (map == 2) ? (nn < 1280 ? nn : (nn < 1304 ? nn + 416 : nn - 24)) : (map == 3) ? ((nn / 96) * 128 + nn % 96) : (map == 4) ? (nn < 1024 ? nn : (nn < 2048 ? 1024 + 256 * ((nn - 1024) >> 7) + ((nn - 1024) & 127) : 1024 + 256 * ((nn - 2048) >> 7) + 128 + ((nn - 2048) & 127))) : (nn + row_off);
            *(u32x4*)(WT + (size_t)row * K + k0 + 8 * c) = o; } }
    asm volatile("s_waitcnt lgkmcnt(0)" ::: "memory");
}
__device__ __forceinline__ void rms_row_to_bf16(const float* xrow, const float* g, bf16_t* orow, int lane) {
    const f32x4* xr = (const f32x4*)xrow + lane; const f32x4* gr = (const f32x4*)g + lane;
    f32x4 v[4]; float s = 0.f;
#pragma unroll
    for (int j = 0; j < 4; ++j) { v[j] = xr[64 * j]; s += (v[j].x * v[j].x + v[j].y * v[j].y) + (v[j].z * v[j].z + v[j].w * v[j].w); }
    const float r = rsqrtf(wsum(s) * (1.f / 1024.f) + EPS);
    u32x2* o8 = (u32x2*)orow + lane;
#pragma unroll
    for (int j = 0; j < 4; ++j) { const f32x4 gg = gr[64 * j]; u32x2 w; w.x = cvtpk(v[j].x * r * gg.x, v[j].y * r * gg.y); w.y = cvtpk(v[j].z * r * gg.z, v[j].w * r * gg.w); o8[64 * j] = w; }
}
constexpr int WD_EARLY = 6;
__device__ __forceinline__ void convert_weights(const Params& p, LAS unsigned char* lds, int d_lo, int d_hi) {
    const int tid = ltid(), lane = tid & 63, wave = tid >> 6;
    const int gw = blockIdx.x * 8 + wave, NGW = gridDim.x * 8;
    LAS float* scr = (LAS float*)(lds + wave * 16384);
    int base = 0;
#pragma unroll 1
    for (int d = d_lo; d < d_hi; ++d) {
        const WDesc& wd = (d < 13) ? WDESC[d] : WDESC_MD;
        const int n_it = wd.rep * (wd.K / 64) * ((wd.N + 31) / 32);
        int first = (gw - (base % NGW) + NGW) % NGW;
        const int per = (wd.K / 64) * ((wd.N + 31) / 32); const float* gain = wd.gain_idx >= 0 ? p.in[wd.gain_idx] : nullptr;
        for (int it = first; it < n_it; it += 4 * NGW) {
            WItem I[4];
#pragma unroll
            for (int q = 0; q < 4; ++q) { const int iq = it + q * NGW; if (iq < n_it) { const int r = iq / per; item_load(I[q], p.in[wd.in_idx] + wd.src_off + (size_t)r * wd.src_stride, wd.K, wd.N, gain, iq % per, lane); } }
#pragma unroll
            for (int q = 0; q < 4; ++q) { const int iq = it + q * NGW; if (iq < n_it) { const int r = iq / per; item_finish(I[q], wd.K, wd.N, (bf16_t*)p.ws + wd.dst_off + (size_t)r * wd.dst_stride, wd.map, wd.row_off, scr, iq % per, lane); } }
        }
        base += n_it;
    }
}
__device__ __forceinline__ void phase_p0(const Params& p, LAS unsigned char* lds) {
    const int tid = ltid(), lane = tid & 63, wave = tid >> 6;
    const int gw = blockIdx.x * 8 + wave, NGW = gridDim.x * 8;
    convert_weights(p, lds, 0, WD_EARLY);
    bf16_t* xn = (bf16_t*)(p.ws + R_XN);
    for (int m = gw; m < T; m += 2 * NGW) { rms_row_to_bf16(p.in[0] + (size_t)m * D, p.in[2], xn + (size_t)m * D, lane); if (m + NGW < T) rms_row_to_bf16(p.in[0] + (size_t)(m + NGW) * D, p.in[2], xn + (size_t)(m + NGW) * D, lane); }
    for (int u = gw; u < 256; u += NGW) {
        const int kc = u >> 3, kv = (u >> 2) & 1, nb = u & 3; float s = 0.f;
        const float* pos = p.in[6] + kv * 2048 + kc * 64; const float* w1 = p.in[7] + ((size_t)kv * 2048 + kc * 64) * 256 + nb * 64 + lane;
#pragma unroll 8
        for (int k = 0; k < 64; ++k) s += pos[k] * w1[(size_t)k * 256];
        ((float*)(p.ws + SM_B1P))[kc * 512 + kv * 256 + nb * 64 + lane] = s;
    }
    for (int i = blockIdx.x * 512 + tid; i < S * 16; i += gridDim.x * 512) {
        const int t = i >> 4, f = i & 15; const float ang = (float)t * powf(10000.f, -(float)f / 16.f);
        float* rp = (float*)(p.ws + SM_ROPE) + t * 32; rp[f] = cosf(ang); rp[16 + f] = sinf(ang);
    }
    if (blockIdx.x == 0) for (int i = tid; i < 8 * 129; i += 512) { const int h = i / 129, dd = i % 129; ((float*)(p.ws + SM_BL))[h * 132 + dd] = p.in[1][(dd < 128 ? (int)gold::T5B[dd] : 31) * 8 + h] * LOG2E; }
}

__device__ __forceinline__ void unpack8(const u32x4 v, float (&x)[8]) { x[0] = bflo(v.x); x[1] = bfhi(v.x); x[2] = bflo(v.y); x[3] = bfhi(v.y); x[4] = bflo(v.z); x[5] = bfhi(v.z); x[6] = bflo(v.w); x[7] = bfhi(v.w); }
__device__ __forceinline__ u32x4 pack8(const float (&x)[8]) { u32x4 w; w.x = cvtpk(x[0], x[1]); w.y = cvtpk(x[2], x[3]); w.z = cvtpk(x[4], x[5]); w.w = cvtpk(x[6], x[7]); return w; }
__device__ __forceinline__ float ss8f(const float (&x)[8]) { return ((x[0] * x[0] + x[1] * x[1]) + (x[2] * x[2] + x[3] * x[3])) + ((x[4] * x[4] + x[5] * x[5]) + (x[6] * x[6] + x[7] * x[7])); }
__device__ __forceinline__ void load8f(const float* g, float (&x)[8], float sc) { const f32x4 a = *(const f32x4*)g, b = *(const f32x4*)(g + 4); x[0] = a.x * sc; x[1] = a.y * sc; x[2] = a.z * sc; x[3] = a.w * sc; x[4] = b.x * sc; x[5] = b.y * sc; x[6] = b.z * sc; x[7] = b.w * sc; }
__device__ __forceinline__ void phase_p2(const Params& p, LAS unsigned char* lds) {
    const int tid = ltid(), lane = tid & 63, wave = tid >> 6;
    const bf16_t* hb = (const bf16_t*)(p.ws + R_H);
    unsigned char* xa = p.ws + R_XA;
    bf16_t* qn = (bf16_t*)(xa + A_QN); bf16_t* ksn = (bf16_t*)(xa + A_KSN); bf16_t* kwn = (bf16_t*)(xa + A_KWN);
    bf16_t* vst = (bf16_t*)(xa + A_VST); bf16_t* vwt = (bf16_t*)(xa + A_VWT); bf16_t* kcin = (bf16_t*)(xa + A_KCIN); bf16_t* vcin = (bf16_t*)(xa + A_VCIN);
    bf16_t* cqn = (bf16_t*)(xa + A_CQN); bf16_t* ckvn = (bf16_t*)(xa + A_CKVN); bf16_t* krope = (bf16_t*)(xa + A_KROPE); float* gates = (float*)(xa + A_GATES);
    LAS bf16_t* vs = (LAS bf16_t*)lds;
    if (blockIdx.x == 0) {
        { float s = 0.f; for (int k = 0; k < 32; ++k) s += ((const float*)(p.ws + SM_B1P))[k * 512 + tid]; ((float*)(p.ws + SM_B1))[tid] = s; }
        for (int i = tid; i < 1024; i += 512) { kcin[(size_t)T * 128 + i] = 0; vcin[(size_t)T * 128 + i] = 0; }
    }
    const int c8 = (lane & 7) * 8, seg = lane >> 3;
    float qg[8], ksg[8], kwg[8], cqg[8], ckvg[8];
    load8f(p.in[4] + c8, qg, 0.125f * LOG2E); load8f(p.in[5] + 64 + c8, ksg, 1.f); load8f(p.in[5] + 128 + c8, kwg, 1.f);
    load8f(p.in[9] + (lane & 31) * 8, cqg, 1.f); load8f(p.in[10] + (lane & 15) * 8, ckvg, 1.f);
    for (int tile = blockIdx.x; tile < T / 64; tile += gridDim.x) {
        const int b = tile / (S / 64), s0 = (tile % (S / 64)) * 64;
#pragma unroll 4
        for (int tt = 0; tt < 8; ++tt) {
            const int sl = wave * 8 + tt, s = s0 + sl; const size_t t = (size_t)b * S + s;
            const bf16_t* hr = hb + t * 1792 + lane * 8;
            const u32x4 L0 = *(const u32x4*)hr, L1 = *(const u32x4*)(hr + 512), L2 = *(const u32x4*)(hr + 1024);
            u32x4 L3 = {0u, 0u, 0u, 0u}; if (lane < 32) L3 = *(const u32x4*)(hr + 1536);
            float x0[8], x1[8], x2[8], x3[8];
            unpack8(L0, x0); unpack8(L1, x1); unpack8(L2, x2); unpack8(L3, x3);
            float a0 = ss8f(x0), a1 = ss8f(x1), a2 = ss8f(x2), a3 = ss8f(x3);
#pragma unroll
            for (int o = 1; o < 8; o <<= 1) { a0 += __shfl_xor(a0, o); a1 += __shfl_xor(a1, o); a2 += __shfl_xor(a2, o); a3 += __shfl_xor(a3, o); }
            float a2w = a2 + __shfl_xor(a2, 8); a2w += __shfl_xor(a2w, 16);
            const float a3w = a3 + __shfl_xor(a3, 8);
            const int pp0 = (sl & ~15) | perm16(sl & 15);
            const int pp = (((pp0 >> 3) ^ (lane & 7)) << 3) | (pp0 & 7);
            {
                const float r = rsqrtf(a0 * (1.f / 64.f) + EPS); float y[8];
#pragma unroll
                for (int j = 0; j < 8; ++j) y[j] = x0[j] * r * qg[j];
                *(u32x4*)(qn + t * 512 + lane * 8) = pack8(y);
            }
            {
                const int g = seg & 1; const size_t gm = (((size_t)b * 2 + g) * S + s) * 64 + c8;
                if (seg < 2) *(u32x4*)(kcin + gm) = L1;
                else if (seg < 4) *(u32x4*)(vcin + gm) = L1;
                else if (seg < 6) { const float r = rsqrtf(a1 * (1.f / 64.f) + EPS); float y[8];
#pragma unroll
                    for (int j = 0; j < 8; ++j) y[j] = x1[j] * r * ksg[j];
                    *(u32x4*)(ksn + gm) = pack8(y); }
                else {
#pragma unroll
                    for (int j = 0; j < 8; ++j) vs[((0 + g) * 64 + c8 + j) * 72 + pp] = (bf16_t)((j & 1) ? (L1[j >> 1] >> 16) : (L1[j >> 1] & 0xffffu)); }
            }
            {
                const int g = seg & 1; const size_t gm = (((size_t)b * 2 + g) * S + s) * 64 + c8;
                if (seg < 2) { const float r = rsqrtf(a2 * (1.f / 64.f) + EPS); float y[8];
#pragma unroll
                    for (int j = 0; j < 8; ++j) y[j] = x2[j] * r * kwg[j];
                    *(u32x4*)(kwn + gm) = pack8(y); }
                else if (seg < 4) {
#pragma unroll
                    for (int j = 0; j < 8; ++j) vs[((2 + g) * 64 + c8 + j) * 72 + pp] = (bf16_t)((j & 1) ? (L2[j >> 1] >> 16) : (L2[j >> 1] & 0xffffu)); }
                else { const float r = rsqrtf(a2w * (1.f / 256.f) + EPS); float y[8];
#pragma unroll
                    for (int j = 0; j < 8; ++j) y[j] = x2[j] * r * cqg[j];
                    *(u32x4*)(cqn + t * 256 + (lane - 32) * 8) = pack8(y); }
            }
            {
                if (lane < 16) { const float r = rsqrtf(a3w * (1.f / 128.f) + EPS); float y[8];
#pragma unroll
                    for (int j = 0; j < 8; ++j) y[j] = x3[j] * r * ckvg[j];
                    *(u32x4*)(ckvn + t * 128 + lane * 8) = pack8(y); }
                else if (lane < 20) *(u32x4*)(krope + t * 32 + (lane - 16) * 8) = L3;
                else if (lane < 23) { float y[8];
#pragma unroll
                    for (int j = 0; j < 8; ++j) y[j] = frcp(1.f + fexp2(-x3[j] * LOG2E));
                    float* gp = gates + t * 24 + (lane - 20) * 8; *(f32x4*)gp = (f32x4){y[0], y[1], y[2], y[3]}; *(f32x4*)(gp + 4) = (f32x4){y[4], y[5], y[6], y[7]}; }
            }
        }
        __syncthreads();
        {
            const int row = tid >> 1, half = tid & 1, which = row >> 6, d = row & 63, g = which & 1;
            bf16_t* dst = ((which < 2) ? vst : vwt) + (((size_t)b * 2 + g) * 64 + d) * S + s0 + half * 32;
            const LAS bf16_t* src = vs + row * 72; const int sx = (row >> 3) & 7;
#pragma unroll
            for (int c = 0; c < 4; ++c) *(u32x4*)(dst + c * 8) = *(const LAS u32x4*)(src + (((half * 4 + c) ^ sx) << 3));
        }
        __syncthreads();
    }
}
__device__ __forceinline__ void phase_p3b(const Params& p, LAS unsigned char* lds) {
    const int tid = ltid(), lane = tid & 63, wave = tid >> 6;
    const int gw = blockIdx.x * 8 + wave, NGW = gridDim.x * 8;
    const bf16_t* qraw = (const bf16_t*)(p.ws + R_H);
    const bf16_t* kvraw = (const bf16_t*)(p.ws + R_H + (size_t)T * 2048);
    const bf16_t* krope = (const bf16_t*)(p.ws + R_XA + A_KROPE);
    const float* rope = (const float*)(p.ws + SM_ROPE);
    bf16_t* qm = (bf16_t*)((unsigned char*)p.out + O_QM); bf16_t* km = (bf16_t*)((unsigned char*)p.out + O_KM); bf16_t* vmt = (bf16_t*)((unsigned char*)p.out + O_VMT);
    const float* q_norm = p.in[13]; const float* k_norm = p.in[14];
    LAS bf16_t* vs = (LAS bf16_t*)lds;
    LAS float* w2s = (LAS float*)(lds + 73728);
    for (int kv = 0; kv < 2; ++kv) {
        __syncthreads();
        for (int i = tid; i < 256 * 64; i += 512) w2s[i] = p.in[8][kv * 16384 + i];
        __syncthreads();
        const bf16_t* P = (const bf16_t*)(p.ws + SM_HID) + (size_t)kv * NB * 512 * 512;
        const f32x4 bs = *(const f32x4*)((const float*)(p.ws + SM_B1) + kv * 256 + lane * 4);
        for (int row = gw; row < NB * 512; row += NGW) {
            const int row1 = row + 1 < NB * 512 ? row + 1 : row;
            const u32x2 pa = *(const u32x2*)(P + (size_t)row * 512 + lane * 4), pb = *(const u32x2*)(P + (size_t)row1 * 512 + 256 + lane * 4);
            const float h0 = gelu_tanh_f(bflo(pa.x) + bflo(pb.x) + bs.x), h1 = gelu_tanh_f(bfhi(pa.x) + bfhi(pb.x) + bs.y), h2 = gelu_tanh_f(bflo(pa.y) + bflo(pb.y) + bs.z), h3 = gelu_tanh_f(bfhi(pa.y) + bfhi(pb.y) + bs.w);
            float acc = 0.f;
#pragma unroll 8
            for (int k4 = 0; k4 < 64; ++k4) {
                acc += __shfl(h0, k4) * w2s[(k4 * 4 + 0) * 64 + lane]; acc += __shfl(h1, k4) * w2s[(k4 * 4 + 1) * 64 + lane];
                acc += __shfl(h2, k4) * w2s[(k4 * 4 + 2) * 64 + lane]; acc += __shfl(h3, k4) * w2s[(k4 * 4 + 3) * 64 + lane];
            }
            if (kv == 0) { const float r = rsqrtf(wsum(acc * acc) * (1.f / 64.f) + EPS); ((bf16_t*)(p.ws + SM_KC))[(size_t)row * 64 + lane] = f2bf(acc * r * p.in[5][lane]); }
            else { const int c = row & 255; ((bf16_t*)(p.ws + SM_VCT))[((size_t)(row >> 8) * 64 + lane) * 256 + ((c & ~15) | perm16(c & 15))] = f2bf(acc); }
        }
    }
    __syncthreads();
    const float QS = 0.10206207261596577f * LOG2E;
    const int c = lane & 15, hl = lane >> 4;
    float qg[8], kg[8];
    load8f(q_norm + (c < 12 ? c * 8 : 0), qg, QS);
    load8f(k_norm + (c < 12 ? c * 8 : 0), kg, 1.f);
    for (int tile = blockIdx.x; tile < T / 64; tile += gridDim.x) {
        const int b = tile / (S / 64), s0 = (tile % (S / 64)) * 64;
#pragma unroll 4
        for (int tt = 0; tt < 8; ++tt) {
            const int sl = wave * 8 + tt, s = s0 + sl; const size_t t = (size_t)b * S + s;
            const int pp0 = (sl & ~15) | perm16(sl & 15);
            const int pp = (((pp0 >> 3) ^ ((c - 8) & 7)) << 3) | (pp0 & 7);
            u32x4 Q[2], KV[2];
#pragma unroll
            for (int ld = 0; ld < 2; ++ld) { Q[ld] = *(const u32x4*)(qraw + t * 1024 + ld * 512 + lane * 8); KV[ld] = *(const u32x4*)(kvraw + t * 1024 + ld * 512 + lane * 8); }
            u32x4 KR = {0u, 0u, 0u, 0u}; f32x4 cs0 = {0.f, 0.f, 0.f, 0.f}, cs1 = cs0, sn0 = cs0, sn1 = cs0;
            if (c >= 8 && c < 12) { KR = *(const u32x4*)(krope + t * 32 + (c - 8) * 8);
                const float* rp = rope + s * 32 + (c & 1) * 8; cs0 = *(const f32x4*)rp; cs1 = *(const f32x4*)(rp + 4); sn0 = *(const f32x4*)(rp + 16); sn1 = *(const f32x4*)(rp + 20); }
            const float cs[8] = {cs0.x, cs0.y, cs0.z, cs0.w, cs1.x, cs1.y, cs1.z, cs1.w}, sn[8] = {sn0.x, sn0.y, sn0.z, sn0.w, sn1.x, sn1.y, sn1.z, sn1.w};
            float kr[8]; unpack8(KR, kr);
            const float krs = ss8f(kr);
#pragma unroll
            for (int ld = 0; ld < 2; ++ld) {
                const int hh = ld * 4 + hl;
                {
                    float x[8]; unpack8(Q[ld], x);
                    float ss = c < 12 ? ss8f(x) : 0.f;
#pragma unroll
                    for (int o = 1; o < 16; o <<= 1) ss += __shfl_xor(ss, o);
                    const float r = rsqrtf(ss * (1.f / 96.f) + EPS); float y[8], z[8];
#pragma unroll
                    for (int j = 0; j < 8; ++j) y[j] = x[j] * r * qg[j];
#pragma unroll
                    for (int j = 0; j < 8; ++j) { const float pb = __shfl_xor(y[j], 2); z[j] = (c < 8) ? y[j] : ((c < 10) ? (y[j] * cs[j] - pb * sn[j]) : (pb * sn[j] + y[j] * cs[j])); }
                    if (c < 12) *(u32x4*)(qm + (t * 8 + hh) * 96 + c * 8) = pack8(z);
                }
                {
                    float x[8]; unpack8(KV[ld], x);
                    float ss = c < 8 ? ss8f(x) : krs;
#pragma unroll
                    for (int o = 1; o < 16; o <<= 1) ss += __shfl_xor(ss, o);
                    const float r = rsqrtf(ss * (1.f / 96.f) + EPS); float y[8], z[8];
#pragma unroll
                    for (int j = 0; j < 8; ++j) y[j] = (c < 8 ? x[j] : kr[j]) * r * kg[j];
#pragma unroll
                    for (int j = 0; j < 8; ++j) { const float pb = __shfl_xor(y[j], 2); z[j] = (c < 8) ? y[j] : ((c < 10) ? (y[j] * cs[j] - pb * sn[j]) : (pb * sn[j] + y[j] * cs[j])); }
                    if (c < 12) *(u32x4*)(km + (((size_t)b * 8 + hh) * S + s) * 96 + c * 8) = pack8(z);
                    if (c >= 8) {
#pragma unroll
                        for (int j = 0; j < 8; ++j) vs[(hh * 64 + (c - 8) * 8 + j) * 72 + pp] = (bf16_t)((j & 1) ? (KV[ld][j >> 1] >> 16) : (KV[ld][j >> 1] & 0xffffu)); }
                }
            }
        }
        __syncthreads();
        {
            const int hh = tid >> 6, d = tid & 63;
            bf16_t* dst = vmt + (((size_t)b * 8 + hh) * 64 + d) * S + s0;
            const LAS bf16_t* src = vs + tid * 72; const int sx = (tid >> 3) & 7;
#pragma unroll
            for (int cc = 0; cc < 8; ++cc) *(u32x4*)(dst + cc * 8) = *(const LAS u32x4*)(src + ((cc ^ sx) << 3));
        }
        __syncthreads();
    }
}

__device__ const unsigned short UNIT_TYPES[256] = {63,127,62,126,61,125,527,591,655,719,783,847,911,975,60,124,59,123,58,122,57,121,56,120,526,590,654,718,782,846,910,974,55,119,54,118,53,117,52,116,51,115,525,589,653,717,781,845,909,973,50,114,49,113,48,112,47,111,524,588,652,716,780,844,908,972,46,110,45,109,44,108,43,107,523,587,651,715,779,843,907,971,42,106,41,105,40,104,39,103,38,102,522,586,650,714,778,842,906,970,37,101,36,100,35,99,34,98,33,97,521,585,649,713,777,841,905,969,32,96,31,95,30,94,520,584,648,712,776,840,904,968,29,93,28,92,27,91,26,90,25,89,519,583,647,711,775,839,903,967,24,88,23,87,22,86,21,85,20,84,518,582,646,710,774,838,902,966,19,83,18,82,17,81,16,80,15,79,517,581,645,709,773,837,901,965,14,78,13,77,12,76,516,580,644,708,772,836,900,964,11,75,10,74,9,73,8,72,515,579,643,707,771,835,899,963,7,71,6,70,5,69,514,578,642,706,770,834,898,962,4,68,3,67,513,577,641,705,769,833,897,961,2,66,1,65,0,64,512,576,640,704,768,832,896,960};
__device__ __forceinline__ int crow(int r, int hi) { return (r & 3) + 8 * (r >> 2) + 4 * hi; }
struct Flash { f32x16 o0, o1; float l; };
__device__ __forceinline__ void flash_init(Flash& st) {
#pragma unroll
    for (int r = 0; r < 16; ++r) { st.o0[r] = 0.f; st.o1[r] = 0.f; }
    st.l = 0.f;
}
constexpr int AL_K64 = 0, AL_V64 = 4 * 8192;
constexpr int AL_K96 = 0, AL_V96 = 4 * 16384;
constexpr int AL_IMP = 65536, AL_SELB = AL_IMP + 64 * 65 * 4, AL_UNI = AL_SELB + 512, AL_TL = AL_UNI + 64, AL_BL = AL_TL + 128, AL_OT = AL_BL + 4 * 132 * 4, AL_END = AL_OT + 8 * 32 * 64 * 4;
static_assert(AL_END <= 163328 && AL_V96 + 4 * 8192 <= 163328, "attention LDS");

template <int RB> struct DmaLane { unsigned g0, g1; };
template <int RB> __device__ __forceinline__ void dma_setup(DmaLane<RB>& L, int w, int lane, unsigned gs) {
    if (RB == 128) { const int r = 8 * w + (lane >> 3), c = (lane & 7) ^ ((r >> 1) & 7); L.g0 = (unsigned)r * gs + c * 16; L.g1 = 0; }
    else {
        { const int r = 8 * w + (lane >> 4); int c = (lane & 15) ^ (r & 15); c = c >= 12 ? c - 4 : c; L.g0 = (unsigned)r * gs + c * 16; }
        { const int r = 8 * w + 4 + (lane >> 4); int c = (lane & 15) ^ (r & 15); c = c >= 12 ? c - 4 : c; L.g1 = (unsigned)r * gs + c * 16; }
    }
}
template <int RB> __device__ __forceinline__ void dma_issue(const unsigned char* tile, const DmaLane<RB>& L, LAS unsigned char* buf, int w) {
    if (RB == 128) __builtin_amdgcn_global_load_lds((const unsigned*)(tile + L.g0), (LAS unsigned*)(buf + w * 1024), 16, 0, 0);
    else { __builtin_amdgcn_global_load_lds((const unsigned*)(tile + L.g0), (LAS unsigned*)(buf + w * 2048), 16, 0, 0);
           __builtin_amdgcn_global_load_lds((const unsigned*)(tile + L.g1), (LAS unsigned*)(buf + w * 2048 + 1024), 16, 0, 0); }
}
template <int DK> __device__ __forceinline__ void frag_offsets(unsigned (&kl)[DK / 16], unsigned (&vl)[4], int r32, int hi) {
#pragma unroll
    for (int s = 0; s < DK / 16; ++s) kl[s] = (DK == 64) ? (unsigned)(r32 * 128 + (((2 * s + hi) ^ ((r32 >> 1) & 7)) << 4)) : (unsigned)(r32 * 256 + (((2 * s + hi) ^ (r32 & 15)) << 4));
#pragma unroll
    for (int s = 0; s < 4; ++s) vl[s] = (unsigned)(r32 * 128 + (((2 * s + hi) ^ ((r32 >> 1) & 7)) << 4));
}

template <int DK, int KP, bool LANEMASK, class F>
__device__ __forceinline__ void tile_compute(Flash& st, const LAS unsigned char* Kt, const LAS unsigned char* Vt, const bf16x8* qf, const f32x16& negm, const unsigned (&kl)[DK / 16], const unsigned (&vl)[4], bool mine, F f) {
    constexpr int NS = DK / 16; constexpr int KH = 32 * KP;
    bf16x8 ka[NS], kh[NS];
#pragma unroll
    for (int s = 0; s < NS; ++s) ka[s] = *(const LAS bf16x8*)(Kt + kl[s]);
#pragma unroll
    for (int s = 0; s < NS; ++s) kh[s] = *(const LAS bf16x8*)(Kt + kl[s] + KH);
    __builtin_amdgcn_sched_barrier(0);
    f32x16 p0, p1;
#pragma unroll
    for (int s = 0; s < NS; ++s) p0 = (s == 0) ? __builtin_amdgcn_mfma_f32_32x32x16_bf16(ka[0], qf[0], negm, 0, 0, 0) : __builtin_amdgcn_mfma_f32_32x32x16_bf16(ka[s], qf[s], p0, 0, 0, 0);
#pragma unroll
    for (int s = 0; s < NS; ++s) p1 = (s == 0) ? __builtin_amdgcn_mfma_f32_32x32x16_bf16(kh[0], qf[0], negm, 0, 0, 0) : __builtin_amdgcn_mfma_f32_32x32x16_bf16(kh[s], qf[s], p1, 0, 0, 0);
    bf16x8 va[4], vh[4];
#pragma unroll
    for (int s = 0; s < 4; ++s) { va[s] = *(const LAS bf16x8*)(Vt + vl[s]); vh[s] = *(const LAS bf16x8*)(Vt + vl[s] + 4096); }
    __builtin_amdgcn_sched_barrier(0);
    float ls = 0.f, ls1 = 0.f;
    u32x4 w0, w1, w2, w3;
    {
#pragma unroll
        for (int r = 0; r < 16; ++r) { float x = p0[r]; const bool v = f(r, 0, x); const float e = fexp2(x); p0[r] = v ? e : 0.f; ls += p0[r]; }
        w0.x = cvtpk(p0[0], p0[1]); w0.y = cvtpk(p0[2], p0[3]); w0.z = cvtpk(p0[4], p0[5]); w0.w = cvtpk(p0[6], p0[7]);
        w1.x = cvtpk(p0[8], p0[9]); w1.y = cvtpk(p0[10], p0[11]); w1.z = cvtpk(p0[12], p0[13]); w1.w = cvtpk(p0[14], p0[15]);
        if (LANEMASK) { w0.x = mine ? w0.x : 0u; w0.y = mine ? w0.y : 0u; w0.z = mine ? w0.z : 0u; w0.w = mine ? w0.w : 0u; w1.x = mine ? w1.x : 0u; w1.y = mine ? w1.y : 0u; w1.z = mine ? w1.z : 0u; w1.w = mine ? w1.w : 0u; }
    }
#pragma unroll
    for (int s = 0; s < 2; ++s) {
        const bf16x8 pa = __builtin_bit_cast(bf16x8, s ? w1 : w0);
        st.o0 = __builtin_amdgcn_mfma_f32_32x32x16_bf16(pa, va[s], st.o0, 0, 0, 0);
        st.o1 = __builtin_amdgcn_mfma_f32_32x32x16_bf16(pa, vh[s], st.o1, 0, 0, 0);
    }
    {
#pragma unroll
        for (int r = 0; r < 16; ++r) { float x = p1[r]; const bool v = f(r, 1, x); const float e = fexp2(x); p1[r] = v ? e : 0.f; ls1 += p1[r]; }
        w2.x = cvtpk(p1[0], p1[1]); w2.y = cvtpk(p1[2], p1[3]); w2.z = cvtpk(p1[4], p1[5]); w2.w = cvtpk(p1[6], p1[7]);
        w3.x = cvtpk(p1[8], p1[9]); w3.y = cvtpk(p1[10], p1[11]); w3.z = cvtpk(p1[12], p1[13]); w3.w = cvtpk(p1[14], p1[15]);
        if (LANEMASK) { w2.x = mine ? w2.x : 0u; w2.y = mine ? w2.y : 0u; w2.z = mine ? w2.z : 0u; w2.w = mine ? w2.w : 0u; w3.x = mine ? w3.x : 0u; w3.y = mine ? w3.y : 0u; w3.z = mine ? w3.z : 0u; w3.w = mine ? w3.w : 0u; }
    }
    ls += ls1;
    if (LANEMASK) ls = mine ? ls : 0.f;
    st.l += ls;
#pragma unroll
    for (int s = 2; s < 4; ++s) {
        const bf16x8 pa = __builtin_bit_cast(bf16x8, (s == 3) ? w3 : w2);
        st.o0 = __builtin_amdgcn_mfma_f32_32x32x16_bf16(pa, va[s], st.o0, 0, 0, 0);
        st.o1 = __builtin_amdgcn_mfma_f32_32x32x16_bf16(pa, vh[s], st.o1, 0, 0, 0);
    }
}
template <int DK, int KP> __device__ __forceinline__ void qk_tile(f32x16& p0, f32x16& p1, const LAS unsigned char* Kt, const bf16x8* qf, const f32x16& negm, const unsigned (&kl)[DK / 16]) {
#pragma unroll
    for (int s = 0; s < DK / 16; ++s) {
        const bf16x8 a0 = *(const LAS bf16x8*)(Kt + kl[s]);
        const bf16x8 a1 = *(const LAS bf16x8*)(Kt + kl[s] + 32 * KP);
        if (s == 0) { p0 = __builtin_amdgcn_mfma_f32_32x32x16_bf16(a0, qf[0], negm, 0, 0, 0); p1 = __builtin_amdgcn_mfma_f32_32x32x16_bf16(a1, qf[0], negm, 0, 0, 0); }
        else { p0 = __builtin_amdgcn_mfma_f32_32x32x16_bf16(a0, qf[s], p0, 0, 0, 0); p1 = __builtin_amdgcn_mfma_f32_32x32x16_bf16(a1, qf[s], p1, 0, 0, 0); }
    }
}
template <bool FIRST> __device__ __forceinline__ void flash_accum(LAS float* otl, const Flash& st, float gate, int hi, int lane) {
    const float lt = st.l + __shfl_xor(st.l, 32);
    const float f = lt > 0.f ? gate * frcp(lt) : 0.f;
#pragma unroll
    for (int r = 0; r < 16; ++r) { const float fr_ = __shfl(f, crow(r, hi));
        if (FIRST) { otl[r * 64 + lane] = fr_ * st.o0[r]; otl[(16 + r) * 64 + lane] = fr_ * st.o1[r]; }
        else { otl[r * 64 + lane] += fr_ * st.o0[r]; otl[(16 + r) * 64 + lane] += fr_ * st.o1[r]; } }
}
template <int NS> __device__ __forceinline__ float qnorm2(const bf16x8* qf) {
    float s = 0.f;
#pragma unroll
    for (int i = 0; i < NS; ++i)
#pragma unroll
        for (int j = 0; j < 8; ++j) { const float x = bf2f((bf16_t)qf[i][j]); s += x * x; }
    return s + __shfl_xor(s, 32);
}
__device__ __forceinline__ float wmax(float v) {
#pragma unroll
    for (int o = 1; o < 64; o <<= 1) v = fmaxf(v, __shfl_xor(v, o));
    return v;
}

struct NoComp {};
template <class T> struct is_nocomp { static constexpr bool v = false; };
template <> struct is_nocomp<NoComp> { static constexpr bool v = true; };
template <class C> __device__ __forceinline__ void rt_call(C& c, int t, LAS unsigned char* kb, LAS unsigned char* vb) { c(t, kb, vb); }
__device__ __forceinline__ void rt_call(NoComp&, int, LAS unsigned char*, LAS unsigned char*) {}
template <int RBK, bool HASV, int KOFF, int KSZ, int VOFF, class SrcK, class SrcV, class C0, class C1, class C2>
__device__ __forceinline__ void run_tiles(int n, int e0, int e1, int e2, LAS unsigned char* lds, int w, int lane, unsigned gsK, unsigned gsV, SrcK srcK, SrcV srcV, C0 c0, C1 c1, C2 c2) {
    DmaLane<RBK> LK; dma_setup<RBK>(LK, w, lane, gsK);
    DmaLane<128> LV; LV.g0 = 0; LV.g1 = 0; if (HASV) dma_setup<128>(LV, w, lane, gsV);
    const int nl = n - 1, t1 = nl < 1 ? nl : 1, t2 = nl < 2 ? nl : 2;
    e0 = __builtin_amdgcn_readfirstlane(e0); e1 = __builtin_amdgcn_readfirstlane(e1); e2 = __builtin_amdgcn_readfirstlane(e2);
    dma_issue<RBK>(srcK(0), LK, lds + KOFF, w); if (HASV) dma_issue<128>(srcV(0), LV, lds + VOFF, w);
    dma_issue<RBK>(srcK(t1), LK, lds + KOFF + KSZ, w); if (HASV) dma_issue<128>(srcV(t1), LV, lds + VOFF + 8192, w);
    dma_issue<RBK>(srcK(t2), LK, lds + KOFF + 2 * KSZ, w); if (HASV) dma_issue<128>(srcV(t2), LV, lds + VOFF + 2 * 8192, w);
    constexpr int P = (RBK == 128 ? 1 : 2) + (HASV ? 1 : 0);
    int t = 0, slot = 0;
#define RT_HEAD() do { \
        if (P == 1) asm volatile("s_waitcnt vmcnt(2)" ::: "memory"); else if (P == 2) asm volatile("s_waitcnt vmcnt(4)" ::: "memory"); else asm volatile("s_waitcnt vmcnt(6)" ::: "memory"); \
        __builtin_amdgcn_s_barrier(); asm volatile("" ::: "memory"); \
        { const int tn = (t + 3 < nl) ? t + 3 : nl; const int s2 = (slot + 3) & 3; \
          dma_issue<RBK>(srcK(tn), LK, lds + KOFF + s2 * KSZ, w); if (HASV) dma_issue<128>(srcV(tn), LV, lds + VOFF + s2 * 8192, w); } } while (0)
#define RT_SEG(cc, ee) if (!is_nocomp<decltype(cc)>::v) { _Pragma("unroll 1") for (; t < (ee); ++t) { RT_HEAD(); rt_call(cc, t, lds + KOFF + slot * KSZ, lds + VOFF + slot * 8192); slot = (slot + 1) & 3; } }
    RT_SEG(c0, e0)
    RT_SEG(c1, e1)
    RT_SEG(c2, e2)
#pragma unroll 1
    for (; t < n; ++t) { RT_HEAD(); slot = (slot + 1) & 3; }
#undef RT_SEG
#undef RT_HEAD
    asm volatile("s_waitcnt vmcnt(0)" ::: "memory");
    __syncthreads();
}

__device__ __forceinline__ void mla_unit(const Params& p, LAS unsigned char* lds, int b, int h, int qb) {
    int tid = threadIdx.x; asm volatile("" : "+v"(tid));
    const int lane = tid & 63, w = __builtin_amdgcn_readfirstlane(tid >> 6), r32 = lane & 31, hi = lane >> 5;
    const bf16_t* qm = (const bf16_t*)((const unsigned char*)p.out + O_QM);
    const unsigned char* km = (const unsigned char*)p.out + O_KM + (((size_t)b * 8 + h) * S) * 192;
    const unsigned char* vmt = (const unsigned char*)p.out + O_VMT + (((size_t)b * 8 + h) * 64) * (size_t)S * 2;
    bf16_t* ocat = (bf16_t*)(p.ws + R_XN);
    const int tq = qb * 256 + 32 * w + r32;
    bf16x8 qf[6];
#pragma unroll
    for (int s = 0; s < 6; ++s) qf[s] = *(const bf16x8*)(qm + (((size_t)b * S + tq) * 8 + h) * 96 + 16 * s + 8 * hi);
    const float kn = 9.797958971f * 1.01f * wmax(fmaxf(fabsf(p.in[14][lane]), lane < 32 ? fabsf(p.in[14][64 + lane]) : 0.f));
    const float mref = sqrtf(qnorm2<6>(qf)) * kn;
    f32x16 negm;
#pragma unroll
    for (int r = 0; r < 16; ++r) negm[r] = -mref;
    Flash st; flash_init(st);
    const int ntile = 4 * qb + 4, dt = 4 * qb + (w >> 1);
#ifdef PROF_SEL
    if (b == 0 && h == 0 && qb == 15 && threadIdx.x == 0) { *PROF_SLOT(36) -= __builtin_amdgcn_s_memtime(); *PROF_SLOT(37) -= __builtin_amdgcn_s_memrealtime(); }
#endif
    unsigned kl[6], vl[4]; frag_offsets<96>(kl, vl, r32, hi);
    run_tiles<192, true, AL_K96, 16384, AL_V96>(ntile, dt, dt + 1, dt + 1, lds, w, lane, 192u, (unsigned)(S * 2),
        [&](int i) { return km + (size_t)i * 64 * 192; }, [&](int i) { return vmt + (size_t)i * 128; },
        [&](int i, LAS unsigned char* kb, LAS unsigned char* vb) { tile_compute<96, 256, false>(st, kb, vb, qf, negm, kl, vl, true, [&](int r, int half, float& x) { return true; }); },
        [&](int i, LAS unsigned char* kb, LAS unsigned char* vb) { const int kb0 = 64 * i + 4 * hi; tile_compute<96, 256, false>(st, kb, vb, qf, negm, kl, vl, true, [&](int r, int half, float& x) { return (kb0 + 32 * half + (r & 3) + 8 * (r >> 2)) <= tq; }); },
        NoComp{});
#ifdef PROF_SEL
    if (b == 0 && h == 0 && qb == 15 && threadIdx.x == 0) { *PROF_SLOT(36) += __builtin_amdgcn_s_memtime(); *PROF_SLOT(37) += __builtin_amdgcn_s_memrealtime(); }
#endif
    {
        const float lt = st.l + __shfl_xor(st.l, 32); const float f = lt > 0.f ? frcp(lt) : 0.f;
#pragma unroll
        for (int r = 0; r < 16; ++r) { const float fr_ = __shfl(f, crow(r, hi)); const size_t ro = ((size_t)b * S + qb * 256 + 32 * w + crow(r, hi)) * 1024 + 512 + h * 64 + r32; ocat[ro] = f2bf(st.o0[r] * fr_); ocat[ro + 32] = f2bf(st.o1[r] * fr_); }
    }
}

__device__ __forceinline__ void nsa_unit(const Params& p, LAS unsigned char* lds, int b, int g, int jt) {
    int tid = threadIdx.x; asm volatile("" : "+v"(tid));
    const int lane = tid & 63, w = __builtin_amdgcn_readfirstlane(tid >> 6), r32 = lane & 31, hi = lane >> 5;
    const int rh = w >> 1, qh = w & 1, h = 4 * g + rh, q0 = 64 * jt, ql = 32 * qh + r32, tq = q0 + ql;
    const unsigned char* xa = p.ws + R_XA;
    const bf16_t* qn = (const bf16_t*)(xa + A_QN);
    const size_t bg = (size_t)b * 2 + g;
    const unsigned char* ksn = xa + A_KSN + bg * S * 128; const unsigned char* kwn = xa + A_KWN + bg * S * 128;
    const unsigned char* vst = xa + A_VST + bg * 64 * (size_t)S * 2; const unsigned char* vwt = xa + A_VWT + bg * 64 * (size_t)S * 2;
    const unsigned char* kc = p.ws + SM_KC + bg * 256 * 128; const unsigned char* vct = p.ws + SM_VCT + bg * 64 * 512;
    const float* gates = (const float*)(xa + A_GATES) + ((size_t)b * S + tq) * 24 + h * 3;
    bf16_t* ocat = (bf16_t*)(p.ws + R_XN);
    LAS float* imp = (LAS float*)(lds + AL_IMP); LAS unsigned char* selb = lds + AL_SELB; LAS unsigned* uni = (LAS unsigned*)(lds + AL_UNI); LAS unsigned char* tl = lds + AL_TL; LAS float* bls = (LAS float*)(lds + AL_BL);
    const float* blg = (const float*)(p.ws + SM_BL) + h * 132;
    const float cb = blg[128];
    const float bmax = wmax(fmaxf(fmaxf(blg[lane], blg[64 + lane]), cb));
    if (qh == 0) { bls[rh * 132 + lane] = blg[lane] - cb; bls[rh * 132 + 64 + lane] = blg[64 + lane] - cb; if (lane == 0) bls[rh * 132 + 128] = 0.f; }
    const LAS float* blh = bls + rh * 132;
    bf16x8 qf[4];
#pragma unroll
    for (int s = 0; s < 4; ++s) qf[s] = *(const bf16x8*)(qn + (((size_t)b * S + tq) * 8 + h) * 64 + 16 * s + 8 * hi);
    const float kn = 8.f * 1.01f * wmax(fmaxf(fmaxf(fabsf(p.in[5][lane]), fabsf(p.in[5][64 + lane])), fabsf(p.in[5][128 + lane])));
    const float mref = sqrtf(qnorm2<4>(qf)) * kn + bmax;
    f32x16 negm;
#pragma unroll
    for (int r = 0; r < 16; ++r) negm[r] = cb - mref;
    float g0 = gates[0], g1 = gates[1], g2 = gates[2];
    if (p.dbg_branch >= 0) { g0 = p.dbg_branch == 0 ? 1.f : 0.f; g1 = p.dbg_branch == 1 ? 1.f : 0.f; g2 = p.dbg_branch == 2 ? 1.f : 0.f; }
    LAS float* otl = (LAS float*)(lds + AL_OT) + w * 2048;
#ifdef PROF_SEL
    if (b == 0 && g == 0 && jt == 63 && threadIdx.x == 0) *PROF_SLOT(48) -= __builtin_amdgcn_s_memtime();
#endif
    const int nvmax = (q0 + 63 - 31) / 16 + 1, ntc = (nvmax + 63) / 64;
    Flash st; flash_init(st);
    unsigned kl[4], vl[4]; frag_offsets<64>(kl, vl, r32, hi);
    const int qb32 = q0 + 32 * qh;
    int ecf = 0;
    for (int i = 0; i < ntc; ++i) if (qb32 - (16 * (64 * i + 63) + 31) >= 128) ecf = i + 1;
    run_tiles<128, true, AL_K64, 8192, AL_V64>(ntc, ecf, ntc, ntc, lds, w, lane, 128u, 512u,
        [&](int i) { return kc + (size_t)i * 64 * 128; }, [&](int i) { return vct + (size_t)i * 128; },
        [&](int i, LAS unsigned char* kb, LAS unsigned char* vb) { tile_compute<64, 128, false>(st, kb, vb, qf, negm, kl, vl, true, [&](int r, int half, float& x) { return true; }); },
        [&](int i, LAS unsigned char* kb, LAS unsigned char* vb) {
            const int cb0 = 64 * i + 4 * hi;
            tile_compute<64, 128, false>(st, kb, vb, qf, negm, kl, vl, true, [&](int r, int half, float& x) {
                const int c = cb0 + 32 * half + (r & 3) + 8 * (r >> 2); const int dist = tq - 16 * c - 31; x += blh[dist < 0 ? 0 : (dist > 128 ? 128 : dist)]; return dist >= 0; });
        },
        NoComp{});
    flash_accum<true>(otl, st, g0, hi, lane);
    unsigned mlo, mhi;
    int nsel;
    if (jt < 16) { const unsigned long long mk = (1ull << (jt + 1)) - 1ull; mlo = (unsigned)mk; mhi = (unsigned)(mk >> 32); nsel = jt + 1; if (tid <= jt) tl[tid] = (unsigned char)tid; }
    else {
        for (int i = tid; i < 64 * 65; i += 512) imp[i] = 0.f;
        const float lt = st.l + __shfl_xor(st.l, 32); const float linv = lt > 0.f ? frcp(lt) : 0.f;
        float xlast = 0.f;
        run_tiles<128, false, AL_K64, 8192, AL_V64>(ntc, ntc, ntc, ntc, lds, w, lane, 128u, 0u,
            [&](int i) { return kc + (size_t)i * 64 * 128; }, [&](int i) { return kc; },
            [&](int i, LAS unsigned char* kb, LAS unsigned char* vb) {
                f32x16 p0, p1; qk_tile<64, 128>(p0, p1, kb, qf, negm, kl);
                const int cb0 = 64 * i + 4 * hi;
                float sm[2][4], cr[2][4];
#pragma unroll
                for (int half = 0; half < 2; ++half)
#pragma unroll
                    for (int a = 0; a < 4; ++a) {
                        float s4 = 0.f, last = 0.f;
#pragma unroll
                        for (int k = 0; k < 4; ++k) {
                            const int r = 4 * a + k; const int c = cb0 + 32 * half + k + 8 * a; const int dist = tq - 16 * c - 31;
                            const float sc = (half ? p1[r] : p0[r]) + blh[dist < 0 ? 0 : (dist > 128 ? 128 : dist)];
                            const float pv = dist >= 0 ? fexp2(sc) * linv : 0.f;
                            s4 += pv; last = pv;
                        }
                        sm[half][a] = s4; cr[half][a] = last;
                    }
                float tot[2][4];
#pragma unroll
                for (int half = 0; half < 2; ++half)
#pragma unroll
                    for (int a = 0; a < 4; ++a) {
                        const float xs_ = __shfl_xor(cr[half][a], 32);
                        const float xp_ = (a > 0) ? __shfl_xor(cr[half][a > 0 ? a - 1 : 0], 32) : (half ? __shfl_xor(cr[0][3], 32) : xlast);
                        tot[half][a] = sm[half][a] + (hi ? xs_ : xp_);
                    }
                xlast = __shfl_xor(cr[1][3], 32);
                for (int rr = 0; rr < 4; ++rr) {
                    if (rh == rr) {
#pragma unroll
                        for (int half = 0; half < 2; ++half)
#pragma unroll
                            for (int a = 0; a < 4; ++a) { const int j = 16 * i + 8 * half + 2 * a + hi; imp[ql * 65 + j] += tot[half][a]; }
                    }
                    __syncthreads();
                }
            }, NoComp{}, NoComp{});
        if (p.dbg_branch == 1) { for (int i = tid; i < 4096; i += 512) ((float*)(p.ws + R_H))[((size_t)g * S + q0 + (i >> 6)) * 64 + (i & 63)] = imp[(i >> 6) * 65 + (i & 63)]; }
        {
            const int q = tid >> 3, jg = tid & 7;
            float vj[8]; int rk[8];
#pragma unroll
            for (int jj = 0; jj < 8; ++jj) { const int j = jg * 8 + jj; const float x = imp[q * 65 + j]; vj[jj] = (j > jt) ? -1.f : ((j == jt || j == 0) ? 1e9f : x); rk[jj] = 0; }
#pragma unroll 4
            for (int i = 0; i < 64; ++i) {
                const float xi = imp[q * 65 + i]; const float vi = (i > jt) ? -1.f : ((i == jt || i == 0) ? 1e9f : xi);
#pragma unroll
                for (int jj = 0; jj < 8; ++jj) rk[jj] += (vi > vj[jj] || (vi == vj[jj] && i < jg * 8 + jj)) ? 1 : 0;
            }
            unsigned byte = 0;
#pragma unroll
            for (int jj = 0; jj < 8; ++jj) if (jg * 8 + jj <= jt && rk[jj] < 16) byte |= 1u << jj;
            selb[q * 8 + jg] = (unsigned char)byte;
        }
        __syncthreads();
        if (w == 0) {
            unsigned a = ((const LAS unsigned*)selb)[lane * 2], c = ((const LAS unsigned*)selb)[lane * 2 + 1];
#pragma unroll
            for (int o = 1; o < 64; o <<= 1) { a |= __shfl_xor(a, o); c |= __shfl_xor(c, o); }
            const unsigned long long um = ((unsigned long long)c << 32) | a;
            if ((um >> lane) & 1ull) tl[__builtin_popcountll(um & ((1ull << lane) - 1ull))] = (unsigned char)lane;
            if (lane == 0) uni[0] = (unsigned)__builtin_popcountll(um);
        }
        __syncthreads();
        mlo = ((const LAS unsigned*)selb)[ql * 2]; mhi = ((const LAS unsigned*)selb)[ql * 2 + 1];
        nsel = (int)uni[0];
    }
    if (p.dbg_branch == 1 && rh == 0) { if (hi == 0) ((unsigned long long*)(p.ws + R_H + 4 * 1048576))[(size_t)g * S + tq] = ((unsigned long long)mhi << 32) | mlo; }
    __syncthreads();
    {
        const unsigned long long mymask = ((unsigned long long)mhi << 32) | mlo;
        nsel = __builtin_amdgcn_readfirstlane(nsel);
        const int mytl = (int)tl[lane];
        flash_init(st);
        const int jfar = qb32 >= 191 ? (qb32 - 191) >> 6 : -1;
        const int nfar = (int)__builtin_popcountll(__ballot(lane < nsel && mytl <= jfar));
        run_tiles<128, true, AL_K64, 8192, AL_V64>(nsel, nfar, nsel, nsel, lds, w, lane, 128u, (unsigned)(S * 2),
            [&](int i) { return ksn + (size_t)__builtin_amdgcn_readlane(mytl, i) * 64 * 128; }, [&](int i) { return vst + (size_t)__builtin_amdgcn_readlane(mytl, i) * 128; },
            [&](int i, LAS unsigned char* kb, LAS unsigned char* vb) {
                const int j = __builtin_amdgcn_readlane(mytl, i);
                const bool mine = (mymask >> j) & 1ull;
                tile_compute<64, 128, true>(st, kb, vb, qf, negm, kl, vl, mine, [&](int r, int half, float& x) { return true; });
            },
            [&](int i, LAS unsigned char* kb, LAS unsigned char* vb) {
                const int j = __builtin_amdgcn_readlane(mytl, i);
                const bool mine = (mymask >> j) & 1ull;
                const int kb0 = 64 * j + 4 * hi;
                tile_compute<64, 128, true>(st, kb, vb, qf, negm, kl, vl, mine, [&](int r, int half, float& x) { const int dist = tq - (kb0 + 32 * half + (r & 3) + 8 * (r >> 2)); x += blh[dist < 0 ? 0 : (dist > 128 ? 128 : dist)]; return dist >= 0; });
            },
            NoComp{});
        flash_accum<false>(otl, st, g1, hi, lane);
    }
    {
        const int j0 = jt >= 8 ? jt - 8 : 0, nw = jt - j0 + 1;
        flash_init(st);
        const int jfar = qb32 >= 191 ? (qb32 - 191) >> 6 : -1, jin = qb32 >= 481 ? ((qb32 - 481) >> 6) + 1 : 0;
        int ew0 = jin - j0; ew0 = ew0 < 0 ? 0 : (ew0 > nw ? nw : ew0);
        int ew1 = jfar + 1 - j0; ew1 = ew1 < ew0 ? ew0 : (ew1 > nw ? nw : ew1);
        auto wedge = [&](int i, LAS unsigned char* kb, LAS unsigned char* vb) {
            const int j = j0 + i, kb0 = 64 * j + 4 * hi;
            tile_compute<64, 128, false>(st, kb, vb, qf, negm, kl, vl, true, [&](int r, int half, float& x) { const int dist = tq - (kb0 + 32 * half + (r & 3) + 8 * (r >> 2)); x += blh[dist < 0 ? 0 : (dist > 128 ? 128 : dist)]; return dist >= 0 && dist < 512; });
        };
        run_tiles<128, true, AL_K64, 8192, AL_V64>(nw, ew0, ew1, nw, lds, w, lane, 128u, (unsigned)(S * 2),
            [&](int i) { return kwn + (size_t)(j0 + i) * 64 * 128; }, [&](int i) { return vwt + (size_t)(j0 + i) * 128; },
            wedge,
            [&](int i, LAS unsigned char* kb, LAS unsigned char* vb) { tile_compute<64, 128, false>(st, kb, vb, qf, negm, kl, vl, true, [&](int r, int half, float& x) { return true; }); },
            wedge);
        flash_accum<false>(otl, st, g2, hi, lane);
    }
#pragma unroll
    for (int r = 0; r < 16; ++r) { const size_t ro = ((size_t)b * S + q0 + 32 * qh + crow(r, hi)) * 1024 + h * 64 + r32; ocat[ro] = f2bf(otl[r * 64 + lane]); ocat[ro + 32] = f2bf(otl[(16 + r) * 64 + lane]); }
    __syncthreads();
#ifdef PROF_SEL
    if (b == 0 && g == 0 && jt == 63 && threadIdx.x == 0) *PROF_SLOT(48) += __builtin_amdgcn_s_memtime();
#endif
}

__device__ __forceinline__ void phase_p4(const Params& p, LAS unsigned char* lds) {
    const int G = gridDim.x, c = blockIdx.x, nunits = 256 * NB;
#if NB == 8
    if (G == 256) {
        const int b = c & 7, idx = c >> 3, pi = idx & 7, hq = idx >> 3;
#pragma unroll 1
        for (int u = 0; u < 8; ++u) {
            if (u == (idx & 7)) { convert_weights(p, lds, WD_EARLY, 14); __syncthreads(); }
            if (u < 4) { const int ix = (u >> 1) ? ((idx + 16) & 31) : idx;
                nsa_unit(p, lds, b, u >> 1, (u & 1) ? ix : 63 - ix); }
            else mla_unit(p, lds, b, ((u - 4) >> 1) * 4 + hq, (u & 1) ? pi : 15 - pi);
        }
        return;
    }
#endif
    convert_weights(p, lds, WD_EARLY, 14); __syncthreads();
    for (int j = 0;; ++j) {
        const int k = j * G + ((j & 1) ? (G - 1 - c) : c);
        if (j * G >= nunits) break;
        if (k >= nunits) continue;
        const int ty = UNIT_TYPES[k / NB], b = k % NB, kind = ty >> 9, a = (ty >> 6) & 7, cc = ty & 63;
        if (kind == 0) nsa_unit(p, lds, b, a, cc); else mla_unit(p, lds, b, a, cc);
    }
}
__device__ __forceinline__ void phase_norm(const float* x, const float* g, bf16_t* xn) {
    const int tid_ = ltid(); const int lane = tid_ & 63, gw = blockIdx.x * 8 + (tid_ >> 6), NGW = gridDim.x * 8;
    for (int m = gw; m < T; m += NGW) rms_row_to_bf16(x + (size_t)m * D, g, xn + (size_t)m * D, lane);
}
__device__ __forceinline__ void phase_conv(const Params& p) {
    const int tid = ltid(), lane = tid & 63, gw = blockIdx.x * 8 + (tid >> 6), NGW = gridDim.x * 8;
    const bf16_t* bg = (const bf16_t*)(p.ws + R_H); const bf16_t* cu = (const bf16_t*)(p.ws + R_H + (size_t)T * 2048); bf16_t* v = (bf16_t*)(p.ws + R_XA); const float* cw = p.in[22];
    constexpr int RUN = 16;
    float w0[2][8], w1[2][8], w2[2][8];
#pragma unroll
    for (int j = 0; j < 2; ++j) { const int d = 8 * lane + 512 * j; load8f(cw + d, w0[j], 1.f); load8f(cw + 1024 + d, w1[j], 1.f); load8f(cw + 2048 + d, w2[j], 1.f); }
    for (int run = gw; run < T / RUN; run += NGW) {
        const int m0 = run * RUN, s0 = m0 & (S - 1);
        float pm2[2][8], pm1[2][8];
#pragma unroll
        for (int j = 0; j < 2; ++j) { const int d = 8 * lane + 512 * j;
#pragma unroll
            for (int q = 0; q < 2; ++q) {
                float (&dst)[8] = q ? pm1[j] : pm2[j];
                if (s0 - 2 + q >= 0) unpack8(*(const u32x4*)(cu + (size_t)(m0 - 2 + q) * 1024 + d), dst);
                else {
#pragma unroll
                    for (int i = 0; i < 8; ++i) dst[i] = 0.f; }
            } }
#pragma unroll 4
        for (int rr = 0; rr < RUN; ++rr) {
            const int m = m0 + rr;
#pragma unroll
            for (int j = 0; j < 2; ++j) { const int d = 8 * lane + 512 * j;
                float b[8], c[8], y[8]; unpack8(*(const u32x4*)(bg + (size_t)m * 1024 + d), b); unpack8(*(const u32x4*)(cu + (size_t)m * 1024 + d), c);
#pragma unroll
                for (int i = 0; i < 8; ++i) { y[i] = b[i] * (w0[j][i] * pm2[j][i] + w1[j][i] * pm1[j][i] + w2[j][i] * c[i]); pm2[j][i] = pm1[j][i]; pm1[j][i] = c[i]; }
                *(u32x4*)(v + (size_t)m * 1024 + d) = pack8(y); }
        }
    }
}
__device__ __forceinline__ void phase_norm_router(const Params& p, LAS unsigned char* lds) {
    const int tid = ltid(), lane = tid & 63, wave = tid >> 6, gw = blockIdx.x * 8 + wave, NGW = gridDim.x * 8;
    const bf16_t* x3 = (const bf16_t*)(p.ws + R_XN); const float* g = p.in[24]; bf16_t* xn = (bf16_t*)p.out;
    LAS float* wr = (LAS float*)lds;
    LAS int* lcnt = (LAS int*)(lds + 40960); LAS int* gb = lcnt + 8;
    int* te = (int*)(p.ws + SM_TE); float* tw = (float*)(p.ws + SM_TW); int* rank = (int*)(p.ws + SM_RANK); int* cnt = (int*)(p.ws + SM_CTL);
    for (int i = tid; i < 8192; i += 512) { const int dd = i >> 3; wr[dd * 8 + (dd >> 2) * 4 + (i & 7)] = p.in[25][i]; }
    if (tid < 8) lcnt[tid] = 0;
    __syncthreads();
    u32x2 nx[4];
#pragma unroll
    for (int j = 0; j < 4; ++j) nx[j] = ((const u32x2*)(x3 + (size_t)(gw < T ? gw : 0) * D) + lane)[64 * j];
    for (int m = gw; m < T; m += NGW) {
        const f32x4* gr = (const f32x4*)g + lane;
        f32x4 v[4]; float s = 0.f;
#pragma unroll
        for (int j = 0; j < 4; ++j) { const u32x2 t = nx[j]; v[j] = (f32x4){bflo(t.x), bfhi(t.x), bflo(t.y), bfhi(t.y)}; s += (v[j].x * v[j].x + v[j].y * v[j].y) + (v[j].z * v[j].z + v[j].w * v[j].w); }
        { const int mn = m + NGW < T ? m + NGW : m;
#pragma unroll
            for (int j = 0; j < 4; ++j) nx[j] = ((const u32x2*)(x3 + (size_t)mn * D) + lane)[64 * j]; }
        const float r = rsqrtf(wsum(s) * (1.f / 1024.f) + EPS);
        float lg[8];
#pragma unroll
        for (int e = 0; e < 8; ++e) lg[e] = 0.f;
        u32x2* o8 = (u32x2*)(xn + (size_t)m * D) + lane;
#pragma unroll
        for (int j = 0; j < 4; ++j) { const f32x4 gg = gr[64 * j]; const f32x4 y = {v[j].x * r * gg.x, v[j].y * r * gg.y, v[j].z * r * gg.z, v[j].w * r * gg.w};
            u32x2 w; w.x = cvtpk(y.x, y.y); w.y = cvtpk(y.z, y.w); o8[64 * j] = w;
#pragma unroll
            for (int i = 0; i < 4; ++i) { const int d = 4 * lane + 256 * j + i; const f32x4 w0 = *(const LAS f32x4*)(wr + d * 8 + (d >> 2) * 4), w1 = *(const LAS f32x4*)(wr + d * 8 + (d >> 2) * 4 + 4);
                lg[0] += y[i] * w0.x; lg[1] += y[i] * w0.y; lg[2] += y[i] * w0.z; lg[3] += y[i] * w0.w; lg[4] += y[i] * w1.x; lg[5] += y[i] * w1.y; lg[6] += y[i] * w1.z; lg[7] += y[i] * w1.w; } }
#pragma unroll
        for (int e = 0; e < 8; ++e) lg[e] = wsum(lg[e]) + p.in[26][e];
        int e1 = 0; float l1 = lg[0];
#pragma unroll
        for (int e = 1; e < 8; ++e) if (lg[e] > l1) { l1 = lg[e]; e1 = e; }
        int e2 = -1; float l2 = -3e38f;
#pragma unroll
        for (int e = 0; e < 8; ++e) if (e != e1 && lg[e] > l2) { l2 = lg[e]; e2 = e; }
        if (lane == 0) {
            const float w1 = 1.f / (1.f + __expf(l2 - l1));
            te[m * 2] = e1; te[m * 2 + 1] = e2; tw[m * 2] = w1; tw[m * 2 + 1] = 1.f - w1;
            rank[m * 2] = __hip_atomic_fetch_add(&lcnt[e1], 1, __ATOMIC_RELAXED, __HIP_MEMORY_SCOPE_WORKGROUP); rank[m * 2 + 1] = __hip_atomic_fetch_add(&lcnt[e2], 1, __ATOMIC_RELAXED, __HIP_MEMORY_SCOPE_WORKGROUP);
        }
    }
    __syncthreads();
    if (tid < 8) gb[tid] = atomicAdd(&cnt[tid], lcnt[tid]);
    __syncthreads();
    for (int m = gw; m < T; m += NGW) if (lane < 2) rank[m * 2 + lane] += gb[te[m * 2 + lane]];
}
__device__ __forceinline__ void phase_moe_gather(const Params& p) {
    const int tid = ltid(), lane = tid & 63, gw = blockIdx.x * 8 + (tid >> 6), NGW = gridDim.x * 8;
    const int* cnt = (const int*)(p.ws + SM_CTL); const int* te = (const int*)(p.ws + SM_TE); const float* tw = (const float*)(p.ws + SM_TW); const int* rank = (const int*)(p.ws + SM_RANK);
    int* pos = (int*)(p.ws + SM_POS); float* roww = (float*)(p.ws + SM_ROWW); int* tile_e = (int*)(p.ws + SM_TILEE);
    int* rowtok = (int*)(p.ws + SM_ROWTOK);
    int off[9]; off[0] = 0;
#pragma unroll
    for (int e = 0; e < 8; ++e) off[e + 1] = off[e] + ((cnt[e] + 255) & ~255);
    if (blockIdx.x == 0) {
        for (int i = tid; i < ROWS_MAX / 256; i += 512) { int e = -1;
#pragma unroll
            for (int k = 0; k < 8; ++k) if (i * 256 >= off[k] && i * 256 < off[k + 1]) e = k;
            tile_e[i] = e < 0 ? 0 : e; }
        if (tid == 0) ((int*)(p.ws + SM_CTL))[8] = off[8];
    }
    if (blockIdx.x < 8 && tid < 256) {
#pragma unroll
        for (int e = 0; e < 8; ++e) if (e == (int)blockIdx.x) { const int c = cnt[e]; if (c + tid < off[e + 1] - off[e]) { roww[off[e] + c + tid] = 0.f; rowtok[off[e] + c + tid] = -1; } }
    }
    for (int pi0 = gw * 4; pi0 < 2 * T; pi0 += NGW * 4) {
        int r[4]; float w[4];
#pragma unroll
        for (int q = 0; q < 4; ++q) { const int e = te[pi0 + q]; int o = 0;
#pragma unroll
            for (int k = 0; k < 8; ++k) if (k == e) o = off[k];
            r[q] = o + rank[pi0 + q]; w[q] = tw[pi0 + q]; }
#pragma unroll
        for (int q = 0; q < 4; ++q) if (lane == q) { pos[pi0 + q] = r[q]; roww[r[q]] = w[q]; rowtok[r[q]] = (pi0 + q) >> 1; }
    }
}
__device__ __forceinline__ void phase_moe_combine(const Params& p) {
    const int tid_ = ltid(); const int lane = tid_ & 63, gw = blockIdx.x * 8 + (tid_ >> 6), NGW = gridDim.x * 8;
    const int* pos = (const int*)(p.ws + SM_POS); const bf16_t* ym = (const bf16_t*)(p.ws + R_XA); const bf16_t* x3 = (const bf16_t*)(p.ws + R_XN);
    for (int m0 = gw * 2; m0 < T; m0 += NGW * 2) {
        int ps[4];
#pragma unroll
        for (int q = 0; q < 4; ++q) ps[q] = pos[m0 * 2 + q];
        f32x4 x[2][4]; u32x2 ya[2][4], yc[2][4];
#pragma unroll
        for (int q = 0; q < 2; ++q)
#pragma unroll
            for (int j = 0; j < 4; ++j) { const int d = 4 * lane + 256 * j;
                { const u32x2 t = *(const u32x2*)(x3 + (size_t)(m0 + q) * D + d); x[q][j] = (f32x4){bflo(t.x), bfhi(t.x), bflo(t.y), bfhi(t.y)}; } ya[q][j] = *(const u32x2*)(ym + (size_t)ps[2 * q] * D + d); yc[q][j] = *(const u32x2*)(ym + (size_t)ps[2 * q + 1] * D + d); }
#pragma unroll
        for (int q = 0; q < 2; ++q)
#pragma unroll
            for (int j = 0; j < 4; ++j) { const int d = 4 * lane + 256 * j; f32x4 o = x[q][j]; const u32x2 a = ya[q][j], c = yc[q][j];
                o.x += bflo(a.x) + bflo(c.x); o.y += bfhi(a.x) + bfhi(c.x); o.z += bflo(a.y) + bflo(c.y); o.w += bfhi(a.y) + bfhi(c.y);
                *(f32x4*)(p.out + (size_t)(m0 + q) * D + d) = o; }
    }
}

#define XB_TMO      128
#define XB_XCNT(j)  (256  + 64 * (j))
#define XB_XSUB(j)  (1280 + 64 * (j))
#define XB_XGEN(j)  (2304 + 64 * (j))
#define XB_TOP      3328
#define XB_TOPGEN   3392
#define XCD_BAR_WORDS 3456
#define XB_SPIN_CAP (1u << 18)

__device__ __forceinline__ unsigned xb_ld(unsigned* p)              { return __hip_atomic_load(p, __ATOMIC_RELAXED, __HIP_MEMORY_SCOPE_AGENT); }
__device__ __forceinline__ unsigned xb_add(unsigned* p, unsigned v) { return __hip_atomic_fetch_add(p, v, __ATOMIC_RELAXED, __HIP_MEMORY_SCOPE_AGENT); }
__device__ __forceinline__ unsigned xb_xcc_id() { return (unsigned)__builtin_amdgcn_s_getreg((3 << 11) | 20) & 0xFu; }
#define XB_SPIN(cond, bar) do { unsigned _sp = 0; while (cond) { __builtin_amdgcn_s_sleep(1); \
    if ((++_sp & 255u) == 0u) { if (xb_ld(&(bar)[XB_TMO])) break; if (_sp > XB_SPIN_CAP) { atomicAdd(&(bar)[XB_TMO], 1u); break; } } } } while (0)

struct XcdBarrier {
    unsigned* bar; unsigned x;
    volatile LAS unsigned* st;
};

__device__ __forceinline__ XcdBarrier xcd_barrier_post(unsigned* bar, volatile LAS unsigned* st) {
    XcdBarrier b; b.bar = bar; b.x = xb_xcc_id(); b.st = st;
    if (threadIdx.x == 0) (void)xb_add(&bar[XB_XCNT(b.x)], 1u);
    return b;
}
__device__ __forceinline__ void xcd_barrier_complete(unsigned* bar, unsigned x, unsigned& nloc, unsigned& nx) {
    const unsigned G = gridDim.x * gridDim.y * gridDim.z;
    unsigned sum, cnt, mine, sp = 0u;
    for (;;) {
        sum = 0u; cnt = 0u; mine = 0u;
#pragma unroll
        for (unsigned j = 0; j < 16; ++j) { const unsigned c = xb_ld(&bar[XB_XCNT(j)]); sum += c; cnt += (c > 0u) ? 1u : 0u; mine = (j == x) ? c : mine; }
        if (sum == G) break;
        __builtin_amdgcn_s_sleep(1);
        if ((++sp & 255u) == 0u) { if (xb_ld(&bar[XB_TMO])) break; if (sp > XB_SPIN_CAP) { atomicAdd(&bar[XB_TMO], 1u); break; } }
    }
    nloc = mine > 0u ? mine : 1u; nx = cnt > 0u ? cnt : 1u;
}

__device__ __forceinline__ void xcd_barrier(const XcdBarrier& b) {
    asm volatile("s_waitcnt vmcnt(0)" ::: "memory");
    __syncthreads();
    if (threadIdx.x == 0) {
        unsigned* bar = b.bar;
        __builtin_amdgcn_s_waitcnt(0);
        unsigned nloc = b.st[0], nx = b.st[1];
        if (nloc == 0u) { xcd_barrier_complete(bar, b.x, nloc, nx); b.st[0] = nloc; b.st[1] = nx; }
        const unsigned old = xb_add(&bar[XB_XSUB(b.x)], 1u);
        const unsigned gen = old / nloc;
        if (old + 1u == (gen + 1u) * nloc) {
            __builtin_amdgcn_fence(__ATOMIC_RELEASE, "agent");
            asm volatile("s_waitcnt vmcnt(0)" ::: "memory");
            const unsigned og = xb_add(&bar[XB_TOP], 1u);
            const unsigned tg = og / nx;
            if (og + 1u == (tg + 1u) * nx) xb_add(&bar[XB_TOPGEN], 1u);
            else XB_SPIN(xb_ld(&bar[XB_TOPGEN]) == tg, bar);
            __builtin_amdgcn_fence(__ATOMIC_ACQUIRE, "agent");
            xb_add(&bar[XB_XGEN(b.x)], 1u);
            asm volatile("s_waitcnt vmcnt(0)" ::: "memory");
        } else {
            XB_SPIN(xb_ld(&bar[XB_XGEN(b.x)]) == gen, bar);
            __builtin_amdgcn_fence(__ATOMIC_ACQUIRE, "agent");
            asm volatile("s_waitcnt vmcnt(0)" ::: "memory");
        }
    }
    __syncthreads();
}


__global__ void __launch_bounds__(512) mega_fwd(Params p) {
    extern __shared__ __attribute__((aligned(16))) unsigned char lds_raw[];
    LAS unsigned char* lds = (LAS unsigned char*)lds_raw;
    cg::grid_group grid = cg::this_grid();
    volatile LAS unsigned* bst = (volatile LAS unsigned*)(lds + 163328);
    if (threadIdx.x == 0) { bst[0] = 0u; bst[1] = 0u; const unsigned long long ba = (unsigned long long)(p.ws + SM_BAR); bst[2] = (unsigned)ba; bst[3] = (unsigned)(ba >> 32); }
    __syncthreads();
    (void)xcd_barrier_post((unsigned*)(p.ws + SM_BAR), bst);
#ifdef PROF_SEL
#define PSTAMP(k) do { if (blockIdx.x == 0 && threadIdx.x == 0) { volatile LAS unsigned* pl_ = (volatile LAS unsigned*)(lds + 163328 + 16); const unsigned long long now_ = __builtin_amdgcn_s_memrealtime(); const unsigned long long last_ = ((unsigned long long)pl_[1] << 32) | pl_[0]; *PROF_SLOT(k) += now_ - last_; pl_[0] = (unsigned)now_; pl_[1] = (unsigned)(now_ >> 32); } } while (0)
#else
#define PSTAMP(k)
#endif
#define GSYNC() do { XcdBarrier xb_; volatile LAS unsigned* st_ = (volatile LAS unsigned*)(lds + 163328); xb_.bar = (unsigned*)(((unsigned long long)st_[3] << 32) | st_[2]); xb_.x = xb_xcc_id(); xb_.st = st_; xcd_barrier(xb_); } while (0)
#ifdef PROF_SEL
    if (threadIdx.x == 0) { volatile LAS unsigned* pl_ = (volatile LAS unsigned*)(lds + 163328 + 16); const unsigned long long now_ = __builtin_amdgcn_s_memrealtime(); pl_[0] = (unsigned)now_; pl_[1] = (unsigned)(now_ >> 32); }
#endif
    const int G = gridDim.x, c = blockIdx.x;
#define LP() bf16_t* W = (bf16_t*)p.ws; bf16_t* xn = (bf16_t*)(p.ws + R_XN); float* x1 = (float*)(p.ws + R_XA); pg8::StaticOrder SO; (void)W; (void)xn; (void)x1; (void)SO
#ifndef PHMASK
#define PHMASK 0xFFFFFFFFu
#endif
#ifndef REPEAT_MASK
#define REPEAT_MASK 0u
#endif
#define PH(k) if (((PHMASK >> (k)) & 1u) && (k) >= p.ph_lo && (k) <= p.ph_hi)
#define RPT(k) if ((REPEAT_MASK >> (k)) & 1u)
    PH(0) { LP(); phase_p0(p, lds); }
    GSYNC(); PSTAMP(0);
    if (p.ph_lo == -12345) grid.sync();
    RPT(0) { { LP(); phase_p0(p, lds); } GSYNC(); }
    PH(1) { LP();
        pg8::Gemm g{xn, W + W_IN_E / 2, T, 1792, 1024, 1024, nullptr, 0, nullptr}; SO.init(T, 1792, G, c);
        pg8::EpiBf16<0> E{(bf16_t*)(p.ws + R_H), 1792, nullptr, nullptr};
        pg8::gemm_phase<pg8::EpiBf16<0>, true>(lds, g, SO, E);
    }
    GSYNC(); PSTAMP(1);
    PH(2) { LP(); phase_p2(p, lds); }
    GSYNC(); PSTAMP(2);
    RPT(2) { { LP(); phase_p2(p, lds); } GSYNC(); }
    PH(3) { LP();
        const int nCu = 2 * (NB * 512 / 256) * 2, Gc = (nCu < G / 2) ? nCu : 0;
        if (Gc == 0 || c < Gc) {
            for (int kv = 0; kv < 2; ++kv) {
                pg8::Gemm g{(const bf16_t*)(p.ws + R_XA + (kv ? A_VCIN : A_KCIN)), W + W_CW1 / 2 + (size_t)kv * 512 * 1024, NB * 512, 512, 1024, 1024, nullptr, 0, nullptr};
                if (Gc) SO.init(NB * 512, 512, Gc / 2, c - kv * (Gc / 2)); else SO.init(NB * 512, 512, G, c);
                pg8::EpiBf16<0> E{(bf16_t*)(p.ws + SM_HID) + (size_t)kv * NB * 512 * 512, 512, nullptr, nullptr};
                if (Gc == 0 || (c / (Gc / 2)) == kv) pg8::gemm_phase<pg8::EpiBf16<0>, true>(lds, g, SO, E);
            }
        }
        if (Gc == 0 || c >= Gc) {
            {
                pg8::Gemm g{(const bf16_t*)(p.ws + R_XA + A_CQN), W + W_UQ / 2, T, 1024, 256, 256, nullptr, 0, nullptr}; SO.init(T, 1024, G - Gc, c - Gc);
                pg8::EpiBf16<0> E{(bf16_t*)(p.ws + R_H), 1024, nullptr, nullptr};
                pg8::gemm_phase<pg8::EpiBf16<0>, true>(lds, g, SO, E);
            }
            {
                pg8::Gemm g{(const bf16_t*)(p.ws + R_XA + A_CKVN), W + W_UKV / 2, T, 1024, 128, 128, nullptr, 0, nullptr}; SO.init(T, 1024, G - Gc, c - Gc);
                pg8::EpiBf16<0> E{(bf16_t*)(p.ws + R_H + (size_t)T * 2048), 1024, nullptr, nullptr};
                pg8::gemm_phase<pg8::EpiBf16<0>, true>(lds, g, SO, E);
            }
        }
    }
    GSYNC(); PSTAMP(3);
    PH(4) { LP(); phase_p3b(p, lds); }
    GSYNC(); PSTAMP(4);
    RPT(4) { { LP(); phase_p3b(p, lds); } GSYNC(); }
    PH(5) { LP(); phase_p4(p, lds); }
    GSYNC(); PSTAMP(5);
    RPT(5) { { LP(); phase_p4(p, lds); } GSYNC(); }
    PH(6) { LP();
        pg8::Gemm g{xn, W + W_OUT_E / 2, T, 1024, 1024, 1024, nullptr, 0, nullptr}; SO.init(T, 1024, G, c);
        pg8::EpiResStat<false> E{p.in[0], (bf16_t*)p.out, (float*)(p.ws + SM_SSP1), 1024};
        pg8::gemm_phase<pg8::EpiResStat<false>, true>(lds, g, SO, E);
    }
    GSYNC(); PSTAMP(6);
    PH(7) { }
    PH(8) { LP();
        pg8::Gemm g{(const bf16_t*)p.out, W + W_GU / 2, T, 5632, 1024, 1024, nullptr, 0, nullptr}; SO.init(T, 5632, G, c);
        pg8::EpiSwiGLU E{(bf16_t*)(p.ws + R_H), 2816, (const float*)(p.ws + SM_SSP1)};
        pg8::gemm_phase<pg8::EpiSwiGLU, true>(lds, g, SO, E);
    }
    GSYNC(); PSTAMP(8);
    PH(9) { LP();
        pg8::Gemm g{(const bf16_t*)(p.ws + R_H), W + W_D / 2, T, 1024, 2816, 2816, nullptr, 0, nullptr}; SO.init(T, 1024, G, c);
        pg8::EpiResStat<true> E{(const bf16_t*)p.out, xn, (float*)(p.ws + SM_SSP2), 1024};
        pg8::gemm_phase<pg8::EpiResStat<true>, true>(lds, g, SO, E);
    }
    GSYNC(); PSTAMP(9);
    PH(10) { }
    PH(11) { LP();
        pg8::Gemm g{xn, W + W_IN_O / 2, T, 3072, 1024, 1024, nullptr, 0, nullptr}; SO.init(T, 3072, G, c);
        pg8::EpiConvIn E{(bf16_t*)(p.ws + R_H), (bf16_t*)(p.ws + R_H + (size_t)T * 2048), (const float*)(p.ws + SM_SSP2)};
        pg8::gemm_phase<pg8::EpiConvIn, true>(lds, g, SO, E);
    }
    GSYNC(); PSTAMP(11);
    PH(12) { LP(); phase_conv(p); }
    GSYNC(); PSTAMP(12);
    RPT(12) { { LP(); phase_conv(p); } GSYNC(); }
    PH(13) { LP();
        pg8::Gemm g{(const bf16_t*)x1, W + W_OUT_O / 2, T, 1024, 1024, 1024, nullptr, 0, nullptr}; SO.init(T, 1024, G, c);
        pg8::EpiResBf16B E{xn, xn, 1024};
        pg8::gemm_phase<pg8::EpiResBf16B, true>(lds, g, SO, E);
    }
    GSYNC(); PSTAMP(13);
    PH(14) { LP(); phase_norm_router(p, lds); }
    GSYNC(); PSTAMP(14);
    PH(15) { LP(); phase_moe_gather(p); }
    GSYNC(); PSTAMP(15);
    PH(16) { LP();
        pg8::Gemm g{(const bf16_t*)p.out, W + W_MGU / 2, 2 * T, 2816, 1024, 1024, (const int*)(p.ws + SM_TILEE), (size_t)2816 * 1024, (const int*)(p.ws + SM_ROWTOK)}; SO.init(2 * T, 2816, G, c);
        pg8::EpiSwiGLU E{(bf16_t*)(p.ws + R_H), 1408, nullptr};
        pg8::gemm_phase<pg8::EpiSwiGLU, true, true>(lds, g, SO, E);
    }
    GSYNC(); PSTAMP(16);
    PH(17) { LP(); const int mrows = ((const int*)(p.ws + SM_CTL))[8]; const int nx = mrows / 256 - 2 * T / 256;
        unsigned* dep = (unsigned*)(p.ws + SM_BAR) + 3584;
        const int nprod = 11 * nx < G ? 11 * nx : G, ncons = 4 * nx < G ? 4 * nx : G;
        if (c < nprod) {
            pg8::Gemm g{(const bf16_t*)p.out, W + W_MGU / 2, 256 * nx, 2816, 1024, 1024, (const int*)(p.ws + SM_TILEE) + 2 * T / 256, (size_t)2816 * 1024, (const int*)(p.ws + SM_ROWTOK) + 2 * T}; SO.init(256 * nx, 2816, G, c);
            pg8::EpiSwiGLU E{(bf16_t*)(p.ws + R_H) + (size_t)2 * T * 1408, 1408, nullptr};
            pg8::gemm_phase<pg8::EpiSwiGLU, true, true>(lds, g, SO, E);
            asm volatile("s_waitcnt vmcnt(0)" ::: "memory");
            __syncthreads();
            if (threadIdx.x == 0) { __builtin_amdgcn_fence(__ATOMIC_RELEASE, "agent"); asm volatile("s_waitcnt vmcnt(0)" ::: "memory"); (void)xb_add(dep, 1u); }
        }
        {
            pg8::Gemm g{(const bf16_t*)(p.ws + R_H), W + W_MD / 2, 2 * T, 1024, 1408, 1408, (const int*)(p.ws + SM_TILEE), (size_t)1024 * 1408, nullptr}; SO.init(2 * T, 1024, G, c);
            pg8::EpiRowScaleBf16 E{(bf16_t*)(p.ws + R_XA), 1024, (const float*)(p.ws + SM_ROWW)};
            pg8::gemm_phase<pg8::EpiRowScaleBf16, true>(lds, g, SO, E);
        }
        if (G - 1 - c < ncons) {
            if (threadIdx.x == 0) { unsigned* bar = (unsigned*)(p.ws + SM_BAR); XB_SPIN(xb_ld(dep) < (unsigned)nprod, bar); __builtin_amdgcn_fence(__ATOMIC_ACQUIRE, "agent"); asm volatile("s_waitcnt vmcnt(0)" ::: "memory"); }
            __syncthreads();
            pg8::Gemm g{(const bf16_t*)(p.ws + R_H) + (size_t)2 * T * 1408, W + W_MD / 2, 256 * nx, 1024, 1408, 1408, (const int*)(p.ws + SM_TILEE) + 2 * T / 256, (size_t)1024 * 1408, nullptr}; SO.init(256 * nx, 1024, G, G - 1 - c);
            pg8::EpiRowScaleBf16 E{(bf16_t*)(p.ws + R_XA) + (size_t)2 * T * 1024, 1024, (const float*)(p.ws + SM_ROWW) + 2 * T};
            pg8::gemm_phase<pg8::EpiRowScaleBf16, true>(lds, g, SO, E);
        }
    }
    GSYNC(); PSTAMP(17);
    PH(18) { LP(); phase_moe_combine(p); }
#ifdef PROF_SEL
    GSYNC(); PSTAMP(18);
    GSYNC();
    {
        unsigned long long v_ = *PROF_SLOT(PROF_SEL);
#ifdef PROF_DIV
        const unsigned long long dv_ = *PROF_SLOT(PROF_DIV); v_ = dv_ ? v_ / dv_ : 0ull;
#endif
        unsigned long long a_ = v_ / (unsigned long long)(PROF_UNIT); if (a_ > 27ull) a_ = 27ull;
        const float sc_ = 1.f + (float)a_;
        for (size_t i = (size_t)blockIdx.x * 512 + threadIdx.x; i < (size_t)S * 1024 / 4; i += (size_t)gridDim.x * 512) { f32x4* o = (f32x4*)p.out + i; *o = *o * sc_; }
    }
#endif
#undef PH
}

inline void launch(void* const* d_in, float* d_out, void* d_ws, size_t ws_size, hipStream_t stream, int ph_lo = 0, int ph_hi = 99, int dbg_branch = -1) {
    static int grid = 0;
    if (grid == 0) {
        int dev = 0, cus = 0, per_cu = 0;
        hipGetDevice(&dev); hipDeviceGetAttribute(&cus, hipDeviceAttributeMultiprocessorCount, dev);
        hipFuncSetAttribute((const void*)mega_fwd, hipFuncAttributeMaxDynamicSharedMemorySize, LDS_BYTES);
        hipOccupancyMaxActiveBlocksPerMultiprocessor(&per_cu, (const void*)mega_fwd, 512, LDS_BYTES);
        if (per_cu < 1) { fprintf(stderr, "occupancy query says %d blocks/CU\n", per_cu); per_cu = 1; }
        grid = cus;
        if (WS_FAST_END > ws_size) { fprintf(stderr, "ws too small: need %zu have %zu\n", (size_t)WS_FAST_END, ws_size); grid = -1; }
    }
    if (grid < 0) return;
    if (ph_lo <= 14 && ph_hi >= 14) hipMemsetAsync((char*)d_ws + SM_CTL, 0, 4096, stream);
    hipMemsetAsync((char*)d_ws + SM_BAR, 0, 16384, stream);
    Params p{};
    for (int i = 0; i < 30; ++i) p.in[i] = (const float*)d_in[i];
    p.out = d_out; p.ws = (unsigned char*)d_ws; p.ph_lo = ph_lo; p.ph_hi = ph_hi; p.dbg_branch = dbg_branch;
    void* args[] = {&p};
    hipError_t e = hipLaunchCooperativeKernel((const void*)mega_fwd, dim3(grid), dim3(512), args, LDS_BYTES, stream);
    if (e != hipSuccess) fprintf(stderr, "cooperative launch failed: %s (grid %d)\n", hipGetErrorString(e), grid);
}
}
extern "C" void kernel_launch(void* const* d_in, const int* in_sizes, int n_in, void* d_out, int out_size, void* d_ws, size_t ws_size, hipStream_t stream) {
    fast::launch(d_in, (float*)d_out, d_ws, ws_size, stream);
}
```

```cpp
#include <hip/hip_runtime.h>
#include <hip/hip_bf16.h>
#include <stdint.h>
#include <stdio.h>
#include <string.h>
#include <hip/hip_cooperative_groups.h>
namespace cg = cooperative_groups;
#define NB 8
#define REPEAT_MASK 0x0u
namespace gold {
constexpr int S = 4096, D = 1024, HW = 1720;
constexpr float EPS = 1e-6f;

__device__ const unsigned char T5B[128] = {0, 1, 2, 3, 4, 5, 6, 7, 8, 9, 10, 11, 12, 13, 14, 15, 16, 16, 16, 17, 17, 18, 18, 18, 19, 19, 19, 20, 20, 20, 20, 21, 21, 21, 21, 22, 22, 22, 22, 22, 23, 23, 23, 23, 23, 23, 24, 24, 24, 24, 24, 24, 25, 25, 25, 25, 25, 25, 25, 26, 26, 26, 26, 26, 26, 26, 26, 27, 27, 27, 27, 27, 27, 27, 27, 27, 27, 28, 28, 28, 28, 28, 28, 28, 28, 28, 28, 29, 29, 29, 29, 29, 29, 29, 29, 29, 29, 29, 29, 30, 30, 30, 30, 30, 30, 30, 30, 30, 30, 30, 30, 30, 30, 31, 31, 31, 31, 31, 31, 31, 31, 31, 31, 31, 31, 31, 31};
}
#ifndef NB
#define NB 8
#endif
namespace fast {
#define LAS __attribute__((address_space(3)))
typedef unsigned short bf16_t;
typedef short bf16x8 __attribute__((ext_vector_type(8)));
typedef float f32x4 __attribute__((ext_vector_type(4)));
typedef float f32x2 __attribute__((ext_vector_type(2)));
typedef float f32x16 __attribute__((ext_vector_type(16)));
typedef unsigned u32x4 __attribute__((ext_vector_type(4)));
typedef unsigned u32x2 __attribute__((ext_vector_type(2)));
typedef __bf16 bf16x2_t __attribute__((ext_vector_type(2)));

constexpr int S = 4096, T = NB * S, D = 1024;
constexpr float EPS = 1e-6f, LOG2E = 1.4426950408889634f;

__device__ __forceinline__ unsigned cvtpk(float lo, float hi) { f32x2 v = {lo, hi}; bf16x2_t b = __builtin_convertvector(v, bf16x2_t); return __builtin_bit_cast(unsigned, b); }
__device__ __forceinline__ bf16_t f2bf(float f) { return (bf16_t)(cvtpk(f, 0.f) & 0xffffu); }
__device__ __forceinline__ float bf2f(bf16_t u) { return __builtin_bit_cast(float, (unsigned)u << 16); }
__device__ __forceinline__ float bflo(unsigned u) { return __builtin_bit_cast(float, u << 16); }
__device__ __forceinline__ float bfhi(unsigned u) { return __builtin_bit_cast(float, u & 0xffff0000u); }
__device__ __forceinline__ float wsum(float v) {
#define WS_DPP(x, ctrl) __builtin_bit_cast(float, __builtin_amdgcn_update_dpp(0, __builtin_bit_cast(int, (x)), (ctrl), 0xF, 0xF, true))
    v += WS_DPP(v, 0xB1); v += WS_DPP(v, 0x4E); v += WS_DPP(v, 0x141); v += WS_DPP(v, 0x140);
#undef WS_DPP
    const int vi = __builtin_bit_cast(int, v);
    const float s0 = __builtin_bit_cast(float, __builtin_amdgcn_readlane(vi, 0)), s1 = __builtin_bit_cast(float, __builtin_amdgcn_readlane(vi, 16));
    const float s2 = __builtin_bit_cast(float, __builtin_amdgcn_readlane(vi, 32)), s3 = __builtin_bit_cast(float, __builtin_amdgcn_readlane(vi, 48));
    return (s0 + s1) + (s2 + s3);
}
__device__ __forceinline__ float fexp2(float x) { return __builtin_amdgcn_exp2f(x); }
__device__ __forceinline__ float frcp(float x) { return __builtin_amdgcn_rcpf(x); }
__device__ __forceinline__ float silu_f(float x) { return x * frcp(1.f + fexp2(-x * LOG2E)); }
__device__ __forceinline__ float gelu_tanh_f(float x) {
    const float u = 0.7978845608028654f * (x + 0.044715f * x * x * x);
    return x * frcp(1.f + fexp2(-2.f * LOG2E * u));
}

namespace pg8 {
constexpr int BM = 256, BK = 64, HALF = 128, HTB = HALF * BK * 2, STAGE_BYTES = 8 * HTB, NXCD = 8, WGM = 8;
__host__ __device__ __forceinline__ int lds_byte(int r, int c) { const int st = (r >> 4) * 2 + (c >> 5), rr = r & 15, cc = c & 31, ob = rr * 64 + cc * 2; return st * 1024 + (ob ^ (((ob >> 9) & 1) << 5)); }
__host__ __device__ __forceinline__ void stage_rc(int b, int& R, int& C) { const int st = b / 1024, sb = b % 1024, swz = sb ^ (((sb >> 9) & 1) << 5); R = (st >> 1) * 16 + swz / 64; C = (st & 1) * 32 + (swz % 64) / 2; }
__host__ __device__ __forceinline__ int perm32(int rho) { const int n = rho >> 4, i = rho & 15; return 8 * (i >> 2) + 4 * n + (i & 3); }

struct Unit { int pm, pn; };
struct Gemm { const bf16_t* A; const bf16_t* Bt; int M, N, K, lda; const int* tile_e; size_t estride; const int* rowidx; };

struct StaticOrder {
    int nM, nN, nwg, G, c;
    __device__ void init(int M, int N, int G_, int c_) { nM = M / BM; nN = N / BM; nwg = nM * nN; G = G_; c = c_; }
    __device__ bool next(int i, Unit& u) const {
        const long L = (long)i * G + c; if (L >= nwg) return false;
        int wgid = (int)L; { const int q = nwg / NXCD, r = nwg % NXCD, xcd = wgid % NXCD, off = wgid / NXCD; wgid = (xcd < r ? xcd * (q + 1) : r * (q + 1) + (xcd - r) * q) + off; }
        const int nig = WGM * nN, gid = wgid / nig, fm = gid * WGM, gsz = (nM - fm) < WGM ? (nM - fm) : WGM;
        u.pm = fm + ((wgid % nig) % gsz); u.pn = (wgid % nig) / gsz; return true;
    }
};

template <class E> struct epi_lds { static constexpr int n = 0; };
__device__ __forceinline__ float row_rstd(const float* ssp, int row);
constexpr int EPI_LDS_OFF = 131072, EPI_TAB_CAP = 30;
template <class Epi, bool ALIGN_EPI, bool GATHER = false>
__device__ __forceinline__ void gemm_phase(LAS unsigned char* lds, const Gemm g, const StaticOrder& S, const Epi& E) {
    int tid = threadIdx.x; asm volatile("" : "+v"(tid));
    const int wid = __builtin_amdgcn_readfirstlane(tid >> 6), lane = tid & 63, wr = wid >> 2, wc = wid & 3, fr = lane & 15, fq = lane >> 4;
    const int K = g.K, nt = K / BK, lda = g.lda;
    unsigned voffA[2], voffB[2];
#pragma unroll
    for (int i = 0; i < 2; ++i) { int R, C; stage_rc(tid * 16 + i * 8192, R, C); const int Rb = Epi::PERM ? ((R & ~31) + perm32(R & 31)) : R;
        voffA[i] = (unsigned)(R * lda + C) * 2u; voffB[i] = (unsigned)(Rb * K + C) * 2u; }
    const size_t kstep = (size_t)(BK * 2);
    const size_t hsA = GATHER ? 0 : (size_t)HALF * lda * 2, tsA = 2 * hsA, hsB = (size_t)HALF * K * 2, tsB = 2 * hsB;
    unsigned vgc[2][2], vgn[2][2];
#define PG8_GOFF(pm_, vg) do { _Pragma("unroll") for (int h_ = 0; h_ < 2; ++h_) _Pragma("unroll") for (int i_ = 0; i_ < 2; ++i_) { int R_, C_; stage_rc(tid * 16 + i_ * 8192, R_, C_); \
        int tok_ = g.rowidx[(pm_) * BM + h_ * HALF + R_]; tok_ = tok_ < 0 ? 0 : tok_; vg[h_][i_] = (unsigned)(tok_ * lda + C_) * 2u; } } while (0)
#define PG8_STAGE_A(bufoff, gbase, h, nx) do { unsigned va_[2]; _Pragma("unroll") for (int i_ = 0; i_ < 2; ++i_) va_[i_] = GATHER ? ((nx) ? vgn[h][i_] : vgc[h][i_]) : voffA[i_]; PG8_STAGE(bufoff, gbase, va_); } while (0)
    const unsigned ldsw = (unsigned)wid * 1024u;
    const int aoff = lds_byte(wr * 64 + fr, fq * 8), boff = lds_byte(wc * 32 + fr, fq * 8);
#define PG8_SA(b, h) (((b) * 2 + (h)) * HTB)
#define PG8_SB(b, h) ((4 + (b) * 2 + (h)) * HTB)
#define PG8_STAGE(bufoff, gbase, voff) do { _Pragma("unroll") for (int _i = 0; _i < 2; ++_i) \
        __builtin_amdgcn_global_load_lds((const unsigned*)((const char*)(gbase) + (voff)[_i]), (LAS unsigned*)(lds + (bufoff) + ldsw + _i * 8192), 16, 0, 0); } while (0)
#define PG8_LDA(dst, b, h) do { _Pragma("unroll") for (int m = 0; m < 4; ++m) _Pragma("unroll") for (int k = 0; k < 2; ++k) dst[m][k] = *(const LAS bf16x8*)(lds + PG8_SA(b, h) + aoff + m * 2048 + k * 1024); } while (0)
#define PG8_LDB(dst, b, h) do { _Pragma("unroll") for (int n = 0; n < 2; ++n) _Pragma("unroll") for (int k = 0; k < 2; ++k) dst[n][k] = *(const LAS bf16x8*)(lds + PG8_SB(b, h) + boff + n * 2048 + k * 1024); } while (0)
#define PG8_MMA(ai, bj, At, Bt) do { __builtin_amdgcn_s_setprio(1); _Pragma("unroll") for (int m = 0; m < 4; ++m) _Pragma("unroll") for (int n = 0; n < 2; ++n) _Pragma("unroll") for (int k = 0; k < 2; ++k) \
        acc[ai][bj][m][n] = __builtin_amdgcn_mfma_f32_16x16x32_bf16(Bt[n][k], At[m][k], acc[ai][bj][m][n], 0, 0, 0); __builtin_amdgcn_s_setprio(0); } while (0)
#define PG8_WAIT_V(n) asm volatile("s_waitcnt vmcnt(" #n ")" ::: "memory")
#define PG8_WAIT_L(n) asm volatile("s_waitcnt lgkmcnt(" #n ")" ::: "memory")
#define PG8_BAR __builtin_amdgcn_s_barrier()
#define PG8_SCHED __builtin_amdgcn_sched_barrier(0)
#define PG8_EOFF(pm_) (g.tile_e ? (size_t)g.tile_e[pm_] * g.estride * 2 : (size_t)0)
    Unit cur, nxt; int ui = 0;
    if (!S.next(0, cur)) return;
    if constexpr (epi_lds<Epi>::n == 16) {
        LAS float* tab_ = (LAS float*)(lds + EPI_LDS_OFF);
        for (int idx = tid; idx < EPI_TAB_CAP * BM; idx += 512) { Unit u_; if (!S.next(idx >> 8, u_)) break; tab_[idx] = row_rstd(E.ssp, u_.pm * BM + (idx & 255)); }
        __syncthreads();
    }
    f32x4 acc[2][2][4][2];
#pragma unroll
    for (int a = 0; a < 2; ++a)
#pragma unroll
        for (int b = 0; b < 2; ++b)
#pragma unroll
            for (int m = 0; m < 4; ++m)
#pragma unroll
                for (int n = 0; n < 2; ++n) acc[a][b][m][n] = (f32x4){0.f, 0.f, 0.f, 0.f};
    bf16x8 At[4][2], B0[2][2], B1[2][2];
    const char* cA = (const char*)g.A + (size_t)cur.pm * tsA; const char* cB = (const char*)g.Bt + PG8_EOFF(cur.pm) + (size_t)cur.pn * tsB;
    if constexpr (GATHER) PG8_GOFF(cur.pm, vgc);
    PG8_STAGE(PG8_SB(0, 0), cB, voffB); PG8_STAGE(PG8_SB(0, 1), cB + hsB, voffB); PG8_STAGE_A(PG8_SA(0, 0), cA, 0, false); PG8_STAGE_A(PG8_SA(0, 1), cA + hsA, 1, false);
    if (wr == 1) PG8_BAR;
    PG8_WAIT_V(2); PG8_BAR;
    PG8_STAGE(PG8_SB(1, 0), cB + kstep, voffB); PG8_STAGE_A(PG8_SA(1, 0), cA + kstep, 0, false); PG8_STAGE(PG8_SB(1, 1), cB + hsB + kstep, voffB);
    PG8_WAIT_V(6); PG8_BAR;
    for (;;) {
        const bool has_next = S.next(ui + 1, nxt);
        if constexpr (GATHER) { if (has_next) PG8_GOFF(nxt.pm, vgn); else { vgn[0][0] = vgc[0][0]; vgn[0][1] = vgc[0][1]; vgn[1][0] = vgc[1][0]; vgn[1][1] = vgc[1][1]; } }
        const char* nA = has_next ? (const char*)g.A + (size_t)nxt.pm * tsA : cA;
        const char* nB = has_next ? (const char*)g.Bt + PG8_EOFF(nxt.pm) + (size_t)nxt.pn * tsB : cB;
        if constexpr (epi_lds<Epi>::n == 1) { if (wid == 0) __builtin_amdgcn_global_load_lds((const unsigned*)((const char*)(E.rowscale + (size_t)cur.pm * BM) + lane * 16), (LAS unsigned*)(lds + EPI_LDS_OFF + (ui & 1) * 1024), 16, 0, 0); }
        for (int t = 0; t < nt; t += 2) {
            const bool last = (t == nt - 2);
            const char* a1 = cA + (size_t)(t + 1) * kstep;
            const char* a2 = last ? nA : cA + (size_t)(t + 2) * kstep; const char* b2 = last ? nB : cB + (size_t)(t + 2) * kstep;
            const char* a3 = a2 + kstep; const char* b3 = b2 + kstep;
            PG8_LDB(B0, 0, 0); PG8_LDB(B1, 0, 1); PG8_SCHED; PG8_LDA(At, 0, 0); PG8_STAGE_A(PG8_SA(1, 1), a1 + hsA, 1, false);
            PG8_WAIT_V(8); PG8_WAIT_L(0); PG8_BAR; PG8_MMA(0, 0, At, B0); PG8_MMA(0, 1, At, B1); PG8_BAR; PG8_SCHED;
            PG8_LDA(At, 0, 1); PG8_STAGE(PG8_SB(0, 0), b2, voffB); PG8_STAGE(PG8_SB(0, 1), b2 + hsB, voffB); PG8_STAGE_A(PG8_SA(0, 0), a2, 0, last);
            PG8_WAIT_V(8); PG8_WAIT_L(0); PG8_BAR; PG8_MMA(1, 0, At, B0); PG8_MMA(1, 1, At, B1); PG8_BAR; PG8_SCHED;
            PG8_LDB(B0, 1, 0); PG8_LDB(B1, 1, 1); PG8_SCHED; PG8_LDA(At, 1, 0); PG8_STAGE_A(PG8_SA(0, 1), a2 + hsA, 1, last);
            PG8_WAIT_V(8); PG8_WAIT_L(0); PG8_BAR; PG8_MMA(0, 0, At, B0); PG8_MMA(0, 1, At, B1); PG8_BAR; PG8_SCHED;
            PG8_LDA(At, 1, 1); PG8_STAGE(PG8_SB(1, 0), b3, voffB); PG8_STAGE(PG8_SB(1, 1), b3 + hsB, voffB); PG8_STAGE_A(PG8_SA(1, 0), a3, 0, last);
            PG8_WAIT_V(8); PG8_WAIT_L(0); PG8_BAR; PG8_MMA(1, 0, At, B0); PG8_MMA(1, 1, At, B1); PG8_BAR; PG8_SCHED;
        }
        if constexpr (ALIGN_EPI) { if (wr == 0) PG8_BAR; }
        if constexpr (epi_lds<Epi>::n == 1) E(acc, cur, wr, wc, fr, fq, (const LAS float*)(lds + EPI_LDS_OFF + (ui & 1) * 1024));
        else if constexpr (epi_lds<Epi>::n == 16) E(acc, cur, wr, wc, fr, fq, ui < EPI_TAB_CAP ? (const LAS float*)(lds + EPI_LDS_OFF + ui * 1024) : (const LAS float*)nullptr);
        else E(acc, cur, wr, wc, fr, fq);
        if (!has_next) break;
#pragma unroll
        for (int a = 0; a < 2; ++a)
#pragma unroll
            for (int b = 0; b < 2; ++b)
#pragma unroll
                for (int m = 0; m < 4; ++m)
#pragma unroll
                    for (int n = 0; n < 2; ++n) acc[a][b][m][n] = (f32x4){0.f, 0.f, 0.f, 0.f};
        cur = nxt; cA = nA; cB = nB; ++ui;
        if constexpr (GATHER) { vgc[0][0] = vgn[0][0]; vgc[0][1] = vgn[0][1]; vgc[1][0] = vgn[1][0]; vgc[1][1] = vgn[1][1]; }
        if constexpr (ALIGN_EPI) { if (wr == 1) PG8_BAR; }
    }
    PG8_WAIT_V(0);
    if constexpr (!ALIGN_EPI) { if (wr == 0) PG8_BAR; }
    PG8_BAR;
#undef PG8_SA
#undef PG8_SB
#undef PG8_STAGE
#undef PG8_LDA
#undef PG8_LDB
#undef PG8_MMA
#undef PG8_WAIT_V
#undef PG8_WAIT_L
#undef PG8_BAR
#undef PG8_SCHED
#undef PG8_EOFF
#undef PG8_GOFF
#undef PG8_STAGE_A
}

__device__ __forceinline__ float row_rstd(const float* ssp, int row);
template <int ACT> struct EpiBf16 {
    static constexpr bool PERM = true;
    bf16_t* O; int ldc; const float* bias; const float* ssp;
    __device__ __forceinline__ void operator()(const f32x4 (&acc)[2][2][4][2], const Unit& u, int wr, int wc, int fr, int fq) const {
        const int row0 = u.pm * BM + wr * 64 + fr, col0 = u.pn * BM + wc * 32 + 8 * fq;
        f32x4 bv[2][2];
#pragma unroll
        for (int bj = 0; bj < 2; ++bj)
#pragma unroll
            for (int n = 0; n < 2; ++n) bv[bj][n] = bias ? *(const f32x4*)(bias + col0 + bj * HALF + 4 * n) : (f32x4){0.f, 0.f, 0.f, 0.f};
#pragma unroll
        for (int ai = 0; ai < 2; ++ai)
#pragma unroll
            for (int m = 0; m < 4; ++m) { bf16_t* rowp = O + (size_t)(row0 + ai * HALF + m * 16) * ldc + col0;
                const float rs = (ACT == 0 && ssp) ? row_rstd(ssp, row0 + ai * HALF + m * 16) : 1.f;
#pragma unroll
                for (int bj = 0; bj < 2; ++bj) { f32x4 v0 = acc[ai][bj][m][0] * rs + bv[bj][0], v1 = acc[ai][bj][m][1] * rs + bv[bj][1];
                    if (ACT == 2) {
#pragma unroll
                        for (int i = 0; i < 4; ++i) { v0[i] = gelu_tanh_f(v0[i]); v1[i] = gelu_tanh_f(v1[i]); } }
                    u32x4 w; w.x = cvtpk(v0[0], v0[1]); w.y = cvtpk(v0[2], v0[3]); w.z = cvtpk(v1[0], v1[1]); w.w = cvtpk(v1[2], v1[3]);
                    *(u32x4*)(rowp + bj * HALF) = w; } }
    }
};
struct EpiResF32 {
    static constexpr bool PERM = false;
    const float* base; float* out; int ldc;
    __device__ __forceinline__ void operator()(const f32x4 (&acc)[2][2][4][2], const Unit& u, int wr, int wc, int fr, int fq) const {
        const int col0 = u.pn * BM + wc * 32 + 4 * fq;
#pragma unroll
        for (int ai = 0; ai < 2; ++ai)
#pragma unroll
            for (int m = 0; m < 4; ++m) { const size_t off = (size_t)(u.pm * BM + ai * HALF + wr * 64 + m * 16 + fr) * ldc + col0;
#pragma unroll
                for (int bj = 0; bj < 2; ++bj)
#pragma unroll
                    for (int n = 0; n < 2; ++n) { const f32x4 bs = *(const f32x4*)(base + off + bj * HALF + n * 16); *(f32x4*)(out + off + bj * HALF + n * 16) = bs + acc[ai][bj][m][n]; } }
    }
};
template <bool BASE_BF16> struct EpiResStat {
    static constexpr bool PERM = true;
    const void* base; bf16_t* xb; float* ssp; int ldc;
    __device__ __forceinline__ void operator()(const f32x4 (&acc)[2][2][4][2], const Unit& u, int wr, int wc, int fr, int fq) const {
        const int col0 = u.pn * BM + wc * 32 + 8 * fq;
#pragma unroll
        for (int ai = 0; ai < 2; ++ai)
#pragma unroll
            for (int m = 0; m < 4; ++m) { const int row = u.pm * BM + ai * HALF + wr * 64 + m * 16 + fr; const size_t off = (size_t)row * ldc + col0; float ss = 0.f;
#pragma unroll
                for (int bj = 0; bj < 2; ++bj) { f32x4 b0, b1;
                    if (BASE_BF16) { const u32x4 t = *(const u32x4*)((const bf16_t*)base + off + bj * HALF); b0 = (f32x4){bflo(t.x), bfhi(t.x), bflo(t.y), bfhi(t.y)}; b1 = (f32x4){bflo(t.z), bfhi(t.z), bflo(t.w), bfhi(t.w)}; }
                    else { b0 = *(const f32x4*)((const float*)base + off + bj * HALF); b1 = *(const f32x4*)((const float*)base + off + bj * HALF + 4); }
                    const f32x4 v0 = b0 + acc[ai][bj][m][0], v1 = b1 + acc[ai][bj][m][1];
                    u32x4 w; w.x = cvtpk(v0.x, v0.y); w.y = cvtpk(v0.z, v0.w); w.z = cvtpk(v1.x, v1.y); w.w = cvtpk(v1.z, v1.w); *(u32x4*)(xb + off + bj * HALF) = w;
                    ss += ((v0.x * v0.x + v0.y * v0.y) + (v0.z * v0.z + v0.w * v0.w)) + ((v1.x * v1.x + v1.y * v1.y) + (v1.z * v1.z + v1.w * v1.w)); }
                ss += __shfl_xor(ss, 16); ss += __shfl_xor(ss, 32);
                if (fq == 0) ssp[(size_t)row * 16 + u.pn * 4 + wc] = ss; }
    }
};
struct EpiResBf16B {
    static constexpr bool PERM = true;
    const bf16_t* base; bf16_t* out; int ldc;
    __device__ __forceinline__ void operator()(const f32x4 (&acc)[2][2][4][2], const Unit& u, int wr, int wc, int fr, int fq) const {
        const int col0 = u.pn * BM + wc * 32 + 8 * fq;
#pragma unroll
        for (int ai = 0; ai < 2; ++ai)
#pragma unroll
            for (int m = 0; m < 4; ++m) { const size_t off = (size_t)(u.pm * BM + ai * HALF + wr * 64 + m * 16 + fr) * ldc + col0;
#pragma unroll
                for (int bj = 0; bj < 2; ++bj) { const u32x4 t = *(const u32x4*)(base + off + bj * HALF);
                    const f32x4 v0 = (f32x4){bflo(t.x), bfhi(t.x), bflo(t.y), bfhi(t.y)} + acc[ai][bj][m][0], v1 = (f32x4){bflo(t.z), bfhi(t.z), bflo(t.w), bfhi(t.w)} + acc[ai][bj][m][1];
                    u32x4 w; w.x = cvtpk(v0.x, v0.y); w.y = cvtpk(v0.z, v0.w); w.z = cvtpk(v1.x, v1.y); w.w = cvtpk(v1.z, v1.w); *(u32x4*)(out + off + bj * HALF) = w; } }
    }
};
struct EpiResF32B {
    static constexpr bool PERM = false;
    const bf16_t* base; float* out; int ldc;
    __device__ __forceinline__ void operator()(const f32x4 (&acc)[2][2][4][2], const Unit& u, int wr, int wc, int fr, int fq) const {
        const int col0 = u.pn * BM + wc * 32 + 4 * fq;
#pragma unroll
        for (int ai = 0; ai < 2; ++ai)
#pragma unroll
            for (int m = 0; m < 4; ++m) { const size_t off = (size_t)(u.pm * BM + ai * HALF + wr * 64 + m * 16 + fr) * ldc + col0;
#pragma unroll
                for (int bj = 0; bj < 2; ++bj)
#pragma unroll
                    for (int n = 0; n < 2; ++n) { const u32x2 t = *(const u32x2*)(base + off + bj * HALF + n * 16); const f32x4 bs = {bflo(t.x), bfhi(t.x), bflo(t.y), bfhi(t.y)};
                        *(f32x4*)(out + off + bj * HALF + n * 16) = bs + acc[ai][bj][m][n]; } }
    }
};
__device__ __forceinline__ float row_rstd(const float* ssp, int row) {
    const f32x4* q = (const f32x4*)(ssp + (size_t)row * 16); const f32x4 a = q[0], b = q[1], c = q[2], d = q[3];
    const float s = ((a.x + a.y) + (a.z + a.w)) + ((b.x + b.y) + (b.z + b.w)) + ((c.x + c.y) + (c.z + c.w)) + ((d.x + d.y) + (d.z + d.w));
    return rsqrtf(s * (1.f / 1024.f) + EPS);
}
struct EpiSwiGLU {
    static constexpr bool PERM = true;
    bf16_t* O; int ldc; const float* ssp; const float* rrs;
    __device__ __forceinline__ void operator()(const f32x4 (&acc)[2][2][4][2], const Unit& u, int wr, int wc, int fr, int fq) const {
        const int row0 = u.pm * BM + wr * 64 + fr, col0 = u.pn * HALF + wc * 32 + 8 * fq;
#pragma unroll
        for (int ai = 0; ai < 2; ++ai)
#pragma unroll
            for (int m = 0; m < 4; ++m) { bf16_t* rowp = O + (size_t)(row0 + ai * HALF + m * 16) * ldc + col0;
                const float rs = rrs ? rrs[row0 + ai * HALF + m * 16] : (ssp ? row_rstd(ssp, row0 + ai * HALF + m * 16) : 1.f);
                float h[8];
#pragma unroll
                for (int n = 0; n < 2; ++n)
#pragma unroll
                    for (int i = 0; i < 4; ++i) h[n * 4 + i] = silu_f(acc[ai][0][m][n][i] * rs) * (acc[ai][1][m][n][i] * rs);
                u32x4 w; w.x = cvtpk(h[0], h[1]); w.y = cvtpk(h[2], h[3]); w.z = cvtpk(h[4], h[5]); w.w = cvtpk(h[6], h[7]);
                *(u32x4*)rowp = w; }
    }
};
struct EpiConvIn {
    static constexpr bool PERM = true;
    bf16_t* Bg; bf16_t* CU; const float* ssp;
    __device__ __forceinline__ void operator()(const f32x4 (&acc)[2][2][4][2], const Unit& u, int wr, int wc, int fr, int fq) const {
        const int row0 = u.pm * BM + wr * 64 + fr;
#pragma unroll
        for (int ai = 0; ai < 2; ++ai)
#pragma unroll
            for (int m = 0; m < 4; ++m) { const int row = row0 + ai * HALF + m * 16; const float rs = row_rstd(ssp, row);
                if (u.pn < 4) {
#pragma unroll
                    for (int bj = 0; bj < 2; ++bj) { const f32x4 v0 = acc[ai][bj][m][0] * rs, v1 = acc[ai][bj][m][1] * rs;
                        u32x4 w; w.x = cvtpk(v0[0], v0[1]); w.y = cvtpk(v0[2], v0[3]); w.z = cvtpk(v1[0], v1[1]); w.w = cvtpk(v1[2], v1[3]);
                        *(u32x4*)(Bg + (size_t)row * 1024 + u.pn * BM + bj * HALF + wc * 32 + 8 * fq) = w; }
                } else { const float r2 = rs * rs; float h[8];
#pragma unroll
                    for (int n = 0; n < 2; ++n)
#pragma unroll
                        for (int i = 0; i < 4; ++i) h[n * 4 + i] = acc[ai][0][m][n][i] * acc[ai][1][m][n][i] * r2;
                    u32x4 w; w.x = cvtpk(h[0], h[1]); w.y = cvtpk(h[2], h[3]); w.z = cvtpk(h[4], h[5]); w.w = cvtpk(h[6], h[7]);
                    *(u32x4*)(CU + (size_t)row * 1024 + (u.pn - 4) * HALF + wc * 32 + 8 * fq) = w; } }
    }
};
struct EpiRowScaleBf16 {
    static constexpr bool PERM = true;
    bf16_t* O; int ldc; const float* roww;
    __device__ __forceinline__ void operator()(const f32x4 (&acc)[2][2][4][2], const Unit& u, int wr, int wc, int fr, int fq) const {
        const int row0 = u.pm * BM + wr * 64 + fr, col0 = u.pn * BM + wc * 32 + 8 * fq;
#pragma unroll
        for (int ai = 0; ai < 2; ++ai)
#pragma unroll
            for (int m = 0; m < 4; ++m) { const int row = row0 + ai * HALF + m * 16; const float sc = roww[row]; bf16_t* rowp = O + (size_t)row * ldc + col0;
#pragma unroll
                for (int bj = 0; bj < 2; ++bj) { const f32x4 v0 = acc[ai][bj][m][0] * sc, v1 = acc[ai][bj][m][1] * sc;
                    u32x4 w; w.x = cvtpk(v0[0], v0[1]); w.y = cvtpk(v0[2], v0[3]); w.z = cvtpk(v1[0], v1[1]); w.w = cvtpk(v1[2], v1[3]);
                    *(u32x4*)(rowp + bj * HALF) = w; } }
    }
};

__device__ __forceinline__ float row_rstd_lds(const LAS float* sl, int rl) {
    const LAS f32x4* q = (const LAS f32x4*)(sl + rl * 16); const f32x4 a = q[0], b = q[1], c = q[2], d = q[3];
    const float s = ((a.x + a.y) + (a.z + a.w)) + ((b.x + b.y) + (b.z + b.w)) + ((c.x + c.y) + (c.z + c.w)) + ((d.x + d.y) + (d.z + d.w));
    return rsqrtf(s * (1.f / 1024.f) + EPS);
}
struct EpiSwiGLUSsp {
    static constexpr bool PERM = true;
    bf16_t* O; int ldc; const float* ssp;
    __device__ __forceinline__ void operator()(const f32x4 (&acc)[2][2][4][2], const Unit& u, int wr, int wc, int fr, int fq, const LAS float* sl) const {
        const int rl0 = wr * 64 + fr, row0 = u.pm * BM + rl0, col0 = u.pn * HALF + wc * 32 + 8 * fq;
#pragma unroll
        for (int ai = 0; ai < 2; ++ai)
#pragma unroll
            for (int m = 0; m < 4; ++m) { bf16_t* rowp = O + (size_t)(row0 + ai * HALF + m * 16) * ldc + col0;
                const float rs = sl ? sl[rl0 + ai * HALF + m * 16] : row_rstd(ssp, row0 + ai * HALF + m * 16);
                float h[8];
#pragma unroll
                for (int n = 0; n < 2; ++n)
#pragma unroll
                    for (int i = 0; i < 4; ++i) h[n * 4 + i] = silu_f(acc[ai][0][m][n][i] * rs) * (acc[ai][1][m][n][i] * rs);
                u32x4 w; w.x = cvtpk(h[0], h[1]); w.y = cvtpk(h[2], h[3]); w.z = cvtpk(h[4], h[5]); w.w = cvtpk(h[6], h[7]);
                *(u32x4*)rowp = w; }
    }
};
template <> struct epi_lds<EpiSwiGLUSsp> { static constexpr int n = 16; };
struct EpiConvInSsp {
    static constexpr bool PERM = true;
    bf16_t* Bg; bf16_t* CU; const float* ssp;
    __device__ __forceinline__ void operator()(const f32x4 (&acc)[2][2][4][2], const Unit& u, int wr, int wc, int fr, int fq, const LAS float* sl) const {
        const int rl0 = wr * 64 + fr, row0 = u.pm * BM + rl0;
#pragma unroll
        for (int ai = 0; ai < 2; ++ai)
#pragma unroll
            for (int m = 0; m < 4; ++m) { const int row = row0 + ai * HALF + m * 16; const float rs = sl ? sl[rl0 + ai * HALF + m * 16] : row_rstd(ssp, row);
                if (u.pn < 4) {
#pragma unroll
                    for (int bj = 0; bj < 2; ++bj) { const f32x4 v0 = acc[ai][bj][m][0] * rs, v1 = acc[ai][bj][m][1] * rs;
                        u32x4 w; w.x = cvtpk(v0[0], v0[1]); w.y = cvtpk(v0[2], v0[3]); w.z = cvtpk(v1[0], v1[1]); w.w = cvtpk(v1[2], v1[3]);
                        *(u32x4*)(Bg + (size_t)row * 1024 + u.pn * BM + bj * HALF + wc * 32 + 8 * fq) = w; }
                } else { const float r2 = rs * rs; float h[8];
#pragma unroll
                    for (int n = 0; n < 2; ++n)
#pragma unroll
                        for (int i = 0; i < 4; ++i) h[n * 4 + i] = acc[ai][0][m][n][i] * acc[ai][1][m][n][i] * r2;
                    u32x4 w; w.x = cvtpk(h[0], h[1]); w.y = cvtpk(h[2], h[3]); w.z = cvtpk(h[4], h[5]); w.w = cvtpk(h[6], h[7]);
                    *(u32x4*)(CU + (size_t)row * 1024 + (u.pn - 4) * HALF + wc * 32 + 8 * fq) = w; } }
    }
};
template <> struct epi_lds<EpiConvInSsp> { static constexpr int n = 16; };
struct EpiSwiGLULds {
    static constexpr bool PERM = true;
    bf16_t* O; int ldc; const float* rowscale;
    __device__ __forceinline__ void operator()(const f32x4 (&acc)[2][2][4][2], const Unit& u, int wr, int wc, int fr, int fq, const LAS float* rsl) const {
        const int rl0 = wr * 64 + fr, row0 = u.pm * BM + rl0, col0 = u.pn * HALF + wc * 32 + 8 * fq;
#pragma unroll
        for (int ai = 0; ai < 2; ++ai)
#pragma unroll
            for (int m = 0; m < 4; ++m) { bf16_t* rowp = O + (size_t)(row0 + ai * HALF + m * 16) * ldc + col0;
                const float rs = rsl[rl0 + ai * HALF + m * 16];
                float h[8];
#pragma unroll
                for (int n = 0; n < 2; ++n)
#pragma unroll
                    for (int i = 0; i < 4; ++i) h[n * 4 + i] = silu_f(acc[ai][0][m][n][i] * rs) * (acc[ai][1][m][n][i] * rs);
                u32x4 w; w.x = cvtpk(h[0], h[1]); w.y = cvtpk(h[2], h[3]); w.z = cvtpk(h[4], h[5]); w.w = cvtpk(h[6], h[7]);
                *(u32x4*)rowp = w; }
    }
};
template <> struct epi_lds<EpiSwiGLULds> { static constexpr int n = 1; };
struct EpiRowScaleLds {
    static constexpr bool PERM = true;
    bf16_t* O; int ldc; const float* rowscale;
    __device__ __forceinline__ void operator()(const f32x4 (&acc)[2][2][4][2], const Unit& u, int wr, int wc, int fr, int fq, const LAS float* rsl) const {
        const int rl0 = wr * 64 + fr, row0 = u.pm * BM + rl0, col0 = u.pn * BM + wc * 32 + 8 * fq;
#pragma unroll
        for (int ai = 0; ai < 2; ++ai)
#pragma unroll
            for (int m = 0; m < 4; ++m) { const int row = row0 + ai * HALF + m * 16; const float sc = rsl[rl0 + ai * HALF + m * 16]; bf16_t* rowp = O + (size_t)row * ldc + col0;
#pragma unroll
                for (int bj = 0; bj < 2; ++bj) { const f32x4 v0 = acc[ai][bj][m][0] * sc, v1 = acc[ai][bj][m][1] * sc;
                    u32x4 w; w.x = cvtpk(v0[0], v0[1]); w.y = cvtpk(v0[2], v0[3]); w.z = cvtpk(v1[0], v1[1]); w.w = cvtpk(v1[2], v1[3]);
                    *(u32x4*)(rowp + bj * HALF) = w; } }
    }
};
template <> struct epi_lds<EpiRowScaleLds> { static constexpr int n = 1; };
}
constexpr int ROWS_MAX = 2 * T + 8 * 256;
constexpr size_t al256(size_t x) { return (x + 255) & ~(size_t)255; }
constexpr size_t W_IN_E = 0;
constexpr size_t W_CW1 = W_IN_E + (size_t)1792 * 1024 * 2;
constexpr size_t W_UQ = W_CW1 + (size_t)2 * 256 * 2048 * 2;
constexpr size_t W_UKV = W_UQ + (size_t)1024 * 256 * 2;
constexpr size_t W_OUT_E = W_UKV + (size_t)1024 * 128 * 2;
constexpr size_t W_GU = W_OUT_E + (size_t)1024 * 1024 * 2;
constexpr size_t W_D = W_GU + (size_t)5632 * 1024 * 2;
constexpr size_t W_IN_O = W_D + (size_t)1024 * 2816 * 2;
constexpr size_t W_OUT_O = W_IN_O + (size_t)3072 * 1024 * 2;
constexpr size_t W_MGU = W_OUT_O + (size_t)1024 * 1024 * 2;
constexpr size_t W_MD = W_MGU + (size_t)8 * 2816 * 1024 * 2;
constexpr size_t W_END = W_MD + (size_t)8 * 1024 * 1408 * 2;
constexpr size_t SM_CTL = al256(W_END);
constexpr size_t SM_BAR = SM_CTL + 4096;
constexpr size_t SM_B1P = SM_BAR + 16384;
constexpr size_t SM_B1 = SM_B1P + 32 * 512 * 4;
constexpr size_t SM_ROPE = SM_B1 + 512 * 4;
constexpr size_t SM_BL = SM_ROPE + (size_t)S * 32 * 4;
constexpr size_t SM_HID = SM_BL + 8 * 132 * 4;
constexpr size_t SM_KC = SM_HID + (size_t)2 * NB * 512 * 512 * 2;
constexpr size_t SM_VCT = SM_KC + (size_t)NB * 512 * 64 * 2;
constexpr size_t SM_TE = SM_VCT + (size_t)NB * 512 * 64 * 2;
constexpr size_t SM_TW = SM_TE + (size_t)T * 8;
constexpr size_t SM_RANK = SM_TW + (size_t)T * 8;
constexpr size_t SM_POS = SM_RANK + (size_t)T * 8;
constexpr size_t SM_ROWW = SM_POS + (size_t)T * 8;
constexpr size_t SM_TILEE = SM_ROWW + (size_t)ROWS_MAX * 4;
constexpr size_t SM_ROWTOK = al256(SM_TILEE + (size_t)(ROWS_MAX / 256 + 8) * 4);
constexpr size_t SM_SSP1 = al256(SM_ROWTOK + (size_t)ROWS_MAX * 4);
constexpr size_t SM_SSP2 = SM_SSP1 + (size_t)T * 64;
constexpr size_t SM_RSTD3 = SM_SSP2 + (size_t)T * 64;
constexpr size_t SM_ROWRS = SM_RSTD3 + (size_t)T * 4;
constexpr size_t SM_END = al256(SM_ROWRS + (size_t)ROWS_MAX * 4);
constexpr size_t R_XA = al256(SM_END);
constexpr size_t SZ_XA = (size_t)T * 4096 + (size_t)4 * 1048576;
constexpr size_t R_XN = R_XA + SZ_XA;
constexpr size_t SZ_XN = (size_t)T * 2048;
constexpr size_t R_H = R_XN + SZ_XN;
constexpr size_t SZ_H = ((size_t)T * 6144 > (size_t)ROWS_MAX * 2816) ? (size_t)T * 6144 : (size_t)ROWS_MAX * 2816;
constexpr size_t WS_FAST_END = R_H + SZ_H;
constexpr size_t A_QN = 0;
constexpr size_t A_KSN = A_QN + (size_t)T * 1024;
constexpr size_t A_KWN = A_KSN + (size_t)T * 256;
constexpr size_t A_VST = A_KWN + (size_t)T * 256;
constexpr size_t A_VWT = A_VST + (size_t)T * 256;
constexpr size_t A_KCIN = A_VWT + (size_t)T * 256;
constexpr size_t A_VCIN = A_KCIN + (size_t)T * 256 + 2048;
constexpr size_t A_CQN = A_VCIN + (size_t)T * 256 + 2048;
constexpr size_t A_CKVN = A_CQN + (size_t)T * 512;
constexpr size_t A_KROPE = A_CKVN + (size_t)T * 256;
constexpr size_t A_GATES = A_KROPE + (size_t)T * 64;
constexpr size_t A_END = A_GATES + (size_t)T * 96;
static_assert(A_END <= SZ_XA, "attention inputs fit R_XA");
constexpr size_t O_QM = 0;
constexpr size_t O_KM = O_QM + (size_t)T * 1536;
constexpr size_t O_VMT = O_KM + (size_t)T * 1536;
static_assert(O_VMT + (size_t)T * 1024 <= (size_t)T * 4096, "d_out scratch");

struct Params {
    const float* in[30];
    float* out;
    unsigned char* ws;
    int ph_lo, ph_hi, dbg_branch, pad_;
};

#ifdef PROF_SEL
#define PROF_SLOT(k) ((unsigned long long*)(p.ws + SM_CTL + 2048) + (k))
#define PROF_ON(cond) ((cond) && threadIdx.x == 0)
#ifndef PROF_WAVE
#define PROF_WAVE 0
#endif
#endif
constexpr int LDS_BYTES = 163840;

__device__ __forceinline__ int ltid() { int t = threadIdx.x; asm volatile("" : "+v"(t)); return t; }
__device__ __forceinline__ int perm16(int k) { return (k & ~12) | ((k & 4) << 1) | ((k & 8) >> 1); }

struct WDesc { int in_idx, K, N, rep, map, row_off; size_t src_stride, dst_off, dst_stride; int gain_idx, pad_; size_t src_off; };
__device__ const WDesc WDESC[13] = {
    {3, 1024, 1720, 1, 2, 0, 0, W_IN_E / 2, 0, -1, 0},
    {7, 1024, 256, 2, 0, 0, (size_t)2048 * 256, W_CW1 / 2, (size_t)512 * 1024, -1, 0, 0},
    {7, 1024, 256, 2, 0, 256, (size_t)2048 * 256, W_CW1 / 2, (size_t)512 * 1024, -1, 0, (size_t)1024 * 256},
    {11, 256, 768, 1, 3, 0, 0, W_UQ / 2, 0, -1, 0},
    {12, 128, 1024, 1, 0, 0, 0, W_UKV / 2, 0, -1, 0},
    {15, 1024, 1024, 1, 0, 0, 0, W_OUT_E / 2, 0, -1, 0},
    {17, 1024, 2816, 1, 1, 0, 0, W_GU / 2, 0, 16, 0},
    {18, 1024, 2816, 1, 1, 128, 0, W_GU / 2, 0, 16, 0},
    {19, 2816, 1024, 1, 0, 0, 0, W_D / 2, 0, -1, 0},
    {21, 1024, 3072, 1, 4, 0, 0, W_IN_O / 2, 0, 20, 0},
    {23, 1024, 1024, 1, 0, 0, 0, W_OUT_O / 2, 0, -1, 0},
    {27, 1024, 1408, 8, 1, 0, (size_t)1024 * 1408, W_MGU / 2, (size_t)2816 * 1024, 24, 0},
    {28, 1024, 1408, 8, 1, 128, (size_t)1024 * 1408, W_MGU / 2, (size_t)2816 * 1024, 24, 0},
};
__device__ const WDesc WDESC_MD = {29, 1408, 1024, 8, 0, 0, (size_t)1408 * 1024, W_MD / 2, (size_t)1024 * 1408, -1, 0};

struct WItem { f32x4 v[8]; float g[8]; };
__device__ __forceinline__ void item_load(WItem& I, const float* W, int K, int N, const float* gain, int item, int lane) {
    const int nblk = (N + 31) / 32, kb = item / nblk, nb = item % nblk, k0 = 64 * kb, n0 = 32 * nb;
    const int n4 = (lane & 7) * 4; const bool nok = (n0 + n4) < N;
#pragma unroll
    for (int i = 0; i < 8; ++i) { const int kk = (lane >> 3) + 8 * i; I.v[i] = nok ? *(const f32x4*)(W + (size_t)(k0 + kk) * N + n0 + n4) : (f32x4){0.f, 0.f, 0.f, 0.f}; I.g[i] = gain ? gain[k0 + kk] : 1.f; }
}
__device__ __forceinline__ void item_finish(const WItem& I, int K, int N, bf16_t* WT, int map, int row_off, LAS float* scr, int item, int lane) {
    const int nblk = (N + 31) / 32, kb = item / nblk, nb = item % nblk, k0 = 64 * kb, n0 = 32 * nb;
    const int n4 = (lane & 7) * 4;
#pragma unroll
    for (int i = 0; i < 8; ++i) { const int kk = (lane >> 3) + 8 * i; LAS float* d = scr + kk * 33 + n4; const float g_ = I.g[i]; d[0] = I.v[i].x * g_; d[1] = I.v[i].y * g_; d[2] = I.v[i].z * g_; d[3] = I.v[i].w * g_; }
    asm volatile("s_waitcnt lgkmcnt(0)" ::: "memory");
    const int c = lane & 7;
#pragma unroll
    for (int j = 0; j < 4; ++j) { const int n = (lane >> 3) + 8 * j; const LAS float* s = scr + (8 * c) * 33 + n;
        u32x4 o; o.x = cvtpk(s[0 * 33], s[1 * 33]); o.y = cvtpk(s[2 * 33], s[3 * 33]); o.z = cvtpk(s[4 * 33], s[5 * 33]); o.w = cvtpk(s[6 * 33], s[7 * 33]);
        const int nn = n0 + n;
        if (nn < N) { const int row = (map == 1) ? (256 * (nn >> 7) + (nn & 127) + row_off) : (map == 2) ? (nn < 1280 ? nn : (nn < 1304 ? nn + 416 : nn - 24)) : (map == 3) ? ((nn / 96) * 128 + nn % 96) : (map == 4) ? (nn < 1024 ? nn : (nn < 2048 ? 1024 + 256 * ((nn - 1024) >> 7) + ((nn - 1024) & 127) : 1024 + 256 * ((nn - 2048) >> 7) + 128 + ((nn - 2048) & 127))) : (nn + row_off);
            *(u32x4*)(WT + (size_t)row * K + k0 + 8 * c) = o; } }
    asm volatile("s_waitcnt lgkmcnt(0)" ::: "memory");
}
__device__ __forceinline__ void rms_row_to_bf16(const float* xrow, const float* g, bf16_t* orow, int lane) {
    const f32x4* xr = (const f32x4*)xrow + lane; const f32x4* gr = (const f32x4*)g + lane;
    f32x4 v[4]; float s = 0.f;
#pragma unroll
    for (int j = 0; j < 4; ++j) { v[j] = xr[64 * j]; s += (v[j].x * v[j].x + v[j].y * v[j].y) + (v[j].z * v[j].z + v[j].w * v[j].w); }
    const float r = rsqrtf(wsum(s) * (1.f / 1024.f) + EPS);
    u32x2* o8 = (u32x2*)orow + lane;
#pragma unroll
    for (int j = 0; j < 4; ++j) { const f32x4 gg = gr[64 * j]; u32x2 w; w.x = cvtpk(v[j].x * r * gg.x, v[j].y * r * gg.y); w.y = cvtpk(v[j].z * r * gg.z, v[j].w * r * gg.w); o8[64 * j] = w; }
}
constexpr int WD_EARLY = 6;
__device__ __forceinline__ void convert_weights(const Params& p, LAS unsigned char* lds, int d_lo, int d_hi) {
    const int tid = ltid(), lane = tid & 63, wave = tid >> 6;
    const int gw = blockIdx.x * 8 + wave, NGW = gridDim.x * 8;
    LAS float* scr = (LAS float*)(lds + wave * 16384);
    int base = 0;
#pragma unroll 1
    for (int d = d_lo; d < d_hi; ++d) {
        const WDesc& wd = (d < 13) ? WDESC[d] : WDESC_MD;
        const int n_it = wd.rep * (wd.K / 64) * ((wd.N + 31) / 32);
        int first = (gw - (base % NGW) + NGW) % NGW;
        const int per = (wd.K / 64) * ((wd.N + 31) / 32); const float* gain = wd.gain_idx >= 0 ? p.in[wd.gain_idx] : nullptr;
        for (int it = first; it < n_it; it += 4 * NGW) {
            WItem I[4];
#pragma unroll
            for (int q = 0; q < 4; ++q) { const int iq = it + q * NGW; if (iq < n_it) { const int r = iq / per; item_load(I[q], p.in[wd.in_idx] + wd.src_off + (size_t)r * wd.src_stride, wd.K, wd.N, gain, iq % per, lane); } }
#pragma unroll
            for (int q = 0; q < 4; ++q) { const int iq = it + q * NGW; if (iq < n_it) { const int r = iq / per; item_finish(I[q], wd.K, wd.N, (bf16_t*)p.ws + wd.dst_off + (size_t)r * wd.dst_stride, wd.map, wd.row_off, scr, iq % per, lane); } }
        }
        base += n_it;
    }
}
__device__ __forceinline__ void phase_p0(const Params& p, LAS unsigned char* lds) {
    const int tid = ltid(), lane = tid & 63, wave = tid >> 6;
    const int gw = blockIdx.x * 8 + wave, NGW = gridDim.x * 8;
    convert_weights(p, lds, 0, WD_EARLY);
    bf16_t* xn = (bf16_t*)(p.ws + R_XN);
    for (int m = gw; m < T; m += 2 * NGW) { rms_row_to_bf16(p.in[0] + (size_t)m * D, p.in[2], xn + (size_t)m * D, lane); if (m + NGW < T) rms_row_to_bf16(p.in[0] + (size_t)(m + NGW) * D, p.in[2], xn + (size_t)(m + NGW) * D, lane); }
    for (int u = gw; u < 256; u += NGW) {
        const int kc = u >> 3, kv = (u >> 2) & 1, nb = u & 3; float s = 0.f;
        const float* pos = p.in[6] + kv * 2048 + kc * 64; const float* w1 = p.in[7] + ((size_t)kv * 2048 + kc * 64) * 256 + nb * 64 + lane;
#pragma unroll 8
        for (int k = 0; k < 64; ++k) s += pos[k] * w1[(size_t)k * 256];
        ((float*)(p.ws + SM_B1P))[kc * 512 + kv * 256 + nb * 64 + lane] = s;
    }
    for (int i = blockIdx.x * 512 + tid; i < S * 16; i += gridDim.x * 512) {
        const int t = i >> 4, f = i & 15; const float ang = (float)t * powf(10000.f, -(float)f / 16.f);
        float* rp = (float*)(p.ws + SM_ROPE) + t * 32; rp[f] = cosf(ang); rp[16 + f] = sinf(ang);
    }
    if (blockIdx.x == 0) for (int i = tid; i < 8 * 129; i += 512) { const int h = i / 129, dd = i % 129; ((float*)(p.ws + SM_BL))[h * 132 + dd] = p.in[1][(dd < 128 ? (int)gold::T5B[dd] : 31) * 8 + h] * LOG2E; }
}

__device__ __forceinline__ void unpack8(const u32x4 v, float (&x)[8]) { x[0] = bflo(v.x); x[1] = bfhi(v.x); x[2] = bflo(v.y); x[3] = bfhi(v.y); x[4] = bflo(v.z); x[5] = bfhi(v.z); x[6] = bflo(v.w); x[7] = bfhi(v.w); }
__device__ __forceinline__ u32x4 pack8(const float (&x)[8]) { u32x4 w; w.x = cvtpk(x[0], x[1]); w.y = cvtpk(x[2], x[3]); w.z = cvtpk(x[4], x[5]); w.w = cvtpk(x[6], x[7]); return w; }
__device__ __forceinline__ float ss8f(const float (&x)[8]) { return ((x[0] * x[0] + x[1] * x[1]) + (x[2] * x[2] + x[3] * x[3])) + ((x[4] * x[4] + x[5] * x[5]) + (x[6] * x[6] + x[7] * x[7])); }
__device__ __forceinline__ void load8f(const float* g, float (&x)[8], float sc) { const f32x4 a = *(const f32x4*)g, b = *(const f32x4*)(g + 4); x[0] = a.x * sc; x[1] = a.y * sc; x[2] = a.z * sc; x[3] = a.w * sc; x[4] = b.x * sc; x[5] = b.y * sc; x[6] = b.z * sc; x[7] = b.w * sc; }
__device__ __forceinline__ void phase_p2(const Params& p, LAS unsigned char* lds) {
    const int tid = ltid(), lane = tid & 63, wave = tid >> 6;
    const bf16_t* hb = (const bf16_t*)(p.ws + R_H);
    unsigned char* xa = p.ws + R_XA;
    bf16_t* qn = (bf16_t*)(xa + A_QN); bf16_t* ksn = (bf16_t*)(xa + A_KSN); bf16_t* kwn = (bf16_t*)(xa + A_KWN);
    bf16_t* vst = (bf16_t*)(xa + A_VST); bf16_t* vwt = (bf16_t*)(xa + A_VWT); bf16_t* kcin = (bf16_t*)(xa + A_KCIN); bf16_t* vcin = (bf16_t*)(xa + A_VCIN);
    bf16_t* cqn = (bf16_t*)(xa + A_CQN); bf16_t* ckvn = (bf16_t*)(xa + A_CKVN); bf16_t* krope = (bf16_t*)(xa + A_KROPE); float* gates = (float*)(xa + A_GATES);
    LAS bf16_t* vs = (LAS bf16_t*)lds;
    if (blockIdx.x == 0) {
        { float s = 0.f; for (int k = 0; k < 32; ++k) s += ((const float*)(p.ws + SM_B1P))[k * 512 + tid]; ((float*)(p.ws + SM_B1))[tid] = s; }
        for (int i = tid; i < 1024; i += 512) { kcin[(size_t)T * 128 + i] = 0; vcin[(size_t)T * 128 + i] = 0; }
    }
    const int c8 = (lane & 7) * 8, seg = lane >> 3;
    float qg[8], ksg[8], kwg[8], cqg[8], ckvg[8];
    load8f(p.in[4] + c8, qg, 0.125f * LOG2E); load8f(p.in[5] + 64 + c8, ksg, 1.f); load8f(p.in[5] + 128 + c8, kwg, 1.f);
    load8f(p.in[9] + (lane & 31) * 8, cqg, 1.f); load8f(p.in[10] + (lane & 15) * 8, ckvg, 1.f);
    for (int tile = blockIdx.x; tile < T / 64; tile += gridDim.x) {
        const int b = tile / (S / 64), s0 = (tile % (S / 64)) * 64;
#pragma unroll 4
        for (int tt = 0; tt < 8; ++tt) {
            const int sl = wave * 8 + tt, s = s0 + sl; const size_t t = (size_t)b * S + s;
            const bf16_t* hr = hb + t * 1792 + lane * 8;
            const u32x4 L0 = *(const u32x4*)hr, L1 = *(const u32x4*)(hr + 512), L2 = *(const u32x4*)(hr + 1024);
            u32x4 L3 = {0u, 0u, 0u, 0u}; if (lane < 32) L3 = *(const u32x4*)(hr + 1536);
            float x0[8], x1[8], x2[8], x3[8];
            unpack8(L0, x0); unpack8(L1, x1); unpack8(L2, x2); unpack8(L3, x3);
            float a0 = ss8f(x0), a1 = ss8f(x1), a2 = ss8f(x2), a3 = ss8f(x3);
#define P2_DPP(v, ctrl) __builtin_bit_cast(float, __builtin_amdgcn_update_dpp(0, __builtin_bit_cast(int, (v)), (ctrl), 0xF, 0xF, true))
#define P2_SUM8(v) do { v += P2_DPP(v, 0xB1); v += P2_DPP(v, 0x4E); v += P2_DPP(v, 0x141); } while (0)
            P2_SUM8(a0); P2_SUM8(a1); P2_SUM8(a2); P2_SUM8(a3);
            float a2w = a2 + P2_DPP(a2, 0x140); a2w += __shfl_xor(a2w, 16);
            const float a3w = a3 + P2_DPP(a3, 0x140);
#undef P2_SUM8
#undef P2_DPP
            const int pp0 = (sl & ~15) | perm16(sl & 15);
            const int pp = (((pp0 >> 3) ^ (lane & 7)) << 3) | (pp0 & 7);
            {
                const float r = rsqrtf(a0 * (1.f / 64.f) + EPS); float y[8];
#pragma unroll
                for (int j = 0; j < 8; ++j) y[j] = x0[j] * r * qg[j];
                *(u32x4*)(qn + t * 512 + lane * 8) = pack8(y);
            }
            {
                const int g = seg & 1; const size_t gm = (((size_t)b * 2 + g) * S + s) * 64 + c8;
                if (seg < 2) *(u32x4*)(kcin + gm) = L1;
                else if (seg < 4) *(u32x4*)(vcin + gm) = L1;
                else if (seg < 6) { const float r = rsqrtf(a1 * (1.f / 64.f) + EPS); float y[8];
#pragma unroll
                    for (int j = 0; j < 8; ++j) y[j] = x1[j] * r * ksg[j];
                    *(u32x4*)(ksn + gm) = pack8(y); }
                else {
#pragma unroll
                    for (int j = 0; j < 8; ++j) vs[((0 + g) * 64 + c8 + j) * 72 + pp] = (bf16_t)((j & 1) ? (L1[j >> 1] >> 16) : (L1[j >> 1] & 0xffffu)); }
            }
            {
                const int g = seg & 1; const size_t gm = (((size_t)b * 2 + g) * S + s) * 64 + c8;
                if (seg < 2) { const float r = rsqrtf(a2 * (1.f / 64.f) + EPS); float y[8];
#pragma unroll
                    for (int j = 0; j < 8; ++j) y[j] = x2[j] * r * kwg[j];
                    *(u32x4*)(kwn + gm) = pack8(y); }
                else if (seg < 4) {
#pragma unroll
                    for (int j = 0; j < 8; ++j) vs[((2 + g) * 64 + c8 + j) * 72 + pp] = (bf16_t)((j & 1) ? (L2[j >> 1] >> 16) : (L2[j >> 1] & 0xffffu)); }
                else { const float r = rsqrtf(a2w * (1.f / 256.f) + EPS); float y[8];
#pragma unroll
                    for (int j = 0; j < 8; ++j) y[j] = x2[j] * r * cqg[j];
                    *(u32x4*)(cqn + t * 256 + (lane - 32) * 8) = pack8(y); }
            }
            {
                if (lane < 16) { const float r = rsqrtf(a3w * (1.f / 128.f) + EPS); float y[8];
#pragma unroll
                    for (int j = 0; j < 8; ++j) y[j] = x3[j] * r * ckvg[j];
                    *(u32x4*)(ckvn + t * 128 + lane * 8) = pack8(y); }
                else if (lane < 20) *(u32x4*)(krope + t * 32 + (lane - 16) * 8) = L3;
                else if (lane < 23) { float y[8];
#pragma unroll
                    for (int j = 0; j < 8; ++j) y[j] = frcp(1.f + fexp2(-x3[j] * LOG2E));
                    float* gp = gates + t * 24 + (lane - 20) * 8; *(f32x4*)gp = (f32x4){y[0], y[1], y[2], y[3]}; *(f32x4*)(gp + 4) = (f32x4){y[4], y[5], y[6], y[7]}; }
            }
        }
        __syncthreads();
        {
            const int ch = tid & 7;
#pragma unroll
            for (int i = 0; i < 4; ++i) { const int row = (tid >> 3) + 64 * i, which = row >> 6, d = row & 63, g = which & 1, sx = (row >> 3) & 7;
                bf16_t* dst = ((which < 2) ? vst : vwt) + (((size_t)b * 2 + g) * 64 + d) * S + s0 + ch * 8;
                *(u32x4*)dst = *(const LAS u32x4*)(vs + row * 72 + ((ch ^ sx) << 3)); }
        }
        __syncthreads();
    }
}
__device__ __forceinline__ void phase_p3b(const Params& p, LAS unsigned char* lds, int parts = 3) {
    const int tid = ltid(), lane = tid & 63, wave = tid >> 6;
    const int gw = blockIdx.x * 8 + wave, NGW = gridDim.x * 8;
    const bf16_t* qraw = (const bf16_t*)(p.ws + R_H);
    const bf16_t* kvraw = (const bf16_t*)(p.ws + R_H + (size_t)T * 2048);
    const bf16_t* krope = (const bf16_t*)(p.ws + R_XA + A_KROPE);
    const float* rope = (const float*)(p.ws + SM_ROPE);
    bf16_t* qm = (bf16_t*)((unsigned char*)p.out + O_QM); bf16_t* km = (bf16_t*)((unsigned char*)p.out + O_KM); bf16_t* vmt = (bf16_t*)((unsigned char*)p.out + O_VMT);
    const float* q_norm = p.in[13]; const float* k_norm = p.in[14];
    LAS bf16_t* vs = (LAS bf16_t*)lds;
    LAS float* w2s = (LAS float*)(lds + 73728);
    if (parts & 1) {
        LAS float* w2a = (LAS float*)lds;
        constexpr int NR = NB * 512;
        u32x2 pa[2][2], pb[2][2];
#define P3_ROWLOADS(r0_) do { _Pragma("unroll") for (int kv = 0; kv < 2; ++kv) _Pragma("unroll") for (int q = 0; q < 2; ++q) { \
            int row = (r0_) + q * NGW; row = row < NR ? row : 0; const int row1 = row + 1 < NR ? row + 1 : row;        \
            const bf16_t* P = (const bf16_t*)(p.ws + SM_HID) + (size_t)kv * NB * 512 * 512;       \
            pa[kv][q] = *(const u32x2*)(P + (size_t)row * 512 + lane * 4); pb[kv][q] = *(const u32x2*)(P + (size_t)row1 * 512 + 256 + lane * 4); } } while (0)
        __syncthreads();
        { f32x4 wv[16];
#pragma unroll
          for (int k = 0; k < 16; ++k) wv[k] = ((const f32x4*)p.in[8])[tid + 512 * ((k + (int)blockIdx.x) & 15)];
          P3_ROWLOADS(gw);
#pragma unroll
          for (int k = 0; k < 16; ++k) ((LAS f32x4*)w2a)[tid + 512 * ((k + (int)blockIdx.x) & 15)] = wv[k]; }
        __syncthreads();
        for (int row0 = gw; row0 < NR; row0 += 2 * NGW) {
            if (row0 != gw) P3_ROWLOADS(row0);
#pragma unroll
            for (int kv = 0; kv < 2; ++kv) {
                const f32x4 bs = *(const f32x4*)((const float*)(p.ws + SM_B1) + kv * 256 + lane * 4);
                const LAS float* w2s = w2a + kv * 16384;
#pragma unroll
                for (int q = 0; q < 2; ++q) { const int row = row0 + q * NGW; if (row >= NR) continue;
                    const u32x2 a_ = pa[kv][q], b_ = pb[kv][q];
                    const float h0 = gelu_tanh_f(bflo(a_.x) + bflo(b_.x) + bs.x), h1 = gelu_tanh_f(bfhi(a_.x) + bfhi(b_.x) + bs.y), h2 = gelu_tanh_f(bflo(a_.y) + bflo(b_.y) + bs.z), h3 = gelu_tanh_f(bfhi(a_.y) + bfhi(b_.y) + bs.w);
                    float acc0 = 0.f, acc1 = 0.f;
#pragma unroll 8
                    for (int k4 = 0; k4 < 64; ++k4) {
#define P3_RL(v) __builtin_bit_cast(float, __builtin_amdgcn_readlane(__builtin_bit_cast(int, (v)), k4))
                        acc0 += P3_RL(h0) * w2s[(k4 * 4 + 0) * 64 + lane]; acc1 += P3_RL(h1) * w2s[(k4 * 4 + 1) * 64 + lane];
                        acc0 += P3_RL(h2) * w2s[(k4 * 4 + 2) * 64 + lane]; acc1 += P3_RL(h3) * w2s[(k4 * 4 + 3) * 64 + lane];
#undef P3_RL
                    }
                    const float acc = acc0 + acc1;
                    if (kv == 0) { const float r = rsqrtf(wsum(acc * acc) * (1.f / 64.f) + EPS); ((bf16_t*)(p.ws + SM_KC))[(size_t)row * 64 + lane] = f2bf(acc * r * p.in[5][lane]); }
                    else { const int c = row & 255; ((bf16_t*)(p.ws + SM_VCT))[((size_t)(row >> 8) * 64 + lane) * 256 + ((c & ~15) | perm16(c & 15))] = f2bf(acc); }
                }
            }
        }
    }
#undef P3_ROWLOADS
    __syncthreads();
    const float QS = 0.10206207261596577f * LOG2E;
    const int c = lane & 15, hl = lane >> 4;
    float qg[8], kg[8];
    load8f(q_norm + (c < 12 ? c * 8 : 0), qg, QS);
    load8f(k_norm + (c < 12 ? c * 8 : 0), kg, 1.f);
    const bool isrope = (c >= 8) && (c < 12);
    const float m12 = c < 12 ? 1.f : 0.f, sgn = c < 10 ? -1.f : 1.f;
    const int cr8 = isrope ? (c - 8) * 8 : 0;
#define P3_DPP(v, ctrl) __builtin_bit_cast(float, __builtin_amdgcn_update_dpp(0, __builtin_bit_cast(int, (v)), (ctrl), 0xF, 0xF, true))
#define P3_SUM16(v) do { v += P3_DPP(v, 0xB1); v += P3_DPP(v, 0x4E); v += P3_DPP(v, 0x141); v += P3_DPP(v, 0x140); } while (0)
    if (parts & 2) for (int tile = blockIdx.x; tile < T / 64; tile += gridDim.x) {
        const int b = tile / (S / 64), s0 = (tile % (S / 64)) * 64;
#pragma unroll 4
        for (int tt = 0; tt < 8; ++tt) {
            const int sl = wave * 8 + tt, s = s0 + sl; const size_t t = (size_t)b * S + s;
            const int pp0 = (sl & ~15) | perm16(sl & 15);
            const int pp = (((pp0 >> 3) ^ ((c - 8) & 7)) << 3) | (pp0 & 7);
            u32x4 Q[2], KV[2];
#pragma unroll
            for (int ld = 0; ld < 2; ++ld) { Q[ld] = *(const u32x4*)(qraw + t * 1024 + ld * 512 + lane * 8); KV[ld] = *(const u32x4*)(kvraw + t * 1024 + ld * 512 + lane * 8); }
            const u32x4 KR = *(const u32x4*)(krope + t * 32 + cr8);
            const float* rp = rope + s * 32 + (c & 1) * 8; const f32x4 cs0 = *(const f32x4*)rp, cs1 = *(const f32x4*)(rp + 4), sn0 = *(const f32x4*)(rp + 16), sn1 = *(const f32x4*)(rp + 20);
            const float csr[8] = {cs0.x, cs0.y, cs0.z, cs0.w, cs1.x, cs1.y, cs1.z, cs1.w}, snr[8] = {sn0.x, sn0.y, sn0.z, sn0.w, sn1.x, sn1.y, sn1.z, sn1.w};
            float cse[8], sne[8], kr[8]; unpack8(KR, kr);
#pragma unroll
            for (int j = 0; j < 8; ++j) { cse[j] = isrope ? csr[j] : 1.f; sne[j] = isrope ? snr[j] * sgn : 0.f; kr[j] = isrope ? kr[j] : 0.f; }
#pragma unroll
            for (int ld = 0; ld < 2; ++ld) {
                const int hh = ld * 4 + hl;
                {
                    float x[8]; unpack8(Q[ld], x);
                    float ss = ss8f(x) * m12; P3_SUM16(ss);
                    const float r = rsqrtf(ss * (1.f / 96.f) + EPS); float y[8], z[8];
#pragma unroll
                    for (int j = 0; j < 8; ++j) y[j] = x[j] * (r * qg[j]);
#pragma unroll
                    for (int j = 0; j < 8; ++j) { const float pb = P3_DPP(y[j], 0x4E); z[j] = __builtin_fmaf(pb, sne[j], y[j] * cse[j]); }
                    if (c < 12) *(u32x4*)(qm + (t * 8 + hh) * 96 + c * 8) = pack8(z);
                }
                {
                    float x[8], xk[8]; unpack8(KV[ld], x);
#pragma unroll
                    for (int j = 0; j < 8; ++j) xk[j] = c < 8 ? x[j] : kr[j];
                    float ss = ss8f(xk); P3_SUM16(ss);
                    const float r = rsqrtf(ss * (1.f / 96.f) + EPS); float y[8], z[8];
#pragma unroll
                    for (int j = 0; j < 8; ++j) y[j] = xk[j] * (r * kg[j]);
#pragma unroll
                    for (int j = 0; j < 8; ++j) { const float pb = P3_DPP(y[j], 0x4E); z[j] = __builtin_fmaf(pb, sne[j], y[j] * cse[j]); }
                    if (c < 12) *(u32x4*)(km + (((size_t)b * 8 + hh) * S + s) * 96 + c * 8) = pack8(z);
                    if (c >= 8) {
#pragma unroll
                        for (int j = 0; j < 8; ++j) vs[(hh * 64 + (c - 8) * 8 + j) * 72 + pp] = (bf16_t)((j & 1) ? (KV[ld][j >> 1] >> 16) : (KV[ld][j >> 1] & 0xffffu)); }
                }
            }
        }
        __syncthreads();
        {
            const int ch = tid & 7;
#pragma unroll
            for (int i = 0; i < 8; ++i) { const int row = (tid >> 3) + 64 * i, hh = row >> 6, d = row & 63, sx = (row >> 3) & 7;
                *(u32x4*)(vmt + (((size_t)b * 8 + hh) * 64 + d) * S + s0 + ch * 8) = *(const LAS u32x4*)(vs + row * 72 + ((ch ^ sx) << 3)); }
        }
        __syncthreads();
    }
#undef P3_SUM16
#undef P3_DPP
}
__device__ const unsigned short UNIT_TYPES[256] = {63,127,62,126,61,125,527,591,655,719,783,847,911,975,60,124,59,123,58,122,57,121,56,120,526,590,654,718,782,846,910,974,55,119,54,118,53,117,52,116,51,115,525,589,653,717,781,845,909,973,50,114,49,113,48,112,47,111,524,588,652,716,780,844,908,972,46,110,45,109,44,108,43,107,523,587,651,715,779,843,907,971,42,106,41,105,40,104,39,103,38,102,522,586,650,714,778,842,906,970,37,101,36,100,35,99,34,98,33,97,521,585,649,713,777,841,905,969,32,96,31,95,30,94,520,584,648,712,776,840,904,968,29,93,28,92,27,91,26,90,25,89,519,583,647,711,775,839,903,967,24,88,23,87,22,86,21,85,20,84,518,582,646,710,774,838,902,966,19,83,18,82,17,81,16,80,15,79,517,581,645,709,773,837,901,965,14,78,13,77,12,76,516,580,644,708,772,836,900,964,11,75,10,74,9,73,8,72,515,579,643,707,771,835,899,963,7,71,6,70,5,69,514,578,642,706,770,834,898,962,4,68,3,67,513,577,641,705,769,833,897,961,2,66,1,65,0,64,512,576,640,704,768,832,896,960};
__device__ __forceinline__ int crow(int r, int hi) { return (r & 3) + 8 * (r >> 2) + 4 * hi; }
struct Flash { f32x16 o0, o1; float l; };
__device__ __forceinline__ void flash_init(Flash& st) {
#pragma unroll
    for (int r = 0; r < 16; ++r) { st.o0[r] = 0.f; st.o1[r] = 0.f; }
    st.l = 0.f;
}
constexpr int AL_K64 = 0, AL_V64 = 4 * 8192;
constexpr int AL_K96 = 0, AL_V96 = 4 * 16384;
constexpr int AL_IMP = 65536, AL_SELB = AL_IMP + 64 * 65 * 4, AL_UNI = AL_SELB + 512, AL_TL = AL_UNI + 64, AL_BL = AL_TL + 128, AL_OT = AL_BL + 4 * 132 * 4, AL_END = AL_OT + 8 * 32 * 64 * 4;
static_assert(AL_END <= 163328 && AL_V96 + 4 * 8192 <= 163328, "attention LDS");

template <int RB> struct DmaLane { unsigned g0, g1; };
template <int RB> __device__ __forceinline__ void dma_setup(DmaLane<RB>& L, int w, int lane, unsigned gs) {
    if (RB == 128) { const int r = 8 * w + (lane >> 3), c = (lane & 7) ^ ((r >> 1) & 7); L.g0 = (unsigned)r * gs + c * 16; L.g1 = 0; }
    else {
        { const int r = 8 * w + (lane >> 4); int c = (lane & 15) ^ (r & 15); c = c >= 12 ? c - 4 : c; L.g0 = (unsigned)r * gs + c * 16; }
        { const int r = 8 * w + 4 + (lane >> 4); int c = (lane & 15) ^ (r & 15); c = c >= 12 ? c - 4 : c; L.g1 = (unsigned)r * gs + c * 16; }
    }
}
template <int RB> __device__ __forceinline__ void dma_issue(const unsigned char* tile, const DmaLane<RB>& L, LAS unsigned char* buf, int w) {
    if (RB == 128) __builtin_amdgcn_global_load_lds((const unsigned*)(tile + L.g0), (LAS unsigned*)(buf + w * 1024), 16, 0, 0);
    else { __builtin_amdgcn_global_load_lds((const unsigned*)(tile + L.g0), (LAS unsigned*)(buf + w * 2048), 16, 0, 0);
           __builtin_amdgcn_global_load_lds((const unsigned*)(tile + L.g1), (LAS unsigned*)(buf + w * 2048 + 1024), 16, 0, 0); }
}
template <int DK> __device__ __forceinline__ void frag_offsets(unsigned (&kl)[DK / 16], unsigned (&vl)[4], int r32, int hi) {
#pragma unroll
    for (int s = 0; s < DK / 16; ++s) kl[s] = (DK == 64) ? (unsigned)(r32 * 128 + (((2 * s + hi) ^ ((r32 >> 1) & 7)) << 4)) : (unsigned)(r32 * 256 + (((2 * s + hi) ^ (r32 & 15)) << 4));
#pragma unroll
    for (int s = 0; s < 4; ++s) vl[s] = (unsigned)(r32 * 128 + (((2 * s + hi) ^ ((r32 >> 1) & 7)) << 4));
}

template <int NS> struct KFrags { bf16x8 ka[NS], kh[NS]; };
template <int DK, int KP> __device__ __forceinline__ void kfrag_load(KFrags<DK / 16>& fr, const LAS unsigned char* Kt, const unsigned (&kl)[DK / 16]) {
#pragma unroll
    for (int s = 0; s < DK / 16; ++s) fr.ka[s] = *(const LAS bf16x8*)(Kt + kl[s]);
#pragma unroll
    for (int s = 0; s < DK / 16; ++s) fr.kh[s] = *(const LAS bf16x8*)(Kt + kl[s] + 32 * KP);
}
template <int DK, int KP, bool LANEMASK, class F>
__device__ __forceinline__ void tile_compute(Flash& st, KFrags<DK / 16>& fr, const LAS unsigned char* Kn, const LAS unsigned char* Vt, const bf16x8* qf, const f32x16& negm, const unsigned (&kl)[DK / 16], const unsigned (&vl)[4], bool mine, F f) {
    constexpr int NS = DK / 16; constexpr int KH = 32 * KP;
    (void)KH;
    f32x16 p0, p1;
#pragma unroll
    for (int s = 0; s < NS; ++s) p0 = (s == 0) ? __builtin_amdgcn_mfma_f32_32x32x16_bf16(fr.ka[0], qf[0], negm, 0, 0, 0) : __builtin_amdgcn_mfma_f32_32x32x16_bf16(fr.ka[s], qf[s], p0, 0, 0, 0);
#pragma unroll
    for (int s = 0; s < NS; ++s) p1 = (s == 0) ? __builtin_amdgcn_mfma_f32_32x32x16_bf16(fr.kh[0], qf[0], negm, 0, 0, 0) : __builtin_amdgcn_mfma_f32_32x32x16_bf16(fr.kh[s], qf[s], p1, 0, 0, 0);
    __builtin_amdgcn_sched_barrier(0);
    bf16x8 va[4], vh[4];
#pragma unroll
    for (int s = 0; s < 4; ++s) { va[s] = *(const LAS bf16x8*)(Vt + vl[s]); vh[s] = *(const LAS bf16x8*)(Vt + vl[s] + 4096); }
    kfrag_load<DK, KP>(fr, Kn, kl);
    __builtin_amdgcn_sched_barrier(0);
    float ls = 0.f, ls1 = 0.f;
    u32x4 w0, w1, w2, w3;
    {
#pragma unroll
        for (int r = 0; r < 16; ++r) { float x = p0[r]; const bool v = f(r, 0, x); const float e = fexp2(x); p0[r] = v ? e : 0.f; ls += p0[r]; }
        w0.x = cvtpk(p0[0], p0[1]); w0.y = cvtpk(p0[2], p0[3]); w0.z = cvtpk(p0[4], p0[5]); w0.w = cvtpk(p0[6], p0[7]);
        w1.x = cvtpk(p0[8], p0[9]); w1.y = cvtpk(p0[10], p0[11]); w1.z = cvtpk(p0[12], p0[13]); w1.w = cvtpk(p0[14], p0[15]);
        if (LANEMASK) { w0.x = mine ? w0.x : 0u; w0.y = mine ? w0.y : 0u; w0.z = mine ? w0.z : 0u; w0.w = mine ? w0.w : 0u; w1.x = mine ? w1.x : 0u; w1.y = mine ? w1.y : 0u; w1.z = mine ? w1.z : 0u; w1.w = mine ? w1.w : 0u; }
    }
#pragma unroll
    for (int s = 0; s < 2; ++s) {
        const bf16x8 pa = __builtin_bit_cast(bf16x8, s ? w1 : w0);
        st.o0 = __builtin_amdgcn_mfma_f32_32x32x16_bf16(pa, va[s], st.o0, 0, 0, 0);
        st.o1 = __builtin_amdgcn_mfma_f32_32x32x16_bf16(pa, vh[s], st.o1, 0, 0, 0);
    }
    {
#pragma unroll
        for (int r = 0; r < 16; ++r) { float x = p1[r]; const bool v = f(r, 1, x); const float e = fexp2(x); p1[r] = v ? e : 0.f; ls1 += p1[r]; }
        w2.x = cvtpk(p1[0], p1[1]); w2.y = cvtpk(p1[2], p1[3]); w2.z = cvtpk(p1[4], p1[5]); w2.w = cvtpk(p1[6], p1[7]);
        w3.x = cvtpk(p1[8], p1[9]); w3.y = cvtpk(p1[10], p1[11]); w3.z = cvtpk(p1[12], p1[13]); w3.w = cvtpk(p1[14], p1[15]);
        if (LANEMASK) { w2.x = mine ? w2.x : 0u; w2.y = mine ? w2.y : 0u; w2.z = mine ? w2.z : 0u; w2.w = mine ? w2.w : 0u; w3.x = mine ? w3.x : 0u; w3.y = mine ? w3.y : 0u; w3.z = mine ? w3.z : 0u; w3.w = mine ? w3.w : 0u; }
    }
    ls += ls1;
    if (LANEMASK) ls = mine ? ls : 0.f;
    st.l += ls;
#pragma unroll
    for (int s = 2; s < 4; ++s) {
        const bf16x8 pa = __builtin_bit_cast(bf16x8, (s == 3) ? w3 : w2);
        st.o0 = __builtin_amdgcn_mfma_f32_32x32x16_bf16(pa, va[s], st.o0, 0, 0, 0);
        st.o1 = __builtin_amdgcn_mfma_f32_32x32x16_bf16(pa, vh[s], st.o1, 0, 0, 0);
    }
}
template <int DK, int KP> __device__ __forceinline__ void qk_tile(f32x16& p0, f32x16& p1, const LAS unsigned char* Kt, const bf16x8* qf, const f32x16& negm, const unsigned (&kl)[DK / 16]) {
#pragma unroll
    for (int s = 0; s < DK / 16; ++s) {
        const bf16x8 a0 = *(const LAS bf16x8*)(Kt + kl[s]);
        const bf16x8 a1 = *(const LAS bf16x8*)(Kt + kl[s] + 32 * KP);
        if (s == 0) { p0 = __builtin_amdgcn_mfma_f32_32x32x16_bf16(a0, qf[0], negm, 0, 0, 0); p1 = __builtin_amdgcn_mfma_f32_32x32x16_bf16(a1, qf[0], negm, 0, 0, 0); }
        else { p0 = __builtin_amdgcn_mfma_f32_32x32x16_bf16(a0, qf[s], p0, 0, 0, 0); p1 = __builtin_amdgcn_mfma_f32_32x32x16_bf16(a1, qf[s], p1, 0, 0, 0); }
    }
}
template <bool FIRST> __device__ __forceinline__ void flash_accum(LAS float* otl, const Flash& st, float gate, int hi, int lane) {
    const float lt = st.l + __shfl_xor(st.l, 32);
    const float f = lt > 0.f ? gate * frcp(lt) : 0.f;
#pragma unroll
    for (int r = 0; r < 16; ++r) { const float fr_ = __shfl(f, crow(r, hi));
        if (FIRST) { otl[r * 64 + lane] = fr_ * st.o0[r]; otl[(16 + r) * 64 + lane] = fr_ * st.o1[r]; }
        else { otl[r * 64 + lane] += fr_ * st.o0[r]; otl[(16 + r) * 64 + lane] += fr_ * st.o1[r]; } }
}
template <int NS> __device__ __forceinline__ float qnorm2(const bf16x8* qf) {
    float s = 0.f;
#pragma unroll
    for (int i = 0; i < NS; ++i)
#pragma unroll
        for (int j = 0; j < 8; ++j) { const float x = bf2f((bf16_t)qf[i][j]); s += x * x; }
    return s + __shfl_xor(s, 32);
}
__device__ __forceinline__ float wmax(float v) {
#pragma unroll
    for (int o = 1; o < 64; o <<= 1) v = fmaxf(v, __shfl_xor(v, o));
    return v;
}

struct NoComp {};
template <class T> struct is_nocomp { static constexpr bool v = false; };
template <> struct is_nocomp<NoComp> { static constexpr bool v = true; };
template <class C> __device__ __forceinline__ void rt_call(C& c, int t, LAS unsigned char* kb, LAS unsigned char* vb, LAS unsigned char* kn) { c(t, kb, vb, kn); }
__device__ __forceinline__ void rt_call(NoComp&, int, LAS unsigned char*, LAS unsigned char*, LAS unsigned char*) {}
template <class C> __device__ __forceinline__ void kl_call(C& c, LAS unsigned char* kb) { c(kb); }
__device__ __forceinline__ void kl_call(NoComp&, LAS unsigned char*) {}
template <int RBK, bool HASV, int KOFF, int KSZ, int VOFF, class SrcK, class SrcV, class C0, class C1, class C2, class KL = NoComp>
__device__ __forceinline__ void run_tiles(int n, int e0, int e1, int e2, LAS unsigned char* lds, int w, int lane, unsigned gsK, unsigned gsV, SrcK srcK, SrcV srcV, C0 c0, C1 c1, C2 c2, KL kload = KL{}) {
    DmaLane<RBK> LK; dma_setup<RBK>(LK, w, lane, gsK);
    DmaLane<128> LV; LV.g0 = 0; LV.g1 = 0; if (HASV) dma_setup<128>(LV, w, lane, gsV);
    const int nl = n - 1, t1 = nl < 1 ? nl : 1, t2 = nl < 2 ? nl : 2;
    e0 = __builtin_amdgcn_readfirstlane(e0); e1 = __builtin_amdgcn_readfirstlane(e1); e2 = __builtin_amdgcn_readfirstlane(e2);
    dma_issue<RBK>(srcK(0), LK, lds + KOFF, w); if (HASV) dma_issue<128>(srcV(0), LV, lds + VOFF, w);
    dma_issue<RBK>(srcK(t1), LK, lds + KOFF + KSZ, w); if (HASV) dma_issue<128>(srcV(t1), LV, lds + VOFF + 8192, w);
    dma_issue<RBK>(srcK(t2), LK, lds + KOFF + 2 * KSZ, w); if (HASV) dma_issue<128>(srcV(t2), LV, lds + VOFF + 2 * 8192, w);
    constexpr int P = (RBK == 128 ? 1 : 2) + (HASV ? 1 : 0);
    int t = 0, slot = 0;
    constexpr bool KPRE = !is_nocomp<KL>::v;
    if (KPRE) {
        if (P == 1) asm volatile("s_waitcnt vmcnt(2)" ::: "memory"); else if (P == 2) asm volatile("s_waitcnt vmcnt(4)" ::: "memory"); else asm volatile("s_waitcnt vmcnt(6)" ::: "memory");
        __builtin_amdgcn_s_barrier(); asm volatile("" ::: "memory");
        kl_call(kload, lds + KOFF);
    }
#define RT_HEAD() do { \
        if (KPRE) { if (P == 1) asm volatile("s_waitcnt vmcnt(1)" ::: "memory"); else if (P == 2) asm volatile("s_waitcnt vmcnt(2)" ::: "memory"); else asm volatile("s_waitcnt vmcnt(3)" ::: "memory"); } \
        else if (P == 1) asm volatile("s_waitcnt vmcnt(2)" ::: "memory"); else if (P == 2) asm volatile("s_waitcnt vmcnt(4)" ::: "memory"); else asm volatile("s_waitcnt vmcnt(6)" ::: "memory"); \
        __builtin_amdgcn_s_barrier(); asm volatile("" ::: "memory"); \
        { const int tn = (t + 3 < nl) ? t + 3 : nl; const int s2 = (slot + 3) & 3; \
          dma_issue<RBK>(srcK(tn), LK, lds + KOFF + s2 * KSZ, w); if (HASV) dma_issue<128>(srcV(tn), LV, lds + VOFF + s2 * 8192, w); } } while (0)
#define RT_SEG(cc, ee) if (!is_nocomp<decltype(cc)>::v) { _Pragma("unroll 1") for (; t < (ee); ++t) { RT_HEAD(); rt_call(cc, t, lds + KOFF + slot * KSZ, lds + VOFF + slot * 8192, lds + KOFF + ((slot + 1) & 3) * KSZ); slot = (slot + 1) & 3; } }
    RT_SEG(c0, e0)
    RT_SEG(c1, e1)
    RT_SEG(c2, e2)
#pragma unroll 1
    for (; t < n; ++t) { RT_HEAD(); slot = (slot + 1) & 3; }
#undef RT_SEG
#undef RT_HEAD
    asm volatile("s_waitcnt vmcnt(0)" ::: "memory");
    __syncthreads();
}

__device__ __forceinline__ void mla_unit(const Params& p, LAS unsigned char* lds, int b, int h, int qb) {
    int tid = threadIdx.x; asm volatile("" : "+v"(tid));
    const int lane = tid & 63, w = __builtin_amdgcn_readfirstlane(tid >> 6), r32 = lane & 31, hi = lane >> 5;
    const bf16_t* qm = (const bf16_t*)((const unsigned char*)p.out + O_QM);
    const unsigned char* km = (const unsigned char*)p.out + O_KM + (((size_t)b * 8 + h) * S) * 192;
    const unsigned char* vmt = (const unsigned char*)p.out + O_VMT + (((size_t)b * 8 + h) * 64) * (size_t)S * 2;
    bf16_t* ocat = (bf16_t*)(p.ws + R_XN);
    const int tq = qb * 256 + 32 * w + r32;
    bf16x8 qf[6];
#pragma unroll
    for (int s = 0; s < 6; ++s) qf[s] = *(const bf16x8*)(qm + (((size_t)b * S + tq) * 8 + h) * 96 + 16 * s + 8 * hi);
    const float kn = 9.797958971f * 1.01f * wmax(fmaxf(fabsf(p.in[14][lane]), lane < 32 ? fabsf(p.in[14][64 + lane]) : 0.f));
    const float mref = sqrtf(qnorm2<6>(qf)) * kn;
    f32x16 negm;
#pragma unroll
    for (int r = 0; r < 16; ++r) negm[r] = -mref;
    Flash st; flash_init(st);
    const int ntile = 4 * qb + 4, dt = 4 * qb + (w >> 1);
#ifdef PROF_SEL
    if (b == 0 && h == 0 && qb == 15 && threadIdx.x == 0) { *PROF_SLOT(36) -= __builtin_amdgcn_s_memtime(); *PROF_SLOT(37) -= __builtin_amdgcn_s_memrealtime(); }
#endif
    unsigned kl[6], vl[4]; frag_offsets<96>(kl, vl, r32, hi);
    KFrags<6> fr;
    run_tiles<192, true, AL_K96, 16384, AL_V96>(ntile, dt, dt + 1, dt + 1, lds, w, lane, 192u, (unsigned)(S * 2),
        [&](int i) { return km + (size_t)i * 64 * 192; }, [&](int i) { return vmt + (size_t)i * 128; },
        [&](int i, LAS unsigned char* kb, LAS unsigned char* vb, LAS unsigned char* kn) { tile_compute<96, 256, false>(st, fr, kn, vb, qf, negm, kl, vl, true, [&](int r, int half, float& x) { return true; }); },
        [&](int i, LAS unsigned char* kb, LAS unsigned char* vb, LAS unsigned char* kn) { const int kb0 = 64 * i + 4 * hi; tile_compute<96, 256, false>(st, fr, kn, vb, qf, negm, kl, vl, true, [&](int r, int half, float& x) { return (kb0 + 32 * half + (r & 3) + 8 * (r >> 2)) <= tq; }); },
        NoComp{}, [&](LAS unsigned char* kb) { kfrag_load<96, 256>(fr, kb, kl); });
#ifdef PROF_SEL
    if (b == 0 && h == 0 && qb == 15 && threadIdx.x == 0) { *PROF_SLOT(36) += __builtin_amdgcn_s_memtime(); *PROF_SLOT(37) += __builtin_amdgcn_s_memrealtime(); }
#endif
    {
        const float lt = st.l + __shfl_xor(st.l, 32); const float f = lt > 0.f ? frcp(lt) : 0.f;
#pragma unroll
        for (int r = 0; r < 16; ++r) { const float fr_ = __shfl(f, crow(r, hi)); const size_t ro = ((size_t)b * S + qb * 256 + 32 * w + crow(r, hi)) * 1024 + 512 + h * 64 + r32; ocat[ro] = f2bf(st.o0[r] * fr_); ocat[ro + 32] = f2bf(st.o1[r] * fr_); }
    }
}

__device__ __forceinline__ void nsa_unit(const Params& p, LAS unsigned char* lds, int b, int g, int jt) {
    int tid = threadIdx.x; asm volatile("" : "+v"(tid));
    const int lane = tid & 63, w = __builtin_amdgcn_readfirstlane(tid >> 6), r32 = lane & 31, hi = lane >> 5;
    const int rh = w >> 1, qh = w & 1, h = 4 * g + rh, q0 = 64 * jt, ql = 32 * qh + r32, tq = q0 + ql;
    const unsigned char* xa = p.ws + R_XA;
    const bf16_t* qn = (const bf16_t*)(xa + A_QN);
    const size_t bg = (size_t)b * 2 + g;
    const unsigned char* ksn = xa + A_KSN + bg * S * 128; const unsigned char* kwn = xa + A_KWN + bg * S * 128;
    const unsigned char* vst = xa + A_VST + bg * 64 * (size_t)S * 2; const unsigned char* vwt = xa + A_VWT + bg * 64 * (size_t)S * 2;
    const unsigned char* kc = p.ws + SM_KC + bg * 256 * 128; const unsigned char* vct = p.ws + SM_VCT + bg * 64 * 512;
    const float* gates = (const float*)(xa + A_GATES) + ((size_t)b * S + tq) * 24 + h * 3;
    bf16_t* ocat = (bf16_t*)(p.ws + R_XN);
    LAS float* imp = (LAS float*)(lds + AL_IMP); LAS unsigned char* selb = lds + AL_SELB; LAS unsigned* uni = (LAS unsigned*)(lds + AL_UNI); LAS unsigned char* tl = lds + AL_TL; LAS float* bls = (LAS float*)(lds + AL_BL);
    const float* blg = (const float*)(p.ws + SM_BL) + h * 132;
    const float cb = blg[128];
    const float bmax = wmax(fmaxf(fmaxf(blg[lane], blg[64 + lane]), cb));
    if (qh == 0) { bls[rh * 132 + lane] = blg[lane] - cb; bls[rh * 132 + 64 + lane] = blg[64 + lane] - cb; if (lane == 0) bls[rh * 132 + 128] = 0.f; }
    const LAS float* blh = bls + rh * 132;
    bf16x8 qf[4];
#pragma unroll
    for (int s = 0; s < 4; ++s) qf[s] = *(const bf16x8*)(qn + (((size_t)b * S + tq) * 8 + h) * 64 + 16 * s + 8 * hi);
    const float kn = 8.f * 1.01f * wmax(fmaxf(fmaxf(fabsf(p.in[5][lane]), fabsf(p.in[5][64 + lane])), fabsf(p.in[5][128 + lane])));
    const float mref = sqrtf(qnorm2<4>(qf)) * kn + bmax;
    f32x16 negm;
#pragma unroll
    for (int r = 0; r < 16; ++r) negm[r] = cb - mref;
    float g0 = gates[0], g1 = gates[1], g2 = gates[2];
    if (p.dbg_branch >= 0) { g0 = p.dbg_branch == 0 ? 1.f : 0.f; g1 = p.dbg_branch == 1 ? 1.f : 0.f; g2 = p.dbg_branch == 2 ? 1.f : 0.f; }
    LAS float* otl = (LAS float*)(lds + AL_OT) + w * 2048;
#ifdef PROF_SEL
    if (b == 0 && g == 0 && jt == 63 && threadIdx.x == 0) *PROF_SLOT(48) -= __builtin_amdgcn_s_memtime();
#endif
    const int nvmax = (q0 + 63 - 31) / 16 + 1, ntc = (nvmax + 63) / 64;
    Flash st; flash_init(st);
    unsigned kl[4], vl[4]; frag_offsets<64>(kl, vl, r32, hi);
    KFrags<4> fr;
    const int qb32 = q0 + 32 * qh;
    int ecf = 0;
    for (int i = 0; i < ntc; ++i) if (qb32 - (16 * (64 * i + 63) + 31) >= 128) ecf = i + 1;
    run_tiles<128, true, AL_K64, 8192, AL_V64>(ntc, ecf, ntc, ntc, lds, w, lane, 128u, 512u,
        [&](int i) { return kc + (size_t)i * 64 * 128; }, [&](int i) { return vct + (size_t)i * 128; },
        [&](int i, LAS unsigned char* kb, LAS unsigned char* vb, LAS unsigned char* kn) { tile_compute<64, 128, false>(st, fr, kn, vb, qf, negm, kl, vl, true, [&](int r, int half, float& x) { return true; }); },
        [&](int i, LAS unsigned char* kb, LAS unsigned char* vb, LAS unsigned char* kn) {
            const int cb0 = 64 * i + 4 * hi;
            tile_compute<64, 128, false>(st, fr, kn, vb, qf, negm, kl, vl, true, [&](int r, int half, float& x) {
                const int c = cb0 + 32 * half + (r & 3) + 8 * (r >> 2); const int dist = tq - 16 * c - 31; x += blh[dist < 0 ? 0 : (dist > 128 ? 128 : dist)]; return dist >= 0; });
        },
        NoComp{}, [&](LAS unsigned char* kb) { kfrag_load<64, 128>(fr, kb, kl); });
    flash_accum<true>(otl, st, g0, hi, lane);
    unsigned mlo, mhi;
    int nsel;
    if (jt < 16) { const unsigned long long mk = (1ull << (jt + 1)) - 1ull; mlo = (unsigned)mk; mhi = (unsigned)(mk >> 32); nsel = jt + 1; if (tid <= jt) tl[tid] = (unsigned char)tid; }
    else {
        for (int i = tid; i < 64 * 65; i += 512) imp[i] = 0.f;
        const float lt = st.l + __shfl_xor(st.l, 32); const float linv = lt > 0.f ? frcp(lt) : 0.f;
        float xlast = 0.f;
        run_tiles<128, false, AL_K64, 8192, AL_V64>(ntc, ntc, ntc, ntc, lds, w, lane, 128u, 0u,
            [&](int i) { return kc + (size_t)i * 64 * 128; }, [&](int i) { return kc; },
            [&](int i, LAS unsigned char* kb, LAS unsigned char* vb, LAS unsigned char* kn) {
                f32x16 p0, p1; qk_tile<64, 128>(p0, p1, kb, qf, negm, kl);
                const int cb0 = 64 * i + 4 * hi;
                float sm[2][4], cr[2][4];
#pragma unroll
                for (int half = 0; half < 2; ++half)
#pragma unroll
                    for (int a = 0; a < 4; ++a) {
                        float s4 = 0.f, last = 0.f;
#pragma unroll
                        for (int k = 0; k < 4; ++k) {
                            const int r = 4 * a + k; const int c = cb0 + 32 * half + k + 8 * a; const int dist = tq - 16 * c - 31;
                            const float sc = (half ? p1[r] : p0[r]) + blh[dist < 0 ? 0 : (dist > 128 ? 128 : dist)];
                            const float pv = dist >= 0 ? fexp2(sc) * linv : 0.f;
                            s4 += pv; last = pv;
                        }
                        sm[half][a] = s4; cr[half][a] = last;
                    }
                float tot[2][4];
#pragma unroll
                for (int half = 0; half < 2; ++half)
#pragma unroll
                    for (int a = 0; a < 4; ++a) {
                        const float xs_ = __shfl_xor(cr[half][a], 32);
                        const float xp_ = (a > 0) ? __shfl_xor(cr[half][a > 0 ? a - 1 : 0], 32) : (half ? __shfl_xor(cr[0][3], 32) : xlast);
                        tot[half][a] = sm[half][a] + (hi ? xs_ : xp_);
                    }
                xlast = __shfl_xor(cr[1][3], 32);
                for (int rr = 0; rr < 4; ++rr) {
                    if (rh == rr) {
#pragma unroll
                        for (int half = 0; half < 2; ++half)
#pragma unroll
                            for (int a = 0; a < 4; ++a) { const int j = 16 * i + 8 * half + 2 * a + hi; imp[ql * 65 + j] += tot[half][a]; }
                    }
                    __syncthreads();
                }
            }, NoComp{}, NoComp{});
        if (p.dbg_branch == 1) { for (int i = tid; i < 4096; i += 512) ((float*)(p.ws + R_H))[((size_t)g * S + q0 + (i >> 6)) * 64 + (i & 63)] = imp[(i >> 6) * 65 + (i & 63)]; }
        {
            const int q = tid >> 3, jg = tid & 7;
            unsigned long long kj[8]; int rk[8];
#pragma unroll
            for (int jj = 0; jj < 8; ++jj) { const int j = jg * 8 + jj; const float x = imp[q * 65 + j]; const float v = (j > jt) ? 0.f : ((j == jt || j == 0) ? 1e9f : x);
                kj[jj] = ((unsigned long long)__builtin_bit_cast(unsigned, v) << 6) | (unsigned)(63 - j); rk[jj] = 0; }
#pragma unroll 4
            for (int i = 0; i <= jt; ++i) {
                const float xi = imp[q * 65 + i]; const float vi = (i == jt || i == 0) ? 1e9f : xi;
                const unsigned long long ki = ((unsigned long long)__builtin_bit_cast(unsigned, vi) << 6) | (unsigned)(63 - i);
#pragma unroll
                for (int jj = 0; jj < 8; ++jj) rk[jj] += (ki > kj[jj]) ? 1 : 0;
            }
            unsigned byte = 0;
#pragma unroll
            for (int jj = 0; jj < 8; ++jj) if (jg * 8 + jj <= jt && rk[jj] < 16) byte |= 1u << jj;
            selb[q * 8 + jg] = (unsigned char)byte;
        }
        __syncthreads();
        if (w == 0) {
            unsigned a = ((const LAS unsigned*)selb)[lane * 2], c = ((const LAS unsigned*)selb)[lane * 2 + 1];
#pragma unroll
            for (int o = 1; o < 64; o <<= 1) { a |= __shfl_xor(a, o); c |= __shfl_xor(c, o); }
            const unsigned long long um = ((unsigned long long)c << 32) | a;
            if ((um >> lane) & 1ull) tl[__builtin_popcountll(um & ((1ull << lane) - 1ull))] = (unsigned char)lane;
            if (lane == 0) uni[0] = (unsigned)__builtin_popcountll(um);
        }
        __syncthreads();
        mlo = ((const LAS unsigned*)selb)[ql * 2]; mhi = ((const LAS unsigned*)selb)[ql * 2 + 1];
        nsel = (int)uni[0];
    }
    if (p.dbg_branch == 1 && rh == 0) { if (hi == 0) ((unsigned long long*)(p.ws + R_H + 4 * 1048576))[(size_t)g * S + tq] = ((unsigned long long)mhi << 32) | mlo; }
    __syncthreads();
    {
        const unsigned long long mymask = ((unsigned long long)mhi << 32) | mlo;
        nsel = __builtin_amdgcn_readfirstlane(nsel);
        const int mytl = (int)tl[lane];
        flash_init(st);
        const int jfar = qb32 >= 191 ? (qb32 - 191) >> 6 : -1;
        const int nfar = (int)__builtin_popcountll(__ballot(lane < nsel && mytl <= jfar));
        run_tiles<128, true, AL_K64, 8192, AL_V64>(nsel, nfar, nsel, nsel, lds, w, lane, 128u, (unsigned)(S * 2),
            [&](int i) { return ksn + (size_t)__builtin_amdgcn_readlane(mytl, i) * 64 * 128; }, [&](int i) { return vst + (size_t)__builtin_amdgcn_readlane(mytl, i) * 128; },
            [&](int i, LAS unsigned char* kb, LAS unsigned char* vb, LAS unsigned char* kn) {
                const int j = __builtin_amdgcn_readlane(mytl, i);
                const bool mine = (mymask >> j) & 1ull;
                tile_compute<64, 128, true>(st, fr, kn, vb, qf, negm, kl, vl, mine, [&](int r, int half, float& x) { return true; });
            },
            [&](int i, LAS unsigned char* kb, LAS unsigned char* vb, LAS unsigned char* kn) {
                const int j = __builtin_amdgcn_readlane(mytl, i);
                const bool mine = (mymask >> j) & 1ull;
                const int kb0 = 64 * j + 4 * hi;
                tile_compute<64, 128, true>(st, fr, kn, vb, qf, negm, kl, vl, mine, [&](int r, int half, float& x) { const int dist = tq - (kb0 + 32 * half + (r & 3) + 8 * (r >> 2)); x += blh[dist < 0 ? 0 : (dist > 128 ? 128 : dist)]; return dist >= 0; });
            },
            NoComp{}, [&](LAS unsigned char* kb) { kfrag_load<64, 128>(fr, kb, kl); });
        flash_accum<false>(otl, st, g1, hi, lane);
    }
    {
        const int j0 = jt >= 8 ? jt - 8 : 0, nw = jt - j0 + 1;
        flash_init(st);
        const int jfar = qb32 >= 191 ? (qb32 - 191) >> 6 : -1, jin = qb32 >= 481 ? ((qb32 - 481) >> 6) + 1 : 0;
        int ew0 = jin - j0; ew0 = ew0 < 0 ? 0 : (ew0 > nw ? nw : ew0);
        int ew1 = jfar + 1 - j0; ew1 = ew1 < ew0 ? ew0 : (ew1 > nw ? nw : ew1);
        auto wedge = [&](int i, LAS unsigned char* kb, LAS unsigned char* vb, LAS unsigned char* kn) {
            const int j = j0 + i, kb0 = 64 * j + 4 * hi;
            tile_compute<64, 128, false>(st, fr, kn, vb, qf, negm, kl, vl, true, [&](int r, int half, float& x) { const int dist = tq - (kb0 + 32 * half + (r & 3) + 8 * (r >> 2)); x += blh[dist < 0 ? 0 : (dist > 128 ? 128 : dist)]; return dist >= 0 && dist < 512; });
        };
        run_tiles<128, true, AL_K64, 8192, AL_V64>(nw, ew0, ew1, nw, lds, w, lane, 128u, (unsigned)(S * 2),
            [&](int i) { return kwn + (size_t)(j0 + i) * 64 * 128; }, [&](int i) { return vwt + (size_t)(j0 + i) * 128; },
            wedge,
            [&](int i, LAS unsigned char* kb, LAS unsigned char* vb, LAS unsigned char* kn) { tile_compute<64, 128, false>(st, fr, kn, vb, qf, negm, kl, vl, true, [&](int r, int half, float& x) { return true; }); },
            wedge, [&](LAS unsigned char* kb) { kfrag_load<64, 128>(fr, kb, kl); });
        flash_accum<false>(otl, st, g2, hi, lane);
    }
#pragma unroll
    for (int r = 0; r < 16; ++r) { const size_t ro = ((size_t)b * S + q0 + 32 * qh + crow(r, hi)) * 1024 + h * 64 + r32; ocat[ro] = f2bf(otl[r * 64 + lane]); ocat[ro + 32] = f2bf(otl[(16 + r) * 64 + lane]); }
    __syncthreads();
#ifdef PROF_SEL
    if (b == 0 && g == 0 && jt == 63 && threadIdx.x == 0) *PROF_SLOT(48) += __builtin_amdgcn_s_memtime();
#endif
}

__device__ __forceinline__ void phase_p4(const Params& p, LAS unsigned char* lds) {
    const int G = gridDim.x, c = blockIdx.x, nunits = 256 * NB;
#if NB == 8
    if (G == 256) {
        const int b = c & 7, idx = c >> 3, pi = idx & 7, hq = idx >> 3;
#pragma unroll 1
        for (int u = 0; u < 8; ++u) {
            if (u == (idx & 7)) { convert_weights(p, lds, WD_EARLY, 14); __syncthreads(); }
            if (u < 4) { const int ix = (u >> 1) ? ((idx + 16) & 31) : idx;
                nsa_unit(p, lds, b, u >> 1, (u & 1) ? ix : 63 - ix); }
            else mla_unit(p, lds, b, ((u - 4) >> 1) * 4 + hq, (u & 1) ? pi : 15 - pi);
        }
        return;
    }
#endif
    convert_weights(p, lds, WD_EARLY, 14); __syncthreads();
    for (int j = 0;; ++j) {
        const int k = j * G + ((j & 1) ? (G - 1 - c) : c);
        if (j * G >= nunits) break;
        if (k >= nunits) continue;
        const int ty = UNIT_TYPES[k / NB], b = k % NB, kind = ty >> 9, a = (ty >> 6) & 7, cc = ty & 63;
        if (kind == 0) nsa_unit(p, lds, b, a, cc); else mla_unit(p, lds, b, a, cc);
    }
}
__device__ __forceinline__ void phase_norm(const float* x, const float* g, bf16_t* xn) {
    const int tid_ = ltid(); const int lane = tid_ & 63, gw = blockIdx.x * 8 + (tid_ >> 6), NGW = gridDim.x * 8;
    for (int m = gw; m < T; m += NGW) rms_row_to_bf16(x + (size_t)m * D, g, xn + (size_t)m * D, lane);
}
__device__ __forceinline__ void phase_conv(const Params& p) {
    const int tid = ltid(), lane = tid & 63, gw = blockIdx.x * 8 + (tid >> 6), NGW = gridDim.x * 8;
    const bf16_t* bg = (const bf16_t*)(p.ws + R_H); const bf16_t* cu = (const bf16_t*)(p.ws + R_H + (size_t)T * 2048); bf16_t* v = (bf16_t*)(p.ws + R_XA); const float* cw = p.in[22];
    constexpr int RUN = 16;
    float w0[2][8], w1[2][8], w2[2][8];
#pragma unroll
    for (int j = 0; j < 2; ++j) { const int d = 8 * lane + 512 * j; load8f(cw + d, w0[j], 1.f); load8f(cw + 1024 + d, w1[j], 1.f); load8f(cw + 2048 + d, w2[j], 1.f); }
    for (int run = gw; run < T / RUN; run += NGW) {
        const int m0 = run * RUN, s0 = m0 & (S - 1);
        float pm2[2][8], pm1[2][8];
#pragma unroll
        for (int j = 0; j < 2; ++j) { const int d = 8 * lane + 512 * j;
#pragma unroll
            for (int q = 0; q < 2; ++q) {
                float (&dst)[8] = q ? pm1[j] : pm2[j];
                if (s0 - 2 + q >= 0) unpack8(*(const u32x4*)(cu + (size_t)(m0 - 2 + q) * 1024 + d), dst);
                else {
#pragma unroll
                    for (int i = 0; i < 8; ++i) dst[i] = 0.f; }
            } }
#pragma unroll 4
        for (int rr = 0; rr < RUN; ++rr) {
            const int m = m0 + rr;
#pragma unroll
            for (int j = 0; j < 2; ++j) { const int d = 8 * lane + 512 * j;
                float b[8], c[8], y[8]; unpack8(*(const u32x4*)(bg + (size_t)m * 1024 + d), b); unpack8(*(const u32x4*)(cu + (size_t)m * 1024 + d), c);
#pragma unroll
                for (int i = 0; i < 8; ++i) { y[i] = b[i] * (w0[j][i] * pm2[j][i] + w1[j][i] * pm1[j][i] + w2[j][i] * c[i]); pm2[j][i] = pm1[j][i]; pm1[j][i] = c[i]; }
                *(u32x4*)(v + (size_t)m * 1024 + d) = pack8(y); }
        }
    }
}
__device__ __forceinline__ void phase_norm_router(const Params& p, LAS unsigned char* lds) {
    const int tid = ltid(), lane = tid & 63, wave = tid >> 6, gw = blockIdx.x * 8 + wave, NGW = gridDim.x * 8;
    const bf16_t* x3 = (const bf16_t*)(p.ws + R_XN); const float* g = p.in[24]; float* rsd = (float*)(p.ws + SM_RSTD3);
    LAS float* wr = (LAS float*)lds;
    LAS int* lcnt = (LAS int*)(lds + 40960); LAS int* gb = lcnt + 8;
    int* te = (int*)(p.ws + SM_TE); float* tw = (float*)(p.ws + SM_TW); int* rank = (int*)(p.ws + SM_RANK); int* cnt = (int*)(p.ws + SM_CTL);
    for (int i = tid; i < 8192; i += 512) { const int dd = i >> 3; wr[dd * 8 + (dd >> 2) * 4 + (i & 7)] = p.in[25][i] * g[dd]; }
    if (tid < 8) lcnt[tid] = 0;
    __syncthreads();
    u32x2 nx[4];
#pragma unroll
    for (int j = 0; j < 4; ++j) nx[j] = ((const u32x2*)(x3 + (size_t)(gw < T ? gw : 0) * D) + lane)[64 * j];
    for (int m = gw; m < T; m += NGW) {
        f32x4 v[4]; float s = 0.f;
#pragma unroll
        for (int j = 0; j < 4; ++j) { const u32x2 t = nx[j]; v[j] = (f32x4){bflo(t.x), bfhi(t.x), bflo(t.y), bfhi(t.y)}; s += (v[j].x * v[j].x + v[j].y * v[j].y) + (v[j].z * v[j].z + v[j].w * v[j].w); }
        { const int mn = m + NGW < T ? m + NGW : m;
#pragma unroll
            for (int j = 0; j < 4; ++j) nx[j] = ((const u32x2*)(x3 + (size_t)mn * D) + lane)[64 * j]; }
        float lg[8];
#pragma unroll
        for (int e = 0; e < 8; ++e) lg[e] = 0.f;
#pragma unroll
        for (int j = 0; j < 4; ++j) {
#pragma unroll
            for (int i = 0; i < 4; ++i) { const int d = 4 * lane + 256 * j + i; const f32x4 w0 = *(const LAS f32x4*)(wr + d * 8 + (d >> 2) * 4), w1 = *(const LAS f32x4*)(wr + d * 8 + (d >> 2) * 4 + 4); const float y = v[j][i];
                lg[0] += y * w0.x; lg[1] += y * w0.y; lg[2] += y * w0.z; lg[3] += y * w0.w; lg[4] += y * w1.x; lg[5] += y * w1.y; lg[6] += y * w1.z; lg[7] += y * w1.w; } }
        const float r = rsqrtf(wsum(s) * (1.f / 1024.f) + EPS);
#pragma unroll
        for (int e = 0; e < 8; ++e) lg[e] = wsum(lg[e]) * r + p.in[26][e];
        int e1 = 0; float l1 = lg[0];
#pragma unroll
        for (int e = 1; e < 8; ++e) if (lg[e] > l1) { l1 = lg[e]; e1 = e; }
        int e2 = -1; float l2 = -3e38f;
#pragma unroll
        for (int e = 0; e < 8; ++e) if (e != e1 && lg[e] > l2) { l2 = lg[e]; e2 = e; }
        if (lane == 0) {
            const float w1 = 1.f / (1.f + __expf(l2 - l1));
            te[m * 2] = e1; te[m * 2 + 1] = e2; tw[m * 2] = w1; tw[m * 2 + 1] = 1.f - w1; rsd[m] = r;
            rank[m * 2] = __hip_atomic_fetch_add(&lcnt[e1], 1, __ATOMIC_RELAXED, __HIP_MEMORY_SCOPE_WORKGROUP); rank[m * 2 + 1] = __hip_atomic_fetch_add(&lcnt[e2], 1, __ATOMIC_RELAXED, __HIP_MEMORY_SCOPE_WORKGROUP);
        }
    }
    __syncthreads();
    if (tid < 8) gb[tid] = atomicAdd(&cnt[tid], lcnt[tid]);
    __syncthreads();
    for (int m = gw; m < T; m += NGW) if (lane < 2) rank[m * 2 + lane] += gb[te[m * 2 + lane]];
}
__device__ __forceinline__ void phase_moe_gather(const Params& p) {
    const int tid = ltid(), lane = tid & 63, gw = blockIdx.x * 8 + (tid >> 6), NGW = gridDim.x * 8;
    const int* cnt = (const int*)(p.ws + SM_CTL); const int* te = (const int*)(p.ws + SM_TE); const float* tw = (const float*)(p.ws + SM_TW); const int* rank = (const int*)(p.ws + SM_RANK);
    int* pos = (int*)(p.ws + SM_POS); float* roww = (float*)(p.ws + SM_ROWW); int* tile_e = (int*)(p.ws + SM_TILEE);
    int* rowtok = (int*)(p.ws + SM_ROWTOK); const float* rsd = (const float*)(p.ws + SM_RSTD3); float* rowrs = (float*)(p.ws + SM_ROWRS);
    int off[9]; off[0] = 0;
#pragma unroll
    for (int e = 0; e < 8; ++e) off[e + 1] = off[e] + ((cnt[e] + 255) & ~255);
    if (blockIdx.x == 0) {
        for (int i = tid; i < ROWS_MAX / 256; i += 512) { int e = -1;
#pragma unroll
            for (int k = 0; k < 8; ++k) if (i * 256 >= off[k] && i * 256 < off[k + 1]) e = k;
            tile_e[i] = e < 0 ? 0 : e; }
        if (tid == 0) ((int*)(p.ws + SM_CTL))[8] = off[8];
    }
    if (blockIdx.x < 8 && tid < 256) {
#pragma unroll
        for (int e = 0; e < 8; ++e) if (e == (int)blockIdx.x) { const int c = cnt[e]; if (c + tid < off[e + 1] - off[e]) { roww[off[e] + c + tid] = 0.f; rowrs[off[e] + c + tid] = 0.f; rowtok[off[e] + c + tid] = -1; } }
    }
    for (int pi0 = gw * 4; pi0 < 2 * T; pi0 += NGW * 4) {
        int r[4]; float w[4], rs[4];
#pragma unroll
        for (int q = 0; q < 4; ++q) { const int e = te[pi0 + q]; int o = 0;
#pragma unroll
            for (int k = 0; k < 8; ++k) if (k == e) o = off[k];
            r[q] = o + rank[pi0 + q]; w[q] = tw[pi0 + q]; rs[q] = rsd[(pi0 + q) >> 1]; }
#pragma unroll
        for (int q = 0; q < 4; ++q) if (lane == q) { pos[pi0 + q] = r[q]; roww[r[q]] = w[q]; rowrs[r[q]] = rs[q]; rowtok[r[q]] = (pi0 + q) >> 1; }
    }
}
__device__ __forceinline__ void phase_moe_combine(const Params& p) {
    const int tid_ = ltid(); const int lane = tid_ & 63, gw = blockIdx.x * 8 + (tid_ >> 6), NGW = gridDim.x * 8;
    const int* pos = (const int*)(p.ws + SM_POS); const bf16_t* ym = (const bf16_t*)(p.ws + R_XA); const bf16_t* x3 = (const bf16_t*)(p.ws + R_XN);
    for (int m0 = gw * 2; m0 < T; m0 += NGW * 2) {
        int ps[4];
#pragma unroll
        for (int q = 0; q < 4; ++q) ps[q] = pos[m0 * 2 + q];
        f32x4 x[2][4]; u32x2 ya[2][4], yc[2][4];
#pragma unroll
        for (int q = 0; q < 2; ++q)
#pragma unroll
            for (int j = 0; j < 4; ++j) { const int d = 4 * lane + 256 * j;
                { const u32x2 t = *(const u32x2*)(x3 + (size_t)(m0 + q) * D + d); x[q][j] = (f32x4){bflo(t.x), bfhi(t.x), bflo(t.y), bfhi(t.y)}; } ya[q][j] = *(const u32x2*)(ym + (size_t)ps[2 * q] * D + d); yc[q][j] = *(const u32x2*)(ym + (size_t)ps[2 * q + 1] * D + d); }
#pragma unroll
        for (int q = 0; q < 2; ++q)
#pragma unroll
            for (int j = 0; j < 4; ++j) { const int d = 4 * lane + 256 * j; f32x4 o = x[q][j]; const u32x2 a = ya[q][j], c = yc[q][j];
                o.x += bflo(a.x) + bflo(c.x); o.y += bfhi(a.x) + bfhi(c.x); o.z += bflo(a.y) + bflo(c.y); o.w += bfhi(a.y) + bfhi(c.y);
                *(f32x4*)(p.out + (size_t)(m0 + q) * D + d) = o; }
    }
}

#define XB_TMO      128
#define XB_XCNT(j)  (256  + 64 * (j))
#define XB_XSUB(j)  (1280 + 64 * (j))
#define XB_XGEN(j)  (2304 + 64 * (j))
#define XB_TOP      3328
#define XB_TOPGEN   3392
#define XCD_BAR_WORDS 3456
#define XB_SPIN_CAP (1u << 18)

__device__ __forceinline__ unsigned xb_ld(unsigned* p)              { return __hip_atomic_load(p, __ATOMIC_RELAXED, __HIP_MEMORY_SCOPE_AGENT); }
__device__ __forceinline__ unsigned xb_add(unsigned* p, unsigned v) { return __hip_atomic_fetch_add(p, v, __ATOMIC_RELAXED, __HIP_MEMORY_SCOPE_AGENT); }
__device__ __forceinline__ unsigned xb_xcc_id() { return (unsigned)__builtin_amdgcn_s_getreg((3 << 11) | 20) & 0xFu; }
#define XB_SPIN(cond, bar) do { unsigned _sp = 0; while (cond) { __builtin_amdgcn_s_sleep(1); \
    if ((++_sp & 255u) == 0u) { if (xb_ld(&(bar)[XB_TMO])) break; if (_sp > XB_SPIN_CAP) { atomicAdd(&(bar)[XB_TMO], 1u); break; } } } } while (0)

struct XcdBarrier {
    unsigned* bar; unsigned x;
    volatile LAS unsigned* st;
};

__device__ __forceinline__ XcdBarrier xcd_barrier_post(unsigned* bar, volatile LAS unsigned* st) {
    XcdBarrier b; b.bar = bar; b.x = xb_xcc_id(); b.st = st;
    if (threadIdx.x == 0) (void)xb_add(&bar[XB_XCNT(b.x)], 1u);
    return b;
}
__device__ __forceinline__ void xcd_barrier_complete(unsigned* bar, unsigned x, unsigned& nloc, unsigned& nx) {
    const unsigned G = gridDim.x * gridDim.y * gridDim.z;
    unsigned sum, cnt, mine, sp = 0u;
    for (;;) {
        sum = 0u; cnt = 0u; mine = 0u;
#pragma unroll
        for (unsigned j = 0; j < 16; ++j) { const unsigned c = xb_ld(&bar[XB_XCNT(j)]); sum += c; cnt += (c > 0u) ? 1u : 0u; mine = (j == x) ? c : mine; }
        if (sum == G) break;
        __builtin_amdgcn_s_sleep(1);
        if ((++sp & 255u) == 0u) { if (xb_ld(&bar[XB_TMO])) break; if (sp > XB_SPIN_CAP) { atomicAdd(&bar[XB_TMO], 1u); break; } }
    }
    nloc = mine > 0u ? mine : 1u; nx = cnt > 0u ? cnt : 1u;
}

__device__ __forceinline__ void xcd_barrier(const XcdBarrier& b) {
    asm volatile("s_waitcnt vmcnt(0)" ::: "memory");
    __syncthreads();
    if (threadIdx.x == 0) {
        unsigned* bar = b.bar;
        __builtin_amdgcn_s_waitcnt(0);
        unsigned nloc = b.st[0], nx = b.st[1];
        if (nloc == 0u) { xcd_barrier_complete(bar, b.x, nloc, nx); b.st[0] = nloc; b.st[1] = nx; }
        const unsigned old = xb_add(&bar[XB_XSUB(b.x)], 1u);
        const unsigned gen = old / nloc;
        if (old + 1u == (gen + 1u) * nloc) {
            __builtin_amdgcn_fence(__ATOMIC_RELEASE, "agent");
            asm volatile("s_waitcnt vmcnt(0)" ::: "memory");
            const unsigned og = xb_add(&bar[XB_TOP], 1u);
            const unsigned tg = og / nx;
            if (og + 1u == (tg + 1u) * nx) xb_add(&bar[XB_TOPGEN], 1u);
            else XB_SPIN(xb_ld(&bar[XB_TOPGEN]) == tg, bar);
            __builtin_amdgcn_fence(__ATOMIC_ACQUIRE, "agent");
            xb_add(&bar[XB_XGEN(b.x)], 1u);
            asm volatile("s_waitcnt vmcnt(0)" ::: "memory");
        } else {
            XB_SPIN(xb_ld(&bar[XB_XGEN(b.x)]) == gen, bar);
            __builtin_amdgcn_fence(__ATOMIC_ACQUIRE, "agent");
            asm volatile("s_waitcnt vmcnt(0)" ::: "memory");
        }
    }
    __syncthreads();
}


__global__ void __launch_bounds__(512) mega_fwd(Params p) {
    extern __shared__ __attribute__((aligned(16))) unsigned char lds_raw[];
    LAS unsigned char* lds = (LAS unsigned char*)lds_raw;
    cg::grid_group grid = cg::this_grid();
    volatile LAS unsigned* bst = (volatile LAS unsigned*)(lds + 163328);
    if (threadIdx.x == 0) { bst[0] = 0u; bst[1] = 0u; const unsigned long long ba = (unsigned long long)(p.ws + SM_BAR); bst[2] = (unsigned)ba; bst[3] = (unsigned)(ba >> 32); }
    __syncthreads();
    (void)xcd_barrier_post((unsigned*)(p.ws + SM_BAR), bst);
#ifdef PROF_SEL
#define PSTAMP(k) do { if (blockIdx.x == 0 && threadIdx.x == 0) { volatile LAS unsigned* pl_ = (volatile LAS unsigned*)(lds + 163328 + 16); const unsigned long long now_ = __builtin_amdgcn_s_memrealtime(); const unsigned long long last_ = ((unsigned long long)pl_[1] << 32) | pl_[0]; *PROF_SLOT(k) += now_ - last_; pl_[0] = (unsigned)now_; pl_[1] = (unsigned)(now_ >> 32); } } while (0)
#else
#define PSTAMP(k)
#endif
#define GSYNC() do { XcdBarrier xb_; volatile LAS unsigned* st_ = (volatile LAS unsigned*)(lds + 163328); xb_.bar = (unsigned*)(((unsigned long long)st_[3] << 32) | st_[2]); xb_.x = xb_xcc_id(); xb_.st = st_; xcd_barrier(xb_); } while (0)
#ifdef PROF_SEL
    if (threadIdx.x == 0) { volatile LAS unsigned* pl_ = (volatile LAS unsigned*)(lds + 163328 + 16); const unsigned long long now_ = __builtin_amdgcn_s_memrealtime(); pl_[0] = (unsigned)now_; pl_[1] = (unsigned)(now_ >> 32); }
#endif
    const int G = gridDim.x, c = blockIdx.x;
#define LP() bf16_t* W = (bf16_t*)p.ws; bf16_t* xn = (bf16_t*)(p.ws + R_XN); float* x1 = (float*)(p.ws + R_XA); pg8::StaticOrder SO; (void)W; (void)xn; (void)x1; (void)SO
#ifndef PHMASK
#define PHMASK 0xFFFFFFFFu
#endif
#ifndef REPEAT_MASK
#define REPEAT_MASK 0u
#endif
#define PH(k) if (((PHMASK >> (k)) & 1u) && (k) >= p.ph_lo && (k) <= p.ph_hi)
#define RPT(k) if ((REPEAT_MASK >> (k)) & 1u)
    PH(0) { LP(); phase_p0(p, lds); }
    GSYNC(); PSTAMP(0);
    if (p.ph_lo == -12345) grid.sync();
    RPT(0) { { LP(); phase_p0(p, lds); } GSYNC(); }
    PH(1) for (int rp_ = 0; rp_ <= (int)((REPEAT_MASK >> 1) & 1u); ++rp_) { LP(); if (rp_) GSYNC();
        pg8::Gemm g{xn, W + W_IN_E / 2, T, 1792, 1024, 1024, nullptr, 0, nullptr}; SO.init(T, 1792, G, c);
        pg8::EpiBf16<0> E{(bf16_t*)(p.ws + R_H), 1792, nullptr, nullptr};
        pg8::gemm_phase<pg8::EpiBf16<0>, true>(lds, g, SO, E);
    }
    GSYNC(); PSTAMP(1);
    PH(2) { LP(); phase_p2(p, lds); }
    GSYNC(); PSTAMP(2);
    RPT(2) { { LP(); phase_p2(p, lds); } GSYNC(); }
    PH(3) for (int rp_ = 0; rp_ <= (int)((REPEAT_MASK >> 3) & 1u); ++rp_) { LP(); if (rp_) GSYNC();
        const int nCu = 2 * (NB * 512 / 256) * 2, Gc = (nCu < G / 2) ? nCu : 0;
        if (Gc == 0 || c < Gc) {
            for (int kv = 0; kv < 2; ++kv) {
                pg8::Gemm g{(const bf16_t*)(p.ws + R_XA + (kv ? A_VCIN : A_KCIN)), W + W_CW1 / 2 + (size_t)kv * 512 * 1024, NB * 512, 512, 1024, 1024, nullptr, 0, nullptr};
                if (Gc) SO.init(NB * 512, 512, Gc / 2, c - kv * (Gc / 2)); else SO.init(NB * 512, 512, G, c);
                pg8::EpiBf16<0> E{(bf16_t*)(p.ws + SM_HID) + (size_t)kv * NB * 512 * 512, 512, nullptr, nullptr};
                if (Gc == 0 || (c / (Gc / 2)) == kv) pg8::gemm_phase<pg8::EpiBf16<0>, true>(lds, g, SO, E);
            }
        }
        if (Gc == 0 || c >= Gc) {
            {
                pg8::Gemm g{(const bf16_t*)(p.ws + R_XA + A_CQN), W + W_UQ / 2, T, 1024, 256, 256, nullptr, 0, nullptr}; SO.init(T, 1024, G - Gc, c - Gc);
                pg8::EpiBf16<0> E{(bf16_t*)(p.ws + R_H), 1024, nullptr, nullptr};
                pg8::gemm_phase<pg8::EpiBf16<0>, true>(lds, g, SO, E);
            }
            {
                pg8::Gemm g{(const bf16_t*)(p.ws + R_XA + A_CKVN), W + W_UKV / 2, T, 1024, 128, 128, nullptr, 0, nullptr}; SO.init(T, 1024, G - Gc, c - Gc);
                pg8::EpiBf16<0> E{(bf16_t*)(p.ws + R_H + (size_t)T * 2048), 1024, nullptr, nullptr};
                pg8::gemm_phase<pg8::EpiBf16<0>, true>(lds, g, SO, E);
            }
        }
    }
    GSYNC(); PSTAMP(3);
    PH(4) { LP(); phase_p3b(p, lds); }
    GSYNC(); PSTAMP(4);
#ifndef P3B_PROBE
#define P3B_PROBE 3
#endif
    RPT(4) { { LP(); phase_p3b(p, lds, P3B_PROBE); } GSYNC(); }
    PH(5) { LP(); phase_p4(p, lds); }
    GSYNC(); PSTAMP(5);
    RPT(5) { { LP(); phase_p4(p, lds); } GSYNC(); }
    PH(6) for (int rp_ = 0; rp_ <= (int)((REPEAT_MASK >> 6) & 1u); ++rp_) { LP(); if (rp_) GSYNC();
        pg8::Gemm g{xn, W + W_OUT_E / 2, T, 1024, 1024, 1024, nullptr, 0, nullptr}; SO.init(T, 1024, G, c);
        pg8::EpiResStat<false> E{p.in[0], (bf16_t*)p.out, (float*)(p.ws + SM_SSP1), 1024};
        pg8::gemm_phase<pg8::EpiResStat<false>, true>(lds, g, SO, E);
    }
    GSYNC(); PSTAMP(6);
    PH(7) { }
    PH(8) for (int rp_ = 0; rp_ <= (int)((REPEAT_MASK >> 8) & 1u); ++rp_) { LP(); if (rp_) GSYNC();
        pg8::Gemm g{(const bf16_t*)p.out, W + W_GU / 2, T, 5632, 1024, 1024, nullptr, 0, nullptr}; SO.init(T, 5632, G, c);
        pg8::EpiSwiGLUSsp E{(bf16_t*)(p.ws + R_H), 2816, (const float*)(p.ws + SM_SSP1)};
        pg8::gemm_phase<pg8::EpiSwiGLUSsp, true>(lds, g, SO, E);
    }
    GSYNC(); PSTAMP(8);
    PH(9) for (int rp_ = 0; rp_ <= (int)((REPEAT_MASK >> 9) & 1u); ++rp_) { LP(); if (rp_) GSYNC();
        pg8::Gemm g{(const bf16_t*)(p.ws + R_H), W + W_D / 2, T, 1024, 2816, 2816, nullptr, 0, nullptr}; SO.init(T, 1024, G, c);
        pg8::EpiResStat<true> E{(const bf16_t*)p.out, xn, (float*)(p.ws + SM_SSP2), 1024};
        pg8::gemm_phase<pg8::EpiResStat<true>, true>(lds, g, SO, E);
    }
    GSYNC(); PSTAMP(9);
    PH(10) { }
    PH(11) for (int rp_ = 0; rp_ <= (int)((REPEAT_MASK >> 11) & 1u); ++rp_) { LP(); if (rp_) GSYNC();
        pg8::Gemm g{xn, W + W_IN_O / 2, T, 3072, 1024, 1024, nullptr, 0, nullptr}; SO.init(T, 3072, G, c);
        pg8::EpiConvInSsp E{(bf16_t*)(p.ws + R_H), (bf16_t*)(p.ws + R_H + (size_t)T * 2048), (const float*)(p.ws + SM_SSP2)};
        pg8::gemm_phase<pg8::EpiConvInSsp, true>(lds, g, SO, E);
    }
    GSYNC(); PSTAMP(11);
    PH(12) { LP(); phase_conv(p); }
    GSYNC(); PSTAMP(12);
    RPT(12) { { LP(); phase_conv(p); } GSYNC(); }
    PH(13) { LP();
        pg8::Gemm g{(const bf16_t*)x1, W + W_OUT_O / 2, T, 1024, 1024, 1024, nullptr, 0, nullptr}; SO.init(T, 1024, G, c);
        pg8::EpiResBf16B E{xn, xn, 1024};
        pg8::gemm_phase<pg8::EpiResBf16B, true>(lds, g, SO, E);
    }
    GSYNC(); PSTAMP(13);
    PH(14) { LP(); phase_norm_router(p, lds); }
    GSYNC(); PSTAMP(14);
    PH(15) { LP(); phase_moe_gather(p); }
    RPT(15) { GSYNC(); { LP(); phase_moe_gather(p); } }
    GSYNC(); PSTAMP(15);
    PH(16) for (int rp_ = 0; rp_ <= (int)((REPEAT_MASK >> 16) & 1u); ++rp_) { LP(); if (rp_) GSYNC();
        pg8::Gemm g{(const bf16_t*)(p.ws + R_XN), W + W_MGU / 2, 2 * T, 2816, 1024, 1024, (const int*)(p.ws + SM_TILEE), (size_t)2816 * 1024, (const int*)(p.ws + SM_ROWTOK)}; SO.init(2 * T, 2816, G, c);
        pg8::EpiSwiGLULds E{(bf16_t*)(p.ws + R_H), 1408, (const float*)(p.ws + SM_ROWRS)};
        pg8::gemm_phase<pg8::EpiSwiGLULds, true, true>(lds, g, SO, E);
    }
    GSYNC(); PSTAMP(16);
    PH(17) { LP(); const int mrows = ((const int*)(p.ws + SM_CTL))[8]; const int nx = mrows / 256 - 2 * T / 256;
        unsigned* dep = (unsigned*)(p.ws + SM_BAR) + 3584;
        const int nprod = 11 * nx < G ? 11 * nx : G, ncons = 4 * nx < G ? 4 * nx : G;
        if (c < nprod) {
            pg8::Gemm g{(const bf16_t*)(p.ws + R_XN), W + W_MGU / 2, 256 * nx, 2816, 1024, 1024, (const int*)(p.ws + SM_TILEE) + 2 * T / 256, (size_t)2816 * 1024, (const int*)(p.ws + SM_ROWTOK) + 2 * T}; SO.init(256 * nx, 2816, G, c);
            pg8::EpiSwiGLULds E{(bf16_t*)(p.ws + R_H) + (size_t)2 * T * 1408, 1408, (const float*)(p.ws + SM_ROWRS) + 2 * T};
            pg8::gemm_phase<pg8::EpiSwiGLULds, true, true>(lds, g, SO, E);
            asm volatile("s_waitcnt vmcnt(0)" ::: "memory");
            __syncthreads();
            if (threadIdx.x == 0) { __builtin_amdgcn_fence(__ATOMIC_RELEASE, "agent"); asm volatile("s_waitcnt vmcnt(0)" ::: "memory"); (void)xb_add(dep, 1u); }
        }
        {
            pg8::Gemm g{(const bf16_t*)(p.ws + R_H), W + W_MD / 2, 2 * T, 1024, 1408, 1408, (const int*)(p.ws + SM_TILEE), (size_t)1024 * 1408, nullptr}; SO.init(2 * T, 1024, G, c);
            pg8::EpiRowScaleLds E{(bf16_t*)(p.ws + R_XA), 1024, (const float*)(p.ws + SM_ROWW)};
            pg8::gemm_phase<pg8::EpiRowScaleLds, true>(lds, g, SO, E);
        }
        if (G - 1 - c < ncons) {
            if (threadIdx.x == 0) { unsigned* bar = (unsigned*)(p.ws + SM_BAR); XB_SPIN(xb_ld(dep) < (unsigned)nprod, bar); __builtin_amdgcn_fence(__ATOMIC_ACQUIRE, "agent"); asm volatile("s_waitcnt vmcnt(0)" ::: "memory"); }
            __syncthreads();
            pg8::Gemm g{(const bf16_t*)(p.ws + R_H) + (size_t)2 * T * 1408, W + W_MD / 2, 256 * nx, 1024, 1408, 1408, (const int*)(p.ws + SM_TILEE) + 2 * T / 256, (size_t)1024 * 1408, nullptr}; SO.init(256 * nx, 1024, G, G - 1 - c);
            pg8::EpiRowScaleLds E{(bf16_t*)(p.ws + R_XA) + (size_t)2 * T * 1024, 1024, (const float*)(p.ws + SM_ROWW) + 2 * T};
            pg8::gemm_phase<pg8::EpiRowScaleLds, true>(lds, g, SO, E);
        }
    }
    GSYNC(); PSTAMP(17);
    PH(18) { LP(); phase_moe_combine(p); }
    RPT(18) { GSYNC(); { LP(); phase_moe_combine(p); } }
#ifdef PROF_SEL
    GSYNC(); PSTAMP(18);
    GSYNC();
    {
        unsigned long long v_ = *PROF_SLOT(PROF_SEL);
#ifdef PROF_DIV
        const unsigned long long dv_ = *PROF_SLOT(PROF_DIV); v_ = dv_ ? v_ / dv_ : 0ull;
#endif
        unsigned long long a_ = v_ / (unsigned long long)(PROF_UNIT); if (a_ > 27ull) a_ = 27ull;
        const float sc_ = 1.f + (float)a_;
        for (size_t i = (size_t)blockIdx.x * 512 + threadIdx.x; i < (size_t)S * 1024 / 4; i += (size_t)gridDim.x * 512) { f32x4* o = (f32x4*)p.out + i; *o = *o * sc_; }
    }
#endif
#undef PH
}

inline void launch(void* const* d_in, float* d_out, void* d_ws, size_t ws_size, hipStream_t stream, int ph_lo = 0, int ph_hi = 99, int dbg_branch = -1) {
    static int grid = 0;
    if (grid == 0) {
        int dev = 0, cus = 0, per_cu = 0;
        hipGetDevice(&dev); hipDeviceGetAttribute(&cus, hipDeviceAttributeMultiprocessorCount, dev);
        hipFuncSetAttribute((const void*)mega_fwd, hipFuncAttributeMaxDynamicSharedMemorySize, LDS_BYTES);
        hipOccupancyMaxActiveBlocksPerMultiprocessor(&per_cu, (const void*)mega_fwd, 512, LDS_BYTES);
        if (per_cu < 1) { fprintf(stderr, "occupancy query says %d blocks/CU\n", per_cu); per_cu = 1; }
        grid = cus;
        if (WS_FAST_END > ws_size) { fprintf(stderr, "ws too small: need %zu have %zu\n", (size_t)WS_FAST_END, ws_size); grid = -1; }
    }
    if (grid < 0) return;
    if (ph_lo <= 14 && ph_hi >= 14) hipMemsetAsync((char*)d_ws + SM_CTL, 0, 4096, stream);
    hipMemsetAsync((char*)d_ws + SM_BAR, 0, 16384, stream);
    Params p{};
    for (int i = 0; i < 30; ++i) p.in[i] = (const float*)d_in[i];
    p.out = d_out; p.ws = (unsigned char*)d_ws; p.ph_lo = ph_lo; p.ph_hi = ph_hi; p.dbg_branch = dbg_branch;
    void* args[] = {&p};
    hipError_t e = hipLaunchCooperativeKernel((const void*)mega_fwd, dim3(grid), dim3(512), args, LDS_BYTES, stream);
    if (e != hipSuccess) fprintf(stderr, "cooperative launch failed: %s (grid %d)\n", hipGetErrorString(e), grid);
}
}
extern "C" void kernel_launch(void* const* d_in, const int* in_sizes, int n_in, void* d_out, int out_size, void* d_ws, size_t ws_size, hipStream_t stream) {
    fast::launch(d_in, (float*)d_out, d_ws, ws_size, stream);
}
```

```cpp
#include <hip/hip_runtime.h>
#include <hip/hip_bf16.h>
#include <stdint.h>
#include <stdio.h>
#include <string.h>
#include <hip/hip_cooperative_groups.h>
namespace cg = cooperative_groups;
#define NB 8
#define REPEAT_MASK 0x0u
namespace gold {
constexpr int S = 4096, D = 1024, HW = 1720;
constexpr float EPS = 1e-6f;

__device__ const unsigned char T5B[128] = {0, 1, 2, 3, 4, 5, 6, 7, 8, 9, 10, 11, 12, 13, 14, 15, 16, 16, 16, 17, 17, 18, 18, 18, 19, 19, 19, 20, 20, 20, 20, 21, 21, 21, 21, 22, 22, 22, 22, 22, 23, 23, 23, 23, 23, 23, 24, 24, 24, 24, 24, 24, 25, 25, 25, 25, 25, 25, 25, 26, 26, 26, 26, 26, 26, 26, 26, 27, 27, 27, 27, 27, 27, 27, 27, 27, 27, 28, 28, 28, 28, 28, 28, 28, 28, 28, 28, 29, 29, 29, 29, 29, 29, 29, 29, 29, 29, 29, 29, 30, 30, 30, 30, 30, 30, 30, 30, 30, 30, 30, 30, 30, 30, 31, 31, 31, 31, 31, 31, 31, 31, 31, 31, 31, 31, 31, 31};
}
#ifndef NB
#define NB 8
#endif
namespace fast {
#define LAS __attribute__((address_space(3)))
typedef unsigned short bf16_t;
typedef short bf16x8 __attribute__((ext_vector_type(8)));
typedef float f32x4 __attribute__((ext_vector_type(4)));
typedef float f32x2 __attribute__((ext_vector_type(2)));
typedef float f32x16 __attribute__((ext_vector_type(16)));
typedef unsigned u32x4 __attribute__((ext_vector_type(4)));
typedef unsigned u32x2 __attribute__((ext_vector_type(2)));
typedef __bf16 bf16x2_t __attribute__((ext_vector_type(2)));

constexpr int S = 4096, T = NB * S, D = 1024;
constexpr float EPS = 1e-6f, LOG2E = 1.4426950408889634f;

__device__ __forceinline__ unsigned cvtpk(float lo, float hi) { f32x2 v = {lo, hi}; bf16x2_t b = __builtin_convertvector(v, bf16x2_t); return __builtin_bit_cast(unsigned, b); }
__device__ __forceinline__ bf16_t f2bf(float f) { return (bf16_t)(cvtpk(f, 0.f) & 0xffffu); }
__device__ __forceinline__ float bf2f(bf16_t u) { return __builtin_bit_cast(float, (unsigned)u << 16); }
__device__ __forceinline__ float bflo(unsigned u) { return __builtin_bit_cast(float, u << 16); }
__device__ __forceinline__ float bfhi(unsigned u) { return __builtin_bit_cast(float, u & 0xffff0000u); }
__device__ __forceinline__ float wsum(float v) {
#define WS_DPP(x, ctrl) __builtin_bit_cast(float, __builtin_amdgcn_update_dpp(0, __builtin_bit_cast(int, (x)), (ctrl), 0xF, 0xF, true))
    v += WS_DPP(v, 0xB1); v += WS_DPP(v, 0x4E); v += WS_DPP(v, 0x141); v += WS_DPP(v, 0x140);
#undef WS_DPP
    const int vi = __builtin_bit_cast(int, v);
    const float s0 = __builtin_bit_cast(float, __builtin_amdgcn_readlane(vi, 0)), s1 = __builtin_bit_cast(float, __builtin_amdgcn_readlane(vi, 16));
    const float s2 = __builtin_bit_cast(float, __builtin_amdgcn_readlane(vi, 32)), s3 = __builtin_bit_cast(float, __builtin_amdgcn_readlane(vi, 48));
    return (s0 + s1) + (s2 + s3);
}
__device__ __forceinline__ float fexp2(float x) { return __builtin_amdgcn_exp2f(x); }
__device__ __forceinline__ float frcp(float x) { return __builtin_amdgcn_rcpf(x); }
__device__ __forceinline__ float silu_f(float x) { return x * frcp(1.f + fexp2(-x * LOG2E)); }
__device__ __forceinline__ float gelu_tanh_f(float x) {
    const float u = 0.7978845608028654f * (x + 0.044715f * x * x * x);
    return x * frcp(1.f + fexp2(-2.f * LOG2E * u));
}

namespace pg8 {
constexpr int BM = 256, BK = 64, HALF = 128, HTB = HALF * BK * 2, STAGE_BYTES = 8 * HTB, NXCD = 8, WGM = 8;
__host__ __device__ __forceinline__ int lds_byte(int r, int c) { const int st = (r >> 4) * 2 + (c >> 5), rr = r & 15, cc = c & 31, ob = rr * 64 + cc * 2; return st * 1024 + (ob ^ (((ob >> 9) & 1) << 5)); }
__host__ __device__ __forceinline__ void stage_rc(int b, int& R, int& C) { const int st = b / 1024, sb = b % 1024, swz = sb ^ (((sb >> 9) & 1) << 5); R = (st >> 1) * 16 + swz / 64; C = (st & 1) * 32 + (swz % 64) / 2; }
__host__ __device__ __forceinline__ int perm32(int rho) { const int n = rho >> 4, i = rho & 15; return 8 * (i >> 2) + 4 * n + (i & 3); }

struct Unit { int pm, pn; };
struct Gemm { const bf16_t* A; const bf16_t* Bt; int M, N, K, lda; const int* tile_e; size_t estride; const int* rowidx; };

struct StaticOrder {
    int nM, nN, nwg, G, c;
    __device__ void init(int M, int N, int G_, int c_) { nM = M / BM; nN = N / BM; nwg = nM * nN; G = G_; c = c_; }
    __device__ bool next(int i, Unit& u) const {
        const long L = (long)i * G + c; if (L >= nwg) return false;
        int wgid = (int)L; { const int q = nwg / NXCD, r = nwg % NXCD, xcd = wgid % NXCD, off = wgid / NXCD; wgid = (xcd < r ? xcd * (q + 1) : r * (q + 1) + (xcd - r) * q) + off; }
        const int nig = WGM * nN, gid = wgid / nig, fm = gid * WGM, gsz = (nM - fm) < WGM ? (nM - fm) : WGM;
        u.pm = fm + ((wgid % nig) % gsz); u.pn = (wgid % nig) / gsz; return true;
    }
};

template <class E> struct epi_lds { static constexpr int n = 0; };
__device__ __forceinline__ float row_rstd(const float* ssp, int row);
constexpr int EPI_LDS_OFF = 131072, EPI_TAB_CAP = 30;
template <class Epi, bool ALIGN_EPI, bool GATHER = false>
__device__ __forceinline__ void gemm_phase(LAS unsigned char* lds, const Gemm g, const StaticOrder& S, const Epi& E) {
    int tid = threadIdx.x; asm volatile("" : "+v"(tid));
    const int wid = __builtin_amdgcn_readfirstlane(tid >> 6), lane = tid & 63, wr = wid >> 2, wc = wid & 3, fr = lane & 15, fq = lane >> 4;
    const int K = g.K, nt = K / BK, lda = g.lda;
    unsigned voffA[2], voffB[2];
#pragma unroll
    for (int i = 0; i < 2; ++i) { int R, C; stage_rc(tid * 16 + i * 8192, R, C); const int Rb = Epi::PERM ? ((R & ~31) + perm32(R & 31)) : R;
        voffA[i] = (unsigned)(R * lda + C) * 2u; voffB[i] = (unsigned)(Rb * K + C) * 2u; }
    const size_t kstep = (size_t)(BK * 2);
    const size_t hsA = GATHER ? 0 : (size_t)HALF * lda * 2, tsA = 2 * hsA, hsB = (size_t)HALF * K * 2, tsB = 2 * hsB;
    unsigned vgc[2][2], vgn[2][2];
#define PG8_GOFF(pm_, vg) do { _Pragma("unroll") for (int h_ = 0; h_ < 2; ++h_) _Pragma("unroll") for (int i_ = 0; i_ < 2; ++i_) { int R_, C_; stage_rc(tid * 16 + i_ * 8192, R_, C_); \
        int tok_ = g.rowidx[(pm_) * BM + h_ * HALF + R_]; tok_ = tok_ < 0 ? 0 : tok_; vg[h_][i_] = (unsigned)(tok_ * lda + C_) * 2u; } } while (0)
#define PG8_GOFF_LDS(buf_, vg) do { const LAS int* ix_ = (const LAS int*)(lds + EPI_LDS_OFF + 4096 + (buf_) * 1024); _Pragma("unroll") for (int h_ = 0; h_ < 2; ++h_) _Pragma("unroll") for (int i_ = 0; i_ < 2; ++i_) { int R_, C_; stage_rc(tid * 16 + i_ * 8192, R_, C_); \
        int tok_ = ix_[h_ * HALF + R_]; tok_ = tok_ < 0 ? 0 : tok_; vg[h_][i_] = (unsigned)(tok_ * lda + C_) * 2u; } } while (0)
#define PG8_STAGE_A(bufoff, gbase, h, nx) do { unsigned va_[2]; _Pragma("unroll") for (int i_ = 0; i_ < 2; ++i_) va_[i_] = GATHER ? ((nx) ? vgn[h][i_] : vgc[h][i_]) : voffA[i_]; PG8_STAGE(bufoff, gbase, va_); } while (0)
    const unsigned ldsw = (unsigned)wid * 1024u;
    const int aoff = lds_byte(wr * 64 + fr, fq * 8), boff = lds_byte(wc * 32 + fr, fq * 8);
#define PG8_SA(b, h) (((b) * 2 + (h)) * HTB)
#define PG8_SB(b, h) ((4 + (b) * 2 + (h)) * HTB)
#define PG8_STAGE(bufoff, gbase, voff) do { _Pragma("unroll") for (int _i = 0; _i < 2; ++_i) \
        __builtin_amdgcn_global_load_lds((const unsigned*)((const char*)(gbase) + (voff)[_i]), (LAS unsigned*)(lds + (bufoff) + ldsw + _i * 8192), 16, 0, 0); } while (0)
#define PG8_LDA(dst, b, h) do { _Pragma("unroll") for (int m = 0; m < 4; ++m) _Pragma("unroll") for (int k = 0; k < 2; ++k) dst[m][k] = *(const LAS bf16x8*)(lds + PG8_SA(b, h) + aoff + m * 2048 + k * 1024); } while (0)
#define PG8_LDB(dst, b, h) do { _Pragma("unroll") for (int n = 0; n < 2; ++n) _Pragma("unroll") for (int k = 0; k < 2; ++k) dst[n][k] = *(const LAS bf16x8*)(lds + PG8_SB(b, h) + boff + n * 2048 + k * 1024); } while (0)
#define PG8_MMA(ai, bj, At, Bt) do { __builtin_amdgcn_s_setprio(1); _Pragma("unroll") for (int m = 0; m < 4; ++m) _Pragma("unroll") for (int n = 0; n < 2; ++n) _Pragma("unroll") for (int k = 0; k < 2; ++k) \
        acc[ai][bj][m][n] = __builtin_amdgcn_mfma_f32_16x16x32_bf16(Bt[n][k], At[m][k], acc[ai][bj][m][n], 0, 0, 0); __builtin_amdgcn_s_setprio(0); } while (0)
#define PG8_WAIT_V(n) asm volatile("s_waitcnt vmcnt(" #n ")" ::: "memory")
#define PG8_WAIT_L(n) asm volatile("s_waitcnt lgkmcnt(" #n ")" ::: "memory")
#define PG8_BAR __builtin_amdgcn_s_barrier()
#define PG8_SCHED __builtin_amdgcn_sched_barrier(0)
#define PG8_EOFF(pm_) (g.tile_e ? (size_t)g.tile_e[pm_] * g.estride * 2 : (size_t)0)
    Unit cur, nxt; int ui = 0;
    if (!S.next(0, cur)) return;
    if constexpr (epi_lds<Epi>::n == 16) {
        LAS float* tab_ = (LAS float*)(lds + EPI_LDS_OFF);
        for (int idx = tid; idx < EPI_TAB_CAP * BM; idx += 512) { Unit u_; if (!S.next(idx >> 8, u_)) break; tab_[idx] = row_rstd(E.ssp, u_.pm * BM + (idx & 255)); }
        __syncthreads();
    }
    f32x4 acc[2][2][4][2];
#pragma unroll
    for (int a = 0; a < 2; ++a)
#pragma unroll
        for (int b = 0; b < 2; ++b)
#pragma unroll
            for (int m = 0; m < 4; ++m)
#pragma unroll
                for (int n = 0; n < 2; ++n) acc[a][b][m][n] = (f32x4){0.f, 0.f, 0.f, 0.f};
    bf16x8 At[4][2], B0[2][2], B1[2][2];
    const char* cA = (const char*)g.A + (size_t)cur.pm * tsA; const char* cB = (const char*)g.Bt + PG8_EOFF(cur.pm) + (size_t)cur.pn * tsB;
    if constexpr (GATHER) PG8_GOFF(cur.pm, vgc);
    PG8_STAGE(PG8_SB(0, 0), cB, voffB); PG8_STAGE(PG8_SB(0, 1), cB + hsB, voffB); PG8_STAGE_A(PG8_SA(0, 0), cA, 0, false); PG8_STAGE_A(PG8_SA(0, 1), cA + hsA, 1, false);
    if (wr == 1) PG8_BAR;
    PG8_WAIT_V(2); PG8_BAR;
    PG8_STAGE(PG8_SB(1, 0), cB + kstep, voffB); PG8_STAGE_A(PG8_SA(1, 0), cA + kstep, 0, false); PG8_STAGE(PG8_SB(1, 1), cB + hsB + kstep, voffB);
    PG8_WAIT_V(6); PG8_BAR;
    for (;;) {
        const bool has_next = S.next(ui + 1, nxt);
        if constexpr (GATHER) {
            if (has_next) { if (ui == 0) PG8_GOFF(nxt.pm, vgn); else PG8_GOFF_LDS((ui + 1) & 1, vgn); } else { vgn[0][0] = vgc[0][0]; vgn[0][1] = vgc[0][1]; vgn[1][0] = vgc[1][0]; vgn[1][1] = vgc[1][1]; }
            { Unit n2_; if (S.next(ui + 2, n2_) && wid == 1) __builtin_amdgcn_global_load_lds((const unsigned*)((const char*)(g.rowidx + (size_t)n2_.pm * BM) + lane * 16), (LAS unsigned*)(lds + EPI_LDS_OFF + 4096 + (ui & 1) * 1024), 16, 0, 0); }
        }
        const char* nA = has_next ? (const char*)g.A + (size_t)nxt.pm * tsA : cA;
        const char* nB = has_next ? (const char*)g.Bt + PG8_EOFF(nxt.pm) + (size_t)nxt.pn * tsB : cB;
        if constexpr (epi_lds<Epi>::n == 1) { if (wid == 0) __builtin_amdgcn_global_load_lds((const unsigned*)((const char*)(E.rowscale + (size_t)cur.pm * BM) + lane * 16), (LAS unsigned*)(lds + EPI_LDS_OFF + (ui & 1) * 1024), 16, 0, 0); }
        for (int t = 0; t < nt; t += 2) {
            const bool last = (t == nt - 2);
            const char* a1 = cA + (size_t)(t + 1) * kstep;
            const char* a2 = last ? nA : cA + (size_t)(t + 2) * kstep; const char* b2 = last ? nB : cB + (size_t)(t + 2) * kstep;
            const char* a3 = a2 + kstep; const char* b3 = b2 + kstep;
            PG8_LDB(B0, 0, 0); PG8_LDB(B1, 0, 1); PG8_SCHED; PG8_LDA(At, 0, 0); PG8_STAGE_A(PG8_SA(1, 1), a1 + hsA, 1, false);
            PG8_WAIT_V(8); PG8_WAIT_L(0); PG8_BAR; PG8_MMA(0, 0, At, B0); PG8_MMA(0, 1, At, B1); PG8_BAR; PG8_SCHED;
            PG8_LDA(At, 0, 1); PG8_STAGE(PG8_SB(0, 0), b2, voffB); PG8_STAGE(PG8_SB(0, 1), b2 + hsB, voffB); PG8_STAGE_A(PG8_SA(0, 0), a2, 0, last);
            PG8_WAIT_V(8); PG8_WAIT_L(0); PG8_BAR; PG8_MMA(1, 0, At, B0); PG8_MMA(1, 1, At, B1); PG8_BAR; PG8_SCHED;
            PG8_LDB(B0, 1, 0); PG8_LDB(B1, 1, 1); PG8_SCHED; PG8_LDA(At, 1, 0); PG8_STAGE_A(PG8_SA(0, 1), a2 + hsA, 1, last);
            PG8_WAIT_V(8); PG8_WAIT_L(0); PG8_BAR; PG8_MMA(0, 0, At, B0); PG8_MMA(0, 1, At, B1); PG8_BAR; PG8_SCHED;
            PG8_LDA(At, 1, 1); PG8_STAGE(PG8_SB(1, 0), b3, voffB); PG8_STAGE(PG8_SB(1, 1), b3 + hsB, voffB); PG8_STAGE_A(PG8_SA(1, 0), a3, 0, last);
            PG8_WAIT_V(8); PG8_WAIT_L(0); PG8_BAR; PG8_MMA(1, 0, At, B0); PG8_MMA(1, 1, At, B1); PG8_BAR; PG8_SCHED;
        }
        if constexpr (ALIGN_EPI) { if (wr == 0) PG8_BAR; }
        if constexpr (epi_lds<Epi>::n == 1) E(acc, cur, wr, wc, fr, fq, (const LAS float*)(lds + EPI_LDS_OFF + (ui & 1) * 1024));
        else if constexpr (epi_lds<Epi>::n == 16) E(acc, cur, wr, wc, fr, fq, ui < EPI_TAB_CAP ? (const LAS float*)(lds + EPI_LDS_OFF + ui * 1024) : (const LAS float*)nullptr);
        else E(acc, cur, wr, wc, fr, fq);
        if (!has_next) break;
#pragma unroll
        for (int a = 0; a < 2; ++a)
#pragma unroll
            for (int b = 0; b < 2; ++b)
#pragma unroll
                for (int m = 0; m < 4; ++m)
#pragma unroll
                    for (int n = 0; n < 2; ++n) acc[a][b][m][n] = (f32x4){0.f, 0.f, 0.f, 0.f};
        cur = nxt; cA = nA; cB = nB; ++ui;
        if constexpr (GATHER) { vgc[0][0] = vgn[0][0]; vgc[0][1] = vgn[0][1]; vgc[1][0] = vgn[1][0]; vgc[1][1] = vgn[1][1]; }
        if constexpr (ALIGN_EPI) { if (wr == 1) PG8_BAR; }
    }
    PG8_WAIT_V(0);
    if constexpr (!ALIGN_EPI) { if (wr == 0) PG8_BAR; }
    PG8_BAR;
#undef PG8_SA
#undef PG8_SB
#undef PG8_STAGE
#undef PG8_LDA
#undef PG8_LDB
#undef PG8_MMA
#undef PG8_WAIT_V
#undef PG8_WAIT_L
#undef PG8_BAR
#undef PG8_SCHED
#undef PG8_EOFF
#undef PG8_GOFF
#undef PG8_GOFF_LDS
#undef PG8_STAGE_A
}

__device__ __forceinline__ float row_rstd(const float* ssp, int row);
template <int ACT> struct EpiBf16 {
    static constexpr bool PERM = true;
    bf16_t* O; int ldc; const float* bias; const float* ssp;
    __device__ __forceinline__ void operator()(const f32x4 (&acc)[2][2][4][2], const Unit& u, int wr, int wc, int fr, int fq) const {
        const int row0 = u.pm * BM + wr * 64 + fr, col0 = u.pn * BM + wc * 32 + 8 * fq;
        f32x4 bv[2][2];
#pragma unroll
        for (int bj = 0; bj < 2; ++bj)
#pragma unroll
            for (int n = 0; n < 2; ++n) bv[bj][n] = bias ? *(const f32x4*)(bias + col0 + bj * HALF + 4 * n) : (f32x4){0.f, 0.f, 0.f, 0.f};
#pragma unroll
        for (int ai = 0; ai < 2; ++ai)
#pragma unroll
            for (int m = 0; m < 4; ++m) { bf16_t* rowp = O + (size_t)(row0 + ai * HALF + m * 16) * ldc + col0;
                const float rs = (ACT == 0 && ssp) ? row_rstd(ssp, row0 + ai * HALF + m * 16) : 1.f;
#pragma unroll
                for (int bj = 0; bj < 2; ++bj) { f32x4 v0 = acc[ai][bj][m][0] * rs + bv[bj][0], v1 = acc[ai][bj][m][1] * rs + bv[bj][1];
                    if (ACT == 2) {
#pragma unroll
                        for (int i = 0; i < 4; ++i) { v0[i] = gelu_tanh_f(v0[i]); v1[i] = gelu_tanh_f(v1[i]); } }
                    u32x4 w; w.x = cvtpk(v0[0], v0[1]); w.y = cvtpk(v0[2], v0[3]); w.z = cvtpk(v1[0], v1[1]); w.w = cvtpk(v1[2], v1[3]);
                    *(u32x4*)(rowp + bj * HALF) = w; } }
    }
};
struct EpiResF32 {
    static constexpr bool PERM = false;
    const float* base; float* out; int ldc;
    __device__ __forceinline__ void operator()(const f32x4 (&acc)[2][2][4][2], const Unit& u, int wr, int wc, int fr, int fq) const {
        const int col0 = u.pn * BM + wc * 32 + 4 * fq;
#pragma unroll
        for (int ai = 0; ai < 2; ++ai)
#pragma unroll
            for (int m = 0; m < 4; ++m) { const size_t off = (size_t)(u.pm * BM + ai * HALF + wr * 64 + m * 16 + fr) * ldc + col0;
#pragma unroll
                for (int bj = 0; bj < 2; ++bj)
#pragma unroll
                    for (int n = 0; n < 2; ++n) { const f32x4 bs = *(const f32x4*)(base + off + bj * HALF + n * 16); *(f32x4*)(out + off + bj * HALF + n * 16) = bs + acc[ai][bj][m][n]; } }
    }
};
template <bool BASE_BF16> struct EpiResStat {
    static constexpr bool PERM = true;
    const void* base; bf16_t* xb; float* ssp; int ldc;
    __device__ __forceinline__ void operator()(const f32x4 (&acc)[2][2][4][2], const Unit& u, int wr, int wc, int fr, int fq) const {
        const int col0 = u.pn * BM + wc * 32 + 8 * fq;
#pragma unroll
        for (int ai = 0; ai < 2; ++ai)
#pragma unroll
            for (int m = 0; m < 4; ++m) { const int row = u.pm * BM + ai * HALF + wr * 64 + m * 16 + fr; const size_t off = (size_t)row * ldc + col0; float ss = 0.f;
#pragma unroll
                for (int bj = 0; bj < 2; ++bj) { f32x4 b0, b1;
                    if (BASE_BF16) { const u32x4 t = *(const u32x4*)((const bf16_t*)base + off + bj * HALF); b0 = (f32x4){bflo(t.x), bfhi(t.x), bflo(t.y), bfhi(t.y)}; b1 = (f32x4){bflo(t.z), bfhi(t.z), bflo(t.w), bfhi(t.w)}; }
                    else { b0 = *(const f32x4*)((const float*)base + off + bj * HALF); b1 = *(const f32x4*)((const float*)base + off + bj * HALF + 4); }
                    const f32x4 v0 = b0 + acc[ai][bj][m][0], v1 = b1 + acc[ai][bj][m][1];
                    u32x4 w; w.x = cvtpk(v0.x, v0.y); w.y = cvtpk(v0.z, v0.w); w.z = cvtpk(v1.x, v1.y); w.w = cvtpk(v1.z, v1.w); *(u32x4*)(xb + off + bj * HALF) = w;
                    ss += ((v0.x * v0.x + v0.y * v0.y) + (v0.z * v0.z + v0.w * v0.w)) + ((v1.x * v1.x + v1.y * v1.y) + (v1.z * v1.z + v1.w * v1.w)); }
                ss += __shfl_xor(ss, 16); ss += __shfl_xor(ss, 32);
                if (fq == 0) ssp[(size_t)row * 16 + u.pn * 4 + wc] = ss; }
    }
};
struct EpiResBf16B {
    static constexpr bool PERM = true;
    const bf16_t* base; bf16_t* out; int ldc;
    __device__ __forceinline__ void operator()(const f32x4 (&acc)[2][2][4][2], const Unit& u, int wr, int wc, int fr, int fq) const {
        const int col0 = u.pn * BM + wc * 32 + 8 * fq;
#pragma unroll
        for (int ai = 0; ai < 2; ++ai)
#pragma unroll
            for (int m = 0; m < 4; ++m) { const size_t off = (size_t)(u.pm * BM + ai * HALF + wr * 64 + m * 16 + fr) * ldc + col0;
#pragma unroll
                for (int bj = 0; bj < 2; ++bj) { const u32x4 t = *(const u32x4*)(base + off + bj * HALF);
                    const f32x4 v0 = (f32x4){bflo(t.x), bfhi(t.x), bflo(t.y), bfhi(t.y)} + acc[ai][bj][m][0], v1 = (f32x4){bflo(t.z), bfhi(t.z), bflo(t.w), bfhi(t.w)} + acc[ai][bj][m][1];
                    u32x4 w; w.x = cvtpk(v0.x, v0.y); w.y = cvtpk(v0.z, v0.w); w.z = cvtpk(v1.x, v1.y); w.w = cvtpk(v1.z, v1.w); *(u32x4*)(out + off + bj * HALF) = w; } }
    }
};
struct EpiResF32B {
    static constexpr bool PERM = false;
    const bf16_t* base; float* out; int ldc;
    __device__ __forceinline__ void operator()(const f32x4 (&acc)[2][2][4][2], const Unit& u, int wr, int wc, int fr, int fq) const {
        const int col0 = u.pn * BM + wc * 32 + 4 * fq;
#pragma unroll
        for (int ai = 0; ai < 2; ++ai)
#pragma unroll
            for (int m = 0; m < 4; ++m) { const size_t off = (size_t)(u.pm * BM + ai * HALF + wr * 64 + m * 16 + fr) * ldc + col0;
#pragma unroll
                for (int bj = 0; bj < 2; ++bj)
#pragma unroll
                    for (int n = 0; n < 2; ++n) { const u32x2 t = *(const u32x2*)(base + off + bj * HALF + n * 16); const f32x4 bs = {bflo(t.x), bfhi(t.x), bflo(t.y), bfhi(t.y)};
                        *(f32x4*)(out + off + bj * HALF + n * 16) = bs + acc[ai][bj][m][n]; } }
    }
};
__device__ __forceinline__ float row_rstd(const float* ssp, int row) {
    const f32x4* q = (const f32x4*)(ssp + (size_t)row * 16); const f32x4 a = q[0], b = q[1], c = q[2], d = q[3];
    const float s = ((a.x + a.y) + (a.z + a.w)) + ((b.x + b.y) + (b.z + b.w)) + ((c.x + c.y) + (c.z + c.w)) + ((d.x + d.y) + (d.z + d.w));
    return rsqrtf(s * (1.f / 1024.f) + EPS);
}
struct EpiSwiGLU {
    static constexpr bool PERM = true;
    bf16_t* O; int ldc; const float* ssp; const float* rrs;
    __device__ __forceinline__ void operator()(const f32x4 (&acc)[2][2][4][2], const Unit& u, int wr, int wc, int fr, int fq) const {
        const int row0 = u.pm * BM + wr * 64 + fr, col0 = u.pn * HALF + wc * 32 + 8 * fq;
#pragma unroll
        for (int ai = 0; ai < 2; ++ai)
#pragma unroll
            for (int m = 0; m < 4; ++m) { bf16_t* rowp = O + (size_t)(row0 + ai * HALF + m * 16) * ldc + col0;
                const float rs = rrs ? rrs[row0 + ai * HALF + m * 16] : (ssp ? row_rstd(ssp, row0 + ai * HALF + m * 16) : 1.f);
                float h[8];
#pragma unroll
                for (int n = 0; n < 2; ++n)
#pragma unroll
                    for (int i = 0; i < 4; ++i) h[n * 4 + i] = silu_f(acc[ai][0][m][n][i] * rs) * (acc[ai][1][m][n][i] * rs);
                u32x4 w; w.x = cvtpk(h[0], h[1]); w.y = cvtpk(h[2], h[3]); w.z = cvtpk(h[4], h[5]); w.w = cvtpk(h[6], h[7]);
                *(u32x4*)rowp = w; }
    }
};
struct EpiConvIn {
    static constexpr bool PERM = true;
    bf16_t* Bg; bf16_t* CU; const float* ssp;
    __device__ __forceinline__ void operator()(const f32x4 (&acc)[2][2][4][2], const Unit& u, int wr, int wc, int fr, int fq) const {
        const int row0 = u.pm * BM + wr * 64 + fr;
#pragma unroll
        for (int ai = 0; ai < 2; ++ai)
#pragma unroll
            for (int m = 0; m < 4; ++m) { const int row = row0 + ai * HALF + m * 16; const float rs = row_rstd(ssp, row);
                if (u.pn < 4) {
#pragma unroll
                    for (int bj = 0; bj < 2; ++bj) { const f32x4 v0 = acc[ai][bj][m][0] * rs, v1 = acc[ai][bj][m][1] * rs;
                        u32x4 w; w.x = cvtpk(v0[0], v0[1]); w.y = cvtpk(v0[2], v0[3]); w.z = cvtpk(v1[0], v1[1]); w.w = cvtpk(v1[2], v1[3]);
                        *(u32x4*)(Bg + (size_t)row * 1024 + u.pn * BM + bj * HALF + wc * 32 + 8 * fq) = w; }
                } else { const float r2 = rs * rs; float h[8];
#pragma unroll
                    for (int n = 0; n < 2; ++n)
#pragma unroll
                        for (int i = 0; i < 4; ++i) h[n * 4 + i] = acc[ai][0][m][n][i] * acc[ai][1][m][n][i] * r2;
                    u32x4 w; w.x = cvtpk(h[0], h[1]); w.y = cvtpk(h[2], h[3]); w.z = cvtpk(h[4], h[5]); w.w = cvtpk(h[6], h[7]);
                    *(u32x4*)(CU + (size_t)row * 1024 + (u.pn - 4) * HALF + wc * 32 + 8 * fq) = w; } }
    }
};
struct EpiRowScaleBf16 {
    static constexpr bool PERM = true;
    bf16_t* O; int ldc; const float* roww;
    __device__ __forceinline__ void operator()(const f32x4 (&acc)[2][2][4][2], const Unit& u, int wr, int wc, int fr, int fq) const {
        const int row0 = u.pm * BM + wr * 64 + fr, col0 = u.pn * BM + wc * 32 + 8 * fq;
#pragma unroll
        for (int ai = 0; ai < 2; ++ai)
#pragma unroll
            for (int m = 0; m < 4; ++m) { const int row = row0 + ai * HALF + m * 16; const float sc = roww[row]; bf16_t* rowp = O + (size_t)row * ldc + col0;
#pragma unroll
                for (int bj = 0; bj < 2; ++bj) { const f32x4 v0 = acc[ai][bj][m][0] * sc, v1 = acc[ai][bj][m][1] * sc;
                    u32x4 w; w.x = cvtpk(v0[0], v0[1]); w.y = cvtpk(v0[2], v0[3]); w.z = cvtpk(v1[0], v1[1]); w.w = cvtpk(v1[2], v1[3]);
                    *(u32x4*)(rowp + bj * HALF) = w; } }
    }
};

__device__ __forceinline__ float row_rstd_lds(const LAS float* sl, int rl) {
    const LAS f32x4* q = (const LAS f32x4*)(sl + rl * 16); const f32x4 a = q[0], b = q[1], c = q[2], d = q[3];
    const float s = ((a.x + a.y) + (a.z + a.w)) + ((b.x + b.y) + (b.z + b.w)) + ((c.x + c.y) + (c.z + c.w)) + ((d.x + d.y) + (d.z + d.w));
    return rsqrtf(s * (1.f / 1024.f) + EPS);
}
struct EpiSwiGLUSsp {
    static constexpr bool PERM = true;
    bf16_t* O; int ldc; const float* ssp;
    __device__ __forceinline__ void operator()(const f32x4 (&acc)[2][2][4][2], const Unit& u, int wr, int wc, int fr, int fq, const LAS float* sl) const {
        const int rl0 = wr * 64 + fr, row0 = u.pm * BM + rl0, col0 = u.pn * HALF + wc * 32 + 8 * fq;
#pragma unroll
        for (int ai = 0; ai < 2; ++ai)
#pragma unroll
            for (int m = 0; m < 4; ++m) { bf16_t* rowp = O + (size_t)(row0 + ai * HALF + m * 16) * ldc + col0;
                const float rs = sl ? sl[rl0 + ai * HALF + m * 16] : row_rstd(ssp, row0 + ai * HALF + m * 16);
                float h[8];
#pragma unroll
                for (int n = 0; n < 2; ++n)
#pragma unroll
                    for (int i = 0; i < 4; ++i) h[n * 4 + i] = silu_f(acc[ai][0][m][n][i] * rs) * (acc[ai][1][m][n][i] * rs);
                u32x4 w; w.x = cvtpk(h[0], h[1]); w.y = cvtpk(h[2], h[3]); w.z = cvtpk(h[4], h[5]); w.w = cvtpk(h[6], h[7]);
                *(u32x4*)rowp = w; }
    }
};
template <> struct epi_lds<EpiSwiGLUSsp> { static constexpr int n = 16; };
struct EpiConvInSsp {
    static constexpr bool PERM = true;
    bf16_t* Bg; bf16_t* CU; const float* ssp;
    __device__ __forceinline__ void operator()(const f32x4 (&acc)[2][2][4][2], const Unit& u, int wr, int wc, int fr, int fq, const LAS float* sl) const {
        const int rl0 = wr * 64 + fr, row0 = u.pm * BM + rl0;
#pragma unroll
        for (int ai = 0; ai < 2; ++ai)
#pragma unroll
            for (int m = 0; m < 4; ++m) { const int row = row0 + ai * HALF + m * 16; const float rs = sl ? sl[rl0 + ai * HALF + m * 16] : row_rstd(ssp, row);
                if (u.pn < 4) {
#pragma unroll
                    for (int bj = 0; bj < 2; ++bj) { const f32x4 v0 = acc[ai][bj][m][0] * rs, v1 = acc[ai][bj][m][1] * rs;
                        u32x4 w; w.x = cvtpk(v0[0], v0[1]); w.y = cvtpk(v0[2], v0[3]); w.z = cvtpk(v1[0], v1[1]); w.w = cvtpk(v1[2], v1[3]);
                        *(u32x4*)(Bg + (size_t)row * 1024 + u.pn * BM + bj * HALF + wc * 32 + 8 * fq) = w; }
                } else { const float r2 = rs * rs; float h[8];
#pragma unroll
                    for (int n = 0; n < 2; ++n)
#pragma unroll
                        for (int i = 0; i < 4; ++i) h[n * 4 + i] = acc[ai][0][m][n][i] * acc[ai][1][m][n][i] * r2;
                    u32x4 w; w.x = cvtpk(h[0], h[1]); w.y = cvtpk(h[2], h[3]); w.z = cvtpk(h[4], h[5]); w.w = cvtpk(h[6], h[7]);
                    *(u32x4*)(CU + (size_t)row * 1024 + (u.pn - 4) * HALF + wc * 32 + 8 * fq) = w; } }
    }
};
template <> struct epi_lds<EpiConvInSsp> { static constexpr int n = 16; };
struct EpiSwiGLULds {
    static constexpr bool PERM = true;
    bf16_t* O; int ldc; const float* rowscale;
    __device__ __forceinline__ void operator()(const f32x4 (&acc)[2][2][4][2], const Unit& u, int wr, int wc, int fr, int fq, const LAS float* rsl) const {
        const int rl0 = wr * 64 + fr, row0 = u.pm * BM + rl0, col0 = u.pn * HALF + wc * 32 + 8 * fq;
#pragma unroll
        for (int ai = 0; ai < 2; ++ai)
#pragma unroll
            for (int m = 0; m < 4; ++m) { bf16_t* rowp = O + (size_t)(row0 + ai * HALF + m * 16) * ldc + col0;
                const float rs = rsl[rl0 + ai * HALF + m * 16];
                float h[8];
#pragma unroll
                for (int n = 0; n < 2; ++n)
#pragma unroll
                    for (int i = 0; i < 4; ++i) h[n * 4 + i] = silu_f(acc[ai][0][m][n][i] * rs) * (acc[ai][1][m][n][i] * rs);
                u32x4 w; w.x = cvtpk(h[0], h[1]); w.y = cvtpk(h[2], h[3]); w.z = cvtpk(h[4], h[5]); w.w = cvtpk(h[6], h[7]);
                *(u32x4*)rowp = w; }
    }
};
template <> struct epi_lds<EpiSwiGLULds> { static constexpr int n = 1; };
struct EpiRowScaleLds {
    static constexpr bool PERM = true;
    bf16_t* O; int ldc; const float* rowscale;
    __device__ __forceinline__ void operator()(const f32x4 (&acc)[2][2][4][2], const Unit& u, int wr, int wc, int fr, int fq, const LAS float* rsl) const {
        const int rl0 = wr * 64 + fr, row0 = u.pm * BM + rl0, col0 = u.pn * BM + wc * 32 + 8 * fq;
#pragma unroll
        for (int ai = 0; ai < 2; ++ai)
#pragma unroll
            for (int m = 0; m < 4; ++m) { const int row = row0 + ai * HALF + m * 16; const float sc = rsl[rl0 + ai * HALF + m * 16]; bf16_t* rowp = O + (size_t)row * ldc + col0;
#pragma unroll
                for (int bj = 0; bj < 2; ++bj) { const f32x4 v0 = acc[ai][bj][m][0] * sc, v1 = acc[ai][bj][m][1] * sc;
                    u32x4 w; w.x = cvtpk(v0[0], v0[1]); w.y = cvtpk(v0[2], v0[3]); w.z = cvtpk(v1[0], v1[1]); w.w = cvtpk(v1[2], v1[3]);
                    *(u32x4*)(rowp + bj * HALF) = w; } }
    }
};
template <> struct epi_lds<EpiRowScaleLds> { static constexpr int n = 1; };
}
constexpr int ROWS_MAX = 2 * T + 8 * 256;
constexpr size_t al256(size_t x) { return (x + 255) & ~(size_t)255; }
constexpr size_t W_IN_E = 0;
constexpr size_t W_CW1 = W_IN_E + (size_t)1792 * 1024 * 2;
constexpr size_t W_UQ = W_CW1 + (size_t)2 * 256 * 2048 * 2;
constexpr size_t W_UKV = W_UQ + (size_t)1024 * 256 * 2;
constexpr size_t W_OUT_E = W_UKV + (size_t)1024 * 128 * 2;
constexpr size_t W_GU = W_OUT_E + (size_t)1024 * 1024 * 2;
constexpr size_t W_D = W_GU + (size_t)5632 * 1024 * 2;
constexpr size_t W_IN_O = W_D + (size_t)1024 * 2816 * 2;
constexpr size_t W_OUT_O = W_IN_O + (size_t)3072 * 1024 * 2;
constexpr size_t W_MGU = W_OUT_O + (size_t)1024 * 1024 * 2;
constexpr size_t W_MD = W_MGU + (size_t)8 * 2816 * 1024 * 2;
constexpr size_t W_END = W_MD + (size_t)8 * 1024 * 1408 * 2;
constexpr size_t SM_CTL = al256(W_END);
constexpr size_t SM_BAR = SM_CTL + 4096;
constexpr size_t SM_B1P = SM_BAR + 16384;
constexpr size_t SM_B1 = SM_B1P + 32 * 512 * 4;
constexpr size_t SM_ROPE = SM_B1 + 512 * 4;
constexpr size_t SM_BL = SM_ROPE + (size_t)S * 32 * 4;
constexpr size_t SM_HID = SM_BL + 8 * 132 * 4;
constexpr size_t SM_KC = SM_HID + (size_t)2 * NB * 512 * 512 * 2;
constexpr size_t SM_VCT = SM_KC + (size_t)NB * 512 * 64 * 2;
constexpr size_t SM_TE = SM_VCT + (size_t)NB * 512 * 64 * 2;
constexpr size_t SM_TW = SM_TE + (size_t)T * 8;
constexpr size_t SM_RANK = SM_TW + (size_t)T * 8;
constexpr size_t SM_POS = SM_RANK + (size_t)T * 8;
constexpr size_t SM_ROWW = SM_POS + (size_t)T * 8;
constexpr size_t SM_TILEE = SM_ROWW + (size_t)ROWS_MAX * 4;
constexpr size_t SM_ROWTOK = al256(SM_TILEE + (size_t)(ROWS_MAX / 256 + 8) * 4);
constexpr size_t SM_SSP1 = al256(SM_ROWTOK + (size_t)ROWS_MAX * 4);
constexpr size_t SM_SSP2 = SM_SSP1 + (size_t)T * 64;
constexpr size_t SM_RSTD3 = SM_SSP2 + (size_t)T * 64;
constexpr size_t SM_ROWRS = SM_RSTD3 + (size_t)T * 4;
constexpr size_t SM_END = al256(SM_ROWRS + (size_t)ROWS_MAX * 4);
constexpr size_t R_XA = al256(SM_END);
constexpr size_t SZ_XA = (size_t)T * 4096 + (size_t)4 * 1048576;
constexpr size_t R_XN = R_XA + SZ_XA;
constexpr size_t SZ_XN = (size_t)T * 2048;
constexpr size_t R_H = R_XN + SZ_XN;
constexpr size_t SZ_H = ((size_t)T * 6144 > (size_t)ROWS_MAX * 2816) ? (size_t)T * 6144 : (size_t)ROWS_MAX * 2816;
constexpr size_t WS_FAST_END = R_H + SZ_H;
constexpr size_t A_QN = 0;
constexpr size_t A_KSN = A_QN + (size_t)T * 1024;
constexpr size_t A_KWN = A_KSN + (size_t)T * 256;
constexpr size_t A_VST = A_KWN + (size_t)T * 256;
constexpr size_t A_VWT = A_VST + (size_t)T * 256;
constexpr size_t A_KCIN = A_VWT + (size_t)T * 256;
constexpr size_t A_VCIN = A_KCIN + (size_t)T * 256 + 2048;
constexpr size_t A_CQN = A_VCIN + (size_t)T * 256 + 2048;
constexpr size_t A_CKVN = A_CQN + (size_t)T * 512;
constexpr size_t A_KROPE = A_CKVN + (size_t)T * 256;
constexpr size_t A_GATES = A_KROPE + (size_t)T * 64;
constexpr size_t A_END = A_GATES + (size_t)T * 96;
static_assert(A_END <= SZ_XA, "attention inputs fit R_XA");
constexpr size_t O_QM = 0;
constexpr size_t O_KM = O_QM + (size_t)T * 1536;
constexpr size_t O_VMT = O_KM + (size_t)T * 1536;
static_assert(O_VMT + (size_t)T * 1024 <= (size_t)T * 4096, "d_out scratch");

struct Params {
    const float* in[30];
    float* out;
    unsigned char* ws;
    int ph_lo, ph_hi, dbg_branch, pad_;
};

#ifdef PROF_SEL
#define PROF_SLOT(k) ((unsigned long long*)(p.ws + SM_CTL + 2048) + (k))
#define PROF_ON(cond) ((cond) && threadIdx.x == 0)
#ifndef PROF_WAVE
#define PROF_WAVE 0
#endif
#endif
constexpr int LDS_BYTES = 163840;

__device__ __forceinline__ int ltid() { int t = threadIdx.x; asm volatile("" : "+v"(t)); return t; }
__device__ __forceinline__ int perm16(int k) { return (k & ~12) | ((k & 4) << 1) | ((k & 8) >> 1); }

struct WDesc { int in_idx, K, N, rep, map, row_off; size_t src_stride, dst_off, dst_stride; int gain_idx, pad_; size_t src_off; };
__device__ const WDesc WDESC[13] = {
    {3, 1024, 1720, 1, 2, 0, 0, W_IN_E / 2, 0, -1, 0},
    {7, 1024, 256, 2, 0, 0, (size_t)2048 * 256, W_CW1 / 2, (size_t)512 * 1024, -1, 0, 0},
    {7, 1024, 256, 2, 0, 256, (size_t)2048 * 256, W_CW1 / 2, (size_t)512 * 1024, -1, 0, (size_t)1024 * 256},
    {11, 256, 768, 1, 3, 0, 0, W_UQ / 2, 0, -1, 0},
    {12, 128, 1024, 1, 0, 0, 0, W_UKV / 2, 0, -1, 0},
    {15, 1024, 1024, 1, 0, 0, 0, W_OUT_E / 2, 0, -1, 0},
    {17, 1024, 2816, 1, 1, 0, 0, W_GU / 2, 0, 16, 0},
    {18, 1024, 2816, 1, 1, 128, 0, W_GU / 2, 0, 16, 0},
    {19, 2816, 1024, 1, 0, 0, 0, W_D / 2, 0, -1, 0},
    {21, 1024, 3072, 1, 4, 0, 0, W_IN_O / 2, 0, 20, 0},
    {23, 1024, 1024, 1, 0, 0, 0, W_OUT_O / 2, 0, -1, 0},
    {27, 1024, 1408, 8, 1, 0, (size_t)1024 * 1408, W_MGU / 2, (size_t)2816 * 1024, 24, 0},
    {28, 1024, 1408, 8, 1, 128, (size_t)1024 * 1408, W_MGU / 2, (size_t)2816 * 1024, 24, 0},
};
__device__ const WDesc WDESC_MD = {29, 1408, 1024, 8, 0, 0, (size_t)1408 * 1024, W_MD / 2, (size_t)1024 * 1408, -1, 0};

struct WItem { f32x4 v[8]; float g[8]; };
__device__ __forceinline__ void item_load(WItem& I, const float* W, int K, int N, const float* gain, int item, int lane) {
    const int nblk = (N + 31) / 32, kb = item / nblk, nb = item % nblk, k0 = 64 * kb, n0 = 32 * nb;
    const int n4 = (lane & 7) * 4; const bool nok = (n0 + n4) < N;
#pragma unroll
    for (int i = 0; i < 8; ++i) { const int kk = (lane >> 3) + 8 * i; I.v[i] = nok ? *(const f32x4*)(W + (size_t)(k0 + kk) * N + n0 + n4) : (f32x4){0.f, 0.f, 0.f, 0.f}; I.g[i] = gain ? gain[k0 + kk] : 1.f; }
}
__device__ __forceinline__ void item_finish(const WItem& I, int K, int N, bf16_t* WT, int map, int row_off, LAS float* scr, int item, int lane) {
    const int nblk = (N + 31) / 32, kb = item / nblk, nb = item % nblk, k0 = 64 * kb, n0 = 32 * nb;
    const int n4 = (lane & 7) * 4;
#pragma unroll
    for (int i = 0; i < 8; ++i) { const int kk = (lane >> 3) + 8 * i; LAS float* d = scr + kk * 33 + n4; const float g_ = I.g[i]; d[0] = I.v[i].x * g_; d[1] = I.v[i].y * g_; d[2] = I.v[i].z * g_; d[3] = I.v[i].w * g_; }
    asm volatile("s_waitcnt lgkmcnt(0)" ::: "memory");
    const int c = lane & 7;
#pragma unroll
    for (int j = 0; j < 4; ++j) { const int n = (lane >> 3) + 8 * j; const LAS float* s = scr + (8 * c) * 33 + n;
        u32x4 o; o.x = cvtpk(s[0 * 33], s[1 * 33]); o.y = cvtpk(s[2 * 33], s[3 * 33]); o.z = cvtpk(s[4 * 33], s[5 * 33]); o.w = cvtpk(s[6 * 33], s[7 * 33]);
        const int nn = n0 + n;
        if (nn < N) { const int row = (map == 1) ? (256 * (nn >> 7) + (nn & 127) + row_off) : (map == 2) ? (nn < 1280 ? nn : (nn < 1304 ? nn + 416 : nn - 24)) : (map == 3) ? ((nn / 96) * 128 + nn % 96) : (map == 4) ? (nn < 1024 ? nn : (nn < 2048 ? 1024 + 256 * ((nn - 1024) >> 7) + ((nn - 1024) & 127) : 1024 + 256 * ((nn - 2048) >> 7) + 128 + ((nn - 2048) & 127))) : (nn + row_off);
            *(u32x4*)(WT + (size_t)row * K + k0 + 8 * c) = o; } }
    asm volatile("s_waitcnt lgkmcnt(0)" ::: "memory");
}
__device__ __forceinline__ void rms_row_to_bf16(const float* xrow, const float* g, bf16_t* orow, int lane) {
    const f32x4* xr = (const f32x4*)xrow + lane; const f32x4* gr = (const f32x4*)g + lane;
    f32x4 v[4]; float s = 0.f;
#pragma unroll
    for (int j = 0; j < 4; ++j) { v[j] = xr[64 * j]; s += (v[j].x * v[j].x + v[j].y * v[j].y) + (v[j].z * v[j].z + v[j].w * v[j].w); }
    const float r = rsqrtf(wsum(s) * (1.f / 1024.f) + EPS);
    u32x2* o8 = (u32x2*)orow + lane;
#pragma unroll
    for (int j = 0; j < 4; ++j) { const f32x4 gg = gr[64 * j]; u32x2 w; w.x = cvtpk(v[j].x * r * gg.x, v[j].y * r * gg.y); w.y = cvtpk(v[j].z * r * gg.z, v[j].w * r * gg.w); o8[64 * j] = w; }
}
constexpr int WD_EARLY = 6;
__device__ __forceinline__ void convert_weights(const Params& p, LAS unsigned char* lds, int d_lo, int d_hi) {
    const int tid = ltid(), lane = tid & 63, wave = tid >> 6;
    const int gw = blockIdx.x * 8 + wave, NGW = gridDim.x * 8;
    LAS float* scr = (LAS float*)(lds + wave * 16384);
    int base = 0;
#pragma unroll 1
    for (int d = d_lo; d < d_hi; ++d) {
        const WDesc& wd = (d < 13) ? WDESC[d] : WDESC_MD;
        const int n_it = wd.rep * (wd.K / 64) * ((wd.N + 31) / 32);
        int first = (gw - (base % NGW) + NGW) % NGW;
        const int per = (wd.K / 64) * ((wd.N + 31) / 32); const float* gain = wd.gain_idx >= 0 ? p.in[wd.gain_idx] : nullptr;
        for (int it = first; it < n_it; it += 4 * NGW) {
            WItem I[4];
#pragma unroll
            for (int q = 0; q < 4; ++q) { const int iq = it + q * NGW; if (iq < n_it) { const int r = iq / per; item_load(I[q], p.in[wd.in_idx] + wd.src_off + (size_t)r * wd.src_stride, wd.K, wd.N, gain, iq % per, lane); } }
#pragma unroll
            for (int q = 0; q < 4; ++q) { const int iq = it + q * NGW; if (iq < n_it) { const int r = iq / per; item_finish(I[q], wd.K, wd.N, (bf16_t*)p.ws + wd.dst_off + (size_t)r * wd.dst_stride, wd.map, wd.row_off, scr, iq % per, lane); } }
        }
        base += n_it;
    }
}
__device__ __forceinline__ void phase_p0(const Params& p, LAS unsigned char* lds) {
    const int tid = ltid(), lane = tid & 63, wave = tid >> 6;
    const int gw = blockIdx.x * 8 + wave, NGW = gridDim.x * 8;
    convert_weights(p, lds, 0, WD_EARLY);
    bf16_t* xn = (bf16_t*)(p.ws + R_XN);
    for (int m = gw; m < T; m += 2 * NGW) { rms_row_to_bf16(p.in[0] + (size_t)m * D, p.in[2], xn + (size_t)m * D, lane); if (m + NGW < T) rms_row_to_bf16(p.in[0] + (size_t)(m + NGW) * D, p.in[2], xn + (size_t)(m + NGW) * D, lane); }
    for (int u = gw; u < 256; u += NGW) {
        const int kc = u >> 3, kv = (u >> 2) & 1, nb = u & 3; float s = 0.f;
        const float* pos = p.in[6] + kv * 2048 + kc * 64; const float* w1 = p.in[7] + ((size_t)kv * 2048 + kc * 64) * 256 + nb * 64 + lane;
#pragma unroll 8
        for (int k = 0; k < 64; ++k) s += pos[k] * w1[(size_t)k * 256];
        ((float*)(p.ws + SM_B1P))[kc * 512 + kv * 256 + nb * 64 + lane] = s;
    }
    for (int i = blockIdx.x * 512 + tid; i < S * 16; i += gridDim.x * 512) {
        const int t = i >> 4, f = i & 15; const float ang = (float)t * powf(10000.f, -(float)f / 16.f);
        float* rp = (float*)(p.ws + SM_ROPE) + t * 32; rp[f] = cosf(ang); rp[16 + f] = sinf(ang);
    }
    if (blockIdx.x == 0) for (int i = tid; i < 8 * 129; i += 512) { const int h = i / 129, dd = i % 129; ((float*)(p.ws + SM_BL))[h * 132 + dd] = p.in[1][(dd < 128 ? (int)gold::T5B[dd] : 31) * 8 + h] * LOG2E; }
}

__device__ __forceinline__ void unpack8(const u32x4 v, float (&x)[8]) { x[0] = bflo(v.x); x[1] = bfhi(v.x); x[2] = bflo(v.y); x[3] = bfhi(v.y); x[4] = bflo(v.z); x[5] = bfhi(v.z); x[6] = bflo(v.w); x[7] = bfhi(v.w); }
__device__ __forceinline__ u32x4 pack8(const float (&x)[8]) { u32x4 w; w.x = cvtpk(x[0], x[1]); w.y = cvtpk(x[2], x[3]); w.z = cvtpk(x[4], x[5]); w.w = cvtpk(x[6], x[7]); return w; }
__device__ __forceinline__ float ss8f(const float (&x)[8]) { return ((x[0] * x[0] + x[1] * x[1]) + (x[2] * x[2] + x[3] * x[3])) + ((x[4] * x[4] + x[5] * x[5]) + (x[6] * x[6] + x[7] * x[7])); }
__device__ __forceinline__ void load8f(const float* g, float (&x)[8], float sc) { const f32x4 a = *(const f32x4*)g, b = *(const f32x4*)(g + 4); x[0] = a.x * sc; x[1] = a.y * sc; x[2] = a.z * sc; x[3] = a.w * sc; x[4] = b.x * sc; x[5] = b.y * sc; x[6] = b.z * sc; x[7] = b.w * sc; }
__device__ __forceinline__ void phase_p2(const Params& p, LAS unsigned char* lds) {
    const int tid = ltid(), lane = tid & 63, wave = tid >> 6;
    const bf16_t* hb = (const bf16_t*)(p.ws + R_H);
    unsigned char* xa = p.ws + R_XA;
    bf16_t* qn = (bf16_t*)(xa + A_QN); bf16_t* ksn = (bf16_t*)(xa + A_KSN); bf16_t* kwn = (bf16_t*)(xa + A_KWN);
    bf16_t* vst = (bf16_t*)(xa + A_VST); bf16_t* vwt = (bf16_t*)(xa + A_VWT); bf16_t* kcin = (bf16_t*)(xa + A_KCIN); bf16_t* vcin = (bf16_t*)(xa + A_VCIN);
    bf16_t* cqn = (bf16_t*)(xa + A_CQN); bf16_t* ckvn = (bf16_t*)(xa + A_CKVN); bf16_t* krope = (bf16_t*)(xa + A_KROPE); float* gates = (float*)(xa + A_GATES);
    LAS bf16_t* vs = (LAS bf16_t*)lds;
    if (blockIdx.x == 0) {
        { float s = 0.f; for (int k = 0; k < 32; ++k) s += ((const float*)(p.ws + SM_B1P))[k * 512 + tid]; ((float*)(p.ws + SM_B1))[tid] = s; }
        for (int i = tid; i < 1024; i += 512) { kcin[(size_t)T * 128 + i] = 0; vcin[(size_t)T * 128 + i] = 0; }
    }
    const int c8 = (lane & 7) * 8, seg = lane >> 3;
    float qg[8], ksg[8], kwg[8], cqg[8], ckvg[8];
    load8f(p.in[4] + c8, qg, 0.125f * LOG2E); load8f(p.in[5] + 64 + c8, ksg, 1.f); load8f(p.in[5] + 128 + c8, kwg, 1.f);
    load8f(p.in[9] + (lane & 31) * 8, cqg, 1.f); load8f(p.in[10] + (lane & 15) * 8, ckvg, 1.f);
    for (int tile = blockIdx.x; tile < T / 64; tile += gridDim.x) {
        const int b = tile / (S / 64), s0 = (tile % (S / 64)) * 64;
#pragma unroll 4
        for (int tt = 0; tt < 8; ++tt) {
            const int sl = wave * 8 + tt, s = s0 + sl; const size_t t = (size_t)b * S + s;
            const bf16_t* hr = hb + t * 1792 + lane * 8;
            const u32x4 L0 = *(const u32x4*)hr, L1 = *(const u32x4*)(hr + 512), L2 = *(const u32x4*)(hr + 1024);
            u32x4 L3 = {0u, 0u, 0u, 0u}; if (lane < 32) L3 = *(const u32x4*)(hr + 1536);
            float x0[8], x1[8], x2[8], x3[8];
            unpack8(L0, x0); unpack8(L1, x1); unpack8(L2, x2); unpack8(L3, x3);
            float a0 = ss8f(x0), a1 = ss8f(x1), a2 = ss8f(x2), a3 = ss8f(x3);
#define P2_DPP(v, ctrl) __builtin_bit_cast(float, __builtin_amdgcn_update_dpp(0, __builtin_bit_cast(int, (v)), (ctrl), 0xF, 0xF, true))
#define P2_SUM8(v) do { v += P2_DPP(v, 0xB1); v += P2_DPP(v, 0x4E); v += P2_DPP(v, 0x141); } while (0)
            P2_SUM8(a0); P2_SUM8(a1); P2_SUM8(a2); P2_SUM8(a3);
            float a2w = a2 + P2_DPP(a2, 0x140); a2w += __shfl_xor(a2w, 16);
            const float a3w = a3 + P2_DPP(a3, 0x140);
#undef P2_SUM8
#undef P2_DPP
            const int pp0 = (sl & ~15) | perm16(sl & 15);
            const int pp = (((pp0 >> 3) ^ (lane & 7)) << 3) | (pp0 & 7);
            {
                const float r = rsqrtf(a0 * (1.f / 64.f) + EPS); float y[8];
#pragma unroll
                for (int j = 0; j < 8; ++j) y[j] = x0[j] * r * qg[j];
                *(u32x4*)(qn + t * 512 + lane * 8) = pack8(y);
            }
            {
                const int g = seg & 1; const size_t gm = (((size_t)b * 2 + g) * S + s) * 64 + c8;
                if (seg < 2) *(u32x4*)(kcin + gm) = L1;
                else if (seg < 4) *(u32x4*)(vcin + gm) = L1;
                else if (seg < 6) { const float r = rsqrtf(a1 * (1.f / 64.f) + EPS); float y[8];
#pragma unroll
                    for (int j = 0; j < 8; ++j) y[j] = x1[j] * r * ksg[j];
                    *(u32x4*)(ksn + gm) = pack8(y); }
                else {
#pragma unroll
                    for (int j = 0; j < 8; ++j) vs[((0 + g) * 64 + c8 + j) * 72 + pp] = (bf16_t)((j & 1) ? (L1[j >> 1] >> 16) : (L1[j >> 1] & 0xffffu)); }
            }
            {
                const int g = seg & 1; const size_t gm = (((size_t)b * 2 + g) * S + s) * 64 + c8;
                if (seg < 2) { const float r = rsqrtf(a2 * (1.f / 64.f) + EPS); float y[8];
#pragma unroll
                    for (int j = 0; j < 8; ++j) y[j] = x2[j] * r * kwg[j];
                    *(u32x4*)(kwn + gm) = pack8(y); }
                else if (seg < 4) {
#pragma unroll
                    for (int j = 0; j < 8; ++j) vs[((2 + g) * 64 + c8 + j) * 72 + pp] = (bf16_t)((j & 1) ? (L2[j >> 1] >> 16) : (L2[j >> 1] & 0xffffu)); }
                else { const float r = rsqrtf(a2w * (1.f / 256.f) + EPS); float y[8];
#pragma unroll
                    for (int j = 0; j < 8; ++j) y[j] = x2[j] * r * cqg[j];
                    *(u32x4*)(cqn + t * 256 + (lane - 32) * 8) = pack8(y); }
            }
            {
                if (lane < 16) { const float r = rsqrtf(a3w * (1.f / 128.f) + EPS); float y[8];
#pragma unroll
                    for (int j = 0; j < 8; ++j) y[j] = x3[j] * r * ckvg[j];
                    *(u32x4*)(ckvn + t * 128 + lane * 8) = pack8(y); }
                else if (lane < 20) *(u32x4*)(krope + t * 32 + (lane - 16) * 8) = L3;
                else if (lane < 23) { float y[8];
#pragma unroll
                    for (int j = 0; j < 8; ++j) y[j] = frcp(1.f + fexp2(-x3[j] * LOG2E));
                    float* gp = gates + t * 24 + (lane - 20) * 8; *(f32x4*)gp = (f32x4){y[0], y[1], y[2], y[3]}; *(f32x4*)(gp + 4) = (f32x4){y[4], y[5], y[6], y[7]}; }
            }
        }
        __syncthreads();
        {
            const int ch = tid & 7;
#pragma unroll
            for (int i = 0; i < 4; ++i) { const int row = (tid >> 3) + 64 * i, which = row >> 6, d = row & 63, g = which & 1, sx = (row >> 3) & 7;
                bf16_t* dst = ((which < 2) ? vst : vwt) + (((size_t)b * 2 + g) * 64 + d) * S + s0 + ch * 8;
                *(u32x4*)dst = *(const LAS u32x4*)(vs + row * 72 + ((ch ^ sx) << 3)); }
        }
        __syncthreads();
    }
}
__device__ __forceinline__ void phase_p3b(const Params& p, LAS unsigned char* lds, int parts = 3) {
    const int tid = ltid(), lane = tid & 63, wave = tid >> 6;
    const int gw = blockIdx.x * 8 + wave, NGW = gridDim.x * 8;
    const bf16_t* qraw = (const bf16_t*)(p.ws + R_H);
    const bf16_t* kvraw = (const bf16_t*)(p.ws + R_H + (size_t)T * 2048);
    const bf16_t* krope = (const bf16_t*)(p.ws + R_XA + A_KROPE);
    const float* rope = (const float*)(p.ws + SM_ROPE);
    bf16_t* qm = (bf16_t*)((unsigned char*)p.out + O_QM); bf16_t* km = (bf16_t*)((unsigned char*)p.out + O_KM); bf16_t* vmt = (bf16_t*)((unsigned char*)p.out + O_VMT);
    const float* q_norm = p.in[13]; const float* k_norm = p.in[14];
    LAS bf16_t* vs = (LAS bf16_t*)lds;
    LAS float* w2s = (LAS float*)(lds + 73728);
    if (parts & 1) {
        LAS float* w2a = (LAS float*)lds;
        constexpr int NR = NB * 512;
        u32x2 pa[2][2], pb[2][2];
#define P3_ROWLOADS(r0_) do { _Pragma("unroll") for (int kv = 0; kv < 2; ++kv) _Pragma("unroll") for (int q = 0; q < 2; ++q) { \
            int row = (r0_) + q * NGW; row = row < NR ? row : 0; const int row1 = row + 1 < NR ? row + 1 : row;        \
            const bf16_t* P = (const bf16_t*)(p.ws + SM_HID) + (size_t)kv * NB * 512 * 512;       \
            pa[kv][q] = *(const u32x2*)(P + (size_t)row * 512 + lane * 4); pb[kv][q] = *(const u32x2*)(P + (size_t)row1 * 512 + 256 + lane * 4); } } while (0)
        __syncthreads();
        { f32x4 wv[16];
#pragma unroll
          for (int k = 0; k < 16; ++k) wv[k] = ((const f32x4*)p.in[8])[tid + 512 * k];
          P3_ROWLOADS(gw);
#pragma unroll
          for (int k = 0; k < 16; ++k) ((LAS f32x4*)w2a)[tid + 512 * k] = wv[k]; }
        __syncthreads();
        for (int row0 = gw; row0 < NR; row0 += 2 * NGW) {
            if (row0 != gw) P3_ROWLOADS(row0);
#pragma unroll
            for (int kv = 0; kv < 2; ++kv) {
                const f32x4 bs = *(const f32x4*)((const float*)(p.ws + SM_B1) + kv * 256 + lane * 4);
                const LAS float* w2s = w2a + kv * 16384;
#pragma unroll
                for (int q = 0; q < 2; ++q) { const int row = row0 + q * NGW; if (row >= NR) continue;
                    const u32x2 a_ = pa[kv][q], b_ = pb[kv][q];
                    const float h0 = gelu_tanh_f(bflo(a_.x) + bflo(b_.x) + bs.x), h1 = gelu_tanh_f(bfhi(a_.x) + bfhi(b_.x) + bs.y), h2 = gelu_tanh_f(bflo(a_.y) + bflo(b_.y) + bs.z), h3 = gelu_tanh_f(bfhi(a_.y) + bfhi(b_.y) + bs.w);
                    float acc0 = 0.f, acc1 = 0.f;
#pragma unroll 8
                    for (int k4 = 0; k4 < 64; ++k4) {
#define P3_RL(v) __builtin_bit_cast(float, __builtin_amdgcn_readlane(__builtin_bit_cast(int, (v)), k4))
                        acc0 += P3_RL(h0) * w2s[(k4 * 4 + 0) * 64 + lane]; acc1 += P3_RL(h1) * w2s[(k4 * 4 + 1) * 64 + lane];
                        acc0 += P3_RL(h2) * w2s[(k4 * 4 + 2) * 64 + lane]; acc1 += P3_RL(h3) * w2s[(k4 * 4 + 3) * 64 + lane];
#undef P3_RL
                    }
                    const float acc = acc0 + acc1;
                    if (kv == 0) { const float r = rsqrtf(wsum(acc * acc) * (1.f / 64.f) + EPS); ((bf16_t*)(p.ws + SM_KC))[(size_t)row * 64 + lane] = f2bf(acc * r * p.in[5][lane]); }
                    else { const int c = row & 255; ((bf16_t*)(p.ws + SM_VCT))[((size_t)(row >> 8) * 64 + lane) * 256 + ((c & ~15) | perm16(c & 15))] = f2bf(acc); }
                }
            }
        }
    }
#undef P3_ROWLOADS
    __syncthreads();
    const float QS = 0.10206207261596577f * LOG2E;
    const int c = lane & 15, hl = lane >> 4;
    float qg[8], kg[8];
    load8f(q_norm + (c < 12 ? c * 8 : 0), qg, QS);
    load8f(k_norm + (c < 12 ? c * 8 : 0), kg, 1.f);
    const bool isrope = (c >= 8) && (c < 12);
    const float m12 = c < 12 ? 1.f : 0.f, sgn = c < 10 ? -1.f : 1.f;
    const int cr8 = isrope ? (c - 8) * 8 : 0;
#define P3_DPP(v, ctrl) __builtin_bit_cast(float, __builtin_amdgcn_update_dpp(0, __builtin_bit_cast(int, (v)), (ctrl), 0xF, 0xF, true))
#define P3_SUM16(v) do { v += P3_DPP(v, 0xB1); v += P3_DPP(v, 0x4E); v += P3_DPP(v, 0x141); v += P3_DPP(v, 0x140); } while (0)
    if (parts & 2) for (int tile = blockIdx.x; tile < T / 64; tile += gridDim.x) {
        const int b = tile / (S / 64), s0 = (tile % (S / 64)) * 64;
#pragma unroll 4
        for (int tt = 0; tt < 8; ++tt) {
            const int sl = wave * 8 + tt, s = s0 + sl; const size_t t = (size_t)b * S + s;
            const int pp0 = (sl & ~15) | perm16(sl & 15);
            const int pp = (((pp0 >> 3) ^ ((c - 8) & 7)) << 3) | (pp0 & 7);
            u32x4 Q[2], KV[2];
#pragma unroll
            for (int ld = 0; ld < 2; ++ld) { Q[ld] = *(const u32x4*)(qraw + t * 1024 + ld * 512 + lane * 8); KV[ld] = *(const u32x4*)(kvraw + t * 1024 + ld * 512 + lane * 8); }
            const u32x4 KR = *(const u32x4*)(krope + t * 32 + cr8);
            const float* rp = rope + s * 32 + (c & 1) * 8; const f32x4 cs0 = *(const f32x4*)rp, cs1 = *(const f32x4*)(rp + 4), sn0 = *(const f32x4*)(rp + 16), sn1 = *(const f32x4*)(rp + 20);
            const float csr[8] = {cs0.x, cs0.y, cs0.z, cs0.w, cs1.x, cs1.y, cs1.z, cs1.w}, snr[8] = {sn0.x, sn0.y, sn0.z, sn0.w, sn1.x, sn1.y, sn1.z, sn1.w};
            float cse[8], sne[8], kr[8]; unpack8(KR, kr);
#pragma unroll
            for (int j = 0; j < 8; ++j) { cse[j] = isrope ? csr[j] : 1.f; sne[j] = isrope ? snr[j] * sgn : 0.f; kr[j] = isrope ? kr[j] : 0.f; }
#pragma unroll
            for (int ld = 0; ld < 2; ++ld) {
                const int hh = ld * 4 + hl;
                {
                    float x[8]; unpack8(Q[ld], x);
                    float ss = ss8f(x) * m12; P3_SUM16(ss);
                    const float r = rsqrtf(ss * (1.f / 96.f) + EPS); float y[8], z[8];
#pragma unroll
                    for (int j = 0; j < 8; ++j) y[j] = x[j] * (r * qg[j]);
#pragma unroll
                    for (int j = 0; j < 8; ++j) { const float pb = P3_DPP(y[j], 0x4E); z[j] = __builtin_fmaf(pb, sne[j], y[j] * cse[j]); }
                    if (c < 12) *(u32x4*)(qm + (t * 8 + hh) * 96 + c * 8) = pack8(z);
                }
                {
                    float x[8], xk[8]; unpack8(KV[ld], x);
#pragma unroll
                    for (int j = 0; j < 8; ++j) xk[j] = c < 8 ? x[j] : kr[j];
                    float ss = ss8f(xk); P3_SUM16(ss);
                    const float r = rsqrtf(ss * (1.f / 96.f) + EPS); float y[8], z[8];
#pragma unroll
                    for (int j = 0; j < 8; ++j) y[j] = xk[j] * (r * kg[j]);
#pragma unroll
                    for (int j = 0; j < 8; ++j) { const float pb = P3_DPP(y[j], 0x4E); z[j] = __builtin_fmaf(pb, sne[j], y[j] * cse[j]); }
                    if (c < 12) *(u32x4*)(km + (((size_t)b * 8 + hh) * S + s) * 96 + c * 8) = pack8(z);
                    if (c >= 8) {
#pragma unroll
                        for (int j = 0; j < 8; ++j) vs[(hh * 64 + (c - 8) * 8 + j) * 72 + pp] = (bf16_t)((j & 1) ? (KV[ld][j >> 1] >> 16) : (KV[ld][j >> 1] & 0xffffu)); }
                }
            }
        }
        __syncthreads();
        {
            const int ch = tid & 7;
#pragma unroll
            for (int i = 0; i < 8; ++i) { const int row = (tid >> 3) + 64 * i, hh = row >> 6, d = row & 63, sx = (row >> 3) & 7;
                *(u32x4*)(vmt + (((size_t)b * 8 + hh) * 64 + d) * S + s0 + ch * 8) = *(const LAS u32x4*)(vs + row * 72 + ((ch ^ sx) << 3)); }
        }
        __syncthreads();
    }
#undef P3_SUM16
#undef P3_DPP
}
__device__ const unsigned short UNIT_TYPES[256] = {63,127,62,126,61,125,527,591,655,719,783,847,911,975,60,124,59,123,58,122,57,121,56,120,526,590,654,718,782,846,910,974,55,119,54,118,53,117,52,116,51,115,525,589,653,717,781,845,909,973,50,114,49,113,48,112,47,111,524,588,652,716,780,844,908,972,46,110,45,109,44,108,43,107,523,587,651,715,779,843,907,971,42,106,41,105,40,104,39,103,38,102,522,586,650,714,778,842,906,970,37,101,36,100,35,99,34,98,33,97,521,585,649,713,777,841,905,969,32,96,31,95,30,94,520,584,648,712,776,840,904,968,29,93,28,92,27,91,26,90,25,89,519,583,647,711,775,839,903,967,24,88,23,87,22,86,21,85,20,84,518,582,646,710,774,838,902,966,19,83,18,82,17,81,16,80,15,79,517,581,645,709,773,837,901,965,14,78,13,77,12,76,516,580,644,708,772,836,900,964,11,75,10,74,9,73,8,72,515,579,643,707,771,835,899,963,7,71,6,70,5,69,514,578,642,706,770,834,898,962,4,68,3,67,513,577,641,705,769,833,897,961,2,66,1,65,0,64,512,576,640,704,768,832,896,960};
__device__ __forceinline__ int crow(int r, int hi) { return (r & 3) + 8 * (r >> 2) + 4 * hi; }
struct Flash { f32x16 o0, o1; float l; };
__device__ __forceinline__ void flash_init(Flash& st) {
#pragma unroll
    for (int r = 0; r < 16; ++r) { st.o0[r] = 0.f; st.o1[r] = 0.f; }
    st.l = 0.f;
}
constexpr int AL_K64 = 0, AL_V64 = 4 * 8192;
constexpr int AL_K96 = 0, AL_V96 = 4 * 16384;
constexpr int AL_IMP = 65536, AL_SELB = AL_IMP + 64 * 65 * 4, AL_UNI = AL_SELB + 512, AL_TL = AL_UNI + 64, AL_BL = AL_TL + 128, AL_OT = AL_BL + 4 * 132 * 4, AL_END = AL_OT + 8 * 32 * 64 * 4;
static_assert(AL_END <= 163328 && AL_V96 + 4 * 8192 <= 163328, "attention LDS");

template <int RB> struct DmaLane { unsigned g0, g1; };
template <int RB> __device__ __forceinline__ void dma_setup(DmaLane<RB>& L, int w, int lane, unsigned gs) {
    if (RB == 128) { const int r = 8 * w + (lane >> 3), c = (lane & 7) ^ ((r >> 1) & 7); L.g0 = (unsigned)r * gs + c * 16; L.g1 = 0; }
    else {
        { const int r = 8 * w + (lane >> 4); int c = (lane & 15) ^ (r & 15); c = c >= 12 ? c - 4 : c; L.g0 = (unsigned)r * gs + c * 16; }
        { const int r = 8 * w + 4 + (lane >> 4); int c = (lane & 15) ^ (r & 15); c = c >= 12 ? c - 4 : c; L.g1 = (unsigned)r * gs + c * 16; }
    }
}
template <int RB> __device__ __forceinline__ void dma_issue(const unsigned char* tile, const DmaLane<RB>& L, LAS unsigned char* buf, int w) {
    if (RB == 128) __builtin_amdgcn_global_load_lds((const unsigned*)(tile + L.g0), (LAS unsigned*)(buf + w * 1024), 16, 0, 0);
    else { __builtin_amdgcn_global_load_lds((const unsigned*)(tile + L.g0), (LAS unsigned*)(buf + w * 2048), 16, 0, 0);
           __builtin_amdgcn_global_load_lds((const unsigned*)(tile + L.g1), (LAS unsigned*)(buf + w * 2048 + 1024), 16, 0, 0); }
}
template <int DK> __device__ __forceinline__ void frag_offsets(unsigned (&kl)[DK / 16], unsigned (&vl)[4], int r32, int hi) {
#pragma unroll
    for (int s = 0; s < DK / 16; ++s) kl[s] = (DK == 64) ? (unsigned)(r32 * 128 + (((2 * s + hi) ^ ((r32 >> 1) & 7)) << 4)) : (unsigned)(r32 * 256 + (((2 * s + hi) ^ (r32 & 15)) << 4));
#pragma unroll
    for (int s = 0; s < 4; ++s) vl[s] = (unsigned)(r32 * 128 + (((2 * s + hi) ^ ((r32 >> 1) & 7)) << 4));
}

template <int NS> struct KFrags { bf16x8 ka[NS], kh[NS]; };
template <int DK, int KP> __device__ __forceinline__ void kfrag_load(KFrags<DK / 16>& fr, const LAS unsigned char* Kt, const unsigned (&kl)[DK / 16]) {
#pragma unroll
    for (int s = 0; s < DK / 16; ++s) fr.ka[s] = *(const LAS bf16x8*)(Kt + kl[s]);
#pragma unroll
    for (int s = 0; s < DK / 16; ++s) fr.kh[s] = *(const LAS bf16x8*)(Kt + kl[s] + 32 * KP);
}
template <int DK, int KP, bool LANEMASK, class F>
__device__ __forceinline__ void tile_compute(Flash& st, KFrags<DK / 16>& fr, const LAS unsigned char* Kn, const LAS unsigned char* Vt, const bf16x8* qf, const f32x16& negm, const unsigned (&kl)[DK / 16], const unsigned (&vl)[4], bool mine, F f) {
    constexpr int NS = DK / 16; constexpr int KH = 32 * KP;
    (void)KH;
    f32x16 p0, p1;
#pragma unroll
    for (int s = 0; s < NS; ++s) p0 = (s == 0) ? __builtin_amdgcn_mfma_f32_32x32x16_bf16(fr.ka[0], qf[0], negm, 0, 0, 0) : __builtin_amdgcn_mfma_f32_32x32x16_bf16(fr.ka[s], qf[s], p0, 0, 0, 0);
#pragma unroll
    for (int s = 0; s < NS; ++s) p1 = (s == 0) ? __builtin_amdgcn_mfma_f32_32x32x16_bf16(fr.kh[0], qf[0], negm, 0, 0, 0) : __builtin_amdgcn_mfma_f32_32x32x16_bf16(fr.kh[s], qf[s], p1, 0, 0, 0);
    __builtin_amdgcn_sched_barrier(0);
    bf16x8 va[4], vh[4];
#pragma unroll
    for (int s = 0; s < 4; ++s) { va[s] = *(const LAS bf16x8*)(Vt + vl[s]); vh[s] = *(const LAS bf16x8*)(Vt + vl[s] + 4096); }
    kfrag_load<DK, KP>(fr, Kn, kl);
    __builtin_amdgcn_sched_barrier(0);
    float ls = 0.f, ls1 = 0.f;
    u32x4 w0, w1, w2, w3;
    {
#pragma unroll
        for (int r = 0; r < 16; ++r) { float x = p0[r]; const bool v = f(r, 0, x); const float e = fexp2(x); p0[r] = v ? e : 0.f; ls += p0[r]; }
        w0.x = cvtpk(p0[0], p0[1]); w0.y = cvtpk(p0[2], p0[3]); w0.z = cvtpk(p0[4], p0[5]); w0.w = cvtpk(p0[6], p0[7]);
        w1.x = cvtpk(p0[8], p0[9]); w1.y = cvtpk(p0[10], p0[11]); w1.z = cvtpk(p0[12], p0[13]); w1.w = cvtpk(p0[14], p0[15]);
        if (LANEMASK) { w0.x = mine ? w0.x : 0u; w0.y = mine ? w0.y : 0u; w0.z = mine ? w0.z : 0u; w0.w = mine ? w0.w : 0u; w1.x = mine ? w1.x : 0u; w1.y = mine ? w1.y : 0u; w1.z = mine ? w1.z : 0u; w1.w = mine ? w1.w : 0u; }
    }
#pragma unroll
    for (int s = 0; s < 2; ++s) {
        const bf16x8 pa = __builtin_bit_cast(bf16x8, s ? w1 : w0);
        st.o0 = __builtin_amdgcn_mfma_f32_32x32x16_bf16(pa, va[s], st.o0, 0, 0, 0);
        st.o1 = __builtin_amdgcn_mfma_f32_32x32x16_bf16(pa, vh[s], st.o1, 0, 0, 0);
    }
    {
#pragma unroll
        for (int r = 0; r < 16; ++r) { float x = p1[r]; const bool v = f(r, 1, x); const float e = fexp2(x); p1[r] = v ? e : 0.f; ls1 += p1[r]; }
        w2.x = cvtpk(p1[0], p1[1]); w2.y = cvtpk(p1[2], p1[3]); w2.z = cvtpk(p1[4], p1[5]); w2.w = cvtpk(p1[6], p1[7]);
        w3.x = cvtpk(p1[8], p1[9]); w3.y = cvtpk(p1[10], p1[11]); w3.z = cvtpk(p1[12], p1[13]); w3.w = cvtpk(p1[14], p1[15]);
        if (LANEMASK) { w2.x = mine ? w2.x : 0u; w2.y = mine ? w2.y : 0u; w2.z = mine ? w2.z : 0u; w2.w = mine ? w2.w : 0u; w3.x = mine ? w3.x : 0u; w3.y = mine ? w3.y : 0u; w3.z = mine ? w3.z : 0u; w3.w = mine ? w3.w : 0u; }
    }
    ls += ls1;
    if (LANEMASK) ls = mine ? ls : 0.f;
    st.l += ls;
#pragma unroll
    for (int s = 2; s < 4; ++s) {
        const bf16x8 pa = __builtin_bit_cast(bf16x8, (s == 3) ? w3 : w2);
        st.o0 = __builtin_amdgcn_mfma_f32_32x32x16_bf16(pa, va[s], st.o0, 0, 0, 0);
        st.o1 = __builtin_amdgcn_mfma_f32_32x32x16_bf16(pa, vh[s], st.o1, 0, 0, 0);
    }
}
template <int DK, int KP> __device__ __forceinline__ void qk_tile(f32x16& p0, f32x16& p1, const LAS unsigned char* Kt, const bf16x8* qf, const f32x16& negm, const unsigned (&kl)[DK / 16]) {
#pragma unroll
    for (int s = 0; s < DK / 16; ++s) {
        const bf16x8 a0 = *(const LAS bf16x8*)(Kt + kl[s]);
        const bf16x8 a1 = *(const LAS bf16x8*)(Kt + kl[s] + 32 * KP);
        if (s == 0) { p0 = __builtin_amdgcn_mfma_f32_32x32x16_bf16(a0, qf[0], negm, 0, 0, 0); p1 = __builtin_amdgcn_mfma_f32_32x32x16_bf16(a1, qf[0], negm, 0, 0, 0); }
        else { p0 = __builtin_amdgcn_mfma_f32_32x32x16_bf16(a0, qf[s], p0, 0, 0, 0); p1 = __builtin_amdgcn_mfma_f32_32x32x16_bf16(a1, qf[s], p1, 0, 0, 0); }
    }
}
template <bool FIRST> __device__ __forceinline__ void flash_accum(LAS float* otl, const Flash& st, float gate, int hi, int lane) {
    const float lt = st.l + __shfl_xor(st.l, 32);
    const float f = lt > 0.f ? gate * frcp(lt) : 0.f;
#pragma unroll
    for (int r = 0; r < 16; ++r) { const float fr_ = __shfl(f, crow(r, hi));
        if (FIRST) { otl[r * 64 + lane] = fr_ * st.o0[r]; otl[(16 + r) * 64 + lane] = fr_ * st.o1[r]; }
        else { otl[r * 64 + lane] += fr_ * st.o0[r]; otl[(16 + r) * 64 + lane] += fr_ * st.o1[r]; } }
}
template <int NS> __device__ __forceinline__ float qnorm2(const bf16x8* qf) {
    float s = 0.f;
#pragma unroll
    for (int i = 0; i < NS; ++i)
#pragma unroll
        for (int j = 0; j < 8; ++j) { const float x = bf2f((bf16_t)qf[i][j]); s += x * x; }
    return s + __shfl_xor(s, 32);
}
__device__ __forceinline__ float wmax(float v) {
#pragma unroll
    for (int o = 1; o < 64; o <<= 1) v = fmaxf(v, __shfl_xor(v, o));
    return v;
}

struct NoComp {};
template <class T> struct is_nocomp { static constexpr bool v = false; };
template <> struct is_nocomp<NoComp> { static constexpr bool v = true; };
template <class C> __device__ __forceinline__ void rt_call(C& c, int t, LAS unsigned char* kb, LAS unsigned char* vb, LAS unsigned char* kn) { c(t, kb, vb, kn); }
__device__ __forceinline__ void rt_call(NoComp&, int, LAS unsigned char*, LAS unsigned char*, LAS unsigned char*) {}
template <class C> __device__ __forceinline__ void kl_call(C& c, LAS unsigned char* kb) { c(kb); }
__device__ __forceinline__ void kl_call(NoComp&, LAS unsigned char*) {}
template <int RBK, bool HASV, int KOFF, int KSZ, int VOFF, class SrcK, class SrcV, class C0, class C1, class C2, class KL = NoComp>
__device__ __forceinline__ void run_tiles(int n, int e0, int e1, int e2, LAS unsigned char* lds, int w, int lane, unsigned gsK, unsigned gsV, SrcK srcK, SrcV srcV, C0 c0, C1 c1, C2 c2, KL kload = KL{}) {
    DmaLane<RBK> LK; dma_setup<RBK>(LK, w, lane, gsK);
    DmaLane<128> LV; LV.g0 = 0; LV.g1 = 0; if (HASV) dma_setup<128>(LV, w, lane, gsV);
    const int nl = n - 1, t1 = nl < 1 ? nl : 1, t2 = nl < 2 ? nl : 2;
    e0 = __builtin_amdgcn_readfirstlane(e0); e1 = __builtin_amdgcn_readfirstlane(e1); e2 = __builtin_amdgcn_readfirstlane(e2);
    dma_issue<RBK>(srcK(0), LK, lds + KOFF, w); if (HASV) dma_issue<128>(srcV(0), LV, lds + VOFF, w);
    dma_issue<RBK>(srcK(t1), LK, lds + KOFF + KSZ, w); if (HASV) dma_issue<128>(srcV(t1), LV, lds + VOFF + 8192, w);
    dma_issue<RBK>(srcK(t2), LK, lds + KOFF + 2 * KSZ, w); if (HASV) dma_issue<128>(srcV(t2), LV, lds + VOFF + 2 * 8192, w);
    constexpr int P = (RBK == 128 ? 1 : 2) + (HASV ? 1 : 0);
    int t = 0, slot = 0;
    constexpr bool KPRE = !is_nocomp<KL>::v;
    if (KPRE) {
        if (P == 1) asm volatile("s_waitcnt vmcnt(2)" ::: "memory"); else if (P == 2) asm volatile("s_waitcnt vmcnt(4)" ::: "memory"); else asm volatile("s_waitcnt vmcnt(6)" ::: "memory");
        __builtin_amdgcn_s_barrier(); asm volatile("" ::: "memory");
        kl_call(kload, lds + KOFF);
    }
#define RT_HEAD() do { \
        if (KPRE) { if (P == 1) asm volatile("s_waitcnt vmcnt(1)" ::: "memory"); else if (P == 2) asm volatile("s_waitcnt vmcnt(2)" ::: "memory"); else asm volatile("s_waitcnt vmcnt(3)" ::: "memory"); } \
        else if (P == 1) asm volatile("s_waitcnt vmcnt(2)" ::: "memory"); else if (P == 2) asm volatile("s_waitcnt vmcnt(4)" ::: "memory"); else asm volatile("s_waitcnt vmcnt(6)" ::: "memory"); \
        __builtin_amdgcn_s_barrier(); asm volatile("" ::: "memory"); \
        { const int tn = (t + 3 < nl) ? t + 3 : nl; const int s2 = (slot + 3) & 3; \
          dma_issue<RBK>(srcK(tn), LK, lds + KOFF + s2 * KSZ, w); if (HASV) dma_issue<128>(srcV(tn), LV, lds + VOFF + s2 * 8192, w); } } while (0)
#define RT_SEG(cc, ee) if (!is_nocomp<decltype(cc)>::v) { _Pragma("unroll 1") for (; t < (ee); ++t) { RT_HEAD(); rt_call(cc, t, lds + KOFF + slot * KSZ, lds + VOFF + slot * 8192, lds + KOFF + ((slot + 1) & 3) * KSZ); slot = (slot + 1) & 3; } }
    RT_SEG(c0, e0)
    RT_SEG(c1, e1)
    RT_SEG(c2, e2)
#pragma unroll 1
    for (; t < n; ++t) { RT_HEAD(); slot = (slot + 1) & 3; }
#undef RT_SEG
#undef RT_HEAD
    asm volatile("s_waitcnt vmcnt(0)" ::: "memory");
    __syncthreads();
}

__device__ __forceinline__ void mla_unit(const Params& p, LAS unsigned char* lds, int b, int h, int qb) {
    int tid = threadIdx.x; asm volatile("" : "+v"(tid));
    const int lane = tid & 63, w = __builtin_amdgcn_readfirstlane(tid >> 6), r32 = lane & 31, hi = lane >> 5;
    const bf16_t* qm = (const bf16_t*)((const unsigned char*)p.out + O_QM);
    const unsigned char* km = (const unsigned char*)p.out + O_KM + (((size_t)b * 8 + h) * S) * 192;
    const unsigned char* vmt = (const unsigned char*)p.out + O_VMT + (((size_t)b * 8 + h) * 64) * (size_t)S * 2;
    bf16_t* ocat = (bf16_t*)(p.ws + R_XN);
    const int tq = qb * 256 + 32 * w + r32;
    bf16x8 qf[6];
#pragma unroll
    for (int s = 0; s < 6; ++s) qf[s] = *(const bf16x8*)(qm + (((size_t)b * S + tq) * 8 + h) * 96 + 16 * s + 8 * hi);
    const float kn = 9.797958971f * 1.01f * wmax(fmaxf(fabsf(p.in[14][lane]), lane < 32 ? fabsf(p.in[14][64 + lane]) : 0.f));
    const float mref = sqrtf(qnorm2<6>(qf)) * kn;
    f32x16 negm;
#pragma unroll
    for (int r = 0; r < 16; ++r) negm[r] = -mref;
    Flash st; flash_init(st);
    const int ntile = 4 * qb + 4, dt = 4 * qb + (w >> 1);
#ifdef PROF_SEL
    if (b == 0 && h == 0 && qb == 15 && threadIdx.x == 0) { *PROF_SLOT(36) -= __builtin_amdgcn_s_memtime(); *PROF_SLOT(37) -= __builtin_amdgcn_s_memrealtime(); }
#endif
    unsigned kl[6], vl[4]; frag_offsets<96>(kl, vl, r32, hi);
    KFrags<6> fr;
    run_tiles<192, true, AL_K96, 16384, AL_V96>(ntile, dt, dt + 1, dt + 1, lds, w, lane, 192u, (unsigned)(S * 2),
        [&](int i) { return km + (size_t)i * 64 * 192; }, [&](int i) { return vmt + (size_t)i * 128; },
        [&](int i, LAS unsigned char* kb, LAS unsigned char* vb, LAS unsigned char* kn) { tile_compute<96, 256, false>(st, fr, kn, vb, qf, negm, kl, vl, true, [&](int r, int half, float& x) { return true; }); },
        [&](int i, LAS unsigned char* kb, LAS unsigned char* vb, LAS unsigned char* kn) { const int kb0 = 64 * i + 4 * hi; tile_compute<96, 256, false>(st, fr, kn, vb, qf, negm, kl, vl, true, [&](int r, int half, float& x) { return (kb0 + 32 * half + (r & 3) + 8 * (r >> 2)) <= tq; }); },
        NoComp{}, [&](LAS unsigned char* kb) { kfrag_load<96, 256>(fr, kb, kl); });
#ifdef PROF_SEL
    if (b == 0 && h == 0 && qb == 15 && threadIdx.x == 0) { *PROF_SLOT(36) += __builtin_amdgcn_s_memtime(); *PROF_SLOT(37) += __builtin_amdgcn_s_memrealtime(); }
#endif
    {
        const float lt = st.l + __shfl_xor(st.l, 32); const float f = lt > 0.f ? frcp(lt) : 0.f;
#pragma unroll
        for (int r = 0; r < 16; ++r) { const float fr_ = __shfl(f, crow(r, hi)); const size_t ro = ((size_t)b * S + qb * 256 + 32 * w + crow(r, hi)) * 1024 + 512 + h * 64 + r32; ocat[ro] = f2bf(st.o0[r] * fr_); ocat[ro + 32] = f2bf(st.o1[r] * fr_); }
    }
}

__device__ __forceinline__ void nsa_unit(const Params& p, LAS unsigned char* lds, int b, int g, int jt) {
    int tid = threadIdx.x; asm volatile("" : "+v"(tid));
    const int lane = tid & 63, w = __builtin_amdgcn_readfirstlane(tid >> 6), r32 = lane & 31, hi = lane >> 5;
    const int rh = w >> 1, qh = w & 1, h = 4 * g + rh, q0 = 64 * jt, ql = 32 * qh + r32, tq = q0 + ql;
    const unsigned char* xa = p.ws + R_XA;
    const bf16_t* qn = (const bf16_t*)(xa + A_QN);
    const size_t bg = (size_t)b * 2 + g;
    const unsigned char* ksn = xa + A_KSN + bg * S * 128; const unsigned char* kwn = xa + A_KWN + bg * S * 128;
    const unsigned char* vst = xa + A_VST + bg * 64 * (size_t)S * 2; const unsigned char* vwt = xa + A_VWT + bg * 64 * (size_t)S * 2;
    const unsigned char* kc = p.ws + SM_KC + bg * 256 * 128; const unsigned char* vct = p.ws + SM_VCT + bg * 64 * 512;
    const float* gates = (const float*)(xa + A_GATES) + ((size_t)b * S + tq) * 24 + h * 3;
    bf16_t* ocat = (bf16_t*)(p.ws + R_XN);
    LAS float* imp = (LAS float*)(lds + AL_IMP); LAS unsigned char* selb = lds + AL_SELB; LAS unsigned* uni = (LAS unsigned*)(lds + AL_UNI); LAS unsigned char* tl = lds + AL_TL; LAS float* bls = (LAS float*)(lds + AL_BL);
    const float* blg = (const float*)(p.ws + SM_BL) + h * 132;
    const float cb = blg[128];
    const float bmax = wmax(fmaxf(fmaxf(blg[lane], blg[64 + lane]), cb));
    if (qh == 0) { bls[rh * 132 + lane] = blg[lane] - cb; bls[rh * 132 + 64 + lane] = blg[64 + lane] - cb; if (lane == 0) bls[rh * 132 + 128] = 0.f; }
    const LAS float* blh = bls + rh * 132;
    bf16x8 qf[4];
#pragma unroll
    for (int s = 0; s < 4; ++s) qf[s] = *(const bf16x8*)(qn + (((size_t)b * S + tq) * 8 + h) * 64 + 16 * s + 8 * hi);
    const float kn = 8.f * 1.01f * wmax(fmaxf(fmaxf(fabsf(p.in[5][lane]), fabsf(p.in[5][64 + lane])), fabsf(p.in[5][128 + lane])));
    const float mref = sqrtf(qnorm2<4>(qf)) * kn + bmax;
    f32x16 negm;
#pragma unroll
    for (int r = 0; r < 16; ++r) negm[r] = cb - mref;
    float g0 = gates[0], g1 = gates[1], g2 = gates[2];
    if (p.dbg_branch >= 0) { g0 = p.dbg_branch == 0 ? 1.f : 0.f; g1 = p.dbg_branch == 1 ? 1.f : 0.f; g2 = p.dbg_branch == 2 ? 1.f : 0.f; }
    LAS float* otl = (LAS float*)(lds + AL_OT) + w * 2048;
#ifdef PROF_SEL
    if (b == 0 && g == 0 && jt == 63 && threadIdx.x == 0) *PROF_SLOT(48) -= __builtin_amdgcn_s_memtime();
#endif
    const int nvmax = (q0 + 63 - 31) / 16 + 1, ntc = (nvmax + 63) / 64;
    Flash st; flash_init(st);
    unsigned kl[4], vl[4]; frag_offsets<64>(kl, vl, r32, hi);
    KFrags<4> fr;
    const int qb32 = q0 + 32 * qh;
    int ecf = 0;
    for (int i = 0; i < ntc; ++i) if (qb32 - (16 * (64 * i + 63) + 31) >= 128) ecf = i + 1;
    run_tiles<128, true, AL_K64, 8192, AL_V64>(ntc, ecf, ntc, ntc, lds, w, lane, 128u, 512u,
        [&](int i) { return kc + (size_t)i * 64 * 128; }, [&](int i) { return vct + (size_t)i * 128; },
        [&](int i, LAS unsigned char* kb, LAS unsigned char* vb, LAS unsigned char* kn) { tile_compute<64, 128, false>(st, fr, kn, vb, qf, negm, kl, vl, true, [&](int r, int half, float& x) { return true; }); },
        [&](int i, LAS unsigned char* kb, LAS unsigned char* vb, LAS unsigned char* kn) {
            const int cb0 = 64 * i + 4 * hi;
            tile_compute<64, 128, false>(st, fr, kn, vb, qf, negm, kl, vl, true, [&](int r, int half, float& x) {
                const int c = cb0 + 32 * half + (r & 3) + 8 * (r >> 2); const int dist = tq - 16 * c - 31; x += blh[dist < 0 ? 0 : (dist > 128 ? 128 : dist)]; return dist >= 0; });
        },
        NoComp{}, [&](LAS unsigned char* kb) { kfrag_load<64, 128>(fr, kb, kl); });
    flash_accum<true>(otl, st, g0, hi, lane);
    unsigned mlo, mhi;
    int nsel;
    if (jt < 16) { const unsigned long long mk = (1ull << (jt + 1)) - 1ull; mlo = (unsigned)mk; mhi = (unsigned)(mk >> 32); nsel = jt + 1; if (tid <= jt) tl[tid] = (unsigned char)tid; }
    else {
        for (int i = tid; i < 64 * 65; i += 512) imp[i] = 0.f;
        const float lt = st.l + __shfl_xor(st.l, 32); const float linv = lt > 0.f ? frcp(lt) : 0.f;
        float xlast = 0.f;
        run_tiles<128, false, AL_K64, 8192, AL_V64>(ntc, ntc, ntc, ntc, lds, w, lane, 128u, 0u,
            [&](int i) { return kc + (size_t)i * 64 * 128; }, [&](int i) { return kc; },
            [&](int i, LAS unsigned char* kb, LAS unsigned char* vb, LAS unsigned char* kn) {
                f32x16 p0, p1; qk_tile<64, 128>(p0, p1, kb, qf, negm, kl);
                const int cb0 = 64 * i + 4 * hi;
                float sm[2][4], cr[2][4];
#pragma unroll
                for (int half = 0; half < 2; ++half)
#pragma unroll
                    for (int a = 0; a < 4; ++a) {
                        float s4 = 0.f, last = 0.f;
#pragma unroll
                        for (int k = 0; k < 4; ++k) {
                            const int r = 4 * a + k; const int c = cb0 + 32 * half + k + 8 * a; const int dist = tq - 16 * c - 31;
                            const float sc = (half ? p1[r] : p0[r]) + blh[dist < 0 ? 0 : (dist > 128 ? 128 : dist)];
                            const float pv = dist >= 0 ? fexp2(sc) * linv : 0.f;
                            s4 += pv; last = pv;
                        }
                        sm[half][a] = s4; cr[half][a] = last;
                    }
                float tot[2][4];
#pragma unroll
                for (int half = 0; half < 2; ++half)
#pragma unroll
                    for (int a = 0; a < 4; ++a) {
                        const float xs_ = __shfl_xor(cr[half][a], 32);
                        const float xp_ = (a > 0) ? __shfl_xor(cr[half][a > 0 ? a - 1 : 0], 32) : (half ? __shfl_xor(cr[0][3], 32) : xlast);
                        tot[half][a] = sm[half][a] + (hi ? xs_ : xp_);
                    }
                xlast = __shfl_xor(cr[1][3], 32);
                for (int rr = 0; rr < 4; ++rr) {
                    if (rh == rr) {
#pragma unroll
                        for (int half = 0; half < 2; ++half)
#pragma unroll
                            for (int a = 0; a < 4; ++a) { const int j = 16 * i + 8 * half + 2 * a + hi; imp[ql * 65 + j] += tot[half][a]; }
                    }
                    __syncthreads();
                }
            }, NoComp{}, NoComp{});
        if (p.dbg_branch == 1) { for (int i = tid; i < 4096; i += 512) ((float*)(p.ws + R_H))[((size_t)g * S + q0 + (i >> 6)) * 64 + (i & 63)] = imp[(i >> 6) * 65 + (i & 63)]; }
        {
            const int q = tid >> 3, jg = tid & 7;
            unsigned long long kj[8]; int rk[8];
#pragma unroll
            for (int jj = 0; jj < 8; ++jj) { const int j = jg * 8 + jj; const float x = imp[q * 65 + j]; const float v = (j > jt) ? 0.f : ((j == jt || j == 0) ? 1e9f : x);
                kj[jj] = ((unsigned long long)__builtin_bit_cast(unsigned, v) << 6) | (unsigned)(63 - j); rk[jj] = 0; }
#pragma unroll 4
            for (int i = 0; i <= jt; ++i) {
                const float xi = imp[q * 65 + i]; const float vi = (i == jt || i == 0) ? 1e9f : xi;
                const unsigned long long ki = ((unsigned long long)__builtin_bit_cast(unsigned, vi) << 6) | (unsigned)(63 - i);
#pragma unroll
                for (int jj = 0; jj < 8; ++jj) rk[jj] += (ki > kj[jj]) ? 1 : 0;
            }
            unsigned byte = 0;
#pragma unroll
            for (int jj = 0; jj < 8; ++jj) if (jg * 8 + jj <= jt && rk[jj] < 16) byte |= 1u << jj;
            selb[q * 8 + jg] = (unsigned char)byte;
        }
        __syncthreads();
        if (w == 0) {
            unsigned a = ((const LAS unsigned*)selb)[lane * 2], c = ((const LAS unsigned*)selb)[lane * 2 + 1];
#pragma unroll
            for (int o = 1; o < 64; o <<= 1) { a |= __shfl_xor(a, o); c |= __shfl_xor(c, o); }
            const unsigned long long um = ((unsigned long long)c << 32) | a;
            if ((um >> lane) & 1ull) tl[__builtin_popcountll(um & ((1ull << lane) - 1ull))] = (unsigned char)lane;
            if (lane == 0) uni[0] = (unsigned)__builtin_popcountll(um);
        }
        __syncthreads();
        mlo = ((const LAS unsigned*)selb)[ql * 2]; mhi = ((const LAS unsigned*)selb)[ql * 2 + 1];
        nsel = (int)uni[0];
    }
    if (p.dbg_branch == 1 && rh == 0) { if (hi == 0) ((unsigned long long*)(p.ws + R_H + 4 * 1048576))[(size_t)g * S + tq] = ((unsigned long long)mhi << 32) | mlo; }
    __syncthreads();
    {
        const unsigned long long mymask = ((unsigned long long)mhi << 32) | mlo;
        nsel = __builtin_amdgcn_readfirstlane(nsel);
        const int mytl = (int)tl[lane];
        flash_init(st);
        const int jfar = qb32 >= 191 ? (qb32 - 191) >> 6 : -1;
        const int nfar = (int)__builtin_popcountll(__ballot(lane < nsel && mytl <= jfar));
        run_tiles<128, true, AL_K64, 8192, AL_V64>(nsel, nfar, nsel, nsel, lds, w, lane, 128u, (unsigned)(S * 2),
            [&](int i) { return ksn + (size_t)__builtin_amdgcn_readlane(mytl, i) * 64 * 128; }, [&](int i) { return vst + (size_t)__builtin_amdgcn_readlane(mytl, i) * 128; },
            [&](int i, LAS unsigned char* kb, LAS unsigned char* vb, LAS unsigned char* kn) {
                const int j = __builtin_amdgcn_readlane(mytl, i);
                const bool mine = (mymask >> j) & 1ull;
                tile_compute<64, 128, true>(st, fr, kn, vb, qf, negm, kl, vl, mine, [&](int r, int half, float& x) { return true; });
            },
            [&](int i, LAS unsigned char* kb, LAS unsigned char* vb, LAS unsigned char* kn) {
                const int j = __builtin_amdgcn_readlane(mytl, i);
                const bool mine = (mymask >> j) & 1ull;
                const int kb0 = 64 * j + 4 * hi;
                tile_compute<64, 128, true>(st, fr, kn, vb, qf, negm, kl, vl, mine, [&](int r, int half, float& x) { const int dist = tq - (kb0 + 32 * half + (r & 3) + 8 * (r >> 2)); x += blh[dist < 0 ? 0 : (dist > 128 ? 128 : dist)]; return dist >= 0; });
            },
            NoComp{}, [&](LAS unsigned char* kb) { kfrag_load<64, 128>(fr, kb, kl); });
        flash_accum<false>(otl, st, g1, hi, lane);
    }
    {
        const int j0 = jt >= 8 ? jt - 8 : 0, nw = jt - j0 + 1;
        flash_init(st);
        const int jfar = qb32 >= 191 ? (qb32 - 191) >> 6 : -1, jin = qb32 >= 481 ? ((qb32 - 481) >> 6) + 1 : 0;
        int ew0 = jin - j0; ew0 = ew0 < 0 ? 0 : (ew0 > nw ? nw : ew0);
        int ew1 = jfar + 1 - j0; ew1 = ew1 < ew0 ? ew0 : (ew1 > nw ? nw : ew1);
        auto wedge = [&](int i, LAS unsigned char* kb, LAS unsigned char* vb, LAS unsigned char* kn) {
            const int j = j0 + i, kb0 = 64 * j + 4 * hi;
            tile_compute<64, 128, false>(st, fr, kn, vb, qf, negm, kl, vl, true, [&](int r, int half, float& x) { const int dist = tq - (kb0 + 32 * half + (r & 3) + 8 * (r >> 2)); x += blh[dist < 0 ? 0 : (dist > 128 ? 128 : dist)]; return dist >= 0 && dist < 512; });
        };
        run_tiles<128, true, AL_K64, 8192, AL_V64>(nw, ew0, ew1, nw, lds, w, lane, 128u, (unsigned)(S * 2),
            [&](int i) { return kwn + (size_t)(j0 + i) * 64 * 128; }, [&](int i) { return vwt + (size_t)(j0 + i) * 128; },
            wedge,
            [&](int i, LAS unsigned char* kb, LAS unsigned char* vb, LAS unsigned char* kn) { tile_compute<64, 128, false>(st, fr, kn, vb, qf, negm, kl, vl, true, [&](int r, int half, float& x) { return true; }); },
            wedge, [&](LAS unsigned char* kb) { kfrag_load<64, 128>(fr, kb, kl); });
        flash_accum<false>(otl, st, g2, hi, lane);
    }
#pragma unroll
    for (int r = 0; r < 16; ++r) { const size_t ro = ((size_t)b * S + q0 + 32 * qh + crow(r, hi)) * 1024 + h * 64 + r32; ocat[ro] = f2bf(otl[r * 64 + lane]); ocat[ro + 32] = f2bf(otl[(16 + r) * 64 + lane]); }
    __syncthreads();
#ifdef PROF_SEL
    if (b == 0 && g == 0 && jt == 63 && threadIdx.x == 0) *PROF_SLOT(48) += __builtin_amdgcn_s_memtime();
#endif
}

__device__ __forceinline__ void phase_p4(const Params& p, LAS unsigned char* lds) {
    const int G = gridDim.x, c = blockIdx.x, nunits = 256 * NB;
#if NB == 8
    if (G == 256) {
        const int b = c & 7, idx = c >> 3, pi = idx & 7, hq = idx >> 3;
#pragma unroll 1
        for (int u = 0; u < 8; ++u) {
            if (u == (idx & 7)) { convert_weights(p, lds, WD_EARLY, 14); __syncthreads(); }
            if (u < 4) { const int ix = (u >> 1) ? ((idx + 16) & 31) : idx;
                nsa_unit(p, lds, b, u >> 1, (u & 1) ? ix : 63 - ix); }
            else mla_unit(p, lds, b, ((u - 4) >> 1) * 4 + hq, (u & 1) ? pi : 15 - pi);
        }
        return;
    }
#endif
    convert_weights(p, lds, WD_EARLY, 14); __syncthreads();
    for (int j = 0;; ++j) {
        const int k = j * G + ((j & 1) ? (G - 1 - c) : c);
        if (j * G >= nunits) break;
        if (k >= nunits) continue;
        const int ty = UNIT_TYPES[k / NB], b = k % NB, kind = ty >> 9, a = (ty >> 6) & 7, cc = ty & 63;
        if (kind == 0) nsa_unit(p, lds, b, a, cc); else mla_unit(p, lds, b, a, cc);
    }
}
__device__ __forceinline__ void phase_norm(const float* x, const float* g, bf16_t* xn) {
    const int tid_ = ltid(); const int lane = tid_ & 63, gw = blockIdx.x * 8 + (tid_ >> 6), NGW = gridDim.x * 8;
    for (int m = gw; m < T; m += NGW) rms_row_to_bf16(x + (size_t)m * D, g, xn + (size_t)m * D, lane);
}
__device__ __forceinline__ void phase_conv(const Params& p) {
    const int tid = ltid(), lane = tid & 63, gw = blockIdx.x * 8 + (tid >> 6), NGW = gridDim.x * 8;
    const bf16_t* bg = (const bf16_t*)(p.ws + R_H); const bf16_t* cu = (const bf16_t*)(p.ws + R_H + (size_t)T * 2048); bf16_t* v = (bf16_t*)(p.ws + R_XA); const float* cw = p.in[22];
    constexpr int RUN = 16;
    float w0[2][8], w1[2][8], w2[2][8];
#pragma unroll
    for (int j = 0; j < 2; ++j) { const int d = 8 * lane + 512 * j; load8f(cw + d, w0[j], 1.f); load8f(cw + 1024 + d, w1[j], 1.f); load8f(cw + 2048 + d, w2[j], 1.f); }
    for (int run = gw; run < T / RUN; run += NGW) {
        const int m0 = run * RUN, s0 = m0 & (S - 1);
        float pm2[2][8], pm1[2][8];
#pragma unroll
        for (int j = 0; j < 2; ++j) { const int d = 8 * lane + 512 * j;
#pragma unroll
            for (int q = 0; q < 2; ++q) {
                float (&dst)[8] = q ? pm1[j] : pm2[j];
                if (s0 - 2 + q >= 0) unpack8(*(const u32x4*)(cu + (size_t)(m0 - 2 + q) * 1024 + d), dst);
                else {
#pragma unroll
                    for (int i = 0; i < 8; ++i) dst[i] = 0.f; }
            } }
#pragma unroll 4
        for (int rr = 0; rr < RUN; ++rr) {
            const int m = m0 + rr;
#pragma unroll
            for (int j = 0; j < 2; ++j) { const int d = 8 * lane + 512 * j;
                float b[8], c[8], y[8]; unpack8(*(const u32x4*)(bg + (size_t)m * 1024 + d), b); unpack8(*(const u32x4*)(cu + (size_t)m * 1024 + d), c);
#pragma unroll
                for (int i = 0; i < 8; ++i) { y[i] = b[i] * (w0[j][i] * pm2[j][i] + w1[j][i] * pm1[j][i] + w2[j][i] * c[i]); pm2[j][i] = pm1[j][i]; pm1[j][i] = c[i]; }
                *(u32x4*)(v + (size_t)m * 1024 + d) = pack8(y); }
        }
    }
}
__device__ __forceinline__ void phase_norm_router(const Params& p, LAS unsigned char* lds) {
    const int tid = ltid(), lane = tid & 63, wave = tid >> 6, gw = blockIdx.x * 8 + wave, NGW = gridDim.x * 8;
    const bf16_t* x3 = (const bf16_t*)(p.ws + R_XN); const float* g = p.in[24]; float* rsd = (float*)(p.ws + SM_RSTD3);
    LAS float* wr = (LAS float*)lds;
    LAS int* lcnt = (LAS int*)(lds + 40960); LAS int* gb = lcnt + 8;
    int* te = (int*)(p.ws + SM_TE); float* tw = (float*)(p.ws + SM_TW); int* rank = (int*)(p.ws + SM_RANK); int* cnt = (int*)(p.ws + SM_CTL);
    for (int i = tid; i < 8192; i += 512) { const int dd = i >> 3; wr[dd * 8 + (dd >> 2) * 4 + (i & 7)] = p.in[25][i] * g[dd]; }
    if (tid < 8) lcnt[tid] = 0;
    __syncthreads();
    u32x2 nx[4];
#pragma unroll
    for (int j = 0; j < 4; ++j) nx[j] = ((const u32x2*)(x3 + (size_t)(gw < T ? gw : 0) * D) + lane)[64 * j];
    for (int m = gw; m < T; m += NGW) {
        f32x4 v[4]; float s = 0.f;
#pragma unroll
        for (int j = 0; j < 4; ++j) { const u32x2 t = nx[j]; v[j] = (f32x4){bflo(t.x), bfhi(t.x), bflo(t.y), bfhi(t.y)}; s += (v[j].x * v[j].x + v[j].y * v[j].y) + (v[j].z * v[j].z + v[j].w * v[j].w); }
        { const int mn = m + NGW < T ? m + NGW : m;
#pragma unroll
            for (int j = 0; j < 4; ++j) nx[j] = ((const u32x2*)(x3 + (size_t)mn * D) + lane)[64 * j]; }
        float lg[8];
#pragma unroll
        for (int e = 0; e < 8; ++e) lg[e] = 0.f;
#pragma unroll
        for (int j = 0; j < 4; ++j) {
#pragma unroll
            for (int i = 0; i < 4; ++i) { const int d = 4 * lane + 256 * j + i; const f32x4 w0 = *(const LAS f32x4*)(wr + d * 8 + (d >> 2) * 4), w1 = *(const LAS f32x4*)(wr + d * 8 + (d >> 2) * 4 + 4); const float y = v[j][i];
                lg[0] += y * w0.x; lg[1] += y * w0.y; lg[2] += y * w0.z; lg[3] += y * w0.w; lg[4] += y * w1.x; lg[5] += y * w1.y; lg[6] += y * w1.z; lg[7] += y * w1.w; } }
        const float r = rsqrtf(wsum(s) * (1.f / 1024.f) + EPS);
#pragma unroll
        for (int e = 0; e < 8; ++e) lg[e] = wsum(lg[e]) * r + p.in[26][e];
        int e1 = 0; float l1 = lg[0];
#pragma unroll
        for (int e = 1; e < 8; ++e) if (lg[e] > l1) { l1 = lg[e]; e1 = e; }
        int e2 = -1; float l2 = -3e38f;
#pragma unroll
        for (int e = 0; e < 8; ++e) if (e != e1 && lg[e] > l2) { l2 = lg[e]; e2 = e; }
        if (lane == 0) {
            const float w1 = 1.f / (1.f + __expf(l2 - l1));
            te[m * 2] = e1; te[m * 2 + 1] = e2; tw[m * 2] = w1; tw[m * 2 + 1] = 1.f - w1; rsd[m] = r;
            rank[m * 2] = __hip_atomic_fetch_add(&lcnt[e1], 1, __ATOMIC_RELAXED, __HIP_MEMORY_SCOPE_WORKGROUP); rank[m * 2 + 1] = __hip_atomic_fetch_add(&lcnt[e2], 1, __ATOMIC_RELAXED, __HIP_MEMORY_SCOPE_WORKGROUP);
        }
    }
    __syncthreads();
    if (tid < 8) gb[tid] = atomicAdd(&cnt[tid], lcnt[tid]);
    __syncthreads();
    for (int m = gw; m < T; m += NGW) if (lane < 2) rank[m * 2 + lane] += gb[te[m * 2 + lane]];
}
__device__ __forceinline__ void phase_moe_gather(const Params& p) {
    const int tid = ltid(), lane = tid & 63, gw = blockIdx.x * 8 + (tid >> 6), NGW = gridDim.x * 8;
    const int* cnt = (const int*)(p.ws + SM_CTL); const int* te = (const int*)(p.ws + SM_TE); const float* tw = (const float*)(p.ws + SM_TW); const int* rank = (const int*)(p.ws + SM_RANK);
    int* pos = (int*)(p.ws + SM_POS); float* roww = (float*)(p.ws + SM_ROWW); int* tile_e = (int*)(p.ws + SM_TILEE);
    int* rowtok = (int*)(p.ws + SM_ROWTOK); const float* rsd = (const float*)(p.ws + SM_RSTD3); float* rowrs = (float*)(p.ws + SM_ROWRS);
    int off[9]; off[0] = 0;
#pragma unroll
    for (int e = 0; e < 8; ++e) off[e + 1] = off[e] + ((cnt[e] + 255) & ~255);
    if (blockIdx.x == 0) {
        for (int i = tid; i < ROWS_MAX / 256; i += 512) { int e = -1;
#pragma unroll
            for (int k = 0; k < 8; ++k) if (i * 256 >= off[k] && i * 256 < off[k + 1]) e = k;
            tile_e[i] = e < 0 ? 0 : e; }
        if (tid == 0) ((int*)(p.ws + SM_CTL))[8] = off[8];
    }
    if (blockIdx.x < 8 && tid < 256) {
#pragma unroll
        for (int e = 0; e < 8; ++e) if (e == (int)blockIdx.x) { const int c = cnt[e]; if (c + tid < off[e + 1] - off[e]) { roww[off[e] + c + tid] = 0.f; rowrs[off[e] + c + tid] = 0.f; rowtok[off[e] + c + tid] = -1; } }
    }
    for (int pi0 = gw * 4; pi0 < 2 * T; pi0 += NGW * 4) {
        int r[4]; float w[4], rs[4];
#pragma unroll
        for (int q = 0; q < 4; ++q) { const int e = te[pi0 + q]; int o = 0;
#pragma unroll
            for (int k = 0; k < 8; ++k) if (k == e) o = off[k];
            r[q] = o + rank[pi0 + q]; w[q] = tw[pi0 + q]; rs[q] = rsd[(pi0 + q) >> 1]; }
#pragma unroll
        for (int q = 0; q < 4; ++q) if (lane == q) { pos[pi0 + q] = r[q]; roww[r[q]] = w[q]; rowrs[r[q]] = rs[q]; rowtok[r[q]] = (pi0 + q) >> 1; }
    }
}
__device__ __forceinline__ void phase_moe_combine(const Params& p) {
    const int tid_ = ltid(); const int lane = tid_ & 63, gw = blockIdx.x * 8 + (tid_ >> 6), NGW = gridDim.x * 8;
    const int* pos = (const int*)(p.ws + SM_POS); const bf16_t* ym = (const bf16_t*)(p.ws + R_XA); const bf16_t* x3 = (const bf16_t*)(p.ws + R_XN);
    for (int m0 = gw * 2; m0 < T; m0 += NGW * 2) {
        int ps[4];
#pragma unroll
        for (int q = 0; q < 4; ++q) ps[q] = pos[m0 * 2 + q];
        f32x4 x[2][4]; u32x2 ya[2][4], yc[2][4];
#pragma unroll
        for (int q = 0; q < 2; ++q)
#pragma unroll
            for (int j = 0; j < 4; ++j) { const int d = 4 * lane + 256 * j;
                { const u32x2 t = *(const u32x2*)(x3 + (size_t)(m0 + q) * D + d); x[q][j] = (f32x4){bflo(t.x), bfhi(t.x), bflo(t.y), bfhi(t.y)}; } ya[q][j] = *(const u32x2*)(ym + (size_t)ps[2 * q] * D + d); yc[q][j] = *(const u32x2*)(ym + (size_t)ps[2 * q + 1] * D + d); }
#pragma unroll
        for (int q = 0; q < 2; ++q)
#pragma unroll
            for (int j = 0; j < 4; ++j) { const int d = 4 * lane + 256 * j; f32x4 o = x[q][j]; const u32x2 a = ya[q][j], c = yc[q][j];
                o.x += bflo(a.x) + bflo(c.x); o.y += bfhi(a.x) + bfhi(c.x); o.z += bflo(a.y) + bflo(c.y); o.w += bfhi(a.y) + bfhi(c.y);
                *(f32x4*)(p.out + (size_t)(m0 + q) * D + d) = o; }
    }
}

#define XB_TMO      128
#define XB_XCNT(j)  (256  + 64 * (j))
#define XB_XSUB(j)  (1280 + 64 * (j))
#define XB_XGEN(j)  (2304 + 64 * (j))
#define XB_TOP      3328
#define XB_TOPGEN   3392
#define XCD_BAR_WORDS 3456
#define XB_SPIN_CAP (1u << 18)

__device__ __forceinline__ unsigned xb_ld(unsigned* p)              { return __hip_atomic_load(p, __ATOMIC_RELAXED, __HIP_MEMORY_SCOPE_AGENT); }
__device__ __forceinline__ unsigned xb_add(unsigned* p, unsigned v) { return __hip_atomic_fetch_add(p, v, __ATOMIC_RELAXED, __HIP_MEMORY_SCOPE_AGENT); }
__device__ __forceinline__ unsigned xb_xcc_id() { return (unsigned)__builtin_amdgcn_s_getreg((3 << 11) | 20) & 0xFu; }
#define XB_SPIN(cond, bar) do { unsigned _sp = 0; while (cond) { __builtin_amdgcn_s_sleep(1); \
    if ((++_sp & 255u) == 0u) { if (xb_ld(&(bar)[XB_TMO])) break; if (_sp > XB_SPIN_CAP) { atomicAdd(&(bar)[XB_TMO], 1u); break; } } } } while (0)

struct XcdBarrier {
    unsigned* bar; unsigned x;
    volatile LAS unsigned* st;
};

__device__ __forceinline__ XcdBarrier xcd_barrier_post(unsigned* bar, volatile LAS unsigned* st) {
    XcdBarrier b; b.bar = bar; b.x = xb_xcc_id(); b.st = st;
    if (threadIdx.x == 0) (void)xb_add(&bar[XB_XCNT(b.x)], 1u);
    return b;
}
__device__ __forceinline__ void xcd_barrier_complete(unsigned* bar, unsigned x, unsigned& nloc, unsigned& nx) {
    const unsigned G = gridDim.x * gridDim.y * gridDim.z;
    unsigned sum, cnt, mine, sp = 0u;
    for (;;) {
        sum = 0u; cnt = 0u; mine = 0u;
#pragma unroll
        for (unsigned j = 0; j < 16; ++j) { const unsigned c = xb_ld(&bar[XB_XCNT(j)]); sum += c; cnt += (c > 0u) ? 1u : 0u; mine = (j == x) ? c : mine; }
        if (sum == G) break;
        __builtin_amdgcn_s_sleep(1);
        if ((++sp & 255u) == 0u) { if (xb_ld(&bar[XB_TMO])) break; if (sp > XB_SPIN_CAP) { atomicAdd(&bar[XB_TMO], 1u); break; } }
    }
    nloc = mine > 0u ? mine : 1u; nx = cnt > 0u ? cnt : 1u;
}

__device__ __forceinline__ void xcd_barrier(const XcdBarrier& b) {
    asm volatile("s_waitcnt vmcnt(0)" ::: "memory");
    __syncthreads();
    if (threadIdx.x == 0) {
        unsigned* bar = b.bar;
        __builtin_amdgcn_s_waitcnt(0);
        unsigned nloc = b.st[0], nx = b.st[1];
        if (nloc == 0u) { xcd_barrier_complete(bar, b.x, nloc, nx); b.st[0] = nloc; b.st[1] = nx; }
        const unsigned old = xb_add(&bar[XB_XSUB(b.x)], 1u);
        const unsigned gen = old / nloc;
        if (old + 1u == (gen + 1u) * nloc) {
            __builtin_amdgcn_fence(__ATOMIC_RELEASE, "agent");
            asm volatile("s_waitcnt vmcnt(0)" ::: "memory");
            const unsigned og = xb_add(&bar[XB_TOP], 1u);
            const unsigned tg = og / nx;
            if (og + 1u == (tg + 1u) * nx) xb_add(&bar[XB_TOPGEN], 1u);
            else XB_SPIN(xb_ld(&bar[XB_TOPGEN]) == tg, bar);
            __builtin_amdgcn_fence(__ATOMIC_ACQUIRE, "agent");
            xb_add(&bar[XB_XGEN(b.x)], 1u);
            asm volatile("s_waitcnt vmcnt(0)" ::: "memory");
        } else {
            XB_SPIN(xb_ld(&bar[XB_XGEN(b.x)]) == gen, bar);
            __builtin_amdgcn_fence(__ATOMIC_ACQUIRE, "agent");
            asm volatile("s_waitcnt vmcnt(0)" ::: "memory");
        }
    }
    __syncthreads();
}


__global__ void __launch_bounds__(512) mega_fwd(Params p) {
    extern __shared__ __attribute__((aligned(16))) unsigned char lds_raw[];
    LAS unsigned char* lds = (LAS unsigned char*)lds_raw;
    cg::grid_group grid = cg::this_grid();
    volatile LAS unsigned* bst = (volatile LAS unsigned*)(lds + 163328);
    if (threadIdx.x == 0) { bst[0] = 0u; bst[1] = 0u; const unsigned long long ba = (unsigned long long)(p.ws + SM_BAR); bst[2] = (unsigned)ba; bst[3] = (unsigned)(ba >> 32); }
    __syncthreads();
    (void)xcd_barrier_post((unsigned*)(p.ws + SM_BAR), bst);
#ifdef PROF_SEL
#define PSTAMP(k) do { if (blockIdx.x == 0 && threadIdx.x == 0) { volatile LAS unsigned* pl_ = (volatile LAS unsigned*)(lds + 163328 + 16); const unsigned long long now_ = __builtin_amdgcn_s_memrealtime(); const unsigned long long last_ = ((unsigned long long)pl_[1] << 32) | pl_[0]; *PROF_SLOT(k) += now_ - last_; pl_[0] = (unsigned)now_; pl_[1] = (unsigned)(now_ >> 32); } } while (0)
#else
#define PSTAMP(k)
#endif
#define GSYNC() do { XcdBarrier xb_; volatile LAS unsigned* st_ = (volatile LAS unsigned*)(lds + 163328); xb_.bar = (unsigned*)(((unsigned long long)st_[3] << 32) | st_[2]); xb_.x = xb_xcc_id(); xb_.st = st_; xcd_barrier(xb_); } while (0)
#ifdef PROF_SEL
    if (threadIdx.x == 0) { volatile LAS unsigned* pl_ = (volatile LAS unsigned*)(lds + 163328 + 16); const unsigned long long now_ = __builtin_amdgcn_s_memrealtime(); pl_[0] = (unsigned)now_; pl_[1] = (unsigned)(now_ >> 32); }
#endif
    const int G = gridDim.x, c = blockIdx.x;
#define LP() bf16_t* W = (bf16_t*)p.ws; bf16_t* xn = (bf16_t*)(p.ws + R_XN); float* x1 = (float*)(p.ws + R_XA); pg8::StaticOrder SO; (void)W; (void)xn; (void)x1; (void)SO
#ifndef PHMASK
#define PHMASK 0xFFFFFFFFu
#endif
#ifndef REPEAT_MASK
#define REPEAT_MASK 0u
#endif
#define PH(k) if (((PHMASK >> (k)) & 1u) && (k) >= p.ph_lo && (k) <= p.ph_hi)
#define RPT(k) if ((REPEAT_MASK >> (k)) & 1u)
    PH(0) { LP(); phase_p0(p, lds); }
    GSYNC(); PSTAMP(0);
    if (p.ph_lo == -12345) grid.sync();
    RPT(0) { { LP(); phase_p0(p, lds); } GSYNC(); }
    PH(1) for (int rp_ = 0; rp_ <= (int)((REPEAT_MASK >> 1) & 1u); ++rp_) { LP(); if (rp_) GSYNC();
        pg8::Gemm g{xn, W + W_IN_E / 2, T, 1792, 1024, 1024, nullptr, 0, nullptr}; SO.init(T, 1792, G, c);
        pg8::EpiBf16<0> E{(bf16_t*)(p.ws + R_H), 1792, nullptr, nullptr};
        pg8::gemm_phase<pg8::EpiBf16<0>, true>(lds, g, SO, E);
    }
    GSYNC(); PSTAMP(1);
    PH(2) { LP(); phase_p2(p, lds); }
    GSYNC(); PSTAMP(2);
    RPT(2) { { LP(); phase_p2(p, lds); } GSYNC(); }
    PH(3) for (int rp_ = 0; rp_ <= (int)((REPEAT_MASK >> 3) & 1u); ++rp_) { LP(); if (rp_) GSYNC();
        const int nCu = 2 * (NB * 512 / 256) * 2, Gc = (nCu < G / 2) ? nCu : 0;
        if (Gc == 0 || c < Gc) {
            for (int kv = 0; kv < 2; ++kv) {
                pg8::Gemm g{(const bf16_t*)(p.ws + R_XA + (kv ? A_VCIN : A_KCIN)), W + W_CW1 / 2 + (size_t)kv * 512 * 1024, NB * 512, 512, 1024, 1024, nullptr, 0, nullptr};
                if (Gc) SO.init(NB * 512, 512, Gc / 2, c - kv * (Gc / 2)); else SO.init(NB * 512, 512, G, c);
                pg8::EpiBf16<0> E{(bf16_t*)(p.ws + SM_HID) + (size_t)kv * NB * 512 * 512, 512, nullptr, nullptr};
                if (Gc == 0 || (c / (Gc / 2)) == kv) pg8::gemm_phase<pg8::EpiBf16<0>, true>(lds, g, SO, E);
            }
        }
        if (Gc == 0 || c >= Gc) {
            {
                pg8::Gemm g{(const bf16_t*)(p.ws + R_XA + A_CQN), W + W_UQ / 2, T, 1024, 256, 256, nullptr, 0, nullptr}; SO.init(T, 1024, G - Gc, c - Gc);
                pg8::EpiBf16<0> E{(bf16_t*)(p.ws + R_H), 1024, nullptr, nullptr};
                pg8::gemm_phase<pg8::EpiBf16<0>, true>(lds, g, SO, E);
            }
            {
                pg8::Gemm g{(const bf16_t*)(p.ws + R_XA + A_CKVN), W + W_UKV / 2, T, 1024, 128, 128, nullptr, 0, nullptr}; SO.init(T, 1024, G - Gc, c - Gc);
                pg8::EpiBf16<0> E{(bf16_t*)(p.ws + R_H + (size_t)T * 2048), 1024, nullptr, nullptr};
                pg8::gemm_phase<pg8::EpiBf16<0>, true>(lds, g, SO, E);
            }
        }
    }
    GSYNC(); PSTAMP(3);
    PH(4) { LP(); phase_p3b(p, lds); }
    GSYNC(); PSTAMP(4);
#ifndef P3B_PROBE
#define P3B_PROBE 3
#endif
    RPT(4) { { LP(); phase_p3b(p, lds, P3B_PROBE); } GSYNC(); }
    PH(5) { LP(); phase_p4(p, lds); }
    GSYNC(); PSTAMP(5);
    RPT(5) { { LP(); phase_p4(p, lds); } GSYNC(); }
    PH(6) for (int rp_ = 0; rp_ <= (int)((REPEAT_MASK >> 6) & 1u); ++rp_) { LP(); if (rp_) GSYNC();
        pg8::Gemm g{xn, W + W_OUT_E / 2, T, 1024, 1024, 1024, nullptr, 0, nullptr}; SO.init(T, 1024, G, c);
        pg8::EpiResStat<false> E{p.in[0], (bf16_t*)p.out, (float*)(p.ws + SM_SSP1), 1024};
        pg8::gemm_phase<pg8::EpiResStat<false>, true>(lds, g, SO, E);
    }
    GSYNC(); PSTAMP(6);
    PH(7) { }
    PH(8) for (int rp_ = 0; rp_ <= (int)((REPEAT_MASK >> 8) & 1u); ++rp_) { LP(); if (rp_) GSYNC();
        pg8::Gemm g{(const bf16_t*)p.out, W + W_GU / 2, T, 5632, 1024, 1024, nullptr, 0, nullptr}; SO.init(T, 5632, G, c);
        pg8::EpiSwiGLUSsp E{(bf16_t*)(p.ws + R_H), 2816, (const float*)(p.ws + SM_SSP1)};
        pg8::gemm_phase<pg8::EpiSwiGLUSsp, true>(lds, g, SO, E);
    }
    GSYNC(); PSTAMP(8);
    PH(9) for (int rp_ = 0; rp_ <= (int)((REPEAT_MASK >> 9) & 1u); ++rp_) { LP(); if (rp_) GSYNC();
        pg8::Gemm g{(const bf16_t*)(p.ws + R_H), W + W_D / 2, T, 1024, 2816, 2816, nullptr, 0, nullptr}; SO.init(T, 1024, G, c);
        pg8::EpiResStat<true> E{(const bf16_t*)p.out, xn, (float*)(p.ws + SM_SSP2), 1024};
        pg8::gemm_phase<pg8::EpiResStat<true>, true>(lds, g, SO, E);
    }
    GSYNC(); PSTAMP(9);
    PH(10) { }
    PH(11) for (int rp_ = 0; rp_ <= (int)((REPEAT_MASK >> 11) & 1u); ++rp_) { LP(); if (rp_) GSYNC();
        pg8::Gemm g{xn, W + W_IN_O / 2, T, 3072, 1024, 1024, nullptr, 0, nullptr}; SO.init(T, 3072, G, c);
        pg8::EpiConvInSsp E{(bf16_t*)(p.ws + R_H), (bf16_t*)(p.ws + R_H + (size_t)T * 2048), (const float*)(p.ws + SM_SSP2)};
        pg8::gemm_phase<pg8::EpiConvInSsp, true>(lds, g, SO, E);
    }
    GSYNC(); PSTAMP(11);
    PH(12) { LP(); phase_conv(p); }
    GSYNC(); PSTAMP(12);
    RPT(12) { { LP(); phase_conv(p); } GSYNC(); }
    PH(13) { LP();
        pg8::Gemm g{(const bf16_t*)x1, W + W_OUT_O / 2, T, 1024, 1024, 1024, nullptr, 0, nullptr}; SO.init(T, 1024, G, c);
        pg8::EpiResBf16B E{xn, xn, 1024};
        pg8::gemm_phase<pg8::EpiResBf16B, true>(lds, g, SO, E);
    }
    GSYNC(); PSTAMP(13);
    PH(14) { LP(); phase_norm_router(p, lds); }
    GSYNC(); PSTAMP(14);
    PH(15) { LP(); phase_moe_gather(p); }
    RPT(15) { GSYNC(); { LP(); phase_moe_gather(p); } }
    GSYNC(); PSTAMP(15);
    PH(16) for (int rp_ = 0; rp_ <= (int)((REPEAT_MASK >> 16) & 1u); ++rp_) { LP(); if (rp_) GSYNC();
        pg8::Gemm g{(const bf16_t*)(p.ws + R_XN), W + W_MGU / 2, 2 * T, 2816, 1024, 1024, (const int*)(p.ws + SM_TILEE), (size_t)2816 * 1024, (const int*)(p.ws + SM_ROWTOK)}; SO.init(2 * T, 2816, G, c);
        pg8::EpiSwiGLULds E{(bf16_t*)(p.ws + R_H), 1408, (const float*)(p.ws + SM_ROWRS)};
        pg8::gemm_phase<pg8::EpiSwiGLULds, true, true>(lds, g, SO, E);
    }
    GSYNC(); PSTAMP(16);
    PH(17) { LP(); const int mrows = ((const int*)(p.ws + SM_CTL))[8]; const int nx = mrows / 256 - 2 * T / 256;
        unsigned* dep = (unsigned*)(p.ws + SM_BAR) + 3584;
        const int nprod = 11 * nx < G ? 11 * nx : G, ncons = 4 * nx < G ? 4 * nx : G;
        if (c < nprod) {
            pg8::Gemm g{(const bf16_t*)(p.ws + R_XN), W + W_MGU / 2, 256 * nx, 2816, 1024, 1024, (const int*)(p.ws + SM_TILEE) + 2 * T / 256, (size_t)2816 * 1024, (const int*)(p.ws + SM_ROWTOK) + 2 * T}; SO.init(256 * nx, 2816, G, c);
            pg8::EpiSwiGLULds E{(bf16_t*)(p.ws + R_H) + (size_t)2 * T * 1408, 1408, (const float*)(p.ws + SM_ROWRS) + 2 * T};
            pg8::gemm_phase<pg8::EpiSwiGLULds, true, true>(lds, g, SO, E);
            asm volatile("s_waitcnt vmcnt(0)" ::: "memory");
            __syncthreads();
            if (threadIdx.x == 0) { __builtin_amdgcn_fence(__ATOMIC_RELEASE, "agent"); asm volatile("s_waitcnt vmcnt(0)" ::: "memory"); (void)xb_add(dep, 1u); }
        }
        {
            pg8::Gemm g{(const bf16_t*)(p.ws + R_H), W + W_MD / 2, 2 * T, 1024, 1408, 1408, (const int*)(p.ws + SM_TILEE), (size_t)1024 * 1408, nullptr}; SO.init(2 * T, 1024, G, c);
            pg8::EpiRowScaleLds E{(bf16_t*)(p.ws + R_XA), 1024, (const float*)(p.ws + SM_ROWW)};
            pg8::gemm_phase<pg8::EpiRowScaleLds, true>(lds, g, SO, E);
        }
        if (G - 1 - c < ncons) {
            if (threadIdx.x == 0) { unsigned* bar = (unsigned*)(p.ws + SM_BAR); XB_SPIN(xb_ld(dep) < (unsigned)nprod, bar); __builtin_amdgcn_fence(__ATOMIC_ACQUIRE, "agent"); asm volatile("s_waitcnt vmcnt(0)" ::: "memory"); }
            __syncthreads();
            pg8::Gemm g{(const bf16_t*)(p.ws + R_H) + (size_t)2 * T * 1408, W + W_MD / 2, 256 * nx, 1024, 1408, 1408, (const int*)(p.ws + SM_TILEE) + 2 * T / 256, (size_t)1024 * 1408, nullptr}; SO.init(256 * nx, 1024, G, G - 1 - c);
            pg8::EpiRowScaleLds E{(bf16_t*)(p.ws + R_XA) + (size_t)2 * T * 1024, 1024, (const float*)(p.ws + SM_ROWW) + 2 * T};
            pg8::gemm_phase<pg8::EpiRowScaleLds, true>(lds, g, SO, E);
        }
    }
    GSYNC(); PSTAMP(17);
    PH(18) { LP(); phase_moe_combine(p); }
    RPT(18) { GSYNC(); { LP(); phase_moe_combine(p); } }
#ifdef PROF_SEL
    GSYNC(); PSTAMP(18);
    GSYNC();
    {
        unsigned long long v_ = *PROF_SLOT(PROF_SEL);
#ifdef PROF_DIV
        const unsigned long long dv_ = *PROF_SLOT(PROF_DIV); v_ = dv_ ? v_ / dv_ : 0ull;
#endif
        unsigned long long a_ = v_ / (unsigned long long)(PROF_UNIT); if (a_ > 27ull) a_ = 27ull;
        const float sc_ = 1.f + (float)a_;
        for (size_t i = (size_t)blockIdx.x * 512 + threadIdx.x; i < (size_t)S * 1024 / 4; i += (size_t)gridDim.x * 512) { f32x4* o = (f32x4*)p.out + i; *o = *o * sc_; }
    }
#endif
#undef PH
}

inline void launch(void* const* d_in, float* d_out, void* d_ws, size_t ws_size, hipStream_t stream, int ph_lo = 0, int ph_hi = 99, int dbg_branch = -1) {
    static int grid = 0;
    if (grid == 0) {
        int dev = 0, cus = 0, per_cu = 0;
        hipGetDevice(&dev); hipDeviceGetAttribute(&cus, hipDeviceAttributeMultiprocessorCount, dev);
        hipFuncSetAttribute((const void*)mega_fwd, hipFuncAttributeMaxDynamicSharedMemorySize, LDS_BYTES);
        hipOccupancyMaxActiveBlocksPerMultiprocessor(&per_cu, (const void*)mega_fwd, 512, LDS_BYTES);
        if (per_cu < 1) { fprintf(stderr, "occupancy query says %d blocks/CU\n", per_cu); per_cu = 1; }
        grid = cus;
        if (WS_FAST_END > ws_size) { fprintf(stderr, "ws too small: need %zu have %zu\n", (size_t)WS_FAST_END, ws_size); grid = -1; }
    }
    if (grid < 0) return;
    if (ph_lo <= 14 && ph_hi >= 14) hipMemsetAsync((char*)d_ws + SM_CTL, 0, 4096, stream);
    hipMemsetAsync((char*)d_ws + SM_BAR, 0, 16384, stream);
    Params p{};
    for (int i = 0; i < 30; ++i) p.in[i] = (const float*)d_in[i];
    p.out = d_out; p.ws = (unsigned char*)d_ws; p.ph_lo = ph_lo; p.ph_hi = ph_hi; p.dbg_branch = dbg_branch;
    void* args[] = {&p};
    hipError_t e = hipLaunchCooperativeKernel((const void*)mega_fwd, dim3(grid), dim3(512), args, LDS_BYTES, stream);
    if (e != hipSuccess) fprintf(stderr, "cooperative launch failed: %s (grid %d)\n", hipGetErrorString(e), grid);
}
}
extern "C" void kernel_launch(void* const* d_in, const int* in_sizes, int n_in, void* d_out, int out_size, void* d_ws, size_t ws_size, hipStream_t stream) {
    fast::launch(d_in, (float*)d_out, d_ws, ws_size, stream);
}
```

```cpp
#include <hip/hip_runtime.h>
#include <hip/hip_bf16.h>
#include <stdint.h>
#include <stdio.h>
#include <string.h>
#include <hip/hip_cooperative_groups.h>
namespace cg = cooperative_groups;
#define NB 8
#define REPEAT_MASK 0x0u
namespace gold {
constexpr int S = 4096, D = 1024, HW = 1720;
constexpr float EPS = 1e-6f;

__device__ const unsigned char T5B[128] = {0, 1, 2, 3, 4, 5, 6, 7, 8, 9, 10, 11, 12, 13, 14, 15, 16, 16, 16, 17, 17, 18, 18, 18, 19, 19, 19, 20, 20, 20, 20, 21, 21, 21, 21, 22, 22, 22, 22, 22, 23, 23, 23, 23, 23, 23, 24, 24, 24, 24, 24, 24, 25, 25, 25, 25, 25, 25, 25, 26, 26, 26, 26, 26, 26, 26, 26, 27, 27, 27, 27, 27, 27, 27, 27, 27, 27, 28, 28, 28, 28, 28, 28, 28, 28, 28, 28, 29, 29, 29, 29, 29, 29, 29, 29, 29, 29, 29, 29, 30, 30, 30, 30, 30, 30, 30, 30, 30, 30, 30, 30, 30, 30, 31, 31, 31, 31, 31, 31, 31, 31, 31, 31, 31, 31, 31, 31};
}
#ifndef NB
#define NB 8
#endif
namespace fast {
#define LAS __attribute__((address_space(3)))
typedef unsigned short bf16_t;
typedef short bf16x8 __attribute__((ext_vector_type(8)));
typedef float f32x4 __attribute__((ext_vector_type(4)));
typedef float f32x2 __attribute__((ext_vector_type(2)));
typedef float f32x16 __attribute__((ext_vector_type(16)));
typedef unsigned u32x4 __attribute__((ext_vector_type(4)));
typedef unsigned u32x2 __attribute__((ext_vector_type(2)));
typedef __bf16 bf16x2_t __attribute__((ext_vector_type(2)));

constexpr int S = 4096, T = NB * S, D = 1024;
constexpr float EPS = 1e-6f, LOG2E = 1.4426950408889634f;

__device__ __forceinline__ unsigned cvtpk(float lo, float hi) { f32x2 v = {lo, hi}; bf16x2_t b = __builtin_convertvector(v, bf16x2_t); return __builtin_bit_cast(unsigned, b); }
__device__ __forceinline__ bf16_t f2bf(float f) { return (bf16_t)(cvtpk(f, 0.f) & 0xffffu); }
__device__ __forceinline__ float bf2f(bf16_t u) { return __builtin_bit_cast(float, (unsigned)u << 16); }
__device__ __forceinline__ float bflo(unsigned u) { return __builtin_bit_cast(float, u << 16); }
__device__ __forceinline__ float bfhi(unsigned u) { return __builtin_bit_cast(float, u & 0xffff0000u); }
__device__ __forceinline__ float wsum(float v) {
#define WS_DPP(x, ctrl) __builtin_bit_cast(float, __builtin_amdgcn_update_dpp(0, __builtin_bit_cast(int, (x)), (ctrl), 0xF, 0xF, true))
    v += WS_DPP(v, 0xB1); v += WS_DPP(v, 0x4E); v += WS_DPP(v, 0x141); v += WS_DPP(v, 0x140);
#undef WS_DPP
    const int vi = __builtin_bit_cast(int, v);
    const float s0 = __builtin_bit_cast(float, __builtin_amdgcn_readlane(vi, 0)), s1 = __builtin_bit_cast(float, __builtin_amdgcn_readlane(vi, 16));
    const float s2 = __builtin_bit_cast(float, __builtin_amdgcn_readlane(vi, 32)), s3 = __builtin_bit_cast(float, __builtin_amdgcn_readlane(vi, 48));
    return (s0 + s1) + (s2 + s3);
}
__device__ __forceinline__ float fexp2(float x) { return __builtin_amdgcn_exp2f(x); }
__device__ __forceinline__ float frcp(float x) { return __builtin_amdgcn_rcpf(x); }
__device__ __forceinline__ float silu_f(float x) { return x * frcp(1.f + fexp2(-x * LOG2E)); }
__device__ __forceinline__ float gelu_tanh_f(float x) {
    const float u = 0.7978845608028654f * (x + 0.044715f * x * x * x);
    return x * frcp(1.f + fexp2(-2.f * LOG2E * u));
}

namespace pg8 {
constexpr int BM = 256, BK = 64, HALF = 128, HTB = HALF * BK * 2, STAGE_BYTES = 8 * HTB, NXCD = 8, WGM = 8;
__host__ __device__ __forceinline__ int lds_byte(int r, int c) { const int st = (r >> 4) * 2 + (c >> 5), rr = r & 15, cc = c & 31, ob = rr * 64 + cc * 2; return st * 1024 + (ob ^ (((ob >> 9) & 1) << 5)); }
__host__ __device__ __forceinline__ void stage_rc(int b, int& R, int& C) { const int st = b / 1024, sb = b % 1024, swz = sb ^ (((sb >> 9) & 1) << 5); R = (st >> 1) * 16 + swz / 64; C = (st & 1) * 32 + (swz % 64) / 2; }
__host__ __device__ __forceinline__ int perm32(int rho) { const int n = rho >> 4, i = rho & 15; return 8 * (i >> 2) + 4 * n + (i & 3); }

struct Unit { int pm, pn; };
struct Gemm { const bf16_t* A; const bf16_t* Bt; int M, N, K, lda; const int* tile_e; size_t estride; const int* rowidx; };

struct StaticOrder {
    int nM, nN, nwg, G, c;
    __device__ void init(int M, int N, int G_, int c_) { nM = M / BM; nN = N / BM; nwg = nM * nN; G = G_; c = c_; }
    __device__ bool next(int i, Unit& u) const {
        const long L = (long)i * G + c; if (L >= nwg) return false;
        int wgid = (int)L; { const int q = nwg / NXCD, r = nwg % NXCD, xcd = wgid % NXCD, off = wgid / NXCD; wgid = (xcd < r ? xcd * (q + 1) : r * (q + 1) + (xcd - r) * q) + off; }
        const int nig = WGM * nN, gid = wgid / nig, fm = gid * WGM, gsz = (nM - fm) < WGM ? (nM - fm) : WGM;
        u.pm = fm + ((wgid % nig) % gsz); u.pn = (wgid % nig) / gsz; return true;
    }
};

template <class E> struct epi_lds { static constexpr int n = 0; };
__device__ __forceinline__ float row_rstd(const float* ssp, int row);
constexpr int EPI_LDS_OFF = 131072, EPI_TAB_CAP = 30;
template <class Epi, bool ALIGN_EPI, bool GATHER = false>
__device__ __forceinline__ void gemm_phase(LAS unsigned char* lds, const Gemm g, const StaticOrder& S, const Epi& E) {
    int tid = threadIdx.x; asm volatile("" : "+v"(tid));
    const int wid = __builtin_amdgcn_readfirstlane(tid >> 6), lane = tid & 63, wr = wid >> 2, wc = wid & 3, fr = lane & 15, fq = lane >> 4;
    const int K = g.K, nt = K / BK, lda = g.lda;
    unsigned voffA[2], voffB[2];
#pragma unroll
    for (int i = 0; i < 2; ++i) { int R, C; stage_rc(tid * 16 + i * 8192, R, C); const int Rb = Epi::PERM ? ((R & ~31) + perm32(R & 31)) : R;
        voffA[i] = (unsigned)(R * lda + C) * 2u; voffB[i] = (unsigned)(Rb * K + C) * 2u; }
    const size_t kstep = (size_t)(BK * 2);
    const size_t hsA = GATHER ? 0 : (size_t)HALF * lda * 2, tsA = 2 * hsA, hsB = (size_t)HALF * K * 2, tsB = 2 * hsB;
    unsigned vgc[2][2], vgn[2][2];
#define PG8_GOFF(pm_, vg) do { _Pragma("unroll") for (int h_ = 0; h_ < 2; ++h_) _Pragma("unroll") for (int i_ = 0; i_ < 2; ++i_) { int R_, C_; stage_rc(tid * 16 + i_ * 8192, R_, C_); \
        int tok_ = g.rowidx[(pm_) * BM + h_ * HALF + R_]; tok_ = tok_ < 0 ? 0 : tok_; vg[h_][i_] = (unsigned)(tok_ * lda + C_) * 2u; } } while (0)
#define PG8_STAGE_A(bufoff, gbase, h, nx) do { unsigned va_[2]; _Pragma("unroll") for (int i_ = 0; i_ < 2; ++i_) va_[i_] = GATHER ? ((nx) ? vgn[h][i_] : vgc[h][i_]) : voffA[i_]; PG8_STAGE(bufoff, gbase, va_); } while (0)
    const unsigned ldsw = (unsigned)wid * 1024u;
    const int aoff = lds_byte(wr * 64 + fr, fq * 8), boff = lds_byte(wc * 32 + fr, fq * 8);
#define PG8_SA(b, h) (((b) * 2 + (h)) * HTB)
#define PG8_SB(b, h) ((4 + (b) * 2 + (h)) * HTB)
#define PG8_STAGE(bufoff, gbase, voff) do { _Pragma("unroll") for (int _i = 0; _i < 2; ++_i) \
        __builtin_amdgcn_global_load_lds((const unsigned*)((const char*)(gbase) + (voff)[_i]), (LAS unsigned*)(lds + (bufoff) + ldsw + _i * 8192), 16, 0, 0); } while (0)
#define PG8_LDA(dst, b, h) do { _Pragma("unroll") for (int m = 0; m < 4; ++m) _Pragma("unroll") for (int k = 0; k < 2; ++k) dst[m][k] = *(const LAS bf16x8*)(lds + PG8_SA(b, h) + aoff + m * 2048 + k * 1024); } while (0)
#define PG8_LDB(dst, b, h) do { _Pragma("unroll") for (int n = 0; n < 2; ++n) _Pragma("unroll") for (int k = 0; k < 2; ++k) dst[n][k] = *(const LAS bf16x8*)(lds + PG8_SB(b, h) + boff + n * 2048 + k * 1024); } while (0)
#define PG8_MMA(ai, bj, At, Bt) do { __builtin_amdgcn_s_setprio(1); _Pragma("unroll") for (int m = 0; m < 4; ++m) _Pragma("unroll") for (int n = 0; n < 2; ++n) _Pragma("unroll") for (int k = 0; k < 2; ++k) \
        acc[ai][bj][m][n] = __builtin_amdgcn_mfma_f32_16x16x32_bf16(Bt[n][k], At[m][k], acc[ai][bj][m][n], 0, 0, 0); __builtin_amdgcn_s_setprio(0); } while (0)
#define PG8_WAIT_V(n) asm volatile("s_waitcnt vmcnt(" #n ")" ::: "memory")
#define PG8_WAIT_L(n) asm volatile("s_waitcnt lgkmcnt(" #n ")" ::: "memory")
#define PG8_BAR __builtin_amdgcn_s_barrier()
#define PG8_SCHED __builtin_amdgcn_sched_barrier(0)
#define PG8_EOFF(pm_) (g.tile_e ? (size_t)g.tile_e[pm_] * g.estride * 2 : (size_t)0)
    Unit cur, nxt; int ui = 0;
    if (!S.next(0, cur)) return;
    if constexpr (epi_lds<Epi>::n == 16) {
        LAS float* tab_ = (LAS float*)(lds + EPI_LDS_OFF);
        for (int idx = tid; idx < EPI_TAB_CAP * BM; idx += 512) { Unit u_; if (!S.next(idx >> 8, u_)) break; tab_[idx] = row_rstd(E.ssp, u_.pm * BM + (idx & 255)); }
        __syncthreads();
    }
    f32x4 acc[2][2][4][2];
#pragma unroll
    for (int a = 0; a < 2; ++a)
#pragma unroll
        for (int b = 0; b < 2; ++b)
#pragma unroll
            for (int m = 0; m < 4; ++m)
#pragma unroll
                for (int n = 0; n < 2; ++n) acc[a][b][m][n] = (f32x4){0.f, 0.f, 0.f, 0.f};
    bf16x8 At[4][2], B0[2][2], B1[2][2];
    const char* cA = (const char*)g.A + (size_t)cur.pm * tsA; const char* cB = (const char*)g.Bt + PG8_EOFF(cur.pm) + (size_t)cur.pn * tsB;
    if constexpr (GATHER) PG8_GOFF(cur.pm, vgc);
    PG8_STAGE(PG8_SB(0, 0), cB, voffB); PG8_STAGE(PG8_SB(0, 1), cB + hsB, voffB); PG8_STAGE_A(PG8_SA(0, 0), cA, 0, false); PG8_STAGE_A(PG8_SA(0, 1), cA + hsA, 1, false);
    if (wr == 1) PG8_BAR;
    PG8_WAIT_V(2); PG8_BAR;
    PG8_STAGE(PG8_SB(1, 0), cB + kstep, voffB); PG8_STAGE_A(PG8_SA(1, 0), cA + kstep, 0, false); PG8_STAGE(PG8_SB(1, 1), cB + hsB + kstep, voffB);
    PG8_WAIT_V(6); PG8_BAR;
    for (;;) {
        const bool has_next = S.next(ui + 1, nxt);
        if constexpr (GATHER) { if (has_next) PG8_GOFF(nxt.pm, vgn); else { vgn[0][0] = vgc[0][0]; vgn[0][1] = vgc[0][1]; vgn[1][0] = vgc[1][0]; vgn[1][1] = vgc[1][1]; } }
        const char* nA = has_next ? (const char*)g.A + (size_t)nxt.pm * tsA : cA;
        const char* nB = has_next ? (const char*)g.Bt + PG8_EOFF(nxt.pm) + (size_t)nxt.pn * tsB : cB;
        if constexpr (epi_lds<Epi>::n == 1) { if (wid == 0) __builtin_amdgcn_global_load_lds((const unsigned*)((const char*)(E.rowscale + (size_t)cur.pm * BM) + lane * 16), (LAS unsigned*)(lds + EPI_LDS_OFF + (ui & 1) * 1024), 16, 0, 0); }
        for (int t = 0; t < nt; t += 2) {
            const bool last = (t == nt - 2);
            const char* a1 = cA + (size_t)(t + 1) * kstep;
            const char* a2 = last ? nA : cA + (size_t)(t + 2) * kstep; const char* b2 = last ? nB : cB + (size_t)(t + 2) * kstep;
            const char* a3 = a2 + kstep; const char* b3 = b2 + kstep;
            PG8_LDB(B0, 0, 0); PG8_LDB(B1, 0, 1); PG8_SCHED; PG8_LDA(At, 0, 0); PG8_STAGE_A(PG8_SA(1, 1), a1 + hsA, 1, false);
            PG8_WAIT_V(8); PG8_WAIT_L(0); PG8_BAR; PG8_MMA(0, 0, At, B0); PG8_MMA(0, 1, At, B1); PG8_BAR; PG8_SCHED;
            PG8_LDA(At, 0, 1); PG8_STAGE(PG8_SB(0, 0), b2, voffB); PG8_STAGE(PG8_SB(0, 1), b2 + hsB, voffB); PG8_STAGE_A(PG8_SA(0, 0), a2, 0, last);
            PG8_WAIT_V(8); PG8_WAIT_L(0); PG8_BAR; PG8_MMA(1, 0, At, B0); PG8_MMA(1, 1, At, B1); PG8_BAR; PG8_SCHED;
            PG8_LDB(B0, 1, 0); PG8_LDB(B1, 1, 1); PG8_SCHED; PG8_LDA(At, 1, 0); PG8_STAGE_A(PG8_SA(0, 1), a2 + hsA, 1, last);
            PG8_WAIT_V(8); PG8_WAIT_L(0); PG8_BAR; PG8_MMA(0, 0, At, B0); PG8_MMA(0, 1, At, B1); PG8_BAR; PG8_SCHED;
            PG8_LDA(At, 1, 1); PG8_STAGE(PG8_SB(1, 0), b3, voffB); PG8_STAGE(PG8_SB(1, 1), b3 + hsB, voffB); PG8_STAGE_A(PG8_SA(1, 0), a3, 0, last);
            PG8_WAIT_V(8); PG8_WAIT_L(0); PG8_BAR; PG8_MMA(1, 0, At, B0); PG8_MMA(1, 1, At, B1); PG8_BAR; PG8_SCHED;
        }
        if constexpr (ALIGN_EPI) { if (wr == 0) PG8_BAR; }
        if constexpr (epi_lds<Epi>::n == 1) E(acc, cur, wr, wc, fr, fq, (const LAS float*)(lds + EPI_LDS_OFF + (ui & 1) * 1024));
        else if constexpr (epi_lds<Epi>::n == 16) E(acc, cur, wr, wc, fr, fq, ui < EPI_TAB_CAP ? (const LAS float*)(lds + EPI_LDS_OFF + ui * 1024) : (const LAS float*)nullptr);
        else E(acc, cur, wr, wc, fr, fq);
        if (!has_next) break;
#pragma unroll
        for (int a = 0; a < 2; ++a)
#pragma unroll
            for (int b = 0; b < 2; ++b)
#pragma unroll
                for (int m = 0; m < 4; ++m)
#pragma unroll
                    for (int n = 0; n < 2; ++n) acc[a][b][m][n] = (f32x4){0.f, 0.f, 0.f, 0.f};
        cur = nxt; cA = nA; cB = nB; ++ui;
        if constexpr (GATHER) { vgc[0][0] = vgn[0][0]; vgc[0][1] = vgn[0][1]; vgc[1][0] = vgn[1][0]; vgc[1][1] = vgn[1][1]; }
        if constexpr (ALIGN_EPI) { if (wr == 1) PG8_BAR; }
    }
    PG8_WAIT_V(0);
    if constexpr (!ALIGN_EPI) { if (wr == 0) PG8_BAR; }
    PG8_BAR;
#undef PG8_SA
#undef PG8_SB
#undef PG8_STAGE
#undef PG8_LDA
#undef PG8_LDB
#undef PG8_MMA
#undef PG8_WAIT_V
#undef PG8_WAIT_L
#undef PG8_BAR
#undef PG8_SCHED
#undef PG8_EOFF
#undef PG8_GOFF
#undef PG8_STAGE_A
}

__device__ __forceinline__ float row_rstd(const float* ssp, int row);
template <int ACT> struct EpiBf16 {
    static constexpr bool PERM = true;
    bf16_t* O; int ldc; const float* bias; const float* ssp;
    __device__ __forceinline__ void operator()(const f32x4 (&acc)[2][2][4][2], const Unit& u, int wr, int wc, int fr, int fq) const {
        const int row0 = u.pm * BM + wr * 64 + fr, col0 = u.pn * BM + wc * 32 + 8 * fq;
        f32x4 bv[2][2];
#pragma unroll
        for (int bj = 0; bj < 2; ++bj)
#pragma unroll
            for (int n = 0; n < 2; ++n) bv[bj][n] = bias ? *(const f32x4*)(bias + col0 + bj * HALF + 4 * n) : (f32x4){0.f, 0.f, 0.f, 0.f};
#pragma unroll
        for (int ai = 0; ai < 2; ++ai)
#pragma unroll
            for (int m = 0; m < 4; ++m) { bf16_t* rowp = O + (size_t)(row0 + ai * HALF + m * 16) * ldc + col0;
                const float rs = (ACT == 0 && ssp) ? row_rstd(ssp, row0 + ai * HALF + m * 16) : 1.f;
#pragma unroll
                for (int bj = 0; bj < 2; ++bj) { f32x4 v0 = acc[ai][bj][m][0] * rs + bv[bj][0], v1 = acc[ai][bj][m][1] * rs + bv[bj][1];
                    if (ACT == 2) {
#pragma unroll
                        for (int i = 0; i < 4; ++i) { v0[i] = gelu_tanh_f(v0[i]); v1[i] = gelu_tanh_f(v1[i]); } }
                    u32x4 w; w.x = cvtpk(v0[0], v0[1]); w.y = cvtpk(v0[2], v0[3]); w.z = cvtpk(v1[0], v1[1]); w.w = cvtpk(v1[2], v1[3]);
                    *(u32x4*)(rowp + bj * HALF) = w; } }
    }
};
struct EpiResF32 {
    static constexpr bool PERM = false;
    const float* base; float* out; int ldc;
    __device__ __forceinline__ void operator()(const f32x4 (&acc)[2][2][4][2], const Unit& u, int wr, int wc, int fr, int fq) const {
        const int col0 = u.pn * BM + wc * 32 + 4 * fq;
#pragma unroll
        for (int ai = 0; ai < 2; ++ai)
#pragma unroll
            for (int m = 0; m < 4; ++m) { const size_t off = (size_t)(u.pm * BM + ai * HALF + wr * 64 + m * 16 + fr) * ldc + col0;
#pragma unroll
                for (int bj = 0; bj < 2; ++bj)
#pragma unroll
                    for (int n = 0; n < 2; ++n) { const f32x4 bs = *(const f32x4*)(base + off + bj * HALF + n * 16); *(f32x4*)(out + off + bj * HALF + n * 16) = bs + acc[ai][bj][m][n]; } }
    }
};
template <bool BASE_BF16> struct EpiResStat {
    static constexpr bool PERM = true;
    const void* base; bf16_t* xb; float* ssp; int ldc;
    __device__ __forceinline__ void operator()(const f32x4 (&acc)[2][2][4][2], const Unit& u, int wr, int wc, int fr, int fq) const {
        const int col0 = u.pn * BM + wc * 32 + 8 * fq;
#pragma unroll
        for (int ai = 0; ai < 2; ++ai)
#pragma unroll
            for (int m = 0; m < 4; ++m) { const int row = u.pm * BM + ai * HALF + wr * 64 + m * 16 + fr; const size_t off = (size_t)row * ldc + col0; float ss = 0.f;
#pragma unroll
                for (int bj = 0; bj < 2; ++bj) { f32x4 b0, b1;
                    if (BASE_BF16) { const u32x4 t = *(const u32x4*)((const bf16_t*)base + off + bj * HALF); b0 = (f32x4){bflo(t.x), bfhi(t.x), bflo(t.y), bfhi(t.y)}; b1 = (f32x4){bflo(t.z), bfhi(t.z), bflo(t.w), bfhi(t.w)}; }
                    else { b0 = *(const f32x4*)((const float*)base + off + bj * HALF); b1 = *(const f32x4*)((const float*)base + off + bj * HALF + 4); }
                    const f32x4 v0 = b0 + acc[ai][bj][m][0], v1 = b1 + acc[ai][bj][m][1];
                    u32x4 w; w.x = cvtpk(v0.x, v0.y); w.y = cvtpk(v0.z, v0.w); w.z = cvtpk(v1.x, v1.y); w.w = cvtpk(v1.z, v1.w); *(u32x4*)(xb + off + bj * HALF) = w;
                    ss += ((v0.x * v0.x + v0.y * v0.y) + (v0.z * v0.z + v0.w * v0.w)) + ((v1.x * v1.x + v1.y * v1.y) + (v1.z * v1.z + v1.w * v1.w)); }
                ss += __shfl_xor(ss, 16); ss += __shfl_xor(ss, 32);
                if (fq == 0) ssp[(size_t)row * 16 + u.pn * 4 + wc] = ss; }
    }
};
struct EpiResBf16B {
    static constexpr bool PERM = true;
    const bf16_t* base; bf16_t* out; int ldc;
    __device__ __forceinline__ void operator()(const f32x4 (&acc)[2][2][4][2], const Unit& u, int wr, int wc, int fr, int fq) const {
        const int col0 = u.pn * BM + wc * 32 + 8 * fq;
#pragma unroll
        for (int ai = 0; ai < 2; ++ai)
#pragma unroll
            for (int m = 0; m < 4; ++m) { const size_t off = (size_t)(u.pm * BM + ai * HALF + wr * 64 + m * 16 + fr) * ldc + col0;
#pragma unroll
                for (int bj = 0; bj < 2; ++bj) { const u32x4 t = *(const u32x4*)(base + off + bj * HALF);
                    const f32x4 v0 = (f32x4){bflo(t.x), bfhi(t.x), bflo(t.y), bfhi(t.y)} + acc[ai][bj][m][0], v1 = (f32x4){bflo(t.z), bfhi(t.z), bflo(t.w), bfhi(t.w)} + acc[ai][bj][m][1];
                    u32x4 w; w.x = cvtpk(v0.x, v0.y); w.y = cvtpk(v0.z, v0.w); w.z = cvtpk(v1.x, v1.y); w.w = cvtpk(v1.z, v1.w); *(u32x4*)(out + off + bj * HALF) = w; } }
    }
};
struct EpiResF32B {
    static constexpr bool PERM = false;
    const bf16_t* base; float* out; int ldc;
    __device__ __forceinline__ void operator()(const f32x4 (&acc)[2][2][4][2], const Unit& u, int wr, int wc, int fr, int fq) const {
        const int col0 = u.pn * BM + wc * 32 + 4 * fq;
#pragma unroll
        for (int ai = 0; ai < 2; ++ai)
#pragma unroll
            for (int m = 0; m < 4; ++m) { const size_t off = (size_t)(u.pm * BM + ai * HALF + wr * 64 + m * 16 + fr) * ldc + col0;
#pragma unroll
                for (int bj = 0; bj < 2; ++bj)
#pragma unroll
                    for (int n = 0; n < 2; ++n) { const u32x2 t = *(const u32x2*)(base + off + bj * HALF + n * 16); const f32x4 bs = {bflo(t.x), bfhi(t.x), bflo(t.y), bfhi(t.y)};
                        *(f32x4*)(out + off + bj * HALF + n * 16) = bs + acc[ai][bj][m][n]; } }
    }
};
__device__ __forceinline__ float row_rstd(const float* ssp, int row) {
    const f32x4* q = (const f32x4*)(ssp + (size_t)row * 16); const f32x4 a = q[0], b = q[1], c = q[2], d = q[3];
    const float s = ((a.x + a.y) + (a.z + a.w)) + ((b.x + b.y) + (b.z + b.w)) + ((c.x + c.y) + (c.z + c.w)) + ((d.x + d.y) + (d.z + d.w));
    return rsqrtf(s * (1.f / 1024.f) + EPS);
}
struct EpiSwiGLU {
    static constexpr bool PERM = true;
    bf16_t* O; int ldc; const float* ssp; const float* rrs;
    __device__ __forceinline__ void operator()(const f32x4 (&acc)[2][2][4][2], const Unit& u, int wr, int wc, int fr, int fq) const {
        const int row0 = u.pm * BM + wr * 64 + fr, col0 = u.pn * HALF + wc * 32 + 8 * fq;
#pragma unroll
        for (int ai = 0; ai < 2; ++ai)
#pragma unroll
            for (int m = 0; m < 4; ++m) { bf16_t* rowp = O + (size_t)(row0 + ai * HALF + m * 16) * ldc + col0;
                const float rs = rrs ? rrs[row0 + ai * HALF + m * 16] : (ssp ? row_rstd(ssp, row0 + ai * HALF + m * 16) : 1.f);
                float h[8];
#pragma unroll
                for (int n = 0; n < 2; ++n)
#pragma unroll
                    for (int i = 0; i < 4; ++i) h[n * 4 + i] = silu_f(acc[ai][0][m][n][i] * rs) * (acc[ai][1][m][n][i] * rs);
                u32x4 w; w.x = cvtpk(h[0], h[1]); w.y = cvtpk(h[2], h[3]); w.z = cvtpk(h[4], h[5]); w.w = cvtpk(h[6], h[7]);
                *(u32x4*)rowp = w; }
    }
};
struct EpiConvIn {
    static constexpr bool PERM = true;
    bf16_t* Bg; bf16_t* CU; const float* ssp;
    __device__ __forceinline__ void operator()(const f32x4 (&acc)[2][2][4][2], const Unit& u, int wr, int wc, int fr, int fq) const {
        const int row0 = u.pm * BM + wr * 64 + fr;
#pragma unroll
        for (int ai = 0; ai < 2; ++ai)
#pragma unroll
            for (int m = 0; m < 4; ++m) { const int row = row0 + ai * HALF + m * 16; const float rs = row_rstd(ssp, row);
                if (u.pn < 4) {
#pragma unroll
                    for (int bj = 0; bj < 2; ++bj) { const f32x4 v0 = acc[ai][bj][m][0] * rs, v1 = acc[ai][bj][m][1] * rs;
                        u32x4 w; w.x = cvtpk(v0[0], v0[1]); w.y = cvtpk(v0[2], v0[3]); w.z = cvtpk(v1[0], v1[1]); w.w = cvtpk(v1[2], v1[3]);
                        *(u32x4*)(Bg + (size_t)row * 1024 + u.pn * BM + bj * HALF + wc * 32 + 8 * fq) = w; }
                } else { const float r2 = rs * rs; float h[8];
#pragma unroll
                    for (int n = 0; n < 2; ++n)
#pragma unroll
                        for (int i = 0; i < 4; ++i) h[n * 4 + i] = acc[ai][0][m][n][i] * acc[ai][1][m][n][i] * r2;
                    u32x4 w; w.x = cvtpk(h[0], h[1]); w.y = cvtpk(h[2], h[3]); w.z = cvtpk(h[4], h[5]); w.w = cvtpk(h[6], h[7]);
                    *(u32x4*)(CU + (size_t)row * 1024 + (u.pn - 4) * HALF + wc * 32 + 8 * fq) = w; } }
    }
};
struct EpiRowScaleBf16 {
    static constexpr bool PERM = true;
    bf16_t* O; int ldc; const float* roww;
    __device__ __forceinline__ void operator()(const f32x4 (&acc)[2][2][4][2], const Unit& u, int wr, int wc, int fr, int fq) const {
        const int row0 = u.pm * BM + wr * 64 + fr, col0 = u.pn * BM + wc * 32 + 8 * fq;
#pragma unroll
        for (int ai = 0; ai < 2; ++ai)
#pragma unroll
            for (int m = 0; m < 4; ++m) { const int row = row0 + ai * HALF + m * 16; const float sc = roww[row]; bf16_t* rowp = O + (size_t)row * ldc + col0;
#pragma unroll
                for (int bj = 0; bj < 2; ++bj) { const f32x4 v0 = acc[ai][bj][m][0] * sc, v1 = acc[ai][bj][m][1] * sc;
                    u32x4 w; w.x = cvtpk(v0[0], v0[1]); w.y = cvtpk(v0[2], v0[3]); w.z = cvtpk(v1[0], v1[1]); w.w = cvtpk(v1[2], v1[3]);
                    *(u32x4*)(rowp + bj * HALF) = w; } }
    }
};

__device__ __forceinline__ float row_rstd_lds(const LAS float* sl, int rl) {
    const LAS f32x4* q = (const LAS f32x4*)(sl + rl * 16); const f32x4 a = q[0], b = q[1], c = q[2], d = q[3];
    const float s = ((a.x + a.y) + (a.z + a.w)) + ((b.x + b.y) + (b.z + b.w)) + ((c.x + c.y) + (c.z + c.w)) + ((d.x + d.y) + (d.z + d.w));
    return rsqrtf(s * (1.f / 1024.f) + EPS);
}
struct EpiSwiGLUSsp {
    static constexpr bool PERM = true;
    bf16_t* O; int ldc; const float* ssp;
    __device__ __forceinline__ void operator()(const f32x4 (&acc)[2][2][4][2], const Unit& u, int wr, int wc, int fr, int fq, const LAS float* sl) const {
        const int rl0 = wr * 64 + fr, row0 = u.pm * BM + rl0, col0 = u.pn * HALF + wc * 32 + 8 * fq;
#pragma unroll
        for (int ai = 0; ai < 2; ++ai)
#pragma unroll
            for (int m = 0; m < 4; ++m) { bf16_t* rowp = O + (size_t)(row0 + ai * HALF + m * 16) * ldc + col0;
                const float rs = sl ? sl[rl0 + ai * HALF + m * 16] : row_rstd(ssp, row0 + ai * HALF + m * 16);
                const float c1 = -rs * LOG2E, c3 = rs > 0.f ? frcp(rs * rs) : 1e30f;
                float h[8];
#pragma unroll
                for (int n = 0; n < 2; ++n)
#pragma unroll
                    for (int i = 0; i < 4; ++i) { const float g_ = acc[ai][0][m][n][i]; const float e_ = fexp2(g_ * c1); h[n * 4 + i] = (g_ * acc[ai][1][m][n][i]) * frcp(__builtin_fmaf(e_, c3, c3)); }
                u32x4 w; w.x = cvtpk(h[0], h[1]); w.y = cvtpk(h[2], h[3]); w.z = cvtpk(h[4], h[5]); w.w = cvtpk(h[6], h[7]);
                *(u32x4*)rowp = w; }
    }
};
template <> struct epi_lds<EpiSwiGLUSsp> { static constexpr int n = 16; };
struct EpiConvInSsp {
    static constexpr bool PERM = true;
    bf16_t* Bg; bf16_t* CU; const float* ssp;
    __device__ __forceinline__ void operator()(const f32x4 (&acc)[2][2][4][2], const Unit& u, int wr, int wc, int fr, int fq, const LAS float* sl) const {
        const int rl0 = wr * 64 + fr, row0 = u.pm * BM + rl0;
#pragma unroll
        for (int ai = 0; ai < 2; ++ai)
#pragma unroll
            for (int m = 0; m < 4; ++m) { const int row = row0 + ai * HALF + m * 16; const float rs = sl ? sl[rl0 + ai * HALF + m * 16] : row_rstd(ssp, row);
                if (u.pn < 4) {
#pragma unroll
                    for (int bj = 0; bj < 2; ++bj) { const f32x4 v0 = acc[ai][bj][m][0] * rs, v1 = acc[ai][bj][m][1] * rs;
                        u32x4 w; w.x = cvtpk(v0[0], v0[1]); w.y = cvtpk(v0[2], v0[3]); w.z = cvtpk(v1[0], v1[1]); w.w = cvtpk(v1[2], v1[3]);
                        *(u32x4*)(Bg + (size_t)row * 1024 + u.pn * BM + bj * HALF + wc * 32 + 8 * fq) = w; }
                } else { const float r2 = rs * rs; float h[8];
#pragma unroll
                    for (int n = 0; n < 2; ++n)
#pragma unroll
                        for (int i = 0; i < 4; ++i) h[n * 4 + i] = acc[ai][0][m][n][i] * acc[ai][1][m][n][i] * r2;
                    u32x4 w; w.x = cvtpk(h[0], h[1]); w.y = cvtpk(h[2], h[3]); w.z = cvtpk(h[4], h[5]); w.w = cvtpk(h[6], h[7]);
                    *(u32x4*)(CU + (size_t)row * 1024 + (u.pn - 4) * HALF + wc * 32 + 8 * fq) = w; } }
    }
};
template <> struct epi_lds<EpiConvInSsp> { static constexpr int n = 16; };
struct EpiSwiGLULds {
    static constexpr bool PERM = true;
    bf16_t* O; int ldc; const float* rowscale;
    __device__ __forceinline__ void operator()(const f32x4 (&acc)[2][2][4][2], const Unit& u, int wr, int wc, int fr, int fq, const LAS float* rsl) const {
        const int rl0 = wr * 64 + fr, row0 = u.pm * BM + rl0, col0 = u.pn * HALF + wc * 32 + 8 * fq;
#pragma unroll
        for (int ai = 0; ai < 2; ++ai)
#pragma unroll
            for (int m = 0; m < 4; ++m) { bf16_t* rowp = O + (size_t)(row0 + ai * HALF + m * 16) * ldc + col0;
                const float rs = rsl[rl0 + ai * HALF + m * 16];
                const float c1 = -rs * LOG2E, c3 = rs > 0.f ? frcp(rs * rs) : 1e30f;
                float h[8];
#pragma unroll
                for (int n = 0; n < 2; ++n)
#pragma unroll
                    for (int i = 0; i < 4; ++i) { const float g_ = acc[ai][0][m][n][i]; const float e_ = fexp2(g_ * c1); h[n * 4 + i] = (g_ * acc[ai][1][m][n][i]) * frcp(__builtin_fmaf(e_, c3, c3)); }
                u32x4 w; w.x = cvtpk(h[0], h[1]); w.y = cvtpk(h[2], h[3]); w.z = cvtpk(h[4], h[5]); w.w = cvtpk(h[6], h[7]);
                *(u32x4*)rowp = w; }
    }
};
template <> struct epi_lds<EpiSwiGLULds> { static constexpr int n = 1; };
struct EpiRowScaleLds {
    static constexpr bool PERM = true;
    bf16_t* O; int ldc; const float* rowscale;
    __device__ __forceinline__ void operator()(const f32x4 (&acc)[2][2][4][2], const Unit& u, int wr, int wc, int fr, int fq, const LAS float* rsl) const {
        const int rl0 = wr * 64 + fr, row0 = u.pm * BM + rl0, col0 = u.pn * BM + wc * 32 + 8 * fq;
#pragma unroll
        for (int ai = 0; ai < 2; ++ai)
#pragma unroll
            for (int m = 0; m < 4; ++m) { const int row = row0 + ai * HALF + m * 16; const float sc = rsl[rl0 + ai * HALF + m * 16]; bf16_t* rowp = O + (size_t)row * ldc + col0;
#pragma unroll
                for (int bj = 0; bj < 2; ++bj) { const f32x4 v0 = acc[ai][bj][m][0] * sc, v1 = acc[ai][bj][m][1] * sc;
                    u32x4 w; w.x = cvtpk(v0[0], v0[1]); w.y = cvtpk(v0[2], v0[3]); w.z = cvtpk(v1[0], v1[1]); w.w = cvtpk(v1[2], v1[3]);
                    *(u32x4*)(rowp + bj * HALF) = w; } }
    }
};
template <> struct epi_lds<EpiRowScaleLds> { static constexpr int n = 1; };
}
constexpr int ROWS_MAX = 2 * T + 8 * 256;
constexpr size_t al256(size_t x) { return (x + 255) & ~(size_t)255; }
constexpr size_t W_IN_E = 0;
constexpr size_t W_CW1 = W_IN_E + (size_t)1792 * 1024 * 2;
constexpr size_t W_UQ = W_CW1 + (size_t)2 * 256 * 2048 * 2;
constexpr size_t W_UKV = W_UQ + (size_t)1024 * 256 * 2;
constexpr size_t W_OUT_E = W_UKV + (size_t)1024 * 128 * 2;
constexpr size_t W_GU = W_OUT_E + (size_t)1024 * 1024 * 2;
constexpr size_t W_D = W_GU + (size_t)5632 * 1024 * 2;
constexpr size_t W_IN_O = W_D + (size_t)1024 * 2816 * 2;
constexpr size_t W_OUT_O = W_IN_O + (size_t)3072 * 1024 * 2;
constexpr size_t W_MGU = W_OUT_O + (size_t)1024 * 1024 * 2;
constexpr size_t W_MD = W_MGU + (size_t)8 * 2816 * 1024 * 2;
constexpr size_t W_END = W_MD + (size_t)8 * 1024 * 1408 * 2;
constexpr size_t SM_CTL = al256(W_END);
constexpr size_t SM_BAR = SM_CTL + 4096;
constexpr size_t SM_B1P = SM_BAR + 16384;
constexpr size_t SM_B1 = SM_B1P + 32 * 512 * 4;
constexpr size_t SM_ROPE = SM_B1 + 512 * 4;
constexpr size_t SM_BL = SM_ROPE + (size_t)S * 32 * 4;
constexpr size_t SM_HID = SM_BL + 8 * 132 * 4;
constexpr size_t SM_KC = SM_HID + (size_t)2 * NB * 512 * 512 * 2;
constexpr size_t SM_VCT = SM_KC + (size_t)NB * 512 * 64 * 2;
constexpr size_t SM_TE = SM_VCT + (size_t)NB * 512 * 64 * 2;
constexpr size_t SM_TW = SM_TE + (size_t)T * 8;
constexpr size_t SM_RANK = SM_TW + (size_t)T * 8;
constexpr size_t SM_POS = SM_RANK + (size_t)T * 8;
constexpr size_t SM_ROWW = SM_POS + (size_t)T * 8;
constexpr size_t SM_TILEE = SM_ROWW + (size_t)ROWS_MAX * 4;
constexpr size_t SM_ROWTOK = al256(SM_TILEE + (size_t)(ROWS_MAX / 256 + 8) * 4);
constexpr size_t SM_SSP1 = al256(SM_ROWTOK + (size_t)ROWS_MAX * 4);
constexpr size_t SM_SSP2 = SM_SSP1 + (size_t)T * 64;
constexpr size_t SM_RSTD3 = SM_SSP2 + (size_t)T * 64;
constexpr size_t SM_ROWRS = SM_RSTD3 + (size_t)T * 4;
constexpr size_t SM_END = al256(SM_ROWRS + (size_t)ROWS_MAX * 4);
constexpr size_t R_XA = al256(SM_END);
constexpr size_t SZ_XA = (size_t)T * 4096 + (size_t)4 * 1048576;
constexpr size_t R_XN = R_XA + SZ_XA;
constexpr size_t SZ_XN = (size_t)T * 2048;
constexpr size_t R_H = R_XN + SZ_XN;
constexpr size_t SZ_H = ((size_t)T * 6144 > (size_t)ROWS_MAX * 2816) ? (size_t)T * 6144 : (size_t)ROWS_MAX * 2816;
constexpr size_t WS_FAST_END = R_H + SZ_H;
constexpr size_t A_QN = 0;
constexpr size_t A_KSN = A_QN + (size_t)T * 1024;
constexpr size_t A_KWN = A_KSN + (size_t)T * 256;
constexpr size_t A_VST = A_KWN + (size_t)T * 256;
constexpr size_t A_VWT = A_VST + (size_t)T * 256;
constexpr size_t A_KCIN = A_VWT + (size_t)T * 256;
constexpr size_t A_VCIN = A_KCIN + (size_t)T * 256 + 2048;
constexpr size_t A_CQN = A_VCIN + (size_t)T * 256 + 2048;
constexpr size_t A_CKVN = A_CQN + (size_t)T * 512;
constexpr size_t A_KROPE = A_CKVN + (size_t)T * 256;
constexpr size_t A_GATES = A_KROPE + (size_t)T * 64;
constexpr size_t A_END = A_GATES + (size_t)T * 96;
static_assert(A_END <= SZ_XA, "attention inputs fit R_XA");
constexpr size_t O_QM = 0;
constexpr size_t O_KM = O_QM + (size_t)T * 1536;
constexpr size_t O_VMT = O_KM + (size_t)T * 1536;
static_assert(O_VMT + (size_t)T * 1024 <= (size_t)T * 4096, "d_out scratch");

struct Params {
    const float* in[30];
    float* out;
    unsigned char* ws;
    int ph_lo, ph_hi, dbg_branch, pad_;
};

#ifdef PROF_SEL
#define PROF_SLOT(k) ((unsigned long long*)(p.ws + SM_CTL + 2048) + (k))
#define PROF_ON(cond) ((cond) && threadIdx.x == 0)
#ifndef PROF_WAVE
#define PROF_WAVE 0
#endif
#endif
constexpr int LDS_BYTES = 163840;

__device__ __forceinline__ int ltid() { int t = threadIdx.x; asm volatile("" : "+v"(t)); return t; }
__device__ __forceinline__ int perm16(int k) { return (k & ~12) | ((k & 4) << 1) | ((k & 8) >> 1); }

struct WDesc { int in_idx, K, N, rep, map, row_off; size_t src_stride, dst_off, dst_stride; int gain_idx, pad_; size_t src_off; };
__device__ const WDesc WDESC[13] = {
    {3, 1024, 1720, 1, 2, 0, 0, W_IN_E / 2, 0, -1, 0},
    {7, 1024, 256, 2, 0, 0, (size_t)2048 * 256, W_CW1 / 2, (size_t)512 * 1024, -1, 0, 0},
    {7, 1024, 256, 2, 0, 256, (size_t)2048 * 256, W_CW1 / 2, (size_t)512 * 1024, -1, 0, (size_t)1024 * 256},
    {11, 256, 768, 1, 3, 0, 0, W_UQ / 2, 0, -1, 0},
    {12, 128, 1024, 1, 0, 0, 0, W_UKV / 2, 0, -1, 0},
    {15, 1024, 1024, 1, 0, 0, 0, W_OUT_E / 2, 0, -1, 0},
    {17, 1024, 2816, 1, 1, 0, 0, W_GU / 2, 0, 16, 0},
    {18, 1024, 2816, 1, 1, 128, 0, W_GU / 2, 0, 16, 0},
    {19, 2816, 1024, 1, 0, 0, 0, W_D / 2, 0, -1, 0},
    {21, 1024, 3072, 1, 4, 0, 0, W_IN_O / 2, 0, 20, 0},
    {23, 1024, 1024, 1, 0, 0, 0, W_OUT_O / 2, 0, -1, 0},
    {27, 1024, 1408, 8, 1, 0, (size_t)1024 * 1408, W_MGU / 2, (size_t)2816 * 1024, 24, 0},
    {28, 1024, 1408, 8, 1, 128, (size_t)1024 * 1408, W_MGU / 2, (size_t)2816 * 1024, 24, 0},
};
__device__ const WDesc WDESC_MD = {29, 1408, 1024, 8, 0, 0, (size_t)1408 * 1024, W_MD / 2, (size_t)1024 * 1408, -1, 0};

struct WItem { f32x4 v[8]; float g[8]; };
__device__ __forceinline__ void item_load(WItem& I, const float* W, int K, int N, const float* gain, int item, int lane) {
    const int nblk = (N + 31) / 32, kb = item / nblk, nb = item % nblk, k0 = 64 * kb, n0 = 32 * nb;
    const int n4 = (lane & 7) * 4; const bool nok = (n0 + n4) < N;
#pragma unroll
    for (int i = 0; i < 8; ++i) { const int kk = (lane >> 3) + 8 * i; I.v[i] = nok ? *(const f32x4*)(W + (size_t)(k0 + kk) * N + n0 + n4) : (f32x4){0.f, 0.f, 0.f, 0.f}; I.g[i] = gain ? gain[k0 + kk] : 1.f; }
}
__device__ __forceinline__ void item_finish(const WItem& I, int K, int N, bf16_t* WT, int map, int row_off, LAS float* scr, int item, int lane) {
    const int nblk = (N + 31) / 32, kb = item / nblk, nb = item % nblk, k0 = 64 * kb, n0 = 32 * nb;
    const int n4 = (lane & 7) * 4;
#pragma unroll
    for (int i = 0; i < 8; ++i) { const int kk = (lane >> 3) + 8 * i; LAS float* d = scr + kk * 33 + n4; const float g_ = I.g[i]; d[0] = I.v[i].x * g_; d[1] = I.v[i].y * g_; d[2] = I.v[i].z * g_; d[3] = I.v[i].w * g_; }
    asm volatile("s_waitcnt lgkmcnt(0)" ::: "memory");
    const int c = lane & 7;
#pragma unroll
    for (int j = 0; j < 4; ++j) { const int n = (lane >> 3) + 8 * j; const LAS float* s = scr + (8 * c) * 33 + n;
        u32x4 o; o.x = cvtpk(s[0 * 33], s[1 * 33]); o.y = cvtpk(s[2 * 33], s[3 * 33]); o.z = cvtpk(s[4 * 33], s[5 * 33]); o.w = cvtpk(s[6 * 33], s[7 * 33]);
        const int nn = n0 + n;
        if (nn < N) { const int row = (map == 1) ? (256 * (nn >> 7) + (nn & 127) + row_off) : (map == 2) ? (nn < 1280 ? nn : (nn < 1304 ? nn + 416 : nn - 24)) : (map == 3) ? ((nn / 96) * 128 + nn % 96) : (map == 4) ? (nn < 1024 ? nn : (nn < 2048 ? 1024 + 256 * ((nn - 1024) >> 7) + ((nn - 1024) & 127) : 1024 + 256 * ((nn - 2048) >> 7) + 128 + ((nn - 2048) & 127))) : (nn + row_off);
            *(u32x4*)(WT + (size_t)row * K + k0 + 8 * c) = o; } }
    asm volatile("s_waitcnt lgkmcnt(0)" ::: "memory");
}
__device__ __forceinline__ void rms_row_to_bf16(const float* xrow, const float* g, bf16_t* orow, int lane) {
    const f32x4* xr = (const f32x4*)xrow + lane; const f32x4* gr = (const f32x4*)g + lane;
    f32x4 v[4]; float s = 0.f;
#pragma unroll
    for (int j = 0; j < 4; ++j) { v[j] = xr[64 * j]; s += (v[j].x * v[j].x + v[j].y * v[j].y) + (v[j].z * v[j].z + v[j].w * v[j].w); }
    const float r = rsqrtf(wsum(s) * (1.f / 1024.f) + EPS);
    u32x2* o8 = (u32x2*)orow + lane;
#pragma unroll
    for (int j = 0; j < 4; ++j) { const f32x4 gg = gr[64 * j]; u32x2 w; w.x = cvtpk(v[j].x * r * gg.x, v[j].y * r * gg.y); w.y = cvtpk(v[j].z * r * gg.z, v[j].w * r * gg.w); o8[64 * j] = w; }
}
constexpr int WD_EARLY = 6;
__device__ __forceinline__ void convert_weights(const Params& p, LAS unsigned char* lds, int d_lo, int d_hi) {
    const int tid = ltid(), lane = tid & 63, wave = tid >> 6;
    const int gw = blockIdx.x * 8 + wave, NGW = gridDim.x * 8;
    LAS float* scr = (LAS float*)(lds + wave * 16384);
    int base = 0;
#pragma unroll 1
    for (int d = d_lo; d < d_hi; ++d) {
        const WDesc& wd = (d < 13) ? WDESC[d] : WDESC_MD;
        const int n_it = wd.rep * (wd.K / 64) * ((wd.N + 31) / 32);
        int first = (gw - (base % NGW) + NGW) % NGW;
        const int per = (wd.K / 64) * ((wd.N + 31) / 32); const float* gain = wd.gain_idx >= 0 ? p.in[wd.gain_idx] : nullptr;
        for (int it = first; it < n_it; it += 4 * NGW) {
            WItem I[4];
#pragma unroll
            for (int q = 0; q < 4; ++q) { const int iq = it + q * NGW; if (iq < n_it) { const int r = iq / per; item_load(I[q], p.in[wd.in_idx] + wd.src_off + (size_t)r * wd.src_stride, wd.K, wd.N, gain, iq % per, lane); } }
#pragma unroll
            for (int q = 0; q < 4; ++q) { const int iq = it + q * NGW; if (iq < n_it) { const int r = iq / per; item_finish(I[q], wd.K, wd.N, (bf16_t*)p.ws + wd.dst_off + (size_t)r * wd.dst_stride, wd.map, wd.row_off, scr, iq % per, lane); } }
        }
        base += n_it;
    }
}
__device__ __forceinline__ void phase_p0(const Params& p, LAS unsigned char* lds) {
    const int tid = ltid(), lane = tid & 63, wave = tid >> 6;
    const int gw = blockIdx.x * 8 + wave, NGW = gridDim.x * 8;
    convert_weights(p, lds, 0, WD_EARLY);
    bf16_t* xn = (bf16_t*)(p.ws + R_XN);
    for (int m = gw; m < T; m += 2 * NGW) { rms_row_to_bf16(p.in[0] + (size_t)m * D, p.in[2], xn + (size_t)m * D, lane); if (m + NGW < T) rms_row_to_bf16(p.in[0] + (size_t)(m + NGW) * D, p.in[2], xn + (size_t)(m + NGW) * D, lane); }
    for (int u = gw; u < 256; u += NGW) {
        const int kc = u >> 3, kv = (u >> 2) & 1, nb = u & 3; float s = 0.f;
        const float* pos = p.in[6] + kv * 2048 + kc * 64; const float* w1 = p.in[7] + ((size_t)kv * 2048 + kc * 64) * 256 + nb * 64 + lane;
#pragma unroll 8
        for (int k = 0; k < 64; ++k) s += pos[k] * w1[(size_t)k * 256];
        ((float*)(p.ws + SM_B1P))[kc * 512 + kv * 256 + nb * 64 + lane] = s;
    }
    for (int i = blockIdx.x * 512 + tid; i < S * 16; i += gridDim.x * 512) {
        const int t = i >> 4, f = i & 15; const float ang = (float)t * powf(10000.f, -(float)f / 16.f);
        float* rp = (float*)(p.ws + SM_ROPE) + t * 32; rp[f] = cosf(ang); rp[16 + f] = sinf(ang);
    }
    if (blockIdx.x == 0) for (int i = tid; i < 8 * 129; i += 512) { const int h = i / 129, dd = i % 129; ((float*)(p.ws + SM_BL))[h * 132 + dd] = p.in[1][(dd < 128 ? (int)gold::T5B[dd] : 31) * 8 + h] * LOG2E; }
}

__device__ __forceinline__ void unpack8(const u32x4 v, float (&x)[8]) { x[0] = bflo(v.x); x[1] = bfhi(v.x); x[2] = bflo(v.y); x[3] = bfhi(v.y); x[4] = bflo(v.z); x[5] = bfhi(v.z); x[6] = bflo(v.w); x[7] = bfhi(v.w); }
__device__ __forceinline__ u32x4 pack8(const float (&x)[8]) { u32x4 w; w.x = cvtpk(x[0], x[1]); w.y = cvtpk(x[2], x[3]); w.z = cvtpk(x[4], x[5]); w.w = cvtpk(x[6], x[7]); return w; }
__device__ __forceinline__ float ss8f(const float (&x)[8]) { return ((x[0] * x[0] + x[1] * x[1]) + (x[2] * x[2] + x[3] * x[3])) + ((x[4] * x[4] + x[5] * x[5]) + (x[6] * x[6] + x[7] * x[7])); }
__device__ __forceinline__ void load8f(const float* g, float (&x)[8], float sc) { const f32x4 a = *(const f32x4*)g, b = *(const f32x4*)(g + 4); x[0] = a.x * sc; x[1] = a.y * sc; x[2] = a.z * sc; x[3] = a.w * sc; x[4] = b.x * sc; x[5] = b.y * sc; x[6] = b.z * sc; x[7] = b.w * sc; }
__device__ __forceinline__ void phase_p2(const Params& p, LAS unsigned char* lds) {
    const int tid = ltid(), lane = tid & 63, wave = tid >> 6;
    const bf16_t* hb = (const bf16_t*)(p.ws + R_H);
    unsigned char* xa = p.ws + R_XA;
    bf16_t* qn = (bf16_t*)(xa + A_QN); bf16_t* ksn = (bf16_t*)(xa + A_KSN); bf16_t* kwn = (bf16_t*)(xa + A_KWN);
    bf16_t* vst = (bf16_t*)(xa + A_VST); bf16_t* vwt = (bf16_t*)(xa + A_VWT); bf16_t* kcin = (bf16_t*)(xa + A_KCIN); bf16_t* vcin = (bf16_t*)(xa + A_VCIN);
    bf16_t* cqn = (bf16_t*)(xa + A_CQN); bf16_t* ckvn = (bf16_t*)(xa + A_CKVN); bf16_t* krope = (bf16_t*)(xa + A_KROPE); float* gates = (float*)(xa + A_GATES);
    LAS bf16_t* vs = (LAS bf16_t*)lds;
    if (blockIdx.x == 0) {
        { float s = 0.f; for (int k = 0; k < 32; ++k) s += ((const float*)(p.ws + SM_B1P))[k * 512 + tid]; ((float*)(p.ws + SM_B1))[tid] = s; }
        for (int i = tid; i < 1024; i += 512) { kcin[(size_t)T * 128 + i] = 0; vcin[(size_t)T * 128 + i] = 0; }
    }
    const int c8 = (lane & 7) * 8, seg = lane >> 3;
    float qg[8], ksg[8], kwg[8], cqg[8], ckvg[8];
    load8f(p.in[4] + c8, qg, 0.125f * LOG2E); load8f(p.in[5] + 64 + c8, ksg, 1.f); load8f(p.in[5] + 128 + c8, kwg, 1.f);
    load8f(p.in[9] + (lane & 31) * 8, cqg, 1.f); load8f(p.in[10] + (lane & 15) * 8, ckvg, 1.f);
    for (int tile = blockIdx.x; tile < T / 64; tile += gridDim.x) {
        const int b = tile / (S / 64), s0 = (tile % (S / 64)) * 64;
#pragma unroll 4
        for (int tt = 0; tt < 8; ++tt) {
            const int sl = wave * 8 + tt, s = s0 + sl; const size_t t = (size_t)b * S + s;
            const bf16_t* hr = hb + t * 1792 + lane * 8;
            const u32x4 L0 = *(const u32x4*)hr, L1 = *(const u32x4*)(hr + 512), L2 = *(const u32x4*)(hr + 1024);
            u32x4 L3 = {0u, 0u, 0u, 0u}; if (lane < 32) L3 = *(const u32x4*)(hr + 1536);
            float x0[8], x1[8], x2[8], x3[8];
            unpack8(L0, x0); unpack8(L1, x1); unpack8(L2, x2); unpack8(L3, x3);
            float a0 = ss8f(x0), a1 = ss8f(x1), a2 = ss8f(x2), a3 = ss8f(x3);
#define P2_DPP(v, ctrl) __builtin_bit_cast(float, __builtin_amdgcn_update_dpp(0, __builtin_bit_cast(int, (v)), (ctrl), 0xF, 0xF, true))
#define P2_SUM8(v) do { v += P2_DPP(v, 0xB1); v += P2_DPP(v, 0x4E); v += P2_DPP(v, 0x141); } while (0)
            P2_SUM8(a0); P2_SUM8(a1); P2_SUM8(a2); P2_SUM8(a3);
            float a2w = a2 + P2_DPP(a2, 0x140); a2w += __shfl_xor(a2w, 16);
            const float a3w = a3 + P2_DPP(a3, 0x140);
#undef P2_SUM8
#undef P2_DPP
            const int pp0 = (sl & ~15) | perm16(sl & 15);
            const int pp = (((pp0 >> 3) ^ (lane & 7)) << 3) | (pp0 & 7);
            {
                const float r = rsqrtf(a0 * (1.f / 64.f) + EPS); float y[8];
#pragma unroll
                for (int j = 0; j < 8; ++j) y[j] = x0[j] * r * qg[j];
                *(u32x4*)(qn + t * 512 + lane * 8) = pack8(y);
            }
            {
                const int g = seg & 1; const size_t gm = (((size_t)b * 2 + g) * S + s) * 64 + c8;
                if (seg < 2) *(u32x4*)(kcin + gm) = L1;
                else if (seg < 4) *(u32x4*)(vcin + gm) = L1;
                else if (seg < 6) { const float r = rsqrtf(a1 * (1.f / 64.f) + EPS); float y[8];
#pragma unroll
                    for (int j = 0; j < 8; ++j) y[j] = x1[j] * r * ksg[j];
                    *(u32x4*)(ksn + gm) = pack8(y); }
                else {
#pragma unroll
                    for (int j = 0; j < 8; ++j) vs[((0 + g) * 64 + c8 + j) * 72 + pp] = (bf16_t)((j & 1) ? (L1[j >> 1] >> 16) : (L1[j >> 1] & 0xffffu)); }
            }
            {
                const int g = seg & 1; const size_t gm = (((size_t)b * 2 + g) * S + s) * 64 + c8;
                if (seg < 2) { const float r = rsqrtf(a2 * (1.f / 64.f) + EPS); float y[8];
#pragma unroll
                    for (int j = 0; j < 8; ++j) y[j] = x2[j] * r * kwg[j];
                    *(u32x4*)(kwn + gm) = pack8(y); }
                else if (seg < 4) {
#pragma unroll
                    for (int j = 0; j < 8; ++j) vs[((2 + g) * 64 + c8 + j) * 72 + pp] = (bf16_t)((j & 1) ? (L2[j >> 1] >> 16) : (L2[j >> 1] & 0xffffu)); }
                else { const float r = rsqrtf(a2w * (1.f / 256.f) + EPS); float y[8];
#pragma unroll
                    for (int j = 0; j < 8; ++j) y[j] = x2[j] * r * cqg[j];
                    *(u32x4*)(cqn + t * 256 + (lane - 32) * 8) = pack8(y); }
            }
            {
                if (lane < 16) { const float r = rsqrtf(a3w * (1.f / 128.f) + EPS); float y[8];
#pragma unroll
                    for (int j = 0; j < 8; ++j) y[j] = x3[j] * r * ckvg[j];
                    *(u32x4*)(ckvn + t * 128 + lane * 8) = pack8(y); }
                else if (lane < 20) *(u32x4*)(krope + t * 32 + (lane - 16) * 8) = L3;
                else if (lane < 23) { float y[8];
#pragma unroll
                    for (int j = 0; j < 8; ++j) y[j] = frcp(1.f + fexp2(-x3[j] * LOG2E));
                    float* gp = gates + t * 24 + (lane - 20) * 8; *(f32x4*)gp = (f32x4){y[0], y[1], y[2], y[3]}; *(f32x4*)(gp + 4) = (f32x4){y[4], y[5], y[6], y[7]}; }
            }
        }
        __syncthreads();
        {
            const int ch = tid & 7;
#pragma unroll
            for (int i = 0; i < 4; ++i) { const int row = (tid >> 3) + 64 * i, which = row >> 6, d = row & 63, g = which & 1, sx = (row >> 3) & 7;
                bf16_t* dst = ((which < 2) ? vst : vwt) + (((size_t)b * 2 + g) * 64 + d) * S + s0 + ch * 8;
                *(u32x4*)dst = *(const LAS u32x4*)(vs + row * 72 + ((ch ^ sx) << 3)); }
        }
        __syncthreads();
    }
}
__device__ __forceinline__ void phase_p3b(const Params& p, LAS unsigned char* lds, int parts = 3) {
    const int tid = ltid(), lane = tid & 63, wave = tid >> 6;
    const int gw = blockIdx.x * 8 + wave, NGW = gridDim.x * 8;
    const bf16_t* qraw = (const bf16_t*)(p.ws + R_H);
    const bf16_t* kvraw = (const bf16_t*)(p.ws + R_H + (size_t)T * 2048);
    const bf16_t* krope = (const bf16_t*)(p.ws + R_XA + A_KROPE);
    const float* rope = (const float*)(p.ws + SM_ROPE);
    bf16_t* qm = (bf16_t*)((unsigned char*)p.out + O_QM); bf16_t* km = (bf16_t*)((unsigned char*)p.out + O_KM); bf16_t* vmt = (bf16_t*)((unsigned char*)p.out + O_VMT);
    const float* q_norm = p.in[13]; const float* k_norm = p.in[14];
    LAS bf16_t* vs = (LAS bf16_t*)lds;
    LAS float* w2s = (LAS float*)(lds + 73728);
    if (parts & 1) {
        LAS float* w2a = (LAS float*)lds;
        constexpr int NR = NB * 512;
        u32x2 pa[2][2], pb[2][2];
#define P3_ROWLOADS(r0_) do { _Pragma("unroll") for (int kv = 0; kv < 2; ++kv) _Pragma("unroll") for (int q = 0; q < 2; ++q) { \
            int row = (r0_) + q * NGW; row = row < NR ? row : 0; const int row1 = row + 1 < NR ? row + 1 : row;        \
            const bf16_t* P = (const bf16_t*)(p.ws + SM_HID) + (size_t)kv * NB * 512 * 512;       \
            pa[kv][q] = *(const u32x2*)(P + (size_t)row * 512 + lane * 4); pb[kv][q] = *(const u32x2*)(P + (size_t)row1 * 512 + 256 + lane * 4); } } while (0)
        __syncthreads();
        { f32x4 wv[16];
#pragma unroll
          for (int k = 0; k < 16; ++k) wv[k] = ((const f32x4*)p.in[8])[tid + 512 * k];
          P3_ROWLOADS(gw);
#pragma unroll
          for (int k = 0; k < 16; ++k) ((LAS f32x4*)w2a)[tid + 512 * k] = wv[k]; }
        __syncthreads();
        for (int row0 = gw; row0 < NR; row0 += 2 * NGW) {
            if (row0 != gw) P3_ROWLOADS(row0);
#pragma unroll
            for (int kv = 0; kv < 2; ++kv) {
                const f32x4 bs = *(const f32x4*)((const float*)(p.ws + SM_B1) + kv * 256 + lane * 4);
                const LAS float* w2s = w2a + kv * 16384;
#pragma unroll
                for (int q = 0; q < 2; ++q) { const int row = row0 + q * NGW; if (row >= NR) continue;
                    const u32x2 a_ = pa[kv][q], b_ = pb[kv][q];
                    const float h0 = gelu_tanh_f(bflo(a_.x) + bflo(b_.x) + bs.x), h1 = gelu_tanh_f(bfhi(a_.x) + bfhi(b_.x) + bs.y), h2 = gelu_tanh_f(bflo(a_.y) + bflo(b_.y) + bs.z), h3 = gelu_tanh_f(bfhi(a_.y) + bfhi(b_.y) + bs.w);
                    float acc0 = 0.f, acc1 = 0.f;
#pragma unroll 8
                    for (int k4 = 0; k4 < 64; ++k4) {
#define P3_RL(v) __builtin_bit_cast(float, __builtin_amdgcn_readlane(__builtin_bit_cast(int, (v)), k4))
                        acc0 += P3_RL(h0) * w2s[(k4 * 4 + 0) * 64 + lane]; acc1 += P3_RL(h1) * w2s[(k4 * 4 + 1) * 64 + lane];
                        acc0 += P3_RL(h2) * w2s[(k4 * 4 + 2) * 64 + lane]; acc1 += P3_RL(h3) * w2s[(k4 * 4 + 3) * 64 + lane];
#undef P3_RL
                    }
                    const float acc = acc0 + acc1;
                    if (kv == 0) { const float r = rsqrtf(wsum(acc * acc) * (1.f / 64.f) + EPS); ((bf16_t*)(p.ws + SM_KC))[(size_t)row * 64 + lane] = f2bf(acc * r * p.in[5][lane]); }
                    else { const int c = row & 255; ((bf16_t*)(p.ws + SM_VCT))[((size_t)(row >> 8) * 64 + lane) * 256 + ((c & ~15) | perm16(c & 15))] = f2bf(acc); }
                }
            }
        }
    }
#undef P3_ROWLOADS
    __syncthreads();
    const float QS = 0.10206207261596577f * LOG2E;
    const int c = lane & 15, hl = lane >> 4;
    float qg[8], kg[8];
    load8f(q_norm + (c < 12 ? c * 8 : 0), qg, QS);
    load8f(k_norm + (c < 12 ? c * 8 : 0), kg, 1.f);
    const bool isrope = (c >= 8) && (c < 12);
    const float m12 = c < 12 ? 1.f : 0.f, sgn = c < 10 ? -1.f : 1.f;
    const int cr8 = isrope ? (c - 8) * 8 : 0;
#define P3_DPP(v, ctrl) __builtin_bit_cast(float, __builtin_amdgcn_update_dpp(0, __builtin_bit_cast(int, (v)), (ctrl), 0xF, 0xF, true))
#define P3_SUM16(v) do { v += P3_DPP(v, 0xB1); v += P3_DPP(v, 0x4E); v += P3_DPP(v, 0x141); v += P3_DPP(v, 0x140); } while (0)
    if (parts & 2) for (int tile = blockIdx.x; tile < T / 64; tile += gridDim.x) {
        const int b = tile / (S / 64), s0 = (tile % (S / 64)) * 64;
#pragma unroll 4
        for (int tt = 0; tt < 8; ++tt) {
            const int sl = wave * 8 + tt, s = s0 + sl; const size_t t = (size_t)b * S + s;
            const int pp0 = (sl & ~15) | perm16(sl & 15);
            const int pp = (((pp0 >> 3) ^ ((c - 8) & 7)) << 3) | (pp0 & 7);
            u32x4 Q[2], KV[2];
#pragma unroll
            for (int ld = 0; ld < 2; ++ld) { Q[ld] = *(const u32x4*)(qraw + t * 1024 + ld * 512 + lane * 8); KV[ld] = *(const u32x4*)(kvraw + t * 1024 + ld * 512 + lane * 8); }
            const u32x4 KR = *(const u32x4*)(krope + t * 32 + cr8);
            const float* rp = rope + s * 32 + (c & 1) * 8; const f32x4 cs0 = *(const f32x4*)rp, cs1 = *(const f32x4*)(rp + 4), sn0 = *(const f32x4*)(rp + 16), sn1 = *(const f32x4*)(rp + 20);
            const float csr[8] = {cs0.x, cs0.y, cs0.z, cs0.w, cs1.x, cs1.y, cs1.z, cs1.w}, snr[8] = {sn0.x, sn0.y, sn0.z, sn0.w, sn1.x, sn1.y, sn1.z, sn1.w};
            float cse[8], sne[8], kr[8]; unpack8(KR, kr);
#pragma unroll
            for (int j = 0; j < 8; ++j) { cse[j] = isrope ? csr[j] : 1.f; sne[j] = isrope ? snr[j] * sgn : 0.f; kr[j] = isrope ? kr[j] : 0.f; }
#pragma unroll
            for (int ld = 0; ld < 2; ++ld) {
                const int hh = ld * 4 + hl;
                {
                    float x[8]; unpack8(Q[ld], x);
                    float ss = ss8f(x) * m12; P3_SUM16(ss);
                    const float r = rsqrtf(ss * (1.f / 96.f) + EPS); float y[8], z[8];
#pragma unroll
                    for (int j = 0; j < 8; ++j) y[j] = x[j] * (r * qg[j]);
#pragma unroll
                    for (int j = 0; j < 8; ++j) { const float pb = P3_DPP(y[j], 0x4E); z[j] = __builtin_fmaf(pb, sne[j], y[j] * cse[j]); }
                    if (c < 12) *(u32x4*)(qm + (t * 8 + hh) * 96 + c * 8) = pack8(z);
                }
                {
                    float x[8], xk[8]; unpack8(KV[ld], x);
#pragma unroll
                    for (int j = 0; j < 8; ++j) xk[j] = c < 8 ? x[j] : kr[j];
                    float ss = ss8f(xk); P3_SUM16(ss);
                    const float r = rsqrtf(ss * (1.f / 96.f) + EPS); float y[8], z[8];
#pragma unroll
                    for (int j = 0; j < 8; ++j) y[j] = xk[j] * (r * kg[j]);
#pragma unroll
                    for (int j = 0; j < 8; ++j) { const float pb = P3_DPP(y[j], 0x4E); z[j] = __builtin_fmaf(pb, sne[j], y[j] * cse[j]); }
                    if (c < 12) *(u32x4*)(km + (((size_t)b * 8 + hh) * S + s) * 96 + c * 8) = pack8(z);
                    if (c >= 8) {
#pragma unroll
                        for (int j = 0; j < 8; ++j) vs[(hh * 64 + (c - 8) * 8 + j) * 72 + pp] = (bf16_t)((j & 1) ? (KV[ld][j >> 1] >> 16) : (KV[ld][j >> 1] & 0xffffu)); }
                }
            }
        }
        __syncthreads();
        {
            const int ch = tid & 7;
#pragma unroll
            for (int i = 0; i < 8; ++i) { const int row = (tid >> 3) + 64 * i, hh = row >> 6, d = row & 63, sx = (row >> 3) & 7;
                *(u32x4*)(vmt + (((size_t)b * 8 + hh) * 64 + d) * S + s0 + ch * 8) = *(const LAS u32x4*)(vs + row * 72 + ((ch ^ sx) << 3)); }
        }
        __syncthreads();
    }
#undef P3_SUM16
#undef P3_DPP
}
__device__ const unsigned short UNIT_TYPES[256] = {63,127,62,126,61,125,527,591,655,719,783,847,911,975,60,124,59,123,58,122,57,121,56,120,526,590,654,718,782,846,910,974,55,119,54,118,53,117,52,116,51,115,525,589,653,717,781,845,909,973,50,114,49,113,48,112,47,111,524,588,652,716,780,844,908,972,46,110,45,109,44,108,43,107,523,587,651,715,779,843,907,971,42,106,41,105,40,104,39,103,38,102,522,586,650,714,778,842,906,970,37,101,36,100,35,99,34,98,33,97,521,585,649,713,777,841,905,969,32,96,31,95,30,94,520,584,648,712,776,840,904,968,29,93,28,92,27,91,26,90,25,89,519,583,647,711,775,839,903,967,24,88,23,87,22,86,21,85,20,84,518,582,646,710,774,838,902,966,19,83,18,82,17,81,16,80,15,79,517,581,645,709,773,837,901,965,14,78,13,77,12,76,516,580,644,708,772,836,900,964,11,75,10,74,9,73,8,72,515,579,643,707,771,835,899,963,7,71,6,70,5,69,514,578,642,706,770,834,898,962,4,68,3,67,513,577,641,705,769,833,897,961,2,66,1,65,0,64,512,576,640,704,768,832,896,960};
__device__ __forceinline__ int crow(int r, int hi) { return (r & 3) + 8 * (r >> 2) + 4 * hi; }
struct Flash { f32x16 o0, o1; float l; };
__device__ __forceinline__ void flash_init(Flash& st) {
#pragma unroll
    for (int r = 0; r < 16; ++r) { st.o0[r] = 0.f; st.o1[r] = 0.f; }
    st.l = 0.f;
}
constexpr int AL_K64 = 0, AL_V64 = 4 * 8192;
constexpr int AL_K96 = 0, AL_V96 = 4 * 16384;
constexpr int AL_IMP = 65536, AL_SELB = AL_IMP + 64 * 65 * 4, AL_UNI = AL_SELB + 512, AL_TL = AL_UNI + 64, AL_BL = AL_TL + 128, AL_OT = AL_BL + 4 * 132 * 4, AL_END = AL_OT + 8 * 32 * 64 * 4;
static_assert(AL_END <= 163328 && AL_V96 + 4 * 8192 <= 163328, "attention LDS");

template <int RB> struct DmaLane { unsigned g0, g1; };
template <int RB> __device__ __forceinline__ void dma_setup(DmaLane<RB>& L, int w, int lane, unsigned gs) {
    if (RB == 128) { const int r = 8 * w + (lane >> 3), c = (lane & 7) ^ ((r >> 1) & 7); L.g0 = (unsigned)r * gs + c * 16; L.g1 = 0; }
    else {
        { const int r = 8 * w + (lane >> 4); int c = (lane & 15) ^ (r & 15); c = c >= 12 ? c - 4 : c; L.g0 = (unsigned)r * gs + c * 16; }
        { const int r = 8 * w + 4 + (lane >> 4); int c = (lane & 15) ^ (r & 15); c = c >= 12 ? c - 4 : c; L.g1 = (unsigned)r * gs + c * 16; }
    }
}
template <int RB> __device__ __forceinline__ void dma_issue(const unsigned char* tile, const DmaLane<RB>& L, LAS unsigned char* buf, int w) {
    if (RB == 128) __builtin_amdgcn_global_load_lds((const unsigned*)(tile + L.g0), (LAS unsigned*)(buf + w * 1024), 16, 0, 0);
    else { __builtin_amdgcn_global_load_lds((const unsigned*)(tile + L.g0), (LAS unsigned*)(buf + w * 2048), 16, 0, 0);
           __builtin_amdgcn_global_load_lds((const unsigned*)(tile + L.g1), (LAS unsigned*)(buf + w * 2048 + 1024), 16, 0, 0); }
}
template <int DK> __device__ __forceinline__ void frag_offsets(unsigned (&kl)[DK / 16], unsigned (&vl)[4], int r32, int hi) {
#pragma unroll
    for (int s = 0; s < DK / 16; ++s) kl[s] = (DK == 64) ? (unsigned)(r32 * 128 + (((2 * s + hi) ^ ((r32 >> 1) & 7)) << 4)) : (unsigned)(r32 * 256 + (((2 * s + hi) ^ (r32 & 15)) << 4));
#pragma unroll
    for (int s = 0; s < 4; ++s) vl[s] = (unsigned)(r32 * 128 + (((2 * s + hi) ^ ((r32 >> 1) & 7)) << 4));
}

template <int NS> struct KFrags { bf16x8 ka[NS], kh[NS]; };
template <int DK, int KP> __device__ __forceinline__ void kfrag_load(KFrags<DK / 16>& fr, const LAS unsigned char* Kt, const unsigned (&kl)[DK / 16]) {
#pragma unroll
    for (int s = 0; s < DK / 16; ++s) fr.ka[s] = *(const LAS bf16x8*)(Kt + kl[s]);
#pragma unroll
    for (int s = 0; s < DK / 16; ++s) fr.kh[s] = *(const LAS bf16x8*)(Kt + kl[s] + 32 * KP);
}
template <int DK, int KP, bool LANEMASK, class F>
__device__ __forceinline__ void tile_compute(Flash& st, KFrags<DK / 16>& fr, const LAS unsigned char* Kn, const LAS unsigned char* Vt, const bf16x8* qf, const f32x16& negm, const unsigned (&kl)[DK / 16], const unsigned (&vl)[4], bool mine, F f) {
    constexpr int NS = DK / 16; constexpr int KH = 32 * KP;
    (void)KH;
    f32x16 p0, p1;
#pragma unroll
    for (int s = 0; s < NS; ++s) p0 = (s == 0) ? __builtin_amdgcn_mfma_f32_32x32x16_bf16(fr.ka[0], qf[0], negm, 0, 0, 0) : __builtin_amdgcn_mfma_f32_32x32x16_bf16(fr.ka[s], qf[s], p0, 0, 0, 0);
#pragma unroll
    for (int s = 0; s < NS; ++s) p1 = (s == 0) ? __builtin_amdgcn_mfma_f32_32x32x16_bf16(fr.kh[0], qf[0], negm, 0, 0, 0) : __builtin_amdgcn_mfma_f32_32x32x16_bf16(fr.kh[s], qf[s], p1, 0, 0, 0);
    __builtin_amdgcn_sched_barrier(0);
    bf16x8 va[4], vh[4];
#pragma unroll
    for (int s = 0; s < 4; ++s) { va[s] = *(const LAS bf16x8*)(Vt + vl[s]); vh[s] = *(const LAS bf16x8*)(Vt + vl[s] + 4096); }
    kfrag_load<DK, KP>(fr, Kn, kl);
    __builtin_amdgcn_sched_barrier(0);
    float ls = 0.f, ls1 = 0.f;
    u32x4 w0, w1, w2, w3;
    {
#pragma unroll
        for (int r = 0; r < 16; ++r) { float x = p0[r]; const bool v = f(r, 0, x); const float e = fexp2(x); p0[r] = v ? e : 0.f; ls += p0[r]; }
        w0.x = cvtpk(p0[0], p0[1]); w0.y = cvtpk(p0[2], p0[3]); w0.z = cvtpk(p0[4], p0[5]); w0.w = cvtpk(p0[6], p0[7]);
        w1.x = cvtpk(p0[8], p0[9]); w1.y = cvtpk(p0[10], p0[11]); w1.z = cvtpk(p0[12], p0[13]); w1.w = cvtpk(p0[14], p0[15]);
        if (LANEMASK) { w0.x = mine ? w0.x : 0u; w0.y = mine ? w0.y : 0u; w0.z = mine ? w0.z : 0u; w0.w = mine ? w0.w : 0u; w1.x = mine ? w1.x : 0u; w1.y = mine ? w1.y : 0u; w1.z = mine ? w1.z : 0u; w1.w = mine ? w1.w : 0u; }
    }
#pragma unroll
    for (int s = 0; s < 2; ++s) {
        const bf16x8 pa = __builtin_bit_cast(bf16x8, s ? w1 : w0);
        st.o0 = __builtin_amdgcn_mfma_f32_32x32x16_bf16(pa, va[s], st.o0, 0, 0, 0);
        st.o1 = __builtin_amdgcn_mfma_f32_32x32x16_bf16(pa, vh[s], st.o1, 0, 0, 0);
    }
    {
#pragma unroll
        for (int r = 0; r < 16; ++r) { float x = p1[r]; const bool v = f(r, 1, x); const float e = fexp2(x); p1[r] = v ? e : 0.f; ls1 += p1[r]; }
        w2.x = cvtpk(p1[0], p1[1]); w2.y = cvtpk(p1[2], p1[3]); w2.z = cvtpk(p1[4], p1[5]); w2.w = cvtpk(p1[6], p1[7]);
        w3.x = cvtpk(p1[8], p1[9]); w3.y = cvtpk(p1[10], p1[11]); w3.z = cvtpk(p1[12], p1[13]); w3.w = cvtpk(p1[14], p1[15]);
        if (LANEMASK) { w2.x = mine ? w2.x : 0u; w2.y = mine ? w2.y : 0u; w2.z = mine ? w2.z : 0u; w2.w = mine ? w2.w : 0u; w3.x = mine ? w3.x : 0u; w3.y = mine ? w3.y : 0u; w3.z = mine ? w3.z : 0u; w3.w = mine ? w3.w : 0u; }
    }
    ls += ls1;
    if (LANEMASK) ls = mine ? ls : 0.f;
    st.l += ls;
#pragma unroll
    for (int s = 2; s < 4; ++s) {
        const bf16x8 pa = __builtin_bit_cast(bf16x8, (s == 3) ? w3 : w2);
        st.o0 = __builtin_amdgcn_mfma_f32_32x32x16_bf16(pa, va[s], st.o0, 0, 0, 0);
        st.o1 = __builtin_amdgcn_mfma_f32_32x32x16_bf16(pa, vh[s], st.o1, 0, 0, 0);
    }
}
template <int DK, int KP> __device__ __forceinline__ void qk_tile(f32x16& p0, f32x16& p1, const LAS unsigned char* Kt, const bf16x8* qf, const f32x16& negm, const unsigned (&kl)[DK / 16]) {
#pragma unroll
    for (int s = 0; s < DK / 16; ++s) {
        const bf16x8 a0 = *(const LAS bf16x8*)(Kt + kl[s]);
        const bf16x8 a1 = *(const LAS bf16x8*)(Kt + kl[s] + 32 * KP);
        if (s == 0) { p0 = __builtin_amdgcn_mfma_f32_32x32x16_bf16(a0, qf[0], negm, 0, 0, 0); p1 = __builtin_amdgcn_mfma_f32_32x32x16_bf16(a1, qf[0], negm, 0, 0, 0); }
        else { p0 = __builtin_amdgcn_mfma_f32_32x32x16_bf16(a0, qf[s], p0, 0, 0, 0); p1 = __builtin_amdgcn_mfma_f32_32x32x16_bf16(a1, qf[s], p1, 0, 0, 0); }
    }
}
template <bool FIRST> __device__ __forceinline__ void flash_accum(LAS float* otl, const Flash& st, float gate, int hi, int lane) {
    const float lt = st.l + __shfl_xor(st.l, 32);
    const float f = lt > 0.f ? gate * frcp(lt) : 0.f;
#pragma unroll
    for (int r = 0; r < 16; ++r) { const float fr_ = __shfl(f, crow(r, hi));
        if (FIRST) { otl[r * 64 + lane] = fr_ * st.o0[r]; otl[(16 + r) * 64 + lane] = fr_ * st.o1[r]; }
        else { otl[r * 64 + lane] += fr_ * st.o0[r]; otl[(16 + r) * 64 + lane] += fr_ * st.o1[r]; } }
}
template <int NS> __device__ __forceinline__ float qnorm2(const bf16x8* qf) {
    float s = 0.f;
#pragma unroll
    for (int i = 0; i < NS; ++i)
#pragma unroll
        for (int j = 0; j < 8; ++j) { const float x = bf2f((bf16_t)qf[i][j]); s += x * x; }
    return s + __shfl_xor(s, 32);
}
__device__ __forceinline__ float wmax(float v) {
#pragma unroll
    for (int o = 1; o < 64; o <<= 1) v = fmaxf(v, __shfl_xor(v, o));
    return v;
}

struct NoComp {};
template <class T> struct is_nocomp { static constexpr bool v = false; };
template <> struct is_nocomp<NoComp> { static constexpr bool v = true; };
template <class C> __device__ __forceinline__ void rt_call(C& c, int t, LAS unsigned char* kb, LAS unsigned char* vb, LAS unsigned char* kn) { c(t, kb, vb, kn); }
__device__ __forceinline__ void rt_call(NoComp&, int, LAS unsigned char*, LAS unsigned char*, LAS unsigned char*) {}
template <class C> __device__ __forceinline__ void kl_call(C& c, LAS unsigned char* kb) { c(kb); }
__device__ __forceinline__ void kl_call(NoComp&, LAS unsigned char*) {}
template <int RBK, bool HASV, int KOFF, int KSZ, int VOFF, class SrcK, class SrcV, class C0, class C1, class C2, class KL = NoComp>
__device__ __forceinline__ void run_tiles(int n, int e0, int e1, int e2, LAS unsigned char* lds, int w, int lane, unsigned gsK, unsigned gsV, SrcK srcK, SrcV srcV, C0 c0, C1 c1, C2 c2, KL kload = KL{}) {
    DmaLane<RBK> LK; dma_setup<RBK>(LK, w, lane, gsK);
    DmaLane<128> LV; LV.g0 = 0; LV.g1 = 0; if (HASV) dma_setup<128>(LV, w, lane, gsV);
    const int nl = n - 1, t1 = nl < 1 ? nl : 1, t2 = nl < 2 ? nl : 2;
    e0 = __builtin_amdgcn_readfirstlane(e0); e1 = __builtin_amdgcn_readfirstlane(e1); e2 = __builtin_amdgcn_readfirstlane(e2);
    dma_issue<RBK>(srcK(0), LK, lds + KOFF, w); if (HASV) dma_issue<128>(srcV(0), LV, lds + VOFF, w);
    dma_issue<RBK>(srcK(t1), LK, lds + KOFF + KSZ, w); if (HASV) dma_issue<128>(srcV(t1), LV, lds + VOFF + 8192, w);
    dma_issue<RBK>(srcK(t2), LK, lds + KOFF + 2 * KSZ, w); if (HASV) dma_issue<128>(srcV(t2), LV, lds + VOFF + 2 * 8192, w);
    constexpr int P = (RBK == 128 ? 1 : 2) + (HASV ? 1 : 0);
    int t = 0, slot = 0;
    constexpr bool KPRE = !is_nocomp<KL>::v;
    if (KPRE) {
        if (P == 1) asm volatile("s_waitcnt vmcnt(2)" ::: "memory"); else if (P == 2) asm volatile("s_waitcnt vmcnt(4)" ::: "memory"); else asm volatile("s_waitcnt vmcnt(6)" ::: "memory");
        __builtin_amdgcn_s_barrier(); asm volatile("" ::: "memory");
        kl_call(kload, lds + KOFF);
    }
#define RT_HEAD() do { \
        if (KPRE) { if (P == 1) asm volatile("s_waitcnt vmcnt(1)" ::: "memory"); else if (P == 2) asm volatile("s_waitcnt vmcnt(2)" ::: "memory"); else asm volatile("s_waitcnt vmcnt(3)" ::: "memory"); } \
        else if (P == 1) asm volatile("s_waitcnt vmcnt(2)" ::: "memory"); else if (P == 2) asm volatile("s_waitcnt vmcnt(4)" ::: "memory"); else asm volatile("s_waitcnt vmcnt(6)" ::: "memory"); \
        __builtin_amdgcn_s_barrier(); asm volatile("" ::: "memory"); \
        { const int tn = (t + 3 < nl) ? t + 3 : nl; const int s2 = (slot + 3) & 3; \
          dma_issue<RBK>(srcK(tn), LK, lds + KOFF + s2 * KSZ, w); if (HASV) dma_issue<128>(srcV(tn), LV, lds + VOFF + s2 * 8192, w); } } while (0)
#define RT_SEG(cc, ee) if (!is_nocomp<decltype(cc)>::v) { _Pragma("unroll 1") for (; t < (ee); ++t) { RT_HEAD(); rt_call(cc, t, lds + KOFF + slot * KSZ, lds + VOFF + slot * 8192, lds + KOFF + ((slot + 1) & 3) * KSZ); slot = (slot + 1) & 3; } }
    RT_SEG(c0, e0)
    RT_SEG(c1, e1)
    RT_SEG(c2, e2)
#pragma unroll 1
    for (; t < n; ++t) { RT_HEAD(); slot = (slot + 1) & 3; }
#undef RT_SEG
#undef RT_HEAD
    asm volatile("s_waitcnt vmcnt(0)" ::: "memory");
    __syncthreads();
}

__device__ __forceinline__ void mla_unit(const Params& p, LAS unsigned char* lds, int b, int h, int qb) {
    int tid = threadIdx.x; asm volatile("" : "+v"(tid));
    const int lane = tid & 63, w = __builtin_amdgcn_readfirstlane(tid >> 6), r32 = lane & 31, hi = lane >> 5;
    const bf16_t* qm = (const bf16_t*)((const unsigned char*)p.out + O_QM);
    const unsigned char* km = (const unsigned char*)p.out + O_KM + (((size_t)b * 8 + h) * S) * 192;
    const unsigned char* vmt = (const unsigned char*)p.out + O_VMT + (((size_t)b * 8 + h) * 64) * (size_t)S * 2;
    bf16_t* ocat = (bf16_t*)(p.ws + R_XN);
    const int tq = qb * 256 + 32 * w + r32;
    bf16x8 qf[6];
#pragma unroll
    for (int s = 0; s < 6; ++s) qf[s] = *(const bf16x8*)(qm + (((size_t)b * S + tq) * 8 + h) * 96 + 16 * s + 8 * hi);
    const float kn = 9.797958971f * 1.01f * wmax(fmaxf(fabsf(p.in[14][lane]), lane < 32 ? fabsf(p.in[14][64 + lane]) : 0.f));
    const float mref = sqrtf(qnorm2<6>(qf)) * kn;
    f32x16 negm;
#pragma unroll
    for (int r = 0; r < 16; ++r) negm[r] = -mref;
    Flash st; flash_init(st);
    const int ntile = 4 * qb + 4, dt = 4 * qb + (w >> 1);
#ifdef PROF_SEL
    if (b == 0 && h == 0 && qb == 15 && threadIdx.x == 0) { *PROF_SLOT(36) -= __builtin_amdgcn_s_memtime(); *PROF_SLOT(37) -= __builtin_amdgcn_s_memrealtime(); }
#endif
    unsigned kl[6], vl[4]; frag_offsets<96>(kl, vl, r32, hi);
    KFrags<6> fr;
    run_tiles<192, true, AL_K96, 16384, AL_V96>(ntile, dt, dt + 1, dt + 1, lds, w, lane, 192u, (unsigned)(S * 2),
        [&](int i) { return km + (size_t)i * 64 * 192; }, [&](int i) { return vmt + (size_t)i * 128; },
        [&](int i, LAS unsigned char* kb, LAS unsigned char* vb, LAS unsigned char* kn) { tile_compute<96, 256, false>(st, fr, kn, vb, qf, negm, kl, vl, true, [&](int r, int half, float& x) { return true; }); },
        [&](int i, LAS unsigned char* kb, LAS unsigned char* vb, LAS unsigned char* kn) { const int kb0 = 64 * i + 4 * hi; tile_compute<96, 256, false>(st, fr, kn, vb, qf, negm, kl, vl, true, [&](int r, int half, float& x) { return (kb0 + 32 * half + (r & 3) + 8 * (r >> 2)) <= tq; }); },
        NoComp{}, [&](LAS unsigned char* kb) { kfrag_load<96, 256>(fr, kb, kl); });
#ifdef PROF_SEL
    if (b == 0 && h == 0 && qb == 15 && threadIdx.x == 0) { *PROF_SLOT(36) += __builtin_amdgcn_s_memtime(); *PROF_SLOT(37) += __builtin_amdgcn_s_memrealtime(); }
#endif
    {
        const float lt = st.l + __shfl_xor(st.l, 32); const float f = lt > 0.f ? frcp(lt) : 0.f;
#pragma unroll
        for (int r = 0; r < 16; ++r) { const float fr_ = __shfl(f, crow(r, hi)); const size_t ro = ((size_t)b * S + qb * 256 + 32 * w + crow(r, hi)) * 1024 + 512 + h * 64 + r32; ocat[ro] = f2bf(st.o0[r] * fr_); ocat[ro + 32] = f2bf(st.o1[r] * fr_); }
    }
}

__device__ __forceinline__ void nsa_unit(const Params& p, LAS unsigned char* lds, int b, int g, int jt) {
    int tid = threadIdx.x; asm volatile("" : "+v"(tid));
    const int lane = tid & 63, w = __builtin_amdgcn_readfirstlane(tid >> 6), r32 = lane & 31, hi = lane >> 5;
    const int rh = w >> 1, qh = w & 1, h = 4 * g + rh, q0 = 64 * jt, ql = 32 * qh + r32, tq = q0 + ql;
    const unsigned char* xa = p.ws + R_XA;
    const bf16_t* qn = (const bf16_t*)(xa + A_QN);
    const size_t bg = (size_t)b * 2 + g;
    const unsigned char* ksn = xa + A_KSN + bg * S * 128; const unsigned char* kwn = xa + A_KWN + bg * S * 128;
    const unsigned char* vst = xa + A_VST + bg * 64 * (size_t)S * 2; const unsigned char* vwt = xa + A_VWT + bg * 64 * (size_t)S * 2;
    const unsigned char* kc = p.ws + SM_KC + bg * 256 * 128; const unsigned char* vct = p.ws + SM_VCT + bg * 64 * 512;
    const float* gates = (const float*)(xa + A_GATES) + ((size_t)b * S + tq) * 24 + h * 3;
    bf16_t* ocat = (bf16_t*)(p.ws + R_XN);
    LAS float* imp = (LAS float*)(lds + AL_IMP); LAS unsigned char* selb = lds + AL_SELB; LAS unsigned* uni = (LAS unsigned*)(lds + AL_UNI); LAS unsigned char* tl = lds + AL_TL; LAS float* bls = (LAS float*)(lds + AL_BL);
    const float* blg = (const float*)(p.ws + SM_BL) + h * 132;
    const float cb = blg[128];
    const float bmax = wmax(fmaxf(fmaxf(blg[lane], blg[64 + lane]), cb));
    if (qh == 0) { bls[rh * 132 + lane] = blg[lane] - cb; bls[rh * 132 + 64 + lane] = blg[64 + lane] - cb; if (lane == 0) bls[rh * 132 + 128] = 0.f; }
    const LAS float* blh = bls + rh * 132;
    bf16x8 qf[4];
#pragma unroll
    for (int s = 0; s < 4; ++s) qf[s] = *(const bf16x8*)(qn + (((size_t)b * S + tq) * 8 + h) * 64 + 16 * s + 8 * hi);
    const float kn = 8.f * 1.01f * wmax(fmaxf(fmaxf(fabsf(p.in[5][lane]), fabsf(p.in[5][64 + lane])), fabsf(p.in[5][128 + lane])));
    const float mref = sqrtf(qnorm2<4>(qf)) * kn + bmax;
    f32x16 negm;
#pragma unroll
    for (int r = 0; r < 16; ++r) negm[r] = cb - mref;
    float g0 = gates[0], g1 = gates[1], g2 = gates[2];
    if (p.dbg_branch >= 0) { g0 = p.dbg_branch == 0 ? 1.f : 0.f; g1 = p.dbg_branch == 1 ? 1.f : 0.f; g2 = p.dbg_branch == 2 ? 1.f : 0.f; }
    LAS float* otl = (LAS float*)(lds + AL_OT) + w * 2048;
#ifdef PROF_SEL
    if (b == 0 && g == 0 && jt == 63 && threadIdx.x == 0) *PROF_SLOT(48) -= __builtin_amdgcn_s_memtime();
#endif
    const int nvmax = (q0 + 63 - 31) / 16 + 1, ntc = (nvmax + 63) / 64;
    Flash st; flash_init(st);
    unsigned kl[4], vl[4]; frag_offsets<64>(kl, vl, r32, hi);
    KFrags<4> fr;
    const int qb32 = q0 + 32 * qh;
    int ecf = 0;
    for (int i = 0; i < ntc; ++i) if (qb32 - (16 * (64 * i + 63) + 31) >= 128) ecf = i + 1;
    run_tiles<128, true, AL_K64, 8192, AL_V64>(ntc, ecf, ntc, ntc, lds, w, lane, 128u, 512u,
        [&](int i) { return kc + (size_t)i * 64 * 128; }, [&](int i) { return vct + (size_t)i * 128; },
        [&](int i, LAS unsigned char* kb, LAS unsigned char* vb, LAS unsigned char* kn) { tile_compute<64, 128, false>(st, fr, kn, vb, qf, negm, kl, vl, true, [&](int r, int half, float& x) { return true; }); },
        [&](int i, LAS unsigned char* kb, LAS unsigned char* vb, LAS unsigned char* kn) {
            const int cb0 = 64 * i + 4 * hi;
            tile_compute<64, 128, false>(st, fr, kn, vb, qf, negm, kl, vl, true, [&](int r, int half, float& x) {
                const int c = cb0 + 32 * half + (r & 3) + 8 * (r >> 2); const int dist = tq - 16 * c - 31; x += blh[dist < 0 ? 0 : (dist > 128 ? 128 : dist)]; return dist >= 0; });
        },
        NoComp{}, [&](LAS unsigned char* kb) { kfrag_load<64, 128>(fr, kb, kl); });
    flash_accum<true>(otl, st, g0, hi, lane);
    unsigned mlo, mhi;
    int nsel;
    if (jt < 16) { const unsigned long long mk = (1ull << (jt + 1)) - 1ull; mlo = (unsigned)mk; mhi = (unsigned)(mk >> 32); nsel = jt + 1; if (tid <= jt) tl[tid] = (unsigned char)tid; }
    else {
        for (int i = tid; i < 64 * 65; i += 512) imp[i] = 0.f;
        const float lt = st.l + __shfl_xor(st.l, 32); const float linv = lt > 0.f ? frcp(lt) : 0.f;
        float xlast = 0.f;
        run_tiles<128, false, AL_K64, 8192, AL_V64>(ntc, ntc, ntc, ntc, lds, w, lane, 128u, 0u,
            [&](int i) { return kc + (size_t)i * 64 * 128; }, [&](int i) { return kc; },
            [&](int i, LAS unsigned char* kb, LAS unsigned char* vb, LAS unsigned char* kn) {
                f32x16 p0, p1; qk_tile<64, 128>(p0, p1, kb, qf, negm, kl);
                const int cb0 = 64 * i + 4 * hi;
                float sm[2][4], cr[2][4];
#pragma unroll
                for (int half = 0; half < 2; ++half)
#pragma unroll
                    for (int a = 0; a < 4; ++a) {
                        float s4 = 0.f, last = 0.f;
#pragma unroll
                        for (int k = 0; k < 4; ++k) {
                            const int r = 4 * a + k; const int c = cb0 + 32 * half + k + 8 * a; const int dist = tq - 16 * c - 31;
                            const float sc = (half ? p1[r] : p0[r]) + blh[dist < 0 ? 0 : (dist > 128 ? 128 : dist)];
                            const float pv = dist >= 0 ? fexp2(sc) * linv : 0.f;
                            s4 += pv; last = pv;
                        }
                        sm[half][a] = s4; cr[half][a] = last;
                    }
                float tot[2][4];
#pragma unroll
                for (int half = 0; half < 2; ++half)
#pragma unroll
                    for (int a = 0; a < 4; ++a) {
                        const float xs_ = __shfl_xor(cr[half][a], 32);
                        const float xp_ = (a > 0) ? __shfl_xor(cr[half][a > 0 ? a - 1 : 0], 32) : (half ? __shfl_xor(cr[0][3], 32) : xlast);
                        tot[half][a] = sm[half][a] + (hi ? xs_ : xp_);
                    }
                xlast = __shfl_xor(cr[1][3], 32);
                for (int rr = 0; rr < 4; ++rr) {
                    if (rh == rr) {
#pragma unroll
                        for (int half = 0; half < 2; ++half)
#pragma unroll
                            for (int a = 0; a < 4; ++a) { const int j = 16 * i + 8 * half + 2 * a + hi; imp[ql * 65 + j] += tot[half][a]; }
                    }
                    __syncthreads();
                }
            }, NoComp{}, NoComp{});
        if (p.dbg_branch == 1) { for (int i = tid; i < 4096; i += 512) ((float*)(p.ws + R_H))[((size_t)g * S + q0 + (i >> 6)) * 64 + (i & 63)] = imp[(i >> 6) * 65 + (i & 63)]; }
        {
            const int q = tid >> 3, jg = tid & 7;
            unsigned long long kj[8]; int rk[8];
#pragma unroll
            for (int jj = 0; jj < 8; ++jj) { const int j = jg * 8 + jj; const float x = imp[q * 65 + j]; const float v = (j > jt) ? 0.f : ((j == jt || j == 0) ? 1e9f : x);
                kj[jj] = ((unsigned long long)__builtin_bit_cast(unsigned, v) << 6) | (unsigned)(63 - j); rk[jj] = 0; }
#pragma unroll 4
            for (int i = 0; i <= jt; ++i) {
                const float xi = imp[q * 65 + i]; const float vi = (i == jt || i == 0) ? 1e9f : xi;
                const unsigned long long ki = ((unsigned long long)__builtin_bit_cast(unsigned, vi) << 6) | (unsigned)(63 - i);
#pragma unroll
                for (int jj = 0; jj < 8; ++jj) rk[jj] += (ki > kj[jj]) ? 1 : 0;
            }
            unsigned byte = 0;
#pragma unroll
            for (int jj = 0; jj < 8; ++jj) if (jg * 8 + jj <= jt && rk[jj] < 16) byte |= 1u << jj;
            selb[q * 8 + jg] = (unsigned char)byte;
        }
        __syncthreads();
        if (w == 0) {
            unsigned a = ((const LAS unsigned*)selb)[lane * 2], c = ((const LAS unsigned*)selb)[lane * 2 + 1];
#pragma unroll
            for (int o = 1; o < 64; o <<= 1) { a |= __shfl_xor(a, o); c |= __shfl_xor(c, o); }
            const unsigned long long um = ((unsigned long long)c << 32) | a;
            if ((um >> lane) & 1ull) tl[__builtin_popcountll(um & ((1ull << lane) - 1ull))] = (unsigned char)lane;
            if (lane == 0) uni[0] = (unsigned)__builtin_popcountll(um);
        }
        __syncthreads();
        mlo = ((const LAS unsigned*)selb)[ql * 2]; mhi = ((const LAS unsigned*)selb)[ql * 2 + 1];
        nsel = (int)uni[0];
    }
    if (p.dbg_branch == 1 && rh == 0) { if (hi == 0) ((unsigned long long*)(p.ws + R_H + 4 * 1048576))[(size_t)g * S + tq] = ((unsigned long long)mhi << 32) | mlo; }
    __syncthreads();
    {
        const unsigned long long mymask = ((unsigned long long)mhi << 32) | mlo;
        nsel = __builtin_amdgcn_readfirstlane(nsel);
        const int mytl = (int)tl[lane];
        flash_init(st);
        const int jfar = qb32 >= 191 ? (qb32 - 191) >> 6 : -1;
        const int nfar = (int)__builtin_popcountll(__ballot(lane < nsel && mytl <= jfar));
        run_tiles<128, true, AL_K64, 8192, AL_V64>(nsel, nfar, nsel, nsel, lds, w, lane, 128u, (unsigned)(S * 2),
            [&](int i) { return ksn + (size_t)__builtin_amdgcn_readlane(mytl, i) * 64 * 128; }, [&](int i) { return vst + (size_t)__builtin_amdgcn_readlane(mytl, i) * 128; },
            [&](int i, LAS unsigned char* kb, LAS unsigned char* vb, LAS unsigned char* kn) {
                const int j = __builtin_amdgcn_readlane(mytl, i);
                const bool mine = (mymask >> j) & 1ull;
                tile_compute<64, 128, true>(st, fr, kn, vb, qf, negm, kl, vl, mine, [&](int r, int half, float& x) { return true; });
            },
            [&](int i, LAS unsigned char* kb, LAS unsigned char* vb, LAS unsigned char* kn) {
                const int j = __builtin_amdgcn_readlane(mytl, i);
                const bool mine = (mymask >> j) & 1ull;
                const int kb0 = 64 * j + 4 * hi;
                tile_compute<64, 128, true>(st, fr, kn, vb, qf, negm, kl, vl, mine, [&](int r, int half, float& x) { const int dist = tq - (kb0 + 32 * half + (r & 3) + 8 * (r >> 2)); x += blh[dist < 0 ? 0 : (dist > 128 ? 128 : dist)]; return dist >= 0; });
            },
            NoComp{}, [&](LAS unsigned char* kb) { kfrag_load<64, 128>(fr, kb, kl); });
        flash_accum<false>(otl, st, g1, hi, lane);
    }
    {
        const int j0 = jt >= 8 ? jt - 8 : 0, nw = jt - j0 + 1;
        flash_init(st);
        const int jfar = qb32 >= 191 ? (qb32 - 191) >> 6 : -1, jin = qb32 >= 481 ? ((qb32 - 481) >> 6) + 1 : 0;
        int ew0 = jin - j0; ew0 = ew0 < 0 ? 0 : (ew0 > nw ? nw : ew0);
        int ew1 = jfar + 1 - j0; ew1 = ew1 < ew0 ? ew0 : (ew1 > nw ? nw : ew1);
        auto wedge = [&](int i, LAS unsigned char* kb, LAS unsigned char* vb, LAS unsigned char* kn) {
            const int j = j0 + i, kb0 = 64 * j + 4 * hi;
            tile_compute<64, 128, false>(st, fr, kn, vb, qf, negm, kl, vl, true, [&](int r, int half, float& x) { const int dist = tq - (kb0 + 32 * half + (r & 3) + 8 * (r >> 2)); x += blh[dist < 0 ? 0 : (dist > 128 ? 128 : dist)]; return dist >= 0 && dist < 512; });
        };
        run_tiles<128, true, AL_K64, 8192, AL_V64>(nw, ew0, ew1, nw, lds, w, lane, 128u, (unsigned)(S * 2),
            [&](int i) { return kwn + (size_t)(j0 + i) * 64 * 128; }, [&](int i) { return vwt + (size_t)(j0 + i) * 128; },
            wedge,
            [&](int i, LAS unsigned char* kb, LAS unsigned char* vb, LAS unsigned char* kn) { tile_compute<64, 128, false>(st, fr, kn, vb, qf, negm, kl, vl, true, [&](int r, int half, float& x) { return true; }); },
            wedge, [&](LAS unsigned char* kb) { kfrag_load<64, 128>(fr, kb, kl); });
        flash_accum<false>(otl, st, g2, hi, lane);
    }
#pragma unroll
    for (int r = 0; r < 16; ++r) { const size_t ro = ((size_t)b * S + q0 + 32 * qh + crow(r, hi)) * 1024 + h * 64 + r32; ocat[ro] = f2bf(otl[r * 64 + lane]); ocat[ro + 32] = f2bf(otl[(16 + r) * 64 + lane]); }
    __syncthreads();
#ifdef PROF_SEL
    if (b == 0 && g == 0 && jt == 63 && threadIdx.x == 0) *PROF_SLOT(48) += __builtin_amdgcn_s_memtime();
#endif
}

__device__ __forceinline__ void phase_p4(const Params& p, LAS unsigned char* lds) {
    const int G = gridDim.x, c = blockIdx.x, nunits = 256 * NB;
#if NB == 8
    if (G == 256) {
        const int b = c & 7, idx = c >> 3, pi = idx & 7, hq = idx >> 3;
#pragma unroll 1
        for (int u = 0; u < 8; ++u) {
            if (u == (idx & 7)) { convert_weights(p, lds, WD_EARLY, 14); __syncthreads(); }
            if (u < 4) { const int ix = (u >> 1) ? ((idx + 16) & 31) : idx;
                nsa_unit(p, lds, b, u >> 1, (u & 1) ? ix : 63 - ix); }
            else mla_unit(p, lds, b, ((u - 4) >> 1) * 4 + hq, (u & 1) ? pi : 15 - pi);
        }
        return;
    }
#endif
    convert_weights(p, lds, WD_EARLY, 14); __syncthreads();
    for (int j = 0;; ++j) {
        const int k = j * G + ((j & 1) ? (G - 1 - c) : c);
        if (j * G >= nunits) break;
        if (k >= nunits) continue;
        const int ty = UNIT_TYPES[k / NB], b = k % NB, kind = ty >> 9, a = (ty >> 6) & 7, cc = ty & 63;
        if (kind == 0) nsa_unit(p, lds, b, a, cc); else mla_unit(p, lds, b, a, cc);
    }
}
__device__ __forceinline__ void phase_norm(const float* x, const float* g, bf16_t* xn) {
    const int tid_ = ltid(); const int lane = tid_ & 63, gw = blockIdx.x * 8 + (tid_ >> 6), NGW = gridDim.x * 8;
    for (int m = gw; m < T; m += NGW) rms_row_to_bf16(x + (size_t)m * D, g, xn + (size_t)m * D, lane);
}
__device__ __forceinline__ void phase_conv(const Params& p) {
    const int tid = ltid(), lane = tid & 63, gw = blockIdx.x * 8 + (tid >> 6), NGW = gridDim.x * 8;
    const bf16_t* bg = (const bf16_t*)(p.ws + R_H); const bf16_t* cu = (const bf16_t*)(p.ws + R_H + (size_t)T * 2048); bf16_t* v = (bf16_t*)(p.ws + R_XA); const float* cw = p.in[22];
    constexpr int RUN = 16;
    float w0[2][8], w1[2][8], w2[2][8];
#pragma unroll
    for (int j = 0; j < 2; ++j) { const int d = 8 * lane + 512 * j; load8f(cw + d, w0[j], 1.f); load8f(cw + 1024 + d, w1[j], 1.f); load8f(cw + 2048 + d, w2[j], 1.f); }
    for (int run = gw; run < T / RUN; run += NGW) {
        const int m0 = run * RUN, s0 = m0 & (S - 1);
        float pm2[2][8], pm1[2][8];
#pragma unroll
        for (int j = 0; j < 2; ++j) { const int d = 8 * lane + 512 * j;
#pragma unroll
            for (int q = 0; q < 2; ++q) {
                float (&dst)[8] = q ? pm1[j] : pm2[j];
                if (s0 - 2 + q >= 0) unpack8(*(const u32x4*)(cu + (size_t)(m0 - 2 + q) * 1024 + d), dst);
                else {
#pragma unroll
                    for (int i = 0; i < 8; ++i) dst[i] = 0.f; }
            } }
#pragma unroll 4
        for (int rr = 0; rr < RUN; ++rr) {
            const int m = m0 + rr;
#pragma unroll
            for (int j = 0; j < 2; ++j) { const int d = 8 * lane + 512 * j;
                float b[8], c[8], y[8]; unpack8(*(const u32x4*)(bg + (size_t)m * 1024 + d), b); unpack8(*(const u32x4*)(cu + (size_t)m * 1024 + d), c);
#pragma unroll
                for (int i = 0; i < 8; ++i) { y[i] = b[i] * (w0[j][i] * pm2[j][i] + w1[j][i] * pm1[j][i] + w2[j][i] * c[i]); pm2[j][i] = pm1[j][i]; pm1[j][i] = c[i]; }
                *(u32x4*)(v + (size_t)m * 1024 + d) = pack8(y); }
        }
    }
}
__device__ __forceinline__ void phase_norm_router(const Params& p, LAS unsigned char* lds) {
    const int tid = ltid(), lane = tid & 63, wave = tid >> 6, gw = blockIdx.x * 8 + wave, NGW = gridDim.x * 8;
    const bf16_t* x3 = (const bf16_t*)(p.ws + R_XN); const float* g = p.in[24]; float* rsd = (float*)(p.ws + SM_RSTD3);
    LAS float* wr = (LAS float*)lds;
    LAS int* lcnt = (LAS int*)(lds + 40960); LAS int* gb = lcnt + 8;
    int* te = (int*)(p.ws + SM_TE); float* tw = (float*)(p.ws + SM_TW); int* rank = (int*)(p.ws + SM_RANK); int* cnt = (int*)(p.ws + SM_CTL);
    for (int i = tid; i < 8192; i += 512) { const int dd = i >> 3; wr[dd * 8 + (dd >> 2) * 4 + (i & 7)] = p.in[25][i] * g[dd]; }
    if (tid < 8) lcnt[tid] = 0;
    __syncthreads();
    u32x2 nx[4];
#pragma unroll
    for (int j = 0; j < 4; ++j) nx[j] = ((const u32x2*)(x3 + (size_t)(gw < T ? gw : 0) * D) + lane)[64 * j];
    for (int m = gw; m < T; m += NGW) {
        f32x4 v[4]; float s = 0.f;
#pragma unroll
        for (int j = 0; j < 4; ++j) { const u32x2 t = nx[j]; v[j] = (f32x4){bflo(t.x), bfhi(t.x), bflo(t.y), bfhi(t.y)}; s += (v[j].x * v[j].x + v[j].y * v[j].y) + (v[j].z * v[j].z + v[j].w * v[j].w); }
        { const int mn = m + NGW < T ? m + NGW : m;
#pragma unroll
            for (int j = 0; j < 4; ++j) nx[j] = ((const u32x2*)(x3 + (size_t)mn * D) + lane)[64 * j]; }
        float lg[8];
#pragma unroll
        for (int e = 0; e < 8; ++e) lg[e] = 0.f;
#pragma unroll
        for (int j = 0; j < 4; ++j) {
#pragma unroll
            for (int i = 0; i < 4; ++i) { const int d = 4 * lane + 256 * j + i; const f32x4 w0 = *(const LAS f32x4*)(wr + d * 8 + (d >> 2) * 4), w1 = *(const LAS f32x4*)(wr + d * 8 + (d >> 2) * 4 + 4); const float y = v[j][i];
                lg[0] += y * w0.x; lg[1] += y * w0.y; lg[2] += y * w0.z; lg[3] += y * w0.w; lg[4] += y * w1.x; lg[5] += y * w1.y; lg[6] += y * w1.z; lg[7] += y * w1.w; } }
        const float r = rsqrtf(wsum(s) * (1.f / 1024.f) + EPS);
#pragma unroll
        for (int e = 0; e < 8; ++e) lg[e] = wsum(lg[e]) * r + p.in[26][e];
        int e1 = 0; float l1 = lg[0];
#pragma unroll
        for (int e = 1; e < 8; ++e) if (lg[e] > l1) { l1 = lg[e]; e1 = e; }
        int e2 = -1; float l2 = -3e38f;
#pragma unroll
        for (int e = 0; e < 8; ++e) if (e != e1 && lg[e] > l2) { l2 = lg[e]; e2 = e; }
        if (lane == 0) {
            const float w1 = 1.f / (1.f + __expf(l2 - l1));
            te[m * 2] = e1; te[m * 2 + 1] = e2; tw[m * 2] = w1; tw[m * 2 + 1] = 1.f - w1; rsd[m] = r;
            rank[m * 2] = __hip_atomic_fetch_add(&lcnt[e1], 1, __ATOMIC_RELAXED, __HIP_MEMORY_SCOPE_WORKGROUP); rank[m * 2 + 1] = __hip_atomic_fetch_add(&lcnt[e2], 1, __ATOMIC_RELAXED, __HIP_MEMORY_SCOPE_WORKGROUP);
        }
    }
    __syncthreads();
    if (tid < 8) gb[tid] = atomicAdd(&cnt[tid], lcnt[tid]);
    __syncthreads();
    for (int m = gw; m < T; m += NGW) if (lane < 2) rank[m * 2 + lane] += gb[te[m * 2 + lane]];
}
__device__ __forceinline__ void phase_moe_gather(const Params& p) {
    const int tid = ltid(), lane = tid & 63, gw = blockIdx.x * 8 + (tid >> 6), NGW = gridDim.x * 8;
    const int* cnt = (const int*)(p.ws + SM_CTL); const int* te = (const int*)(p.ws + SM_TE); const float* tw = (const float*)(p.ws + SM_TW); const int* rank = (const int*)(p.ws + SM_RANK);
    int* pos = (int*)(p.ws + SM_POS); float* roww = (float*)(p.ws + SM_ROWW); int* tile_e = (int*)(p.ws + SM_TILEE);
    int* rowtok = (int*)(p.ws + SM_ROWTOK); const float* rsd = (const float*)(p.ws + SM_RSTD3); float* rowrs = (float*)(p.ws + SM_ROWRS);
    int off[9]; off[0] = 0;
#pragma unroll
    for (int e = 0; e < 8; ++e) off[e + 1] = off[e] + ((cnt[e] + 255) & ~255);
    if (blockIdx.x == 0) {
        for (int i = tid; i < ROWS_MAX / 256; i += 512) { int e = -1;
#pragma unroll
            for (int k = 0; k < 8; ++k) if (i * 256 >= off[k] && i * 256 < off[k + 1]) e = k;
            tile_e[i] = e < 0 ? 0 : e; }
        if (tid == 0) ((int*)(p.ws + SM_CTL))[8] = off[8];
    }
    if (blockIdx.x < 8 && tid < 256) {
#pragma unroll
        for (int e = 0; e < 8; ++e) if (e == (int)blockIdx.x) { const int c = cnt[e]; if (c + tid < off[e + 1] - off[e]) { roww[off[e] + c + tid] = 0.f; rowrs[off[e] + c + tid] = 0.f; rowtok[off[e] + c + tid] = -1; } }
    }
    for (int pi0 = gw * 4; pi0 < 2 * T; pi0 += NGW * 4) {
        int r[4]; float w[4], rs[4];
#pragma unroll
        for (int q = 0; q < 4; ++q) { const int e = te[pi0 + q]; int o = 0;
#pragma unroll
            for (int k = 0; k < 8; ++k) if (k == e) o = off[k];
            r[q] = o + rank[pi0 + q]; w[q] = tw[pi0 + q]; rs[q] = rsd[(pi0 + q) >> 1]; }
#pragma unroll
        for (int q = 0; q < 4; ++q) if (lane == q) { pos[pi0 + q] = r[q]; roww[r[q]] = w[q]; rowrs[r[q]] = rs[q]; rowtok[r[q]] = (pi0 + q) >> 1; }
    }
}
__device__ __forceinline__ void phase_moe_combine(const Params& p) {
    const int tid_ = ltid(); const int lane = tid_ & 63, gw = blockIdx.x * 8 + (tid_ >> 6), NGW = gridDim.x * 8;
    const int* pos = (const int*)(p.ws + SM_POS); const bf16_t* ym = (const bf16_t*)(p.ws + R_XA); const bf16_t* x3 = (const bf16_t*)(p.ws + R_XN);
    for (int m0 = gw * 2; m0 < T; m0 += NGW * 2) {
        int ps[4];
#pragma unroll
        for (int q = 0; q < 4; ++q) ps[q] = pos[m0 * 2 + q];
        f32x4 x[2][4]; u32x2 ya[2][4], yc[2][4];
#pragma unroll
        for (int q = 0; q < 2; ++q)
#pragma unroll
            for (int j = 0; j < 4; ++j) { const int d = 4 * lane + 256 * j;
                { const u32x2 t = *(const u32x2*)(x3 + (size_t)(m0 + q) * D + d); x[q][j] = (f32x4){bflo(t.x), bfhi(t.x), bflo(t.y), bfhi(t.y)}; } ya[q][j] = *(const u32x2*)(ym + (size_t)ps[2 * q] * D + d); yc[q][j] = *(const u32x2*)(ym + (size_t)ps[2 * q + 1] * D + d); }
#pragma unroll
        for (int q = 0; q < 2; ++q)
#pragma unroll
            for (int j = 0; j < 4; ++j) { const int d = 4 * lane + 256 * j; f32x4 o = x[q][j]; const u32x2 a = ya[q][j], c = yc[q][j];
                o.x += bflo(a.x) + bflo(c.x); o.y += bfhi(a.x) + bfhi(c.x); o.z += bflo(a.y) + bflo(c.y); o.w += bfhi(a.y) + bfhi(c.y);
                *(f32x4*)(p.out + (size_t)(m0 + q) * D + d) = o; }
    }
}

#define XB_TMO      128
#define XB_XCNT(j)  (256  + 64 * (j))
#define XB_XSUB(j)  (1280 + 64 * (j))
#define XB_XGEN(j)  (2304 + 64 * (j))
#define XB_TOP      3328
#define XB_TOPGEN   3392
#define XCD_BAR_WORDS 3456
#define XB_SPIN_CAP (1u << 18)

__device__ __forceinline__ unsigned xb_ld(unsigned* p)              { return __hip_atomic_load(p, __ATOMIC_RELAXED, __HIP_MEMORY_SCOPE_AGENT); }
__device__ __forceinline__ unsigned xb_add(unsigned* p, unsigned v) { return __hip_atomic_fetch_add(p, v, __ATOMIC_RELAXED, __HIP_MEMORY_SCOPE_AGENT); }
__device__ __forceinline__ unsigned xb_xcc_id() { return (unsigned)__builtin_amdgcn_s_getreg((3 << 11) | 20) & 0xFu; }
#define XB_SPIN(cond, bar) do { unsigned _sp = 0; while (cond) { __builtin_amdgcn_s_sleep(1); \
    if ((++_sp & 255u) == 0u) { if (xb_ld(&(bar)[XB_TMO])) break; if (_sp > XB_SPIN_CAP) { atomicAdd(&(bar)[XB_TMO], 1u); break; } } } } while (0)

struct XcdBarrier {
    unsigned* bar; unsigned x;
    volatile LAS unsigned* st;
};

__device__ __forceinline__ XcdBarrier xcd_barrier_post(unsigned* bar, volatile LAS unsigned* st) {
    XcdBarrier b; b.bar = bar; b.x = xb_xcc_id(); b.st = st;
    if (threadIdx.x == 0) (void)xb_add(&bar[XB_XCNT(b.x)], 1u);
    return b;
}
__device__ __forceinline__ void xcd_barrier_complete(unsigned* bar, unsigned x, unsigned& nloc, unsigned& nx) {
    const unsigned G = gridDim.x * gridDim.y * gridDim.z;
    unsigned sum, cnt, mine, sp = 0u;
    for (;;) {
        sum = 0u; cnt = 0u; mine = 0u;
#pragma unroll
        for (unsigned j = 0; j < 16; ++j) { const unsigned c = xb_ld(&bar[XB_XCNT(j)]); sum += c; cnt += (c > 0u) ? 1u : 0u; mine = (j == x) ? c : mine; }
        if (sum == G) break;
        __builtin_amdgcn_s_sleep(1);
        if ((++sp & 255u) == 0u) { if (xb_ld(&bar[XB_TMO])) break; if (sp > XB_SPIN_CAP) { atomicAdd(&bar[XB_TMO], 1u); break; } }
    }
    nloc = mine > 0u ? mine : 1u; nx = cnt > 0u ? cnt : 1u;
}

__device__ __forceinline__ void xcd_barrier(const XcdBarrier& b) {
    asm volatile("s_waitcnt vmcnt(0)" ::: "memory");
    __syncthreads();
    if (threadIdx.x == 0) {
        unsigned* bar = b.bar;
        __builtin_amdgcn_s_waitcnt(0);
        unsigned nloc = b.st[0], nx = b.st[1];
        if (nloc == 0u) { xcd_barrier_complete(bar, b.x, nloc, nx); b.st[0] = nloc; b.st[1] = nx; }
        const unsigned old = xb_add(&bar[XB_XSUB(b.x)], 1u);
        const unsigned gen = old / nloc;
        if (old + 1u == (gen + 1u) * nloc) {
            __builtin_amdgcn_fence(__ATOMIC_RELEASE, "agent");
            asm volatile("s_waitcnt vmcnt(0)" ::: "memory");
            const unsigned og = xb_add(&bar[XB_TOP], 1u);
            const unsigned tg = og / nx;
            if (og + 1u == (tg + 1u) * nx) xb_add(&bar[XB_TOPGEN], 1u);
            else XB_SPIN(xb_ld(&bar[XB_TOPGEN]) == tg, bar);
            __builtin_amdgcn_fence(__ATOMIC_ACQUIRE, "agent");
            xb_add(&bar[XB_XGEN(b.x)], 1u);
            asm volatile("s_waitcnt vmcnt(0)" ::: "memory");
        } else {
            XB_SPIN(xb_ld(&bar[XB_XGEN(b.x)]) == gen, bar);
            __builtin_amdgcn_fence(__ATOMIC_ACQUIRE, "agent");
            asm volatile("s_waitcnt vmcnt(0)" ::: "memory");
        }
    }
    __syncthreads();
}


__global__ void __launch_bounds__(512) mega_fwd(Params p) {
    extern __shared__ __attribute__((aligned(16))) unsigned char lds_raw[];
    LAS unsigned char* lds = (LAS unsigned char*)lds_raw;
    cg::grid_group grid = cg::this_grid();
    volatile LAS unsigned* bst = (volatile LAS unsigned*)(lds + 163328);
    if (threadIdx.x == 0) { bst[0] = 0u; bst[1] = 0u; const unsigned long long ba = (unsigned long long)(p.ws + SM_BAR); bst[2] = (unsigned)ba; bst[3] = (unsigned)(ba >> 32); }
    __syncthreads();
    (void)xcd_barrier_post((unsigned*)(p.ws + SM_BAR), bst);
#ifdef PROF_SEL
#define PSTAMP(k) do { if (blockIdx.x == 0 && threadIdx.x == 0) { volatile LAS unsigned* pl_ = (volatile LAS unsigned*)(lds + 163328 + 16); const unsigned long long now_ = __builtin_amdgcn_s_memrealtime(); const unsigned long long last_ = ((unsigned long long)pl_[1] << 32) | pl_[0]; *PROF_SLOT(k) += now_ - last_; pl_[0] = (unsigned)now_; pl_[1] = (unsigned)(now_ >> 32); } } while (0)
#else
#define PSTAMP(k)
#endif
#define GSYNC() do { XcdBarrier xb_; volatile LAS unsigned* st_ = (volatile LAS unsigned*)(lds + 163328); xb_.bar = (unsigned*)(((unsigned long long)st_[3] << 32) | st_[2]); xb_.x = xb_xcc_id(); xb_.st = st_; xcd_barrier(xb_); } while (0)
#ifdef PROF_SEL
    if (threadIdx.x == 0) { volatile LAS unsigned* pl_ = (volatile LAS unsigned*)(lds + 163328 + 16); const unsigned long long now_ = __builtin_amdgcn_s_memrealtime(); pl_[0] = (unsigned)now_; pl_[1] = (unsigned)(now_ >> 32); }
#endif
    const int G = gridDim.x, c = blockIdx.x;
#define LP() bf16_t* W = (bf16_t*)p.ws; bf16_t* xn = (bf16_t*)(p.ws + R_XN); float* x1 = (float*)(p.ws + R_XA); pg8::StaticOrder SO; (void)W; (void)xn; (void)x1; (void)SO
#ifndef PHMASK
#define PHMASK 0xFFFFFFFFu
#endif
#ifndef REPEAT_MASK
#define REPEAT_MASK 0u
#endif
#define PH(k) if (((PHMASK >> (k)) & 1u) && (k) >= p.ph_lo && (k) <= p.ph_hi)
#define RPT(k) if ((REPEAT_MASK >> (k)) & 1u)
    PH(0) { LP(); phase_p0(p, lds); }
    GSYNC(); PSTAMP(0);
    if (p.ph_lo == -12345) grid.sync();
    RPT(0) { { LP(); phase_p0(p, lds); } GSYNC(); }
    PH(1) for (int rp_ = 0; rp_ <= (int)((REPEAT_MASK >> 1) & 1u); ++rp_) { LP(); if (rp_) GSYNC();
        pg8::Gemm g{xn, W + W_IN_E / 2, T, 1792, 1024, 1024, nullptr, 0, nullptr}; SO.init(T, 1792, G, c);
        pg8::EpiBf16<0> E{(bf16_t*)(p.ws + R_H), 1792, nullptr, nullptr};
        pg8::gemm_phase<pg8::EpiBf16<0>, true>(lds, g, SO, E);
    }
    GSYNC(); PSTAMP(1);
    PH(2) { LP(); phase_p2(p, lds); }
    GSYNC(); PSTAMP(2);
    RPT(2) { { LP(); phase_p2(p, lds); } GSYNC(); }
    PH(3) for (int rp_ = 0; rp_ <= (int)((REPEAT_MASK >> 3) & 1u); ++rp_) { LP(); if (rp_) GSYNC();
        const int nCu = 2 * (NB * 512 / 256) * 2, Gc = (nCu < G / 2) ? nCu : 0;
        if (Gc == 0 || c < Gc) {
            for (int kv = 0; kv < 2; ++kv) {
                pg8::Gemm g{(const bf16_t*)(p.ws + R_XA + (kv ? A_VCIN : A_KCIN)), W + W_CW1 / 2 + (size_t)kv * 512 * 1024, NB * 512, 512, 1024, 1024, nullptr, 0, nullptr};
                if (Gc) SO.init(NB * 512, 512, Gc / 2, c - kv * (Gc / 2)); else SO.init(NB * 512, 512, G, c);
                pg8::EpiBf16<0> E{(bf16_t*)(p.ws + SM_HID) + (size_t)kv * NB * 512 * 512, 512, nullptr, nullptr};
                if (Gc == 0 || (c / (Gc / 2)) == kv) pg8::gemm_phase<pg8::EpiBf16<0>, true>(lds, g, SO, E);
            }
        }
        if (Gc == 0 || c >= Gc) {
            {
                pg8::Gemm g{(const bf16_t*)(p.ws + R_XA + A_CQN), W + W_UQ / 2, T, 1024, 256, 256, nullptr, 0, nullptr}; SO.init(T, 1024, G - Gc, c - Gc);
                pg8::EpiBf16<0> E{(bf16_t*)(p.ws + R_H), 1024, nullptr, nullptr};
                pg8::gemm_phase<pg8::EpiBf16<0>, true>(lds, g, SO, E);
            }
            {
                pg8::Gemm g{(const bf16_t*)(p.ws + R_XA + A_CKVN), W + W_UKV / 2, T, 1024, 128, 128, nullptr, 0, nullptr}; SO.init(T, 1024, G - Gc, c - Gc);
                pg8::EpiBf16<0> E{(bf16_t*)(p.ws + R_H + (size_t)T * 2048), 1024, nullptr, nullptr};
                pg8::gemm_phase<pg8::EpiBf16<0>, true>(lds, g, SO, E);
            }
        }
    }
    GSYNC(); PSTAMP(3);
    PH(4) { LP(); phase_p3b(p, lds); }
    GSYNC(); PSTAMP(4);
#ifndef P3B_PROBE
#define P3B_PROBE 3
#endif
    RPT(4) { { LP(); phase_p3b(p, lds, P3B_PROBE); } GSYNC(); }
    PH(5) { LP(); phase_p4(p, lds); }
    GSYNC(); PSTAMP(5);
    RPT(5) { { LP(); phase_p4(p, lds); } GSYNC(); }
    PH(6) for (int rp_ = 0; rp_ <= (int)((REPEAT_MASK >> 6) & 1u); ++rp_) { LP(); if (rp_) GSYNC();
        pg8::Gemm g{xn, W + W_OUT_E / 2, T, 1024, 1024, 1024, nullptr, 0, nullptr}; SO.init(T, 1024, G, c);
        pg8::EpiResStat<false> E{p.in[0], (bf16_t*)p.out, (float*)(p.ws + SM_SSP1), 1024};
        pg8::gemm_phase<pg8::EpiResStat<false>, true>(lds, g, SO, E);
    }
    GSYNC(); PSTAMP(6);
    PH(7) { }
    PH(8) for (int rp_ = 0; rp_ <= (int)((REPEAT_MASK >> 8) & 1u); ++rp_) { LP(); if (rp_) GSYNC();
        pg8::Gemm g{(const bf16_t*)p.out, W + W_GU / 2, T, 5632, 1024, 1024, nullptr, 0, nullptr}; SO.init(T, 5632, G, c);
        pg8::EpiSwiGLUSsp E{(bf16_t*)(p.ws + R_H), 2816, (const float*)(p.ws + SM_SSP1)};
        pg8::gemm_phase<pg8::EpiSwiGLUSsp, true>(lds, g, SO, E);
    }
    GSYNC(); PSTAMP(8);
    PH(9) for (int rp_ = 0; rp_ <= (int)((REPEAT_MASK >> 9) & 1u); ++rp_) { LP(); if (rp_) GSYNC();
        pg8::Gemm g{(const bf16_t*)(p.ws + R_H), W + W_D / 2, T, 1024, 2816, 2816, nullptr, 0, nullptr}; SO.init(T, 1024, G, c);
        pg8::EpiResStat<true> E{(const bf16_t*)p.out, xn, (float*)(p.ws + SM_SSP2), 1024};
        pg8::gemm_phase<pg8::EpiResStat<true>, true>(lds, g, SO, E);
    }
    GSYNC(); PSTAMP(9);
    PH(10) { }
    PH(11) for (int rp_ = 0; rp_ <= (int)((REPEAT_MASK >> 11) & 1u); ++rp_) { LP(); if (rp_) GSYNC();
        pg8::Gemm g{xn, W + W_IN_O / 2, T, 3072, 1024, 1024, nullptr, 0, nullptr}; SO.init(T, 3072, G, c);
        pg8::EpiConvInSsp E{(bf16_t*)(p.ws + R_H), (bf16_t*)(p.ws + R_H + (size_t)T * 2048), (const float*)(p.ws + SM_SSP2)};
        pg8::gemm_phase<pg8::EpiConvInSsp, true>(lds, g, SO, E);
    }
    GSYNC(); PSTAMP(11);
    PH(12) { LP(); phase_conv(p); }
    GSYNC(); PSTAMP(12);
    RPT(12) { { LP(); phase_conv(p); } GSYNC(); }
    PH(13) { LP();
        pg8::Gemm g{(const bf16_t*)x1, W + W_OUT_O / 2, T, 1024, 1024, 1024, nullptr, 0, nullptr}; SO.init(T, 1024, G, c);
        pg8::EpiResBf16B E{xn, xn, 1024};
        pg8::gemm_phase<pg8::EpiResBf16B, true>(lds, g, SO, E);
    }
    GSYNC(); PSTAMP(13);
    PH(14) { LP(); phase_norm_router(p, lds); }
    GSYNC(); PSTAMP(14);
    PH(15) { LP(); phase_moe_gather(p); }
    RPT(15) { GSYNC(); { LP(); phase_moe_gather(p); } }
    GSYNC(); PSTAMP(15);
    PH(16) for (int rp_ = 0; rp_ <= (int)((REPEAT_MASK >> 16) & 1u); ++rp_) { LP(); if (rp_) GSYNC();
        pg8::Gemm g{(const bf16_t*)(p.ws + R_XN), W + W_MGU / 2, 2 * T, 2816, 1024, 1024, (const int*)(p.ws + SM_TILEE), (size_t)2816 * 1024, (const int*)(p.ws + SM_ROWTOK)}; SO.init(2 * T, 2816, G, c);
        pg8::EpiSwiGLULds E{(bf16_t*)(p.ws + R_H), 1408, (const float*)(p.ws + SM_ROWRS)};
        pg8::gemm_phase<pg8::EpiSwiGLULds, true, true>(lds, g, SO, E);
    }
    GSYNC(); PSTAMP(16);
    PH(17) { LP(); const int mrows = ((const int*)(p.ws + SM_CTL))[8]; const int nx = mrows / 256 - 2 * T / 256;
        unsigned* dep = (unsigned*)(p.ws + SM_BAR) + 3584;
        const int nprod = 11 * nx < G ? 11 * nx : G, ncons = 4 * nx < G ? 4 * nx : G;
        if (c < nprod) {
            pg8::Gemm g{(const bf16_t*)(p.ws + R_XN), W + W_MGU / 2, 256 * nx, 2816, 1024, 1024, (const int*)(p.ws + SM_TILEE) + 2 * T / 256, (size_t)2816 * 1024, (const int*)(p.ws + SM_ROWTOK) + 2 * T}; SO.init(256 * nx, 2816, G, c);
            pg8::EpiSwiGLULds E{(bf16_t*)(p.ws + R_H) + (size_t)2 * T * 1408, 1408, (const float*)(p.ws + SM_ROWRS) + 2 * T};
            pg8::gemm_phase<pg8::EpiSwiGLULds, true, true>(lds, g, SO, E);
            asm volatile("s_waitcnt vmcnt(0)" ::: "memory");
            __syncthreads();
            if (threadIdx.x == 0) { __builtin_amdgcn_fence(__ATOMIC_RELEASE, "agent"); asm volatile("s_waitcnt vmcnt(0)" ::: "memory"); (void)xb_add(dep, 1u); }
        }
        {
            pg8::Gemm g{(const bf16_t*)(p.ws + R_H), W + W_MD / 2, 2 * T, 1024, 1408, 1408, (const int*)(p.ws + SM_TILEE), (size_t)1024 * 1408, nullptr}; SO.init(2 * T, 1024, G, c);
            pg8::EpiRowScaleLds E{(bf16_t*)(p.ws + R_XA), 1024, (const float*)(p.ws + SM_ROWW)};
            pg8::gemm_phase<pg8::EpiRowScaleLds, true>(lds, g, SO, E);
        }
        if (G - 1 - c < ncons) {
            if (threadIdx.x == 0) { unsigned* bar = (unsigned*)(p.ws + SM_BAR); XB_SPIN(xb_ld(dep) < (unsigned)nprod, bar); __builtin_amdgcn_fence(__ATOMIC_ACQUIRE, "agent"); asm volatile("s_waitcnt vmcnt(0)" ::: "memory"); }
            __syncthreads();
            pg8::Gemm g{(const bf16_t*)(p.ws + R_H) + (size_t)2 * T * 1408, W + W_MD / 2, 256 * nx, 1024, 1408, 1408, (const int*)(p.ws + SM_TILEE) + 2 * T / 256, (size_t)1024 * 1408, nullptr}; SO.init(256 * nx, 1024, G, G - 1 - c);
            pg8::EpiRowScaleLds E{(bf16_t*)(p.ws + R_XA) + (size_t)2 * T * 1024, 1024, (const float*)(p.ws + SM_ROWW) + 2 * T};
            pg8::gemm_phase<pg8::EpiRowScaleLds, true>(lds, g, SO, E);
        }
    }
    GSYNC(); PSTAMP(17);
    PH(18) { LP(); phase_moe_combine(p); }
    RPT(18) { GSYNC(); { LP(); phase_moe_combine(p); } }
#ifdef PROF_SEL
    GSYNC(); PSTAMP(18);
    GSYNC();
    {
        unsigned long long v_ = *PROF_SLOT(PROF_SEL);
#ifdef PROF_DIV
        const unsigned long long dv_ = *PROF_SLOT(PROF_DIV); v_ = dv_ ? v_ / dv_ : 0ull;
#endif
        unsigned long long a_ = v_ / (unsigned long long)(PROF_UNIT); if (a_ > 27ull) a_ = 27ull;
        const float sc_ = 1.f + (float)a_;
        for (size_t i = (size_t)blockIdx.x * 512 + threadIdx.x; i < (size_t)S * 1024 / 4; i += (size_t)gridDim.x * 512) { f32x4* o = (f32x4*)p.out + i; *o = *o * sc_; }
    }
#endif
#undef PH
}

inline void launch(void* const* d_in, float* d_out, void* d_ws, size_t ws_size, hipStream_t stream, int ph_lo = 0, int ph_hi = 99, int dbg_branch = -1) {
    static int grid = 0;
    if (grid == 0) {
        int dev = 0, cus = 0, per_cu = 0;
        hipGetDevice(&dev); hipDeviceGetAttribute(&cus, hipDeviceAttributeMultiprocessorCount, dev);
        hipFuncSetAttribute((const void*)mega_fwd, hipFuncAttributeMaxDynamicSharedMemorySize, LDS_BYTES);
        hipOccupancyMaxActiveBlocksPerMultiprocessor(&per_cu, (const void*)mega_fwd, 512, LDS_BYTES);
        if (per_cu < 1) { fprintf(stderr, "occupancy query says %d blocks/CU\n", per_cu); per_cu = 1; }
        grid = cus;
        if (WS_FAST_END > ws_size) { fprintf(stderr, "ws too small: need %zu have %zu\n", (size_t)WS_FAST_END, ws_size); grid = -1; }
    }
    if (grid < 0) return;
    if (ph_lo <= 14 && ph_hi >= 14) hipMemsetAsync((char*)d_ws + SM_CTL, 0, 4096, stream);
    hipMemsetAsync((char*)d_ws + SM_BAR, 0, 16384, stream);
    Params p{};
    for (int i = 0; i < 30; ++i) p.in[i] = (const float*)d_in[i];
    p.out = d_out; p.ws = (unsigned char*)d_ws; p.ph_lo = ph_lo; p.ph_hi = ph_hi; p.dbg_branch = dbg_branch;
    void* args[] = {&p};
    hipError_t e = hipLaunchCooperativeKernel((const void*)mega_fwd, dim3(grid), dim3(512), args, LDS_BYTES, stream);
    if (e != hipSuccess) fprintf(stderr, "cooperative launch failed: %s (grid %d)\n", hipGetErrorString(e), grid);
}
}
extern "C" void kernel_launch(void* const* d_in, const int* in_sizes, int n_in, void* d_out, int out_size, void* d_ws, size_t ws_size, hipStream_t stream) {
    fast::launch(d_in, (float*)d_out, d_ws, ws_size, stream);
}
```
